# Optimizing an MI355X kernel written in HIP

```python
import math
import jax
import jax.numpy as jnp
from jax import lax
import numpy as np

D_MODEL = 1024
BATCH = 16
SEQ = 4096
DEPTH = 4

CHUNK = 64
BLOCK_Q = 128
N_BRANCH = 4
HEAD_DIM = 64
BRANCH_HEADS = 4
BRANCH_WIDTH = BRANCH_HEADS * HEAD_DIM

LRU_WIDTH = BRANCH_WIDTH
LRU_BLOCKS = BRANCH_HEADS
LRU_BLOCK = LRU_WIDTH // LRU_BLOCKS
LRU_C = 8.0
CONV_W = 4
SB_HEADS = BRANCH_HEADS
SB_WIDTH = BRANCH_WIDTH
GDN_HEADS = BRANCH_HEADS
GDN_WIDTH = BRANCH_WIDTH
RW_HEADS = BRANCH_HEADS
RW_WIDTH = BRANCH_WIDTH
W_LORA = 32
A_LORA = 32
G_LORA = 64
RW_LN_EPS = 64e-5
FFN_DIM = 2816
FFN_CONV_W = 3
EPS = 1e-6

LRU_IN = (LRU_WIDTH, LRU_WIDTH)
SB_IN = (SB_WIDTH, SB_WIDTH, SB_WIDTH)
GDN_IN = (GDN_WIDTH, GDN_WIDTH, GDN_WIDTH, GDN_WIDTH, GDN_HEADS, GDN_HEADS)
RW_IN = (RW_WIDTH, RW_WIDTH, RW_WIDTH, W_LORA, A_LORA, G_LORA)
MIXER_IN = (sum(LRU_IN), sum(SB_IN), sum(GDN_IN), sum(RW_IN))
IN_DIM = sum(MIXER_IN)

kernel_name = "hybrid_gated_parallel_mixer_trunk"


def _split(t, widths):
    cuts = [int(v) for v in np.cumsum(widths)[:-1]]
    return jnp.split(t, cuts, axis=-1)


def rms_norm(x, g):
    xf = x.astype(jnp.float32)
    y = xf * lax.rsqrt(jnp.mean(xf * xf, axis=-1, keepdims=True) + EPS)
    return (y * g.astype(jnp.float32)).astype(x.dtype)


def l2_normalize(t):
    return t * lax.rsqrt(jnp.sum(t * t, axis=-1, keepdims=True) + EPS)


def causal_depthwise_conv(x, w):
    width, seq = w.shape[0], x.shape[1]
    xp = jnp.pad(x, ((0, 0), (width - 1, 0), (0, 0)))
    return sum(xp[:, j:j + seq] * w[j] for j in range(width))


def token_shift(x):
    return jnp.pad(x, ((0, 0), (1, 0), (0, 0)))[:, :-1]


def rg_lru_branch(p, conv_w, conv_b, w_r, b_r, w_i, b_i, lam):
    bsz, seq, _ = p.shape
    x_in, y_in = _split(p, LRU_IN)
    u = (causal_depthwise_conv(x_in, conv_w) + conv_b).astype(jnp.float32)
    ub = u.reshape(bsz, seq, LRU_BLOCKS, LRU_BLOCK)
    r = jax.nn.sigmoid(jnp.einsum('bsne,nef->bsnf', ub, w_r.astype(jnp.float32)).reshape(bsz, seq, LRU_WIDTH) + b_r)
    i = jax.nn.sigmoid(jnp.einsum('bsne,nef->bsnf', ub, w_i.astype(jnp.float32)).reshape(bsz, seq, LRU_WIDTH) + b_i)
    log_a = -LRU_C * r * jax.nn.softplus(-lam.astype(jnp.float32))
    a = jnp.exp(log_a)
    b = jnp.sqrt(-jnp.expm1(2.0 * log_a)) * (i * u)

    def combine(e1, e2):
        return (e1[0] * e2[0], e2[0] * e1[1] + e2[1])

    _, h = lax.associative_scan(combine, (a, b), axis=1)
    return (h * jax.nn.gelu(y_in.astype(jnp.float32))).astype(p.dtype)


def stick_breaking_branch(p):
    bsz, seq, _ = p.shape
    q, k, v = [t.reshape(bsz, seq, SB_HEADS, HEAD_DIM).astype(jnp.float32) for t in _split(p, SB_IN)]
    scale = HEAD_DIM ** -0.5
    blocks = []
    for blk in range(seq // BLOCK_Q):
        start, end = blk * BLOCK_Q, (blk + 1) * BLOCK_Q
        z = jnp.einsum('bqhd,bshd->bhqs', q[:, start:end], k[:, :end]) * scale
        t_pos = start + jnp.arange(BLOCK_Q)
        s_pos = jnp.arange(end)
        past = s_pos[None, :] < t_pos[:, None]
        neg_log_keep = jnp.where(past, jax.nn.softplus(z), 0.0)
        between = lax.cumsum(neg_log_keep, axis=3, reverse=True) - neg_log_keep
        weight = jnp.where(past, jnp.exp(jax.nn.log_sigmoid(z) - between), 0.0)
        blocks.append(jnp.einsum('bhqs,bshd->bqhd', weight, v[:, :end]))
    return jnp.concatenate(blocks, axis=1).reshape(bsz, seq, SB_WIDTH).astype(p.dtype)


def chunked_gated_delta_rule(q, k, v, g, beta):
    bsz, seq, nh, dk = q.shape
    dv = v.shape[-1]
    nc = seq // CHUNK

    def chunks(t):
        return t.reshape(bsz, nc, CHUNK, nh, t.shape[-1]).transpose(0, 3, 1, 2, 4)

    q, k, v = chunks(q), chunks(k), chunks(v)
    g = g.reshape(bsz, nc, CHUNK, nh).transpose(0, 3, 1, 2)
    beta = beta.reshape(bsz, nc, CHUNK, nh).transpose(0, 3, 1, 2)
    G = jnp.cumsum(g, axis=-1)
    pos = jnp.arange(CHUNK)
    incl = pos[:, None] >= pos[None, :]
    strict = pos[:, None] > pos[None, :]
    decay = jnp.exp(jnp.where(incl, G[..., :, None] - G[..., None, :], -jnp.inf))
    k_beta = k * beta[..., None]
    lower = jnp.where(strict, jnp.einsum('bhnid,bhnjd->bhnij', k_beta, k) * decay, 0.0)
    rhs = jnp.concatenate([v * beta[..., None], k_beta * jnp.exp(G)[..., None]], axis=-1)
    sol = lax.linalg.triangular_solve(lower + jnp.eye(CHUNK, dtype=lower.dtype), rhs,
                                      left_side=True, lower=True, unit_diagonal=True)
    u_intra, w_state = sol[..., :dv], sol[..., dv:]
    qk = jnp.einsum('bhnid,bhnjd->bhnij', q, k) * decay
    q_dec = q * jnp.exp(G)[..., None]
    G_last = G[..., -1:]
    k_dec = k * jnp.exp(G_last - G)[..., None]
    chunk_decay = jnp.exp(G_last[..., 0])

    def step(state, inp):
        u_i, w_i, qk_i, qd_i, kd_i, cd_i = inp
        u = u_i - jnp.einsum('bhik,bhkv->bhiv', w_i, state)
        o = jnp.einsum('bhik,bhkv->bhiv', qd_i, state) + jnp.einsum('bhij,bhjv->bhiv', qk_i, u)
        state = state * cd_i[..., None, None] + jnp.einsum('bhjk,bhjv->bhkv', kd_i, u)
        return state, o

    xs = tuple(jnp.moveaxis(t, 2, 0) for t in (u_intra, w_state, qk, q_dec, k_dec, chunk_decay))
    _, o = lax.scan(step, jnp.zeros((bsz, nh, dk, dv), q.dtype), xs)
    return o.transpose(1, 0, 3, 2, 4).reshape(bsz, seq, nh, dv)


def gated_deltanet_branch(p, conv_w, a_log, dt_bias, norm_g):
    bsz, seq, _ = p.shape
    q, k, v, z, a_in, b_in = _split(p, GDN_IN)
    qkv = jax.nn.silu(causal_depthwise_conv(jnp.concatenate([q, k, v], axis=-1), conv_w)).astype(jnp.float32)

    def heads(t):
        return t.reshape(bsz, seq, GDN_HEADS, HEAD_DIM)

    q, k, v = [heads(t) for t in jnp.split(qkv, 3, axis=-1)]
    q = l2_normalize(q) * (HEAD_DIM ** -0.5)
    k = l2_normalize(k)
    beta = jax.nn.sigmoid(b_in.astype(jnp.float32))
    g = -jnp.exp(a_log.astype(jnp.float32)) * jax.nn.softplus(a_in.astype(jnp.float32) + dt_bias.astype(jnp.float32))
    o = chunked_gated_delta_rule(q, k, v, g, beta)
    o = o * lax.rsqrt(jnp.mean(o * o, axis=-1, keepdims=True) + EPS) * norm_g.astype(jnp.float32)
    o = o * jax.nn.silu(heads(z.astype(jnp.float32)))
    return o.reshape(bsz, seq, GDN_WIDTH).astype(p.dtype)


def rwkv7_scan(r, w, k, v, kk, a):
    bsz, _, nh, hd = r.shape

    def step(state, inp):
        r_t, w_t, k_t, v_t, kk_t, a_t = inp
        sa = jnp.einsum('bhvk,bhk->bhv', state, -kk_t)
        state = (state * w_t[:, :, None, :] + sa[..., None] * (kk_t * a_t)[:, :, None, :]
                 + v_t[..., None] * k_t[:, :, None, :])
        return state, jnp.einsum('bhvk,bhk->bhv', state, r_t)

    xs = tuple(jnp.moveaxis(t, 1, 0) for t in (r, w, k, v, kk, a))
    _, y = lax.scan(step, jnp.zeros((bsz, nh, hd, hd), r.dtype), xs)
    return jnp.moveaxis(y, 0, 1)


def rwkv7_branch(p, mu, w0, w_up, a0, a_up, g_up, k_k, k_a, r_k, ln_g, ln_b):
    bsz, seq, _ = p.shape
    pf = p.astype(jnp.float32)
    pf = pf + (token_shift(pf) - pf) * mu
    r, k, v, xw, xa, xg = _split(pf, RW_IN)
    w_log = -jax.nn.softplus(-(w0 + jnp.tanh(xw) @ w_up)) - 0.5
    decay = jnp.exp(-jnp.exp(w_log))
    a = jax.nn.sigmoid(a0 + xa @ a_up)
    gate = jax.nn.sigmoid(xg) @ g_up

    def heads(t):
        return t.reshape(bsz, seq, RW_HEADS, HEAD_DIM)

    kk = l2_normalize(heads(k * k_k))
    k = k * (1.0 + (a - 1.0) * k_a)
    r_h, k_h, v_h = heads(r), heads(k), heads(v)
    y = rwkv7_scan(r_h, heads(decay), k_h, v_h, kk, heads(a))
    mean = jnp.mean(y, axis=-1, keepdims=True)
    var = jnp.mean(jnp.square(y - mean), axis=-1, keepdims=True)
    y = ((y - mean) * lax.rsqrt(var + RW_LN_EPS)).reshape(bsz, seq, RW_WIDTH) * ln_g + ln_b
    bonus = jnp.sum(r_h * k_h * r_k, axis=-1, keepdims=True) * v_h
    return ((y + bonus.reshape(bsz, seq, RW_WIDTH)) * gate).astype(p.dtype)


def conv_ffn(h, w_gate, w_up, conv_w, w_down):
    a = causal_depthwise_conv(h @ w_gate, conv_w)
    return (jax.nn.gelu(a) * (h @ w_up)) @ w_down


def setup_inputs(seed: int = 0) -> dict:
    key = jax.random.key(seed)
    keys = iter(jax.random.split(key, 64))
    f32 = jnp.float32
    L, D = DEPTH, D_MODEL

    def nrm(shape, scale):
        return jax.random.normal(next(keys), shape, f32) * scale

    def uni(shape, lo, hi):
        return jax.random.uniform(next(keys), shape, f32, lo, hi)

    x = nrm((BATCH, SEQ, D), 1.0)
    c = nrm((BATCH, D), 1.0)
    s = uni((L, LRU_WIDTH), 0.9, 0.999) ** (1.0 / LRU_C)
    lru_lambda = jnp.log(s) - jnp.log1p(-s)
    dt = jnp.exp(uni((L, GDN_HEADS), math.log(1e-3), math.log(1e-1)))
    gdn_dt_bias = dt + jnp.log(-jnp.expm1(-dt))
    return {
        'x': x,
        'c': c,
        'norm1_g': 1.0 + nrm((L, D), 0.02),
        'norm2_g': 1.0 + nrm((L, D), 0.02),
        'final_g': 1.0 + nrm((D,), 0.02),
        'w_ada': nrm((L, D, 6 * D), D ** -0.5),
        'b_ada': nrm((L, 6 * D), 0.02),
        'w_in': nrm((L, D, IN_DIM), D ** -0.5),
        'lru_conv_w': nrm((L, CONV_W, LRU_WIDTH), CONV_W ** -0.5),
        'lru_conv_b': nrm((L, LRU_WIDTH), 0.02),
        'lru_w_r': nrm((L, LRU_BLOCKS, LRU_BLOCK, LRU_BLOCK), LRU_BLOCK ** -0.5),
        'lru_b_r': nrm((L, LRU_WIDTH), 0.02),
        'lru_w_i': nrm((L, LRU_BLOCKS, LRU_BLOCK, LRU_BLOCK), LRU_BLOCK ** -0.5),
        'lru_b_i': nrm((L, LRU_WIDTH), 0.02),
        'lru_lambda': lru_lambda,
        'gdn_conv_w': nrm((L, CONV_W, 3 * GDN_WIDTH), CONV_W ** -0.5),
        'gdn_a_log': jnp.log(uni((L, GDN_HEADS), 1.0, 16.0)),
        'gdn_dt_bias': gdn_dt_bias,
        'gdn_norm_g': 1.0 + nrm((L, HEAD_DIM), 0.02),
        'rw_mu': uni((L, sum(RW_IN)), 0.0, 1.0),
        'rw_w0': uni((L, RW_WIDTH), -6.0, -1.0),
        'rw_w_up': nrm((L, W_LORA, RW_WIDTH), W_LORA ** -0.5),
        'rw_a0': nrm((L, RW_WIDTH), 0.1),
        'rw_a_up': nrm((L, A_LORA, RW_WIDTH), A_LORA ** -0.5),
        'rw_g_up': nrm((L, G_LORA, RW_WIDTH), G_LORA ** -0.5),
        'rw_k_k': 0.85 + nrm((L, RW_WIDTH), 0.05),
        'rw_k_a': 1.0 + nrm((L, RW_WIDTH), 0.05),
        'rw_r_k': nrm((L, RW_HEADS, HEAD_DIM), 0.1),
        'rw_ln_g': 1.0 + nrm((L, RW_WIDTH), 0.02),
        'rw_ln_b': nrm((L, RW_WIDTH), 0.02),
        'w_branch': nrm((L, N_BRANCH, BRANCH_WIDTH, D), BRANCH_WIDTH ** -0.5),
        'w_gate': nrm((L, N_BRANCH, D, D), D ** -0.5),
        'b_gate': nrm((L, N_BRANCH, D), 0.02),
        'w_out': nrm((L, D, D), D ** -0.5),
        'ffn_w_gate': nrm((L, D, FFN_DIM), D ** -0.5),
        'ffn_w_up': nrm((L, D, FFN_DIM), D ** -0.5),
        'ffn_conv_w': nrm((L, FFN_CONV_W, FFN_DIM), FFN_CONV_W ** -0.5),
        'ffn_w_down': nrm((L, FFN_DIM, D), FFN_DIM ** -0.5),
    }


def reference(x, c, norm1_g, norm2_g, final_g, w_ada, b_ada, w_in,
              lru_conv_w, lru_conv_b, lru_w_r, lru_b_r, lru_w_i, lru_b_i, lru_lambda,
              gdn_conv_w, gdn_a_log, gdn_dt_bias, gdn_norm_g,
              rw_mu, rw_w0, rw_w_up, rw_a0, rw_a_up, rw_g_up, rw_k_k, rw_k_a, rw_r_k, rw_ln_g, rw_ln_b,
              w_branch, w_gate, b_gate, w_out,
              ffn_w_gate, ffn_w_up, ffn_conv_w, ffn_w_down):
    cond = jax.nn.silu(c)
    for l in range(DEPTH):
        mod = cond @ w_ada[l] + b_ada[l]
        shift1, scale1, gate1, shift2, scale2, gate2 = [m[:, None, :] for m in jnp.split(mod, 6, axis=-1)]
        h = rms_norm(x, norm1_g[l]) * (1.0 + scale1) + shift1
        p_lru, p_sb, p_gdn, p_rw = _split(h @ w_in[l], MIXER_IN)
        branches = (
            rg_lru_branch(p_lru, lru_conv_w[l], lru_conv_b[l], lru_w_r[l], lru_b_r[l],
                          lru_w_i[l], lru_b_i[l], lru_lambda[l]),
            stick_breaking_branch(p_sb),
            gated_deltanet_branch(p_gdn, gdn_conv_w[l], gdn_a_log[l], gdn_dt_bias[l], gdn_norm_g[l]),
            rwkv7_branch(p_rw, rw_mu[l], rw_w0[l], rw_w_up[l], rw_a0[l], rw_a_up[l], rw_g_up[l],
                         rw_k_k[l], rw_k_a[l], rw_r_k[l], rw_ln_g[l], rw_ln_b[l]),
        )
        mixed = sum(jax.nn.sigmoid(h @ w_gate[l, n] + b_gate[l, n]) * (o @ w_branch[l, n])
                    for n, o in enumerate(branches))
        x = x + gate1 * (mixed @ w_out[l])
        h = rms_norm(x, norm2_g[l]) * (1.0 + scale2) + shift2
        x = x + gate2 * conv_ffn(h, ffn_w_gate[l], ffn_w_up[l], ffn_conv_w[l], ffn_w_down[l])
    return rms_norm(x, final_g)
```

```cpp
#include <hip/hip_runtime.h>
#include <hip/hip_cooperative_groups.h>
#include <cstdio>
namespace cg = cooperative_groups;

typedef unsigned short bf16_t;
typedef short bf16x8 __attribute__((ext_vector_type(8)));
typedef short s16x4 __attribute__((ext_vector_type(4)));
typedef float f32x4 __attribute__((ext_vector_type(4)));
typedef float f32x16 __attribute__((ext_vector_type(16)));
#define DI __device__ __forceinline__

constexpr int NTOK = 65536, DM = 1024, SEQ = 4096, PSTR = 3328, FFN = 2816, AUS = 5632;
constexpr int C_LRU_X = 0, C_LRU_Y = 256, C_SB_Q = 512, C_SB_K = 768, C_SB_V = 1024;
constexpr int C_GDN_Q = 1280, C_GDN_Z = 2048, C_GDN_A = 2304, C_GDN_B = 2308, C_RW = 2312;
constexpr float EPSF = 1e-6f;
#ifndef MASK
#define MASK 0x1ffff
#endif
constexpr int NTHR = 512;
constexpr int SMEM_BYTES = 131072;

constexpr size_t OFF_MODP = 0;
constexpr size_t OFF_WIN = 6291456;
constexpr size_t OFF_WG = OFF_WIN + 6815744;
constexpr size_t OFF_WBR = OFF_WG + 8388608;
constexpr size_t OFF_WO = OFF_WBR + 2097152;
constexpr size_t OFF_WF = OFF_WO + 2097152;
constexpr size_t OFF_WD = OFF_WF + 11534336;
constexpr size_t OFF_H = OFF_WD + 5767168;
constexpr size_t OFF_P = OFF_H + 134217728;
constexpr size_t OFF_O = OFF_P + 436207616;
constexpr size_t OFF_G = OFF_O + 134217728;
constexpr size_t GSZ = 33554432;
constexpr size_t OFF_GCD = OFF_G + 5 * GSZ;
constexpr size_t OFF_L = OFF_GCD + 16384;
constexpr size_t LSZ = 67108864;
constexpr size_t OFF_LCA = OFF_L + 2 * LSZ;
constexpr size_t OFF_LCH = OFF_LCA + 2097152;
constexpr size_t WS_NEED = OFF_LCH + 2097152;

struct Params { const float* in[38]; float* out; char* ws; };
enum { I_X = 0, I_C, I_N1G, I_N2G, I_FG, I_WADA, I_BADA, I_WIN, I_LCW, I_LCB, I_LWR, I_LBR, I_LWI, I_LBI, I_LLAM,
       I_GCW, I_GAL, I_GDT, I_GNG, I_RMU, I_RW0, I_RWUP, I_RA0, I_RAUP, I_RGUP, I_RKK, I_RKA, I_RRK, I_RLG, I_RLB,
       I_WBR, I_WGATE, I_BGATE, I_WOUT, I_FWG, I_FWU, I_FCW, I_FWD };

DI float bf2f(bf16_t v) { return __uint_as_float(((unsigned)v) << 16); }
DI bf16_t f2bf(float x) { unsigned u = __float_as_uint(x); u += 0x7fffu + ((u >> 16) & 1u); return (bf16_t)(u >> 16); }
DI unsigned pack2(float lo, float hi) { return (unsigned)f2bf(lo) | (((unsigned)f2bf(hi)) << 16); }
DI float sigmoidf_(float x) { return 1.f / (1.f + __expf(-x)); }
DI float softplusf_(float x) { return fmaxf(x, 0.f) + __logf(1.f + __expf(-fabsf(x))); }
DI float siluf_(float x) { return x / (1.f + __expf(-x)); }
DI float geluf_(float x) { float u = 0.7978845608f * (x + 0.044715f * x * x * x); return x / (1.f + __expf(-2.f * u)); }
DI float tanhf_(float x) { return 1.f - 2.f / (1.f + __expf(2.f * x)); }
DI float wave_sum(float x) {
#pragma unroll
  for (int o = 32; o >= 1; o >>= 1) x += __shfl_xor(x, o);
  return x;
}
template <int CTRL> DI float dppf(float x) { return __int_as_float(__builtin_amdgcn_update_dpp(0, __float_as_int(x), CTRL, 0xf, 0xf, true)); }
DI float reduce8(float x) { x += dppf<0xB1>(x); x += dppf<0x4E>(x); x += dppf<0x141>(x); return x; }
DI f32x16 mfma32(bf16x8 a, bf16x8 b, f32x16 c) { return __builtin_amdgcn_mfma_f32_32x32x16_bf16(a, b, c, 0, 0, 0); }
DI f32x4 mfma16(bf16x8 a, bf16x8 b, f32x4 c) { return __builtin_amdgcn_mfma_f32_16x16x32_bf16(a, b, c, 0, 0, 0); }
DI int crow(int i, int h) { return (i & 3) + 8 * (i >> 2) + 4 * h; }

DI float modv(const float* modp, const float* bada, int l, int b, int idx) {
  const float* q = modp + ((size_t)(l * 16 + b)) * 6144 + idx;
  const size_t ks = (size_t)4 * 16 * 6144;
  return bada[l * 6144 + idx] + q[0] + q[ks] + q[2 * ks] + q[3 * ks];
}

DI int otid() { int t = threadIdx.x; asm volatile("" : "+v"(t)); return t; }
DI int obid() { int b = blockIdx.x; asm volatile("" : "+s"(b)); return b; }
DI void phase_mod(const Params& p, char* smem) {
  float* sm = (float*)smem;
  float* modp = (float*)(p.ws + OFF_MODP);
  const int tid = otid();
  for (int item = obid(); item < 192; item += gridDim.x) {
    const int l = item / 48, rem = item % 48, jb = rem >> 2, kq = rem & 3;
    for (int i = 0; i < 8; ++i) {
      int e = tid + 512 * i; int b = e >> 8, k = e & 255;
      float cv = p.in[I_C][b * 1024 + kq * 256 + k];
      sm[e] = siluf_(cv);
    }
    __syncthreads();
    float acc[16];
#pragma unroll
    for (int b = 0; b < 16; ++b) acc[b] = 0.f;
    const float* wp = p.in[I_WADA] + ((size_t)l * 1024 + kq * 256) * 6144 + jb * 512 + tid;
    for (int k = 0; k < 256; k += 4) {
      float w0 = wp[(size_t)k * 6144], w1 = wp[(size_t)(k + 1) * 6144], w2 = wp[(size_t)(k + 2) * 6144], w3 = wp[(size_t)(k + 3) * 6144];
#pragma unroll
      for (int b = 0; b < 16; ++b) {
        f32x4 cv = *(const f32x4*)(sm + b * 256 + k);
        acc[b] += cv[0] * w0 + cv[1] * w1 + cv[2] * w2 + cv[3] * w3;
      }
    }
#pragma unroll
    for (int b = 0; b < 16; ++b) modp[((size_t)((kq * 4 + l) * 16 + b)) * 6144 + jb * 512 + tid] = acc[b];
    __syncthreads();
  }
}

DI void conv_tile(const float* src, bf16_t* dst, int K, int N, int k0, int n0, char* smem) {
  float* tile = (float*)smem;
  const int tid = otid();
#pragma unroll
  for (int it = 0; it < 2; ++it) {
    int kr = (tid >> 4) + 32 * it, nc = (tid & 15) * 4;
    f32x4 v = {0.f, 0.f, 0.f, 0.f};
    if (n0 + nc < N) v = *(const f32x4*)(src + (size_t)(k0 + kr) * N + n0 + nc);
    tile[kr * 65 + nc] = v[0]; tile[kr * 65 + nc + 1] = v[1]; tile[kr * 65 + nc + 2] = v[2]; tile[kr * 65 + nc + 3] = v[3];
  }
  __syncthreads();
  {
    int n = tid >> 3, kc = (tid & 7) * 8;
    unsigned o[4];
#pragma unroll
    for (int e = 0; e < 4; ++e) o[e] = pack2(tile[(kc + 2 * e) * 65 + n], tile[(kc + 2 * e + 1) * 65 + n]);
    uint4 ov = {o[0], o[1], o[2], o[3]};
    *(uint4*)(dst + (size_t)(n0 + n) * K + k0 + kc) = ov;
  }
  __syncthreads();
}

DI void phase_convert(const Params& p, int l, char* smem) {
  for (int t = obid(); t < 4480; t += gridDim.x) {
    const float* src; bf16_t* dst; int K, N, Npad, tt = t;
    if (tt < 832) { src = p.in[I_WIN] + (size_t)l * 1024 * 3208; dst = (bf16_t*)(p.ws + OFF_WIN); K = 1024; N = 3208; Npad = 3328; }
    else if ((tt -= 832) < 1024) { int br = tt >> 8; tt &= 255; src = p.in[I_WGATE] + ((size_t)l * 4 + br) * 1048576; dst = (bf16_t*)(p.ws + OFF_WG) + (size_t)br * 1048576; K = 1024; N = 1024; Npad = 1024; }
    else if ((tt -= 1024) < 256) { int br = tt >> 6; tt &= 63; src = p.in[I_WBR] + ((size_t)l * 4 + br) * 262144; dst = (bf16_t*)(p.ws + OFF_WBR) + (size_t)br * 262144; K = 256; N = 1024; Npad = 1024; }
    else if ((tt -= 256) < 256) { src = p.in[I_WOUT] + (size_t)l * 1048576; dst = (bf16_t*)(p.ws + OFF_WO); K = 1024; N = 1024; Npad = 1024; }
    else if ((tt -= 256) < 704) { src = p.in[I_FWG] + (size_t)l * 1024 * 2816; dst = (bf16_t*)(p.ws + OFF_WF); K = 1024; N = 2816; Npad = 2816; }
    else if ((tt -= 704) < 704) { src = p.in[I_FWU] + (size_t)l * 1024 * 2816; dst = (bf16_t*)(p.ws + OFF_WF) + (size_t)2816 * 1024; K = 1024; N = 2816; Npad = 2816; }
    else { tt -= 704; src = p.in[I_FWD] + (size_t)l * 2816 * 1024; dst = (bf16_t*)(p.ws + OFF_WD); K = 2816; N = 1024; Npad = 1024; }
    const int nNt = Npad >> 6;
    const int kt = tt / nNt, nt = tt % nNt;
    conv_tile(src, dst, K, N, kt * 64, nt * 64, smem);
  }
}

DI void phase_norm(const Params& p, const float* xin, const float* g, int l, int scale_idx, int shift_idx, bf16_t* hout, float* fout) {
  const float* modp = (const float*)(p.ws + OFF_MODP);
  const int lane = otid() & 63, wv = otid() >> 6;
  const int nw = gridDim.x * 8;
  const int rows_per = 32;
  for (int chunk = obid() * 8 + wv; chunk < NTOK / 32; chunk += nw) {
  const int row0 = chunk * rows_per;
  const int b = row0 / SEQ;
  f32x4 gv[4], sc[4], sh[4];
#pragma unroll
  for (int j = 0; j < 4; ++j) {
    int c = lane * 4 + 256 * j;
    gv[j] = *(const f32x4*)(g + c);
    if (hout) {
#pragma unroll
      for (int e = 0; e < 4; ++e) {
        sc[j][e] = 1.f + modv(modp, p.in[I_BADA], l, b, scale_idx + c + e);
        sh[j][e] = modv(modp, p.in[I_BADA], l, b, shift_idx + c + e);
      }
    }
  }
  for (int rr = 0; rr < rows_per; ++rr) {
    const size_t row = (size_t)row0 + rr;
    f32x4 xv[4]; float ss = 0.f;
#pragma unroll
    for (int j = 0; j < 4; ++j) {
      xv[j] = *(const f32x4*)(xin + row * DM + lane * 4 + 256 * j);
      ss += xv[j][0] * xv[j][0] + xv[j][1] * xv[j][1] + xv[j][2] * xv[j][2] + xv[j][3] * xv[j][3];
    }
    ss = wave_sum(ss);
    const float rs = rsqrtf(ss * (1.f / 1024.f) + EPSF);
#pragma unroll
    for (int j = 0; j < 4; ++j) {
      f32x4 y = xv[j] * rs * gv[j];
      if (hout) {
        y = y * sc[j] + sh[j];
        uint2 o = {pack2(y[0], y[1]), pack2(y[2], y[3])};
        *(uint2*)(hout + row * DM + lane * 4 + 256 * j) = o;
      } else {
        *(f32x4*)(fout + row * DM + lane * 4 + 256 * j) = y;
      }
    }
  }
  }
}

template <int WMT, int WNT>
DI void gemm_seg(const bf16_t* __restrict__ Ag, int lda, const bf16_t* __restrict__ Bg, int ldb, int nk,
                 f32x16 (&acc)[WMT][WNT], char* smem) {
  constexpr int BM = 128 * WMT, BN = 64 * WNT, NA = BM / 64, NBL = BN / 64, STAGE = (BM + BN) * 144;
  const int tid = otid(), lane = tid & 63, wv = tid >> 6, wm = wv >> 1, wn = wv & 1, r = lane & 31, h = lane >> 5;
  uint4 ra[NA], rb[NBL];
#define GLOAD(kt_)                                                                                            \
  {                                                                                                           \
    _Pragma("unroll") for (int i = 0; i < NA; ++i) { int q = tid + 512 * i; int row = q >> 3, cc = q & 7;     \
      ra[i] = *(const uint4*)(Ag + (size_t)row * lda + (kt_) * 64 + cc * 8); }                                \
    _Pragma("unroll") for (int i = 0; i < NBL; ++i) { int q = tid + 512 * i; int row = q >> 3, cc = q & 7;    \
      rb[i] = *(const uint4*)(Bg + (size_t)row * ldb + (kt_) * 64 + cc * 8); }                                \
  }
#define SSTORE(buf_)                                                                                          \
  {                                                                                                           \
    char* sa_ = smem + (buf_) * STAGE; char* sb_ = sa_ + BM * 144;                                            \
    _Pragma("unroll") for (int i = 0; i < NA; ++i) { int q = tid + 512 * i; int row = q >> 3, cc = q & 7;     \
      *(uint4*)(sa_ + row * 144 + cc * 16) = ra[i]; }                                                         \
    _Pragma("unroll") for (int i = 0; i < NBL; ++i) { int q = tid + 512 * i; int row = q >> 3, cc = q & 7;    \
      *(uint4*)(sb_ + row * 144 + cc * 16) = rb[i]; }                                                         \
  }
  GLOAD(0); SSTORE(0); __syncthreads();
  for (int kt = 0; kt < nk; ++kt) {
    if (kt + 1 < nk) GLOAD(kt + 1);
    const char* sa = smem + (kt & 1) * STAGE; const char* sb = sa + BM * 144;
#pragma unroll
    for (int ks = 0; ks < 4; ++ks) {
      bf16x8 af[WMT], bfr[WNT];
#pragma unroll
      for (int mi = 0; mi < WMT; ++mi) af[mi] = *(const bf16x8*)(sa + (wm * 32 * WMT + mi * 32 + r) * 144 + ks * 32 + h * 16);
#pragma unroll
      for (int ni = 0; ni < WNT; ++ni) bfr[ni] = *(const bf16x8*)(sb + (wn * 32 * WNT + ni * 32 + r) * 144 + ks * 32 + h * 16);
#pragma unroll
      for (int mi = 0; mi < WMT; ++mi)
#pragma unroll
        for (int ni = 0; ni < WNT; ++ni) acc[mi][ni] = mfma32(af[mi], bfr[ni], acc[mi][ni]);
    }
    if (kt + 1 < nk) SSTORE((kt + 1) & 1);
    __syncthreads();
  }
#undef GLOAD
#undef SSTORE
}

template <int WMT, int WNT> DI void zero_acc(f32x16 (&acc)[WMT][WNT]) {
#pragma unroll
  for (int mi = 0; mi < WMT; ++mi)
#pragma unroll
    for (int ni = 0; ni < WNT; ++ni)
#pragma unroll
      for (int i = 0; i < 16; ++i) acc[mi][ni][i] = 0.f;
}

DI void phase_gemm_bf16(const bf16_t* A, int lda, const bf16_t* Bt, int K, int N, bf16_t* C, int ldc, char* smem) {
  const int nN = N / 128, ntiles = (NTOK / 256) * nN;
  const int lane = otid() & 63, wv = otid() >> 6, wm = wv >> 1, wn = wv & 1, r = lane & 31, h = lane >> 5;
  for (int tile = obid(); tile < ntiles; tile += gridDim.x) {
    const int mt = tile / nN, nt = tile % nN;
    const int m0 = mt * 256, n0 = nt * 128;
    f32x16 acc[2][2]; zero_acc<2, 2>(acc);
    gemm_seg<2, 2>(A + (size_t)m0 * lda, lda, Bt + (size_t)n0 * K, K, K / 64, acc, smem);
#pragma unroll
    for (int mi = 0; mi < 2; ++mi)
#pragma unroll
      for (int ni = 0; ni < 2; ++ni)
#pragma unroll
        for (int i = 0; i < 16; ++i) {
          const int row = m0 + wm * 64 + mi * 32 + crow(i, h), col = n0 + wn * 64 + ni * 32 + r;
          C[(size_t)row * ldc + col] = f2bf(acc[mi][ni][i]);
        }
  }
}

DI void phase_gemm_resid(const Params& p, const bf16_t* A, int lda, const bf16_t* Bt, int K, const float* xold, float* xnew,
                                 int l, int gate_idx, char* smem) {
  const float* modp = (const float*)(p.ws + OFF_MODP);
  const int nN = DM / 128, ntiles = (NTOK / 256) * nN;
  const int lane = otid() & 63, wv = otid() >> 6, wm = wv >> 1, wn = wv & 1, r = lane & 31, h = lane >> 5;
  for (int tile = obid(); tile < ntiles; tile += gridDim.x) {
    const int mt = tile / nN, nt = tile % nN;
    const int m0 = mt * 256, n0 = nt * 128;
    const int b = m0 / SEQ;
    f32x16 acc[2][2]; zero_acc<2, 2>(acc);
    gemm_seg<2, 2>(A + (size_t)m0 * lda, lda, Bt + (size_t)n0 * K, K, K / 64, acc, smem);
#pragma unroll
    for (int ni = 0; ni < 2; ++ni) {
      const int col = n0 + wn * 64 + ni * 32 + r;
      const float gt = modv(modp, p.in[I_BADA], l, b, gate_idx + col);
#pragma unroll
      for (int mi = 0; mi < 2; ++mi)
#pragma unroll
        for (int i = 0; i < 16; ++i) {
          const int row = m0 + wm * 64 + mi * 32 + crow(i, h);
          const size_t o = (size_t)row * DM + col;
          xnew[o] = xold[o] + gt * acc[mi][ni][i];
        }
    }
  }
}

DI void phase_gemm_mix(const Params& p, int l, char* smem) {
  const bf16_t* H = (const bf16_t*)(p.ws + OFF_H);
  const bf16_t* O = (const bf16_t*)(p.ws + OFF_O);
  const bf16_t* WG = (const bf16_t*)(p.ws + OFF_WG);
  const bf16_t* WB = (const bf16_t*)(p.ws + OFF_WBR);
  bf16_t* MIX = (bf16_t*)(p.ws + OFF_P);
  const float* bg = p.in[I_BGATE] + (size_t)l * 4096;
  const int nN = 8, ntiles = (NTOK / 128) * nN;
  const int lane = otid() & 63, wv = otid() >> 6, wm = wv >> 1, wn = wv & 1, r = lane & 31, h = lane >> 5;
  for (int tile = obid(); tile < ntiles; tile += gridDim.x) {
    const int mt = tile / nN, nt = tile % nN;
    const int m0 = mt * 128, n0 = nt * 128;
    f32x16 mix[1][2]; zero_acc<1, 2>(mix);
#pragma unroll 1
    for (int br = 0; br < 4; ++br) {
      unsigned gpk[2][8];
      {
        f32x16 accg[1][2]; zero_acc<1, 2>(accg);
        gemm_seg<1, 2>(H + (size_t)m0 * DM, DM, WG + (size_t)br * 1048576 + (size_t)n0 * 1024, 1024, 16, accg, smem);
#pragma unroll
        for (int ni = 0; ni < 2; ++ni) {
          const float bias = bg[br * 1024 + n0 + wn * 64 + ni * 32 + r];
#pragma unroll
          for (int i = 0; i < 8; ++i) gpk[ni][i] = pack2(sigmoidf_(accg[0][ni][2 * i] + bias), sigmoidf_(accg[0][ni][2 * i + 1] + bias));
        }
      }
      {
        f32x16 accb[1][2]; zero_acc<1, 2>(accb);
        gemm_seg<1, 2>(O + (size_t)m0 * DM + br * 256, DM, WB + (size_t)br * 262144 + (size_t)n0 * 256, 256, 4, accb, smem);
#pragma unroll
        for (int ni = 0; ni < 2; ++ni)
#pragma unroll
          for (int i = 0; i < 8; ++i) {
            mix[0][ni][2 * i] += __uint_as_float(gpk[ni][i] << 16) * accb[0][ni][2 * i];
            mix[0][ni][2 * i + 1] += __uint_as_float(gpk[ni][i] & 0xffff0000u) * accb[0][ni][2 * i + 1];
          }
      }
    }
#pragma unroll
    for (int ni = 0; ni < 2; ++ni)
#pragma unroll
      for (int i = 0; i < 16; ++i) {
        const int row = m0 + wm * 32 + crow(i, h), col = n0 + wn * 64 + ni * 32 + r;
        MIX[(size_t)row * DM + col] = f2bf(mix[0][ni][i]);
      }
  }
}

DI void phase_ffn_act(const Params& p, int l) {
  bf16_t* AU = (bf16_t*)(p.ws + OFF_P);
  const float* cw = p.in[I_FCW] + (size_t)l * 3 * FFN;
  const int nthr = gridDim.x * NTHR;
  for (int run = obid() * NTHR + otid(); run < 1024 * 352; run += nthr) {
    const int ch = run / 352, j8 = run % 352, j0 = j8 * 8;
    float w0[8], w1[8], w2[8];
#pragma unroll
    for (int e = 0; e < 8; ++e) { w0[e] = cw[j0 + e]; w1[e] = cw[FFN + j0 + e]; w2[e] = cw[2 * FFN + j0 + e]; }
    const int t0 = ch * 64, s0 = t0 % SEQ;
    float a1[8], a2[8];
#pragma unroll
    for (int e = 0; e < 8; ++e) { a1[e] = 0.f; a2[e] = 0.f; }
    if (s0 > 0) {
      bf16x8 v1 = *(const bf16x8*)(AU + (size_t)(t0 - 1) * AUS + j0);
      bf16x8 v2 = *(const bf16x8*)(AU + (size_t)(t0 - 2) * AUS + j0);
#pragma unroll
      for (int e = 0; e < 8; ++e) { a1[e] = bf2f((bf16_t)v1[e]); a2[e] = bf2f((bf16_t)v2[e]); }
    }
    for (int t = t0; t < t0 + 64; ++t) {
      bf16x8 va = *(const bf16x8*)(AU + (size_t)t * AUS + j0);
      bf16x8 vu = *(const bf16x8*)(AU + (size_t)t * AUS + FFN + j0);
      float o[8];
#pragma unroll
      for (int e = 0; e < 8; ++e) {
        float a0 = bf2f((bf16_t)va[e]);
        float cv = w0[e] * a2[e] + w1[e] * a1[e] + w2[e] * a0;
        o[e] = geluf_(cv) * bf2f((bf16_t)vu[e]);
        a2[e] = a1[e]; a1[e] = a0;
      }
      uint4 ov = {pack2(o[0], o[1]), pack2(o[2], o[3]), pack2(o[4], o[5]), pack2(o[6], o[7])};
      *(uint4*)(AU + (size_t)t * AUS + FFN + j0) = ov;
    }
  }
}

DI void rwkv_item(const Params& p, int l, int b, int hd, char* smem) {
  const bf16_t* P = (const bf16_t*)(p.ws + OFF_P);
  bf16_t* O = (bf16_t*)(p.ws + OFF_O);
  float* R = (float*)smem;
  float* KP = R + 2048;
  float* V = KP + 2048;
  float* W = V + 2048;
  float* KK = W + 2048;
  float* KA = KK + 2048;
  float* GATE = KA + 2048;
  float* Y = GATE + 2048;
  float* TXW = Y + 2048;
  float* XA = TXW + 1024;
  float* SXG = XA + 1024;
  float* WUP = SXG + 2048;
  float* AUP = WUP + 2048;
  float* GUP = AUP + 2048;
  float* BONUS = GUP + 4096;
  const int tid = otid(), lane = tid & 63, wv = tid >> 6;
  const float* mu = p.in[I_RMU] + (size_t)l * 896;
  for (int e = tid; e < 2048; e += NTHR) {
    int j = e >> 6, c = e & 63;
    WUP[e] = p.in[I_RWUP][((size_t)l * 32 + j) * 256 + hd * 64 + c];
    AUP[e] = p.in[I_RAUP][((size_t)l * 32 + j) * 256 + hd * 64 + c];
  }
  for (int e = tid; e < 4096; e += NTHR) {
    int j = e >> 6, c = e & 63;
    GUP[e] = p.in[I_RGUP][((size_t)l * 64 + j) * 256 + hd * 64 + c];
  }
  const int hc = hd * 64 + lane;
  const float w0c = p.in[I_RW0][l * 256 + hc], a0c = p.in[I_RA0][l * 256 + hc], kkc = p.in[I_RKK][l * 256 + hc],
              kac = p.in[I_RKA][l * 256 + hc], rkc = p.in[I_RRK][l * 256 + hc], lgc = p.in[I_RLG][l * 256 + hc], lbc = p.in[I_RLB][l * 256 + hc];
  float S[8];
#pragma unroll
  for (int j = 0; j < 8; ++j) S[j] = 0.f;
  const int rl = lane >> 3, kq = lane & 7, vrow = wv * 8 + rl;
  __syncthreads();
  for (int ch = 0; ch < SEQ / 32; ++ch) {
    const size_t tok0 = (size_t)b * SEQ + ch * 32;
    for (int i = 0; i < 20; ++i) {
      const int e = tid + NTHR * i;
      const int t = e / 320, f = e % 320;
      int rwc;
      if (f < 64) rwc = hd * 64 + f;
      else if (f < 128) rwc = 256 + hd * 64 + (f - 64);
      else if (f < 192) rwc = 512 + hd * 64 + (f - 128);
      else rwc = 768 + (f - 192);
      const size_t tok = tok0 + t;
      const float cur = bf2f(P[tok * PSTR + C_RW + rwc]);
      const float prev = (ch == 0 && t == 0) ? 0.f : bf2f(P[(tok - 1) * PSTR + C_RW + rwc]);
      const float mv = cur + (prev - cur) * mu[rwc];
      if (f < 64) R[t * 64 + f] = mv;
      else if (f < 128) KP[t * 64 + f - 64] = mv;
      else if (f < 192) V[t * 64 + f - 128] = mv;
      else if (f < 224) TXW[t * 32 + f - 192] = tanhf_(mv);
      else if (f < 256) XA[t * 32 + f - 224] = mv;
      else SXG[t * 64 + f - 256] = sigmoidf_(mv);
    }
    __syncthreads();
#pragma unroll 1
    for (int i = 0; i < 4; ++i) {
      const int t = wv + 8 * i;
      float wl = w0c, al = a0c, gt = 0.f;
#pragma unroll 8
      for (int j = 0; j < 32; ++j) { wl += TXW[t * 32 + j] * WUP[j * 64 + lane]; al += XA[t * 32 + j] * AUP[j * 64 + lane]; }
#pragma unroll 8
      for (int j = 0; j < 64; ++j) gt += SXG[t * 64 + j] * GUP[j * 64 + lane];
      const float wlog = -softplusf_(-wl) - 0.5f;
      const float dec = __expf(-__expf(wlog));
      const float a = sigmoidf_(al);
      const float kraw = KP[t * 64 + lane];
      const float kkr = kraw * kkc;
      const float kp = kraw * (1.f + (a - 1.f) * kac);
      const float ss = wave_sum(kkr * kkr);
      const float kk = kkr * rsqrtf(ss + EPSF);
      const float bn = wave_sum(R[t * 64 + lane] * kp * rkc);
      W[t * 64 + lane] = dec; KK[t * 64 + lane] = kk; KA[t * 64 + lane] = kk * a; KP[t * 64 + lane] = kp; GATE[t * 64 + lane] = gt;
      if (lane == 0) BONUS[t] = bn;
    }
    __syncthreads();
#pragma unroll 2
    for (int t = 0; t < 32; ++t) {
      const f32x4 kk0 = *(const f32x4*)(KK + t * 64 + kq * 8), kk1 = *(const f32x4*)(KK + t * 64 + kq * 8 + 4);
      const f32x4 w0 = *(const f32x4*)(W + t * 64 + kq * 8), w1 = *(const f32x4*)(W + t * 64 + kq * 8 + 4);
      const f32x4 ka0 = *(const f32x4*)(KA + t * 64 + kq * 8), ka1 = *(const f32x4*)(KA + t * 64 + kq * 8 + 4);
      const f32x4 kp0 = *(const f32x4*)(KP + t * 64 + kq * 8), kp1 = *(const f32x4*)(KP + t * 64 + kq * 8 + 4);
      const f32x4 r0 = *(const f32x4*)(R + t * 64 + kq * 8), r1 = *(const f32x4*)(R + t * 64 + kq * 8 + 4);
      const float vv = V[t * 64 + vrow];
      float sa = 0.f;
#pragma unroll
      for (int j = 0; j < 4; ++j) sa += S[j] * kk0[j] + S[j + 4] * kk1[j];
      sa = -reduce8(sa);
      float y = 0.f;
#pragma unroll
      for (int j = 0; j < 4; ++j) {
        S[j] = S[j] * w0[j] + sa * ka0[j] + vv * kp0[j];
        S[j + 4] = S[j + 4] * w1[j] + sa * ka1[j] + vv * kp1[j];
        y += S[j] * r0[j] + S[j + 4] * r1[j];
      }
      y = reduce8(y);
      if (kq == 0) Y[t * 64 + vrow] = y;
    }
    __syncthreads();
#pragma unroll 1
    for (int i = 0; i < 4; ++i) {
      const int t = wv + 8 * i;
      const float y = Y[t * 64 + lane];
      const float mean = wave_sum(y) * (1.f / 64.f);
      const float d = y - mean;
      const float var = wave_sum(d * d) * (1.f / 64.f);
      const float yn = d * rsqrtf(var + 64e-5f) * lgc + lbc;
      const float o = (yn + BONUS[t] * V[t * 64 + lane]) * GATE[t * 64 + lane];
      O[(tok0 + t) * DM + 768 + hc] = f2bf(o);
    }
    __syncthreads();
  }
}

DI void sb_item(const Params& p, int item, char* smem) {
  const bf16_t* P = (const bf16_t*)(p.ws + OFF_P);
  bf16_t* O = (bf16_t*)(p.ws + OFF_O);
  const int qt = item & 15, hd = (item >> 4) & 3, b = item >> 6;
  const int tid = otid(), lane = tid & 63, wv = tid >> 6, r = lane & 31, h = lane >> 5;
  bf16_t* Vt = (bf16_t*)(smem + wv * 8704);
  const int q0 = qt * 256 + wv * 32;
  const int sq = q0 + r;
  const size_t tokb = (size_t)b * SEQ;
  bf16x8 qf[4];
#pragma unroll
  for (int ks = 0; ks < 4; ++ks) qf[ks] = *(const bf16x8*)(P + (tokb + sq) * PSTR + C_SB_Q + hd * 64 + ks * 16 + h * 8);
  f32x16 accO[2];
#pragma unroll
  for (int i = 0; i < 16; ++i) { accO[0][i] = 0.f; accO[1][i] = 0.f; }
  float Rsum = 0.f;
  for (int kt = (q0 + 31) >> 6; kt >= 0; --kt) {
    const int k0 = kt * 64;
#pragma unroll
    for (int it = 0; it < 8; ++it) {
      const int key = it * 8 + (lane >> 3), chv = lane & 7;
      bf16x8 v = *(const bf16x8*)(P + (tokb + k0 + key) * PSTR + C_SB_V + hd * 64 + chv * 8);
#pragma unroll
      for (int e = 0; e < 8; ++e) Vt[(chv * 8 + e) * 68 + key] = (bf16_t)v[e];
    }
    f32x16 acc[2];
#pragma unroll
    for (int m = 0; m < 2; ++m) {
#pragma unroll
      for (int i = 0; i < 16; ++i) acc[m][i] = 0.f;
#pragma unroll
      for (int ks = 0; ks < 4; ++ks) {
        bf16x8 kf = *(const bf16x8*)(P + (tokb + k0 + 32 * m + r) * PSTR + C_SB_K + hd * 64 + ks * 16 + h * 8);
        acc[m] = mfma32(kf, qf[ks], acc[m]);
      }
    }
    float spv[2][16];
    float gs[8];
#pragma unroll
    for (int m = 0; m < 2; ++m)
#pragma unroll
      for (int i = 0; i < 16; ++i) {
        const int key = k0 + 32 * m + crow(i, h);
        const float z = acc[m][i] * 0.125f;
        float sp = softplusf_(z);
        const bool valid = key < sq;
        acc[m][i] = valid ? (z - sp) : -1e30f;
        sp = valid ? sp : 0.f;
        spv[m][i] = sp;
      }
#pragma unroll
    for (int q = 0; q < 8; ++q) {
      const int m = q >> 2, g = q & 3;
      gs[q] = spv[m][4 * g] + spv[m][4 * g + 1] + spv[m][4 * g + 2] + spv[m][4 * g + 3];
    }
    float run = 0.f;
#pragma unroll
    for (int q = 7; q >= 0; --q) {
      const int m = q >> 2, g = q & 3;
      const float pg = __shfl_xor(gs[q], 32);
      const float base = Rsum + run + (h == 0 ? pg : 0.f);
      const float s3 = spv[m][4 * g + 3], s2 = spv[m][4 * g + 2], s1 = spv[m][4 * g + 1];
      const float b3 = base, b2 = base + s3, b1 = b2 + s2, b0 = b1 + s1;
      acc[m][4 * g + 3] = __expf(acc[m][4 * g + 3] - b3);
      acc[m][4 * g + 2] = __expf(acc[m][4 * g + 2] - b2);
      acc[m][4 * g + 1] = __expf(acc[m][4 * g + 1] - b1);
      acc[m][4 * g + 0] = __expf(acc[m][4 * g + 0] - b0);
      run += gs[q] + pg;
    }
    Rsum += run;
    __builtin_amdgcn_wave_barrier();
#pragma unroll
    for (int m = 0; m < 2; ++m)
#pragma unroll
      for (int s = 0; s < 2; ++s) {
        bf16x8 pb;
        {
          unsigned u0 = pack2(acc[m][8 * s + 0], acc[m][8 * s + 1]), u1 = pack2(acc[m][8 * s + 2], acc[m][8 * s + 3]);
          unsigned u2 = pack2(acc[m][8 * s + 4], acc[m][8 * s + 5]), u3 = pack2(acc[m][8 * s + 6], acc[m][8 * s + 7]);
          uint4 uu = {u0, u1, u2, u3};
          pb = __builtin_bit_cast(bf16x8, uu);
        }
#pragma unroll
        for (int dt = 0; dt < 2; ++dt) {
          const bf16_t* vp = Vt + (32 * dt + r) * 68 + 32 * m + 16 * s + 4 * h;
          s16x4 lo = *(const s16x4*)vp, hi = *(const s16x4*)(vp + 8);
          bf16x8 va = __builtin_shufflevector(lo, hi, 0, 1, 2, 3, 4, 5, 6, 7);
          accO[dt] = mfma32(va, pb, accO[dt]);
        }
      }
    __builtin_amdgcn_wave_barrier();
    if (__ballot(Rsum <= 88.f) == 0ull) break;
  }
#pragma unroll
  for (int dt = 0; dt < 2; ++dt)
#pragma unroll
    for (int g = 0; g < 4; ++g) {
      const int d = 32 * dt + 8 * g + 4 * h;
      uint2 o = {pack2(accO[dt][4 * g], accO[dt][4 * g + 1]), pack2(accO[dt][4 * g + 2], accO[dt][4 * g + 3])};
      *(uint2*)(O + (tokb + sq) * DM + 256 + hd * 64 + d) = o;
    }
}

DI void gdn_intra_item(const Params& p, int l, int item, char* smem) {
  const bf16_t* P = (const bf16_t*)(p.ws + OFF_P);
  const int hp = item & 1, c = (item >> 1) & 63, b = item >> 7;
  const int tid = otid(), lane = tid & 63;
  bf16_t* Kb = (bf16_t*)smem;
  bf16_t* Qb = Kb + 2 * 64 * 72;
  bf16_t* Vb = Qb + 2 * 64 * 72;
  float* Lm = (float*)(smem + 3 * 2 * 64 * 72 * 2);
  float* Gs = Lm + 2 * 4096;
  float* Bs = Gs + 128;
  const size_t tok0 = (size_t)b * SEQ + c * 64;
  const float* cw = p.in[I_GCW] + (size_t)l * 4 * 768;
  {
    const int t = tid >> 3, cg = tid & 7;
#pragma unroll 1
    for (int it = 0; it < 6; ++it) {
      const int hh = it / 3, which = it % 3, head = hp * 2 + hh;
      const int ccol = which * 256 + head * 64 + cg * 8;
      float acc[8];
#pragma unroll
      for (int e = 0; e < 8; ++e) acc[e] = 0.f;
#pragma unroll
      for (int j = 0; j < 4; ++j) {
        const int s = c * 64 + t - 3 + j;
        if (s >= 0) {
          bf16x8 xv = *(const bf16x8*)(P + ((size_t)b * SEQ + s) * PSTR + C_GDN_Q + ccol);
          f32x4 wa = *(const f32x4*)(cw + j * 768 + ccol), wb = *(const f32x4*)(cw + j * 768 + ccol + 4);
#pragma unroll
          for (int e = 0; e < 4; ++e) { acc[e] += wa[e] * bf2f((bf16_t)xv[e]); acc[e + 4] += wb[e] * bf2f((bf16_t)xv[e + 4]); }
        }
      }
      float ss = 0.f;
#pragma unroll
      for (int e = 0; e < 8; ++e) { acc[e] = siluf_(acc[e]); ss += acc[e] * acc[e]; }
      ss += __shfl_xor(ss, 1); ss += __shfl_xor(ss, 2); ss += __shfl_xor(ss, 4);
      float sc = 1.f;
      if (which == 0) sc = rsqrtf(ss + EPSF) * 0.125f;
      else if (which == 1) sc = rsqrtf(ss + EPSF);
      uint4 ov = {pack2(acc[0] * sc, acc[1] * sc), pack2(acc[2] * sc, acc[3] * sc), pack2(acc[4] * sc, acc[5] * sc), pack2(acc[6] * sc, acc[7] * sc)};
      bf16_t* dst = (which == 0 ? Qb : (which == 1 ? Kb : Vb)) + (hh * 64 + t) * 72 + cg * 8;
      *(uint4*)dst = ov;
    }
  }
  if (tid < 128) {
    const int hh = tid >> 6, t = lane, head = hp * 2 + hh;
    const float a_in = bf2f(P[(tok0 + t) * PSTR + C_GDN_A + head]);
    const float b_in = bf2f(P[(tok0 + t) * PSTR + C_GDN_B + head]);
    const float beta = sigmoidf_(b_in);
    float g = -__expf(p.in[I_GAL][l * 4 + head]) * softplusf_(a_in + p.in[I_GDT][l * 4 + head]);
#pragma unroll
    for (int d = 1; d < 64; d <<= 1) { float v = __shfl_up(g, d); if (lane >= d) g += v; }
    Gs[hh * 64 + t] = g; Bs[hh * 64 + t] = beta;
  }
  __syncthreads();
  const int hh = tid >> 8, lt = tid & 255, head = hp * 2 + hh;
  const size_t ih = ((size_t)(b * 4 + head)) * 64 + c;
  bf16_t* GW = (bf16_t*)(p.ws + OFF_G) + ih * 4096;
  bf16_t* GQD = (bf16_t*)(p.ws + OFF_G + GSZ) + ih * 4096;
  bf16_t* GQK = (bf16_t*)(p.ws + OFF_G + 2 * GSZ) + ih * 4096;
  bf16_t* GKD = (bf16_t*)(p.ws + OFF_G + 3 * GSZ) + ih * 4096;
  bf16_t* GU = (bf16_t*)(p.ws + OFF_G + 4 * GSZ) + ih * 4096;
  float* GCD = (float*)(p.ws + OFF_GCD);
  const float* Gh = Gs + hh * 64; const float* Bh = Bs + hh * 64;
  {
    const int wq = (tid >> 6) & 3, ti = wq >> 1, tj = wq & 1, r = lane & 31, h = lane >> 5;
    f32x16 akk, aqk;
#pragma unroll
    for (int i = 0; i < 16; ++i) { akk[i] = 0.f; aqk[i] = 0.f; }
    if (ti >= tj) {
#pragma unroll
      for (int ks = 0; ks < 4; ++ks) {
        bf16x8 ka = *(const bf16x8*)(Kb + (hh * 64 + 32 * ti + r) * 72 + ks * 16 + h * 8);
        bf16x8 qa = *(const bf16x8*)(Qb + (hh * 64 + 32 * ti + r) * 72 + ks * 16 + h * 8);
        bf16x8 kb = *(const bf16x8*)(Kb + (hh * 64 + 32 * tj + r) * 72 + ks * 16 + h * 8);
        akk = mfma32(ka, kb, akk);
        aqk = mfma32(qa, kb, aqk);
      }
    }
    const int j = 32 * tj + r;
    const float Gj = Gh[j];
#pragma unroll
    for (int i_ = 0; i_ < 16; ++i_) {
      const int i = 32 * ti + crow(i_, h);
      const float dec = (i >= j) ? __expf(Gh[i] - Gj) : 0.f;
      Lm[hh * 4096 + i * 64 + j] = (i > j) ? Bh[i] * akk[i_] * dec : 0.f;
      GQK[i * 64 + j] = f2bf((i >= j) ? aqk[i_] * dec : 0.f);
    }
  }
  __syncthreads();
  if (lt < 128) {
    const int cc = lt;
    float x[64];
    if (cc < 64) {
#pragma unroll
      for (int i = 0; i < 64; ++i) x[i] = bf2f(Vb[(hh * 64 + i) * 72 + cc]) * Bh[i];
    } else {
#pragma unroll
      for (int i = 0; i < 64; ++i) x[i] = bf2f(Kb[(hh * 64 + i) * 72 + cc - 64]) * Bh[i] * __expf(Gh[i]);
    }
    const float* Lh = Lm + hh * 4096;
#pragma unroll
    for (int i = 1; i < 64; ++i) {
      float s = x[i];
#pragma unroll
      for (int j4 = 0; j4 < (i + 3) / 4; ++j4) {
        const f32x4 lv = *(const f32x4*)(Lh + i * 64 + j4 * 4);
#pragma unroll
        for (int e = 0; e < 4; ++e) if (j4 * 4 + e < i) s -= lv[e] * x[j4 * 4 + e];
      }
      x[i] = s;
    }
    if (cc < 64) {
#pragma unroll
      for (int q = 0; q < 8; ++q) {
        uint4 ov = {pack2(x[8 * q], x[8 * q + 1]), pack2(x[8 * q + 2], x[8 * q + 3]), pack2(x[8 * q + 4], x[8 * q + 5]), pack2(x[8 * q + 6], x[8 * q + 7])};
        *(uint4*)(GU + cc * 64 + 8 * q) = ov;
      }
    } else {
#pragma unroll
      for (int i = 0; i < 64; ++i) GW[i * 64 + cc - 64] = f2bf(x[i]);
    }
  } else {
    const int q_ = lt - 128;
    const float Glast = Gh[63];
#pragma unroll
    for (int i = 0; i < 4; ++i) {
      const int q = q_ + 128 * i; const int pos = q >> 3, kc = q & 7;
      bf16x8 qv = *(const bf16x8*)(Qb + (hh * 64 + pos) * 72 + kc * 8);
      const float eg = __expf(Gh[pos]);
      uint4 ov = {pack2(bf2f((bf16_t)qv[0]) * eg, bf2f((bf16_t)qv[1]) * eg), pack2(bf2f((bf16_t)qv[2]) * eg, bf2f((bf16_t)qv[3]) * eg),
                  pack2(bf2f((bf16_t)qv[4]) * eg, bf2f((bf16_t)qv[5]) * eg), pack2(bf2f((bf16_t)qv[6]) * eg, bf2f((bf16_t)qv[7]) * eg)};
      *(uint4*)(GQD + pos * 64 + kc * 8) = ov;
    }
#pragma unroll
    for (int i = 0; i < 4; ++i) {
      const int q = q_ + 128 * i; const int k = q >> 3, pc = q & 7;
      float o[8];
#pragma unroll
      for (int e = 0; e < 8; ++e) { const int pos = pc * 8 + e; o[e] = bf2f(Kb[(hh * 64 + pos) * 72 + k]) * __expf(Glast - Gh[pos]); }
      uint4 ov = {pack2(o[0], o[1]), pack2(o[2], o[3]), pack2(o[4], o[5]), pack2(o[6], o[7])};
      *(uint4*)(GKD + k * 64 + pc * 8) = ov;
    }
    if (q_ == 0) GCD[ih] = __expf(Glast);
  }
}

DI void gdn_rec_item(const Params& p, int l, int b, int head, char* smem) {
  const bf16_t* P = (const bf16_t*)(p.ws + OFF_P);
  bf16_t* O = (bf16_t*)(p.ws + OFF_O);
  float* SS = (float*)smem;
  const int tid = otid(), lane = tid & 63, wv = tid >> 6, fr = lane & 15, fq = lane >> 4;
  const int split = wv & 3;
  const bool active = wv < 4;
  const float ng = p.in[I_GNG][l * 64 + split * 16 + fr];
  const float* GCD = (const float*)(p.ws + OFF_GCD);
  f32x4 S[4];
#pragma unroll
  for (int kt = 0; kt < 4; ++kt) S[kt] = (f32x4){0.f, 0.f, 0.f, 0.f};
  for (int c = 0; c < 64; ++c) {
    const size_t ih = ((size_t)(b * 4 + head)) * 64 + c;
    f32x4 acco[4];
    if (active) {
      const bf16_t* GW = (const bf16_t*)(p.ws + OFF_G) + ih * 4096;
      const bf16_t* GQD = (const bf16_t*)(p.ws + OFF_G + GSZ) + ih * 4096;
      const bf16_t* GQK = (const bf16_t*)(p.ws + OFF_G + 2 * GSZ) + ih * 4096;
      const bf16_t* GKD = (const bf16_t*)(p.ws + OFF_G + 3 * GSZ) + ih * 4096;
      const bf16_t* GU = (const bf16_t*)(p.ws + OFF_G + 4 * GSZ) + ih * 4096;
      const float cd = GCD[ih];
      bf16x8 bS[2];
#pragma unroll
      for (int ks = 0; ks < 2; ++ks) {
        uint4 uu = {pack2(S[2 * ks][0], S[2 * ks][1]), pack2(S[2 * ks][2], S[2 * ks][3]), pack2(S[2 * ks + 1][0], S[2 * ks + 1][1]), pack2(S[2 * ks + 1][2], S[2 * ks + 1][3])};
        bS[ks] = __builtin_bit_cast(bf16x8, uu);
      }
      f32x4 u[4];
#pragma unroll
      for (int rt = 0; rt < 4; ++rt) {
        f32x4 aw = {0.f, 0.f, 0.f, 0.f};
        acco[rt] = (f32x4){0.f, 0.f, 0.f, 0.f};
#pragma unroll
        for (int ks = 0; ks < 2; ++ks) {
          const int off = (16 * rt + fr) * 64 + 32 * ks + 4 * fq;
          s16x4 lo = *(const s16x4*)(GW + off), hi = *(const s16x4*)(GW + off + 16);
          bf16x8 wa = __builtin_shufflevector(lo, hi, 0, 1, 2, 3, 4, 5, 6, 7);
          aw = mfma16(wa, bS[ks], aw);
          s16x4 lo2 = *(const s16x4*)(GQD + off), hi2 = *(const s16x4*)(GQD + off + 16);
          bf16x8 qa = __builtin_shufflevector(lo2, hi2, 0, 1, 2, 3, 4, 5, 6, 7);
          acco[rt] = mfma16(qa, bS[ks], acco[rt]);
        }
        s16x4 uv = *(const s16x4*)(GU + (16 * split + fr) * 64 + 16 * rt + 4 * fq);
#pragma unroll
        for (int j = 0; j < 4; ++j) u[rt][j] = bf2f((bf16_t)uv[j]) - aw[j];
      }
      bf16x8 bU[2];
#pragma unroll
      for (int ks = 0; ks < 2; ++ks) {
        uint4 uu = {pack2(u[2 * ks][0], u[2 * ks][1]), pack2(u[2 * ks][2], u[2 * ks][3]), pack2(u[2 * ks + 1][0], u[2 * ks + 1][1]), pack2(u[2 * ks + 1][2], u[2 * ks + 1][3])};
        bU[ks] = __builtin_bit_cast(bf16x8, uu);
      }
#pragma unroll
      for (int rt = 0; rt < 4; ++rt) {
        f32x4 sn = S[rt] * cd;
#pragma unroll
        for (int ks = 0; ks < 2; ++ks) {
          const int off = (16 * rt + fr) * 64 + 32 * ks + 4 * fq;
          s16x4 lo = *(const s16x4*)(GQK + off), hi = *(const s16x4*)(GQK + off + 16);
          bf16x8 qa = __builtin_shufflevector(lo, hi, 0, 1, 2, 3, 4, 5, 6, 7);
          acco[rt] = mfma16(qa, bU[ks], acco[rt]);
          s16x4 lo2 = *(const s16x4*)(GKD + off), hi2 = *(const s16x4*)(GKD + off + 16);
          bf16x8 ka = __builtin_shufflevector(lo2, hi2, 0, 1, 2, 3, 4, 5, 6, 7);
          sn = mfma16(ka, bU[ks], sn);
        }
        S[rt] = sn;
      }
#pragma unroll
      for (int rt = 0; rt < 4; ++rt)
#pragma unroll
        for (int j = 0; j < 4; ++j) {
          float s = acco[rt][j] * acco[rt][j];
          s += __shfl_xor(s, 1); s += __shfl_xor(s, 2); s += __shfl_xor(s, 4); s += __shfl_xor(s, 8);
          if (fr == 0) SS[(c & 1) * 256 + split * 64 + 16 * rt + 4 * fq + j] = s;
        }
    }
    __syncthreads();
    if (active) {
      const float* ssb = SS + (c & 1) * 256;
#pragma unroll
      for (int rt = 0; rt < 4; ++rt)
#pragma unroll
        for (int j = 0; j < 4; ++j) {
          const int pos = 16 * rt + 4 * fq + j;
          const float tot = ssb[pos] + ssb[64 + pos] + ssb[128 + pos] + ssb[192 + pos];
          const float rn = rsqrtf(tot * (1.f / 64.f) + EPSF);
          const size_t tok = (size_t)b * SEQ + c * 64 + pos;
          const float z = bf2f(P[tok * PSTR + C_GDN_Z + head * 64 + split * 16 + fr]);
          O[tok * DM + 512 + head * 64 + split * 16 + fr] = f2bf(acco[rt][j] * rn * ng * siluf_(z));
        }
    }
  }
}

DI void lru_local_item(const Params& p, int l, int item, char* smem) {
  const bf16_t* P = (const bf16_t*)(p.ws + OFF_P);
  float* HL = (float*)(p.ws + OFF_L);
  float* AC = (float*)(p.ws + OFF_L + LSZ);
  float* CA = (float*)(p.ws + OFF_LCA);
  float* CH = (float*)(p.ws + OFF_LCH);
  bf16_t* XS = (bf16_t*)smem;
  float* U = (float*)(smem + 34816);
  const int b = item >> 6, ct = item & 63;
  const int tid = otid(), sc = tid >> 8, c = tid & 255;
  for (int i = 0; i < 5; ++i) {
    const int q = tid + NTHR * i;
    if (q < 67 * 32) {
      const int row = q >> 5, cc = q & 31;
      const int s = ct * 64 - 3 + row;
      uint4 v = {0u, 0u, 0u, 0u};
      if (s >= 0) v = *(const uint4*)(P + ((size_t)b * SEQ + s) * PSTR + C_LRU_X + cc * 8);
      *(uint4*)(XS + row * 256 + cc * 8) = v;
    }
  }
  __syncthreads();
  {
    const float cb = p.in[I_LCB][l * 256 + c];
    const float c0 = p.in[I_LCW][(l * 4 + 0) * 256 + c], c1 = p.in[I_LCW][(l * 4 + 1) * 256 + c],
                c2 = p.in[I_LCW][(l * 4 + 2) * 256 + c], c3 = p.in[I_LCW][(l * 4 + 3) * 256 + c];
    for (int t = sc * 32; t < sc * 32 + 32; ++t)
      U[t * 256 + c] = cb + c0 * bf2f(XS[t * 256 + c]) + c1 * bf2f(XS[(t + 1) * 256 + c]) + c2 * bf2f(XS[(t + 2) * 256 + c]) + c3 * bf2f(XS[(t + 3) * 256 + c]);
  }
  __syncthreads();
  {
    const int n = c >> 6, f = c & 63;
    float wr[64], wi[64];
    {
      const float* wrp = p.in[I_LWR] + (((size_t)l * 4 + n) * 64) * 64 + f;
      const float* wip = p.in[I_LWI] + (((size_t)l * 4 + n) * 64) * 64 + f;
      asm volatile("" : "+v"(wrp), "+v"(wip));
#pragma unroll
      for (int e = 0; e < 64; ++e) { wr[e] = wrp[e * 64]; wi[e] = wip[e * 64]; }
    }
    const float br = p.in[I_LBR][l * 256 + c], bi = p.in[I_LBI][l * 256 + c];
    const float lamsp = softplusf_(-p.in[I_LLAM][l * 256 + c]);
    float hl = 0.f, ac = 1.f;
    for (int t = sc * 32; t < sc * 32 + 32; ++t) {
      float ar = br, ai = bi;
#pragma unroll
      for (int e4 = 0; e4 < 16; ++e4) {
        const f32x4 uu = *(const f32x4*)(U + t * 256 + n * 64 + e4 * 4);
#pragma unroll
        for (int e = 0; e < 4; ++e) { ar += uu[e] * wr[e4 * 4 + e]; ai += uu[e] * wi[e4 * 4 + e]; }
      }
      const float rg = sigmoidf_(ar), ig = sigmoidf_(ai);
      const float la = -8.f * rg * lamsp;
      const float a = __expf(la);
      const float bb = sqrtf(fmaxf(0.f, 1.f - __expf(2.f * la))) * (ig * U[t * 256 + c]);
      hl = a * hl + bb; ac *= a;
      const size_t tok = (size_t)b * SEQ + ct * 64 + t;
      HL[tok * 256 + c] = hl; AC[tok * 256 + c] = ac;
    }
    const int ck = ct * 2 + sc;
    CA[((size_t)b * 128 + ck) * 256 + c] = ac; CH[((size_t)b * 128 + ck) * 256 + c] = hl;
  }
}

DI void lru_final(const Params& p, int wave_id, int nwaves) {
  const bf16_t* P = (const bf16_t*)(p.ws + OFF_P);
  bf16_t* O = (bf16_t*)(p.ws + OFF_O);
  const float* HL = (const float*)(p.ws + OFF_L);
  const float* AC = (const float*)(p.ws + OFF_L + LSZ);
  const float* CA = (const float*)(p.ws + OFF_LCA);
  const float* CH = (const float*)(p.ws + OFF_LCH);
  const int lane = otid() & 63;
  for (int it = wave_id; it < 16 * 128 * 4; it += nwaves) {
    const int cg = it & 3, ck = (it >> 2) & 127, b = it >> 9;
    const int c = cg * 64 + lane;
    float carry = 0.f;
    for (int k = 0; k < ck; ++k) carry = CA[((size_t)b * 128 + k) * 256 + c] * carry + CH[((size_t)b * 128 + k) * 256 + c];
    for (int t = 0; t < 32; ++t) {
      const size_t tok = (size_t)b * SEQ + ck * 32 + t;
      const float hf = HL[tok * 256 + c] + AC[tok * 256 + c] * carry;
      const float y = bf2f(P[tok * PSTR + C_LRU_Y + c]);
      O[tok * DM + c] = f2bf(hf * geluf_(y));
    }
  }
}

__global__ void __launch_bounds__(NTHR) mega(Params p) {
  extern __shared__ __attribute__((aligned(16))) char smem[];
  cg::grid_group grid = cg::this_grid();
  const int tid = threadIdx.x;
  bf16_t* H = (bf16_t*)(p.ws + OFF_H);
  bf16_t* PB = (bf16_t*)(p.ws + OFF_P);

  if (MASK & 1) phase_mod(p, smem);
  grid.sync();
  for (int l = 0; l < 4; ++l) {
    const float* xcur = (l == 0) ? p.in[I_X] : p.out;
    if (MASK & 2) phase_convert(p, l, smem);
    if (MASK & 4) phase_norm(p, xcur, p.in[I_N1G] + l * 1024, l, 1024, 0, H, nullptr);
    grid.sync();
    if (MASK & 8) phase_gemm_bf16(H, DM, (const bf16_t*)(p.ws + OFF_WIN), 1024, PSTR, PB, PSTR, smem);
    grid.sync();
    if (blockIdx.x < 64) {
      if (MASK & 16) rwkv_item(p, l, blockIdx.x >> 2, blockIdx.x & 3, smem);
    } else {
      const int nb = gridDim.x - 64;
      for (int it = blockIdx.x - 64; it < 4096; it += nb) {
        if (it < 2048) { if (MASK & 32) gdn_intra_item(p, l, it, smem); }
        else if (it < 3072) { if (MASK & 64) sb_item(p, it - 2048, smem); }
        else { if (MASK & 128) lru_local_item(p, l, it - 3072, smem); }
        __syncthreads();
      }
    }
    grid.sync();
    if (blockIdx.x < 64) {
      if (MASK & 256) gdn_rec_item(p, l, blockIdx.x >> 2, blockIdx.x & 3, smem);
    } else {
      if (MASK & 512) lru_final(p, (blockIdx.x - 64) * 8 + (tid >> 6), (gridDim.x - 64) * 8);
    }
    grid.sync();
    if (MASK & 1024) phase_gemm_mix(p, l, smem);
    grid.sync();
    if (MASK & 2048) phase_gemm_resid(p, PB, DM, (const bf16_t*)(p.ws + OFF_WO), 1024, xcur, p.out, l, 2048, smem);
    grid.sync();
    if (MASK & 4096) phase_norm(p, p.out, p.in[I_N2G] + l * 1024, l, 4096, 3072, H, nullptr);
    grid.sync();
    if (MASK & 8192) phase_gemm_bf16(H, DM, (const bf16_t*)(p.ws + OFF_WF), 1024, AUS, PB, AUS, smem);
    grid.sync();
    if (MASK & 16384) phase_ffn_act(p, l);
    grid.sync();
    if (MASK & 32768) phase_gemm_resid(p, PB + FFN, AUS, (const bf16_t*)(p.ws + OFF_WD), FFN, p.out, p.out, l, 5120, smem);
    grid.sync();
  }
  if (MASK & 65536) phase_norm(p, p.out, p.in[I_FG], 0, 0, 0, nullptr, p.out);
}

extern "C" void kernel_launch(void* const* d_in, const int* in_sizes, int n_in,
                              void* d_out, int out_size, void* d_ws, size_t ws_size,
                              hipStream_t stream) {
  if (ws_size < WS_NEED || n_in < 38) { fprintf(stderr, "workspace too small: %zu < %zu\n", ws_size, (size_t)WS_NEED); return; }
  (void)hipFuncSetAttribute((const void*)mega, hipFuncAttributeMaxDynamicSharedMemorySize, SMEM_BYTES);
  int dev = 0, cus = 0, per_cu = 0;
  (void)hipGetDevice(&dev);
  (void)hipDeviceGetAttribute(&cus, hipDeviceAttributeMultiprocessorCount, dev);
  (void)hipOccupancyMaxActiveBlocksPerMultiprocessor(&per_cu, mega, NTHR, SMEM_BYTES);
  if (per_cu < 1 || cus < 1) { fprintf(stderr, "occupancy query failed (%d, %d)\n", per_cu, cus); return; }
  if (cus > 256) cus = 256;
  const int grid_blocks = cus;
  Params p{};
  for (int i = 0; i < 38; ++i) p.in[i] = (const float*)d_in[i];
  p.out = (float*)d_out; p.ws = (char*)d_ws;
  void* args[] = {&p};
  hipError_t e = hipLaunchCooperativeKernel((void*)mega, dim3(grid_blocks), dim3(NTHR), args, SMEM_BYTES, stream);
  if (e != hipSuccess) fprintf(stderr, "cooperative launch failed: %s (grid %d)\n", hipGetErrorString(e), grid_blocks);
}
```

```cpp
#include <hip/hip_runtime.h>
#include <hip/hip_cooperative_groups.h>
#include <cstdio>
namespace cg = cooperative_groups;

typedef unsigned short bf16_t;
typedef short bf16x8 __attribute__((ext_vector_type(8)));
typedef short s16x4 __attribute__((ext_vector_type(4)));
typedef float f32x4 __attribute__((ext_vector_type(4)));
typedef float f32x16 __attribute__((ext_vector_type(16)));
#define DI __device__ __forceinline__

constexpr int NTOK = 65536, DM = 1024, SEQ = 4096, PSTR = 3328, FFN = 2816, AUS = 5632;
constexpr int C_LRU_X = 0, C_LRU_Y = 256, C_SB_Q = 512, C_SB_K = 768, C_SB_V = 1024;
constexpr int C_GDN_Q = 1280, C_GDN_Z = 2048, C_GDN_A = 2304, C_GDN_B = 2308, C_RW = 2312;
constexpr float EPSF = 1e-6f;
#ifndef MASK
#define MASK 0x1ffff
#endif
#ifndef REP_M1
#define REP_M1 1
#endif
#ifndef REP_M2
#define REP_M2 1
#endif
#ifndef REP_G
#define REP_G 1
#endif
#ifndef REP_MISC
#define REP_MISC 1
#endif
constexpr int NTHR = 512;
constexpr int SMEM_BYTES = 131072;

constexpr size_t OFF_MODP = 0;
constexpr size_t OFF_WIN = 6291456;
constexpr size_t OFF_WG = OFF_WIN + 6815744;
constexpr size_t OFF_WBR = OFF_WG + 8388608;
constexpr size_t OFF_WO = OFF_WBR + 2097152;
constexpr size_t OFF_WF = OFF_WO + 2097152;
constexpr size_t OFF_WD = OFF_WF + 11534336;
constexpr size_t OFF_H = OFF_WD + 5767168;
constexpr size_t OFF_P = OFF_H + 134217728;
constexpr size_t OFF_O = OFF_P + 436207616;
constexpr size_t OFF_G = OFF_O + 134217728;
constexpr size_t GSZ = 33554432;
constexpr size_t OFF_GCD = OFF_G + 5 * GSZ;
constexpr size_t OFF_L = OFF_GCD + 16384;
constexpr size_t LSZ = 67108864;
constexpr size_t OFF_LCA = OFF_L + 2 * LSZ;
constexpr size_t OFF_LCH = OFF_LCA + 2097152;
constexpr size_t OFF_BON = OFF_LCH + 2097152;
constexpr size_t WS_NEED = OFF_BON + 1048576;

struct Params { const float* in[38]; float* out; char* ws; };
enum { I_X = 0, I_C, I_N1G, I_N2G, I_FG, I_WADA, I_BADA, I_WIN, I_LCW, I_LCB, I_LWR, I_LBR, I_LWI, I_LBI, I_LLAM,
       I_GCW, I_GAL, I_GDT, I_GNG, I_RMU, I_RW0, I_RWUP, I_RA0, I_RAUP, I_RGUP, I_RKK, I_RKA, I_RRK, I_RLG, I_RLB,
       I_WBR, I_WGATE, I_BGATE, I_WOUT, I_FWG, I_FWU, I_FCW, I_FWD };

DI float bf2f(bf16_t v) { return __uint_as_float(((unsigned)v) << 16); }
DI bf16_t f2bf(float x) { unsigned u = __float_as_uint(x); u += 0x7fffu + ((u >> 16) & 1u); return (bf16_t)(u >> 16); }
DI unsigned pack2(float lo, float hi) { return (unsigned)f2bf(lo) | (((unsigned)f2bf(hi)) << 16); }
DI float sigmoidf_(float x) { return 1.f / (1.f + __expf(-x)); }
DI float softplusf_(float x) { return fmaxf(x, 0.f) + __logf(1.f + __expf(-fabsf(x))); }
DI float siluf_(float x) { return x / (1.f + __expf(-x)); }
DI float geluf_(float x) { float u = 0.7978845608f * (x + 0.044715f * x * x * x); return x / (1.f + __expf(-2.f * u)); }
DI float tanhf_(float x) { return 1.f - 2.f / (1.f + __expf(2.f * x)); }
DI float wave_sum(float x) {
#pragma unroll
  for (int o = 32; o >= 1; o >>= 1) x += __shfl_xor(x, o);
  return x;
}
template <int CTRL> DI float dppf(float x) { return __int_as_float(__builtin_amdgcn_update_dpp(0, __float_as_int(x), CTRL, 0xf, 0xf, true)); }
DI float reduce8(float x) { x += dppf<0xB1>(x); x += dppf<0x4E>(x); x += dppf<0x141>(x); return x; }
DI f32x16 mfma32(bf16x8 a, bf16x8 b, f32x16 c) { return __builtin_amdgcn_mfma_f32_32x32x16_bf16(a, b, c, 0, 0, 0); }
DI f32x4 mfma16(bf16x8 a, bf16x8 b, f32x4 c) { return __builtin_amdgcn_mfma_f32_16x16x32_bf16(a, b, c, 0, 0, 0); }
DI int crow(int i, int h) { return (i & 3) + 8 * (i >> 2) + 4 * h; }

DI float modv(const float* modp, const float* bada, int l, int b, int idx) {
  const float* q = modp + ((size_t)(l * 16 + b)) * 6144 + idx;
  const size_t ks = (size_t)4 * 16 * 6144;
  return bada[l * 6144 + idx] + q[0] + q[ks] + q[2 * ks] + q[3 * ks];
}

DI int otid() { int t = threadIdx.x; asm volatile("" : "+v"(t)); return t; }
DI int obid() { int b = blockIdx.x; asm volatile("" : "+s"(b)); return b; }
DI void phase_mod(const Params& p, char* smem) {
  float* sm = (float*)smem;
  float* modp = (float*)(p.ws + OFF_MODP);
  const int tid = otid();
  for (int item = obid(); item < 192; item += gridDim.x) {
    const int l = item / 48, rem = item % 48, jb = rem >> 2, kq = rem & 3;
    for (int i = 0; i < 8; ++i) {
      int e = tid + 512 * i; int b = e >> 8, k = e & 255;
      float cv = p.in[I_C][b * 1024 + kq * 256 + k];
      sm[e] = siluf_(cv);
    }
    __syncthreads();
    float acc[16];
#pragma unroll
    for (int b = 0; b < 16; ++b) acc[b] = 0.f;
    const float* wp = p.in[I_WADA] + ((size_t)l * 1024 + kq * 256) * 6144 + jb * 512 + tid;
    for (int k = 0; k < 256; k += 4) {
      float w0 = wp[(size_t)k * 6144], w1 = wp[(size_t)(k + 1) * 6144], w2 = wp[(size_t)(k + 2) * 6144], w3 = wp[(size_t)(k + 3) * 6144];
#pragma unroll
      for (int b = 0; b < 16; ++b) {
        f32x4 cv = *(const f32x4*)(sm + b * 256 + k);
        acc[b] += cv[0] * w0 + cv[1] * w1 + cv[2] * w2 + cv[3] * w3;
      }
    }
#pragma unroll
    for (int b = 0; b < 16; ++b) modp[((size_t)((kq * 4 + l) * 16 + b)) * 6144 + jb * 512 + tid] = acc[b];
    __syncthreads();
  }
}

DI void conv_tile(const float* src, bf16_t* dst, int K, int N, int k0, int n0, char* smem) {
  float* tile = (float*)smem;
  const int tid = otid();
#pragma unroll
  for (int it = 0; it < 2; ++it) {
    int kr = (tid >> 4) + 32 * it, nc = (tid & 15) * 4;
    f32x4 v = {0.f, 0.f, 0.f, 0.f};
    if (n0 + nc < N) v = *(const f32x4*)(src + (size_t)(k0 + kr) * N + n0 + nc);
    tile[kr * 65 + nc] = v[0]; tile[kr * 65 + nc + 1] = v[1]; tile[kr * 65 + nc + 2] = v[2]; tile[kr * 65 + nc + 3] = v[3];
  }
  __syncthreads();
  {
    int n = tid >> 3, kc = (tid & 7) * 8;
    unsigned o[4];
#pragma unroll
    for (int e = 0; e < 4; ++e) o[e] = pack2(tile[(kc + 2 * e) * 65 + n], tile[(kc + 2 * e + 1) * 65 + n]);
    uint4 ov = {o[0], o[1], o[2], o[3]};
    *(uint4*)(dst + (size_t)(n0 + n) * K + k0 + kc) = ov;
  }
  __syncthreads();
}

DI void phase_convert(const Params& p, int l, char* smem) {
  for (int t = obid(); t < 4480; t += gridDim.x) {
    const float* src; bf16_t* dst; int K, N, Npad, tt = t;
    if (tt < 832) { src = p.in[I_WIN] + (size_t)l * 1024 * 3208; dst = (bf16_t*)(p.ws + OFF_WIN); K = 1024; N = 3208; Npad = 3328; }
    else if ((tt -= 832) < 1024) { int br = tt >> 8; tt &= 255; src = p.in[I_WGATE] + ((size_t)l * 4 + br) * 1048576; dst = (bf16_t*)(p.ws + OFF_WG) + (size_t)br * 1048576; K = 1024; N = 1024; Npad = 1024; }
    else if ((tt -= 1024) < 256) { int br = tt >> 6; tt &= 63; src = p.in[I_WBR] + ((size_t)l * 4 + br) * 262144; dst = (bf16_t*)(p.ws + OFF_WBR) + (size_t)br * 262144; K = 256; N = 1024; Npad = 1024; }
    else if ((tt -= 256) < 256) { src = p.in[I_WOUT] + (size_t)l * 1048576; dst = (bf16_t*)(p.ws + OFF_WO); K = 1024; N = 1024; Npad = 1024; }
    else if ((tt -= 256) < 704) { src = p.in[I_FWG] + (size_t)l * 1024 * 2816; dst = (bf16_t*)(p.ws + OFF_WF); K = 1024; N = 2816; Npad = 2816; }
    else if ((tt -= 704) < 704) { src = p.in[I_FWU] + (size_t)l * 1024 * 2816; dst = (bf16_t*)(p.ws + OFF_WF) + (size_t)2816 * 1024; K = 1024; N = 2816; Npad = 2816; }
    else { tt -= 704; src = p.in[I_FWD] + (size_t)l * 2816 * 1024; dst = (bf16_t*)(p.ws + OFF_WD); K = 2816; N = 1024; Npad = 1024; }
    const int nNt = Npad >> 6;
    const int kt = tt / nNt, nt = tt % nNt;
    conv_tile(src, dst, K, N, kt * 64, nt * 64, smem);
  }
}

DI void phase_norm(const Params& p, const float* xin, const float* g, int l, int scale_idx, int shift_idx, bf16_t* hout, float* fout) {
  const float* modp = (const float*)(p.ws + OFF_MODP);
  const int lane = otid() & 63, wv = otid() >> 6;
  const int nw = gridDim.x * 8;
  const int rows_per = 32;
  for (int chunk = obid() * 8 + wv; chunk < NTOK / 32; chunk += nw) {
  const int row0 = chunk * rows_per;
  const int b = row0 / SEQ;
  f32x4 gv[4], sc[4], sh[4];
#pragma unroll
  for (int j = 0; j < 4; ++j) {
    int c = lane * 4 + 256 * j;
    gv[j] = *(const f32x4*)(g + c);
    if (hout) {
#pragma unroll
      for (int e = 0; e < 4; ++e) {
        sc[j][e] = 1.f + modv(modp, p.in[I_BADA], l, b, scale_idx + c + e);
        sh[j][e] = modv(modp, p.in[I_BADA], l, b, shift_idx + c + e);
      }
    }
  }
  for (int rr = 0; rr < rows_per; ++rr) {
    const size_t row = (size_t)row0 + rr;
    f32x4 xv[4]; float ss = 0.f;
#pragma unroll
    for (int j = 0; j < 4; ++j) {
      xv[j] = *(const f32x4*)(xin + row * DM + lane * 4 + 256 * j);
      ss += xv[j][0] * xv[j][0] + xv[j][1] * xv[j][1] + xv[j][2] * xv[j][2] + xv[j][3] * xv[j][3];
    }
    ss = wave_sum(ss);
    const float rs = rsqrtf(ss * (1.f / 1024.f) + EPSF);
#pragma unroll
    for (int j = 0; j < 4; ++j) {
      f32x4 y = xv[j] * rs * gv[j];
      if (hout) {
        y = y * sc[j] + sh[j];
        uint2 o = {pack2(y[0], y[1]), pack2(y[2], y[3])};
        *(uint2*)(hout + row * DM + lane * 4 + 256 * j) = o;
      } else {
        *(f32x4*)(fout + row * DM + lane * 4 + 256 * j) = y;
      }
    }
  }
  }
}

template <int WMT, int WNT>
DI void gemm_seg(const bf16_t* __restrict__ Ag, int lda, const bf16_t* __restrict__ Bg, int ldb, int nk,
                 f32x16 (&acc)[WMT][WNT], char* smem) {
  constexpr int BM = 128 * WMT, BN = 64 * WNT, NA = BM / 64, NBL = BN / 64, STAGE = (BM + BN) * 144;
  const int tid = otid(), lane = tid & 63, wv = tid >> 6, wm = wv >> 1, wn = wv & 1, r = lane & 31, h = lane >> 5;
  uint4 ra[NA], rb[NBL];
#define GLOAD(kt_)                                                                                            \
  {                                                                                                           \
    _Pragma("unroll") for (int i = 0; i < NA; ++i) { int q = tid + 512 * i; int row = q >> 3, cc = q & 7;     \
      ra[i] = *(const uint4*)(Ag + (size_t)row * lda + (kt_) * 64 + cc * 8); }                                \
    _Pragma("unroll") for (int i = 0; i < NBL; ++i) { int q = tid + 512 * i; int row = q >> 3, cc = q & 7;    \
      rb[i] = *(const uint4*)(Bg + (size_t)row * ldb + (kt_) * 64 + cc * 8); }                                \
  }
#define SSTORE(buf_)                                                                                          \
  {                                                                                                           \
    char* sa_ = smem + (buf_) * STAGE; char* sb_ = sa_ + BM * 144;                                            \
    _Pragma("unroll") for (int i = 0; i < NA; ++i) { int q = tid + 512 * i; int row = q >> 3, cc = q & 7;     \
      *(uint4*)(sa_ + row * 144 + cc * 16) = ra[i]; }                                                         \
    _Pragma("unroll") for (int i = 0; i < NBL; ++i) { int q = tid + 512 * i; int row = q >> 3, cc = q & 7;    \
      *(uint4*)(sb_ + row * 144 + cc * 16) = rb[i]; }                                                         \
  }
  GLOAD(0); SSTORE(0); __syncthreads();
  for (int kt = 0; kt < nk; ++kt) {
    if (kt + 1 < nk) GLOAD(kt + 1);
    const char* sa = smem + (kt & 1) * STAGE; const char* sb = sa + BM * 144;
#pragma unroll
    for (int ks = 0; ks < 4; ++ks) {
      bf16x8 af[WMT], bfr[WNT];
#pragma unroll
      for (int mi = 0; mi < WMT; ++mi) af[mi] = *(const bf16x8*)(sa + (wm * 32 * WMT + mi * 32 + r) * 144 + ks * 32 + h * 16);
#pragma unroll
      for (int ni = 0; ni < WNT; ++ni) bfr[ni] = *(const bf16x8*)(sb + (wn * 32 * WNT + ni * 32 + r) * 144 + ks * 32 + h * 16);
#pragma unroll
      for (int mi = 0; mi < WMT; ++mi)
#pragma unroll
        for (int ni = 0; ni < WNT; ++ni) acc[mi][ni] = mfma32(af[mi], bfr[ni], acc[mi][ni]);
    }
    if (kt + 1 < nk) SSTORE((kt + 1) & 1);
    __syncthreads();
  }
#undef GLOAD
#undef SSTORE
}

template <int WMT, int WNT> DI void zero_acc(f32x16 (&acc)[WMT][WNT]) {
#pragma unroll
  for (int mi = 0; mi < WMT; ++mi)
#pragma unroll
    for (int ni = 0; ni < WNT; ++ni)
#pragma unroll
      for (int i = 0; i < 16; ++i) acc[mi][ni][i] = 0.f;
}

DI void phase_gemm_bf16(const bf16_t* A, int lda, const bf16_t* Bt, int K, int N, bf16_t* C, int ldc, char* smem) {
  const int nN = N / 128, ntiles = (NTOK / 256) * nN;
  const int lane = otid() & 63, wv = otid() >> 6, wm = wv >> 1, wn = wv & 1, r = lane & 31, h = lane >> 5;
  for (int tile = obid(); tile < ntiles; tile += gridDim.x) {
    const int mt = tile / nN, nt = tile % nN;
    const int m0 = mt * 256, n0 = nt * 128;
    f32x16 acc[2][2]; zero_acc<2, 2>(acc);
    gemm_seg<2, 2>(A + (size_t)m0 * lda, lda, Bt + (size_t)n0 * K, K, K / 64, acc, smem);
#pragma unroll
    for (int mi = 0; mi < 2; ++mi)
#pragma unroll
      for (int ni = 0; ni < 2; ++ni)
#pragma unroll
        for (int i = 0; i < 16; ++i) {
          const int row = m0 + wm * 64 + mi * 32 + crow(i, h), col = n0 + wn * 64 + ni * 32 + r;
          C[(size_t)row * ldc + col] = f2bf(acc[mi][ni][i]);
        }
  }
}

DI void phase_gemm_resid(const Params& p, const bf16_t* A, int lda, const bf16_t* Bt, int K, const float* xold, float* xnew,
                                 int l, int gate_idx, char* smem) {
  const float* modp = (const float*)(p.ws + OFF_MODP);
  const int nN = DM / 128, ntiles = (NTOK / 256) * nN;
  const int lane = otid() & 63, wv = otid() >> 6, wm = wv >> 1, wn = wv & 1, r = lane & 31, h = lane >> 5;
  for (int tile = obid(); tile < ntiles; tile += gridDim.x) {
    const int mt = tile / nN, nt = tile % nN;
    const int m0 = mt * 256, n0 = nt * 128;
    const int b = m0 / SEQ;
    f32x16 acc[2][2]; zero_acc<2, 2>(acc);
    gemm_seg<2, 2>(A + (size_t)m0 * lda, lda, Bt + (size_t)n0 * K, K, K / 64, acc, smem);
#pragma unroll
    for (int ni = 0; ni < 2; ++ni) {
      const int col = n0 + wn * 64 + ni * 32 + r;
      const float gt = modv(modp, p.in[I_BADA], l, b, gate_idx + col);
#pragma unroll
      for (int mi = 0; mi < 2; ++mi)
#pragma unroll
        for (int i = 0; i < 16; ++i) {
          const int row = m0 + wm * 64 + mi * 32 + crow(i, h);
          const size_t o = (size_t)row * DM + col;
          xnew[o] = xold[o] + gt * acc[mi][ni][i];
        }
    }
  }
}

DI void phase_gemm_mix(const Params& p, int l, char* smem) {
  const bf16_t* H = (const bf16_t*)(p.ws + OFF_H);
  const bf16_t* O = (const bf16_t*)(p.ws + OFF_O);
  const bf16_t* WG = (const bf16_t*)(p.ws + OFF_WG);
  const bf16_t* WB = (const bf16_t*)(p.ws + OFF_WBR);
  bf16_t* MIX = (bf16_t*)(p.ws + OFF_P);
  const float* bg = p.in[I_BGATE] + (size_t)l * 4096;
  const int nN = 8, ntiles = (NTOK / 128) * nN;
  const int lane = otid() & 63, wv = otid() >> 6, wm = wv >> 1, wn = wv & 1, r = lane & 31, h = lane >> 5;
  for (int tile = obid(); tile < ntiles; tile += gridDim.x) {
    const int mt = tile / nN, nt = tile % nN;
    const int m0 = mt * 128, n0 = nt * 128;
    f32x16 mix[1][2]; zero_acc<1, 2>(mix);
#pragma unroll 1
    for (int br = 0; br < 4; ++br) {
      unsigned gpk[2][8];
      {
        f32x16 accg[1][2]; zero_acc<1, 2>(accg);
        gemm_seg<1, 2>(H + (size_t)m0 * DM, DM, WG + (size_t)br * 1048576 + (size_t)n0 * 1024, 1024, 16, accg, smem);
#pragma unroll
        for (int ni = 0; ni < 2; ++ni) {
          const float bias = bg[br * 1024 + n0 + wn * 64 + ni * 32 + r];
#pragma unroll
          for (int i = 0; i < 8; ++i) gpk[ni][i] = pack2(sigmoidf_(accg[0][ni][2 * i] + bias), sigmoidf_(accg[0][ni][2 * i + 1] + bias));
        }
      }
      {
        f32x16 accb[1][2]; zero_acc<1, 2>(accb);
        gemm_seg<1, 2>(O + (size_t)m0 * DM + br * 256, DM, WB + (size_t)br * 262144 + (size_t)n0 * 256, 256, 4, accb, smem);
#pragma unroll
        for (int ni = 0; ni < 2; ++ni)
#pragma unroll
          for (int i = 0; i < 8; ++i) {
            mix[0][ni][2 * i] += __uint_as_float(gpk[ni][i] << 16) * accb[0][ni][2 * i];
            mix[0][ni][2 * i + 1] += __uint_as_float(gpk[ni][i] & 0xffff0000u) * accb[0][ni][2 * i + 1];
          }
      }
    }
#pragma unroll
    for (int ni = 0; ni < 2; ++ni)
#pragma unroll
      for (int i = 0; i < 16; ++i) {
        const int row = m0 + wm * 32 + crow(i, h), col = n0 + wn * 64 + ni * 32 + r;
        MIX[(size_t)row * DM + col] = f2bf(mix[0][ni][i]);
      }
  }
}

DI void phase_ffn_act(const Params& p, int l) {
  bf16_t* AU = (bf16_t*)(p.ws + OFF_P);
  const float* cw = p.in[I_FCW] + (size_t)l * 3 * FFN;
  const int nthr = gridDim.x * NTHR;
  for (int run = obid() * NTHR + otid(); run < 1024 * 352; run += nthr) {
    const int ch = run / 352, j8 = run % 352, j0 = j8 * 8;
    float w0[8], w1[8], w2[8];
#pragma unroll
    for (int e = 0; e < 8; ++e) { w0[e] = cw[j0 + e]; w1[e] = cw[FFN + j0 + e]; w2[e] = cw[2 * FFN + j0 + e]; }
    const int t0 = ch * 64, s0 = t0 % SEQ;
    float a1[8], a2[8];
#pragma unroll
    for (int e = 0; e < 8; ++e) { a1[e] = 0.f; a2[e] = 0.f; }
    if (s0 > 0) {
      bf16x8 v1 = *(const bf16x8*)(AU + (size_t)(t0 - 1) * AUS + j0);
      bf16x8 v2 = *(const bf16x8*)(AU + (size_t)(t0 - 2) * AUS + j0);
#pragma unroll
      for (int e = 0; e < 8; ++e) { a1[e] = bf2f((bf16_t)v1[e]); a2[e] = bf2f((bf16_t)v2[e]); }
    }
    for (int t = t0; t < t0 + 64; ++t) {
      bf16x8 va = *(const bf16x8*)(AU + (size_t)t * AUS + j0);
      bf16x8 vu = *(const bf16x8*)(AU + (size_t)t * AUS + FFN + j0);
      float o[8];
#pragma unroll
      for (int e = 0; e < 8; ++e) {
        float a0 = bf2f((bf16_t)va[e]);
        float cv = w0[e] * a2[e] + w1[e] * a1[e] + w2[e] * a0;
        o[e] = geluf_(cv) * bf2f((bf16_t)vu[e]);
        a2[e] = a1[e]; a1[e] = a0;
      }
      uint4 ov = {pack2(o[0], o[1]), pack2(o[2], o[3]), pack2(o[4], o[5]), pack2(o[6], o[7])};
      *(uint4*)(AU + (size_t)t * AUS + FFN + j0) = ov;
    }
  }
}

DI float mixf(bf16_t cur, bf16_t prev, float mu) { const float c = bf2f(cur); return c + (bf2f(prev) - c) * mu; }
DI void rw_prep_item(const Params& p, int l, int item, char* smem) {
  const bf16_t* P = (const bf16_t*)(p.ws + OFF_P);
  bf16_t* RD = (bf16_t*)(p.ws + OFF_L);
  bf16_t* RKK = (bf16_t*)(p.ws + OFF_L + GSZ);
  bf16_t* RA = (bf16_t*)(p.ws + OFF_L + 2 * GSZ);
  bf16_t* RG = (bf16_t*)(p.ws + OFF_L + 3 * GSZ);
  float* BON = (float*)(p.ws + OFF_BON);
  const int b = item >> 6, ct = item & 63;
  const int tid = otid(), lane = tid & 63, wv = tid >> 6, hd = wv & 3, tp = wv >> 2;
  float* st = (float*)smem + wv * 128;
  const int hc = hd * 64 + lane;
  const float* mu = p.in[I_RMU] + (size_t)l * 896;
  float wup[32], aup[32], gup[64];
  {
    const float* wp = p.in[I_RWUP] + (size_t)l * 32 * 256 + hc;
    const float* ap = p.in[I_RAUP] + (size_t)l * 32 * 256 + hc;
    const float* gp = p.in[I_RGUP] + (size_t)l * 64 * 256 + hc;
    asm volatile("" : "+v"(wp), "+v"(ap), "+v"(gp));
#pragma unroll
    for (int j = 0; j < 32; ++j) { wup[j] = wp[j * 256]; aup[j] = ap[j * 256]; }
#pragma unroll
    for (int j = 0; j < 64; ++j) gup[j] = gp[j * 256];
  }
  const float w0c = p.in[I_RW0][l * 256 + hc], a0c = p.in[I_RA0][l * 256 + hc], kkc = p.in[I_RKK][l * 256 + hc],
              kac = p.in[I_RKA][l * 256 + hc], rkc = p.in[I_RRK][l * 256 + hc];
  const float mu_r = mu[hc], mu_k = mu[256 + hc], mu_1 = mu[768 + lane], mu_2 = mu[832 + lane];
  const size_t tok0 = (size_t)b * SEQ + ct * 64 + tp;
  bf16_t nx[8];
#define RWLOAD(i_)                                                                         \
  {                                                                                        \
    const bf16_t* pr_ = P + (tok0 + 2 * (i_)) * PSTR + C_RW;                               \
    nx[0] = pr_[hc]; nx[1] = pr_[256 + hc]; nx[2] = pr_[768 + lane]; nx[3] = pr_[832 + lane]; \
    if (ct * 64 + tp + 2 * (i_) > 0) {                                                     \
      const bf16_t* pp_ = pr_ - PSTR;                                                      \
      nx[4] = pp_[hc]; nx[5] = pp_[256 + hc]; nx[6] = pp_[768 + lane]; nx[7] = pp_[832 + lane]; \
    } else { nx[4] = 0; nx[5] = 0; nx[6] = 0; nx[7] = 0; }                                 \
  }
  RWLOAD(0);
#pragma unroll 1
  for (int i = 0; i < 32; ++i) {
    bf16_t cu[8];
#pragma unroll
    for (int e = 0; e < 8; ++e) cu[e] = nx[e];
    if (i + 1 < 32) RWLOAD(i + 1);
    const float r = mixf(cu[0], cu[4], mu_r), k = mixf(cu[1], cu[5], mu_k), m1 = mixf(cu[2], cu[6], mu_1), m2 = mixf(cu[3], cu[7], mu_2);
    __builtin_amdgcn_wave_barrier();
    st[lane] = lane < 32 ? tanhf_(m1) : m1;
    st[64 + lane] = sigmoidf_(m2);
    __builtin_amdgcn_wave_barrier();
    float wl = w0c, al = a0c, gt = 0.f;
#pragma unroll
    for (int j4 = 0; j4 < 8; ++j4) {
      const f32x4 tx = *(const f32x4*)(st + 4 * j4), xa = *(const f32x4*)(st + 32 + 4 * j4);
#pragma unroll
      for (int e = 0; e < 4; ++e) { wl += tx[e] * wup[4 * j4 + e]; al += xa[e] * aup[4 * j4 + e]; }
    }
#pragma unroll
    for (int j4 = 0; j4 < 16; ++j4) {
      const f32x4 sg = *(const f32x4*)(st + 64 + 4 * j4);
#pragma unroll
      for (int e = 0; e < 4; ++e) gt += sg[e] * gup[4 * j4 + e];
    }
    const float wlog = -softplusf_(-wl) - 0.5f;
    const float ee = __expf(wlog);
    const float dd = 1.f - __expf(-ee);
    const float a = sigmoidf_(al);
    const float kkr = k * kkc;
    const float kp = k * (1.f + (a - 1.f) * kac);
    const float ss = wave_sum(kkr * kkr);
    const float kk = kkr * rsqrtf(ss + EPSF);
    const float bn = wave_sum(r * kp * rkc);
    const size_t tok = tok0 + 2 * i;
    RD[tok * 256 + hc] = f2bf(dd); RKK[tok * 256 + hc] = f2bf(kk); RA[tok * 256 + hc] = f2bf(a); RG[tok * 256 + hc] = f2bf(gt);
    if (lane == 0) BON[tok * 4 + hd] = bn;
  }
#undef RWLOAD
}

DI void rwkv_scan_item(const Params& p, int l, int b, int hd, char* smem) {
  const bf16_t* P = (const bf16_t*)(p.ws + OFF_P);
  bf16_t* O = (bf16_t*)(p.ws + OFF_O);
  const bf16_t* RD = (const bf16_t*)(p.ws + OFF_L);
  const bf16_t* RKK = (const bf16_t*)(p.ws + OFF_L + GSZ);
  const bf16_t* RA = (const bf16_t*)(p.ws + OFF_L + 2 * GSZ);
  const bf16_t* RG = (const bf16_t*)(p.ws + OFF_L + 3 * GSZ);
  const float* BON = (const float*)(p.ws + OFF_BON);
  float* fb = (float*)smem;
  float* Yb = fb + 2 * 6208;
  const int tid = otid(), lane = tid & 63, wv = tid >> 6;
  const int hc = hd * 64 + lane;
  constexpr int NCH = SEQ / 16;
  float S0[8], S1[8];
#pragma unroll
  for (int j = 0; j < 8; ++j) { S0[j] = 0.f; S1[j] = 0.f; }
  const int rg = lane >> 3, kq = lane & 7, va = (wv & 3) * 16 + rg * 2;
  const float* mu = p.in[I_RMU] + (size_t)l * 896;
  const float mu_r = mu[hc], mu_k = mu[256 + hc], mu_v = mu[512 + hc];
  const float kac = p.in[I_RKA][l * 256 + hc], lgc = p.in[I_RLG][l * 256 + hc], lbc = p.in[I_RLB][l * 256 + hc];
  const int pw = wv & 3;
#pragma unroll 1
  for (int i = 0; i < NCH + 2; ++i) {
    if (wv >= 4) {
      float* B = fb + (i & 1) * 6208;
      if (i >= 2) {
        const float* Yc = Yb + (i & 1) * 1024;
#pragma unroll
        for (int j = 0; j < 4; ++j) {
          const int tl = pw * 4 + j;
          const size_t tok = (size_t)b * SEQ + (i - 2) * 16 + tl;
          const float y = Yc[tl * 64 + lane];
          const float g = bf2f(RG[tok * 256 + hc]);
          const float bn = BON[tok * 4 + hd];
          const float mean = wave_sum(y) * (1.f / 64.f);
          const float d = y - mean;
          const float var = wave_sum(d * d) * (1.f / 64.f);
          const float yn = d * rsqrtf(var + 64e-5f) * lgc + lbc;
          O[tok * DM + 768 + hc] = f2bf((yn + bn * B[5 * 1024 + tl * 64 + lane]) * g);
        }
      }
      if (i < NCH) {
        bf16_t raw[4][9];
#pragma unroll
        for (int j = 0; j < 4; ++j) {
          const int tl = pw * 4 + j;
          const int s = i * 16 + tl;
          const size_t tok = (size_t)b * SEQ + s;
          const bf16_t* pr = P + tok * PSTR + C_RW;
          raw[j][0] = pr[hc]; raw[j][1] = pr[256 + hc]; raw[j][2] = pr[512 + hc];
          if (s > 0) { raw[j][3] = (pr - PSTR)[hc]; raw[j][4] = (pr - PSTR)[256 + hc]; raw[j][5] = (pr - PSTR)[512 + hc]; }
          else { raw[j][3] = 0; raw[j][4] = 0; raw[j][5] = 0; }
          raw[j][6] = RD[tok * 256 + hc]; raw[j][7] = RKK[tok * 256 + hc]; raw[j][8] = RA[tok * 256 + hc];
        }
#pragma unroll
        for (int j = 0; j < 4; ++j) {
          const int tl = pw * 4 + j;
          const float r = mixf(raw[j][0], raw[j][3], mu_r), k = mixf(raw[j][1], raw[j][4], mu_k), v = mixf(raw[j][2], raw[j][5], mu_v);
          const float w = 1.f - bf2f(raw[j][6]), kk = bf2f(raw[j][7]), a = bf2f(raw[j][8]);
          const float ka = kk * a, kp = k * (1.f + (a - 1.f) * kac);
          const float c1 = wave_sum(ka * r), c2 = wave_sum(kp * r);
          B[tl * 64 + lane] = w; B[1024 + tl * 64 + lane] = kk; B[2048 + tl * 64 + lane] = ka; B[3072 + tl * 64 + lane] = kp;
          B[4096 + tl * 64 + lane] = w * r; B[5120 + tl * 64 + lane] = v;
          if (lane == 0) { B[6144 + tl * 2] = c1; B[6144 + tl * 2 + 1] = c2; }
        }
      }
    } else if (i >= 1 && i <= NCH) {
      const float* B = fb + ((i - 1) & 1) * 6208;
      float* Yc = Yb + ((i - 1) & 1) * 1024;
#pragma unroll 2
      for (int t = 0; t < 16; ++t) {
        const float* bt = B + t * 64 + kq * 8;
        const f32x4 w0 = *(const f32x4*)(bt), w1 = *(const f32x4*)(bt + 4);
        const f32x4 kk0 = *(const f32x4*)(bt + 1024), kk1 = *(const f32x4*)(bt + 1028);
        const f32x4 ka0 = *(const f32x4*)(bt + 2048), ka1 = *(const f32x4*)(bt + 2052);
        const f32x4 kp0 = *(const f32x4*)(bt + 3072), kp1 = *(const f32x4*)(bt + 3076);
        const f32x4 wr0 = *(const f32x4*)(bt + 4096), wr1 = *(const f32x4*)(bt + 4100);
        const float2 vv = *(const float2*)(B + 5120 + t * 64 + va);
        const float2 sc = *(const float2*)(B + 6144 + t * 2);
        float d0 = 0.f, e0 = 0.f, d1 = 0.f, e1 = 0.f;
#pragma unroll
        for (int j = 0; j < 4; ++j) {
          d0 += S0[j] * kk0[j] + S0[j + 4] * kk1[j]; e0 += S0[j] * wr0[j] + S0[j + 4] * wr1[j];
          d1 += S1[j] * kk0[j] + S1[j + 4] * kk1[j]; e1 += S1[j] * wr0[j] + S1[j + 4] * wr1[j];
        }
        d0 = reduce8(d0); e0 = reduce8(e0); d1 = reduce8(d1); e1 = reduce8(e1);
        const float sa0 = -d0, sa1 = -d1;
        const float y0 = e0 + sa0 * sc.x + vv.x * sc.y, y1 = e1 + sa1 * sc.x + vv.y * sc.y;
#pragma unroll
        for (int j = 0; j < 4; ++j) {
          S0[j] = S0[j] * w0[j] + sa0 * ka0[j] + vv.x * kp0[j]; S0[j + 4] = S0[j + 4] * w1[j] + sa0 * ka1[j] + vv.x * kp1[j];
          S1[j] = S1[j] * w0[j] + sa1 * ka0[j] + vv.y * kp0[j]; S1[j + 4] = S1[j + 4] * w1[j] + sa1 * ka1[j] + vv.y * kp1[j];
        }
        if (kq == 0) { float2 yo = {y0, y1}; *(float2*)(Yc + t * 64 + va) = yo; }
      }
    }
    __syncthreads();
  }
}

DI void sb_item(const Params& p, int item, char* smem) {
  const bf16_t* P = (const bf16_t*)(p.ws + OFF_P);
  bf16_t* O = (bf16_t*)(p.ws + OFF_O);
  const int qt = item & 15, hd = (item >> 4) & 3, b = item >> 6;
  const int tid = otid(), lane = tid & 63, wv = tid >> 6, r = lane & 31, h = lane >> 5;
  bf16_t* Vt = (bf16_t*)(smem + wv * 8704);
  const int q0 = qt * 256 + wv * 32;
  const int sq = q0 + r;
  const size_t tokb = (size_t)b * SEQ;
  bf16x8 qf[4];
#pragma unroll
  for (int ks = 0; ks < 4; ++ks) qf[ks] = *(const bf16x8*)(P + (tokb + sq) * PSTR + C_SB_Q + hd * 64 + ks * 16 + h * 8);
  f32x16 accO[2];
#pragma unroll
  for (int i = 0; i < 16; ++i) { accO[0][i] = 0.f; accO[1][i] = 0.f; }
  float Rsum = 0.f;
  for (int kt = (q0 + 31) >> 6; kt >= 0; --kt) {
    const int k0 = kt * 64;
#pragma unroll
    for (int it = 0; it < 8; ++it) {
      const int key = it * 8 + (lane >> 3), chv = lane & 7;
      bf16x8 v = *(const bf16x8*)(P + (tokb + k0 + key) * PSTR + C_SB_V + hd * 64 + chv * 8);
#pragma unroll
      for (int e = 0; e < 8; ++e) Vt[(chv * 8 + e) * 68 + key] = (bf16_t)v[e];
    }
    f32x16 acc[2];
#pragma unroll
    for (int m = 0; m < 2; ++m) {
#pragma unroll
      for (int i = 0; i < 16; ++i) acc[m][i] = 0.f;
#pragma unroll
      for (int ks = 0; ks < 4; ++ks) {
        bf16x8 kf = *(const bf16x8*)(P + (tokb + k0 + 32 * m + r) * PSTR + C_SB_K + hd * 64 + ks * 16 + h * 8);
        acc[m] = mfma32(kf, qf[ks], acc[m]);
      }
    }
    float spv[2][16];
    float gs[8];
#pragma unroll
    for (int m = 0; m < 2; ++m)
#pragma unroll
      for (int i = 0; i < 16; ++i) {
        const int key = k0 + 32 * m + crow(i, h);
        const float z = acc[m][i] * 0.125f;
        float sp = softplusf_(z);
        const bool valid = key < sq;
        acc[m][i] = valid ? (z - sp) : -1e30f;
        sp = valid ? sp : 0.f;
        spv[m][i] = sp;
      }
#pragma unroll
    for (int q = 0; q < 8; ++q) {
      const int m = q >> 2, g = q & 3;
      gs[q] = spv[m][4 * g] + spv[m][4 * g + 1] + spv[m][4 * g + 2] + spv[m][4 * g + 3];
    }
    float run = 0.f;
#pragma unroll
    for (int q = 7; q >= 0; --q) {
      const int m = q >> 2, g = q & 3;
      const float pg = __shfl_xor(gs[q], 32);
      const float base = Rsum + run + (h == 0 ? pg : 0.f);
      const float s3 = spv[m][4 * g + 3], s2 = spv[m][4 * g + 2], s1 = spv[m][4 * g + 1];
      const float b3 = base, b2 = base + s3, b1 = b2 + s2, b0 = b1 + s1;
      acc[m][4 * g + 3] = __expf(acc[m][4 * g + 3] - b3);
      acc[m][4 * g + 2] = __expf(acc[m][4 * g + 2] - b2);
      acc[m][4 * g + 1] = __expf(acc[m][4 * g + 1] - b1);
      acc[m][4 * g + 0] = __expf(acc[m][4 * g + 0] - b0);
      run += gs[q] + pg;
    }
    Rsum += run;
    __builtin_amdgcn_wave_barrier();
#pragma unroll
    for (int m = 0; m < 2; ++m)
#pragma unroll
      for (int s = 0; s < 2; ++s) {
        bf16x8 pb;
        {
          unsigned u0 = pack2(acc[m][8 * s + 0], acc[m][8 * s + 1]), u1 = pack2(acc[m][8 * s + 2], acc[m][8 * s + 3]);
          unsigned u2 = pack2(acc[m][8 * s + 4], acc[m][8 * s + 5]), u3 = pack2(acc[m][8 * s + 6], acc[m][8 * s + 7]);
          uint4 uu = {u0, u1, u2, u3};
          pb = __builtin_bit_cast(bf16x8, uu);
        }
#pragma unroll
        for (int dt = 0; dt < 2; ++dt) {
          const bf16_t* vp = Vt + (32 * dt + r) * 68 + 32 * m + 16 * s + 4 * h;
          s16x4 lo = *(const s16x4*)vp, hi = *(const s16x4*)(vp + 8);
          bf16x8 va = __builtin_shufflevector(lo, hi, 0, 1, 2, 3, 4, 5, 6, 7);
          accO[dt] = mfma32(va, pb, accO[dt]);
        }
      }
    __builtin_amdgcn_wave_barrier();
    if (__ballot(Rsum <= 88.f) == 0ull) break;
  }
#pragma unroll
  for (int dt = 0; dt < 2; ++dt)
#pragma unroll
    for (int g = 0; g < 4; ++g) {
      const int d = 32 * dt + 8 * g + 4 * h;
      uint2 o = {pack2(accO[dt][4 * g], accO[dt][4 * g + 1]), pack2(accO[dt][4 * g + 2], accO[dt][4 * g + 3])};
      *(uint2*)(O + (tokb + sq) * DM + 256 + hd * 64 + d) = o;
    }
}

DI void gdn_intra_item(const Params& p, int l, int item, char* smem) {
  const bf16_t* P = (const bf16_t*)(p.ws + OFF_P);
  const int hp = item & 1, c = (item >> 1) & 63, b = item >> 7;
  const int tid = otid(), lane = tid & 63;
  bf16_t* Kb = (bf16_t*)smem;
  bf16_t* Qb = Kb + 2 * 64 * 72;
  bf16_t* Vb = Qb + 2 * 64 * 72;
  float* Lm = (float*)(smem + 3 * 2 * 64 * 72 * 2);
  float* Gs = Lm + 2 * 4096;
  float* Bs = Gs + 128;
  const size_t tok0 = (size_t)b * SEQ + c * 64;
  const float* cw = p.in[I_GCW] + (size_t)l * 4 * 768;
  {
    const int t = tid >> 3, cg = tid & 7;
#pragma unroll 1
    for (int it = 0; it < 6; ++it) {
      const int hh = it / 3, which = it % 3, head = hp * 2 + hh;
      const int ccol = which * 256 + head * 64 + cg * 8;
      float acc[8];
#pragma unroll
      for (int e = 0; e < 8; ++e) acc[e] = 0.f;
#pragma unroll
      for (int j = 0; j < 4; ++j) {
        const int s = c * 64 + t - 3 + j;
        if (s >= 0) {
          bf16x8 xv = *(const bf16x8*)(P + ((size_t)b * SEQ + s) * PSTR + C_GDN_Q + ccol);
          f32x4 wa = *(const f32x4*)(cw + j * 768 + ccol), wb = *(const f32x4*)(cw + j * 768 + ccol + 4);
#pragma unroll
          for (int e = 0; e < 4; ++e) { acc[e] += wa[e] * bf2f((bf16_t)xv[e]); acc[e + 4] += wb[e] * bf2f((bf16_t)xv[e + 4]); }
        }
      }
      float ss = 0.f;
#pragma unroll
      for (int e = 0; e < 8; ++e) { acc[e] = siluf_(acc[e]); ss += acc[e] * acc[e]; }
      ss += __shfl_xor(ss, 1); ss += __shfl_xor(ss, 2); ss += __shfl_xor(ss, 4);
      float sc = 1.f;
      if (which == 0) sc = rsqrtf(ss + EPSF) * 0.125f;
      else if (which == 1) sc = rsqrtf(ss + EPSF);
      uint4 ov = {pack2(acc[0] * sc, acc[1] * sc), pack2(acc[2] * sc, acc[3] * sc), pack2(acc[4] * sc, acc[5] * sc), pack2(acc[6] * sc, acc[7] * sc)};
      bf16_t* dst = (which == 0 ? Qb : (which == 1 ? Kb : Vb)) + (hh * 64 + t) * 72 + cg * 8;
      *(uint4*)dst = ov;
    }
  }
  if (tid < 128) {
    const int hh = tid >> 6, t = lane, head = hp * 2 + hh;
    const float a_in = bf2f(P[(tok0 + t) * PSTR + C_GDN_A + head]);
    const float b_in = bf2f(P[(tok0 + t) * PSTR + C_GDN_B + head]);
    const float beta = sigmoidf_(b_in);
    float g = -__expf(p.in[I_GAL][l * 4 + head]) * softplusf_(a_in + p.in[I_GDT][l * 4 + head]);
#pragma unroll
    for (int d = 1; d < 64; d <<= 1) { float v = __shfl_up(g, d); if (lane >= d) g += v; }
    Gs[hh * 64 + t] = g; Bs[hh * 64 + t] = beta;
  }
  __syncthreads();
  const int hh = tid >> 8, lt = tid & 255, head = hp * 2 + hh;
  const size_t ih = ((size_t)(b * 4 + head)) * 64 + c;
  bf16_t* GW = (bf16_t*)(p.ws + OFF_G) + ih * 4096;
  bf16_t* GQD = (bf16_t*)(p.ws + OFF_G + GSZ) + ih * 4096;
  bf16_t* GQK = (bf16_t*)(p.ws + OFF_G + 2 * GSZ) + ih * 4096;
  bf16_t* GKD = (bf16_t*)(p.ws + OFF_G + 3 * GSZ) + ih * 4096;
  bf16_t* GU = (bf16_t*)(p.ws + OFF_G + 4 * GSZ) + ih * 4096;
  float* GCD = (float*)(p.ws + OFF_GCD);
  const float* Gh = Gs + hh * 64; const float* Bh = Bs + hh * 64;
  {
    const int wq = (tid >> 6) & 3, ti = wq >> 1, tj = wq & 1, r = lane & 31, h = lane >> 5;
    f32x16 akk, aqk;
#pragma unroll
    for (int i = 0; i < 16; ++i) { akk[i] = 0.f; aqk[i] = 0.f; }
    if (ti >= tj) {
#pragma unroll
      for (int ks = 0; ks < 4; ++ks) {
        bf16x8 ka = *(const bf16x8*)(Kb + (hh * 64 + 32 * ti + r) * 72 + ks * 16 + h * 8);
        bf16x8 qa = *(const bf16x8*)(Qb + (hh * 64 + 32 * ti + r) * 72 + ks * 16 + h * 8);
        bf16x8 kb = *(const bf16x8*)(Kb + (hh * 64 + 32 * tj + r) * 72 + ks * 16 + h * 8);
        akk = mfma32(ka, kb, akk);
        aqk = mfma32(qa, kb, aqk);
      }
    }
    const int j = 32 * tj + r;
    const float Gj = Gh[j];
#pragma unroll
    for (int i_ = 0; i_ < 16; ++i_) {
      const int i = 32 * ti + crow(i_, h);
      const float dec = (i >= j) ? __expf(Gh[i] - Gj) : 0.f;
      Lm[hh * 4096 + i * 64 + j] = (i > j) ? Bh[i] * akk[i_] * dec : 0.f;
      GQK[i * 64 + j] = f2bf((i >= j) ? aqk[i_] * dec : 0.f);
    }
  }
  __syncthreads();
  if (lt < 128) {
    const int cc = lt;
    float x[64];
    if (cc < 64) {
#pragma unroll
      for (int i = 0; i < 64; ++i) x[i] = bf2f(Vb[(hh * 64 + i) * 72 + cc]) * Bh[i];
    } else {
#pragma unroll
      for (int i = 0; i < 64; ++i) x[i] = bf2f(Kb[(hh * 64 + i) * 72 + cc - 64]) * Bh[i] * __expf(Gh[i]);
    }
    const float* Lh = Lm + hh * 4096;
#pragma unroll
    for (int i = 1; i < 64; ++i) {
      float s = x[i];
#pragma unroll
      for (int j4 = 0; j4 < (i + 3) / 4; ++j4) {
        const f32x4 lv = *(const f32x4*)(Lh + i * 64 + j4 * 4);
#pragma unroll
        for (int e = 0; e < 4; ++e) if (j4 * 4 + e < i) s -= lv[e] * x[j4 * 4 + e];
      }
      x[i] = s;
    }
    if (cc < 64) {
#pragma unroll
      for (int q = 0; q < 8; ++q) {
        uint4 ov = {pack2(x[8 * q], x[8 * q + 1]), pack2(x[8 * q + 2], x[8 * q + 3]), pack2(x[8 * q + 4], x[8 * q + 5]), pack2(x[8 * q + 6], x[8 * q + 7])};
        *(uint4*)(GU + cc * 64 + 8 * q) = ov;
      }
    } else {
#pragma unroll
      for (int i = 0; i < 64; ++i) GW[i * 64 + cc - 64] = f2bf(x[i]);
    }
  } else {
    const int q_ = lt - 128;
    const float Glast = Gh[63];
#pragma unroll
    for (int i = 0; i < 4; ++i) {
      const int q = q_ + 128 * i; const int pos = q >> 3, kc = q & 7;
      bf16x8 qv = *(const bf16x8*)(Qb + (hh * 64 + pos) * 72 + kc * 8);
      const float eg = __expf(Gh[pos]);
      uint4 ov = {pack2(bf2f((bf16_t)qv[0]) * eg, bf2f((bf16_t)qv[1]) * eg), pack2(bf2f((bf16_t)qv[2]) * eg, bf2f((bf16_t)qv[3]) * eg),
                  pack2(bf2f((bf16_t)qv[4]) * eg, bf2f((bf16_t)qv[5]) * eg), pack2(bf2f((bf16_t)qv[6]) * eg, bf2f((bf16_t)qv[7]) * eg)};
      *(uint4*)(GQD + pos * 64 + kc * 8) = ov;
    }
#pragma unroll
    for (int i = 0; i < 4; ++i) {
      const int q = q_ + 128 * i; const int k = q >> 3, pc = q & 7;
      float o[8];
#pragma unroll
      for (int e = 0; e < 8; ++e) { const int pos = pc * 8 + e; o[e] = bf2f(Kb[(hh * 64 + pos) * 72 + k]) * __expf(Glast - Gh[pos]); }
      uint4 ov = {pack2(o[0], o[1]), pack2(o[2], o[3]), pack2(o[4], o[5]), pack2(o[6], o[7])};
      *(uint4*)(GKD + k * 64 + pc * 8) = ov;
    }
    if (q_ == 0) GCD[ih] = __expf(Glast);
  }
}

DI void gdn_rec_item(const Params& p, int l, int b, int head, char* smem) {
  const bf16_t* P = (const bf16_t*)(p.ws + OFF_P);
  bf16_t* O = (bf16_t*)(p.ws + OFF_O);
  float* SS = (float*)smem;
  const int tid = otid(), lane = tid & 63, wv = tid >> 6, fr = lane & 15, fq = lane >> 4;
  const int split = wv & 3;
  const bool active = wv < 4;
  const float ng = p.in[I_GNG][l * 64 + split * 16 + fr];
  const float* GCD = (const float*)(p.ws + OFF_GCD);
  f32x4 S[4];
#pragma unroll
  for (int kt = 0; kt < 4; ++kt) S[kt] = (f32x4){0.f, 0.f, 0.f, 0.f};
  for (int c = 0; c < 64; ++c) {
    const size_t ih = ((size_t)(b * 4 + head)) * 64 + c;
    f32x4 acco[4];
    if (active) {
      const bf16_t* GW = (const bf16_t*)(p.ws + OFF_G) + ih * 4096;
      const bf16_t* GQD = (const bf16_t*)(p.ws + OFF_G + GSZ) + ih * 4096;
      const bf16_t* GQK = (const bf16_t*)(p.ws + OFF_G + 2 * GSZ) + ih * 4096;
      const bf16_t* GKD = (const bf16_t*)(p.ws + OFF_G + 3 * GSZ) + ih * 4096;
      const bf16_t* GU = (const bf16_t*)(p.ws + OFF_G + 4 * GSZ) + ih * 4096;
      const float cd = GCD[ih];
      bf16x8 bS[2];
#pragma unroll
      for (int ks = 0; ks < 2; ++ks) {
        uint4 uu = {pack2(S[2 * ks][0], S[2 * ks][1]), pack2(S[2 * ks][2], S[2 * ks][3]), pack2(S[2 * ks + 1][0], S[2 * ks + 1][1]), pack2(S[2 * ks + 1][2], S[2 * ks + 1][3])};
        bS[ks] = __builtin_bit_cast(bf16x8, uu);
      }
      f32x4 u[4];
#pragma unroll
      for (int rt = 0; rt < 4; ++rt) {
        f32x4 aw = {0.f, 0.f, 0.f, 0.f};
        acco[rt] = (f32x4){0.f, 0.f, 0.f, 0.f};
#pragma unroll
        for (int ks = 0; ks < 2; ++ks) {
          const int off = (16 * rt + fr) * 64 + 32 * ks + 4 * fq;
          s16x4 lo = *(const s16x4*)(GW + off), hi = *(const s16x4*)(GW + off + 16);
          bf16x8 wa = __builtin_shufflevector(lo, hi, 0, 1, 2, 3, 4, 5, 6, 7);
          aw = mfma16(wa, bS[ks], aw);
          s16x4 lo2 = *(const s16x4*)(GQD + off), hi2 = *(const s16x4*)(GQD + off + 16);
          bf16x8 qa = __builtin_shufflevector(lo2, hi2, 0, 1, 2, 3, 4, 5, 6, 7);
          acco[rt] = mfma16(qa, bS[ks], acco[rt]);
        }
        s16x4 uv = *(const s16x4*)(GU + (16 * split + fr) * 64 + 16 * rt + 4 * fq);
#pragma unroll
        for (int j = 0; j < 4; ++j) u[rt][j] = bf2f((bf16_t)uv[j]) - aw[j];
      }
      bf16x8 bU[2];
#pragma unroll
      for (int ks = 0; ks < 2; ++ks) {
        uint4 uu = {pack2(u[2 * ks][0], u[2 * ks][1]), pack2(u[2 * ks][2], u[2 * ks][3]), pack2(u[2 * ks + 1][0], u[2 * ks + 1][1]), pack2(u[2 * ks + 1][2], u[2 * ks + 1][3])};
        bU[ks] = __builtin_bit_cast(bf16x8, uu);
      }
#pragma unroll
      for (int rt = 0; rt < 4; ++rt) {
        f32x4 sn = S[rt] * cd;
#pragma unroll
        for (int ks = 0; ks < 2; ++ks) {
          const int off = (16 * rt + fr) * 64 + 32 * ks + 4 * fq;
          s16x4 lo = *(const s16x4*)(GQK + off), hi = *(const s16x4*)(GQK + off + 16);
          bf16x8 qa = __builtin_shufflevector(lo, hi, 0, 1, 2, 3, 4, 5, 6, 7);
          acco[rt] = mfma16(qa, bU[ks], acco[rt]);
          s16x4 lo2 = *(const s16x4*)(GKD + off), hi2 = *(const s16x4*)(GKD + off + 16);
          bf16x8 ka = __builtin_shufflevector(lo2, hi2, 0, 1, 2, 3, 4, 5, 6, 7);
          sn = mfma16(ka, bU[ks], sn);
        }
        S[rt] = sn;
      }
#pragma unroll
      for (int rt = 0; rt < 4; ++rt)
#pragma unroll
        for (int j = 0; j < 4; ++j) {
          float s = acco[rt][j] * acco[rt][j];
          s += __shfl_xor(s, 1); s += __shfl_xor(s, 2); s += __shfl_xor(s, 4); s += __shfl_xor(s, 8);
          if (fr == 0) SS[(c & 1) * 256 + split * 64 + 16 * rt + 4 * fq + j] = s;
        }
    }
    __syncthreads();
    if (active) {
      const float* ssb = SS + (c & 1) * 256;
#pragma unroll
      for (int rt = 0; rt < 4; ++rt)
#pragma unroll
        for (int j = 0; j < 4; ++j) {
          const int pos = 16 * rt + 4 * fq + j;
          const float tot = ssb[pos] + ssb[64 + pos] + ssb[128 + pos] + ssb[192 + pos];
          const float rn = rsqrtf(tot * (1.f / 64.f) + EPSF);
          const size_t tok = (size_t)b * SEQ + c * 64 + pos;
          const float z = bf2f(P[tok * PSTR + C_GDN_Z + head * 64 + split * 16 + fr]);
          O[tok * DM + 512 + head * 64 + split * 16 + fr] = f2bf(acco[rt][j] * rn * ng * siluf_(z));
        }
    }
  }
}

DI void lru_item(const Params& p, int l, int item, char* smem, const int mode) {
  const bf16_t* P = (const bf16_t*)(p.ws + OFF_P);
  bf16_t* O = (bf16_t*)(p.ws + OFF_O);
  float* CA = (float*)(p.ws + OFF_LCA);
  float* CH = (float*)(p.ws + OFF_LCH);
  bf16_t* XS = (bf16_t*)smem;
  float* U = (float*)(smem + 34816);
  float* XC = (float*)(smem + 34816 + 65536);
  const int b = item >> 6, ct = item & 63;
  const int tid = otid(), sc = tid >> 8, c = tid & 255;
  for (int i = 0; i < 5; ++i) {
    const int q = tid + NTHR * i;
    if (q < 67 * 32) {
      const int row = q >> 5, cc = q & 31;
      const int s = ct * 64 - 3 + row;
      uint4 v = {0u, 0u, 0u, 0u};
      if (s >= 0) v = *(const uint4*)(P + ((size_t)b * SEQ + s) * PSTR + C_LRU_X + cc * 8);
      *(uint4*)(XS + row * 256 + cc * 8) = v;
    }
  }
  float carry = 0.f;
  if (mode == 1) {
    float A = 1.f, hh = 0.f;
    const float* ca = CA + ((size_t)b * 128 + sc * ct) * 256 + c;
    const float* chp = CH + ((size_t)b * 128 + sc * ct) * 256 + c;
    int k = 0;
    for (; k + 8 <= ct; k += 8) {
      float av[8], hv[8];
#pragma unroll
      for (int e = 0; e < 8; ++e) { av[e] = ca[(size_t)(k + e) * 256]; hv[e] = chp[(size_t)(k + e) * 256]; }
#pragma unroll
      for (int e = 0; e < 8; ++e) { hh = av[e] * hh + hv[e]; A *= av[e]; }
    }
    for (; k < ct; ++k) { const float a_ = ca[(size_t)k * 256], h_ = chp[(size_t)k * 256]; hh = a_ * hh + h_; A *= a_; }
    XC[(sc * 256 + c) * 2] = A; XC[(sc * 256 + c) * 2 + 1] = hh;
  }
  __syncthreads();
  if (mode == 1) {
    const float h0 = XC[c * 2 + 1], A1 = XC[(256 + c) * 2], h1 = XC[(256 + c) * 2 + 1];
    carry = A1 * h0 + h1;
    if (sc == 1) carry = CA[((size_t)b * 128 + 2 * ct) * 256 + c] * carry + CH[((size_t)b * 128 + 2 * ct) * 256 + c];
  }
  {
    const float cb = p.in[I_LCB][l * 256 + c];
    const float c0 = p.in[I_LCW][(l * 4 + 0) * 256 + c], c1 = p.in[I_LCW][(l * 4 + 1) * 256 + c],
                c2 = p.in[I_LCW][(l * 4 + 2) * 256 + c], c3 = p.in[I_LCW][(l * 4 + 3) * 256 + c];
    for (int t = sc * 32; t < sc * 32 + 32; ++t)
      U[t * 256 + c] = cb + c0 * bf2f(XS[t * 256 + c]) + c1 * bf2f(XS[(t + 1) * 256 + c]) + c2 * bf2f(XS[(t + 2) * 256 + c]) + c3 * bf2f(XS[(t + 3) * 256 + c]);
  }
  __syncthreads();
  {
    const int n = c >> 6, f = c & 63;
    float wr[64], wi[64];
    {
      const float* wrp = p.in[I_LWR] + (((size_t)l * 4 + n) * 64) * 64 + f;
      const float* wip = p.in[I_LWI] + (((size_t)l * 4 + n) * 64) * 64 + f;
      asm volatile("" : "+v"(wrp), "+v"(wip));
#pragma unroll
      for (int e = 0; e < 64; ++e) { wr[e] = wrp[e * 64]; wi[e] = wip[e * 64]; }
    }
    const float br = p.in[I_LBR][l * 256 + c], bi = p.in[I_LBI][l * 256 + c];
    const float lamsp = softplusf_(-p.in[I_LLAM][l * 256 + c]);
    float hl = carry, ac = 1.f;
    for (int t = sc * 32; t < sc * 32 + 32; ++t) {
      float ar = br, ai = bi;
#pragma unroll
      for (int e4 = 0; e4 < 16; ++e4) {
        const f32x4 uu = *(const f32x4*)(U + t * 256 + n * 64 + e4 * 4);
#pragma unroll
        for (int e = 0; e < 4; ++e) { ar += uu[e] * wr[e4 * 4 + e]; ai += uu[e] * wi[e4 * 4 + e]; }
      }
      const float rg = sigmoidf_(ar), ig = sigmoidf_(ai);
      const float la = -8.f * rg * lamsp;
      const float a = __expf(la);
      const float bb = sqrtf(fmaxf(0.f, 1.f - __expf(2.f * la))) * (ig * U[t * 256 + c]);
      hl = a * hl + bb; ac *= a;
      if (mode == 1) {
        const size_t tok = (size_t)b * SEQ + ct * 64 + t;
        const float y = bf2f(P[tok * PSTR + C_LRU_Y + c]);
        O[tok * DM + c] = f2bf(hl * geluf_(y));
      }
    }
    if (mode == 0) {
      const int ck = ct * 2 + sc;
      CA[((size_t)b * 128 + ck) * 256 + c] = ac; CH[((size_t)b * 128 + ck) * 256 + c] = hl;
    }
  }
}

__global__ void __launch_bounds__(NTHR) mega(Params p) {
  extern __shared__ __attribute__((aligned(16))) char smem[];
  cg::grid_group grid = cg::this_grid();
  const int tid = threadIdx.x;
  bf16_t* H = (bf16_t*)(p.ws + OFF_H);
  bf16_t* PB = (bf16_t*)(p.ws + OFF_P);

  for (int rep = 0; rep < REP_MISC; ++rep) {
  if (MASK & 1) phase_mod(p, smem);
  grid.sync();
  }
  for (int l = 0; l < 4; ++l) {
    const float* xcur = (l == 0) ? p.in[I_X] : p.out;
    for (int rep = 0; rep < REP_MISC; ++rep) {
    if (MASK & 2) phase_convert(p, l, smem);
    if (MASK & 4) phase_norm(p, xcur, p.in[I_N1G] + l * 1024, l, 1024, 0, H, nullptr);
    grid.sync();
    }
    for (int rep = 0; rep < REP_G; ++rep) {
    if (MASK & 8) phase_gemm_bf16(H, DM, (const bf16_t*)(p.ws + OFF_WIN), 1024, PSTR, PB, PSTR, smem);
    grid.sync();
    }
    for (int rep = 0; rep < REP_M1; ++rep) {
    for (int it = blockIdx.x; it < 5120; it += gridDim.x) {
      if (it < 2048) { if (MASK & 32) gdn_intra_item(p, l, it, smem); }
      else if (it < 3072) { if (MASK & 64) sb_item(p, it - 2048, smem); }
      else if (it < 4096) { if (MASK & 128) lru_item(p, l, it - 3072, smem, 0); }
      else { if (MASK & 16) rw_prep_item(p, l, it - 4096, smem); }
      __syncthreads();
    }
    grid.sync();
    }
    for (int rep = 0; rep < REP_M2; ++rep) {
    if (blockIdx.x < 64) {
      if (MASK & 16) rwkv_scan_item(p, l, blockIdx.x >> 2, blockIdx.x & 3, smem);
    } else if (blockIdx.x < 128) {
      if (MASK & 256) gdn_rec_item(p, l, (blockIdx.x - 64) >> 2, (blockIdx.x - 64) & 3, smem);
    } else {
      for (int it = blockIdx.x - 128; it < 1024; it += gridDim.x - 128) {
        if (MASK & 512) lru_item(p, l, it, smem, 1);
        __syncthreads();
      }
    }
    grid.sync();
    }
    for (int rep = 0; rep < REP_G; ++rep) {
    if (MASK & 1024) phase_gemm_mix(p, l, smem);
    grid.sync();
    }
    if (MASK & 2048) phase_gemm_resid(p, PB, DM, (const bf16_t*)(p.ws + OFF_WO), 1024, xcur, p.out, l, 2048, smem);
    grid.sync();
    for (int rep = 0; rep < REP_MISC; ++rep) {
    if (MASK & 4096) phase_norm(p, p.out, p.in[I_N2G] + l * 1024, l, 4096, 3072, H, nullptr);
    grid.sync();
    }
    for (int rep = 0; rep < REP_G; ++rep) {
    if (MASK & 8192) phase_gemm_bf16(H, DM, (const bf16_t*)(p.ws + OFF_WF), 1024, AUS, PB, AUS, smem);
    grid.sync();
    }
    if (MASK & 16384) phase_ffn_act(p, l);
    grid.sync();
    if (MASK & 32768) phase_gemm_resid(p, PB + FFN, AUS, (const bf16_t*)(p.ws + OFF_WD), FFN, p.out, p.out, l, 5120, smem);
    grid.sync();
  }
  if (MASK & 65536) phase_norm(p, p.out, p.in[I_FG], 0, 0, 0, nullptr, p.out);
}

extern "C" void kernel_launch(void* const* d_in, const int* in_sizes, int n_in,
                              void* d_out, int out_size, void* d_ws, size_t ws_size,
                              hipStream_t stream) {
  if (ws_size < WS_NEED || n_in < 38) { fprintf(stderr, "workspace too small: %zu < %zu\n", ws_size, (size_t)WS_NEED); return; }
  (void)hipFuncSetAttribute((const void*)mega, hipFuncAttributeMaxDynamicSharedMemorySize, SMEM_BYTES);
  int dev = 0, cus = 0, per_cu = 0;
  (void)hipGetDevice(&dev);
  (void)hipDeviceGetAttribute(&cus, hipDeviceAttributeMultiprocessorCount, dev);
  (void)hipOccupancyMaxActiveBlocksPerMultiprocessor(&per_cu, mega, NTHR, SMEM_BYTES);
  if (per_cu < 1 || cus < 1) { fprintf(stderr, "occupancy query failed (%d, %d)\n", per_cu, cus); return; }
  if (cus > 256) cus = 256;
  const int grid_blocks = cus;
  Params p{};
  for (int i = 0; i < 38; ++i) p.in[i] = (const float*)d_in[i];
  p.out = (float*)d_out; p.ws = (char*)d_ws;
  void* args[] = {&p};
  hipError_t e = hipLaunchCooperativeKernel((void*)mega, dim3(grid_blocks), dim3(NTHR), args, SMEM_BYTES, stream);
  if (e != hipSuccess) fprintf(stderr, "cooperative launch failed: %s (grid %d)\n", hipGetErrorString(e), grid_blocks);
}
```

```cpp
#include <hip/hip_runtime.h>
#include <hip/hip_cooperative_groups.h>
#include <cstdio>
namespace cg = cooperative_groups;

typedef unsigned short bf16_t;
typedef short bf16x8 __attribute__((ext_vector_type(8)));
typedef short s16x4 __attribute__((ext_vector_type(4)));
typedef float f32x4 __attribute__((ext_vector_type(4)));
typedef float f32x16 __attribute__((ext_vector_type(16)));
typedef unsigned u32x4 __attribute__((ext_vector_type(4)));
#define DI __device__ __forceinline__

constexpr int NTOK = 65536, DM = 1024, SEQ = 4096, PSTR = 3328, FFN = 2816, AUS = 5632;
constexpr int C_LRU_X = 0, C_LRU_Y = 256, C_SB_Q = 512, C_SB_K = 768, C_SB_V = 1024;
constexpr int C_GDN_Q = 1280, C_GDN_Z = 2048, C_GDN_A = 2304, C_GDN_B = 2308, C_RW = 2312;
constexpr float EPSF = 1e-6f;
#ifndef MASK
#define MASK 0x1ffff
#endif
#ifndef REP_M1
#define REP_M1 1
#endif
#ifndef REP_M2
#define REP_M2 1
#endif
#ifndef REP_G
#define REP_G 1
#endif
#ifndef REP_MISC
#define REP_MISC 1
#endif
constexpr int NTHR = 512;
constexpr int SMEM_BYTES = 131072;

constexpr size_t OFF_MODP = 0;
constexpr size_t OFF_WIN = 6291456;
constexpr size_t OFF_WG = OFF_WIN + 6815744;
constexpr size_t OFF_WBR = OFF_WG + 8388608;
constexpr size_t OFF_WO = OFF_WBR + 2097152;
constexpr size_t OFF_WF = OFF_WO + 2097152;
constexpr size_t OFF_WD = OFF_WF + 11534336;
constexpr size_t OFF_H = OFF_WD + 5767168;
constexpr size_t OFF_P = OFF_H + 134217728;
constexpr size_t OFF_O = OFF_P + 436207616;
constexpr size_t OFF_G = OFF_O + 134217728;
constexpr size_t GSZ = 33554432;
constexpr size_t OFF_GCD = OFF_G + 5 * GSZ;
constexpr size_t OFF_L = OFF_GCD + 16384;
constexpr size_t LSZ = 67108864;
constexpr size_t OFF_LCA = OFF_L + 2 * LSZ;
constexpr size_t OFF_LCH = OFF_LCA + 2097152;
constexpr size_t OFF_BON = OFF_LCH + 2097152;
constexpr size_t WS_NEED = OFF_BON + 1048576;

struct Params { const float* in[38]; float* out; char* ws; };
enum { I_X = 0, I_C, I_N1G, I_N2G, I_FG, I_WADA, I_BADA, I_WIN, I_LCW, I_LCB, I_LWR, I_LBR, I_LWI, I_LBI, I_LLAM,
       I_GCW, I_GAL, I_GDT, I_GNG, I_RMU, I_RW0, I_RWUP, I_RA0, I_RAUP, I_RGUP, I_RKK, I_RKA, I_RRK, I_RLG, I_RLB,
       I_WBR, I_WGATE, I_BGATE, I_WOUT, I_FWG, I_FWU, I_FCW, I_FWD };

DI float bf2f(bf16_t v) { return __uint_as_float(((unsigned)v) << 16); }
DI bf16_t f2bf(float x) { unsigned u = __float_as_uint(x); u += 0x7fffu + ((u >> 16) & 1u); return (bf16_t)(u >> 16); }
DI unsigned pack2(float lo, float hi) { return (unsigned)f2bf(lo) | (((unsigned)f2bf(hi)) << 16); }
DI float sigmoidf_(float x) { return 1.f / (1.f + __expf(-x)); }
DI float softplusf_(float x) { return fmaxf(x, 0.f) + __logf(1.f + __expf(-fabsf(x))); }
DI float siluf_(float x) { return x / (1.f + __expf(-x)); }
DI float geluf_(float x) { float u = 0.7978845608f * (x + 0.044715f * x * x * x); return x / (1.f + __expf(-2.f * u)); }
DI float tanhf_(float x) { return 1.f - 2.f / (1.f + __expf(2.f * x)); }
DI float wave_sum(float x) {
#pragma unroll
  for (int o = 32; o >= 1; o >>= 1) x += __shfl_xor(x, o);
  return x;
}
template <int CTRL> DI float dppf(float x) { return __int_as_float(__builtin_amdgcn_update_dpp(0, __float_as_int(x), CTRL, 0xf, 0xf, true)); }
DI float reduce8(float x) { x += dppf<0xB1>(x); x += dppf<0x4E>(x); x += dppf<0x141>(x); return x; }
DI f32x16 mfma32(bf16x8 a, bf16x8 b, f32x16 c) { return __builtin_amdgcn_mfma_f32_32x32x16_bf16(a, b, c, 0, 0, 0); }
DI f32x4 mfma16(bf16x8 a, bf16x8 b, f32x4 c) { return __builtin_amdgcn_mfma_f32_16x16x32_bf16(a, b, c, 0, 0, 0); }
DI int crow(int i, int h) { return (i & 3) + 8 * (i >> 2) + 4 * h; }

DI float modv(const float* modp, const float* bada, int l, int b, int idx) {
  const float* q = modp + ((size_t)(l * 16 + b)) * 6144 + idx;
  const size_t ks = (size_t)4 * 16 * 6144;
  return bada[l * 6144 + idx] + q[0] + q[ks] + q[2 * ks] + q[3 * ks];
}

DI int otid() { int t = threadIdx.x; asm volatile("" : "+v"(t)); return t; }
DI int obid() { int b = blockIdx.x; asm volatile("" : "+s"(b)); return b; }
DI void phase_mod(const Params& p, char* smem) {
  float* sm = (float*)smem;
  float* modp = (float*)(p.ws + OFF_MODP);
  const int tid = otid();
  for (int item = obid(); item < 192; item += gridDim.x) {
    const int l = item / 48, rem = item % 48, jb = rem >> 2, kq = rem & 3;
    for (int i = 0; i < 8; ++i) {
      int e = tid + 512 * i; int b = e >> 8, k = e & 255;
      float cv = p.in[I_C][b * 1024 + kq * 256 + k];
      sm[e] = siluf_(cv);
    }
    __syncthreads();
    float acc[16];
#pragma unroll
    for (int b = 0; b < 16; ++b) acc[b] = 0.f;
    const float* wp = p.in[I_WADA] + ((size_t)l * 1024 + kq * 256) * 6144 + jb * 512 + tid;
    for (int k = 0; k < 256; k += 4) {
      float w0 = wp[(size_t)k * 6144], w1 = wp[(size_t)(k + 1) * 6144], w2 = wp[(size_t)(k + 2) * 6144], w3 = wp[(size_t)(k + 3) * 6144];
#pragma unroll
      for (int b = 0; b < 16; ++b) {
        f32x4 cv = *(const f32x4*)(sm + b * 256 + k);
        acc[b] += cv[0] * w0 + cv[1] * w1 + cv[2] * w2 + cv[3] * w3;
      }
    }
#pragma unroll
    for (int b = 0; b < 16; ++b) modp[((size_t)((kq * 4 + l) * 16 + b)) * 6144 + jb * 512 + tid] = acc[b];
    __syncthreads();
  }
}

DI void conv_tile(const float* src, bf16_t* dst, int K, int N, int k0, int n0, char* smem) {
  float* tile = (float*)smem;
  const int tid = otid();
#pragma unroll
  for (int it = 0; it < 2; ++it) {
    int kr = (tid >> 4) + 32 * it, nc = (tid & 15) * 4;
    f32x4 v = {0.f, 0.f, 0.f, 0.f};
    if (n0 + nc < N) v = *(const f32x4*)(src + (size_t)(k0 + kr) * N + n0 + nc);
    tile[kr * 65 + nc] = v[0]; tile[kr * 65 + nc + 1] = v[1]; tile[kr * 65 + nc + 2] = v[2]; tile[kr * 65 + nc + 3] = v[3];
  }
  __syncthreads();
  {
    int n = tid >> 3, kc = (tid & 7) * 8;
    unsigned o[4];
#pragma unroll
    for (int e = 0; e < 4; ++e) o[e] = pack2(tile[(kc + 2 * e) * 65 + n], tile[(kc + 2 * e + 1) * 65 + n]);
    uint4 ov = {o[0], o[1], o[2], o[3]};
    *(uint4*)(dst + (size_t)(n0 + n) * K + k0 + kc) = ov;
  }
  __syncthreads();
}

DI void phase_convert(const Params& p, int l, char* smem) {
  for (int t = obid(); t < 4480; t += gridDim.x) {
    const float* src; bf16_t* dst; int K, N, Npad, tt = t;
    if (tt < 832) { src = p.in[I_WIN] + (size_t)l * 1024 * 3208; dst = (bf16_t*)(p.ws + OFF_WIN); K = 1024; N = 3208; Npad = 3328; }
    else if ((tt -= 832) < 1024) { int br = tt >> 8; tt &= 255; src = p.in[I_WGATE] + ((size_t)l * 4 + br) * 1048576; dst = (bf16_t*)(p.ws + OFF_WG) + (size_t)br * 1048576; K = 1024; N = 1024; Npad = 1024; }
    else if ((tt -= 1024) < 256) { int br = tt >> 6; tt &= 63; src = p.in[I_WBR] + ((size_t)l * 4 + br) * 262144; dst = (bf16_t*)(p.ws + OFF_WBR) + (size_t)br * 262144; K = 256; N = 1024; Npad = 1024; }
    else if ((tt -= 256) < 256) { src = p.in[I_WOUT] + (size_t)l * 1048576; dst = (bf16_t*)(p.ws + OFF_WO); K = 1024; N = 1024; Npad = 1024; }
    else if ((tt -= 256) < 704) { src = p.in[I_FWG] + (size_t)l * 1024 * 2816; dst = (bf16_t*)(p.ws + OFF_WF); K = 1024; N = 2816; Npad = 2816; }
    else if ((tt -= 704) < 704) { src = p.in[I_FWU] + (size_t)l * 1024 * 2816; dst = (bf16_t*)(p.ws + OFF_WF) + (size_t)2816 * 1024; K = 1024; N = 2816; Npad = 2816; }
    else { tt -= 704; src = p.in[I_FWD] + (size_t)l * 2816 * 1024; dst = (bf16_t*)(p.ws + OFF_WD); K = 2816; N = 1024; Npad = 1024; }
    const int nNt = Npad >> 6;
    const int kt = tt / nNt, nt = tt % nNt;
    conv_tile(src, dst, K, N, kt * 64, nt * 64, smem);
  }
}

DI void phase_norm(const Params& p, const float* xin, const float* g, int l, int scale_idx, int shift_idx, bf16_t* hout, float* fout) {
  const float* modp = (const float*)(p.ws + OFF_MODP);
  const int lane = otid() & 63, wv = otid() >> 6;
  const int nw = gridDim.x * 8;
  const int rows_per = 32;
  for (int chunk = obid() * 8 + wv; chunk < NTOK / 32; chunk += nw) {
  const int row0 = chunk * rows_per;
  const int b = row0 / SEQ;
  f32x4 gv[4], sc[4], sh[4];
#pragma unroll
  for (int j = 0; j < 4; ++j) {
    int c = lane * 4 + 256 * j;
    gv[j] = *(const f32x4*)(g + c);
    if (hout) {
#pragma unroll
      for (int e = 0; e < 4; ++e) {
        sc[j][e] = 1.f + modv(modp, p.in[I_BADA], l, b, scale_idx + c + e);
        sh[j][e] = modv(modp, p.in[I_BADA], l, b, shift_idx + c + e);
      }
    }
  }
  for (int rr = 0; rr < rows_per; ++rr) {
    const size_t row = (size_t)row0 + rr;
    f32x4 xv[4]; float ss = 0.f;
#pragma unroll
    for (int j = 0; j < 4; ++j) {
      xv[j] = *(const f32x4*)(xin + row * DM + lane * 4 + 256 * j);
      ss += xv[j][0] * xv[j][0] + xv[j][1] * xv[j][1] + xv[j][2] * xv[j][2] + xv[j][3] * xv[j][3];
    }
    ss = wave_sum(ss);
    const float rs = rsqrtf(ss * (1.f / 1024.f) + EPSF);
#pragma unroll
    for (int j = 0; j < 4; ++j) {
      f32x4 y = xv[j] * rs * gv[j];
      if (hout) {
        y = y * sc[j] + sh[j];
        uint2 o = {pack2(y[0], y[1]), pack2(y[2], y[3])};
        *(uint2*)(hout + row * DM + lane * 4 + 256 * j) = o;
      } else {
        *(f32x4*)(fout + row * DM + lane * 4 + 256 * j) = y;
      }
    }
  }
  }
}

#define PG_LAS __attribute__((address_space(3)))
namespace pg {
constexpr int BM = 256, BK = 64, HALF = 128, HTB = HALF * BK * 2, NXCD = 8, WGM = 8;
DI int lds_byte(int r, int c) { const int st = (r >> 4) * 2 + (c >> 5), rr = r & 15, cc = c & 31, ob = rr * 64 + cc * 2; return st * 1024 + (ob ^ (((ob >> 9) & 1) << 5)); }
DI void stage_rc(int b, int& R, int& C) { const int st = b / 1024, sb = b % 1024, swz = sb ^ (((sb >> 9) & 1) << 5); R = (st >> 1) * 16 + swz / 64; C = (st & 1) * 32 + (swz % 64) / 2; }
DI int perm32(int rho) { const int n = rho >> 4, i = rho & 15; return 8 * (i >> 2) + 4 * n + (i & 3); }
struct Unit { int pm, pn; int aux; long ao, bo; };
template <int REP> struct Order {
  int nM, nN, nwg, G, c; long astep, bstep;
  DI void init(int M, int N, int G_, int c_, long astep_ = 0, long bstep_ = 0) { nM = M / BM; nN = N / BM; nwg = nM * nN; G = G_; c = c_; astep = astep_; bstep = bstep_; }
  DI bool next(int i, Unit& u) const {
    const int ti = i / REP, aux = i % REP;
    const long L = (long)ti * G + c; if (L >= nwg) return false;
    int wgid = (int)L; { const int q = nwg / NXCD, r = nwg % NXCD, xcd = wgid % NXCD, off = wgid / NXCD; wgid = (xcd < r ? xcd * (q + 1) : r * (q + 1) + (xcd - r) * q) + off; }
    const int nig = WGM * nN, gid = wgid / nig, fm = gid * WGM, gsz = (nM - fm) < WGM ? (nM - fm) : WGM;
    u.pm = fm + ((wgid % nig) % gsz); u.pn = (wgid % nig) / gsz; u.aux = aux; u.ao = aux * astep; u.bo = aux * bstep; return true;
  }
};
DI unsigned cvt_pk_bf16(float lo, float hi) { unsigned r; asm volatile("v_cvt_pk_bf16_f32 %0, %1, %2" : "=v"(r) : "v"(lo), "v"(hi)); return r; }

template <class Epi, class Sched>
DI void gemm_phase(PG_LAS unsigned char* lds, const bf16_t* Ag, int lda, const bf16_t* Bg, int K, const Sched& S, const Epi& E) {
  const int tid = otid(), wid = __builtin_amdgcn_readfirstlane(tid >> 6), lane = tid & 63, wr = wid >> 2, wc = wid & 3, fr = lane & 15, fq = lane >> 4;
  const int nt = K / BK;
  unsigned voffA[2], voffB[2];
#pragma unroll
  for (int i = 0; i < 2; ++i) { int R, C; stage_rc(tid * 16 + i * 8192, R, C); const int Rb = Epi::PERM ? ((R & ~31) + perm32(R & 31)) : R;
    voffA[i] = (unsigned)(R * lda + C) * 2u; voffB[i] = (unsigned)(Rb * K + C) * 2u; }
  const size_t kstep = (size_t)(BK * 2);
  const size_t hstepA = (size_t)HALF * lda * 2, hstepB = (size_t)HALF * K * 2;
  const size_t tstepA = 2 * hstepA, tstepB = 2 * hstepB;
  const unsigned ldsw = (unsigned)wid * 1024u;
  const int aoff = lds_byte(wr * 64 + fr, fq * 8), boff = lds_byte(wc * 32 + fr, fq * 8);
#define PG_SA(b, h) (((b) * 2 + (h)) * HTB)
#define PG_SB(b, h) ((4 + (b) * 2 + (h)) * HTB)
#define PG_STAGE(bufoff, gbase, voff) do { _Pragma("unroll") for (int _i = 0; _i < 2; ++_i) \
    __builtin_amdgcn_global_load_lds((const unsigned*)((const char*)(gbase) + (voff)[_i]), (PG_LAS unsigned*)(lds + (bufoff) + ldsw + _i * 8192), 16, 0, 0); } while (0)
#define PG_LDA(dst, b, h) do { _Pragma("unroll") for (int m = 0; m < 4; ++m) _Pragma("unroll") for (int k = 0; k < 2; ++k) dst[m][k] = *(const PG_LAS bf16x8*)(lds + PG_SA(b, h) + aoff + m * 2048 + k * 1024); } while (0)
#define PG_LDB(dst, b, h) do { _Pragma("unroll") for (int n = 0; n < 2; ++n) _Pragma("unroll") for (int k = 0; k < 2; ++k) dst[n][k] = *(const PG_LAS bf16x8*)(lds + PG_SB(b, h) + boff + n * 2048 + k * 1024); } while (0)
#define PG_MMA(ai, bj, At, Bt) do { __builtin_amdgcn_s_setprio(1); _Pragma("unroll") for (int m = 0; m < 4; ++m) _Pragma("unroll") for (int n = 0; n < 2; ++n) _Pragma("unroll") for (int k = 0; k < 2; ++k) \
    acc[ai][bj][m][n] = __builtin_amdgcn_mfma_f32_16x16x32_bf16(Bt[n][k], At[m][k], acc[ai][bj][m][n], 0, 0, 0); __builtin_amdgcn_s_setprio(0); } while (0)
#define PG_WAIT_V(n) asm volatile("s_waitcnt vmcnt(" #n ")" ::: "memory")
#define PG_WAIT_L(n) asm volatile("s_waitcnt lgkmcnt(" #n ")" ::: "memory")
#define PG_BAR __builtin_amdgcn_s_barrier()
#define PG_SCHED __builtin_amdgcn_sched_barrier(0)
  Unit cur, nxt; int ui = 0;
  if (!S.next(0, cur)) return;
  f32x4 acc[2][2][4][2];
#pragma unroll
  for (int a = 0; a < 2; ++a)
#pragma unroll
    for (int b = 0; b < 2; ++b)
#pragma unroll
      for (int m = 0; m < 4; ++m)
#pragma unroll
        for (int n = 0; n < 2; ++n) acc[a][b][m][n] = (f32x4){0.f, 0.f, 0.f, 0.f};
  bf16x8 At[4][2], B0[2][2], B1[2][2];
  const char* cA = (const char*)Ag + (size_t)cur.pm * tstepA + cur.ao; const char* cB = (const char*)Bg + (size_t)cur.pn * tstepB + cur.bo;
  PG_STAGE(PG_SB(0, 0), cB, voffB); PG_STAGE(PG_SA(0, 0), cA, voffA); PG_STAGE(PG_SB(0, 1), cB + hstepB, voffB); PG_STAGE(PG_SA(0, 1), cA + hstepA, voffA);
  if (wr == 1) PG_BAR;
  PG_WAIT_V(4); PG_BAR;
  PG_STAGE(PG_SB(1, 0), cB + kstep, voffB); PG_STAGE(PG_SA(1, 0), cA + kstep, voffA); PG_STAGE(PG_SB(1, 1), cB + hstepB + kstep, voffB);
  PG_WAIT_V(6); PG_BAR;
  for (;;) {
    const bool has_next = S.next(ui + 1, nxt);
    const char* nA = has_next ? (const char*)Ag + (size_t)nxt.pm * tstepA + nxt.ao : cA; const char* nB = has_next ? (const char*)Bg + (size_t)nxt.pn * tstepB + nxt.bo : cB;
#pragma unroll 1
    for (int t = 0; t < nt; t += 2) {
      const bool last = (t == nt - 2);
      const char* a1 = cA + (size_t)(t + 1) * kstep;
      const char* a2 = last ? nA : cA + (size_t)(t + 2) * kstep; const char* b2 = last ? nB : cB + (size_t)(t + 2) * kstep;
      const char* a3 = a2 + kstep; const char* b3 = b2 + kstep;
      PG_LDB(B0, 0, 0); PG_SCHED; PG_LDA(At, 0, 0); PG_STAGE(PG_SA(1, 1), a1 + hstepA, voffA);
      PG_WAIT_L(8); PG_BAR; PG_WAIT_L(0); PG_MMA(0, 0, At, B0); PG_BAR; PG_SCHED;
      PG_LDB(B1, 0, 1); PG_STAGE(PG_SB(0, 0), b2, voffB);
      PG_BAR; PG_WAIT_L(0); PG_MMA(0, 1, At, B1); PG_BAR;
      PG_LDA(At, 0, 1); PG_STAGE(PG_SA(0, 0), a2, voffA);
      PG_BAR; PG_WAIT_L(0); PG_MMA(1, 0, At, B0); PG_BAR; PG_SCHED;
      PG_STAGE(PG_SB(0, 1), b2 + hstepB, voffB);
      PG_WAIT_V(6); PG_BAR; PG_MMA(1, 1, At, B1); PG_BAR;
      PG_LDB(B0, 1, 0); PG_SCHED; PG_LDA(At, 1, 0); PG_STAGE(PG_SA(0, 1), a2 + hstepA, voffA);
      PG_WAIT_L(8); PG_BAR; PG_WAIT_L(0); PG_MMA(0, 0, At, B0); PG_BAR; PG_SCHED;
      PG_LDB(B1, 1, 1); PG_STAGE(PG_SB(1, 0), b3, voffB);
      PG_BAR; PG_WAIT_L(0); PG_MMA(0, 1, At, B1); PG_BAR;
      PG_LDA(At, 1, 1); PG_STAGE(PG_SA(1, 0), a3, voffA);
      PG_BAR; PG_WAIT_L(0); PG_MMA(1, 0, At, B0); PG_BAR; PG_SCHED;
      PG_STAGE(PG_SB(1, 1), b3 + hstepB, voffB);
      PG_WAIT_V(6); PG_BAR; PG_MMA(1, 1, At, B1); PG_BAR;
    }
    E(acc, cur, wr, wc, fr, fq);
    if (!has_next) break;
#pragma unroll
    for (int a = 0; a < 2; ++a)
#pragma unroll
      for (int b = 0; b < 2; ++b)
#pragma unroll
        for (int m = 0; m < 4; ++m)
#pragma unroll
          for (int n = 0; n < 2; ++n) acc[a][b][m][n] = (f32x4){0.f, 0.f, 0.f, 0.f};
    cur = nxt; cA = nA; cB = nB; ++ui;
  }
  PG_WAIT_V(0);
  if (wr == 0) PG_BAR;
  PG_BAR;
#undef PG_SA
#undef PG_SB
#undef PG_STAGE
#undef PG_LDA
#undef PG_LDB
#undef PG_MMA
#undef PG_WAIT_V
#undef PG_WAIT_L
#undef PG_BAR
#undef PG_SCHED
}

template <int ACT> struct EpiBf16 {
  static constexpr bool PERM = true;
  bf16_t* O; int ldc; const float* bias;
  DI void operator()(const f32x4 (&acc)[2][2][4][2], const Unit& u, int wr, int wc, int fr, int fq) const {
    const int row0 = u.pm * BM + wr * 64 + fr, col0 = u.pn * BM + wc * 32 + 8 * fq;
    f32x4 bv[2][2];
#pragma unroll
    for (int bj = 0; bj < 2; ++bj)
#pragma unroll
      for (int n = 0; n < 2; ++n) bv[bj][n] = ACT ? *(const f32x4*)(bias + col0 + bj * HALF + 4 * n) : (f32x4){0.f, 0.f, 0.f, 0.f};
#pragma unroll
    for (int ai = 0; ai < 2; ++ai)
#pragma unroll
      for (int m = 0; m < 4; ++m) { bf16_t* rowp = O + (size_t)(row0 + ai * HALF + m * 16) * ldc + col0;
#pragma unroll
        for (int bj = 0; bj < 2; ++bj) { f32x4 v0 = acc[ai][bj][m][0] + bv[bj][0], v1 = acc[ai][bj][m][1] + bv[bj][1];
          if (ACT) {
#pragma unroll
            for (int j = 0; j < 4; ++j) { v0[j] = sigmoidf_(v0[j]); v1[j] = sigmoidf_(v1[j]); } }
          u32x4 w; w.x = cvt_pk_bf16(v0[0], v0[1]); w.y = cvt_pk_bf16(v0[2], v0[3]); w.z = cvt_pk_bf16(v1[0], v1[1]); w.w = cvt_pk_bf16(v1[2], v1[3]);
          *(u32x4*)(rowp + bj * HALF) = w; } }
  }
};
struct EpiBranch {
  static constexpr bool PERM = true;
  bf16_t* MIX; const bf16_t* G;
  DI void operator()(const f32x4 (&acc)[2][2][4][2], const Unit& u, int wr, int wc, int fr, int fq) const {
    const int row0 = u.pm * BM + wr * 64 + fr, col0 = u.pn * BM + wc * 32 + 8 * fq;
#pragma unroll
    for (int ai = 0; ai < 2; ++ai)
#pragma unroll
      for (int m = 0; m < 4; ++m) {
        asm volatile("" ::: "memory");
        const size_t row = (size_t)(row0 + ai * HALF + m * 16);
        bf16_t* mp = MIX + row * DM + col0; const bf16_t* gp = G + row * 4096 + u.aux * 1024 + col0;
#pragma unroll
        for (int bj = 0; bj < 2; ++bj) {
          const bf16x8 gv = *(const bf16x8*)(gp + bj * HALF);
          float o[8];
#pragma unroll
          for (int j = 0; j < 4; ++j) { o[j] = bf2f((bf16_t)gv[j]) * acc[ai][bj][m][0][j]; o[4 + j] = bf2f((bf16_t)gv[4 + j]) * acc[ai][bj][m][1][j]; }
          if (u.aux > 0) {
            const bf16x8 mv = *(const bf16x8*)(mp + bj * HALF);
#pragma unroll
            for (int j = 0; j < 8; ++j) o[j] += bf2f((bf16_t)mv[j]);
          }
          u32x4 w; w.x = cvt_pk_bf16(o[0], o[1]); w.y = cvt_pk_bf16(o[2], o[3]); w.z = cvt_pk_bf16(o[4], o[5]); w.w = cvt_pk_bf16(o[6], o[7]);
          *(u32x4*)(mp + bj * HALF) = w;
        }
      }
  }
};
struct EpiResid {
  static constexpr bool PERM = false;
  const float* xold; float* xnew; const float* modp; const float* bada; int l, gate_idx;
  DI void operator()(const f32x4 (&acc)[2][2][4][2], const Unit& u, int wr, int wc, int fr, int fq) const {
    const int row0 = u.pm * BM + wr * 64 + fr, col0 = u.pn * BM + wc * 32 + 4 * fq;
    const int b = (u.pm * BM) / SEQ;
    f32x4 gv[2][2];
#pragma unroll
    for (int bj = 0; bj < 2; ++bj)
#pragma unroll
      for (int n = 0; n < 2; ++n)
#pragma unroll
        for (int j = 0; j < 4; ++j) gv[bj][n][j] = modv(modp, bada, l, b, gate_idx + col0 + bj * HALF + n * 16 + j);
#pragma unroll
    for (int ai = 0; ai < 2; ++ai)
#pragma unroll
      for (int m = 0; m < 4; ++m) { const size_t ro = (size_t)(row0 + ai * HALF + m * 16) * DM + col0;
#pragma unroll
        for (int bj = 0; bj < 2; ++bj)
#pragma unroll
          for (int n = 0; n < 2; ++n) {
            const f32x4 xo = *(const f32x4*)(xold + ro + bj * HALF + n * 16);
            *(f32x4*)(xnew + ro + bj * HALF + n * 16) = xo + gv[bj][n] * acc[ai][bj][m][n];
          } }
  }
};
}

DI void phase_ffn_act(const Params& p, int l) {
  bf16_t* AU = (bf16_t*)(p.ws + OFF_P);
  const float* cw = p.in[I_FCW] + (size_t)l * 3 * FFN;
  const int nthr = gridDim.x * NTHR;
  for (int run = obid() * NTHR + otid(); run < 1024 * 352; run += nthr) {
    const int ch = run / 352, j8 = run % 352, j0 = j8 * 8;
    float w0[8], w1[8], w2[8];
#pragma unroll
    for (int e = 0; e < 8; ++e) { w0[e] = cw[j0 + e]; w1[e] = cw[FFN + j0 + e]; w2[e] = cw[2 * FFN + j0 + e]; }
    const int t0 = ch * 64, s0 = t0 % SEQ;
    float a1[8], a2[8];
#pragma unroll
    for (int e = 0; e < 8; ++e) { a1[e] = 0.f; a2[e] = 0.f; }
    if (s0 > 0) {
      bf16x8 v1 = *(const bf16x8*)(AU + (size_t)(t0 - 1) * AUS + j0);
      bf16x8 v2 = *(const bf16x8*)(AU + (size_t)(t0 - 2) * AUS + j0);
#pragma unroll
      for (int e = 0; e < 8; ++e) { a1[e] = bf2f((bf16_t)v1[e]); a2[e] = bf2f((bf16_t)v2[e]); }
    }
    for (int t = t0; t < t0 + 64; ++t) {
      bf16x8 va = *(const bf16x8*)(AU + (size_t)t * AUS + j0);
      bf16x8 vu = *(const bf16x8*)(AU + (size_t)t * AUS + FFN + j0);
      float o[8];
#pragma unroll
      for (int e = 0; e < 8; ++e) {
        float a0 = bf2f((bf16_t)va[e]);
        float cv = w0[e] * a2[e] + w1[e] * a1[e] + w2[e] * a0;
        o[e] = geluf_(cv) * bf2f((bf16_t)vu[e]);
        a2[e] = a1[e]; a1[e] = a0;
      }
      uint4 ov = {pack2(o[0], o[1]), pack2(o[2], o[3]), pack2(o[4], o[5]), pack2(o[6], o[7])};
      *(uint4*)(AU + (size_t)t * AUS + FFN + j0) = ov;
    }
  }
}

DI float mixf(bf16_t cur, bf16_t prev, float mu) { const float c = bf2f(cur); return c + (bf2f(prev) - c) * mu; }
DI void rw_prep_item(const Params& p, int l, int item, char* smem) {
  const bf16_t* P = (const bf16_t*)(p.ws + OFF_P);
  bf16_t* RD = (bf16_t*)(p.ws + OFF_L);
  bf16_t* RKK = (bf16_t*)(p.ws + OFF_L + GSZ);
  bf16_t* RA = (bf16_t*)(p.ws + OFF_L + 2 * GSZ);
  bf16_t* RG = (bf16_t*)(p.ws + OFF_L + 3 * GSZ);
  float* BON = (float*)(p.ws + OFF_BON);
  const int b = item >> 6, ct = item & 63;
  const int tid = otid(), lane = tid & 63, wv = tid >> 6, hd = wv & 3, tp = wv >> 2;
  float* st = (float*)smem + wv * 128;
  const int hc = hd * 64 + lane;
  const float* mu = p.in[I_RMU] + (size_t)l * 896;
  float wup[32], aup[32], gup[64];
  {
    const float* wp = p.in[I_RWUP] + (size_t)l * 32 * 256 + hc;
    const float* ap = p.in[I_RAUP] + (size_t)l * 32 * 256 + hc;
    const float* gp = p.in[I_RGUP] + (size_t)l * 64 * 256 + hc;
    asm volatile("" : "+v"(wp), "+v"(ap), "+v"(gp));
#pragma unroll
    for (int j = 0; j < 32; ++j) { wup[j] = wp[j * 256]; aup[j] = ap[j * 256]; }
#pragma unroll
    for (int j = 0; j < 64; ++j) gup[j] = gp[j * 256];
  }
  const float w0c = p.in[I_RW0][l * 256 + hc], a0c = p.in[I_RA0][l * 256 + hc], kkc = p.in[I_RKK][l * 256 + hc],
              kac = p.in[I_RKA][l * 256 + hc], rkc = p.in[I_RRK][l * 256 + hc];
  const float mu_r = mu[hc], mu_k = mu[256 + hc], mu_1 = mu[768 + lane], mu_2 = mu[832 + lane];
  const size_t tok0 = (size_t)b * SEQ + ct * 64 + tp;
  bf16_t nx[8];
#define RWLOAD(i_)                                                                         \
  {                                                                                        \
    const bf16_t* pr_ = P + (tok0 + 2 * (i_)) * PSTR + C_RW;                               \
    nx[0] = pr_[hc]; nx[1] = pr_[256 + hc]; nx[2] = pr_[768 + lane]; nx[3] = pr_[832 + lane]; \
    if (ct * 64 + tp + 2 * (i_) > 0) {                                                     \
      const bf16_t* pp_ = pr_ - PSTR;                                                      \
      nx[4] = pp_[hc]; nx[5] = pp_[256 + hc]; nx[6] = pp_[768 + lane]; nx[7] = pp_[832 + lane]; \
    } else { nx[4] = 0; nx[5] = 0; nx[6] = 0; nx[7] = 0; }                                 \
  }
  RWLOAD(0);
#pragma unroll 1
  for (int i = 0; i < 32; ++i) {
    bf16_t cu[8];
#pragma unroll
    for (int e = 0; e < 8; ++e) cu[e] = nx[e];
    if (i + 1 < 32) RWLOAD(i + 1);
    const float r = mixf(cu[0], cu[4], mu_r), k = mixf(cu[1], cu[5], mu_k), m1 = mixf(cu[2], cu[6], mu_1), m2 = mixf(cu[3], cu[7], mu_2);
    __builtin_amdgcn_wave_barrier();
    st[lane] = lane < 32 ? tanhf_(m1) : m1;
    st[64 + lane] = sigmoidf_(m2);
    __builtin_amdgcn_wave_barrier();
    float wl = w0c, al = a0c, gt = 0.f;
#pragma unroll
    for (int j4 = 0; j4 < 8; ++j4) {
      const f32x4 tx = *(const f32x4*)(st + 4 * j4), xa = *(const f32x4*)(st + 32 + 4 * j4);
#pragma unroll
      for (int e = 0; e < 4; ++e) { wl += tx[e] * wup[4 * j4 + e]; al += xa[e] * aup[4 * j4 + e]; }
    }
#pragma unroll
    for (int j4 = 0; j4 < 16; ++j4) {
      const f32x4 sg = *(const f32x4*)(st + 64 + 4 * j4);
#pragma unroll
      for (int e = 0; e < 4; ++e) gt += sg[e] * gup[4 * j4 + e];
    }
    const float wlog = -softplusf_(-wl) - 0.5f;
    const float ee = __expf(wlog);
    const float dd = 1.f - __expf(-ee);
    const float a = sigmoidf_(al);
    const float kkr = k * kkc;
    const float kp = k * (1.f + (a - 1.f) * kac);
    const float ss = wave_sum(kkr * kkr);
    const float kk = kkr * rsqrtf(ss + EPSF);
    const float bn = wave_sum(r * kp * rkc);
    const size_t tok = tok0 + 2 * i;
    RD[tok * 256 + hc] = f2bf(dd); RKK[tok * 256 + hc] = f2bf(kk); RA[tok * 256 + hc] = f2bf(a); RG[tok * 256 + hc] = f2bf(gt);
    if (lane == 0) BON[tok * 4 + hd] = bn;
  }
#undef RWLOAD
}

DI void rwkv_scan_item(const Params& p, int l, int b, int hd, char* smem) {
  const bf16_t* P = (const bf16_t*)(p.ws + OFF_P);
  bf16_t* O = (bf16_t*)(p.ws + OFF_O);
  const bf16_t* RD = (const bf16_t*)(p.ws + OFF_L);
  const bf16_t* RKK = (const bf16_t*)(p.ws + OFF_L + GSZ);
  const bf16_t* RA = (const bf16_t*)(p.ws + OFF_L + 2 * GSZ);
  const bf16_t* RG = (const bf16_t*)(p.ws + OFF_L + 3 * GSZ);
  const float* BON = (const float*)(p.ws + OFF_BON);
  float* fb = (float*)smem;
  float* Yb = fb + 2 * 6208;
  const int tid = otid(), lane = tid & 63, wv = tid >> 6;
  const int hc = hd * 64 + lane;
  constexpr int NCH = SEQ / 16;
  float S0[8], S1[8];
#pragma unroll
  for (int j = 0; j < 8; ++j) { S0[j] = 0.f; S1[j] = 0.f; }
  const int rg = lane >> 3, kq = lane & 7, va = (wv & 3) * 16 + rg * 2;
  const float* mu = p.in[I_RMU] + (size_t)l * 896;
  const float mu_r = mu[hc], mu_k = mu[256 + hc], mu_v = mu[512 + hc];
  const float kac = p.in[I_RKA][l * 256 + hc], lgc = p.in[I_RLG][l * 256 + hc], lbc = p.in[I_RLB][l * 256 + hc];
  const int pw = wv & 3;
#pragma unroll 1
  for (int i = 0; i < NCH + 2; ++i) {
    if (wv >= 4) {
      float* B = fb + (i & 1) * 6208;
      if (i >= 2) {
        const float* Yc = Yb + (i & 1) * 1024;
#pragma unroll
        for (int j = 0; j < 4; ++j) {
          const int tl = pw * 4 + j;
          const size_t tok = (size_t)b * SEQ + (i - 2) * 16 + tl;
          const float y = Yc[tl * 64 + lane];
          const float g = bf2f(RG[tok * 256 + hc]);
          const float bn = BON[tok * 4 + hd];
          const float mean = wave_sum(y) * (1.f / 64.f);
          const float d = y - mean;
          const float var = wave_sum(d * d) * (1.f / 64.f);
          const float yn = d * rsqrtf(var + 64e-5f) * lgc + lbc;
          O[tok * DM + 768 + hc] = f2bf((yn + bn * B[5 * 1024 + tl * 64 + lane]) * g);
        }
      }
      if (i < NCH) {
        bf16_t raw[4][9];
#pragma unroll
        for (int j = 0; j < 4; ++j) {
          const int tl = pw * 4 + j;
          const int s = i * 16 + tl;
          const size_t tok = (size_t)b * SEQ + s;
          const bf16_t* pr = P + tok * PSTR + C_RW;
          raw[j][0] = pr[hc]; raw[j][1] = pr[256 + hc]; raw[j][2] = pr[512 + hc];
          if (s > 0) { raw[j][3] = (pr - PSTR)[hc]; raw[j][4] = (pr - PSTR)[256 + hc]; raw[j][5] = (pr - PSTR)[512 + hc]; }
          else { raw[j][3] = 0; raw[j][4] = 0; raw[j][5] = 0; }
          raw[j][6] = RD[tok * 256 + hc]; raw[j][7] = RKK[tok * 256 + hc]; raw[j][8] = RA[tok * 256 + hc];
        }
#pragma unroll
        for (int j = 0; j < 4; ++j) {
          const int tl = pw * 4 + j;
          const float r = mixf(raw[j][0], raw[j][3], mu_r), k = mixf(raw[j][1], raw[j][4], mu_k), v = mixf(raw[j][2], raw[j][5], mu_v);
          const float w = 1.f - bf2f(raw[j][6]), kk = bf2f(raw[j][7]), a = bf2f(raw[j][8]);
          const float ka = kk * a, kp = k * (1.f + (a - 1.f) * kac);
          const float c1 = wave_sum(ka * r), c2 = wave_sum(kp * r);
          B[tl * 64 + lane] = w; B[1024 + tl * 64 + lane] = kk; B[2048 + tl * 64 + lane] = ka; B[3072 + tl * 64 + lane] = kp;
          B[4096 + tl * 64 + lane] = w * r; B[5120 + tl * 64 + lane] = v;
          if (lane == 0) { B[6144 + tl * 2] = c1; B[6144 + tl * 2 + 1] = c2; }
        }
      }
    } else if (i >= 1 && i <= NCH) {
      const float* B = fb + ((i - 1) & 1) * 6208;
      float* Yc = Yb + ((i - 1) & 1) * 1024;
#pragma unroll 2
      for (int t = 0; t < 16; ++t) {
        const float* bt = B + t * 64 + kq * 8;
        const f32x4 w0 = *(const f32x4*)(bt), w1 = *(const f32x4*)(bt + 4);
        const f32x4 kk0 = *(const f32x4*)(bt + 1024), kk1 = *(const f32x4*)(bt + 1028);
        const f32x4 ka0 = *(const f32x4*)(bt + 2048), ka1 = *(const f32x4*)(bt + 2052);
        const f32x4 kp0 = *(const f32x4*)(bt + 3072), kp1 = *(const f32x4*)(bt + 3076);
        const f32x4 wr0 = *(const f32x4*)(bt + 4096), wr1 = *(const f32x4*)(bt + 4100);
        const float2 vv = *(const float2*)(B + 5120 + t * 64 + va);
        const float2 sc = *(const float2*)(B + 6144 + t * 2);
        float d0 = 0.f, e0 = 0.f, d1 = 0.f, e1 = 0.f;
#pragma unroll
        for (int j = 0; j < 4; ++j) {
          d0 += S0[j] * kk0[j] + S0[j + 4] * kk1[j]; e0 += S0[j] * wr0[j] + S0[j + 4] * wr1[j];
          d1 += S1[j] * kk0[j] + S1[j + 4] * kk1[j]; e1 += S1[j] * wr0[j] + S1[j + 4] * wr1[j];
        }
        d0 = reduce8(d0); e0 = reduce8(e0); d1 = reduce8(d1); e1 = reduce8(e1);
        const float sa0 = -d0, sa1 = -d1;
        const float y0 = e0 + sa0 * sc.x + vv.x * sc.y, y1 = e1 + sa1 * sc.x + vv.y * sc.y;
#pragma unroll
        for (int j = 0; j < 4; ++j) {
          S0[j] = S0[j] * w0[j] + sa0 * ka0[j] + vv.x * kp0[j]; S0[j + 4] = S0[j + 4] * w1[j] + sa0 * ka1[j] + vv.x * kp1[j];
          S1[j] = S1[j] * w0[j] + sa1 * ka0[j] + vv.y * kp0[j]; S1[j + 4] = S1[j + 4] * w1[j] + sa1 * ka1[j] + vv.y * kp1[j];
        }
        if (kq == 0) { float2 yo = {y0, y1}; *(float2*)(Yc + t * 64 + va) = yo; }
      }
    }
    __syncthreads();
  }
}

DI void sb_item(const Params& p, int item, char* smem) {
  const bf16_t* P = (const bf16_t*)(p.ws + OFF_P);
  bf16_t* O = (bf16_t*)(p.ws + OFF_O);
  const int qt = item & 15, hd = (item >> 4) & 3, b = item >> 6;
  const int tid = otid(), lane = tid & 63, wv = tid >> 6, r = lane & 31, h = lane >> 5;
  bf16_t* Vt = (bf16_t*)(smem + wv * 8704);
  const int q0 = qt * 256 + wv * 32;
  const int sq = q0 + r;
  const size_t tokb = (size_t)b * SEQ;
  bf16x8 qf[4];
#pragma unroll
  for (int ks = 0; ks < 4; ++ks) qf[ks] = *(const bf16x8*)(P + (tokb + sq) * PSTR + C_SB_Q + hd * 64 + ks * 16 + h * 8);
  f32x16 accO[2];
#pragma unroll
  for (int i = 0; i < 16; ++i) { accO[0][i] = 0.f; accO[1][i] = 0.f; }
  float Rsum = 0.f;
  for (int kt = (q0 + 31) >> 6; kt >= 0; --kt) {
    const int k0 = kt * 64;
#pragma unroll
    for (int it = 0; it < 8; ++it) {
      const int key = it * 8 + (lane >> 3), chv = lane & 7;
      bf16x8 v = *(const bf16x8*)(P + (tokb + k0 + key) * PSTR + C_SB_V + hd * 64 + chv * 8);
#pragma unroll
      for (int e = 0; e < 8; ++e) Vt[(chv * 8 + e) * 68 + key] = (bf16_t)v[e];
    }
    f32x16 acc[2];
#pragma unroll
    for (int m = 0; m < 2; ++m) {
#pragma unroll
      for (int i = 0; i < 16; ++i) acc[m][i] = 0.f;
#pragma unroll
      for (int ks = 0; ks < 4; ++ks) {
        bf16x8 kf = *(const bf16x8*)(P + (tokb + k0 + 32 * m + r) * PSTR + C_SB_K + hd * 64 + ks * 16 + h * 8);
        acc[m] = mfma32(kf, qf[ks], acc[m]);
      }
    }
    float spv[2][16];
    float gs[8];
#pragma unroll
    for (int m = 0; m < 2; ++m)
#pragma unroll
      for (int i = 0; i < 16; ++i) {
        const int key = k0 + 32 * m + crow(i, h);
        const float z = acc[m][i] * 0.125f;
        float sp = softplusf_(z);
        const bool valid = key < sq;
        acc[m][i] = valid ? (z - sp) : -1e30f;
        sp = valid ? sp : 0.f;
        spv[m][i] = sp;
      }
#pragma unroll
    for (int q = 0; q < 8; ++q) {
      const int m = q >> 2, g = q & 3;
      gs[q] = spv[m][4 * g] + spv[m][4 * g + 1] + spv[m][4 * g + 2] + spv[m][4 * g + 3];
    }
    float run = 0.f;
#pragma unroll
    for (int q = 7; q >= 0; --q) {
      const int m = q >> 2, g = q & 3;
      const float pg = __shfl_xor(gs[q], 32);
      const float base = Rsum + run + (h == 0 ? pg : 0.f);
      const float s3 = spv[m][4 * g + 3], s2 = spv[m][4 * g + 2], s1 = spv[m][4 * g + 1];
      const float b3 = base, b2 = base + s3, b1 = b2 + s2, b0 = b1 + s1;
      acc[m][4 * g + 3] = __expf(acc[m][4 * g + 3] - b3);
      acc[m][4 * g + 2] = __expf(acc[m][4 * g + 2] - b2);
      acc[m][4 * g + 1] = __expf(acc[m][4 * g + 1] - b1);
      acc[m][4 * g + 0] = __expf(acc[m][4 * g + 0] - b0);
      run += gs[q] + pg;
    }
    Rsum += run;
    __builtin_amdgcn_wave_barrier();
#pragma unroll
    for (int m = 0; m < 2; ++m)
#pragma unroll
      for (int s = 0; s < 2; ++s) {
        bf16x8 pb;
        {
          unsigned u0 = pack2(acc[m][8 * s + 0], acc[m][8 * s + 1]), u1 = pack2(acc[m][8 * s + 2], acc[m][8 * s + 3]);
          unsigned u2 = pack2(acc[m][8 * s + 4], acc[m][8 * s + 5]), u3 = pack2(acc[m][8 * s + 6], acc[m][8 * s + 7]);
          uint4 uu = {u0, u1, u2, u3};
          pb = __builtin_bit_cast(bf16x8, uu);
        }
#pragma unroll
        for (int dt = 0; dt < 2; ++dt) {
          const bf16_t* vp = Vt + (32 * dt + r) * 68 + 32 * m + 16 * s + 4 * h;
          s16x4 lo = *(const s16x4*)vp, hi = *(const s16x4*)(vp + 8);
          bf16x8 va = __builtin_shufflevector(lo, hi, 0, 1, 2, 3, 4, 5, 6, 7);
          accO[dt] = mfma32(va, pb, accO[dt]);
        }
      }
    __builtin_amdgcn_wave_barrier();
    if (__ballot(Rsum <= 88.f) == 0ull) break;
  }
#pragma unroll
  for (int dt = 0; dt < 2; ++dt)
#pragma unroll
    for (int g = 0; g < 4; ++g) {
      const int d = 32 * dt + 8 * g + 4 * h;
      uint2 o = {pack2(accO[dt][4 * g], accO[dt][4 * g + 1]), pack2(accO[dt][4 * g + 2], accO[dt][4 * g + 3])};
      *(uint2*)(O + (tokb + sq) * DM + 256 + hd * 64 + d) = o;
    }
}

DI int frag_off(int row, int k) {
  const int rt = row >> 4, fr = row & 15, ks = k >> 5, kk = k & 31, hi = kk >> 4, fq = (kk & 15) >> 2, j = (kk & 3) + 4 * hi;
  return ((rt * 2 + ks) * 64 + fq * 16 + fr) * 8 + j;
}
DI int frag_off8(int row, int k0) {
  const int rt = row >> 4, fr = row & 15, ks = k0 >> 5, kk = k0 & 31, hi = kk >> 4, fq = (kk & 15) >> 2;
  return ((rt * 2 + ks) * 64 + fq * 16 + fr) * 8 + 4 * hi;
}
DI void gdn_intra_item(const Params& p, int l, int item, char* smem) {
  const bf16_t* P = (const bf16_t*)(p.ws + OFF_P);
  const int hp = item & 1, c = (item >> 1) & 63, b = item >> 7;
  const int tid = otid(), lane = tid & 63;
  bf16_t* Kb = (bf16_t*)smem;
  bf16_t* Qb = Kb + 2 * 64 * 72;
  bf16_t* Vb = Qb + 2 * 64 * 72;
  float* Lm = (float*)(smem + 3 * 2 * 64 * 72 * 2);
  float* Gs = Lm + 2 * 4096;
  float* Bs = Gs + 128;
  const size_t tok0 = (size_t)b * SEQ + c * 64;
  const float* cw = p.in[I_GCW] + (size_t)l * 4 * 768;
  {
    const int t = tid >> 3, cg = tid & 7;
#pragma unroll 1
    for (int it = 0; it < 6; ++it) {
      const int hh = it / 3, which = it % 3, head = hp * 2 + hh;
      const int ccol = which * 256 + head * 64 + cg * 8;
      float acc[8];
#pragma unroll
      for (int e = 0; e < 8; ++e) acc[e] = 0.f;
#pragma unroll
      for (int j = 0; j < 4; ++j) {
        const int s = c * 64 + t - 3 + j;
        if (s >= 0) {
          bf16x8 xv = *(const bf16x8*)(P + ((size_t)b * SEQ + s) * PSTR + C_GDN_Q + ccol);
          f32x4 wa = *(const f32x4*)(cw + j * 768 + ccol), wb = *(const f32x4*)(cw + j * 768 + ccol + 4);
#pragma unroll
          for (int e = 0; e < 4; ++e) { acc[e] += wa[e] * bf2f((bf16_t)xv[e]); acc[e + 4] += wb[e] * bf2f((bf16_t)xv[e + 4]); }
        }
      }
      float ss = 0.f;
#pragma unroll
      for (int e = 0; e < 8; ++e) { acc[e] = siluf_(acc[e]); ss += acc[e] * acc[e]; }
      ss += __shfl_xor(ss, 1); ss += __shfl_xor(ss, 2); ss += __shfl_xor(ss, 4);
      float sc = 1.f;
      if (which == 0) sc = rsqrtf(ss + EPSF) * 0.125f;
      else if (which == 1) sc = rsqrtf(ss + EPSF);
      uint4 ov = {pack2(acc[0] * sc, acc[1] * sc), pack2(acc[2] * sc, acc[3] * sc), pack2(acc[4] * sc, acc[5] * sc), pack2(acc[6] * sc, acc[7] * sc)};
      bf16_t* dst = (which == 0 ? Qb : (which == 1 ? Kb : Vb)) + (hh * 64 + t) * 72 + cg * 8;
      *(uint4*)dst = ov;
    }
  }
  if (tid < 128) {
    const int hh = tid >> 6, t = lane, head = hp * 2 + hh;
    const float a_in = bf2f(P[(tok0 + t) * PSTR + C_GDN_A + head]);
    const float b_in = bf2f(P[(tok0 + t) * PSTR + C_GDN_B + head]);
    const float beta = sigmoidf_(b_in);
    float g = -__expf(p.in[I_GAL][l * 4 + head]) * softplusf_(a_in + p.in[I_GDT][l * 4 + head]);
#pragma unroll
    for (int d = 1; d < 64; d <<= 1) { float v = __shfl_up(g, d); if (lane >= d) g += v; }
    Gs[hh * 64 + t] = g; Bs[hh * 64 + t] = beta;
  }
  __syncthreads();
  const int hh = tid >> 8, lt = tid & 255, head = hp * 2 + hh;
  const size_t ih = ((size_t)(b * 4 + head)) * 64 + c;
  bf16_t* GW = (bf16_t*)(p.ws + OFF_G) + ih * 4096;
  bf16_t* GQD = (bf16_t*)(p.ws + OFF_G + GSZ) + ih * 4096;
  bf16_t* GQK = (bf16_t*)(p.ws + OFF_G + 2 * GSZ) + ih * 4096;
  bf16_t* GKD = (bf16_t*)(p.ws + OFF_G + 3 * GSZ) + ih * 4096;
  bf16_t* GU = (bf16_t*)(p.ws + OFF_G + 4 * GSZ) + ih * 4096;
  float* GCD = (float*)(p.ws + OFF_GCD);
  const float* Gh = Gs + hh * 64; const float* Bh = Bs + hh * 64;
  {
    const int wq = (tid >> 6) & 3, ti = wq >> 1, tj = wq & 1, r = lane & 31, h = lane >> 5;
    f32x16 akk, aqk;
#pragma unroll
    for (int i = 0; i < 16; ++i) { akk[i] = 0.f; aqk[i] = 0.f; }
    if (ti >= tj) {
#pragma unroll
      for (int ks = 0; ks < 4; ++ks) {
        bf16x8 ka = *(const bf16x8*)(Kb + (hh * 64 + 32 * ti + r) * 72 + ks * 16 + h * 8);
        bf16x8 qa = *(const bf16x8*)(Qb + (hh * 64 + 32 * ti + r) * 72 + ks * 16 + h * 8);
        bf16x8 kb = *(const bf16x8*)(Kb + (hh * 64 + 32 * tj + r) * 72 + ks * 16 + h * 8);
        akk = mfma32(ka, kb, akk);
        aqk = mfma32(qa, kb, aqk);
      }
    }
    const int j = 32 * tj + r;
    const float Gj = Gh[j];
#pragma unroll
    for (int i_ = 0; i_ < 16; ++i_) {
      const int i = 32 * ti + crow(i_, h);
      const float dec = (i >= j) ? __expf(Gh[i] - Gj) : 0.f;
      Lm[hh * 4096 + i * 64 + j] = (i > j) ? Bh[i] * akk[i_] * dec : 0.f;
      GQK[frag_off(i, j)] = f2bf((i >= j) ? aqk[i_] * dec : 0.f);
    }
  }
  __syncthreads();
  if (lt < 128) {
    const int cc = lt;
    float x[64];
    if (cc < 64) {
#pragma unroll
      for (int i = 0; i < 64; ++i) x[i] = bf2f(Vb[(hh * 64 + i) * 72 + cc]) * Bh[i];
    } else {
#pragma unroll
      for (int i = 0; i < 64; ++i) x[i] = bf2f(Kb[(hh * 64 + i) * 72 + cc - 64]) * Bh[i] * __expf(Gh[i]);
    }
    const float* Lh = Lm + hh * 4096;
#pragma unroll
    for (int i = 1; i < 64; ++i) {
      float s = x[i];
#pragma unroll
      for (int j4 = 0; j4 < (i + 3) / 4; ++j4) {
        const f32x4 lv = *(const f32x4*)(Lh + i * 64 + j4 * 4);
#pragma unroll
        for (int e = 0; e < 4; ++e) if (j4 * 4 + e < i) s -= lv[e] * x[j4 * 4 + e];
      }
      x[i] = s;
    }
    if (cc < 64) {
      const int split = cc >> 4, fr = cc & 15;
#pragma unroll
      for (int i4 = 0; i4 < 16; ++i4) {
        uint2 ov = {pack2(x[4 * i4], x[4 * i4 + 1]), pack2(x[4 * i4 + 2], x[4 * i4 + 3])};
        *(uint2*)(GU + ((split * 4 + (i4 >> 2)) * 64 + (i4 & 3) * 16 + fr) * 4) = ov;
      }
    } else {
#pragma unroll
      for (int i = 0; i < 64; ++i) GW[frag_off(i, cc - 64)] = f2bf(x[i]);
    }
  } else {
    const int q_ = lt - 128;
    const float Glast = Gh[63];
#pragma unroll
    for (int i = 0; i < 4; ++i) {
      const int q = q_ + 128 * i; const int pos = q >> 3, kc = q & 7;
      bf16x8 qv = *(const bf16x8*)(Qb + (hh * 64 + pos) * 72 + kc * 8);
      const float eg = __expf(Gh[pos]);
      uint4 ov = {pack2(bf2f((bf16_t)qv[0]) * eg, bf2f((bf16_t)qv[1]) * eg), pack2(bf2f((bf16_t)qv[2]) * eg, bf2f((bf16_t)qv[3]) * eg),
                  pack2(bf2f((bf16_t)qv[4]) * eg, bf2f((bf16_t)qv[5]) * eg), pack2(bf2f((bf16_t)qv[6]) * eg, bf2f((bf16_t)qv[7]) * eg)};
      { const int fo = frag_off8(pos, kc * 8); uint2 o0 = {ov.x, ov.y}, o1 = {ov.z, ov.w}; *(uint2*)(GQD + fo) = o0; *(uint2*)(GQD + fo + 128) = o1; }
    }
#pragma unroll
    for (int i = 0; i < 4; ++i) {
      const int q = q_ + 128 * i; const int k = q >> 3, pc = q & 7;
      float o[8];
#pragma unroll
      for (int e = 0; e < 8; ++e) { const int pos = pc * 8 + e; o[e] = bf2f(Kb[(hh * 64 + pos) * 72 + k]) * __expf(Glast - Gh[pos]); }
      uint4 ov = {pack2(o[0], o[1]), pack2(o[2], o[3]), pack2(o[4], o[5]), pack2(o[6], o[7])};
      { const int fo = frag_off8(k, pc * 8); uint2 o0 = {ov.x, ov.y}, o1 = {ov.z, ov.w}; *(uint2*)(GKD + fo) = o0; *(uint2*)(GKD + fo + 128) = o1; }
    }
    if (q_ == 0) GCD[ih] = __expf(Glast);
  }
}

DI void gdn_rec_item(const Params& p, int l, int b, int head, char* smem) {
  const bf16_t* P = (const bf16_t*)(p.ws + OFF_P);
  bf16_t* O = (bf16_t*)(p.ws + OFF_O);
  float* SS = (float*)(smem + 81920);
  const int tid = otid(), lane = tid & 63, wv = tid >> 6, fr = lane & 15, fq = lane >> 4;
  const int split = wv & 3;
  const bool active = wv < 4;
  const float ng = p.in[I_GNG][l * 64 + split * 16 + fr];
  const float* GCD = (const float*)(p.ws + OFF_GCD);
  const size_t ih0 = ((size_t)(b * 4 + head)) * 64;
  f32x4 S[4];
#pragma unroll
  for (int kt = 0; kt < 4; ++kt) S[kt] = (f32x4){0.f, 0.f, 0.f, 0.f};
  u32x4 lr[10];
#pragma unroll
  for (int i = 0; i < 10; ++i) lr[i] = (u32x4){0u, 0u, 0u, 0u};
  const int lq = (wv & 3) * 64 + lane;
#define GLOADC(c_)                                                                              \
  {                                                                                             \
    _Pragma("unroll") for (int i = 0; i < 10; ++i) {                                            \
      const int q_ = lq + 256 * i; const int a_ = q_ >> 9, o_ = q_ & 511;                       \
      lr[i] = *(const u32x4*)((const bf16_t*)(p.ws + OFF_G + (size_t)a_ * GSZ) + (ih0 + (c_)) * 4096 + o_ * 8); \
    }                                                                                           \
  }
#define LSTORE(buf_)                                                                            \
  {                                                                                             \
    _Pragma("unroll") for (int i = 0; i < 10; ++i) {                                            \
      const int q_ = lq + 256 * i;                                                              \
      *(u32x4*)(smem + (buf_) * 40960 + q_ * 16) = lr[i];                                       \
    }                                                                                           \
  }
#define BAR_LDS() { asm volatile("s_waitcnt lgkmcnt(0)" ::: "memory"); __builtin_amdgcn_s_barrier(); asm volatile("" ::: "memory"); }
  float cdn = 0.f;
  if (!active) { GLOADC(0); LSTORE(0); GLOADC(1); }
  else cdn = GCD[ih0];
  BAR_LDS();
#pragma unroll 1
  for (int c = 0; c < 64; ++c) {
    f32x4 acco[4];
    if (active) {
      const char* bufp = smem + (c & 1) * 40960;
      const float cd = cdn;
      if (c + 1 < 64) cdn = GCD[ih0 + c + 1];
      float zr[16];
#pragma unroll
      for (int rt = 0; rt < 4; ++rt)
#pragma unroll
        for (int j = 0; j < 4; ++j) {
          const size_t tok = (size_t)b * SEQ + c * 64 + 16 * rt + 4 * fq + j;
          zr[rt * 4 + j] = bf2f(P[tok * PSTR + C_GDN_Z + head * 64 + split * 16 + fr]);
        }
      bf16x8 bS[2];
#pragma unroll
      for (int ks = 0; ks < 2; ++ks) {
        uint4 uu = {pack2(S[2 * ks][0], S[2 * ks][1]), pack2(S[2 * ks][2], S[2 * ks][3]), pack2(S[2 * ks + 1][0], S[2 * ks + 1][1]), pack2(S[2 * ks + 1][2], S[2 * ks + 1][3])};
        bS[ks] = __builtin_bit_cast(bf16x8, uu);
      }
      f32x4 u[4];
#pragma unroll
      for (int rt = 0; rt < 4; ++rt) {
        f32x4 aw = {0.f, 0.f, 0.f, 0.f};
        acco[rt] = (f32x4){0.f, 0.f, 0.f, 0.f};
#pragma unroll
        for (int ks = 0; ks < 2; ++ks) {
          const bf16x8 wa = *(const bf16x8*)(bufp + ((rt * 2 + ks) * 64 + lane) * 16);
          const bf16x8 qa = *(const bf16x8*)(bufp + 8192 + ((rt * 2 + ks) * 64 + lane) * 16);
          aw = mfma16(wa, bS[ks], aw); acco[rt] = mfma16(qa, bS[ks], acco[rt]);
        }
        const s16x4 uv = *(const s16x4*)(bufp + 32768 + ((split * 4 + rt) * 64 + lane) * 8);
#pragma unroll
        for (int j = 0; j < 4; ++j) u[rt][j] = bf2f((bf16_t)uv[j]) - aw[j];
      }
      bf16x8 bU[2];
#pragma unroll
      for (int ks = 0; ks < 2; ++ks) {
        uint4 uu = {pack2(u[2 * ks][0], u[2 * ks][1]), pack2(u[2 * ks][2], u[2 * ks][3]), pack2(u[2 * ks + 1][0], u[2 * ks + 1][1]), pack2(u[2 * ks + 1][2], u[2 * ks + 1][3])};
        bU[ks] = __builtin_bit_cast(bf16x8, uu);
      }
#pragma unroll
      for (int rt = 0; rt < 4; ++rt) {
        f32x4 sn = S[rt] * cd;
#pragma unroll
        for (int ks = 0; ks < 2; ++ks) {
          const bf16x8 qa = *(const bf16x8*)(bufp + 16384 + ((rt * 2 + ks) * 64 + lane) * 16);
          const bf16x8 ka = *(const bf16x8*)(bufp + 24576 + ((rt * 2 + ks) * 64 + lane) * 16);
          acco[rt] = mfma16(qa, bU[ks], acco[rt]); sn = mfma16(ka, bU[ks], sn);
        }
        S[rt] = sn;
      }
#pragma unroll
      for (int rt = 0; rt < 4; ++rt)
#pragma unroll
        for (int j = 0; j < 4; ++j) {
          float s = acco[rt][j] * acco[rt][j];
          s += __shfl_xor(s, 1); s += __shfl_xor(s, 2); s += __shfl_xor(s, 4); s += __shfl_xor(s, 8);
          if (fr == 0) SS[(c & 1) * 256 + split * 64 + 16 * rt + 4 * fq + j] = s;
        }
      BAR_LDS();
      const float* ssb = SS + (c & 1) * 256;
#pragma unroll
      for (int rt = 0; rt < 4; ++rt)
#pragma unroll
        for (int j = 0; j < 4; ++j) {
          const int pos = 16 * rt + 4 * fq + j;
          const float tot = ssb[pos] + ssb[64 + pos] + ssb[128 + pos] + ssb[192 + pos];
          const float rn = rsqrtf(tot * (1.f / 64.f) + EPSF);
          const size_t tok = (size_t)b * SEQ + c * 64 + pos;
          O[tok * DM + 512 + head * 64 + split * 16 + fr] = f2bf(acco[rt][j] * rn * ng * siluf_(zr[rt * 4 + j]));
        }
    } else {
      if (c + 1 < 64) LSTORE((c + 1) & 1);
      if (c + 2 < 64) GLOADC(c + 2);
      BAR_LDS();
    }
  }
#undef GLOADC
#undef LSTORE
#undef BAR_LDS
}

DI void lru_item(const Params& p, int l, int item, char* smem, const int mode) {
  const bf16_t* P = (const bf16_t*)(p.ws + OFF_P);
  bf16_t* O = (bf16_t*)(p.ws + OFF_O);
  float* CA = (float*)(p.ws + OFF_LCA);
  float* CH = (float*)(p.ws + OFF_LCH);
  bf16_t* XS = (bf16_t*)smem;
  float* U = (float*)(smem + 34816);
  float* XC = (float*)(smem + 34816 + 65536);
  const int b = item >> 6, ct = item & 63;
  const int tid = otid(), sc = tid >> 8, c = tid & 255;
  for (int i = 0; i < 5; ++i) {
    const int q = tid + NTHR * i;
    if (q < 67 * 32) {
      const int row = q >> 5, cc = q & 31;
      const int s = ct * 64 - 3 + row;
      uint4 v = {0u, 0u, 0u, 0u};
      if (s >= 0) v = *(const uint4*)(P + ((size_t)b * SEQ + s) * PSTR + C_LRU_X + cc * 8);
      *(uint4*)(XS + row * 256 + cc * 8) = v;
    }
  }
  float carry = 0.f;
  if (mode == 1) {
    float A = 1.f, hh = 0.f;
    const float* ca = CA + ((size_t)b * 128 + sc * ct) * 256 + c;
    const float* chp = CH + ((size_t)b * 128 + sc * ct) * 256 + c;
    int k = 0;
    for (; k + 8 <= ct; k += 8) {
      float av[8], hv[8];
#pragma unroll
      for (int e = 0; e < 8; ++e) { av[e] = ca[(size_t)(k + e) * 256]; hv[e] = chp[(size_t)(k + e) * 256]; }
#pragma unroll
      for (int e = 0; e < 8; ++e) { hh = av[e] * hh + hv[e]; A *= av[e]; }
    }
    for (; k < ct; ++k) { const float a_ = ca[(size_t)k * 256], h_ = chp[(size_t)k * 256]; hh = a_ * hh + h_; A *= a_; }
    XC[(sc * 256 + c) * 2] = A; XC[(sc * 256 + c) * 2 + 1] = hh;
  }
  __syncthreads();
  if (mode == 1) {
    const float h0 = XC[c * 2 + 1], A1 = XC[(256 + c) * 2], h1 = XC[(256 + c) * 2 + 1];
    carry = A1 * h0 + h1;
    if (sc == 1) carry = CA[((size_t)b * 128 + 2 * ct) * 256 + c] * carry + CH[((size_t)b * 128 + 2 * ct) * 256 + c];
  }
  {
    const float cb = p.in[I_LCB][l * 256 + c];
    const float c0 = p.in[I_LCW][(l * 4 + 0) * 256 + c], c1 = p.in[I_LCW][(l * 4 + 1) * 256 + c],
                c2 = p.in[I_LCW][(l * 4 + 2) * 256 + c], c3 = p.in[I_LCW][(l * 4 + 3) * 256 + c];
    for (int t = sc * 32; t < sc * 32 + 32; ++t)
      U[t * 256 + c] = cb + c0 * bf2f(XS[t * 256 + c]) + c1 * bf2f(XS[(t + 1) * 256 + c]) + c2 * bf2f(XS[(t + 2) * 256 + c]) + c3 * bf2f(XS[(t + 3) * 256 + c]);
  }
  __syncthreads();
  {
    const int n = c >> 6, f = c & 63;
    float wr[64], wi[64];
    {
      const float* wrp = p.in[I_LWR] + (((size_t)l * 4 + n) * 64) * 64 + f;
      const float* wip = p.in[I_LWI] + (((size_t)l * 4 + n) * 64) * 64 + f;
      asm volatile("" : "+v"(wrp), "+v"(wip));
#pragma unroll
      for (int e = 0; e < 64; ++e) { wr[e] = wrp[e * 64]; wi[e] = wip[e * 64]; }
    }
    const float br = p.in[I_LBR][l * 256 + c], bi = p.in[I_LBI][l * 256 + c];
    const float lamsp = softplusf_(-p.in[I_LLAM][l * 256 + c]);
    float hl = carry, ac = 1.f;
    for (int t = sc * 32; t < sc * 32 + 32; ++t) {
      float ar = br, ai = bi;
#pragma unroll
      for (int e4 = 0; e4 < 16; ++e4) {
        const f32x4 uu = *(const f32x4*)(U + t * 256 + n * 64 + e4 * 4);
#pragma unroll
        for (int e = 0; e < 4; ++e) { ar += uu[e] * wr[e4 * 4 + e]; ai += uu[e] * wi[e4 * 4 + e]; }
      }
      const float rg = sigmoidf_(ar), ig = sigmoidf_(ai);
      const float la = -8.f * rg * lamsp;
      const float a = __expf(la);
      const float bb = sqrtf(fmaxf(0.f, 1.f - __expf(2.f * la))) * (ig * U[t * 256 + c]);
      hl = a * hl + bb; ac *= a;
      if (mode == 1) {
        const size_t tok = (size_t)b * SEQ + ct * 64 + t;
        const float y = bf2f(P[tok * PSTR + C_LRU_Y + c]);
        O[tok * DM + c] = f2bf(hl * geluf_(y));
      }
    }
    if (mode == 0) {
      const int ck = ct * 2 + sc;
      CA[((size_t)b * 128 + ck) * 256 + c] = ac; CH[((size_t)b * 128 + ck) * 256 + c] = hl;
    }
  }
}

__global__ void __launch_bounds__(NTHR) mega(Params p) {
  extern __shared__ __attribute__((aligned(16))) char smem[];
  cg::grid_group grid = cg::this_grid();
  const int tid = threadIdx.x;
  bf16_t* H = (bf16_t*)(p.ws + OFF_H);
  bf16_t* PB = (bf16_t*)(p.ws + OFF_P);
  PG_LAS unsigned char* lds = (PG_LAS unsigned char*)smem;

  for (int rep = 0; rep < REP_MISC; ++rep) {
  if (MASK & 1) phase_mod(p, smem);
  grid.sync();
  }
  for (int l = 0; l < 4; ++l) {
    const float* xcur = (l == 0) ? p.in[I_X] : p.out;
    for (int rep = 0; rep < REP_MISC; ++rep) {
    if (MASK & 2) phase_convert(p, l, smem);
    if (MASK & 4) phase_norm(p, xcur, p.in[I_N1G] + l * 1024, l, 1024, 0, H, nullptr);
    grid.sync();
    }
    for (int rep = 0; rep < REP_G; ++rep) {
    if (MASK & 8) { pg::Order<1> S; S.init(NTOK, PSTR, gridDim.x, blockIdx.x); pg::EpiBf16<0> E{PB, PSTR, nullptr};
      pg::gemm_phase(lds, H, DM, (const bf16_t*)(p.ws + OFF_WIN), 1024, S, E); }
    grid.sync();
    }
    for (int rep = 0; rep < REP_M1; ++rep) {
    for (int it = blockIdx.x; it < 5120; it += gridDim.x) {
      if (it < 2048) { if (MASK & 32) gdn_intra_item(p, l, it, smem); }
      else if (it < 3072) { if (MASK & 64) sb_item(p, it - 2048, smem); }
      else if (it < 4096) { if (MASK & 128) lru_item(p, l, it - 3072, smem, 0); }
      else { if (MASK & 16) rw_prep_item(p, l, it - 4096, smem); }
      __syncthreads();
    }
    grid.sync();
    }
    for (int rep = 0; rep < REP_M2; ++rep) {
    if (blockIdx.x < 64) {
      if (MASK & 16) rwkv_scan_item(p, l, blockIdx.x >> 2, blockIdx.x & 3, smem);
    } else if (blockIdx.x < 128) {
      if (MASK & 256) gdn_rec_item(p, l, (blockIdx.x - 64) >> 2, (blockIdx.x - 64) & 3, smem);
    } else {
      for (int it = blockIdx.x - 128; it < 1024; it += gridDim.x - 128) {
        if (MASK & 512) lru_item(p, l, it, smem, 1);
        __syncthreads();
      }
    }
    grid.sync();
    }
    for (int rep = 0; rep < REP_G; ++rep) {
    for (int half = 0; half < 2; ++half) {
      bf16_t* GH = (bf16_t*)(p.ws + OFF_P + 134217728);
      if (MASK & 1024) { pg::Order<1> S; S.init(NTOK / 2, 4096, gridDim.x, blockIdx.x); pg::EpiBf16<1> E{GH, 4096, p.in[I_BGATE] + (size_t)l * 4096};
        pg::gemm_phase(lds, H + (size_t)half * 32768 * DM, DM, (const bf16_t*)(p.ws + OFF_WG), 1024, S, E); }
      grid.sync();
      if (MASK & 1024) { pg::Order<4> S; S.init(NTOK / 2, 1024, gridDim.x, blockIdx.x, 512, 524288); pg::EpiBranch E{PB + (size_t)half * 32768 * DM, GH};
        pg::gemm_phase(lds, (const bf16_t*)(p.ws + OFF_O) + (size_t)half * 32768 * DM, DM, (const bf16_t*)(p.ws + OFF_WBR), 256, S, E); }
      grid.sync();
    }
    }
    if (MASK & 2048) { pg::Order<1> S; S.init(NTOK, 1024, gridDim.x, blockIdx.x); pg::EpiResid E{xcur, p.out, (const float*)(p.ws + OFF_MODP), p.in[I_BADA], l, 2048};
      pg::gemm_phase(lds, PB, DM, (const bf16_t*)(p.ws + OFF_WO), 1024, S, E); }
    grid.sync();
    for (int rep = 0; rep < REP_MISC; ++rep) {
    if (MASK & 4096) phase_norm(p, p.out, p.in[I_N2G] + l * 1024, l, 4096, 3072, H, nullptr);
    grid.sync();
    }
    for (int rep = 0; rep < REP_G; ++rep) {
    if (MASK & 8192) { pg::Order<1> S; S.init(NTOK, AUS, gridDim.x, blockIdx.x); pg::EpiBf16<0> E{PB, AUS, nullptr};
      pg::gemm_phase(lds, H, DM, (const bf16_t*)(p.ws + OFF_WF), 1024, S, E); }
    grid.sync();
    }
    if (MASK & 16384) phase_ffn_act(p, l);
    grid.sync();
    if (MASK & 32768) { pg::Order<1> S; S.init(NTOK, 1024, gridDim.x, blockIdx.x); pg::EpiResid E{p.out, p.out, (const float*)(p.ws + OFF_MODP), p.in[I_BADA], l, 5120};
      pg::gemm_phase(lds, PB + FFN, AUS, (const bf16_t*)(p.ws + OFF_WD), FFN, S, E); }
    grid.sync();
  }
  if (MASK & 65536) phase_norm(p, p.out, p.in[I_FG], 0, 0, 0, nullptr, p.out);
}

extern "C" void kernel_launch(void* const* d_in, const int* in_sizes, int n_in,
                              void* d_out, int out_size, void* d_ws, size_t ws_size,
                              hipStream_t stream) {
  if (ws_size < WS_NEED || n_in < 38) { fprintf(stderr, "workspace too small: %zu < %zu\n", ws_size, (size_t)WS_NEED); return; }
  (void)hipFuncSetAttribute((const void*)mega, hipFuncAttributeMaxDynamicSharedMemorySize, SMEM_BYTES);
  int dev = 0, cus = 0, per_cu = 0;
  (void)hipGetDevice(&dev);
  (void)hipDeviceGetAttribute(&cus, hipDeviceAttributeMultiprocessorCount, dev);
  (void)hipOccupancyMaxActiveBlocksPerMultiprocessor(&per_cu, mega, NTHR, SMEM_BYTES);
  if (per_cu < 1 || cus < 1) { fprintf(stderr, "occupancy query failed (%d, %d)\n", per_cu, cus); return; }
  if (cus > 256) cus = 256;
  const int grid_blocks = cus;
  Params p{};
  for (int i = 0; i < 38; ++i) p.in[i] = (const float*)d_in[i];
  p.out = (float*)d_out; p.ws = (char*)d_ws;
  void* args[] = {&p};
  hipError_t e = hipLaunchCooperativeKernel((void*)mega, dim3(grid_blocks), dim3(NTHR), args, SMEM_BYTES, stream);
  if (e != hipSuccess) fprintf(stderr, "cooperative launch failed: %s (grid %d)\n", hipGetErrorString(e), grid_blocks);
}
```

```cpp
#include <hip/hip_runtime.h>
#include <hip/hip_cooperative_groups.h>
#include <cstdio>
namespace cg = cooperative_groups;

typedef unsigned short bf16_t;
typedef short bf16x8 __attribute__((ext_vector_type(8)));
typedef short s16x4 __attribute__((ext_vector_type(4)));
typedef float f32x4 __attribute__((ext_vector_type(4)));
typedef float f32x16 __attribute__((ext_vector_type(16)));
typedef unsigned u32x4 __attribute__((ext_vector_type(4)));
#define DI __device__ __forceinline__

constexpr int NTOK = 65536, DM = 1024, SEQ = 4096, PSTR = 3328, FFN = 2816, AUS = 5632;
constexpr int C_LRU_X = 0, C_LRU_Y = 256, C_SB_Q = 512, C_SB_K = 768, C_SB_V = 1024;
constexpr int C_GDN_Q = 1280, C_GDN_Z = 2048, C_GDN_A = 2304, C_GDN_B = 2308, C_RW = 2312;
constexpr float EPSF = 1e-6f;
#ifndef MASK
#define MASK 0x1ffff
#endif
#ifndef REP_M1
#define REP_M1 1
#endif
#ifndef REP_M2
#define REP_M2 1
#endif
#ifndef REP_G
#define REP_G 1
#endif
#ifndef REP_MISC
#define REP_MISC 1
#endif
constexpr int NTHR = 512;
constexpr int SMEM_BYTES = 131072 + 64;

constexpr size_t OFF_MODP = 0;
constexpr size_t OFF_WIN = 6291456;
constexpr size_t OFF_WG = OFF_WIN + 6815744;
constexpr size_t OFF_WBR = OFF_WG + 8388608;
constexpr size_t OFF_WO = OFF_WBR + 2097152;
constexpr size_t OFF_WF = OFF_WO + 2097152;
constexpr size_t OFF_WD = OFF_WF + 11534336;
constexpr size_t OFF_H = OFF_WD + 5767168;
constexpr size_t OFF_P = OFF_H + 134217728;
constexpr size_t OFF_O = OFF_P + 436207616;
constexpr size_t OFF_G = OFF_O + 134217728;
constexpr size_t GSZ = 33554432;
constexpr size_t OFF_GCD = OFF_G + 5 * GSZ;
constexpr size_t OFF_L = OFF_GCD + 16384;
constexpr size_t LSZ = 67108864;
constexpr size_t OFF_LCA = OFF_L + 2 * LSZ;
constexpr size_t OFF_LCH = OFF_LCA + 2097152;
constexpr size_t OFF_BON = OFF_LCH + 2097152;
constexpr size_t OFF_CTR = OFF_BON + 1048576;
constexpr size_t OFF_BAR = OFF_CTR + 256;
constexpr size_t WS_NEED = OFF_BAR + 16384;

struct Params { const float* in[38]; float* out; char* ws; };
enum { I_X = 0, I_C, I_N1G, I_N2G, I_FG, I_WADA, I_BADA, I_WIN, I_LCW, I_LCB, I_LWR, I_LBR, I_LWI, I_LBI, I_LLAM,
       I_GCW, I_GAL, I_GDT, I_GNG, I_RMU, I_RW0, I_RWUP, I_RA0, I_RAUP, I_RGUP, I_RKK, I_RKA, I_RRK, I_RLG, I_RLB,
       I_WBR, I_WGATE, I_BGATE, I_WOUT, I_FWG, I_FWU, I_FCW, I_FWD };

DI float bf2f(bf16_t v) { return __uint_as_float(((unsigned)v) << 16); }
DI bf16_t f2bf(float x) { unsigned u = __float_as_uint(x); u += 0x7fffu + ((u >> 16) & 1u); return (bf16_t)(u >> 16); }
DI unsigned pack2(float lo, float hi) { return (unsigned)f2bf(lo) | (((unsigned)f2bf(hi)) << 16); }
DI float sigmoidf_(float x) { return 1.f / (1.f + __expf(-x)); }
DI float softplusf_(float x) { return fmaxf(x, 0.f) + __logf(1.f + __expf(-fabsf(x))); }
DI float siluf_(float x) { return x / (1.f + __expf(-x)); }
DI float geluf_(float x) { float u = 0.7978845608f * (x + 0.044715f * x * x * x); return x / (1.f + __expf(-2.f * u)); }
DI float tanhf_(float x) { return 1.f - 2.f / (1.f + __expf(2.f * x)); }
DI float wave_sum(float x) {
#pragma unroll
  for (int o = 32; o >= 1; o >>= 1) x += __shfl_xor(x, o);
  return x;
}
template <int CTRL> DI float dppf(float x) { return __int_as_float(__builtin_amdgcn_update_dpp(0, __float_as_int(x), CTRL, 0xf, 0xf, true)); }
DI float reduce8(float x) { x += dppf<0xB1>(x); x += dppf<0x4E>(x); x += dppf<0x141>(x); return x; }
DI f32x16 mfma32(bf16x8 a, bf16x8 b, f32x16 c) { return __builtin_amdgcn_mfma_f32_32x32x16_bf16(a, b, c, 0, 0, 0); }
DI f32x4 mfma16(bf16x8 a, bf16x8 b, f32x4 c) { return __builtin_amdgcn_mfma_f32_16x16x32_bf16(a, b, c, 0, 0, 0); }
DI int crow(int i, int h) { return (i & 3) + 8 * (i >> 2) + 4 * h; }

DI float modv(const float* modp, const float* bada, int l, int b, int idx) {
  const float* q = modp + ((size_t)(l * 16 + b)) * 6144 + idx;
  const size_t ks = (size_t)4 * 16 * 6144;
  return bada[l * 6144 + idx] + q[0] + q[ks] + q[2 * ks] + q[3 * ks];
}

DI int otid() { int t = threadIdx.x; asm volatile("" : "+v"(t)); return t; }
DI int obid() { int b = blockIdx.x; asm volatile("" : "+s"(b)); return b; }
DI void phase_mod(const Params& p, char* smem) {
  float* sm = (float*)smem;
  float* modp = (float*)(p.ws + OFF_MODP);
  const int tid = otid();
  if (obid() == 0 && tid < 64) ((unsigned*)(p.ws + OFF_CTR))[tid] = 0u;
  for (int item = obid(); item < 192; item += gridDim.x) {
    const int l = item / 48, rem = item % 48, jb = rem >> 2, kq = rem & 3;
    for (int i = 0; i < 8; ++i) {
      int e = tid + 512 * i; int b = e >> 8, k = e & 255;
      float cv = p.in[I_C][b * 1024 + kq * 256 + k];
      sm[e] = siluf_(cv);
    }
    __syncthreads();
    float acc[16];
#pragma unroll
    for (int b = 0; b < 16; ++b) acc[b] = 0.f;
    const float* wp = p.in[I_WADA] + ((size_t)l * 1024 + kq * 256) * 6144 + jb * 512 + tid;
    for (int k = 0; k < 256; k += 4) {
      float w0 = wp[(size_t)k * 6144], w1 = wp[(size_t)(k + 1) * 6144], w2 = wp[(size_t)(k + 2) * 6144], w3 = wp[(size_t)(k + 3) * 6144];
#pragma unroll
      for (int b = 0; b < 16; ++b) {
        f32x4 cv = *(const f32x4*)(sm + b * 256 + k);
        acc[b] += cv[0] * w0 + cv[1] * w1 + cv[2] * w2 + cv[3] * w3;
      }
    }
#pragma unroll
    for (int b = 0; b < 16; ++b) modp[((size_t)((kq * 4 + l) * 16 + b)) * 6144 + jb * 512 + tid] = acc[b];
    __syncthreads();
  }
}

DI void conv_tile(const float* src, bf16_t* dst, int K, int N, int k0, int n0, char* smem) {
  float* tile = (float*)smem;
  const int tid = otid();
#pragma unroll
  for (int it = 0; it < 2; ++it) {
    int kr = (tid >> 4) + 32 * it, nc = (tid & 15) * 4;
    f32x4 v = {0.f, 0.f, 0.f, 0.f};
    if (n0 + nc < N) v = *(const f32x4*)(src + (size_t)(k0 + kr) * N + n0 + nc);
    tile[kr * 65 + nc] = v[0]; tile[kr * 65 + nc + 1] = v[1]; tile[kr * 65 + nc + 2] = v[2]; tile[kr * 65 + nc + 3] = v[3];
  }
  __syncthreads();
  {
    int n = tid >> 3, kc = (tid & 7) * 8;
    unsigned o[4];
#pragma unroll
    for (int e = 0; e < 4; ++e) o[e] = pack2(tile[(kc + 2 * e) * 65 + n], tile[(kc + 2 * e + 1) * 65 + n]);
    uint4 ov = {o[0], o[1], o[2], o[3]};
    *(uint4*)(dst + (size_t)(n0 + n) * K + k0 + kc) = ov;
  }
  __syncthreads();
}

DI void phase_convert(const Params& p, int l, char* smem) {
  for (int t = obid(); t < 4480; t += gridDim.x) {
    const float* src; bf16_t* dst; int K, N, Npad, tt = t;
    if (tt < 832) { src = p.in[I_WIN] + (size_t)l * 1024 * 3208; dst = (bf16_t*)(p.ws + OFF_WIN); K = 1024; N = 3208; Npad = 3328; }
    else if ((tt -= 832) < 1024) { int br = tt >> 8; tt &= 255; src = p.in[I_WGATE] + ((size_t)l * 4 + br) * 1048576; dst = (bf16_t*)(p.ws + OFF_WG) + (size_t)br * 1048576; K = 1024; N = 1024; Npad = 1024; }
    else if ((tt -= 1024) < 256) { int br = tt >> 6; tt &= 63; src = p.in[I_WBR] + ((size_t)l * 4 + br) * 262144; dst = (bf16_t*)(p.ws + OFF_WBR) + (size_t)br * 262144; K = 256; N = 1024; Npad = 1024; }
    else if ((tt -= 256) < 256) { src = p.in[I_WOUT] + (size_t)l * 1048576; dst = (bf16_t*)(p.ws + OFF_WO); K = 1024; N = 1024; Npad = 1024; }
    else if ((tt -= 256) < 704) { src = p.in[I_FWG] + (size_t)l * 1024 * 2816; dst = (bf16_t*)(p.ws + OFF_WF); K = 1024; N = 2816; Npad = 2816; }
    else if ((tt -= 704) < 704) { src = p.in[I_FWU] + (size_t)l * 1024 * 2816; dst = (bf16_t*)(p.ws + OFF_WF) + (size_t)2816 * 1024; K = 1024; N = 2816; Npad = 2816; }
    else { tt -= 704; src = p.in[I_FWD] + (size_t)l * 2816 * 1024; dst = (bf16_t*)(p.ws + OFF_WD); K = 2816; N = 1024; Npad = 1024; }
    const int nNt = Npad >> 6;
    const int kt = tt / nNt, nt = tt % nNt;
    conv_tile(src, dst, K, N, kt * 64, nt * 64, smem);
  }
}

DI void phase_norm(const Params& p, const float* xin, const float* g, int l, int scale_idx, int shift_idx, bf16_t* hout, float* fout) {
  const float* modp = (const float*)(p.ws + OFF_MODP);
  const int lane = otid() & 63, wv = otid() >> 6;
  const int nw = gridDim.x * 8;
  const int rows_per = 32;
  for (int chunk = obid() * 8 + wv; chunk < NTOK / 32; chunk += nw) {
  const int row0 = chunk * rows_per;
  const int b = row0 / SEQ;
  f32x4 gv[4], sc[4], sh[4];
#pragma unroll
  for (int j = 0; j < 4; ++j) {
    int c = lane * 4 + 256 * j;
    gv[j] = *(const f32x4*)(g + c);
    if (hout) {
#pragma unroll
      for (int e = 0; e < 4; ++e) {
        sc[j][e] = 1.f + modv(modp, p.in[I_BADA], l, b, scale_idx + c + e);
        sh[j][e] = modv(modp, p.in[I_BADA], l, b, shift_idx + c + e);
      }
    }
  }
  for (int rr = 0; rr < rows_per; ++rr) {
    const size_t row = (size_t)row0 + rr;
    f32x4 xv[4]; float ss = 0.f;
#pragma unroll
    for (int j = 0; j < 4; ++j) {
      xv[j] = *(const f32x4*)(xin + row * DM + lane * 4 + 256 * j);
      ss += xv[j][0] * xv[j][0] + xv[j][1] * xv[j][1] + xv[j][2] * xv[j][2] + xv[j][3] * xv[j][3];
    }
    ss = wave_sum(ss);
    const float rs = rsqrtf(ss * (1.f / 1024.f) + EPSF);
#pragma unroll
    for (int j = 0; j < 4; ++j) {
      f32x4 y = xv[j] * rs * gv[j];
      if (hout) {
        y = y * sc[j] + sh[j];
        uint2 o = {pack2(y[0], y[1]), pack2(y[2], y[3])};
        *(uint2*)(hout + row * DM + lane * 4 + 256 * j) = o;
      } else {
        *(f32x4*)(fout + row * DM + lane * 4 + 256 * j) = y;
      }
    }
  }
  }
}

#define PG_LAS __attribute__((address_space(3)))
namespace pg {
constexpr int BM = 256, BK = 64, HALF = 128, HTB = HALF * BK * 2, NXCD = 8, WGM = 8;
DI int lds_byte(int r, int c) { const int st = (r >> 4) * 2 + (c >> 5), rr = r & 15, cc = c & 31, ob = rr * 64 + cc * 2; return st * 1024 + (ob ^ (((ob >> 9) & 1) << 5)); }
DI void stage_rc(int b, int& R, int& C) { const int st = b / 1024, sb = b % 1024, swz = sb ^ (((sb >> 9) & 1) << 5); R = (st >> 1) * 16 + swz / 64; C = (st & 1) * 32 + (swz % 64) / 2; }
DI int perm32(int rho) { const int n = rho >> 4, i = rho & 15; return 8 * (i >> 2) + 4 * n + (i & 3); }
struct Unit { int pm, pn; int aux; long ao, bo; };
template <int REP> struct Order {
  int nM, nN, nwg, G, c; long astep, bstep;
  DI void init(int M, int N, int G_, int c_, long astep_ = 0, long bstep_ = 0) { nM = M / BM; nN = N / BM; nwg = nM * nN; G = G_; c = c_; astep = astep_; bstep = bstep_; }
  DI bool next(int i, Unit& u) const {
    const int ti = i / REP, aux = i % REP;
    const long L = (long)ti * G + c; if (L >= nwg) return false;
    int wgid = (int)L; { const int q = nwg / NXCD, r = nwg % NXCD, xcd = wgid % NXCD, off = wgid / NXCD; wgid = (xcd < r ? xcd * (q + 1) : r * (q + 1) + (xcd - r) * q) + off; }
    const int nig = WGM * nN, gid = wgid / nig, fm = gid * WGM, gsz = (nM - fm) < WGM ? (nM - fm) : WGM;
    u.pm = fm + ((wgid % nig) % gsz); u.pn = (wgid % nig) / gsz; u.aux = aux; u.ao = aux * astep; u.bo = aux * bstep; return true;
  }
};
DI unsigned cvt_pk_bf16(float lo, float hi) { unsigned r; asm volatile("v_cvt_pk_bf16_f32 %0, %1, %2" : "=v"(r) : "v"(lo), "v"(hi)); return r; }

template <class Epi, class Sched>
DI void gemm_phase(PG_LAS unsigned char* lds, const bf16_t* Ag, int lda, const bf16_t* Bg, int K, const Sched& S, const Epi& E) {
  const int tid = otid(), wid = __builtin_amdgcn_readfirstlane(tid >> 6), lane = tid & 63, wr = wid >> 2, wc = wid & 3, fr = lane & 15, fq = lane >> 4;
  const int nt = K / BK;
  unsigned voffA[2], voffB[2];
#pragma unroll
  for (int i = 0; i < 2; ++i) { int R, C; stage_rc(tid * 16 + i * 8192, R, C); const int Rb = Epi::PERM ? ((R & ~31) + perm32(R & 31)) : R;
    voffA[i] = (unsigned)(R * lda + C) * 2u; voffB[i] = (unsigned)(Rb * K + C) * 2u; }
  const size_t kstep = (size_t)(BK * 2);
  const size_t hstepA = (size_t)HALF * lda * 2, hstepB = (size_t)HALF * K * 2;
  const size_t tstepA = 2 * hstepA, tstepB = 2 * hstepB;
  const unsigned ldsw = (unsigned)wid * 1024u;
  const int aoff = lds_byte(wr * 64 + fr, fq * 8), boff = lds_byte(wc * 32 + fr, fq * 8);
#define PG_SA(b, h) (((b) * 2 + (h)) * HTB)
#define PG_SB(b, h) ((4 + (b) * 2 + (h)) * HTB)
#define PG_STAGE(bufoff, gbase, voff) do { _Pragma("unroll") for (int _i = 0; _i < 2; ++_i) \
    __builtin_amdgcn_global_load_lds((const unsigned*)((const char*)(gbase) + (voff)[_i]), (PG_LAS unsigned*)(lds + (bufoff) + ldsw + _i * 8192), 16, 0, 0); } while (0)
#define PG_LDA(dst, b, h) do { _Pragma("unroll") for (int m = 0; m < 4; ++m) _Pragma("unroll") for (int k = 0; k < 2; ++k) dst[m][k] = *(const PG_LAS bf16x8*)(lds + PG_SA(b, h) + aoff + m * 2048 + k * 1024); } while (0)
#define PG_LDB(dst, b, h) do { _Pragma("unroll") for (int n = 0; n < 2; ++n) _Pragma("unroll") for (int k = 0; k < 2; ++k) dst[n][k] = *(const PG_LAS bf16x8*)(lds + PG_SB(b, h) + boff + n * 2048 + k * 1024); } while (0)
#define PG_MMA(ai, bj, At, Bt) do { __builtin_amdgcn_s_setprio(1); _Pragma("unroll") for (int m = 0; m < 4; ++m) _Pragma("unroll") for (int n = 0; n < 2; ++n) _Pragma("unroll") for (int k = 0; k < 2; ++k) \
    acc[ai][bj][m][n] = __builtin_amdgcn_mfma_f32_16x16x32_bf16(Bt[n][k], At[m][k], acc[ai][bj][m][n], 0, 0, 0); __builtin_amdgcn_s_setprio(0); } while (0)
#define PG_WAIT_V(n) asm volatile("s_waitcnt vmcnt(" #n ")" ::: "memory")
#define PG_WAIT_L(n) asm volatile("s_waitcnt lgkmcnt(" #n ")" ::: "memory")
#define PG_BAR __builtin_amdgcn_s_barrier()
#define PG_SCHED __builtin_amdgcn_sched_barrier(0)
  Unit cur, nxt; int ui = 0;
  if (!S.next(0, cur)) return;
  f32x4 acc[2][2][4][2];
#pragma unroll
  for (int a = 0; a < 2; ++a)
#pragma unroll
    for (int b = 0; b < 2; ++b)
#pragma unroll
      for (int m = 0; m < 4; ++m)
#pragma unroll
        for (int n = 0; n < 2; ++n) acc[a][b][m][n] = (f32x4){0.f, 0.f, 0.f, 0.f};
  bf16x8 At[4][2], B0[2][2], B1[2][2];
  const char* cA = (const char*)Ag + (size_t)cur.pm * tstepA + cur.ao; const char* cB = (const char*)Bg + (size_t)cur.pn * tstepB + cur.bo;
  PG_STAGE(PG_SB(0, 0), cB, voffB); PG_STAGE(PG_SA(0, 0), cA, voffA); PG_STAGE(PG_SB(0, 1), cB + hstepB, voffB); PG_STAGE(PG_SA(0, 1), cA + hstepA, voffA);
  if (wr == 1) PG_BAR;
  PG_WAIT_V(4); PG_BAR;
  PG_STAGE(PG_SB(1, 0), cB + kstep, voffB); PG_STAGE(PG_SA(1, 0), cA + kstep, voffA); PG_STAGE(PG_SB(1, 1), cB + hstepB + kstep, voffB);
  PG_WAIT_V(6); PG_BAR;
  for (;;) {
    const bool has_next = S.next(ui + 1, nxt);
    const char* nA = has_next ? (const char*)Ag + (size_t)nxt.pm * tstepA + nxt.ao : cA; const char* nB = has_next ? (const char*)Bg + (size_t)nxt.pn * tstepB + nxt.bo : cB;
#pragma unroll 1
    for (int t = 0; t < nt; t += 2) {
      const bool last = (t == nt - 2);
      const char* a1 = cA + (size_t)(t + 1) * kstep;
      const char* a2 = last ? nA : cA + (size_t)(t + 2) * kstep; const char* b2 = last ? nB : cB + (size_t)(t + 2) * kstep;
      const char* a3 = a2 + kstep; const char* b3 = b2 + kstep;
      PG_LDB(B0, 0, 0); PG_SCHED; PG_LDA(At, 0, 0); PG_STAGE(PG_SA(1, 1), a1 + hstepA, voffA);
      PG_WAIT_L(8); PG_BAR; PG_WAIT_L(0); PG_MMA(0, 0, At, B0); PG_BAR; PG_SCHED;
      PG_LDB(B1, 0, 1); PG_STAGE(PG_SB(0, 0), b2, voffB);
      PG_BAR; PG_WAIT_L(0); PG_MMA(0, 1, At, B1); PG_BAR;
      PG_LDA(At, 0, 1); PG_STAGE(PG_SA(0, 0), a2, voffA);
      PG_BAR; PG_WAIT_L(0); PG_MMA(1, 0, At, B0); PG_BAR; PG_SCHED;
      PG_STAGE(PG_SB(0, 1), b2 + hstepB, voffB);
      PG_WAIT_V(6); PG_BAR; PG_MMA(1, 1, At, B1); PG_BAR;
      PG_LDB(B0, 1, 0); PG_SCHED; PG_LDA(At, 1, 0); PG_STAGE(PG_SA(0, 1), a2 + hstepA, voffA);
      PG_WAIT_L(8); PG_BAR; PG_WAIT_L(0); PG_MMA(0, 0, At, B0); PG_BAR; PG_SCHED;
      PG_LDB(B1, 1, 1); PG_STAGE(PG_SB(1, 0), b3, voffB);
      PG_BAR; PG_WAIT_L(0); PG_MMA(0, 1, At, B1); PG_BAR;
      PG_LDA(At, 1, 1); PG_STAGE(PG_SA(1, 0), a3, voffA);
      PG_BAR; PG_WAIT_L(0); PG_MMA(1, 0, At, B0); PG_BAR; PG_SCHED;
      PG_STAGE(PG_SB(1, 1), b3 + hstepB, voffB);
      PG_WAIT_V(6); PG_BAR; PG_MMA(1, 1, At, B1); PG_BAR;
    }
    E(acc, cur, wr, wc, fr, fq);
    if (!has_next) break;
#pragma unroll
    for (int a = 0; a < 2; ++a)
#pragma unroll
      for (int b = 0; b < 2; ++b)
#pragma unroll
        for (int m = 0; m < 4; ++m)
#pragma unroll
          for (int n = 0; n < 2; ++n) acc[a][b][m][n] = (f32x4){0.f, 0.f, 0.f, 0.f};
    cur = nxt; cA = nA; cB = nB; ++ui;
  }
  PG_WAIT_V(0);
  if (wr == 0) PG_BAR;
  PG_BAR;
#undef PG_SA
#undef PG_SB
#undef PG_STAGE
#undef PG_LDA
#undef PG_LDB
#undef PG_MMA
#undef PG_WAIT_V
#undef PG_WAIT_L
#undef PG_BAR
#undef PG_SCHED
}

template <int ACT> struct EpiBf16 {
  static constexpr bool PERM = true;
  bf16_t* O; int ldc; const float* bias;
  DI void operator()(const f32x4 (&acc)[2][2][4][2], const Unit& u, int wr, int wc, int fr, int fq) const {
    const int row0 = u.pm * BM + wr * 64 + fr, col0 = u.pn * BM + wc * 32 + 8 * fq;
    f32x4 bv[2][2];
#pragma unroll
    for (int bj = 0; bj < 2; ++bj)
#pragma unroll
      for (int n = 0; n < 2; ++n) bv[bj][n] = ACT ? *(const f32x4*)(bias + col0 + bj * HALF + 4 * n) : (f32x4){0.f, 0.f, 0.f, 0.f};
#pragma unroll
    for (int ai = 0; ai < 2; ++ai)
#pragma unroll
      for (int m = 0; m < 4; ++m) { bf16_t* rowp = O + (size_t)(row0 + ai * HALF + m * 16) * ldc + col0;
#pragma unroll
        for (int bj = 0; bj < 2; ++bj) { f32x4 v0 = acc[ai][bj][m][0] + bv[bj][0], v1 = acc[ai][bj][m][1] + bv[bj][1];
          if (ACT) {
#pragma unroll
            for (int j = 0; j < 4; ++j) { v0[j] = sigmoidf_(v0[j]); v1[j] = sigmoidf_(v1[j]); } }
          u32x4 w; w.x = cvt_pk_bf16(v0[0], v0[1]); w.y = cvt_pk_bf16(v0[2], v0[3]); w.z = cvt_pk_bf16(v1[0], v1[1]); w.w = cvt_pk_bf16(v1[2], v1[3]);
          *(u32x4*)(rowp + bj * HALF) = w; } }
  }
};
struct EpiBranch {
  static constexpr bool PERM = true;
  bf16_t* MIX; const bf16_t* G;
  DI void operator()(const f32x4 (&acc)[2][2][4][2], const Unit& u, int wr, int wc, int fr, int fq) const {
    const int row0 = u.pm * BM + wr * 64 + fr, col0 = u.pn * BM + wc * 32 + 8 * fq;
#pragma unroll
    for (int ai = 0; ai < 2; ++ai)
#pragma unroll
      for (int m = 0; m < 4; ++m) {
        asm volatile("" ::: "memory");
        const size_t row = (size_t)(row0 + ai * HALF + m * 16);
        bf16_t* mp = MIX + row * DM + col0; const bf16_t* gp = G + row * 4096 + u.aux * 1024 + col0;
#pragma unroll
        for (int bj = 0; bj < 2; ++bj) {
          const bf16x8 gv = *(const bf16x8*)(gp + bj * HALF);
          float o[8];
#pragma unroll
          for (int j = 0; j < 4; ++j) { o[j] = bf2f((bf16_t)gv[j]) * acc[ai][bj][m][0][j]; o[4 + j] = bf2f((bf16_t)gv[4 + j]) * acc[ai][bj][m][1][j]; }
          if (u.aux > 0) {
            const bf16x8 mv = *(const bf16x8*)(mp + bj * HALF);
#pragma unroll
            for (int j = 0; j < 8; ++j) o[j] += bf2f((bf16_t)mv[j]);
          }
          u32x4 w; w.x = cvt_pk_bf16(o[0], o[1]); w.y = cvt_pk_bf16(o[2], o[3]); w.z = cvt_pk_bf16(o[4], o[5]); w.w = cvt_pk_bf16(o[6], o[7]);
          *(u32x4*)(mp + bj * HALF) = w;
        }
      }
  }
};
struct EpiResid {
  static constexpr bool PERM = false;
  const float* xold; float* xnew; const float* modp; const float* bada; int l, gate_idx;
  DI void operator()(const f32x4 (&acc)[2][2][4][2], const Unit& u, int wr, int wc, int fr, int fq) const {
    const int row0 = u.pm * BM + wr * 64 + fr, col0 = u.pn * BM + wc * 32 + 4 * fq;
    const int b = (u.pm * BM) / SEQ;
    f32x4 gv[2][2];
#pragma unroll
    for (int bj = 0; bj < 2; ++bj)
#pragma unroll
      for (int n = 0; n < 2; ++n)
#pragma unroll
        for (int j = 0; j < 4; ++j) gv[bj][n][j] = modv(modp, bada, l, b, gate_idx + col0 + bj * HALF + n * 16 + j);
#pragma unroll
    for (int ai = 0; ai < 2; ++ai)
#pragma unroll
      for (int m = 0; m < 4; ++m) { const size_t ro = (size_t)(row0 + ai * HALF + m * 16) * DM + col0;
#pragma unroll
        for (int bj = 0; bj < 2; ++bj)
#pragma unroll
          for (int n = 0; n < 2; ++n) {
            const f32x4 xo = *(const f32x4*)(xold + ro + bj * HALF + n * 16);
            *(f32x4*)(xnew + ro + bj * HALF + n * 16) = xo + gv[bj][n] * acc[ai][bj][m][n];
          } }
  }
};
}

DI void phase_ffn_act(const Params& p, int l) {
  bf16_t* AU = (bf16_t*)(p.ws + OFF_P);
  const float* cw = p.in[I_FCW] + (size_t)l * 3 * FFN;
  const int nthr = gridDim.x * NTHR;
  for (int run = obid() * NTHR + otid(); run < 1024 * 352; run += nthr) {
    const int ch = run / 352, j8 = run % 352, j0 = j8 * 8;
    float w0[8], w1[8], w2[8];
#pragma unroll
    for (int e = 0; e < 8; ++e) { w0[e] = cw[j0 + e]; w1[e] = cw[FFN + j0 + e]; w2[e] = cw[2 * FFN + j0 + e]; }
    const int t0 = ch * 64, s0 = t0 % SEQ;
    float a1[8], a2[8];
#pragma unroll
    for (int e = 0; e < 8; ++e) { a1[e] = 0.f; a2[e] = 0.f; }
    if (s0 > 0) {
      bf16x8 v1 = *(const bf16x8*)(AU + (size_t)(t0 - 1) * AUS + j0);
      bf16x8 v2 = *(const bf16x8*)(AU + (size_t)(t0 - 2) * AUS + j0);
#pragma unroll
      for (int e = 0; e < 8; ++e) { a1[e] = bf2f((bf16_t)v1[e]); a2[e] = bf2f((bf16_t)v2[e]); }
    }
    for (int t = t0; t < t0 + 64; ++t) {
      bf16x8 va = *(const bf16x8*)(AU + (size_t)t * AUS + j0);
      bf16x8 vu = *(const bf16x8*)(AU + (size_t)t * AUS + FFN + j0);
      float o[8];
#pragma unroll
      for (int e = 0; e < 8; ++e) {
        float a0 = bf2f((bf16_t)va[e]);
        float cv = w0[e] * a2[e] + w1[e] * a1[e] + w2[e] * a0;
        o[e] = geluf_(cv) * bf2f((bf16_t)vu[e]);
        a2[e] = a1[e]; a1[e] = a0;
      }
      uint4 ov = {pack2(o[0], o[1]), pack2(o[2], o[3]), pack2(o[4], o[5]), pack2(o[6], o[7])};
      *(uint4*)(AU + (size_t)t * AUS + FFN + j0) = ov;
    }
  }
}

DI float mixf(bf16_t cur, bf16_t prev, float mu) { const float c = bf2f(cur); return c + (bf2f(prev) - c) * mu; }
DI void rw_prep_item(const Params& p, int l, int item, char* smem) {
  const bf16_t* P = (const bf16_t*)(p.ws + OFF_P);
  bf16_t* RD = (bf16_t*)(p.ws + OFF_L);
  bf16_t* RKK = (bf16_t*)(p.ws + OFF_L + GSZ);
  bf16_t* RA = (bf16_t*)(p.ws + OFF_L + 2 * GSZ);
  bf16_t* RG = (bf16_t*)(p.ws + OFF_L + 3 * GSZ);
  float* BON = (float*)(p.ws + OFF_BON);
  const int b = item >> 6, ct = item & 63;
  const int tid = otid(), lane = tid & 63, wv = tid >> 6, hd = wv & 3, tp = wv >> 2;
  float* st = (float*)smem + wv * 128;
  const int hc = hd * 64 + lane;
  const float* mu = p.in[I_RMU] + (size_t)l * 896;
  float wup[32], aup[32], gup[64];
  {
    const float* wp = p.in[I_RWUP] + (size_t)l * 32 * 256 + hc;
    const float* ap = p.in[I_RAUP] + (size_t)l * 32 * 256 + hc;
    const float* gp = p.in[I_RGUP] + (size_t)l * 64 * 256 + hc;
    asm volatile("" : "+v"(wp), "+v"(ap), "+v"(gp));
#pragma unroll
    for (int j = 0; j < 32; ++j) { wup[j] = wp[j * 256]; aup[j] = ap[j * 256]; }
#pragma unroll
    for (int j = 0; j < 64; ++j) gup[j] = gp[j * 256];
  }
  const float w0c = p.in[I_RW0][l * 256 + hc], a0c = p.in[I_RA0][l * 256 + hc], kkc = p.in[I_RKK][l * 256 + hc],
              kac = p.in[I_RKA][l * 256 + hc], rkc = p.in[I_RRK][l * 256 + hc];
  const float mu_r = mu[hc], mu_k = mu[256 + hc], mu_1 = mu[768 + lane], mu_2 = mu[832 + lane];
  const size_t tok0 = (size_t)b * SEQ + ct * 64 + tp;
  bf16_t nx[8];
#define RWLOAD(i_)                                                                         \
  {                                                                                        \
    const bf16_t* pr_ = P + (tok0 + 2 * (i_)) * PSTR + C_RW;                               \
    nx[0] = pr_[hc]; nx[1] = pr_[256 + hc]; nx[2] = pr_[768 + lane]; nx[3] = pr_[832 + lane]; \
    if (ct * 64 + tp + 2 * (i_) > 0) {                                                     \
      const bf16_t* pp_ = pr_ - PSTR;                                                      \
      nx[4] = pp_[hc]; nx[5] = pp_[256 + hc]; nx[6] = pp_[768 + lane]; nx[7] = pp_[832 + lane]; \
    } else { nx[4] = 0; nx[5] = 0; nx[6] = 0; nx[7] = 0; }                                 \
  }
  RWLOAD(0);
#pragma unroll 1
  for (int i = 0; i < 32; ++i) {
    bf16_t cu[8];
#pragma unroll
    for (int e = 0; e < 8; ++e) cu[e] = nx[e];
    if (i + 1 < 32) RWLOAD(i + 1);
    const float r = mixf(cu[0], cu[4], mu_r), k = mixf(cu[1], cu[5], mu_k), m1 = mixf(cu[2], cu[6], mu_1), m2 = mixf(cu[3], cu[7], mu_2);
    __builtin_amdgcn_wave_barrier();
    st[lane] = lane < 32 ? tanhf_(m1) : m1;
    st[64 + lane] = sigmoidf_(m2);
    __builtin_amdgcn_wave_barrier();
    float wl = w0c, al = a0c, gt = 0.f;
#pragma unroll
    for (int j4 = 0; j4 < 8; ++j4) {
      const f32x4 tx = *(const f32x4*)(st + 4 * j4), xa = *(const f32x4*)(st + 32 + 4 * j4);
#pragma unroll
      for (int e = 0; e < 4; ++e) { wl += tx[e] * wup[4 * j4 + e]; al += xa[e] * aup[4 * j4 + e]; }
    }
#pragma unroll
    for (int j4 = 0; j4 < 16; ++j4) {
      const f32x4 sg = *(const f32x4*)(st + 64 + 4 * j4);
#pragma unroll
      for (int e = 0; e < 4; ++e) gt += sg[e] * gup[4 * j4 + e];
    }
    const float wlog = -softplusf_(-wl) - 0.5f;
    const float ee = __expf(wlog);
    const float dd = 1.f - __expf(-ee);
    const float a = sigmoidf_(al);
    const float kkr = k * kkc;
    const float kp = k * (1.f + (a - 1.f) * kac);
    const float ss = wave_sum(kkr * kkr);
    const float kk = kkr * rsqrtf(ss + EPSF);
    const float bn = wave_sum(r * kp * rkc);
    const size_t tok = tok0 + 2 * i;
    RD[tok * 256 + hc] = f2bf(dd); RKK[tok * 256 + hc] = f2bf(kk); RA[tok * 256 + hc] = f2bf(a); RG[tok * 256 + hc] = f2bf(gt);
    if (lane == 0) BON[tok * 4 + hd] = bn;
  }
#undef RWLOAD
}

DI void rwkv_scan_item(const Params& p, int l, int b, int hd, int half, char* smem) {
  const bf16_t* P = (const bf16_t*)(p.ws + OFF_P);
  bf16_t* O = (bf16_t*)(p.ws + OFF_O);
  const bf16_t* RD = (const bf16_t*)(p.ws + OFF_L);
  const bf16_t* RKK = (const bf16_t*)(p.ws + OFF_L + GSZ);
  const bf16_t* RA = (const bf16_t*)(p.ws + OFF_L + 2 * GSZ);
  float* fb = (float*)smem;
  float* Yb = fb + 2 * 6208;
  const int tid = otid(), lane = tid & 63, wv = tid >> 6;
  const int hc = hd * 64 + lane;
  constexpr int NCH = SEQ / 16;
  float S[8];
#pragma unroll
  for (int j = 0; j < 8; ++j) S[j] = 0.f;
  const int rl = lane >> 3, kq = lane & 7, vloc = (wv & 3) * 8 + rl, vrow = half * 32 + vloc;
  const float* mu = p.in[I_RMU] + (size_t)l * 896;
  const float mu_r = mu[hc], mu_k = mu[256 + hc], mu_v = mu[512 + hc];
  const float kac = p.in[I_RKA][l * 256 + hc];
  const int pw = wv & 3;
  unsigned raw[4][9];
#pragma unroll
  for (int j = 0; j < 4; ++j)
#pragma unroll
    for (int e = 0; e < 9; ++e) raw[j][e] = 0u;
#define RAWLOAD(i_)                                                                                 \
  {                                                                                                 \
    _Pragma("unroll") for (int j = 0; j < 4; ++j) {                                                 \
      const int s_ = (i_) * 16 + pw * 4 + j;                                                        \
      const size_t tok_ = (size_t)b * SEQ + s_;                                                     \
      const bf16_t* pr_ = P + tok_ * PSTR + C_RW;                                                   \
      raw[j][0] = pr_[hc]; raw[j][1] = pr_[256 + hc]; raw[j][2] = pr_[512 + hc];                    \
      if (s_ > 0) { raw[j][3] = (pr_ - PSTR)[hc]; raw[j][4] = (pr_ - PSTR)[256 + hc]; raw[j][5] = (pr_ - PSTR)[512 + hc]; } \
      else { raw[j][3] = 0u; raw[j][4] = 0u; raw[j][5] = 0u; }                                      \
      raw[j][6] = RD[tok_ * 256 + hc]; raw[j][7] = RKK[tok_ * 256 + hc]; raw[j][8] = RA[tok_ * 256 + hc]; \
    }                                                                                               \
  }
#define RBAR() { asm volatile("s_waitcnt lgkmcnt(0)" ::: "memory"); __builtin_amdgcn_s_barrier(); asm volatile("" ::: "memory"); }
  if (wv >= 4) RAWLOAD(0);
#pragma unroll 1
  for (int i = 0; i < NCH + 2; ++i) {
    if (wv >= 4) {
      float* B = fb + (i & 1) * 6208;
      if (i >= 2) {
        const float* Yc = Yb + (i & 1) * 512;
        if (lane < 32) {
#pragma unroll
          for (int j = 0; j < 4; ++j) {
            const int tl = pw * 4 + j;
            const size_t tok = (size_t)b * SEQ + (i - 2) * 16 + tl;
            O[tok * DM + 768 + hd * 64 + half * 32 + lane] = f2bf(Yc[tl * 32 + lane]);
          }
        }
      }
      if (i < NCH) {
#pragma unroll
        for (int j = 0; j < 4; ++j) {
          const int tl = pw * 4 + j;
          const float r = mixf((bf16_t)raw[j][0], (bf16_t)raw[j][3], mu_r), k = mixf((bf16_t)raw[j][1], (bf16_t)raw[j][4], mu_k), v = mixf((bf16_t)raw[j][2], (bf16_t)raw[j][5], mu_v);
          const float w = 1.f - bf2f((bf16_t)raw[j][6]), kk = bf2f((bf16_t)raw[j][7]), a = bf2f((bf16_t)raw[j][8]);
          const float ka = kk * a, kp = k * (1.f + (a - 1.f) * kac);
          const float c1 = wave_sum(ka * r), c2 = wave_sum(kp * r);
          B[tl * 64 + lane] = w; B[1024 + tl * 64 + lane] = kk; B[2048 + tl * 64 + lane] = ka; B[3072 + tl * 64 + lane] = kp;
          B[4096 + tl * 64 + lane] = w * r; B[5120 + tl * 64 + lane] = v;
          if (lane == 0) { B[6144 + tl * 2] = c1; B[6144 + tl * 2 + 1] = c2; }
        }
        if (i + 1 < NCH) RAWLOAD(i + 1);
      }
    } else if (i >= 1 && i <= NCH) {
      const float* B = fb + ((i - 1) & 1) * 6208;
      float* Yc = Yb + ((i - 1) & 1) * 512;
      f32x4 vw[2][10]; float vvv[2]; float2 vsc[2];
#define RWLD(t_, s_)                                                                              \
      { const float* bt_ = B + (t_) * 64 + kq * 8;                                                 \
        _Pragma("unroll") for (int q_ = 0; q_ < 5; ++q_) { vw[s_][2 * q_] = *(const f32x4*)(bt_ + 1024 * q_); vw[s_][2 * q_ + 1] = *(const f32x4*)(bt_ + 1024 * q_ + 4); } \
        vvv[s_] = B[5120 + (t_) * 64 + vrow]; vsc[s_] = *(const float2*)(B + 6144 + (t_) * 2); }
      RWLD(0, 0);
#pragma unroll
      for (int t = 0; t < 16; ++t) {
        const int cs = t & 1;
        if (t + 1 < 16) RWLD(t + 1, cs ^ 1);
        const f32x4 w0 = vw[cs][0], w1 = vw[cs][1], kk0 = vw[cs][2], kk1 = vw[cs][3], ka0 = vw[cs][4], ka1 = vw[cs][5],
                    kp0 = vw[cs][6], kp1 = vw[cs][7], wr0 = vw[cs][8], wr1 = vw[cs][9];
        const float vv = vvv[cs]; const float2 sc = vsc[cs];
        float d0 = 0.f, e0 = 0.f;
#pragma unroll
        for (int j = 0; j < 4; ++j) { d0 += S[j] * kk0[j] + S[j + 4] * kk1[j]; e0 += S[j] * wr0[j] + S[j + 4] * wr1[j]; }
        d0 = reduce8(d0); e0 = reduce8(e0);
        const float sa0 = -d0;
        const float y0 = e0 + sa0 * sc.x + vv * sc.y;
#pragma unroll
        for (int j = 0; j < 4; ++j) {
          S[j] = S[j] * w0[j] + sa0 * ka0[j] + vv * kp0[j]; S[j + 4] = S[j + 4] * w1[j] + sa0 * ka1[j] + vv * kp1[j];
        }
        if (kq == 0) Yc[t * 32 + vloc] = y0;
      }
#undef RWLD
    }
    RBAR();
  }
#undef RAWLOAD
#undef RBAR
}

DI void rwkv_post(const Params& p, int l) {
  const bf16_t* P = (const bf16_t*)(p.ws + OFF_P);
  bf16_t* O = (bf16_t*)(p.ws + OFF_O);
  const bf16_t* RG = (const bf16_t*)(p.ws + OFF_L + 3 * GSZ);
  const float* BON = (const float*)(p.ws + OFF_BON);
  const int tid = otid(), lane = tid & 63, wv = tid >> 6;
  const float* mu = p.in[I_RMU] + (size_t)l * 896;
  const int nw = gridDim.x * 8;
  for (int task0 = (obid() * 8 + wv) * 4; task0 < NTOK * 4; task0 += nw * 4) {
    float yv[4], vv[4], gv[4], bv[4];
#pragma unroll
    for (int q = 0; q < 4; ++q) {
      const int task = task0 + q; const size_t tok = task >> 2; const int hd = task & 3, hc = hd * 64 + lane;
      yv[q] = bf2f(O[tok * DM + 768 + hc]);
      const bf16_t cur = P[tok * PSTR + C_RW + 512 + hc];
      const bf16_t prev = (tok % SEQ) ? P[(tok - 1) * PSTR + C_RW + 512 + hc] : (bf16_t)0;
      vv[q] = mixf(cur, prev, mu[512 + hc]);
      gv[q] = bf2f(RG[tok * 256 + hc]); bv[q] = BON[tok * 4 + hd];
    }
#pragma unroll
    for (int q = 0; q < 4; ++q) {
      const int task = task0 + q; const size_t tok = task >> 2; const int hd = task & 3, hc = hd * 64 + lane;
      const float mean = wave_sum(yv[q]) * (1.f / 64.f);
      const float d = yv[q] - mean;
      const float var = wave_sum(d * d) * (1.f / 64.f);
      const float yn = d * rsqrtf(var + 64e-5f) * p.in[I_RLG][l * 256 + hc] + p.in[I_RLB][l * 256 + hc];
      O[tok * DM + 768 + hc] = f2bf((yn + bv[q] * vv[q]) * gv[q]);
    }
  }
}

DI void sb_item(const Params& p, int item, char* smem) {
  const bf16_t* P = (const bf16_t*)(p.ws + OFF_P);
  bf16_t* O = (bf16_t*)(p.ws + OFF_O);
  const int qt = item & 15, hd = (item >> 4) & 3, b = item >> 6;
  const int tid = otid(), lane = tid & 63, wv = tid >> 6, r = lane & 31, h = lane >> 5;
  bf16_t* Vt = (bf16_t*)(smem + wv * 8704);
  const int q0 = qt * 256 + wv * 32;
  const int sq = q0 + r;
  const size_t tokb = (size_t)b * SEQ;
  bf16x8 qf[4];
#pragma unroll
  for (int ks = 0; ks < 4; ++ks) qf[ks] = *(const bf16x8*)(P + (tokb + sq) * PSTR + C_SB_Q + hd * 64 + ks * 16 + h * 8);
  f32x16 accO[2];
#pragma unroll
  for (int i = 0; i < 16; ++i) { accO[0][i] = 0.f; accO[1][i] = 0.f; }
  float Rsum = 0.f;
  for (int kt = (q0 + 31) >> 6; kt >= 0; --kt) {
    const int k0 = kt * 64;
#pragma unroll
    for (int it = 0; it < 8; ++it) {
      const int key = it * 8 + (lane >> 3), chv = lane & 7;
      bf16x8 v = *(const bf16x8*)(P + (tokb + k0 + key) * PSTR + C_SB_V + hd * 64 + chv * 8);
#pragma unroll
      for (int e = 0; e < 8; ++e) Vt[(chv * 8 + e) * 68 + key] = (bf16_t)v[e];
    }
    f32x16 acc[2];
#pragma unroll
    for (int m = 0; m < 2; ++m) {
#pragma unroll
      for (int i = 0; i < 16; ++i) acc[m][i] = 0.f;
#pragma unroll
      for (int ks = 0; ks < 4; ++ks) {
        bf16x8 kf = *(const bf16x8*)(P + (tokb + k0 + 32 * m + r) * PSTR + C_SB_K + hd * 64 + ks * 16 + h * 8);
        acc[m] = mfma32(kf, qf[ks], acc[m]);
      }
    }
    float spv[2][16];
    float gs[8];
#pragma unroll
    for (int m = 0; m < 2; ++m)
#pragma unroll
      for (int i = 0; i < 16; ++i) {
        const int key = k0 + 32 * m + crow(i, h);
        const float z = acc[m][i] * 0.125f;
        float sp = softplusf_(z);
        const bool valid = key < sq;
        acc[m][i] = valid ? (z - sp) : -1e30f;
        sp = valid ? sp : 0.f;
        spv[m][i] = sp;
      }
#pragma unroll
    for (int q = 0; q < 8; ++q) {
      const int m = q >> 2, g = q & 3;
      gs[q] = spv[m][4 * g] + spv[m][4 * g + 1] + spv[m][4 * g + 2] + spv[m][4 * g + 3];
    }
    float run = 0.f;
#pragma unroll
    for (int q = 7; q >= 0; --q) {
      const int m = q >> 2, g = q & 3;
      const float pg = __shfl_xor(gs[q], 32);
      const float base = Rsum + run + (h == 0 ? pg : 0.f);
      const float s3 = spv[m][4 * g + 3], s2 = spv[m][4 * g + 2], s1 = spv[m][4 * g + 1];
      const float b3 = base, b2 = base + s3, b1 = b2 + s2, b0 = b1 + s1;
      acc[m][4 * g + 3] = __expf(acc[m][4 * g + 3] - b3);
      acc[m][4 * g + 2] = __expf(acc[m][4 * g + 2] - b2);
      acc[m][4 * g + 1] = __expf(acc[m][4 * g + 1] - b1);
      acc[m][4 * g + 0] = __expf(acc[m][4 * g + 0] - b0);
      run += gs[q] + pg;
    }
    Rsum += run;
    __builtin_amdgcn_wave_barrier();
#pragma unroll
    for (int m = 0; m < 2; ++m)
#pragma unroll
      for (int s = 0; s < 2; ++s) {
        bf16x8 pb;
        {
          unsigned u0 = pack2(acc[m][8 * s + 0], acc[m][8 * s + 1]), u1 = pack2(acc[m][8 * s + 2], acc[m][8 * s + 3]);
          unsigned u2 = pack2(acc[m][8 * s + 4], acc[m][8 * s + 5]), u3 = pack2(acc[m][8 * s + 6], acc[m][8 * s + 7]);
          uint4 uu = {u0, u1, u2, u3};
          pb = __builtin_bit_cast(bf16x8, uu);
        }
#pragma unroll
        for (int dt = 0; dt < 2; ++dt) {
          const bf16_t* vp = Vt + (32 * dt + r) * 68 + 32 * m + 16 * s + 4 * h;
          s16x4 lo = *(const s16x4*)vp, hi = *(const s16x4*)(vp + 8);
          bf16x8 va = __builtin_shufflevector(lo, hi, 0, 1, 2, 3, 4, 5, 6, 7);
          accO[dt] = mfma32(va, pb, accO[dt]);
        }
      }
    __builtin_amdgcn_wave_barrier();
    if (__ballot(Rsum <= 88.f) == 0ull) break;
  }
#pragma unroll
  for (int dt = 0; dt < 2; ++dt)
#pragma unroll
    for (int g = 0; g < 4; ++g) {
      const int d = 32 * dt + 8 * g + 4 * h;
      uint2 o = {pack2(accO[dt][4 * g], accO[dt][4 * g + 1]), pack2(accO[dt][4 * g + 2], accO[dt][4 * g + 3])};
      *(uint2*)(O + (tokb + sq) * DM + 256 + hd * 64 + d) = o;
    }
}

DI int frag_off(int row, int k) {
  const int rt = row >> 4, fr = row & 15, ks = k >> 5, kk = k & 31, hi = kk >> 4, fq = (kk & 15) >> 2, j = (kk & 3) + 4 * hi;
  return ((rt * 2 + ks) * 64 + fq * 16 + fr) * 8 + j;
}
DI int frag_off8(int row, int k0) {
  const int rt = row >> 4, fr = row & 15, ks = k0 >> 5, kk = k0 & 31, hi = kk >> 4, fq = (kk & 15) >> 2;
  return ((rt * 2 + ks) * 64 + fq * 16 + fr) * 8 + 4 * hi;
}
DI void gdn_intra_item(const Params& p, int l, int item, char* smem) {
  const bf16_t* P = (const bf16_t*)(p.ws + OFF_P);
  const int hp = item & 1, c = (item >> 1) & 63, b = item >> 7;
  const int tid = otid(), lane = tid & 63;
  bf16_t* Kb = (bf16_t*)smem;
  bf16_t* Qb = Kb + 2 * 64 * 72;
  bf16_t* Vb = Qb + 2 * 64 * 72;
  float* Lm = (float*)(smem + 3 * 2 * 64 * 72 * 2);
  float* Gs = Lm + 2 * 4096;
  float* Bs = Gs + 128;
  const size_t tok0 = (size_t)b * SEQ + c * 64;
  const float* cw = p.in[I_GCW] + (size_t)l * 4 * 768;
  {
    const int t = tid >> 3, cg = tid & 7;
#pragma unroll 1
    for (int it = 0; it < 6; ++it) {
      const int hh = it / 3, which = it % 3, head = hp * 2 + hh;
      const int ccol = which * 256 + head * 64 + cg * 8;
      float acc[8];
#pragma unroll
      for (int e = 0; e < 8; ++e) acc[e] = 0.f;
#pragma unroll
      for (int j = 0; j < 4; ++j) {
        const int s = c * 64 + t - 3 + j;
        if (s >= 0) {
          bf16x8 xv = *(const bf16x8*)(P + ((size_t)b * SEQ + s) * PSTR + C_GDN_Q + ccol);
          f32x4 wa = *(const f32x4*)(cw + j * 768 + ccol), wb = *(const f32x4*)(cw + j * 768 + ccol + 4);
#pragma unroll
          for (int e = 0; e < 4; ++e) { acc[e] += wa[e] * bf2f((bf16_t)xv[e]); acc[e + 4] += wb[e] * bf2f((bf16_t)xv[e + 4]); }
        }
      }
      float ss = 0.f;
#pragma unroll
      for (int e = 0; e < 8; ++e) { acc[e] = siluf_(acc[e]); ss += acc[e] * acc[e]; }
      ss += __shfl_xor(ss, 1); ss += __shfl_xor(ss, 2); ss += __shfl_xor(ss, 4);
      float sc = 1.f;
      if (which == 0) sc = rsqrtf(ss + EPSF) * 0.125f;
      else if (which == 1) sc = rsqrtf(ss + EPSF);
      uint4 ov = {pack2(acc[0] * sc, acc[1] * sc), pack2(acc[2] * sc, acc[3] * sc), pack2(acc[4] * sc, acc[5] * sc), pack2(acc[6] * sc, acc[7] * sc)};
      bf16_t* dst = (which == 0 ? Qb : (which == 1 ? Kb : Vb)) + (hh * 64 + t) * 72 + cg * 8;
      *(uint4*)dst = ov;
    }
  }
  if (tid < 128) {
    const int hh = tid >> 6, t = lane, head = hp * 2 + hh;
    const float a_in = bf2f(P[(tok0 + t) * PSTR + C_GDN_A + head]);
    const float b_in = bf2f(P[(tok0 + t) * PSTR + C_GDN_B + head]);
    const float beta = sigmoidf_(b_in);
    float g = -__expf(p.in[I_GAL][l * 4 + head]) * softplusf_(a_in + p.in[I_GDT][l * 4 + head]);
#pragma unroll
    for (int d = 1; d < 64; d <<= 1) { float v = __shfl_up(g, d); if (lane >= d) g += v; }
    Gs[hh * 64 + t] = g; Bs[hh * 64 + t] = beta;
  }
  __syncthreads();
  const int hh = tid >> 8, lt = tid & 255, head = hp * 2 + hh;
  const size_t ih = ((size_t)(b * 4 + head)) * 64 + c;
  bf16_t* GW = (bf16_t*)(p.ws + OFF_G) + ih * 4096;
  bf16_t* GQD = (bf16_t*)(p.ws + OFF_G + GSZ) + ih * 4096;
  bf16_t* GQK = (bf16_t*)(p.ws + OFF_G + 2 * GSZ) + ih * 4096;
  bf16_t* GKD = (bf16_t*)(p.ws + OFF_G + 3 * GSZ) + ih * 4096;
  bf16_t* GU = (bf16_t*)(p.ws + OFF_G + 4 * GSZ) + ih * 4096;
  float* GCD = (float*)(p.ws + OFF_GCD);
  const float* Gh = Gs + hh * 64; const float* Bh = Bs + hh * 64;
  {
    const int wq = (tid >> 6) & 3, ti = wq >> 1, tj = wq & 1, r = lane & 31, h = lane >> 5;
    f32x16 akk, aqk;
#pragma unroll
    for (int i = 0; i < 16; ++i) { akk[i] = 0.f; aqk[i] = 0.f; }
    if (ti >= tj) {
#pragma unroll
      for (int ks = 0; ks < 4; ++ks) {
        bf16x8 ka = *(const bf16x8*)(Kb + (hh * 64 + 32 * ti + r) * 72 + ks * 16 + h * 8);
        bf16x8 qa = *(const bf16x8*)(Qb + (hh * 64 + 32 * ti + r) * 72 + ks * 16 + h * 8);
        bf16x8 kb = *(const bf16x8*)(Kb + (hh * 64 + 32 * tj + r) * 72 + ks * 16 + h * 8);
        akk = mfma32(ka, kb, akk);
        aqk = mfma32(qa, kb, aqk);
      }
    }
    const int j = 32 * tj + r;
    const float Gj = Gh[j];
#pragma unroll
    for (int i_ = 0; i_ < 16; ++i_) {
      const int i = 32 * ti + crow(i_, h);
      const float dec = (i >= j) ? __expf(Gh[i] - Gj) : 0.f;
      Lm[hh * 4096 + i * 64 + j] = (i > j) ? Bh[i] * akk[i_] * dec : 0.f;
      GQK[frag_off(i, j)] = f2bf((i >= j) ? aqk[i_] * dec : 0.f);
    }
  }
  __syncthreads();
  if (lt < 128) {
    const int cc = lt;
    float x[64];
    if (cc < 64) {
#pragma unroll
      for (int i = 0; i < 64; ++i) x[i] = bf2f(Vb[(hh * 64 + i) * 72 + cc]) * Bh[i];
    } else {
#pragma unroll
      for (int i = 0; i < 64; ++i) x[i] = bf2f(Kb[(hh * 64 + i) * 72 + cc - 64]) * Bh[i] * __expf(Gh[i]);
    }
    const float* Lh = Lm + hh * 4096;
#pragma unroll
    for (int i = 1; i < 64; ++i) {
      float s = x[i];
#pragma unroll
      for (int j4 = 0; j4 < (i + 3) / 4; ++j4) {
        const f32x4 lv = *(const f32x4*)(Lh + i * 64 + j4 * 4);
#pragma unroll
        for (int e = 0; e < 4; ++e) if (j4 * 4 + e < i) s -= lv[e] * x[j4 * 4 + e];
      }
      x[i] = s;
    }
    if (cc < 64) {
      const int split = cc >> 4, fr = cc & 15;
#pragma unroll
      for (int i4 = 0; i4 < 16; ++i4) {
        uint2 ov = {pack2(x[4 * i4], x[4 * i4 + 1]), pack2(x[4 * i4 + 2], x[4 * i4 + 3])};
        *(uint2*)(GU + ((split * 4 + (i4 >> 2)) * 64 + (i4 & 3) * 16 + fr) * 4) = ov;
      }
    } else {
#pragma unroll
      for (int i = 0; i < 64; ++i) GW[frag_off(i, cc - 64)] = f2bf(x[i]);
    }
  } else {
    const int q_ = lt - 128;
    const float Glast = Gh[63];
#pragma unroll
    for (int i = 0; i < 4; ++i) {
      const int q = q_ + 128 * i; const int pos = q >> 3, kc = q & 7;
      bf16x8 qv = *(const bf16x8*)(Qb + (hh * 64 + pos) * 72 + kc * 8);
      const float eg = __expf(Gh[pos]);
      uint4 ov = {pack2(bf2f((bf16_t)qv[0]) * eg, bf2f((bf16_t)qv[1]) * eg), pack2(bf2f((bf16_t)qv[2]) * eg, bf2f((bf16_t)qv[3]) * eg),
                  pack2(bf2f((bf16_t)qv[4]) * eg, bf2f((bf16_t)qv[5]) * eg), pack2(bf2f((bf16_t)qv[6]) * eg, bf2f((bf16_t)qv[7]) * eg)};
      { const int fo = frag_off8(pos, kc * 8); uint2 o0 = {ov.x, ov.y}, o1 = {ov.z, ov.w}; *(uint2*)(GQD + fo) = o0; *(uint2*)(GQD + fo + 128) = o1; }
    }
#pragma unroll
    for (int i = 0; i < 4; ++i) {
      const int q = q_ + 128 * i; const int k = q >> 3, pc = q & 7;
      float o[8];
#pragma unroll
      for (int e = 0; e < 8; ++e) { const int pos = pc * 8 + e; o[e] = bf2f(Kb[(hh * 64 + pos) * 72 + k]) * __expf(Glast - Gh[pos]); }
      uint4 ov = {pack2(o[0], o[1]), pack2(o[2], o[3]), pack2(o[4], o[5]), pack2(o[6], o[7])};
      { const int fo = frag_off8(k, pc * 8); uint2 o0 = {ov.x, ov.y}, o1 = {ov.z, ov.w}; *(uint2*)(GKD + fo) = o0; *(uint2*)(GKD + fo + 128) = o1; }
    }
    if (q_ == 0) GCD[ih] = __expf(Glast);
  }
}

DI void gdn_rec_item(const Params& p, int l, int b, int head, char* smem) {
  const bf16_t* P = (const bf16_t*)(p.ws + OFF_P);
  bf16_t* O = (bf16_t*)(p.ws + OFF_O);
  float* SS = (float*)(smem + 81920);
  const int tid = otid(), lane = tid & 63, wv = tid >> 6, fr = lane & 15, fq = lane >> 4;
  const int split = wv & 3;
  const bool active = wv < 4;
  const float ng = p.in[I_GNG][l * 64 + split * 16 + fr];
  const float* GCD = (const float*)(p.ws + OFF_GCD);
  const size_t ih0 = ((size_t)(b * 4 + head)) * 64;
  f32x4 S[4];
#pragma unroll
  for (int kt = 0; kt < 4; ++kt) S[kt] = (f32x4){0.f, 0.f, 0.f, 0.f};
  u32x4 lr[10];
#pragma unroll
  for (int i = 0; i < 10; ++i) lr[i] = (u32x4){0u, 0u, 0u, 0u};
  const int lq = (wv & 3) * 64 + lane;
#define GLOADC(c_)                                                                              \
  {                                                                                             \
    _Pragma("unroll") for (int i = 0; i < 10; ++i) {                                            \
      const int q_ = lq + 256 * i; const int a_ = q_ >> 9, o_ = q_ & 511;                       \
      lr[i] = *(const u32x4*)((const bf16_t*)(p.ws + OFF_G + (size_t)a_ * GSZ) + (ih0 + (c_)) * 4096 + o_ * 8); \
    }                                                                                           \
  }
#define LSTORE(buf_)                                                                            \
  {                                                                                             \
    _Pragma("unroll") for (int i = 0; i < 10; ++i) {                                            \
      const int q_ = lq + 256 * i;                                                              \
      *(u32x4*)(smem + (buf_) * 40960 + q_ * 16) = lr[i];                                       \
    }                                                                                           \
  }
#define BAR_LDS() { asm volatile("s_waitcnt lgkmcnt(0)" ::: "memory"); __builtin_amdgcn_s_barrier(); asm volatile("" ::: "memory"); }
  float cdn = 0.f;
  if (!active) { GLOADC(0); LSTORE(0); GLOADC(1); }
  else cdn = GCD[ih0];
  BAR_LDS();
#pragma unroll 1
  for (int c = 0; c < 64; ++c) {
    f32x4 acco[4];
    if (active) {
      const char* bufp = smem + (c & 1) * 40960;
      const float cd = cdn;
      if (c + 1 < 64) cdn = GCD[ih0 + c + 1];
      float zr[16];
#pragma unroll
      for (int rt = 0; rt < 4; ++rt)
#pragma unroll
        for (int j = 0; j < 4; ++j) {
          const size_t tok = (size_t)b * SEQ + c * 64 + 16 * rt + 4 * fq + j;
          zr[rt * 4 + j] = bf2f(P[tok * PSTR + C_GDN_Z + head * 64 + split * 16 + fr]);
        }
      bf16x8 bS[2];
#pragma unroll
      for (int ks = 0; ks < 2; ++ks) {
        uint4 uu = {pack2(S[2 * ks][0], S[2 * ks][1]), pack2(S[2 * ks][2], S[2 * ks][3]), pack2(S[2 * ks + 1][0], S[2 * ks + 1][1]), pack2(S[2 * ks + 1][2], S[2 * ks + 1][3])};
        bS[ks] = __builtin_bit_cast(bf16x8, uu);
      }
      f32x4 u[4];
#pragma unroll
      for (int rt = 0; rt < 4; ++rt) {
        f32x4 aw = {0.f, 0.f, 0.f, 0.f};
        acco[rt] = (f32x4){0.f, 0.f, 0.f, 0.f};
#pragma unroll
        for (int ks = 0; ks < 2; ++ks) {
          const bf16x8 wa = *(const bf16x8*)(bufp + ((rt * 2 + ks) * 64 + lane) * 16);
          const bf16x8 qa = *(const bf16x8*)(bufp + 8192 + ((rt * 2 + ks) * 64 + lane) * 16);
          aw = mfma16(wa, bS[ks], aw); acco[rt] = mfma16(qa, bS[ks], acco[rt]);
        }
        const s16x4 uv = *(const s16x4*)(bufp + 32768 + ((split * 4 + rt) * 64 + lane) * 8);
#pragma unroll
        for (int j = 0; j < 4; ++j) u[rt][j] = bf2f((bf16_t)uv[j]) - aw[j];
      }
      bf16x8 bU[2];
#pragma unroll
      for (int ks = 0; ks < 2; ++ks) {
        uint4 uu = {pack2(u[2 * ks][0], u[2 * ks][1]), pack2(u[2 * ks][2], u[2 * ks][3]), pack2(u[2 * ks + 1][0], u[2 * ks + 1][1]), pack2(u[2 * ks + 1][2], u[2 * ks + 1][3])};
        bU[ks] = __builtin_bit_cast(bf16x8, uu);
      }
#pragma unroll
      for (int rt = 0; rt < 4; ++rt) {
        f32x4 sn = S[rt] * cd;
#pragma unroll
        for (int ks = 0; ks < 2; ++ks) {
          const bf16x8 qa = *(const bf16x8*)(bufp + 16384 + ((rt * 2 + ks) * 64 + lane) * 16);
          const bf16x8 ka = *(const bf16x8*)(bufp + 24576 + ((rt * 2 + ks) * 64 + lane) * 16);
          acco[rt] = mfma16(qa, bU[ks], acco[rt]); sn = mfma16(ka, bU[ks], sn);
        }
        S[rt] = sn;
      }
#pragma unroll
      for (int rt = 0; rt < 4; ++rt)
#pragma unroll
        for (int j = 0; j < 4; ++j) {
          float s = acco[rt][j] * acco[rt][j];
          s += __shfl_xor(s, 1); s += __shfl_xor(s, 2); s += __shfl_xor(s, 4); s += __shfl_xor(s, 8);
          if (fr == 0) SS[(c & 1) * 256 + split * 64 + 16 * rt + 4 * fq + j] = s;
        }
      BAR_LDS();
      const float* ssb = SS + (c & 1) * 256;
#pragma unroll
      for (int rt = 0; rt < 4; ++rt)
#pragma unroll
        for (int j = 0; j < 4; ++j) {
          const int pos = 16 * rt + 4 * fq + j;
          const float tot = ssb[pos] + ssb[64 + pos] + ssb[128 + pos] + ssb[192 + pos];
          const float rn = rsqrtf(tot * (1.f / 64.f) + EPSF);
          const size_t tok = (size_t)b * SEQ + c * 64 + pos;
          O[tok * DM + 512 + head * 64 + split * 16 + fr] = f2bf(acco[rt][j] * rn * ng * siluf_(zr[rt * 4 + j]));
        }
    } else {
      if (c + 1 < 64) LSTORE((c + 1) & 1);
      if (c + 2 < 64) GLOADC(c + 2);
      BAR_LDS();
    }
  }
#undef GLOADC
#undef LSTORE
#undef BAR_LDS
}

DI void lru_item(const Params& p, int l, int item, char* smem, const int mode) {
  const bf16_t* P = (const bf16_t*)(p.ws + OFF_P);
  bf16_t* O = (bf16_t*)(p.ws + OFF_O);
  float* CA = (float*)(p.ws + OFF_LCA);
  float* CH = (float*)(p.ws + OFF_LCH);
  bf16_t* XS = (bf16_t*)smem;
  float* U = (float*)(smem + 34816);
  float* XC = (float*)(smem + 34816 + 65536);
  const int b = item >> 6, ct = item & 63;
  const int tid = otid(), sc = tid >> 8, c = tid & 255;
  for (int i = 0; i < 5; ++i) {
    const int q = tid + NTHR * i;
    if (q < 67 * 32) {
      const int row = q >> 5, cc = q & 31;
      const int s = ct * 64 - 3 + row;
      uint4 v = {0u, 0u, 0u, 0u};
      if (s >= 0) v = *(const uint4*)(P + ((size_t)b * SEQ + s) * PSTR + C_LRU_X + cc * 8);
      *(uint4*)(XS + row * 256 + cc * 8) = v;
    }
  }
  float carry = 0.f;
  if (mode == 1) {
    float A = 1.f, hh = 0.f;
    const float* ca = CA + ((size_t)b * 128 + sc * ct) * 256 + c;
    const float* chp = CH + ((size_t)b * 128 + sc * ct) * 256 + c;
    int k = 0;
    for (; k + 8 <= ct; k += 8) {
      float av[8], hv[8];
#pragma unroll
      for (int e = 0; e < 8; ++e) { av[e] = ca[(size_t)(k + e) * 256]; hv[e] = chp[(size_t)(k + e) * 256]; }
#pragma unroll
      for (int e = 0; e < 8; ++e) { hh = av[e] * hh + hv[e]; A *= av[e]; }
    }
    for (; k < ct; ++k) { const float a_ = ca[(size_t)k * 256], h_ = chp[(size_t)k * 256]; hh = a_ * hh + h_; A *= a_; }
    XC[(sc * 256 + c) * 2] = A; XC[(sc * 256 + c) * 2 + 1] = hh;
  }
  __syncthreads();
  if (mode == 1) {
    const float h0 = XC[c * 2 + 1], A1 = XC[(256 + c) * 2], h1 = XC[(256 + c) * 2 + 1];
    carry = A1 * h0 + h1;
    if (sc == 1) carry = CA[((size_t)b * 128 + 2 * ct) * 256 + c] * carry + CH[((size_t)b * 128 + 2 * ct) * 256 + c];
  }
  {
    const float cb = p.in[I_LCB][l * 256 + c];
    const float c0 = p.in[I_LCW][(l * 4 + 0) * 256 + c], c1 = p.in[I_LCW][(l * 4 + 1) * 256 + c],
                c2 = p.in[I_LCW][(l * 4 + 2) * 256 + c], c3 = p.in[I_LCW][(l * 4 + 3) * 256 + c];
    for (int t = sc * 32; t < sc * 32 + 32; ++t)
      U[t * 256 + c] = cb + c0 * bf2f(XS[t * 256 + c]) + c1 * bf2f(XS[(t + 1) * 256 + c]) + c2 * bf2f(XS[(t + 2) * 256 + c]) + c3 * bf2f(XS[(t + 3) * 256 + c]);
  }
  __syncthreads();
  {
    const int n = c >> 6, f = c & 63;
    float wr[64], wi[64];
    {
      const float* wrp = p.in[I_LWR] + (((size_t)l * 4 + n) * 64) * 64 + f;
      const float* wip = p.in[I_LWI] + (((size_t)l * 4 + n) * 64) * 64 + f;
      asm volatile("" : "+v"(wrp), "+v"(wip));
#pragma unroll
      for (int e = 0; e < 64; ++e) { wr[e] = wrp[e * 64]; wi[e] = wip[e * 64]; }
    }
    const float br = p.in[I_LBR][l * 256 + c], bi = p.in[I_LBI][l * 256 + c];
    const float lamsp = softplusf_(-p.in[I_LLAM][l * 256 + c]);
    float hl = carry, ac = 1.f;
    for (int t = sc * 32; t < sc * 32 + 32; ++t) {
      float ar = br, ai = bi;
#pragma unroll
      for (int e4 = 0; e4 < 16; ++e4) {
        const f32x4 uu = *(const f32x4*)(U + t * 256 + n * 64 + e4 * 4);
#pragma unroll
        for (int e = 0; e < 4; ++e) { ar += uu[e] * wr[e4 * 4 + e]; ai += uu[e] * wi[e4 * 4 + e]; }
      }
      const float rg = sigmoidf_(ar), ig = sigmoidf_(ai);
      const float la = -8.f * rg * lamsp;
      const float a = __expf(la);
      const float bb = sqrtf(fmaxf(0.f, 1.f - __expf(2.f * la))) * (ig * U[t * 256 + c]);
      hl = a * hl + bb; ac *= a;
      if (mode == 1) {
        const size_t tok = (size_t)b * SEQ + ct * 64 + t;
        const float y = bf2f(P[tok * PSTR + C_LRU_Y + c]);
        O[tok * DM + c] = f2bf(hl * geluf_(y));
      }
    }
    if (mode == 0) {
      const int ck = ct * 2 + sc;
      CA[((size_t)b * 128 + ck) * 256 + c] = ac; CH[((size_t)b * 128 + ck) * 256 + c] = hl;
    }
  }
}


#define XB_TMO      128
#define XB_XCNT(j)  (256  + 64 * (j))
#define XB_XSUB(j)  (1280 + 64 * (j))
#define XB_XGEN(j)  (2304 + 64 * (j))
#define XB_TOP      3328
#define XB_TOPGEN   3392
#define XCD_BAR_WORDS 3456
#define XB_SPIN_CAP (1u << 18)
#define XLAS __attribute__((address_space(3)))
DI unsigned xb_ld(unsigned* p)              { return __hip_atomic_load(p, __ATOMIC_RELAXED, __HIP_MEMORY_SCOPE_AGENT); }
DI unsigned xb_add(unsigned* p, unsigned v) { return __hip_atomic_fetch_add(p, v, __ATOMIC_RELAXED, __HIP_MEMORY_SCOPE_AGENT); }
DI unsigned xb_xcc_id() { return (unsigned)__builtin_amdgcn_s_getreg((3 << 11) | 20) & 0xFu; }
#define XB_SPIN(cond, bar) do { unsigned _sp = 0; while (cond) { __builtin_amdgcn_s_sleep(1); \
    if ((++_sp & 255u) == 0u) { if (xb_ld(&(bar)[XB_TMO])) break; if (_sp > XB_SPIN_CAP) { atomicAdd(&(bar)[XB_TMO], 1u); break; } } } } while (0)
struct XcdBarrier { unsigned* bar; unsigned x; volatile XLAS unsigned* st; };
DI XcdBarrier xcd_barrier_post(unsigned* bar, volatile XLAS unsigned* st) {
  XcdBarrier b; b.bar = bar; b.x = xb_xcc_id(); b.st = st;
  if (threadIdx.x == 0) (void)xb_add(&bar[XB_XCNT(b.x)], 1u);
  return b;
}
DI void xcd_barrier_complete(unsigned* bar, unsigned x, unsigned& nloc, unsigned& nx) {
  const unsigned G = gridDim.x * gridDim.y * gridDim.z;
  unsigned sum, cnt, mine, sp = 0u;
  for (;;) {
    sum = 0u; cnt = 0u; mine = 0u;
#pragma unroll
    for (unsigned j = 0; j < 16; ++j) { const unsigned c = xb_ld(&bar[XB_XCNT(j)]); sum += c; cnt += (c > 0u) ? 1u : 0u; mine = (j == x) ? c : mine; }
    if (sum == G) break;
    __builtin_amdgcn_s_sleep(1);
    if ((++sp & 255u) == 0u) { if (xb_ld(&bar[XB_TMO])) break; if (sp > XB_SPIN_CAP) { atomicAdd(&bar[XB_TMO], 1u); break; } }
  }
  nloc = mine > 0u ? mine : 1u; nx = cnt > 0u ? cnt : 1u;
}
DI void xcd_barrier(const XcdBarrier& b) {
  asm volatile("s_waitcnt vmcnt(0)" ::: "memory");
  __syncthreads();
  if (threadIdx.x == 0) {
    unsigned* bar = b.bar;
    __builtin_amdgcn_s_waitcnt(0);
    unsigned nloc = b.st[0], nx = b.st[1];
    if (nloc == 0u) { xcd_barrier_complete(bar, b.x, nloc, nx); b.st[0] = nloc; b.st[1] = nx; }
    const unsigned old = xb_add(&bar[XB_XSUB(b.x)], 1u);
    const unsigned gen = old / nloc;
    if (old + 1u == (gen + 1u) * nloc) {
      __builtin_amdgcn_fence(__ATOMIC_RELEASE, "agent");
      asm volatile("s_waitcnt vmcnt(0)" ::: "memory");
      const unsigned og = xb_add(&bar[XB_TOP], 1u);
      const unsigned tg = og / nx;
      if (og + 1u == (tg + 1u) * nx) xb_add(&bar[XB_TOPGEN], 1u);
      else XB_SPIN(xb_ld(&bar[XB_TOPGEN]) == tg, bar);
      __builtin_amdgcn_fence(__ATOMIC_ACQUIRE, "agent");
      xb_add(&bar[XB_XGEN(b.x)], 1u);
      asm volatile("s_waitcnt vmcnt(0)" ::: "memory");
    } else {
      XB_SPIN(xb_ld(&bar[XB_XGEN(b.x)]) == gen, bar);
      __builtin_amdgcn_fence(__ATOMIC_ACQUIRE, "agent");
      asm volatile("s_waitcnt vmcnt(0)" ::: "memory");
    }
  }
  __syncthreads();
}

__global__ void __launch_bounds__(NTHR) mega(Params p) {
  extern __shared__ __attribute__((aligned(16))) char smem[];
  cg::grid_group grid = cg::this_grid();
  const int tid = threadIdx.x;
  bf16_t* H = (bf16_t*)(p.ws + OFF_H);
  bf16_t* PB = (bf16_t*)(p.ws + OFF_P);
  PG_LAS unsigned char* lds = (PG_LAS unsigned char*)smem;
  volatile XLAS unsigned* xst = (volatile XLAS unsigned*)(smem + 131072);
  if (tid < 2) xst[tid] = 0u;
  __syncthreads();
  const XcdBarrier xb = xcd_barrier_post((unsigned*)(p.ws + OFF_BAR), xst);

  for (int rep = 0; rep < REP_MISC; ++rep) {
  if (MASK & 1) phase_mod(p, smem);
  grid.sync();
  }
  for (int l = 0; l < 4; ++l) {
    const float* xcur = (l == 0) ? p.in[I_X] : p.out;
    for (int rep = 0; rep < REP_MISC; ++rep) {
    if (MASK & 2) phase_convert(p, l, smem);
    if (MASK & 4) phase_norm(p, xcur, p.in[I_N1G] + l * 1024, l, 1024, 0, H, nullptr);
    xcd_barrier(xb);
    }
    for (int rep = 0; rep < REP_G; ++rep) {
    if (MASK & 8) { pg::Order<1> S; S.init(NTOK, PSTR, gridDim.x, blockIdx.x); pg::EpiBf16<0> E{PB, PSTR, nullptr};
      pg::gemm_phase(lds, H, DM, (const bf16_t*)(p.ws + OFF_WIN), 1024, S, E); }
    xcd_barrier(xb);
    }
    for (int rep = 0; rep < REP_M1; ++rep) {
    for (int it = blockIdx.x; it < 5120; it += gridDim.x) {
      if (it < 2048) { if (MASK & 32) gdn_intra_item(p, l, it, smem); }
      else if (it < 3072) { if (MASK & 64) sb_item(p, it - 2048, smem); }
      else if (it < 4096) { if (MASK & 128) lru_item(p, l, it - 3072, smem, 0); }
      else { if (MASK & 16) rw_prep_item(p, l, it - 4096, smem); }
      __syncthreads();
    }
    xcd_barrier(xb);
    }
    for (int rep = 0; rep < REP_M2; ++rep) {
    if (blockIdx.x < 128) {
      if (MASK & 16) rwkv_scan_item(p, l, blockIdx.x >> 3, (blockIdx.x >> 1) & 3, blockIdx.x & 1, smem);
    } else {
      if (blockIdx.x < 192) { if (MASK & 256) gdn_rec_item(p, l, (blockIdx.x - 128) >> 2, (blockIdx.x - 128) & 3, smem); }
      unsigned* ctr = (unsigned*)(p.ws + OFF_CTR) + l * 4 + rep;
      volatile int* slot = (volatile int*)(smem + 110016);
      for (;;) {
        __syncthreads();
        if (tid == 0) *slot = (int)atomicAdd(ctr, 1u);
        __syncthreads();
        const int it = *slot;
        if (it >= 1024) break;
        if (MASK & 512) lru_item(p, l, it, smem, 1);
      }
    }
    xcd_barrier(xb);
    }
    for (int rep = 0; rep < REP_G; ++rep) {
    for (int half = 0; half < 2; ++half) {
      bf16_t* GH = (bf16_t*)(p.ws + OFF_P + 134217728);
      if (half == 0 && rep == 0) { if (MASK & 16) rwkv_post(p, l); __syncthreads(); }
      if (MASK & 1024) { pg::Order<1> S; S.init(NTOK / 2, 4096, gridDim.x, blockIdx.x); pg::EpiBf16<1> E{GH, 4096, p.in[I_BGATE] + (size_t)l * 4096};
        pg::gemm_phase(lds, H + (size_t)half * 32768 * DM, DM, (const bf16_t*)(p.ws + OFF_WG), 1024, S, E); }
      xcd_barrier(xb);
      if (MASK & 1024) { pg::Order<4> S; S.init(NTOK / 2, 1024, gridDim.x, blockIdx.x, 512, 524288); pg::EpiBranch E{PB + (size_t)half * 32768 * DM, GH};
        pg::gemm_phase(lds, (const bf16_t*)(p.ws + OFF_O) + (size_t)half * 32768 * DM, DM, (const bf16_t*)(p.ws + OFF_WBR), 256, S, E); }
      xcd_barrier(xb);
    }
    }
    if (MASK & 2048) { pg::Order<1> S; S.init(NTOK, 1024, gridDim.x, blockIdx.x); pg::EpiResid E{xcur, p.out, (const float*)(p.ws + OFF_MODP), p.in[I_BADA], l, 2048};
      pg::gemm_phase(lds, PB, DM, (const bf16_t*)(p.ws + OFF_WO), 1024, S, E); }
    xcd_barrier(xb);
    for (int rep = 0; rep < REP_MISC; ++rep) {
    if (MASK & 4096) phase_norm(p, p.out, p.in[I_N2G] + l * 1024, l, 4096, 3072, H, nullptr);
    xcd_barrier(xb);
    }
    for (int rep = 0; rep < REP_G; ++rep) {
    if (MASK & 8192) { pg::Order<1> S; S.init(NTOK, AUS, gridDim.x, blockIdx.x); pg::EpiBf16<0> E{PB, AUS, nullptr};
      pg::gemm_phase(lds, H, DM, (const bf16_t*)(p.ws + OFF_WF), 1024, S, E); }
    xcd_barrier(xb);
    }
    if (MASK & 16384) phase_ffn_act(p, l);
    xcd_barrier(xb);
    if (MASK & 32768) { pg::Order<1> S; S.init(NTOK, 1024, gridDim.x, blockIdx.x); pg::EpiResid E{p.out, p.out, (const float*)(p.ws + OFF_MODP), p.in[I_BADA], l, 5120};
      pg::gemm_phase(lds, PB + FFN, AUS, (const bf16_t*)(p.ws + OFF_WD), FFN, S, E); }
    xcd_barrier(xb);
  }
  if (MASK & 65536) phase_norm(p, p.out, p.in[I_FG], 0, 0, 0, nullptr, p.out);
}

extern "C" void kernel_launch(void* const* d_in, const int* in_sizes, int n_in,
                              void* d_out, int out_size, void* d_ws, size_t ws_size,
                              hipStream_t stream) {
  if (ws_size < WS_NEED || n_in < 38) { fprintf(stderr, "workspace too small: %zu < %zu\n", ws_size, (size_t)WS_NEED); return; }
  (void)hipFuncSetAttribute((const void*)mega, hipFuncAttributeMaxDynamicSharedMemorySize, SMEM_BYTES);
  int dev = 0, cus = 0, per_cu = 0;
  (void)hipGetDevice(&dev);
  (void)hipDeviceGetAttribute(&cus, hipDeviceAttributeMultiprocessorCount, dev);
  (void)hipOccupancyMaxActiveBlocksPerMultiprocessor(&per_cu, mega, NTHR, SMEM_BYTES);
  if (per_cu < 1 || cus < 1) { fprintf(stderr, "occupancy query failed (%d, %d)\n", per_cu, cus); return; }
  if (cus > 256) cus = 256;
  const int grid_blocks = cus;
  Params p{};
  for (int i = 0; i < 38; ++i) p.in[i] = (const float*)d_in[i];
  p.out = (float*)d_out; p.ws = (char*)d_ws;
  (void)hipMemsetAsync((char*)d_ws + OFF_BAR, 0, XCD_BAR_WORDS * 4, stream);
  void* args[] = {&p};
  hipError_t e = hipLaunchCooperativeKernel((void*)mega, dim3(grid_blocks), dim3(NTHR), args, SMEM_BYTES, stream);
  if (e != hipSuccess) fprintf(stderr, "cooperative launch failed: %s (grid %d)\n", hipGetErrorString(e), grid_blocks);
}
```

```cpp
#include <hip/hip_runtime.h>
#include <hip/hip_cooperative_groups.h>
#include <cstdio>
namespace cg = cooperative_groups;

typedef unsigned short bf16_t;
typedef short bf16x8 __attribute__((ext_vector_type(8)));
typedef short s16x4 __attribute__((ext_vector_type(4)));
typedef float f32x4 __attribute__((ext_vector_type(4)));
typedef float f32x16 __attribute__((ext_vector_type(16)));
typedef unsigned u32x4 __attribute__((ext_vector_type(4)));
#define DI __device__ __forceinline__

constexpr int NTOK = 65536, DM = 1024, SEQ = 4096, PSTR = 3328, FFN = 2816, AUS = 5632;
constexpr int C_LRU_X = 0, C_LRU_Y = 256, C_SB_Q = 512, C_SB_K = 768, C_SB_V = 1024;
constexpr int C_GDN_Q = 1280, C_GDN_Z = 2048, C_GDN_A = 2304, C_GDN_B = 2308, C_RW = 2312;
constexpr float EPSF = 1e-6f;
#ifndef MASK
#define MASK 0x1ffff
#endif
#ifndef REP_M1
#define REP_M1 1
#endif
#ifndef REP_M2
#define REP_M2 1
#endif
#ifndef REP_G
#define REP_G 1
#endif
#ifndef REP_MISC
#define REP_MISC 1
#endif
constexpr int NTHR = 512;
constexpr int SMEM_BYTES = 131072 + 64;

constexpr size_t OFF_MODP = 0;
constexpr size_t OFF_WIN = 6291456;
constexpr size_t OFF_WG = OFF_WIN + 6815744;
constexpr size_t OFF_WBR = OFF_WG + 8388608;
constexpr size_t OFF_WO = OFF_WBR + 2097152;
constexpr size_t OFF_WF = OFF_WO + 2097152;
constexpr size_t OFF_WD = OFF_WF + 11534336;
constexpr size_t OFF_H = OFF_WD + 5767168;
constexpr size_t OFF_P = OFF_H + 134217728;
constexpr size_t OFF_O = OFF_P + 436207616;
constexpr size_t OFF_G = OFF_O + 134217728;
constexpr size_t GSZ = 33554432;
constexpr size_t OFF_GCD = OFF_G + 5 * GSZ;
constexpr size_t OFF_L = OFF_GCD + 16384;
constexpr size_t LSZ = 67108864;
constexpr size_t OFF_LCA = OFF_L + 2 * LSZ;
constexpr size_t OFF_LCH = OFF_LCA + 2097152;
constexpr size_t OFF_BON = OFF_LCH + 2097152;
constexpr size_t OFF_CTR = OFF_BON + 1048576;
constexpr size_t OFF_BAR = OFF_CTR + 256;
constexpr size_t WS_NEED = OFF_BAR + 16384;

struct Params { const float* in[38]; float* out; char* ws; };
enum { I_X = 0, I_C, I_N1G, I_N2G, I_FG, I_WADA, I_BADA, I_WIN, I_LCW, I_LCB, I_LWR, I_LBR, I_LWI, I_LBI, I_LLAM,
       I_GCW, I_GAL, I_GDT, I_GNG, I_RMU, I_RW0, I_RWUP, I_RA0, I_RAUP, I_RGUP, I_RKK, I_RKA, I_RRK, I_RLG, I_RLB,
       I_WBR, I_WGATE, I_BGATE, I_WOUT, I_FWG, I_FWU, I_FCW, I_FWD };

DI float bf2f(bf16_t v) { return __uint_as_float(((unsigned)v) << 16); }
DI unsigned pack2(float lo, float hi) { unsigned r; asm("v_cvt_pk_bf16_f32 %0, %1, %2" : "=v"(r) : "v"(lo), "v"(hi)); return r; }
DI bf16_t f2bf(float x) { return (bf16_t)(pack2(x, x) & 0xffffu); }
DI float sigmoidf_(float x) { return 1.f / (1.f + __expf(-x)); }
DI float softplusf_(float x) { return fmaxf(x, 0.f) + __logf(1.f + __expf(-fabsf(x))); }
DI float siluf_(float x) { return x / (1.f + __expf(-x)); }
DI float geluf_(float x) { float u = 0.7978845608f * (x + 0.044715f * x * x * x); return x / (1.f + __expf(-2.f * u)); }
DI float tanhf_(float x) { return 1.f - 2.f / (1.f + __expf(2.f * x)); }
DI float wave_sum(float x) {
#pragma unroll
  for (int o = 32; o >= 1; o >>= 1) x += __shfl_xor(x, o);
  return x;
}
template <int CTRL> DI float dppf(float x) { return __int_as_float(__builtin_amdgcn_update_dpp(0, __float_as_int(x), CTRL, 0xf, 0xf, true)); }
DI float reduce8(float x) { x += dppf<0xB1>(x); x += dppf<0x4E>(x); x += dppf<0x141>(x); return x; }
DI f32x16 mfma32(bf16x8 a, bf16x8 b, f32x16 c) { return __builtin_amdgcn_mfma_f32_32x32x16_bf16(a, b, c, 0, 0, 0); }
DI f32x4 mfma16(bf16x8 a, bf16x8 b, f32x4 c) { return __builtin_amdgcn_mfma_f32_16x16x32_bf16(a, b, c, 0, 0, 0); }
DI int crow(int i, int h) { return (i & 3) + 8 * (i >> 2) + 4 * h; }

DI float modv(const float* modp, const float* bada, int l, int b, int idx) {
  const float* q = modp + ((size_t)(l * 16 + b)) * 6144 + idx;
  const size_t ks = (size_t)4 * 16 * 6144;
  return bada[l * 6144 + idx] + q[0] + q[ks] + q[2 * ks] + q[3 * ks];
}

DI int otid() { int t = threadIdx.x; asm volatile("" : "+v"(t)); return t; }
DI int obid() { int b = blockIdx.x; asm volatile("" : "+s"(b)); return b; }
DI void phase_mod(const Params& p, char* smem) {
  float* sm = (float*)smem;
  float* modp = (float*)(p.ws + OFF_MODP);
  const int tid = otid();
  if (obid() == 0 && tid < 64) ((unsigned*)(p.ws + OFF_CTR))[tid] = 0u;
  for (int item = obid(); item < 192; item += gridDim.x) {
    const int l = item / 48, rem = item % 48, jb = rem >> 2, kq = rem & 3;
    for (int i = 0; i < 8; ++i) {
      int e = tid + 512 * i; int b = e >> 8, k = e & 255;
      float cv = p.in[I_C][b * 1024 + kq * 256 + k];
      sm[e] = siluf_(cv);
    }
    __syncthreads();
    float acc[16];
#pragma unroll
    for (int b = 0; b < 16; ++b) acc[b] = 0.f;
    const float* wp = p.in[I_WADA] + ((size_t)l * 1024 + kq * 256) * 6144 + jb * 512 + tid;
    for (int k = 0; k < 256; k += 4) {
      float w0 = wp[(size_t)k * 6144], w1 = wp[(size_t)(k + 1) * 6144], w2 = wp[(size_t)(k + 2) * 6144], w3 = wp[(size_t)(k + 3) * 6144];
#pragma unroll
      for (int b = 0; b < 16; ++b) {
        f32x4 cv = *(const f32x4*)(sm + b * 256 + k);
        acc[b] += cv[0] * w0 + cv[1] * w1 + cv[2] * w2 + cv[3] * w3;
      }
    }
#pragma unroll
    for (int b = 0; b < 16; ++b) modp[((size_t)((kq * 4 + l) * 16 + b)) * 6144 + jb * 512 + tid] = acc[b];
    __syncthreads();
  }
}

DI void conv_tile(const float* src, bf16_t* dst, int K, int N, int k0, int n0, char* smem) {
  float* tile = (float*)smem;
  const int tid = otid();
#pragma unroll
  for (int it = 0; it < 2; ++it) {
    int kr = (tid >> 4) + 32 * it, nc = (tid & 15) * 4;
    f32x4 v = {0.f, 0.f, 0.f, 0.f};
    if (n0 + nc < N) v = *(const f32x4*)(src + (size_t)(k0 + kr) * N + n0 + nc);
    tile[kr * 65 + nc] = v[0]; tile[kr * 65 + nc + 1] = v[1]; tile[kr * 65 + nc + 2] = v[2]; tile[kr * 65 + nc + 3] = v[3];
  }
  __syncthreads();
  {
    int n = tid >> 3, kc = (tid & 7) * 8;
    unsigned o[4];
#pragma unroll
    for (int e = 0; e < 4; ++e) o[e] = pack2(tile[(kc + 2 * e) * 65 + n], tile[(kc + 2 * e + 1) * 65 + n]);
    uint4 ov = {o[0], o[1], o[2], o[3]};
    *(uint4*)(dst + (size_t)(n0 + n) * K + k0 + kc) = ov;
  }
  __syncthreads();
}

DI void phase_convert(const Params& p, int l, char* smem) {
  for (int t = obid(); t < 4480; t += gridDim.x) {
    const float* src; bf16_t* dst; int K, N, Npad, tt = t;
    if (tt < 832) { src = p.in[I_WIN] + (size_t)l * 1024 * 3208; dst = (bf16_t*)(p.ws + OFF_WIN); K = 1024; N = 3208; Npad = 3328; }
    else if ((tt -= 832) < 1024) { int br = tt >> 8; tt &= 255; src = p.in[I_WGATE] + ((size_t)l * 4 + br) * 1048576; dst = (bf16_t*)(p.ws + OFF_WG) + (size_t)br * 1048576; K = 1024; N = 1024; Npad = 1024; }
    else if ((tt -= 1024) < 256) { int br = tt >> 6; tt &= 63; src = p.in[I_WBR] + ((size_t)l * 4 + br) * 262144; dst = (bf16_t*)(p.ws + OFF_WBR) + (size_t)br * 262144; K = 256; N = 1024; Npad = 1024; }
    else if ((tt -= 256) < 256) { src = p.in[I_WOUT] + (size_t)l * 1048576; dst = (bf16_t*)(p.ws + OFF_WO); K = 1024; N = 1024; Npad = 1024; }
    else if ((tt -= 256) < 704) { src = p.in[I_FWG] + (size_t)l * 1024 * 2816; dst = (bf16_t*)(p.ws + OFF_WF); K = 1024; N = 2816; Npad = 2816; }
    else if ((tt -= 704) < 704) { src = p.in[I_FWU] + (size_t)l * 1024 * 2816; dst = (bf16_t*)(p.ws + OFF_WF) + (size_t)2816 * 1024; K = 1024; N = 2816; Npad = 2816; }
    else { tt -= 704; src = p.in[I_FWD] + (size_t)l * 2816 * 1024; dst = (bf16_t*)(p.ws + OFF_WD); K = 2816; N = 1024; Npad = 1024; }
    const int nNt = Npad >> 6;
    const int kt = tt / nNt, nt = tt % nNt;
    conv_tile(src, dst, K, N, kt * 64, nt * 64, smem);
  }
}

DI void phase_norm(const Params& p, const float* xin, const float* g, int l, int scale_idx, int shift_idx, bf16_t* hout, float* fout) {
  const float* modp = (const float*)(p.ws + OFF_MODP);
  const int lane = otid() & 63, wv = otid() >> 6;
  const int nw = gridDim.x * 8;
  const int rows_per = 32;
  for (int chunk = obid() * 8 + wv; chunk < NTOK / 32; chunk += nw) {
  const int row0 = chunk * rows_per;
  const int b = row0 / SEQ;
  f32x4 gv[4], sc[4], sh[4];
#pragma unroll
  for (int j = 0; j < 4; ++j) {
    int c = lane * 4 + 256 * j;
    gv[j] = *(const f32x4*)(g + c);
    if (hout) {
#pragma unroll
      for (int e = 0; e < 4; ++e) {
        sc[j][e] = 1.f + modv(modp, p.in[I_BADA], l, b, scale_idx + c + e);
        sh[j][e] = modv(modp, p.in[I_BADA], l, b, shift_idx + c + e);
      }
    }
  }
  for (int rr = 0; rr < rows_per; ++rr) {
    const size_t row = (size_t)row0 + rr;
    f32x4 xv[4]; float ss = 0.f;
#pragma unroll
    for (int j = 0; j < 4; ++j) {
      xv[j] = *(const f32x4*)(xin + row * DM + lane * 4 + 256 * j);
      ss += xv[j][0] * xv[j][0] + xv[j][1] * xv[j][1] + xv[j][2] * xv[j][2] + xv[j][3] * xv[j][3];
    }
    ss = wave_sum(ss);
    const float rs = rsqrtf(ss * (1.f / 1024.f) + EPSF);
#pragma unroll
    for (int j = 0; j < 4; ++j) {
      f32x4 y = xv[j] * rs * gv[j];
      if (hout) {
        y = y * sc[j] + sh[j];
        uint2 o = {pack2(y[0], y[1]), pack2(y[2], y[3])};
        *(uint2*)(hout + row * DM + lane * 4 + 256 * j) = o;
      } else {
        *(f32x4*)(fout + row * DM + lane * 4 + 256 * j) = y;
      }
    }
  }
  }
}

#define PG_LAS __attribute__((address_space(3)))
namespace pg {
constexpr int BM = 256, BK = 64, HALF = 128, HTB = HALF * BK * 2, NXCD = 8, WGM = 8;
DI int lds_byte(int r, int c) { const int st = (r >> 4) * 2 + (c >> 5), rr = r & 15, cc = c & 31, ob = rr * 64 + cc * 2; return st * 1024 + (ob ^ (((ob >> 9) & 1) << 5)); }
DI void stage_rc(int b, int& R, int& C) { const int st = b / 1024, sb = b % 1024, swz = sb ^ (((sb >> 9) & 1) << 5); R = (st >> 1) * 16 + swz / 64; C = (st & 1) * 32 + (swz % 64) / 2; }
DI int perm32(int rho) { const int n = rho >> 4, i = rho & 15; return 8 * (i >> 2) + 4 * n + (i & 3); }
struct Unit { int pm, pn; int aux; long ao, bo; };
template <int REP> struct Order {
  int nM, nN, nwg, G, c; long astep, bstep;
  DI void init(int M, int N, int G_, int c_, long astep_ = 0, long bstep_ = 0) { nM = M / BM; nN = N / BM; nwg = nM * nN; G = G_; c = c_; astep = astep_; bstep = bstep_; }
  DI bool next(int i, Unit& u) const {
    const int ti = i / REP, aux = i % REP;
    const long L = (long)ti * G + c; if (L >= nwg) return false;
    int wgid = (int)L; { const int q = nwg / NXCD, r = nwg % NXCD, xcd = wgid % NXCD, off = wgid / NXCD; wgid = (xcd < r ? xcd * (q + 1) : r * (q + 1) + (xcd - r) * q) + off; }
    const int nig = WGM * nN, gid = wgid / nig, fm = gid * WGM, gsz = (nM - fm) < WGM ? (nM - fm) : WGM;
    u.pm = fm + ((wgid % nig) % gsz); u.pn = (wgid % nig) / gsz; u.aux = aux; u.ao = aux * astep; u.bo = aux * bstep; return true;
  }
};
DI unsigned cvt_pk_bf16(float lo, float hi) { unsigned r; asm volatile("v_cvt_pk_bf16_f32 %0, %1, %2" : "=v"(r) : "v"(lo), "v"(hi)); return r; }

template <class Epi, class Sched>
DI void gemm_phase(PG_LAS unsigned char* lds, const bf16_t* Ag, int lda, const bf16_t* Bg, int K, const Sched& S, const Epi& E) {
  const int tid = otid(), wid = __builtin_amdgcn_readfirstlane(tid >> 6), lane = tid & 63, wr = wid >> 2, wc = wid & 3, fr = lane & 15, fq = lane >> 4;
  const int nt = K / BK;
  unsigned voffA[2], voffB[2];
#pragma unroll
  for (int i = 0; i < 2; ++i) { int R, C; stage_rc(tid * 16 + i * 8192, R, C); const int Rb = Epi::PERM ? ((R & ~31) + perm32(R & 31)) : R;
    voffA[i] = (unsigned)(R * lda + C) * 2u; voffB[i] = (unsigned)(Rb * K + C) * 2u; }
  const size_t kstep = (size_t)(BK * 2);
  const size_t hstepA = (size_t)HALF * lda * 2, hstepB = (size_t)HALF * K * 2;
  const size_t tstepA = 2 * hstepA, tstepB = 2 * hstepB;
  const unsigned ldsw = (unsigned)wid * 1024u;
  const int aoff = lds_byte(wr * 64 + fr, fq * 8), boff = lds_byte(wc * 32 + fr, fq * 8);
#define PG_SA(b, h) (((b) * 2 + (h)) * HTB)
#define PG_SB(b, h) ((4 + (b) * 2 + (h)) * HTB)
#define PG_STAGE(bufoff, gbase, voff) do { _Pragma("unroll") for (int _i = 0; _i < 2; ++_i) \
    __builtin_amdgcn_global_load_lds((const unsigned*)((const char*)(gbase) + (voff)[_i]), (PG_LAS unsigned*)(lds + (bufoff) + ldsw + _i * 8192), 16, 0, 0); } while (0)
#define PG_LDA(dst, b, h) do { _Pragma("unroll") for (int m = 0; m < 4; ++m) _Pragma("unroll") for (int k = 0; k < 2; ++k) dst[m][k] = *(const PG_LAS bf16x8*)(lds + PG_SA(b, h) + aoff + m * 2048 + k * 1024); } while (0)
#define PG_LDB(dst, b, h) do { _Pragma("unroll") for (int n = 0; n < 2; ++n) _Pragma("unroll") for (int k = 0; k < 2; ++k) dst[n][k] = *(const PG_LAS bf16x8*)(lds + PG_SB(b, h) + boff + n * 2048 + k * 1024); } while (0)
#define PG_MMA(ai, bj, At, Bt) do { __builtin_amdgcn_s_setprio(1); _Pragma("unroll") for (int m = 0; m < 4; ++m) _Pragma("unroll") for (int n = 0; n < 2; ++n) _Pragma("unroll") for (int k = 0; k < 2; ++k) \
    acc[ai][bj][m][n] = __builtin_amdgcn_mfma_f32_16x16x32_bf16(Bt[n][k], At[m][k], acc[ai][bj][m][n], 0, 0, 0); __builtin_amdgcn_s_setprio(0); } while (0)
#define PG_WAIT_V(n) asm volatile("s_waitcnt vmcnt(" #n ")" ::: "memory")
#define PG_WAIT_L(n) asm volatile("s_waitcnt lgkmcnt(" #n ")" ::: "memory")
#define PG_BAR __builtin_amdgcn_s_barrier()
#define PG_SCHED __builtin_amdgcn_sched_barrier(0)
  Unit cur, nxt; int ui = 0;
  if (!S.next(0, cur)) return;
  f32x4 acc[2][2][4][2];
#pragma unroll
  for (int a = 0; a < 2; ++a)
#pragma unroll
    for (int b = 0; b < 2; ++b)
#pragma unroll
      for (int m = 0; m < 4; ++m)
#pragma unroll
        for (int n = 0; n < 2; ++n) acc[a][b][m][n] = (f32x4){0.f, 0.f, 0.f, 0.f};
  bf16x8 At[4][2], B0[2][2], B1[2][2];
  const char* cA = (const char*)Ag + (size_t)cur.pm * tstepA + cur.ao; const char* cB = (const char*)Bg + (size_t)cur.pn * tstepB + cur.bo;
  PG_STAGE(PG_SB(0, 0), cB, voffB); PG_STAGE(PG_SA(0, 0), cA, voffA); PG_STAGE(PG_SB(0, 1), cB + hstepB, voffB); PG_STAGE(PG_SA(0, 1), cA + hstepA, voffA);
  if (wr == 1) PG_BAR;
  PG_WAIT_V(4); PG_BAR;
  PG_STAGE(PG_SB(1, 0), cB + kstep, voffB); PG_STAGE(PG_SA(1, 0), cA + kstep, voffA); PG_STAGE(PG_SB(1, 1), cB + hstepB + kstep, voffB);
  PG_WAIT_V(6); PG_BAR;
  for (;;) {
    const bool has_next = S.next(ui + 1, nxt);
    const char* nA = has_next ? (const char*)Ag + (size_t)nxt.pm * tstepA + nxt.ao : cA; const char* nB = has_next ? (const char*)Bg + (size_t)nxt.pn * tstepB + nxt.bo : cB;
#pragma unroll 1
    for (int t = 0; t < nt; t += 2) {
      const bool last = (t == nt - 2);
      const char* a1 = cA + (size_t)(t + 1) * kstep;
      const char* a2 = last ? nA : cA + (size_t)(t + 2) * kstep; const char* b2 = last ? nB : cB + (size_t)(t + 2) * kstep;
      const char* a3 = a2 + kstep; const char* b3 = b2 + kstep;
      PG_LDB(B0, 0, 0); PG_SCHED; PG_LDA(At, 0, 0); PG_STAGE(PG_SA(1, 1), a1 + hstepA, voffA);
      PG_WAIT_L(8); PG_BAR; PG_WAIT_L(0); PG_MMA(0, 0, At, B0); PG_BAR; PG_SCHED;
      PG_LDB(B1, 0, 1); PG_STAGE(PG_SB(0, 0), b2, voffB);
      PG_BAR; PG_WAIT_L(0); PG_MMA(0, 1, At, B1); PG_BAR;
      PG_LDA(At, 0, 1); PG_STAGE(PG_SA(0, 0), a2, voffA);
      PG_BAR; PG_WAIT_L(0); PG_MMA(1, 0, At, B0); PG_BAR; PG_SCHED;
      PG_STAGE(PG_SB(0, 1), b2 + hstepB, voffB);
      PG_WAIT_V(6); PG_BAR; PG_MMA(1, 1, At, B1); PG_BAR;
      PG_LDB(B0, 1, 0); PG_SCHED; PG_LDA(At, 1, 0); PG_STAGE(PG_SA(0, 1), a2 + hstepA, voffA);
      PG_WAIT_L(8); PG_BAR; PG_WAIT_L(0); PG_MMA(0, 0, At, B0); PG_BAR; PG_SCHED;
      PG_LDB(B1, 1, 1); PG_STAGE(PG_SB(1, 0), b3, voffB);
      PG_BAR; PG_WAIT_L(0); PG_MMA(0, 1, At, B1); PG_BAR;
      PG_LDA(At, 1, 1); PG_STAGE(PG_SA(1, 0), a3, voffA);
      PG_BAR; PG_WAIT_L(0); PG_MMA(1, 0, At, B0); PG_BAR; PG_SCHED;
      PG_STAGE(PG_SB(1, 1), b3 + hstepB, voffB);
      PG_WAIT_V(6); PG_BAR; PG_MMA(1, 1, At, B1); PG_BAR;
    }
    E(acc, cur, wr, wc, fr, fq);
    if (!has_next) break;
#pragma unroll
    for (int a = 0; a < 2; ++a)
#pragma unroll
      for (int b = 0; b < 2; ++b)
#pragma unroll
        for (int m = 0; m < 4; ++m)
#pragma unroll
          for (int n = 0; n < 2; ++n) acc[a][b][m][n] = (f32x4){0.f, 0.f, 0.f, 0.f};
    cur = nxt; cA = nA; cB = nB; ++ui;
  }
  PG_WAIT_V(0);
  if (wr == 0) PG_BAR;
  PG_BAR;
#undef PG_SA
#undef PG_SB
#undef PG_STAGE
#undef PG_LDA
#undef PG_LDB
#undef PG_MMA
#undef PG_WAIT_V
#undef PG_WAIT_L
#undef PG_BAR
#undef PG_SCHED
}

template <int ACT> struct EpiBf16 {
  static constexpr bool PERM = true;
  bf16_t* O; int ldc; const float* bias;
  DI void operator()(const f32x4 (&acc)[2][2][4][2], const Unit& u, int wr, int wc, int fr, int fq) const {
    const int row0 = u.pm * BM + wr * 64 + fr, col0 = u.pn * BM + wc * 32 + 8 * fq;
    f32x4 bv[2][2];
#pragma unroll
    for (int bj = 0; bj < 2; ++bj)
#pragma unroll
      for (int n = 0; n < 2; ++n) bv[bj][n] = ACT ? *(const f32x4*)(bias + col0 + bj * HALF + 4 * n) : (f32x4){0.f, 0.f, 0.f, 0.f};
#pragma unroll
    for (int ai = 0; ai < 2; ++ai)
#pragma unroll
      for (int m = 0; m < 4; ++m) { bf16_t* rowp = O + (size_t)(row0 + ai * HALF + m * 16) * ldc + col0;
#pragma unroll
        for (int bj = 0; bj < 2; ++bj) { f32x4 v0 = acc[ai][bj][m][0] + bv[bj][0], v1 = acc[ai][bj][m][1] + bv[bj][1];
          if (ACT) {
#pragma unroll
            for (int j = 0; j < 4; ++j) { v0[j] = sigmoidf_(v0[j]); v1[j] = sigmoidf_(v1[j]); } }
          u32x4 w; w.x = cvt_pk_bf16(v0[0], v0[1]); w.y = cvt_pk_bf16(v0[2], v0[3]); w.z = cvt_pk_bf16(v1[0], v1[1]); w.w = cvt_pk_bf16(v1[2], v1[3]);
          *(u32x4*)(rowp + bj * HALF) = w; } }
  }
};
struct EpiBranch {
  static constexpr bool PERM = true;
  bf16_t* MIX; const bf16_t* G;
  DI void operator()(const f32x4 (&acc)[2][2][4][2], const Unit& u, int wr, int wc, int fr, int fq) const {
    const int row0 = u.pm * BM + wr * 64 + fr, col0 = u.pn * BM + wc * 32 + 8 * fq;
#pragma unroll
    for (int ai = 0; ai < 2; ++ai)
#pragma unroll
      for (int m = 0; m < 4; ++m) {
        asm volatile("" ::: "memory");
        const size_t row = (size_t)(row0 + ai * HALF + m * 16);
        bf16_t* mp = MIX + row * DM + col0; const bf16_t* gp = G + row * 4096 + u.aux * 1024 + col0;
#pragma unroll
        for (int bj = 0; bj < 2; ++bj) {
          const bf16x8 gv = *(const bf16x8*)(gp + bj * HALF);
          float o[8];
#pragma unroll
          for (int j = 0; j < 4; ++j) { o[j] = bf2f((bf16_t)gv[j]) * acc[ai][bj][m][0][j]; o[4 + j] = bf2f((bf16_t)gv[4 + j]) * acc[ai][bj][m][1][j]; }
          if (u.aux > 0) {
            const bf16x8 mv = *(const bf16x8*)(mp + bj * HALF);
#pragma unroll
            for (int j = 0; j < 8; ++j) o[j] += bf2f((bf16_t)mv[j]);
          }
          u32x4 w; w.x = cvt_pk_bf16(o[0], o[1]); w.y = cvt_pk_bf16(o[2], o[3]); w.z = cvt_pk_bf16(o[4], o[5]); w.w = cvt_pk_bf16(o[6], o[7]);
          *(u32x4*)(mp + bj * HALF) = w;
        }
      }
  }
};
struct EpiResid {
  static constexpr bool PERM = false;
  const float* xold; float* xnew; const float* modp; const float* bada; int l, gate_idx;
  DI void operator()(const f32x4 (&acc)[2][2][4][2], const Unit& u, int wr, int wc, int fr, int fq) const {
    const int row0 = u.pm * BM + wr * 64 + fr, col0 = u.pn * BM + wc * 32 + 4 * fq;
    const int b = (u.pm * BM) / SEQ;
    f32x4 gv[2][2];
#pragma unroll
    for (int bj = 0; bj < 2; ++bj)
#pragma unroll
      for (int n = 0; n < 2; ++n)
#pragma unroll
        for (int j = 0; j < 4; ++j) gv[bj][n][j] = modv(modp, bada, l, b, gate_idx + col0 + bj * HALF + n * 16 + j);
#pragma unroll
    for (int ai = 0; ai < 2; ++ai)
#pragma unroll
      for (int m = 0; m < 4; ++m) { const size_t ro = (size_t)(row0 + ai * HALF + m * 16) * DM + col0;
#pragma unroll
        for (int bj = 0; bj < 2; ++bj)
#pragma unroll
          for (int n = 0; n < 2; ++n) {
            const f32x4 xo = *(const f32x4*)(xold + ro + bj * HALF + n * 16);
            *(f32x4*)(xnew + ro + bj * HALF + n * 16) = xo + gv[bj][n] * acc[ai][bj][m][n];
          } }
  }
};
struct EpiFfnAct {
  static constexpr bool PERM = true;
  bf16_t* ACT; const bf16_t* APRE; const float* cw;
  DI void operator()(const f32x4 (&acc)[2][2][4][2], const Unit& u, int wr, int wc, int fr, int fq) const {
    const int row0 = u.pm * BM + wr * 64 + fr, col0 = u.pn * BM + wc * 32 + 8 * fq;
#pragma unroll
    for (int ai = 0; ai < 2; ++ai)
#pragma unroll
      for (int m = 0; m < 4; ++m) {
        asm volatile("" ::: "memory");
        const int row = row0 + ai * HALF + m * 16; const int sp = row & (SEQ - 1);
        const bf16_t* ap = APRE + (size_t)row * FFN + col0;
        bf16_t* op = ACT + (size_t)row * FFN + col0;
#pragma unroll
        for (int bj = 0; bj < 2; ++bj) {
          const int c = bj * HALF;
          const bf16x8 z8 = {0, 0, 0, 0, 0, 0, 0, 0};
          const bf16x8 a0 = *(const bf16x8*)(ap + c);
          const bf16x8 a1 = sp >= 1 ? *(const bf16x8*)(ap - FFN + c) : z8;
          const bf16x8 a2 = sp >= 2 ? *(const bf16x8*)(ap - 2 * FFN + c) : z8;
          float o[8];
#pragma unroll
          for (int hh = 0; hh < 2; ++hh) {
            const f32x4 w0 = *(const f32x4*)(cw + col0 + c + 4 * hh), w1 = *(const f32x4*)(cw + FFN + col0 + c + 4 * hh), w2 = *(const f32x4*)(cw + 2 * FFN + col0 + c + 4 * hh);
#pragma unroll
            for (int j = 0; j < 4; ++j) {
              const float cv = w0[j] * bf2f((bf16_t)a2[4 * hh + j]) + w1[j] * bf2f((bf16_t)a1[4 * hh + j]) + w2[j] * bf2f((bf16_t)a0[4 * hh + j]);
              o[4 * hh + j] = geluf_(cv) * acc[ai][bj][m][hh][j];
            }
          }
          u32x4 w; w.x = cvt_pk_bf16(o[0], o[1]); w.y = cvt_pk_bf16(o[2], o[3]); w.z = cvt_pk_bf16(o[4], o[5]); w.w = cvt_pk_bf16(o[6], o[7]);
          *(u32x4*)(op + c) = w;
        }
      }
  }
};
}

DI void phase_ffn_act(const Params& p, int l) {
  bf16_t* AU = (bf16_t*)(p.ws + OFF_P);
  const float* cw = p.in[I_FCW] + (size_t)l * 3 * FFN;
  const int nthr = gridDim.x * NTHR;
  for (int run = obid() * NTHR + otid(); run < 1024 * 352; run += nthr) {
    const int ch = run / 352, j8 = run % 352, j0 = j8 * 8;
    float w0[8], w1[8], w2[8];
#pragma unroll
    for (int e = 0; e < 8; ++e) { w0[e] = cw[j0 + e]; w1[e] = cw[FFN + j0 + e]; w2[e] = cw[2 * FFN + j0 + e]; }
    const int t0 = ch * 64, s0 = t0 % SEQ;
    float a1[8], a2[8];
#pragma unroll
    for (int e = 0; e < 8; ++e) { a1[e] = 0.f; a2[e] = 0.f; }
    if (s0 > 0) {
      bf16x8 v1 = *(const bf16x8*)(AU + (size_t)(t0 - 1) * AUS + j0);
      bf16x8 v2 = *(const bf16x8*)(AU + (size_t)(t0 - 2) * AUS + j0);
#pragma unroll
      for (int e = 0; e < 8; ++e) { a1[e] = bf2f((bf16_t)v1[e]); a2[e] = bf2f((bf16_t)v2[e]); }
    }
    for (int t = t0; t < t0 + 64; ++t) {
      bf16x8 va = *(const bf16x8*)(AU + (size_t)t * AUS + j0);
      bf16x8 vu = *(const bf16x8*)(AU + (size_t)t * AUS + FFN + j0);
      float o[8];
#pragma unroll
      for (int e = 0; e < 8; ++e) {
        float a0 = bf2f((bf16_t)va[e]);
        float cv = w0[e] * a2[e] + w1[e] * a1[e] + w2[e] * a0;
        o[e] = geluf_(cv) * bf2f((bf16_t)vu[e]);
        a2[e] = a1[e]; a1[e] = a0;
      }
      uint4 ov = {pack2(o[0], o[1]), pack2(o[2], o[3]), pack2(o[4], o[5]), pack2(o[6], o[7])};
      *(uint4*)(AU + (size_t)t * AUS + FFN + j0) = ov;
    }
  }
}

DI float mixf(bf16_t cur, bf16_t prev, float mu) { const float c = bf2f(cur); return c + (bf2f(prev) - c) * mu; }
DI void rw_prep_item(const Params& p, int l, int item, char* smem) {
  const bf16_t* P = (const bf16_t*)(p.ws + OFF_P);
  bf16_t* RD = (bf16_t*)(p.ws + OFF_L);
  bf16_t* RKK = (bf16_t*)(p.ws + OFF_L + GSZ);
  bf16_t* RA = (bf16_t*)(p.ws + OFF_L + 2 * GSZ);
  bf16_t* RG = (bf16_t*)(p.ws + OFF_L + 3 * GSZ);
  float* BON = (float*)(p.ws + OFF_BON);
  const int b = item >> 6, ct = item & 63;
  const int tid = otid(), lane = tid & 63, wv = tid >> 6, hd = wv & 3, tp = wv >> 2;
  float* st = (float*)smem + wv * 128;
  const int hc = hd * 64 + lane;
  const float* mu = p.in[I_RMU] + (size_t)l * 896;
  float wup[32], aup[32], gup[64];
  {
    const float* wp = p.in[I_RWUP] + (size_t)l * 32 * 256 + hc;
    const float* ap = p.in[I_RAUP] + (size_t)l * 32 * 256 + hc;
    const float* gp = p.in[I_RGUP] + (size_t)l * 64 * 256 + hc;
    asm volatile("" : "+v"(wp), "+v"(ap), "+v"(gp));
#pragma unroll
    for (int j = 0; j < 32; ++j) { wup[j] = wp[j * 256]; aup[j] = ap[j * 256]; }
#pragma unroll
    for (int j = 0; j < 64; ++j) gup[j] = gp[j * 256];
  }
  const float w0c = p.in[I_RW0][l * 256 + hc], a0c = p.in[I_RA0][l * 256 + hc], kkc = p.in[I_RKK][l * 256 + hc],
              kac = p.in[I_RKA][l * 256 + hc], rkc = p.in[I_RRK][l * 256 + hc];
  const float mu_r = mu[hc], mu_k = mu[256 + hc], mu_1 = mu[768 + lane], mu_2 = mu[832 + lane];
  const size_t tok0 = (size_t)b * SEQ + ct * 64 + tp;
  bf16_t nx[8];
#define RWLOAD(i_)                                                                         \
  {                                                                                        \
    const bf16_t* pr_ = P + (tok0 + 2 * (i_)) * PSTR + C_RW;                               \
    nx[0] = pr_[hc]; nx[1] = pr_[256 + hc]; nx[2] = pr_[768 + lane]; nx[3] = pr_[832 + lane]; \
    if (ct * 64 + tp + 2 * (i_) > 0) {                                                     \
      const bf16_t* pp_ = pr_ - PSTR;                                                      \
      nx[4] = pp_[hc]; nx[5] = pp_[256 + hc]; nx[6] = pp_[768 + lane]; nx[7] = pp_[832 + lane]; \
    } else { nx[4] = 0; nx[5] = 0; nx[6] = 0; nx[7] = 0; }                                 \
  }
  RWLOAD(0);
#pragma unroll 1
  for (int i = 0; i < 32; ++i) {
    bf16_t cu[8];
#pragma unroll
    for (int e = 0; e < 8; ++e) cu[e] = nx[e];
    if (i + 1 < 32) RWLOAD(i + 1);
    const float r = mixf(cu[0], cu[4], mu_r), k = mixf(cu[1], cu[5], mu_k), m1 = mixf(cu[2], cu[6], mu_1), m2 = mixf(cu[3], cu[7], mu_2);
    __builtin_amdgcn_wave_barrier();
    st[lane] = lane < 32 ? tanhf_(m1) : m1;
    st[64 + lane] = sigmoidf_(m2);
    __builtin_amdgcn_wave_barrier();
    float wl = w0c, al = a0c, gt = 0.f;
#pragma unroll
    for (int j4 = 0; j4 < 8; ++j4) {
      const f32x4 tx = *(const f32x4*)(st + 4 * j4), xa = *(const f32x4*)(st + 32 + 4 * j4);
#pragma unroll
      for (int e = 0; e < 4; ++e) { wl += tx[e] * wup[4 * j4 + e]; al += xa[e] * aup[4 * j4 + e]; }
    }
#pragma unroll
    for (int j4 = 0; j4 < 16; ++j4) {
      const f32x4 sg = *(const f32x4*)(st + 64 + 4 * j4);
#pragma unroll
      for (int e = 0; e < 4; ++e) gt += sg[e] * gup[4 * j4 + e];
    }
    const float wlog = -softplusf_(-wl) - 0.5f;
    const float ee = __expf(wlog);
    const float dd = 1.f - __expf(-ee);
    const float a = sigmoidf_(al);
    const float kkr = k * kkc;
    const float kp = k * (1.f + (a - 1.f) * kac);
    const float ss = wave_sum(kkr * kkr);
    const float kk = kkr * rsqrtf(ss + EPSF);
    const float bn = wave_sum(r * kp * rkc);
    const size_t tok = tok0 + 2 * i;
    RD[tok * 256 + hc] = f2bf(dd); RKK[tok * 256 + hc] = f2bf(kk); RA[tok * 256 + hc] = f2bf(a); RG[tok * 256 + hc] = f2bf(gt);
    if (lane == 0) BON[tok * 4 + hd] = bn;
  }
#undef RWLOAD
}

DI void rwkv_scan_item(const Params& p, int l, int b, int hd, int half, char* smem) {
  const bf16_t* P = (const bf16_t*)(p.ws + OFF_P);
  bf16_t* O = (bf16_t*)(p.ws + OFF_O);
  const bf16_t* RD = (const bf16_t*)(p.ws + OFF_L);
  const bf16_t* RKK = (const bf16_t*)(p.ws + OFF_L + GSZ);
  const bf16_t* RA = (const bf16_t*)(p.ws + OFF_L + 2 * GSZ);
  float* fb = (float*)smem;
  float* Yb = fb + 2 * 6208;
  const int tid = otid(), lane = tid & 63, wv = tid >> 6;
  const int hc = hd * 64 + lane;
  constexpr int NCH = SEQ / 16;
  float S[8];
#pragma unroll
  for (int j = 0; j < 8; ++j) S[j] = 0.f;
  const int rl = lane >> 3, kq = lane & 7, vloc = (wv & 3) * 8 + rl, vrow = half * 32 + vloc;
  const float* mu = p.in[I_RMU] + (size_t)l * 896;
  const float mu_r = mu[hc], mu_k = mu[256 + hc], mu_v = mu[512 + hc];
  const float kac = p.in[I_RKA][l * 256 + hc];
  const int pw = wv & 3;
  unsigned raw[4][9];
#pragma unroll
  for (int j = 0; j < 4; ++j)
#pragma unroll
    for (int e = 0; e < 9; ++e) raw[j][e] = 0u;
#define RAWLOAD(i_)                                                                                 \
  {                                                                                                 \
    _Pragma("unroll") for (int j = 0; j < 4; ++j) {                                                 \
      const int s_ = (i_) * 16 + pw * 4 + j;                                                        \
      const size_t tok_ = (size_t)b * SEQ + s_;                                                     \
      const bf16_t* pr_ = P + tok_ * PSTR + C_RW;                                                   \
      raw[j][0] = pr_[hc]; raw[j][1] = pr_[256 + hc]; raw[j][2] = pr_[512 + hc];                    \
      if (s_ > 0) { raw[j][3] = (pr_ - PSTR)[hc]; raw[j][4] = (pr_ - PSTR)[256 + hc]; raw[j][5] = (pr_ - PSTR)[512 + hc]; } \
      else { raw[j][3] = 0u; raw[j][4] = 0u; raw[j][5] = 0u; }                                      \
      raw[j][6] = RD[tok_ * 256 + hc]; raw[j][7] = RKK[tok_ * 256 + hc]; raw[j][8] = RA[tok_ * 256 + hc]; \
    }                                                                                               \
  }
#define RBAR() { asm volatile("s_waitcnt lgkmcnt(0)" ::: "memory"); __builtin_amdgcn_s_barrier(); asm volatile("" ::: "memory"); }
  if (wv >= 4) RAWLOAD(0);
#pragma unroll 1
  for (int i = 0; i < NCH + 2; ++i) {
    if (wv >= 4) {
      float* B = fb + (i & 1) * 6208;
      if (i >= 2) {
        const float* Yc = Yb + (i & 1) * 512;
        if (lane < 32) {
#pragma unroll
          for (int j = 0; j < 4; ++j) {
            const int tl = pw * 4 + j;
            const size_t tok = (size_t)b * SEQ + (i - 2) * 16 + tl;
            O[tok * DM + 768 + hd * 64 + half * 32 + lane] = f2bf(Yc[tl * 32 + lane]);
          }
        }
      }
      if (i < NCH) {
#pragma unroll
        for (int j = 0; j < 4; ++j) {
          const int tl = pw * 4 + j;
          const float r = mixf((bf16_t)raw[j][0], (bf16_t)raw[j][3], mu_r), k = mixf((bf16_t)raw[j][1], (bf16_t)raw[j][4], mu_k), v = mixf((bf16_t)raw[j][2], (bf16_t)raw[j][5], mu_v);
          const float w = 1.f - bf2f((bf16_t)raw[j][6]), kk = bf2f((bf16_t)raw[j][7]), a = bf2f((bf16_t)raw[j][8]);
          const float ka = kk * a, kp = k * (1.f + (a - 1.f) * kac);
          const float c1 = wave_sum(ka * r), c2 = wave_sum(kp * r);
          B[tl * 64 + lane] = w; B[1024 + tl * 64 + lane] = kk; B[2048 + tl * 64 + lane] = ka; B[3072 + tl * 64 + lane] = kp;
          B[4096 + tl * 64 + lane] = w * r; B[5120 + tl * 64 + lane] = v;
          if (lane == 0) { B[6144 + tl * 2] = c1; B[6144 + tl * 2 + 1] = c2; }
        }
        if (i + 1 < NCH) RAWLOAD(i + 1);
      }
    } else if (i >= 1 && i <= NCH) {
      const float* B = fb + ((i - 1) & 1) * 6208;
      float* Yc = Yb + ((i - 1) & 1) * 512;
      f32x4 vw[2][10]; float vvv[2]; float2 vsc[2];
#define RWLD(t_, s_)                                                                              \
      { const float* bt_ = B + (t_) * 64 + kq * 8;                                                 \
        _Pragma("unroll") for (int q_ = 0; q_ < 5; ++q_) { vw[s_][2 * q_] = *(const f32x4*)(bt_ + 1024 * q_); vw[s_][2 * q_ + 1] = *(const f32x4*)(bt_ + 1024 * q_ + 4); } \
        vvv[s_] = B[5120 + (t_) * 64 + vrow]; vsc[s_] = *(const float2*)(B + 6144 + (t_) * 2); }
      RWLD(0, 0);
#pragma unroll
      for (int t = 0; t < 16; ++t) {
        const int cs = t & 1;
        if (t + 1 < 16) RWLD(t + 1, cs ^ 1);
        const f32x4 w0 = vw[cs][0], w1 = vw[cs][1], kk0 = vw[cs][2], kk1 = vw[cs][3], ka0 = vw[cs][4], ka1 = vw[cs][5],
                    kp0 = vw[cs][6], kp1 = vw[cs][7], wr0 = vw[cs][8], wr1 = vw[cs][9];
        const float vv = vvv[cs]; const float2 sc = vsc[cs];
        float d0 = 0.f, e0 = 0.f;
#pragma unroll
        for (int j = 0; j < 4; ++j) { d0 += S[j] * kk0[j] + S[j + 4] * kk1[j]; e0 += S[j] * wr0[j] + S[j + 4] * wr1[j]; }
        d0 = reduce8(d0); e0 = reduce8(e0);
        const float sa0 = -d0;
        const float y0 = e0 + sa0 * sc.x + vv * sc.y;
#pragma unroll
        for (int j = 0; j < 4; ++j) {
          S[j] = S[j] * w0[j] + sa0 * ka0[j] + vv * kp0[j]; S[j + 4] = S[j + 4] * w1[j] + sa0 * ka1[j] + vv * kp1[j];
        }
        if (kq == 0) Yc[t * 32 + vloc] = y0;
      }
#undef RWLD
    }
    RBAR();
  }
#undef RAWLOAD
#undef RBAR
}

DI void rwkv_post(const Params& p, int l) {
  const bf16_t* P = (const bf16_t*)(p.ws + OFF_P);
  bf16_t* O = (bf16_t*)(p.ws + OFF_O);
  const bf16_t* RG = (const bf16_t*)(p.ws + OFF_L + 3 * GSZ);
  const float* BON = (const float*)(p.ws + OFF_BON);
  const int tid = otid(), lane = tid & 63, wv = tid >> 6;
  const float* mu = p.in[I_RMU] + (size_t)l * 896;
  const int nw = gridDim.x * 8;
  for (int task0 = (obid() * 8 + wv) * 4; task0 < NTOK * 4; task0 += nw * 4) {
    float yv[4], vv[4], gv[4], bv[4];
#pragma unroll
    for (int q = 0; q < 4; ++q) {
      const int task = task0 + q; const size_t tok = task >> 2; const int hd = task & 3, hc = hd * 64 + lane;
      yv[q] = bf2f(O[tok * DM + 768 + hc]);
      const bf16_t cur = P[tok * PSTR + C_RW + 512 + hc];
      const bf16_t prev = (tok % SEQ) ? P[(tok - 1) * PSTR + C_RW + 512 + hc] : (bf16_t)0;
      vv[q] = mixf(cur, prev, mu[512 + hc]);
      gv[q] = bf2f(RG[tok * 256 + hc]); bv[q] = BON[tok * 4 + hd];
    }
#pragma unroll
    for (int q = 0; q < 4; ++q) {
      const int task = task0 + q; const size_t tok = task >> 2; const int hd = task & 3, hc = hd * 64 + lane;
      const float mean = wave_sum(yv[q]) * (1.f / 64.f);
      const float d = yv[q] - mean;
      const float var = wave_sum(d * d) * (1.f / 64.f);
      const float yn = d * rsqrtf(var + 64e-5f) * p.in[I_RLG][l * 256 + hc] + p.in[I_RLB][l * 256 + hc];
      O[tok * DM + 768 + hc] = f2bf((yn + bv[q] * vv[q]) * gv[q]);
    }
  }
}

DI void sb_item(const Params& p, int item, char* smem) {
  const bf16_t* P = (const bf16_t*)(p.ws + OFF_P);
  bf16_t* O = (bf16_t*)(p.ws + OFF_O);
  const int qt = item & 15, hd = (item >> 4) & 3, b = item >> 6;
  const int tid = otid(), lane = tid & 63, wv = tid >> 6, r = lane & 31, h = lane >> 5;
  bf16_t* Vt = (bf16_t*)(smem + wv * 8704);
  const int q0 = qt * 256 + wv * 32;
  const int sq = q0 + r;
  const size_t tokb = (size_t)b * SEQ;
  bf16x8 qf[4];
#pragma unroll
  for (int ks = 0; ks < 4; ++ks) qf[ks] = *(const bf16x8*)(P + (tokb + sq) * PSTR + C_SB_Q + hd * 64 + ks * 16 + h * 8);
  f32x16 accO[2];
#pragma unroll
  for (int i = 0; i < 16; ++i) { accO[0][i] = 0.f; accO[1][i] = 0.f; }
  float Prun = 1.f;
  bf16x8 kf[2][4];
  const int kt0 = (q0 + 31) >> 6;
#define SBKLOAD(kt_) { _Pragma("unroll") for (int m = 0; m < 2; ++m) _Pragma("unroll") for (int ks = 0; ks < 4; ++ks) \
    kf[m][ks] = *(const bf16x8*)(P + (tokb + (kt_) * 64 + 32 * m + r) * PSTR + C_SB_K + hd * 64 + ks * 16 + h * 8); }
  SBKLOAD(kt0);
  for (int kt = kt0; kt >= 0; --kt) {
    const int k0 = kt * 64;
    bf16x8 vr[8];
#pragma unroll
    for (int it = 0; it < 8; ++it) vr[it] = *(const bf16x8*)(P + (tokb + k0 + it * 8 + (lane >> 3)) * PSTR + C_SB_V + hd * 64 + (lane & 7) * 8);
    f32x16 acc[2];
#pragma unroll
    for (int m = 0; m < 2; ++m) {
#pragma unroll
      for (int i = 0; i < 16; ++i) acc[m][i] = 0.f;
#pragma unroll
      for (int ks = 0; ks < 4; ++ks) acc[m] = mfma32(kf[m][ks], qf[ks], acc[m]);
    }
    if (kt > 0) SBKLOAD(kt - 1);
    float om[2][16];
#pragma unroll
    for (int m = 0; m < 2; ++m)
#pragma unroll
      for (int i = 0; i < 16; ++i) {
        const int key = k0 + 32 * m + crow(i, h);
        const float z = fmaxf(acc[m][i] * 0.125f, -80.f);
        const float e = __expf(-z);
        const float sg = __builtin_amdgcn_rcpf(1.f + e);
        const bool valid = key < sq;
        acc[m][i] = valid ? sg : 0.f;
        om[m][i] = valid ? e * sg : 1.f;
      }
    float gp[8];
#pragma unroll
    for (int q = 0; q < 8; ++q) {
      const int m = q >> 2, g = q & 3;
      gp[q] = (om[m][4 * g] * om[m][4 * g + 1]) * (om[m][4 * g + 2] * om[m][4 * g + 3]);
    }
    float run = 1.f;
#pragma unroll
    for (int q = 7; q >= 0; --q) {
      const int m = q >> 2, g = q & 3;
      const float pg = __shfl_xor(gp[q], 32);
      const float f3 = Prun * run * (h == 0 ? pg : 1.f);
      const float f2 = f3 * om[m][4 * g + 3], f1 = f2 * om[m][4 * g + 2], f0 = f1 * om[m][4 * g + 1];
      acc[m][4 * g + 3] *= f3; acc[m][4 * g + 2] *= f2; acc[m][4 * g + 1] *= f1; acc[m][4 * g + 0] *= f0;
      run *= gp[q] * pg;
    }
    Prun *= run;
    __builtin_amdgcn_wave_barrier();
#pragma unroll
    for (int it = 0; it < 8; ++it) {
      const int key = it * 8 + (lane >> 3), chv = lane & 7;
#pragma unroll
      for (int e = 0; e < 8; ++e) Vt[(chv * 8 + e) * 68 + key] = (bf16_t)vr[it][e];
    }
    __builtin_amdgcn_wave_barrier();
#pragma unroll
    for (int m = 0; m < 2; ++m)
#pragma unroll
      for (int s2 = 0; s2 < 2; ++s2) {
        uint4 uu = {pack2(acc[m][8 * s2 + 0], acc[m][8 * s2 + 1]), pack2(acc[m][8 * s2 + 2], acc[m][8 * s2 + 3]),
                    pack2(acc[m][8 * s2 + 4], acc[m][8 * s2 + 5]), pack2(acc[m][8 * s2 + 6], acc[m][8 * s2 + 7])};
        const bf16x8 pb = __builtin_bit_cast(bf16x8, uu);
#pragma unroll
        for (int dt = 0; dt < 2; ++dt) {
          const bf16_t* vp = Vt + (32 * dt + r) * 68 + 32 * m + 16 * s2 + 4 * h;
          s16x4 lo = *(const s16x4*)vp, hi = *(const s16x4*)(vp + 8);
          bf16x8 va = __builtin_shufflevector(lo, hi, 0, 1, 2, 3, 4, 5, 6, 7);
          accO[dt] = mfma32(va, pb, accO[dt]);
        }
      }
    __builtin_amdgcn_wave_barrier();
    if (__ballot(Prun > 1e-37f) == 0ull) break;
  }
#undef SBKLOAD
#pragma unroll
  for (int dt = 0; dt < 2; ++dt)
#pragma unroll
    for (int g = 0; g < 4; ++g) {
      const int d = 32 * dt + 8 * g + 4 * h;
      uint2 o = {pack2(accO[dt][4 * g], accO[dt][4 * g + 1]), pack2(accO[dt][4 * g + 2], accO[dt][4 * g + 3])};
      *(uint2*)(O + (tokb + sq) * DM + 256 + hd * 64 + d) = o;
    }
}

DI int frag_off(int row, int k) {
  const int rt = row >> 4, fr = row & 15, ks = k >> 5, kk = k & 31, hi = kk >> 4, fq = (kk & 15) >> 2, j = (kk & 3) + 4 * hi;
  return ((rt * 2 + ks) * 64 + fq * 16 + fr) * 8 + j;
}
DI int frag_off8(int row, int k0) {
  const int rt = row >> 4, fr = row & 15, ks = k0 >> 5, kk = k0 & 31, hi = kk >> 4, fq = (kk & 15) >> 2;
  return ((rt * 2 + ks) * 64 + fq * 16 + fr) * 8 + 4 * hi;
}
DI void gdn_intra_item(const Params& p, int l, int item, char* smem) {
  const bf16_t* P = (const bf16_t*)(p.ws + OFF_P);
  const int hp = item & 1, c = (item >> 1) & 63, b = item >> 7;
  const int tid = otid(), lane = tid & 63;
  bf16_t* Kb = (bf16_t*)smem;
  bf16_t* Qb = Kb + 2 * 64 * 72;
  bf16_t* Vb = Qb + 2 * 64 * 72;
  float* Lm = (float*)(smem + 3 * 2 * 64 * 72 * 2);
  float* Gs = Lm + 2 * 4096;
  float* Bs = Gs + 128;
  const size_t tok0 = (size_t)b * SEQ + c * 64;
  const float* cw = p.in[I_GCW] + (size_t)l * 4 * 768;
  {
    const int t = tid >> 3, cg = tid & 7;
#pragma unroll 1
    for (int it = 0; it < 6; ++it) {
      const int hh = it / 3, which = it % 3, head = hp * 2 + hh;
      const int ccol = which * 256 + head * 64 + cg * 8;
      float acc[8];
#pragma unroll
      for (int e = 0; e < 8; ++e) acc[e] = 0.f;
#pragma unroll
      for (int j = 0; j < 4; ++j) {
        const int s = c * 64 + t - 3 + j;
        if (s >= 0) {
          bf16x8 xv = *(const bf16x8*)(P + ((size_t)b * SEQ + s) * PSTR + C_GDN_Q + ccol);
          f32x4 wa = *(const f32x4*)(cw + j * 768 + ccol), wb = *(const f32x4*)(cw + j * 768 + ccol + 4);
#pragma unroll
          for (int e = 0; e < 4; ++e) { acc[e] += wa[e] * bf2f((bf16_t)xv[e]); acc[e + 4] += wb[e] * bf2f((bf16_t)xv[e + 4]); }
        }
      }
      float ss = 0.f;
#pragma unroll
      for (int e = 0; e < 8; ++e) { acc[e] = siluf_(acc[e]); ss += acc[e] * acc[e]; }
      ss += __shfl_xor(ss, 1); ss += __shfl_xor(ss, 2); ss += __shfl_xor(ss, 4);
      float sc = 1.f;
      if (which == 0) sc = rsqrtf(ss + EPSF) * 0.125f;
      else if (which == 1) sc = rsqrtf(ss + EPSF);
      uint4 ov = {pack2(acc[0] * sc, acc[1] * sc), pack2(acc[2] * sc, acc[3] * sc), pack2(acc[4] * sc, acc[5] * sc), pack2(acc[6] * sc, acc[7] * sc)};
      bf16_t* dst = (which == 0 ? Qb : (which == 1 ? Kb : Vb)) + (hh * 64 + t) * 72 + cg * 8;
      *(uint4*)dst = ov;
    }
  }
  if (tid < 128) {
    const int hh = tid >> 6, t = lane, head = hp * 2 + hh;
    const float a_in = bf2f(P[(tok0 + t) * PSTR + C_GDN_A + head]);
    const float b_in = bf2f(P[(tok0 + t) * PSTR + C_GDN_B + head]);
    const float beta = sigmoidf_(b_in);
    float g = -__expf(p.in[I_GAL][l * 4 + head]) * softplusf_(a_in + p.in[I_GDT][l * 4 + head]);
#pragma unroll
    for (int d = 1; d < 64; d <<= 1) { float v = __shfl_up(g, d); if (lane >= d) g += v; }
    Gs[hh * 64 + t] = g; Bs[hh * 64 + t] = beta;
  }
  __syncthreads();
  const int hh = tid >> 8, lt = tid & 255, head = hp * 2 + hh;
  const size_t ih = ((size_t)(b * 4 + head)) * 64 + c;
  bf16_t* GW = (bf16_t*)(p.ws + OFF_G) + ih * 4096;
  bf16_t* GQD = (bf16_t*)(p.ws + OFF_G + GSZ) + ih * 4096;
  bf16_t* GQK = (bf16_t*)(p.ws + OFF_G + 2 * GSZ) + ih * 4096;
  bf16_t* GKD = (bf16_t*)(p.ws + OFF_G + 3 * GSZ) + ih * 4096;
  bf16_t* GU = (bf16_t*)(p.ws + OFF_G + 4 * GSZ) + ih * 4096;
  float* GCD = (float*)(p.ws + OFF_GCD);
  const float* Gh = Gs + hh * 64; const float* Bh = Bs + hh * 64;
  {
    const int wq = (tid >> 6) & 3, ti = wq >> 1, tj = wq & 1, r = lane & 31, h = lane >> 5;
    f32x16 akk, aqk;
#pragma unroll
    for (int i = 0; i < 16; ++i) { akk[i] = 0.f; aqk[i] = 0.f; }
    if (ti >= tj) {
#pragma unroll
      for (int ks = 0; ks < 4; ++ks) {
        bf16x8 ka = *(const bf16x8*)(Kb + (hh * 64 + 32 * ti + r) * 72 + ks * 16 + h * 8);
        bf16x8 qa = *(const bf16x8*)(Qb + (hh * 64 + 32 * ti + r) * 72 + ks * 16 + h * 8);
        bf16x8 kb = *(const bf16x8*)(Kb + (hh * 64 + 32 * tj + r) * 72 + ks * 16 + h * 8);
        akk = mfma32(ka, kb, akk);
        aqk = mfma32(qa, kb, aqk);
      }
    }
    const int j = 32 * tj + r;
    const float Gj = Gh[j];
#pragma unroll
    for (int i_ = 0; i_ < 16; ++i_) {
      const int i = 32 * ti + crow(i_, h);
      const float dec = (i >= j) ? __expf(Gh[i] - Gj) : 0.f;
      Lm[hh * 4096 + i * 64 + j] = (i > j) ? Bh[i] * akk[i_] * dec : 0.f;
      GQK[frag_off(i, j)] = f2bf((i >= j) ? aqk[i_] * dec : 0.f);
    }
  }
  __syncthreads();
  if (lt < 128) {
    const int cc = lt;
    float x[64];
    if (cc < 64) {
#pragma unroll
      for (int i = 0; i < 64; ++i) x[i] = bf2f(Vb[(hh * 64 + i) * 72 + cc]) * Bh[i];
    } else {
#pragma unroll
      for (int i = 0; i < 64; ++i) x[i] = bf2f(Kb[(hh * 64 + i) * 72 + cc - 64]) * Bh[i] * __expf(Gh[i]);
    }
    const float* Lh = Lm + hh * 4096;
#pragma unroll
    for (int i = 1; i < 64; ++i) {
      float s = x[i];
#pragma unroll
      for (int j4 = 0; j4 < (i + 3) / 4; ++j4) {
        const f32x4 lv = *(const f32x4*)(Lh + i * 64 + j4 * 4);
#pragma unroll
        for (int e = 0; e < 4; ++e) if (j4 * 4 + e < i) s -= lv[e] * x[j4 * 4 + e];
      }
      x[i] = s;
    }
    if (cc < 64) {
      const int split = cc >> 4, fr = cc & 15;
#pragma unroll
      for (int i4 = 0; i4 < 16; ++i4) {
        uint2 ov = {pack2(x[4 * i4], x[4 * i4 + 1]), pack2(x[4 * i4 + 2], x[4 * i4 + 3])};
        *(uint2*)(GU + ((split * 4 + (i4 >> 2)) * 64 + (i4 & 3) * 16 + fr) * 4) = ov;
      }
    } else {
#pragma unroll
      for (int i = 0; i < 64; ++i) GW[frag_off(i, cc - 64)] = f2bf(x[i]);
    }
  } else {
    const int q_ = lt - 128;
    const float Glast = Gh[63];
#pragma unroll
    for (int i = 0; i < 4; ++i) {
      const int q = q_ + 128 * i; const int pos = q >> 3, kc = q & 7;
      bf16x8 qv = *(const bf16x8*)(Qb + (hh * 64 + pos) * 72 + kc * 8);
      const float eg = __expf(Gh[pos]);
      uint4 ov = {pack2(bf2f((bf16_t)qv[0]) * eg, bf2f((bf16_t)qv[1]) * eg), pack2(bf2f((bf16_t)qv[2]) * eg, bf2f((bf16_t)qv[3]) * eg),
                  pack2(bf2f((bf16_t)qv[4]) * eg, bf2f((bf16_t)qv[5]) * eg), pack2(bf2f((bf16_t)qv[6]) * eg, bf2f((bf16_t)qv[7]) * eg)};
      { const int fo = frag_off8(pos, kc * 8); uint2 o0 = {ov.x, ov.y}, o1 = {ov.z, ov.w}; *(uint2*)(GQD + fo) = o0; *(uint2*)(GQD + fo + 128) = o1; }
    }
#pragma unroll
    for (int i = 0; i < 4; ++i) {
      const int q = q_ + 128 * i; const int k = q >> 3, pc = q & 7;
      float o[8];
#pragma unroll
      for (int e = 0; e < 8; ++e) { const int pos = pc * 8 + e; o[e] = bf2f(Kb[(hh * 64 + pos) * 72 + k]) * __expf(Glast - Gh[pos]); }
      uint4 ov = {pack2(o[0], o[1]), pack2(o[2], o[3]), pack2(o[4], o[5]), pack2(o[6], o[7])};
      { const int fo = frag_off8(k, pc * 8); uint2 o0 = {ov.x, ov.y}, o1 = {ov.z, ov.w}; *(uint2*)(GKD + fo) = o0; *(uint2*)(GKD + fo + 128) = o1; }
    }
    if (q_ == 0) GCD[ih] = __expf(Glast);
  }
}

DI void gdn_rec_item(const Params& p, int l, int b, int head, char* smem) {
  const bf16_t* P = (const bf16_t*)(p.ws + OFF_P);
  bf16_t* O = (bf16_t*)(p.ws + OFF_O);
  float* SS = (float*)(smem + 81920);
  const int tid = otid(), lane = tid & 63, wv = tid >> 6, fr = lane & 15, fq = lane >> 4;
  const int split = wv & 3;
  const bool active = wv < 4;
  const float ng = p.in[I_GNG][l * 64 + split * 16 + fr];
  const float* GCD = (const float*)(p.ws + OFF_GCD);
  const size_t ih0 = ((size_t)(b * 4 + head)) * 64;
  f32x4 S[4];
#pragma unroll
  for (int kt = 0; kt < 4; ++kt) S[kt] = (f32x4){0.f, 0.f, 0.f, 0.f};
  u32x4 lr[10];
#pragma unroll
  for (int i = 0; i < 10; ++i) lr[i] = (u32x4){0u, 0u, 0u, 0u};
  const int lq = (wv & 3) * 64 + lane;
#define GLOADC(c_)                                                                              \
  {                                                                                             \
    _Pragma("unroll") for (int i = 0; i < 10; ++i) {                                            \
      const int q_ = lq + 256 * i; const int a_ = q_ >> 9, o_ = q_ & 511;                       \
      lr[i] = *(const u32x4*)((const bf16_t*)(p.ws + OFF_G + (size_t)a_ * GSZ) + (ih0 + (c_)) * 4096 + o_ * 8); \
    }                                                                                           \
  }
#define LSTORE(buf_)                                                                            \
  {                                                                                             \
    _Pragma("unroll") for (int i = 0; i < 10; ++i) {                                            \
      const int q_ = lq + 256 * i;                                                              \
      *(u32x4*)(smem + (buf_) * 40960 + q_ * 16) = lr[i];                                       \
    }                                                                                           \
  }
#define BAR_LDS() { asm volatile("s_waitcnt lgkmcnt(0)" ::: "memory"); __builtin_amdgcn_s_barrier(); asm volatile("" ::: "memory"); }
  float cdn = 0.f;
  if (!active) { GLOADC(0); LSTORE(0); GLOADC(1); }
  else cdn = GCD[ih0];
  BAR_LDS();
#pragma unroll 1
  for (int c = 0; c < 64; ++c) {
    f32x4 acco[4];
    if (active) {
      const char* bufp = smem + (c & 1) * 40960;
      const float cd = cdn;
      if (c + 1 < 64) cdn = GCD[ih0 + c + 1];
      float zr[16];
#pragma unroll
      for (int rt = 0; rt < 4; ++rt)
#pragma unroll
        for (int j = 0; j < 4; ++j) {
          const size_t tok = (size_t)b * SEQ + c * 64 + 16 * rt + 4 * fq + j;
          zr[rt * 4 + j] = bf2f(P[tok * PSTR + C_GDN_Z + head * 64 + split * 16 + fr]);
        }
      bf16x8 bS[2];
#pragma unroll
      for (int ks = 0; ks < 2; ++ks) {
        uint4 uu = {pack2(S[2 * ks][0], S[2 * ks][1]), pack2(S[2 * ks][2], S[2 * ks][3]), pack2(S[2 * ks + 1][0], S[2 * ks + 1][1]), pack2(S[2 * ks + 1][2], S[2 * ks + 1][3])};
        bS[ks] = __builtin_bit_cast(bf16x8, uu);
      }
      f32x4 u[4];
#pragma unroll
      for (int rt = 0; rt < 4; ++rt) {
        f32x4 aw = {0.f, 0.f, 0.f, 0.f};
        acco[rt] = (f32x4){0.f, 0.f, 0.f, 0.f};
#pragma unroll
        for (int ks = 0; ks < 2; ++ks) {
          const bf16x8 wa = *(const bf16x8*)(bufp + ((rt * 2 + ks) * 64 + lane) * 16);
          const bf16x8 qa = *(const bf16x8*)(bufp + 8192 + ((rt * 2 + ks) * 64 + lane) * 16);
          aw = mfma16(wa, bS[ks], aw); acco[rt] = mfma16(qa, bS[ks], acco[rt]);
        }
        const s16x4 uv = *(const s16x4*)(bufp + 32768 + ((split * 4 + rt) * 64 + lane) * 8);
#pragma unroll
        for (int j = 0; j < 4; ++j) u[rt][j] = bf2f((bf16_t)uv[j]) - aw[j];
      }
      bf16x8 bU[2];
#pragma unroll
      for (int ks = 0; ks < 2; ++ks) {
        uint4 uu = {pack2(u[2 * ks][0], u[2 * ks][1]), pack2(u[2 * ks][2], u[2 * ks][3]), pack2(u[2 * ks + 1][0], u[2 * ks + 1][1]), pack2(u[2 * ks + 1][2], u[2 * ks + 1][3])};
        bU[ks] = __builtin_bit_cast(bf16x8, uu);
      }
#pragma unroll
      for (int rt = 0; rt < 4; ++rt) {
        f32x4 sn = S[rt] * cd;
#pragma unroll
        for (int ks = 0; ks < 2; ++ks) {
          const bf16x8 qa = *(const bf16x8*)(bufp + 16384 + ((rt * 2 + ks) * 64 + lane) * 16);
          const bf16x8 ka = *(const bf16x8*)(bufp + 24576 + ((rt * 2 + ks) * 64 + lane) * 16);
          acco[rt] = mfma16(qa, bU[ks], acco[rt]); sn = mfma16(ka, bU[ks], sn);
        }
        S[rt] = sn;
      }
#pragma unroll
      for (int rt = 0; rt < 4; ++rt)
#pragma unroll
        for (int j = 0; j < 4; ++j) {
          float s = acco[rt][j] * acco[rt][j];
          s += __shfl_xor(s, 1); s += __shfl_xor(s, 2); s += __shfl_xor(s, 4); s += __shfl_xor(s, 8);
          if (fr == 0) SS[(c & 1) * 256 + split * 64 + 16 * rt + 4 * fq + j] = s;
        }
      BAR_LDS();
      const float* ssb = SS + (c & 1) * 256;
#pragma unroll
      for (int rt = 0; rt < 4; ++rt)
#pragma unroll
        for (int j = 0; j < 4; ++j) {
          const int pos = 16 * rt + 4 * fq + j;
          const float tot = ssb[pos] + ssb[64 + pos] + ssb[128 + pos] + ssb[192 + pos];
          const float rn = rsqrtf(tot * (1.f / 64.f) + EPSF);
          const size_t tok = (size_t)b * SEQ + c * 64 + pos;
          O[tok * DM + 512 + head * 64 + split * 16 + fr] = f2bf(acco[rt][j] * rn * ng * siluf_(zr[rt * 4 + j]));
        }
    } else {
      if (c + 1 < 64) LSTORE((c + 1) & 1);
      if (c + 2 < 64) GLOADC(c + 2);
      BAR_LDS();
    }
  }
#undef GLOADC
#undef LSTORE
#undef BAR_LDS
}

DI void lru_item(const Params& p, int l, int item, char* smem, const int mode) {
  const bf16_t* P = (const bf16_t*)(p.ws + OFF_P);
  bf16_t* O = (bf16_t*)(p.ws + OFF_O);
  float* CA = (float*)(p.ws + OFF_LCA);
  float* CH = (float*)(p.ws + OFF_LCH);
  bf16_t* XS = (bf16_t*)smem;
  float* U = (float*)(smem + 34816);
  float* XC = (float*)(smem + 34816 + 65536);
  const int b = item >> 6, ct = item & 63;
  const int tid = otid(), sc = tid >> 8, c = tid & 255;
  for (int i = 0; i < 5; ++i) {
    const int q = tid + NTHR * i;
    if (q < 67 * 32) {
      const int row = q >> 5, cc = q & 31;
      const int s = ct * 64 - 3 + row;
      uint4 v = {0u, 0u, 0u, 0u};
      if (s >= 0) v = *(const uint4*)(P + ((size_t)b * SEQ + s) * PSTR + C_LRU_X + cc * 8);
      *(uint4*)(XS + row * 256 + cc * 8) = v;
    }
  }
  float carry = 0.f;
  if (mode == 1) {
    float A = 1.f, hh = 0.f;
    const float* ca = CA + ((size_t)b * 128 + sc * ct) * 256 + c;
    const float* chp = CH + ((size_t)b * 128 + sc * ct) * 256 + c;
    int k = 0;
    for (; k + 8 <= ct; k += 8) {
      float av[8], hv[8];
#pragma unroll
      for (int e = 0; e < 8; ++e) { av[e] = ca[(size_t)(k + e) * 256]; hv[e] = chp[(size_t)(k + e) * 256]; }
#pragma unroll
      for (int e = 0; e < 8; ++e) { hh = av[e] * hh + hv[e]; A *= av[e]; }
    }
    for (; k < ct; ++k) { const float a_ = ca[(size_t)k * 256], h_ = chp[(size_t)k * 256]; hh = a_ * hh + h_; A *= a_; }
    XC[(sc * 256 + c) * 2] = A; XC[(sc * 256 + c) * 2 + 1] = hh;
  }
  __syncthreads();
  if (mode == 1) {
    const float h0 = XC[c * 2 + 1], A1 = XC[(256 + c) * 2], h1 = XC[(256 + c) * 2 + 1];
    carry = A1 * h0 + h1;
    if (sc == 1) carry = CA[((size_t)b * 128 + 2 * ct) * 256 + c] * carry + CH[((size_t)b * 128 + 2 * ct) * 256 + c];
  }
  {
    const float cb = p.in[I_LCB][l * 256 + c];
    const float c0 = p.in[I_LCW][(l * 4 + 0) * 256 + c], c1 = p.in[I_LCW][(l * 4 + 1) * 256 + c],
                c2 = p.in[I_LCW][(l * 4 + 2) * 256 + c], c3 = p.in[I_LCW][(l * 4 + 3) * 256 + c];
    for (int t = sc * 32; t < sc * 32 + 32; ++t)
      U[t * 256 + c] = cb + c0 * bf2f(XS[t * 256 + c]) + c1 * bf2f(XS[(t + 1) * 256 + c]) + c2 * bf2f(XS[(t + 2) * 256 + c]) + c3 * bf2f(XS[(t + 3) * 256 + c]);
  }
  __syncthreads();
  {
    const int n = c >> 6, f = c & 63;
    float wr[64], wi[64];
    {
      const float* wrp = p.in[I_LWR] + (((size_t)l * 4 + n) * 64) * 64 + f;
      const float* wip = p.in[I_LWI] + (((size_t)l * 4 + n) * 64) * 64 + f;
      asm volatile("" : "+v"(wrp), "+v"(wip));
#pragma unroll
      for (int e = 0; e < 64; ++e) { wr[e] = wrp[e * 64]; wi[e] = wip[e * 64]; }
    }
    const float br = p.in[I_LBR][l * 256 + c], bi = p.in[I_LBI][l * 256 + c];
    const float lamsp = softplusf_(-p.in[I_LLAM][l * 256 + c]);
    float hl = carry, ac = 1.f;
    for (int t = sc * 32; t < sc * 32 + 32; ++t) {
      float ar = br, ai = bi;
#pragma unroll
      for (int e4 = 0; e4 < 16; ++e4) {
        const f32x4 uu = *(const f32x4*)(U + t * 256 + n * 64 + e4 * 4);
#pragma unroll
        for (int e = 0; e < 4; ++e) { ar += uu[e] * wr[e4 * 4 + e]; ai += uu[e] * wi[e4 * 4 + e]; }
      }
      const float rg = sigmoidf_(ar), ig = sigmoidf_(ai);
      const float la = -8.f * rg * lamsp;
      const float a = __expf(la);
      const float bb = sqrtf(fmaxf(0.f, 1.f - __expf(2.f * la))) * (ig * U[t * 256 + c]);
      hl = a * hl + bb; ac *= a;
      if (mode == 1) {
        const size_t tok = (size_t)b * SEQ + ct * 64 + t;
        const float y = bf2f(P[tok * PSTR + C_LRU_Y + c]);
        O[tok * DM + c] = f2bf(hl * geluf_(y));
      }
    }
    if (mode == 0) {
      const int ck = ct * 2 + sc;
      CA[((size_t)b * 128 + ck) * 256 + c] = ac; CH[((size_t)b * 128 + ck) * 256 + c] = hl;
    }
  }
}


#define XB_TMO      128
#define XB_XCNT(j)  (256  + 64 * (j))
#define XB_XSUB(j)  (1280 + 64 * (j))
#define XB_XGEN(j)  (2304 + 64 * (j))
#define XB_TOP      3328
#define XB_TOPGEN   3392
#define XCD_BAR_WORDS 3456
#define XB_SPIN_CAP (1u << 18)
#define XLAS __attribute__((address_space(3)))
DI unsigned xb_ld(unsigned* p)              { return __hip_atomic_load(p, __ATOMIC_RELAXED, __HIP_MEMORY_SCOPE_AGENT); }
DI unsigned xb_add(unsigned* p, unsigned v) { return __hip_atomic_fetch_add(p, v, __ATOMIC_RELAXED, __HIP_MEMORY_SCOPE_AGENT); }
DI unsigned xb_xcc_id() { return (unsigned)__builtin_amdgcn_s_getreg((3 << 11) | 20) & 0xFu; }
#define XB_SPIN(cond, bar) do { unsigned _sp = 0; while (cond) { __builtin_amdgcn_s_sleep(1); \
    if ((++_sp & 255u) == 0u) { if (xb_ld(&(bar)[XB_TMO])) break; if (_sp > XB_SPIN_CAP) { atomicAdd(&(bar)[XB_TMO], 1u); break; } } } } while (0)
struct XcdBarrier { unsigned* bar; unsigned x; volatile XLAS unsigned* st; };
DI XcdBarrier xcd_barrier_post(unsigned* bar, volatile XLAS unsigned* st) {
  XcdBarrier b; b.bar = bar; b.x = xb_xcc_id(); b.st = st;
  if (threadIdx.x == 0) (void)xb_add(&bar[XB_XCNT(b.x)], 1u);
  return b;
}
DI void xcd_barrier_complete(unsigned* bar, unsigned x, unsigned& nloc, unsigned& nx) {
  const unsigned G = gridDim.x * gridDim.y * gridDim.z;
  unsigned sum, cnt, mine, sp = 0u;
  for (;;) {
    sum = 0u; cnt = 0u; mine = 0u;
#pragma unroll
    for (unsigned j = 0; j < 16; ++j) { const unsigned c = xb_ld(&bar[XB_XCNT(j)]); sum += c; cnt += (c > 0u) ? 1u : 0u; mine = (j == x) ? c : mine; }
    if (sum == G) break;
    __builtin_amdgcn_s_sleep(1);
    if ((++sp & 255u) == 0u) { if (xb_ld(&bar[XB_TMO])) break; if (sp > XB_SPIN_CAP) { atomicAdd(&bar[XB_TMO], 1u); break; } }
  }
  nloc = mine > 0u ? mine : 1u; nx = cnt > 0u ? cnt : 1u;
}
DI void xcd_barrier(const XcdBarrier& b) {
  asm volatile("s_waitcnt vmcnt(0)" ::: "memory");
  __syncthreads();
  if (threadIdx.x == 0) {
    unsigned* bar = b.bar;
    __builtin_amdgcn_s_waitcnt(0);
    unsigned nloc = b.st[0], nx = b.st[1];
    if (nloc == 0u) { xcd_barrier_complete(bar, b.x, nloc, nx); b.st[0] = nloc; b.st[1] = nx; }
    const unsigned old = xb_add(&bar[XB_XSUB(b.x)], 1u);
    const unsigned gen = old / nloc;
    if (old + 1u == (gen + 1u) * nloc) {
      __builtin_amdgcn_fence(__ATOMIC_RELEASE, "agent");
      asm volatile("s_waitcnt vmcnt(0)" ::: "memory");
      const unsigned og = xb_add(&bar[XB_TOP], 1u);
      const unsigned tg = og / nx;
      if (og + 1u == (tg + 1u) * nx) xb_add(&bar[XB_TOPGEN], 1u);
      else XB_SPIN(xb_ld(&bar[XB_TOPGEN]) == tg, bar);
      __builtin_amdgcn_fence(__ATOMIC_ACQUIRE, "agent");
      xb_add(&bar[XB_XGEN(b.x)], 1u);
      asm volatile("s_waitcnt vmcnt(0)" ::: "memory");
    } else {
      XB_SPIN(xb_ld(&bar[XB_XGEN(b.x)]) == gen, bar);
      __builtin_amdgcn_fence(__ATOMIC_ACQUIRE, "agent");
      asm volatile("s_waitcnt vmcnt(0)" ::: "memory");
    }
  }
  __syncthreads();
}

__global__ void __launch_bounds__(NTHR) mega(Params p) {
  extern __shared__ __attribute__((aligned(16))) char smem[];
  cg::grid_group grid = cg::this_grid();
  const int tid = threadIdx.x;
  bf16_t* H = (bf16_t*)(p.ws + OFF_H);
  bf16_t* PB = (bf16_t*)(p.ws + OFF_P);
  PG_LAS unsigned char* lds = (PG_LAS unsigned char*)smem;
  volatile XLAS unsigned* xst = (volatile XLAS unsigned*)(smem + 131072);
  if (tid < 2) xst[tid] = 0u;
  __syncthreads();
  const XcdBarrier xb = xcd_barrier_post((unsigned*)(p.ws + OFF_BAR), xst);

  for (int rep = 0; rep < REP_MISC; ++rep) {
  if (MASK & 1) phase_mod(p, smem);
  grid.sync();
  }
  for (int l = 0; l < 4; ++l) {
    const float* xcur = (l == 0) ? p.in[I_X] : p.out;
    for (int rep = 0; rep < REP_MISC; ++rep) {
    if (MASK & 2) phase_convert(p, l, smem);
    if (MASK & 4) phase_norm(p, xcur, p.in[I_N1G] + l * 1024, l, 1024, 0, H, nullptr);
    xcd_barrier(xb);
    }
    for (int rep = 0; rep < REP_G; ++rep) {
    if (MASK & 8) { pg::Order<1> S; S.init(NTOK, PSTR, gridDim.x, blockIdx.x); pg::EpiBf16<0> E{PB, PSTR, nullptr};
      pg::gemm_phase(lds, H, DM, (const bf16_t*)(p.ws + OFF_WIN), 1024, S, E); }
    xcd_barrier(xb);
    }
    for (int rep = 0; rep < REP_M1; ++rep) {
    for (int it = blockIdx.x; it < 5120; it += gridDim.x) {
      if (it < 2048) { if (MASK & 32) gdn_intra_item(p, l, it, smem); }
      else if (it < 3072) { if (MASK & 64) sb_item(p, it - 2048, smem); }
      else if (it < 4096) { if (MASK & 128) lru_item(p, l, it - 3072, smem, 0); }
      else { if (MASK & 16) rw_prep_item(p, l, it - 4096, smem); }
      __syncthreads();
    }
    xcd_barrier(xb);
    }
    for (int rep = 0; rep < REP_M2; ++rep) {
    if (blockIdx.x < 128) {
      if (MASK & 16) rwkv_scan_item(p, l, blockIdx.x >> 3, (blockIdx.x >> 1) & 3, blockIdx.x & 1, smem);
    } else {
      if (blockIdx.x < 192) { if (MASK & 256) gdn_rec_item(p, l, (blockIdx.x - 128) >> 2, (blockIdx.x - 128) & 3, smem); }
      unsigned* ctr = (unsigned*)(p.ws + OFF_CTR) + l * 4 + rep;
      volatile int* slot = (volatile int*)(smem + 110016);
      for (;;) {
        __syncthreads();
        if (tid == 0) *slot = (int)atomicAdd(ctr, 1u);
        __syncthreads();
        const int it = *slot;
        if (it >= 1024) break;
        if (MASK & 512) lru_item(p, l, it, smem, 1);
      }
    }
    xcd_barrier(xb);
    }
    for (int rep = 0; rep < REP_G; ++rep) {
    for (int half = 0; half < 2; ++half) {
      bf16_t* GH = (bf16_t*)(p.ws + OFF_P + 134217728);
      if (half == 0 && rep == 0) { if (MASK & 16) rwkv_post(p, l); __syncthreads(); }
      if (MASK & 1024) { pg::Order<1> S; S.init(NTOK / 2, 4096, gridDim.x, blockIdx.x); pg::EpiBf16<1> E{GH, 4096, p.in[I_BGATE] + (size_t)l * 4096};
        pg::gemm_phase(lds, H + (size_t)half * 32768 * DM, DM, (const bf16_t*)(p.ws + OFF_WG), 1024, S, E); }
      xcd_barrier(xb);
      if (MASK & 1024) { pg::Order<4> S; S.init(NTOK / 2, 1024, gridDim.x, blockIdx.x, 512, 524288); pg::EpiBranch E{PB + (size_t)half * 32768 * DM, GH};
        pg::gemm_phase(lds, (const bf16_t*)(p.ws + OFF_O) + (size_t)half * 32768 * DM, DM, (const bf16_t*)(p.ws + OFF_WBR), 256, S, E); }
      xcd_barrier(xb);
    }
    }
    if (MASK & 2048) { pg::Order<1> S; S.init(NTOK, 1024, gridDim.x, blockIdx.x); pg::EpiResid E{xcur, p.out, (const float*)(p.ws + OFF_MODP), p.in[I_BADA], l, 2048};
      pg::gemm_phase(lds, PB, DM, (const bf16_t*)(p.ws + OFF_WO), 1024, S, E); }
    xcd_barrier(xb);
    for (int rep = 0; rep < REP_MISC; ++rep) {
    if (MASK & 4096) phase_norm(p, p.out, p.in[I_N2G] + l * 1024, l, 4096, 3072, H, nullptr);
    xcd_barrier(xb);
    }
    for (int rep = 0; rep < REP_G; ++rep) {
    if (MASK & 8192) { pg::Order<1> S; S.init(NTOK, FFN, gridDim.x, blockIdx.x); pg::EpiBf16<0> E{PB, FFN, nullptr};
      pg::gemm_phase(lds, H, DM, (const bf16_t*)(p.ws + OFF_WF), 1024, S, E); }
    xcd_barrier(xb);
    if (MASK & 8192) { pg::Order<1> S; S.init(NTOK, FFN, gridDim.x, blockIdx.x); pg::EpiFfnAct E{PB + (size_t)NTOK * FFN, PB, p.in[I_FCW] + (size_t)l * 3 * FFN};
      pg::gemm_phase(lds, H, DM, (const bf16_t*)(p.ws + OFF_WF) + (size_t)FFN * 1024, 1024, S, E); }
    xcd_barrier(xb);
    }
    if (MASK & 32768) { pg::Order<1> S; S.init(NTOK, 1024, gridDim.x, blockIdx.x); pg::EpiResid E{p.out, p.out, (const float*)(p.ws + OFF_MODP), p.in[I_BADA], l, 5120};
      pg::gemm_phase(lds, PB + (size_t)NTOK * FFN, FFN, (const bf16_t*)(p.ws + OFF_WD), FFN, S, E); }
    xcd_barrier(xb);
  }
  if (MASK & 65536) phase_norm(p, p.out, p.in[I_FG], 0, 0, 0, nullptr, p.out);
}

extern "C" void kernel_launch(void* const* d_in, const int* in_sizes, int n_in,
                              void* d_out, int out_size, void* d_ws, size_t ws_size,
                              hipStream_t stream) {
  if (ws_size < WS_NEED || n_in < 38) { fprintf(stderr, "workspace too small: %zu < %zu\n", ws_size, (size_t)WS_NEED); return; }
  (void)hipFuncSetAttribute((const void*)mega, hipFuncAttributeMaxDynamicSharedMemorySize, SMEM_BYTES);
  int dev = 0, cus = 0, per_cu = 0;
  (void)hipGetDevice(&dev);
  (void)hipDeviceGetAttribute(&cus, hipDeviceAttributeMultiprocessorCount, dev);
  (void)hipOccupancyMaxActiveBlocksPerMultiprocessor(&per_cu, mega, NTHR, SMEM_BYTES);
  if (per_cu < 1 || cus < 1) { fprintf(stderr, "occupancy query failed (%d, %d)\n", per_cu, cus); return; }
  if (cus > 256) cus = 256;
  const int grid_blocks = cus;
  Params p{};
  for (int i = 0; i < 38; ++i) p.in[i] = (const float*)d_in[i];
  p.out = (float*)d_out; p.ws = (char*)d_ws;
  (void)hipMemsetAsync((char*)d_ws + OFF_BAR, 0, XCD_BAR_WORDS * 4, stream);
  void* args[] = {&p};
  hipError_t e = hipLaunchCooperativeKernel((void*)mega, dim3(grid_blocks), dim3(NTHR), args, SMEM_BYTES, stream);
  if (e != hipSuccess) fprintf(stderr, "cooperative launch failed: %s (grid %d)\n", hipGetErrorString(e), grid_blocks);
}
```

```cpp
#include <hip/hip_runtime.h>
#include <hip/hip_cooperative_groups.h>
#include <cstdio>
namespace cg = cooperative_groups;

typedef unsigned short bf16_t;
typedef short bf16x8 __attribute__((ext_vector_type(8)));
typedef short s16x4 __attribute__((ext_vector_type(4)));
typedef float f32x4 __attribute__((ext_vector_type(4)));
typedef float f32x16 __attribute__((ext_vector_type(16)));
typedef unsigned u32x4 __attribute__((ext_vector_type(4)));
#define DI __device__ __forceinline__

constexpr int NTOK = 65536, DM = 1024, SEQ = 4096, PSTR = 3328, FFN = 2816, AUS = 5632;
constexpr int C_LRU_X = 0, C_LRU_Y = 256, C_SB_Q = 512, C_SB_K = 768, C_SB_V = 1024;
constexpr int C_GDN_Q = 1280, C_GDN_Z = 2048, C_GDN_A = 2304, C_GDN_B = 2308, C_RW = 2312;
constexpr float EPSF = 1e-6f;
#ifndef MASK
#define MASK 0x1ffff
#endif
#ifndef REP_M1
#define REP_M1 1
#endif
#ifndef REP_M2
#define REP_M2 1
#endif
#ifndef REP_G
#define REP_G 1
#endif
#ifndef REP_MISC
#define REP_MISC 1
#endif
constexpr int NTHR = 512;
constexpr int SMEM_BYTES = 131072 + 64;

constexpr size_t OFF_MODP = 0;
constexpr size_t OFF_WIN = 6291456;
constexpr size_t OFF_WG = OFF_WIN + 6815744;
constexpr size_t OFF_WBR = OFF_WG + 8388608;
constexpr size_t OFF_WO = OFF_WBR + 2097152;
constexpr size_t OFF_WF = OFF_WO + 2097152;
constexpr size_t OFF_WD = OFF_WF + 11534336;
constexpr size_t OFF_H = OFF_WD + 5767168;
constexpr size_t OFF_P = OFF_H + 134217728;
constexpr size_t OFF_O = OFF_P + 436207616;
constexpr size_t OFF_G = OFF_O + 134217728;
constexpr size_t GSZ = 33554432;
constexpr size_t OFF_GCD = OFF_G + 5 * GSZ;
constexpr size_t OFF_L = OFF_GCD + 16384;
constexpr size_t LSZ = 67108864;
constexpr size_t OFF_LCA = OFF_L + 2 * LSZ;
constexpr size_t OFF_LCH = OFF_LCA + 2097152;
constexpr size_t OFF_BON = OFF_LCH + 2097152;
constexpr size_t OFF_CTR = OFF_BON + 1048576;
constexpr size_t OFF_BAR = OFF_CTR + 256;
constexpr size_t WS_NEED = OFF_BAR + 16384;

struct Params { const float* in[38]; float* out; char* ws; };
enum { I_X = 0, I_C, I_N1G, I_N2G, I_FG, I_WADA, I_BADA, I_WIN, I_LCW, I_LCB, I_LWR, I_LBR, I_LWI, I_LBI, I_LLAM,
       I_GCW, I_GAL, I_GDT, I_GNG, I_RMU, I_RW0, I_RWUP, I_RA0, I_RAUP, I_RGUP, I_RKK, I_RKA, I_RRK, I_RLG, I_RLB,
       I_WBR, I_WGATE, I_BGATE, I_WOUT, I_FWG, I_FWU, I_FCW, I_FWD };

DI float bf2f(bf16_t v) { return __uint_as_float(((unsigned)v) << 16); }
DI unsigned pack2(float lo, float hi) { unsigned r; asm("v_cvt_pk_bf16_f32 %0, %1, %2" : "=v"(r) : "v"(lo), "v"(hi)); return r; }
DI bf16_t f2bf(float x) { return (bf16_t)(pack2(x, x) & 0xffffu); }
DI float sigmoidf_(float x) { return 1.f / (1.f + __expf(-x)); }
DI float softplusf_(float x) { return fmaxf(x, 0.f) + __logf(1.f + __expf(-fabsf(x))); }
DI float siluf_(float x) { return x / (1.f + __expf(-x)); }
DI float geluf_(float x) { float u = 0.7978845608f * (x + 0.044715f * x * x * x); return x / (1.f + __expf(-2.f * u)); }
DI float tanhf_(float x) { return 1.f - 2.f / (1.f + __expf(2.f * x)); }
DI float wave_sum(float x) {
#pragma unroll
  for (int o = 32; o >= 1; o >>= 1) x += __shfl_xor(x, o);
  return x;
}
template <int CTRL> DI float dppf(float x) { return __int_as_float(__builtin_amdgcn_update_dpp(0, __float_as_int(x), CTRL, 0xf, 0xf, true)); }
DI float reduce8(float x) { x += dppf<0xB1>(x); x += dppf<0x4E>(x); x += dppf<0x141>(x); return x; }
DI f32x16 mfma32(bf16x8 a, bf16x8 b, f32x16 c) { return __builtin_amdgcn_mfma_f32_32x32x16_bf16(a, b, c, 0, 0, 0); }
DI f32x4 mfma16(bf16x8 a, bf16x8 b, f32x4 c) { return __builtin_amdgcn_mfma_f32_16x16x32_bf16(a, b, c, 0, 0, 0); }
DI int crow(int i, int h) { return (i & 3) + 8 * (i >> 2) + 4 * h; }

DI float modv(const float* modp, const float* bada, int l, int b, int idx) {
  const float* q = modp + ((size_t)(l * 16 + b)) * 6144 + idx;
  const size_t ks = (size_t)4 * 16 * 6144;
  return bada[l * 6144 + idx] + q[0] + q[ks] + q[2 * ks] + q[3 * ks];
}

DI int otid() { int t = threadIdx.x; asm volatile("" : "+v"(t)); return t; }
DI int obid() { int b = blockIdx.x; asm volatile("" : "+s"(b)); return b; }
DI void phase_mod(const Params& p, char* smem) {
  float* sm = (float*)smem;
  float* modp = (float*)(p.ws + OFF_MODP);
  const int tid = otid();
  if (obid() == 0 && tid < 64) ((unsigned*)(p.ws + OFF_CTR))[tid] = 0u;
  for (int item = obid(); item < 192; item += gridDim.x) {
    const int l = item / 48, rem = item % 48, jb = rem >> 2, kq = rem & 3;
    for (int i = 0; i < 8; ++i) {
      int e = tid + 512 * i; int b = e >> 8, k = e & 255;
      float cv = p.in[I_C][b * 1024 + kq * 256 + k];
      sm[e] = siluf_(cv);
    }
    __syncthreads();
    float acc[16];
#pragma unroll
    for (int b = 0; b < 16; ++b) acc[b] = 0.f;
    const float* wp = p.in[I_WADA] + ((size_t)l * 1024 + kq * 256) * 6144 + jb * 512 + tid;
    for (int k = 0; k < 256; k += 4) {
      float w0 = wp[(size_t)k * 6144], w1 = wp[(size_t)(k + 1) * 6144], w2 = wp[(size_t)(k + 2) * 6144], w3 = wp[(size_t)(k + 3) * 6144];
#pragma unroll
      for (int b = 0; b < 16; ++b) {
        f32x4 cv = *(const f32x4*)(sm + b * 256 + k);
        acc[b] += cv[0] * w0 + cv[1] * w1 + cv[2] * w2 + cv[3] * w3;
      }
    }
#pragma unroll
    for (int b = 0; b < 16; ++b) modp[((size_t)((kq * 4 + l) * 16 + b)) * 6144 + jb * 512 + tid] = acc[b];
    __syncthreads();
  }
}

DI void conv_tile(const float* src, bf16_t* dst, int K, int N, int k0, int n0, char* smem) {
  float* tile = (float*)smem;
  const int tid = otid();
#pragma unroll
  for (int it = 0; it < 2; ++it) {
    int kr = (tid >> 4) + 32 * it, nc = (tid & 15) * 4;
    f32x4 v = {0.f, 0.f, 0.f, 0.f};
    if (n0 + nc < N) v = *(const f32x4*)(src + (size_t)(k0 + kr) * N + n0 + nc);
    tile[kr * 65 + nc] = v[0]; tile[kr * 65 + nc + 1] = v[1]; tile[kr * 65 + nc + 2] = v[2]; tile[kr * 65 + nc + 3] = v[3];
  }
  __syncthreads();
  {
    int n = tid >> 3, kc = (tid & 7) * 8;
    unsigned o[4];
#pragma unroll
    for (int e = 0; e < 4; ++e) o[e] = pack2(tile[(kc + 2 * e) * 65 + n], tile[(kc + 2 * e + 1) * 65 + n]);
    uint4 ov = {o[0], o[1], o[2], o[3]};
    *(uint4*)(dst + (size_t)(n0 + n) * K + k0 + kc) = ov;
  }
  __syncthreads();
}

DI void phase_convert(const Params& p, int l, char* smem) {
  for (int t = obid(); t < 4480; t += gridDim.x) {
    const float* src; bf16_t* dst; int K, N, Npad, tt = t;
    if (tt < 832) { src = p.in[I_WIN] + (size_t)l * 1024 * 3208; dst = (bf16_t*)(p.ws + OFF_WIN); K = 1024; N = 3208; Npad = 3328; }
    else if ((tt -= 832) < 1024) { int br = tt >> 8; tt &= 255; src = p.in[I_WGATE] + ((size_t)l * 4 + br) * 1048576; dst = (bf16_t*)(p.ws + OFF_WG) + (size_t)br * 1048576; K = 1024; N = 1024; Npad = 1024; }
    else if ((tt -= 1024) < 256) { int br = tt >> 6; tt &= 63; src = p.in[I_WBR] + ((size_t)l * 4 + br) * 262144; dst = (bf16_t*)(p.ws + OFF_WBR) + (size_t)br * 262144; K = 256; N = 1024; Npad = 1024; }
    else if ((tt -= 256) < 256) { src = p.in[I_WOUT] + (size_t)l * 1048576; dst = (bf16_t*)(p.ws + OFF_WO); K = 1024; N = 1024; Npad = 1024; }
    else if ((tt -= 256) < 704) { src = p.in[I_FWG] + (size_t)l * 1024 * 2816; dst = (bf16_t*)(p.ws + OFF_WF); K = 1024; N = 2816; Npad = 2816; }
    else if ((tt -= 704) < 704) { src = p.in[I_FWU] + (size_t)l * 1024 * 2816; dst = (bf16_t*)(p.ws + OFF_WF) + (size_t)2816 * 1024; K = 1024; N = 2816; Npad = 2816; }
    else { tt -= 704; src = p.in[I_FWD] + (size_t)l * 2816 * 1024; dst = (bf16_t*)(p.ws + OFF_WD); K = 2816; N = 1024; Npad = 1024; }
    const int nNt = Npad >> 6;
    const int kt = tt / nNt, nt = tt % nNt;
    conv_tile(src, dst, K, N, kt * 64, nt * 64, smem);
  }
}

DI void phase_norm(const Params& p, const float* xin, const float* g, int l, int scale_idx, int shift_idx, bf16_t* hout, float* fout) {
  const float* modp = (const float*)(p.ws + OFF_MODP);
  const int lane = otid() & 63, wv = otid() >> 6;
  const int nw = gridDim.x * 8;
  const int rows_per = 32;
  for (int chunk = obid() * 8 + wv; chunk < NTOK / 32; chunk += nw) {
  const int row0 = chunk * rows_per;
  const int b = row0 / SEQ;
  f32x4 gv[4], sc[4], sh[4];
#pragma unroll
  for (int j = 0; j < 4; ++j) {
    int c = lane * 4 + 256 * j;
    gv[j] = *(const f32x4*)(g + c);
    if (hout) {
#pragma unroll
      for (int e = 0; e < 4; ++e) {
        sc[j][e] = 1.f + modv(modp, p.in[I_BADA], l, b, scale_idx + c + e);
        sh[j][e] = modv(modp, p.in[I_BADA], l, b, shift_idx + c + e);
      }
    }
  }
  for (int rr = 0; rr < rows_per; ++rr) {
    const size_t row = (size_t)row0 + rr;
    f32x4 xv[4]; float ss = 0.f;
#pragma unroll
    for (int j = 0; j < 4; ++j) {
      xv[j] = *(const f32x4*)(xin + row * DM + lane * 4 + 256 * j);
      ss += xv[j][0] * xv[j][0] + xv[j][1] * xv[j][1] + xv[j][2] * xv[j][2] + xv[j][3] * xv[j][3];
    }
    ss = wave_sum(ss);
    const float rs = rsqrtf(ss * (1.f / 1024.f) + EPSF);
#pragma unroll
    for (int j = 0; j < 4; ++j) {
      f32x4 y = xv[j] * rs * gv[j];
      if (hout) {
        y = y * sc[j] + sh[j];
        uint2 o = {pack2(y[0], y[1]), pack2(y[2], y[3])};
        *(uint2*)(hout + row * DM + lane * 4 + 256 * j) = o;
      } else {
        *(f32x4*)(fout + row * DM + lane * 4 + 256 * j) = y;
      }
    }
  }
  }
}

#define PG_LAS __attribute__((address_space(3)))
namespace pg {
constexpr int BM = 256, BK = 64, HALF = 128, HTB = HALF * BK * 2, NXCD = 8, WGM = 8;
DI int lds_byte(int r, int c) { const int st = (r >> 4) * 2 + (c >> 5), rr = r & 15, cc = c & 31, ob = rr * 64 + cc * 2; return st * 1024 + (ob ^ (((ob >> 9) & 1) << 5)); }
DI void stage_rc(int b, int& R, int& C) { const int st = b / 1024, sb = b % 1024, swz = sb ^ (((sb >> 9) & 1) << 5); R = (st >> 1) * 16 + swz / 64; C = (st & 1) * 32 + (swz % 64) / 2; }
DI int perm32(int rho) { const int n = rho >> 4, i = rho & 15; return 8 * (i >> 2) + 4 * n + (i & 3); }
struct Unit { int pm, pn; int aux; long ao, bo; };
template <int REP> struct Order {
  int nM, nN, nwg, G, c, ashift; long astep, bstep, apnstep;
  DI void init(int M, int N, int G_, int c_, long astep_ = 0, long bstep_ = 0, int ashift_ = 0, long apnstep_ = 0) {
    nM = M / BM; nN = N / BM; nwg = nM * nN; G = G_; c = c_; astep = astep_; bstep = bstep_; ashift = ashift_; apnstep = apnstep_; }
  DI bool next(int i, Unit& u) const {
    const int ti = i / REP, aux = i % REP;
    const long L = (long)ti * G + c; if (L >= nwg) return false;
    int wgid = (int)L; { const int q = nwg / NXCD, r = nwg % NXCD, xcd = wgid % NXCD, off = wgid / NXCD; wgid = (xcd < r ? xcd * (q + 1) : r * (q + 1) + (xcd - r) * q) + off; }
    const int nig = WGM * nN, gid = wgid / nig, fm = gid * WGM, gsz = (nM - fm) < WGM ? (nM - fm) : WGM;
    u.pm = fm + ((wgid % nig) % gsz); u.pn = (wgid % nig) / gsz; u.aux = aux; u.ao = aux * astep + (long)(u.pn >> ashift) * apnstep; u.bo = aux * bstep; return true;
  }
};
DI unsigned cvt_pk_bf16(float lo, float hi) { unsigned r; asm volatile("v_cvt_pk_bf16_f32 %0, %1, %2" : "=v"(r) : "v"(lo), "v"(hi)); return r; }

template <class Epi, class Sched>
DI void gemm_phase(PG_LAS unsigned char* lds, const bf16_t* Ag, int lda, const bf16_t* Bg, int K, const Sched& S, const Epi& E) {
  const int tid = otid(), wid = __builtin_amdgcn_readfirstlane(tid >> 6), lane = tid & 63, wr = wid >> 2, wc = wid & 3, fr = lane & 15, fq = lane >> 4;
  const int nt = K / BK;
  unsigned voffA[2], voffB[2];
#pragma unroll
  for (int i = 0; i < 2; ++i) { int R, C; stage_rc(tid * 16 + i * 8192, R, C); const int Rb = Epi::PERM ? ((R & ~31) + perm32(R & 31)) : R;
    voffA[i] = (unsigned)(R * lda + C) * 2u; voffB[i] = (unsigned)(Rb * K + C) * 2u; }
  const size_t kstep = (size_t)(BK * 2);
  const size_t hstepA = (size_t)HALF * lda * 2, hstepB = (size_t)HALF * K * 2;
  const size_t tstepA = 2 * hstepA, tstepB = 2 * hstepB;
  const unsigned ldsw = (unsigned)wid * 1024u;
  const int aoff = lds_byte(wr * 64 + fr, fq * 8), boff = lds_byte(wc * 32 + fr, fq * 8);
#define PG_SA(b, h) (((b) * 2 + (h)) * HTB)
#define PG_SB(b, h) ((4 + (b) * 2 + (h)) * HTB)
#define PG_STAGE(bufoff, gbase, voff) do { _Pragma("unroll") for (int _i = 0; _i < 2; ++_i) \
    __builtin_amdgcn_global_load_lds((const unsigned*)((const char*)(gbase) + (voff)[_i]), (PG_LAS unsigned*)(lds + (bufoff) + ldsw + _i * 8192), 16, 0, 0); } while (0)
#define PG_LDA(dst, b, h) do { _Pragma("unroll") for (int m = 0; m < 4; ++m) _Pragma("unroll") for (int k = 0; k < 2; ++k) dst[m][k] = *(const PG_LAS bf16x8*)(lds + PG_SA(b, h) + aoff + m * 2048 + k * 1024); } while (0)
#define PG_LDB(dst, b, h) do { _Pragma("unroll") for (int n = 0; n < 2; ++n) _Pragma("unroll") for (int k = 0; k < 2; ++k) dst[n][k] = *(const PG_LAS bf16x8*)(lds + PG_SB(b, h) + boff + n * 2048 + k * 1024); } while (0)
#define PG_MMA(ai, bj, At, Bt) do { __builtin_amdgcn_s_setprio(1); _Pragma("unroll") for (int m = 0; m < 4; ++m) _Pragma("unroll") for (int n = 0; n < 2; ++n) _Pragma("unroll") for (int k = 0; k < 2; ++k) \
    acc[ai][bj][m][n] = __builtin_amdgcn_mfma_f32_16x16x32_bf16(Bt[n][k], At[m][k], acc[ai][bj][m][n], 0, 0, 0); __builtin_amdgcn_s_setprio(0); } while (0)
#define PG_WAIT_V(n) asm volatile("s_waitcnt vmcnt(" #n ")" ::: "memory")
#define PG_WAIT_L(n) asm volatile("s_waitcnt lgkmcnt(" #n ")" ::: "memory")
#define PG_BAR __builtin_amdgcn_s_barrier()
#define PG_SCHED __builtin_amdgcn_sched_barrier(0)
  Unit cur, nxt; int ui = 0;
  if (!S.next(0, cur)) return;
  f32x4 acc[2][2][4][2];
#pragma unroll
  for (int a = 0; a < 2; ++a)
#pragma unroll
    for (int b = 0; b < 2; ++b)
#pragma unroll
      for (int m = 0; m < 4; ++m)
#pragma unroll
        for (int n = 0; n < 2; ++n) acc[a][b][m][n] = (f32x4){0.f, 0.f, 0.f, 0.f};
  bf16x8 At[4][2], B0[2][2], B1[2][2];
  const char* cA = (const char*)Ag + (size_t)cur.pm * tstepA + cur.ao; const char* cB = (const char*)Bg + (size_t)cur.pn * tstepB + cur.bo;
  PG_STAGE(PG_SB(0, 0), cB, voffB); PG_STAGE(PG_SA(0, 0), cA, voffA); PG_STAGE(PG_SB(0, 1), cB + hstepB, voffB); PG_STAGE(PG_SA(0, 1), cA + hstepA, voffA);
  if (wr == 1) PG_BAR;
  PG_WAIT_V(4); PG_BAR;
  PG_STAGE(PG_SB(1, 0), cB + kstep, voffB); PG_STAGE(PG_SA(1, 0), cA + kstep, voffA); PG_STAGE(PG_SB(1, 1), cB + hstepB + kstep, voffB);
  PG_WAIT_V(6); PG_BAR;
  for (;;) {
    const bool has_next = S.next(ui + 1, nxt);
    const char* nA = has_next ? (const char*)Ag + (size_t)nxt.pm * tstepA + nxt.ao : cA; const char* nB = has_next ? (const char*)Bg + (size_t)nxt.pn * tstepB + nxt.bo : cB;
#pragma unroll 1
    for (int t = 0; t < nt; t += 2) {
      const bool last = (t == nt - 2);
      const char* a1 = cA + (size_t)(t + 1) * kstep;
      const char* a2 = last ? nA : cA + (size_t)(t + 2) * kstep; const char* b2 = last ? nB : cB + (size_t)(t + 2) * kstep;
      const char* a3 = a2 + kstep; const char* b3 = b2 + kstep;
      PG_LDB(B0, 0, 0); PG_SCHED; PG_LDA(At, 0, 0); PG_STAGE(PG_SA(1, 1), a1 + hstepA, voffA);
      PG_WAIT_L(8); PG_BAR; PG_WAIT_L(0); PG_MMA(0, 0, At, B0); PG_BAR; PG_SCHED;
      PG_LDB(B1, 0, 1); PG_STAGE(PG_SB(0, 0), b2, voffB);
      PG_BAR; PG_WAIT_L(0); PG_MMA(0, 1, At, B1); PG_BAR;
      PG_LDA(At, 0, 1); PG_STAGE(PG_SA(0, 0), a2, voffA);
      PG_BAR; PG_WAIT_L(0); PG_MMA(1, 0, At, B0); PG_BAR; PG_SCHED;
      PG_STAGE(PG_SB(0, 1), b2 + hstepB, voffB);
      PG_WAIT_V(6); PG_BAR; PG_MMA(1, 1, At, B1); PG_BAR;
      PG_LDB(B0, 1, 0); PG_SCHED; PG_LDA(At, 1, 0); PG_STAGE(PG_SA(0, 1), a2 + hstepA, voffA);
      PG_WAIT_L(8); PG_BAR; PG_WAIT_L(0); PG_MMA(0, 0, At, B0); PG_BAR; PG_SCHED;
      PG_LDB(B1, 1, 1); PG_STAGE(PG_SB(1, 0), b3, voffB);
      PG_BAR; PG_WAIT_L(0); PG_MMA(0, 1, At, B1); PG_BAR;
      PG_LDA(At, 1, 1); PG_STAGE(PG_SA(1, 0), a3, voffA);
      PG_BAR; PG_WAIT_L(0); PG_MMA(1, 0, At, B0); PG_BAR; PG_SCHED;
      PG_STAGE(PG_SB(1, 1), b3 + hstepB, voffB);
      PG_WAIT_V(6); PG_BAR; PG_MMA(1, 1, At, B1); PG_BAR;
    }
    E(acc, cur, wr, wc, fr, fq);
    if (!has_next) break;
#pragma unroll
    for (int a = 0; a < 2; ++a)
#pragma unroll
      for (int b = 0; b < 2; ++b)
#pragma unroll
        for (int m = 0; m < 4; ++m)
#pragma unroll
          for (int n = 0; n < 2; ++n) acc[a][b][m][n] = (f32x4){0.f, 0.f, 0.f, 0.f};
    cur = nxt; cA = nA; cB = nB; ++ui;
  }
  PG_WAIT_V(0);
  if (wr == 0) PG_BAR;
  PG_BAR;
#undef PG_SA
#undef PG_SB
#undef PG_STAGE
#undef PG_LDA
#undef PG_LDB
#undef PG_MMA
#undef PG_WAIT_V
#undef PG_WAIT_L
#undef PG_BAR
#undef PG_SCHED
}

template <int ACT> struct EpiBf16 {
  static constexpr bool PERM = true;
  bf16_t* O; int ldc; const float* bias;
  DI void operator()(const f32x4 (&acc)[2][2][4][2], const Unit& u, int wr, int wc, int fr, int fq) const {
    const int row0 = u.pm * BM + wr * 64 + fr, col0 = u.pn * BM + wc * 32 + 8 * fq;
    f32x4 bv[2][2];
#pragma unroll
    for (int bj = 0; bj < 2; ++bj)
#pragma unroll
      for (int n = 0; n < 2; ++n) bv[bj][n] = ACT ? *(const f32x4*)(bias + col0 + bj * HALF + 4 * n) : (f32x4){0.f, 0.f, 0.f, 0.f};
#pragma unroll
    for (int ai = 0; ai < 2; ++ai)
#pragma unroll
      for (int m = 0; m < 4; ++m) { bf16_t* rowp = O + (size_t)(row0 + ai * HALF + m * 16) * ldc + col0;
#pragma unroll
        for (int bj = 0; bj < 2; ++bj) { f32x4 v0 = acc[ai][bj][m][0] + bv[bj][0], v1 = acc[ai][bj][m][1] + bv[bj][1];
          if (ACT) {
#pragma unroll
            for (int j = 0; j < 4; ++j) { v0[j] = sigmoidf_(v0[j]); v1[j] = sigmoidf_(v1[j]); } }
          u32x4 w; w.x = cvt_pk_bf16(v0[0], v0[1]); w.y = cvt_pk_bf16(v0[2], v0[3]); w.z = cvt_pk_bf16(v1[0], v1[1]); w.w = cvt_pk_bf16(v1[2], v1[3]);
          *(u32x4*)(rowp + bj * HALF) = w; } }
  }
};
struct EpiBranch {
  static constexpr bool PERM = true;
  bf16_t* MIX; const bf16_t* G;
  DI void operator()(const f32x4 (&acc)[2][2][4][2], const Unit& u, int wr, int wc, int fr, int fq) const {
    const int row0 = u.pm * BM + wr * 64 + fr, col0 = u.pn * BM + wc * 32 + 8 * fq;
#pragma unroll
    for (int ai = 0; ai < 2; ++ai)
#pragma unroll
      for (int m = 0; m < 4; ++m) {
        asm volatile("" ::: "memory");
        const size_t row = (size_t)(row0 + ai * HALF + m * 16);
        bf16_t* mp = MIX + row * DM + col0; const bf16_t* gp = G + row * 4096 + u.aux * 1024 + col0;
#pragma unroll
        for (int bj = 0; bj < 2; ++bj) {
          const bf16x8 gv = *(const bf16x8*)(gp + bj * HALF);
          float o[8];
#pragma unroll
          for (int j = 0; j < 4; ++j) { o[j] = bf2f((bf16_t)gv[j]) * acc[ai][bj][m][0][j]; o[4 + j] = bf2f((bf16_t)gv[4 + j]) * acc[ai][bj][m][1][j]; }
          if (u.aux > 0) {
            const bf16x8 mv = *(const bf16x8*)(mp + bj * HALF);
#pragma unroll
            for (int j = 0; j < 8; ++j) o[j] += bf2f((bf16_t)mv[j]);
          }
          u32x4 w; w.x = cvt_pk_bf16(o[0], o[1]); w.y = cvt_pk_bf16(o[2], o[3]); w.z = cvt_pk_bf16(o[4], o[5]); w.w = cvt_pk_bf16(o[6], o[7]);
          *(u32x4*)(mp + bj * HALF) = w;
        }
      }
  }
};
struct EpiResid {
  static constexpr bool PERM = false;
  const float* xold; float* xnew; const float* modp; const float* bada; int l, gate_idx;
  DI void operator()(const f32x4 (&acc)[2][2][4][2], const Unit& u, int wr, int wc, int fr, int fq) const {
    const int row0 = u.pm * BM + wr * 64 + fr, col0 = u.pn * BM + wc * 32 + 4 * fq;
    const int b = (u.pm * BM) / SEQ;
    f32x4 gv[2][2];
#pragma unroll
    for (int bj = 0; bj < 2; ++bj)
#pragma unroll
      for (int n = 0; n < 2; ++n)
#pragma unroll
        for (int j = 0; j < 4; ++j) gv[bj][n][j] = modv(modp, bada, l, b, gate_idx + col0 + bj * HALF + n * 16 + j);
#pragma unroll
    for (int ai = 0; ai < 2; ++ai)
#pragma unroll
      for (int m = 0; m < 4; ++m) { const size_t ro = (size_t)(row0 + ai * HALF + m * 16) * DM + col0;
#pragma unroll
        for (int bj = 0; bj < 2; ++bj)
#pragma unroll
          for (int n = 0; n < 2; ++n) {
            const f32x4 xo = *(const f32x4*)(xold + ro + bj * HALF + n * 16);
            *(f32x4*)(xnew + ro + bj * HALF + n * 16) = xo + gv[bj][n] * acc[ai][bj][m][n];
          } }
  }
};
struct EpiFfnAct {
  static constexpr bool PERM = true;
  bf16_t* ACT; const bf16_t* APRE; const float* cw;
  DI void operator()(const f32x4 (&acc)[2][2][4][2], const Unit& u, int wr, int wc, int fr, int fq) const {
    const int row0 = u.pm * BM + wr * 64 + fr, col0 = u.pn * BM + wc * 32 + 8 * fq;
#pragma unroll
    for (int ai = 0; ai < 2; ++ai)
#pragma unroll
      for (int m = 0; m < 4; ++m) {
        asm volatile("" ::: "memory");
        const int row = row0 + ai * HALF + m * 16; const int sp = row & (SEQ - 1);
        const bf16_t* ap = APRE + (size_t)row * FFN + col0;
        bf16_t* op = ACT + (size_t)row * FFN + col0;
#pragma unroll
        for (int bj = 0; bj < 2; ++bj) {
          const int c = bj * HALF;
          const bf16x8 z8 = {0, 0, 0, 0, 0, 0, 0, 0};
          const bf16x8 a0 = *(const bf16x8*)(ap + c);
          const bf16x8 a1 = sp >= 1 ? *(const bf16x8*)(ap - FFN + c) : z8;
          const bf16x8 a2 = sp >= 2 ? *(const bf16x8*)(ap - 2 * FFN + c) : z8;
          float o[8];
#pragma unroll
          for (int hh = 0; hh < 2; ++hh) {
            const f32x4 w0 = *(const f32x4*)(cw + col0 + c + 4 * hh), w1 = *(const f32x4*)(cw + FFN + col0 + c + 4 * hh), w2 = *(const f32x4*)(cw + 2 * FFN + col0 + c + 4 * hh);
#pragma unroll
            for (int j = 0; j < 4; ++j) {
              const float cv = w0[j] * bf2f((bf16_t)a2[4 * hh + j]) + w1[j] * bf2f((bf16_t)a1[4 * hh + j]) + w2[j] * bf2f((bf16_t)a0[4 * hh + j]);
              o[4 * hh + j] = geluf_(cv) * acc[ai][bj][m][hh][j];
            }
          }
          u32x4 w; w.x = cvt_pk_bf16(o[0], o[1]); w.y = cvt_pk_bf16(o[2], o[3]); w.z = cvt_pk_bf16(o[4], o[5]); w.w = cvt_pk_bf16(o[6], o[7]);
          *(u32x4*)(op + c) = w;
        }
      }
  }
};
struct EpiGateMix {
  static constexpr bool PERM = true;
  bf16_t* MIX; float* MIX32; const bf16_t* BH; const float* bias;
  DI void operator()(const f32x4 (&acc)[2][2][4][2], const Unit& u, int wr, int wc, int fr, int fq) const {
    const int row0 = u.pm * BM + wr * 64 + fr, col0 = u.pn * BM + wc * 32 + 8 * fq;
    const bool rmw = u.aux > 0, fin = u.aux == 3;
    f32x4 bv[2][2];
#pragma unroll
    for (int bj = 0; bj < 2; ++bj)
#pragma unroll
      for (int n = 0; n < 2; ++n) bv[bj][n] = *(const f32x4*)(bias + u.aux * 1024 + col0 + bj * HALF + 4 * n);
    const f32x4 z4 = {0.f, 0.f, 0.f, 0.f};
    bf16x8 nb[2]; f32x4 nm[2][2];
#define GM_LOAD(it_) { const size_t row_ = (size_t)(row0 + ((it_) >> 2) * HALF + ((it_) & 3) * 16); \
      _Pragma("unroll") for (int bj = 0; bj < 2; ++bj) { nb[bj] = *(const bf16x8*)(BH + row_ * 4096 + u.aux * 1024 + col0 + bj * HALF); \
        nm[bj][0] = rmw ? *(const f32x4*)(MIX32 + row_ * DM + col0 + bj * HALF) : z4; nm[bj][1] = rmw ? *(const f32x4*)(MIX32 + row_ * DM + col0 + bj * HALF + 4) : z4; } }
    GM_LOAD(0);
#pragma unroll
    for (int it = 0; it < 8; ++it) {
      const int ai = it >> 2, m = it & 3;
      bf16x8 cb[2]; f32x4 cm[2][2];
#pragma unroll
      for (int bj = 0; bj < 2; ++bj) { cb[bj] = nb[bj]; cm[bj][0] = nm[bj][0]; cm[bj][1] = nm[bj][1]; }
      if (it + 1 < 8) GM_LOAD(it + 1);
      const size_t ro = (size_t)(row0 + ai * HALF + m * 16) * DM + col0;
#pragma unroll
      for (int bj = 0; bj < 2; ++bj) {
        f32x4 o[2];
#pragma unroll
        for (int hh = 0; hh < 2; ++hh)
#pragma unroll
          for (int j = 0; j < 4; ++j)
            o[hh][j] = sigmoidf_(acc[ai][bj][m][hh][j] + bv[bj][hh][j]) * bf2f((bf16_t)cb[bj][4 * hh + j]) + cm[bj][hh][j];
        if (fin) {
          u32x4 w; w.x = cvt_pk_bf16(o[0][0], o[0][1]); w.y = cvt_pk_bf16(o[0][2], o[0][3]); w.z = cvt_pk_bf16(o[1][0], o[1][1]); w.w = cvt_pk_bf16(o[1][2], o[1][3]);
          *(u32x4*)(MIX + ro + bj * HALF) = w;
        } else {
          *(f32x4*)(MIX32 + ro + bj * HALF) = o[0]; *(f32x4*)(MIX32 + ro + bj * HALF + 4) = o[1];
        }
      }
    }
#undef GM_LOAD
  }
};
}

DI void phase_ffn_act(const Params& p, int l) {
  bf16_t* AU = (bf16_t*)(p.ws + OFF_P);
  const float* cw = p.in[I_FCW] + (size_t)l * 3 * FFN;
  const int nthr = gridDim.x * NTHR;
  for (int run = obid() * NTHR + otid(); run < 1024 * 352; run += nthr) {
    const int ch = run / 352, j8 = run % 352, j0 = j8 * 8;
    float w0[8], w1[8], w2[8];
#pragma unroll
    for (int e = 0; e < 8; ++e) { w0[e] = cw[j0 + e]; w1[e] = cw[FFN + j0 + e]; w2[e] = cw[2 * FFN + j0 + e]; }
    const int t0 = ch * 64, s0 = t0 % SEQ;
    float a1[8], a2[8];
#pragma unroll
    for (int e = 0; e < 8; ++e) { a1[e] = 0.f; a2[e] = 0.f; }
    if (s0 > 0) {
      bf16x8 v1 = *(const bf16x8*)(AU + (size_t)(t0 - 1) * AUS + j0);
      bf16x8 v2 = *(const bf16x8*)(AU + (size_t)(t0 - 2) * AUS + j0);
#pragma unroll
      for (int e = 0; e < 8; ++e) { a1[e] = bf2f((bf16_t)v1[e]); a2[e] = bf2f((bf16_t)v2[e]); }
    }
    for (int t = t0; t < t0 + 64; ++t) {
      bf16x8 va = *(const bf16x8*)(AU + (size_t)t * AUS + j0);
      bf16x8 vu = *(const bf16x8*)(AU + (size_t)t * AUS + FFN + j0);
      float o[8];
#pragma unroll
      for (int e = 0; e < 8; ++e) {
        float a0 = bf2f((bf16_t)va[e]);
        float cv = w0[e] * a2[e] + w1[e] * a1[e] + w2[e] * a0;
        o[e] = geluf_(cv) * bf2f((bf16_t)vu[e]);
        a2[e] = a1[e]; a1[e] = a0;
      }
      uint4 ov = {pack2(o[0], o[1]), pack2(o[2], o[3]), pack2(o[4], o[5]), pack2(o[6], o[7])};
      *(uint4*)(AU + (size_t)t * AUS + FFN + j0) = ov;
    }
  }
}

DI float mixf(bf16_t cur, bf16_t prev, float mu) { const float c = bf2f(cur); return c + (bf2f(prev) - c) * mu; }
DI void rw_prep_item(const Params& p, int l, int item, char* smem) {
  const bf16_t* P = (const bf16_t*)(p.ws + OFF_P);
  bf16_t* RD = (bf16_t*)(p.ws + OFF_L);
  bf16_t* RKK = (bf16_t*)(p.ws + OFF_L + GSZ);
  bf16_t* RA = (bf16_t*)(p.ws + OFF_L + 2 * GSZ);
  bf16_t* RG = (bf16_t*)(p.ws + OFF_L + 3 * GSZ);
  float* BON = (float*)(p.ws + OFF_BON);
  const int b = item >> 6, ct = item & 63;
  const int tid = otid(), lane = tid & 63, wv = tid >> 6, hd = wv & 3, tp = wv >> 2;
  float* st = (float*)smem + wv * 128;
  const int hc = hd * 64 + lane;
  const float* mu = p.in[I_RMU] + (size_t)l * 896;
  float wup[32], aup[32], gup[64];
  {
    const float* wp = p.in[I_RWUP] + (size_t)l * 32 * 256 + hc;
    const float* ap = p.in[I_RAUP] + (size_t)l * 32 * 256 + hc;
    const float* gp = p.in[I_RGUP] + (size_t)l * 64 * 256 + hc;
    asm volatile("" : "+v"(wp), "+v"(ap), "+v"(gp));
#pragma unroll
    for (int j = 0; j < 32; ++j) { wup[j] = wp[j * 256]; aup[j] = ap[j * 256]; }
#pragma unroll
    for (int j = 0; j < 64; ++j) gup[j] = gp[j * 256];
  }
  const float w0c = p.in[I_RW0][l * 256 + hc], a0c = p.in[I_RA0][l * 256 + hc], kkc = p.in[I_RKK][l * 256 + hc],
              kac = p.in[I_RKA][l * 256 + hc], rkc = p.in[I_RRK][l * 256 + hc];
  const float mu_r = mu[hc], mu_k = mu[256 + hc], mu_1 = mu[768 + lane], mu_2 = mu[832 + lane];
  const size_t tok0 = (size_t)b * SEQ + ct * 64 + tp;
  bf16_t nx[8];
#define RWLOAD(i_)                                                                         \
  {                                                                                        \
    const bf16_t* pr_ = P + (tok0 + 2 * (i_)) * PSTR + C_RW;                               \
    nx[0] = pr_[hc]; nx[1] = pr_[256 + hc]; nx[2] = pr_[768 + lane]; nx[3] = pr_[832 + lane]; \
    if (ct * 64 + tp + 2 * (i_) > 0) {                                                     \
      const bf16_t* pp_ = pr_ - PSTR;                                                      \
      nx[4] = pp_[hc]; nx[5] = pp_[256 + hc]; nx[6] = pp_[768 + lane]; nx[7] = pp_[832 + lane]; \
    } else { nx[4] = 0; nx[5] = 0; nx[6] = 0; nx[7] = 0; }                                 \
  }
  RWLOAD(0);
#pragma unroll 1
  for (int i = 0; i < 32; ++i) {
    bf16_t cu[8];
#pragma unroll
    for (int e = 0; e < 8; ++e) cu[e] = nx[e];
    if (i + 1 < 32) RWLOAD(i + 1);
    const float r = mixf(cu[0], cu[4], mu_r), k = mixf(cu[1], cu[5], mu_k), m1 = mixf(cu[2], cu[6], mu_1), m2 = mixf(cu[3], cu[7], mu_2);
    __builtin_amdgcn_wave_barrier();
    st[lane] = lane < 32 ? tanhf_(m1) : m1;
    st[64 + lane] = sigmoidf_(m2);
    __builtin_amdgcn_wave_barrier();
    float wl = w0c, al = a0c, gt = 0.f;
#pragma unroll
    for (int j4 = 0; j4 < 8; ++j4) {
      const f32x4 tx = *(const f32x4*)(st + 4 * j4), xa = *(const f32x4*)(st + 32 + 4 * j4);
#pragma unroll
      for (int e = 0; e < 4; ++e) { wl += tx[e] * wup[4 * j4 + e]; al += xa[e] * aup[4 * j4 + e]; }
    }
#pragma unroll
    for (int j4 = 0; j4 < 16; ++j4) {
      const f32x4 sg = *(const f32x4*)(st + 64 + 4 * j4);
#pragma unroll
      for (int e = 0; e < 4; ++e) gt += sg[e] * gup[4 * j4 + e];
    }
    const float wlog = -softplusf_(-wl) - 0.5f;
    const float ee = __expf(wlog);
    const float dd = 1.f - __expf(-ee);
    const float a = sigmoidf_(al);
    const float kkr = k * kkc;
    const float kp = k * (1.f + (a - 1.f) * kac);
    const float ss = wave_sum(kkr * kkr);
    const float kk = kkr * rsqrtf(ss + EPSF);
    const float bn = wave_sum(r * kp * rkc);
    const size_t tok = tok0 + 2 * i;
    RD[tok * 256 + hc] = f2bf(dd); RKK[tok * 256 + hc] = f2bf(kk); RA[tok * 256 + hc] = f2bf(a); RG[tok * 256 + hc] = f2bf(gt);
    if (lane == 0) BON[tok * 4 + hd] = bn;
  }
#undef RWLOAD
}

DI void rwkv_scan_item(const Params& p, int l, int b, int hd, int half, char* smem) {
  const bf16_t* P = (const bf16_t*)(p.ws + OFF_P);
  bf16_t* O = (bf16_t*)(p.ws + OFF_O);
  const bf16_t* RD = (const bf16_t*)(p.ws + OFF_L);
  const bf16_t* RKK = (const bf16_t*)(p.ws + OFF_L + GSZ);
  const bf16_t* RA = (const bf16_t*)(p.ws + OFF_L + 2 * GSZ);
  float* fb = (float*)smem;
  float* Yb = fb + 2 * 6208;
  const int tid = otid(), lane = tid & 63, wv = tid >> 6;
  const int hc = hd * 64 + lane;
  constexpr int NCH = SEQ / 16;
  float S[8];
#pragma unroll
  for (int j = 0; j < 8; ++j) S[j] = 0.f;
  const int rl = lane >> 3, kq = lane & 7, vloc = (wv & 3) * 8 + rl, vrow = half * 32 + vloc;
  const float* mu = p.in[I_RMU] + (size_t)l * 896;
  const float mu_r = mu[hc], mu_k = mu[256 + hc], mu_v = mu[512 + hc];
  const float kac = p.in[I_RKA][l * 256 + hc];
  const int pw = wv & 3;
  unsigned raw[4][9];
#pragma unroll
  for (int j = 0; j < 4; ++j)
#pragma unroll
    for (int e = 0; e < 9; ++e) raw[j][e] = 0u;
#define RAWLOAD(i_)                                                                                 \
  {                                                                                                 \
    _Pragma("unroll") for (int j = 0; j < 4; ++j) {                                                 \
      const int s_ = (i_) * 16 + pw * 4 + j;                                                        \
      const size_t tok_ = (size_t)b * SEQ + s_;                                                     \
      const bf16_t* pr_ = P + tok_ * PSTR + C_RW;                                                   \
      raw[j][0] = pr_[hc]; raw[j][1] = pr_[256 + hc]; raw[j][2] = pr_[512 + hc];                    \
      if (s_ > 0) { raw[j][3] = (pr_ - PSTR)[hc]; raw[j][4] = (pr_ - PSTR)[256 + hc]; raw[j][5] = (pr_ - PSTR)[512 + hc]; } \
      else { raw[j][3] = 0u; raw[j][4] = 0u; raw[j][5] = 0u; }                                      \
      raw[j][6] = RD[tok_ * 256 + hc]; raw[j][7] = RKK[tok_ * 256 + hc]; raw[j][8] = RA[tok_ * 256 + hc]; \
    }                                                                                               \
  }
#define RBAR() { asm volatile("s_waitcnt lgkmcnt(0)" ::: "memory"); __builtin_amdgcn_s_barrier(); asm volatile("" ::: "memory"); }
  if (wv >= 4) RAWLOAD(0);
#pragma unroll 1
  for (int i = 0; i < NCH + 2; ++i) {
    if (wv >= 4) {
      float* B = fb + (i & 1) * 6208;
      if (i >= 2) {
        const float* Yc = Yb + (i & 1) * 512;
        if (lane < 32) {
#pragma unroll
          for (int j = 0; j < 4; ++j) {
            const int tl = pw * 4 + j;
            const size_t tok = (size_t)b * SEQ + (i - 2) * 16 + tl;
            O[tok * DM + 768 + hd * 64 + half * 32 + lane] = f2bf(Yc[tl * 32 + lane]);
          }
        }
      }
      if (i < NCH) {
#pragma unroll
        for (int j = 0; j < 4; ++j) {
          const int tl = pw * 4 + j;
          const float r = mixf((bf16_t)raw[j][0], (bf16_t)raw[j][3], mu_r), k = mixf((bf16_t)raw[j][1], (bf16_t)raw[j][4], mu_k), v = mixf((bf16_t)raw[j][2], (bf16_t)raw[j][5], mu_v);
          const float w = 1.f - bf2f((bf16_t)raw[j][6]), kk = bf2f((bf16_t)raw[j][7]), a = bf2f((bf16_t)raw[j][8]);
          const float ka = kk * a, kp = k * (1.f + (a - 1.f) * kac);
          const float c1 = wave_sum(ka * r), c2 = wave_sum(kp * r);
          B[tl * 64 + lane] = w; B[1024 + tl * 64 + lane] = kk; B[2048 + tl * 64 + lane] = ka; B[3072 + tl * 64 + lane] = kp;
          B[4096 + tl * 64 + lane] = w * r; B[5120 + tl * 64 + lane] = v;
          if (lane == 0) { B[6144 + tl * 2] = c1; B[6144 + tl * 2 + 1] = c2; }
        }
        if (i + 1 < NCH) RAWLOAD(i + 1);
      }
    } else if (i >= 1 && i <= NCH) {
      const float* B = fb + ((i - 1) & 1) * 6208;
      float* Yc = Yb + ((i - 1) & 1) * 512;
      f32x4 vw[2][10]; float vvv[2]; float2 vsc[2];
#define RWLD(t_, s_)                                                                              \
      { const float* bt_ = B + (t_) * 64 + kq * 8;                                                 \
        _Pragma("unroll") for (int q_ = 0; q_ < 5; ++q_) { vw[s_][2 * q_] = *(const f32x4*)(bt_ + 1024 * q_); vw[s_][2 * q_ + 1] = *(const f32x4*)(bt_ + 1024 * q_ + 4); } \
        vvv[s_] = B[5120 + (t_) * 64 + vrow]; vsc[s_] = *(const float2*)(B + 6144 + (t_) * 2); }
      RWLD(0, 0);
#pragma unroll
      for (int t = 0; t < 16; ++t) {
        const int cs = t & 1;
        if (t + 1 < 16) RWLD(t + 1, cs ^ 1);
        const f32x4 w0 = vw[cs][0], w1 = vw[cs][1], kk0 = vw[cs][2], kk1 = vw[cs][3], ka0 = vw[cs][4], ka1 = vw[cs][5],
                    kp0 = vw[cs][6], kp1 = vw[cs][7], wr0 = vw[cs][8], wr1 = vw[cs][9];
        const float vv = vvv[cs]; const float2 sc = vsc[cs];
        float d0 = 0.f, e0 = 0.f;
#pragma unroll
        for (int j = 0; j < 4; ++j) { d0 += S[j] * kk0[j] + S[j + 4] * kk1[j]; e0 += S[j] * wr0[j] + S[j + 4] * wr1[j]; }
        d0 = reduce8(d0); e0 = reduce8(e0);
        const float sa0 = -d0;
        const float y0 = e0 + sa0 * sc.x + vv * sc.y;
#pragma unroll
        for (int j = 0; j < 4; ++j) {
          S[j] = S[j] * w0[j] + sa0 * ka0[j] + vv * kp0[j]; S[j + 4] = S[j + 4] * w1[j] + sa0 * ka1[j] + vv * kp1[j];
        }
        if (kq == 0) Yc[t * 32 + vloc] = y0;
      }
#undef RWLD
    }
    RBAR();
  }
#undef RAWLOAD
#undef RBAR
}

DI void rwkv_post(const Params& p, int l) {
  const bf16_t* P = (const bf16_t*)(p.ws + OFF_P);
  bf16_t* O = (bf16_t*)(p.ws + OFF_O);
  const bf16_t* RG = (const bf16_t*)(p.ws + OFF_L + 3 * GSZ);
  const float* BON = (const float*)(p.ws + OFF_BON);
  const int tid = otid(), lane = tid & 63, wv = tid >> 6;
  const float* mu = p.in[I_RMU] + (size_t)l * 896;
  const int nw = gridDim.x * 8;
  for (int task0 = (obid() * 8 + wv) * 4; task0 < NTOK * 4; task0 += nw * 4) {
    float yv[4], vv[4], gv[4], bv[4];
#pragma unroll
    for (int q = 0; q < 4; ++q) {
      const int task = task0 + q; const size_t tok = task >> 2; const int hd = task & 3, hc = hd * 64 + lane;
      yv[q] = bf2f(O[tok * DM + 768 + hc]);
      const bf16_t cur = P[tok * PSTR + C_RW + 512 + hc];
      const bf16_t prev = (tok % SEQ) ? P[(tok - 1) * PSTR + C_RW + 512 + hc] : (bf16_t)0;
      vv[q] = mixf(cur, prev, mu[512 + hc]);
      gv[q] = bf2f(RG[tok * 256 + hc]); bv[q] = BON[tok * 4 + hd];
    }
#pragma unroll
    for (int q = 0; q < 4; ++q) {
      const int task = task0 + q; const size_t tok = task >> 2; const int hd = task & 3, hc = hd * 64 + lane;
      const float mean = wave_sum(yv[q]) * (1.f / 64.f);
      const float d = yv[q] - mean;
      const float var = wave_sum(d * d) * (1.f / 64.f);
      const float yn = d * rsqrtf(var + 64e-5f) * p.in[I_RLG][l * 256 + hc] + p.in[I_RLB][l * 256 + hc];
      O[tok * DM + 768 + hc] = f2bf((yn + bv[q] * vv[q]) * gv[q]);
    }
  }
}

DI void sb_item(const Params& p, int item, char* smem) {
  const bf16_t* P = (const bf16_t*)(p.ws + OFF_P);
  bf16_t* O = (bf16_t*)(p.ws + OFF_O);
  const int qt = item & 15, hd = (item >> 4) & 3, b = item >> 6;
  const int tid = otid(), lane = tid & 63, wv = tid >> 6, r = lane & 31, h = lane >> 5;
  bf16_t* Vt = (bf16_t*)(smem + wv * 8704);
  const int q0 = qt * 256 + wv * 32;
  const int sq = q0 + r;
  const size_t tokb = (size_t)b * SEQ;
  bf16x8 qf[4];
#pragma unroll
  for (int ks = 0; ks < 4; ++ks) qf[ks] = *(const bf16x8*)(P + (tokb + sq) * PSTR + C_SB_Q + hd * 64 + ks * 16 + h * 8);
  f32x16 accO[2];
#pragma unroll
  for (int i = 0; i < 16; ++i) { accO[0][i] = 0.f; accO[1][i] = 0.f; }
  float Prun = 1.f;
  bf16x8 kf[2][4];
  const int kt0 = (q0 + 31) >> 6;
#define SBKLOAD(kt_) { _Pragma("unroll") for (int m = 0; m < 2; ++m) _Pragma("unroll") for (int ks = 0; ks < 4; ++ks) \
    kf[m][ks] = *(const bf16x8*)(P + (tokb + (kt_) * 64 + 32 * m + r) * PSTR + C_SB_K + hd * 64 + ks * 16 + h * 8); }
  SBKLOAD(kt0);
  for (int kt = kt0; kt >= 0; --kt) {
    const int k0 = kt * 64;
    bf16x8 vr[8];
#pragma unroll
    for (int it = 0; it < 8; ++it) vr[it] = *(const bf16x8*)(P + (tokb + k0 + it * 8 + (lane >> 3)) * PSTR + C_SB_V + hd * 64 + (lane & 7) * 8);
    f32x16 acc[2];
#pragma unroll
    for (int m = 0; m < 2; ++m) {
#pragma unroll
      for (int i = 0; i < 16; ++i) acc[m][i] = 0.f;
#pragma unroll
      for (int ks = 0; ks < 4; ++ks) acc[m] = mfma32(kf[m][ks], qf[ks], acc[m]);
    }
    if (kt > 0) SBKLOAD(kt - 1);
    float om[2][16];
#pragma unroll
    for (int m = 0; m < 2; ++m)
#pragma unroll
      for (int i = 0; i < 16; ++i) {
        const int key = k0 + 32 * m + crow(i, h);
        const float z = fmaxf(acc[m][i] * 0.125f, -80.f);
        const float e = __expf(-z);
        const float sg = __builtin_amdgcn_rcpf(1.f + e);
        const bool valid = key < sq;
        acc[m][i] = valid ? sg : 0.f;
        om[m][i] = valid ? e * sg : 1.f;
      }
    float gp[8];
#pragma unroll
    for (int q = 0; q < 8; ++q) {
      const int m = q >> 2, g = q & 3;
      gp[q] = (om[m][4 * g] * om[m][4 * g + 1]) * (om[m][4 * g + 2] * om[m][4 * g + 3]);
    }
    float run = 1.f;
#pragma unroll
    for (int q = 7; q >= 0; --q) {
      const int m = q >> 2, g = q & 3;
      const float pg = __shfl_xor(gp[q], 32);
      const float f3 = Prun * run * (h == 0 ? pg : 1.f);
      const float f2 = f3 * om[m][4 * g + 3], f1 = f2 * om[m][4 * g + 2], f0 = f1 * om[m][4 * g + 1];
      acc[m][4 * g + 3] *= f3; acc[m][4 * g + 2] *= f2; acc[m][4 * g + 1] *= f1; acc[m][4 * g + 0] *= f0;
      run *= gp[q] * pg;
    }
    Prun *= run;
    __builtin_amdgcn_wave_barrier();
#pragma unroll
    for (int it = 0; it < 8; ++it) {
      const int key = it * 8 + (lane >> 3), chv = lane & 7;
#pragma unroll
      for (int e = 0; e < 8; ++e) Vt[(chv * 8 + e) * 68 + key] = (bf16_t)vr[it][e];
    }
    __builtin_amdgcn_wave_barrier();
#pragma unroll
    for (int m = 0; m < 2; ++m)
#pragma unroll
      for (int s2 = 0; s2 < 2; ++s2) {
        uint4 uu = {pack2(acc[m][8 * s2 + 0], acc[m][8 * s2 + 1]), pack2(acc[m][8 * s2 + 2], acc[m][8 * s2 + 3]),
                    pack2(acc[m][8 * s2 + 4], acc[m][8 * s2 + 5]), pack2(acc[m][8 * s2 + 6], acc[m][8 * s2 + 7])};
        const bf16x8 pb = __builtin_bit_cast(bf16x8, uu);
#pragma unroll
        for (int dt = 0; dt < 2; ++dt) {
          const bf16_t* vp = Vt + (32 * dt + r) * 68 + 32 * m + 16 * s2 + 4 * h;
          s16x4 lo = *(const s16x4*)vp, hi = *(const s16x4*)(vp + 8);
          bf16x8 va = __builtin_shufflevector(lo, hi, 0, 1, 2, 3, 4, 5, 6, 7);
          accO[dt] = mfma32(va, pb, accO[dt]);
        }
      }
    __builtin_amdgcn_wave_barrier();
    if (__ballot(Prun > 1e-37f) == 0ull) break;
  }
#undef SBKLOAD
#pragma unroll
  for (int dt = 0; dt < 2; ++dt)
#pragma unroll
    for (int g = 0; g < 4; ++g) {
      const int d = 32 * dt + 8 * g + 4 * h;
      uint2 o = {pack2(accO[dt][4 * g], accO[dt][4 * g + 1]), pack2(accO[dt][4 * g + 2], accO[dt][4 * g + 3])};
      *(uint2*)(O + (tokb + sq) * DM + 256 + hd * 64 + d) = o;
    }
}

DI int frag_off(int row, int k) {
  const int rt = row >> 4, fr = row & 15, ks = k >> 5, kk = k & 31, hi = kk >> 4, fq = (kk & 15) >> 2, j = (kk & 3) + 4 * hi;
  return ((rt * 2 + ks) * 64 + fq * 16 + fr) * 8 + j;
}
DI int frag_off8(int row, int k0) {
  const int rt = row >> 4, fr = row & 15, ks = k0 >> 5, kk = k0 & 31, hi = kk >> 4, fq = (kk & 15) >> 2;
  return ((rt * 2 + ks) * 64 + fq * 16 + fr) * 8 + 4 * hi;
}
DI void gdn_intra_item(const Params& p, int l, int item, char* smem) {
  const bf16_t* P = (const bf16_t*)(p.ws + OFF_P);
  const int hp = item & 1, c = (item >> 1) & 63, b = item >> 7;
  const int tid = otid(), lane = tid & 63;
  bf16_t* Kb = (bf16_t*)smem;
  bf16_t* Qb = Kb + 2 * 64 * 72;
  bf16_t* Vb = Qb + 2 * 64 * 72;
  float* Lm = (float*)(smem + 3 * 2 * 64 * 72 * 2);
  float* Gs = Lm + 2 * 4096;
  float* Bs = Gs + 128;
  const size_t tok0 = (size_t)b * SEQ + c * 64;
  const float* cw = p.in[I_GCW] + (size_t)l * 4 * 768;
  {
    const int t = tid >> 3, cg = tid & 7;
#pragma unroll 1
    for (int it = 0; it < 6; ++it) {
      const int hh = it / 3, which = it % 3, head = hp * 2 + hh;
      const int ccol = which * 256 + head * 64 + cg * 8;
      float acc[8];
#pragma unroll
      for (int e = 0; e < 8; ++e) acc[e] = 0.f;
#pragma unroll
      for (int j = 0; j < 4; ++j) {
        const int s = c * 64 + t - 3 + j;
        if (s >= 0) {
          bf16x8 xv = *(const bf16x8*)(P + ((size_t)b * SEQ + s) * PSTR + C_GDN_Q + ccol);
          f32x4 wa = *(const f32x4*)(cw + j * 768 + ccol), wb = *(const f32x4*)(cw + j * 768 + ccol + 4);
#pragma unroll
          for (int e = 0; e < 4; ++e) { acc[e] += wa[e] * bf2f((bf16_t)xv[e]); acc[e + 4] += wb[e] * bf2f((bf16_t)xv[e + 4]); }
        }
      }
      float ss = 0.f;
#pragma unroll
      for (int e = 0; e < 8; ++e) { acc[e] = siluf_(acc[e]); ss += acc[e] * acc[e]; }
      ss += __shfl_xor(ss, 1); ss += __shfl_xor(ss, 2); ss += __shfl_xor(ss, 4);
      float sc = 1.f;
      if (which == 0) sc = rsqrtf(ss + EPSF) * 0.125f;
      else if (which == 1) sc = rsqrtf(ss + EPSF);
      uint4 ov = {pack2(acc[0] * sc, acc[1] * sc), pack2(acc[2] * sc, acc[3] * sc), pack2(acc[4] * sc, acc[5] * sc), pack2(acc[6] * sc, acc[7] * sc)};
      bf16_t* dst = (which == 0 ? Qb : (which == 1 ? Kb : Vb)) + (hh * 64 + t) * 72 + cg * 8;
      *(uint4*)dst = ov;
    }
  }
  if (tid < 128) {
    const int hh = tid >> 6, t = lane, head = hp * 2 + hh;
    const float a_in = bf2f(P[(tok0 + t) * PSTR + C_GDN_A + head]);
    const float b_in = bf2f(P[(tok0 + t) * PSTR + C_GDN_B + head]);
    const float beta = sigmoidf_(b_in);
    float g = -__expf(p.in[I_GAL][l * 4 + head]) * softplusf_(a_in + p.in[I_GDT][l * 4 + head]);
#pragma unroll
    for (int d = 1; d < 64; d <<= 1) { float v = __shfl_up(g, d); if (lane >= d) g += v; }
    Gs[hh * 64 + t] = g; Bs[hh * 64 + t] = beta;
  }
  __syncthreads();
  const int hh = tid >> 8, lt = tid & 255, head = hp * 2 + hh;
  const size_t ih = ((size_t)(b * 4 + head)) * 64 + c;
  bf16_t* GW = (bf16_t*)(p.ws + OFF_G) + ih * 4096;
  bf16_t* GQD = (bf16_t*)(p.ws + OFF_G + GSZ) + ih * 4096;
  bf16_t* GQK = (bf16_t*)(p.ws + OFF_G + 2 * GSZ) + ih * 4096;
  bf16_t* GKD = (bf16_t*)(p.ws + OFF_G + 3 * GSZ) + ih * 4096;
  bf16_t* GU = (bf16_t*)(p.ws + OFF_G + 4 * GSZ) + ih * 4096;
  float* GCD = (float*)(p.ws + OFF_GCD);
  const float* Gh = Gs + hh * 64; const float* Bh = Bs + hh * 64;
  {
    const int wq = (tid >> 6) & 3, ti = wq >> 1, tj = wq & 1, r = lane & 31, h = lane >> 5;
    f32x16 akk, aqk;
#pragma unroll
    for (int i = 0; i < 16; ++i) { akk[i] = 0.f; aqk[i] = 0.f; }
    if (ti >= tj) {
#pragma unroll
      for (int ks = 0; ks < 4; ++ks) {
        bf16x8 ka = *(const bf16x8*)(Kb + (hh * 64 + 32 * ti + r) * 72 + ks * 16 + h * 8);
        bf16x8 qa = *(const bf16x8*)(Qb + (hh * 64 + 32 * ti + r) * 72 + ks * 16 + h * 8);
        bf16x8 kb = *(const bf16x8*)(Kb + (hh * 64 + 32 * tj + r) * 72 + ks * 16 + h * 8);
        akk = mfma32(ka, kb, akk);
        aqk = mfma32(qa, kb, aqk);
      }
    }
    const int j = 32 * tj + r;
    const float Gj = Gh[j];
#pragma unroll
    for (int i_ = 0; i_ < 16; ++i_) {
      const int i = 32 * ti + crow(i_, h);
      const float dec = (i >= j) ? __expf(Gh[i] - Gj) : 0.f;
      Lm[hh * 4096 + i * 64 + j] = (i > j) ? Bh[i] * akk[i_] * dec : 0.f;
      GQK[frag_off(i, j)] = f2bf((i >= j) ? aqk[i_] * dec : 0.f);
    }
  }
  __syncthreads();
  if (lt < 128) {
    const int cc = lt;
    float x[64];
    if (cc < 64) {
#pragma unroll
      for (int i = 0; i < 64; ++i) x[i] = bf2f(Vb[(hh * 64 + i) * 72 + cc]) * Bh[i];
    } else {
#pragma unroll
      for (int i = 0; i < 64; ++i) x[i] = bf2f(Kb[(hh * 64 + i) * 72 + cc - 64]) * Bh[i] * __expf(Gh[i]);
    }
    const float* Lh = Lm + hh * 4096;
#pragma unroll
    for (int i = 1; i < 64; ++i) {
      float s = x[i];
#pragma unroll
      for (int j4 = 0; j4 < (i + 3) / 4; ++j4) {
        const f32x4 lv = *(const f32x4*)(Lh + i * 64 + j4 * 4);
#pragma unroll
        for (int e = 0; e < 4; ++e) if (j4 * 4 + e < i) s -= lv[e] * x[j4 * 4 + e];
      }
      x[i] = s;
    }
    if (cc < 64) {
      const int split = cc >> 4, fr = cc & 15;
#pragma unroll
      for (int i4 = 0; i4 < 16; ++i4) {
        uint2 ov = {pack2(x[4 * i4], x[4 * i4 + 1]), pack2(x[4 * i4 + 2], x[4 * i4 + 3])};
        *(uint2*)(GU + ((split * 4 + (i4 >> 2)) * 64 + (i4 & 3) * 16 + fr) * 4) = ov;
      }
    } else {
#pragma unroll
      for (int i = 0; i < 64; ++i) GW[frag_off(i, cc - 64)] = f2bf(x[i]);
    }
  } else {
    const int q_ = lt - 128;
    const float Glast = Gh[63];
#pragma unroll
    for (int i = 0; i < 4; ++i) {
      const int q = q_ + 128 * i; const int pos = q >> 3, kc = q & 7;
      bf16x8 qv = *(const bf16x8*)(Qb + (hh * 64 + pos) * 72 + kc * 8);
      const float eg = __expf(Gh[pos]);
      uint4 ov = {pack2(bf2f((bf16_t)qv[0]) * eg, bf2f((bf16_t)qv[1]) * eg), pack2(bf2f((bf16_t)qv[2]) * eg, bf2f((bf16_t)qv[3]) * eg),
                  pack2(bf2f((bf16_t)qv[4]) * eg, bf2f((bf16_t)qv[5]) * eg), pack2(bf2f((bf16_t)qv[6]) * eg, bf2f((bf16_t)qv[7]) * eg)};
      { const int fo = frag_off8(pos, kc * 8); uint2 o0 = {ov.x, ov.y}, o1 = {ov.z, ov.w}; *(uint2*)(GQD + fo) = o0; *(uint2*)(GQD + fo + 128) = o1; }
    }
#pragma unroll
    for (int i = 0; i < 4; ++i) {
      const int q = q_ + 128 * i; const int k = q >> 3, pc = q & 7;
      float o[8];
#pragma unroll
      for (int e = 0; e < 8; ++e) { const int pos = pc * 8 + e; o[e] = bf2f(Kb[(hh * 64 + pos) * 72 + k]) * __expf(Glast - Gh[pos]); }
      uint4 ov = {pack2(o[0], o[1]), pack2(o[2], o[3]), pack2(o[4], o[5]), pack2(o[6], o[7])};
      { const int fo = frag_off8(k, pc * 8); uint2 o0 = {ov.x, ov.y}, o1 = {ov.z, ov.w}; *(uint2*)(GKD + fo) = o0; *(uint2*)(GKD + fo + 128) = o1; }
    }
    if (q_ == 0) GCD[ih] = __expf(Glast);
  }
}

DI void gdn_rec_item(const Params& p, int l, int b, int head, char* smem) {
  const bf16_t* P = (const bf16_t*)(p.ws + OFF_P);
  bf16_t* O = (bf16_t*)(p.ws + OFF_O);
  float* SS = (float*)(smem + 81920);
  const int tid = otid(), lane = tid & 63, wv = tid >> 6, fr = lane & 15, fq = lane >> 4;
  const int split = wv & 3;
  const bool active = wv < 4;
  const float ng = p.in[I_GNG][l * 64 + split * 16 + fr];
  const float* GCD = (const float*)(p.ws + OFF_GCD);
  const size_t ih0 = ((size_t)(b * 4 + head)) * 64;
  f32x4 S[4];
#pragma unroll
  for (int kt = 0; kt < 4; ++kt) S[kt] = (f32x4){0.f, 0.f, 0.f, 0.f};
  u32x4 lr[10];
#pragma unroll
  for (int i = 0; i < 10; ++i) lr[i] = (u32x4){0u, 0u, 0u, 0u};
  const int lq = (wv & 3) * 64 + lane;
#define GLOADC(c_)                                                                              \
  {                                                                                             \
    _Pragma("unroll") for (int i = 0; i < 10; ++i) {                                            \
      const int q_ = lq + 256 * i; const int a_ = q_ >> 9, o_ = q_ & 511;                       \
      lr[i] = *(const u32x4*)((const bf16_t*)(p.ws + OFF_G + (size_t)a_ * GSZ) + (ih0 + (c_)) * 4096 + o_ * 8); \
    }                                                                                           \
  }
#define LSTORE(buf_)                                                                            \
  {                                                                                             \
    _Pragma("unroll") for (int i = 0; i < 10; ++i) {                                            \
      const int q_ = lq + 256 * i;                                                              \
      *(u32x4*)(smem + (buf_) * 40960 + q_ * 16) = lr[i];                                       \
    }                                                                                           \
  }
#define BAR_LDS() { asm volatile("s_waitcnt lgkmcnt(0)" ::: "memory"); __builtin_amdgcn_s_barrier(); asm volatile("" ::: "memory"); }
  float cdn = 0.f;
  if (!active) { GLOADC(0); LSTORE(0); GLOADC(1); }
  else cdn = GCD[ih0];
  BAR_LDS();
#pragma unroll 1
  for (int c = 0; c < 64; ++c) {
    f32x4 acco[4];
    if (active) {
      const char* bufp = smem + (c & 1) * 40960;
      const float cd = cdn;
      if (c + 1 < 64) cdn = GCD[ih0 + c + 1];
      float zr[16];
#pragma unroll
      for (int rt = 0; rt < 4; ++rt)
#pragma unroll
        for (int j = 0; j < 4; ++j) {
          const size_t tok = (size_t)b * SEQ + c * 64 + 16 * rt + 4 * fq + j;
          zr[rt * 4 + j] = bf2f(P[tok * PSTR + C_GDN_Z + head * 64 + split * 16 + fr]);
        }
      bf16x8 bS[2];
#pragma unroll
      for (int ks = 0; ks < 2; ++ks) {
        uint4 uu = {pack2(S[2 * ks][0], S[2 * ks][1]), pack2(S[2 * ks][2], S[2 * ks][3]), pack2(S[2 * ks + 1][0], S[2 * ks + 1][1]), pack2(S[2 * ks + 1][2], S[2 * ks + 1][3])};
        bS[ks] = __builtin_bit_cast(bf16x8, uu);
      }
      f32x4 u[4];
#pragma unroll
      for (int rt = 0; rt < 4; ++rt) {
        f32x4 aw = {0.f, 0.f, 0.f, 0.f};
        acco[rt] = (f32x4){0.f, 0.f, 0.f, 0.f};
#pragma unroll
        for (int ks = 0; ks < 2; ++ks) {
          const bf16x8 wa = *(const bf16x8*)(bufp + ((rt * 2 + ks) * 64 + lane) * 16);
          const bf16x8 qa = *(const bf16x8*)(bufp + 8192 + ((rt * 2 + ks) * 64 + lane) * 16);
          aw = mfma16(wa, bS[ks], aw); acco[rt] = mfma16(qa, bS[ks], acco[rt]);
        }
        const s16x4 uv = *(const s16x4*)(bufp + 32768 + ((split * 4 + rt) * 64 + lane) * 8);
#pragma unroll
        for (int j = 0; j < 4; ++j) u[rt][j] = bf2f((bf16_t)uv[j]) - aw[j];
      }
      bf16x8 bU[2];
#pragma unroll
      for (int ks = 0; ks < 2; ++ks) {
        uint4 uu = {pack2(u[2 * ks][0], u[2 * ks][1]), pack2(u[2 * ks][2], u[2 * ks][3]), pack2(u[2 * ks + 1][0], u[2 * ks + 1][1]), pack2(u[2 * ks + 1][2], u[2 * ks + 1][3])};
        bU[ks] = __builtin_bit_cast(bf16x8, uu);
      }
#pragma unroll
      for (int rt = 0; rt < 4; ++rt) {
        f32x4 sn = S[rt] * cd;
#pragma unroll
        for (int ks = 0; ks < 2; ++ks) {
          const bf16x8 qa = *(const bf16x8*)(bufp + 16384 + ((rt * 2 + ks) * 64 + lane) * 16);
          const bf16x8 ka = *(const bf16x8*)(bufp + 24576 + ((rt * 2 + ks) * 64 + lane) * 16);
          acco[rt] = mfma16(qa, bU[ks], acco[rt]); sn = mfma16(ka, bU[ks], sn);
        }
        S[rt] = sn;
      }
#pragma unroll
      for (int rt = 0; rt < 4; ++rt)
#pragma unroll
        for (int j = 0; j < 4; ++j) {
          float s = acco[rt][j] * acco[rt][j];
          s += __shfl_xor(s, 1); s += __shfl_xor(s, 2); s += __shfl_xor(s, 4); s += __shfl_xor(s, 8);
          if (fr == 0) SS[(c & 1) * 256 + split * 64 + 16 * rt + 4 * fq + j] = s;
        }
      BAR_LDS();
      const float* ssb = SS + (c & 1) * 256;
#pragma unroll
      for (int rt = 0; rt < 4; ++rt)
#pragma unroll
        for (int j = 0; j < 4; ++j) {
          const int pos = 16 * rt + 4 * fq + j;
          const float tot = ssb[pos] + ssb[64 + pos] + ssb[128 + pos] + ssb[192 + pos];
          const float rn = rsqrtf(tot * (1.f / 64.f) + EPSF);
          const size_t tok = (size_t)b * SEQ + c * 64 + pos;
          O[tok * DM + 512 + head * 64 + split * 16 + fr] = f2bf(acco[rt][j] * rn * ng * siluf_(zr[rt * 4 + j]));
        }
    } else {
      if (c + 1 < 64) LSTORE((c + 1) & 1);
      if (c + 2 < 64) GLOADC(c + 2);
      BAR_LDS();
    }
  }
#undef GLOADC
#undef LSTORE
#undef BAR_LDS
}

DI void lru_item(const Params& p, int l, int item, char* smem, const int mode) {
  const bf16_t* P = (const bf16_t*)(p.ws + OFF_P);
  bf16_t* O = (bf16_t*)(p.ws + OFF_O);
  float* CA = (float*)(p.ws + OFF_LCA);
  float* CH = (float*)(p.ws + OFF_LCH);
  bf16_t* XS = (bf16_t*)smem;
  float* U = (float*)(smem + 34816);
  float* XC = (float*)(smem + 34816 + 65536);
  const int b = item >> 6, ct = item & 63;
  const int tid = otid(), sc = tid >> 8, c = tid & 255;
  for (int i = 0; i < 5; ++i) {
    const int q = tid + NTHR * i;
    if (q < 67 * 32) {
      const int row = q >> 5, cc = q & 31;
      const int s = ct * 64 - 3 + row;
      uint4 v = {0u, 0u, 0u, 0u};
      if (s >= 0) v = *(const uint4*)(P + ((size_t)b * SEQ + s) * PSTR + C_LRU_X + cc * 8);
      *(uint4*)(XS + row * 256 + cc * 8) = v;
    }
  }
  float carry = 0.f;
  if (mode == 1) {
    float A = 1.f, hh = 0.f;
    const float* ca = CA + ((size_t)b * 128 + sc * ct) * 256 + c;
    const float* chp = CH + ((size_t)b * 128 + sc * ct) * 256 + c;
    int k = 0;
    for (; k + 8 <= ct; k += 8) {
      float av[8], hv[8];
#pragma unroll
      for (int e = 0; e < 8; ++e) { av[e] = ca[(size_t)(k + e) * 256]; hv[e] = chp[(size_t)(k + e) * 256]; }
#pragma unroll
      for (int e = 0; e < 8; ++e) { hh = av[e] * hh + hv[e]; A *= av[e]; }
    }
    for (; k < ct; ++k) { const float a_ = ca[(size_t)k * 256], h_ = chp[(size_t)k * 256]; hh = a_ * hh + h_; A *= a_; }
    XC[(sc * 256 + c) * 2] = A; XC[(sc * 256 + c) * 2 + 1] = hh;
  }
  __syncthreads();
  if (mode == 1) {
    const float h0 = XC[c * 2 + 1], A1 = XC[(256 + c) * 2], h1 = XC[(256 + c) * 2 + 1];
    carry = A1 * h0 + h1;
    if (sc == 1) carry = CA[((size_t)b * 128 + 2 * ct) * 256 + c] * carry + CH[((size_t)b * 128 + 2 * ct) * 256 + c];
  }
  {
    const float cb = p.in[I_LCB][l * 256 + c];
    const float c0 = p.in[I_LCW][(l * 4 + 0) * 256 + c], c1 = p.in[I_LCW][(l * 4 + 1) * 256 + c],
                c2 = p.in[I_LCW][(l * 4 + 2) * 256 + c], c3 = p.in[I_LCW][(l * 4 + 3) * 256 + c];
    for (int t = sc * 32; t < sc * 32 + 32; ++t)
      U[t * 256 + c] = cb + c0 * bf2f(XS[t * 256 + c]) + c1 * bf2f(XS[(t + 1) * 256 + c]) + c2 * bf2f(XS[(t + 2) * 256 + c]) + c3 * bf2f(XS[(t + 3) * 256 + c]);
  }
  __syncthreads();
  {
    const int n = c >> 6, f = c & 63;
    float wr[64], wi[64];
    {
      const float* wrp = p.in[I_LWR] + (((size_t)l * 4 + n) * 64) * 64 + f;
      const float* wip = p.in[I_LWI] + (((size_t)l * 4 + n) * 64) * 64 + f;
      asm volatile("" : "+v"(wrp), "+v"(wip));
#pragma unroll
      for (int e = 0; e < 64; ++e) { wr[e] = wrp[e * 64]; wi[e] = wip[e * 64]; }
    }
    const float br = p.in[I_LBR][l * 256 + c], bi = p.in[I_LBI][l * 256 + c];
    const float lamsp = softplusf_(-p.in[I_LLAM][l * 256 + c]);
    float hl = carry, ac = 1.f;
    for (int t = sc * 32; t < sc * 32 + 32; ++t) {
      float ar = br, ai = bi;
#pragma unroll
      for (int e4 = 0; e4 < 16; ++e4) {
        const f32x4 uu = *(const f32x4*)(U + t * 256 + n * 64 + e4 * 4);
#pragma unroll
        for (int e = 0; e < 4; ++e) { ar += uu[e] * wr[e4 * 4 + e]; ai += uu[e] * wi[e4 * 4 + e]; }
      }
      const float rg = sigmoidf_(ar), ig = sigmoidf_(ai);
      const float la = -8.f * rg * lamsp;
      const float a = __expf(la);
      const float bb = sqrtf(fmaxf(0.f, 1.f - __expf(2.f * la))) * (ig * U[t * 256 + c]);
      hl = a * hl + bb; ac *= a;
      if (mode == 1) {
        const size_t tok = (size_t)b * SEQ + ct * 64 + t;
        const float y = bf2f(P[tok * PSTR + C_LRU_Y + c]);
        O[tok * DM + c] = f2bf(hl * geluf_(y));
      }
    }
    if (mode == 0) {
      const int ck = ct * 2 + sc;
      CA[((size_t)b * 128 + ck) * 256 + c] = ac; CH[((size_t)b * 128 + ck) * 256 + c] = hl;
    }
  }
}


#define XB_TMO      128
#define XB_XCNT(j)  (256  + 64 * (j))
#define XB_XSUB(j)  (1280 + 64 * (j))
#define XB_XGEN(j)  (2304 + 64 * (j))
#define XB_TOP      3328
#define XB_TOPGEN   3392
#define XCD_BAR_WORDS 3456
#define XB_SPIN_CAP (1u << 18)
#define XLAS __attribute__((address_space(3)))
DI unsigned xb_ld(unsigned* p)              { return __hip_atomic_load(p, __ATOMIC_RELAXED, __HIP_MEMORY_SCOPE_AGENT); }
DI unsigned xb_add(unsigned* p, unsigned v) { return __hip_atomic_fetch_add(p, v, __ATOMIC_RELAXED, __HIP_MEMORY_SCOPE_AGENT); }
DI unsigned xb_xcc_id() { return (unsigned)__builtin_amdgcn_s_getreg((3 << 11) | 20) & 0xFu; }
#define XB_SPIN(cond, bar) do { unsigned _sp = 0; while (cond) { __builtin_amdgcn_s_sleep(1); \
    if ((++_sp & 255u) == 0u) { if (xb_ld(&(bar)[XB_TMO])) break; if (_sp > XB_SPIN_CAP) { atomicAdd(&(bar)[XB_TMO], 1u); break; } } } } while (0)
struct XcdBarrier { unsigned* bar; unsigned x; volatile XLAS unsigned* st; };
DI XcdBarrier xcd_barrier_post(unsigned* bar, volatile XLAS unsigned* st) {
  XcdBarrier b; b.bar = bar; b.x = xb_xcc_id(); b.st = st;
  if (threadIdx.x == 0) (void)xb_add(&bar[XB_XCNT(b.x)], 1u);
  return b;
}
DI void xcd_barrier_complete(unsigned* bar, unsigned x, unsigned& nloc, unsigned& nx) {
  const unsigned G = gridDim.x * gridDim.y * gridDim.z;
  unsigned sum, cnt, mine, sp = 0u;
  for (;;) {
    sum = 0u; cnt = 0u; mine = 0u;
#pragma unroll
    for (unsigned j = 0; j < 16; ++j) { const unsigned c = xb_ld(&bar[XB_XCNT(j)]); sum += c; cnt += (c > 0u) ? 1u : 0u; mine = (j == x) ? c : mine; }
    if (sum == G) break;
    __builtin_amdgcn_s_sleep(1);
    if ((++sp & 255u) == 0u) { if (xb_ld(&bar[XB_TMO])) break; if (sp > XB_SPIN_CAP) { atomicAdd(&bar[XB_TMO], 1u); break; } }
  }
  nloc = mine > 0u ? mine : 1u; nx = cnt > 0u ? cnt : 1u;
}
DI void xcd_barrier(const XcdBarrier& b) {
  asm volatile("s_waitcnt vmcnt(0)" ::: "memory");
  __syncthreads();
  if (threadIdx.x == 0) {
    unsigned* bar = b.bar;
    __builtin_amdgcn_s_waitcnt(0);
    unsigned nloc = b.st[0], nx = b.st[1];
    if (nloc == 0u) { xcd_barrier_complete(bar, b.x, nloc, nx); b.st[0] = nloc; b.st[1] = nx; }
    const unsigned old = xb_add(&bar[XB_XSUB(b.x)], 1u);
    const unsigned gen = old / nloc;
    if (old + 1u == (gen + 1u) * nloc) {
      __builtin_amdgcn_fence(__ATOMIC_RELEASE, "agent");
      asm volatile("s_waitcnt vmcnt(0)" ::: "memory");
      const unsigned og = xb_add(&bar[XB_TOP], 1u);
      const unsigned tg = og / nx;
      if (og + 1u == (tg + 1u) * nx) xb_add(&bar[XB_TOPGEN], 1u);
      else XB_SPIN(xb_ld(&bar[XB_TOPGEN]) == tg, bar);
      __builtin_amdgcn_fence(__ATOMIC_ACQUIRE, "agent");
      xb_add(&bar[XB_XGEN(b.x)], 1u);
      asm volatile("s_waitcnt vmcnt(0)" ::: "memory");
    } else {
      XB_SPIN(xb_ld(&bar[XB_XGEN(b.x)]) == gen, bar);
      __builtin_amdgcn_fence(__ATOMIC_ACQUIRE, "agent");
      asm volatile("s_waitcnt vmcnt(0)" ::: "memory");
    }
  }
  __syncthreads();
}

__global__ void __launch_bounds__(NTHR) mega(Params p) {
  extern __shared__ __attribute__((aligned(16))) char smem[];
  cg::grid_group grid = cg::this_grid();
  const int tid = threadIdx.x;
  bf16_t* H = (bf16_t*)(p.ws + OFF_H);
  bf16_t* PB = (bf16_t*)(p.ws + OFF_P);
  PG_LAS unsigned char* lds = (PG_LAS unsigned char*)smem;
  volatile XLAS unsigned* xst = (volatile XLAS unsigned*)(smem + 131072);
  if (tid < 2) xst[tid] = 0u;
  __syncthreads();
  const XcdBarrier xb = xcd_barrier_post((unsigned*)(p.ws + OFF_BAR), xst);

  for (int rep = 0; rep < REP_MISC; ++rep) {
  if (MASK & 1) phase_mod(p, smem);
  grid.sync();
  }
  for (int l = 0; l < 4; ++l) {
    const float* xcur = (l == 0) ? p.in[I_X] : p.out;
    for (int rep = 0; rep < REP_MISC; ++rep) {
    if (MASK & 2) phase_convert(p, l, smem);
    if (MASK & 4) phase_norm(p, xcur, p.in[I_N1G] + l * 1024, l, 1024, 0, H, nullptr);
    xcd_barrier(xb);
    }
    for (int rep = 0; rep < REP_G; ++rep) {
    if (MASK & 8) { pg::Order<1> S; S.init(NTOK, PSTR, gridDim.x, blockIdx.x); pg::EpiBf16<0> E{PB, PSTR, nullptr};
      pg::gemm_phase(lds, H, DM, (const bf16_t*)(p.ws + OFF_WIN), 1024, S, E); }
    xcd_barrier(xb);
    }
    for (int rep = 0; rep < REP_M1; ++rep) {
    for (int it = blockIdx.x; it < 5120; it += gridDim.x) {
      if (it < 2048) { if (MASK & 32) gdn_intra_item(p, l, it, smem); }
      else if (it < 3072) { if (MASK & 64) sb_item(p, it - 2048, smem); }
      else if (it < 4096) { if (MASK & 128) lru_item(p, l, it - 3072, smem, 0); }
      else { if (MASK & 16) rw_prep_item(p, l, it - 4096, smem); }
      __syncthreads();
    }
    xcd_barrier(xb);
    }
    for (int rep = 0; rep < REP_M2; ++rep) {
    if (blockIdx.x < 128) {
      if (MASK & 16) rwkv_scan_item(p, l, blockIdx.x >> 3, (blockIdx.x >> 1) & 3, blockIdx.x & 1, smem);
    } else {
      if (blockIdx.x < 192) { if (MASK & 256) gdn_rec_item(p, l, (blockIdx.x - 128) >> 2, (blockIdx.x - 128) & 3, smem); }
      unsigned* ctr = (unsigned*)(p.ws + OFF_CTR) + l * 4 + rep;
      volatile int* slot = (volatile int*)(smem + 110016);
      for (;;) {
        __syncthreads();
        if (tid == 0) *slot = (int)atomicAdd(ctr, 1u);
        __syncthreads();
        const int it = *slot;
        if (it >= 1024) break;
        if (MASK & 512) lru_item(p, l, it, smem, 1);
      }
    }
    xcd_barrier(xb);
    }
    for (int rep = 0; rep < REP_G; ++rep) {
    for (int half = 0; half < 2; ++half) {
      bf16_t* BH = (bf16_t*)(p.ws + OFF_P + 134217728);
      if (half == 0 && rep == 0) { if (MASK & 16) rwkv_post(p, l); xcd_barrier(xb); }
      if (MASK & 1024) { pg::Order<1> S; S.init(NTOK / 2, 4096, gridDim.x, blockIdx.x, 0, 0, 2, 512); pg::EpiBf16<0> E{BH, 4096, nullptr};
        pg::gemm_phase(lds, (const bf16_t*)(p.ws + OFF_O) + (size_t)half * 32768 * DM, DM, (const bf16_t*)(p.ws + OFF_WBR), 256, S, E); }
      xcd_barrier(xb);
      if (MASK & 1024) { pg::Order<4> S; S.init(NTOK / 2, 1024, gridDim.x, blockIdx.x, 0, 2097152); pg::EpiGateMix E{PB + (size_t)half * 32768 * DM, (float*)(p.ws + OFF_G), BH, p.in[I_BGATE] + (size_t)l * 4096};
        pg::gemm_phase(lds, H + (size_t)half * 32768 * DM, DM, (const bf16_t*)(p.ws + OFF_WG), 1024, S, E); }
      xcd_barrier(xb);
    }
    }
    if (MASK & 2048) { pg::Order<1> S; S.init(NTOK, 1024, gridDim.x, blockIdx.x); pg::EpiResid E{xcur, p.out, (const float*)(p.ws + OFF_MODP), p.in[I_BADA], l, 2048};
      pg::gemm_phase(lds, PB, DM, (const bf16_t*)(p.ws + OFF_WO), 1024, S, E); }
    xcd_barrier(xb);
    for (int rep = 0; rep < REP_MISC; ++rep) {
    if (MASK & 4096) phase_norm(p, p.out, p.in[I_N2G] + l * 1024, l, 4096, 3072, H, nullptr);
    xcd_barrier(xb);
    }
    for (int rep = 0; rep < REP_G; ++rep) {
    if (MASK & 8192) { pg::Order<1> S; S.init(NTOK, FFN, gridDim.x, blockIdx.x); pg::EpiBf16<0> E{PB, FFN, nullptr};
      pg::gemm_phase(lds, H, DM, (const bf16_t*)(p.ws + OFF_WF), 1024, S, E); }
    xcd_barrier(xb);
    if (MASK & 8192) { pg::Order<1> S; S.init(NTOK, FFN, gridDim.x, blockIdx.x); pg::EpiFfnAct E{PB + (size_t)NTOK * FFN, PB, p.in[I_FCW] + (size_t)l * 3 * FFN};
      pg::gemm_phase(lds, H, DM, (const bf16_t*)(p.ws + OFF_WF) + (size_t)FFN * 1024, 1024, S, E); }
    xcd_barrier(xb);
    }
    if (MASK & 32768) { pg::Order<1> S; S.init(NTOK, 1024, gridDim.x, blockIdx.x); pg::EpiResid E{p.out, p.out, (const float*)(p.ws + OFF_MODP), p.in[I_BADA], l, 5120};
      pg::gemm_phase(lds, PB + (size_t)NTOK * FFN, FFN, (const bf16_t*)(p.ws + OFF_WD), FFN, S, E); }
    xcd_barrier(xb);
  }
  if (MASK & 65536) phase_norm(p, p.out, p.in[I_FG], 0, 0, 0, nullptr, p.out);
}

extern "C" void kernel_launch(void* const* d_in, const int* in_sizes, int n_in,
                              void* d_out, int out_size, void* d_ws, size_t ws_size,
                              hipStream_t stream) {
  if (ws_size < WS_NEED || n_in < 38) { fprintf(stderr, "workspace too small: %zu < %zu\n", ws_size, (size_t)WS_NEED); return; }
  (void)hipFuncSetAttribute((const void*)mega, hipFuncAttributeMaxDynamicSharedMemorySize, SMEM_BYTES);
  int dev = 0, cus = 0, per_cu = 0;
  (void)hipGetDevice(&dev);
  (void)hipDeviceGetAttribute(&cus, hipDeviceAttributeMultiprocessorCount, dev);
  (void)hipOccupancyMaxActiveBlocksPerMultiprocessor(&per_cu, mega, NTHR, SMEM_BYTES);
  if (per_cu < 1 || cus < 1) { fprintf(stderr, "occupancy query failed (%d, %d)\n", per_cu, cus); return; }
  if (cus > 256) cus = 256;
  const int grid_blocks = cus;
  Params p{};
  for (int i = 0; i < 38; ++i) p.in[i] = (const float*)d_in[i];
  p.out = (float*)d_out; p.ws = (char*)d_ws;
  (void)hipMemsetAsync((char*)d_ws + OFF_BAR, 0, XCD_BAR_WORDS * 4, stream);
  void* args[] = {&p};
  hipError_t e = hipLaunchCooperativeKernel((void*)mega, dim3(grid_blocks), dim3(NTHR), args, SMEM_BYTES, stream);
  if (e != hipSuccess) fprintf(stderr, "cooperative launch failed: %s (grid %d)\n", hipGetErrorString(e), grid_blocks);
}
```

```cpp
#include <hip/hip_runtime.h>
#include <hip/hip_cooperative_groups.h>
#include <cstdio>
namespace cg = cooperative_groups;

typedef unsigned short bf16_t;
typedef short bf16x8 __attribute__((ext_vector_type(8)));
typedef short s16x4 __attribute__((ext_vector_type(4)));
typedef float f32x4 __attribute__((ext_vector_type(4)));
typedef float f32x16 __attribute__((ext_vector_type(16)));
typedef unsigned u32x4 __attribute__((ext_vector_type(4)));
#define DI __device__ __forceinline__

constexpr int NTOK = 65536, DM = 1024, SEQ = 4096, PSTR = 3328, FFN = 2816, AUS = 5632;
constexpr int C_LRU_X = 0, C_LRU_Y = 256, C_SB_Q = 512, C_SB_K = 768, C_SB_V = 1024;
constexpr int C_GDN_Q = 1280, C_GDN_Z = 2048, C_GDN_A = 2304, C_GDN_B = 2308, C_RW = 2312;
constexpr float EPSF = 1e-6f;
#ifndef MASK
#define MASK 0x1ffff
#endif
#ifndef REP_M1
#define REP_M1 1
#endif
#ifndef REP_M2
#define REP_M2 1
#endif
#ifndef REP_G
#define REP_G 1
#endif
#ifndef REP_MISC
#define REP_MISC 1
#endif
constexpr int NTHR = 512;
constexpr int SMEM_BYTES = 131072 + 64;

constexpr size_t OFF_MODP = 0;
constexpr size_t OFF_WIN = 6291456;
constexpr size_t OFF_WG = OFF_WIN + 6815744;
constexpr size_t OFF_WBR = OFF_WG + 8388608;
constexpr size_t OFF_WO = OFF_WBR + 2097152;
constexpr size_t OFF_WF = OFF_WO + 2097152;
constexpr size_t OFF_WD = OFF_WF + 11534336;
constexpr size_t OFF_H = OFF_WD + 5767168;
constexpr size_t OFF_P = OFF_H + 134217728;
constexpr size_t OFF_O = OFF_P + 436207616;
constexpr size_t OFF_G = OFF_O + 134217728;
constexpr size_t GSZ = 33554432;
constexpr size_t OFF_GCD = OFF_G + 5 * GSZ;
constexpr size_t OFF_L = OFF_GCD + 16384;
constexpr size_t LSZ = 67108864;
constexpr size_t OFF_LCA = OFF_L + 2 * LSZ;
constexpr size_t OFF_LCH = OFF_LCA + 2097152;
constexpr size_t OFF_BON = OFF_LCH + 2097152;
constexpr size_t OFF_CTR = OFF_BON + 1048576;
constexpr size_t OFF_BAR = OFF_CTR + 256;
constexpr size_t WS_NEED = OFF_BAR + 16384;

struct Params { const float* in[38]; float* out; char* ws; };
enum { I_X = 0, I_C, I_N1G, I_N2G, I_FG, I_WADA, I_BADA, I_WIN, I_LCW, I_LCB, I_LWR, I_LBR, I_LWI, I_LBI, I_LLAM,
       I_GCW, I_GAL, I_GDT, I_GNG, I_RMU, I_RW0, I_RWUP, I_RA0, I_RAUP, I_RGUP, I_RKK, I_RKA, I_RRK, I_RLG, I_RLB,
       I_WBR, I_WGATE, I_BGATE, I_WOUT, I_FWG, I_FWU, I_FCW, I_FWD };

DI float bf2f(bf16_t v) { return __uint_as_float(((unsigned)v) << 16); }
DI unsigned pack2(float lo, float hi) { unsigned r; asm("v_cvt_pk_bf16_f32 %0, %1, %2" : "=v"(r) : "v"(lo), "v"(hi)); return r; }
DI bf16_t f2bf(float x) { return (bf16_t)(pack2(x, x) & 0xffffu); }
DI float sigmoidf_(float x) { return 1.f / (1.f + __expf(-x)); }
DI float softplusf_(float x) { return fmaxf(x, 0.f) + __logf(1.f + __expf(-fabsf(x))); }
DI float siluf_(float x) { return x / (1.f + __expf(-x)); }
DI float geluf_(float x) { float u = 0.7978845608f * (x + 0.044715f * x * x * x); return x / (1.f + __expf(-2.f * u)); }
DI float tanhf_(float x) { return 1.f - 2.f / (1.f + __expf(2.f * x)); }
DI float wave_sum(float x) {
#pragma unroll
  for (int o = 32; o >= 1; o >>= 1) x += __shfl_xor(x, o);
  return x;
}
template <int CTRL> DI float dppf(float x) { return __int_as_float(__builtin_amdgcn_update_dpp(0, __float_as_int(x), CTRL, 0xf, 0xf, true)); }
DI float reduce8(float x) { x += dppf<0xB1>(x); x += dppf<0x4E>(x); x += dppf<0x141>(x); return x; }
DI f32x16 mfma32(bf16x8 a, bf16x8 b, f32x16 c) { return __builtin_amdgcn_mfma_f32_32x32x16_bf16(a, b, c, 0, 0, 0); }
DI f32x4 mfma16(bf16x8 a, bf16x8 b, f32x4 c) { return __builtin_amdgcn_mfma_f32_16x16x32_bf16(a, b, c, 0, 0, 0); }
DI int crow(int i, int h) { return (i & 3) + 8 * (i >> 2) + 4 * h; }

DI float modv(const float* modp, const float* bada, int l, int b, int idx) {
  const float* q = modp + ((size_t)(l * 16 + b)) * 6144 + idx;
  const size_t ks = (size_t)4 * 16 * 6144;
  return bada[l * 6144 + idx] + q[0] + q[ks] + q[2 * ks] + q[3 * ks];
}

DI int otid() { int t = threadIdx.x; asm volatile("" : "+v"(t)); return t; }
DI int obid() { int b = blockIdx.x; asm volatile("" : "+s"(b)); return b; }
DI void phase_mod(const Params& p, char* smem) {
  float* sm = (float*)smem;
  float* modp = (float*)(p.ws + OFF_MODP);
  const int tid = otid();
  if (obid() == 0 && tid < 64) ((unsigned*)(p.ws + OFF_CTR))[tid] = 0u;
  for (int item = obid(); item < 192; item += gridDim.x) {
    const int l = item / 48, rem = item % 48, jb = rem >> 2, kq = rem & 3;
    for (int i = 0; i < 8; ++i) {
      int e = tid + 512 * i; int b = e >> 8, k = e & 255;
      float cv = p.in[I_C][b * 1024 + kq * 256 + k];
      sm[e] = siluf_(cv);
    }
    __syncthreads();
    float acc[16];
#pragma unroll
    for (int b = 0; b < 16; ++b) acc[b] = 0.f;
    const float* wp = p.in[I_WADA] + ((size_t)l * 1024 + kq * 256) * 6144 + jb * 512 + tid;
    for (int k = 0; k < 256; k += 4) {
      float w0 = wp[(size_t)k * 6144], w1 = wp[(size_t)(k + 1) * 6144], w2 = wp[(size_t)(k + 2) * 6144], w3 = wp[(size_t)(k + 3) * 6144];
#pragma unroll
      for (int b = 0; b < 16; ++b) {
        f32x4 cv = *(const f32x4*)(sm + b * 256 + k);
        acc[b] += cv[0] * w0 + cv[1] * w1 + cv[2] * w2 + cv[3] * w3;
      }
    }
#pragma unroll
    for (int b = 0; b < 16; ++b) modp[((size_t)((kq * 4 + l) * 16 + b)) * 6144 + jb * 512 + tid] = acc[b];
    __syncthreads();
  }
}

DI void conv_tile(const float* src, bf16_t* dst, int K, int N, int k0, int n0, char* smem) {
  float* tile = (float*)smem;
  const int tid = otid();
#pragma unroll
  for (int it = 0; it < 2; ++it) {
    int kr = (tid >> 4) + 32 * it, nc = (tid & 15) * 4;
    f32x4 v = {0.f, 0.f, 0.f, 0.f};
    if (n0 + nc < N) v = *(const f32x4*)(src + (size_t)(k0 + kr) * N + n0 + nc);
    tile[kr * 65 + nc] = v[0]; tile[kr * 65 + nc + 1] = v[1]; tile[kr * 65 + nc + 2] = v[2]; tile[kr * 65 + nc + 3] = v[3];
  }
  __syncthreads();
  {
    int n = tid >> 3, kc = (tid & 7) * 8;
    unsigned o[4];
#pragma unroll
    for (int e = 0; e < 4; ++e) o[e] = pack2(tile[(kc + 2 * e) * 65 + n], tile[(kc + 2 * e + 1) * 65 + n]);
    uint4 ov = {o[0], o[1], o[2], o[3]};
    *(uint4*)(dst + (size_t)(n0 + n) * K + k0 + kc) = ov;
  }
  __syncthreads();
}

DI void phase_convert(const Params& p, int l, char* smem) {
  for (int t = obid(); t < 4480; t += gridDim.x) {
    const float* src; bf16_t* dst; int K, N, Npad, tt = t;
    if (tt < 832) { src = p.in[I_WIN] + (size_t)l * 1024 * 3208; dst = (bf16_t*)(p.ws + OFF_WIN); K = 1024; N = 3208; Npad = 3328; }
    else if ((tt -= 832) < 1024) { int br = tt >> 8; tt &= 255; src = p.in[I_WGATE] + ((size_t)l * 4 + br) * 1048576; dst = (bf16_t*)(p.ws + OFF_WG) + (size_t)br * 1048576; K = 1024; N = 1024; Npad = 1024; }
    else if ((tt -= 1024) < 256) { int br = tt >> 6; tt &= 63; src = p.in[I_WBR] + ((size_t)l * 4 + br) * 262144; dst = (bf16_t*)(p.ws + OFF_WBR) + (size_t)br * 262144; K = 256; N = 1024; Npad = 1024; }
    else if ((tt -= 256) < 256) { src = p.in[I_WOUT] + (size_t)l * 1048576; dst = (bf16_t*)(p.ws + OFF_WO); K = 1024; N = 1024; Npad = 1024; }
    else if ((tt -= 256) < 704) { src = p.in[I_FWG] + (size_t)l * 1024 * 2816; dst = (bf16_t*)(p.ws + OFF_WF); K = 1024; N = 2816; Npad = 2816; }
    else if ((tt -= 704) < 704) { src = p.in[I_FWU] + (size_t)l * 1024 * 2816; dst = (bf16_t*)(p.ws + OFF_WF) + (size_t)2816 * 1024; K = 1024; N = 2816; Npad = 2816; }
    else { tt -= 704; src = p.in[I_FWD] + (size_t)l * 2816 * 1024; dst = (bf16_t*)(p.ws + OFF_WD); K = 2816; N = 1024; Npad = 1024; }
    const int nNt = Npad >> 6;
    const int kt = tt / nNt, nt = tt % nNt;
    conv_tile(src, dst, K, N, kt * 64, nt * 64, smem);
  }
}

DI void phase_norm(const Params& p, const float* xin, const float* g, int l, int scale_idx, int shift_idx, bf16_t* hout, float* fout) {
  const float* modp = (const float*)(p.ws + OFF_MODP);
  const int lane = otid() & 63, wv = otid() >> 6;
  const int nw = gridDim.x * 8;
  const int rows_per = 32;
  for (int chunk = obid() * 8 + wv; chunk < NTOK / 32; chunk += nw) {
  const int row0 = chunk * rows_per;
  const int b = row0 / SEQ;
  f32x4 gv[4], sc[4], sh[4];
#pragma unroll
  for (int j = 0; j < 4; ++j) {
    int c = lane * 4 + 256 * j;
    gv[j] = *(const f32x4*)(g + c);
    if (hout) {
#pragma unroll
      for (int e = 0; e < 4; ++e) {
        sc[j][e] = 1.f + modv(modp, p.in[I_BADA], l, b, scale_idx + c + e);
        sh[j][e] = modv(modp, p.in[I_BADA], l, b, shift_idx + c + e);
      }
    }
  }
  for (int rr = 0; rr < rows_per; ++rr) {
    const size_t row = (size_t)row0 + rr;
    f32x4 xv[4]; float ss = 0.f;
#pragma unroll
    for (int j = 0; j < 4; ++j) {
      xv[j] = *(const f32x4*)(xin + row * DM + lane * 4 + 256 * j);
      ss += xv[j][0] * xv[j][0] + xv[j][1] * xv[j][1] + xv[j][2] * xv[j][2] + xv[j][3] * xv[j][3];
    }
    ss = wave_sum(ss);
    const float rs = rsqrtf(ss * (1.f / 1024.f) + EPSF);
#pragma unroll
    for (int j = 0; j < 4; ++j) {
      f32x4 y = xv[j] * rs * gv[j];
      if (hout) {
        y = y * sc[j] + sh[j];
        uint2 o = {pack2(y[0], y[1]), pack2(y[2], y[3])};
        *(uint2*)(hout + row * DM + lane * 4 + 256 * j) = o;
      } else {
        *(f32x4*)(fout + row * DM + lane * 4 + 256 * j) = y;
      }
    }
  }
  }
}

#define PG_LAS __attribute__((address_space(3)))
namespace pg {
constexpr int BM = 256, BK = 64, HALF = 128, HTB = HALF * BK * 2, NXCD = 8, WGM = 8;
DI int lds_byte(int r, int c) { const int st = (r >> 4) * 2 + (c >> 5), rr = r & 15, cc = c & 31, ob = rr * 64 + cc * 2; return st * 1024 + (ob ^ (((ob >> 9) & 1) << 5)); }
DI void stage_rc(int b, int& R, int& C) { const int st = b / 1024, sb = b % 1024, swz = sb ^ (((sb >> 9) & 1) << 5); R = (st >> 1) * 16 + swz / 64; C = (st & 1) * 32 + (swz % 64) / 2; }
DI int perm32(int rho) { const int n = rho >> 4, i = rho & 15; return 8 * (i >> 2) + 4 * n + (i & 3); }
struct Unit { int pm, pn; int aux; long ao, bo; };
template <int REP> struct Order {
  int nM, nN, nwg, G, c, ashift; long astep, bstep, apnstep;
  DI void init(int M, int N, int G_, int c_, long astep_ = 0, long bstep_ = 0, int ashift_ = 0, long apnstep_ = 0) {
    nM = M / BM; nN = N / BM; nwg = nM * nN; G = G_; c = c_; astep = astep_; bstep = bstep_; ashift = ashift_; apnstep = apnstep_; }
  DI bool next(int i, Unit& u) const {
    const int ti = i / REP, aux = i % REP;
    const long L = (long)ti * G + c; if (L >= nwg) return false;
    int wgid = (int)L; { const int q = nwg / NXCD, r = nwg % NXCD, xcd = wgid % NXCD, off = wgid / NXCD; wgid = (xcd < r ? xcd * (q + 1) : r * (q + 1) + (xcd - r) * q) + off; }
    const int nig = WGM * nN, gid = wgid / nig, fm = gid * WGM, gsz = (nM - fm) < WGM ? (nM - fm) : WGM;
    u.pm = fm + ((wgid % nig) % gsz); u.pn = (wgid % nig) / gsz; u.aux = aux; u.ao = aux * astep + (long)(u.pn >> ashift) * apnstep; u.bo = aux * bstep; return true;
  }
};
DI unsigned cvt_pk_bf16(float lo, float hi) { unsigned r; asm volatile("v_cvt_pk_bf16_f32 %0, %1, %2" : "=v"(r) : "v"(lo), "v"(hi)); return r; }

template <class Epi, class Sched>
DI void gemm_phase(PG_LAS unsigned char* lds, const bf16_t* Ag, int lda, const bf16_t* Bg, int K, const Sched& S, const Epi& E) {
  const int tid = otid(), wid = __builtin_amdgcn_readfirstlane(tid >> 6), lane = tid & 63, wr = wid >> 2, wc = wid & 3, fr = lane & 15, fq = lane >> 4;
  const int nt = K / BK;
  unsigned voffA[2], voffB[2];
#pragma unroll
  for (int i = 0; i < 2; ++i) { int R, C; stage_rc(tid * 16 + i * 8192, R, C); const int Rb = Epi::PERM ? ((R & ~31) + perm32(R & 31)) : R;
    voffA[i] = (unsigned)(R * lda + C) * 2u; voffB[i] = (unsigned)(Rb * K + C) * 2u; }
  const size_t kstep = (size_t)(BK * 2);
  const size_t hstepA = (size_t)HALF * lda * 2, hstepB = (size_t)HALF * K * 2;
  const size_t tstepA = 2 * hstepA, tstepB = 2 * hstepB;
  const unsigned ldsw = (unsigned)wid * 1024u;
  const int aoff = lds_byte(wr * 64 + fr, fq * 8), boff = lds_byte(wc * 32 + fr, fq * 8);
#define PG_SA(b, h) (((b) * 2 + (h)) * HTB)
#define PG_SB(b, h) ((4 + (b) * 2 + (h)) * HTB)
#define PG_STAGE(bufoff, gbase, voff) do { _Pragma("unroll") for (int _i = 0; _i < 2; ++_i) \
    __builtin_amdgcn_global_load_lds((const unsigned*)((const char*)(gbase) + (voff)[_i]), (PG_LAS unsigned*)(lds + (bufoff) + ldsw + _i * 8192), 16, 0, 0); } while (0)
#define PG_LDA(dst, b, h) do { _Pragma("unroll") for (int m = 0; m < 4; ++m) _Pragma("unroll") for (int k = 0; k < 2; ++k) dst[m][k] = *(const PG_LAS bf16x8*)(lds + PG_SA(b, h) + aoff + m * 2048 + k * 1024); } while (0)
#define PG_LDB(dst, b, h) do { _Pragma("unroll") for (int n = 0; n < 2; ++n) _Pragma("unroll") for (int k = 0; k < 2; ++k) dst[n][k] = *(const PG_LAS bf16x8*)(lds + PG_SB(b, h) + boff + n * 2048 + k * 1024); } while (0)
#define PG_MMA(ai, bj, At, Bt) do { __builtin_amdgcn_s_setprio(1); _Pragma("unroll") for (int m = 0; m < 4; ++m) _Pragma("unroll") for (int n = 0; n < 2; ++n) _Pragma("unroll") for (int k = 0; k < 2; ++k) \
    acc[ai][bj][m][n] = __builtin_amdgcn_mfma_f32_16x16x32_bf16(Bt[n][k], At[m][k], acc[ai][bj][m][n], 0, 0, 0); __builtin_amdgcn_s_setprio(0); } while (0)
#define PG_WAIT_V(n) asm volatile("s_waitcnt vmcnt(" #n ")" ::: "memory")
#define PG_WAIT_L(n) asm volatile("s_waitcnt lgkmcnt(" #n ")" ::: "memory")
#define PG_BAR __builtin_amdgcn_s_barrier()
#define PG_SCHED __builtin_amdgcn_sched_barrier(0)
  Unit cur, nxt; int ui = 0;
  if (!S.next(0, cur)) return;
  f32x4 acc[2][2][4][2];
#pragma unroll
  for (int a = 0; a < 2; ++a)
#pragma unroll
    for (int b = 0; b < 2; ++b)
#pragma unroll
      for (int m = 0; m < 4; ++m)
#pragma unroll
        for (int n = 0; n < 2; ++n) acc[a][b][m][n] = (f32x4){0.f, 0.f, 0.f, 0.f};
  bf16x8 At[4][2], B0[2][2], B1[2][2];
  const char* cA = (const char*)Ag + (size_t)cur.pm * tstepA + cur.ao; const char* cB = (const char*)Bg + (size_t)cur.pn * tstepB + cur.bo;
  PG_STAGE(PG_SB(0, 0), cB, voffB); PG_STAGE(PG_SA(0, 0), cA, voffA); PG_STAGE(PG_SB(0, 1), cB + hstepB, voffB); PG_STAGE(PG_SA(0, 1), cA + hstepA, voffA);
  if (wr == 1) PG_BAR;
  PG_WAIT_V(4); PG_BAR;
  PG_STAGE(PG_SB(1, 0), cB + kstep, voffB); PG_STAGE(PG_SA(1, 0), cA + kstep, voffA); PG_STAGE(PG_SB(1, 1), cB + hstepB + kstep, voffB);
  PG_WAIT_V(6); PG_BAR;
  for (;;) {
    const bool has_next = S.next(ui + 1, nxt);
    const char* nA = has_next ? (const char*)Ag + (size_t)nxt.pm * tstepA + nxt.ao : cA; const char* nB = has_next ? (const char*)Bg + (size_t)nxt.pn * tstepB + nxt.bo : cB;
#pragma unroll 1
    for (int t = 0; t < nt; t += 2) {
      const bool last = (t == nt - 2);
      const char* a1 = cA + (size_t)(t + 1) * kstep;
      const char* a2 = last ? nA : cA + (size_t)(t + 2) * kstep; const char* b2 = last ? nB : cB + (size_t)(t + 2) * kstep;
      const char* a3 = a2 + kstep; const char* b3 = b2 + kstep;
      PG_LDB(B0, 0, 0); PG_SCHED; PG_LDA(At, 0, 0); PG_STAGE(PG_SA(1, 1), a1 + hstepA, voffA);
      PG_WAIT_L(8); PG_BAR; PG_WAIT_L(0); PG_MMA(0, 0, At, B0); PG_BAR; PG_SCHED;
      PG_LDB(B1, 0, 1); PG_STAGE(PG_SB(0, 0), b2, voffB);
      PG_BAR; PG_WAIT_L(0); PG_MMA(0, 1, At, B1); PG_BAR;
      PG_LDA(At, 0, 1); PG_STAGE(PG_SA(0, 0), a2, voffA);
      PG_BAR; PG_WAIT_L(0); PG_MMA(1, 0, At, B0); PG_BAR; PG_SCHED;
      PG_STAGE(PG_SB(0, 1), b2 + hstepB, voffB);
      PG_WAIT_V(6); PG_BAR; PG_MMA(1, 1, At, B1); PG_BAR;
      PG_LDB(B0, 1, 0); PG_SCHED; PG_LDA(At, 1, 0); PG_STAGE(PG_SA(0, 1), a2 + hstepA, voffA);
      PG_WAIT_L(8); PG_BAR; PG_WAIT_L(0); PG_MMA(0, 0, At, B0); PG_BAR; PG_SCHED;
      PG_LDB(B1, 1, 1); PG_STAGE(PG_SB(1, 0), b3, voffB);
      PG_BAR; PG_WAIT_L(0); PG_MMA(0, 1, At, B1); PG_BAR;
      PG_LDA(At, 1, 1); PG_STAGE(PG_SA(1, 0), a3, voffA);
      PG_BAR; PG_WAIT_L(0); PG_MMA(1, 0, At, B0); PG_BAR; PG_SCHED;
      PG_STAGE(PG_SB(1, 1), b3 + hstepB, voffB);
      PG_WAIT_V(6); PG_BAR; PG_MMA(1, 1, At, B1); PG_BAR;
    }
    E(acc, cur, wr, wc, fr, fq);
    if (!has_next) break;
#pragma unroll
    for (int a = 0; a < 2; ++a)
#pragma unroll
      for (int b = 0; b < 2; ++b)
#pragma unroll
        for (int m = 0; m < 4; ++m)
#pragma unroll
          for (int n = 0; n < 2; ++n) acc[a][b][m][n] = (f32x4){0.f, 0.f, 0.f, 0.f};
    cur = nxt; cA = nA; cB = nB; ++ui;
  }
  PG_WAIT_V(0);
  if (wr == 0) PG_BAR;
  PG_BAR;
#undef PG_SA
#undef PG_SB
#undef PG_STAGE
#undef PG_LDA
#undef PG_LDB
#undef PG_MMA
#undef PG_WAIT_V
#undef PG_WAIT_L
#undef PG_BAR
#undef PG_SCHED
}

template <int ACT> struct EpiBf16 {
  static constexpr bool PERM = true;
  bf16_t* O; int ldc; const float* bias;
  DI void operator()(const f32x4 (&acc)[2][2][4][2], const Unit& u, int wr, int wc, int fr, int fq) const {
    const int row0 = u.pm * BM + wr * 64 + fr, col0 = u.pn * BM + wc * 32 + 8 * fq;
    f32x4 bv[2][2];
#pragma unroll
    for (int bj = 0; bj < 2; ++bj)
#pragma unroll
      for (int n = 0; n < 2; ++n) bv[bj][n] = ACT ? *(const f32x4*)(bias + col0 + bj * HALF + 4 * n) : (f32x4){0.f, 0.f, 0.f, 0.f};
#pragma unroll
    for (int ai = 0; ai < 2; ++ai)
#pragma unroll
      for (int m = 0; m < 4; ++m) { bf16_t* rowp = O + (size_t)(row0 + ai * HALF + m * 16) * ldc + col0;
#pragma unroll
        for (int bj = 0; bj < 2; ++bj) { f32x4 v0 = acc[ai][bj][m][0] + bv[bj][0], v1 = acc[ai][bj][m][1] + bv[bj][1];
          if (ACT) {
#pragma unroll
            for (int j = 0; j < 4; ++j) { v0[j] = sigmoidf_(v0[j]); v1[j] = sigmoidf_(v1[j]); } }
          u32x4 w; w.x = cvt_pk_bf16(v0[0], v0[1]); w.y = cvt_pk_bf16(v0[2], v0[3]); w.z = cvt_pk_bf16(v1[0], v1[1]); w.w = cvt_pk_bf16(v1[2], v1[3]);
          *(u32x4*)(rowp + bj * HALF) = w; } }
  }
};
struct EpiBranch {
  static constexpr bool PERM = true;
  bf16_t* MIX; const bf16_t* G;
  DI void operator()(const f32x4 (&acc)[2][2][4][2], const Unit& u, int wr, int wc, int fr, int fq) const {
    const int row0 = u.pm * BM + wr * 64 + fr, col0 = u.pn * BM + wc * 32 + 8 * fq;
#pragma unroll
    for (int ai = 0; ai < 2; ++ai)
#pragma unroll
      for (int m = 0; m < 4; ++m) {
        asm volatile("" ::: "memory");
        const size_t row = (size_t)(row0 + ai * HALF + m * 16);
        bf16_t* mp = MIX + row * DM + col0; const bf16_t* gp = G + row * 4096 + u.aux * 1024 + col0;
#pragma unroll
        for (int bj = 0; bj < 2; ++bj) {
          const bf16x8 gv = *(const bf16x8*)(gp + bj * HALF);
          float o[8];
#pragma unroll
          for (int j = 0; j < 4; ++j) { o[j] = bf2f((bf16_t)gv[j]) * acc[ai][bj][m][0][j]; o[4 + j] = bf2f((bf16_t)gv[4 + j]) * acc[ai][bj][m][1][j]; }
          if (u.aux > 0) {
            const bf16x8 mv = *(const bf16x8*)(mp + bj * HALF);
#pragma unroll
            for (int j = 0; j < 8; ++j) o[j] += bf2f((bf16_t)mv[j]);
          }
          u32x4 w; w.x = cvt_pk_bf16(o[0], o[1]); w.y = cvt_pk_bf16(o[2], o[3]); w.z = cvt_pk_bf16(o[4], o[5]); w.w = cvt_pk_bf16(o[6], o[7]);
          *(u32x4*)(mp + bj * HALF) = w;
        }
      }
  }
};
struct EpiResid {
  static constexpr bool PERM = false;
  const float* xold; float* xnew; const float* modp; const float* bada; int l, gate_idx;
  DI void operator()(const f32x4 (&acc)[2][2][4][2], const Unit& u, int wr, int wc, int fr, int fq) const {
    const int row0 = u.pm * BM + wr * 64 + fr, col0 = u.pn * BM + wc * 32 + 4 * fq;
    const int b = (u.pm * BM) / SEQ;
    f32x4 gv[2][2];
#pragma unroll
    for (int bj = 0; bj < 2; ++bj)
#pragma unroll
      for (int n = 0; n < 2; ++n)
#pragma unroll
        for (int j = 0; j < 4; ++j) gv[bj][n][j] = modv(modp, bada, l, b, gate_idx + col0 + bj * HALF + n * 16 + j);
#pragma unroll
    for (int ai = 0; ai < 2; ++ai)
#pragma unroll
      for (int m = 0; m < 4; ++m) { const size_t ro = (size_t)(row0 + ai * HALF + m * 16) * DM + col0;
#pragma unroll
        for (int bj = 0; bj < 2; ++bj)
#pragma unroll
          for (int n = 0; n < 2; ++n) {
            const f32x4 xo = *(const f32x4*)(xold + ro + bj * HALF + n * 16);
            *(f32x4*)(xnew + ro + bj * HALF + n * 16) = xo + gv[bj][n] * acc[ai][bj][m][n];
          } }
  }
};
struct EpiFfnAct {
  static constexpr bool PERM = true;
  bf16_t* ACT; const bf16_t* APRE; const float* cw;
  DI void operator()(const f32x4 (&acc)[2][2][4][2], const Unit& u, int wr, int wc, int fr, int fq) const {
    const int row0 = u.pm * BM + wr * 64 + fr, col0 = u.pn * BM + wc * 32 + 8 * fq;
#pragma unroll
    for (int ai = 0; ai < 2; ++ai)
#pragma unroll
      for (int m = 0; m < 4; ++m) {
        asm volatile("" ::: "memory");
        const int row = row0 + ai * HALF + m * 16; const int sp = row & (SEQ - 1);
        const bf16_t* ap = APRE + (size_t)row * FFN + col0;
        bf16_t* op = ACT + (size_t)row * FFN + col0;
#pragma unroll
        for (int bj = 0; bj < 2; ++bj) {
          const int c = bj * HALF;
          const bf16x8 z8 = {0, 0, 0, 0, 0, 0, 0, 0};
          const bf16x8 a0 = *(const bf16x8*)(ap + c);
          const bf16x8 a1 = sp >= 1 ? *(const bf16x8*)(ap - FFN + c) : z8;
          const bf16x8 a2 = sp >= 2 ? *(const bf16x8*)(ap - 2 * FFN + c) : z8;
          float o[8];
#pragma unroll
          for (int hh = 0; hh < 2; ++hh) {
            const f32x4 w0 = *(const f32x4*)(cw + col0 + c + 4 * hh), w1 = *(const f32x4*)(cw + FFN + col0 + c + 4 * hh), w2 = *(const f32x4*)(cw + 2 * FFN + col0 + c + 4 * hh);
#pragma unroll
            for (int j = 0; j < 4; ++j) {
              const float cv = w0[j] * bf2f((bf16_t)a2[4 * hh + j]) + w1[j] * bf2f((bf16_t)a1[4 * hh + j]) + w2[j] * bf2f((bf16_t)a0[4 * hh + j]);
              o[4 * hh + j] = geluf_(cv) * acc[ai][bj][m][hh][j];
            }
          }
          u32x4 w; w.x = cvt_pk_bf16(o[0], o[1]); w.y = cvt_pk_bf16(o[2], o[3]); w.z = cvt_pk_bf16(o[4], o[5]); w.w = cvt_pk_bf16(o[6], o[7]);
          *(u32x4*)(op + c) = w;
        }
      }
  }
};
struct EpiGateMix {
  static constexpr bool PERM = true;
  bf16_t* MIX; float* MIX32; const bf16_t* BH; const float* bias;
  DI void operator()(const f32x4 (&acc)[2][2][4][2], const Unit& u, int wr, int wc, int fr, int fq) const {
    const int row0 = u.pm * BM + wr * 64 + fr, col0 = u.pn * BM + wc * 32 + 8 * fq;
    const bool rmw = u.aux > 0, fin = u.aux == 3;
    f32x4 bv[2][2];
#pragma unroll
    for (int bj = 0; bj < 2; ++bj)
#pragma unroll
      for (int n = 0; n < 2; ++n) bv[bj][n] = *(const f32x4*)(bias + u.aux * 1024 + col0 + bj * HALF + 4 * n);
    const f32x4 z4 = {0.f, 0.f, 0.f, 0.f};
    bf16x8 nb[2]; f32x4 nm[2][2];
#define GM_LOAD(it_) { const size_t row_ = (size_t)(row0 + ((it_) >> 2) * HALF + ((it_) & 3) * 16); \
      _Pragma("unroll") for (int bj = 0; bj < 2; ++bj) { nb[bj] = *(const bf16x8*)(BH + row_ * 4096 + u.aux * 1024 + col0 + bj * HALF); \
        nm[bj][0] = rmw ? *(const f32x4*)(MIX32 + row_ * DM + col0 + bj * HALF) : z4; nm[bj][1] = rmw ? *(const f32x4*)(MIX32 + row_ * DM + col0 + bj * HALF + 4) : z4; } }
    GM_LOAD(0);
#pragma unroll
    for (int it = 0; it < 8; ++it) {
      const int ai = it >> 2, m = it & 3;
      bf16x8 cb[2]; f32x4 cm[2][2];
#pragma unroll
      for (int bj = 0; bj < 2; ++bj) { cb[bj] = nb[bj]; cm[bj][0] = nm[bj][0]; cm[bj][1] = nm[bj][1]; }
      if (it + 1 < 8) GM_LOAD(it + 1);
      const size_t ro = (size_t)(row0 + ai * HALF + m * 16) * DM + col0;
#pragma unroll
      for (int bj = 0; bj < 2; ++bj) {
        f32x4 o[2];
#pragma unroll
        for (int hh = 0; hh < 2; ++hh)
#pragma unroll
          for (int j = 0; j < 4; ++j)
            o[hh][j] = sigmoidf_(acc[ai][bj][m][hh][j] + bv[bj][hh][j]) * bf2f((bf16_t)cb[bj][4 * hh + j]) + cm[bj][hh][j];
        if (fin) {
          u32x4 w; w.x = cvt_pk_bf16(o[0][0], o[0][1]); w.y = cvt_pk_bf16(o[0][2], o[0][3]); w.z = cvt_pk_bf16(o[1][0], o[1][1]); w.w = cvt_pk_bf16(o[1][2], o[1][3]);
          *(u32x4*)(MIX + ro + bj * HALF) = w;
        } else {
          *(f32x4*)(MIX32 + ro + bj * HALF) = o[0]; *(f32x4*)(MIX32 + ro + bj * HALF + 4) = o[1];
        }
      }
    }
#undef GM_LOAD
  }
};
}

DI void phase_ffn_act(const Params& p, int l) {
  bf16_t* AU = (bf16_t*)(p.ws + OFF_P);
  const float* cw = p.in[I_FCW] + (size_t)l * 3 * FFN;
  const int nthr = gridDim.x * NTHR;
  for (int run = obid() * NTHR + otid(); run < 1024 * 352; run += nthr) {
    const int ch = run / 352, j8 = run % 352, j0 = j8 * 8;
    float w0[8], w1[8], w2[8];
#pragma unroll
    for (int e = 0; e < 8; ++e) { w0[e] = cw[j0 + e]; w1[e] = cw[FFN + j0 + e]; w2[e] = cw[2 * FFN + j0 + e]; }
    const int t0 = ch * 64, s0 = t0 % SEQ;
    float a1[8], a2[8];
#pragma unroll
    for (int e = 0; e < 8; ++e) { a1[e] = 0.f; a2[e] = 0.f; }
    if (s0 > 0) {
      bf16x8 v1 = *(const bf16x8*)(AU + (size_t)(t0 - 1) * AUS + j0);
      bf16x8 v2 = *(const bf16x8*)(AU + (size_t)(t0 - 2) * AUS + j0);
#pragma unroll
      for (int e = 0; e < 8; ++e) { a1[e] = bf2f((bf16_t)v1[e]); a2[e] = bf2f((bf16_t)v2[e]); }
    }
    for (int t = t0; t < t0 + 64; ++t) {
      bf16x8 va = *(const bf16x8*)(AU + (size_t)t * AUS + j0);
      bf16x8 vu = *(const bf16x8*)(AU + (size_t)t * AUS + FFN + j0);
      float o[8];
#pragma unroll
      for (int e = 0; e < 8; ++e) {
        float a0 = bf2f((bf16_t)va[e]);
        float cv = w0[e] * a2[e] + w1[e] * a1[e] + w2[e] * a0;
        o[e] = geluf_(cv) * bf2f((bf16_t)vu[e]);
        a2[e] = a1[e]; a1[e] = a0;
      }
      uint4 ov = {pack2(o[0], o[1]), pack2(o[2], o[3]), pack2(o[4], o[5]), pack2(o[6], o[7])};
      *(uint4*)(AU + (size_t)t * AUS + FFN + j0) = ov;
    }
  }
}

DI float mixf(bf16_t cur, bf16_t prev, float mu) { const float c = bf2f(cur); return c + (bf2f(prev) - c) * mu; }
DI void rw_prep_item(const Params& p, int l, int item, char* smem) {
  const bf16_t* P = (const bf16_t*)(p.ws + OFF_P);
  bf16_t* RD = (bf16_t*)(p.ws + OFF_L);
  bf16_t* RKK = (bf16_t*)(p.ws + OFF_L + GSZ);
  bf16_t* RA = (bf16_t*)(p.ws + OFF_L + 2 * GSZ);
  bf16_t* RG = (bf16_t*)(p.ws + OFF_L + 3 * GSZ);
  float* BON = (float*)(p.ws + OFF_BON);
  const int b = item >> 6, ct = item & 63;
  const int tid = otid(), lane = tid & 63, wv = tid >> 6, hd = wv & 3, mi = wv >> 2, r = lane & 31, h = lane >> 5;
  bf16_t* TX = (bf16_t*)smem;
  bf16_t* XA = TX + 64 * 40;
  bf16_t* SG = XA + 64 * 40;
  const float* mu = p.in[I_RMU] + (size_t)l * 896;
  const size_t tok0 = (size_t)b * SEQ + ct * 64;
  bf16x8 bw[2][2], ba[2][2], bg[2][4];
  {
    const float* wp = p.in[I_RWUP] + (size_t)l * 32 * 256 + hd * 64 + r;
    const float* ap = p.in[I_RAUP] + (size_t)l * 32 * 256 + hd * 64 + r;
    const float* gp = p.in[I_RGUP] + (size_t)l * 64 * 256 + hd * 64 + r;
    asm volatile("" : "+v"(wp), "+v"(ap), "+v"(gp));
#pragma unroll
    for (int ni = 0; ni < 2; ++ni) {
#pragma unroll
      for (int ks = 0; ks < 2; ++ks) {
        unsigned uw[4], ua[4];
#pragma unroll
        for (int j2 = 0; j2 < 4; ++j2) {
          const int k = 16 * ks + 8 * h + 2 * j2;
          uw[j2] = pack2(wp[k * 256 + 32 * ni], wp[(k + 1) * 256 + 32 * ni]);
          ua[j2] = pack2(ap[k * 256 + 32 * ni], ap[(k + 1) * 256 + 32 * ni]);
        }
        uint4 t1 = {uw[0], uw[1], uw[2], uw[3]}, t2 = {ua[0], ua[1], ua[2], ua[3]};
        bw[ni][ks] = __builtin_bit_cast(bf16x8, t1); ba[ni][ks] = __builtin_bit_cast(bf16x8, t2);
      }
#pragma unroll
      for (int ks = 0; ks < 4; ++ks) {
        unsigned ug[4];
#pragma unroll
        for (int j2 = 0; j2 < 4; ++j2) { const int k = 16 * ks + 8 * h + 2 * j2; ug[j2] = pack2(gp[k * 256 + 32 * ni], gp[(k + 1) * 256 + 32 * ni]); }
        uint4 t3 = {ug[0], ug[1], ug[2], ug[3]};
        bg[ni][ks] = __builtin_bit_cast(bf16x8, t3);
      }
    }
  }
#pragma unroll 4
  for (int i = 0; i < 16; ++i) {
    const int e = tid + NTHR * i; const int t = e >> 7, f = e & 127;
    const bf16_t* pr = P + (tok0 + t) * PSTR + C_RW + 768 + f;
    const bf16_t cur = pr[0];
    const bf16_t prev = (ct * 64 + t > 0) ? (pr - PSTR)[0] : (bf16_t)0;
    const float m = mixf(cur, prev, mu[768 + f]);
    if (f < 32) TX[t * 40 + f] = f2bf(tanhf_(m));
    else if (f < 64) XA[t * 40 + f - 32] = f2bf(m);
    else SG[t * 72 + f - 64] = f2bf(sigmoidf_(m));
  }
  __syncthreads();
  f32x16 cw[2], ca[2], cg[2];
#pragma unroll
  for (int ni = 0; ni < 2; ++ni)
#pragma unroll
    for (int i = 0; i < 16; ++i) { cw[ni][i] = 0.f; ca[ni][i] = 0.f; cg[ni][i] = 0.f; }
#pragma unroll
  for (int ks = 0; ks < 2; ++ks) {
    const bf16x8 atx = *(const bf16x8*)(TX + (32 * mi + r) * 40 + 16 * ks + 8 * h);
    const bf16x8 axa = *(const bf16x8*)(XA + (32 * mi + r) * 40 + 16 * ks + 8 * h);
#pragma unroll
    for (int ni = 0; ni < 2; ++ni) { cw[ni] = mfma32(atx, bw[ni][ks], cw[ni]); ca[ni] = mfma32(axa, ba[ni][ks], ca[ni]); }
  }
#pragma unroll
  for (int ks = 0; ks < 4; ++ks) {
    const bf16x8 asg = *(const bf16x8*)(SG + (32 * mi + r) * 72 + 16 * ks + 8 * h);
#pragma unroll
    for (int ni = 0; ni < 2; ++ni) cg[ni] = mfma32(asg, bg[ni][ks], cg[ni]);
  }
  float ss[16], bn[16];
#pragma unroll
  for (int i = 0; i < 16; ++i) { ss[i] = 0.f; bn[i] = 0.f; }
#pragma unroll
  for (int ni = 0; ni < 2; ++ni) {
    const int hc = hd * 64 + 32 * ni + r;
    const float w0c = p.in[I_RW0][l * 256 + hc], a0c = p.in[I_RA0][l * 256 + hc], kkc = p.in[I_RKK][l * 256 + hc],
                kac = p.in[I_RKA][l * 256 + hc], rkc = p.in[I_RRK][l * 256 + hc], mu_r = mu[hc], mu_k = mu[256 + hc];
#pragma unroll
    for (int i = 0; i < 16; ++i) {
      const int tl = 32 * mi + crow(i, h);
      const size_t tok = tok0 + tl;
      const bf16_t* pr = P + tok * PSTR + C_RW + hc;
      const bool hp = (ct * 64 + tl) > 0;
      const float rr = mixf(pr[0], hp ? (pr - PSTR)[0] : (bf16_t)0, mu_r);
      const float k = mixf(pr[256], hp ? (pr - PSTR)[256] : (bf16_t)0, mu_k);
      const float wl = w0c + cw[ni][i];
      const float wlog = -softplusf_(-wl) - 0.5f;
      const float dd = 1.f - __expf(-__expf(wlog));
      const float a = sigmoidf_(a0c + ca[ni][i]);
      const float kkr = k * kkc;
      const float kp = k * (1.f + (a - 1.f) * kac);
      ss[i] += kkr * kkr; bn[i] += rr * kp * rkc;
      cw[ni][i] = kkr;
      RD[tok * 256 + hc] = f2bf(dd); RA[tok * 256 + hc] = f2bf(a); RG[tok * 256 + hc] = f2bf(cg[ni][i]);
    }
  }
#pragma unroll
  for (int i = 0; i < 16; ++i) {
#pragma unroll
    for (int o = 1; o < 32; o <<= 1) { ss[i] += __shfl_xor(ss[i], o); bn[i] += __shfl_xor(bn[i], o); }
    ss[i] = rsqrtf(ss[i] + EPSF);
  }
#pragma unroll
  for (int ni = 0; ni < 2; ++ni) {
    const int hc = hd * 64 + 32 * ni + r;
#pragma unroll
    for (int i = 0; i < 16; ++i) {
      const size_t tok = tok0 + 32 * mi + crow(i, h);
      RKK[tok * 256 + hc] = f2bf(cw[ni][i] * ss[i]);
    }
  }
  if (r == 0) {
#pragma unroll
    for (int i = 0; i < 16; ++i) BON[(tok0 + 32 * mi + crow(i, h)) * 4 + hd] = bn[i];
  }
}

DI void rwkv_scan_item(const Params& p, int l, int b, int hd, int half, char* smem) {
  const bf16_t* P = (const bf16_t*)(p.ws + OFF_P);
  bf16_t* O = (bf16_t*)(p.ws + OFF_O);
  const bf16_t* RD = (const bf16_t*)(p.ws + OFF_L);
  const bf16_t* RKK = (const bf16_t*)(p.ws + OFF_L + GSZ);
  const bf16_t* RA = (const bf16_t*)(p.ws + OFF_L + 2 * GSZ);
  float* fb = (float*)smem;
  float* Yb = fb + 2 * 6208;
  const int tid = otid(), lane = tid & 63, wv = tid >> 6;
  const int hc = hd * 64 + lane;
  constexpr int NCH = SEQ / 16;
  float S[8];
#pragma unroll
  for (int j = 0; j < 8; ++j) S[j] = 0.f;
  const int rl = lane >> 3, kq = lane & 7, vloc = (wv & 3) * 8 + rl, vrow = half * 32 + vloc;
  const float* mu = p.in[I_RMU] + (size_t)l * 896;
  const float mu_r = mu[hc], mu_k = mu[256 + hc], mu_v = mu[512 + hc];
  const float kac = p.in[I_RKA][l * 256 + hc];
  const int pw = wv & 3;
  unsigned raw[4][9];
#pragma unroll
  for (int j = 0; j < 4; ++j)
#pragma unroll
    for (int e = 0; e < 9; ++e) raw[j][e] = 0u;
#define RAWLOAD(i_)                                                                                 \
  {                                                                                                 \
    _Pragma("unroll") for (int j = 0; j < 4; ++j) {                                                 \
      const int s_ = (i_) * 16 + pw * 4 + j;                                                        \
      const size_t tok_ = (size_t)b * SEQ + s_;                                                     \
      const bf16_t* pr_ = P + tok_ * PSTR + C_RW;                                                   \
      raw[j][0] = pr_[hc]; raw[j][1] = pr_[256 + hc]; raw[j][2] = pr_[512 + hc];                    \
      if (s_ > 0) { raw[j][3] = (pr_ - PSTR)[hc]; raw[j][4] = (pr_ - PSTR)[256 + hc]; raw[j][5] = (pr_ - PSTR)[512 + hc]; } \
      else { raw[j][3] = 0u; raw[j][4] = 0u; raw[j][5] = 0u; }                                      \
      raw[j][6] = RD[tok_ * 256 + hc]; raw[j][7] = RKK[tok_ * 256 + hc]; raw[j][8] = RA[tok_ * 256 + hc]; \
    }                                                                                               \
  }
#define RBAR() { asm volatile("s_waitcnt lgkmcnt(0)" ::: "memory"); __builtin_amdgcn_s_barrier(); asm volatile("" ::: "memory"); }
  if (wv >= 4) RAWLOAD(0);
#pragma unroll 1
  for (int i = 0; i < NCH + 2; ++i) {
    if (wv >= 4) {
      float* B = fb + (i & 1) * 6208;
      if (i >= 2) {
        const float* Yc = Yb + (i & 1) * 512;
        if (lane < 32) {
#pragma unroll
          for (int j = 0; j < 4; ++j) {
            const int tl = pw * 4 + j;
            const size_t tok = (size_t)b * SEQ + (i - 2) * 16 + tl;
            O[tok * DM + 768 + hd * 64 + half * 32 + lane] = f2bf(Yc[tl * 32 + lane]);
          }
        }
      }
      if (i < NCH) {
#pragma unroll
        for (int j = 0; j < 4; ++j) {
          const int tl = pw * 4 + j;
          const float r = mixf((bf16_t)raw[j][0], (bf16_t)raw[j][3], mu_r), k = mixf((bf16_t)raw[j][1], (bf16_t)raw[j][4], mu_k), v = mixf((bf16_t)raw[j][2], (bf16_t)raw[j][5], mu_v);
          const float w = 1.f - bf2f((bf16_t)raw[j][6]), kk = bf2f((bf16_t)raw[j][7]), a = bf2f((bf16_t)raw[j][8]);
          const float ka = kk * a, kp = k * (1.f + (a - 1.f) * kac);
          const float c1 = wave_sum(ka * r), c2 = wave_sum(kp * r);
          B[tl * 64 + lane] = w; B[1024 + tl * 64 + lane] = kk; B[2048 + tl * 64 + lane] = ka; B[3072 + tl * 64 + lane] = kp;
          B[4096 + tl * 64 + lane] = w * r; B[5120 + tl * 64 + lane] = v;
          if (lane == 0) { B[6144 + tl * 2] = c1; B[6144 + tl * 2 + 1] = c2; }
        }
        if (i + 1 < NCH) RAWLOAD(i + 1);
      }
    } else if (i >= 1 && i <= NCH) {
      const float* B = fb + ((i - 1) & 1) * 6208;
      float* Yc = Yb + ((i - 1) & 1) * 512;
      f32x4 vw[2][10]; float vvv[2]; float2 vsc[2];
#define RWLD(t_, s_)                                                                              \
      { const float* bt_ = B + (t_) * 64 + kq * 8;                                                 \
        _Pragma("unroll") for (int q_ = 0; q_ < 5; ++q_) { vw[s_][2 * q_] = *(const f32x4*)(bt_ + 1024 * q_); vw[s_][2 * q_ + 1] = *(const f32x4*)(bt_ + 1024 * q_ + 4); } \
        vvv[s_] = B[5120 + (t_) * 64 + vrow]; vsc[s_] = *(const float2*)(B + 6144 + (t_) * 2); }
      RWLD(0, 0);
#pragma unroll
      for (int t = 0; t < 16; ++t) {
        const int cs = t & 1;
        if (t + 1 < 16) RWLD(t + 1, cs ^ 1);
        const f32x4 w0 = vw[cs][0], w1 = vw[cs][1], kk0 = vw[cs][2], kk1 = vw[cs][3], ka0 = vw[cs][4], ka1 = vw[cs][5],
                    kp0 = vw[cs][6], kp1 = vw[cs][7], wr0 = vw[cs][8], wr1 = vw[cs][9];
        const float vv = vvv[cs]; const float2 sc = vsc[cs];
        float d0 = 0.f, e0 = 0.f;
#pragma unroll
        for (int j = 0; j < 4; ++j) { d0 += S[j] * kk0[j] + S[j + 4] * kk1[j]; e0 += S[j] * wr0[j] + S[j + 4] * wr1[j]; }
        d0 = reduce8(d0); e0 = reduce8(e0);
        const float sa0 = -d0;
        const float y0 = e0 + sa0 * sc.x + vv * sc.y;
#pragma unroll
        for (int j = 0; j < 4; ++j) {
          S[j] = S[j] * w0[j] + sa0 * ka0[j] + vv * kp0[j]; S[j + 4] = S[j + 4] * w1[j] + sa0 * ka1[j] + vv * kp1[j];
        }
        if (kq == 0) Yc[t * 32 + vloc] = y0;
      }
#undef RWLD
    }
    RBAR();
  }
#undef RAWLOAD
#undef RBAR
}

DI void rwkv_post(const Params& p, int l) {
  const bf16_t* P = (const bf16_t*)(p.ws + OFF_P);
  bf16_t* O = (bf16_t*)(p.ws + OFF_O);
  const bf16_t* RG = (const bf16_t*)(p.ws + OFF_L + 3 * GSZ);
  const float* BON = (const float*)(p.ws + OFF_BON);
  const int tid = otid(), lane = tid & 63, wv = tid >> 6;
  const float* mu = p.in[I_RMU] + (size_t)l * 896;
  const int nw = gridDim.x * 8;
  for (int task0 = (obid() * 8 + wv) * 4; task0 < NTOK * 4; task0 += nw * 4) {
    float yv[4], vv[4], gv[4], bv[4];
#pragma unroll
    for (int q = 0; q < 4; ++q) {
      const int task = task0 + q; const size_t tok = task >> 2; const int hd = task & 3, hc = hd * 64 + lane;
      yv[q] = bf2f(O[tok * DM + 768 + hc]);
      const bf16_t cur = P[tok * PSTR + C_RW + 512 + hc];
      const bf16_t prev = (tok % SEQ) ? P[(tok - 1) * PSTR + C_RW + 512 + hc] : (bf16_t)0;
      vv[q] = mixf(cur, prev, mu[512 + hc]);
      gv[q] = bf2f(RG[tok * 256 + hc]); bv[q] = BON[tok * 4 + hd];
    }
#pragma unroll
    for (int q = 0; q < 4; ++q) {
      const int task = task0 + q; const size_t tok = task >> 2; const int hd = task & 3, hc = hd * 64 + lane;
      const float mean = wave_sum(yv[q]) * (1.f / 64.f);
      const float d = yv[q] - mean;
      const float var = wave_sum(d * d) * (1.f / 64.f);
      const float yn = d * rsqrtf(var + 64e-5f) * p.in[I_RLG][l * 256 + hc] + p.in[I_RLB][l * 256 + hc];
      O[tok * DM + 768 + hc] = f2bf((yn + bv[q] * vv[q]) * gv[q]);
    }
  }
}

DI void sb_item(const Params& p, int item, char* smem) {
  const bf16_t* P = (const bf16_t*)(p.ws + OFF_P);
  bf16_t* O = (bf16_t*)(p.ws + OFF_O);
  const int qt = item & 15, hd = (item >> 4) & 3, b = item >> 6;
  const int tid = otid(), lane = tid & 63, wv = tid >> 6, r = lane & 31, h = lane >> 5;
  bf16_t* Vt = (bf16_t*)(smem + wv * 8704);
  const int q0 = qt * 256 + wv * 32;
  const int sq = q0 + r;
  const size_t tokb = (size_t)b * SEQ;
  bf16x8 qf[4];
#pragma unroll
  for (int ks = 0; ks < 4; ++ks) qf[ks] = *(const bf16x8*)(P + (tokb + sq) * PSTR + C_SB_Q + hd * 64 + ks * 16 + h * 8);
  f32x16 accO[2];
#pragma unroll
  for (int i = 0; i < 16; ++i) { accO[0][i] = 0.f; accO[1][i] = 0.f; }
  float Prun = 1.f;
  bf16x8 kf[2][4];
  const int kt0 = (q0 + 31) >> 6;
#define SBKLOAD(kt_) { _Pragma("unroll") for (int m = 0; m < 2; ++m) _Pragma("unroll") for (int ks = 0; ks < 4; ++ks) \
    kf[m][ks] = *(const bf16x8*)(P + (tokb + (kt_) * 64 + 32 * m + r) * PSTR + C_SB_K + hd * 64 + ks * 16 + h * 8); }
  SBKLOAD(kt0);
  for (int kt = kt0; kt >= 0; --kt) {
    const int k0 = kt * 64;
    bf16x8 vr[8];
#pragma unroll
    for (int it = 0; it < 8; ++it) vr[it] = *(const bf16x8*)(P + (tokb + k0 + it * 8 + (lane >> 3)) * PSTR + C_SB_V + hd * 64 + (lane & 7) * 8);
    f32x16 acc[2];
#pragma unroll
    for (int m = 0; m < 2; ++m) {
#pragma unroll
      for (int i = 0; i < 16; ++i) acc[m][i] = 0.f;
#pragma unroll
      for (int ks = 0; ks < 4; ++ks) acc[m] = mfma32(kf[m][ks], qf[ks], acc[m]);
    }
    if (kt > 0) SBKLOAD(kt - 1);
    float om[2][16];
#pragma unroll
    for (int m = 0; m < 2; ++m)
#pragma unroll
      for (int i = 0; i < 16; ++i) {
        const int key = k0 + 32 * m + crow(i, h);
        const float z = fmaxf(acc[m][i] * 0.125f, -80.f);
        const float e = __expf(-z);
        const float sg = __builtin_amdgcn_rcpf(1.f + e);
        const bool valid = key < sq;
        acc[m][i] = valid ? sg : 0.f;
        om[m][i] = valid ? e * sg : 1.f;
      }
    float gp[8];
#pragma unroll
    for (int q = 0; q < 8; ++q) {
      const int m = q >> 2, g = q & 3;
      gp[q] = (om[m][4 * g] * om[m][4 * g + 1]) * (om[m][4 * g + 2] * om[m][4 * g + 3]);
    }
    float run = 1.f;
#pragma unroll
    for (int q = 7; q >= 0; --q) {
      const int m = q >> 2, g = q & 3;
      const float pg = __shfl_xor(gp[q], 32);
      const float f3 = Prun * run * (h == 0 ? pg : 1.f);
      const float f2 = f3 * om[m][4 * g + 3], f1 = f2 * om[m][4 * g + 2], f0 = f1 * om[m][4 * g + 1];
      acc[m][4 * g + 3] *= f3; acc[m][4 * g + 2] *= f2; acc[m][4 * g + 1] *= f1; acc[m][4 * g + 0] *= f0;
      run *= gp[q] * pg;
    }
    Prun *= run;
    __builtin_amdgcn_wave_barrier();
#pragma unroll
    for (int it = 0; it < 8; ++it) {
      const int key = it * 8 + (lane >> 3), chv = lane & 7;
#pragma unroll
      for (int e = 0; e < 8; ++e) Vt[(chv * 8 + e) * 68 + key] = (bf16_t)vr[it][e];
    }
    __builtin_amdgcn_wave_barrier();
#pragma unroll
    for (int m = 0; m < 2; ++m)
#pragma unroll
      for (int s2 = 0; s2 < 2; ++s2) {
        uint4 uu = {pack2(acc[m][8 * s2 + 0], acc[m][8 * s2 + 1]), pack2(acc[m][8 * s2 + 2], acc[m][8 * s2 + 3]),
                    pack2(acc[m][8 * s2 + 4], acc[m][8 * s2 + 5]), pack2(acc[m][8 * s2 + 6], acc[m][8 * s2 + 7])};
        const bf16x8 pb = __builtin_bit_cast(bf16x8, uu);
#pragma unroll
        for (int dt = 0; dt < 2; ++dt) {
          const bf16_t* vp = Vt + (32 * dt + r) * 68 + 32 * m + 16 * s2 + 4 * h;
          s16x4 lo = *(const s16x4*)vp, hi = *(const s16x4*)(vp + 8);
          bf16x8 va = __builtin_shufflevector(lo, hi, 0, 1, 2, 3, 4, 5, 6, 7);
          accO[dt] = mfma32(va, pb, accO[dt]);
        }
      }
    __builtin_amdgcn_wave_barrier();
    if (__ballot(Prun > 1e-37f) == 0ull) break;
  }
#undef SBKLOAD
#pragma unroll
  for (int dt = 0; dt < 2; ++dt)
#pragma unroll
    for (int g = 0; g < 4; ++g) {
      const int d = 32 * dt + 8 * g + 4 * h;
      uint2 o = {pack2(accO[dt][4 * g], accO[dt][4 * g + 1]), pack2(accO[dt][4 * g + 2], accO[dt][4 * g + 3])};
      *(uint2*)(O + (tokb + sq) * DM + 256 + hd * 64 + d) = o;
    }
}

DI int frag_off(int row, int k) {
  const int rt = row >> 4, fr = row & 15, ks = k >> 5, kk = k & 31, hi = kk >> 4, fq = (kk & 15) >> 2, j = (kk & 3) + 4 * hi;
  return ((rt * 2 + ks) * 64 + fq * 16 + fr) * 8 + j;
}
DI int frag_off8(int row, int k0) {
  const int rt = row >> 4, fr = row & 15, ks = k0 >> 5, kk = k0 & 31, hi = kk >> 4, fq = (kk & 15) >> 2;
  return ((rt * 2 + ks) * 64 + fq * 16 + fr) * 8 + 4 * hi;
}
DI void gdn_intra_item(const Params& p, int l, int item, char* smem) {
  const bf16_t* P = (const bf16_t*)(p.ws + OFF_P);
  const int hp = item & 1, c = (item >> 1) & 63, b = item >> 7;
  const int tid = otid(), lane = tid & 63;
  bf16_t* Kb = (bf16_t*)smem;
  bf16_t* Qb = Kb + 2 * 64 * 72;
  bf16_t* Vb = Qb + 2 * 64 * 72;
  float* Lm = (float*)(smem + 3 * 2 * 64 * 72 * 2);
  float* Gs = Lm + 2 * 4096;
  float* Bs = Gs + 128;
  const size_t tok0 = (size_t)b * SEQ + c * 64;
  const float* cw = p.in[I_GCW] + (size_t)l * 4 * 768;
  {
    const int t = tid >> 3, cg = tid & 7;
#pragma unroll 1
    for (int it = 0; it < 6; ++it) {
      const int hh = it / 3, which = it % 3, head = hp * 2 + hh;
      const int ccol = which * 256 + head * 64 + cg * 8;
      float acc[8];
#pragma unroll
      for (int e = 0; e < 8; ++e) acc[e] = 0.f;
#pragma unroll
      for (int j = 0; j < 4; ++j) {
        const int s = c * 64 + t - 3 + j;
        if (s >= 0) {
          bf16x8 xv = *(const bf16x8*)(P + ((size_t)b * SEQ + s) * PSTR + C_GDN_Q + ccol);
          f32x4 wa = *(const f32x4*)(cw + j * 768 + ccol), wb = *(const f32x4*)(cw + j * 768 + ccol + 4);
#pragma unroll
          for (int e = 0; e < 4; ++e) { acc[e] += wa[e] * bf2f((bf16_t)xv[e]); acc[e + 4] += wb[e] * bf2f((bf16_t)xv[e + 4]); }
        }
      }
      float ss = 0.f;
#pragma unroll
      for (int e = 0; e < 8; ++e) { acc[e] = siluf_(acc[e]); ss += acc[e] * acc[e]; }
      ss += __shfl_xor(ss, 1); ss += __shfl_xor(ss, 2); ss += __shfl_xor(ss, 4);
      float sc = 1.f;
      if (which == 0) sc = rsqrtf(ss + EPSF) * 0.125f;
      else if (which == 1) sc = rsqrtf(ss + EPSF);
      uint4 ov = {pack2(acc[0] * sc, acc[1] * sc), pack2(acc[2] * sc, acc[3] * sc), pack2(acc[4] * sc, acc[5] * sc), pack2(acc[6] * sc, acc[7] * sc)};
      bf16_t* dst = (which == 0 ? Qb : (which == 1 ? Kb : Vb)) + (hh * 64 + t) * 72 + cg * 8;
      *(uint4*)dst = ov;
    }
  }
  if (tid < 128) {
    const int hh = tid >> 6, t = lane, head = hp * 2 + hh;
    const float a_in = bf2f(P[(tok0 + t) * PSTR + C_GDN_A + head]);
    const float b_in = bf2f(P[(tok0 + t) * PSTR + C_GDN_B + head]);
    const float beta = sigmoidf_(b_in);
    float g = -__expf(p.in[I_GAL][l * 4 + head]) * softplusf_(a_in + p.in[I_GDT][l * 4 + head]);
#pragma unroll
    for (int d = 1; d < 64; d <<= 1) { float v = __shfl_up(g, d); if (lane >= d) g += v; }
    Gs[hh * 64 + t] = g; Bs[hh * 64 + t] = beta;
  }
  __syncthreads();
  const int hh = tid >> 8, lt = tid & 255, head = hp * 2 + hh;
  const size_t ih = ((size_t)(b * 4 + head)) * 64 + c;
  bf16_t* GW = (bf16_t*)(p.ws + OFF_G) + ih * 4096;
  bf16_t* GQD = (bf16_t*)(p.ws + OFF_G + GSZ) + ih * 4096;
  bf16_t* GQK = (bf16_t*)(p.ws + OFF_G + 2 * GSZ) + ih * 4096;
  bf16_t* GKD = (bf16_t*)(p.ws + OFF_G + 3 * GSZ) + ih * 4096;
  bf16_t* GU = (bf16_t*)(p.ws + OFF_G + 4 * GSZ) + ih * 4096;
  float* GCD = (float*)(p.ws + OFF_GCD);
  const float* Gh = Gs + hh * 64; const float* Bh = Bs + hh * 64;
  {
    const int wq = (tid >> 6) & 3, ti = wq >> 1, tj = wq & 1, r = lane & 31, h = lane >> 5;
    f32x16 akk, aqk;
#pragma unroll
    for (int i = 0; i < 16; ++i) { akk[i] = 0.f; aqk[i] = 0.f; }
    if (ti >= tj) {
#pragma unroll
      for (int ks = 0; ks < 4; ++ks) {
        bf16x8 ka = *(const bf16x8*)(Kb + (hh * 64 + 32 * ti + r) * 72 + ks * 16 + h * 8);
        bf16x8 qa = *(const bf16x8*)(Qb + (hh * 64 + 32 * ti + r) * 72 + ks * 16 + h * 8);
        bf16x8 kb = *(const bf16x8*)(Kb + (hh * 64 + 32 * tj + r) * 72 + ks * 16 + h * 8);
        akk = mfma32(ka, kb, akk);
        aqk = mfma32(qa, kb, aqk);
      }
    }
    const int j = 32 * tj + r;
    const float Gj = Gh[j];
#pragma unroll
    for (int i_ = 0; i_ < 16; ++i_) {
      const int i = 32 * ti + crow(i_, h);
      const float dec = (i >= j) ? __expf(Gh[i] - Gj) : 0.f;
      Lm[hh * 4096 + i * 64 + j] = (i > j) ? Bh[i] * akk[i_] * dec : 0.f;
      GQK[frag_off(i, j)] = f2bf((i >= j) ? aqk[i_] * dec : 0.f);
    }
  }
  __syncthreads();
  if (lt < 128) {
    const int cc = lt;
    float x[64];
    if (cc < 64) {
#pragma unroll
      for (int i = 0; i < 64; ++i) x[i] = bf2f(Vb[(hh * 64 + i) * 72 + cc]) * Bh[i];
    } else {
#pragma unroll
      for (int i = 0; i < 64; ++i) x[i] = bf2f(Kb[(hh * 64 + i) * 72 + cc - 64]) * Bh[i] * __expf(Gh[i]);
    }
    const float* Lh = Lm + hh * 4096;
#pragma unroll
    for (int i = 1; i < 64; ++i) {
      float s = x[i];
#pragma unroll
      for (int j4 = 0; j4 < (i + 3) / 4; ++j4) {
        const f32x4 lv = *(const f32x4*)(Lh + i * 64 + j4 * 4);
#pragma unroll
        for (int e = 0; e < 4; ++e) if (j4 * 4 + e < i) s -= lv[e] * x[j4 * 4 + e];
      }
      x[i] = s;
    }
    if (cc < 64) {
      const int split = cc >> 4, fr = cc & 15;
#pragma unroll
      for (int i4 = 0; i4 < 16; ++i4) {
        uint2 ov = {pack2(x[4 * i4], x[4 * i4 + 1]), pack2(x[4 * i4 + 2], x[4 * i4 + 3])};
        *(uint2*)(GU + ((split * 4 + (i4 >> 2)) * 64 + (i4 & 3) * 16 + fr) * 4) = ov;
      }
    } else {
#pragma unroll
      for (int i = 0; i < 64; ++i) GW[frag_off(i, cc - 64)] = f2bf(x[i]);
    }
  } else {
    const int q_ = lt - 128;
    const float Glast = Gh[63];
#pragma unroll
    for (int i = 0; i < 4; ++i) {
      const int q = q_ + 128 * i; const int pos = q >> 3, kc = q & 7;
      bf16x8 qv = *(const bf16x8*)(Qb + (hh * 64 + pos) * 72 + kc * 8);
      const float eg = __expf(Gh[pos]);
      uint4 ov = {pack2(bf2f((bf16_t)qv[0]) * eg, bf2f((bf16_t)qv[1]) * eg), pack2(bf2f((bf16_t)qv[2]) * eg, bf2f((bf16_t)qv[3]) * eg),
                  pack2(bf2f((bf16_t)qv[4]) * eg, bf2f((bf16_t)qv[5]) * eg), pack2(bf2f((bf16_t)qv[6]) * eg, bf2f((bf16_t)qv[7]) * eg)};
      { const int fo = frag_off8(pos, kc * 8); uint2 o0 = {ov.x, ov.y}, o1 = {ov.z, ov.w}; *(uint2*)(GQD + fo) = o0; *(uint2*)(GQD + fo + 128) = o1; }
    }
#pragma unroll
    for (int i = 0; i < 4; ++i) {
      const int q = q_ + 128 * i; const int k = q >> 3, pc = q & 7;
      float o[8];
#pragma unroll
      for (int e = 0; e < 8; ++e) { const int pos = pc * 8 + e; o[e] = bf2f(Kb[(hh * 64 + pos) * 72 + k]) * __expf(Glast - Gh[pos]); }
      uint4 ov = {pack2(o[0], o[1]), pack2(o[2], o[3]), pack2(o[4], o[5]), pack2(o[6], o[7])};
      { const int fo = frag_off8(k, pc * 8); uint2 o0 = {ov.x, ov.y}, o1 = {ov.z, ov.w}; *(uint2*)(GKD + fo) = o0; *(uint2*)(GKD + fo + 128) = o1; }
    }
    if (q_ == 0) GCD[ih] = __expf(Glast);
  }
}

DI void gdn_rec_item(const Params& p, int l, int b, int head, char* smem) {
  const bf16_t* P = (const bf16_t*)(p.ws + OFF_P);
  bf16_t* O = (bf16_t*)(p.ws + OFF_O);
  float* SS = (float*)(smem + 81920);
  const int tid = otid(), lane = tid & 63, wv = tid >> 6, fr = lane & 15, fq = lane >> 4;
  const int split = wv & 3;
  const bool active = wv < 4;
  const float ng = p.in[I_GNG][l * 64 + split * 16 + fr];
  const float* GCD = (const float*)(p.ws + OFF_GCD);
  const size_t ih0 = ((size_t)(b * 4 + head)) * 64;
  f32x4 S[4];
#pragma unroll
  for (int kt = 0; kt < 4; ++kt) S[kt] = (f32x4){0.f, 0.f, 0.f, 0.f};
  u32x4 lr[10];
#pragma unroll
  for (int i = 0; i < 10; ++i) lr[i] = (u32x4){0u, 0u, 0u, 0u};
  const int lq = (wv & 3) * 64 + lane;
#define GLOADC(c_)                                                                              \
  {                                                                                             \
    _Pragma("unroll") for (int i = 0; i < 10; ++i) {                                            \
      const int q_ = lq + 256 * i; const int a_ = q_ >> 9, o_ = q_ & 511;                       \
      lr[i] = *(const u32x4*)((const bf16_t*)(p.ws + OFF_G + (size_t)a_ * GSZ) + (ih0 + (c_)) * 4096 + o_ * 8); \
    }                                                                                           \
  }
#define LSTORE(buf_)                                                                            \
  {                                                                                             \
    _Pragma("unroll") for (int i = 0; i < 10; ++i) {                                            \
      const int q_ = lq + 256 * i;                                                              \
      *(u32x4*)(smem + (buf_) * 40960 + q_ * 16) = lr[i];                                       \
    }                                                                                           \
  }
#define BAR_LDS() { asm volatile("s_waitcnt lgkmcnt(0)" ::: "memory"); __builtin_amdgcn_s_barrier(); asm volatile("" ::: "memory"); }
  float cdn = 0.f;
  if (!active) { GLOADC(0); LSTORE(0); GLOADC(1); }
  else cdn = GCD[ih0];
  BAR_LDS();
#pragma unroll 1
  for (int c = 0; c < 64; ++c) {
    f32x4 acco[4];
    if (active) {
      const char* bufp = smem + (c & 1) * 40960;
      const float cd = cdn;
      if (c + 1 < 64) cdn = GCD[ih0 + c + 1];
      float zr[16];
#pragma unroll
      for (int rt = 0; rt < 4; ++rt)
#pragma unroll
        for (int j = 0; j < 4; ++j) {
          const size_t tok = (size_t)b * SEQ + c * 64 + 16 * rt + 4 * fq + j;
          zr[rt * 4 + j] = bf2f(P[tok * PSTR + C_GDN_Z + head * 64 + split * 16 + fr]);
        }
      bf16x8 bS[2];
#pragma unroll
      for (int ks = 0; ks < 2; ++ks) {
        uint4 uu = {pack2(S[2 * ks][0], S[2 * ks][1]), pack2(S[2 * ks][2], S[2 * ks][3]), pack2(S[2 * ks + 1][0], S[2 * ks + 1][1]), pack2(S[2 * ks + 1][2], S[2 * ks + 1][3])};
        bS[ks] = __builtin_bit_cast(bf16x8, uu);
      }
      f32x4 u[4];
#pragma unroll
      for (int rt = 0; rt < 4; ++rt) {
        f32x4 aw = {0.f, 0.f, 0.f, 0.f};
        acco[rt] = (f32x4){0.f, 0.f, 0.f, 0.f};
#pragma unroll
        for (int ks = 0; ks < 2; ++ks) {
          const bf16x8 wa = *(const bf16x8*)(bufp + ((rt * 2 + ks) * 64 + lane) * 16);
          const bf16x8 qa = *(const bf16x8*)(bufp + 8192 + ((rt * 2 + ks) * 64 + lane) * 16);
          aw = mfma16(wa, bS[ks], aw); acco[rt] = mfma16(qa, bS[ks], acco[rt]);
        }
        const s16x4 uv = *(const s16x4*)(bufp + 32768 + ((split * 4 + rt) * 64 + lane) * 8);
#pragma unroll
        for (int j = 0; j < 4; ++j) u[rt][j] = bf2f((bf16_t)uv[j]) - aw[j];
      }
      bf16x8 bU[2];
#pragma unroll
      for (int ks = 0; ks < 2; ++ks) {
        uint4 uu = {pack2(u[2 * ks][0], u[2 * ks][1]), pack2(u[2 * ks][2], u[2 * ks][3]), pack2(u[2 * ks + 1][0], u[2 * ks + 1][1]), pack2(u[2 * ks + 1][2], u[2 * ks + 1][3])};
        bU[ks] = __builtin_bit_cast(bf16x8, uu);
      }
#pragma unroll
      for (int rt = 0; rt < 4; ++rt) {
        f32x4 sn = S[rt] * cd;
#pragma unroll
        for (int ks = 0; ks < 2; ++ks) {
          const bf16x8 qa = *(const bf16x8*)(bufp + 16384 + ((rt * 2 + ks) * 64 + lane) * 16);
          const bf16x8 ka = *(const bf16x8*)(bufp + 24576 + ((rt * 2 + ks) * 64 + lane) * 16);
          acco[rt] = mfma16(qa, bU[ks], acco[rt]); sn = mfma16(ka, bU[ks], sn);
        }
        S[rt] = sn;
      }
#pragma unroll
      for (int rt = 0; rt < 4; ++rt)
#pragma unroll
        for (int j = 0; j < 4; ++j) {
          float s = acco[rt][j] * acco[rt][j];
          s += __shfl_xor(s, 1); s += __shfl_xor(s, 2); s += __shfl_xor(s, 4); s += __shfl_xor(s, 8);
          if (fr == 0) SS[(c & 1) * 256 + split * 64 + 16 * rt + 4 * fq + j] = s;
        }
      BAR_LDS();
      const float* ssb = SS + (c & 1) * 256;
#pragma unroll
      for (int rt = 0; rt < 4; ++rt)
#pragma unroll
        for (int j = 0; j < 4; ++j) {
          const int pos = 16 * rt + 4 * fq + j;
          const float tot = ssb[pos] + ssb[64 + pos] + ssb[128 + pos] + ssb[192 + pos];
          const float rn = rsqrtf(tot * (1.f / 64.f) + EPSF);
          const size_t tok = (size_t)b * SEQ + c * 64 + pos;
          O[tok * DM + 512 + head * 64 + split * 16 + fr] = f2bf(acco[rt][j] * rn * ng * siluf_(zr[rt * 4 + j]));
        }
    } else {
      if (c + 1 < 64) LSTORE((c + 1) & 1);
      if (c + 2 < 64) GLOADC(c + 2);
      BAR_LDS();
    }
  }
#undef GLOADC
#undef LSTORE
#undef BAR_LDS
}

DI void lru_item(const Params& p, int l, int item, char* smem, const int mode) {
  const bf16_t* P = (const bf16_t*)(p.ws + OFF_P);
  bf16_t* O = (bf16_t*)(p.ws + OFF_O);
  float* CA = (float*)(p.ws + OFF_LCA);
  float* CH = (float*)(p.ws + OFF_LCH);
  bf16_t* XS = (bf16_t*)smem;
  float* U = (float*)(smem + 34816);
  float* XC = (float*)(smem + 34816 + 65536);
  const int b = item >> 6, ct = item & 63;
  const int tid = otid(), sc = tid >> 8, c = tid & 255;
  for (int i = 0; i < 5; ++i) {
    const int q = tid + NTHR * i;
    if (q < 67 * 32) {
      const int row = q >> 5, cc = q & 31;
      const int s = ct * 64 - 3 + row;
      uint4 v = {0u, 0u, 0u, 0u};
      if (s >= 0) v = *(const uint4*)(P + ((size_t)b * SEQ + s) * PSTR + C_LRU_X + cc * 8);
      *(uint4*)(XS + row * 256 + cc * 8) = v;
    }
  }
  float carry = 0.f;
  if (mode == 1) {
    float A = 1.f, hh = 0.f;
    const float* ca = CA + ((size_t)b * 128 + sc * ct) * 256 + c;
    const float* chp = CH + ((size_t)b * 128 + sc * ct) * 256 + c;
    int k = 0;
    for (; k + 8 <= ct; k += 8) {
      float av[8], hv[8];
#pragma unroll
      for (int e = 0; e < 8; ++e) { av[e] = ca[(size_t)(k + e) * 256]; hv[e] = chp[(size_t)(k + e) * 256]; }
#pragma unroll
      for (int e = 0; e < 8; ++e) { hh = av[e] * hh + hv[e]; A *= av[e]; }
    }
    for (; k < ct; ++k) { const float a_ = ca[(size_t)k * 256], h_ = chp[(size_t)k * 256]; hh = a_ * hh + h_; A *= a_; }
    XC[(sc * 256 + c) * 2] = A; XC[(sc * 256 + c) * 2 + 1] = hh;
  }
  __syncthreads();
  if (mode == 1) {
    const float h0 = XC[c * 2 + 1], A1 = XC[(256 + c) * 2], h1 = XC[(256 + c) * 2 + 1];
    carry = A1 * h0 + h1;
    if (sc == 1) carry = CA[((size_t)b * 128 + 2 * ct) * 256 + c] * carry + CH[((size_t)b * 128 + 2 * ct) * 256 + c];
  }
  {
    const float cb = p.in[I_LCB][l * 256 + c];
    const float c0 = p.in[I_LCW][(l * 4 + 0) * 256 + c], c1 = p.in[I_LCW][(l * 4 + 1) * 256 + c],
                c2 = p.in[I_LCW][(l * 4 + 2) * 256 + c], c3 = p.in[I_LCW][(l * 4 + 3) * 256 + c];
    for (int t = sc * 32; t < sc * 32 + 32; ++t)
      U[t * 256 + c] = cb + c0 * bf2f(XS[t * 256 + c]) + c1 * bf2f(XS[(t + 1) * 256 + c]) + c2 * bf2f(XS[(t + 2) * 256 + c]) + c3 * bf2f(XS[(t + 3) * 256 + c]);
  }
  __syncthreads();
  {
    const int n = c >> 6, f = c & 63;
    float wr[64], wi[64];
    {
      const float* wrp = p.in[I_LWR] + (((size_t)l * 4 + n) * 64) * 64 + f;
      const float* wip = p.in[I_LWI] + (((size_t)l * 4 + n) * 64) * 64 + f;
      asm volatile("" : "+v"(wrp), "+v"(wip));
#pragma unroll
      for (int e = 0; e < 64; ++e) { wr[e] = wrp[e * 64]; wi[e] = wip[e * 64]; }
    }
    const float br = p.in[I_LBR][l * 256 + c], bi = p.in[I_LBI][l * 256 + c];
    const float lamsp = softplusf_(-p.in[I_LLAM][l * 256 + c]);
    float hl = carry, ac = 1.f;
    for (int t = sc * 32; t < sc * 32 + 32; ++t) {
      float ar = br, ai = bi;
#pragma unroll
      for (int e4 = 0; e4 < 16; ++e4) {
        const f32x4 uu = *(const f32x4*)(U + t * 256 + n * 64 + e4 * 4);
#pragma unroll
        for (int e = 0; e < 4; ++e) { ar += uu[e] * wr[e4 * 4 + e]; ai += uu[e] * wi[e4 * 4 + e]; }
      }
      const float rg = sigmoidf_(ar), ig = sigmoidf_(ai);
      const float la = -8.f * rg * lamsp;
      const float a = __expf(la);
      const float bb = sqrtf(fmaxf(0.f, 1.f - __expf(2.f * la))) * (ig * U[t * 256 + c]);
      hl = a * hl + bb; ac *= a;
      if (mode == 1) {
        const size_t tok = (size_t)b * SEQ + ct * 64 + t;
        const float y = bf2f(P[tok * PSTR + C_LRU_Y + c]);
        O[tok * DM + c] = f2bf(hl * geluf_(y));
      }
    }
    if (mode == 0) {
      const int ck = ct * 2 + sc;
      CA[((size_t)b * 128 + ck) * 256 + c] = ac; CH[((size_t)b * 128 + ck) * 256 + c] = hl;
    }
  }
}


#define XB_TMO      128
#define XB_XCNT(j)  (256  + 64 * (j))
#define XB_XSUB(j)  (1280 + 64 * (j))
#define XB_XGEN(j)  (2304 + 64 * (j))
#define XB_TOP      3328
#define XB_TOPGEN   3392
#define XCD_BAR_WORDS 3456
#define XB_SPIN_CAP (1u << 18)
#define XLAS __attribute__((address_space(3)))
DI unsigned xb_ld(unsigned* p)              { return __hip_atomic_load(p, __ATOMIC_RELAXED, __HIP_MEMORY_SCOPE_AGENT); }
DI unsigned xb_add(unsigned* p, unsigned v) { return __hip_atomic_fetch_add(p, v, __ATOMIC_RELAXED, __HIP_MEMORY_SCOPE_AGENT); }
DI unsigned xb_xcc_id() { return (unsigned)__builtin_amdgcn_s_getreg((3 << 11) | 20) & 0xFu; }
#define XB_SPIN(cond, bar) do { unsigned _sp = 0; while (cond) { __builtin_amdgcn_s_sleep(1); \
    if ((++_sp & 255u) == 0u) { if (xb_ld(&(bar)[XB_TMO])) break; if (_sp > XB_SPIN_CAP) { atomicAdd(&(bar)[XB_TMO], 1u); break; } } } } while (0)
struct XcdBarrier { unsigned* bar; unsigned x; volatile XLAS unsigned* st; };
DI XcdBarrier xcd_barrier_post(unsigned* bar, volatile XLAS unsigned* st) {
  XcdBarrier b; b.bar = bar; b.x = xb_xcc_id(); b.st = st;
  if (threadIdx.x == 0) (void)xb_add(&bar[XB_XCNT(b.x)], 1u);
  return b;
}
DI void xcd_barrier_complete(unsigned* bar, unsigned x, unsigned& nloc, unsigned& nx) {
  const unsigned G = gridDim.x * gridDim.y * gridDim.z;
  unsigned sum, cnt, mine, sp = 0u;
  for (;;) {
    sum = 0u; cnt = 0u; mine = 0u;
#pragma unroll
    for (unsigned j = 0; j < 16; ++j) { const unsigned c = xb_ld(&bar[XB_XCNT(j)]); sum += c; cnt += (c > 0u) ? 1u : 0u; mine = (j == x) ? c : mine; }
    if (sum == G) break;
    __builtin_amdgcn_s_sleep(1);
    if ((++sp & 255u) == 0u) { if (xb_ld(&bar[XB_TMO])) break; if (sp > XB_SPIN_CAP) { atomicAdd(&bar[XB_TMO], 1u); break; } }
  }
  nloc = mine > 0u ? mine : 1u; nx = cnt > 0u ? cnt : 1u;
}
DI void xcd_barrier(const XcdBarrier& b) {
  asm volatile("s_waitcnt vmcnt(0)" ::: "memory");
  __syncthreads();
  if (threadIdx.x == 0) {
    unsigned* bar = b.bar;
    __builtin_amdgcn_s_waitcnt(0);
    unsigned nloc = b.st[0], nx = b.st[1];
    if (nloc == 0u) { xcd_barrier_complete(bar, b.x, nloc, nx); b.st[0] = nloc; b.st[1] = nx; }
    const unsigned old = xb_add(&bar[XB_XSUB(b.x)], 1u);
    const unsigned gen = old / nloc;
    if (old + 1u == (gen + 1u) * nloc) {
      __builtin_amdgcn_fence(__ATOMIC_RELEASE, "agent");
      asm volatile("s_waitcnt vmcnt(0)" ::: "memory");
      const unsigned og = xb_add(&bar[XB_TOP], 1u);
      const unsigned tg = og / nx;
      if (og + 1u == (tg + 1u) * nx) xb_add(&bar[XB_TOPGEN], 1u);
      else XB_SPIN(xb_ld(&bar[XB_TOPGEN]) == tg, bar);
      __builtin_amdgcn_fence(__ATOMIC_ACQUIRE, "agent");
      xb_add(&bar[XB_XGEN(b.x)], 1u);
      asm volatile("s_waitcnt vmcnt(0)" ::: "memory");
    } else {
      XB_SPIN(xb_ld(&bar[XB_XGEN(b.x)]) == gen, bar);
      __builtin_amdgcn_fence(__ATOMIC_ACQUIRE, "agent");
      asm volatile("s_waitcnt vmcnt(0)" ::: "memory");
    }
  }
  __syncthreads();
}

__global__ void __launch_bounds__(NTHR) mega(Params p) {
  extern __shared__ __attribute__((aligned(16))) char smem[];
  cg::grid_group grid = cg::this_grid();
  const int tid = threadIdx.x;
  bf16_t* H = (bf16_t*)(p.ws + OFF_H);
  bf16_t* PB = (bf16_t*)(p.ws + OFF_P);
  PG_LAS unsigned char* lds = (PG_LAS unsigned char*)smem;
  volatile XLAS unsigned* xst = (volatile XLAS unsigned*)(smem + 131072);
  if (tid < 2) xst[tid] = 0u;
  __syncthreads();
  const XcdBarrier xb = xcd_barrier_post((unsigned*)(p.ws + OFF_BAR), xst);

  for (int rep = 0; rep < REP_MISC; ++rep) {
  if (MASK & 1) phase_mod(p, smem);
  grid.sync();
  }
  for (int l = 0; l < 4; ++l) {
    const float* xcur = (l == 0) ? p.in[I_X] : p.out;
    for (int rep = 0; rep < REP_MISC; ++rep) {
    if (MASK & 2) phase_convert(p, l, smem);
    if (MASK & 4) phase_norm(p, xcur, p.in[I_N1G] + l * 1024, l, 1024, 0, H, nullptr);
    xcd_barrier(xb);
    }
    for (int rep = 0; rep < REP_G; ++rep) {
    if (MASK & 8) { pg::Order<1> S; S.init(NTOK, PSTR, gridDim.x, blockIdx.x); pg::EpiBf16<0> E{PB, PSTR, nullptr};
      pg::gemm_phase(lds, H, DM, (const bf16_t*)(p.ws + OFF_WIN), 1024, S, E); }
    xcd_barrier(xb);
    }
    for (int rep = 0; rep < REP_M1; ++rep) {
    for (int it = blockIdx.x; it < 5120; it += gridDim.x) {
      if (it < 2048) { if (MASK & 32) gdn_intra_item(p, l, it, smem); }
      else if (it < 3072) { }
      else if (it < 4096) { if (MASK & 128) lru_item(p, l, it - 3072, smem, 0); }
      else { if (MASK & 16) rw_prep_item(p, l, it - 4096, smem); }
      __syncthreads();
    }
    xcd_barrier(xb);
    }
    for (int rep = 0; rep < REP_M2; ++rep) {
    if (blockIdx.x < 128) {
      if (MASK & 16) rwkv_scan_item(p, l, blockIdx.x >> 3, (blockIdx.x >> 1) & 3, blockIdx.x & 1, smem);
    } else {
      if (blockIdx.x < 192) { if (MASK & 256) gdn_rec_item(p, l, (blockIdx.x - 128) >> 2, (blockIdx.x - 128) & 3, smem); }
      unsigned* ctr = (unsigned*)(p.ws + OFF_CTR) + l * 4 + rep;
      volatile int* slot = (volatile int*)(smem + 110016);
      for (;;) {
        __syncthreads();
        if (tid == 0) *slot = (int)atomicAdd(ctr, 1u);
        __syncthreads();
        const int it = *slot;
        if (it >= 2048) break;
        if (it < 1024) { if (MASK & 64) sb_item(p, it, smem); }
        else { if (MASK & 512) lru_item(p, l, it - 1024, smem, 1); }
      }
    }
    xcd_barrier(xb);
    }
    for (int rep = 0; rep < REP_G; ++rep) {
    for (int half = 0; half < 2; ++half) {
      bf16_t* BH = (bf16_t*)(p.ws + OFF_P + 134217728);
      if (half == 0 && rep == 0) { if (MASK & 16) rwkv_post(p, l); xcd_barrier(xb); }
      if (MASK & 1024) { pg::Order<1> S; S.init(NTOK / 2, 4096, gridDim.x, blockIdx.x, 0, 0, 2, 512); pg::EpiBf16<0> E{BH, 4096, nullptr};
        pg::gemm_phase(lds, (const bf16_t*)(p.ws + OFF_O) + (size_t)half * 32768 * DM, DM, (const bf16_t*)(p.ws + OFF_WBR), 256, S, E); }
      xcd_barrier(xb);
      if (MASK & 1024) { pg::Order<4> S; S.init(NTOK / 2, 1024, gridDim.x, blockIdx.x, 0, 2097152); pg::EpiGateMix E{PB + (size_t)half * 32768 * DM, (float*)(p.ws + OFF_G), BH, p.in[I_BGATE] + (size_t)l * 4096};
        pg::gemm_phase(lds, H + (size_t)half * 32768 * DM, DM, (const bf16_t*)(p.ws + OFF_WG), 1024, S, E); }
      xcd_barrier(xb);
    }
    }
    if (MASK & 2048) { pg::Order<1> S; S.init(NTOK, 1024, gridDim.x, blockIdx.x); pg::EpiResid E{xcur, p.out, (const float*)(p.ws + OFF_MODP), p.in[I_BADA], l, 2048};
      pg::gemm_phase(lds, PB, DM, (const bf16_t*)(p.ws + OFF_WO), 1024, S, E); }
    xcd_barrier(xb);
    for (int rep = 0; rep < REP_MISC; ++rep) {
    if (MASK & 4096) phase_norm(p, p.out, p.in[I_N2G] + l * 1024, l, 4096, 3072, H, nullptr);
    xcd_barrier(xb);
    }
    for (int rep = 0; rep < REP_G; ++rep) {
    if (MASK & 8192) { pg::Order<1> S; S.init(NTOK, FFN, gridDim.x, blockIdx.x); pg::EpiBf16<0> E{PB, FFN, nullptr};
      pg::gemm_phase(lds, H, DM, (const bf16_t*)(p.ws + OFF_WF), 1024, S, E); }
    xcd_barrier(xb);
    if (MASK & 8192) { pg::Order<1> S; S.init(NTOK, FFN, gridDim.x, blockIdx.x); pg::EpiFfnAct E{PB + (size_t)NTOK * FFN, PB, p.in[I_FCW] + (size_t)l * 3 * FFN};
      pg::gemm_phase(lds, H, DM, (const bf16_t*)(p.ws + OFF_WF) + (size_t)FFN * 1024, 1024, S, E); }
    xcd_barrier(xb);
    }
    if (MASK & 32768) { pg::Order<1> S; S.init(NTOK, 1024, gridDim.x, blockIdx.x); pg::EpiResid E{p.out, p.out, (const float*)(p.ws + OFF_MODP), p.in[I_BADA], l, 5120};
      pg::gemm_phase(lds, PB + (size_t)NTOK * FFN, FFN, (const bf16_t*)(p.ws + OFF_WD), FFN, S, E); }
    xcd_barrier(xb);
  }
  if (MASK & 65536) phase_norm(p, p.out, p.in[I_FG], 0, 0, 0, nullptr, p.out);
}

extern "C" void kernel_launch(void* const* d_in, const int* in_sizes, int n_in,
                              void* d_out, int out_size, void* d_ws, size_t ws_size,
                              hipStream_t stream) {
  if (ws_size < WS_NEED || n_in < 38) { fprintf(stderr, "workspace too small: %zu < %zu\n", ws_size, (size_t)WS_NEED); return; }
  (void)hipFuncSetAttribute((const void*)mega, hipFuncAttributeMaxDynamicSharedMemorySize, SMEM_BYTES);
  int dev = 0, cus = 0, per_cu = 0;
  (void)hipGetDevice(&dev);
  (void)hipDeviceGetAttribute(&cus, hipDeviceAttributeMultiprocessorCount, dev);
  (void)hipOccupancyMaxActiveBlocksPerMultiprocessor(&per_cu, mega, NTHR, SMEM_BYTES);
  if (per_cu < 1 || cus < 1) { fprintf(stderr, "occupancy query failed (%d, %d)\n", per_cu, cus); return; }
  if (cus > 256) cus = 256;
  const int grid_blocks = cus;
  Params p{};
  for (int i = 0; i < 38; ++i) p.in[i] = (const float*)d_in[i];
  p.out = (float*)d_out; p.ws = (char*)d_ws;
  (void)hipMemsetAsync((char*)d_ws + OFF_BAR, 0, XCD_BAR_WORDS * 4, stream);
  void* args[] = {&p};
  hipError_t e = hipLaunchCooperativeKernel((void*)mega, dim3(grid_blocks), dim3(NTHR), args, SMEM_BYTES, stream);
  if (e != hipSuccess) fprintf(stderr, "cooperative launch failed: %s (grid %d)\n", hipGetErrorString(e), grid_blocks);
}
```

```cpp
#include <hip/hip_runtime.h>
#include <hip/hip_cooperative_groups.h>
#include <cstdio>
namespace cg = cooperative_groups;

typedef unsigned short bf16_t;
typedef short bf16x8 __attribute__((ext_vector_type(8)));
typedef short s16x4 __attribute__((ext_vector_type(4)));
typedef float f32x4 __attribute__((ext_vector_type(4)));
typedef float f32x16 __attribute__((ext_vector_type(16)));
typedef unsigned u32x4 __attribute__((ext_vector_type(4)));
#define DI __device__ __forceinline__

constexpr int NTOK = 65536, DM = 1024, SEQ = 4096, PSTR = 3328, FFN = 2816, AUS = 5632;
constexpr int C_LRU_X = 0, C_LRU_Y = 256, C_SB_Q = 512, C_SB_K = 768, C_SB_V = 1024;
constexpr int C_GDN_Q = 1280, C_GDN_Z = 2048, C_GDN_A = 2304, C_GDN_B = 2308, C_RW = 2312;
constexpr float EPSF = 1e-6f;
#ifndef MASK
#define MASK 0x1ffff
#endif
#ifndef REP_M1
#define REP_M1 1
#endif
#ifndef REP_M2
#define REP_M2 1
#endif
#ifndef REP_G
#define REP_G 1
#endif
#ifndef REP_MISC
#define REP_MISC 1
#endif
constexpr int NTHR = 512;
constexpr int SMEM_BYTES = 131072 + 64;

constexpr size_t OFF_MODP = 0;
constexpr size_t OFF_WIN = 6291456;
constexpr size_t OFF_WG = OFF_WIN + 6815744;
constexpr size_t OFF_WBR = OFF_WG + 8388608;
constexpr size_t OFF_WO = OFF_WBR + 2097152;
constexpr size_t OFF_WF = OFF_WO + 2097152;
constexpr size_t OFF_WD = OFF_WF + 11534336;
constexpr size_t OFF_H = OFF_WD + 5767168;
constexpr size_t OFF_P = OFF_H + 134217728;
constexpr size_t OFF_O = OFF_P + 436207616;
constexpr size_t OFF_G = OFF_O + 134217728;
constexpr size_t GSZ = 33554432;
constexpr size_t OFF_GCD = OFF_G + 5 * GSZ;
constexpr size_t OFF_L = OFF_GCD + 16384;
constexpr size_t LSZ = 67108864;
constexpr size_t OFF_LCA = OFF_L + 2 * LSZ;
constexpr size_t OFF_LCH = OFF_LCA + 2097152;
constexpr size_t OFF_BON = OFF_LCH + 2097152;
constexpr size_t OFF_CTR = OFF_BON + 1048576;
constexpr size_t OFF_BAR = OFF_CTR + 256;
constexpr size_t WS_NEED = OFF_BAR + 16384;

struct Params { const float* in[38]; float* out; char* ws; };
enum { I_X = 0, I_C, I_N1G, I_N2G, I_FG, I_WADA, I_BADA, I_WIN, I_LCW, I_LCB, I_LWR, I_LBR, I_LWI, I_LBI, I_LLAM,
       I_GCW, I_GAL, I_GDT, I_GNG, I_RMU, I_RW0, I_RWUP, I_RA0, I_RAUP, I_RGUP, I_RKK, I_RKA, I_RRK, I_RLG, I_RLB,
       I_WBR, I_WGATE, I_BGATE, I_WOUT, I_FWG, I_FWU, I_FCW, I_FWD };

DI float bf2f(bf16_t v) { return __uint_as_float(((unsigned)v) << 16); }
DI unsigned pack2(float lo, float hi) { unsigned r; asm("v_cvt_pk_bf16_f32 %0, %1, %2" : "=v"(r) : "v"(lo), "v"(hi)); return r; }
DI bf16_t f2bf(float x) { return (bf16_t)(pack2(x, x) & 0xffffu); }
DI float sigmoidf_(float x) { return 1.f / (1.f + __expf(-x)); }
DI float softplusf_(float x) { return fmaxf(x, 0.f) + __logf(1.f + __expf(-fabsf(x))); }
DI float siluf_(float x) { return x / (1.f + __expf(-x)); }
DI float geluf_(float x) { float u = 0.7978845608f * (x + 0.044715f * x * x * x); return x / (1.f + __expf(-2.f * u)); }
DI float tanhf_(float x) { return 1.f - 2.f / (1.f + __expf(2.f * x)); }
DI float wave_sum(float x) {
#pragma unroll
  for (int o = 32; o >= 1; o >>= 1) x += __shfl_xor(x, o);
  return x;
}
template <int CTRL> DI float dppf(float x) { return __int_as_float(__builtin_amdgcn_update_dpp(0, __float_as_int(x), CTRL, 0xf, 0xf, true)); }
DI float reduce8(float x) { x += dppf<0xB1>(x); x += dppf<0x4E>(x); x += dppf<0x141>(x); return x; }
DI f32x16 mfma32(bf16x8 a, bf16x8 b, f32x16 c) { return __builtin_amdgcn_mfma_f32_32x32x16_bf16(a, b, c, 0, 0, 0); }
DI f32x4 mfma16(bf16x8 a, bf16x8 b, f32x4 c) { return __builtin_amdgcn_mfma_f32_16x16x32_bf16(a, b, c, 0, 0, 0); }
DI int crow(int i, int h) { return (i & 3) + 8 * (i >> 2) + 4 * h; }

DI float modv(const float* modp, const float* bada, int l, int b, int idx) {
  const float* q = modp + ((size_t)(l * 16 + b)) * 6144 + idx;
  const size_t ks = (size_t)4 * 16 * 6144;
  return bada[l * 6144 + idx] + q[0] + q[ks] + q[2 * ks] + q[3 * ks];
}

DI int otid() { int t = threadIdx.x; asm volatile("" : "+v"(t)); return t; }
DI int obid() { int b = blockIdx.x; asm volatile("" : "+s"(b)); return b; }
DI void phase_mod(const Params& p, char* smem) {
  float* sm = (float*)smem;
  float* modp = (float*)(p.ws + OFF_MODP);
  const int tid = otid();
  if (obid() == 0 && tid < 64) ((unsigned*)(p.ws + OFF_CTR))[tid] = 0u;
  for (int item = obid(); item < 192; item += gridDim.x) {
    const int l = item / 48, rem = item % 48, jb = rem >> 2, kq = rem & 3;
    for (int i = 0; i < 8; ++i) {
      int e = tid + 512 * i; int b = e >> 8, k = e & 255;
      float cv = p.in[I_C][b * 1024 + kq * 256 + k];
      sm[e] = siluf_(cv);
    }
    __syncthreads();
    float acc[16];
#pragma unroll
    for (int b = 0; b < 16; ++b) acc[b] = 0.f;
    const float* wp = p.in[I_WADA] + ((size_t)l * 1024 + kq * 256) * 6144 + jb * 512 + tid;
    for (int k = 0; k < 256; k += 4) {
      float w0 = wp[(size_t)k * 6144], w1 = wp[(size_t)(k + 1) * 6144], w2 = wp[(size_t)(k + 2) * 6144], w3 = wp[(size_t)(k + 3) * 6144];
#pragma unroll
      for (int b = 0; b < 16; ++b) {
        f32x4 cv = *(const f32x4*)(sm + b * 256 + k);
        acc[b] += cv[0] * w0 + cv[1] * w1 + cv[2] * w2 + cv[3] * w3;
      }
    }
#pragma unroll
    for (int b = 0; b < 16; ++b) modp[((size_t)((kq * 4 + l) * 16 + b)) * 6144 + jb * 512 + tid] = acc[b];
    __syncthreads();
  }
}

DI void conv_tile(const float* src, bf16_t* dst, int K, int N, int k0, int n0, char* smem) {
  float* tile = (float*)smem;
  const int tid = otid();
#pragma unroll
  for (int it = 0; it < 2; ++it) {
    int kr = (tid >> 4) + 32 * it, nc = (tid & 15) * 4;
    f32x4 v = {0.f, 0.f, 0.f, 0.f};
    if (n0 + nc < N) v = *(const f32x4*)(src + (size_t)(k0 + kr) * N + n0 + nc);
    tile[kr * 65 + nc] = v[0]; tile[kr * 65 + nc + 1] = v[1]; tile[kr * 65 + nc + 2] = v[2]; tile[kr * 65 + nc + 3] = v[3];
  }
  __syncthreads();
  {
    int n = tid >> 3, kc = (tid & 7) * 8;
    unsigned o[4];
#pragma unroll
    for (int e = 0; e < 4; ++e) o[e] = pack2(tile[(kc + 2 * e) * 65 + n], tile[(kc + 2 * e + 1) * 65 + n]);
    uint4 ov = {o[0], o[1], o[2], o[3]};
    *(uint4*)(dst + (size_t)(n0 + n) * K + k0 + kc) = ov;
  }
  __syncthreads();
}

DI void phase_convert(const Params& p, int l, char* smem) {
  for (int t = obid(); t < 4480; t += gridDim.x) {
    const float* src; bf16_t* dst; int K, N, Npad, tt = t;
    if (tt < 832) { src = p.in[I_WIN] + (size_t)l * 1024 * 3208; dst = (bf16_t*)(p.ws + OFF_WIN); K = 1024; N = 3208; Npad = 3328; }
    else if ((tt -= 832) < 1024) { int br = tt >> 8; tt &= 255; src = p.in[I_WGATE] + ((size_t)l * 4 + br) * 1048576; dst = (bf16_t*)(p.ws + OFF_WG) + (size_t)br * 1048576; K = 1024; N = 1024; Npad = 1024; }
    else if ((tt -= 1024) < 256) { int br = tt >> 6; tt &= 63; src = p.in[I_WBR] + ((size_t)l * 4 + br) * 262144; dst = (bf16_t*)(p.ws + OFF_WBR) + (size_t)br * 262144; K = 256; N = 1024; Npad = 1024; }
    else if ((tt -= 256) < 256) { src = p.in[I_WOUT] + (size_t)l * 1048576; dst = (bf16_t*)(p.ws + OFF_WO); K = 1024; N = 1024; Npad = 1024; }
    else if ((tt -= 256) < 704) { src = p.in[I_FWG] + (size_t)l * 1024 * 2816; dst = (bf16_t*)(p.ws + OFF_WF); K = 1024; N = 2816; Npad = 2816; }
    else if ((tt -= 704) < 704) { src = p.in[I_FWU] + (size_t)l * 1024 * 2816; dst = (bf16_t*)(p.ws + OFF_WF) + (size_t)2816 * 1024; K = 1024; N = 2816; Npad = 2816; }
    else { tt -= 704; src = p.in[I_FWD] + (size_t)l * 2816 * 1024; dst = (bf16_t*)(p.ws + OFF_WD); K = 2816; N = 1024; Npad = 1024; }
    const int nNt = Npad >> 6;
    const int kt = tt / nNt, nt = tt % nNt;
    conv_tile(src, dst, K, N, kt * 64, nt * 64, smem);
  }
}

DI void phase_norm(const Params& p, const float* xin, const float* g, int l, int scale_idx, int shift_idx, bf16_t* hout, float* fout) {
  const float* modp = (const float*)(p.ws + OFF_MODP);
  const int lane = otid() & 63, wv = otid() >> 6;
  const int nw = gridDim.x * 8;
  const int rows_per = 32;
  for (int chunk = obid() * 8 + wv; chunk < NTOK / 32; chunk += nw) {
  const int row0 = chunk * rows_per;
  const int b = row0 / SEQ;
  f32x4 gv[4], sc[4], sh[4];
#pragma unroll
  for (int j = 0; j < 4; ++j) {
    int c = lane * 4 + 256 * j;
    gv[j] = *(const f32x4*)(g + c);
    if (hout) {
#pragma unroll
      for (int e = 0; e < 4; ++e) {
        sc[j][e] = 1.f + modv(modp, p.in[I_BADA], l, b, scale_idx + c + e);
        sh[j][e] = modv(modp, p.in[I_BADA], l, b, shift_idx + c + e);
      }
    }
  }
  for (int rr = 0; rr < rows_per; ++rr) {
    const size_t row = (size_t)row0 + rr;
    f32x4 xv[4]; float ss = 0.f;
#pragma unroll
    for (int j = 0; j < 4; ++j) {
      xv[j] = *(const f32x4*)(xin + row * DM + lane * 4 + 256 * j);
      ss += xv[j][0] * xv[j][0] + xv[j][1] * xv[j][1] + xv[j][2] * xv[j][2] + xv[j][3] * xv[j][3];
    }
    ss = wave_sum(ss);
    const float rs = rsqrtf(ss * (1.f / 1024.f) + EPSF);
#pragma unroll
    for (int j = 0; j < 4; ++j) {
      f32x4 y = xv[j] * rs * gv[j];
      if (hout) {
        y = y * sc[j] + sh[j];
        uint2 o = {pack2(y[0], y[1]), pack2(y[2], y[3])};
        *(uint2*)(hout + row * DM + lane * 4 + 256 * j) = o;
      } else {
        *(f32x4*)(fout + row * DM + lane * 4 + 256 * j) = y;
      }
    }
  }
  }
}

#define PG_LAS __attribute__((address_space(3)))
namespace pg {
constexpr int BM = 256, BK = 64, HALF = 128, HTB = HALF * BK * 2, NXCD = 8, WGM = 8;
DI int lds_byte(int r, int c) { const int st = (r >> 4) * 2 + (c >> 5), rr = r & 15, cc = c & 31, ob = rr * 64 + cc * 2; return st * 1024 + (ob ^ (((ob >> 9) & 1) << 5)); }
DI void stage_rc(int b, int& R, int& C) { const int st = b / 1024, sb = b % 1024, swz = sb ^ (((sb >> 9) & 1) << 5); R = (st >> 1) * 16 + swz / 64; C = (st & 1) * 32 + (swz % 64) / 2; }
DI int perm32(int rho) { const int n = rho >> 4, i = rho & 15; return 8 * (i >> 2) + 4 * n + (i & 3); }
struct Unit { int pm, pn; int aux; long ao, bo; };
template <int REP> struct Order {
  int nM, nN, nwg, G, c, ashift; long astep, bstep, apnstep;
  DI void init(int M, int N, int G_, int c_, long astep_ = 0, long bstep_ = 0, int ashift_ = 0, long apnstep_ = 0) {
    nM = M / BM; nN = N / BM; nwg = nM * nN; G = G_; c = c_; astep = astep_; bstep = bstep_; ashift = ashift_; apnstep = apnstep_; }
  DI bool next(int i, Unit& u) const {
    const int ti = i / REP, aux = i % REP;
    const long L = (long)ti * G + c; if (L >= nwg) return false;
    int wgid = (int)L; { const int q = nwg / NXCD, r = nwg % NXCD, xcd = wgid % NXCD, off = wgid / NXCD; wgid = (xcd < r ? xcd * (q + 1) : r * (q + 1) + (xcd - r) * q) + off; }
    const int nig = WGM * nN, gid = wgid / nig, fm = gid * WGM, gsz = (nM - fm) < WGM ? (nM - fm) : WGM;
    u.pm = fm + ((wgid % nig) % gsz); u.pn = (wgid % nig) / gsz; u.aux = aux; u.ao = aux * astep + (long)(u.pn >> ashift) * apnstep; u.bo = aux * bstep; return true;
  }
};
DI unsigned cvt_pk_bf16(float lo, float hi) { unsigned r; asm volatile("v_cvt_pk_bf16_f32 %0, %1, %2" : "=v"(r) : "v"(lo), "v"(hi)); return r; }

template <class Epi, class Sched>
DI void gemm_phase(PG_LAS unsigned char* lds, const bf16_t* Ag, int lda, const bf16_t* Bg, int K, const Sched& S, const Epi& E) {
  const int tid = otid(), wid = __builtin_amdgcn_readfirstlane(tid >> 6), lane = tid & 63, wr = wid >> 2, wc = wid & 3, fr = lane & 15, fq = lane >> 4;
  const int nt = K / BK;
  unsigned voffA[2], voffB[2];
#pragma unroll
  for (int i = 0; i < 2; ++i) { int R, C; stage_rc(tid * 16 + i * 8192, R, C); const int Rb = Epi::PERM ? ((R & ~31) + perm32(R & 31)) : R;
    voffA[i] = (unsigned)(R * lda + C) * 2u; voffB[i] = (unsigned)(Rb * K + C) * 2u; }
  const size_t kstep = (size_t)(BK * 2);
  const size_t hstepA = (size_t)HALF * lda * 2, hstepB = (size_t)HALF * K * 2;
  const size_t tstepA = 2 * hstepA, tstepB = 2 * hstepB;
  const unsigned ldsw = (unsigned)wid * 1024u;
  const int aoff = lds_byte(wr * 64 + fr, fq * 8), boff = lds_byte(wc * 32 + fr, fq * 8);
#define PG_SA(b, h) (((b) * 2 + (h)) * HTB)
#define PG_SB(b, h) ((4 + (b) * 2 + (h)) * HTB)
#define PG_STAGE(bufoff, gbase, voff) do { _Pragma("unroll") for (int _i = 0; _i < 2; ++_i) \
    __builtin_amdgcn_global_load_lds((const unsigned*)((const char*)(gbase) + (voff)[_i]), (PG_LAS unsigned*)(lds + (bufoff) + ldsw + _i * 8192), 16, 0, 0); } while (0)
#define PG_LDA(dst, b, h) do { _Pragma("unroll") for (int m = 0; m < 4; ++m) _Pragma("unroll") for (int k = 0; k < 2; ++k) dst[m][k] = *(const PG_LAS bf16x8*)(lds + PG_SA(b, h) + aoff + m * 2048 + k * 1024); } while (0)
#define PG_LDB(dst, b, h) do { _Pragma("unroll") for (int n = 0; n < 2; ++n) _Pragma("unroll") for (int k = 0; k < 2; ++k) dst[n][k] = *(const PG_LAS bf16x8*)(lds + PG_SB(b, h) + boff + n * 2048 + k * 1024); } while (0)
#define PG_MMA(ai, bj, At, Bt) do { __builtin_amdgcn_s_setprio(1); _Pragma("unroll") for (int m = 0; m < 4; ++m) _Pragma("unroll") for (int n = 0; n < 2; ++n) _Pragma("unroll") for (int k = 0; k < 2; ++k) \
    acc[ai][bj][m][n] = __builtin_amdgcn_mfma_f32_16x16x32_bf16(Bt[n][k], At[m][k], acc[ai][bj][m][n], 0, 0, 0); __builtin_amdgcn_s_setprio(0); } while (0)
#define PG_WAIT_V(n) asm volatile("s_waitcnt vmcnt(" #n ")" ::: "memory")
#define PG_WAIT_L(n) asm volatile("s_waitcnt lgkmcnt(" #n ")" ::: "memory")
#define PG_BAR __builtin_amdgcn_s_barrier()
#define PG_SCHED __builtin_amdgcn_sched_barrier(0)
  Unit cur, nxt; int ui = 0;
  if (!S.next(0, cur)) return;
  f32x4 acc[2][2][4][2];
#pragma unroll
  for (int a = 0; a < 2; ++a)
#pragma unroll
    for (int b = 0; b < 2; ++b)
#pragma unroll
      for (int m = 0; m < 4; ++m)
#pragma unroll
        for (int n = 0; n < 2; ++n) acc[a][b][m][n] = (f32x4){0.f, 0.f, 0.f, 0.f};
  bf16x8 At[4][2], B0[2][2], B1[2][2];
  const char* cA = (const char*)Ag + (size_t)cur.pm * tstepA + cur.ao; const char* cB = (const char*)Bg + (size_t)cur.pn * tstepB + cur.bo;
  PG_STAGE(PG_SB(0, 0), cB, voffB); PG_STAGE(PG_SA(0, 0), cA, voffA); PG_STAGE(PG_SB(0, 1), cB + hstepB, voffB); PG_STAGE(PG_SA(0, 1), cA + hstepA, voffA);
  if (wr == 1) PG_BAR;
  PG_WAIT_V(4); PG_BAR;
  PG_STAGE(PG_SB(1, 0), cB + kstep, voffB); PG_STAGE(PG_SA(1, 0), cA + kstep, voffA); PG_STAGE(PG_SB(1, 1), cB + hstepB + kstep, voffB);
  PG_WAIT_V(6); PG_BAR;
  for (;;) {
    const bool has_next = S.next(ui + 1, nxt);
    const char* nA = has_next ? (const char*)Ag + (size_t)nxt.pm * tstepA + nxt.ao : cA; const char* nB = has_next ? (const char*)Bg + (size_t)nxt.pn * tstepB + nxt.bo : cB;
#pragma unroll 1
    for (int t = 0; t < nt; t += 2) {
      const bool last = (t == nt - 2);
      const char* a1 = cA + (size_t)(t + 1) * kstep;
      const char* a2 = last ? nA : cA + (size_t)(t + 2) * kstep; const char* b2 = last ? nB : cB + (size_t)(t + 2) * kstep;
      const char* a3 = a2 + kstep; const char* b3 = b2 + kstep;
      PG_LDB(B0, 0, 0); PG_SCHED; PG_LDA(At, 0, 0); PG_STAGE(PG_SA(1, 1), a1 + hstepA, voffA);
      PG_WAIT_L(8); PG_BAR; PG_WAIT_L(0); PG_MMA(0, 0, At, B0); PG_BAR; PG_SCHED;
      PG_LDB(B1, 0, 1); PG_STAGE(PG_SB(0, 0), b2, voffB);
      PG_BAR; PG_WAIT_L(0); PG_MMA(0, 1, At, B1); PG_BAR;
      PG_LDA(At, 0, 1); PG_STAGE(PG_SA(0, 0), a2, voffA);
      PG_BAR; PG_WAIT_L(0); PG_MMA(1, 0, At, B0); PG_BAR; PG_SCHED;
      PG_STAGE(PG_SB(0, 1), b2 + hstepB, voffB);
      PG_WAIT_V(6); PG_BAR; PG_MMA(1, 1, At, B1); PG_BAR;
      PG_LDB(B0, 1, 0); PG_SCHED; PG_LDA(At, 1, 0); PG_STAGE(PG_SA(0, 1), a2 + hstepA, voffA);
      PG_WAIT_L(8); PG_BAR; PG_WAIT_L(0); PG_MMA(0, 0, At, B0); PG_BAR; PG_SCHED;
      PG_LDB(B1, 1, 1); PG_STAGE(PG_SB(1, 0), b3, voffB);
      PG_BAR; PG_WAIT_L(0); PG_MMA(0, 1, At, B1); PG_BAR;
      PG_LDA(At, 1, 1); PG_STAGE(PG_SA(1, 0), a3, voffA);
      PG_BAR; PG_WAIT_L(0); PG_MMA(1, 0, At, B0); PG_BAR; PG_SCHED;
      PG_STAGE(PG_SB(1, 1), b3 + hstepB, voffB);
      PG_WAIT_V(6); PG_BAR; PG_MMA(1, 1, At, B1); PG_BAR;
    }
    E(acc, cur, wr, wc, fr, fq);
    if (!has_next) break;
#pragma unroll
    for (int a = 0; a < 2; ++a)
#pragma unroll
      for (int b = 0; b < 2; ++b)
#pragma unroll
        for (int m = 0; m < 4; ++m)
#pragma unroll
          for (int n = 0; n < 2; ++n) acc[a][b][m][n] = (f32x4){0.f, 0.f, 0.f, 0.f};
    cur = nxt; cA = nA; cB = nB; ++ui;
  }
  PG_WAIT_V(0);
  if (wr == 0) PG_BAR;
  PG_BAR;
#undef PG_SA
#undef PG_SB
#undef PG_STAGE
#undef PG_LDA
#undef PG_LDB
#undef PG_MMA
#undef PG_WAIT_V
#undef PG_WAIT_L
#undef PG_BAR
#undef PG_SCHED
}

template <int ACT> struct EpiBf16 {
  static constexpr bool PERM = true;
  bf16_t* O; int ldc; const float* bias;
  DI void operator()(const f32x4 (&acc)[2][2][4][2], const Unit& u, int wr, int wc, int fr, int fq) const {
    const int row0 = u.pm * BM + wr * 64 + fr, col0 = u.pn * BM + wc * 32 + 8 * fq;
    f32x4 bv[2][2];
#pragma unroll
    for (int bj = 0; bj < 2; ++bj)
#pragma unroll
      for (int n = 0; n < 2; ++n) bv[bj][n] = ACT ? *(const f32x4*)(bias + col0 + bj * HALF + 4 * n) : (f32x4){0.f, 0.f, 0.f, 0.f};
#pragma unroll
    for (int ai = 0; ai < 2; ++ai)
#pragma unroll
      for (int m = 0; m < 4; ++m) { bf16_t* rowp = O + (size_t)(row0 + ai * HALF + m * 16) * ldc + col0;
#pragma unroll
        for (int bj = 0; bj < 2; ++bj) { f32x4 v0 = acc[ai][bj][m][0] + bv[bj][0], v1 = acc[ai][bj][m][1] + bv[bj][1];
          if (ACT) {
#pragma unroll
            for (int j = 0; j < 4; ++j) { v0[j] = sigmoidf_(v0[j]); v1[j] = sigmoidf_(v1[j]); } }
          u32x4 w; w.x = cvt_pk_bf16(v0[0], v0[1]); w.y = cvt_pk_bf16(v0[2], v0[3]); w.z = cvt_pk_bf16(v1[0], v1[1]); w.w = cvt_pk_bf16(v1[2], v1[3]);
          *(u32x4*)(rowp + bj * HALF) = w; } }
  }
};
struct EpiBranch {
  static constexpr bool PERM = true;
  bf16_t* MIX; const bf16_t* G;
  DI void operator()(const f32x4 (&acc)[2][2][4][2], const Unit& u, int wr, int wc, int fr, int fq) const {
    const int row0 = u.pm * BM + wr * 64 + fr, col0 = u.pn * BM + wc * 32 + 8 * fq;
#pragma unroll
    for (int ai = 0; ai < 2; ++ai)
#pragma unroll
      for (int m = 0; m < 4; ++m) {
        asm volatile("" ::: "memory");
        const size_t row = (size_t)(row0 + ai * HALF + m * 16);
        bf16_t* mp = MIX + row * DM + col0; const bf16_t* gp = G + row * 4096 + u.aux * 1024 + col0;
#pragma unroll
        for (int bj = 0; bj < 2; ++bj) {
          const bf16x8 gv = *(const bf16x8*)(gp + bj * HALF);
          float o[8];
#pragma unroll
          for (int j = 0; j < 4; ++j) { o[j] = bf2f((bf16_t)gv[j]) * acc[ai][bj][m][0][j]; o[4 + j] = bf2f((bf16_t)gv[4 + j]) * acc[ai][bj][m][1][j]; }
          if (u.aux > 0) {
            const bf16x8 mv = *(const bf16x8*)(mp + bj * HALF);
#pragma unroll
            for (int j = 0; j < 8; ++j) o[j] += bf2f((bf16_t)mv[j]);
          }
          u32x4 w; w.x = cvt_pk_bf16(o[0], o[1]); w.y = cvt_pk_bf16(o[2], o[3]); w.z = cvt_pk_bf16(o[4], o[5]); w.w = cvt_pk_bf16(o[6], o[7]);
          *(u32x4*)(mp + bj * HALF) = w;
        }
      }
  }
};
struct EpiResid {
  static constexpr bool PERM = false;
  const float* xold; float* xnew; const float* modp; const float* bada; int l, gate_idx;
  DI void operator()(const f32x4 (&acc)[2][2][4][2], const Unit& u, int wr, int wc, int fr, int fq) const {
    const int row0 = u.pm * BM + wr * 64 + fr, col0 = u.pn * BM + wc * 32 + 4 * fq;
    const int b = (u.pm * BM) / SEQ;
    f32x4 gv[2][2];
#pragma unroll
    for (int bj = 0; bj < 2; ++bj)
#pragma unroll
      for (int n = 0; n < 2; ++n)
#pragma unroll
        for (int j = 0; j < 4; ++j) gv[bj][n][j] = modv(modp, bada, l, b, gate_idx + col0 + bj * HALF + n * 16 + j);
#pragma unroll
    for (int ai = 0; ai < 2; ++ai)
#pragma unroll
      for (int m = 0; m < 4; ++m) { const size_t ro = (size_t)(row0 + ai * HALF + m * 16) * DM + col0;
#pragma unroll
        for (int bj = 0; bj < 2; ++bj)
#pragma unroll
          for (int n = 0; n < 2; ++n) {
            const f32x4 xo = *(const f32x4*)(xold + ro + bj * HALF + n * 16);
            *(f32x4*)(xnew + ro + bj * HALF + n * 16) = xo + gv[bj][n] * acc[ai][bj][m][n];
          } }
  }
};
struct EpiFfnAct {
  static constexpr bool PERM = true;
  bf16_t* ACT; const bf16_t* APRE; const float* cw;
  DI void operator()(const f32x4 (&acc)[2][2][4][2], const Unit& u, int wr, int wc, int fr, int fq) const {
    const int row0 = u.pm * BM + wr * 64 + fr, col0 = u.pn * BM + wc * 32 + 8 * fq;
#pragma unroll
    for (int ai = 0; ai < 2; ++ai)
#pragma unroll
      for (int m = 0; m < 4; ++m) {
        asm volatile("" ::: "memory");
        const int row = row0 + ai * HALF + m * 16; const int sp = row & (SEQ - 1);
        const bf16_t* ap = APRE + (size_t)row * FFN + col0;
        bf16_t* op = ACT + (size_t)row * FFN + col0;
#pragma unroll
        for (int bj = 0; bj < 2; ++bj) {
          const int c = bj * HALF;
          const bf16x8 z8 = {0, 0, 0, 0, 0, 0, 0, 0};
          const bf16x8 a0 = *(const bf16x8*)(ap + c);
          const bf16x8 a1 = sp >= 1 ? *(const bf16x8*)(ap - FFN + c) : z8;
          const bf16x8 a2 = sp >= 2 ? *(const bf16x8*)(ap - 2 * FFN + c) : z8;
          float o[8];
#pragma unroll
          for (int hh = 0; hh < 2; ++hh) {
            const f32x4 w0 = *(const f32x4*)(cw + col0 + c + 4 * hh), w1 = *(const f32x4*)(cw + FFN + col0 + c + 4 * hh), w2 = *(const f32x4*)(cw + 2 * FFN + col0 + c + 4 * hh);
#pragma unroll
            for (int j = 0; j < 4; ++j) {
              const float cv = w0[j] * bf2f((bf16_t)a2[4 * hh + j]) + w1[j] * bf2f((bf16_t)a1[4 * hh + j]) + w2[j] * bf2f((bf16_t)a0[4 * hh + j]);
              o[4 * hh + j] = geluf_(cv) * acc[ai][bj][m][hh][j];
            }
          }
          u32x4 w; w.x = cvt_pk_bf16(o[0], o[1]); w.y = cvt_pk_bf16(o[2], o[3]); w.z = cvt_pk_bf16(o[4], o[5]); w.w = cvt_pk_bf16(o[6], o[7]);
          *(u32x4*)(op + c) = w;
        }
      }
  }
};
struct EpiGateMix {
  static constexpr bool PERM = true;
  bf16_t* MIX; float* MIX32; const bf16_t* BH; const float* bias;
  DI void operator()(const f32x4 (&acc)[2][2][4][2], const Unit& u, int wr, int wc, int fr, int fq) const {
    const int row0 = u.pm * BM + wr * 64 + fr, col0 = u.pn * BM + wc * 32 + 8 * fq;
    const bool rmw = u.aux > 0, fin = u.aux == 3;
    f32x4 bv[2][2];
#pragma unroll
    for (int bj = 0; bj < 2; ++bj)
#pragma unroll
      for (int n = 0; n < 2; ++n) bv[bj][n] = *(const f32x4*)(bias + u.aux * 1024 + col0 + bj * HALF + 4 * n);
    const f32x4 z4 = {0.f, 0.f, 0.f, 0.f};
    bf16x8 nb[2]; f32x4 nm[2][2];
#define GM_LOAD(it_) { const size_t row_ = (size_t)(row0 + ((it_) >> 2) * HALF + ((it_) & 3) * 16); \
      _Pragma("unroll") for (int bj = 0; bj < 2; ++bj) { nb[bj] = *(const bf16x8*)(BH + row_ * 4096 + u.aux * 1024 + col0 + bj * HALF); \
        nm[bj][0] = rmw ? *(const f32x4*)(MIX32 + row_ * DM + col0 + bj * HALF) : z4; nm[bj][1] = rmw ? *(const f32x4*)(MIX32 + row_ * DM + col0 + bj * HALF + 4) : z4; } }
    GM_LOAD(0);
#pragma unroll
    for (int it = 0; it < 8; ++it) {
      const int ai = it >> 2, m = it & 3;
      bf16x8 cb[2]; f32x4 cm[2][2];
#pragma unroll
      for (int bj = 0; bj < 2; ++bj) { cb[bj] = nb[bj]; cm[bj][0] = nm[bj][0]; cm[bj][1] = nm[bj][1]; }
      if (it + 1 < 8) GM_LOAD(it + 1);
      const size_t ro = (size_t)(row0 + ai * HALF + m * 16) * DM + col0;
#pragma unroll
      for (int bj = 0; bj < 2; ++bj) {
        f32x4 o[2];
#pragma unroll
        for (int hh = 0; hh < 2; ++hh)
#pragma unroll
          for (int j = 0; j < 4; ++j)
            o[hh][j] = sigmoidf_(acc[ai][bj][m][hh][j] + bv[bj][hh][j]) * bf2f((bf16_t)cb[bj][4 * hh + j]) + cm[bj][hh][j];
        if (fin) {
          u32x4 w; w.x = cvt_pk_bf16(o[0][0], o[0][1]); w.y = cvt_pk_bf16(o[0][2], o[0][3]); w.z = cvt_pk_bf16(o[1][0], o[1][1]); w.w = cvt_pk_bf16(o[1][2], o[1][3]);
          *(u32x4*)(MIX + ro + bj * HALF) = w;
        } else {
          *(f32x4*)(MIX32 + ro + bj * HALF) = o[0]; *(f32x4*)(MIX32 + ro + bj * HALF + 4) = o[1];
        }
      }
    }
#undef GM_LOAD
  }
};
}

DI void phase_ffn_act(const Params& p, int l) {
  bf16_t* AU = (bf16_t*)(p.ws + OFF_P);
  const float* cw = p.in[I_FCW] + (size_t)l * 3 * FFN;
  const int nthr = gridDim.x * NTHR;
  for (int run = obid() * NTHR + otid(); run < 1024 * 352; run += nthr) {
    const int ch = run / 352, j8 = run % 352, j0 = j8 * 8;
    float w0[8], w1[8], w2[8];
#pragma unroll
    for (int e = 0; e < 8; ++e) { w0[e] = cw[j0 + e]; w1[e] = cw[FFN + j0 + e]; w2[e] = cw[2 * FFN + j0 + e]; }
    const int t0 = ch * 64, s0 = t0 % SEQ;
    float a1[8], a2[8];
#pragma unroll
    for (int e = 0; e < 8; ++e) { a1[e] = 0.f; a2[e] = 0.f; }
    if (s0 > 0) {
      bf16x8 v1 = *(const bf16x8*)(AU + (size_t)(t0 - 1) * AUS + j0);
      bf16x8 v2 = *(const bf16x8*)(AU + (size_t)(t0 - 2) * AUS + j0);
#pragma unroll
      for (int e = 0; e < 8; ++e) { a1[e] = bf2f((bf16_t)v1[e]); a2[e] = bf2f((bf16_t)v2[e]); }
    }
    for (int t = t0; t < t0 + 64; ++t) {
      bf16x8 va = *(const bf16x8*)(AU + (size_t)t * AUS + j0);
      bf16x8 vu = *(const bf16x8*)(AU + (size_t)t * AUS + FFN + j0);
      float o[8];
#pragma unroll
      for (int e = 0; e < 8; ++e) {
        float a0 = bf2f((bf16_t)va[e]);
        float cv = w0[e] * a2[e] + w1[e] * a1[e] + w2[e] * a0;
        o[e] = geluf_(cv) * bf2f((bf16_t)vu[e]);
        a2[e] = a1[e]; a1[e] = a0;
      }
      uint4 ov = {pack2(o[0], o[1]), pack2(o[2], o[3]), pack2(o[4], o[5]), pack2(o[6], o[7])};
      *(uint4*)(AU + (size_t)t * AUS + FFN + j0) = ov;
    }
  }
}

DI float mixf(bf16_t cur, bf16_t prev, float mu) { const float c = bf2f(cur); return c + (bf2f(prev) - c) * mu; }
DI void rw_prep_item(const Params& p, int l, int item, char* smem) {
  const bf16_t* P = (const bf16_t*)(p.ws + OFF_P);
  bf16_t* RD = (bf16_t*)(p.ws + OFF_L);
  bf16_t* RKK = (bf16_t*)(p.ws + OFF_L + GSZ);
  bf16_t* RA = (bf16_t*)(p.ws + OFF_L + 2 * GSZ);
  bf16_t* RG = (bf16_t*)(p.ws + OFF_L + 3 * GSZ);
  float* BON = (float*)(p.ws + OFF_BON);
  const int b = item >> 6, ct = item & 63;
  const int tid = otid(), lane = tid & 63, wv = tid >> 6, hd = wv & 3, mi = wv >> 2, r = lane & 31, h = lane >> 5;
  bf16_t* TX = (bf16_t*)smem;
  bf16_t* XA = TX + 64 * 40;
  bf16_t* SG = XA + 64 * 40;
  const float* mu = p.in[I_RMU] + (size_t)l * 896;
  const size_t tok0 = (size_t)b * SEQ + ct * 64;
  bf16x8 bw[2][2], ba[2][2], bg[2][4];
  {
    const float* wp = p.in[I_RWUP] + (size_t)l * 32 * 256 + hd * 64 + r;
    const float* ap = p.in[I_RAUP] + (size_t)l * 32 * 256 + hd * 64 + r;
    const float* gp = p.in[I_RGUP] + (size_t)l * 64 * 256 + hd * 64 + r;
    asm volatile("" : "+v"(wp), "+v"(ap), "+v"(gp));
#pragma unroll
    for (int ni = 0; ni < 2; ++ni) {
#pragma unroll
      for (int ks = 0; ks < 2; ++ks) {
        unsigned uw[4], ua[4];
#pragma unroll
        for (int j2 = 0; j2 < 4; ++j2) {
          const int k = 16 * ks + 8 * h + 2 * j2;
          uw[j2] = pack2(wp[k * 256 + 32 * ni], wp[(k + 1) * 256 + 32 * ni]);
          ua[j2] = pack2(ap[k * 256 + 32 * ni], ap[(k + 1) * 256 + 32 * ni]);
        }
        uint4 t1 = {uw[0], uw[1], uw[2], uw[3]}, t2 = {ua[0], ua[1], ua[2], ua[3]};
        bw[ni][ks] = __builtin_bit_cast(bf16x8, t1); ba[ni][ks] = __builtin_bit_cast(bf16x8, t2);
      }
#pragma unroll
      for (int ks = 0; ks < 4; ++ks) {
        unsigned ug[4];
#pragma unroll
        for (int j2 = 0; j2 < 4; ++j2) { const int k = 16 * ks + 8 * h + 2 * j2; ug[j2] = pack2(gp[k * 256 + 32 * ni], gp[(k + 1) * 256 + 32 * ni]); }
        uint4 t3 = {ug[0], ug[1], ug[2], ug[3]};
        bg[ni][ks] = __builtin_bit_cast(bf16x8, t3);
      }
    }
  }
#pragma unroll 4
  for (int i = 0; i < 16; ++i) {
    const int e = tid + NTHR * i; const int t = e >> 7, f = e & 127;
    const bf16_t* pr = P + (tok0 + t) * PSTR + C_RW + 768 + f;
    const bf16_t cur = pr[0];
    const bf16_t prev = (ct * 64 + t > 0) ? (pr - PSTR)[0] : (bf16_t)0;
    const float m = mixf(cur, prev, mu[768 + f]);
    if (f < 32) TX[t * 40 + f] = f2bf(tanhf_(m));
    else if (f < 64) XA[t * 40 + f - 32] = f2bf(m);
    else SG[t * 72 + f - 64] = f2bf(sigmoidf_(m));
  }
  __syncthreads();
  f32x16 cw[2], ca[2], cg[2];
#pragma unroll
  for (int ni = 0; ni < 2; ++ni)
#pragma unroll
    for (int i = 0; i < 16; ++i) { cw[ni][i] = 0.f; ca[ni][i] = 0.f; cg[ni][i] = 0.f; }
#pragma unroll
  for (int ks = 0; ks < 2; ++ks) {
    const bf16x8 atx = *(const bf16x8*)(TX + (32 * mi + r) * 40 + 16 * ks + 8 * h);
    const bf16x8 axa = *(const bf16x8*)(XA + (32 * mi + r) * 40 + 16 * ks + 8 * h);
#pragma unroll
    for (int ni = 0; ni < 2; ++ni) { cw[ni] = mfma32(atx, bw[ni][ks], cw[ni]); ca[ni] = mfma32(axa, ba[ni][ks], ca[ni]); }
  }
#pragma unroll
  for (int ks = 0; ks < 4; ++ks) {
    const bf16x8 asg = *(const bf16x8*)(SG + (32 * mi + r) * 72 + 16 * ks + 8 * h);
#pragma unroll
    for (int ni = 0; ni < 2; ++ni) cg[ni] = mfma32(asg, bg[ni][ks], cg[ni]);
  }
  float ss[16], bn[16];
#pragma unroll
  for (int i = 0; i < 16; ++i) { ss[i] = 0.f; bn[i] = 0.f; }
#pragma unroll
  for (int ni = 0; ni < 2; ++ni) {
    const int hc = hd * 64 + 32 * ni + r;
    const float w0c = p.in[I_RW0][l * 256 + hc], a0c = p.in[I_RA0][l * 256 + hc], kkc = p.in[I_RKK][l * 256 + hc],
                kac = p.in[I_RKA][l * 256 + hc], rkc = p.in[I_RRK][l * 256 + hc], mu_r = mu[hc], mu_k = mu[256 + hc];
#pragma unroll
    for (int i = 0; i < 16; ++i) {
      const int tl = 32 * mi + crow(i, h);
      const size_t tok = tok0 + tl;
      const bf16_t* pr = P + tok * PSTR + C_RW + hc;
      const bool hp = (ct * 64 + tl) > 0;
      const float rr = mixf(pr[0], hp ? (pr - PSTR)[0] : (bf16_t)0, mu_r);
      const float k = mixf(pr[256], hp ? (pr - PSTR)[256] : (bf16_t)0, mu_k);
      const float wl = w0c + cw[ni][i];
      const float wlog = -softplusf_(-wl) - 0.5f;
      const float dd = 1.f - __expf(-__expf(wlog));
      const float a = sigmoidf_(a0c + ca[ni][i]);
      const float kkr = k * kkc;
      const float kp = k * (1.f + (a - 1.f) * kac);
      ss[i] += kkr * kkr; bn[i] += rr * kp * rkc;
      cw[ni][i] = kkr;
      RD[tok * 256 + hc] = f2bf(dd); RA[tok * 256 + hc] = f2bf(a); RG[tok * 256 + hc] = f2bf(cg[ni][i]);
    }
  }
#pragma unroll
  for (int i = 0; i < 16; ++i) {
#pragma unroll
    for (int o = 1; o < 32; o <<= 1) { ss[i] += __shfl_xor(ss[i], o); bn[i] += __shfl_xor(bn[i], o); }
    ss[i] = rsqrtf(ss[i] + EPSF);
  }
#pragma unroll
  for (int ni = 0; ni < 2; ++ni) {
    const int hc = hd * 64 + 32 * ni + r;
#pragma unroll
    for (int i = 0; i < 16; ++i) {
      const size_t tok = tok0 + 32 * mi + crow(i, h);
      RKK[tok * 256 + hc] = f2bf(cw[ni][i] * ss[i]);
    }
  }
  if (r == 0) {
#pragma unroll
    for (int i = 0; i < 16; ++i) BON[(tok0 + 32 * mi + crow(i, h)) * 4 + hd] = bn[i];
  }
}

DI void rwkv_scan_item(const Params& p, int l, int b, int hd, int half, char* smem) {
  const bf16_t* P = (const bf16_t*)(p.ws + OFF_P);
  bf16_t* O = (bf16_t*)(p.ws + OFF_O);
  const bf16_t* RD = (const bf16_t*)(p.ws + OFF_L);
  const bf16_t* RKK = (const bf16_t*)(p.ws + OFF_L + GSZ);
  const bf16_t* RA = (const bf16_t*)(p.ws + OFF_L + 2 * GSZ);
  float* fb = (float*)smem;
  float* Yb = fb + 2 * 6208;
  const int tid = otid(), lane = tid & 63, wv = tid >> 6;
  const int hc = hd * 64 + lane;
  constexpr int NCH = SEQ / 16;
  float S[8];
#pragma unroll
  for (int j = 0; j < 8; ++j) S[j] = 0.f;
  const int rl = lane >> 3, kq = lane & 7, vloc = (wv & 3) * 8 + rl, vrow = half * 32 + vloc;
  const float* mu = p.in[I_RMU] + (size_t)l * 896;
  const float mu_r = mu[hc], mu_k = mu[256 + hc], mu_v = mu[512 + hc];
  const float kac = p.in[I_RKA][l * 256 + hc];
  const int pw = wv & 3;
  unsigned raw[4][9];
#pragma unroll
  for (int j = 0; j < 4; ++j)
#pragma unroll
    for (int e = 0; e < 9; ++e) raw[j][e] = 0u;
#define RAWLOAD(i_)                                                                                 \
  {                                                                                                 \
    _Pragma("unroll") for (int j = 0; j < 4; ++j) {                                                 \
      const int s_ = (i_) * 16 + pw * 4 + j;                                                        \
      const size_t tok_ = (size_t)b * SEQ + s_;                                                     \
      const bf16_t* pr_ = P + tok_ * PSTR + C_RW;                                                   \
      raw[j][0] = pr_[hc]; raw[j][1] = pr_[256 + hc]; raw[j][2] = pr_[512 + hc];                    \
      if (s_ > 0) { raw[j][3] = (pr_ - PSTR)[hc]; raw[j][4] = (pr_ - PSTR)[256 + hc]; raw[j][5] = (pr_ - PSTR)[512 + hc]; } \
      else { raw[j][3] = 0u; raw[j][4] = 0u; raw[j][5] = 0u; }                                      \
      raw[j][6] = RD[tok_ * 256 + hc]; raw[j][7] = RKK[tok_ * 256 + hc]; raw[j][8] = RA[tok_ * 256 + hc]; \
    }                                                                                               \
  }
#define RBAR() { asm volatile("s_waitcnt lgkmcnt(0)" ::: "memory"); __builtin_amdgcn_s_barrier(); asm volatile("" ::: "memory"); }
  if (wv >= 4) RAWLOAD(0);
#pragma unroll 1
  for (int i = 0; i < NCH + 2; ++i) {
    if (wv >= 4) {
      float* B = fb + (i & 1) * 6208;
      if (i >= 2) {
        const float* Yc = Yb + (i & 1) * 512;
        if (lane < 32) {
#pragma unroll
          for (int j = 0; j < 4; ++j) {
            const int tl = pw * 4 + j;
            const size_t tok = (size_t)b * SEQ + (i - 2) * 16 + tl;
            O[tok * DM + 768 + hd * 64 + half * 32 + lane] = f2bf(Yc[tl * 32 + lane]);
          }
        }
      }
      if (i < NCH) {
#pragma unroll
        for (int j = 0; j < 4; ++j) {
          const int tl = pw * 4 + j;
          const float r = mixf((bf16_t)raw[j][0], (bf16_t)raw[j][3], mu_r), k = mixf((bf16_t)raw[j][1], (bf16_t)raw[j][4], mu_k), v = mixf((bf16_t)raw[j][2], (bf16_t)raw[j][5], mu_v);
          const float w = 1.f - bf2f((bf16_t)raw[j][6]), kk = bf2f((bf16_t)raw[j][7]), a = bf2f((bf16_t)raw[j][8]);
          const float ka = kk * a, kp = k * (1.f + (a - 1.f) * kac);
          const float c1 = wave_sum(ka * r), c2 = wave_sum(kp * r);
          B[tl * 64 + lane] = w; B[1024 + tl * 64 + lane] = kk; B[2048 + tl * 64 + lane] = ka; B[3072 + tl * 64 + lane] = kp;
          B[4096 + tl * 64 + lane] = w * r; B[5120 + tl * 64 + lane] = v;
          if (lane == 0) { B[6144 + tl * 2] = c1; B[6144 + tl * 2 + 1] = c2; }
        }
        if (i + 1 < NCH) RAWLOAD(i + 1);
      }
    } else if (i >= 1 && i <= NCH) {
      const float* B = fb + ((i - 1) & 1) * 6208;
      float* Yc = Yb + ((i - 1) & 1) * 512;
      f32x4 vw[2][10]; float vvv[2]; float2 vsc[2];
#define RWLD(t_, s_)                                                                              \
      { const float* bt_ = B + (t_) * 64 + kq * 8;                                                 \
        _Pragma("unroll") for (int q_ = 0; q_ < 5; ++q_) { vw[s_][2 * q_] = *(const f32x4*)(bt_ + 1024 * q_); vw[s_][2 * q_ + 1] = *(const f32x4*)(bt_ + 1024 * q_ + 4); } \
        vvv[s_] = B[5120 + (t_) * 64 + vrow]; vsc[s_] = *(const float2*)(B + 6144 + (t_) * 2); }
      RWLD(0, 0);
#pragma unroll
      for (int t = 0; t < 16; ++t) {
        const int cs = t & 1;
        if (t + 1 < 16) RWLD(t + 1, cs ^ 1);
        const f32x4 w0 = vw[cs][0], w1 = vw[cs][1], kk0 = vw[cs][2], kk1 = vw[cs][3], ka0 = vw[cs][4], ka1 = vw[cs][5],
                    kp0 = vw[cs][6], kp1 = vw[cs][7], wr0 = vw[cs][8], wr1 = vw[cs][9];
        const float vv = vvv[cs]; const float2 sc = vsc[cs];
        float d0 = 0.f, e0 = 0.f;
#pragma unroll
        for (int j = 0; j < 4; ++j) { d0 += S[j] * kk0[j] + S[j + 4] * kk1[j]; e0 += S[j] * wr0[j] + S[j + 4] * wr1[j]; }
        d0 = reduce8(d0); e0 = reduce8(e0);
        const float sa0 = -d0;
        const float y0 = e0 + sa0 * sc.x + vv * sc.y;
#pragma unroll
        for (int j = 0; j < 4; ++j) {
          S[j] = S[j] * w0[j] + sa0 * ka0[j] + vv * kp0[j]; S[j + 4] = S[j + 4] * w1[j] + sa0 * ka1[j] + vv * kp1[j];
        }
        if (kq == 0) Yc[t * 32 + vloc] = y0;
      }
#undef RWLD
    }
    RBAR();
  }
#undef RAWLOAD
#undef RBAR
}

DI void rwkv_post(const Params& p, int l) {
  const bf16_t* P = (const bf16_t*)(p.ws + OFF_P);
  bf16_t* O = (bf16_t*)(p.ws + OFF_O);
  const bf16_t* RG = (const bf16_t*)(p.ws + OFF_L + 3 * GSZ);
  const float* BON = (const float*)(p.ws + OFF_BON);
  const int tid = otid(), lane = tid & 63, wv = tid >> 6;
  const float* mu = p.in[I_RMU] + (size_t)l * 896;
  const int nw = gridDim.x * 8;
  for (int task0 = (obid() * 8 + wv) * 4; task0 < NTOK * 4; task0 += nw * 4) {
    float yv[4], vv[4], gv[4], bv[4];
#pragma unroll
    for (int q = 0; q < 4; ++q) {
      const int task = task0 + q; const size_t tok = task >> 2; const int hd = task & 3, hc = hd * 64 + lane;
      yv[q] = bf2f(O[tok * DM + 768 + hc]);
      const bf16_t cur = P[tok * PSTR + C_RW + 512 + hc];
      const bf16_t prev = (tok % SEQ) ? P[(tok - 1) * PSTR + C_RW + 512 + hc] : (bf16_t)0;
      vv[q] = mixf(cur, prev, mu[512 + hc]);
      gv[q] = bf2f(RG[tok * 256 + hc]); bv[q] = BON[tok * 4 + hd];
    }
#pragma unroll
    for (int q = 0; q < 4; ++q) {
      const int task = task0 + q; const size_t tok = task >> 2; const int hd = task & 3, hc = hd * 64 + lane;
      const float mean = wave_sum(yv[q]) * (1.f / 64.f);
      const float d = yv[q] - mean;
      const float var = wave_sum(d * d) * (1.f / 64.f);
      const float yn = d * rsqrtf(var + 64e-5f) * p.in[I_RLG][l * 256 + hc] + p.in[I_RLB][l * 256 + hc];
      O[tok * DM + 768 + hc] = f2bf((yn + bv[q] * vv[q]) * gv[q]);
    }
  }
}

DI void sb_item(const Params& p, int item, char* smem) {
  const bf16_t* P = (const bf16_t*)(p.ws + OFF_P);
  bf16_t* O = (bf16_t*)(p.ws + OFF_O);
  const int qt = item & 15, hd = (item >> 4) & 3, b = item >> 6;
  const int tid = otid(), lane = tid & 63, wv = tid >> 6, r = lane & 31, h = lane >> 5;
  bf16_t* Vt = (bf16_t*)(smem + wv * 8704);
  const int q0 = qt * 256 + wv * 32;
  const int sq = q0 + r;
  const size_t tokb = (size_t)b * SEQ;
  bf16x8 qf[4];
#pragma unroll
  for (int ks = 0; ks < 4; ++ks) qf[ks] = *(const bf16x8*)(P + (tokb + sq) * PSTR + C_SB_Q + hd * 64 + ks * 16 + h * 8);
  f32x16 accO[2];
#pragma unroll
  for (int i = 0; i < 16; ++i) { accO[0][i] = 0.f; accO[1][i] = 0.f; }
  float Prun = 1.f;
  bf16x8 kf[2][4];
  const int kt0 = (q0 + 31) >> 6;
#define SBKLOAD(kt_) { _Pragma("unroll") for (int m = 0; m < 2; ++m) _Pragma("unroll") for (int ks = 0; ks < 4; ++ks) \
    kf[m][ks] = *(const bf16x8*)(P + (tokb + (kt_) * 64 + 32 * m + r) * PSTR + C_SB_K + hd * 64 + ks * 16 + h * 8); }
  SBKLOAD(kt0);
  for (int kt = kt0; kt >= 0; --kt) {
    const int k0 = kt * 64;
    bf16x8 vr[8];
#pragma unroll
    for (int it = 0; it < 8; ++it) vr[it] = *(const bf16x8*)(P + (tokb + k0 + it * 8 + (lane >> 3)) * PSTR + C_SB_V + hd * 64 + (lane & 7) * 8);
    f32x16 acc[2];
#pragma unroll
    for (int m = 0; m < 2; ++m) {
#pragma unroll
      for (int i = 0; i < 16; ++i) acc[m][i] = 0.f;
#pragma unroll
      for (int ks = 0; ks < 4; ++ks) acc[m] = mfma32(kf[m][ks], qf[ks], acc[m]);
    }
    if (kt > 0) SBKLOAD(kt - 1);
    float om[2][16];
#pragma unroll
    for (int m = 0; m < 2; ++m)
#pragma unroll
      for (int i = 0; i < 16; ++i) {
        const int key = k0 + 32 * m + crow(i, h);
        const float z = fmaxf(acc[m][i] * 0.125f, -80.f);
        const float e = __expf(-z);
        const float sg = __builtin_amdgcn_rcpf(1.f + e);
        const bool valid = key < sq;
        acc[m][i] = valid ? sg : 0.f;
        om[m][i] = valid ? e * sg : 1.f;
      }
    float gp[8];
#pragma unroll
    for (int q = 0; q < 8; ++q) {
      const int m = q >> 2, g = q & 3;
      gp[q] = (om[m][4 * g] * om[m][4 * g + 1]) * (om[m][4 * g + 2] * om[m][4 * g + 3]);
    }
    float run = 1.f;
#pragma unroll
    for (int q = 7; q >= 0; --q) {
      const int m = q >> 2, g = q & 3;
      const float pg = __shfl_xor(gp[q], 32);
      const float f3 = Prun * run * (h == 0 ? pg : 1.f);
      const float f2 = f3 * om[m][4 * g + 3], f1 = f2 * om[m][4 * g + 2], f0 = f1 * om[m][4 * g + 1];
      acc[m][4 * g + 3] *= f3; acc[m][4 * g + 2] *= f2; acc[m][4 * g + 1] *= f1; acc[m][4 * g + 0] *= f0;
      run *= gp[q] * pg;
    }
    Prun *= run;
    __builtin_amdgcn_wave_barrier();
#pragma unroll
    for (int it = 0; it < 8; ++it) {
      const int key = it * 8 + (lane >> 3), chv = lane & 7;
#pragma unroll
      for (int e = 0; e < 8; ++e) Vt[(chv * 8 + e) * 68 + key] = (bf16_t)vr[it][e];
    }
    __builtin_amdgcn_wave_barrier();
#pragma unroll
    for (int m = 0; m < 2; ++m)
#pragma unroll
      for (int s2 = 0; s2 < 2; ++s2) {
        uint4 uu = {pack2(acc[m][8 * s2 + 0], acc[m][8 * s2 + 1]), pack2(acc[m][8 * s2 + 2], acc[m][8 * s2 + 3]),
                    pack2(acc[m][8 * s2 + 4], acc[m][8 * s2 + 5]), pack2(acc[m][8 * s2 + 6], acc[m][8 * s2 + 7])};
        const bf16x8 pb = __builtin_bit_cast(bf16x8, uu);
#pragma unroll
        for (int dt = 0; dt < 2; ++dt) {
          const bf16_t* vp = Vt + (32 * dt + r) * 68 + 32 * m + 16 * s2 + 4 * h;
          s16x4 lo = *(const s16x4*)vp, hi = *(const s16x4*)(vp + 8);
          bf16x8 va = __builtin_shufflevector(lo, hi, 0, 1, 2, 3, 4, 5, 6, 7);
          accO[dt] = mfma32(va, pb, accO[dt]);
        }
      }
    __builtin_amdgcn_wave_barrier();
    if (__ballot(Prun > 1e-37f) == 0ull) break;
  }
#undef SBKLOAD
#pragma unroll
  for (int dt = 0; dt < 2; ++dt)
#pragma unroll
    for (int g = 0; g < 4; ++g) {
      const int d = 32 * dt + 8 * g + 4 * h;
      uint2 o = {pack2(accO[dt][4 * g], accO[dt][4 * g + 1]), pack2(accO[dt][4 * g + 2], accO[dt][4 * g + 3])};
      *(uint2*)(O + (tokb + sq) * DM + 256 + hd * 64 + d) = o;
    }
}

DI int frag_off(int row, int k) {
  const int rt = row >> 4, fr = row & 15, ks = k >> 5, kk = k & 31, hi = kk >> 4, fq = (kk & 15) >> 2, j = (kk & 3) + 4 * hi;
  return ((rt * 2 + ks) * 64 + fq * 16 + fr) * 8 + j;
}
DI int frag_off8(int row, int k0) {
  const int rt = row >> 4, fr = row & 15, ks = k0 >> 5, kk = k0 & 31, hi = kk >> 4, fq = (kk & 15) >> 2;
  return ((rt * 2 + ks) * 64 + fq * 16 + fr) * 8 + 4 * hi;
}
DI void gdn_intra_item(const Params& p, int l, int item, char* smem) {
  const bf16_t* P = (const bf16_t*)(p.ws + OFF_P);
  const int hp = item & 1, c = (item >> 1) & 63, b = item >> 7;
  const int tid = otid(), lane = tid & 63;
  bf16_t* Kb = (bf16_t*)smem;
  bf16_t* Qb = Kb + 2 * 64 * 72;
  bf16_t* Vb = Qb + 2 * 64 * 72;
  float* Lm = (float*)(smem + 3 * 2 * 64 * 72 * 2);
  float* Gs = Lm + 2 * 4096;
  float* Bs = Gs + 128;
  const size_t tok0 = (size_t)b * SEQ + c * 64;
  const float* cw = p.in[I_GCW] + (size_t)l * 4 * 768;
  float* CW = Bs + 128;
  for (int e = tid; e < 6 * 4 * 64; e += NTHR) {
    const int blk = e >> 8, j = (e >> 6) & 3, col = e & 63;
    const int hh_ = blk / 3, which_ = blk % 3;
    CW[e] = cw[j * 768 + which_ * 256 + (hp * 2 + hh_) * 64 + col];
  }
  __syncthreads();
  {
    const int t = tid >> 3, cg = tid & 7;
#pragma unroll 3
    for (int it = 0; it < 6; ++it) {
      const int hh = it / 3, which = it % 3, head = hp * 2 + hh;
      const int ccol = which * 256 + head * 64 + cg * 8;
      float acc[8];
#pragma unroll
      for (int e = 0; e < 8; ++e) acc[e] = 0.f;
#pragma unroll
      for (int j = 0; j < 4; ++j) {
        const int s = c * 64 + t - 3 + j;
        if (s >= 0) {
          bf16x8 xv = *(const bf16x8*)(P + ((size_t)b * SEQ + s) * PSTR + C_GDN_Q + ccol);
          f32x4 wa = *(const f32x4*)(CW + (it * 4 + j) * 64 + cg * 8), wb = *(const f32x4*)(CW + (it * 4 + j) * 64 + cg * 8 + 4);
#pragma unroll
          for (int e = 0; e < 4; ++e) { acc[e] += wa[e] * bf2f((bf16_t)xv[e]); acc[e + 4] += wb[e] * bf2f((bf16_t)xv[e + 4]); }
        }
      }
      float ss = 0.f;
#pragma unroll
      for (int e = 0; e < 8; ++e) { acc[e] = siluf_(acc[e]); ss += acc[e] * acc[e]; }
      ss += __shfl_xor(ss, 1); ss += __shfl_xor(ss, 2); ss += __shfl_xor(ss, 4);
      float sc = 1.f;
      if (which == 0) sc = rsqrtf(ss + EPSF) * 0.125f;
      else if (which == 1) sc = rsqrtf(ss + EPSF);
      uint4 ov = {pack2(acc[0] * sc, acc[1] * sc), pack2(acc[2] * sc, acc[3] * sc), pack2(acc[4] * sc, acc[5] * sc), pack2(acc[6] * sc, acc[7] * sc)};
      bf16_t* dst = (which == 0 ? Qb : (which == 1 ? Kb : Vb)) + (hh * 64 + t) * 72 + cg * 8;
      *(uint4*)dst = ov;
    }
  }
  if (tid < 128) {
    const int hh = tid >> 6, t = lane, head = hp * 2 + hh;
    const float a_in = bf2f(P[(tok0 + t) * PSTR + C_GDN_A + head]);
    const float b_in = bf2f(P[(tok0 + t) * PSTR + C_GDN_B + head]);
    const float beta = sigmoidf_(b_in);
    float g = -__expf(p.in[I_GAL][l * 4 + head]) * softplusf_(a_in + p.in[I_GDT][l * 4 + head]);
#pragma unroll
    for (int d = 1; d < 64; d <<= 1) { float v = __shfl_up(g, d); if (lane >= d) g += v; }
    Gs[hh * 64 + t] = g; Bs[hh * 64 + t] = beta;
  }
  __syncthreads();
  const int hh = tid >> 8, lt = tid & 255, head = hp * 2 + hh;
  const size_t ih = ((size_t)(b * 4 + head)) * 64 + c;
  bf16_t* GW = (bf16_t*)(p.ws + OFF_G) + ih * 4096;
  bf16_t* GQD = (bf16_t*)(p.ws + OFF_G + GSZ) + ih * 4096;
  bf16_t* GQK = (bf16_t*)(p.ws + OFF_G + 2 * GSZ) + ih * 4096;
  bf16_t* GKD = (bf16_t*)(p.ws + OFF_G + 3 * GSZ) + ih * 4096;
  bf16_t* GU = (bf16_t*)(p.ws + OFF_G + 4 * GSZ) + ih * 4096;
  float* GCD = (float*)(p.ws + OFF_GCD);
  const float* Gh = Gs + hh * 64; const float* Bh = Bs + hh * 64;
  {
    const int wq = (tid >> 6) & 3, ti = wq >> 1, tj = wq & 1, r = lane & 31, h = lane >> 5;
    f32x16 akk, aqk;
#pragma unroll
    for (int i = 0; i < 16; ++i) { akk[i] = 0.f; aqk[i] = 0.f; }
    if (ti >= tj) {
#pragma unroll
      for (int ks = 0; ks < 4; ++ks) {
        bf16x8 ka = *(const bf16x8*)(Kb + (hh * 64 + 32 * ti + r) * 72 + ks * 16 + h * 8);
        bf16x8 qa = *(const bf16x8*)(Qb + (hh * 64 + 32 * ti + r) * 72 + ks * 16 + h * 8);
        bf16x8 kb = *(const bf16x8*)(Kb + (hh * 64 + 32 * tj + r) * 72 + ks * 16 + h * 8);
        akk = mfma32(ka, kb, akk);
        aqk = mfma32(qa, kb, aqk);
      }
    }
    const int j = 32 * tj + r;
    const float Gj = Gh[j];
#pragma unroll
    for (int i_ = 0; i_ < 16; ++i_) {
      const int i = 32 * ti + crow(i_, h);
      const float dec = (i >= j) ? __expf(Gh[i] - Gj) : 0.f;
      Lm[hh * 4096 + i * 64 + j] = (i > j) ? Bh[i] * akk[i_] * dec : 0.f;
      GQK[frag_off(i, j)] = f2bf((i >= j) ? aqk[i_] * dec : 0.f);
    }
  }
  __syncthreads();
  if (lt < 128) {
    const int cc = lt;
    float x[64];
    if (cc < 64) {
#pragma unroll
      for (int i = 0; i < 64; ++i) x[i] = bf2f(Vb[(hh * 64 + i) * 72 + cc]) * Bh[i];
    } else {
#pragma unroll
      for (int i = 0; i < 64; ++i) x[i] = bf2f(Kb[(hh * 64 + i) * 72 + cc - 64]) * Bh[i] * __expf(Gh[i]);
    }
    const float* Lh = Lm + hh * 4096;
#pragma unroll
    for (int i = 1; i < 64; ++i) {
      float s = x[i];
#pragma unroll
      for (int j4 = 0; j4 < (i + 3) / 4; ++j4) {
        const f32x4 lv = *(const f32x4*)(Lh + i * 64 + j4 * 4);
#pragma unroll
        for (int e = 0; e < 4; ++e) if (j4 * 4 + e < i) s -= lv[e] * x[j4 * 4 + e];
      }
      x[i] = s;
    }
    if (cc < 64) {
      const int split = cc >> 4, fr = cc & 15;
#pragma unroll
      for (int i4 = 0; i4 < 16; ++i4) {
        uint2 ov = {pack2(x[4 * i4], x[4 * i4 + 1]), pack2(x[4 * i4 + 2], x[4 * i4 + 3])};
        *(uint2*)(GU + ((split * 4 + (i4 >> 2)) * 64 + (i4 & 3) * 16 + fr) * 4) = ov;
      }
    } else {
#pragma unroll
      for (int i = 0; i < 64; ++i) GW[frag_off(i, cc - 64)] = f2bf(x[i]);
    }
  } else {
    const int q_ = lt - 128;
    const float Glast = Gh[63];
#pragma unroll
    for (int i = 0; i < 4; ++i) {
      const int q = q_ + 128 * i; const int pos = q >> 3, kc = q & 7;
      bf16x8 qv = *(const bf16x8*)(Qb + (hh * 64 + pos) * 72 + kc * 8);
      const float eg = __expf(Gh[pos]);
      uint4 ov = {pack2(bf2f((bf16_t)qv[0]) * eg, bf2f((bf16_t)qv[1]) * eg), pack2(bf2f((bf16_t)qv[2]) * eg, bf2f((bf16_t)qv[3]) * eg),
                  pack2(bf2f((bf16_t)qv[4]) * eg, bf2f((bf16_t)qv[5]) * eg), pack2(bf2f((bf16_t)qv[6]) * eg, bf2f((bf16_t)qv[7]) * eg)};
      { const int fo = frag_off8(pos, kc * 8); uint2 o0 = {ov.x, ov.y}, o1 = {ov.z, ov.w}; *(uint2*)(GQD + fo) = o0; *(uint2*)(GQD + fo + 128) = o1; }
    }
#pragma unroll
    for (int i = 0; i < 4; ++i) {
      const int q = q_ + 128 * i; const int k = q >> 3, pc = q & 7;
      float o[8];
#pragma unroll
      for (int e = 0; e < 8; ++e) { const int pos = pc * 8 + e; o[e] = bf2f(Kb[(hh * 64 + pos) * 72 + k]) * __expf(Glast - Gh[pos]); }
      uint4 ov = {pack2(o[0], o[1]), pack2(o[2], o[3]), pack2(o[4], o[5]), pack2(o[6], o[7])};
      { const int fo = frag_off8(k, pc * 8); uint2 o0 = {ov.x, ov.y}, o1 = {ov.z, ov.w}; *(uint2*)(GKD + fo) = o0; *(uint2*)(GKD + fo + 128) = o1; }
    }
    if (q_ == 0) GCD[ih] = __expf(Glast);
  }
}

DI void gdn_rec_item(const Params& p, int l, int b, int head, char* smem) {
  const bf16_t* P = (const bf16_t*)(p.ws + OFF_P);
  bf16_t* O = (bf16_t*)(p.ws + OFF_O);
  float* SS = (float*)(smem + 81920);
  const int tid = otid(), lane = tid & 63, wv = tid >> 6, fr = lane & 15, fq = lane >> 4;
  const int split = wv & 3;
  const bool active = wv < 4;
  const float ng = p.in[I_GNG][l * 64 + split * 16 + fr];
  const float* GCD = (const float*)(p.ws + OFF_GCD);
  const size_t ih0 = ((size_t)(b * 4 + head)) * 64;
  f32x4 S[4];
#pragma unroll
  for (int kt = 0; kt < 4; ++kt) S[kt] = (f32x4){0.f, 0.f, 0.f, 0.f};
  u32x4 lr[10];
#pragma unroll
  for (int i = 0; i < 10; ++i) lr[i] = (u32x4){0u, 0u, 0u, 0u};
  const int lq = (wv & 3) * 64 + lane;
#define GLOADC(c_)                                                                              \
  {                                                                                             \
    _Pragma("unroll") for (int i = 0; i < 10; ++i) {                                            \
      const int q_ = lq + 256 * i; const int a_ = q_ >> 9, o_ = q_ & 511;                       \
      lr[i] = *(const u32x4*)((const bf16_t*)(p.ws + OFF_G + (size_t)a_ * GSZ) + (ih0 + (c_)) * 4096 + o_ * 8); \
    }                                                                                           \
  }
#define LSTORE(buf_)                                                                            \
  {                                                                                             \
    _Pragma("unroll") for (int i = 0; i < 10; ++i) {                                            \
      const int q_ = lq + 256 * i;                                                              \
      *(u32x4*)(smem + (buf_) * 40960 + q_ * 16) = lr[i];                                       \
    }                                                                                           \
  }
#define BAR_LDS() { asm volatile("s_waitcnt lgkmcnt(0)" ::: "memory"); __builtin_amdgcn_s_barrier(); asm volatile("" ::: "memory"); }
  float cdn = 0.f;
  if (!active) { GLOADC(0); LSTORE(0); GLOADC(1); }
  else cdn = GCD[ih0];
  BAR_LDS();
#pragma unroll 1
  for (int c = 0; c < 64; ++c) {
    f32x4 acco[4];
    if (active) {
      const char* bufp = smem + (c & 1) * 40960;
      const float cd = cdn;
      if (c + 1 < 64) cdn = GCD[ih0 + c + 1];
      float zr[16];
#pragma unroll
      for (int rt = 0; rt < 4; ++rt)
#pragma unroll
        for (int j = 0; j < 4; ++j) {
          const size_t tok = (size_t)b * SEQ + c * 64 + 16 * rt + 4 * fq + j;
          zr[rt * 4 + j] = bf2f(P[tok * PSTR + C_GDN_Z + head * 64 + split * 16 + fr]);
        }
      bf16x8 bS[2];
#pragma unroll
      for (int ks = 0; ks < 2; ++ks) {
        uint4 uu = {pack2(S[2 * ks][0], S[2 * ks][1]), pack2(S[2 * ks][2], S[2 * ks][3]), pack2(S[2 * ks + 1][0], S[2 * ks + 1][1]), pack2(S[2 * ks + 1][2], S[2 * ks + 1][3])};
        bS[ks] = __builtin_bit_cast(bf16x8, uu);
      }
      f32x4 u[4];
#pragma unroll
      for (int rt = 0; rt < 4; ++rt) {
        f32x4 aw = {0.f, 0.f, 0.f, 0.f};
        acco[rt] = (f32x4){0.f, 0.f, 0.f, 0.f};
#pragma unroll
        for (int ks = 0; ks < 2; ++ks) {
          const bf16x8 wa = *(const bf16x8*)(bufp + ((rt * 2 + ks) * 64 + lane) * 16);
          const bf16x8 qa = *(const bf16x8*)(bufp + 8192 + ((rt * 2 + ks) * 64 + lane) * 16);
          aw = mfma16(wa, bS[ks], aw); acco[rt] = mfma16(qa, bS[ks], acco[rt]);
        }
        const s16x4 uv = *(const s16x4*)(bufp + 32768 + ((split * 4 + rt) * 64 + lane) * 8);
#pragma unroll
        for (int j = 0; j < 4; ++j) u[rt][j] = bf2f((bf16_t)uv[j]) - aw[j];
      }
      bf16x8 bU[2];
#pragma unroll
      for (int ks = 0; ks < 2; ++ks) {
        uint4 uu = {pack2(u[2 * ks][0], u[2 * ks][1]), pack2(u[2 * ks][2], u[2 * ks][3]), pack2(u[2 * ks + 1][0], u[2 * ks + 1][1]), pack2(u[2 * ks + 1][2], u[2 * ks + 1][3])};
        bU[ks] = __builtin_bit_cast(bf16x8, uu);
      }
#pragma unroll
      for (int rt = 0; rt < 4; ++rt) {
        f32x4 sn = S[rt] * cd;
#pragma unroll
        for (int ks = 0; ks < 2; ++ks) {
          const bf16x8 qa = *(const bf16x8*)(bufp + 16384 + ((rt * 2 + ks) * 64 + lane) * 16);
          const bf16x8 ka = *(const bf16x8*)(bufp + 24576 + ((rt * 2 + ks) * 64 + lane) * 16);
          acco[rt] = mfma16(qa, bU[ks], acco[rt]); sn = mfma16(ka, bU[ks], sn);
        }
        S[rt] = sn;
      }
#pragma unroll
      for (int rt = 0; rt < 4; ++rt)
#pragma unroll
        for (int j = 0; j < 4; ++j) {
          float s = acco[rt][j] * acco[rt][j];
          s += __shfl_xor(s, 1); s += __shfl_xor(s, 2); s += __shfl_xor(s, 4); s += __shfl_xor(s, 8);
          if (fr == 0) SS[(c & 1) * 256 + split * 64 + 16 * rt + 4 * fq + j] = s;
        }
      BAR_LDS();
      const float* ssb = SS + (c & 1) * 256;
#pragma unroll
      for (int rt = 0; rt < 4; ++rt)
#pragma unroll
        for (int j = 0; j < 4; ++j) {
          const int pos = 16 * rt + 4 * fq + j;
          const float tot = ssb[pos] + ssb[64 + pos] + ssb[128 + pos] + ssb[192 + pos];
          const float rn = rsqrtf(tot * (1.f / 64.f) + EPSF);
          const size_t tok = (size_t)b * SEQ + c * 64 + pos;
          O[tok * DM + 512 + head * 64 + split * 16 + fr] = f2bf(acco[rt][j] * rn * ng * siluf_(zr[rt * 4 + j]));
        }
    } else {
      if (c + 1 < 64) LSTORE((c + 1) & 1);
      if (c + 2 < 64) GLOADC(c + 2);
      BAR_LDS();
    }
  }
#undef GLOADC
#undef LSTORE
#undef BAR_LDS
}

DI void lru_item(const Params& p, int l, int item, char* smem, const int mode) {
  const bf16_t* P = (const bf16_t*)(p.ws + OFF_P);
  bf16_t* O = (bf16_t*)(p.ws + OFF_O);
  float* CA = (float*)(p.ws + OFF_LCA);
  float* CH = (float*)(p.ws + OFF_LCH);
  bf16_t* XS = (bf16_t*)smem;
  bf16_t* UB = (bf16_t*)(smem + 34816);
  const int b = item >> 6, ct = item & 63;
  const int tid = otid(), lane = tid & 63, wv = tid >> 6, r = lane & 31, h = lane >> 5, n = wv & 3, mi = wv >> 2;
  for (int i = 0; i < 5; ++i) {
    const int q = tid + NTHR * i;
    if (q < 67 * 32) {
      const int row = q >> 5, cc = q & 31;
      const int s = ct * 64 - 3 + row;
      uint4 v = {0u, 0u, 0u, 0u};
      if (s >= 0) v = *(const uint4*)(P + ((size_t)b * SEQ + s) * PSTR + C_LRU_X + cc * 8);
      *(uint4*)(XS + row * 256 + cc * 8) = v;
    }
  }
  bf16x8 bwr[2][4], bwi[2][4];
  {
    const float* wrp = p.in[I_LWR] + (((size_t)l * 4 + n) * 64) * 64 + r;
    const float* wip = p.in[I_LWI] + (((size_t)l * 4 + n) * 64) * 64 + r;
    asm volatile("" : "+v"(wrp), "+v"(wip));
#pragma unroll
    for (int ni = 0; ni < 2; ++ni)
#pragma unroll
      for (int ks = 0; ks < 4; ++ks) {
        unsigned ur[4], ui[4];
#pragma unroll
        for (int j2 = 0; j2 < 4; ++j2) {
          const int e = 16 * ks + 8 * h + 2 * j2;
          ur[j2] = pack2(wrp[e * 64 + 32 * ni], wrp[(e + 1) * 64 + 32 * ni]);
          ui[j2] = pack2(wip[e * 64 + 32 * ni], wip[(e + 1) * 64 + 32 * ni]);
        }
        uint4 t1 = {ur[0], ur[1], ur[2], ur[3]}, t2 = {ui[0], ui[1], ui[2], ui[3]};
        bwr[ni][ks] = __builtin_bit_cast(bf16x8, t1); bwi[ni][ks] = __builtin_bit_cast(bf16x8, t2);
      }
  }
  __syncthreads();
  {
    const int sc = tid >> 8, c = tid & 255;
    const float cb = p.in[I_LCB][l * 256 + c];
    const float c0 = p.in[I_LCW][(l * 4 + 0) * 256 + c], c1 = p.in[I_LCW][(l * 4 + 1) * 256 + c],
                c2 = p.in[I_LCW][(l * 4 + 2) * 256 + c], c3 = p.in[I_LCW][(l * 4 + 3) * 256 + c];
    for (int t = sc * 32; t < sc * 32 + 32; ++t)
      UB[t * 264 + c] = f2bf(cb + c0 * bf2f(XS[t * 256 + c]) + c1 * bf2f(XS[(t + 1) * 256 + c]) + c2 * bf2f(XS[(t + 2) * 256 + c]) + c3 * bf2f(XS[(t + 3) * 256 + c]));
  }
  __syncthreads();
  f32x16 ar[2], ai[2];
#pragma unroll
  for (int ni = 0; ni < 2; ++ni)
#pragma unroll
    for (int i = 0; i < 16; ++i) { ar[ni][i] = 0.f; ai[ni][i] = 0.f; }
#pragma unroll
  for (int ks = 0; ks < 4; ++ks) {
    const bf16x8 au = *(const bf16x8*)(UB + (32 * mi + r) * 264 + n * 64 + 16 * ks + 8 * h);
#pragma unroll
    for (int ni = 0; ni < 2; ++ni) { ar[ni] = mfma32(au, bwr[ni][ks], ar[ni]); ai[ni] = mfma32(au, bwi[ni][ks], ai[ni]); }
  }
  const int ck = ct * 2 + mi;
#pragma unroll
  for (int ni = 0; ni < 2; ++ni) {
    const int c = n * 64 + 32 * ni + r;
    const float brc = p.in[I_LBR][l * 256 + c], bic = p.in[I_LBI][l * 256 + c];
    const float lamsp = softplusf_(-p.in[I_LLAM][l * 256 + c]);
    float av[16], bv[16];
#pragma unroll
    for (int i = 0; i < 16; ++i) {
      const int tl = 32 * mi + crow(i, h);
      const float u = bf2f(UB[tl * 264 + c]);
      const float rg = sigmoidf_(ar[ni][i] + brc), ig = sigmoidf_(ai[ni][i] + bic);
      const float la = -8.f * rg * lamsp;
      av[i] = __expf(la);
      bv[i] = sqrtf(fmaxf(0.f, 1.f - __expf(2.f * la))) * (ig * u);
    }
    float GA[4], GB[4], PA[4], PB[4];
#pragma unroll
    for (int q = 0; q < 4; ++q) {
      float A = 1.f, hh = 0.f;
#pragma unroll
      for (int e = 0; e < 4; ++e) { hh = av[4 * q + e] * hh + bv[4 * q + e]; A *= av[4 * q + e]; }
      GA[q] = A; GB[q] = hh;
      PA[q] = __shfl_xor(A, 32); PB[q] = __shfl_xor(hh, 32);
    }
    float cin = 0.f;
    if (mode == 1) {
      const int lo = h ? (ck >> 1) : 0, hi = h ? ck : (ck >> 1);
      float A = 1.f, hh = 0.f;
      const float* ca = CA + ((size_t)b * 128) * 256 + c;
      const float* chp = CH + ((size_t)b * 128) * 256 + c;
      int k = lo;
      for (; k + 8 <= hi; k += 8) {
        float a8[8], h8[8];
#pragma unroll
        for (int e = 0; e < 8; ++e) { a8[e] = ca[(size_t)(k + e) * 256]; h8[e] = chp[(size_t)(k + e) * 256]; }
#pragma unroll
        for (int e = 0; e < 8; ++e) { hh = a8[e] * hh + h8[e]; A *= a8[e]; }
      }
      for (; k < hi; ++k) { const float a_ = ca[(size_t)k * 256], h_ = chp[(size_t)k * 256]; hh = a_ * hh + h_; A *= a_; }
      const float pAx = __shfl_xor(A, 32), pHx = __shfl_xor(hh, 32);
      cin = h ? (A * pHx + hh) : (pAx * hh + pHx);
    }
    float cg = cin, Ap = 1.f, myc[4];
#pragma unroll
    for (int q = 0; q < 4; ++q) {
      const float Ae = h ? PA[q] : GA[q], Be = h ? PB[q] : GB[q];
      const float Ao = h ? GA[q] : PA[q], Bo = h ? GB[q] : PB[q];
      const float c_even = cg;
      cg = Ae * cg + Be;
      const float c_odd = cg;
      cg = Ao * cg + Bo;
      myc[q] = h ? c_odd : c_even;
      Ap *= Ae * Ao;
    }
    if (mode == 0) {
      if (h == 0) { CA[((size_t)b * 128 + ck) * 256 + c] = Ap; CH[((size_t)b * 128 + ck) * 256 + c] = cg; }
    } else {
#pragma unroll
      for (int q = 0; q < 4; ++q) {
        float hh = myc[q];
#pragma unroll
        for (int e = 0; e < 4; ++e) {
          const int i = 4 * q + e;
          hh = av[i] * hh + bv[i];
          const size_t tok = (size_t)b * SEQ + ct * 64 + 32 * mi + crow(i, h);
          const float y = bf2f(P[tok * PSTR + C_LRU_Y + c]);
          O[tok * DM + c] = f2bf(hh * geluf_(y));
        }
      }
    }
  }
}

#define XB_TMO      128
#define XB_XCNT(j)  (256  + 64 * (j))
#define XB_XSUB(j)  (1280 + 64 * (j))
#define XB_XGEN(j)  (2304 + 64 * (j))
#define XB_TOP      3328
#define XB_TOPGEN   3392
#define XCD_BAR_WORDS 3456
#define XB_SPIN_CAP (1u << 18)
#define XLAS __attribute__((address_space(3)))
DI unsigned xb_ld(unsigned* p)              { return __hip_atomic_load(p, __ATOMIC_RELAXED, __HIP_MEMORY_SCOPE_AGENT); }
DI unsigned xb_add(unsigned* p, unsigned v) { return __hip_atomic_fetch_add(p, v, __ATOMIC_RELAXED, __HIP_MEMORY_SCOPE_AGENT); }
DI unsigned xb_xcc_id() { return (unsigned)__builtin_amdgcn_s_getreg((3 << 11) | 20) & 0xFu; }
#define XB_SPIN(cond, bar) do { unsigned _sp = 0; while (cond) { __builtin_amdgcn_s_sleep(1); \
    if ((++_sp & 255u) == 0u) { if (xb_ld(&(bar)[XB_TMO])) break; if (_sp > XB_SPIN_CAP) { atomicAdd(&(bar)[XB_TMO], 1u); break; } } } } while (0)
struct XcdBarrier { unsigned* bar; unsigned x; volatile XLAS unsigned* st; };
DI XcdBarrier xcd_barrier_post(unsigned* bar, volatile XLAS unsigned* st) {
  XcdBarrier b; b.bar = bar; b.x = xb_xcc_id(); b.st = st;
  if (threadIdx.x == 0) (void)xb_add(&bar[XB_XCNT(b.x)], 1u);
  return b;
}
DI void xcd_barrier_complete(unsigned* bar, unsigned x, unsigned& nloc, unsigned& nx) {
  const unsigned G = gridDim.x * gridDim.y * gridDim.z;
  unsigned sum, cnt, mine, sp = 0u;
  for (;;) {
    sum = 0u; cnt = 0u; mine = 0u;
#pragma unroll
    for (unsigned j = 0; j < 16; ++j) { const unsigned c = xb_ld(&bar[XB_XCNT(j)]); sum += c; cnt += (c > 0u) ? 1u : 0u; mine = (j == x) ? c : mine; }
    if (sum == G) break;
    __builtin_amdgcn_s_sleep(1);
    if ((++sp & 255u) == 0u) { if (xb_ld(&bar[XB_TMO])) break; if (sp > XB_SPIN_CAP) { atomicAdd(&bar[XB_TMO], 1u); break; } }
  }
  nloc = mine > 0u ? mine : 1u; nx = cnt > 0u ? cnt : 1u;
}
DI void xcd_barrier(const XcdBarrier& b) {
  asm volatile("s_waitcnt vmcnt(0)" ::: "memory");
  __syncthreads();
  if (threadIdx.x == 0) {
    unsigned* bar = b.bar;
    __builtin_amdgcn_s_waitcnt(0);
    unsigned nloc = b.st[0], nx = b.st[1];
    if (nloc == 0u) { xcd_barrier_complete(bar, b.x, nloc, nx); b.st[0] = nloc; b.st[1] = nx; }
    const unsigned old = xb_add(&bar[XB_XSUB(b.x)], 1u);
    const unsigned gen = old / nloc;
    if (old + 1u == (gen + 1u) * nloc) {
      __builtin_amdgcn_fence(__ATOMIC_RELEASE, "agent");
      asm volatile("s_waitcnt vmcnt(0)" ::: "memory");
      const unsigned og = xb_add(&bar[XB_TOP], 1u);
      const unsigned tg = og / nx;
      if (og + 1u == (tg + 1u) * nx) xb_add(&bar[XB_TOPGEN], 1u);
      else XB_SPIN(xb_ld(&bar[XB_TOPGEN]) == tg, bar);
      __builtin_amdgcn_fence(__ATOMIC_ACQUIRE, "agent");
      xb_add(&bar[XB_XGEN(b.x)], 1u);
      asm volatile("s_waitcnt vmcnt(0)" ::: "memory");
    } else {
      XB_SPIN(xb_ld(&bar[XB_XGEN(b.x)]) == gen, bar);
      __builtin_amdgcn_fence(__ATOMIC_ACQUIRE, "agent");
      asm volatile("s_waitcnt vmcnt(0)" ::: "memory");
    }
  }
  __syncthreads();
}

__global__ void __launch_bounds__(NTHR) mega(Params p) {
  extern __shared__ __attribute__((aligned(16))) char smem[];
  cg::grid_group grid = cg::this_grid();
  const int tid = threadIdx.x;
  bf16_t* H = (bf16_t*)(p.ws + OFF_H);
  bf16_t* PB = (bf16_t*)(p.ws + OFF_P);
  PG_LAS unsigned char* lds = (PG_LAS unsigned char*)smem;
  volatile XLAS unsigned* xst = (volatile XLAS unsigned*)(smem + 131072);
  if (tid < 2) xst[tid] = 0u;
  __syncthreads();
  const XcdBarrier xb = xcd_barrier_post((unsigned*)(p.ws + OFF_BAR), xst);

  for (int rep = 0; rep < REP_MISC; ++rep) {
  if (MASK & 1) phase_mod(p, smem);
  grid.sync();
  }
  for (int l = 0; l < 4; ++l) {
    const float* xcur = (l == 0) ? p.in[I_X] : p.out;
    for (int rep = 0; rep < REP_MISC; ++rep) {
    if (MASK & 2) phase_convert(p, l, smem);
    if (MASK & 4) phase_norm(p, xcur, p.in[I_N1G] + l * 1024, l, 1024, 0, H, nullptr);
    xcd_barrier(xb);
    }
    for (int rep = 0; rep < REP_G; ++rep) {
    if (MASK & 8) { pg::Order<1> S; S.init(NTOK, PSTR, gridDim.x, blockIdx.x); pg::EpiBf16<0> E{PB, PSTR, nullptr};
      pg::gemm_phase(lds, H, DM, (const bf16_t*)(p.ws + OFF_WIN), 1024, S, E); }
    xcd_barrier(xb);
    }
    for (int rep = 0; rep < REP_M1; ++rep) {
    for (int it = blockIdx.x; it < 5120; it += gridDim.x) {
      if (it < 2048) { if (MASK & 32) gdn_intra_item(p, l, it, smem); }
      else if (it < 3072) { }
      else if (it < 4096) { if (MASK & 128) lru_item(p, l, it - 3072, smem, 0); }
      else { if (MASK & 16) rw_prep_item(p, l, it - 4096, smem); }
      __syncthreads();
    }
    xcd_barrier(xb);
    }
    for (int rep = 0; rep < REP_M2; ++rep) {
    if (blockIdx.x < 128) {
      if (MASK & 16) rwkv_scan_item(p, l, blockIdx.x >> 3, (blockIdx.x >> 1) & 3, blockIdx.x & 1, smem);
    } else {
      if (blockIdx.x < 192) { if (MASK & 256) gdn_rec_item(p, l, (blockIdx.x - 128) >> 2, (blockIdx.x - 128) & 3, smem); }
      unsigned* ctr = (unsigned*)(p.ws + OFF_CTR) + l * 4 + rep;
      volatile int* slot = (volatile int*)(smem + 110016);
      for (;;) {
        __syncthreads();
        if (tid == 0) *slot = (int)atomicAdd(ctr, 1u);
        __syncthreads();
        const int it = *slot;
        if (it >= 2048) break;
        if (it < 1024) { if (MASK & 64) sb_item(p, it, smem); }
        else { if (MASK & 512) lru_item(p, l, it - 1024, smem, 1); }
      }
    }
    xcd_barrier(xb);
    }
    for (int rep = 0; rep < REP_G; ++rep) {
    for (int half = 0; half < 2; ++half) {
      bf16_t* BH = (bf16_t*)(p.ws + OFF_P + 134217728);
      if (half == 0 && rep == 0) { if (MASK & 16) rwkv_post(p, l); xcd_barrier(xb); }
      if (MASK & 1024) { pg::Order<1> S; S.init(NTOK / 2, 4096, gridDim.x, blockIdx.x, 0, 0, 2, 512); pg::EpiBf16<0> E{BH, 4096, nullptr};
        pg::gemm_phase(lds, (const bf16_t*)(p.ws + OFF_O) + (size_t)half * 32768 * DM, DM, (const bf16_t*)(p.ws + OFF_WBR), 256, S, E); }
      xcd_barrier(xb);
      if (MASK & 1024) { pg::Order<4> S; S.init(NTOK / 2, 1024, gridDim.x, blockIdx.x, 0, 2097152); pg::EpiGateMix E{PB + (size_t)half * 32768 * DM, (float*)(p.ws + OFF_G), BH, p.in[I_BGATE] + (size_t)l * 4096};
        pg::gemm_phase(lds, H + (size_t)half * 32768 * DM, DM, (const bf16_t*)(p.ws + OFF_WG), 1024, S, E); }
      xcd_barrier(xb);
    }
    }
    if (MASK & 2048) { pg::Order<1> S; S.init(NTOK, 1024, gridDim.x, blockIdx.x); pg::EpiResid E{xcur, p.out, (const float*)(p.ws + OFF_MODP), p.in[I_BADA], l, 2048};
      pg::gemm_phase(lds, PB, DM, (const bf16_t*)(p.ws + OFF_WO), 1024, S, E); }
    xcd_barrier(xb);
    for (int rep = 0; rep < REP_MISC; ++rep) {
    if (MASK & 4096) phase_norm(p, p.out, p.in[I_N2G] + l * 1024, l, 4096, 3072, H, nullptr);
    xcd_barrier(xb);
    }
    for (int rep = 0; rep < REP_G; ++rep) {
    if (MASK & 8192) { pg::Order<1> S; S.init(NTOK, FFN, gridDim.x, blockIdx.x); pg::EpiBf16<0> E{PB, FFN, nullptr};
      pg::gemm_phase(lds, H, DM, (const bf16_t*)(p.ws + OFF_WF), 1024, S, E); }
    xcd_barrier(xb);
    if (MASK & 8192) { pg::Order<1> S; S.init(NTOK, FFN, gridDim.x, blockIdx.x); pg::EpiFfnAct E{PB + (size_t)NTOK * FFN, PB, p.in[I_FCW] + (size_t)l * 3 * FFN};
      pg::gemm_phase(lds, H, DM, (const bf16_t*)(p.ws + OFF_WF) + (size_t)FFN * 1024, 1024, S, E); }
    xcd_barrier(xb);
    }
    if (MASK & 32768) { pg::Order<1> S; S.init(NTOK, 1024, gridDim.x, blockIdx.x); pg::EpiResid E{p.out, p.out, (const float*)(p.ws + OFF_MODP), p.in[I_BADA], l, 5120};
      pg::gemm_phase(lds, PB + (size_t)NTOK * FFN, FFN, (const bf16_t*)(p.ws + OFF_WD), FFN, S, E); }
    xcd_barrier(xb);
  }
  if (MASK & 65536) phase_norm(p, p.out, p.in[I_FG], 0, 0, 0, nullptr, p.out);
}

extern "C" void kernel_launch(void* const* d_in, const int* in_sizes, int n_in,
                              void* d_out, int out_size, void* d_ws, size_t ws_size,
                              hipStream_t stream) {
  if (ws_size < WS_NEED || n_in < 38) { fprintf(stderr, "workspace too small: %zu < %zu\n", ws_size, (size_t)WS_NEED); return; }
  (void)hipFuncSetAttribute((const void*)mega, hipFuncAttributeMaxDynamicSharedMemorySize, SMEM_BYTES);
  int dev = 0, cus = 0, per_cu = 0;
  (void)hipGetDevice(&dev);
  (void)hipDeviceGetAttribute(&cus, hipDeviceAttributeMultiprocessorCount, dev);
  (void)hipOccupancyMaxActiveBlocksPerMultiprocessor(&per_cu, mega, NTHR, SMEM_BYTES);
  if (per_cu < 1 || cus < 1) { fprintf(stderr, "occupancy query failed (%d, %d)\n", per_cu, cus); return; }
  if (cus > 256) cus = 256;
  const int grid_blocks = cus;
  Params p{};
  for (int i = 0; i < 38; ++i) p.in[i] = (const float*)d_in[i];
  p.out = (float*)d_out; p.ws = (char*)d_ws;
  (void)hipMemsetAsync((char*)d_ws + OFF_BAR, 0, XCD_BAR_WORDS * 4, stream);
  void* args[] = {&p};
  hipError_t e = hipLaunchCooperativeKernel((void*)mega, dim3(grid_blocks), dim3(NTHR), args, SMEM_BYTES, stream);
  if (e != hipSuccess) fprintf(stderr, "cooperative launch failed: %s (grid %d)\n", hipGetErrorString(e), grid_blocks);
}
```

```cpp
#include <hip/hip_runtime.h>
#include <hip/hip_cooperative_groups.h>
#include <cstdio>
namespace cg = cooperative_groups;

typedef unsigned short bf16_t;
typedef short bf16x8 __attribute__((ext_vector_type(8)));
typedef short s16x4 __attribute__((ext_vector_type(4)));
typedef float f32x4 __attribute__((ext_vector_type(4)));
typedef float f32x16 __attribute__((ext_vector_type(16)));
typedef unsigned u32x4 __attribute__((ext_vector_type(4)));
#define DI __device__ __forceinline__

constexpr int NTOK = 65536, DM = 1024, SEQ = 4096, PSTR = 3328, FFN = 2816, AUS = 5632;
constexpr int C_LRU_X = 0, C_LRU_Y = 256, C_SB_Q = 512, C_SB_K = 768, C_SB_V = 1024;
constexpr int C_GDN_Q = 1280, C_GDN_Z = 2048, C_GDN_A = 2304, C_GDN_B = 2308, C_RW = 2312;
constexpr float EPSF = 1e-6f;
#ifndef MASK
#define MASK 0x1ffff
#endif
#ifndef REP_M1
#define REP_M1 1
#endif
#ifndef REP_M2
#define REP_M2 1
#endif
#ifndef REP_G
#define REP_G 1
#endif
#ifndef REP_MISC
#define REP_MISC 1
#endif
constexpr int NTHR = 512;
constexpr int SMEM_BYTES = 131072 + 64;

constexpr size_t OFF_MODP = 0;
constexpr size_t OFF_WIN = 6291456;
constexpr size_t OFF_WG = OFF_WIN + 6815744;
constexpr size_t OFF_WBR = OFF_WG + 8388608;
constexpr size_t OFF_WO = OFF_WBR + 2097152;
constexpr size_t OFF_WF = OFF_WO + 2097152;
constexpr size_t OFF_WD = OFF_WF + 11534336;
constexpr size_t OFF_H = OFF_WD + 5767168;
constexpr size_t OFF_P = OFF_H + 134217728;
constexpr size_t OFF_O = OFF_P + 436207616;
constexpr size_t OFF_G = OFF_O + 134217728;
constexpr size_t GSZ = 33554432;
constexpr size_t OFF_GCD = OFF_G + 5 * GSZ;
constexpr size_t OFF_L = OFF_GCD + 16384;
constexpr size_t LSZ = 67108864;
constexpr size_t OFF_LCA = OFF_L + 2 * LSZ;
constexpr size_t OFF_LCH = OFF_LCA + 2097152;
constexpr size_t OFF_BON = OFF_LCH + 2097152;
constexpr size_t OFF_CTR = OFF_BON + 1048576;
constexpr size_t OFF_BAR = OFF_CTR + 256;
constexpr size_t WS_NEED = OFF_BAR + 16384;

struct Params { const float* in[38]; float* out; char* ws; };
enum { I_X = 0, I_C, I_N1G, I_N2G, I_FG, I_WADA, I_BADA, I_WIN, I_LCW, I_LCB, I_LWR, I_LBR, I_LWI, I_LBI, I_LLAM,
       I_GCW, I_GAL, I_GDT, I_GNG, I_RMU, I_RW0, I_RWUP, I_RA0, I_RAUP, I_RGUP, I_RKK, I_RKA, I_RRK, I_RLG, I_RLB,
       I_WBR, I_WGATE, I_BGATE, I_WOUT, I_FWG, I_FWU, I_FCW, I_FWD };

DI float bf2f(bf16_t v) { return __uint_as_float(((unsigned)v) << 16); }
DI unsigned pack2(float lo, float hi) { unsigned r; asm("v_cvt_pk_bf16_f32 %0, %1, %2" : "=v"(r) : "v"(lo), "v"(hi)); return r; }
DI bf16_t f2bf(float x) { return (bf16_t)(pack2(x, x) & 0xffffu); }
DI float sigmoidf_(float x) { return 1.f / (1.f + __expf(-x)); }
DI float softplusf_(float x) { return fmaxf(x, 0.f) + __logf(1.f + __expf(-fabsf(x))); }
DI float siluf_(float x) { return x / (1.f + __expf(-x)); }
DI float geluf_(float x) { float u = 0.7978845608f * (x + 0.044715f * x * x * x); return x / (1.f + __expf(-2.f * u)); }
DI float tanhf_(float x) { return 1.f - 2.f / (1.f + __expf(2.f * x)); }
DI float wave_sum(float x) {
#pragma unroll
  for (int o = 32; o >= 1; o >>= 1) x += __shfl_xor(x, o);
  return x;
}
template <int CTRL> DI float dppf(float x) { return __int_as_float(__builtin_amdgcn_update_dpp(0, __float_as_int(x), CTRL, 0xf, 0xf, true)); }
DI float reduce8(float x) { x += dppf<0xB1>(x); x += dppf<0x4E>(x); x += dppf<0x141>(x); return x; }
DI f32x16 mfma32(bf16x8 a, bf16x8 b, f32x16 c) { return __builtin_amdgcn_mfma_f32_32x32x16_bf16(a, b, c, 0, 0, 0); }
DI f32x4 mfma16(bf16x8 a, bf16x8 b, f32x4 c) { return __builtin_amdgcn_mfma_f32_16x16x32_bf16(a, b, c, 0, 0, 0); }
DI int crow(int i, int h) { return (i & 3) + 8 * (i >> 2) + 4 * h; }

DI float modv(const float* modp, const float* bada, int l, int b, int idx) {
  const float* q = modp + ((size_t)(l * 16 + b)) * 6144 + idx;
  const size_t ks = (size_t)4 * 16 * 6144;
  return bada[l * 6144 + idx] + q[0] + q[ks] + q[2 * ks] + q[3 * ks];
}

DI int otid() { int t = threadIdx.x; asm volatile("" : "+v"(t)); return t; }
DI int obid() { int b = blockIdx.x; asm volatile("" : "+s"(b)); return b; }
DI void phase_mod(const Params& p, char* smem) {
  float* sm = (float*)smem;
  float* modp = (float*)(p.ws + OFF_MODP);
  const int tid = otid();
  if (obid() == 0 && tid < 64) ((unsigned*)(p.ws + OFF_CTR))[tid] = 0u;
  for (int item = obid(); item < 192; item += gridDim.x) {
    const int l = item / 48, rem = item % 48, jb = rem >> 2, kq = rem & 3;
    for (int i = 0; i < 8; ++i) {
      int e = tid + 512 * i; int b = e >> 8, k = e & 255;
      float cv = p.in[I_C][b * 1024 + kq * 256 + k];
      sm[e] = siluf_(cv);
    }
    __syncthreads();
    float acc[16];
#pragma unroll
    for (int b = 0; b < 16; ++b) acc[b] = 0.f;
    const float* wp = p.in[I_WADA] + ((size_t)l * 1024 + kq * 256) * 6144 + jb * 512 + tid;
    for (int k = 0; k < 256; k += 4) {
      float w0 = wp[(size_t)k * 6144], w1 = wp[(size_t)(k + 1) * 6144], w2 = wp[(size_t)(k + 2) * 6144], w3 = wp[(size_t)(k + 3) * 6144];
#pragma unroll
      for (int b = 0; b < 16; ++b) {
        f32x4 cv = *(const f32x4*)(sm + b * 256 + k);
        acc[b] += cv[0] * w0 + cv[1] * w1 + cv[2] * w2 + cv[3] * w3;
      }
    }
#pragma unroll
    for (int b = 0; b < 16; ++b) modp[((size_t)((kq * 4 + l) * 16 + b)) * 6144 + jb * 512 + tid] = acc[b];
    __syncthreads();
  }
}

DI void conv_tile(const float* src, bf16_t* dst, int K, int N, int k0, int n0, char* smem) {
  float* tile = (float*)smem;
  const int tid = otid();
#pragma unroll
  for (int it = 0; it < 2; ++it) {
    int kr = (tid >> 4) + 32 * it, nc = (tid & 15) * 4;
    f32x4 v = {0.f, 0.f, 0.f, 0.f};
    if (n0 + nc < N) v = *(const f32x4*)(src + (size_t)(k0 + kr) * N + n0 + nc);
    tile[kr * 65 + nc] = v[0]; tile[kr * 65 + nc + 1] = v[1]; tile[kr * 65 + nc + 2] = v[2]; tile[kr * 65 + nc + 3] = v[3];
  }
  __syncthreads();
  {
    int n = tid >> 3, kc = (tid & 7) * 8;
    unsigned o[4];
#pragma unroll
    for (int e = 0; e < 4; ++e) o[e] = pack2(tile[(kc + 2 * e) * 65 + n], tile[(kc + 2 * e + 1) * 65 + n]);
    uint4 ov = {o[0], o[1], o[2], o[3]};
    *(uint4*)(dst + (size_t)(n0 + n) * K + k0 + kc) = ov;
  }
  __syncthreads();
}

DI void phase_convert(const Params& p, int l, char* smem) {
  for (int t = obid(); t < 4480; t += gridDim.x) {
    const float* src; bf16_t* dst; int K, N, Npad, tt = t;
    if (tt < 832) { src = p.in[I_WIN] + (size_t)l * 1024 * 3208; dst = (bf16_t*)(p.ws + OFF_WIN); K = 1024; N = 3208; Npad = 3328; }
    else if ((tt -= 832) < 1024) { int br = tt >> 8; tt &= 255; src = p.in[I_WGATE] + ((size_t)l * 4 + br) * 1048576; dst = (bf16_t*)(p.ws + OFF_WG) + (size_t)br * 1048576; K = 1024; N = 1024; Npad = 1024; }
    else if ((tt -= 1024) < 256) { int br = tt >> 6; tt &= 63; src = p.in[I_WBR] + ((size_t)l * 4 + br) * 262144; dst = (bf16_t*)(p.ws + OFF_WBR) + (size_t)br * 262144; K = 256; N = 1024; Npad = 1024; }
    else if ((tt -= 256) < 256) { src = p.in[I_WOUT] + (size_t)l * 1048576; dst = (bf16_t*)(p.ws + OFF_WO); K = 1024; N = 1024; Npad = 1024; }
    else if ((tt -= 256) < 704) { src = p.in[I_FWG] + (size_t)l * 1024 * 2816; dst = (bf16_t*)(p.ws + OFF_WF); K = 1024; N = 2816; Npad = 2816; }
    else if ((tt -= 704) < 704) { src = p.in[I_FWU] + (size_t)l * 1024 * 2816; dst = (bf16_t*)(p.ws + OFF_WF) + (size_t)2816 * 1024; K = 1024; N = 2816; Npad = 2816; }
    else { tt -= 704; src = p.in[I_FWD] + (size_t)l * 2816 * 1024; dst = (bf16_t*)(p.ws + OFF_WD); K = 2816; N = 1024; Npad = 1024; }
    const int nNt = Npad >> 6;
    const int kt = tt / nNt, nt = tt % nNt;
    conv_tile(src, dst, K, N, kt * 64, nt * 64, smem);
  }
}

DI void phase_norm(const Params& p, const float* xin, const float* g, int l, int scale_idx, int shift_idx, bf16_t* hout, float* fout) {
  const float* modp = (const float*)(p.ws + OFF_MODP);
  const int lane = otid() & 63, wv = otid() >> 6;
  const int nw = gridDim.x * 8;
  const int rows_per = 32;
  for (int chunk = obid() * 8 + wv; chunk < NTOK / 32; chunk += nw) {
  const int row0 = chunk * rows_per;
  const int b = row0 / SEQ;
  f32x4 gv[4], sc[4], sh[4];
#pragma unroll
  for (int j = 0; j < 4; ++j) {
    int c = lane * 4 + 256 * j;
    gv[j] = *(const f32x4*)(g + c);
    if (hout) {
#pragma unroll
      for (int e = 0; e < 4; ++e) {
        sc[j][e] = 1.f + modv(modp, p.in[I_BADA], l, b, scale_idx + c + e);
        sh[j][e] = modv(modp, p.in[I_BADA], l, b, shift_idx + c + e);
      }
    }
  }
  for (int rr = 0; rr < rows_per; ++rr) {
    const size_t row = (size_t)row0 + rr;
    f32x4 xv[4]; float ss = 0.f;
#pragma unroll
    for (int j = 0; j < 4; ++j) {
      xv[j] = *(const f32x4*)(xin + row * DM + lane * 4 + 256 * j);
      ss += xv[j][0] * xv[j][0] + xv[j][1] * xv[j][1] + xv[j][2] * xv[j][2] + xv[j][3] * xv[j][3];
    }
    ss = wave_sum(ss);
    const float rs = rsqrtf(ss * (1.f / 1024.f) + EPSF);
#pragma unroll
    for (int j = 0; j < 4; ++j) {
      f32x4 y = xv[j] * rs * gv[j];
      if (hout) {
        y = y * sc[j] + sh[j];
        uint2 o = {pack2(y[0], y[1]), pack2(y[2], y[3])};
        *(uint2*)(hout + row * DM + lane * 4 + 256 * j) = o;
      } else {
        *(f32x4*)(fout + row * DM + lane * 4 + 256 * j) = y;
      }
    }
  }
  }
}

#define PG_LAS __attribute__((address_space(3)))
namespace pg {
constexpr int BM = 256, BK = 64, HALF = 128, HTB = HALF * BK * 2, NXCD = 8, WGM = 8;
DI int lds_byte(int r, int c) { const int st = (r >> 4) * 2 + (c >> 5), rr = r & 15, cc = c & 31, ob = rr * 64 + cc * 2; return st * 1024 + (ob ^ (((ob >> 9) & 1) << 5)); }
DI void stage_rc(int b, int& R, int& C) { const int st = b / 1024, sb = b % 1024, swz = sb ^ (((sb >> 9) & 1) << 5); R = (st >> 1) * 16 + swz / 64; C = (st & 1) * 32 + (swz % 64) / 2; }
DI int perm32(int rho) { const int n = rho >> 4, i = rho & 15; return 8 * (i >> 2) + 4 * n + (i & 3); }
struct Unit { int pm, pn; int aux; long ao, bo; };
template <int REP> struct Order {
  int nM, nN, nwg, G, c, ashift; long astep, bstep, apnstep;
  DI void init(int M, int N, int G_, int c_, long astep_ = 0, long bstep_ = 0, int ashift_ = 0, long apnstep_ = 0) {
    nM = M / BM; nN = N / BM; nwg = nM * nN; G = G_; c = c_; astep = astep_; bstep = bstep_; ashift = ashift_; apnstep = apnstep_; }
  DI bool next(int i, Unit& u) const {
    const int ti = i / REP, aux = i % REP;
    const long L = (long)ti * G + c; if (L >= nwg) return false;
    int wgid = (int)L; { const int q = nwg / NXCD, r = nwg % NXCD, xcd = wgid % NXCD, off = wgid / NXCD; wgid = (xcd < r ? xcd * (q + 1) : r * (q + 1) + (xcd - r) * q) + off; }
    const int nig = WGM * nN, gid = wgid / nig, fm = gid * WGM, gsz = (nM - fm) < WGM ? (nM - fm) : WGM;
    u.pm = fm + ((wgid % nig) % gsz); u.pn = (wgid % nig) / gsz; u.aux = aux; u.ao = aux * astep + (long)(u.pn >> ashift) * apnstep; u.bo = aux * bstep; return true;
  }
};
DI unsigned cvt_pk_bf16(float lo, float hi) { unsigned r; asm volatile("v_cvt_pk_bf16_f32 %0, %1, %2" : "=v"(r) : "v"(lo), "v"(hi)); return r; }

template <class Epi, class Sched>
DI void gemm_phase(PG_LAS unsigned char* lds, const bf16_t* Ag, int lda, const bf16_t* Bg, int K, const Sched& S, const Epi& E) {
  const int tid = otid(), wid = __builtin_amdgcn_readfirstlane(tid >> 6), lane = tid & 63, wr = wid >> 2, wc = wid & 3, fr = lane & 15, fq = lane >> 4;
  const int nt = K / BK;
  unsigned voffA[2], voffB[2];
#pragma unroll
  for (int i = 0; i < 2; ++i) { int R, C; stage_rc(tid * 16 + i * 8192, R, C); const int Rb = Epi::PERM ? ((R & ~31) + perm32(R & 31)) : R;
    voffA[i] = (unsigned)(R * lda + C) * 2u; voffB[i] = (unsigned)(Rb * K + C) * 2u; }
  const size_t kstep = (size_t)(BK * 2);
  const size_t hstepA = (size_t)HALF * lda * 2, hstepB = (size_t)HALF * K * 2;
  const size_t tstepA = 2 * hstepA, tstepB = 2 * hstepB;
  const unsigned ldsw = (unsigned)wid * 1024u;
  const int aoff = lds_byte(wr * 64 + fr, fq * 8), boff = lds_byte(wc * 32 + fr, fq * 8);
#define PG_SA(b, h) (((b) * 2 + (h)) * HTB)
#define PG_SB(b, h) ((4 + (b) * 2 + (h)) * HTB)
#define PG_STAGE(bufoff, gbase, voff) do { _Pragma("unroll") for (int _i = 0; _i < 2; ++_i) \
    __builtin_amdgcn_global_load_lds((const unsigned*)((const char*)(gbase) + (voff)[_i]), (PG_LAS unsigned*)(lds + (bufoff) + ldsw + _i * 8192), 16, 0, 0); } while (0)
#define PG_LDA(dst, b, h) do { _Pragma("unroll") for (int m = 0; m < 4; ++m) _Pragma("unroll") for (int k = 0; k < 2; ++k) dst[m][k] = *(const PG_LAS bf16x8*)(lds + PG_SA(b, h) + aoff + m * 2048 + k * 1024); } while (0)
#define PG_LDB(dst, b, h) do { _Pragma("unroll") for (int n = 0; n < 2; ++n) _Pragma("unroll") for (int k = 0; k < 2; ++k) dst[n][k] = *(const PG_LAS bf16x8*)(lds + PG_SB(b, h) + boff + n * 2048 + k * 1024); } while (0)
#define PG_MMA(ai, bj, At, Bt) do { __builtin_amdgcn_s_setprio(1); _Pragma("unroll") for (int m = 0; m < 4; ++m) _Pragma("unroll") for (int n = 0; n < 2; ++n) _Pragma("unroll") for (int k = 0; k < 2; ++k) \
    acc[ai][bj][m][n] = __builtin_amdgcn_mfma_f32_16x16x32_bf16(Bt[n][k], At[m][k], acc[ai][bj][m][n], 0, 0, 0); __builtin_amdgcn_s_setprio(0); } while (0)
#define PG_WAIT_V(n) asm volatile("s_waitcnt vmcnt(" #n ")" ::: "memory")
#define PG_WAIT_L(n) asm volatile("s_waitcnt lgkmcnt(" #n ")" ::: "memory")
#define PG_BAR __builtin_amdgcn_s_barrier()
#define PG_SCHED __builtin_amdgcn_sched_barrier(0)
  Unit cur, nxt; int ui = 0;
  if (!S.next(0, cur)) return;
  f32x4 acc[2][2][4][2];
#pragma unroll
  for (int a = 0; a < 2; ++a)
#pragma unroll
    for (int b = 0; b < 2; ++b)
#pragma unroll
      for (int m = 0; m < 4; ++m)
#pragma unroll
        for (int n = 0; n < 2; ++n) acc[a][b][m][n] = (f32x4){0.f, 0.f, 0.f, 0.f};
  bf16x8 At[4][2], B0[2][2], B1[2][2];
  const char* cA = (const char*)Ag + (size_t)cur.pm * tstepA + cur.ao; const char* cB = (const char*)Bg + (size_t)cur.pn * tstepB + cur.bo;
  PG_STAGE(PG_SB(0, 0), cB, voffB); PG_STAGE(PG_SA(0, 0), cA, voffA); PG_STAGE(PG_SB(0, 1), cB + hstepB, voffB); PG_STAGE(PG_SA(0, 1), cA + hstepA, voffA);
  if (wr == 1) PG_BAR;
  PG_WAIT_V(4); PG_BAR;
  PG_STAGE(PG_SB(1, 0), cB + kstep, voffB); PG_STAGE(PG_SA(1, 0), cA + kstep, voffA); PG_STAGE(PG_SB(1, 1), cB + hstepB + kstep, voffB);
  PG_WAIT_V(6); PG_BAR;
  for (;;) {
    const bool has_next = S.next(ui + 1, nxt);
    const char* nA = has_next ? (const char*)Ag + (size_t)nxt.pm * tstepA + nxt.ao : cA; const char* nB = has_next ? (const char*)Bg + (size_t)nxt.pn * tstepB + nxt.bo : cB;
#pragma unroll 1
    for (int t = 0; t < nt; t += 2) {
      const bool last = (t == nt - 2);
      const char* a1 = cA + (size_t)(t + 1) * kstep;
      const char* a2 = last ? nA : cA + (size_t)(t + 2) * kstep; const char* b2 = last ? nB : cB + (size_t)(t + 2) * kstep;
      const char* a3 = a2 + kstep; const char* b3 = b2 + kstep;
      PG_LDB(B0, 0, 0); PG_SCHED; PG_LDA(At, 0, 0); PG_STAGE(PG_SA(1, 1), a1 + hstepA, voffA);
      PG_WAIT_L(8); PG_BAR; PG_WAIT_L(0); PG_MMA(0, 0, At, B0); PG_BAR; PG_SCHED;
      PG_LDB(B1, 0, 1); PG_STAGE(PG_SB(0, 0), b2, voffB);
      PG_BAR; PG_WAIT_L(0); PG_MMA(0, 1, At, B1); PG_BAR;
      PG_LDA(At, 0, 1); PG_STAGE(PG_SA(0, 0), a2, voffA);
      PG_BAR; PG_WAIT_L(0); PG_MMA(1, 0, At, B0); PG_BAR; PG_SCHED;
      PG_STAGE(PG_SB(0, 1), b2 + hstepB, voffB);
      PG_WAIT_V(6); PG_BAR; PG_MMA(1, 1, At, B1); PG_BAR;
      PG_LDB(B0, 1, 0); PG_SCHED; PG_LDA(At, 1, 0); PG_STAGE(PG_SA(0, 1), a2 + hstepA, voffA);
      PG_WAIT_L(8); PG_BAR; PG_WAIT_L(0); PG_MMA(0, 0, At, B0); PG_BAR; PG_SCHED;
      PG_LDB(B1, 1, 1); PG_STAGE(PG_SB(1, 0), b3, voffB);
      PG_BAR; PG_WAIT_L(0); PG_MMA(0, 1, At, B1); PG_BAR;
      PG_LDA(At, 1, 1); PG_STAGE(PG_SA(1, 0), a3, voffA);
      PG_BAR; PG_WAIT_L(0); PG_MMA(1, 0, At, B0); PG_BAR; PG_SCHED;
      PG_STAGE(PG_SB(1, 1), b3 + hstepB, voffB);
      PG_WAIT_V(6); PG_BAR; PG_MMA(1, 1, At, B1); PG_BAR;
    }
    E(acc, cur, wr, wc, fr, fq);
    if (!has_next) break;
#pragma unroll
    for (int a = 0; a < 2; ++a)
#pragma unroll
      for (int b = 0; b < 2; ++b)
#pragma unroll
        for (int m = 0; m < 4; ++m)
#pragma unroll
          for (int n = 0; n < 2; ++n) acc[a][b][m][n] = (f32x4){0.f, 0.f, 0.f, 0.f};
    cur = nxt; cA = nA; cB = nB; ++ui;
  }
  PG_WAIT_V(0);
  if (wr == 0) PG_BAR;
  PG_BAR;
#undef PG_SA
#undef PG_SB
#undef PG_STAGE
#undef PG_LDA
#undef PG_LDB
#undef PG_MMA
#undef PG_WAIT_V
#undef PG_WAIT_L
#undef PG_BAR
#undef PG_SCHED
}

template <int ACT> struct EpiBf16 {
  static constexpr bool PERM = true;
  bf16_t* O; int ldc; const float* bias;
  DI void operator()(const f32x4 (&acc)[2][2][4][2], const Unit& u, int wr, int wc, int fr, int fq) const {
    const int row0 = u.pm * BM + wr * 64 + fr, col0 = u.pn * BM + wc * 32 + 8 * fq;
    f32x4 bv[2][2];
#pragma unroll
    for (int bj = 0; bj < 2; ++bj)
#pragma unroll
      for (int n = 0; n < 2; ++n) bv[bj][n] = ACT ? *(const f32x4*)(bias + col0 + bj * HALF + 4 * n) : (f32x4){0.f, 0.f, 0.f, 0.f};
#pragma unroll
    for (int ai = 0; ai < 2; ++ai)
#pragma unroll
      for (int m = 0; m < 4; ++m) { bf16_t* rowp = O + (size_t)(row0 + ai * HALF + m * 16) * ldc + col0;
#pragma unroll
        for (int bj = 0; bj < 2; ++bj) { f32x4 v0 = acc[ai][bj][m][0] + bv[bj][0], v1 = acc[ai][bj][m][1] + bv[bj][1];
          if (ACT) {
#pragma unroll
            for (int j = 0; j < 4; ++j) { v0[j] = sigmoidf_(v0[j]); v1[j] = sigmoidf_(v1[j]); } }
          u32x4 w; w.x = cvt_pk_bf16(v0[0], v0[1]); w.y = cvt_pk_bf16(v0[2], v0[3]); w.z = cvt_pk_bf16(v1[0], v1[1]); w.w = cvt_pk_bf16(v1[2], v1[3]);
          *(u32x4*)(rowp + bj * HALF) = w; } }
  }
};
struct EpiBranch {
  static constexpr bool PERM = true;
  bf16_t* MIX; const bf16_t* G;
  DI void operator()(const f32x4 (&acc)[2][2][4][2], const Unit& u, int wr, int wc, int fr, int fq) const {
    const int row0 = u.pm * BM + wr * 64 + fr, col0 = u.pn * BM + wc * 32 + 8 * fq;
#pragma unroll
    for (int ai = 0; ai < 2; ++ai)
#pragma unroll
      for (int m = 0; m < 4; ++m) {
        asm volatile("" ::: "memory");
        const size_t row = (size_t)(row0 + ai * HALF + m * 16);
        bf16_t* mp = MIX + row * DM + col0; const bf16_t* gp = G + row * 4096 + u.aux * 1024 + col0;
#pragma unroll
        for (int bj = 0; bj < 2; ++bj) {
          const bf16x8 gv = *(const bf16x8*)(gp + bj * HALF);
          float o[8];
#pragma unroll
          for (int j = 0; j < 4; ++j) { o[j] = bf2f((bf16_t)gv[j]) * acc[ai][bj][m][0][j]; o[4 + j] = bf2f((bf16_t)gv[4 + j]) * acc[ai][bj][m][1][j]; }
          if (u.aux > 0) {
            const bf16x8 mv = *(const bf16x8*)(mp + bj * HALF);
#pragma unroll
            for (int j = 0; j < 8; ++j) o[j] += bf2f((bf16_t)mv[j]);
          }
          u32x4 w; w.x = cvt_pk_bf16(o[0], o[1]); w.y = cvt_pk_bf16(o[2], o[3]); w.z = cvt_pk_bf16(o[4], o[5]); w.w = cvt_pk_bf16(o[6], o[7]);
          *(u32x4*)(mp + bj * HALF) = w;
        }
      }
  }
};
struct EpiResid {
  static constexpr bool PERM = false;
  const float* xold; float* xnew; const float* modp; const float* bada; int l, gate_idx;
  DI void operator()(const f32x4 (&acc)[2][2][4][2], const Unit& u, int wr, int wc, int fr, int fq) const {
    const int row0 = u.pm * BM + wr * 64 + fr, col0 = u.pn * BM + wc * 32 + 4 * fq;
    const int b = (u.pm * BM) / SEQ;
    f32x4 gv[2][2];
#pragma unroll
    for (int bj = 0; bj < 2; ++bj)
#pragma unroll
      for (int n = 0; n < 2; ++n)
#pragma unroll
        for (int j = 0; j < 4; ++j) gv[bj][n][j] = modv(modp, bada, l, b, gate_idx + col0 + bj * HALF + n * 16 + j);
#pragma unroll
    for (int ai = 0; ai < 2; ++ai)
#pragma unroll
      for (int m = 0; m < 4; ++m) { const size_t ro = (size_t)(row0 + ai * HALF + m * 16) * DM + col0;
#pragma unroll
        for (int bj = 0; bj < 2; ++bj)
#pragma unroll
          for (int n = 0; n < 2; ++n) {
            const f32x4 xo = *(const f32x4*)(xold + ro + bj * HALF + n * 16);
            *(f32x4*)(xnew + ro + bj * HALF + n * 16) = xo + gv[bj][n] * acc[ai][bj][m][n];
          } }
  }
};
struct EpiFfnAct {
  static constexpr bool PERM = true;
  bf16_t* ACT; const bf16_t* APRE; const float* cw;
  DI void operator()(const f32x4 (&acc)[2][2][4][2], const Unit& u, int wr, int wc, int fr, int fq) const {
    const int row0 = u.pm * BM + wr * 64 + fr, col0 = u.pn * BM + wc * 32 + 8 * fq;
#pragma unroll
    for (int ai = 0; ai < 2; ++ai)
#pragma unroll
      for (int m = 0; m < 4; ++m) {
        asm volatile("" ::: "memory");
        const int row = row0 + ai * HALF + m * 16; const int sp = row & (SEQ - 1);
        const bf16_t* ap = APRE + (size_t)row * FFN + col0;
        bf16_t* op = ACT + (size_t)row * FFN + col0;
#pragma unroll
        for (int bj = 0; bj < 2; ++bj) {
          const int c = bj * HALF;
          const bf16x8 z8 = {0, 0, 0, 0, 0, 0, 0, 0};
          const bf16x8 a0 = *(const bf16x8*)(ap + c);
          const bf16x8 a1 = sp >= 1 ? *(const bf16x8*)(ap - FFN + c) : z8;
          const bf16x8 a2 = sp >= 2 ? *(const bf16x8*)(ap - 2 * FFN + c) : z8;
          float o[8];
#pragma unroll
          for (int hh = 0; hh < 2; ++hh) {
            const f32x4 w0 = *(const f32x4*)(cw + col0 + c + 4 * hh), w1 = *(const f32x4*)(cw + FFN + col0 + c + 4 * hh), w2 = *(const f32x4*)(cw + 2 * FFN + col0 + c + 4 * hh);
#pragma unroll
            for (int j = 0; j < 4; ++j) {
              const float cv = w0[j] * bf2f((bf16_t)a2[4 * hh + j]) + w1[j] * bf2f((bf16_t)a1[4 * hh + j]) + w2[j] * bf2f((bf16_t)a0[4 * hh + j]);
              o[4 * hh + j] = geluf_(cv) * acc[ai][bj][m][hh][j];
            }
          }
          u32x4 w; w.x = cvt_pk_bf16(o[0], o[1]); w.y = cvt_pk_bf16(o[2], o[3]); w.z = cvt_pk_bf16(o[4], o[5]); w.w = cvt_pk_bf16(o[6], o[7]);
          *(u32x4*)(op + c) = w;
        }
      }
  }
};
struct EpiGateMix {
  static constexpr bool PERM = true;
  bf16_t* MIX; float* MIX32; const bf16_t* BH; const float* bias;
  DI void operator()(const f32x4 (&acc)[2][2][4][2], const Unit& u, int wr, int wc, int fr, int fq) const {
    const int row0 = u.pm * BM + wr * 64 + fr, col0 = u.pn * BM + wc * 32 + 8 * fq;
    const bool rmw = u.aux > 0, fin = u.aux == 3;
    f32x4 bv[2][2];
#pragma unroll
    for (int bj = 0; bj < 2; ++bj)
#pragma unroll
      for (int n = 0; n < 2; ++n) bv[bj][n] = *(const f32x4*)(bias + u.aux * 1024 + col0 + bj * HALF + 4 * n);
    const f32x4 z4 = {0.f, 0.f, 0.f, 0.f};
    bf16x8 nb[2]; f32x4 nm[2][2];
#define GM_LOAD(it_) { const size_t row_ = (size_t)(row0 + ((it_) >> 2) * HALF + ((it_) & 3) * 16); \
      _Pragma("unroll") for (int bj = 0; bj < 2; ++bj) { nb[bj] = *(const bf16x8*)(BH + row_ * 4096 + u.aux * 1024 + col0 + bj * HALF); \
        nm[bj][0] = rmw ? *(const f32x4*)(MIX32 + row_ * DM + col0 + bj * HALF) : z4; nm[bj][1] = rmw ? *(const f32x4*)(MIX32 + row_ * DM + col0 + bj * HALF + 4) : z4; } }
    GM_LOAD(0);
#pragma unroll
    for (int it = 0; it < 8; ++it) {
      const int ai = it >> 2, m = it & 3;
      bf16x8 cb[2]; f32x4 cm[2][2];
#pragma unroll
      for (int bj = 0; bj < 2; ++bj) { cb[bj] = nb[bj]; cm[bj][0] = nm[bj][0]; cm[bj][1] = nm[bj][1]; }
      if (it + 1 < 8) GM_LOAD(it + 1);
      const size_t ro = (size_t)(row0 + ai * HALF + m * 16) * DM + col0;
#pragma unroll
      for (int bj = 0; bj < 2; ++bj) {
        f32x4 o[2];
#pragma unroll
        for (int hh = 0; hh < 2; ++hh)
#pragma unroll
          for (int j = 0; j < 4; ++j)
            o[hh][j] = sigmoidf_(acc[ai][bj][m][hh][j] + bv[bj][hh][j]) * bf2f((bf16_t)cb[bj][4 * hh + j]) + cm[bj][hh][j];
        if (fin) {
          u32x4 w; w.x = cvt_pk_bf16(o[0][0], o[0][1]); w.y = cvt_pk_bf16(o[0][2], o[0][3]); w.z = cvt_pk_bf16(o[1][0], o[1][1]); w.w = cvt_pk_bf16(o[1][2], o[1][3]);
          *(u32x4*)(MIX + ro + bj * HALF) = w;
        } else {
          *(f32x4*)(MIX32 + ro + bj * HALF) = o[0]; *(f32x4*)(MIX32 + ro + bj * HALF + 4) = o[1];
        }
      }
    }
#undef GM_LOAD
  }
};
}

DI void phase_ffn_act(const Params& p, int l) {
  bf16_t* AU = (bf16_t*)(p.ws + OFF_P);
  const float* cw = p.in[I_FCW] + (size_t)l * 3 * FFN;
  const int nthr = gridDim.x * NTHR;
  for (int run = obid() * NTHR + otid(); run < 1024 * 352; run += nthr) {
    const int ch = run / 352, j8 = run % 352, j0 = j8 * 8;
    float w0[8], w1[8], w2[8];
#pragma unroll
    for (int e = 0; e < 8; ++e) { w0[e] = cw[j0 + e]; w1[e] = cw[FFN + j0 + e]; w2[e] = cw[2 * FFN + j0 + e]; }
    const int t0 = ch * 64, s0 = t0 % SEQ;
    float a1[8], a2[8];
#pragma unroll
    for (int e = 0; e < 8; ++e) { a1[e] = 0.f; a2[e] = 0.f; }
    if (s0 > 0) {
      bf16x8 v1 = *(const bf16x8*)(AU + (size_t)(t0 - 1) * AUS + j0);
      bf16x8 v2 = *(const bf16x8*)(AU + (size_t)(t0 - 2) * AUS + j0);
#pragma unroll
      for (int e = 0; e < 8; ++e) { a1[e] = bf2f((bf16_t)v1[e]); a2[e] = bf2f((bf16_t)v2[e]); }
    }
    for (int t = t0; t < t0 + 64; ++t) {
      bf16x8 va = *(const bf16x8*)(AU + (size_t)t * AUS + j0);
      bf16x8 vu = *(const bf16x8*)(AU + (size_t)t * AUS + FFN + j0);
      float o[8];
#pragma unroll
      for (int e = 0; e < 8; ++e) {
        float a0 = bf2f((bf16_t)va[e]);
        float cv = w0[e] * a2[e] + w1[e] * a1[e] + w2[e] * a0;
        o[e] = geluf_(cv) * bf2f((bf16_t)vu[e]);
        a2[e] = a1[e]; a1[e] = a0;
      }
      uint4 ov = {pack2(o[0], o[1]), pack2(o[2], o[3]), pack2(o[4], o[5]), pack2(o[6], o[7])};
      *(uint4*)(AU + (size_t)t * AUS + FFN + j0) = ov;
    }
  }
}

DI float mixf(bf16_t cur, bf16_t prev, float mu) { const float c = bf2f(cur); return c + (bf2f(prev) - c) * mu; }
DI void rw_prep_item(const Params& p, int l, int item, char* smem) {
  const bf16_t* P = (const bf16_t*)(p.ws + OFF_P);
  bf16_t* RD = (bf16_t*)(p.ws + OFF_L);
  bf16_t* RKK = (bf16_t*)(p.ws + OFF_L + GSZ);
  bf16_t* RA = (bf16_t*)(p.ws + OFF_L + 2 * GSZ);
  bf16_t* RG = (bf16_t*)(p.ws + OFF_L + 3 * GSZ);
  float* BON = (float*)(p.ws + OFF_BON);
  const int b = item >> 6, ct = item & 63;
  const int tid = otid(), lane = tid & 63, wv = tid >> 6, hd = wv & 3, mi = wv >> 2, r = lane & 31, h = lane >> 5;
  bf16_t* TX = (bf16_t*)smem;
  bf16_t* XA = TX + 64 * 40;
  bf16_t* SG = XA + 64 * 40;
  const float* mu = p.in[I_RMU] + (size_t)l * 896;
  const size_t tok0 = (size_t)b * SEQ + ct * 64;
  bf16x8 bw[2][2], ba[2][2], bg[2][4];
  {
    const float* wp = p.in[I_RWUP] + (size_t)l * 32 * 256 + hd * 64 + r;
    const float* ap = p.in[I_RAUP] + (size_t)l * 32 * 256 + hd * 64 + r;
    const float* gp = p.in[I_RGUP] + (size_t)l * 64 * 256 + hd * 64 + r;
    asm volatile("" : "+v"(wp), "+v"(ap), "+v"(gp));
#pragma unroll
    for (int ni = 0; ni < 2; ++ni) {
#pragma unroll
      for (int ks = 0; ks < 2; ++ks) {
        unsigned uw[4], ua[4];
#pragma unroll
        for (int j2 = 0; j2 < 4; ++j2) {
          const int k = 16 * ks + 8 * h + 2 * j2;
          uw[j2] = pack2(wp[k * 256 + 32 * ni], wp[(k + 1) * 256 + 32 * ni]);
          ua[j2] = pack2(ap[k * 256 + 32 * ni], ap[(k + 1) * 256 + 32 * ni]);
        }
        uint4 t1 = {uw[0], uw[1], uw[2], uw[3]}, t2 = {ua[0], ua[1], ua[2], ua[3]};
        bw[ni][ks] = __builtin_bit_cast(bf16x8, t1); ba[ni][ks] = __builtin_bit_cast(bf16x8, t2);
      }
#pragma unroll
      for (int ks = 0; ks < 4; ++ks) {
        unsigned ug[4];
#pragma unroll
        for (int j2 = 0; j2 < 4; ++j2) { const int k = 16 * ks + 8 * h + 2 * j2; ug[j2] = pack2(gp[k * 256 + 32 * ni], gp[(k + 1) * 256 + 32 * ni]); }
        uint4 t3 = {ug[0], ug[1], ug[2], ug[3]};
        bg[ni][ks] = __builtin_bit_cast(bf16x8, t3);
      }
    }
  }
#pragma unroll 4
  for (int i = 0; i < 16; ++i) {
    const int e = tid + NTHR * i; const int t = e >> 7, f = e & 127;
    const bf16_t* pr = P + (tok0 + t) * PSTR + C_RW + 768 + f;
    const bf16_t cur = pr[0];
    const bf16_t prev = (ct * 64 + t > 0) ? (pr - PSTR)[0] : (bf16_t)0;
    const float m = mixf(cur, prev, mu[768 + f]);
    if (f < 32) TX[t * 40 + f] = f2bf(tanhf_(m));
    else if (f < 64) XA[t * 40 + f - 32] = f2bf(m);
    else SG[t * 72 + f - 64] = f2bf(sigmoidf_(m));
  }
  __syncthreads();
  f32x16 cw[2], ca[2], cg[2];
#pragma unroll
  for (int ni = 0; ni < 2; ++ni)
#pragma unroll
    for (int i = 0; i < 16; ++i) { cw[ni][i] = 0.f; ca[ni][i] = 0.f; cg[ni][i] = 0.f; }
#pragma unroll
  for (int ks = 0; ks < 2; ++ks) {
    const bf16x8 atx = *(const bf16x8*)(TX + (32 * mi + r) * 40 + 16 * ks + 8 * h);
    const bf16x8 axa = *(const bf16x8*)(XA + (32 * mi + r) * 40 + 16 * ks + 8 * h);
#pragma unroll
    for (int ni = 0; ni < 2; ++ni) { cw[ni] = mfma32(atx, bw[ni][ks], cw[ni]); ca[ni] = mfma32(axa, ba[ni][ks], ca[ni]); }
  }
#pragma unroll
  for (int ks = 0; ks < 4; ++ks) {
    const bf16x8 asg = *(const bf16x8*)(SG + (32 * mi + r) * 72 + 16 * ks + 8 * h);
#pragma unroll
    for (int ni = 0; ni < 2; ++ni) cg[ni] = mfma32(asg, bg[ni][ks], cg[ni]);
  }
  float ss[16], bn[16];
#pragma unroll
  for (int i = 0; i < 16; ++i) { ss[i] = 0.f; bn[i] = 0.f; }
#pragma unroll
  for (int ni = 0; ni < 2; ++ni) {
    const int hc = hd * 64 + 32 * ni + r;
    const float w0c = p.in[I_RW0][l * 256 + hc], a0c = p.in[I_RA0][l * 256 + hc], kkc = p.in[I_RKK][l * 256 + hc],
                kac = p.in[I_RKA][l * 256 + hc], rkc = p.in[I_RRK][l * 256 + hc], mu_r = mu[hc], mu_k = mu[256 + hc];
#pragma unroll
    for (int i = 0; i < 16; ++i) {
      const int tl = 32 * mi + crow(i, h);
      const size_t tok = tok0 + tl;
      const bf16_t* pr = P + tok * PSTR + C_RW + hc;
      const bool hp = (ct * 64 + tl) > 0;
      const float rr = mixf(pr[0], hp ? (pr - PSTR)[0] : (bf16_t)0, mu_r);
      const float k = mixf(pr[256], hp ? (pr - PSTR)[256] : (bf16_t)0, mu_k);
      const float wl = w0c + cw[ni][i];
      const float wlog = -softplusf_(-wl) - 0.5f;
      const float dd = 1.f - __expf(-__expf(wlog));
      const float a = sigmoidf_(a0c + ca[ni][i]);
      const float kkr = k * kkc;
      const float kp = k * (1.f + (a - 1.f) * kac);
      ss[i] += kkr * kkr; bn[i] += rr * kp * rkc;
      cw[ni][i] = kkr;
      RD[tok * 256 + hc] = f2bf(dd); RA[tok * 256 + hc] = f2bf(a); RG[tok * 256 + hc] = f2bf(cg[ni][i]);
    }
  }
#pragma unroll
  for (int i = 0; i < 16; ++i) {
#pragma unroll
    for (int o = 1; o < 32; o <<= 1) { ss[i] += __shfl_xor(ss[i], o); bn[i] += __shfl_xor(bn[i], o); }
    ss[i] = rsqrtf(ss[i] + EPSF);
  }
#pragma unroll
  for (int ni = 0; ni < 2; ++ni) {
    const int hc = hd * 64 + 32 * ni + r;
#pragma unroll
    for (int i = 0; i < 16; ++i) {
      const size_t tok = tok0 + 32 * mi + crow(i, h);
      RKK[tok * 256 + hc] = f2bf(cw[ni][i] * ss[i]);
    }
  }
  if (r == 0) {
#pragma unroll
    for (int i = 0; i < 16; ++i) BON[(tok0 + 32 * mi + crow(i, h)) * 4 + hd] = bn[i];
  }
}

DI void rwkv_scan_item(const Params& p, int l, int b, int hd, int half, char* smem) {
  const bf16_t* P = (const bf16_t*)(p.ws + OFF_P);
  bf16_t* O = (bf16_t*)(p.ws + OFF_O);
  const bf16_t* RD = (const bf16_t*)(p.ws + OFF_L);
  const bf16_t* RKK = (const bf16_t*)(p.ws + OFF_L + GSZ);
  const bf16_t* RA = (const bf16_t*)(p.ws + OFF_L + 2 * GSZ);
  float* fb = (float*)smem;
  float* Yb = fb + 2 * 6208;
  const int tid = otid(), lane = tid & 63, wv = tid >> 6;
  const int hc = hd * 64 + lane;
  constexpr int NCH = SEQ / 16;
  float S[8];
#pragma unroll
  for (int j = 0; j < 8; ++j) S[j] = 0.f;
  const int rl = lane >> 3, kq = lane & 7, vloc = (wv & 3) * 8 + rl, vrow = half * 32 + vloc;
  const float* mu = p.in[I_RMU] + (size_t)l * 896;
  const float mu_r = mu[hc], mu_k = mu[256 + hc], mu_v = mu[512 + hc];
  const float kac = p.in[I_RKA][l * 256 + hc];
  const int pw = wv & 3;
  unsigned raw[4][9];
#pragma unroll
  for (int j = 0; j < 4; ++j)
#pragma unroll
    for (int e = 0; e < 9; ++e) raw[j][e] = 0u;
#define RAWLOAD(i_)                                                                                 \
  {                                                                                                 \
    _Pragma("unroll") for (int j = 0; j < 4; ++j) {                                                 \
      const int s_ = (i_) * 16 + pw * 4 + j;                                                        \
      const size_t tok_ = (size_t)b * SEQ + s_;                                                     \
      const bf16_t* pr_ = P + tok_ * PSTR + C_RW;                                                   \
      raw[j][0] = pr_[hc]; raw[j][1] = pr_[256 + hc]; raw[j][2] = pr_[512 + hc];                    \
      if (s_ > 0) { raw[j][3] = (pr_ - PSTR)[hc]; raw[j][4] = (pr_ - PSTR)[256 + hc]; raw[j][5] = (pr_ - PSTR)[512 + hc]; } \
      else { raw[j][3] = 0u; raw[j][4] = 0u; raw[j][5] = 0u; }                                      \
      raw[j][6] = RD[tok_ * 256 + hc]; raw[j][7] = RKK[tok_ * 256 + hc]; raw[j][8] = RA[tok_ * 256 + hc]; \
    }                                                                                               \
  }
#define RBAR() { asm volatile("s_waitcnt lgkmcnt(0)" ::: "memory"); __builtin_amdgcn_s_barrier(); asm volatile("" ::: "memory"); }
  if (wv >= 4) RAWLOAD(0);
#pragma unroll 1
  for (int i = 0; i < NCH + 2; ++i) {
    if (wv >= 4) {
      float* B = fb + (i & 1) * 6208;
      if (i >= 2) {
        const float* Yc = Yb + (i & 1) * 512;
        if (lane < 32) {
#pragma unroll
          for (int j = 0; j < 4; ++j) {
            const int tl = pw * 4 + j;
            const size_t tok = (size_t)b * SEQ + (i - 2) * 16 + tl;
            O[tok * DM + 768 + hd * 64 + half * 32 + lane] = f2bf(Yc[tl * 32 + lane]);
          }
        }
      }
      if (i < NCH) {
#pragma unroll
        for (int j = 0; j < 4; ++j) {
          const int tl = pw * 4 + j;
          const float r = mixf((bf16_t)raw[j][0], (bf16_t)raw[j][3], mu_r), k = mixf((bf16_t)raw[j][1], (bf16_t)raw[j][4], mu_k), v = mixf((bf16_t)raw[j][2], (bf16_t)raw[j][5], mu_v);
          const float w = 1.f - bf2f((bf16_t)raw[j][6]), kk = bf2f((bf16_t)raw[j][7]), a = bf2f((bf16_t)raw[j][8]);
          const float ka = kk * a, kp = k * (1.f + (a - 1.f) * kac);
          const float c1 = wave_sum(ka * r), c2 = wave_sum(kp * r);
          B[tl * 64 + lane] = w; B[1024 + tl * 64 + lane] = kk; B[2048 + tl * 64 + lane] = ka; B[3072 + tl * 64 + lane] = kp;
          B[4096 + tl * 64 + lane] = w * r; B[5120 + tl * 64 + lane] = v;
          if (lane == 0) { B[6144 + tl * 2] = c1; B[6144 + tl * 2 + 1] = c2; }
        }
        if (i + 1 < NCH) RAWLOAD(i + 1);
      }
    } else if (i >= 1 && i <= NCH) {
      const float* B = fb + ((i - 1) & 1) * 6208;
      float* Yc = Yb + ((i - 1) & 1) * 512;
      f32x4 vw[2][10]; float vvv[2]; float2 vsc[2];
#define RWLD(t_, s_)                                                                              \
      { const float* bt_ = B + (t_) * 64 + kq * 8;                                                 \
        _Pragma("unroll") for (int q_ = 0; q_ < 5; ++q_) { vw[s_][2 * q_] = *(const f32x4*)(bt_ + 1024 * q_); vw[s_][2 * q_ + 1] = *(const f32x4*)(bt_ + 1024 * q_ + 4); } \
        vvv[s_] = B[5120 + (t_) * 64 + vrow]; vsc[s_] = *(const float2*)(B + 6144 + (t_) * 2); }
      RWLD(0, 0);
#pragma unroll
      for (int t = 0; t < 16; ++t) {
        const int cs = t & 1;
        if (t + 1 < 16) RWLD(t + 1, cs ^ 1);
        const f32x4 w0 = vw[cs][0], w1 = vw[cs][1], kk0 = vw[cs][2], kk1 = vw[cs][3], ka0 = vw[cs][4], ka1 = vw[cs][5],
                    kp0 = vw[cs][6], kp1 = vw[cs][7], wr0 = vw[cs][8], wr1 = vw[cs][9];
        const float vv = vvv[cs]; const float2 sc = vsc[cs];
        float d0 = 0.f, e0 = 0.f;
#pragma unroll
        for (int j = 0; j < 4; ++j) { d0 += S[j] * kk0[j] + S[j + 4] * kk1[j]; e0 += S[j] * wr0[j] + S[j + 4] * wr1[j]; }
        d0 = reduce8(d0); e0 = reduce8(e0);
        const float sa0 = -d0;
        const float y0 = e0 + sa0 * sc.x + vv * sc.y;
#pragma unroll
        for (int j = 0; j < 4; ++j) {
          S[j] = S[j] * w0[j] + sa0 * ka0[j] + vv * kp0[j]; S[j + 4] = S[j + 4] * w1[j] + sa0 * ka1[j] + vv * kp1[j];
        }
        if (kq == 0) Yc[t * 32 + vloc] = y0;
      }
#undef RWLD
    }
    RBAR();
  }
#undef RAWLOAD
#undef RBAR
}

DI void rwkv_post(const Params& p, int l) {
  const bf16_t* P = (const bf16_t*)(p.ws + OFF_P);
  bf16_t* O = (bf16_t*)(p.ws + OFF_O);
  const bf16_t* RG = (const bf16_t*)(p.ws + OFF_L + 3 * GSZ);
  const float* BON = (const float*)(p.ws + OFF_BON);
  const int tid = otid(), lane = tid & 63, wv = tid >> 6;
  const float* mu = p.in[I_RMU] + (size_t)l * 896;
  const int nw = gridDim.x * 8;
  for (int task0 = (obid() * 8 + wv) * 4; task0 < NTOK * 4; task0 += nw * 4) {
    float yv[4], vv[4], gv[4], bv[4];
#pragma unroll
    for (int q = 0; q < 4; ++q) {
      const int task = task0 + q; const size_t tok = task >> 2; const int hd = task & 3, hc = hd * 64 + lane;
      yv[q] = bf2f(O[tok * DM + 768 + hc]);
      const bf16_t cur = P[tok * PSTR + C_RW + 512 + hc];
      const bf16_t prev = (tok % SEQ) ? P[(tok - 1) * PSTR + C_RW + 512 + hc] : (bf16_t)0;
      vv[q] = mixf(cur, prev, mu[512 + hc]);
      gv[q] = bf2f(RG[tok * 256 + hc]); bv[q] = BON[tok * 4 + hd];
    }
#pragma unroll
    for (int q = 0; q < 4; ++q) {
      const int task = task0 + q; const size_t tok = task >> 2; const int hd = task & 3, hc = hd * 64 + lane;
      const float mean = wave_sum(yv[q]) * (1.f / 64.f);
      const float d = yv[q] - mean;
      const float var = wave_sum(d * d) * (1.f / 64.f);
      const float yn = d * rsqrtf(var + 64e-5f) * p.in[I_RLG][l * 256 + hc] + p.in[I_RLB][l * 256 + hc];
      O[tok * DM + 768 + hc] = f2bf((yn + bv[q] * vv[q]) * gv[q]);
    }
  }
}

DI void sb_item(const Params& p, int item, char* smem) {
  const bf16_t* P = (const bf16_t*)(p.ws + OFF_P);
  bf16_t* O = (bf16_t*)(p.ws + OFF_O);
  const int qt = item & 15, hd = (item >> 4) & 3, b = item >> 6;
  const int tid = otid(), lane = tid & 63, wv = tid >> 6, r = lane & 31, h = lane >> 5;
  bf16_t* Vt = (bf16_t*)(smem + wv * 8704);
  const int q0 = qt * 256 + wv * 32;
  const int sq = q0 + r;
  const size_t tokb = (size_t)b * SEQ;
  bf16x8 qf[4];
#pragma unroll
  for (int ks = 0; ks < 4; ++ks) qf[ks] = *(const bf16x8*)(P + (tokb + sq) * PSTR + C_SB_Q + hd * 64 + ks * 16 + h * 8);
  f32x16 accO[2];
#pragma unroll
  for (int i = 0; i < 16; ++i) { accO[0][i] = 0.f; accO[1][i] = 0.f; }
  float Prun = 1.f;
  bf16x8 kf[2][4];
  const int kt0 = (q0 + 31) >> 6;
#define SBKLOAD(kt_) { _Pragma("unroll") for (int m = 0; m < 2; ++m) _Pragma("unroll") for (int ks = 0; ks < 4; ++ks) \
    kf[m][ks] = *(const bf16x8*)(P + (tokb + (kt_) * 64 + 32 * m + r) * PSTR + C_SB_K + hd * 64 + ks * 16 + h * 8); }
  SBKLOAD(kt0);
  for (int kt = kt0; kt >= 0; --kt) {
    const int k0 = kt * 64;
    bf16x8 vr[8];
#pragma unroll
    for (int it = 0; it < 8; ++it) vr[it] = *(const bf16x8*)(P + (tokb + k0 + it * 8 + (lane >> 3)) * PSTR + C_SB_V + hd * 64 + (lane & 7) * 8);
    f32x16 acc[2];
#pragma unroll
    for (int m = 0; m < 2; ++m) {
#pragma unroll
      for (int i = 0; i < 16; ++i) acc[m][i] = 0.f;
#pragma unroll
      for (int ks = 0; ks < 4; ++ks) acc[m] = mfma32(kf[m][ks], qf[ks], acc[m]);
    }
    if (kt > 0) SBKLOAD(kt - 1);
    float om[2][16];
#pragma unroll
    for (int m = 0; m < 2; ++m)
#pragma unroll
      for (int i = 0; i < 16; ++i) {
        const int key = k0 + 32 * m + crow(i, h);
        const float z = fmaxf(acc[m][i] * 0.125f, -80.f);
        const float e = __expf(-z);
        const float sg = __builtin_amdgcn_rcpf(1.f + e);
        const bool valid = key < sq;
        acc[m][i] = valid ? sg : 0.f;
        om[m][i] = valid ? e * sg : 1.f;
      }
    float gp[8];
#pragma unroll
    for (int q = 0; q < 8; ++q) {
      const int m = q >> 2, g = q & 3;
      gp[q] = (om[m][4 * g] * om[m][4 * g + 1]) * (om[m][4 * g + 2] * om[m][4 * g + 3]);
    }
    float run = 1.f;
#pragma unroll
    for (int q = 7; q >= 0; --q) {
      const int m = q >> 2, g = q & 3;
      const float pg = __shfl_xor(gp[q], 32);
      const float f3 = Prun * run * (h == 0 ? pg : 1.f);
      const float f2 = f3 * om[m][4 * g + 3], f1 = f2 * om[m][4 * g + 2], f0 = f1 * om[m][4 * g + 1];
      acc[m][4 * g + 3] *= f3; acc[m][4 * g + 2] *= f2; acc[m][4 * g + 1] *= f1; acc[m][4 * g + 0] *= f0;
      run *= gp[q] * pg;
    }
    Prun *= run;
    __builtin_amdgcn_wave_barrier();
#pragma unroll
    for (int it = 0; it < 8; ++it) {
      const int key = it * 8 + (lane >> 3), chv = lane & 7;
#pragma unroll
      for (int e = 0; e < 8; ++e) Vt[(chv * 8 + e) * 68 + key] = (bf16_t)vr[it][e];
    }
    __builtin_amdgcn_wave_barrier();
#pragma unroll
    for (int m = 0; m < 2; ++m)
#pragma unroll
      for (int s2 = 0; s2 < 2; ++s2) {
        uint4 uu = {pack2(acc[m][8 * s2 + 0], acc[m][8 * s2 + 1]), pack2(acc[m][8 * s2 + 2], acc[m][8 * s2 + 3]),
                    pack2(acc[m][8 * s2 + 4], acc[m][8 * s2 + 5]), pack2(acc[m][8 * s2 + 6], acc[m][8 * s2 + 7])};
        const bf16x8 pb = __builtin_bit_cast(bf16x8, uu);
#pragma unroll
        for (int dt = 0; dt < 2; ++dt) {
          const bf16_t* vp = Vt + (32 * dt + r) * 68 + 32 * m + 16 * s2 + 4 * h;
          s16x4 lo = *(const s16x4*)vp, hi = *(const s16x4*)(vp + 8);
          bf16x8 va = __builtin_shufflevector(lo, hi, 0, 1, 2, 3, 4, 5, 6, 7);
          accO[dt] = mfma32(va, pb, accO[dt]);
        }
      }
    __builtin_amdgcn_wave_barrier();
    if (__ballot(Prun > 1e-37f) == 0ull) break;
  }
#undef SBKLOAD
#pragma unroll
  for (int dt = 0; dt < 2; ++dt)
#pragma unroll
    for (int g = 0; g < 4; ++g) {
      const int d = 32 * dt + 8 * g + 4 * h;
      uint2 o = {pack2(accO[dt][4 * g], accO[dt][4 * g + 1]), pack2(accO[dt][4 * g + 2], accO[dt][4 * g + 3])};
      *(uint2*)(O + (tokb + sq) * DM + 256 + hd * 64 + d) = o;
    }
}

DI int frag_off(int row, int k) {
  const int rt = row >> 4, fr = row & 15, ks = k >> 5, kk = k & 31, hi = kk >> 4, fq = (kk & 15) >> 2, j = (kk & 3) + 4 * hi;
  return ((rt * 2 + ks) * 64 + fq * 16 + fr) * 8 + j;
}
DI int frag_off8(int row, int k0) {
  const int rt = row >> 4, fr = row & 15, ks = k0 >> 5, kk = k0 & 31, hi = kk >> 4, fq = (kk & 15) >> 2;
  return ((rt * 2 + ks) * 64 + fq * 16 + fr) * 8 + 4 * hi;
}
DI void gdn_intra_item(const Params& p, int l, int item, char* smem) {
  const bf16_t* P = (const bf16_t*)(p.ws + OFF_P);
  const int hp = item & 1, c = (item >> 1) & 63, b = item >> 7;
  const int tid = otid(), lane = tid & 63;
  bf16_t* Kb = (bf16_t*)smem;
  bf16_t* Qb = Kb + 2 * 64 * 72;
  bf16_t* Vb = Qb + 2 * 64 * 72;
  float* Lm = (float*)(smem + 3 * 2 * 64 * 72 * 2);
  float* Gs = Lm + 2 * 4096;
  float* Bs = Gs + 128;
  const size_t tok0 = (size_t)b * SEQ + c * 64;
  const float* cw = p.in[I_GCW] + (size_t)l * 4 * 768;
  float* CW = Bs + 128;
  for (int e = tid; e < 6 * 4 * 64; e += NTHR) {
    const int blk = e >> 8, j = (e >> 6) & 3, col = e & 63;
    const int hh_ = blk / 3, which_ = blk % 3;
    CW[e] = cw[j * 768 + which_ * 256 + (hp * 2 + hh_) * 64 + col];
  }
  __syncthreads();
  {
    const int t = tid >> 3, cg = tid & 7;
#pragma unroll 3
    for (int it = 0; it < 6; ++it) {
      const int hh = it / 3, which = it % 3, head = hp * 2 + hh;
      const int ccol = which * 256 + head * 64 + cg * 8;
      float acc[8];
#pragma unroll
      for (int e = 0; e < 8; ++e) acc[e] = 0.f;
#pragma unroll
      for (int j = 0; j < 4; ++j) {
        const int s = c * 64 + t - 3 + j;
        if (s >= 0) {
          bf16x8 xv = *(const bf16x8*)(P + ((size_t)b * SEQ + s) * PSTR + C_GDN_Q + ccol);
          f32x4 wa = *(const f32x4*)(CW + (it * 4 + j) * 64 + cg * 8), wb = *(const f32x4*)(CW + (it * 4 + j) * 64 + cg * 8 + 4);
#pragma unroll
          for (int e = 0; e < 4; ++e) { acc[e] += wa[e] * bf2f((bf16_t)xv[e]); acc[e + 4] += wb[e] * bf2f((bf16_t)xv[e + 4]); }
        }
      }
      float ss = 0.f;
#pragma unroll
      for (int e = 0; e < 8; ++e) { acc[e] = siluf_(acc[e]); ss += acc[e] * acc[e]; }
      ss += __shfl_xor(ss, 1); ss += __shfl_xor(ss, 2); ss += __shfl_xor(ss, 4);
      float sc = 1.f;
      if (which == 0) sc = rsqrtf(ss + EPSF) * 0.125f;
      else if (which == 1) sc = rsqrtf(ss + EPSF);
      uint4 ov = {pack2(acc[0] * sc, acc[1] * sc), pack2(acc[2] * sc, acc[3] * sc), pack2(acc[4] * sc, acc[5] * sc), pack2(acc[6] * sc, acc[7] * sc)};
      bf16_t* dst = (which == 0 ? Qb : (which == 1 ? Kb : Vb)) + (hh * 64 + t) * 72 + cg * 8;
      *(uint4*)dst = ov;
    }
  }
  if (tid < 128) {
    const int hh = tid >> 6, t = lane, head = hp * 2 + hh;
    const float a_in = bf2f(P[(tok0 + t) * PSTR + C_GDN_A + head]);
    const float b_in = bf2f(P[(tok0 + t) * PSTR + C_GDN_B + head]);
    const float beta = sigmoidf_(b_in);
    float g = -__expf(p.in[I_GAL][l * 4 + head]) * softplusf_(a_in + p.in[I_GDT][l * 4 + head]);
#pragma unroll
    for (int d = 1; d < 64; d <<= 1) { float v = __shfl_up(g, d); if (lane >= d) g += v; }
    Gs[hh * 64 + t] = g; Bs[hh * 64 + t] = beta;
  }
  __syncthreads();
  const int hh = tid >> 8, lt = tid & 255, head = hp * 2 + hh;
  const size_t ih = ((size_t)(b * 4 + head)) * 64 + c;
  bf16_t* GW = (bf16_t*)(p.ws + OFF_G) + ih * 4096;
  bf16_t* GQD = (bf16_t*)(p.ws + OFF_G + GSZ) + ih * 4096;
  bf16_t* GQK = (bf16_t*)(p.ws + OFF_G + 2 * GSZ) + ih * 4096;
  bf16_t* GKD = (bf16_t*)(p.ws + OFF_G + 3 * GSZ) + ih * 4096;
  bf16_t* GU = (bf16_t*)(p.ws + OFF_G + 4 * GSZ) + ih * 4096;
  float* GCD = (float*)(p.ws + OFF_GCD);
  const float* Gh = Gs + hh * 64; const float* Bh = Bs + hh * 64;
  {
    const int wq = (tid >> 6) & 3, ti = wq >> 1, tj = wq & 1, r = lane & 31, h = lane >> 5;
    f32x16 akk, aqk;
#pragma unroll
    for (int i = 0; i < 16; ++i) { akk[i] = 0.f; aqk[i] = 0.f; }
    if (ti >= tj) {
#pragma unroll
      for (int ks = 0; ks < 4; ++ks) {
        bf16x8 ka = *(const bf16x8*)(Kb + (hh * 64 + 32 * ti + r) * 72 + ks * 16 + h * 8);
        bf16x8 qa = *(const bf16x8*)(Qb + (hh * 64 + 32 * ti + r) * 72 + ks * 16 + h * 8);
        bf16x8 kb = *(const bf16x8*)(Kb + (hh * 64 + 32 * tj + r) * 72 + ks * 16 + h * 8);
        akk = mfma32(ka, kb, akk);
        aqk = mfma32(qa, kb, aqk);
      }
    }
    const int j = 32 * tj + r;
    const float Gj = Gh[j];
#pragma unroll
    for (int i_ = 0; i_ < 16; ++i_) {
      const int i = 32 * ti + crow(i_, h);
      const float dec = (i >= j) ? __expf(Gh[i] - Gj) : 0.f;
      Lm[hh * 4096 + i * 64 + j] = (i > j) ? Bh[i] * akk[i_] * dec : 0.f;
      GQK[frag_off(i, j)] = f2bf((i >= j) ? aqk[i_] * dec : 0.f);
    }
  }
  __syncthreads();
  if (lt < 128) {
    const int cc = lt;
    float x[64];
    if (cc < 64) {
#pragma unroll
      for (int i = 0; i < 64; ++i) x[i] = bf2f(Vb[(hh * 64 + i) * 72 + cc]) * Bh[i];
    } else {
#pragma unroll
      for (int i = 0; i < 64; ++i) x[i] = bf2f(Kb[(hh * 64 + i) * 72 + cc - 64]) * Bh[i] * __expf(Gh[i]);
    }
    const float* Lh = Lm + hh * 4096;
#pragma unroll
    for (int i = 1; i < 64; ++i) {
      float s = x[i];
#pragma unroll
      for (int j4 = 0; j4 < (i + 3) / 4; ++j4) {
        const f32x4 lv = *(const f32x4*)(Lh + i * 64 + j4 * 4);
#pragma unroll
        for (int e = 0; e < 4; ++e) if (j4 * 4 + e < i) s -= lv[e] * x[j4 * 4 + e];
      }
      x[i] = s;
    }
    if (cc < 64) {
      const int split = cc >> 4, fr = cc & 15;
#pragma unroll
      for (int i4 = 0; i4 < 16; ++i4) {
        uint2 ov = {pack2(x[4 * i4], x[4 * i4 + 1]), pack2(x[4 * i4 + 2], x[4 * i4 + 3])};
        *(uint2*)(GU + ((split * 4 + (i4 >> 2)) * 64 + (i4 & 3) * 16 + fr) * 4) = ov;
      }
    } else {
#pragma unroll
      for (int i = 0; i < 64; ++i) GW[frag_off(i, cc - 64)] = f2bf(x[i]);
    }
  } else {
    const int q_ = lt - 128;
    const float Glast = Gh[63];
#pragma unroll
    for (int i = 0; i < 4; ++i) {
      const int q = q_ + 128 * i; const int pos = q >> 3, kc = q & 7;
      bf16x8 qv = *(const bf16x8*)(Qb + (hh * 64 + pos) * 72 + kc * 8);
      const float eg = __expf(Gh[pos]);
      uint4 ov = {pack2(bf2f((bf16_t)qv[0]) * eg, bf2f((bf16_t)qv[1]) * eg), pack2(bf2f((bf16_t)qv[2]) * eg, bf2f((bf16_t)qv[3]) * eg),
                  pack2(bf2f((bf16_t)qv[4]) * eg, bf2f((bf16_t)qv[5]) * eg), pack2(bf2f((bf16_t)qv[6]) * eg, bf2f((bf16_t)qv[7]) * eg)};
      { const int fo = frag_off8(pos, kc * 8); uint2 o0 = {ov.x, ov.y}, o1 = {ov.z, ov.w}; *(uint2*)(GQD + fo) = o0; *(uint2*)(GQD + fo + 128) = o1; }
    }
#pragma unroll
    for (int i = 0; i < 4; ++i) {
      const int q = q_ + 128 * i; const int k = q >> 3, pc = q & 7;
      float o[8];
#pragma unroll
      for (int e = 0; e < 8; ++e) { const int pos = pc * 8 + e; o[e] = bf2f(Kb[(hh * 64 + pos) * 72 + k]) * __expf(Glast - Gh[pos]); }
      uint4 ov = {pack2(o[0], o[1]), pack2(o[2], o[3]), pack2(o[4], o[5]), pack2(o[6], o[7])};
      { const int fo = frag_off8(k, pc * 8); uint2 o0 = {ov.x, ov.y}, o1 = {ov.z, ov.w}; *(uint2*)(GKD + fo) = o0; *(uint2*)(GKD + fo + 128) = o1; }
    }
    if (q_ == 0) GCD[ih] = __expf(Glast);
  }
}

DI void gdn_rec_item(const Params& p, int l, int b, int head, char* smem) {
  const bf16_t* P = (const bf16_t*)(p.ws + OFF_P);
  bf16_t* O = (bf16_t*)(p.ws + OFF_O);
  float* SS = (float*)(smem + 81920);
  const int tid = otid(), lane = tid & 63, wv = tid >> 6, fr = lane & 15, fq = lane >> 4;
  const int split = wv & 3;
  const bool active = wv < 4;
  const float ng = p.in[I_GNG][l * 64 + split * 16 + fr];
  const float* GCD = (const float*)(p.ws + OFF_GCD);
  const size_t ih0 = ((size_t)(b * 4 + head)) * 64;
  f32x4 S[4];
#pragma unroll
  for (int kt = 0; kt < 4; ++kt) S[kt] = (f32x4){0.f, 0.f, 0.f, 0.f};
  u32x4 lr[10];
#pragma unroll
  for (int i = 0; i < 10; ++i) lr[i] = (u32x4){0u, 0u, 0u, 0u};
  const int lq = (wv & 3) * 64 + lane;
#define GLOADC(c_)                                                                              \
  {                                                                                             \
    _Pragma("unroll") for (int i = 0; i < 10; ++i) {                                            \
      const int q_ = lq + 256 * i; const int a_ = q_ >> 9, o_ = q_ & 511;                       \
      lr[i] = *(const u32x4*)((const bf16_t*)(p.ws + OFF_G + (size_t)a_ * GSZ) + (ih0 + (c_)) * 4096 + o_ * 8); \
    }                                                                                           \
  }
#define LSTORE(buf_)                                                                            \
  {                                                                                             \
    _Pragma("unroll") for (int i = 0; i < 10; ++i) {                                            \
      const int q_ = lq + 256 * i;                                                              \
      *(u32x4*)(smem + (buf_) * 40960 + q_ * 16) = lr[i];                                       \
    }                                                                                           \
  }
#define BAR_LDS() { asm volatile("s_waitcnt lgkmcnt(0)" ::: "memory"); __builtin_amdgcn_s_barrier(); asm volatile("" ::: "memory"); }
  float cdn = 0.f;
  if (!active) { GLOADC(0); LSTORE(0); GLOADC(1); }
  else cdn = GCD[ih0];
  BAR_LDS();
#pragma unroll 1
  for (int c = 0; c < 64; ++c) {
    f32x4 acco[4];
    if (active) {
      const char* bufp = smem + (c & 1) * 40960;
      const float cd = cdn;
      if (c + 1 < 64) cdn = GCD[ih0 + c + 1];
      float zr[16];
#pragma unroll
      for (int rt = 0; rt < 4; ++rt)
#pragma unroll
        for (int j = 0; j < 4; ++j) {
          const size_t tok = (size_t)b * SEQ + c * 64 + 16 * rt + 4 * fq + j;
          zr[rt * 4 + j] = bf2f(P[tok * PSTR + C_GDN_Z + head * 64 + split * 16 + fr]);
        }
      bf16x8 bS[2];
#pragma unroll
      for (int ks = 0; ks < 2; ++ks) {
        uint4 uu = {pack2(S[2 * ks][0], S[2 * ks][1]), pack2(S[2 * ks][2], S[2 * ks][3]), pack2(S[2 * ks + 1][0], S[2 * ks + 1][1]), pack2(S[2 * ks + 1][2], S[2 * ks + 1][3])};
        bS[ks] = __builtin_bit_cast(bf16x8, uu);
      }
      f32x4 u[4];
#pragma unroll
      for (int rt = 0; rt < 4; ++rt) {
        f32x4 aw = {0.f, 0.f, 0.f, 0.f};
        acco[rt] = (f32x4){0.f, 0.f, 0.f, 0.f};
#pragma unroll
        for (int ks = 0; ks < 2; ++ks) {
          const bf16x8 wa = *(const bf16x8*)(bufp + ((rt * 2 + ks) * 64 + lane) * 16);
          const bf16x8 qa = *(const bf16x8*)(bufp + 8192 + ((rt * 2 + ks) * 64 + lane) * 16);
          aw = mfma16(wa, bS[ks], aw); acco[rt] = mfma16(qa, bS[ks], acco[rt]);
        }
        const s16x4 uv = *(const s16x4*)(bufp + 32768 + ((split * 4 + rt) * 64 + lane) * 8);
#pragma unroll
        for (int j = 0; j < 4; ++j) u[rt][j] = bf2f((bf16_t)uv[j]) - aw[j];
      }
      bf16x8 bU[2];
#pragma unroll
      for (int ks = 0; ks < 2; ++ks) {
        uint4 uu = {pack2(u[2 * ks][0], u[2 * ks][1]), pack2(u[2 * ks][2], u[2 * ks][3]), pack2(u[2 * ks + 1][0], u[2 * ks + 1][1]), pack2(u[2 * ks + 1][2], u[2 * ks + 1][3])};
        bU[ks] = __builtin_bit_cast(bf16x8, uu);
      }
#pragma unroll
      for (int rt = 0; rt < 4; ++rt) {
        f32x4 sn = S[rt] * cd;
#pragma unroll
        for (int ks = 0; ks < 2; ++ks) {
          const bf16x8 qa = *(const bf16x8*)(bufp + 16384 + ((rt * 2 + ks) * 64 + lane) * 16);
          const bf16x8 ka = *(const bf16x8*)(bufp + 24576 + ((rt * 2 + ks) * 64 + lane) * 16);
          acco[rt] = mfma16(qa, bU[ks], acco[rt]); sn = mfma16(ka, bU[ks], sn);
        }
        S[rt] = sn;
      }
#pragma unroll
      for (int rt = 0; rt < 4; ++rt)
#pragma unroll
        for (int j = 0; j < 4; ++j) {
          float s = acco[rt][j] * acco[rt][j];
          s += __shfl_xor(s, 1); s += __shfl_xor(s, 2); s += __shfl_xor(s, 4); s += __shfl_xor(s, 8);
          if (fr == 0) SS[(c & 1) * 256 + split * 64 + 16 * rt + 4 * fq + j] = s;
        }
      BAR_LDS();
      const float* ssb = SS + (c & 1) * 256;
#pragma unroll
      for (int rt = 0; rt < 4; ++rt)
#pragma unroll
        for (int j = 0; j < 4; ++j) {
          const int pos = 16 * rt + 4 * fq + j;
          const float tot = ssb[pos] + ssb[64 + pos] + ssb[128 + pos] + ssb[192 + pos];
          const float rn = rsqrtf(tot * (1.f / 64.f) + EPSF);
          const size_t tok = (size_t)b * SEQ + c * 64 + pos;
          O[tok * DM + 512 + head * 64 + split * 16 + fr] = f2bf(acco[rt][j] * rn * ng * siluf_(zr[rt * 4 + j]));
        }
    } else {
      if (c + 1 < 64) LSTORE((c + 1) & 1);
      if (c + 2 < 64) GLOADC(c + 2);
      BAR_LDS();
    }
  }
#undef GLOADC
#undef LSTORE
#undef BAR_LDS
}

DI void lru_item(const Params& p, int l, int item, char* smem, const int mode) {
  const bf16_t* P = (const bf16_t*)(p.ws + OFF_P);
  bf16_t* O = (bf16_t*)(p.ws + OFF_O);
  float* CA = (float*)(p.ws + OFF_LCA);
  float* CH = (float*)(p.ws + OFF_LCH);
  bf16_t* XS = (bf16_t*)smem;
  bf16_t* UB = (bf16_t*)(smem + 34816);
  const int b = item >> 6, ct = item & 63;
  const int tid = otid(), lane = tid & 63, wv = tid >> 6, r = lane & 31, h = lane >> 5, n = wv & 3, mi = wv >> 2;
  for (int i = 0; i < 5; ++i) {
    const int q = tid + NTHR * i;
    if (q < 67 * 32) {
      const int row = q >> 5, cc = q & 31;
      const int s = ct * 64 - 3 + row;
      uint4 v = {0u, 0u, 0u, 0u};
      if (s >= 0) v = *(const uint4*)(P + ((size_t)b * SEQ + s) * PSTR + C_LRU_X + cc * 8);
      *(uint4*)(XS + row * 256 + cc * 8) = v;
    }
  }
  bf16x8 bwr[2][4], bwi[2][4];
  {
    const float* wrp = p.in[I_LWR] + (((size_t)l * 4 + n) * 64) * 64 + r;
    const float* wip = p.in[I_LWI] + (((size_t)l * 4 + n) * 64) * 64 + r;
    asm volatile("" : "+v"(wrp), "+v"(wip));
#pragma unroll
    for (int ni = 0; ni < 2; ++ni)
#pragma unroll
      for (int ks = 0; ks < 4; ++ks) {
        unsigned ur[4], ui[4];
#pragma unroll
        for (int j2 = 0; j2 < 4; ++j2) {
          const int e = 16 * ks + 8 * h + 2 * j2;
          ur[j2] = pack2(wrp[e * 64 + 32 * ni], wrp[(e + 1) * 64 + 32 * ni]);
          ui[j2] = pack2(wip[e * 64 + 32 * ni], wip[(e + 1) * 64 + 32 * ni]);
        }
        uint4 t1 = {ur[0], ur[1], ur[2], ur[3]}, t2 = {ui[0], ui[1], ui[2], ui[3]};
        bwr[ni][ks] = __builtin_bit_cast(bf16x8, t1); bwi[ni][ks] = __builtin_bit_cast(bf16x8, t2);
      }
  }
  __syncthreads();
  {
    const int sc = tid >> 8, c = tid & 255;
    const float cb = p.in[I_LCB][l * 256 + c];
    const float c0 = p.in[I_LCW][(l * 4 + 0) * 256 + c], c1 = p.in[I_LCW][(l * 4 + 1) * 256 + c],
                c2 = p.in[I_LCW][(l * 4 + 2) * 256 + c], c3 = p.in[I_LCW][(l * 4 + 3) * 256 + c];
    for (int t = sc * 32; t < sc * 32 + 32; ++t)
      UB[t * 264 + c] = f2bf(cb + c0 * bf2f(XS[t * 256 + c]) + c1 * bf2f(XS[(t + 1) * 256 + c]) + c2 * bf2f(XS[(t + 2) * 256 + c]) + c3 * bf2f(XS[(t + 3) * 256 + c]));
  }
  __syncthreads();
  f32x16 ar[2], ai[2];
#pragma unroll
  for (int ni = 0; ni < 2; ++ni)
#pragma unroll
    for (int i = 0; i < 16; ++i) { ar[ni][i] = 0.f; ai[ni][i] = 0.f; }
#pragma unroll
  for (int ks = 0; ks < 4; ++ks) {
    const bf16x8 au = *(const bf16x8*)(UB + (32 * mi + r) * 264 + n * 64 + 16 * ks + 8 * h);
#pragma unroll
    for (int ni = 0; ni < 2; ++ni) { ar[ni] = mfma32(au, bwr[ni][ks], ar[ni]); ai[ni] = mfma32(au, bwi[ni][ks], ai[ni]); }
  }
  const int ck = ct * 2 + mi;
#pragma unroll
  for (int ni = 0; ni < 2; ++ni) {
    const int c = n * 64 + 32 * ni + r;
    const float brc = p.in[I_LBR][l * 256 + c], bic = p.in[I_LBI][l * 256 + c];
    const float lamsp = softplusf_(-p.in[I_LLAM][l * 256 + c]);
    float av[16], bv[16];
#pragma unroll
    for (int i = 0; i < 16; ++i) {
      const int tl = 32 * mi + crow(i, h);
      const float u = bf2f(UB[tl * 264 + c]);
      const float rg = sigmoidf_(ar[ni][i] + brc), ig = sigmoidf_(ai[ni][i] + bic);
      const float la = -8.f * rg * lamsp;
      av[i] = __expf(la);
      bv[i] = sqrtf(fmaxf(0.f, 1.f - __expf(2.f * la))) * (ig * u);
    }
    float GA[4], GB[4], PA[4], PB[4];
#pragma unroll
    for (int q = 0; q < 4; ++q) {
      float A = 1.f, hh = 0.f;
#pragma unroll
      for (int e = 0; e < 4; ++e) { hh = av[4 * q + e] * hh + bv[4 * q + e]; A *= av[4 * q + e]; }
      GA[q] = A; GB[q] = hh;
      PA[q] = __shfl_xor(A, 32); PB[q] = __shfl_xor(hh, 32);
    }
    float cin = 0.f;
    if (mode == 1) {
      const int lo = h ? (ck >> 1) : 0, hi = h ? ck : (ck >> 1);
      float A = 1.f, hh = 0.f;
      const float* ca = CA + ((size_t)b * 128) * 256 + c;
      const float* chp = CH + ((size_t)b * 128) * 256 + c;
      int k = lo;
      for (; k + 8 <= hi; k += 8) {
        float a8[8], h8[8];
#pragma unroll
        for (int e = 0; e < 8; ++e) { a8[e] = ca[(size_t)(k + e) * 256]; h8[e] = chp[(size_t)(k + e) * 256]; }
#pragma unroll
        for (int e = 0; e < 8; ++e) { hh = a8[e] * hh + h8[e]; A *= a8[e]; }
      }
      for (; k < hi; ++k) { const float a_ = ca[(size_t)k * 256], h_ = chp[(size_t)k * 256]; hh = a_ * hh + h_; A *= a_; }
      const float pAx = __shfl_xor(A, 32), pHx = __shfl_xor(hh, 32);
      cin = h ? (A * pHx + hh) : (pAx * hh + pHx);
    }
    float cg = cin, Ap = 1.f, myc[4];
#pragma unroll
    for (int q = 0; q < 4; ++q) {
      const float Ae = h ? PA[q] : GA[q], Be = h ? PB[q] : GB[q];
      const float Ao = h ? GA[q] : PA[q], Bo = h ? GB[q] : PB[q];
      const float c_even = cg;
      cg = Ae * cg + Be;
      const float c_odd = cg;
      cg = Ao * cg + Bo;
      myc[q] = h ? c_odd : c_even;
      Ap *= Ae * Ao;
    }
    if (mode == 0) {
      if (h == 0) { CA[((size_t)b * 128 + ck) * 256 + c] = Ap; CH[((size_t)b * 128 + ck) * 256 + c] = cg; }
    } else {
#pragma unroll
      for (int q = 0; q < 4; ++q) {
        float hh = myc[q];
#pragma unroll
        for (int e = 0; e < 4; ++e) {
          const int i = 4 * q + e;
          hh = av[i] * hh + bv[i];
          const size_t tok = (size_t)b * SEQ + ct * 64 + 32 * mi + crow(i, h);
          const float y = bf2f(P[tok * PSTR + C_LRU_Y + c]);
          O[tok * DM + c] = f2bf(hh * geluf_(y));
        }
      }
    }
  }
}

#define XB_TMO      128
#define XB_XCNT(j)  (256  + 64 * (j))
#define XB_XSUB(j)  (1280 + 64 * (j))
#define XB_XGEN(j)  (2304 + 64 * (j))
#define XB_TOP      3328
#define XB_TOPGEN   3392
#define XCD_BAR_WORDS 3456
#define XB_SPIN_CAP (1u << 18)
#define XLAS __attribute__((address_space(3)))
DI unsigned xb_ld(unsigned* p)              { return __hip_atomic_load(p, __ATOMIC_RELAXED, __HIP_MEMORY_SCOPE_AGENT); }
DI unsigned xb_add(unsigned* p, unsigned v) { return __hip_atomic_fetch_add(p, v, __ATOMIC_RELAXED, __HIP_MEMORY_SCOPE_AGENT); }
DI unsigned xb_xcc_id() { return (unsigned)__builtin_amdgcn_s_getreg((3 << 11) | 20) & 0xFu; }
#define XB_SPIN(cond, bar) do { unsigned _sp = 0; while (cond) { __builtin_amdgcn_s_sleep(1); \
    if ((++_sp & 255u) == 0u) { if (xb_ld(&(bar)[XB_TMO])) break; if (_sp > XB_SPIN_CAP) { atomicAdd(&(bar)[XB_TMO], 1u); break; } } } } while (0)
struct XcdBarrier { unsigned* bar; unsigned x; volatile XLAS unsigned* st; };
DI XcdBarrier xcd_barrier_post(unsigned* bar, volatile XLAS unsigned* st) {
  XcdBarrier b; b.bar = bar; b.x = xb_xcc_id(); b.st = st;
  if (threadIdx.x == 0) (void)xb_add(&bar[XB_XCNT(b.x)], 1u);
  return b;
}
DI void xcd_barrier_complete(unsigned* bar, unsigned x, unsigned& nloc, unsigned& nx) {
  const unsigned G = gridDim.x * gridDim.y * gridDim.z;
  unsigned sum, cnt, mine, sp = 0u;
  for (;;) {
    sum = 0u; cnt = 0u; mine = 0u;
#pragma unroll
    for (unsigned j = 0; j < 16; ++j) { const unsigned c = xb_ld(&bar[XB_XCNT(j)]); sum += c; cnt += (c > 0u) ? 1u : 0u; mine = (j == x) ? c : mine; }
    if (sum == G) break;
    __builtin_amdgcn_s_sleep(1);
    if ((++sp & 255u) == 0u) { if (xb_ld(&bar[XB_TMO])) break; if (sp > XB_SPIN_CAP) { atomicAdd(&bar[XB_TMO], 1u); break; } }
  }
  nloc = mine > 0u ? mine : 1u; nx = cnt > 0u ? cnt : 1u;
}
DI void xcd_barrier(const XcdBarrier& b) {
  asm volatile("s_waitcnt vmcnt(0)" ::: "memory");
  __syncthreads();
  if (threadIdx.x == 0) {
    unsigned* bar = b.bar;
    __builtin_amdgcn_s_waitcnt(0);
    unsigned nloc = b.st[0], nx = b.st[1];
    if (nloc == 0u) { xcd_barrier_complete(bar, b.x, nloc, nx); b.st[0] = nloc; b.st[1] = nx; }
    const unsigned old = xb_add(&bar[XB_XSUB(b.x)], 1u);
    const unsigned gen = old / nloc;
    if (old + 1u == (gen + 1u) * nloc) {
      __builtin_amdgcn_fence(__ATOMIC_RELEASE, "agent");
      asm volatile("s_waitcnt vmcnt(0)" ::: "memory");
      const unsigned og = xb_add(&bar[XB_TOP], 1u);
      const unsigned tg = og / nx;
      if (og + 1u == (tg + 1u) * nx) xb_add(&bar[XB_TOPGEN], 1u);
      else XB_SPIN(xb_ld(&bar[XB_TOPGEN]) == tg, bar);
      __builtin_amdgcn_fence(__ATOMIC_ACQUIRE, "agent");
      xb_add(&bar[XB_XGEN(b.x)], 1u);
      asm volatile("s_waitcnt vmcnt(0)" ::: "memory");
    } else {
      XB_SPIN(xb_ld(&bar[XB_XGEN(b.x)]) == gen, bar);
      __builtin_amdgcn_fence(__ATOMIC_ACQUIRE, "agent");
      asm volatile("s_waitcnt vmcnt(0)" ::: "memory");
    }
  }
  __syncthreads();
}

__global__ void __launch_bounds__(NTHR) mega(Params p) {
  extern __shared__ __attribute__((aligned(16))) char smem[];
  cg::grid_group grid = cg::this_grid();
  const int tid = threadIdx.x;
  bf16_t* H = (bf16_t*)(p.ws + OFF_H);
  bf16_t* PB = (bf16_t*)(p.ws + OFF_P);
  PG_LAS unsigned char* lds = (PG_LAS unsigned char*)smem;
  volatile XLAS unsigned* xst = (volatile XLAS unsigned*)(smem + 131072);
  if (tid < 2) xst[tid] = 0u;
  __syncthreads();
  const XcdBarrier xb = xcd_barrier_post((unsigned*)(p.ws + OFF_BAR), xst);

  for (int rep = 0; rep < REP_MISC; ++rep) {
  if (MASK & 1) phase_mod(p, smem);
  grid.sync();
  }
  for (int l = 0; l < 4; ++l) {
    const float* xcur = (l == 0) ? p.in[I_X] : p.out;
    for (int rep = 0; rep < REP_MISC; ++rep) {
    if (MASK & 2) phase_convert(p, l, smem);
    if (MASK & 4) phase_norm(p, xcur, p.in[I_N1G] + l * 1024, l, 1024, 0, H, nullptr);
    xcd_barrier(xb);
    }
    for (int rep = 0; rep < REP_G; ++rep) {
    if (MASK & 8) { pg::Order<1> S; S.init(NTOK, PSTR, gridDim.x, blockIdx.x); pg::EpiBf16<0> E{PB, PSTR, nullptr};
      pg::gemm_phase(lds, H, DM, (const bf16_t*)(p.ws + OFF_WIN), 1024, S, E); }
    xcd_barrier(xb);
    }
    for (int rep = 0; rep < REP_M1; ++rep) {
    for (int it = blockIdx.x; it < 5120; it += gridDim.x) {
      if (it < 2048) { if (MASK & 32) gdn_intra_item(p, l, it, smem); }
      else if (it < 3072) { }
      else if (it < 4096) { if (MASK & 128) lru_item(p, l, it - 3072, smem, 0); }
      else { if (MASK & 16) rw_prep_item(p, l, it - 4096, smem); }
      __syncthreads();
    }
    xcd_barrier(xb);
    }
    for (int rep = 0; rep < REP_M2; ++rep) {
    if (blockIdx.x < 128) {
      if (MASK & 16) rwkv_scan_item(p, l, blockIdx.x >> 3, (blockIdx.x >> 1) & 3, blockIdx.x & 1, smem);
    } else {
      if (blockIdx.x < 192) { if (MASK & 256) gdn_rec_item(p, l, (blockIdx.x - 128) >> 2, (blockIdx.x - 128) & 3, smem); }
      unsigned* ctr = (unsigned*)(p.ws + OFF_CTR) + l * 4 + rep;
      volatile int* slot = (volatile int*)(smem + 110016);
      for (;;) {
        __syncthreads();
        if (tid == 0) *slot = (int)atomicAdd(ctr, 1u);
        __syncthreads();
        const int it = *slot;
        if (it >= 2048) break;
        if (it < 1024) { if (MASK & 64) sb_item(p, it, smem); }
        else { if (MASK & 512) lru_item(p, l, it - 1024, smem, 1); }
      }
    }
    xcd_barrier(xb);
    }
    for (int rep = 0; rep < REP_G; ++rep) {
    for (int half = 0; half < 4; ++half) {
      bf16_t* BH = (bf16_t*)(p.ws + OFF_P + 134217728);
      if (half == 0 && rep == 0) { if (MASK & 16) rwkv_post(p, l); xcd_barrier(xb); }
      if (MASK & 1024) { pg::Order<1> S; S.init(NTOK / 4, 4096, gridDim.x, blockIdx.x, 0, 0, 2, 512); pg::EpiBf16<0> E{BH, 4096, nullptr};
        pg::gemm_phase(lds, (const bf16_t*)(p.ws + OFF_O) + (size_t)half * 16384 * DM, DM, (const bf16_t*)(p.ws + OFF_WBR), 256, S, E); }
      xcd_barrier(xb);
      if (MASK & 1024) { pg::Order<4> S; S.init(NTOK / 4, 1024, gridDim.x, blockIdx.x, 0, 2097152); pg::EpiGateMix E{PB + (size_t)half * 16384 * DM, (float*)(p.ws + OFF_G), BH, p.in[I_BGATE] + (size_t)l * 4096};
        pg::gemm_phase(lds, H + (size_t)half * 16384 * DM, DM, (const bf16_t*)(p.ws + OFF_WG), 1024, S, E); }
      xcd_barrier(xb);
    }
    }
    if (MASK & 2048) { pg::Order<1> S; S.init(NTOK, 1024, gridDim.x, blockIdx.x); pg::EpiResid E{xcur, p.out, (const float*)(p.ws + OFF_MODP), p.in[I_BADA], l, 2048};
      pg::gemm_phase(lds, PB, DM, (const bf16_t*)(p.ws + OFF_WO), 1024, S, E); }
    xcd_barrier(xb);
    for (int rep = 0; rep < REP_MISC; ++rep) {
    if (MASK & 4096) phase_norm(p, p.out, p.in[I_N2G] + l * 1024, l, 4096, 3072, H, nullptr);
    xcd_barrier(xb);
    }
    for (int rep = 0; rep < REP_G; ++rep) {
    if (MASK & 8192) { pg::Order<1> S; S.init(NTOK, FFN, gridDim.x, blockIdx.x); pg::EpiBf16<0> E{PB, FFN, nullptr};
      pg::gemm_phase(lds, H, DM, (const bf16_t*)(p.ws + OFF_WF), 1024, S, E); }
    xcd_barrier(xb);
    if (MASK & 8192) { pg::Order<1> S; S.init(NTOK, FFN, gridDim.x, blockIdx.x); pg::EpiFfnAct E{PB + (size_t)NTOK * FFN, PB, p.in[I_FCW] + (size_t)l * 3 * FFN};
      pg::gemm_phase(lds, H, DM, (const bf16_t*)(p.ws + OFF_WF) + (size_t)FFN * 1024, 1024, S, E); }
    xcd_barrier(xb);
    }
    if (MASK & 32768) { pg::Order<1> S; S.init(NTOK, 1024, gridDim.x, blockIdx.x); pg::EpiResid E{p.out, p.out, (const float*)(p.ws + OFF_MODP), p.in[I_BADA], l, 5120};
      pg::gemm_phase(lds, PB + (size_t)NTOK * FFN, FFN, (const bf16_t*)(p.ws + OFF_WD), FFN, S, E); }
    xcd_barrier(xb);
  }
  if (MASK & 65536) phase_norm(p, p.out, p.in[I_FG], 0, 0, 0, nullptr, p.out);
}

extern "C" void kernel_launch(void* const* d_in, const int* in_sizes, int n_in,
                              void* d_out, int out_size, void* d_ws, size_t ws_size,
                              hipStream_t stream) {
  if (ws_size < WS_NEED || n_in < 38) { fprintf(stderr, "workspace too small: %zu < %zu\n", ws_size, (size_t)WS_NEED); return; }
  (void)hipFuncSetAttribute((const void*)mega, hipFuncAttributeMaxDynamicSharedMemorySize, SMEM_BYTES);
  int dev = 0, cus = 0, per_cu = 0;
  (void)hipGetDevice(&dev);
  (void)hipDeviceGetAttribute(&cus, hipDeviceAttributeMultiprocessorCount, dev);
  (void)hipOccupancyMaxActiveBlocksPerMultiprocessor(&per_cu, mega, NTHR, SMEM_BYTES);
  if (per_cu < 1 || cus < 1) { fprintf(stderr, "occupancy query failed (%d, %d)\n", per_cu, cus); return; }
  if (cus > 256) cus = 256;
  const int grid_blocks = cus;
  Params p{};
  for (int i = 0; i < 38; ++i) p.in[i] = (const float*)d_in[i];
  p.out = (float*)d_out; p.ws = (char*)d_ws;
  (void)hipMemsetAsync((char*)d_ws + OFF_BAR, 0, XCD_BAR_WORDS * 4, stream);
  void* args[] = {&p};
  hipError_t e = hipLaunchCooperativeKernel((void*)mega, dim3(grid_blocks), dim3(NTHR), args, SMEM_BYTES, stream);
  if (e != hipSuccess) fprintf(stderr, "cooperative launch failed: %s (grid %d)\n", hipGetErrorString(e), grid_blocks);
}
```

```cpp
#include <hip/hip_runtime.h>
#include <hip/hip_cooperative_groups.h>
#include <cstdio>
namespace cg = cooperative_groups;

typedef unsigned short bf16_t;
typedef short bf16x8 __attribute__((ext_vector_type(8)));
typedef short s16x4 __attribute__((ext_vector_type(4)));
typedef float f32x4 __attribute__((ext_vector_type(4)));
typedef float f32x16 __attribute__((ext_vector_type(16)));
typedef unsigned u32x4 __attribute__((ext_vector_type(4)));
#define DI __device__ __forceinline__

constexpr int NTOK = 65536, DM = 1024, SEQ = 4096, PSTR = 3328, FFN = 2816, AUS = 5632;
constexpr int C_LRU_X = 0, C_LRU_Y = 256, C_SB_Q = 512, C_SB_K = 768, C_SB_V = 1024;
constexpr int C_GDN_Q = 1280, C_GDN_Z = 2048, C_GDN_A = 2304, C_GDN_B = 2308, C_RW = 2312;
constexpr float EPSF = 1e-6f;
#ifndef MASK
#define MASK 0x1ffff
#endif
#ifndef REP_M1
#define REP_M1 1
#endif
#ifndef REP_M2
#define REP_M2 1
#endif
#ifndef REP_G
#define REP_G 1
#endif
#ifndef REP_MISC
#define REP_MISC 1
#endif
constexpr int NTHR = 512;
constexpr int SMEM_BYTES = 131072 + 64;

constexpr size_t OFF_MODP = 0;
constexpr size_t OFF_WIN = 6291456;
constexpr size_t OFF_WG = OFF_WIN + 6815744;
constexpr size_t OFF_WBR = OFF_WG + 8388608;
constexpr size_t OFF_WO = OFF_WBR + 2097152;
constexpr size_t OFF_WF = OFF_WO + 2097152;
constexpr size_t OFF_WD = OFF_WF + 11534336;
constexpr size_t OFF_H = OFF_WD + 5767168;
constexpr size_t OFF_P = OFF_H + 134217728;
constexpr size_t OFF_O = OFF_P + 436207616;
constexpr size_t OFF_G = OFF_O + 134217728;
constexpr size_t GSZ = 33554432;
constexpr size_t OFF_GCD = OFF_G + 5 * GSZ;
constexpr size_t OFF_L = OFF_GCD + 16384;
constexpr size_t LSZ = 67108864;
constexpr size_t OFF_LCA = OFF_L + 2 * LSZ;
constexpr size_t OFF_LCH = OFF_LCA + 2097152;
constexpr size_t OFF_BON = OFF_LCH + 2097152;
constexpr size_t OFF_CTR = OFF_BON + 1048576;
constexpr size_t OFF_BAR = OFF_CTR + 256;
constexpr size_t WS_NEED = OFF_BAR + 16384;

struct Params { const float* in[38]; float* out; char* ws; };
enum { I_X = 0, I_C, I_N1G, I_N2G, I_FG, I_WADA, I_BADA, I_WIN, I_LCW, I_LCB, I_LWR, I_LBR, I_LWI, I_LBI, I_LLAM,
       I_GCW, I_GAL, I_GDT, I_GNG, I_RMU, I_RW0, I_RWUP, I_RA0, I_RAUP, I_RGUP, I_RKK, I_RKA, I_RRK, I_RLG, I_RLB,
       I_WBR, I_WGATE, I_BGATE, I_WOUT, I_FWG, I_FWU, I_FCW, I_FWD };

DI float bf2f(bf16_t v) { return __uint_as_float(((unsigned)v) << 16); }
DI unsigned pack2(float lo, float hi) { unsigned r; asm("v_cvt_pk_bf16_f32 %0, %1, %2" : "=v"(r) : "v"(lo), "v"(hi)); return r; }
DI bf16_t f2bf(float x) { return (bf16_t)(pack2(x, x) & 0xffffu); }
DI float sigmoidf_(float x) { return 1.f / (1.f + __expf(-x)); }
DI float sigmoid_rcp(float x) { return __builtin_amdgcn_rcpf(1.f + __expf(-x)); }
DI float gelu_rcp(float x) { float u = 0.7978845608f * (x + 0.044715f * x * x * x); return x * __builtin_amdgcn_rcpf(1.f + __expf(-2.f * u)); }
DI float softplusf_(float x) { return fmaxf(x, 0.f) + __logf(1.f + __expf(-fabsf(x))); }
DI float siluf_(float x) { return x / (1.f + __expf(-x)); }
DI float geluf_(float x) { float u = 0.7978845608f * (x + 0.044715f * x * x * x); return x / (1.f + __expf(-2.f * u)); }
DI float tanhf_(float x) { return 1.f - 2.f / (1.f + __expf(2.f * x)); }
DI float wave_sum(float x) {
#pragma unroll
  for (int o = 32; o >= 1; o >>= 1) x += __shfl_xor(x, o);
  return x;
}
template <int CTRL> DI float dppf(float x) { return __int_as_float(__builtin_amdgcn_update_dpp(0, __float_as_int(x), CTRL, 0xf, 0xf, true)); }
DI float reduce8(float x) { x += dppf<0xB1>(x); x += dppf<0x4E>(x); x += dppf<0x141>(x); return x; }
DI f32x16 mfma32(bf16x8 a, bf16x8 b, f32x16 c) { return __builtin_amdgcn_mfma_f32_32x32x16_bf16(a, b, c, 0, 0, 0); }
DI f32x4 mfma16(bf16x8 a, bf16x8 b, f32x4 c) { return __builtin_amdgcn_mfma_f32_16x16x32_bf16(a, b, c, 0, 0, 0); }
DI int crow(int i, int h) { return (i & 3) + 8 * (i >> 2) + 4 * h; }

DI float modv(const float* modp, const float* bada, int l, int b, int idx) {
  const float* q = modp + ((size_t)(l * 16 + b)) * 6144 + idx;
  const size_t ks = (size_t)4 * 16 * 6144;
  return bada[l * 6144 + idx] + q[0] + q[ks] + q[2 * ks] + q[3 * ks];
}

DI int otid() { int t = threadIdx.x; asm volatile("" : "+v"(t)); return t; }
DI int obid() { int b = blockIdx.x; asm volatile("" : "+s"(b)); return b; }
DI void phase_mod(const Params& p, char* smem) {
  float* sm = (float*)smem;
  float* modp = (float*)(p.ws + OFF_MODP);
  const int tid = otid();
  if (obid() == 0 && tid < 64) ((unsigned*)(p.ws + OFF_CTR))[tid] = 0u;
  for (int item = obid(); item < 192; item += gridDim.x) {
    const int l = item / 48, rem = item % 48, jb = rem >> 2, kq = rem & 3;
    for (int i = 0; i < 8; ++i) {
      int e = tid + 512 * i; int b = e >> 8, k = e & 255;
      float cv = p.in[I_C][b * 1024 + kq * 256 + k];
      sm[e] = siluf_(cv);
    }
    __syncthreads();
    float acc[16];
#pragma unroll
    for (int b = 0; b < 16; ++b) acc[b] = 0.f;
    const float* wp = p.in[I_WADA] + ((size_t)l * 1024 + kq * 256) * 6144 + jb * 512 + tid;
    for (int k = 0; k < 256; k += 4) {
      float w0 = wp[(size_t)k * 6144], w1 = wp[(size_t)(k + 1) * 6144], w2 = wp[(size_t)(k + 2) * 6144], w3 = wp[(size_t)(k + 3) * 6144];
#pragma unroll
      for (int b = 0; b < 16; ++b) {
        f32x4 cv = *(const f32x4*)(sm + b * 256 + k);
        acc[b] += cv[0] * w0 + cv[1] * w1 + cv[2] * w2 + cv[3] * w3;
      }
    }
#pragma unroll
    for (int b = 0; b < 16; ++b) modp[((size_t)((kq * 4 + l) * 16 + b)) * 6144 + jb * 512 + tid] = acc[b];
    __syncthreads();
  }
}

DI void conv_tile(const float* src, bf16_t* dst, int K, int N, int k0, int n0, char* smem) {
  float* tile = (float*)smem;
  const int tid = otid();
#pragma unroll
  for (int it = 0; it < 2; ++it) {
    int kr = (tid >> 4) + 32 * it, nc = (tid & 15) * 4;
    f32x4 v = {0.f, 0.f, 0.f, 0.f};
    if (n0 + nc < N) v = *(const f32x4*)(src + (size_t)(k0 + kr) * N + n0 + nc);
    tile[kr * 65 + nc] = v[0]; tile[kr * 65 + nc + 1] = v[1]; tile[kr * 65 + nc + 2] = v[2]; tile[kr * 65 + nc + 3] = v[3];
  }
  __syncthreads();
  {
    int n = tid >> 3, kc = (tid & 7) * 8;
    unsigned o[4];
#pragma unroll
    for (int e = 0; e < 4; ++e) o[e] = pack2(tile[(kc + 2 * e) * 65 + n], tile[(kc + 2 * e + 1) * 65 + n]);
    uint4 ov = {o[0], o[1], o[2], o[3]};
    *(uint4*)(dst + (size_t)(n0 + n) * K + k0 + kc) = ov;
  }
  __syncthreads();
}

DI void phase_convert(const Params& p, int l, char* smem) {
  for (int t = obid(); t < 4480; t += gridDim.x) {
    const float* src; bf16_t* dst; int K, N, Npad, tt = t;
    if (tt < 832) { src = p.in[I_WIN] + (size_t)l * 1024 * 3208; dst = (bf16_t*)(p.ws + OFF_WIN); K = 1024; N = 3208; Npad = 3328; }
    else if ((tt -= 832) < 1024) { int br = tt >> 8; tt &= 255; src = p.in[I_WGATE] + ((size_t)l * 4 + br) * 1048576; dst = (bf16_t*)(p.ws + OFF_WG) + (size_t)br * 1048576; K = 1024; N = 1024; Npad = 1024; }
    else if ((tt -= 1024) < 256) { int br = tt >> 6; tt &= 63; src = p.in[I_WBR] + ((size_t)l * 4 + br) * 262144; dst = (bf16_t*)(p.ws + OFF_WBR) + (size_t)br * 262144; K = 256; N = 1024; Npad = 1024; }
    else if ((tt -= 256) < 256) { src = p.in[I_WOUT] + (size_t)l * 1048576; dst = (bf16_t*)(p.ws + OFF_WO); K = 1024; N = 1024; Npad = 1024; }
    else if ((tt -= 256) < 704) { src = p.in[I_FWG] + (size_t)l * 1024 * 2816; dst = (bf16_t*)(p.ws + OFF_WF); K = 1024; N = 2816; Npad = 2816; }
    else if ((tt -= 704) < 704) { src = p.in[I_FWU] + (size_t)l * 1024 * 2816; dst = (bf16_t*)(p.ws + OFF_WF) + (size_t)2816 * 1024; K = 1024; N = 2816; Npad = 2816; }
    else { tt -= 704; src = p.in[I_FWD] + (size_t)l * 2816 * 1024; dst = (bf16_t*)(p.ws + OFF_WD); K = 2816; N = 1024; Npad = 1024; }
    const int nNt = Npad >> 6;
    const int kt = tt / nNt, nt = tt % nNt;
    conv_tile(src, dst, K, N, kt * 64, nt * 64, smem);
  }
}

DI void phase_norm(const Params& p, const float* xin, const float* g, int l, int scale_idx, int shift_idx, bf16_t* hout, float* fout) {
  const float* modp = (const float*)(p.ws + OFF_MODP);
  const int lane = otid() & 63, wv = otid() >> 6;
  const int nw = gridDim.x * 8;
  const int rows_per = 32;
  for (int chunk = obid() * 8 + wv; chunk < NTOK / 32; chunk += nw) {
  const int row0 = chunk * rows_per;
  const int b = row0 / SEQ;
  f32x4 gv[4], sc[4], sh[4];
#pragma unroll
  for (int j = 0; j < 4; ++j) {
    int c = lane * 4 + 256 * j;
    gv[j] = *(const f32x4*)(g + c);
    if (hout) {
#pragma unroll
      for (int e = 0; e < 4; ++e) {
        sc[j][e] = 1.f + modv(modp, p.in[I_BADA], l, b, scale_idx + c + e);
        sh[j][e] = modv(modp, p.in[I_BADA], l, b, shift_idx + c + e);
      }
    }
  }
  for (int rr = 0; rr < rows_per; ++rr) {
    const size_t row = (size_t)row0 + rr;
    f32x4 xv[4]; float ss = 0.f;
#pragma unroll
    for (int j = 0; j < 4; ++j) {
      xv[j] = *(const f32x4*)(xin + row * DM + lane * 4 + 256 * j);
      ss += xv[j][0] * xv[j][0] + xv[j][1] * xv[j][1] + xv[j][2] * xv[j][2] + xv[j][3] * xv[j][3];
    }
    ss = wave_sum(ss);
    const float rs = rsqrtf(ss * (1.f / 1024.f) + EPSF);
#pragma unroll
    for (int j = 0; j < 4; ++j) {
      f32x4 y = xv[j] * rs * gv[j];
      if (hout) {
        y = y * sc[j] + sh[j];
        uint2 o = {pack2(y[0], y[1]), pack2(y[2], y[3])};
        *(uint2*)(hout + row * DM + lane * 4 + 256 * j) = o;
      } else {
        *(f32x4*)(fout + row * DM + lane * 4 + 256 * j) = y;
      }
    }
  }
  }
}

#define PG_LAS __attribute__((address_space(3)))
namespace pg {
constexpr int BM = 256, BK = 64, HALF = 128, HTB = HALF * BK * 2, NXCD = 8, WGM = 8;
DI int lds_byte(int r, int c) { const int st = (r >> 4) * 2 + (c >> 5), rr = r & 15, cc = c & 31, ob = rr * 64 + cc * 2; return st * 1024 + (ob ^ (((ob >> 9) & 1) << 5)); }
DI void stage_rc(int b, int& R, int& C) { const int st = b / 1024, sb = b % 1024, swz = sb ^ (((sb >> 9) & 1) << 5); R = (st >> 1) * 16 + swz / 64; C = (st & 1) * 32 + (swz % 64) / 2; }
DI int perm32(int rho) { const int n = rho >> 4, i = rho & 15; return 8 * (i >> 2) + 4 * n + (i & 3); }
struct Unit { int pm, pn; int aux; long ao, bo; };
template <int REP> struct Order {
  int nM, nN, nwg, G, c, ashift; long astep, bstep, apnstep;
  DI void init(int M, int N, int G_, int c_, long astep_ = 0, long bstep_ = 0, int ashift_ = 0, long apnstep_ = 0) {
    nM = M / BM; nN = N / BM; nwg = nM * nN; G = G_; c = c_; astep = astep_; bstep = bstep_; ashift = ashift_; apnstep = apnstep_; }
  DI bool next(int i, Unit& u) const {
    const int ti = i / REP, aux = i % REP;
    const long L = (long)ti * G + c; if (L >= nwg) return false;
    int wgid = (int)L; { const int q = nwg / NXCD, r = nwg % NXCD, xcd = wgid % NXCD, off = wgid / NXCD; wgid = (xcd < r ? xcd * (q + 1) : r * (q + 1) + (xcd - r) * q) + off; }
    const int nig = WGM * nN, gid = wgid / nig, fm = gid * WGM, gsz = (nM - fm) < WGM ? (nM - fm) : WGM;
    u.pm = fm + ((wgid % nig) % gsz); u.pn = (wgid % nig) / gsz; u.aux = aux; u.ao = aux * astep + (long)(u.pn >> ashift) * apnstep; u.bo = aux * bstep; return true;
  }
};
DI unsigned cvt_pk_bf16(float lo, float hi) { unsigned r; asm volatile("v_cvt_pk_bf16_f32 %0, %1, %2" : "=v"(r) : "v"(lo), "v"(hi)); return r; }

template <class Epi, class Sched>
DI void gemm_phase(PG_LAS unsigned char* lds, const bf16_t* Ag, int lda, const bf16_t* Bg, int K, const Sched& S, const Epi& E) {
  const int tid = otid(), wid = __builtin_amdgcn_readfirstlane(tid >> 6), lane = tid & 63, wr = wid >> 2, wc = wid & 3, fr = lane & 15, fq = lane >> 4;
  const int nt = K / BK;
  unsigned voffA[2], voffB[2];
#pragma unroll
  for (int i = 0; i < 2; ++i) { int R, C; stage_rc(tid * 16 + i * 8192, R, C); const int Rb = Epi::PERM ? ((R & ~31) + perm32(R & 31)) : R;
    voffA[i] = (unsigned)(R * lda + C) * 2u; voffB[i] = (unsigned)(Rb * K + C) * 2u; }
  const size_t kstep = (size_t)(BK * 2);
  const size_t hstepA = (size_t)HALF * lda * 2, hstepB = (size_t)HALF * K * 2;
  const size_t tstepA = 2 * hstepA, tstepB = 2 * hstepB;
  const unsigned ldsw = (unsigned)wid * 1024u;
  const int aoff = lds_byte(wr * 64 + fr, fq * 8), boff = lds_byte(wc * 32 + fr, fq * 8);
#define PG_SA(b, h) (((b) * 2 + (h)) * HTB)
#define PG_SB(b, h) ((4 + (b) * 2 + (h)) * HTB)
#define PG_STAGE(bufoff, gbase, voff) do { _Pragma("unroll") for (int _i = 0; _i < 2; ++_i) \
    __builtin_amdgcn_global_load_lds((const unsigned*)((const char*)(gbase) + (voff)[_i]), (PG_LAS unsigned*)(lds + (bufoff) + ldsw + _i * 8192), 16, 0, 0); } while (0)
#define PG_LDA(dst, b, h) do { _Pragma("unroll") for (int m = 0; m < 4; ++m) _Pragma("unroll") for (int k = 0; k < 2; ++k) dst[m][k] = *(const PG_LAS bf16x8*)(lds + PG_SA(b, h) + aoff + m * 2048 + k * 1024); } while (0)
#define PG_LDB(dst, b, h) do { _Pragma("unroll") for (int n = 0; n < 2; ++n) _Pragma("unroll") for (int k = 0; k < 2; ++k) dst[n][k] = *(const PG_LAS bf16x8*)(lds + PG_SB(b, h) + boff + n * 2048 + k * 1024); } while (0)
#define PG_MMA(ai, bj, At, Bt) do { __builtin_amdgcn_s_setprio(1); _Pragma("unroll") for (int m = 0; m < 4; ++m) _Pragma("unroll") for (int n = 0; n < 2; ++n) _Pragma("unroll") for (int k = 0; k < 2; ++k) \
    acc[ai][bj][m][n] = __builtin_amdgcn_mfma_f32_16x16x32_bf16(Bt[n][k], At[m][k], acc[ai][bj][m][n], 0, 0, 0); __builtin_amdgcn_s_setprio(0); } while (0)
#define PG_WAIT_V(n) asm volatile("s_waitcnt vmcnt(" #n ")" ::: "memory")
#define PG_WAIT_L(n) asm volatile("s_waitcnt lgkmcnt(" #n ")" ::: "memory")
#define PG_BAR __builtin_amdgcn_s_barrier()
#define PG_SCHED __builtin_amdgcn_sched_barrier(0)
  Unit cur, nxt; int ui = 0;
  if (!S.next(0, cur)) return;
  f32x4 acc[2][2][4][2];
#pragma unroll
  for (int a = 0; a < 2; ++a)
#pragma unroll
    for (int b = 0; b < 2; ++b)
#pragma unroll
      for (int m = 0; m < 4; ++m)
#pragma unroll
        for (int n = 0; n < 2; ++n) acc[a][b][m][n] = (f32x4){0.f, 0.f, 0.f, 0.f};
  bf16x8 At[4][2], B0[2][2], B1[2][2];
  const char* cA = (const char*)Ag + (size_t)cur.pm * tstepA + cur.ao; const char* cB = (const char*)Bg + (size_t)cur.pn * tstepB + cur.bo;
  PG_STAGE(PG_SB(0, 0), cB, voffB); PG_STAGE(PG_SA(0, 0), cA, voffA); PG_STAGE(PG_SB(0, 1), cB + hstepB, voffB); PG_STAGE(PG_SA(0, 1), cA + hstepA, voffA);
  if (wr == 1) PG_BAR;
  PG_WAIT_V(4); PG_BAR;
  PG_STAGE(PG_SB(1, 0), cB + kstep, voffB); PG_STAGE(PG_SA(1, 0), cA + kstep, voffA); PG_STAGE(PG_SB(1, 1), cB + hstepB + kstep, voffB);
  PG_WAIT_V(6); PG_BAR;
  for (;;) {
    const bool has_next = S.next(ui + 1, nxt);
    const char* nA = has_next ? (const char*)Ag + (size_t)nxt.pm * tstepA + nxt.ao : cA; const char* nB = has_next ? (const char*)Bg + (size_t)nxt.pn * tstepB + nxt.bo : cB;
#pragma unroll 1
    for (int t = 0; t < nt; t += 2) {
      const bool last = (t == nt - 2);
      const char* a1 = cA + (size_t)(t + 1) * kstep;
      const char* a2 = last ? nA : cA + (size_t)(t + 2) * kstep; const char* b2 = last ? nB : cB + (size_t)(t + 2) * kstep;
      const char* a3 = a2 + kstep; const char* b3 = b2 + kstep;
      PG_LDB(B0, 0, 0); PG_SCHED; PG_LDA(At, 0, 0); PG_STAGE(PG_SA(1, 1), a1 + hstepA, voffA);
      PG_WAIT_L(8); PG_BAR; PG_WAIT_L(0); PG_MMA(0, 0, At, B0); PG_BAR; PG_SCHED;
      PG_LDB(B1, 0, 1); PG_STAGE(PG_SB(0, 0), b2, voffB);
      PG_BAR; PG_WAIT_L(0); PG_MMA(0, 1, At, B1); PG_BAR;
      PG_LDA(At, 0, 1); PG_STAGE(PG_SA(0, 0), a2, voffA);
      PG_BAR; PG_WAIT_L(0); PG_MMA(1, 0, At, B0); PG_BAR; PG_SCHED;
      PG_STAGE(PG_SB(0, 1), b2 + hstepB, voffB);
      PG_WAIT_V(6); PG_BAR; PG_MMA(1, 1, At, B1); PG_BAR;
      PG_LDB(B0, 1, 0); PG_SCHED; PG_LDA(At, 1, 0); PG_STAGE(PG_SA(0, 1), a2 + hstepA, voffA);
      PG_WAIT_L(8); PG_BAR; PG_WAIT_L(0); PG_MMA(0, 0, At, B0); PG_BAR; PG_SCHED;
      PG_LDB(B1, 1, 1); PG_STAGE(PG_SB(1, 0), b3, voffB);
      PG_BAR; PG_WAIT_L(0); PG_MMA(0, 1, At, B1); PG_BAR;
      PG_LDA(At, 1, 1); PG_STAGE(PG_SA(1, 0), a3, voffA);
      PG_BAR; PG_WAIT_L(0); PG_MMA(1, 0, At, B0); PG_BAR; PG_SCHED;
      PG_STAGE(PG_SB(1, 1), b3 + hstepB, voffB);
      PG_WAIT_V(6); PG_BAR; PG_MMA(1, 1, At, B1); PG_BAR;
    }
    E(acc, cur, wr, wc, fr, fq);
    if (!has_next) break;
#pragma unroll
    for (int a = 0; a < 2; ++a)
#pragma unroll
      for (int b = 0; b < 2; ++b)
#pragma unroll
        for (int m = 0; m < 4; ++m)
#pragma unroll
          for (int n = 0; n < 2; ++n) acc[a][b][m][n] = (f32x4){0.f, 0.f, 0.f, 0.f};
    cur = nxt; cA = nA; cB = nB; ++ui;
  }
  PG_WAIT_V(0);
  if (wr == 0) PG_BAR;
  PG_BAR;
#undef PG_SA
#undef PG_SB
#undef PG_STAGE
#undef PG_LDA
#undef PG_LDB
#undef PG_MMA
#undef PG_WAIT_V
#undef PG_WAIT_L
#undef PG_BAR
#undef PG_SCHED
}

template <int ACT> struct EpiBf16 {
  static constexpr bool PERM = true;
  bf16_t* O; int ldc; const float* bias;
  DI void operator()(const f32x4 (&acc)[2][2][4][2], const Unit& u, int wr, int wc, int fr, int fq) const {
    const int row0 = u.pm * BM + wr * 64 + fr, col0 = u.pn * BM + wc * 32 + 8 * fq;
    f32x4 bv[2][2];
#pragma unroll
    for (int bj = 0; bj < 2; ++bj)
#pragma unroll
      for (int n = 0; n < 2; ++n) bv[bj][n] = ACT ? *(const f32x4*)(bias + col0 + bj * HALF + 4 * n) : (f32x4){0.f, 0.f, 0.f, 0.f};
#pragma unroll
    for (int ai = 0; ai < 2; ++ai)
#pragma unroll
      for (int m = 0; m < 4; ++m) { bf16_t* rowp = O + (size_t)(row0 + ai * HALF + m * 16) * ldc + col0;
#pragma unroll
        for (int bj = 0; bj < 2; ++bj) { f32x4 v0 = acc[ai][bj][m][0] + bv[bj][0], v1 = acc[ai][bj][m][1] + bv[bj][1];
          if (ACT) {
#pragma unroll
            for (int j = 0; j < 4; ++j) { v0[j] = sigmoid_rcp(v0[j]); v1[j] = sigmoid_rcp(v1[j]); } }
          u32x4 w; w.x = cvt_pk_bf16(v0[0], v0[1]); w.y = cvt_pk_bf16(v0[2], v0[3]); w.z = cvt_pk_bf16(v1[0], v1[1]); w.w = cvt_pk_bf16(v1[2], v1[3]);
          *(u32x4*)(rowp + bj * HALF) = w; } }
  }
};
struct EpiBranch {
  static constexpr bool PERM = true;
  bf16_t* MIX; const bf16_t* G;
  DI void operator()(const f32x4 (&acc)[2][2][4][2], const Unit& u, int wr, int wc, int fr, int fq) const {
    const int row0 = u.pm * BM + wr * 64 + fr, col0 = u.pn * BM + wc * 32 + 8 * fq;
#pragma unroll
    for (int ai = 0; ai < 2; ++ai)
#pragma unroll
      for (int m = 0; m < 4; ++m) {
        asm volatile("" ::: "memory");
        const size_t row = (size_t)(row0 + ai * HALF + m * 16);
        bf16_t* mp = MIX + row * DM + col0; const bf16_t* gp = G + row * 4096 + u.aux * 1024 + col0;
#pragma unroll
        for (int bj = 0; bj < 2; ++bj) {
          const bf16x8 gv = *(const bf16x8*)(gp + bj * HALF);
          float o[8];
#pragma unroll
          for (int j = 0; j < 4; ++j) { o[j] = bf2f((bf16_t)gv[j]) * acc[ai][bj][m][0][j]; o[4 + j] = bf2f((bf16_t)gv[4 + j]) * acc[ai][bj][m][1][j]; }
          if (u.aux > 0) {
            const bf16x8 mv = *(const bf16x8*)(mp + bj * HALF);
#pragma unroll
            for (int j = 0; j < 8; ++j) o[j] += bf2f((bf16_t)mv[j]);
          }
          u32x4 w; w.x = cvt_pk_bf16(o[0], o[1]); w.y = cvt_pk_bf16(o[2], o[3]); w.z = cvt_pk_bf16(o[4], o[5]); w.w = cvt_pk_bf16(o[6], o[7]);
          *(u32x4*)(mp + bj * HALF) = w;
        }
      }
  }
};
struct EpiResid {
  static constexpr bool PERM = false;
  const float* xold; float* xnew; const float* modp; const float* bada; int l, gate_idx;
  DI void operator()(const f32x4 (&acc)[2][2][4][2], const Unit& u, int wr, int wc, int fr, int fq) const {
    const int row0 = u.pm * BM + wr * 64 + fr, col0 = u.pn * BM + wc * 32 + 4 * fq;
    const int b = (u.pm * BM) / SEQ;
    f32x4 gv[2][2];
#pragma unroll
    for (int bj = 0; bj < 2; ++bj)
#pragma unroll
      for (int n = 0; n < 2; ++n)
#pragma unroll
        for (int j = 0; j < 4; ++j) gv[bj][n][j] = modv(modp, bada, l, b, gate_idx + col0 + bj * HALF + n * 16 + j);
#pragma unroll
    for (int ai = 0; ai < 2; ++ai)
#pragma unroll
      for (int m = 0; m < 4; ++m) { const size_t ro = (size_t)(row0 + ai * HALF + m * 16) * DM + col0;
#pragma unroll
        for (int bj = 0; bj < 2; ++bj)
#pragma unroll
          for (int n = 0; n < 2; ++n) {
            const f32x4 xo = *(const f32x4*)(xold + ro + bj * HALF + n * 16);
            *(f32x4*)(xnew + ro + bj * HALF + n * 16) = xo + gv[bj][n] * acc[ai][bj][m][n];
          } }
  }
};
struct EpiFfnAct {
  static constexpr bool PERM = true;
  bf16_t* ACT; const bf16_t* APRE; const float* cw;
  DI void operator()(const f32x4 (&acc)[2][2][4][2], const Unit& u, int wr, int wc, int fr, int fq) const {
    const int row0 = u.pm * BM + wr * 64 + fr, col0 = u.pn * BM + wc * 32 + 8 * fq;
#pragma unroll
    for (int ai = 0; ai < 2; ++ai)
#pragma unroll
      for (int m = 0; m < 4; ++m) {
        asm volatile("" ::: "memory");
        const int row = row0 + ai * HALF + m * 16; const int sp = row & (SEQ - 1);
        const bf16_t* ap = APRE + (size_t)row * FFN + col0;
        bf16_t* op = ACT + (size_t)row * FFN + col0;
#pragma unroll
        for (int bj = 0; bj < 2; ++bj) {
          const int c = bj * HALF;
          const bf16x8 z8 = {0, 0, 0, 0, 0, 0, 0, 0};
          const bf16x8 a0 = *(const bf16x8*)(ap + c);
          const bf16x8 a1 = sp >= 1 ? *(const bf16x8*)(ap - FFN + c) : z8;
          const bf16x8 a2 = sp >= 2 ? *(const bf16x8*)(ap - 2 * FFN + c) : z8;
          float o[8];
#pragma unroll
          for (int hh = 0; hh < 2; ++hh) {
            const f32x4 w0 = *(const f32x4*)(cw + col0 + c + 4 * hh), w1 = *(const f32x4*)(cw + FFN + col0 + c + 4 * hh), w2 = *(const f32x4*)(cw + 2 * FFN + col0 + c + 4 * hh);
#pragma unroll
            for (int j = 0; j < 4; ++j) {
              const float cv = w0[j] * bf2f((bf16_t)a2[4 * hh + j]) + w1[j] * bf2f((bf16_t)a1[4 * hh + j]) + w2[j] * bf2f((bf16_t)a0[4 * hh + j]);
              o[4 * hh + j] = gelu_rcp(cv) * acc[ai][bj][m][hh][j];
            }
          }
          u32x4 w; w.x = cvt_pk_bf16(o[0], o[1]); w.y = cvt_pk_bf16(o[2], o[3]); w.z = cvt_pk_bf16(o[4], o[5]); w.w = cvt_pk_bf16(o[6], o[7]);
          *(u32x4*)(op + c) = w;
        }
      }
  }
};
struct EpiGateMix {
  static constexpr bool PERM = true;
  bf16_t* MIX; float* MIX32; const bf16_t* BH; const float* bias;
  DI void operator()(const f32x4 (&acc)[2][2][4][2], const Unit& u, int wr, int wc, int fr, int fq) const {
    const int row0 = u.pm * BM + wr * 64 + fr, col0 = u.pn * BM + wc * 32 + 8 * fq;
    const bool rmw = u.aux > 0, fin = u.aux == 3;
    f32x4 bv[2][2];
#pragma unroll
    for (int bj = 0; bj < 2; ++bj)
#pragma unroll
      for (int n = 0; n < 2; ++n) bv[bj][n] = *(const f32x4*)(bias + u.aux * 1024 + col0 + bj * HALF + 4 * n);
    const f32x4 z4 = {0.f, 0.f, 0.f, 0.f};
    bf16x8 nb[2]; f32x4 nm[2][2];
#define GM_LOAD(it_) { const size_t row_ = (size_t)(row0 + ((it_) >> 2) * HALF + ((it_) & 3) * 16); \
      _Pragma("unroll") for (int bj = 0; bj < 2; ++bj) { nb[bj] = *(const bf16x8*)(BH + row_ * 4096 + u.aux * 1024 + col0 + bj * HALF); \
        nm[bj][0] = rmw ? *(const f32x4*)(MIX32 + row_ * DM + col0 + bj * HALF) : z4; nm[bj][1] = rmw ? *(const f32x4*)(MIX32 + row_ * DM + col0 + bj * HALF + 4) : z4; } }
    GM_LOAD(0);
#pragma unroll
    for (int it = 0; it < 8; ++it) {
      const int ai = it >> 2, m = it & 3;
      bf16x8 cb[2]; f32x4 cm[2][2];
#pragma unroll
      for (int bj = 0; bj < 2; ++bj) { cb[bj] = nb[bj]; cm[bj][0] = nm[bj][0]; cm[bj][1] = nm[bj][1]; }
      if (it + 1 < 8) GM_LOAD(it + 1);
      const size_t ro = (size_t)(row0 + ai * HALF + m * 16) * DM + col0;
#pragma unroll
      for (int bj = 0; bj < 2; ++bj) {
        f32x4 o[2];
#pragma unroll
        for (int hh = 0; hh < 2; ++hh)
#pragma unroll
          for (int j = 0; j < 4; ++j)
            o[hh][j] = sigmoid_rcp(acc[ai][bj][m][hh][j] + bv[bj][hh][j]) * bf2f((bf16_t)cb[bj][4 * hh + j]) + cm[bj][hh][j];
        if (fin) {
          u32x4 w; w.x = cvt_pk_bf16(o[0][0], o[0][1]); w.y = cvt_pk_bf16(o[0][2], o[0][3]); w.z = cvt_pk_bf16(o[1][0], o[1][1]); w.w = cvt_pk_bf16(o[1][2], o[1][3]);
          *(u32x4*)(MIX + ro + bj * HALF) = w;
        } else {
          *(f32x4*)(MIX32 + ro + bj * HALF) = o[0]; *(f32x4*)(MIX32 + ro + bj * HALF + 4) = o[1];
        }
      }
    }
#undef GM_LOAD
  }
};
}

DI void phase_ffn_act(const Params& p, int l) {
  bf16_t* AU = (bf16_t*)(p.ws + OFF_P);
  const float* cw = p.in[I_FCW] + (size_t)l * 3 * FFN;
  const int nthr = gridDim.x * NTHR;
  for (int run = obid() * NTHR + otid(); run < 1024 * 352; run += nthr) {
    const int ch = run / 352, j8 = run % 352, j0 = j8 * 8;
    float w0[8], w1[8], w2[8];
#pragma unroll
    for (int e = 0; e < 8; ++e) { w0[e] = cw[j0 + e]; w1[e] = cw[FFN + j0 + e]; w2[e] = cw[2 * FFN + j0 + e]; }
    const int t0 = ch * 64, s0 = t0 % SEQ;
    float a1[8], a2[8];
#pragma unroll
    for (int e = 0; e < 8; ++e) { a1[e] = 0.f; a2[e] = 0.f; }
    if (s0 > 0) {
      bf16x8 v1 = *(const bf16x8*)(AU + (size_t)(t0 - 1) * AUS + j0);
      bf16x8 v2 = *(const bf16x8*)(AU + (size_t)(t0 - 2) * AUS + j0);
#pragma unroll
      for (int e = 0; e < 8; ++e) { a1[e] = bf2f((bf16_t)v1[e]); a2[e] = bf2f((bf16_t)v2[e]); }
    }
    for (int t = t0; t < t0 + 64; ++t) {
      bf16x8 va = *(const bf16x8*)(AU + (size_t)t * AUS + j0);
      bf16x8 vu = *(const bf16x8*)(AU + (size_t)t * AUS + FFN + j0);
      float o[8];
#pragma unroll
      for (int e = 0; e < 8; ++e) {
        float a0 = bf2f((bf16_t)va[e]);
        float cv = w0[e] * a2[e] + w1[e] * a1[e] + w2[e] * a0;
        o[e] = geluf_(cv) * bf2f((bf16_t)vu[e]);
        a2[e] = a1[e]; a1[e] = a0;
      }
      uint4 ov = {pack2(o[0], o[1]), pack2(o[2], o[3]), pack2(o[4], o[5]), pack2(o[6], o[7])};
      *(uint4*)(AU + (size_t)t * AUS + FFN + j0) = ov;
    }
  }
}

DI float mixf(bf16_t cur, bf16_t prev, float mu) { const float c = bf2f(cur); return c + (bf2f(prev) - c) * mu; }
DI void rw_prep_item(const Params& p, int l, int item, char* smem) {
  const bf16_t* P = (const bf16_t*)(p.ws + OFF_P);
  bf16_t* RD = (bf16_t*)(p.ws + OFF_L);
  bf16_t* RKK = (bf16_t*)(p.ws + OFF_L + GSZ);
  bf16_t* RA = (bf16_t*)(p.ws + OFF_L + 2 * GSZ);
  bf16_t* RG = (bf16_t*)(p.ws + OFF_L + 3 * GSZ);
  float* BON = (float*)(p.ws + OFF_BON);
  const int b = item >> 6, ct = item & 63;
  const int tid = otid(), lane = tid & 63, wv = tid >> 6, hd = wv & 3, mi = wv >> 2, r = lane & 31, h = lane >> 5;
  bf16_t* TX = (bf16_t*)smem;
  bf16_t* XA = TX + 64 * 40;
  bf16_t* SG = XA + 64 * 40;
  const float* mu = p.in[I_RMU] + (size_t)l * 896;
  const size_t tok0 = (size_t)b * SEQ + ct * 64;
  bf16x8 bw[2][2], ba[2][2], bg[2][4];
  {
    const float* wp = p.in[I_RWUP] + (size_t)l * 32 * 256 + hd * 64 + r;
    const float* ap = p.in[I_RAUP] + (size_t)l * 32 * 256 + hd * 64 + r;
    const float* gp = p.in[I_RGUP] + (size_t)l * 64 * 256 + hd * 64 + r;
    asm volatile("" : "+v"(wp), "+v"(ap), "+v"(gp));
#pragma unroll
    for (int ni = 0; ni < 2; ++ni) {
#pragma unroll
      for (int ks = 0; ks < 2; ++ks) {
        unsigned uw[4], ua[4];
#pragma unroll
        for (int j2 = 0; j2 < 4; ++j2) {
          const int k = 16 * ks + 8 * h + 2 * j2;
          uw[j2] = pack2(wp[k * 256 + 32 * ni], wp[(k + 1) * 256 + 32 * ni]);
          ua[j2] = pack2(ap[k * 256 + 32 * ni], ap[(k + 1) * 256 + 32 * ni]);
        }
        uint4 t1 = {uw[0], uw[1], uw[2], uw[3]}, t2 = {ua[0], ua[1], ua[2], ua[3]};
        bw[ni][ks] = __builtin_bit_cast(bf16x8, t1); ba[ni][ks] = __builtin_bit_cast(bf16x8, t2);
      }
#pragma unroll
      for (int ks = 0; ks < 4; ++ks) {
        unsigned ug[4];
#pragma unroll
        for (int j2 = 0; j2 < 4; ++j2) { const int k = 16 * ks + 8 * h + 2 * j2; ug[j2] = pack2(gp[k * 256 + 32 * ni], gp[(k + 1) * 256 + 32 * ni]); }
        uint4 t3 = {ug[0], ug[1], ug[2], ug[3]};
        bg[ni][ks] = __builtin_bit_cast(bf16x8, t3);
      }
    }
  }
#pragma unroll 4
  for (int i = 0; i < 16; ++i) {
    const int e = tid + NTHR * i; const int t = e >> 7, f = e & 127;
    const bf16_t* pr = P + (tok0 + t) * PSTR + C_RW + 768 + f;
    const bf16_t cur = pr[0];
    const bf16_t prev = (ct * 64 + t > 0) ? (pr - PSTR)[0] : (bf16_t)0;
    const float m = mixf(cur, prev, mu[768 + f]);
    if (f < 32) TX[t * 40 + f] = f2bf(tanhf_(m));
    else if (f < 64) XA[t * 40 + f - 32] = f2bf(m);
    else SG[t * 72 + f - 64] = f2bf(sigmoidf_(m));
  }
  __syncthreads();
  f32x16 cw[2], ca[2], cg[2];
#pragma unroll
  for (int ni = 0; ni < 2; ++ni)
#pragma unroll
    for (int i = 0; i < 16; ++i) { cw[ni][i] = 0.f; ca[ni][i] = 0.f; cg[ni][i] = 0.f; }
#pragma unroll
  for (int ks = 0; ks < 2; ++ks) {
    const bf16x8 atx = *(const bf16x8*)(TX + (32 * mi + r) * 40 + 16 * ks + 8 * h);
    const bf16x8 axa = *(const bf16x8*)(XA + (32 * mi + r) * 40 + 16 * ks + 8 * h);
#pragma unroll
    for (int ni = 0; ni < 2; ++ni) { cw[ni] = mfma32(atx, bw[ni][ks], cw[ni]); ca[ni] = mfma32(axa, ba[ni][ks], ca[ni]); }
  }
#pragma unroll
  for (int ks = 0; ks < 4; ++ks) {
    const bf16x8 asg = *(const bf16x8*)(SG + (32 * mi + r) * 72 + 16 * ks + 8 * h);
#pragma unroll
    for (int ni = 0; ni < 2; ++ni) cg[ni] = mfma32(asg, bg[ni][ks], cg[ni]);
  }
  float ss[16], bn[16];
#pragma unroll
  for (int i = 0; i < 16; ++i) { ss[i] = 0.f; bn[i] = 0.f; }
#pragma unroll
  for (int ni = 0; ni < 2; ++ni) {
    const int hc = hd * 64 + 32 * ni + r;
    const float w0c = p.in[I_RW0][l * 256 + hc], a0c = p.in[I_RA0][l * 256 + hc], kkc = p.in[I_RKK][l * 256 + hc],
                kac = p.in[I_RKA][l * 256 + hc], rkc = p.in[I_RRK][l * 256 + hc], mu_r = mu[hc], mu_k = mu[256 + hc];
#pragma unroll
    for (int i = 0; i < 16; ++i) {
      const int tl = 32 * mi + crow(i, h);
      const size_t tok = tok0 + tl;
      const bf16_t* pr = P + tok * PSTR + C_RW + hc;
      const bool hp = (ct * 64 + tl) > 0;
      const float rr = mixf(pr[0], hp ? (pr - PSTR)[0] : (bf16_t)0, mu_r);
      const float k = mixf(pr[256], hp ? (pr - PSTR)[256] : (bf16_t)0, mu_k);
      const float wl = w0c + cw[ni][i];
      const float wlog = -softplusf_(-wl) - 0.5f;
      const float dd = 1.f - __expf(-__expf(wlog));
      const float a = sigmoidf_(a0c + ca[ni][i]);
      const float kkr = k * kkc;
      const float kp = k * (1.f + (a - 1.f) * kac);
      ss[i] += kkr * kkr; bn[i] += rr * kp * rkc;
      cw[ni][i] = kkr;
      RD[tok * 256 + hc] = f2bf(dd); RA[tok * 256 + hc] = f2bf(a); RG[tok * 256 + hc] = f2bf(cg[ni][i]);
    }
  }
#pragma unroll
  for (int i = 0; i < 16; ++i) {
#pragma unroll
    for (int o = 1; o < 32; o <<= 1) { ss[i] += __shfl_xor(ss[i], o); bn[i] += __shfl_xor(bn[i], o); }
    ss[i] = rsqrtf(ss[i] + EPSF);
  }
#pragma unroll
  for (int ni = 0; ni < 2; ++ni) {
    const int hc = hd * 64 + 32 * ni + r;
#pragma unroll
    for (int i = 0; i < 16; ++i) {
      const size_t tok = tok0 + 32 * mi + crow(i, h);
      RKK[tok * 256 + hc] = f2bf(cw[ni][i] * ss[i]);
    }
  }
  if (r == 0) {
#pragma unroll
    for (int i = 0; i < 16; ++i) BON[(tok0 + 32 * mi + crow(i, h)) * 4 + hd] = bn[i];
  }
}

DI void rwkv_scan_item(const Params& p, int l, int b, int hd, int half, char* smem) {
  const bf16_t* P = (const bf16_t*)(p.ws + OFF_P);
  bf16_t* O = (bf16_t*)(p.ws + OFF_O);
  const bf16_t* RD = (const bf16_t*)(p.ws + OFF_L);
  const bf16_t* RKK = (const bf16_t*)(p.ws + OFF_L + GSZ);
  const bf16_t* RA = (const bf16_t*)(p.ws + OFF_L + 2 * GSZ);
  float* fb = (float*)smem;
  float* Yb = fb + 2 * 6208;
  const int tid = otid(), lane = tid & 63, wv = tid >> 6;
  const int hc = hd * 64 + lane;
  constexpr int NCH = SEQ / 16;
  float S[8];
#pragma unroll
  for (int j = 0; j < 8; ++j) S[j] = 0.f;
  const int rl = lane >> 3, kq = lane & 7, vloc = (wv & 3) * 8 + rl, vrow = half * 32 + vloc;
  const float* mu = p.in[I_RMU] + (size_t)l * 896;
  const float mu_r = mu[hc], mu_k = mu[256 + hc], mu_v = mu[512 + hc];
  const float kac = p.in[I_RKA][l * 256 + hc];
  const int pw = wv & 3;
  unsigned raw[4][9];
#pragma unroll
  for (int j = 0; j < 4; ++j)
#pragma unroll
    for (int e = 0; e < 9; ++e) raw[j][e] = 0u;
#define RAWLOAD(i_)                                                                                 \
  {                                                                                                 \
    _Pragma("unroll") for (int j = 0; j < 4; ++j) {                                                 \
      const int s_ = (i_) * 16 + pw * 4 + j;                                                        \
      const size_t tok_ = (size_t)b * SEQ + s_;                                                     \
      const bf16_t* pr_ = P + tok_ * PSTR + C_RW;                                                   \
      raw[j][0] = pr_[hc]; raw[j][1] = pr_[256 + hc]; raw[j][2] = pr_[512 + hc];                    \
      if (s_ > 0) { raw[j][3] = (pr_ - PSTR)[hc]; raw[j][4] = (pr_ - PSTR)[256 + hc]; raw[j][5] = (pr_ - PSTR)[512 + hc]; } \
      else { raw[j][3] = 0u; raw[j][4] = 0u; raw[j][5] = 0u; }                                      \
      raw[j][6] = RD[tok_ * 256 + hc]; raw[j][7] = RKK[tok_ * 256 + hc]; raw[j][8] = RA[tok_ * 256 + hc]; \
    }                                                                                               \
  }
#define RBAR() { asm volatile("s_waitcnt lgkmcnt(0)" ::: "memory"); __builtin_amdgcn_s_barrier(); asm volatile("" ::: "memory"); }
  if (wv >= 4) RAWLOAD(0);
#pragma unroll 1
  for (int i = 0; i < NCH + 2; ++i) {
    if (wv >= 4) {
      float* B = fb + (i & 1) * 6208;
      if (i >= 2) {
        const float* Yc = Yb + (i & 1) * 512;
        if (lane < 32) {
#pragma unroll
          for (int j = 0; j < 4; ++j) {
            const int tl = pw * 4 + j;
            const size_t tok = (size_t)b * SEQ + (i - 2) * 16 + tl;
            O[tok * DM + 768 + hd * 64 + half * 32 + lane] = f2bf(Yc[tl * 32 + lane]);
          }
        }
      }
      if (i < NCH) {
#pragma unroll
        for (int j = 0; j < 4; ++j) {
          const int tl = pw * 4 + j;
          const float r = mixf((bf16_t)raw[j][0], (bf16_t)raw[j][3], mu_r), k = mixf((bf16_t)raw[j][1], (bf16_t)raw[j][4], mu_k), v = mixf((bf16_t)raw[j][2], (bf16_t)raw[j][5], mu_v);
          const float w = 1.f - bf2f((bf16_t)raw[j][6]), kk = bf2f((bf16_t)raw[j][7]), a = bf2f((bf16_t)raw[j][8]);
          const float ka = kk * a, kp = k * (1.f + (a - 1.f) * kac);
          const float c1 = wave_sum(ka * r), c2 = wave_sum(kp * r);
          B[tl * 64 + lane] = w; B[1024 + tl * 64 + lane] = kk; B[2048 + tl * 64 + lane] = ka; B[3072 + tl * 64 + lane] = kp;
          B[4096 + tl * 64 + lane] = w * r; B[5120 + tl * 64 + lane] = v;
          if (lane == 0) { B[6144 + tl * 2] = c1; B[6144 + tl * 2 + 1] = c2; }
        }
        if (i + 1 < NCH) RAWLOAD(i + 1);
      }
    } else if (i >= 1 && i <= NCH) {
      const float* B = fb + ((i - 1) & 1) * 6208;
      float* Yc = Yb + ((i - 1) & 1) * 512;
      f32x4 vw[2][10]; float vvv[2]; float2 vsc[2];
#define RWLD(t_, s_)                                                                              \
      { const float* bt_ = B + (t_) * 64 + kq * 8;                                                 \
        _Pragma("unroll") for (int q_ = 0; q_ < 5; ++q_) { vw[s_][2 * q_] = *(const f32x4*)(bt_ + 1024 * q_); vw[s_][2 * q_ + 1] = *(const f32x4*)(bt_ + 1024 * q_ + 4); } \
        vvv[s_] = B[5120 + (t_) * 64 + vrow]; vsc[s_] = *(const float2*)(B + 6144 + (t_) * 2); }
      RWLD(0, 0);
#pragma unroll
      for (int t = 0; t < 16; ++t) {
        const int cs = t & 1;
        if (t + 1 < 16) RWLD(t + 1, cs ^ 1);
        const f32x4 w0 = vw[cs][0], w1 = vw[cs][1], kk0 = vw[cs][2], kk1 = vw[cs][3], ka0 = vw[cs][4], ka1 = vw[cs][5],
                    kp0 = vw[cs][6], kp1 = vw[cs][7], wr0 = vw[cs][8], wr1 = vw[cs][9];
        const float vv = vvv[cs]; const float2 sc = vsc[cs];
        float d0 = 0.f, e0 = 0.f;
#pragma unroll
        for (int j = 0; j < 4; ++j) { d0 += S[j] * kk0[j] + S[j + 4] * kk1[j]; e0 += S[j] * wr0[j] + S[j + 4] * wr1[j]; }
        d0 = reduce8(d0); e0 = reduce8(e0);
        const float sa0 = -d0;
        const float y0 = e0 + sa0 * sc.x + vv * sc.y;
#pragma unroll
        for (int j = 0; j < 4; ++j) {
          S[j] = S[j] * w0[j] + sa0 * ka0[j] + vv * kp0[j]; S[j + 4] = S[j + 4] * w1[j] + sa0 * ka1[j] + vv * kp1[j];
        }
        if (kq == 0) Yc[t * 32 + vloc] = y0;
      }
#undef RWLD
    }
    RBAR();
  }
#undef RAWLOAD
#undef RBAR
}

DI void rwkv_post(const Params& p, int l) {
  const bf16_t* P = (const bf16_t*)(p.ws + OFF_P);
  bf16_t* O = (bf16_t*)(p.ws + OFF_O);
  const bf16_t* RG = (const bf16_t*)(p.ws + OFF_L + 3 * GSZ);
  const float* BON = (const float*)(p.ws + OFF_BON);
  const int tid = otid(), lane = tid & 63, wv = tid >> 6;
  const float* mu = p.in[I_RMU] + (size_t)l * 896;
  const int nw = gridDim.x * 8;
  for (int task0 = (obid() * 8 + wv) * 4; task0 < NTOK * 4; task0 += nw * 4) {
    float yv[4], vv[4], gv[4], bv[4];
#pragma unroll
    for (int q = 0; q < 4; ++q) {
      const int task = task0 + q; const size_t tok = task >> 2; const int hd = task & 3, hc = hd * 64 + lane;
      yv[q] = bf2f(O[tok * DM + 768 + hc]);
      const bf16_t cur = P[tok * PSTR + C_RW + 512 + hc];
      const bf16_t prev = (tok % SEQ) ? P[(tok - 1) * PSTR + C_RW + 512 + hc] : (bf16_t)0;
      vv[q] = mixf(cur, prev, mu[512 + hc]);
      gv[q] = bf2f(RG[tok * 256 + hc]); bv[q] = BON[tok * 4 + hd];
    }
#pragma unroll
    for (int q = 0; q < 4; ++q) {
      const int task = task0 + q; const size_t tok = task >> 2; const int hd = task & 3, hc = hd * 64 + lane;
      const float mean = wave_sum(yv[q]) * (1.f / 64.f);
      const float d = yv[q] - mean;
      const float var = wave_sum(d * d) * (1.f / 64.f);
      const float yn = d * rsqrtf(var + 64e-5f) * p.in[I_RLG][l * 256 + hc] + p.in[I_RLB][l * 256 + hc];
      O[tok * DM + 768 + hc] = f2bf((yn + bv[q] * vv[q]) * gv[q]);
    }
  }
}

DI void sb_item(const Params& p, int item, char* smem) {
  const bf16_t* P = (const bf16_t*)(p.ws + OFF_P);
  bf16_t* O = (bf16_t*)(p.ws + OFF_O);
  const int qt = item & 15, hd = (item >> 4) & 3, b = item >> 6;
  const int tid = otid(), lane = tid & 63, wv = tid >> 6, r = lane & 31, h = lane >> 5;
  bf16_t* Vt = (bf16_t*)(smem + wv * 8704);
  const int q0 = qt * 256 + wv * 32;
  const int sq = q0 + r;
  const size_t tokb = (size_t)b * SEQ;
  bf16x8 qf[4];
#pragma unroll
  for (int ks = 0; ks < 4; ++ks) qf[ks] = *(const bf16x8*)(P + (tokb + sq) * PSTR + C_SB_Q + hd * 64 + ks * 16 + h * 8);
  f32x16 accO[2];
#pragma unroll
  for (int i = 0; i < 16; ++i) { accO[0][i] = 0.f; accO[1][i] = 0.f; }
  float Prun = 1.f;
  bf16x8 kf[2][4];
  const int kt0 = (q0 + 31) >> 6;
#define SBKLOAD(kt_) { _Pragma("unroll") for (int m = 0; m < 2; ++m) _Pragma("unroll") for (int ks = 0; ks < 4; ++ks) \
    kf[m][ks] = *(const bf16x8*)(P + (tokb + (kt_) * 64 + 32 * m + r) * PSTR + C_SB_K + hd * 64 + ks * 16 + h * 8); }
  SBKLOAD(kt0);
  for (int kt = kt0; kt >= 0; --kt) {
    const int k0 = kt * 64;
    bf16x8 vr[8];
#pragma unroll
    for (int it = 0; it < 8; ++it) vr[it] = *(const bf16x8*)(P + (tokb + k0 + it * 8 + (lane >> 3)) * PSTR + C_SB_V + hd * 64 + (lane & 7) * 8);
    f32x16 acc[2];
#pragma unroll
    for (int m = 0; m < 2; ++m) {
#pragma unroll
      for (int i = 0; i < 16; ++i) acc[m][i] = 0.f;
#pragma unroll
      for (int ks = 0; ks < 4; ++ks) acc[m] = mfma32(kf[m][ks], qf[ks], acc[m]);
    }
    if (kt > 0) SBKLOAD(kt - 1);
    float om[2][16];
#pragma unroll
    for (int m = 0; m < 2; ++m)
#pragma unroll
      for (int i = 0; i < 16; ++i) {
        const int key = k0 + 32 * m + crow(i, h);
        const float z = fmaxf(acc[m][i] * 0.125f, -80.f);
        const float e = __expf(-z);
        const float sg = __builtin_amdgcn_rcpf(1.f + e);
        const bool valid = key < sq;
        acc[m][i] = valid ? sg : 0.f;
        om[m][i] = valid ? e * sg : 1.f;
      }
    float gp[8];
#pragma unroll
    for (int q = 0; q < 8; ++q) {
      const int m = q >> 2, g = q & 3;
      gp[q] = (om[m][4 * g] * om[m][4 * g + 1]) * (om[m][4 * g + 2] * om[m][4 * g + 3]);
    }
    float run = 1.f;
#pragma unroll
    for (int q = 7; q >= 0; --q) {
      const int m = q >> 2, g = q & 3;
      const float pg = __shfl_xor(gp[q], 32);
      const float f3 = Prun * run * (h == 0 ? pg : 1.f);
      const float f2 = f3 * om[m][4 * g + 3], f1 = f2 * om[m][4 * g + 2], f0 = f1 * om[m][4 * g + 1];
      acc[m][4 * g + 3] *= f3; acc[m][4 * g + 2] *= f2; acc[m][4 * g + 1] *= f1; acc[m][4 * g + 0] *= f0;
      run *= gp[q] * pg;
    }
    Prun *= run;
    __builtin_amdgcn_wave_barrier();
#pragma unroll
    for (int it = 0; it < 8; ++it) {
      const int key = it * 8 + (lane >> 3), chv = lane & 7;
#pragma unroll
      for (int e = 0; e < 8; ++e) Vt[(chv * 8 + e) * 68 + key] = (bf16_t)vr[it][e];
    }
    __builtin_amdgcn_wave_barrier();
#pragma unroll
    for (int m = 0; m < 2; ++m)
#pragma unroll
      for (int s2 = 0; s2 < 2; ++s2) {
        uint4 uu = {pack2(acc[m][8 * s2 + 0], acc[m][8 * s2 + 1]), pack2(acc[m][8 * s2 + 2], acc[m][8 * s2 + 3]),
                    pack2(acc[m][8 * s2 + 4], acc[m][8 * s2 + 5]), pack2(acc[m][8 * s2 + 6], acc[m][8 * s2 + 7])};
        const bf16x8 pb = __builtin_bit_cast(bf16x8, uu);
#pragma unroll
        for (int dt = 0; dt < 2; ++dt) {
          const bf16_t* vp = Vt + (32 * dt + r) * 68 + 32 * m + 16 * s2 + 4 * h;
          s16x4 lo = *(const s16x4*)vp, hi = *(const s16x4*)(vp + 8);
          bf16x8 va = __builtin_shufflevector(lo, hi, 0, 1, 2, 3, 4, 5, 6, 7);
          accO[dt] = mfma32(va, pb, accO[dt]);
        }
      }
    __builtin_amdgcn_wave_barrier();
    if (__ballot(Prun > 1e-37f) == 0ull) break;
  }
#undef SBKLOAD
#pragma unroll
  for (int dt = 0; dt < 2; ++dt)
#pragma unroll
    for (int g = 0; g < 4; ++g) {
      const int d = 32 * dt + 8 * g + 4 * h;
      uint2 o = {pack2(accO[dt][4 * g], accO[dt][4 * g + 1]), pack2(accO[dt][4 * g + 2], accO[dt][4 * g + 3])};
      *(uint2*)(O + (tokb + sq) * DM + 256 + hd * 64 + d) = o;
    }
}

DI int frag_off(int row, int k) {
  const int rt = row >> 4, fr = row & 15, ks = k >> 5, kk = k & 31, hi = kk >> 4, fq = (kk & 15) >> 2, j = (kk & 3) + 4 * hi;
  return ((rt * 2 + ks) * 64 + fq * 16 + fr) * 8 + j;
}
DI int frag_off8(int row, int k0) {
  const int rt = row >> 4, fr = row & 15, ks = k0 >> 5, kk = k0 & 31, hi = kk >> 4, fq = (kk & 15) >> 2;
  return ((rt * 2 + ks) * 64 + fq * 16 + fr) * 8 + 4 * hi;
}
DI void gdn_intra_item(const Params& p, int l, int item, char* smem) {
  const bf16_t* P = (const bf16_t*)(p.ws + OFF_P);
  const int hp = item & 1, c = (item >> 1) & 63, b = item >> 7;
  const int tid = otid(), lane = tid & 63;
  bf16_t* Kb = (bf16_t*)smem;
  bf16_t* Qb = Kb + 2 * 64 * 72;
  bf16_t* Vb = Qb + 2 * 64 * 72;
  float* Lm = (float*)(smem + 3 * 2 * 64 * 72 * 2);
  float* Gs = Lm + 2 * 4096;
  float* Bs = Gs + 128;
  const size_t tok0 = (size_t)b * SEQ + c * 64;
  const float* cw = p.in[I_GCW] + (size_t)l * 4 * 768;
  float* CW = Bs + 128;
  for (int e = tid; e < 6 * 4 * 64; e += NTHR) {
    const int blk = e >> 8, j = (e >> 6) & 3, col = e & 63;
    const int hh_ = blk / 3, which_ = blk % 3;
    CW[e] = cw[j * 768 + which_ * 256 + (hp * 2 + hh_) * 64 + col];
  }
  __syncthreads();
  {
    const int t = tid >> 3, cg = tid & 7;
#pragma unroll 3
    for (int it = 0; it < 6; ++it) {
      const int hh = it / 3, which = it % 3, head = hp * 2 + hh;
      const int ccol = which * 256 + head * 64 + cg * 8;
      float acc[8];
#pragma unroll
      for (int e = 0; e < 8; ++e) acc[e] = 0.f;
#pragma unroll
      for (int j = 0; j < 4; ++j) {
        const int s = c * 64 + t - 3 + j;
        if (s >= 0) {
          bf16x8 xv = *(const bf16x8*)(P + ((size_t)b * SEQ + s) * PSTR + C_GDN_Q + ccol);
          f32x4 wa = *(const f32x4*)(CW + (it * 4 + j) * 64 + cg * 8), wb = *(const f32x4*)(CW + (it * 4 + j) * 64 + cg * 8 + 4);
#pragma unroll
          for (int e = 0; e < 4; ++e) { acc[e] += wa[e] * bf2f((bf16_t)xv[e]); acc[e + 4] += wb[e] * bf2f((bf16_t)xv[e + 4]); }
        }
      }
      float ss = 0.f;
#pragma unroll
      for (int e = 0; e < 8; ++e) { acc[e] = siluf_(acc[e]); ss += acc[e] * acc[e]; }
      ss += __shfl_xor(ss, 1); ss += __shfl_xor(ss, 2); ss += __shfl_xor(ss, 4);
      float sc = 1.f;
      if (which == 0) sc = rsqrtf(ss + EPSF) * 0.125f;
      else if (which == 1) sc = rsqrtf(ss + EPSF);
      uint4 ov = {pack2(acc[0] * sc, acc[1] * sc), pack2(acc[2] * sc, acc[3] * sc), pack2(acc[4] * sc, acc[5] * sc), pack2(acc[6] * sc, acc[7] * sc)};
      bf16_t* dst = (which == 0 ? Qb : (which == 1 ? Kb : Vb)) + (hh * 64 + t) * 72 + cg * 8;
      *(uint4*)dst = ov;
    }
  }
  if (tid < 128) {
    const int hh = tid >> 6, t = lane, head = hp * 2 + hh;
    const float a_in = bf2f(P[(tok0 + t) * PSTR + C_GDN_A + head]);
    const float b_in = bf2f(P[(tok0 + t) * PSTR + C_GDN_B + head]);
    const float beta = sigmoidf_(b_in);
    float g = -__expf(p.in[I_GAL][l * 4 + head]) * softplusf_(a_in + p.in[I_GDT][l * 4 + head]);
#pragma unroll
    for (int d = 1; d < 64; d <<= 1) { float v = __shfl_up(g, d); if (lane >= d) g += v; }
    Gs[hh * 64 + t] = g; Bs[hh * 64 + t] = beta;
  }
  __syncthreads();
  const int hh = tid >> 8, lt = tid & 255, head = hp * 2 + hh;
  const size_t ih = ((size_t)(b * 4 + head)) * 64 + c;
  bf16_t* GW = (bf16_t*)(p.ws + OFF_G) + ih * 4096;
  bf16_t* GQD = (bf16_t*)(p.ws + OFF_G + GSZ) + ih * 4096;
  bf16_t* GQK = (bf16_t*)(p.ws + OFF_G + 2 * GSZ) + ih * 4096;
  bf16_t* GKD = (bf16_t*)(p.ws + OFF_G + 3 * GSZ) + ih * 4096;
  bf16_t* GU = (bf16_t*)(p.ws + OFF_G + 4 * GSZ) + ih * 4096;
  float* GCD = (float*)(p.ws + OFF_GCD);
  const float* Gh = Gs + hh * 64; const float* Bh = Bs + hh * 64;
  {
    const int wq = (tid >> 6) & 3, ti = wq >> 1, tj = wq & 1, r = lane & 31, h = lane >> 5;
    f32x16 akk, aqk;
#pragma unroll
    for (int i = 0; i < 16; ++i) { akk[i] = 0.f; aqk[i] = 0.f; }
    if (ti >= tj) {
#pragma unroll
      for (int ks = 0; ks < 4; ++ks) {
        bf16x8 ka = *(const bf16x8*)(Kb + (hh * 64 + 32 * ti + r) * 72 + ks * 16 + h * 8);
        bf16x8 qa = *(const bf16x8*)(Qb + (hh * 64 + 32 * ti + r) * 72 + ks * 16 + h * 8);
        bf16x8 kb = *(const bf16x8*)(Kb + (hh * 64 + 32 * tj + r) * 72 + ks * 16 + h * 8);
        akk = mfma32(ka, kb, akk);
        aqk = mfma32(qa, kb, aqk);
      }
    }
    const int j = 32 * tj + r;
    const float Gj = Gh[j];
#pragma unroll
    for (int i_ = 0; i_ < 16; ++i_) {
      const int i = 32 * ti + crow(i_, h);
      const float dec = (i >= j) ? __expf(Gh[i] - Gj) : 0.f;
      Lm[hh * 4096 + i * 64 + j] = (i > j) ? Bh[i] * akk[i_] * dec : 0.f;
      GQK[frag_off(i, j)] = f2bf((i >= j) ? aqk[i_] * dec : 0.f);
    }
  }
  __syncthreads();
  if (lt < 128) {
    const int cc = lt;
    float x[64];
    if (cc < 64) {
#pragma unroll
      for (int i = 0; i < 64; ++i) x[i] = bf2f(Vb[(hh * 64 + i) * 72 + cc]) * Bh[i];
    } else {
#pragma unroll
      for (int i = 0; i < 64; ++i) x[i] = bf2f(Kb[(hh * 64 + i) * 72 + cc - 64]) * Bh[i] * __expf(Gh[i]);
    }
    const float* Lh = Lm + hh * 4096;
#pragma unroll
    for (int i = 1; i < 64; ++i) {
      float s = x[i];
#pragma unroll
      for (int j4 = 0; j4 < (i + 3) / 4; ++j4) {
        const f32x4 lv = *(const f32x4*)(Lh + i * 64 + j4 * 4);
#pragma unroll
        for (int e = 0; e < 4; ++e) if (j4 * 4 + e < i) s -= lv[e] * x[j4 * 4 + e];
      }
      x[i] = s;
    }
    if (cc < 64) {
      const int split = cc >> 4, fr = cc & 15;
#pragma unroll
      for (int i4 = 0; i4 < 16; ++i4) {
        uint2 ov = {pack2(x[4 * i4], x[4 * i4 + 1]), pack2(x[4 * i4 + 2], x[4 * i4 + 3])};
        *(uint2*)(GU + ((split * 4 + (i4 >> 2)) * 64 + (i4 & 3) * 16 + fr) * 4) = ov;
      }
    } else {
#pragma unroll
      for (int i = 0; i < 64; ++i) GW[frag_off(i, cc - 64)] = f2bf(x[i]);
    }
  } else {
    const int q_ = lt - 128;
    const float Glast = Gh[63];
#pragma unroll
    for (int i = 0; i < 4; ++i) {
      const int q = q_ + 128 * i; const int pos = q >> 3, kc = q & 7;
      bf16x8 qv = *(const bf16x8*)(Qb + (hh * 64 + pos) * 72 + kc * 8);
      const float eg = __expf(Gh[pos]);
      uint4 ov = {pack2(bf2f((bf16_t)qv[0]) * eg, bf2f((bf16_t)qv[1]) * eg), pack2(bf2f((bf16_t)qv[2]) * eg, bf2f((bf16_t)qv[3]) * eg),
                  pack2(bf2f((bf16_t)qv[4]) * eg, bf2f((bf16_t)qv[5]) * eg), pack2(bf2f((bf16_t)qv[6]) * eg, bf2f((bf16_t)qv[7]) * eg)};
      { const int fo = frag_off8(pos, kc * 8); uint2 o0 = {ov.x, ov.y}, o1 = {ov.z, ov.w}; *(uint2*)(GQD + fo) = o0; *(uint2*)(GQD + fo + 128) = o1; }
    }
#pragma unroll
    for (int i = 0; i < 4; ++i) {
      const int q = q_ + 128 * i; const int k = q >> 3, pc = q & 7;
      float o[8];
#pragma unroll
      for (int e = 0; e < 8; ++e) { const int pos = pc * 8 + e; o[e] = bf2f(Kb[(hh * 64 + pos) * 72 + k]) * __expf(Glast - Gh[pos]); }
      uint4 ov = {pack2(o[0], o[1]), pack2(o[2], o[3]), pack2(o[4], o[5]), pack2(o[6], o[7])};
      { const int fo = frag_off8(k, pc * 8); uint2 o0 = {ov.x, ov.y}, o1 = {ov.z, ov.w}; *(uint2*)(GKD + fo) = o0; *(uint2*)(GKD + fo + 128) = o1; }
    }
    if (q_ == 0) GCD[ih] = __expf(Glast);
  }
}

DI void gdn_rec_item(const Params& p, int l, int b, int head, char* smem) {
  const bf16_t* P = (const bf16_t*)(p.ws + OFF_P);
  bf16_t* O = (bf16_t*)(p.ws + OFF_O);
  float* SS = (float*)(smem + 81920);
  const int tid = otid(), lane = tid & 63, wv = tid >> 6, fr = lane & 15, fq = lane >> 4;
  const int split = wv & 3;
  const bool active = wv < 4;
  const float ng = p.in[I_GNG][l * 64 + split * 16 + fr];
  const float* GCD = (const float*)(p.ws + OFF_GCD);
  const size_t ih0 = ((size_t)(b * 4 + head)) * 64;
  f32x4 S[4];
#pragma unroll
  for (int kt = 0; kt < 4; ++kt) S[kt] = (f32x4){0.f, 0.f, 0.f, 0.f};
  u32x4 lr[10];
#pragma unroll
  for (int i = 0; i < 10; ++i) lr[i] = (u32x4){0u, 0u, 0u, 0u};
  const int lq = (wv & 3) * 64 + lane;
#define GLOADC(c_)                                                                              \
  {                                                                                             \
    _Pragma("unroll") for (int i = 0; i < 10; ++i) {                                            \
      const int q_ = lq + 256 * i; const int a_ = q_ >> 9, o_ = q_ & 511;                       \
      lr[i] = *(const u32x4*)((const bf16_t*)(p.ws + OFF_G + (size_t)a_ * GSZ) + (ih0 + (c_)) * 4096 + o_ * 8); \
    }                                                                                           \
  }
#define LSTORE(buf_)                                                                            \
  {                                                                                             \
    _Pragma("unroll") for (int i = 0; i < 10; ++i) {                                            \
      const int q_ = lq + 256 * i;                                                              \
      *(u32x4*)(smem + (buf_) * 40960 + q_ * 16) = lr[i];                                       \
    }                                                                                           \
  }
#define BAR_LDS() { asm volatile("s_waitcnt lgkmcnt(0)" ::: "memory"); __builtin_amdgcn_s_barrier(); asm volatile("" ::: "memory"); }
  float cdn = 0.f;
  if (!active) { GLOADC(0); LSTORE(0); GLOADC(1); }
  else cdn = GCD[ih0];
  BAR_LDS();
#pragma unroll 1
  for (int c = 0; c < 64; ++c) {
    f32x4 acco[4];
    if (active) {
      const char* bufp = smem + (c & 1) * 40960;
      const float cd = cdn;
      if (c + 1 < 64) cdn = GCD[ih0 + c + 1];
      float zr[16];
#pragma unroll
      for (int rt = 0; rt < 4; ++rt)
#pragma unroll
        for (int j = 0; j < 4; ++j) {
          const size_t tok = (size_t)b * SEQ + c * 64 + 16 * rt + 4 * fq + j;
          zr[rt * 4 + j] = bf2f(P[tok * PSTR + C_GDN_Z + head * 64 + split * 16 + fr]);
        }
      bf16x8 bS[2];
#pragma unroll
      for (int ks = 0; ks < 2; ++ks) {
        uint4 uu = {pack2(S[2 * ks][0], S[2 * ks][1]), pack2(S[2 * ks][2], S[2 * ks][3]), pack2(S[2 * ks + 1][0], S[2 * ks + 1][1]), pack2(S[2 * ks + 1][2], S[2 * ks + 1][3])};
        bS[ks] = __builtin_bit_cast(bf16x8, uu);
      }
      f32x4 u[4];
#pragma unroll
      for (int rt = 0; rt < 4; ++rt) {
        f32x4 aw = {0.f, 0.f, 0.f, 0.f};
        acco[rt] = (f32x4){0.f, 0.f, 0.f, 0.f};
#pragma unroll
        for (int ks = 0; ks < 2; ++ks) {
          const bf16x8 wa = *(const bf16x8*)(bufp + ((rt * 2 + ks) * 64 + lane) * 16);
          const bf16x8 qa = *(const bf16x8*)(bufp + 8192 + ((rt * 2 + ks) * 64 + lane) * 16);
          aw = mfma16(wa, bS[ks], aw); acco[rt] = mfma16(qa, bS[ks], acco[rt]);
        }
        const s16x4 uv = *(const s16x4*)(bufp + 32768 + ((split * 4 + rt) * 64 + lane) * 8);
#pragma unroll
        for (int j = 0; j < 4; ++j) u[rt][j] = bf2f((bf16_t)uv[j]) - aw[j];
      }
      bf16x8 bU[2];
#pragma unroll
      for (int ks = 0; ks < 2; ++ks) {
        uint4 uu = {pack2(u[2 * ks][0], u[2 * ks][1]), pack2(u[2 * ks][2], u[2 * ks][3]), pack2(u[2 * ks + 1][0], u[2 * ks + 1][1]), pack2(u[2 * ks + 1][2], u[2 * ks + 1][3])};
        bU[ks] = __builtin_bit_cast(bf16x8, uu);
      }
#pragma unroll
      for (int rt = 0; rt < 4; ++rt) {
        f32x4 sn = S[rt] * cd;
#pragma unroll
        for (int ks = 0; ks < 2; ++ks) {
          const bf16x8 qa = *(const bf16x8*)(bufp + 16384 + ((rt * 2 + ks) * 64 + lane) * 16);
          const bf16x8 ka = *(const bf16x8*)(bufp + 24576 + ((rt * 2 + ks) * 64 + lane) * 16);
          acco[rt] = mfma16(qa, bU[ks], acco[rt]); sn = mfma16(ka, bU[ks], sn);
        }
        S[rt] = sn;
      }
#pragma unroll
      for (int rt = 0; rt < 4; ++rt)
#pragma unroll
        for (int j = 0; j < 4; ++j) {
          float s = acco[rt][j] * acco[rt][j];
          s += __shfl_xor(s, 1); s += __shfl_xor(s, 2); s += __shfl_xor(s, 4); s += __shfl_xor(s, 8);
          if (fr == 0) SS[(c & 1) * 256 + split * 64 + 16 * rt + 4 * fq + j] = s;
        }
      BAR_LDS();
      const float* ssb = SS + (c & 1) * 256;
#pragma unroll
      for (int rt = 0; rt < 4; ++rt)
#pragma unroll
        for (int j = 0; j < 4; ++j) {
          const int pos = 16 * rt + 4 * fq + j;
          const float tot = ssb[pos] + ssb[64 + pos] + ssb[128 + pos] + ssb[192 + pos];
          const float rn = rsqrtf(tot * (1.f / 64.f) + EPSF);
          const size_t tok = (size_t)b * SEQ + c * 64 + pos;
          O[tok * DM + 512 + head * 64 + split * 16 + fr] = f2bf(acco[rt][j] * rn * ng * siluf_(zr[rt * 4 + j]));
        }
    } else {
      if (c + 1 < 64) LSTORE((c + 1) & 1);
      if (c + 2 < 64) GLOADC(c + 2);
      BAR_LDS();
    }
  }
#undef GLOADC
#undef LSTORE
#undef BAR_LDS
}

DI void lru_item(const Params& p, int l, int item, char* smem, const int mode) {
  const bf16_t* P = (const bf16_t*)(p.ws + OFF_P);
  bf16_t* O = (bf16_t*)(p.ws + OFF_O);
  float* CA = (float*)(p.ws + OFF_LCA);
  float* CH = (float*)(p.ws + OFF_LCH);
  bf16_t* XS = (bf16_t*)smem;
  bf16_t* UB = (bf16_t*)(smem + 34816);
  const int b = item >> 6, ct = item & 63;
  const int tid = otid(), lane = tid & 63, wv = tid >> 6, r = lane & 31, h = lane >> 5, n = wv & 3, mi = wv >> 2;
  for (int i = 0; i < 5; ++i) {
    const int q = tid + NTHR * i;
    if (q < 67 * 32) {
      const int row = q >> 5, cc = q & 31;
      const int s = ct * 64 - 3 + row;
      uint4 v = {0u, 0u, 0u, 0u};
      if (s >= 0) v = *(const uint4*)(P + ((size_t)b * SEQ + s) * PSTR + C_LRU_X + cc * 8);
      *(uint4*)(XS + row * 256 + cc * 8) = v;
    }
  }
  bf16x8 bwr[2][4], bwi[2][4];
  {
    const float* wrp = p.in[I_LWR] + (((size_t)l * 4 + n) * 64) * 64 + r;
    const float* wip = p.in[I_LWI] + (((size_t)l * 4 + n) * 64) * 64 + r;
    asm volatile("" : "+v"(wrp), "+v"(wip));
#pragma unroll
    for (int ni = 0; ni < 2; ++ni)
#pragma unroll
      for (int ks = 0; ks < 4; ++ks) {
        unsigned ur[4], ui[4];
#pragma unroll
        for (int j2 = 0; j2 < 4; ++j2) {
          const int e = 16 * ks + 8 * h + 2 * j2;
          ur[j2] = pack2(wrp[e * 64 + 32 * ni], wrp[(e + 1) * 64 + 32 * ni]);
          ui[j2] = pack2(wip[e * 64 + 32 * ni], wip[(e + 1) * 64 + 32 * ni]);
        }
        uint4 t1 = {ur[0], ur[1], ur[2], ur[3]}, t2 = {ui[0], ui[1], ui[2], ui[3]};
        bwr[ni][ks] = __builtin_bit_cast(bf16x8, t1); bwi[ni][ks] = __builtin_bit_cast(bf16x8, t2);
      }
  }
  __syncthreads();
  {
    const int sc = tid >> 8, c = tid & 255;
    const float cb = p.in[I_LCB][l * 256 + c];
    const float c0 = p.in[I_LCW][(l * 4 + 0) * 256 + c], c1 = p.in[I_LCW][(l * 4 + 1) * 256 + c],
                c2 = p.in[I_LCW][(l * 4 + 2) * 256 + c], c3 = p.in[I_LCW][(l * 4 + 3) * 256 + c];
    for (int t = sc * 32; t < sc * 32 + 32; ++t)
      UB[t * 264 + c] = f2bf(cb + c0 * bf2f(XS[t * 256 + c]) + c1 * bf2f(XS[(t + 1) * 256 + c]) + c2 * bf2f(XS[(t + 2) * 256 + c]) + c3 * bf2f(XS[(t + 3) * 256 + c]));
  }
  __syncthreads();
  f32x16 ar[2], ai[2];
#pragma unroll
  for (int ni = 0; ni < 2; ++ni)
#pragma unroll
    for (int i = 0; i < 16; ++i) { ar[ni][i] = 0.f; ai[ni][i] = 0.f; }
#pragma unroll
  for (int ks = 0; ks < 4; ++ks) {
    const bf16x8 au = *(const bf16x8*)(UB + (32 * mi + r) * 264 + n * 64 + 16 * ks + 8 * h);
#pragma unroll
    for (int ni = 0; ni < 2; ++ni) { ar[ni] = mfma32(au, bwr[ni][ks], ar[ni]); ai[ni] = mfma32(au, bwi[ni][ks], ai[ni]); }
  }
  const int ck = ct * 2 + mi;
#pragma unroll
  for (int ni = 0; ni < 2; ++ni) {
    const int c = n * 64 + 32 * ni + r;
    const float brc = p.in[I_LBR][l * 256 + c], bic = p.in[I_LBI][l * 256 + c];
    const float lamsp = softplusf_(-p.in[I_LLAM][l * 256 + c]);
    float av[16], bv[16];
#pragma unroll
    for (int i = 0; i < 16; ++i) {
      const int tl = 32 * mi + crow(i, h);
      const float u = bf2f(UB[tl * 264 + c]);
      const float rg = sigmoid_rcp(ar[ni][i] + brc), ig = sigmoid_rcp(ai[ni][i] + bic);
      const float la = -8.f * rg * lamsp;
      av[i] = __expf(la);
      bv[i] = sqrtf(fmaxf(0.f, 1.f - __expf(2.f * la))) * (ig * u);
    }
    float GA[4], GB[4], PA[4], PB[4];
#pragma unroll
    for (int q = 0; q < 4; ++q) {
      float A = 1.f, hh = 0.f;
#pragma unroll
      for (int e = 0; e < 4; ++e) { hh = av[4 * q + e] * hh + bv[4 * q + e]; A *= av[4 * q + e]; }
      GA[q] = A; GB[q] = hh;
      PA[q] = __shfl_xor(A, 32); PB[q] = __shfl_xor(hh, 32);
    }
    float cin = 0.f;
    if (mode == 1) {
      const int lo = h ? (ck >> 1) : 0, hi = h ? ck : (ck >> 1);
      float A = 1.f, hh = 0.f;
      const float* ca = CA + ((size_t)b * 128) * 256 + c;
      const float* chp = CH + ((size_t)b * 128) * 256 + c;
      int k = lo;
      for (; k + 8 <= hi; k += 8) {
        float a8[8], h8[8];
#pragma unroll
        for (int e = 0; e < 8; ++e) { a8[e] = ca[(size_t)(k + e) * 256]; h8[e] = chp[(size_t)(k + e) * 256]; }
#pragma unroll
        for (int e = 0; e < 8; ++e) { hh = a8[e] * hh + h8[e]; A *= a8[e]; }
      }
      for (; k < hi; ++k) { const float a_ = ca[(size_t)k * 256], h_ = chp[(size_t)k * 256]; hh = a_ * hh + h_; A *= a_; }
      const float pAx = __shfl_xor(A, 32), pHx = __shfl_xor(hh, 32);
      cin = h ? (A * pHx + hh) : (pAx * hh + pHx);
    }
    float cg = cin, Ap = 1.f, myc[4];
#pragma unroll
    for (int q = 0; q < 4; ++q) {
      const float Ae = h ? PA[q] : GA[q], Be = h ? PB[q] : GB[q];
      const float Ao = h ? GA[q] : PA[q], Bo = h ? GB[q] : PB[q];
      const float c_even = cg;
      cg = Ae * cg + Be;
      const float c_odd = cg;
      cg = Ao * cg + Bo;
      myc[q] = h ? c_odd : c_even;
      Ap *= Ae * Ao;
    }
    if (mode == 0) {
      if (h == 0) { CA[((size_t)b * 128 + ck) * 256 + c] = Ap; CH[((size_t)b * 128 + ck) * 256 + c] = cg; }
    } else {
#pragma unroll
      for (int q = 0; q < 4; ++q) {
        float hh = myc[q];
#pragma unroll
        for (int e = 0; e < 4; ++e) {
          const int i = 4 * q + e;
          hh = av[i] * hh + bv[i];
          const size_t tok = (size_t)b * SEQ + ct * 64 + 32 * mi + crow(i, h);
          const float y = bf2f(P[tok * PSTR + C_LRU_Y + c]);
          O[tok * DM + c] = f2bf(hh * gelu_rcp(y));
        }
      }
    }
  }
}

#define XB_TMO      128
#define XB_XCNT(j)  (256  + 64 * (j))
#define XB_XSUB(j)  (1280 + 64 * (j))
#define XB_XGEN(j)  (2304 + 64 * (j))
#define XB_TOP      3328
#define XB_TOPGEN   3392
#define XCD_BAR_WORDS 3456
#define XB_SPIN_CAP (1u << 18)
#define XLAS __attribute__((address_space(3)))
DI unsigned xb_ld(unsigned* p)              { return __hip_atomic_load(p, __ATOMIC_RELAXED, __HIP_MEMORY_SCOPE_AGENT); }
DI unsigned xb_add(unsigned* p, unsigned v) { return __hip_atomic_fetch_add(p, v, __ATOMIC_RELAXED, __HIP_MEMORY_SCOPE_AGENT); }
DI unsigned xb_xcc_id() { return (unsigned)__builtin_amdgcn_s_getreg((3 << 11) | 20) & 0xFu; }
#define XB_SPIN(cond, bar) do { unsigned _sp = 0; while (cond) { __builtin_amdgcn_s_sleep(1); \
    if ((++_sp & 255u) == 0u) { if (xb_ld(&(bar)[XB_TMO])) break; if (_sp > XB_SPIN_CAP) { atomicAdd(&(bar)[XB_TMO], 1u); break; } } } } while (0)
struct XcdBarrier { unsigned* bar; unsigned x; volatile XLAS unsigned* st; };
DI XcdBarrier xcd_barrier_post(unsigned* bar, volatile XLAS unsigned* st) {
  XcdBarrier b; b.bar = bar; b.x = xb_xcc_id(); b.st = st;
  if (threadIdx.x == 0) (void)xb_add(&bar[XB_XCNT(b.x)], 1u);
  return b;
}
DI void xcd_barrier_complete(unsigned* bar, unsigned x, unsigned& nloc, unsigned& nx) {
  const unsigned G = gridDim.x * gridDim.y * gridDim.z;
  unsigned sum, cnt, mine, sp = 0u;
  for (;;) {
    sum = 0u; cnt = 0u; mine = 0u;
#pragma unroll
    for (unsigned j = 0; j < 16; ++j) { const unsigned c = xb_ld(&bar[XB_XCNT(j)]); sum += c; cnt += (c > 0u) ? 1u : 0u; mine = (j == x) ? c : mine; }
    if (sum == G) break;
    __builtin_amdgcn_s_sleep(1);
    if ((++sp & 255u) == 0u) { if (xb_ld(&bar[XB_TMO])) break; if (sp > XB_SPIN_CAP) { atomicAdd(&bar[XB_TMO], 1u); break; } }
  }
  nloc = mine > 0u ? mine : 1u; nx = cnt > 0u ? cnt : 1u;
}
DI void xcd_barrier(const XcdBarrier& b) {
  asm volatile("s_waitcnt vmcnt(0)" ::: "memory");
  __syncthreads();
  if (threadIdx.x == 0) {
    unsigned* bar = b.bar;
    __builtin_amdgcn_s_waitcnt(0);
    unsigned nloc = b.st[0], nx = b.st[1];
    if (nloc == 0u) { xcd_barrier_complete(bar, b.x, nloc, nx); b.st[0] = nloc; b.st[1] = nx; }
    const unsigned old = xb_add(&bar[XB_XSUB(b.x)], 1u);
    const unsigned gen = old / nloc;
    if (old + 1u == (gen + 1u) * nloc) {
      __builtin_amdgcn_fence(__ATOMIC_RELEASE, "agent");
      asm volatile("s_waitcnt vmcnt(0)" ::: "memory");
      const unsigned og = xb_add(&bar[XB_TOP], 1u);
      const unsigned tg = og / nx;
      if (og + 1u == (tg + 1u) * nx) xb_add(&bar[XB_TOPGEN], 1u);
      else XB_SPIN(xb_ld(&bar[XB_TOPGEN]) == tg, bar);
      __builtin_amdgcn_fence(__ATOMIC_ACQUIRE, "agent");
      xb_add(&bar[XB_XGEN(b.x)], 1u);
      asm volatile("s_waitcnt vmcnt(0)" ::: "memory");
    } else {
      XB_SPIN(xb_ld(&bar[XB_XGEN(b.x)]) == gen, bar);
      __builtin_amdgcn_fence(__ATOMIC_ACQUIRE, "agent");
      asm volatile("s_waitcnt vmcnt(0)" ::: "memory");
    }
  }
  __syncthreads();
}

__global__ void __launch_bounds__(NTHR) mega(Params p) {
  extern __shared__ __attribute__((aligned(16))) char smem[];
  cg::grid_group grid = cg::this_grid();
  const int tid = threadIdx.x;
  bf16_t* H = (bf16_t*)(p.ws + OFF_H);
  bf16_t* PB = (bf16_t*)(p.ws + OFF_P);
  PG_LAS unsigned char* lds = (PG_LAS unsigned char*)smem;
  volatile XLAS unsigned* xst = (volatile XLAS unsigned*)(smem + 131072);
  if (tid < 2) xst[tid] = 0u;
  __syncthreads();
  const XcdBarrier xb = xcd_barrier_post((unsigned*)(p.ws + OFF_BAR), xst);

  for (int rep = 0; rep < REP_MISC; ++rep) {
  if (MASK & 1) phase_mod(p, smem);
  grid.sync();
  }
  for (int l = 0; l < 4; ++l) {
    const float* xcur = (l == 0) ? p.in[I_X] : p.out;
    for (int rep = 0; rep < REP_MISC; ++rep) {
    if (MASK & 2) phase_convert(p, l, smem);
    if (MASK & 4) phase_norm(p, xcur, p.in[I_N1G] + l * 1024, l, 1024, 0, H, nullptr);
    xcd_barrier(xb);
    }
    for (int rep = 0; rep < REP_G; ++rep) {
    if (MASK & 8) { pg::Order<1> S; S.init(NTOK, PSTR, gridDim.x, blockIdx.x); pg::EpiBf16<0> E{PB, PSTR, nullptr};
      pg::gemm_phase(lds, H, DM, (const bf16_t*)(p.ws + OFF_WIN), 1024, S, E); }
    xcd_barrier(xb);
    }
    for (int rep = 0; rep < REP_M1; ++rep) {
    for (int it = blockIdx.x; it < 5120; it += gridDim.x) {
      if (it < 2048) { if (MASK & 32) gdn_intra_item(p, l, it, smem); }
      else if (it < 3072) { }
      else if (it < 4096) { if (MASK & 128) lru_item(p, l, it - 3072, smem, 0); }
      else { if (MASK & 16) rw_prep_item(p, l, it - 4096, smem); }
      __syncthreads();
    }
    xcd_barrier(xb);
    }
    for (int rep = 0; rep < REP_M2; ++rep) {
    if (blockIdx.x < 128) {
      if (MASK & 16) rwkv_scan_item(p, l, blockIdx.x >> 3, (blockIdx.x >> 1) & 3, blockIdx.x & 1, smem);
    } else {
      if (blockIdx.x < 192) { if (MASK & 256) gdn_rec_item(p, l, (blockIdx.x - 128) >> 2, (blockIdx.x - 128) & 3, smem); }
      unsigned* ctr = (unsigned*)(p.ws + OFF_CTR) + l * 4 + rep;
      volatile int* slot = (volatile int*)(smem + 110016);
      for (;;) {
        __syncthreads();
        if (tid == 0) *slot = (int)atomicAdd(ctr, 1u);
        __syncthreads();
        const int it = *slot;
        if (it >= 2048) break;
        if (it < 1024) { if (MASK & 64) sb_item(p, it, smem); }
        else { if (MASK & 512) lru_item(p, l, it - 1024, smem, 1); }
      }
    }
    xcd_barrier(xb);
    }
    for (int rep = 0; rep < REP_G; ++rep) {
    for (int half = 0; half < 4; ++half) {
      bf16_t* BH = (bf16_t*)(p.ws + OFF_P + 134217728);
      if (half == 0 && rep == 0) { if (MASK & 16) rwkv_post(p, l); xcd_barrier(xb); }
      if (MASK & 1024) { pg::Order<1> S; S.init(NTOK / 4, 4096, gridDim.x, blockIdx.x, 0, 0, 2, 512); pg::EpiBf16<0> E{BH, 4096, nullptr};
        pg::gemm_phase(lds, (const bf16_t*)(p.ws + OFF_O) + (size_t)half * 16384 * DM, DM, (const bf16_t*)(p.ws + OFF_WBR), 256, S, E); }
      xcd_barrier(xb);
      if (MASK & 1024) { pg::Order<4> S; S.init(NTOK / 4, 1024, gridDim.x, blockIdx.x, 0, 2097152); pg::EpiGateMix E{PB + (size_t)half * 16384 * DM, (float*)(p.ws + OFF_G), BH, p.in[I_BGATE] + (size_t)l * 4096};
        pg::gemm_phase(lds, H + (size_t)half * 16384 * DM, DM, (const bf16_t*)(p.ws + OFF_WG), 1024, S, E); }
      xcd_barrier(xb);
    }
    }
    if (MASK & 2048) { pg::Order<1> S; S.init(NTOK, 1024, gridDim.x, blockIdx.x); pg::EpiResid E{xcur, p.out, (const float*)(p.ws + OFF_MODP), p.in[I_BADA], l, 2048};
      pg::gemm_phase(lds, PB, DM, (const bf16_t*)(p.ws + OFF_WO), 1024, S, E); }
    xcd_barrier(xb);
    for (int rep = 0; rep < REP_MISC; ++rep) {
    if (MASK & 4096) phase_norm(p, p.out, p.in[I_N2G] + l * 1024, l, 4096, 3072, H, nullptr);
    xcd_barrier(xb);
    }
    for (int rep = 0; rep < REP_G; ++rep) {
    if (MASK & 8192) { pg::Order<1> S; S.init(NTOK, FFN, gridDim.x, blockIdx.x); pg::EpiBf16<0> E{PB, FFN, nullptr};
      pg::gemm_phase(lds, H, DM, (const bf16_t*)(p.ws + OFF_WF), 1024, S, E); }
    xcd_barrier(xb);
    if (MASK & 8192) { pg::Order<1> S; S.init(NTOK, FFN, gridDim.x, blockIdx.x); pg::EpiFfnAct E{PB + (size_t)NTOK * FFN, PB, p.in[I_FCW] + (size_t)l * 3 * FFN};
      pg::gemm_phase(lds, H, DM, (const bf16_t*)(p.ws + OFF_WF) + (size_t)FFN * 1024, 1024, S, E); }
    xcd_barrier(xb);
    }
    if (MASK & 32768) { pg::Order<1> S; S.init(NTOK, 1024, gridDim.x, blockIdx.x); pg::EpiResid E{p.out, p.out, (const float*)(p.ws + OFF_MODP), p.in[I_BADA], l, 5120};
      pg::gemm_phase(lds, PB + (size_t)NTOK * FFN, FFN, (const bf16_t*)(p.ws + OFF_WD), FFN, S, E); }
    xcd_barrier(xb);
  }
  if (MASK & 65536) phase_norm(p, p.out, p.in[I_FG], 0, 0, 0, nullptr, p.out);
}

extern "C" void kernel_launch(void* const* d_in, const int* in_sizes, int n_in,
                              void* d_out, int out_size, void* d_ws, size_t ws_size,
                              hipStream_t stream) {
  if (ws_size < WS_NEED || n_in < 38) { fprintf(stderr, "workspace too small: %zu < %zu\n", ws_size, (size_t)WS_NEED); return; }
  (void)hipFuncSetAttribute((const void*)mega, hipFuncAttributeMaxDynamicSharedMemorySize, SMEM_BYTES);
  int dev = 0, cus = 0, per_cu = 0;
  (void)hipGetDevice(&dev);
  (void)hipDeviceGetAttribute(&cus, hipDeviceAttributeMultiprocessorCount, dev);
  (void)hipOccupancyMaxActiveBlocksPerMultiprocessor(&per_cu, mega, NTHR, SMEM_BYTES);
  if (per_cu < 1 || cus < 1) { fprintf(stderr, "occupancy query failed (%d, %d)\n", per_cu, cus); return; }
  if (cus > 256) cus = 256;
  const int grid_blocks = cus;
  Params p{};
  for (int i = 0; i < 38; ++i) p.in[i] = (const float*)d_in[i];
  p.out = (float*)d_out; p.ws = (char*)d_ws;
  (void)hipMemsetAsync((char*)d_ws + OFF_BAR, 0, XCD_BAR_WORDS * 4, stream);
  void* args[] = {&p};
  hipError_t e = hipLaunchCooperativeKernel((void*)mega, dim3(grid_blocks), dim3(NTHR), args, SMEM_BYTES, stream);
  if (e != hipSuccess) fprintf(stderr, "cooperative launch failed: %s (grid %d)\n", hipGetErrorString(e), grid_blocks);
}
```

```cpp
#include <hip/hip_runtime.h>
#include <hip/hip_cooperative_groups.h>
#include <cstdio>
namespace cg = cooperative_groups;

typedef unsigned short bf16_t;
typedef short bf16x8 __attribute__((ext_vector_type(8)));
typedef short s16x4 __attribute__((ext_vector_type(4)));
typedef float f32x4 __attribute__((ext_vector_type(4)));
typedef float f32x16 __attribute__((ext_vector_type(16)));
typedef unsigned u32x4 __attribute__((ext_vector_type(4)));
#define DI __device__ __forceinline__

constexpr int NTOK = 65536, DM = 1024, SEQ = 4096, PSTR = 3328, FFN = 2816, AUS = 5632;
constexpr int C_LRU_X = 0, C_LRU_Y = 256, C_SB_Q = 512, C_SB_K = 768, C_SB_V = 1024;
constexpr int C_GDN_Q = 1280, C_GDN_Z = 2048, C_GDN_A = 2304, C_GDN_B = 2308, C_RW = 2312;
constexpr float EPSF = 1e-6f;
#ifndef MASK
#define MASK 0x1ffff
#endif
#ifndef REP_M1
#define REP_M1 1
#endif
#ifndef REP_M2
#define REP_M2 1
#endif
#ifndef REP_G
#define REP_G 1
#endif
#ifndef REP_MISC
#define REP_MISC 1
#endif
constexpr int NTHR = 512;
constexpr int SMEM_BYTES = 131072 + 64;

constexpr size_t OFF_MODP = 0;
constexpr size_t OFF_WIN = 6291456;
constexpr size_t OFF_WG = OFF_WIN + 6815744;
constexpr size_t OFF_WBR = OFF_WG + 8388608;
constexpr size_t OFF_WO = OFF_WBR + 2097152;
constexpr size_t OFF_WF = OFF_WO + 2097152;
constexpr size_t OFF_WD = OFF_WF + 11534336;
constexpr size_t OFF_H = OFF_WD + 5767168;
constexpr size_t OFF_P = OFF_H + 134217728;
constexpr size_t OFF_O = OFF_P + 436207616;
constexpr size_t OFF_G = OFF_O + 134217728;
constexpr size_t GSZ = 33554432;
constexpr size_t OFF_GCD = OFF_G + 5 * GSZ;
constexpr size_t OFF_L = OFF_GCD + 16384;
constexpr size_t LSZ = 67108864;
constexpr size_t OFF_LCA = OFF_L + 2 * LSZ;
constexpr size_t OFF_LCH = OFF_LCA + 2097152;
constexpr size_t OFF_BON = OFF_LCH + 2097152;
constexpr size_t OFF_CTR = OFF_BON + 1048576;
constexpr size_t OFF_BAR = OFF_CTR + 256;
constexpr size_t WS_NEED = OFF_BAR + 16384;

struct Params { const float* in[38]; float* out; char* ws; };
enum { I_X = 0, I_C, I_N1G, I_N2G, I_FG, I_WADA, I_BADA, I_WIN, I_LCW, I_LCB, I_LWR, I_LBR, I_LWI, I_LBI, I_LLAM,
       I_GCW, I_GAL, I_GDT, I_GNG, I_RMU, I_RW0, I_RWUP, I_RA0, I_RAUP, I_RGUP, I_RKK, I_RKA, I_RRK, I_RLG, I_RLB,
       I_WBR, I_WGATE, I_BGATE, I_WOUT, I_FWG, I_FWU, I_FCW, I_FWD };

DI float bf2f(bf16_t v) { return __uint_as_float(((unsigned)v) << 16); }
typedef __bf16 bf16n2 __attribute__((ext_vector_type(2)));
typedef float f32x2_ __attribute__((ext_vector_type(2)));
DI unsigned pack2(float lo, float hi) { f32x2_ v = {lo, hi}; bf16n2 b = __builtin_convertvector(v, bf16n2); return __builtin_bit_cast(unsigned, b); }
DI bf16_t f2bf(float x) { return (bf16_t)(pack2(x, x) & 0xffffu); }
DI float sigmoidf_(float x) { return __builtin_amdgcn_rcpf(1.f + __expf(-x)); }
DI float sigmoid_rcp(float x) { return __builtin_amdgcn_rcpf(1.f + __expf(-x)); }
DI float gelu_rcp(float x) { float u = 0.7978845608f * (x + 0.044715f * x * x * x); return x * __builtin_amdgcn_rcpf(1.f + __expf(-2.f * u)); }
DI float softplusf_(float x) { return fmaxf(x, 0.f) + __logf(1.f + __expf(-fabsf(x))); }
DI float siluf_(float x) { return x * __builtin_amdgcn_rcpf(1.f + __expf(-x)); }
DI float geluf_(float x) { float u = 0.7978845608f * (x + 0.044715f * x * x * x); return x * __builtin_amdgcn_rcpf(1.f + __expf(-2.f * u)); }
DI float tanhf_(float x) { return 1.f - 2.f * __builtin_amdgcn_rcpf(1.f + __expf(2.f * x)); }
DI float wave_sum(float x) {
#pragma unroll
  for (int o = 32; o >= 1; o >>= 1) x += __shfl_xor(x, o);
  return x;
}
template <int CTRL> DI float dppf(float x) { return __int_as_float(__builtin_amdgcn_update_dpp(0, __float_as_int(x), CTRL, 0xf, 0xf, true)); }
DI float reduce8(float x) { x += dppf<0xB1>(x); x += dppf<0x4E>(x); x += dppf<0x141>(x); return x; }
DI f32x16 mfma32(bf16x8 a, bf16x8 b, f32x16 c) { return __builtin_amdgcn_mfma_f32_32x32x16_bf16(a, b, c, 0, 0, 0); }
DI f32x4 mfma16(bf16x8 a, bf16x8 b, f32x4 c) { return __builtin_amdgcn_mfma_f32_16x16x32_bf16(a, b, c, 0, 0, 0); }
DI int crow(int i, int h) { return (i & 3) + 8 * (i >> 2) + 4 * h; }

DI float modv(const float* modp, const float* bada, int l, int b, int idx) {
  const float* q = modp + ((size_t)(l * 16 + b)) * 6144 + idx;
  const size_t ks = (size_t)4 * 16 * 6144;
  return bada[l * 6144 + idx] + q[0] + q[ks] + q[2 * ks] + q[3 * ks];
}

DI int otid() { int t = threadIdx.x; asm volatile("" : "+v"(t)); return t; }
DI int obid() { int b = blockIdx.x; asm volatile("" : "+s"(b)); return b; }
DI void phase_mod(const Params& p, char* smem) {
  float* sm = (float*)smem;
  float* modp = (float*)(p.ws + OFF_MODP);
  const int tid = otid();
  if (obid() == 0 && tid < 64) ((unsigned*)(p.ws + OFF_CTR))[tid] = 0u;
  for (int item = obid(); item < 192; item += gridDim.x) {
    const int l = item / 48, rem = item % 48, jb = rem >> 2, kq = rem & 3;
    for (int i = 0; i < 8; ++i) {
      int e = tid + 512 * i; int b = e >> 8, k = e & 255;
      float cv = p.in[I_C][b * 1024 + kq * 256 + k];
      sm[e] = siluf_(cv);
    }
    __syncthreads();
    float acc[16];
#pragma unroll
    for (int b = 0; b < 16; ++b) acc[b] = 0.f;
    const float* wp = p.in[I_WADA] + ((size_t)l * 1024 + kq * 256) * 6144 + jb * 512 + tid;
    for (int k = 0; k < 256; k += 4) {
      float w0 = wp[(size_t)k * 6144], w1 = wp[(size_t)(k + 1) * 6144], w2 = wp[(size_t)(k + 2) * 6144], w3 = wp[(size_t)(k + 3) * 6144];
#pragma unroll
      for (int b = 0; b < 16; ++b) {
        f32x4 cv = *(const f32x4*)(sm + b * 256 + k);
        acc[b] += cv[0] * w0 + cv[1] * w1 + cv[2] * w2 + cv[3] * w3;
      }
    }
#pragma unroll
    for (int b = 0; b < 16; ++b) modp[((size_t)((kq * 4 + l) * 16 + b)) * 6144 + jb * 512 + tid] = acc[b];
    __syncthreads();
  }
}

DI void conv_tile(const float* src, bf16_t* dst, int K, int N, int k0, int n0, char* smem) {
  float* tile = (float*)smem;
  const int tid = otid();
#pragma unroll
  for (int it = 0; it < 2; ++it) {
    int kr = (tid >> 4) + 32 * it, nc = (tid & 15) * 4;
    f32x4 v = {0.f, 0.f, 0.f, 0.f};
    if (n0 + nc < N) v = *(const f32x4*)(src + (size_t)(k0 + kr) * N + n0 + nc);
    tile[kr * 65 + nc] = v[0]; tile[kr * 65 + nc + 1] = v[1]; tile[kr * 65 + nc + 2] = v[2]; tile[kr * 65 + nc + 3] = v[3];
  }
  __syncthreads();
  {
    int n = tid >> 3, kc = (tid & 7) * 8;
    unsigned o[4];
#pragma unroll
    for (int e = 0; e < 4; ++e) o[e] = pack2(tile[(kc + 2 * e) * 65 + n], tile[(kc + 2 * e + 1) * 65 + n]);
    uint4 ov = {o[0], o[1], o[2], o[3]};
    *(uint4*)(dst + (size_t)(n0 + n) * K + k0 + kc) = ov;
  }
  __syncthreads();
}

DI void phase_convert(const Params& p, int l, char* smem) {
  for (int t = obid(); t < 4480; t += gridDim.x) {
    const float* src; bf16_t* dst; int K, N, Npad, tt = t;
    if (tt < 832) { src = p.in[I_WIN] + (size_t)l * 1024 * 3208; dst = (bf16_t*)(p.ws + OFF_WIN); K = 1024; N = 3208; Npad = 3328; }
    else if ((tt -= 832) < 1024) { int br = tt >> 8; tt &= 255; src = p.in[I_WGATE] + ((size_t)l * 4 + br) * 1048576; dst = (bf16_t*)(p.ws + OFF_WG) + (size_t)br * 1048576; K = 1024; N = 1024; Npad = 1024; }
    else if ((tt -= 1024) < 256) { int br = tt >> 6; tt &= 63; src = p.in[I_WBR] + ((size_t)l * 4 + br) * 262144; dst = (bf16_t*)(p.ws + OFF_WBR) + (size_t)br * 262144; K = 256; N = 1024; Npad = 1024; }
    else if ((tt -= 256) < 256) { src = p.in[I_WOUT] + (size_t)l * 1048576; dst = (bf16_t*)(p.ws + OFF_WO); K = 1024; N = 1024; Npad = 1024; }
    else if ((tt -= 256) < 704) { src = p.in[I_FWG] + (size_t)l * 1024 * 2816; dst = (bf16_t*)(p.ws + OFF_WF); K = 1024; N = 2816; Npad = 2816; }
    else if ((tt -= 704) < 704) { src = p.in[I_FWU] + (size_t)l * 1024 * 2816; dst = (bf16_t*)(p.ws + OFF_WF) + (size_t)2816 * 1024; K = 1024; N = 2816; Npad = 2816; }
    else { tt -= 704; src = p.in[I_FWD] + (size_t)l * 2816 * 1024; dst = (bf16_t*)(p.ws + OFF_WD); K = 2816; N = 1024; Npad = 1024; }
    const int nNt = Npad >> 6;
    const int kt = tt / nNt, nt = tt % nNt;
    conv_tile(src, dst, K, N, kt * 64, nt * 64, smem);
  }
}

DI void phase_norm(const Params& p, const float* xin, const float* g, int l, int scale_idx, int shift_idx, bf16_t* hout, float* fout) {
  const float* modp = (const float*)(p.ws + OFF_MODP);
  const int lane = otid() & 63, wv = otid() >> 6;
  const int nw = gridDim.x * 8;
  const int rows_per = 32;
  for (int chunk = obid() * 8 + wv; chunk < NTOK / 32; chunk += nw) {
  const int row0 = chunk * rows_per;
  const int b = row0 / SEQ;
  f32x4 gv[4], sc[4], sh[4];
#pragma unroll
  for (int j = 0; j < 4; ++j) {
    int c = lane * 4 + 256 * j;
    gv[j] = *(const f32x4*)(g + c);
    if (hout) {
#pragma unroll
      for (int e = 0; e < 4; ++e) {
        sc[j][e] = 1.f + modv(modp, p.in[I_BADA], l, b, scale_idx + c + e);
        sh[j][e] = modv(modp, p.in[I_BADA], l, b, shift_idx + c + e);
      }
    }
  }
  for (int rr = 0; rr < rows_per; ++rr) {
    const size_t row = (size_t)row0 + rr;
    f32x4 xv[4]; float ss = 0.f;
#pragma unroll
    for (int j = 0; j < 4; ++j) {
      xv[j] = *(const f32x4*)(xin + row * DM + lane * 4 + 256 * j);
      ss += xv[j][0] * xv[j][0] + xv[j][1] * xv[j][1] + xv[j][2] * xv[j][2] + xv[j][3] * xv[j][3];
    }
    ss = wave_sum(ss);
    const float rs = rsqrtf(ss * (1.f / 1024.f) + EPSF);
#pragma unroll
    for (int j = 0; j < 4; ++j) {
      f32x4 y = xv[j] * rs * gv[j];
      if (hout) {
        y = y * sc[j] + sh[j];
        uint2 o = {pack2(y[0], y[1]), pack2(y[2], y[3])};
        *(uint2*)(hout + row * DM + lane * 4 + 256 * j) = o;
      } else {
        *(f32x4*)(fout + row * DM + lane * 4 + 256 * j) = y;
      }
    }
  }
  }
}

#define PG_LAS __attribute__((address_space(3)))
namespace pg {
constexpr int BM = 256, BK = 64, HALF = 128, HTB = HALF * BK * 2, NXCD = 8, WGM = 8;
DI int lds_byte(int r, int c) { const int st = (r >> 4) * 2 + (c >> 5), rr = r & 15, cc = c & 31, ob = rr * 64 + cc * 2; return st * 1024 + (ob ^ (((ob >> 9) & 1) << 5)); }
DI void stage_rc(int b, int& R, int& C) { const int st = b / 1024, sb = b % 1024, swz = sb ^ (((sb >> 9) & 1) << 5); R = (st >> 1) * 16 + swz / 64; C = (st & 1) * 32 + (swz % 64) / 2; }
DI int perm32(int rho) { const int n = rho >> 4, i = rho & 15; return 8 * (i >> 2) + 4 * n + (i & 3); }
struct Unit { int pm, pn; int aux; long ao, bo; };
template <int REP> struct Order {
  int nM, nN, nwg, G, c, ashift; long astep, bstep, apnstep;
  DI void init(int M, int N, int G_, int c_, long astep_ = 0, long bstep_ = 0, int ashift_ = 0, long apnstep_ = 0) {
    nM = M / BM; nN = N / BM; nwg = nM * nN; G = G_; c = c_; astep = astep_; bstep = bstep_; ashift = ashift_; apnstep = apnstep_; }
  DI bool next(int i, Unit& u) const {
    const int ti = i / REP, aux = i % REP;
    const long L = (long)ti * G + c; if (L >= nwg) return false;
    int wgid = (int)L; { const int q = nwg / NXCD, r = nwg % NXCD, xcd = wgid % NXCD, off = wgid / NXCD; wgid = (xcd < r ? xcd * (q + 1) : r * (q + 1) + (xcd - r) * q) + off; }
    const int nig = WGM * nN, gid = wgid / nig, fm = gid * WGM, gsz = (nM - fm) < WGM ? (nM - fm) : WGM;
    u.pm = fm + ((wgid % nig) % gsz); u.pn = (wgid % nig) / gsz; u.aux = aux; u.ao = aux * astep + (long)(u.pn >> ashift) * apnstep; u.bo = aux * bstep; return true;
  }
};
DI unsigned cvt_pk_bf16(float lo, float hi) { return pack2(lo, hi); }

template <class Epi, class Sched>
DI void gemm_phase(PG_LAS unsigned char* lds, const bf16_t* Ag, int lda, const bf16_t* Bg, int K, const Sched& S, const Epi& E) {
  const int tid = otid(), wid = __builtin_amdgcn_readfirstlane(tid >> 6), lane = tid & 63, wr = wid >> 2, wc = wid & 3, fr = lane & 15, fq = lane >> 4;
  const int nt = K / BK;
  unsigned voffA[2], voffB[2];
#pragma unroll
  for (int i = 0; i < 2; ++i) { int R, C; stage_rc(tid * 16 + i * 8192, R, C); const int Rb = Epi::PERM ? ((R & ~31) + perm32(R & 31)) : R;
    voffA[i] = (unsigned)(R * lda + C) * 2u; voffB[i] = (unsigned)(Rb * K + C) * 2u; }
  const size_t kstep = (size_t)(BK * 2);
  const size_t hstepA = (size_t)HALF * lda * 2, hstepB = (size_t)HALF * K * 2;
  const size_t tstepA = 2 * hstepA, tstepB = 2 * hstepB;
  const unsigned ldsw = (unsigned)wid * 1024u;
  const int aoff = lds_byte(wr * 64 + fr, fq * 8), boff = lds_byte(wc * 32 + fr, fq * 8);
#define PG_SA(b, h) (((b) * 2 + (h)) * HTB)
#define PG_SB(b, h) ((4 + (b) * 2 + (h)) * HTB)
#define PG_STAGE(bufoff, gbase, voff) do { _Pragma("unroll") for (int _i = 0; _i < 2; ++_i) \
    __builtin_amdgcn_global_load_lds((const unsigned*)((const char*)(gbase) + (voff)[_i]), (PG_LAS unsigned*)(lds + (bufoff) + ldsw + _i * 8192), 16, 0, 0); } while (0)
#define PG_LDA(dst, b, h) do { _Pragma("unroll") for (int m = 0; m < 4; ++m) _Pragma("unroll") for (int k = 0; k < 2; ++k) dst[m][k] = *(const PG_LAS bf16x8*)(lds + PG_SA(b, h) + aoff + m * 2048 + k * 1024); } while (0)
#define PG_LDB(dst, b, h) do { _Pragma("unroll") for (int n = 0; n < 2; ++n) _Pragma("unroll") for (int k = 0; k < 2; ++k) dst[n][k] = *(const PG_LAS bf16x8*)(lds + PG_SB(b, h) + boff + n * 2048 + k * 1024); } while (0)
#define PG_MMA(ai, bj, At, Bt) do { __builtin_amdgcn_s_setprio(1); _Pragma("unroll") for (int m = 0; m < 4; ++m) _Pragma("unroll") for (int n = 0; n < 2; ++n) _Pragma("unroll") for (int k = 0; k < 2; ++k) \
    acc[ai][bj][m][n] = __builtin_amdgcn_mfma_f32_16x16x32_bf16(Bt[n][k], At[m][k], acc[ai][bj][m][n], 0, 0, 0); __builtin_amdgcn_s_setprio(0); } while (0)
#define PG_WAIT_V(n) asm volatile("s_waitcnt vmcnt(" #n ")" ::: "memory")
#define PG_WAIT_L(n) asm volatile("s_waitcnt lgkmcnt(" #n ")" ::: "memory")
#define PG_BAR __builtin_amdgcn_s_barrier()
#define PG_SCHED __builtin_amdgcn_sched_barrier(0)
  Unit cur, nxt; int ui = 0;
  if (!S.next(0, cur)) return;
  f32x4 acc[2][2][4][2];
#pragma unroll
  for (int a = 0; a < 2; ++a)
#pragma unroll
    for (int b = 0; b < 2; ++b)
#pragma unroll
      for (int m = 0; m < 4; ++m)
#pragma unroll
        for (int n = 0; n < 2; ++n) acc[a][b][m][n] = (f32x4){0.f, 0.f, 0.f, 0.f};
  bf16x8 At[4][2], B0[2][2], B1[2][2];
  const char* cA = (const char*)Ag + (size_t)cur.pm * tstepA + cur.ao; const char* cB = (const char*)Bg + (size_t)cur.pn * tstepB + cur.bo;
  PG_STAGE(PG_SB(0, 0), cB, voffB); PG_STAGE(PG_SA(0, 0), cA, voffA); PG_STAGE(PG_SB(0, 1), cB + hstepB, voffB); PG_STAGE(PG_SA(0, 1), cA + hstepA, voffA);
  if (wr == 1) PG_BAR;
  PG_WAIT_V(4); PG_BAR;
  PG_STAGE(PG_SB(1, 0), cB + kstep, voffB); PG_STAGE(PG_SA(1, 0), cA + kstep, voffA); PG_STAGE(PG_SB(1, 1), cB + hstepB + kstep, voffB);
  PG_WAIT_V(6); PG_BAR;
  for (;;) {
    const bool has_next = S.next(ui + 1, nxt);
    const char* nA = has_next ? (const char*)Ag + (size_t)nxt.pm * tstepA + nxt.ao : cA; const char* nB = has_next ? (const char*)Bg + (size_t)nxt.pn * tstepB + nxt.bo : cB;
#pragma unroll 1
    for (int t = 0; t < nt; t += 2) {
      const bool last = (t == nt - 2);
      const char* a1 = cA + (size_t)(t + 1) * kstep;
      const char* a2 = last ? nA : cA + (size_t)(t + 2) * kstep; const char* b2 = last ? nB : cB + (size_t)(t + 2) * kstep;
      const char* a3 = a2 + kstep; const char* b3 = b2 + kstep;
      PG_LDB(B0, 0, 0); PG_SCHED; PG_LDA(At, 0, 0); PG_STAGE(PG_SA(1, 1), a1 + hstepA, voffA);
      PG_WAIT_L(8); PG_BAR; PG_WAIT_L(0); PG_MMA(0, 0, At, B0); PG_BAR; PG_SCHED;
      PG_LDB(B1, 0, 1); PG_STAGE(PG_SB(0, 0), b2, voffB);
      PG_BAR; PG_WAIT_L(0); PG_MMA(0, 1, At, B1); PG_BAR;
      PG_LDA(At, 0, 1); PG_STAGE(PG_SA(0, 0), a2, voffA);
      PG_BAR; PG_WAIT_L(0); PG_MMA(1, 0, At, B0); PG_BAR; PG_SCHED;
      PG_STAGE(PG_SB(0, 1), b2 + hstepB, voffB);
      PG_WAIT_V(6); PG_BAR; PG_MMA(1, 1, At, B1); PG_BAR;
      PG_LDB(B0, 1, 0); PG_SCHED; PG_LDA(At, 1, 0); PG_STAGE(PG_SA(0, 1), a2 + hstepA, voffA);
      PG_WAIT_L(8); PG_BAR; PG_WAIT_L(0); PG_MMA(0, 0, At, B0); PG_BAR; PG_SCHED;
      PG_LDB(B1, 1, 1); PG_STAGE(PG_SB(1, 0), b3, voffB);
      PG_BAR; PG_WAIT_L(0); PG_MMA(0, 1, At, B1); PG_BAR;
      PG_LDA(At, 1, 1); PG_STAGE(PG_SA(1, 0), a3, voffA);
      PG_BAR; PG_WAIT_L(0); PG_MMA(1, 0, At, B0); PG_BAR; PG_SCHED;
      PG_STAGE(PG_SB(1, 1), b3 + hstepB, voffB);
      PG_WAIT_V(6); PG_BAR; PG_MMA(1, 1, At, B1); PG_BAR;
    }
    E(acc, cur, wr, wc, fr, fq);
    if (!has_next) break;
#pragma unroll
    for (int a = 0; a < 2; ++a)
#pragma unroll
      for (int b = 0; b < 2; ++b)
#pragma unroll
        for (int m = 0; m < 4; ++m)
#pragma unroll
          for (int n = 0; n < 2; ++n) acc[a][b][m][n] = (f32x4){0.f, 0.f, 0.f, 0.f};
    cur = nxt; cA = nA; cB = nB; ++ui;
  }
  PG_WAIT_V(0);
  if (wr == 0) PG_BAR;
  PG_BAR;
#undef PG_SA
#undef PG_SB
#undef PG_STAGE
#undef PG_LDA
#undef PG_LDB
#undef PG_MMA
#undef PG_WAIT_V
#undef PG_WAIT_L
#undef PG_BAR
#undef PG_SCHED
}

template <int ACT> struct EpiBf16 {
  static constexpr bool PERM = true;
  bf16_t* O; int ldc; const float* bias;
  DI void operator()(const f32x4 (&acc)[2][2][4][2], const Unit& u, int wr, int wc, int fr, int fq) const {
    const int row0 = u.pm * BM + wr * 64 + fr, col0 = u.pn * BM + wc * 32 + 8 * fq;
    f32x4 bv[2][2];
#pragma unroll
    for (int bj = 0; bj < 2; ++bj)
#pragma unroll
      for (int n = 0; n < 2; ++n) bv[bj][n] = ACT ? *(const f32x4*)(bias + col0 + bj * HALF + 4 * n) : (f32x4){0.f, 0.f, 0.f, 0.f};
#pragma unroll
    for (int ai = 0; ai < 2; ++ai)
#pragma unroll
      for (int m = 0; m < 4; ++m) { bf16_t* rowp = O + (size_t)(row0 + ai * HALF + m * 16) * ldc + col0;
#pragma unroll
        for (int bj = 0; bj < 2; ++bj) { f32x4 v0 = acc[ai][bj][m][0] + bv[bj][0], v1 = acc[ai][bj][m][1] + bv[bj][1];
          if (ACT) {
#pragma unroll
            for (int j = 0; j < 4; ++j) { v0[j] = sigmoid_rcp(v0[j]); v1[j] = sigmoid_rcp(v1[j]); } }
          u32x4 w; w.x = cvt_pk_bf16(v0[0], v0[1]); w.y = cvt_pk_bf16(v0[2], v0[3]); w.z = cvt_pk_bf16(v1[0], v1[1]); w.w = cvt_pk_bf16(v1[2], v1[3]);
          *(u32x4*)(rowp + bj * HALF) = w; } }
  }
};
struct EpiBranch {
  static constexpr bool PERM = true;
  bf16_t* MIX; const bf16_t* G;
  DI void operator()(const f32x4 (&acc)[2][2][4][2], const Unit& u, int wr, int wc, int fr, int fq) const {
    const int row0 = u.pm * BM + wr * 64 + fr, col0 = u.pn * BM + wc * 32 + 8 * fq;
#pragma unroll
    for (int ai = 0; ai < 2; ++ai)
#pragma unroll
      for (int m = 0; m < 4; ++m) {
        asm volatile("" ::: "memory");
        const size_t row = (size_t)(row0 + ai * HALF + m * 16);
        bf16_t* mp = MIX + row * DM + col0; const bf16_t* gp = G + row * 4096 + u.aux * 1024 + col0;
#pragma unroll
        for (int bj = 0; bj < 2; ++bj) {
          const bf16x8 gv = *(const bf16x8*)(gp + bj * HALF);
          float o[8];
#pragma unroll
          for (int j = 0; j < 4; ++j) { o[j] = bf2f((bf16_t)gv[j]) * acc[ai][bj][m][0][j]; o[4 + j] = bf2f((bf16_t)gv[4 + j]) * acc[ai][bj][m][1][j]; }
          if (u.aux > 0) {
            const bf16x8 mv = *(const bf16x8*)(mp + bj * HALF);
#pragma unroll
            for (int j = 0; j < 8; ++j) o[j] += bf2f((bf16_t)mv[j]);
          }
          u32x4 w; w.x = cvt_pk_bf16(o[0], o[1]); w.y = cvt_pk_bf16(o[2], o[3]); w.z = cvt_pk_bf16(o[4], o[5]); w.w = cvt_pk_bf16(o[6], o[7]);
          *(u32x4*)(mp + bj * HALF) = w;
        }
      }
  }
};
struct EpiResid {
  static constexpr bool PERM = false;
  const float* xold; float* xnew; const float* modp; const float* bada; int l, gate_idx;
  DI void operator()(const f32x4 (&acc)[2][2][4][2], const Unit& u, int wr, int wc, int fr, int fq) const {
    const int row0 = u.pm * BM + wr * 64 + fr, col0 = u.pn * BM + wc * 32 + 4 * fq;
    const int b = (u.pm * BM) / SEQ;
    f32x4 gv[2][2];
#pragma unroll
    for (int bj = 0; bj < 2; ++bj)
#pragma unroll
      for (int n = 0; n < 2; ++n)
#pragma unroll
        for (int j = 0; j < 4; ++j) gv[bj][n][j] = modv(modp, bada, l, b, gate_idx + col0 + bj * HALF + n * 16 + j);
#pragma unroll
    for (int ai = 0; ai < 2; ++ai)
#pragma unroll
      for (int m = 0; m < 4; ++m) { const size_t ro = (size_t)(row0 + ai * HALF + m * 16) * DM + col0;
#pragma unroll
        for (int bj = 0; bj < 2; ++bj)
#pragma unroll
          for (int n = 0; n < 2; ++n) {
            const f32x4 xo = *(const f32x4*)(xold + ro + bj * HALF + n * 16);
            *(f32x4*)(xnew + ro + bj * HALF + n * 16) = xo + gv[bj][n] * acc[ai][bj][m][n];
          } }
  }
};
struct EpiFfnAct {
  static constexpr bool PERM = true;
  bf16_t* ACT; const bf16_t* APRE; const float* cw;
  DI void operator()(const f32x4 (&acc)[2][2][4][2], const Unit& u, int wr, int wc, int fr, int fq) const {
    const int row0 = u.pm * BM + wr * 64 + fr, col0 = u.pn * BM + wc * 32 + 8 * fq;
#pragma unroll
    for (int ai = 0; ai < 2; ++ai)
#pragma unroll
      for (int m = 0; m < 4; ++m) {
        asm volatile("" ::: "memory");
        const int row = row0 + ai * HALF + m * 16; const int sp = row & (SEQ - 1);
        const bf16_t* ap = APRE + (size_t)row * FFN + col0;
        bf16_t* op = ACT + (size_t)row * FFN + col0;
#pragma unroll
        for (int bj = 0; bj < 2; ++bj) {
          const int c = bj * HALF;
          const bf16x8 z8 = {0, 0, 0, 0, 0, 0, 0, 0};
          const bf16x8 a0 = *(const bf16x8*)(ap + c);
          const bf16x8 a1 = sp >= 1 ? *(const bf16x8*)(ap - FFN + c) : z8;
          const bf16x8 a2 = sp >= 2 ? *(const bf16x8*)(ap - 2 * FFN + c) : z8;
          float o[8];
#pragma unroll
          for (int hh = 0; hh < 2; ++hh) {
            const f32x4 w0 = *(const f32x4*)(cw + col0 + c + 4 * hh), w1 = *(const f32x4*)(cw + FFN + col0 + c + 4 * hh), w2 = *(const f32x4*)(cw + 2 * FFN + col0 + c + 4 * hh);
#pragma unroll
            for (int j = 0; j < 4; ++j) {
              const float cv = w0[j] * bf2f((bf16_t)a2[4 * hh + j]) + w1[j] * bf2f((bf16_t)a1[4 * hh + j]) + w2[j] * bf2f((bf16_t)a0[4 * hh + j]);
              o[4 * hh + j] = gelu_rcp(cv) * acc[ai][bj][m][hh][j];
            }
          }
          u32x4 w; w.x = cvt_pk_bf16(o[0], o[1]); w.y = cvt_pk_bf16(o[2], o[3]); w.z = cvt_pk_bf16(o[4], o[5]); w.w = cvt_pk_bf16(o[6], o[7]);
          *(u32x4*)(op + c) = w;
        }
      }
  }
};
struct EpiGateMix {
  static constexpr bool PERM = true;
  bf16_t* MIX; float* MIX32; const bf16_t* BH; const float* bias;
  DI void operator()(const f32x4 (&acc)[2][2][4][2], const Unit& u, int wr, int wc, int fr, int fq) const {
    const int row0 = u.pm * BM + wr * 64 + fr, col0 = u.pn * BM + wc * 32 + 8 * fq;
    const bool rmw = u.aux > 0, fin = u.aux == 3;
    f32x4 bv[2][2];
#pragma unroll
    for (int bj = 0; bj < 2; ++bj)
#pragma unroll
      for (int n = 0; n < 2; ++n) bv[bj][n] = *(const f32x4*)(bias + u.aux * 1024 + col0 + bj * HALF + 4 * n);
    const f32x4 z4 = {0.f, 0.f, 0.f, 0.f};
    bf16x8 nb[2]; f32x4 nm[2][2];
#define GM_LOAD(it_) { const size_t row_ = (size_t)(row0 + ((it_) >> 2) * HALF + ((it_) & 3) * 16); \
      _Pragma("unroll") for (int bj = 0; bj < 2; ++bj) { nb[bj] = *(const bf16x8*)(BH + row_ * 4096 + u.aux * 1024 + col0 + bj * HALF); \
        nm[bj][0] = rmw ? *(const f32x4*)(MIX32 + row_ * DM + col0 + bj * HALF) : z4; nm[bj][1] = rmw ? *(const f32x4*)(MIX32 + row_ * DM + col0 + bj * HALF + 4) : z4; } }
    GM_LOAD(0);
#pragma unroll
    for (int it = 0; it < 8; ++it) {
      const int ai = it >> 2, m = it & 3;
      bf16x8 cb[2]; f32x4 cm[2][2];
#pragma unroll
      for (int bj = 0; bj < 2; ++bj) { cb[bj] = nb[bj]; cm[bj][0] = nm[bj][0]; cm[bj][1] = nm[bj][1]; }
      if (it + 1 < 8) GM_LOAD(it + 1);
      const size_t ro = (size_t)(row0 + ai * HALF + m * 16) * DM + col0;
#pragma unroll
      for (int bj = 0; bj < 2; ++bj) {
        f32x4 o[2];
#pragma unroll
        for (int hh = 0; hh < 2; ++hh)
#pragma unroll
          for (int j = 0; j < 4; ++j)
            o[hh][j] = sigmoid_rcp(acc[ai][bj][m][hh][j] + bv[bj][hh][j]) * bf2f((bf16_t)cb[bj][4 * hh + j]) + cm[bj][hh][j];
        if (fin) {
          u32x4 w; w.x = cvt_pk_bf16(o[0][0], o[0][1]); w.y = cvt_pk_bf16(o[0][2], o[0][3]); w.z = cvt_pk_bf16(o[1][0], o[1][1]); w.w = cvt_pk_bf16(o[1][2], o[1][3]);
          *(u32x4*)(MIX + ro + bj * HALF) = w;
        } else {
          *(f32x4*)(MIX32 + ro + bj * HALF) = o[0]; *(f32x4*)(MIX32 + ro + bj * HALF + 4) = o[1];
        }
      }
    }
#undef GM_LOAD
  }
};
}

DI void phase_ffn_act(const Params& p, int l) {
  bf16_t* AU = (bf16_t*)(p.ws + OFF_P);
  const float* cw = p.in[I_FCW] + (size_t)l * 3 * FFN;
  const int nthr = gridDim.x * NTHR;
  for (int run = obid() * NTHR + otid(); run < 1024 * 352; run += nthr) {
    const int ch = run / 352, j8 = run % 352, j0 = j8 * 8;
    float w0[8], w1[8], w2[8];
#pragma unroll
    for (int e = 0; e < 8; ++e) { w0[e] = cw[j0 + e]; w1[e] = cw[FFN + j0 + e]; w2[e] = cw[2 * FFN + j0 + e]; }
    const int t0 = ch * 64, s0 = t0 % SEQ;
    float a1[8], a2[8];
#pragma unroll
    for (int e = 0; e < 8; ++e) { a1[e] = 0.f; a2[e] = 0.f; }
    if (s0 > 0) {
      bf16x8 v1 = *(const bf16x8*)(AU + (size_t)(t0 - 1) * AUS + j0);
      bf16x8 v2 = *(const bf16x8*)(AU + (size_t)(t0 - 2) * AUS + j0);
#pragma unroll
      for (int e = 0; e < 8; ++e) { a1[e] = bf2f((bf16_t)v1[e]); a2[e] = bf2f((bf16_t)v2[e]); }
    }
    for (int t = t0; t < t0 + 64; ++t) {
      bf16x8 va = *(const bf16x8*)(AU + (size_t)t * AUS + j0);
      bf16x8 vu = *(const bf16x8*)(AU + (size_t)t * AUS + FFN + j0);
      float o[8];
#pragma unroll
      for (int e = 0; e < 8; ++e) {
        float a0 = bf2f((bf16_t)va[e]);
        float cv = w0[e] * a2[e] + w1[e] * a1[e] + w2[e] * a0;
        o[e] = geluf_(cv) * bf2f((bf16_t)vu[e]);
        a2[e] = a1[e]; a1[e] = a0;
      }
      uint4 ov = {pack2(o[0], o[1]), pack2(o[2], o[3]), pack2(o[4], o[5]), pack2(o[6], o[7])};
      *(uint4*)(AU + (size_t)t * AUS + FFN + j0) = ov;
    }
  }
}

DI float mixf(bf16_t cur, bf16_t prev, float mu) { const float c = bf2f(cur); return c + (bf2f(prev) - c) * mu; }
DI void rw_prep_item(const Params& p, int l, int item, char* smem) {
  const bf16_t* P = (const bf16_t*)(p.ws + OFF_P);
  bf16_t* RD = (bf16_t*)(p.ws + OFF_L);
  bf16_t* RKK = (bf16_t*)(p.ws + OFF_L + GSZ);
  bf16_t* RA = (bf16_t*)(p.ws + OFF_L + 2 * GSZ);
  bf16_t* RG = (bf16_t*)(p.ws + OFF_L + 3 * GSZ);
  float* BON = (float*)(p.ws + OFF_BON);
  const int b = item >> 6, ct = item & 63;
  const int tid = otid(), lane = tid & 63, wv = tid >> 6, hd = wv & 3, mi = wv >> 2, r = lane & 31, h = lane >> 5;
  bf16_t* TX = (bf16_t*)smem;
  bf16_t* XA = TX + 64 * 40;
  bf16_t* SG = XA + 64 * 40;
  const float* mu = p.in[I_RMU] + (size_t)l * 896;
  const size_t tok0 = (size_t)b * SEQ + ct * 64;
  bf16x8 bw[2][2], ba[2][2], bg[2][4];
  {
    const float* wp = p.in[I_RWUP] + (size_t)l * 32 * 256 + hd * 64 + r;
    const float* ap = p.in[I_RAUP] + (size_t)l * 32 * 256 + hd * 64 + r;
    const float* gp = p.in[I_RGUP] + (size_t)l * 64 * 256 + hd * 64 + r;
    asm volatile("" : "+v"(wp), "+v"(ap), "+v"(gp));
#pragma unroll
    for (int ni = 0; ni < 2; ++ni) {
#pragma unroll
      for (int ks = 0; ks < 2; ++ks) {
        unsigned uw[4], ua[4];
#pragma unroll
        for (int j2 = 0; j2 < 4; ++j2) {
          const int k = 16 * ks + 8 * h + 2 * j2;
          uw[j2] = pack2(wp[k * 256 + 32 * ni], wp[(k + 1) * 256 + 32 * ni]);
          ua[j2] = pack2(ap[k * 256 + 32 * ni], ap[(k + 1) * 256 + 32 * ni]);
        }
        uint4 t1 = {uw[0], uw[1], uw[2], uw[3]}, t2 = {ua[0], ua[1], ua[2], ua[3]};
        bw[ni][ks] = __builtin_bit_cast(bf16x8, t1); ba[ni][ks] = __builtin_bit_cast(bf16x8, t2);
      }
#pragma unroll
      for (int ks = 0; ks < 4; ++ks) {
        unsigned ug[4];
#pragma unroll
        for (int j2 = 0; j2 < 4; ++j2) { const int k = 16 * ks + 8 * h + 2 * j2; ug[j2] = pack2(gp[k * 256 + 32 * ni], gp[(k + 1) * 256 + 32 * ni]); }
        uint4 t3 = {ug[0], ug[1], ug[2], ug[3]};
        bg[ni][ks] = __builtin_bit_cast(bf16x8, t3);
      }
    }
  }
#pragma unroll 4
  for (int i = 0; i < 16; ++i) {
    const int e = tid + NTHR * i; const int t = e >> 7, f = e & 127;
    const bf16_t* pr = P + (tok0 + t) * PSTR + C_RW + 768 + f;
    const bf16_t cur = pr[0];
    const bf16_t prev = (ct * 64 + t > 0) ? (pr - PSTR)[0] : (bf16_t)0;
    const float m = mixf(cur, prev, mu[768 + f]);
    if (f < 32) TX[t * 40 + f] = f2bf(tanhf_(m));
    else if (f < 64) XA[t * 40 + f - 32] = f2bf(m);
    else SG[t * 72 + f - 64] = f2bf(sigmoidf_(m));
  }
  __syncthreads();
  f32x16 cw[2], ca[2], cg[2];
#pragma unroll
  for (int ni = 0; ni < 2; ++ni)
#pragma unroll
    for (int i = 0; i < 16; ++i) { cw[ni][i] = 0.f; ca[ni][i] = 0.f; cg[ni][i] = 0.f; }
#pragma unroll
  for (int ks = 0; ks < 2; ++ks) {
    const bf16x8 atx = *(const bf16x8*)(TX + (32 * mi + r) * 40 + 16 * ks + 8 * h);
    const bf16x8 axa = *(const bf16x8*)(XA + (32 * mi + r) * 40 + 16 * ks + 8 * h);
#pragma unroll
    for (int ni = 0; ni < 2; ++ni) { cw[ni] = mfma32(atx, bw[ni][ks], cw[ni]); ca[ni] = mfma32(axa, ba[ni][ks], ca[ni]); }
  }
#pragma unroll
  for (int ks = 0; ks < 4; ++ks) {
    const bf16x8 asg = *(const bf16x8*)(SG + (32 * mi + r) * 72 + 16 * ks + 8 * h);
#pragma unroll
    for (int ni = 0; ni < 2; ++ni) cg[ni] = mfma32(asg, bg[ni][ks], cg[ni]);
  }
  float ss[16], bn[16];
#pragma unroll
  for (int i = 0; i < 16; ++i) { ss[i] = 0.f; bn[i] = 0.f; }
#pragma unroll
  for (int ni = 0; ni < 2; ++ni) {
    const int hc = hd * 64 + 32 * ni + r;
    const float w0c = p.in[I_RW0][l * 256 + hc], a0c = p.in[I_RA0][l * 256 + hc], kkc = p.in[I_RKK][l * 256 + hc],
                kac = p.in[I_RKA][l * 256 + hc], rkc = p.in[I_RRK][l * 256 + hc], mu_r = mu[hc], mu_k = mu[256 + hc];
#pragma unroll
    for (int i = 0; i < 16; ++i) {
      const int tl = 32 * mi + crow(i, h);
      const size_t tok = tok0 + tl;
      const bf16_t* pr = P + tok * PSTR + C_RW + hc;
      const bool hp = (ct * 64 + tl) > 0;
      const float rr = mixf(pr[0], hp ? (pr - PSTR)[0] : (bf16_t)0, mu_r);
      const float k = mixf(pr[256], hp ? (pr - PSTR)[256] : (bf16_t)0, mu_k);
      const float wl = w0c + cw[ni][i];
      const float wlog = -softplusf_(-wl) - 0.5f;
      const float dd = 1.f - __expf(-__expf(wlog));
      const float a = sigmoidf_(a0c + ca[ni][i]);
      const float kkr = k * kkc;
      const float kp = k * (1.f + (a - 1.f) * kac);
      ss[i] += kkr * kkr; bn[i] += rr * kp * rkc;
      cw[ni][i] = kkr;
      RD[tok * 256 + hc] = f2bf(dd); RA[tok * 256 + hc] = f2bf(a); RG[tok * 256 + hc] = f2bf(cg[ni][i]);
    }
  }
#pragma unroll
  for (int i = 0; i < 16; ++i) {
#pragma unroll
    for (int o = 1; o < 32; o <<= 1) { ss[i] += __shfl_xor(ss[i], o); bn[i] += __shfl_xor(bn[i], o); }
    ss[i] = rsqrtf(ss[i] + EPSF);
  }
#pragma unroll
  for (int ni = 0; ni < 2; ++ni) {
    const int hc = hd * 64 + 32 * ni + r;
#pragma unroll
    for (int i = 0; i < 16; ++i) {
      const size_t tok = tok0 + 32 * mi + crow(i, h);
      RKK[tok * 256 + hc] = f2bf(cw[ni][i] * ss[i]);
    }
  }
  if (r == 0) {
#pragma unroll
    for (int i = 0; i < 16; ++i) BON[(tok0 + 32 * mi + crow(i, h)) * 4 + hd] = bn[i];
  }
}

DI void rwkv_scan_item(const Params& p, int l, int b, int hd, int half, char* smem) {
  const bf16_t* P = (const bf16_t*)(p.ws + OFF_P);
  bf16_t* O = (bf16_t*)(p.ws + OFF_O);
  const bf16_t* RD = (const bf16_t*)(p.ws + OFF_L);
  const bf16_t* RKK = (const bf16_t*)(p.ws + OFF_L + GSZ);
  const bf16_t* RA = (const bf16_t*)(p.ws + OFF_L + 2 * GSZ);
  float* fb = (float*)smem;
  float* Yb = fb + 2 * 6208;
  const int tid = otid(), lane = tid & 63, wv = tid >> 6;
  const int hc = hd * 64 + lane;
  constexpr int NCH = SEQ / 16;
  float S[8];
#pragma unroll
  for (int j = 0; j < 8; ++j) S[j] = 0.f;
  const int rl = lane >> 3, kq = lane & 7, vloc = (wv & 3) * 8 + rl, vrow = half * 32 + vloc;
  const float* mu = p.in[I_RMU] + (size_t)l * 896;
  const float mu_r = mu[hc], mu_k = mu[256 + hc], mu_v = mu[512 + hc];
  const float kac = p.in[I_RKA][l * 256 + hc];
  const int pw = wv & 3;
  unsigned raw[4][9];
#pragma unroll
  for (int j = 0; j < 4; ++j)
#pragma unroll
    for (int e = 0; e < 9; ++e) raw[j][e] = 0u;
#define RAWLOAD(i_)                                                                                 \
  {                                                                                                 \
    _Pragma("unroll") for (int j = 0; j < 4; ++j) {                                                 \
      const int s_ = (i_) * 16 + pw * 4 + j;                                                        \
      const size_t tok_ = (size_t)b * SEQ + s_;                                                     \
      const bf16_t* pr_ = P + tok_ * PSTR + C_RW;                                                   \
      raw[j][0] = pr_[hc]; raw[j][1] = pr_[256 + hc]; raw[j][2] = pr_[512 + hc];                    \
      if (s_ > 0) { raw[j][3] = (pr_ - PSTR)[hc]; raw[j][4] = (pr_ - PSTR)[256 + hc]; raw[j][5] = (pr_ - PSTR)[512 + hc]; } \
      else { raw[j][3] = 0u; raw[j][4] = 0u; raw[j][5] = 0u; }                                      \
      raw[j][6] = RD[tok_ * 256 + hc]; raw[j][7] = RKK[tok_ * 256 + hc]; raw[j][8] = RA[tok_ * 256 + hc]; \
    }                                                                                               \
  }
#define RBAR() { asm volatile("s_waitcnt lgkmcnt(0)" ::: "memory"); __builtin_amdgcn_s_barrier(); asm volatile("" ::: "memory"); }
  if (wv >= 4) RAWLOAD(0);
#pragma unroll 1
  for (int i = 0; i < NCH + 2; ++i) {
    if (wv >= 4) {
      float* B = fb + (i & 1) * 6208;
      if (i >= 2) {
        const float* Yc = Yb + (i & 1) * 512;
        if (lane < 32) {
#pragma unroll
          for (int j = 0; j < 4; ++j) {
            const int tl = pw * 4 + j;
            const size_t tok = (size_t)b * SEQ + (i - 2) * 16 + tl;
            O[tok * DM + 768 + hd * 64 + half * 32 + lane] = f2bf(Yc[tl * 32 + lane]);
          }
        }
      }
      if (i < NCH) {
#pragma unroll
        for (int j = 0; j < 4; ++j) {
          const int tl = pw * 4 + j;
          const float r = mixf((bf16_t)raw[j][0], (bf16_t)raw[j][3], mu_r), k = mixf((bf16_t)raw[j][1], (bf16_t)raw[j][4], mu_k), v = mixf((bf16_t)raw[j][2], (bf16_t)raw[j][5], mu_v);
          const float w = 1.f - bf2f((bf16_t)raw[j][6]), kk = bf2f((bf16_t)raw[j][7]), a = bf2f((bf16_t)raw[j][8]);
          const float ka = kk * a, kp = k * (1.f + (a - 1.f) * kac);
          const float c1 = wave_sum(ka * r), c2 = wave_sum(kp * r);
          B[tl * 64 + lane] = w; B[1024 + tl * 64 + lane] = kk; B[2048 + tl * 64 + lane] = ka; B[3072 + tl * 64 + lane] = kp;
          B[4096 + tl * 64 + lane] = w * r; B[5120 + tl * 64 + lane] = v;
          if (lane == 0) { B[6144 + tl * 2] = c1; B[6144 + tl * 2 + 1] = c2; }
        }
        if (i + 1 < NCH) RAWLOAD(i + 1);
      }
    } else if (i >= 1 && i <= NCH) {
      const float* B = fb + ((i - 1) & 1) * 6208;
      float* Yc = Yb + ((i - 1) & 1) * 512;
      f32x4 vw[2][10]; float vvv[2]; float2 vsc[2];
#define RWLD(t_, s_)                                                                              \
      { const float* bt_ = B + (t_) * 64 + kq * 8;                                                 \
        _Pragma("unroll") for (int q_ = 0; q_ < 5; ++q_) { vw[s_][2 * q_] = *(const f32x4*)(bt_ + 1024 * q_); vw[s_][2 * q_ + 1] = *(const f32x4*)(bt_ + 1024 * q_ + 4); } \
        vvv[s_] = B[5120 + (t_) * 64 + vrow]; vsc[s_] = *(const float2*)(B + 6144 + (t_) * 2); }
      RWLD(0, 0);
#pragma unroll
      for (int t = 0; t < 16; ++t) {
        const int cs = t & 1;
        if (t + 1 < 16) RWLD(t + 1, cs ^ 1);
        const f32x4 w0 = vw[cs][0], w1 = vw[cs][1], kk0 = vw[cs][2], kk1 = vw[cs][3], ka0 = vw[cs][4], ka1 = vw[cs][5],
                    kp0 = vw[cs][6], kp1 = vw[cs][7], wr0 = vw[cs][8], wr1 = vw[cs][9];
        const float vv = vvv[cs]; const float2 sc = vsc[cs];
        float d0 = 0.f, e0 = 0.f;
#pragma unroll
        for (int j = 0; j < 4; ++j) { d0 += S[j] * kk0[j] + S[j + 4] * kk1[j]; e0 += S[j] * wr0[j] + S[j + 4] * wr1[j]; }
        d0 = reduce8(d0); e0 = reduce8(e0);
        const float sa0 = -d0;
        const float y0 = e0 + sa0 * sc.x + vv * sc.y;
#pragma unroll
        for (int j = 0; j < 4; ++j) {
          S[j] = S[j] * w0[j] + sa0 * ka0[j] + vv * kp0[j]; S[j + 4] = S[j + 4] * w1[j] + sa0 * ka1[j] + vv * kp1[j];
        }
        if (kq == 0) Yc[t * 32 + vloc] = y0;
      }
#undef RWLD
    }
    RBAR();
  }
#undef RAWLOAD
#undef RBAR
}

DI void rwkv_post(const Params& p, int l) {
  const bf16_t* P = (const bf16_t*)(p.ws + OFF_P);
  bf16_t* O = (bf16_t*)(p.ws + OFF_O);
  const bf16_t* RG = (const bf16_t*)(p.ws + OFF_L + 3 * GSZ);
  const float* BON = (const float*)(p.ws + OFF_BON);
  const int tid = otid(), lane = tid & 63, wv = tid >> 6;
  const float* mu = p.in[I_RMU] + (size_t)l * 896;
  const int nw = gridDim.x * 8;
  for (int task0 = (obid() * 8 + wv) * 4; task0 < NTOK * 4; task0 += nw * 4) {
    float yv[4], vv[4], gv[4], bv[4];
#pragma unroll
    for (int q = 0; q < 4; ++q) {
      const int task = task0 + q; const size_t tok = task >> 2; const int hd = task & 3, hc = hd * 64 + lane;
      yv[q] = bf2f(O[tok * DM + 768 + hc]);
      const bf16_t cur = P[tok * PSTR + C_RW + 512 + hc];
      const bf16_t prev = (tok % SEQ) ? P[(tok - 1) * PSTR + C_RW + 512 + hc] : (bf16_t)0;
      vv[q] = mixf(cur, prev, mu[512 + hc]);
      gv[q] = bf2f(RG[tok * 256 + hc]); bv[q] = BON[tok * 4 + hd];
    }
#pragma unroll
    for (int q = 0; q < 4; ++q) {
      const int task = task0 + q; const size_t tok = task >> 2; const int hd = task & 3, hc = hd * 64 + lane;
      const float mean = wave_sum(yv[q]) * (1.f / 64.f);
      const float d = yv[q] - mean;
      const float var = wave_sum(d * d) * (1.f / 64.f);
      const float yn = d * rsqrtf(var + 64e-5f) * p.in[I_RLG][l * 256 + hc] + p.in[I_RLB][l * 256 + hc];
      O[tok * DM + 768 + hc] = f2bf((yn + bv[q] * vv[q]) * gv[q]);
    }
  }
}

DI void sb_item(const Params& p, int item, char* smem) {
  const bf16_t* P = (const bf16_t*)(p.ws + OFF_P);
  bf16_t* O = (bf16_t*)(p.ws + OFF_O);
  const int qt = item & 15, hd = (item >> 4) & 3, b = item >> 6;
  const int tid = otid(), lane = tid & 63, wv = tid >> 6, r = lane & 31, h = lane >> 5;
  bf16_t* Vt = (bf16_t*)(smem + wv * 8704);
  const int q0 = qt * 256 + wv * 32;
  const int sq = q0 + r;
  const size_t tokb = (size_t)b * SEQ;
  bf16x8 qf[4];
#pragma unroll
  for (int ks = 0; ks < 4; ++ks) qf[ks] = *(const bf16x8*)(P + (tokb + sq) * PSTR + C_SB_Q + hd * 64 + ks * 16 + h * 8);
  f32x16 accO[2];
#pragma unroll
  for (int i = 0; i < 16; ++i) { accO[0][i] = 0.f; accO[1][i] = 0.f; }
  float Prun = 1.f;
  bf16x8 kf[2][4];
  const int kt0 = (q0 + 31) >> 6;
#define SBKLOAD(kt_) { _Pragma("unroll") for (int m = 0; m < 2; ++m) _Pragma("unroll") for (int ks = 0; ks < 4; ++ks) \
    kf[m][ks] = *(const bf16x8*)(P + (tokb + (kt_) * 64 + 32 * m + r) * PSTR + C_SB_K + hd * 64 + ks * 16 + h * 8); }
  SBKLOAD(kt0);
  for (int kt = kt0; kt >= 0; --kt) {
    const int k0 = kt * 64;
    bf16x8 vr[8];
#pragma unroll
    for (int it = 0; it < 8; ++it) vr[it] = *(const bf16x8*)(P + (tokb + k0 + it * 8 + (lane >> 3)) * PSTR + C_SB_V + hd * 64 + (lane & 7) * 8);
    f32x16 acc[2];
#pragma unroll
    for (int m = 0; m < 2; ++m) {
#pragma unroll
      for (int i = 0; i < 16; ++i) acc[m][i] = 0.f;
#pragma unroll
      for (int ks = 0; ks < 4; ++ks) acc[m] = mfma32(kf[m][ks], qf[ks], acc[m]);
    }
    if (kt > 0) SBKLOAD(kt - 1);
    float om[2][16];
#pragma unroll
    for (int m = 0; m < 2; ++m)
#pragma unroll
      for (int i = 0; i < 16; ++i) {
        const int key = k0 + 32 * m + crow(i, h);
        const float z = fmaxf(acc[m][i] * 0.125f, -80.f);
        const float e = __expf(-z);
        const float sg = __builtin_amdgcn_rcpf(1.f + e);
        const bool valid = key < sq;
        acc[m][i] = valid ? sg : 0.f;
        om[m][i] = valid ? e * sg : 1.f;
      }
    float gp[8];
#pragma unroll
    for (int q = 0; q < 8; ++q) {
      const int m = q >> 2, g = q & 3;
      gp[q] = (om[m][4 * g] * om[m][4 * g + 1]) * (om[m][4 * g + 2] * om[m][4 * g + 3]);
    }
    float run = 1.f;
#pragma unroll
    for (int q = 7; q >= 0; --q) {
      const int m = q >> 2, g = q & 3;
      const float pg = __shfl_xor(gp[q], 32);
      const float f3 = Prun * run * (h == 0 ? pg : 1.f);
      const float f2 = f3 * om[m][4 * g + 3], f1 = f2 * om[m][4 * g + 2], f0 = f1 * om[m][4 * g + 1];
      acc[m][4 * g + 3] *= f3; acc[m][4 * g + 2] *= f2; acc[m][4 * g + 1] *= f1; acc[m][4 * g + 0] *= f0;
      run *= gp[q] * pg;
    }
    Prun *= run;
    __builtin_amdgcn_wave_barrier();
#pragma unroll
    for (int it = 0; it < 8; ++it) {
      const int key = it * 8 + (lane >> 3), chv = lane & 7;
#pragma unroll
      for (int e = 0; e < 8; ++e) Vt[(chv * 8 + e) * 68 + key] = (bf16_t)vr[it][e];
    }
    __builtin_amdgcn_wave_barrier();
#pragma unroll
    for (int m = 0; m < 2; ++m)
#pragma unroll
      for (int s2 = 0; s2 < 2; ++s2) {
        uint4 uu = {pack2(acc[m][8 * s2 + 0], acc[m][8 * s2 + 1]), pack2(acc[m][8 * s2 + 2], acc[m][8 * s2 + 3]),
                    pack2(acc[m][8 * s2 + 4], acc[m][8 * s2 + 5]), pack2(acc[m][8 * s2 + 6], acc[m][8 * s2 + 7])};
        const bf16x8 pb = __builtin_bit_cast(bf16x8, uu);
#pragma unroll
        for (int dt = 0; dt < 2; ++dt) {
          const bf16_t* vp = Vt + (32 * dt + r) * 68 + 32 * m + 16 * s2 + 4 * h;
          s16x4 lo = *(const s16x4*)vp, hi = *(const s16x4*)(vp + 8);
          bf16x8 va = __builtin_shufflevector(lo, hi, 0, 1, 2, 3, 4, 5, 6, 7);
          accO[dt] = mfma32(va, pb, accO[dt]);
        }
      }
    __builtin_amdgcn_wave_barrier();
    if (__ballot(Prun > 1e-37f) == 0ull) break;
  }
#undef SBKLOAD
#pragma unroll
  for (int dt = 0; dt < 2; ++dt)
#pragma unroll
    for (int g = 0; g < 4; ++g) {
      const int d = 32 * dt + 8 * g + 4 * h;
      uint2 o = {pack2(accO[dt][4 * g], accO[dt][4 * g + 1]), pack2(accO[dt][4 * g + 2], accO[dt][4 * g + 3])};
      *(uint2*)(O + (tokb + sq) * DM + 256 + hd * 64 + d) = o;
    }
}

DI int frag_off(int row, int k) {
  const int rt = row >> 4, fr = row & 15, ks = k >> 5, kk = k & 31, hi = kk >> 4, fq = (kk & 15) >> 2, j = (kk & 3) + 4 * hi;
  return ((rt * 2 + ks) * 64 + fq * 16 + fr) * 8 + j;
}
DI int frag_off8(int row, int k0) {
  const int rt = row >> 4, fr = row & 15, ks = k0 >> 5, kk = k0 & 31, hi = kk >> 4, fq = (kk & 15) >> 2;
  return ((rt * 2 + ks) * 64 + fq * 16 + fr) * 8 + 4 * hi;
}
DI void gdn_intra_item(const Params& p, int l, int item, char* smem) {
  const bf16_t* P = (const bf16_t*)(p.ws + OFF_P);
  const int hp = item & 1, c = (item >> 1) & 63, b = item >> 7;
  const int tid = otid(), lane = tid & 63;
  bf16_t* Kb = (bf16_t*)smem;
  bf16_t* Qb = Kb + 2 * 64 * 72;
  bf16_t* Vb = Qb + 2 * 64 * 72;
  float* Lm = (float*)(smem + 3 * 2 * 64 * 72 * 2);
  float* Gs = Lm + 2 * 4096;
  float* Bs = Gs + 128;
  const size_t tok0 = (size_t)b * SEQ + c * 64;
  const float* cw = p.in[I_GCW] + (size_t)l * 4 * 768;
  float* CW = Bs + 128;
  for (int e = tid; e < 6 * 4 * 64; e += NTHR) {
    const int blk = e >> 8, j = (e >> 6) & 3, col = e & 63;
    const int hh_ = blk / 3, which_ = blk % 3;
    CW[e] = cw[j * 768 + which_ * 256 + (hp * 2 + hh_) * 64 + col];
  }
  __syncthreads();
  {
    const int t = tid >> 3, cg = tid & 7;
#pragma unroll 3
    for (int it = 0; it < 6; ++it) {
      const int hh = it / 3, which = it % 3, head = hp * 2 + hh;
      const int ccol = which * 256 + head * 64 + cg * 8;
      float acc[8];
#pragma unroll
      for (int e = 0; e < 8; ++e) acc[e] = 0.f;
#pragma unroll
      for (int j = 0; j < 4; ++j) {
        const int s = c * 64 + t - 3 + j;
        if (s >= 0) {
          bf16x8 xv = *(const bf16x8*)(P + ((size_t)b * SEQ + s) * PSTR + C_GDN_Q + ccol);
          f32x4 wa = *(const f32x4*)(CW + (it * 4 + j) * 64 + cg * 8), wb = *(const f32x4*)(CW + (it * 4 + j) * 64 + cg * 8 + 4);
#pragma unroll
          for (int e = 0; e < 4; ++e) { acc[e] += wa[e] * bf2f((bf16_t)xv[e]); acc[e + 4] += wb[e] * bf2f((bf16_t)xv[e + 4]); }
        }
      }
      float ss = 0.f;
#pragma unroll
      for (int e = 0; e < 8; ++e) { acc[e] = siluf_(acc[e]); ss += acc[e] * acc[e]; }
      ss += __shfl_xor(ss, 1); ss += __shfl_xor(ss, 2); ss += __shfl_xor(ss, 4);
      float sc = 1.f;
      if (which == 0) sc = rsqrtf(ss + EPSF) * 0.125f;
      else if (which == 1) sc = rsqrtf(ss + EPSF);
      uint4 ov = {pack2(acc[0] * sc, acc[1] * sc), pack2(acc[2] * sc, acc[3] * sc), pack2(acc[4] * sc, acc[5] * sc), pack2(acc[6] * sc, acc[7] * sc)};
      bf16_t* dst = (which == 0 ? Qb : (which == 1 ? Kb : Vb)) + (hh * 64 + t) * 72 + cg * 8;
      *(uint4*)dst = ov;
    }
  }
  if (tid < 128) {
    const int hh = tid >> 6, t = lane, head = hp * 2 + hh;
    const float a_in = bf2f(P[(tok0 + t) * PSTR + C_GDN_A + head]);
    const float b_in = bf2f(P[(tok0 + t) * PSTR + C_GDN_B + head]);
    const float beta = sigmoidf_(b_in);
    float g = -__expf(p.in[I_GAL][l * 4 + head]) * softplusf_(a_in + p.in[I_GDT][l * 4 + head]);
#pragma unroll
    for (int d = 1; d < 64; d <<= 1) { float v = __shfl_up(g, d); if (lane >= d) g += v; }
    Gs[hh * 64 + t] = g; Bs[hh * 64 + t] = beta;
  }
  __syncthreads();
  const int hh = tid >> 8, lt = tid & 255, head = hp * 2 + hh;
  const size_t ih = ((size_t)(b * 4 + head)) * 64 + c;
  bf16_t* GW = (bf16_t*)(p.ws + OFF_G) + ih * 4096;
  bf16_t* GQD = (bf16_t*)(p.ws + OFF_G + GSZ) + ih * 4096;
  bf16_t* GQK = (bf16_t*)(p.ws + OFF_G + 2 * GSZ) + ih * 4096;
  bf16_t* GKD = (bf16_t*)(p.ws + OFF_G + 3 * GSZ) + ih * 4096;
  bf16_t* GU = (bf16_t*)(p.ws + OFF_G + 4 * GSZ) + ih * 4096;
  float* GCD = (float*)(p.ws + OFF_GCD);
  const float* Gh = Gs + hh * 64; const float* Bh = Bs + hh * 64;
  {
    const int wq = (tid >> 6) & 3, ti = wq >> 1, tj = wq & 1, r = lane & 31, h = lane >> 5;
    f32x16 akk, aqk;
#pragma unroll
    for (int i = 0; i < 16; ++i) { akk[i] = 0.f; aqk[i] = 0.f; }
    if (ti >= tj) {
#pragma unroll
      for (int ks = 0; ks < 4; ++ks) {
        bf16x8 ka = *(const bf16x8*)(Kb + (hh * 64 + 32 * ti + r) * 72 + ks * 16 + h * 8);
        bf16x8 qa = *(const bf16x8*)(Qb + (hh * 64 + 32 * ti + r) * 72 + ks * 16 + h * 8);
        bf16x8 kb = *(const bf16x8*)(Kb + (hh * 64 + 32 * tj + r) * 72 + ks * 16 + h * 8);
        akk = mfma32(ka, kb, akk);
        aqk = mfma32(qa, kb, aqk);
      }
    }
    const int j = 32 * tj + r;
    const float Gj = Gh[j];
#pragma unroll
    for (int i_ = 0; i_ < 16; ++i_) {
      const int i = 32 * ti + crow(i_, h);
      const float dec = (i >= j) ? __expf(Gh[i] - Gj) : 0.f;
      Lm[hh * 4096 + i * 64 + j] = (i > j) ? Bh[i] * akk[i_] * dec : 0.f;
      GQK[frag_off(i, j)] = f2bf((i >= j) ? aqk[i_] * dec : 0.f);
    }
  }
  __syncthreads();
  if (lt < 128) {
    const int cc = lt;
    float x[64];
    if (cc < 64) {
#pragma unroll
      for (int i = 0; i < 64; ++i) x[i] = bf2f(Vb[(hh * 64 + i) * 72 + cc]) * Bh[i];
    } else {
#pragma unroll
      for (int i = 0; i < 64; ++i) x[i] = bf2f(Kb[(hh * 64 + i) * 72 + cc - 64]) * Bh[i] * __expf(Gh[i]);
    }
    const float* Lh = Lm + hh * 4096;
#pragma unroll
    for (int i = 1; i < 64; ++i) {
      float s = x[i];
#pragma unroll
      for (int j4 = 0; j4 < (i + 3) / 4; ++j4) {
        const f32x4 lv = *(const f32x4*)(Lh + i * 64 + j4 * 4);
#pragma unroll
        for (int e = 0; e < 4; ++e) if (j4 * 4 + e < i) s -= lv[e] * x[j4 * 4 + e];
      }
      x[i] = s;
    }
    if (cc < 64) {
      const int split = cc >> 4, fr = cc & 15;
#pragma unroll
      for (int i4 = 0; i4 < 16; ++i4) {
        uint2 ov = {pack2(x[4 * i4], x[4 * i4 + 1]), pack2(x[4 * i4 + 2], x[4 * i4 + 3])};
        *(uint2*)(GU + ((split * 4 + (i4 >> 2)) * 64 + (i4 & 3) * 16 + fr) * 4) = ov;
      }
    } else {
#pragma unroll
      for (int i = 0; i < 64; ++i) GW[frag_off(i, cc - 64)] = f2bf(x[i]);
    }
  } else {
    const int q_ = lt - 128;
    const float Glast = Gh[63];
#pragma unroll
    for (int i = 0; i < 4; ++i) {
      const int q = q_ + 128 * i; const int pos = q >> 3, kc = q & 7;
      bf16x8 qv = *(const bf16x8*)(Qb + (hh * 64 + pos) * 72 + kc * 8);
      const float eg = __expf(Gh[pos]);
      uint4 ov = {pack2(bf2f((bf16_t)qv[0]) * eg, bf2f((bf16_t)qv[1]) * eg), pack2(bf2f((bf16_t)qv[2]) * eg, bf2f((bf16_t)qv[3]) * eg),
                  pack2(bf2f((bf16_t)qv[4]) * eg, bf2f((bf16_t)qv[5]) * eg), pack2(bf2f((bf16_t)qv[6]) * eg, bf2f((bf16_t)qv[7]) * eg)};
      { const int fo = frag_off8(pos, kc * 8); uint2 o0 = {ov.x, ov.y}, o1 = {ov.z, ov.w}; *(uint2*)(GQD + fo) = o0; *(uint2*)(GQD + fo + 128) = o1; }
    }
#pragma unroll
    for (int i = 0; i < 4; ++i) {
      const int q = q_ + 128 * i; const int k = q >> 3, pc = q & 7;
      float o[8];
#pragma unroll
      for (int e = 0; e < 8; ++e) { const int pos = pc * 8 + e; o[e] = bf2f(Kb[(hh * 64 + pos) * 72 + k]) * __expf(Glast - Gh[pos]); }
      uint4 ov = {pack2(o[0], o[1]), pack2(o[2], o[3]), pack2(o[4], o[5]), pack2(o[6], o[7])};
      { const int fo = frag_off8(k, pc * 8); uint2 o0 = {ov.x, ov.y}, o1 = {ov.z, ov.w}; *(uint2*)(GKD + fo) = o0; *(uint2*)(GKD + fo + 128) = o1; }
    }
    if (q_ == 0) GCD[ih] = __expf(Glast);
  }
}

DI void gdn_rec_item(const Params& p, int l, int b, int head, char* smem) {
  const bf16_t* P = (const bf16_t*)(p.ws + OFF_P);
  bf16_t* O = (bf16_t*)(p.ws + OFF_O);
  float* SS = (float*)(smem + 81920);
  const int tid = otid(), lane = tid & 63, wv = tid >> 6, fr = lane & 15, fq = lane >> 4;
  const int split = wv & 3;
  const bool active = wv < 4;
  const float ng = p.in[I_GNG][l * 64 + split * 16 + fr];
  const float* GCD = (const float*)(p.ws + OFF_GCD);
  const size_t ih0 = ((size_t)(b * 4 + head)) * 64;
  f32x4 S[4];
#pragma unroll
  for (int kt = 0; kt < 4; ++kt) S[kt] = (f32x4){0.f, 0.f, 0.f, 0.f};
  u32x4 lr[10];
#pragma unroll
  for (int i = 0; i < 10; ++i) lr[i] = (u32x4){0u, 0u, 0u, 0u};
  const int lq = (wv & 3) * 64 + lane;
#define GLOADC(c_)                                                                              \
  {                                                                                             \
    _Pragma("unroll") for (int i = 0; i < 10; ++i) {                                            \
      const int q_ = lq + 256 * i; const int a_ = q_ >> 9, o_ = q_ & 511;                       \
      lr[i] = *(const u32x4*)((const bf16_t*)(p.ws + OFF_G + (size_t)a_ * GSZ) + (ih0 + (c_)) * 4096 + o_ * 8); \
    }                                                                                           \
  }
#define LSTORE(buf_)                                                                            \
  {                                                                                             \
    _Pragma("unroll") for (int i = 0; i < 10; ++i) {                                            \
      const int q_ = lq + 256 * i;                                                              \
      *(u32x4*)(smem + (buf_) * 40960 + q_ * 16) = lr[i];                                       \
    }                                                                                           \
  }
#define BAR_LDS() { asm volatile("s_waitcnt lgkmcnt(0)" ::: "memory"); __builtin_amdgcn_s_barrier(); asm volatile("" ::: "memory"); }
  float cdn = 0.f;
  if (!active) { GLOADC(0); LSTORE(0); GLOADC(1); }
  else cdn = GCD[ih0];
  BAR_LDS();
#pragma unroll 1
  for (int c = 0; c < 64; ++c) {
    f32x4 acco[4];
    if (active) {
      const char* bufp = smem + (c & 1) * 40960;
      const float cd = cdn;
      if (c + 1 < 64) cdn = GCD[ih0 + c + 1];
      float zr[16];
#pragma unroll
      for (int rt = 0; rt < 4; ++rt)
#pragma unroll
        for (int j = 0; j < 4; ++j) {
          const size_t tok = (size_t)b * SEQ + c * 64 + 16 * rt + 4 * fq + j;
          zr[rt * 4 + j] = bf2f(P[tok * PSTR + C_GDN_Z + head * 64 + split * 16 + fr]);
        }
      bf16x8 bS[2];
#pragma unroll
      for (int ks = 0; ks < 2; ++ks) {
        uint4 uu = {pack2(S[2 * ks][0], S[2 * ks][1]), pack2(S[2 * ks][2], S[2 * ks][3]), pack2(S[2 * ks + 1][0], S[2 * ks + 1][1]), pack2(S[2 * ks + 1][2], S[2 * ks + 1][3])};
        bS[ks] = __builtin_bit_cast(bf16x8, uu);
      }
      f32x4 u[4];
#pragma unroll
      for (int rt = 0; rt < 4; ++rt) {
        f32x4 aw = {0.f, 0.f, 0.f, 0.f};
        acco[rt] = (f32x4){0.f, 0.f, 0.f, 0.f};
#pragma unroll
        for (int ks = 0; ks < 2; ++ks) {
          const bf16x8 wa = *(const bf16x8*)(bufp + ((rt * 2 + ks) * 64 + lane) * 16);
          const bf16x8 qa = *(const bf16x8*)(bufp + 8192 + ((rt * 2 + ks) * 64 + lane) * 16);
          aw = mfma16(wa, bS[ks], aw); acco[rt] = mfma16(qa, bS[ks], acco[rt]);
        }
        const s16x4 uv = *(const s16x4*)(bufp + 32768 + ((split * 4 + rt) * 64 + lane) * 8);
#pragma unroll
        for (int j = 0; j < 4; ++j) u[rt][j] = bf2f((bf16_t)uv[j]) - aw[j];
      }
      bf16x8 bU[2];
#pragma unroll
      for (int ks = 0; ks < 2; ++ks) {
        uint4 uu = {pack2(u[2 * ks][0], u[2 * ks][1]), pack2(u[2 * ks][2], u[2 * ks][3]), pack2(u[2 * ks + 1][0], u[2 * ks + 1][1]), pack2(u[2 * ks + 1][2], u[2 * ks + 1][3])};
        bU[ks] = __builtin_bit_cast(bf16x8, uu);
      }
#pragma unroll
      for (int rt = 0; rt < 4; ++rt) {
        f32x4 sn = S[rt] * cd;
#pragma unroll
        for (int ks = 0; ks < 2; ++ks) {
          const bf16x8 qa = *(const bf16x8*)(bufp + 16384 + ((rt * 2 + ks) * 64 + lane) * 16);
          const bf16x8 ka = *(const bf16x8*)(bufp + 24576 + ((rt * 2 + ks) * 64 + lane) * 16);
          acco[rt] = mfma16(qa, bU[ks], acco[rt]); sn = mfma16(ka, bU[ks], sn);
        }
        S[rt] = sn;
      }
#pragma unroll
      for (int rt = 0; rt < 4; ++rt)
#pragma unroll
        for (int j = 0; j < 4; ++j) {
          float s = acco[rt][j] * acco[rt][j];
          s += __shfl_xor(s, 1); s += __shfl_xor(s, 2); s += __shfl_xor(s, 4); s += __shfl_xor(s, 8);
          if (fr == 0) SS[(c & 1) * 256 + split * 64 + 16 * rt + 4 * fq + j] = s;
        }
      BAR_LDS();
      const float* ssb = SS + (c & 1) * 256;
#pragma unroll
      for (int rt = 0; rt < 4; ++rt)
#pragma unroll
        for (int j = 0; j < 4; ++j) {
          const int pos = 16 * rt + 4 * fq + j;
          const float tot = ssb[pos] + ssb[64 + pos] + ssb[128 + pos] + ssb[192 + pos];
          const float rn = rsqrtf(tot * (1.f / 64.f) + EPSF);
          const size_t tok = (size_t)b * SEQ + c * 64 + pos;
          O[tok * DM + 512 + head * 64 + split * 16 + fr] = f2bf(acco[rt][j] * rn * ng * siluf_(zr[rt * 4 + j]));
        }
    } else {
      if (c + 1 < 64) LSTORE((c + 1) & 1);
      if (c + 2 < 64) GLOADC(c + 2);
      BAR_LDS();
    }
  }
#undef GLOADC
#undef LSTORE
#undef BAR_LDS
}

DI void lru_item(const Params& p, int l, int item, char* smem, const int mode) {
  const bf16_t* P = (const bf16_t*)(p.ws + OFF_P);
  bf16_t* O = (bf16_t*)(p.ws + OFF_O);
  float* CA = (float*)(p.ws + OFF_LCA);
  float* CH = (float*)(p.ws + OFF_LCH);
  bf16_t* XS = (bf16_t*)smem;
  bf16_t* UB = (bf16_t*)(smem + 34816);
  const int b = item >> 6, ct = item & 63;
  const int tid = otid(), lane = tid & 63, wv = tid >> 6, r = lane & 31, h = lane >> 5, n = wv & 3, mi = wv >> 2;
  for (int i = 0; i < 5; ++i) {
    const int q = tid + NTHR * i;
    if (q < 67 * 32) {
      const int row = q >> 5, cc = q & 31;
      const int s = ct * 64 - 3 + row;
      uint4 v = {0u, 0u, 0u, 0u};
      if (s >= 0) v = *(const uint4*)(P + ((size_t)b * SEQ + s) * PSTR + C_LRU_X + cc * 8);
      *(uint4*)(XS + row * 256 + cc * 8) = v;
    }
  }
  bf16x8 bwr[2][4], bwi[2][4];
  {
    const float* wrp = p.in[I_LWR] + (((size_t)l * 4 + n) * 64) * 64 + r;
    const float* wip = p.in[I_LWI] + (((size_t)l * 4 + n) * 64) * 64 + r;
    asm volatile("" : "+v"(wrp), "+v"(wip));
#pragma unroll
    for (int ni = 0; ni < 2; ++ni)
#pragma unroll
      for (int ks = 0; ks < 4; ++ks) {
        unsigned ur[4], ui[4];
#pragma unroll
        for (int j2 = 0; j2 < 4; ++j2) {
          const int e = 16 * ks + 8 * h + 2 * j2;
          ur[j2] = pack2(wrp[e * 64 + 32 * ni], wrp[(e + 1) * 64 + 32 * ni]);
          ui[j2] = pack2(wip[e * 64 + 32 * ni], wip[(e + 1) * 64 + 32 * ni]);
        }
        uint4 t1 = {ur[0], ur[1], ur[2], ur[3]}, t2 = {ui[0], ui[1], ui[2], ui[3]};
        bwr[ni][ks] = __builtin_bit_cast(bf16x8, t1); bwi[ni][ks] = __builtin_bit_cast(bf16x8, t2);
      }
  }
  __syncthreads();
  {
    const int sc = tid >> 8, c = tid & 255;
    const float cb = p.in[I_LCB][l * 256 + c];
    const float c0 = p.in[I_LCW][(l * 4 + 0) * 256 + c], c1 = p.in[I_LCW][(l * 4 + 1) * 256 + c],
                c2 = p.in[I_LCW][(l * 4 + 2) * 256 + c], c3 = p.in[I_LCW][(l * 4 + 3) * 256 + c];
    for (int t = sc * 32; t < sc * 32 + 32; ++t)
      UB[t * 264 + c] = f2bf(cb + c0 * bf2f(XS[t * 256 + c]) + c1 * bf2f(XS[(t + 1) * 256 + c]) + c2 * bf2f(XS[(t + 2) * 256 + c]) + c3 * bf2f(XS[(t + 3) * 256 + c]));
  }
  __syncthreads();
  f32x16 ar[2], ai[2];
#pragma unroll
  for (int ni = 0; ni < 2; ++ni)
#pragma unroll
    for (int i = 0; i < 16; ++i) { ar[ni][i] = 0.f; ai[ni][i] = 0.f; }
#pragma unroll
  for (int ks = 0; ks < 4; ++ks) {
    const bf16x8 au = *(const bf16x8*)(UB + (32 * mi + r) * 264 + n * 64 + 16 * ks + 8 * h);
#pragma unroll
    for (int ni = 0; ni < 2; ++ni) { ar[ni] = mfma32(au, bwr[ni][ks], ar[ni]); ai[ni] = mfma32(au, bwi[ni][ks], ai[ni]); }
  }
  const int ck = ct * 2 + mi;
#pragma unroll
  for (int ni = 0; ni < 2; ++ni) {
    const int c = n * 64 + 32 * ni + r;
    const float brc = p.in[I_LBR][l * 256 + c], bic = p.in[I_LBI][l * 256 + c];
    const float lamsp = softplusf_(-p.in[I_LLAM][l * 256 + c]);
    float av[16], bv[16];
#pragma unroll
    for (int i = 0; i < 16; ++i) {
      const int tl = 32 * mi + crow(i, h);
      const float u = bf2f(UB[tl * 264 + c]);
      const float rg = sigmoid_rcp(ar[ni][i] + brc), ig = sigmoid_rcp(ai[ni][i] + bic);
      const float la = -8.f * rg * lamsp;
      av[i] = __expf(la);
      bv[i] = sqrtf(fmaxf(0.f, 1.f - __expf(2.f * la))) * (ig * u);
    }
    float GA[4], GB[4], PA[4], PB[4];
#pragma unroll
    for (int q = 0; q < 4; ++q) {
      float A = 1.f, hh = 0.f;
#pragma unroll
      for (int e = 0; e < 4; ++e) { hh = av[4 * q + e] * hh + bv[4 * q + e]; A *= av[4 * q + e]; }
      GA[q] = A; GB[q] = hh;
      PA[q] = __shfl_xor(A, 32); PB[q] = __shfl_xor(hh, 32);
    }
    float cin = 0.f;
    if (mode == 1) {
      const int lo = h ? (ck >> 1) : 0, hi = h ? ck : (ck >> 1);
      float A = 1.f, hh = 0.f;
      const float* ca = CA + ((size_t)b * 128) * 256 + c;
      const float* chp = CH + ((size_t)b * 128) * 256 + c;
      int k = lo;
      for (; k + 8 <= hi; k += 8) {
        float a8[8], h8[8];
#pragma unroll
        for (int e = 0; e < 8; ++e) { a8[e] = ca[(size_t)(k + e) * 256]; h8[e] = chp[(size_t)(k + e) * 256]; }
#pragma unroll
        for (int e = 0; e < 8; ++e) { hh = a8[e] * hh + h8[e]; A *= a8[e]; }
      }
      for (; k < hi; ++k) { const float a_ = ca[(size_t)k * 256], h_ = chp[(size_t)k * 256]; hh = a_ * hh + h_; A *= a_; }
      const float pAx = __shfl_xor(A, 32), pHx = __shfl_xor(hh, 32);
      cin = h ? (A * pHx + hh) : (pAx * hh + pHx);
    }
    float cg = cin, Ap = 1.f, myc[4];
#pragma unroll
    for (int q = 0; q < 4; ++q) {
      const float Ae = h ? PA[q] : GA[q], Be = h ? PB[q] : GB[q];
      const float Ao = h ? GA[q] : PA[q], Bo = h ? GB[q] : PB[q];
      const float c_even = cg;
      cg = Ae * cg + Be;
      const float c_odd = cg;
      cg = Ao * cg + Bo;
      myc[q] = h ? c_odd : c_even;
      Ap *= Ae * Ao;
    }
    if (mode == 0) {
      if (h == 0) { CA[((size_t)b * 128 + ck) * 256 + c] = Ap; CH[((size_t)b * 128 + ck) * 256 + c] = cg; }
    } else {
#pragma unroll
      for (int q = 0; q < 4; ++q) {
        float hh = myc[q];
#pragma unroll
        for (int e = 0; e < 4; ++e) {
          const int i = 4 * q + e;
          hh = av[i] * hh + bv[i];
          const size_t tok = (size_t)b * SEQ + ct * 64 + 32 * mi + crow(i, h);
          const float y = bf2f(P[tok * PSTR + C_LRU_Y + c]);
          O[tok * DM + c] = f2bf(hh * gelu_rcp(y));
        }
      }
    }
  }
}

#define XB_TMO      128
#define XB_XCNT(j)  (256  + 64 * (j))
#define XB_XSUB(j)  (1280 + 64 * (j))
#define XB_XGEN(j)  (2304 + 64 * (j))
#define XB_TOP      3328
#define XB_TOPGEN   3392
#define XCD_BAR_WORDS 3456
#define XB_SPIN_CAP (1u << 18)
#define XLAS __attribute__((address_space(3)))
DI unsigned xb_ld(unsigned* p)              { return __hip_atomic_load(p, __ATOMIC_RELAXED, __HIP_MEMORY_SCOPE_AGENT); }
DI unsigned xb_add(unsigned* p, unsigned v) { return __hip_atomic_fetch_add(p, v, __ATOMIC_RELAXED, __HIP_MEMORY_SCOPE_AGENT); }
DI unsigned xb_xcc_id() { return (unsigned)__builtin_amdgcn_s_getreg((3 << 11) | 20) & 0xFu; }
#define XB_SPIN(cond, bar) do { unsigned _sp = 0; while (cond) { __builtin_amdgcn_s_sleep(1); \
    if ((++_sp & 255u) == 0u) { if (xb_ld(&(bar)[XB_TMO])) break; if (_sp > XB_SPIN_CAP) { atomicAdd(&(bar)[XB_TMO], 1u); break; } } } } while (0)
struct XcdBarrier { unsigned* bar; unsigned x; volatile XLAS unsigned* st; };
DI XcdBarrier xcd_barrier_post(unsigned* bar, volatile XLAS unsigned* st) {
  XcdBarrier b; b.bar = bar; b.x = xb_xcc_id(); b.st = st;
  if (threadIdx.x == 0) (void)xb_add(&bar[XB_XCNT(b.x)], 1u);
  return b;
}
DI void xcd_barrier_complete(unsigned* bar, unsigned x, unsigned& nloc, unsigned& nx) {
  const unsigned G = gridDim.x * gridDim.y * gridDim.z;
  unsigned sum, cnt, mine, sp = 0u;
  for (;;) {
    sum = 0u; cnt = 0u; mine = 0u;
#pragma unroll
    for (unsigned j = 0; j < 16; ++j) { const unsigned c = xb_ld(&bar[XB_XCNT(j)]); sum += c; cnt += (c > 0u) ? 1u : 0u; mine = (j == x) ? c : mine; }
    if (sum == G) break;
    __builtin_amdgcn_s_sleep(1);
    if ((++sp & 255u) == 0u) { if (xb_ld(&bar[XB_TMO])) break; if (sp > XB_SPIN_CAP) { atomicAdd(&bar[XB_TMO], 1u); break; } }
  }
  nloc = mine > 0u ? mine : 1u; nx = cnt > 0u ? cnt : 1u;
}
DI void xcd_barrier(const XcdBarrier& b) {
  asm volatile("s_waitcnt vmcnt(0)" ::: "memory");
  __syncthreads();
  if (threadIdx.x == 0) {
    unsigned* bar = b.bar;
    __builtin_amdgcn_s_waitcnt(0);
    unsigned nloc = b.st[0], nx = b.st[1];
    if (nloc == 0u) { xcd_barrier_complete(bar, b.x, nloc, nx); b.st[0] = nloc; b.st[1] = nx; }
    const unsigned old = xb_add(&bar[XB_XSUB(b.x)], 1u);
    const unsigned gen = old / nloc;
    if (old + 1u == (gen + 1u) * nloc) {
      __builtin_amdgcn_fence(__ATOMIC_RELEASE, "agent");
      asm volatile("s_waitcnt vmcnt(0)" ::: "memory");
      const unsigned og = xb_add(&bar[XB_TOP], 1u);
      const unsigned tg = og / nx;
      if (og + 1u == (tg + 1u) * nx) xb_add(&bar[XB_TOPGEN], 1u);
      else XB_SPIN(xb_ld(&bar[XB_TOPGEN]) == tg, bar);
      __builtin_amdgcn_fence(__ATOMIC_ACQUIRE, "agent");
      xb_add(&bar[XB_XGEN(b.x)], 1u);
      asm volatile("s_waitcnt vmcnt(0)" ::: "memory");
    } else {
      XB_SPIN(xb_ld(&bar[XB_XGEN(b.x)]) == gen, bar);
      __builtin_amdgcn_fence(__ATOMIC_ACQUIRE, "agent");
      asm volatile("s_waitcnt vmcnt(0)" ::: "memory");
    }
  }
  __syncthreads();
}

__global__ void __launch_bounds__(NTHR) mega(Params p) {
  extern __shared__ __attribute__((aligned(16))) char smem[];
  cg::grid_group grid = cg::this_grid();
  const int tid = threadIdx.x;
  bf16_t* H = (bf16_t*)(p.ws + OFF_H);
  bf16_t* PB = (bf16_t*)(p.ws + OFF_P);
  PG_LAS unsigned char* lds = (PG_LAS unsigned char*)smem;
  volatile XLAS unsigned* xst = (volatile XLAS unsigned*)(smem + 131072);
  if (tid < 2) xst[tid] = 0u;
  __syncthreads();
  const XcdBarrier xb = xcd_barrier_post((unsigned*)(p.ws + OFF_BAR), xst);

  for (int rep = 0; rep < REP_MISC; ++rep) {
  if (MASK & 1) phase_mod(p, smem);
  grid.sync();
  }
  for (int l = 0; l < 4; ++l) {
    const float* xcur = (l == 0) ? p.in[I_X] : p.out;
    for (int rep = 0; rep < REP_MISC; ++rep) {
    if (MASK & 2) phase_convert(p, l, smem);
    if (MASK & 4) phase_norm(p, xcur, p.in[I_N1G] + l * 1024, l, 1024, 0, H, nullptr);
    xcd_barrier(xb);
    }
    for (int rep = 0; rep < REP_G; ++rep) {
    if (MASK & 8) { pg::Order<1> S; S.init(NTOK, PSTR, gridDim.x, blockIdx.x); pg::EpiBf16<0> E{PB, PSTR, nullptr};
      pg::gemm_phase(lds, H, DM, (const bf16_t*)(p.ws + OFF_WIN), 1024, S, E); }
    xcd_barrier(xb);
    }
    for (int rep = 0; rep < REP_M1; ++rep) {
    for (int it = blockIdx.x; it < 5120; it += gridDim.x) {
      if (it < 2048) { if (MASK & 32) gdn_intra_item(p, l, it, smem); }
      else if (it < 3072) { }
      else if (it < 4096) { if (MASK & 128) lru_item(p, l, it - 3072, smem, 0); }
      else { if (MASK & 16) rw_prep_item(p, l, it - 4096, smem); }
      __syncthreads();
    }
    xcd_barrier(xb);
    }
    for (int rep = 0; rep < REP_M2; ++rep) {
    if (blockIdx.x < 128) {
      if (MASK & 16) rwkv_scan_item(p, l, blockIdx.x >> 3, (blockIdx.x >> 1) & 3, blockIdx.x & 1, smem);
    } else {
      if (blockIdx.x < 192) { if (MASK & 256) gdn_rec_item(p, l, (blockIdx.x - 128) >> 2, (blockIdx.x - 128) & 3, smem); }
      unsigned* ctr = (unsigned*)(p.ws + OFF_CTR) + l * 4 + rep;
      volatile int* slot = (volatile int*)(smem + 110016);
      for (;;) {
        __syncthreads();
        if (tid == 0) *slot = (int)atomicAdd(ctr, 1u);
        __syncthreads();
        const int it = *slot;
        if (it >= 2048) break;
        if (it < 1024) { if (MASK & 64) sb_item(p, it, smem); }
        else { if (MASK & 512) lru_item(p, l, it - 1024, smem, 1); }
      }
    }
    xcd_barrier(xb);
    }
    for (int rep = 0; rep < REP_G; ++rep) {
    for (int half = 0; half < 4; ++half) {
      bf16_t* BH = (bf16_t*)(p.ws + OFF_P + 134217728);
      if (half == 0 && rep == 0) { if (MASK & 16) rwkv_post(p, l); xcd_barrier(xb); }
      if (MASK & 1024) { pg::Order<1> S; S.init(NTOK / 4, 4096, gridDim.x, blockIdx.x, 0, 0, 2, 512); pg::EpiBf16<0> E{BH, 4096, nullptr};
        pg::gemm_phase(lds, (const bf16_t*)(p.ws + OFF_O) + (size_t)half * 16384 * DM, DM, (const bf16_t*)(p.ws + OFF_WBR), 256, S, E); }
      xcd_barrier(xb);
      if (MASK & 1024) { pg::Order<4> S; S.init(NTOK / 4, 1024, gridDim.x, blockIdx.x, 0, 2097152); pg::EpiGateMix E{PB + (size_t)half * 16384 * DM, (float*)(p.ws + OFF_G), BH, p.in[I_BGATE] + (size_t)l * 4096};
        pg::gemm_phase(lds, H + (size_t)half * 16384 * DM, DM, (const bf16_t*)(p.ws + OFF_WG), 1024, S, E); }
      xcd_barrier(xb);
    }
    }
    if (MASK & 2048) { pg::Order<1> S; S.init(NTOK, 1024, gridDim.x, blockIdx.x); pg::EpiResid E{xcur, p.out, (const float*)(p.ws + OFF_MODP), p.in[I_BADA], l, 2048};
      pg::gemm_phase(lds, PB, DM, (const bf16_t*)(p.ws + OFF_WO), 1024, S, E); }
    xcd_barrier(xb);
    for (int rep = 0; rep < REP_MISC; ++rep) {
    if (MASK & 4096) phase_norm(p, p.out, p.in[I_N2G] + l * 1024, l, 4096, 3072, H, nullptr);
    xcd_barrier(xb);
    }
    for (int rep = 0; rep < REP_G; ++rep) {
    if (MASK & 8192) { pg::Order<1> S; S.init(NTOK, FFN, gridDim.x, blockIdx.x); pg::EpiBf16<0> E{PB, FFN, nullptr};
      pg::gemm_phase(lds, H, DM, (const bf16_t*)(p.ws + OFF_WF), 1024, S, E); }
    xcd_barrier(xb);
    if (MASK & 8192) { pg::Order<1> S; S.init(NTOK, FFN, gridDim.x, blockIdx.x); pg::EpiFfnAct E{PB + (size_t)NTOK * FFN, PB, p.in[I_FCW] + (size_t)l * 3 * FFN};
      pg::gemm_phase(lds, H, DM, (const bf16_t*)(p.ws + OFF_WF) + (size_t)FFN * 1024, 1024, S, E); }
    xcd_barrier(xb);
    }
    if (MASK & 32768) { pg::Order<1> S; S.init(NTOK, 1024, gridDim.x, blockIdx.x); pg::EpiResid E{p.out, p.out, (const float*)(p.ws + OFF_MODP), p.in[I_BADA], l, 5120};
      pg::gemm_phase(lds, PB + (size_t)NTOK * FFN, FFN, (const bf16_t*)(p.ws + OFF_WD), FFN, S, E); }
    xcd_barrier(xb);
  }
  if (MASK & 65536) phase_norm(p, p.out, p.in[I_FG], 0, 0, 0, nullptr, p.out);
}

extern "C" void kernel_launch(void* const* d_in, const int* in_sizes, int n_in,
                              void* d_out, int out_size, void* d_ws, size_t ws_size,
                              hipStream_t stream) {
  if (ws_size < WS_NEED || n_in < 38) { fprintf(stderr, "workspace too small: %zu < %zu\n", ws_size, (size_t)WS_NEED); return; }
  (void)hipFuncSetAttribute((const void*)mega, hipFuncAttributeMaxDynamicSharedMemorySize, SMEM_BYTES);
  int dev = 0, cus = 0, per_cu = 0;
  (void)hipGetDevice(&dev);
  (void)hipDeviceGetAttribute(&cus, hipDeviceAttributeMultiprocessorCount, dev);
  (void)hipOccupancyMaxActiveBlocksPerMultiprocessor(&per_cu, mega, NTHR, SMEM_BYTES);
  if (per_cu < 1 || cus < 1) { fprintf(stderr, "occupancy query failed (%d, %d)\n", per_cu, cus); return; }
  if (cus > 256) cus = 256;
  const int grid_blocks = cus;
  Params p{};
  for (int i = 0; i < 38; ++i) p.in[i] = (const float*)d_in[i];
  p.out = (float*)d_out; p.ws = (char*)d_ws;
  (void)hipMemsetAsync((char*)d_ws + OFF_BAR, 0, XCD_BAR_WORDS * 4, stream);
  void* args[] = {&p};
  hipError_t e = hipLaunchCooperativeKernel((void*)mega, dim3(grid_blocks), dim3(NTHR), args, SMEM_BYTES, stream);
  if (e != hipSuccess) fprintf(stderr, "cooperative launch failed: %s (grid %d)\n", hipGetErrorString(e), grid_blocks);
}
```

```cpp
#include <hip/hip_runtime.h>
#include <hip/hip_cooperative_groups.h>
#include <cstdio>
namespace cg = cooperative_groups;

typedef unsigned short bf16_t;
typedef short bf16x8 __attribute__((ext_vector_type(8)));
typedef short s16x4 __attribute__((ext_vector_type(4)));
typedef float f32x4 __attribute__((ext_vector_type(4)));
typedef float f32x16 __attribute__((ext_vector_type(16)));
typedef unsigned u32x4 __attribute__((ext_vector_type(4)));
#define DI __device__ __forceinline__

constexpr int NTOK = 65536, DM = 1024, SEQ = 4096, PSTR = 3328, FFN = 2816, AUS = 5632;
constexpr int C_LRU_X = 0, C_LRU_Y = 256, C_SB_Q = 512, C_SB_K = 768, C_SB_V = 1024;
constexpr int C_GDN_Q = 1280, C_GDN_Z = 2048, C_GDN_A = 2304, C_GDN_B = 2308, C_RW = 2312;
constexpr float EPSF = 1e-6f;
#ifndef MASK
#define MASK 0x1ffff
#endif
#ifndef REP_M1
#define REP_M1 1
#endif
#ifndef REP_M2
#define REP_M2 1
#endif
#ifndef REP_G
#define REP_G 1
#endif
#ifndef REP_MISC
#define REP_MISC 1
#endif
constexpr int NTHR = 512;
constexpr int SMEM_BYTES = 131072 + 64;

constexpr size_t OFF_MODP = 0;
constexpr size_t OFF_WIN = 6291456;
constexpr size_t OFF_WG = OFF_WIN + 6815744;
constexpr size_t OFF_WBR = OFF_WG + 8388608;
constexpr size_t OFF_WO = OFF_WBR + 2097152;
constexpr size_t OFF_WF = OFF_WO + 2097152;
constexpr size_t OFF_WD = OFF_WF + 11534336;
constexpr size_t OFF_H = OFF_WD + 5767168;
constexpr size_t OFF_P = OFF_H + 134217728;
constexpr size_t OFF_O = OFF_P + 436207616;
constexpr size_t OFF_G = OFF_O + 134217728;
constexpr size_t GSZ = 33554432;
constexpr size_t OFF_GCD = OFF_G + 5 * GSZ;
constexpr size_t OFF_L = OFF_GCD + 16384;
constexpr size_t LSZ = 67108864;
constexpr size_t OFF_LCA = OFF_L + 2 * LSZ;
constexpr size_t OFF_LCH = OFF_LCA + 2097152;
constexpr size_t OFF_BON = OFF_LCH + 2097152;
constexpr size_t OFF_CTR = OFF_BON + 1048576;
constexpr size_t OFF_BAR = OFF_CTR + 256;
constexpr size_t WS_NEED = OFF_BAR + 16384;

struct Params { const float* in[38]; float* out; char* ws; };
enum { I_X = 0, I_C, I_N1G, I_N2G, I_FG, I_WADA, I_BADA, I_WIN, I_LCW, I_LCB, I_LWR, I_LBR, I_LWI, I_LBI, I_LLAM,
       I_GCW, I_GAL, I_GDT, I_GNG, I_RMU, I_RW0, I_RWUP, I_RA0, I_RAUP, I_RGUP, I_RKK, I_RKA, I_RRK, I_RLG, I_RLB,
       I_WBR, I_WGATE, I_BGATE, I_WOUT, I_FWG, I_FWU, I_FCW, I_FWD };

DI float bf2f(bf16_t v) { return __uint_as_float(((unsigned)v) << 16); }
typedef __bf16 bf16n2 __attribute__((ext_vector_type(2)));
typedef float f32x2_ __attribute__((ext_vector_type(2)));
DI unsigned pack2(float lo, float hi) { f32x2_ v = {lo, hi}; bf16n2 b = __builtin_convertvector(v, bf16n2); return __builtin_bit_cast(unsigned, b); }
DI bf16_t f2bf(float x) { return (bf16_t)(pack2(x, x) & 0xffffu); }
DI float sigmoidf_(float x) { return __builtin_amdgcn_rcpf(1.f + __expf(-x)); }
DI float sigmoid_rcp(float x) { return __builtin_amdgcn_rcpf(1.f + __expf(-x)); }
DI float gelu_rcp(float x) { float u = 0.7978845608f * (x + 0.044715f * x * x * x); return x * __builtin_amdgcn_rcpf(1.f + __expf(-2.f * u)); }
DI float softplusf_(float x) { return fmaxf(x, 0.f) + __logf(1.f + __expf(-fabsf(x))); }
DI float siluf_(float x) { return x * __builtin_amdgcn_rcpf(1.f + __expf(-x)); }
DI float geluf_(float x) { float u = 0.7978845608f * (x + 0.044715f * x * x * x); return x * __builtin_amdgcn_rcpf(1.f + __expf(-2.f * u)); }
DI float tanhf_(float x) { return 1.f - 2.f * __builtin_amdgcn_rcpf(1.f + __expf(2.f * x)); }
DI float wave_sum(float x) {
#pragma unroll
  for (int o = 32; o >= 1; o >>= 1) x += __shfl_xor(x, o);
  return x;
}
template <int CTRL> DI float dppf(float x) { return __int_as_float(__builtin_amdgcn_update_dpp(0, __float_as_int(x), CTRL, 0xf, 0xf, true)); }
DI float reduce8(float x) { x += dppf<0xB1>(x); x += dppf<0x4E>(x); x += dppf<0x141>(x); return x; }
DI f32x16 mfma32(bf16x8 a, bf16x8 b, f32x16 c) { return __builtin_amdgcn_mfma_f32_32x32x16_bf16(a, b, c, 0, 0, 0); }
DI f32x4 mfma16(bf16x8 a, bf16x8 b, f32x4 c) { return __builtin_amdgcn_mfma_f32_16x16x32_bf16(a, b, c, 0, 0, 0); }
DI int crow(int i, int h) { return (i & 3) + 8 * (i >> 2) + 4 * h; }

DI float modv(const float* modp, const float* bada, int l, int b, int idx) {
  const float* q = modp + ((size_t)(l * 16 + b)) * 6144 + idx;
  const size_t ks = (size_t)4 * 16 * 6144;
  return bada[l * 6144 + idx] + q[0] + q[ks] + q[2 * ks] + q[3 * ks];
}

DI int otid() { int t = threadIdx.x; asm volatile("" : "+v"(t)); return t; }
DI int obid() { int b = blockIdx.x; asm volatile("" : "+s"(b)); return b; }
DI void phase_mod(const Params& p, char* smem) {
  float* sm = (float*)smem;
  float* modp = (float*)(p.ws + OFF_MODP);
  const int tid = otid();
  if (obid() == 0 && tid < 64) ((unsigned*)(p.ws + OFF_CTR))[tid] = 0u;
  for (int item = obid(); item < 192; item += gridDim.x) {
    const int l = item / 48, rem = item % 48, jb = rem >> 2, kq = rem & 3;
    for (int i = 0; i < 8; ++i) {
      int e = tid + 512 * i; int b = e >> 8, k = e & 255;
      float cv = p.in[I_C][b * 1024 + kq * 256 + k];
      sm[e] = siluf_(cv);
    }
    __syncthreads();
    float acc[16];
#pragma unroll
    for (int b = 0; b < 16; ++b) acc[b] = 0.f;
    const float* wp = p.in[I_WADA] + ((size_t)l * 1024 + kq * 256) * 6144 + jb * 512 + tid;
    for (int k = 0; k < 256; k += 4) {
      float w0 = wp[(size_t)k * 6144], w1 = wp[(size_t)(k + 1) * 6144], w2 = wp[(size_t)(k + 2) * 6144], w3 = wp[(size_t)(k + 3) * 6144];
#pragma unroll
      for (int b = 0; b < 16; ++b) {
        f32x4 cv = *(const f32x4*)(sm + b * 256 + k);
        acc[b] += cv[0] * w0 + cv[1] * w1 + cv[2] * w2 + cv[3] * w3;
      }
    }
#pragma unroll
    for (int b = 0; b < 16; ++b) modp[((size_t)((kq * 4 + l) * 16 + b)) * 6144 + jb * 512 + tid] = acc[b];
    __syncthreads();
  }
}

DI void conv_tile(const float* src, bf16_t* dst, int K, int N, int k0, int n0, char* smem) {
  float* tile = (float*)smem;
  const int tid = otid();
#pragma unroll
  for (int it = 0; it < 2; ++it) {
    int kr = (tid >> 4) + 32 * it, nc = (tid & 15) * 4;
    f32x4 v = {0.f, 0.f, 0.f, 0.f};
    if (n0 + nc < N) v = *(const f32x4*)(src + (size_t)(k0 + kr) * N + n0 + nc);
    tile[kr * 65 + nc] = v[0]; tile[kr * 65 + nc + 1] = v[1]; tile[kr * 65 + nc + 2] = v[2]; tile[kr * 65 + nc + 3] = v[3];
  }
  __syncthreads();
  {
    int n = tid >> 3, kc = (tid & 7) * 8;
    unsigned o[4];
#pragma unroll
    for (int e = 0; e < 4; ++e) o[e] = pack2(tile[(kc + 2 * e) * 65 + n], tile[(kc + 2 * e + 1) * 65 + n]);
    uint4 ov = {o[0], o[1], o[2], o[3]};
    *(uint4*)(dst + (size_t)(n0 + n) * K + k0 + kc) = ov;
  }
  __syncthreads();
}

DI void phase_convert(const Params& p, int l, char* smem) {
  for (int t = obid(); t < 4480; t += gridDim.x) {
    const float* src; bf16_t* dst; int K, N, Npad, tt = t;
    if (tt < 832) { src = p.in[I_WIN] + (size_t)l * 1024 * 3208; dst = (bf16_t*)(p.ws + OFF_WIN); K = 1024; N = 3208; Npad = 3328; }
    else if ((tt -= 832) < 1024) { int br = tt >> 8; tt &= 255; src = p.in[I_WGATE] + ((size_t)l * 4 + br) * 1048576; dst = (bf16_t*)(p.ws + OFF_WG) + (size_t)br * 1048576; K = 1024; N = 1024; Npad = 1024; }
    else if ((tt -= 1024) < 256) { int br = tt >> 6; tt &= 63; src = p.in[I_WBR] + ((size_t)l * 4 + br) * 262144; dst = (bf16_t*)(p.ws + OFF_WBR) + (size_t)br * 262144; K = 256; N = 1024; Npad = 1024; }
    else if ((tt -= 256) < 256) { src = p.in[I_WOUT] + (size_t)l * 1048576; dst = (bf16_t*)(p.ws + OFF_WO); K = 1024; N = 1024; Npad = 1024; }
    else if ((tt -= 256) < 704) { src = p.in[I_FWG] + (size_t)l * 1024 * 2816; dst = (bf16_t*)(p.ws + OFF_WF); K = 1024; N = 2816; Npad = 2816; }
    else if ((tt -= 704) < 704) { src = p.in[I_FWU] + (size_t)l * 1024 * 2816; dst = (bf16_t*)(p.ws + OFF_WF) + (size_t)2816 * 1024; K = 1024; N = 2816; Npad = 2816; }
    else { tt -= 704; src = p.in[I_FWD] + (size_t)l * 2816 * 1024; dst = (bf16_t*)(p.ws + OFF_WD); K = 2816; N = 1024; Npad = 1024; }
    const int nNt = Npad >> 6;
    const int kt = tt / nNt, nt = tt % nNt;
    conv_tile(src, dst, K, N, kt * 64, nt * 64, smem);
  }
}

DI void phase_norm(const Params& p, const float* xin, const float* g, int l, int scale_idx, int shift_idx, bf16_t* hout, float* fout) {
  const float* modp = (const float*)(p.ws + OFF_MODP);
  const int lane = otid() & 63, wv = otid() >> 6;
  const int nw = gridDim.x * 8;
  const int rows_per = 32;
  for (int chunk = obid() * 8 + wv; chunk < NTOK / 32; chunk += nw) {
  const int row0 = chunk * rows_per;
  const int b = row0 / SEQ;
  f32x4 gv[4], sc[4], sh[4];
#pragma unroll
  for (int j = 0; j < 4; ++j) {
    int c = lane * 4 + 256 * j;
    gv[j] = *(const f32x4*)(g + c);
    if (hout) {
#pragma unroll
      for (int e = 0; e < 4; ++e) {
        sc[j][e] = 1.f + modv(modp, p.in[I_BADA], l, b, scale_idx + c + e);
        sh[j][e] = modv(modp, p.in[I_BADA], l, b, shift_idx + c + e);
      }
    }
  }
  for (int rr = 0; rr < rows_per; ++rr) {
    const size_t row = (size_t)row0 + rr;
    f32x4 xv[4]; float ss = 0.f;
#pragma unroll
    for (int j = 0; j < 4; ++j) {
      xv[j] = *(const f32x4*)(xin + row * DM + lane * 4 + 256 * j);
      ss += xv[j][0] * xv[j][0] + xv[j][1] * xv[j][1] + xv[j][2] * xv[j][2] + xv[j][3] * xv[j][3];
    }
    ss = wave_sum(ss);
    const float rs = rsqrtf(ss * (1.f / 1024.f) + EPSF);
#pragma unroll
    for (int j = 0; j < 4; ++j) {
      f32x4 y = xv[j] * rs * gv[j];
      if (hout) {
        y = y * sc[j] + sh[j];
        uint2 o = {pack2(y[0], y[1]), pack2(y[2], y[3])};
        *(uint2*)(hout + row * DM + lane * 4 + 256 * j) = o;
      } else {
        *(f32x4*)(fout + row * DM + lane * 4 + 256 * j) = y;
      }
    }
  }
  }
}

#define PG_LAS __attribute__((address_space(3)))
namespace pg {
constexpr int BM = 256, BK = 64, HALF = 128, HTB = HALF * BK * 2, NXCD = 8, WGM = 8;
DI int lds_byte(int r, int c) { const int st = (r >> 4) * 2 + (c >> 5), rr = r & 15, cc = c & 31, ob = rr * 64 + cc * 2; return st * 1024 + (ob ^ (((ob >> 9) & 1) << 5)); }
DI void stage_rc(int b, int& R, int& C) { const int st = b / 1024, sb = b % 1024, swz = sb ^ (((sb >> 9) & 1) << 5); R = (st >> 1) * 16 + swz / 64; C = (st & 1) * 32 + (swz % 64) / 2; }
DI int perm32(int rho) { const int n = rho >> 4, i = rho & 15; return 8 * (i >> 2) + 4 * n + (i & 3); }
struct Unit { int pm, pn; int aux; long ao, bo; };
template <int REP> struct Order {
  int nM, nN, nwg, G, c, ashift; long astep, bstep, apnstep;
  DI void init(int M, int N, int G_, int c_, long astep_ = 0, long bstep_ = 0, int ashift_ = 0, long apnstep_ = 0) {
    nM = M / BM; nN = N / BM; nwg = nM * nN; G = G_; c = c_; astep = astep_; bstep = bstep_; ashift = ashift_; apnstep = apnstep_; }
  DI bool next(int i, Unit& u) const {
    const int ti = i / REP, aux = i % REP;
    const long L = (long)ti * G + c; if (L >= nwg) return false;
    int wgid = (int)L; { const int q = nwg / NXCD, r = nwg % NXCD, xcd = wgid % NXCD, off = wgid / NXCD; wgid = (xcd < r ? xcd * (q + 1) : r * (q + 1) + (xcd - r) * q) + off; }
    const int nig = WGM * nN, gid = wgid / nig, fm = gid * WGM, gsz = (nM - fm) < WGM ? (nM - fm) : WGM;
    u.pm = fm + ((wgid % nig) % gsz); u.pn = (wgid % nig) / gsz; u.aux = aux; u.ao = aux * astep + (long)(u.pn >> ashift) * apnstep; u.bo = aux * bstep; return true;
  }
};
DI unsigned cvt_pk_bf16(float lo, float hi) { return pack2(lo, hi); }

template <class Epi, class Sched>
DI void gemm_phase(PG_LAS unsigned char* lds, const bf16_t* Ag, int lda, const bf16_t* Bg, int K, const Sched& S, const Epi& E) {
  const int tid = otid(), wid = __builtin_amdgcn_readfirstlane(tid >> 6), lane = tid & 63, wr = wid >> 2, wc = wid & 3, fr = lane & 15, fq = lane >> 4;
  const int nt = K / BK;
  unsigned voffA[2], voffB[2];
#pragma unroll
  for (int i = 0; i < 2; ++i) { int R, C; stage_rc(tid * 16 + i * 8192, R, C); const int Rb = Epi::PERM ? ((R & ~31) + perm32(R & 31)) : R;
    voffA[i] = (unsigned)(R * lda + C) * 2u; voffB[i] = (unsigned)(Rb * K + C) * 2u; }
  const size_t kstep = (size_t)(BK * 2);
  const size_t hstepA = (size_t)HALF * lda * 2, hstepB = (size_t)HALF * K * 2;
  const size_t tstepA = 2 * hstepA, tstepB = 2 * hstepB;
  const unsigned ldsw = (unsigned)wid * 1024u;
  const int aoff = lds_byte(wr * 64 + fr, fq * 8), boff = lds_byte(wc * 32 + fr, fq * 8);
#define PG_SA(b, h) (((b) * 2 + (h)) * HTB)
#define PG_SB(b, h) ((4 + (b) * 2 + (h)) * HTB)
#define PG_STAGE(bufoff, gbase, voff) do { _Pragma("unroll") for (int _i = 0; _i < 2; ++_i) \
    __builtin_amdgcn_global_load_lds((const unsigned*)((const char*)(gbase) + (voff)[_i]), (PG_LAS unsigned*)(lds + (bufoff) + ldsw + _i * 8192), 16, 0, 0); } while (0)
#define PG_LDA(dst, b, h) do { _Pragma("unroll") for (int m = 0; m < 4; ++m) _Pragma("unroll") for (int k = 0; k < 2; ++k) dst[m][k] = *(const PG_LAS bf16x8*)(lds + PG_SA(b, h) + aoff + m * 2048 + k * 1024); } while (0)
#define PG_LDB(dst, b, h) do { _Pragma("unroll") for (int n = 0; n < 2; ++n) _Pragma("unroll") for (int k = 0; k < 2; ++k) dst[n][k] = *(const PG_LAS bf16x8*)(lds + PG_SB(b, h) + boff + n * 2048 + k * 1024); } while (0)
#define PG_MMA(ai, bj, At, Bt) do { __builtin_amdgcn_s_setprio(1); _Pragma("unroll") for (int m = 0; m < 4; ++m) _Pragma("unroll") for (int n = 0; n < 2; ++n) _Pragma("unroll") for (int k = 0; k < 2; ++k) \
    acc[ai][bj][m][n] = __builtin_amdgcn_mfma_f32_16x16x32_bf16(Bt[n][k], At[m][k], acc[ai][bj][m][n], 0, 0, 0); __builtin_amdgcn_s_setprio(0); } while (0)
#define PG_WAIT_V(n) asm volatile("s_waitcnt vmcnt(" #n ")" ::: "memory")
#define PG_WAIT_L(n) asm volatile("s_waitcnt lgkmcnt(" #n ")" ::: "memory")
#define PG_BAR __builtin_amdgcn_s_barrier()
#define PG_SCHED __builtin_amdgcn_sched_barrier(0)
  Unit cur, nxt; int ui = 0;
  if (!S.next(0, cur)) return;
  f32x4 acc[2][2][4][2];
#pragma unroll
  for (int a = 0; a < 2; ++a)
#pragma unroll
    for (int b = 0; b < 2; ++b)
#pragma unroll
      for (int m = 0; m < 4; ++m)
#pragma unroll
        for (int n = 0; n < 2; ++n) acc[a][b][m][n] = (f32x4){0.f, 0.f, 0.f, 0.f};
  bf16x8 At[4][2], B0[2][2], B1[2][2];
  const char* cA = (const char*)Ag + (size_t)cur.pm * tstepA + cur.ao; const char* cB = (const char*)Bg + (size_t)cur.pn * tstepB + cur.bo;
  PG_STAGE(PG_SB(0, 0), cB, voffB); PG_STAGE(PG_SA(0, 0), cA, voffA); PG_STAGE(PG_SB(0, 1), cB + hstepB, voffB); PG_STAGE(PG_SA(0, 1), cA + hstepA, voffA);
  if (wr == 1) PG_BAR;
  PG_WAIT_V(4); PG_BAR;
  PG_STAGE(PG_SB(1, 0), cB + kstep, voffB); PG_STAGE(PG_SA(1, 0), cA + kstep, voffA); PG_STAGE(PG_SB(1, 1), cB + hstepB + kstep, voffB);
  PG_WAIT_V(6); PG_BAR;
  for (;;) {
    const bool has_next = S.next(ui + 1, nxt);
    const char* nA = has_next ? (const char*)Ag + (size_t)nxt.pm * tstepA + nxt.ao : cA; const char* nB = has_next ? (const char*)Bg + (size_t)nxt.pn * tstepB + nxt.bo : cB;
#pragma unroll 1
    for (int t = 0; t < nt; t += 2) {
      const bool last = (t == nt - 2);
      const char* a1 = cA + (size_t)(t + 1) * kstep;
      const char* a2 = last ? nA : cA + (size_t)(t + 2) * kstep; const char* b2 = last ? nB : cB + (size_t)(t + 2) * kstep;
      const char* a3 = a2 + kstep; const char* b3 = b2 + kstep;
      PG_LDB(B0, 0, 0); PG_SCHED; PG_LDA(At, 0, 0); PG_STAGE(PG_SA(1, 1), a1 + hstepA, voffA);
      PG_WAIT_L(8); PG_BAR; PG_WAIT_L(0); PG_MMA(0, 0, At, B0); PG_BAR; PG_SCHED;
      PG_LDB(B1, 0, 1); PG_STAGE(PG_SB(0, 0), b2, voffB);
      PG_BAR; PG_WAIT_L(0); PG_MMA(0, 1, At, B1); PG_BAR;
      PG_LDA(At, 0, 1); PG_STAGE(PG_SA(0, 0), a2, voffA);
      PG_BAR; PG_WAIT_L(0); PG_MMA(1, 0, At, B0); PG_BAR; PG_SCHED;
      PG_STAGE(PG_SB(0, 1), b2 + hstepB, voffB);
      PG_WAIT_V(6); PG_BAR; PG_MMA(1, 1, At, B1); PG_BAR;
      PG_LDB(B0, 1, 0); PG_SCHED; PG_LDA(At, 1, 0); PG_STAGE(PG_SA(0, 1), a2 + hstepA, voffA);
      PG_WAIT_L(8); PG_BAR; PG_WAIT_L(0); PG_MMA(0, 0, At, B0); PG_BAR; PG_SCHED;
      PG_LDB(B1, 1, 1); PG_STAGE(PG_SB(1, 0), b3, voffB);
      PG_BAR; PG_WAIT_L(0); PG_MMA(0, 1, At, B1); PG_BAR;
      PG_LDA(At, 1, 1); PG_STAGE(PG_SA(1, 0), a3, voffA);
      PG_BAR; PG_WAIT_L(0); PG_MMA(1, 0, At, B0); PG_BAR; PG_SCHED;
      PG_STAGE(PG_SB(1, 1), b3 + hstepB, voffB);
      PG_WAIT_V(6); PG_BAR; PG_MMA(1, 1, At, B1); PG_BAR;
    }
    E(acc, cur, wr, wc, fr, fq);
    if (!has_next) break;
#pragma unroll
    for (int a = 0; a < 2; ++a)
#pragma unroll
      for (int b = 0; b < 2; ++b)
#pragma unroll
        for (int m = 0; m < 4; ++m)
#pragma unroll
          for (int n = 0; n < 2; ++n) acc[a][b][m][n] = (f32x4){0.f, 0.f, 0.f, 0.f};
    cur = nxt; cA = nA; cB = nB; ++ui;
  }
  PG_WAIT_V(0);
  if (wr == 0) PG_BAR;
  PG_BAR;
#undef PG_SA
#undef PG_SB
#undef PG_STAGE
#undef PG_LDA
#undef PG_LDB
#undef PG_MMA
#undef PG_WAIT_V
#undef PG_WAIT_L
#undef PG_BAR
#undef PG_SCHED
}

template <int ACT> struct EpiBf16 {
  static constexpr bool PERM = true;
  bf16_t* O; int ldc; const float* bias;
  DI void operator()(const f32x4 (&acc)[2][2][4][2], const Unit& u, int wr, int wc, int fr, int fq) const {
    const int row0 = u.pm * BM + wr * 64 + fr, col0 = u.pn * BM + wc * 32 + 8 * fq;
    f32x4 bv[2][2];
#pragma unroll
    for (int bj = 0; bj < 2; ++bj)
#pragma unroll
      for (int n = 0; n < 2; ++n) bv[bj][n] = ACT ? *(const f32x4*)(bias + col0 + bj * HALF + 4 * n) : (f32x4){0.f, 0.f, 0.f, 0.f};
#pragma unroll
    for (int ai = 0; ai < 2; ++ai)
#pragma unroll
      for (int m = 0; m < 4; ++m) { bf16_t* rowp = O + (size_t)(row0 + ai * HALF + m * 16) * ldc + col0;
#pragma unroll
        for (int bj = 0; bj < 2; ++bj) { f32x4 v0 = acc[ai][bj][m][0] + bv[bj][0], v1 = acc[ai][bj][m][1] + bv[bj][1];
          if (ACT) {
#pragma unroll
            for (int j = 0; j < 4; ++j) { v0[j] = sigmoid_rcp(v0[j]); v1[j] = sigmoid_rcp(v1[j]); } }
          u32x4 w; w.x = cvt_pk_bf16(v0[0], v0[1]); w.y = cvt_pk_bf16(v0[2], v0[3]); w.z = cvt_pk_bf16(v1[0], v1[1]); w.w = cvt_pk_bf16(v1[2], v1[3]);
          *(u32x4*)(rowp + bj * HALF) = w; } }
  }
};
struct EpiBranch {
  static constexpr bool PERM = true;
  bf16_t* MIX; const bf16_t* G;
  DI void operator()(const f32x4 (&acc)[2][2][4][2], const Unit& u, int wr, int wc, int fr, int fq) const {
    const int row0 = u.pm * BM + wr * 64 + fr, col0 = u.pn * BM + wc * 32 + 8 * fq;
#pragma unroll
    for (int ai = 0; ai < 2; ++ai)
#pragma unroll
      for (int m = 0; m < 4; ++m) {
        asm volatile("" ::: "memory");
        const size_t row = (size_t)(row0 + ai * HALF + m * 16);
        bf16_t* mp = MIX + row * DM + col0; const bf16_t* gp = G + row * 4096 + u.aux * 1024 + col0;
#pragma unroll
        for (int bj = 0; bj < 2; ++bj) {
          const bf16x8 gv = *(const bf16x8*)(gp + bj * HALF);
          float o[8];
#pragma unroll
          for (int j = 0; j < 4; ++j) { o[j] = bf2f((bf16_t)gv[j]) * acc[ai][bj][m][0][j]; o[4 + j] = bf2f((bf16_t)gv[4 + j]) * acc[ai][bj][m][1][j]; }
          if (u.aux > 0) {
            const bf16x8 mv = *(const bf16x8*)(mp + bj * HALF);
#pragma unroll
            for (int j = 0; j < 8; ++j) o[j] += bf2f((bf16_t)mv[j]);
          }
          u32x4 w; w.x = cvt_pk_bf16(o[0], o[1]); w.y = cvt_pk_bf16(o[2], o[3]); w.z = cvt_pk_bf16(o[4], o[5]); w.w = cvt_pk_bf16(o[6], o[7]);
          *(u32x4*)(mp + bj * HALF) = w;
        }
      }
  }
};
struct EpiResid {
  static constexpr bool PERM = false;
  const float* xold; float* xnew; const float* modp; const float* bada; int l, gate_idx;
  DI void operator()(const f32x4 (&acc)[2][2][4][2], const Unit& u, int wr, int wc, int fr, int fq) const {
    const int row0 = u.pm * BM + wr * 64 + fr, col0 = u.pn * BM + wc * 32 + 4 * fq;
    const int b = (u.pm * BM) / SEQ;
    f32x4 gv[2][2];
#pragma unroll
    for (int bj = 0; bj < 2; ++bj)
#pragma unroll
      for (int n = 0; n < 2; ++n)
#pragma unroll
        for (int j = 0; j < 4; ++j) gv[bj][n][j] = modv(modp, bada, l, b, gate_idx + col0 + bj * HALF + n * 16 + j);
#pragma unroll
    for (int ai = 0; ai < 2; ++ai)
#pragma unroll
      for (int m = 0; m < 4; ++m) { const size_t ro = (size_t)(row0 + ai * HALF + m * 16) * DM + col0;
#pragma unroll
        for (int bj = 0; bj < 2; ++bj)
#pragma unroll
          for (int n = 0; n < 2; ++n) {
            const f32x4 xo = *(const f32x4*)(xold + ro + bj * HALF + n * 16);
            *(f32x4*)(xnew + ro + bj * HALF + n * 16) = xo + gv[bj][n] * acc[ai][bj][m][n];
          } }
  }
};
struct EpiFfnAct {
  static constexpr bool PERM = true;
  bf16_t* ACT; const bf16_t* APRE; const float* cw;
  DI void operator()(const f32x4 (&acc)[2][2][4][2], const Unit& u, int wr, int wc, int fr, int fq) const {
    const int row0 = u.pm * BM + wr * 64 + fr, col0 = u.pn * BM + wc * 32 + 8 * fq;
#pragma unroll
    for (int ai = 0; ai < 2; ++ai)
#pragma unroll
      for (int m = 0; m < 4; ++m) {
        asm volatile("" ::: "memory");
        const int row = row0 + ai * HALF + m * 16; const int sp = row & (SEQ - 1);
        const bf16_t* ap = APRE + (size_t)row * FFN + col0;
        bf16_t* op = ACT + (size_t)row * FFN + col0;
#pragma unroll
        for (int bj = 0; bj < 2; ++bj) {
          const int c = bj * HALF;
          const bf16x8 z8 = {0, 0, 0, 0, 0, 0, 0, 0};
          const bf16x8 a0 = *(const bf16x8*)(ap + c);
          const bf16x8 a1 = sp >= 1 ? *(const bf16x8*)(ap - FFN + c) : z8;
          const bf16x8 a2 = sp >= 2 ? *(const bf16x8*)(ap - 2 * FFN + c) : z8;
          float o[8];
#pragma unroll
          for (int hh = 0; hh < 2; ++hh) {
            const f32x4 w0 = *(const f32x4*)(cw + col0 + c + 4 * hh), w1 = *(const f32x4*)(cw + FFN + col0 + c + 4 * hh), w2 = *(const f32x4*)(cw + 2 * FFN + col0 + c + 4 * hh);
#pragma unroll
            for (int j = 0; j < 4; ++j) {
              const float cv = w0[j] * bf2f((bf16_t)a2[4 * hh + j]) + w1[j] * bf2f((bf16_t)a1[4 * hh + j]) + w2[j] * bf2f((bf16_t)a0[4 * hh + j]);
              o[4 * hh + j] = gelu_rcp(cv) * acc[ai][bj][m][hh][j];
            }
          }
          u32x4 w; w.x = cvt_pk_bf16(o[0], o[1]); w.y = cvt_pk_bf16(o[2], o[3]); w.z = cvt_pk_bf16(o[4], o[5]); w.w = cvt_pk_bf16(o[6], o[7]);
          *(u32x4*)(op + c) = w;
        }
      }
  }
};
struct EpiGateMix {
  static constexpr bool PERM = true;
  bf16_t* MIX; float* MIX32; const bf16_t* BH; const float* bias;
  DI void operator()(const f32x4 (&acc)[2][2][4][2], const Unit& u, int wr, int wc, int fr, int fq) const {
    const int row0 = u.pm * BM + wr * 64 + fr, col0 = u.pn * BM + wc * 32 + 8 * fq;
    const bool rmw = u.aux > 0, fin = u.aux == 3;
    f32x4 bv[2][2];
#pragma unroll
    for (int bj = 0; bj < 2; ++bj)
#pragma unroll
      for (int n = 0; n < 2; ++n) bv[bj][n] = *(const f32x4*)(bias + u.aux * 1024 + col0 + bj * HALF + 4 * n);
    const f32x4 z4 = {0.f, 0.f, 0.f, 0.f};
    bf16x8 nb[2]; f32x4 nm[2][2];
#define GM_LOAD(it_) { const size_t row_ = (size_t)(row0 + ((it_) >> 2) * HALF + ((it_) & 3) * 16); \
      _Pragma("unroll") for (int bj = 0; bj < 2; ++bj) { nb[bj] = *(const bf16x8*)(BH + row_ * 4096 + u.aux * 1024 + col0 + bj * HALF); \
        nm[bj][0] = rmw ? *(const f32x4*)(MIX32 + row_ * DM + col0 + bj * HALF) : z4; nm[bj][1] = rmw ? *(const f32x4*)(MIX32 + row_ * DM + col0 + bj * HALF + 4) : z4; } }
    GM_LOAD(0);
#pragma unroll
    for (int it = 0; it < 8; ++it) {
      const int ai = it >> 2, m = it & 3;
      bf16x8 cb[2]; f32x4 cm[2][2];
#pragma unroll
      for (int bj = 0; bj < 2; ++bj) { cb[bj] = nb[bj]; cm[bj][0] = nm[bj][0]; cm[bj][1] = nm[bj][1]; }
      if (it + 1 < 8) GM_LOAD(it + 1);
      const size_t ro = (size_t)(row0 + ai * HALF + m * 16) * DM + col0;
#pragma unroll
      for (int bj = 0; bj < 2; ++bj) {
        f32x4 o[2];
#pragma unroll
        for (int hh = 0; hh < 2; ++hh)
#pragma unroll
          for (int j = 0; j < 4; ++j)
            o[hh][j] = sigmoid_rcp(acc[ai][bj][m][hh][j] + bv[bj][hh][j]) * bf2f((bf16_t)cb[bj][4 * hh + j]) + cm[bj][hh][j];
        if (fin) {
          u32x4 w; w.x = cvt_pk_bf16(o[0][0], o[0][1]); w.y = cvt_pk_bf16(o[0][2], o[0][3]); w.z = cvt_pk_bf16(o[1][0], o[1][1]); w.w = cvt_pk_bf16(o[1][2], o[1][3]);
          *(u32x4*)(MIX + ro + bj * HALF) = w;
        } else {
          *(f32x4*)(MIX32 + ro + bj * HALF) = o[0]; *(f32x4*)(MIX32 + ro + bj * HALF + 4) = o[1];
        }
      }
    }
#undef GM_LOAD
  }
};
}

DI void phase_ffn_act(const Params& p, int l) {
  bf16_t* AU = (bf16_t*)(p.ws + OFF_P);
  const float* cw = p.in[I_FCW] + (size_t)l * 3 * FFN;
  const int nthr = gridDim.x * NTHR;
  for (int run = obid() * NTHR + otid(); run < 1024 * 352; run += nthr) {
    const int ch = run / 352, j8 = run % 352, j0 = j8 * 8;
    float w0[8], w1[8], w2[8];
#pragma unroll
    for (int e = 0; e < 8; ++e) { w0[e] = cw[j0 + e]; w1[e] = cw[FFN + j0 + e]; w2[e] = cw[2 * FFN + j0 + e]; }
    const int t0 = ch * 64, s0 = t0 % SEQ;
    float a1[8], a2[8];
#pragma unroll
    for (int e = 0; e < 8; ++e) { a1[e] = 0.f; a2[e] = 0.f; }
    if (s0 > 0) {
      bf16x8 v1 = *(const bf16x8*)(AU + (size_t)(t0 - 1) * AUS + j0);
      bf16x8 v2 = *(const bf16x8*)(AU + (size_t)(t0 - 2) * AUS + j0);
#pragma unroll
      for (int e = 0; e < 8; ++e) { a1[e] = bf2f((bf16_t)v1[e]); a2[e] = bf2f((bf16_t)v2[e]); }
    }
    for (int t = t0; t < t0 + 64; ++t) {
      bf16x8 va = *(const bf16x8*)(AU + (size_t)t * AUS + j0);
      bf16x8 vu = *(const bf16x8*)(AU + (size_t)t * AUS + FFN + j0);
      float o[8];
#pragma unroll
      for (int e = 0; e < 8; ++e) {
        float a0 = bf2f((bf16_t)va[e]);
        float cv = w0[e] * a2[e] + w1[e] * a1[e] + w2[e] * a0;
        o[e] = geluf_(cv) * bf2f((bf16_t)vu[e]);
        a2[e] = a1[e]; a1[e] = a0;
      }
      uint4 ov = {pack2(o[0], o[1]), pack2(o[2], o[3]), pack2(o[4], o[5]), pack2(o[6], o[7])};
      *(uint4*)(AU + (size_t)t * AUS + FFN + j0) = ov;
    }
  }
}

DI float mixf(bf16_t cur, bf16_t prev, float mu) { const float c = bf2f(cur); return c + (bf2f(prev) - c) * mu; }
DI void rw_prep_item(const Params& p, int l, int item, char* smem) {
  const bf16_t* P = (const bf16_t*)(p.ws + OFF_P);
  bf16_t* RD = (bf16_t*)(p.ws + OFF_L);
  bf16_t* RKK = (bf16_t*)(p.ws + OFF_L + GSZ);
  bf16_t* RA = (bf16_t*)(p.ws + OFF_L + 2 * GSZ);
  bf16_t* RG = (bf16_t*)(p.ws + OFF_L + 3 * GSZ);
  float* BON = (float*)(p.ws + OFF_BON);
  const int b = item >> 6, ct = item & 63;
  const int tid = otid(), lane = tid & 63, wv = tid >> 6, hd = wv & 3, mi = wv >> 2, r = lane & 31, h = lane >> 5;
  bf16_t* TX = (bf16_t*)smem;
  bf16_t* XA = TX + 64 * 40;
  bf16_t* SG = XA + 64 * 40;
  const float* mu = p.in[I_RMU] + (size_t)l * 896;
  const size_t tok0 = (size_t)b * SEQ + ct * 64;
  bf16x8 bw[2][2], ba[2][2], bg[2][4];
  {
    const float* wp = p.in[I_RWUP] + (size_t)l * 32 * 256 + hd * 64 + r;
    const float* ap = p.in[I_RAUP] + (size_t)l * 32 * 256 + hd * 64 + r;
    const float* gp = p.in[I_RGUP] + (size_t)l * 64 * 256 + hd * 64 + r;
    asm volatile("" : "+v"(wp), "+v"(ap), "+v"(gp));
#pragma unroll
    for (int ni = 0; ni < 2; ++ni) {
#pragma unroll
      for (int ks = 0; ks < 2; ++ks) {
        unsigned uw[4], ua[4];
#pragma unroll
        for (int j2 = 0; j2 < 4; ++j2) {
          const int k = 16 * ks + 8 * h + 2 * j2;
          uw[j2] = pack2(wp[k * 256 + 32 * ni], wp[(k + 1) * 256 + 32 * ni]);
          ua[j2] = pack2(ap[k * 256 + 32 * ni], ap[(k + 1) * 256 + 32 * ni]);
        }
        uint4 t1 = {uw[0], uw[1], uw[2], uw[3]}, t2 = {ua[0], ua[1], ua[2], ua[3]};
        bw[ni][ks] = __builtin_bit_cast(bf16x8, t1); ba[ni][ks] = __builtin_bit_cast(bf16x8, t2);
      }
#pragma unroll
      for (int ks = 0; ks < 4; ++ks) {
        unsigned ug[4];
#pragma unroll
        for (int j2 = 0; j2 < 4; ++j2) { const int k = 16 * ks + 8 * h + 2 * j2; ug[j2] = pack2(gp[k * 256 + 32 * ni], gp[(k + 1) * 256 + 32 * ni]); }
        uint4 t3 = {ug[0], ug[1], ug[2], ug[3]};
        bg[ni][ks] = __builtin_bit_cast(bf16x8, t3);
      }
    }
  }
#pragma unroll 4
  for (int i = 0; i < 16; ++i) {
    const int e = tid + NTHR * i; const int t = e >> 7, f = e & 127;
    const bf16_t* pr = P + (tok0 + t) * PSTR + C_RW + 768 + f;
    const bf16_t cur = pr[0];
    const bf16_t prev = (ct * 64 + t > 0) ? (pr - PSTR)[0] : (bf16_t)0;
    const float m = mixf(cur, prev, mu[768 + f]);
    if (f < 32) TX[t * 40 + f] = f2bf(tanhf_(m));
    else if (f < 64) XA[t * 40 + f - 32] = f2bf(m);
    else SG[t * 72 + f - 64] = f2bf(sigmoidf_(m));
  }
  __syncthreads();
  f32x16 cw[2], ca[2], cg[2];
#pragma unroll
  for (int ni = 0; ni < 2; ++ni)
#pragma unroll
    for (int i = 0; i < 16; ++i) { cw[ni][i] = 0.f; ca[ni][i] = 0.f; cg[ni][i] = 0.f; }
#pragma unroll
  for (int ks = 0; ks < 2; ++ks) {
    const bf16x8 atx = *(const bf16x8*)(TX + (32 * mi + r) * 40 + 16 * ks + 8 * h);
    const bf16x8 axa = *(const bf16x8*)(XA + (32 * mi + r) * 40 + 16 * ks + 8 * h);
#pragma unroll
    for (int ni = 0; ni < 2; ++ni) { cw[ni] = mfma32(atx, bw[ni][ks], cw[ni]); ca[ni] = mfma32(axa, ba[ni][ks], ca[ni]); }
  }
#pragma unroll
  for (int ks = 0; ks < 4; ++ks) {
    const bf16x8 asg = *(const bf16x8*)(SG + (32 * mi + r) * 72 + 16 * ks + 8 * h);
#pragma unroll
    for (int ni = 0; ni < 2; ++ni) cg[ni] = mfma32(asg, bg[ni][ks], cg[ni]);
  }
  float ss[16], bn[16];
#pragma unroll
  for (int i = 0; i < 16; ++i) { ss[i] = 0.f; bn[i] = 0.f; }
#pragma unroll
  for (int ni = 0; ni < 2; ++ni) {
    const int hc = hd * 64 + 32 * ni + r;
    const float w0c = p.in[I_RW0][l * 256 + hc], a0c = p.in[I_RA0][l * 256 + hc], kkc = p.in[I_RKK][l * 256 + hc],
                kac = p.in[I_RKA][l * 256 + hc], rkc = p.in[I_RRK][l * 256 + hc], mu_r = mu[hc], mu_k = mu[256 + hc];
#pragma unroll
    for (int i = 0; i < 16; ++i) {
      const int tl = 32 * mi + crow(i, h);
      const size_t tok = tok0 + tl;
      const bf16_t* pr = P + tok * PSTR + C_RW + hc;
      const bool hp = (ct * 64 + tl) > 0;
      const float rr = mixf(pr[0], hp ? (pr - PSTR)[0] : (bf16_t)0, mu_r);
      const float k = mixf(pr[256], hp ? (pr - PSTR)[256] : (bf16_t)0, mu_k);
      const float wl = w0c + cw[ni][i];
      const float wlog = -softplusf_(-wl) - 0.5f;
      const float dd = 1.f - __expf(-__expf(wlog));
      const float a = sigmoidf_(a0c + ca[ni][i]);
      const float kkr = k * kkc;
      const float kp = k * (1.f + (a - 1.f) * kac);
      ss[i] += kkr * kkr; bn[i] += rr * kp * rkc;
      cw[ni][i] = kkr;
      RD[tok * 256 + hc] = f2bf(dd); RA[tok * 256 + hc] = f2bf(a); RG[tok * 256 + hc] = f2bf(cg[ni][i]);
    }
  }
#pragma unroll
  for (int i = 0; i < 16; ++i) {
#pragma unroll
    for (int o = 1; o < 32; o <<= 1) { ss[i] += __shfl_xor(ss[i], o); bn[i] += __shfl_xor(bn[i], o); }
    ss[i] = rsqrtf(ss[i] + EPSF);
  }
#pragma unroll
  for (int ni = 0; ni < 2; ++ni) {
    const int hc = hd * 64 + 32 * ni + r;
#pragma unroll
    for (int i = 0; i < 16; ++i) {
      const size_t tok = tok0 + 32 * mi + crow(i, h);
      RKK[tok * 256 + hc] = f2bf(cw[ni][i] * ss[i]);
    }
  }
  if (r == 0) {
#pragma unroll
    for (int i = 0; i < 16; ++i) BON[(tok0 + 32 * mi + crow(i, h)) * 4 + hd] = bn[i];
  }
}

DI void rwkv_scan_item(const Params& p, int l, int b, int hd, int half, char* smem) {
  const bf16_t* P = (const bf16_t*)(p.ws + OFF_P);
  bf16_t* O = (bf16_t*)(p.ws + OFF_O);
  const bf16_t* RD = (const bf16_t*)(p.ws + OFF_L);
  const bf16_t* RKK = (const bf16_t*)(p.ws + OFF_L + GSZ);
  const bf16_t* RA = (const bf16_t*)(p.ws + OFF_L + 2 * GSZ);
  float* fb = (float*)smem;
  float* Yb = fb + 2 * 12352;
  const int tid = otid(), lane = tid & 63, wv = tid >> 6;
  const int hc = hd * 64 + lane;
  constexpr int NCH = SEQ / 32;
  float S[8];
#pragma unroll
  for (int j = 0; j < 8; ++j) S[j] = 0.f;
  const int rl = lane >> 3, kq = lane & 7, vloc = (wv & 3) * 8 + rl, vrow = half * 32 + vloc;
  const float* mu = p.in[I_RMU] + (size_t)l * 896;
  const float mu_r = mu[hc], mu_k = mu[256 + hc], mu_v = mu[512 + hc];
  const float kac = p.in[I_RKA][l * 256 + hc];
  const int pw = wv & 3;
  unsigned raw[8][9];
#pragma unroll
  for (int j = 0; j < 8; ++j)
#pragma unroll
    for (int e = 0; e < 9; ++e) raw[j][e] = 0u;
#define RAWLOAD(i_)                                                                                 \
  {                                                                                                 \
    _Pragma("unroll") for (int j = 0; j < 8; ++j) {                                                 \
      const int s_ = (i_) * 32 + pw * 8 + j;                                                        \
      const size_t tok_ = (size_t)b * SEQ + s_;                                                     \
      const bf16_t* pr_ = P + tok_ * PSTR + C_RW;                                                   \
      raw[j][0] = pr_[hc]; raw[j][1] = pr_[256 + hc]; raw[j][2] = pr_[512 + hc];                    \
      if (s_ > 0) { raw[j][3] = (pr_ - PSTR)[hc]; raw[j][4] = (pr_ - PSTR)[256 + hc]; raw[j][5] = (pr_ - PSTR)[512 + hc]; } \
      else { raw[j][3] = 0u; raw[j][4] = 0u; raw[j][5] = 0u; }                                      \
      raw[j][6] = RD[tok_ * 256 + hc]; raw[j][7] = RKK[tok_ * 256 + hc]; raw[j][8] = RA[tok_ * 256 + hc]; \
    }                                                                                               \
  }
#define RBAR() { asm volatile("s_waitcnt lgkmcnt(0)" ::: "memory"); __builtin_amdgcn_s_barrier(); asm volatile("" ::: "memory"); }
  if (wv >= 4) RAWLOAD(0);
#pragma unroll 1
  for (int i = 0; i < NCH + 2; ++i) {
    if (wv >= 4) {
      float* B = fb + (i & 1) * 12352;
      if (i >= 2) {
        const float* Yc = Yb + (i & 1) * 1024;
        if (lane < 32) {
#pragma unroll
          for (int j = 0; j < 8; ++j) {
            const int tl = pw * 8 + j;
            const size_t tok = (size_t)b * SEQ + (i - 2) * 32 + tl;
            O[tok * DM + 768 + hd * 64 + half * 32 + lane] = f2bf(Yc[tl * 32 + lane]);
          }
        }
      }
      if (i < NCH) {
#pragma unroll
        for (int j = 0; j < 8; ++j) {
          const int tl = pw * 8 + j;
          const float r = mixf((bf16_t)raw[j][0], (bf16_t)raw[j][3], mu_r), k = mixf((bf16_t)raw[j][1], (bf16_t)raw[j][4], mu_k), v = mixf((bf16_t)raw[j][2], (bf16_t)raw[j][5], mu_v);
          const float w = 1.f - bf2f((bf16_t)raw[j][6]), kk = bf2f((bf16_t)raw[j][7]), a = bf2f((bf16_t)raw[j][8]);
          const float ka = kk * a, kp = k * (1.f + (a - 1.f) * kac);
          const float c1 = wave_sum(ka * r), c2 = wave_sum(kp * r);
          B[tl * 64 + lane] = w; B[2048 + tl * 64 + lane] = kk; B[4096 + tl * 64 + lane] = ka; B[6144 + tl * 64 + lane] = kp;
          B[8192 + tl * 64 + lane] = w * r; B[10240 + tl * 64 + lane] = v;
          if (lane == 0) { B[12288 + tl * 2] = c1; B[12288 + tl * 2 + 1] = c2; }
        }
        if (i + 1 < NCH) RAWLOAD(i + 1);
      }
    } else if (i >= 1 && i <= NCH) {
      const float* B = fb + ((i - 1) & 1) * 12352;
      float* Yc = Yb + ((i - 1) & 1) * 1024;
      f32x4 vw[2][10]; float vvv[2]; float2 vsc[2];
#define RWLD(t_, s_)                                                                              \
      { const float* bt_ = B + (t_) * 64 + kq * 8;                                                 \
        _Pragma("unroll") for (int q_ = 0; q_ < 5; ++q_) { vw[s_][2 * q_] = *(const f32x4*)(bt_ + 2048 * q_); vw[s_][2 * q_ + 1] = *(const f32x4*)(bt_ + 2048 * q_ + 4); } \
        vvv[s_] = B[10240 + (t_) * 64 + vrow]; vsc[s_] = *(const float2*)(B + 12288 + (t_) * 2); }
#pragma unroll 1
      for (int tb = 0; tb < 32; tb += 16) {
      RWLD(tb, 0);
#pragma unroll
      for (int t = 0; t < 16; ++t) {
        const int cs = t & 1;
        if (t + 1 < 16) RWLD(tb + t + 1, cs ^ 1);
        const f32x4 w0 = vw[cs][0], w1 = vw[cs][1], kk0 = vw[cs][2], kk1 = vw[cs][3], ka0 = vw[cs][4], ka1 = vw[cs][5],
                    kp0 = vw[cs][6], kp1 = vw[cs][7], wr0 = vw[cs][8], wr1 = vw[cs][9];
        const float vv = vvv[cs]; const float2 sc = vsc[cs];
        float d0 = 0.f, e0 = 0.f;
#pragma unroll
        for (int j = 0; j < 4; ++j) { d0 += S[j] * kk0[j] + S[j + 4] * kk1[j]; e0 += S[j] * wr0[j] + S[j + 4] * wr1[j]; }
        d0 = reduce8(d0); e0 = reduce8(e0);
        const float sa0 = -d0;
        const float y0 = e0 + sa0 * sc.x + vv * sc.y;
#pragma unroll
        for (int j = 0; j < 4; ++j) {
          S[j] = S[j] * w0[j] + sa0 * ka0[j] + vv * kp0[j]; S[j + 4] = S[j + 4] * w1[j] + sa0 * ka1[j] + vv * kp1[j];
        }
        if (kq == 0) Yc[(tb + t) * 32 + vloc] = y0;
      }
      }
#undef RWLD
    }
    RBAR();
  }
#undef RAWLOAD
#undef RBAR
}

DI void rwkv_post(const Params& p, int l) {
  const bf16_t* P = (const bf16_t*)(p.ws + OFF_P);
  bf16_t* O = (bf16_t*)(p.ws + OFF_O);
  const bf16_t* RG = (const bf16_t*)(p.ws + OFF_L + 3 * GSZ);
  const float* BON = (const float*)(p.ws + OFF_BON);
  const int tid = otid(), lane = tid & 63, wv = tid >> 6;
  const float* mu = p.in[I_RMU] + (size_t)l * 896;
  const int nw = gridDim.x * 8;
  for (int task0 = (obid() * 8 + wv) * 4; task0 < NTOK * 4; task0 += nw * 4) {
    float yv[4], vv[4], gv[4], bv[4];
#pragma unroll
    for (int q = 0; q < 4; ++q) {
      const int task = task0 + q; const size_t tok = task >> 2; const int hd = task & 3, hc = hd * 64 + lane;
      yv[q] = bf2f(O[tok * DM + 768 + hc]);
      const bf16_t cur = P[tok * PSTR + C_RW + 512 + hc];
      const bf16_t prev = (tok % SEQ) ? P[(tok - 1) * PSTR + C_RW + 512 + hc] : (bf16_t)0;
      vv[q] = mixf(cur, prev, mu[512 + hc]);
      gv[q] = bf2f(RG[tok * 256 + hc]); bv[q] = BON[tok * 4 + hd];
    }
#pragma unroll
    for (int q = 0; q < 4; ++q) {
      const int task = task0 + q; const size_t tok = task >> 2; const int hd = task & 3, hc = hd * 64 + lane;
      const float mean = wave_sum(yv[q]) * (1.f / 64.f);
      const float d = yv[q] - mean;
      const float var = wave_sum(d * d) * (1.f / 64.f);
      const float yn = d * rsqrtf(var + 64e-5f) * p.in[I_RLG][l * 256 + hc] + p.in[I_RLB][l * 256 + hc];
      O[tok * DM + 768 + hc] = f2bf((yn + bv[q] * vv[q]) * gv[q]);
    }
  }
}

DI void sb_item(const Params& p, int item, char* smem) {
  const bf16_t* P = (const bf16_t*)(p.ws + OFF_P);
  bf16_t* O = (bf16_t*)(p.ws + OFF_O);
  const int qt = item & 15, hd = (item >> 4) & 3, b = item >> 6;
  const int tid = otid(), lane = tid & 63, wv = tid >> 6, r = lane & 31, h = lane >> 5;
  bf16_t* Vt = (bf16_t*)(smem + wv * 8704);
  const int q0 = qt * 256 + wv * 32;
  const int sq = q0 + r;
  const size_t tokb = (size_t)b * SEQ;
  bf16x8 qf[4];
#pragma unroll
  for (int ks = 0; ks < 4; ++ks) qf[ks] = *(const bf16x8*)(P + (tokb + sq) * PSTR + C_SB_Q + hd * 64 + ks * 16 + h * 8);
  f32x16 accO[2];
#pragma unroll
  for (int i = 0; i < 16; ++i) { accO[0][i] = 0.f; accO[1][i] = 0.f; }
  float Prun = 1.f;
  bf16x8 kf[2][4];
  const int kt0 = (q0 + 31) >> 6;
#define SBKLOAD(kt_) { _Pragma("unroll") for (int m = 0; m < 2; ++m) _Pragma("unroll") for (int ks = 0; ks < 4; ++ks) \
    kf[m][ks] = *(const bf16x8*)(P + (tokb + (kt_) * 64 + 32 * m + r) * PSTR + C_SB_K + hd * 64 + ks * 16 + h * 8); }
  SBKLOAD(kt0);
  for (int kt = kt0; kt >= 0; --kt) {
    const int k0 = kt * 64;
    bf16x8 vr[8];
#pragma unroll
    for (int it = 0; it < 8; ++it) vr[it] = *(const bf16x8*)(P + (tokb + k0 + it * 8 + (lane >> 3)) * PSTR + C_SB_V + hd * 64 + (lane & 7) * 8);
    f32x16 acc[2];
#pragma unroll
    for (int m = 0; m < 2; ++m) {
#pragma unroll
      for (int i = 0; i < 16; ++i) acc[m][i] = 0.f;
#pragma unroll
      for (int ks = 0; ks < 4; ++ks) acc[m] = mfma32(kf[m][ks], qf[ks], acc[m]);
    }
    if (kt > 0) SBKLOAD(kt - 1);
    float om[2][16];
#pragma unroll
    for (int m = 0; m < 2; ++m)
#pragma unroll
      for (int i = 0; i < 16; ++i) {
        const int key = k0 + 32 * m + crow(i, h);
        const float z = fmaxf(acc[m][i] * 0.125f, -80.f);
        const float e = __expf(-z);
        const float sg = __builtin_amdgcn_rcpf(1.f + e);
        const bool valid = key < sq;
        acc[m][i] = valid ? sg : 0.f;
        om[m][i] = valid ? e * sg : 1.f;
      }
    float gp[8];
#pragma unroll
    for (int q = 0; q < 8; ++q) {
      const int m = q >> 2, g = q & 3;
      gp[q] = (om[m][4 * g] * om[m][4 * g + 1]) * (om[m][4 * g + 2] * om[m][4 * g + 3]);
    }
    float run = 1.f;
#pragma unroll
    for (int q = 7; q >= 0; --q) {
      const int m = q >> 2, g = q & 3;
      const float pg = __shfl_xor(gp[q], 32);
      const float f3 = Prun * run * (h == 0 ? pg : 1.f);
      const float f2 = f3 * om[m][4 * g + 3], f1 = f2 * om[m][4 * g + 2], f0 = f1 * om[m][4 * g + 1];
      acc[m][4 * g + 3] *= f3; acc[m][4 * g + 2] *= f2; acc[m][4 * g + 1] *= f1; acc[m][4 * g + 0] *= f0;
      run *= gp[q] * pg;
    }
    Prun *= run;
    __builtin_amdgcn_wave_barrier();
#pragma unroll
    for (int it = 0; it < 8; ++it) {
      const int key = it * 8 + (lane >> 3), chv = lane & 7;
#pragma unroll
      for (int e = 0; e < 8; ++e) Vt[(chv * 8 + e) * 68 + key] = (bf16_t)vr[it][e];
    }
    __builtin_amdgcn_wave_barrier();
#pragma unroll
    for (int m = 0; m < 2; ++m)
#pragma unroll
      for (int s2 = 0; s2 < 2; ++s2) {
        uint4 uu = {pack2(acc[m][8 * s2 + 0], acc[m][8 * s2 + 1]), pack2(acc[m][8 * s2 + 2], acc[m][8 * s2 + 3]),
                    pack2(acc[m][8 * s2 + 4], acc[m][8 * s2 + 5]), pack2(acc[m][8 * s2 + 6], acc[m][8 * s2 + 7])};
        const bf16x8 pb = __builtin_bit_cast(bf16x8, uu);
#pragma unroll
        for (int dt = 0; dt < 2; ++dt) {
          const bf16_t* vp = Vt + (32 * dt + r) * 68 + 32 * m + 16 * s2 + 4 * h;
          s16x4 lo = *(const s16x4*)vp, hi = *(const s16x4*)(vp + 8);
          bf16x8 va = __builtin_shufflevector(lo, hi, 0, 1, 2, 3, 4, 5, 6, 7);
          accO[dt] = mfma32(va, pb, accO[dt]);
        }
      }
    __builtin_amdgcn_wave_barrier();
    if (__ballot(Prun > 1e-37f) == 0ull) break;
  }
#undef SBKLOAD
#pragma unroll
  for (int dt = 0; dt < 2; ++dt)
#pragma unroll
    for (int g = 0; g < 4; ++g) {
      const int d = 32 * dt + 8 * g + 4 * h;
      uint2 o = {pack2(accO[dt][4 * g], accO[dt][4 * g + 1]), pack2(accO[dt][4 * g + 2], accO[dt][4 * g + 3])};
      *(uint2*)(O + (tokb + sq) * DM + 256 + hd * 64 + d) = o;
    }
}

DI int frag_off(int row, int k) {
  const int rt = row >> 4, fr = row & 15, ks = k >> 5, kk = k & 31, hi = kk >> 4, fq = (kk & 15) >> 2, j = (kk & 3) + 4 * hi;
  return ((rt * 2 + ks) * 64 + fq * 16 + fr) * 8 + j;
}
DI int frag_off8(int row, int k0) {
  const int rt = row >> 4, fr = row & 15, ks = k0 >> 5, kk = k0 & 31, hi = kk >> 4, fq = (kk & 15) >> 2;
  return ((rt * 2 + ks) * 64 + fq * 16 + fr) * 8 + 4 * hi;
}
DI void gdn_intra_item(const Params& p, int l, int item, char* smem) {
  const bf16_t* P = (const bf16_t*)(p.ws + OFF_P);
  const int hp = item & 1, c = (item >> 1) & 63, b = item >> 7;
  const int tid = otid(), lane = tid & 63;
  bf16_t* Kb = (bf16_t*)smem;
  bf16_t* Qb = Kb + 2 * 64 * 72;
  bf16_t* Vb = Qb + 2 * 64 * 72;
  float* Lm = (float*)(smem + 3 * 2 * 64 * 72 * 2);
  float* Gs = Lm + 2 * 4096;
  float* Bs = Gs + 128;
  const size_t tok0 = (size_t)b * SEQ + c * 64;
  const float* cw = p.in[I_GCW] + (size_t)l * 4 * 768;
  float* CW = Bs + 128;
  for (int e = tid; e < 6 * 4 * 64; e += NTHR) {
    const int blk = e >> 8, j = (e >> 6) & 3, col = e & 63;
    const int hh_ = blk / 3, which_ = blk % 3;
    CW[e] = cw[j * 768 + which_ * 256 + (hp * 2 + hh_) * 64 + col];
  }
  __syncthreads();
  {
    const int t = tid >> 3, cg = tid & 7;
#pragma unroll 3
    for (int it = 0; it < 6; ++it) {
      const int hh = it / 3, which = it % 3, head = hp * 2 + hh;
      const int ccol = which * 256 + head * 64 + cg * 8;
      float acc[8];
#pragma unroll
      for (int e = 0; e < 8; ++e) acc[e] = 0.f;
#pragma unroll
      for (int j = 0; j < 4; ++j) {
        const int s = c * 64 + t - 3 + j;
        if (s >= 0) {
          bf16x8 xv = *(const bf16x8*)(P + ((size_t)b * SEQ + s) * PSTR + C_GDN_Q + ccol);
          f32x4 wa = *(const f32x4*)(CW + (it * 4 + j) * 64 + cg * 8), wb = *(const f32x4*)(CW + (it * 4 + j) * 64 + cg * 8 + 4);
#pragma unroll
          for (int e = 0; e < 4; ++e) { acc[e] += wa[e] * bf2f((bf16_t)xv[e]); acc[e + 4] += wb[e] * bf2f((bf16_t)xv[e + 4]); }
        }
      }
      float ss = 0.f;
#pragma unroll
      for (int e = 0; e < 8; ++e) { acc[e] = siluf_(acc[e]); ss += acc[e] * acc[e]; }
      ss += __shfl_xor(ss, 1); ss += __shfl_xor(ss, 2); ss += __shfl_xor(ss, 4);
      float sc = 1.f;
      if (which == 0) sc = rsqrtf(ss + EPSF) * 0.125f;
      else if (which == 1) sc = rsqrtf(ss + EPSF);
      uint4 ov = {pack2(acc[0] * sc, acc[1] * sc), pack2(acc[2] * sc, acc[3] * sc), pack2(acc[4] * sc, acc[5] * sc), pack2(acc[6] * sc, acc[7] * sc)};
      bf16_t* dst = (which == 0 ? Qb : (which == 1 ? Kb : Vb)) + (hh * 64 + t) * 72 + cg * 8;
      *(uint4*)dst = ov;
    }
  }
  if (tid < 128) {
    const int hh = tid >> 6, t = lane, head = hp * 2 + hh;
    const float a_in = bf2f(P[(tok0 + t) * PSTR + C_GDN_A + head]);
    const float b_in = bf2f(P[(tok0 + t) * PSTR + C_GDN_B + head]);
    const float beta = sigmoidf_(b_in);
    float g = -__expf(p.in[I_GAL][l * 4 + head]) * softplusf_(a_in + p.in[I_GDT][l * 4 + head]);
#pragma unroll
    for (int d = 1; d < 64; d <<= 1) { float v = __shfl_up(g, d); if (lane >= d) g += v; }
    Gs[hh * 64 + t] = g; Bs[hh * 64 + t] = beta;
  }
  __syncthreads();
  const int hh = tid >> 8, lt = tid & 255, head = hp * 2 + hh;
  const size_t ih = ((size_t)(b * 4 + head)) * 64 + c;
  bf16_t* GW = (bf16_t*)(p.ws + OFF_G) + ih * 4096;
  bf16_t* GQD = (bf16_t*)(p.ws + OFF_G + GSZ) + ih * 4096;
  bf16_t* GQK = (bf16_t*)(p.ws + OFF_G + 2 * GSZ) + ih * 4096;
  bf16_t* GKD = (bf16_t*)(p.ws + OFF_G + 3 * GSZ) + ih * 4096;
  bf16_t* GU = (bf16_t*)(p.ws + OFF_G + 4 * GSZ) + ih * 4096;
  float* GCD = (float*)(p.ws + OFF_GCD);
  const float* Gh = Gs + hh * 64; const float* Bh = Bs + hh * 64;
  {
    const int wq = (tid >> 6) & 3, ti = wq >> 1, tj = wq & 1, r = lane & 31, h = lane >> 5;
    f32x16 akk, aqk;
#pragma unroll
    for (int i = 0; i < 16; ++i) { akk[i] = 0.f; aqk[i] = 0.f; }
    if (ti >= tj) {
#pragma unroll
      for (int ks = 0; ks < 4; ++ks) {
        bf16x8 ka = *(const bf16x8*)(Kb + (hh * 64 + 32 * ti + r) * 72 + ks * 16 + h * 8);
        bf16x8 qa = *(const bf16x8*)(Qb + (hh * 64 + 32 * ti + r) * 72 + ks * 16 + h * 8);
        bf16x8 kb = *(const bf16x8*)(Kb + (hh * 64 + 32 * tj + r) * 72 + ks * 16 + h * 8);
        akk = mfma32(ka, kb, akk);
        aqk = mfma32(qa, kb, aqk);
      }
    }
    const int j = 32 * tj + r;
    const float Gj = Gh[j];
#pragma unroll
    for (int i_ = 0; i_ < 16; ++i_) {
      const int i = 32 * ti + crow(i_, h);
      const float dec = (i >= j) ? __expf(Gh[i] - Gj) : 0.f;
      Lm[hh * 4096 + i * 64 + j] = (i > j) ? Bh[i] * akk[i_] * dec : 0.f;
      GQK[frag_off(i, j)] = f2bf((i >= j) ? aqk[i_] * dec : 0.f);
    }
  }
  __syncthreads();
  if (lt < 128) {
    const int cc = lt;
    float x[64];
    if (cc < 64) {
#pragma unroll
      for (int i = 0; i < 64; ++i) x[i] = bf2f(Vb[(hh * 64 + i) * 72 + cc]) * Bh[i];
    } else {
#pragma unroll
      for (int i = 0; i < 64; ++i) x[i] = bf2f(Kb[(hh * 64 + i) * 72 + cc - 64]) * Bh[i] * __expf(Gh[i]);
    }
    const float* Lh = Lm + hh * 4096;
#pragma unroll
    for (int i = 1; i < 64; ++i) {
      float s = x[i];
#pragma unroll
      for (int j4 = 0; j4 < (i + 3) / 4; ++j4) {
        const f32x4 lv = *(const f32x4*)(Lh + i * 64 + j4 * 4);
#pragma unroll
        for (int e = 0; e < 4; ++e) if (j4 * 4 + e < i) s -= lv[e] * x[j4 * 4 + e];
      }
      x[i] = s;
    }
    if (cc < 64) {
      const int split = cc >> 4, fr = cc & 15;
#pragma unroll
      for (int i4 = 0; i4 < 16; ++i4) {
        uint2 ov = {pack2(x[4 * i4], x[4 * i4 + 1]), pack2(x[4 * i4 + 2], x[4 * i4 + 3])};
        *(uint2*)(GU + ((split * 4 + (i4 >> 2)) * 64 + (i4 & 3) * 16 + fr) * 4) = ov;
      }
    } else {
#pragma unroll
      for (int i = 0; i < 64; ++i) GW[frag_off(i, cc - 64)] = f2bf(x[i]);
    }
  } else {
    const int q_ = lt - 128;
    const float Glast = Gh[63];
#pragma unroll
    for (int i = 0; i < 4; ++i) {
      const int q = q_ + 128 * i; const int pos = q >> 3, kc = q & 7;
      bf16x8 qv = *(const bf16x8*)(Qb + (hh * 64 + pos) * 72 + kc * 8);
      const float eg = __expf(Gh[pos]);
      uint4 ov = {pack2(bf2f((bf16_t)qv[0]) * eg, bf2f((bf16_t)qv[1]) * eg), pack2(bf2f((bf16_t)qv[2]) * eg, bf2f((bf16_t)qv[3]) * eg),
                  pack2(bf2f((bf16_t)qv[4]) * eg, bf2f((bf16_t)qv[5]) * eg), pack2(bf2f((bf16_t)qv[6]) * eg, bf2f((bf16_t)qv[7]) * eg)};
      { const int fo = frag_off8(pos, kc * 8); uint2 o0 = {ov.x, ov.y}, o1 = {ov.z, ov.w}; *(uint2*)(GQD + fo) = o0; *(uint2*)(GQD + fo + 128) = o1; }
    }
#pragma unroll
    for (int i = 0; i < 4; ++i) {
      const int q = q_ + 128 * i; const int k = q >> 3, pc = q & 7;
      float o[8];
#pragma unroll
      for (int e = 0; e < 8; ++e) { const int pos = pc * 8 + e; o[e] = bf2f(Kb[(hh * 64 + pos) * 72 + k]) * __expf(Glast - Gh[pos]); }
      uint4 ov = {pack2(o[0], o[1]), pack2(o[2], o[3]), pack2(o[4], o[5]), pack2(o[6], o[7])};
      { const int fo = frag_off8(k, pc * 8); uint2 o0 = {ov.x, ov.y}, o1 = {ov.z, ov.w}; *(uint2*)(GKD + fo) = o0; *(uint2*)(GKD + fo + 128) = o1; }
    }
    if (q_ == 0) GCD[ih] = __expf(Glast);
  }
}

DI void gdn_rec_item(const Params& p, int l, int b, int head, char* smem) {
  const bf16_t* P = (const bf16_t*)(p.ws + OFF_P);
  bf16_t* O = (bf16_t*)(p.ws + OFF_O);
  float* SS = (float*)(smem + 81920);
  const int tid = otid(), lane = tid & 63, wv = tid >> 6, fr = lane & 15, fq = lane >> 4;
  const int split = wv & 3;
  const bool active = wv < 4;
  const float ng = p.in[I_GNG][l * 64 + split * 16 + fr];
  const float* GCD = (const float*)(p.ws + OFF_GCD);
  const size_t ih0 = ((size_t)(b * 4 + head)) * 64;
  f32x4 S[4];
#pragma unroll
  for (int kt = 0; kt < 4; ++kt) S[kt] = (f32x4){0.f, 0.f, 0.f, 0.f};
  u32x4 lr[10];
#pragma unroll
  for (int i = 0; i < 10; ++i) lr[i] = (u32x4){0u, 0u, 0u, 0u};
  const int lq = (wv & 3) * 64 + lane;
#define GLOADC(c_)                                                                              \
  {                                                                                             \
    _Pragma("unroll") for (int i = 0; i < 10; ++i) {                                            \
      const int q_ = lq + 256 * i; const int a_ = q_ >> 9, o_ = q_ & 511;                       \
      lr[i] = *(const u32x4*)((const bf16_t*)(p.ws + OFF_G + (size_t)a_ * GSZ) + (ih0 + (c_)) * 4096 + o_ * 8); \
    }                                                                                           \
  }
#define LSTORE(buf_)                                                                            \
  {                                                                                             \
    _Pragma("unroll") for (int i = 0; i < 10; ++i) {                                            \
      const int q_ = lq + 256 * i;                                                              \
      *(u32x4*)(smem + (buf_) * 40960 + q_ * 16) = lr[i];                                       \
    }                                                                                           \
  }
#define BAR_LDS() { asm volatile("s_waitcnt lgkmcnt(0)" ::: "memory"); __builtin_amdgcn_s_barrier(); asm volatile("" ::: "memory"); }
  float cdn = 0.f;
  if (!active) { GLOADC(0); LSTORE(0); GLOADC(1); }
  else cdn = GCD[ih0];
  BAR_LDS();
#pragma unroll 1
  for (int c = 0; c < 64; ++c) {
    f32x4 acco[4];
    if (active) {
      const char* bufp = smem + (c & 1) * 40960;
      const float cd = cdn;
      if (c + 1 < 64) cdn = GCD[ih0 + c + 1];
      float zr[16];
#pragma unroll
      for (int rt = 0; rt < 4; ++rt)
#pragma unroll
        for (int j = 0; j < 4; ++j) {
          const size_t tok = (size_t)b * SEQ + c * 64 + 16 * rt + 4 * fq + j;
          zr[rt * 4 + j] = bf2f(P[tok * PSTR + C_GDN_Z + head * 64 + split * 16 + fr]);
        }
      bf16x8 bS[2];
#pragma unroll
      for (int ks = 0; ks < 2; ++ks) {
        uint4 uu = {pack2(S[2 * ks][0], S[2 * ks][1]), pack2(S[2 * ks][2], S[2 * ks][3]), pack2(S[2 * ks + 1][0], S[2 * ks + 1][1]), pack2(S[2 * ks + 1][2], S[2 * ks + 1][3])};
        bS[ks] = __builtin_bit_cast(bf16x8, uu);
      }
      f32x4 u[4];
#pragma unroll
      for (int rt = 0; rt < 4; ++rt) {
        f32x4 aw = {0.f, 0.f, 0.f, 0.f};
        acco[rt] = (f32x4){0.f, 0.f, 0.f, 0.f};
#pragma unroll
        for (int ks = 0; ks < 2; ++ks) {
          const bf16x8 wa = *(const bf16x8*)(bufp + ((rt * 2 + ks) * 64 + lane) * 16);
          const bf16x8 qa = *(const bf16x8*)(bufp + 8192 + ((rt * 2 + ks) * 64 + lane) * 16);
          aw = mfma16(wa, bS[ks], aw); acco[rt] = mfma16(qa, bS[ks], acco[rt]);
        }
        const s16x4 uv = *(const s16x4*)(bufp + 32768 + ((split * 4 + rt) * 64 + lane) * 8);
#pragma unroll
        for (int j = 0; j < 4; ++j) u[rt][j] = bf2f((bf16_t)uv[j]) - aw[j];
      }
      bf16x8 bU[2];
#pragma unroll
      for (int ks = 0; ks < 2; ++ks) {
        uint4 uu = {pack2(u[2 * ks][0], u[2 * ks][1]), pack2(u[2 * ks][2], u[2 * ks][3]), pack2(u[2 * ks + 1][0], u[2 * ks + 1][1]), pack2(u[2 * ks + 1][2], u[2 * ks + 1][3])};
        bU[ks] = __builtin_bit_cast(bf16x8, uu);
      }
#pragma unroll
      for (int rt = 0; rt < 4; ++rt) {
        f32x4 sn = S[rt] * cd;
#pragma unroll
        for (int ks = 0; ks < 2; ++ks) {
          const bf16x8 qa = *(const bf16x8*)(bufp + 16384 + ((rt * 2 + ks) * 64 + lane) * 16);
          const bf16x8 ka = *(const bf16x8*)(bufp + 24576 + ((rt * 2 + ks) * 64 + lane) * 16);
          acco[rt] = mfma16(qa, bU[ks], acco[rt]); sn = mfma16(ka, bU[ks], sn);
        }
        S[rt] = sn;
      }
#pragma unroll
      for (int rt = 0; rt < 4; ++rt)
#pragma unroll
        for (int j = 0; j < 4; ++j) {
          float s = acco[rt][j] * acco[rt][j];
          s += __shfl_xor(s, 1); s += __shfl_xor(s, 2); s += __shfl_xor(s, 4); s += __shfl_xor(s, 8);
          if (fr == 0) SS[(c & 1) * 256 + split * 64 + 16 * rt + 4 * fq + j] = s;
        }
      BAR_LDS();
      const float* ssb = SS + (c & 1) * 256;
#pragma unroll
      for (int rt = 0; rt < 4; ++rt)
#pragma unroll
        for (int j = 0; j < 4; ++j) {
          const int pos = 16 * rt + 4 * fq + j;
          const float tot = ssb[pos] + ssb[64 + pos] + ssb[128 + pos] + ssb[192 + pos];
          const float rn = rsqrtf(tot * (1.f / 64.f) + EPSF);
          const size_t tok = (size_t)b * SEQ + c * 64 + pos;
          O[tok * DM + 512 + head * 64 + split * 16 + fr] = f2bf(acco[rt][j] * rn * ng * siluf_(zr[rt * 4 + j]));
        }
    } else {
      if (c + 1 < 64) LSTORE((c + 1) & 1);
      if (c + 2 < 64) GLOADC(c + 2);
      BAR_LDS();
    }
  }
#undef GLOADC
#undef LSTORE
#undef BAR_LDS
}

DI void lru_item(const Params& p, int l, int item, char* smem, const int mode) {
  const bf16_t* P = (const bf16_t*)(p.ws + OFF_P);
  bf16_t* O = (bf16_t*)(p.ws + OFF_O);
  float* CA = (float*)(p.ws + OFF_LCA);
  float* CH = (float*)(p.ws + OFF_LCH);
  bf16_t* XS = (bf16_t*)smem;
  bf16_t* UB = (bf16_t*)(smem + 34816);
  const int b = item >> 6, ct = item & 63;
  const int tid = otid(), lane = tid & 63, wv = tid >> 6, r = lane & 31, h = lane >> 5, n = wv & 3, mi = wv >> 2;
  for (int i = 0; i < 5; ++i) {
    const int q = tid + NTHR * i;
    if (q < 67 * 32) {
      const int row = q >> 5, cc = q & 31;
      const int s = ct * 64 - 3 + row;
      uint4 v = {0u, 0u, 0u, 0u};
      if (s >= 0) v = *(const uint4*)(P + ((size_t)b * SEQ + s) * PSTR + C_LRU_X + cc * 8);
      *(uint4*)(XS + row * 256 + cc * 8) = v;
    }
  }
  bf16x8 bwr[2][4], bwi[2][4];
  {
    const float* wrp = p.in[I_LWR] + (((size_t)l * 4 + n) * 64) * 64 + r;
    const float* wip = p.in[I_LWI] + (((size_t)l * 4 + n) * 64) * 64 + r;
    asm volatile("" : "+v"(wrp), "+v"(wip));
#pragma unroll
    for (int ni = 0; ni < 2; ++ni)
#pragma unroll
      for (int ks = 0; ks < 4; ++ks) {
        unsigned ur[4], ui[4];
#pragma unroll
        for (int j2 = 0; j2 < 4; ++j2) {
          const int e = 16 * ks + 8 * h + 2 * j2;
          ur[j2] = pack2(wrp[e * 64 + 32 * ni], wrp[(e + 1) * 64 + 32 * ni]);
          ui[j2] = pack2(wip[e * 64 + 32 * ni], wip[(e + 1) * 64 + 32 * ni]);
        }
        uint4 t1 = {ur[0], ur[1], ur[2], ur[3]}, t2 = {ui[0], ui[1], ui[2], ui[3]};
        bwr[ni][ks] = __builtin_bit_cast(bf16x8, t1); bwi[ni][ks] = __builtin_bit_cast(bf16x8, t2);
      }
  }
  __syncthreads();
  {
    const int sc = tid >> 8, c = tid & 255;
    const float cb = p.in[I_LCB][l * 256 + c];
    const float c0 = p.in[I_LCW][(l * 4 + 0) * 256 + c], c1 = p.in[I_LCW][(l * 4 + 1) * 256 + c],
                c2 = p.in[I_LCW][(l * 4 + 2) * 256 + c], c3 = p.in[I_LCW][(l * 4 + 3) * 256 + c];
    for (int t = sc * 32; t < sc * 32 + 32; ++t)
      UB[t * 264 + c] = f2bf(cb + c0 * bf2f(XS[t * 256 + c]) + c1 * bf2f(XS[(t + 1) * 256 + c]) + c2 * bf2f(XS[(t + 2) * 256 + c]) + c3 * bf2f(XS[(t + 3) * 256 + c]));
  }
  __syncthreads();
  f32x16 ar[2], ai[2];
#pragma unroll
  for (int ni = 0; ni < 2; ++ni)
#pragma unroll
    for (int i = 0; i < 16; ++i) { ar[ni][i] = 0.f; ai[ni][i] = 0.f; }
#pragma unroll
  for (int ks = 0; ks < 4; ++ks) {
    const bf16x8 au = *(const bf16x8*)(UB + (32 * mi + r) * 264 + n * 64 + 16 * ks + 8 * h);
#pragma unroll
    for (int ni = 0; ni < 2; ++ni) { ar[ni] = mfma32(au, bwr[ni][ks], ar[ni]); ai[ni] = mfma32(au, bwi[ni][ks], ai[ni]); }
  }
  const int ck = ct * 2 + mi;
#pragma unroll
  for (int ni = 0; ni < 2; ++ni) {
    const int c = n * 64 + 32 * ni + r;
    const float brc = p.in[I_LBR][l * 256 + c], bic = p.in[I_LBI][l * 256 + c];
    const float lamsp = softplusf_(-p.in[I_LLAM][l * 256 + c]);
    float av[16], bv[16];
#pragma unroll
    for (int i = 0; i < 16; ++i) {
      const int tl = 32 * mi + crow(i, h);
      const float u = bf2f(UB[tl * 264 + c]);
      const float rg = sigmoid_rcp(ar[ni][i] + brc), ig = sigmoid_rcp(ai[ni][i] + bic);
      const float la = -8.f * rg * lamsp;
      av[i] = __expf(la);
      bv[i] = sqrtf(fmaxf(0.f, 1.f - __expf(2.f * la))) * (ig * u);
    }
    float GA[4], GB[4], PA[4], PB[4];
#pragma unroll
    for (int q = 0; q < 4; ++q) {
      float A = 1.f, hh = 0.f;
#pragma unroll
      for (int e = 0; e < 4; ++e) { hh = av[4 * q + e] * hh + bv[4 * q + e]; A *= av[4 * q + e]; }
      GA[q] = A; GB[q] = hh;
      PA[q] = __shfl_xor(A, 32); PB[q] = __shfl_xor(hh, 32);
    }
    float cin = 0.f;
    if (mode == 1) {
      const int lo = h ? (ck >> 1) : 0, hi = h ? ck : (ck >> 1);
      float A = 1.f, hh = 0.f;
      const float* ca = CA + ((size_t)b * 128) * 256 + c;
      const float* chp = CH + ((size_t)b * 128) * 256 + c;
      int k = lo;
      for (; k + 8 <= hi; k += 8) {
        float a8[8], h8[8];
#pragma unroll
        for (int e = 0; e < 8; ++e) { a8[e] = ca[(size_t)(k + e) * 256]; h8[e] = chp[(size_t)(k + e) * 256]; }
#pragma unroll
        for (int e = 0; e < 8; ++e) { hh = a8[e] * hh + h8[e]; A *= a8[e]; }
      }
      for (; k < hi; ++k) { const float a_ = ca[(size_t)k * 256], h_ = chp[(size_t)k * 256]; hh = a_ * hh + h_; A *= a_; }
      const float pAx = __shfl_xor(A, 32), pHx = __shfl_xor(hh, 32);
      cin = h ? (A * pHx + hh) : (pAx * hh + pHx);
    }
    float cg = cin, Ap = 1.f, myc[4];
#pragma unroll
    for (int q = 0; q < 4; ++q) {
      const float Ae = h ? PA[q] : GA[q], Be = h ? PB[q] : GB[q];
      const float Ao = h ? GA[q] : PA[q], Bo = h ? GB[q] : PB[q];
      const float c_even = cg;
      cg = Ae * cg + Be;
      const float c_odd = cg;
      cg = Ao * cg + Bo;
      myc[q] = h ? c_odd : c_even;
      Ap *= Ae * Ao;
    }
    if (mode == 0) {
      if (h == 0) { CA[((size_t)b * 128 + ck) * 256 + c] = Ap; CH[((size_t)b * 128 + ck) * 256 + c] = cg; }
    } else {
#pragma unroll
      for (int q = 0; q < 4; ++q) {
        float hh = myc[q];
#pragma unroll
        for (int e = 0; e < 4; ++e) {
          const int i = 4 * q + e;
          hh = av[i] * hh + bv[i];
          const size_t tok = (size_t)b * SEQ + ct * 64 + 32 * mi + crow(i, h);
          const float y = bf2f(P[tok * PSTR + C_LRU_Y + c]);
          O[tok * DM + c] = f2bf(hh * gelu_rcp(y));
        }
      }
    }
  }
}

#define XB_TMO      128
#define XB_XCNT(j)  (256  + 64 * (j))
#define XB_XSUB(j)  (1280 + 64 * (j))
#define XB_XGEN(j)  (2304 + 64 * (j))
#define XB_TOP      3328
#define XB_TOPGEN   3392
#define XCD_BAR_WORDS 3456
#define XB_SPIN_CAP (1u << 18)
#define XLAS __attribute__((address_space(3)))
DI unsigned xb_ld(unsigned* p)              { return __hip_atomic_load(p, __ATOMIC_RELAXED, __HIP_MEMORY_SCOPE_AGENT); }
DI unsigned xb_add(unsigned* p, unsigned v) { return __hip_atomic_fetch_add(p, v, __ATOMIC_RELAXED, __HIP_MEMORY_SCOPE_AGENT); }
DI unsigned xb_xcc_id() { return (unsigned)__builtin_amdgcn_s_getreg((3 << 11) | 20) & 0xFu; }
#define XB_SPIN(cond, bar) do { unsigned _sp = 0; while (cond) { __builtin_amdgcn_s_sleep(1); \
    if ((++_sp & 255u) == 0u) { if (xb_ld(&(bar)[XB_TMO])) break; if (_sp > XB_SPIN_CAP) { atomicAdd(&(bar)[XB_TMO], 1u); break; } } } } while (0)
struct XcdBarrier { unsigned* bar; unsigned x; volatile XLAS unsigned* st; };
DI XcdBarrier xcd_barrier_post(unsigned* bar, volatile XLAS unsigned* st) {
  XcdBarrier b; b.bar = bar; b.x = xb_xcc_id(); b.st = st;
  if (threadIdx.x == 0) (void)xb_add(&bar[XB_XCNT(b.x)], 1u);
  return b;
}
DI void xcd_barrier_complete(unsigned* bar, unsigned x, unsigned& nloc, unsigned& nx) {
  const unsigned G = gridDim.x * gridDim.y * gridDim.z;
  unsigned sum, cnt, mine, sp = 0u;
  for (;;) {
    sum = 0u; cnt = 0u; mine = 0u;
#pragma unroll
    for (unsigned j = 0; j < 16; ++j) { const unsigned c = xb_ld(&bar[XB_XCNT(j)]); sum += c; cnt += (c > 0u) ? 1u : 0u; mine = (j == x) ? c : mine; }
    if (sum == G) break;
    __builtin_amdgcn_s_sleep(1);
    if ((++sp & 255u) == 0u) { if (xb_ld(&bar[XB_TMO])) break; if (sp > XB_SPIN_CAP) { atomicAdd(&bar[XB_TMO], 1u); break; } }
  }
  nloc = mine > 0u ? mine : 1u; nx = cnt > 0u ? cnt : 1u;
}
DI void xcd_barrier(const XcdBarrier& b) {
  asm volatile("s_waitcnt vmcnt(0)" ::: "memory");
  __syncthreads();
  if (threadIdx.x == 0) {
    unsigned* bar = b.bar;
    __builtin_amdgcn_s_waitcnt(0);
    unsigned nloc = b.st[0], nx = b.st[1];
    if (nloc == 0u) { xcd_barrier_complete(bar, b.x, nloc, nx); b.st[0] = nloc; b.st[1] = nx; }
    const unsigned old = xb_add(&bar[XB_XSUB(b.x)], 1u);
    const unsigned gen = old / nloc;
    if (old + 1u == (gen + 1u) * nloc) {
      __builtin_amdgcn_fence(__ATOMIC_RELEASE, "agent");
      asm volatile("s_waitcnt vmcnt(0)" ::: "memory");
      const unsigned og = xb_add(&bar[XB_TOP], 1u);
      const unsigned tg = og / nx;
      if (og + 1u == (tg + 1u) * nx) xb_add(&bar[XB_TOPGEN], 1u);
      else XB_SPIN(xb_ld(&bar[XB_TOPGEN]) == tg, bar);
      __builtin_amdgcn_fence(__ATOMIC_ACQUIRE, "agent");
      xb_add(&bar[XB_XGEN(b.x)], 1u);
      asm volatile("s_waitcnt vmcnt(0)" ::: "memory");
    } else {
      XB_SPIN(xb_ld(&bar[XB_XGEN(b.x)]) == gen, bar);
      __builtin_amdgcn_fence(__ATOMIC_ACQUIRE, "agent");
      asm volatile("s_waitcnt vmcnt(0)" ::: "memory");
    }
  }
  __syncthreads();
}

__global__ void __launch_bounds__(NTHR) mega(Params p) {
  extern __shared__ __attribute__((aligned(16))) char smem[];
  cg::grid_group grid = cg::this_grid();
  const int tid = threadIdx.x;
  bf16_t* H = (bf16_t*)(p.ws + OFF_H);
  bf16_t* PB = (bf16_t*)(p.ws + OFF_P);
  PG_LAS unsigned char* lds = (PG_LAS unsigned char*)smem;
  volatile XLAS unsigned* xst = (volatile XLAS unsigned*)(smem + 131072);
  if (tid < 2) xst[tid] = 0u;
  __syncthreads();
  const XcdBarrier xb = xcd_barrier_post((unsigned*)(p.ws + OFF_BAR), xst);

  for (int rep = 0; rep < REP_MISC; ++rep) {
  if (MASK & 1) phase_mod(p, smem);
  grid.sync();
  }
  for (int l = 0; l < 4; ++l) {
    const float* xcur = (l == 0) ? p.in[I_X] : p.out;
    for (int rep = 0; rep < REP_MISC; ++rep) {
    if (MASK & 2) phase_convert(p, l, smem);
    if (MASK & 4) phase_norm(p, xcur, p.in[I_N1G] + l * 1024, l, 1024, 0, H, nullptr);
    xcd_barrier(xb);
    }
    for (int rep = 0; rep < REP_G; ++rep) {
    if (MASK & 8) { pg::Order<1> S; S.init(NTOK, PSTR, gridDim.x, blockIdx.x); pg::EpiBf16<0> E{PB, PSTR, nullptr};
      pg::gemm_phase(lds, H, DM, (const bf16_t*)(p.ws + OFF_WIN), 1024, S, E); }
    xcd_barrier(xb);
    }
    for (int rep = 0; rep < REP_M1; ++rep) {
    for (int it = blockIdx.x; it < 5120; it += gridDim.x) {
      if (it < 2048) { if (MASK & 32) gdn_intra_item(p, l, it, smem); }
      else if (it < 3072) { }
      else if (it < 4096) { if (MASK & 128) lru_item(p, l, it - 3072, smem, 0); }
      else { if (MASK & 16) rw_prep_item(p, l, it - 4096, smem); }
      __syncthreads();
    }
    xcd_barrier(xb);
    }
    for (int rep = 0; rep < REP_M2; ++rep) {
    if (blockIdx.x < 128) {
      if (MASK & 16) rwkv_scan_item(p, l, blockIdx.x >> 3, (blockIdx.x >> 1) & 3, blockIdx.x & 1, smem);
    } else {
      if (blockIdx.x < 192) { if (MASK & 256) gdn_rec_item(p, l, (blockIdx.x - 128) >> 2, (blockIdx.x - 128) & 3, smem); }
      unsigned* ctr = (unsigned*)(p.ws + OFF_CTR) + l * 4 + rep;
      volatile int* slot = (volatile int*)(smem + 110016);
      for (;;) {
        __syncthreads();
        if (tid == 0) *slot = (int)atomicAdd(ctr, 1u);
        __syncthreads();
        const int it = *slot;
        if (it >= 2048) break;
        if (it < 1024) { if (MASK & 64) sb_item(p, it, smem); }
        else { if (MASK & 512) lru_item(p, l, it - 1024, smem, 1); }
      }
    }
    xcd_barrier(xb);
    }
    for (int rep = 0; rep < REP_G; ++rep) {
    for (int half = 0; half < 4; ++half) {
      bf16_t* BH = (bf16_t*)(p.ws + OFF_P + 134217728);
      if (half == 0 && rep == 0) { if (MASK & 16) rwkv_post(p, l); xcd_barrier(xb); }
      if (MASK & 1024) { pg::Order<1> S; S.init(NTOK / 4, 4096, gridDim.x, blockIdx.x, 0, 0, 2, 512); pg::EpiBf16<0> E{BH, 4096, nullptr};
        pg::gemm_phase(lds, (const bf16_t*)(p.ws + OFF_O) + (size_t)half * 16384 * DM, DM, (const bf16_t*)(p.ws + OFF_WBR), 256, S, E); }
      xcd_barrier(xb);
      if (MASK & 1024) { pg::Order<4> S; S.init(NTOK / 4, 1024, gridDim.x, blockIdx.x, 0, 2097152); pg::EpiGateMix E{PB + (size_t)half * 16384 * DM, (float*)(p.ws + OFF_G), BH, p.in[I_BGATE] + (size_t)l * 4096};
        pg::gemm_phase(lds, H + (size_t)half * 16384 * DM, DM, (const bf16_t*)(p.ws + OFF_WG), 1024, S, E); }
      xcd_barrier(xb);
    }
    }
    if (MASK & 2048) { pg::Order<1> S; S.init(NTOK, 1024, gridDim.x, blockIdx.x); pg::EpiResid E{xcur, p.out, (const float*)(p.ws + OFF_MODP), p.in[I_BADA], l, 2048};
      pg::gemm_phase(lds, PB, DM, (const bf16_t*)(p.ws + OFF_WO), 1024, S, E); }
    xcd_barrier(xb);
    for (int rep = 0; rep < REP_MISC; ++rep) {
    if (MASK & 4096) phase_norm(p, p.out, p.in[I_N2G] + l * 1024, l, 4096, 3072, H, nullptr);
    xcd_barrier(xb);
    }
    for (int rep = 0; rep < REP_G; ++rep) {
    if (MASK & 8192) { pg::Order<1> S; S.init(NTOK, FFN, gridDim.x, blockIdx.x); pg::EpiBf16<0> E{PB, FFN, nullptr};
      pg::gemm_phase(lds, H, DM, (const bf16_t*)(p.ws + OFF_WF), 1024, S, E); }
    xcd_barrier(xb);
    if (MASK & 8192) { pg::Order<1> S; S.init(NTOK, FFN, gridDim.x, blockIdx.x); pg::EpiFfnAct E{PB + (size_t)NTOK * FFN, PB, p.in[I_FCW] + (size_t)l * 3 * FFN};
      pg::gemm_phase(lds, H, DM, (const bf16_t*)(p.ws + OFF_WF) + (size_t)FFN * 1024, 1024, S, E); }
    xcd_barrier(xb);
    }
    if (MASK & 32768) { pg::Order<1> S; S.init(NTOK, 1024, gridDim.x, blockIdx.x); pg::EpiResid E{p.out, p.out, (const float*)(p.ws + OFF_MODP), p.in[I_BADA], l, 5120};
      pg::gemm_phase(lds, PB + (size_t)NTOK * FFN, FFN, (const bf16_t*)(p.ws + OFF_WD), FFN, S, E); }
    xcd_barrier(xb);
  }
  if (MASK & 65536) phase_norm(p, p.out, p.in[I_FG], 0, 0, 0, nullptr, p.out);
}

extern "C" void kernel_launch(void* const* d_in, const int* in_sizes, int n_in,
                              void* d_out, int out_size, void* d_ws, size_t ws_size,
                              hipStream_t stream) {
  if (ws_size < WS_NEED || n_in < 38) { fprintf(stderr, "workspace too small: %zu < %zu\n", ws_size, (size_t)WS_NEED); return; }
  (void)hipFuncSetAttribute((const void*)mega, hipFuncAttributeMaxDynamicSharedMemorySize, SMEM_BYTES);
  int dev = 0, cus = 0, per_cu = 0;
  (void)hipGetDevice(&dev);
  (void)hipDeviceGetAttribute(&cus, hipDeviceAttributeMultiprocessorCount, dev);
  (void)hipOccupancyMaxActiveBlocksPerMultiprocessor(&per_cu, mega, NTHR, SMEM_BYTES);
  if (per_cu < 1 || cus < 1) { fprintf(stderr, "occupancy query failed (%d, %d)\n", per_cu, cus); return; }
  if (cus > 256) cus = 256;
  const int grid_blocks = cus;
  Params p{};
  for (int i = 0; i < 38; ++i) p.in[i] = (const float*)d_in[i];
  p.out = (float*)d_out; p.ws = (char*)d_ws;
  (void)hipMemsetAsync((char*)d_ws + OFF_BAR, 0, XCD_BAR_WORDS * 4, stream);
  void* args[] = {&p};
  hipError_t e = hipLaunchCooperativeKernel((void*)mega, dim3(grid_blocks), dim3(NTHR), args, SMEM_BYTES, stream);
  if (e != hipSuccess) fprintf(stderr, "cooperative launch failed: %s (grid %d)\n", hipGetErrorString(e), grid_blocks);
}
```

```cpp
#include <hip/hip_runtime.h>
#include <hip/hip_cooperative_groups.h>
#include <cstdio>
namespace cg = cooperative_groups;

typedef unsigned short bf16_t;
typedef short bf16x8 __attribute__((ext_vector_type(8)));
typedef short s16x4 __attribute__((ext_vector_type(4)));
typedef float f32x4 __attribute__((ext_vector_type(4)));
typedef float f32x16 __attribute__((ext_vector_type(16)));
typedef unsigned u32x4 __attribute__((ext_vector_type(4)));
#define DI __device__ __forceinline__

constexpr int NTOK = 65536, DM = 1024, SEQ = 4096, PSTR = 3328, FFN = 2816, AUS = 5632;
constexpr int C_LRU_X = 0, C_LRU_Y = 256, C_SB_Q = 512, C_SB_K = 768, C_SB_V = 1024;
constexpr int C_GDN_Q = 1280, C_GDN_Z = 2048, C_GDN_A = 2304, C_GDN_B = 2308, C_RW = 2312;
constexpr float EPSF = 1e-6f;
#ifndef MASK
#define MASK 0x1ffff
#endif
#ifndef REP_M1
#define REP_M1 1
#endif
#ifndef REP_M2
#define REP_M2 1
#endif
#ifndef REP_G
#define REP_G 1
#endif
#ifndef REP_MISC
#define REP_MISC 1
#endif
constexpr int NTHR = 512;
constexpr int SMEM_BYTES = 131072 + 64;

constexpr size_t OFF_MODP = 0;
constexpr size_t OFF_WIN = 6291456;
constexpr size_t OFF_WG = OFF_WIN + 6815744;
constexpr size_t OFF_WBR = OFF_WG + 8388608;
constexpr size_t OFF_WO = OFF_WBR + 2097152;
constexpr size_t OFF_WF = OFF_WO + 2097152;
constexpr size_t OFF_WD = OFF_WF + 11534336;
constexpr size_t OFF_H = OFF_WD + 5767168;
constexpr size_t OFF_P = OFF_H + 134217728;
constexpr size_t OFF_O = OFF_P + 436207616;
constexpr size_t OFF_G = OFF_O + 134217728;
constexpr size_t GSZ = 33554432;
constexpr size_t OFF_GCD = OFF_G + 5 * GSZ;
constexpr size_t OFF_L = OFF_GCD + 16384;
constexpr size_t LSZ = 67108864;
constexpr size_t OFF_LCA = OFF_L + 2 * LSZ;
constexpr size_t OFF_LCH = OFF_LCA + 2097152;
constexpr size_t OFF_BON = OFF_LCH + 2097152;
constexpr size_t OFF_CTR = OFF_BON + 1048576;
constexpr size_t OFF_BAR = OFF_CTR + 256;
constexpr size_t WS_NEED = OFF_BAR + 16384;

struct Params { const float* in[38]; float* out; char* ws; };
enum { I_X = 0, I_C, I_N1G, I_N2G, I_FG, I_WADA, I_BADA, I_WIN, I_LCW, I_LCB, I_LWR, I_LBR, I_LWI, I_LBI, I_LLAM,
       I_GCW, I_GAL, I_GDT, I_GNG, I_RMU, I_RW0, I_RWUP, I_RA0, I_RAUP, I_RGUP, I_RKK, I_RKA, I_RRK, I_RLG, I_RLB,
       I_WBR, I_WGATE, I_BGATE, I_WOUT, I_FWG, I_FWU, I_FCW, I_FWD };

DI float bf2f(bf16_t v) { return __uint_as_float(((unsigned)v) << 16); }
typedef __bf16 bf16n2 __attribute__((ext_vector_type(2)));
typedef float f32x2_ __attribute__((ext_vector_type(2)));
DI unsigned pack2(float lo, float hi) { f32x2_ v = {lo, hi}; bf16n2 b = __builtin_convertvector(v, bf16n2); return __builtin_bit_cast(unsigned, b); }
DI bf16_t f2bf(float x) { return (bf16_t)(pack2(x, x) & 0xffffu); }
DI float sigmoidf_(float x) { return __builtin_amdgcn_rcpf(1.f + __expf(-x)); }
DI float sigmoid_rcp(float x) { return __builtin_amdgcn_rcpf(1.f + __expf(-x)); }
DI float gelu_rcp(float x) { float u = 0.7978845608f * (x + 0.044715f * x * x * x); return x * __builtin_amdgcn_rcpf(1.f + __expf(-2.f * u)); }
DI float softplusf_(float x) { return fmaxf(x, 0.f) + __logf(1.f + __expf(-fabsf(x))); }
DI float siluf_(float x) { return x * __builtin_amdgcn_rcpf(1.f + __expf(-x)); }
DI float geluf_(float x) { float u = 0.7978845608f * (x + 0.044715f * x * x * x); return x * __builtin_amdgcn_rcpf(1.f + __expf(-2.f * u)); }
DI float tanhf_(float x) { return 1.f - 2.f * __builtin_amdgcn_rcpf(1.f + __expf(2.f * x)); }
DI float wave_sum(float x) {
#pragma unroll
  for (int o = 32; o >= 1; o >>= 1) x += __shfl_xor(x, o);
  return x;
}
template <int CTRL> DI float dppf(float x) { return __int_as_float(__builtin_amdgcn_update_dpp(0, __float_as_int(x), CTRL, 0xf, 0xf, true)); }
DI float reduce8(float x) { x += dppf<0xB1>(x); x += dppf<0x4E>(x); x += dppf<0x141>(x); return x; }
DI f32x16 mfma32(bf16x8 a, bf16x8 b, f32x16 c) { return __builtin_amdgcn_mfma_f32_32x32x16_bf16(a, b, c, 0, 0, 0); }
DI f32x4 mfma16(bf16x8 a, bf16x8 b, f32x4 c) { return __builtin_amdgcn_mfma_f32_16x16x32_bf16(a, b, c, 0, 0, 0); }
DI int crow(int i, int h) { return (i & 3) + 8 * (i >> 2) + 4 * h; }

DI float modv(const float* modp, const float* bada, int l, int b, int idx) {
  const float* q = modp + ((size_t)(l * 16 + b)) * 6144 + idx;
  const size_t ks = (size_t)4 * 16 * 6144;
  return bada[l * 6144 + idx] + q[0] + q[ks] + q[2 * ks] + q[3 * ks];
}

DI int otid() { int t = threadIdx.x; asm volatile("" : "+v"(t)); return t; }
DI int obid() { int b = blockIdx.x; asm volatile("" : "+s"(b)); return b; }
DI void phase_mod(const Params& p, char* smem) {
  float* sm = (float*)smem;
  float* modp = (float*)(p.ws + OFF_MODP);
  const int tid = otid();
  if (obid() == 0 && tid < 64) ((unsigned*)(p.ws + OFF_CTR))[tid] = 0u;
  for (int item = obid(); item < 192; item += gridDim.x) {
    const int l = item / 48, rem = item % 48, jb = rem >> 2, kq = rem & 3;
    for (int i = 0; i < 8; ++i) {
      int e = tid + 512 * i; int b = e >> 8, k = e & 255;
      float cv = p.in[I_C][b * 1024 + kq * 256 + k];
      sm[e] = siluf_(cv);
    }
    __syncthreads();
    float acc[16];
#pragma unroll
    for (int b = 0; b < 16; ++b) acc[b] = 0.f;
    const float* wp = p.in[I_WADA] + ((size_t)l * 1024 + kq * 256) * 6144 + jb * 512 + tid;
    for (int k = 0; k < 256; k += 4) {
      float w0 = wp[(size_t)k * 6144], w1 = wp[(size_t)(k + 1) * 6144], w2 = wp[(size_t)(k + 2) * 6144], w3 = wp[(size_t)(k + 3) * 6144];
#pragma unroll
      for (int b = 0; b < 16; ++b) {
        f32x4 cv = *(const f32x4*)(sm + b * 256 + k);
        acc[b] += cv[0] * w0 + cv[1] * w1 + cv[2] * w2 + cv[3] * w3;
      }
    }
#pragma unroll
    for (int b = 0; b < 16; ++b) modp[((size_t)((kq * 4 + l) * 16 + b)) * 6144 + jb * 512 + tid] = acc[b];
    __syncthreads();
  }
}

DI void conv_tile(const float* src, bf16_t* dst, int K, int N, int k0, int n0, char* smem) {
  float* tile = (float*)smem;
  const int tid = otid();
#pragma unroll
  for (int it = 0; it < 2; ++it) {
    int kr = (tid >> 4) + 32 * it, nc = (tid & 15) * 4;
    f32x4 v = {0.f, 0.f, 0.f, 0.f};
    if (n0 + nc < N) v = *(const f32x4*)(src + (size_t)(k0 + kr) * N + n0 + nc);
    tile[kr * 65 + nc] = v[0]; tile[kr * 65 + nc + 1] = v[1]; tile[kr * 65 + nc + 2] = v[2]; tile[kr * 65 + nc + 3] = v[3];
  }
  __syncthreads();
  {
    int n = tid >> 3, kc = (tid & 7) * 8;
    unsigned o[4];
#pragma unroll
    for (int e = 0; e < 4; ++e) o[e] = pack2(tile[(kc + 2 * e) * 65 + n], tile[(kc + 2 * e + 1) * 65 + n]);
    uint4 ov = {o[0], o[1], o[2], o[3]};
    *(uint4*)(dst + (size_t)(n0 + n) * K + k0 + kc) = ov;
  }
  __syncthreads();
}

DI void phase_convert(const Params& p, int l, char* smem) {
  for (int t = obid(); t < 4480; t += gridDim.x) {
    const float* src; bf16_t* dst; int K, N, Npad, tt = t;
    if (tt < 832) { src = p.in[I_WIN] + (size_t)l * 1024 * 3208; dst = (bf16_t*)(p.ws + OFF_WIN); K = 1024; N = 3208; Npad = 3328; }
    else if ((tt -= 832) < 1024) { int br = tt >> 8; tt &= 255; src = p.in[I_WGATE] + ((size_t)l * 4 + br) * 1048576; dst = (bf16_t*)(p.ws + OFF_WG) + (size_t)br * 1048576; K = 1024; N = 1024; Npad = 1024; }
    else if ((tt -= 1024) < 256) { int br = tt >> 6; tt &= 63; src = p.in[I_WBR] + ((size_t)l * 4 + br) * 262144; dst = (bf16_t*)(p.ws + OFF_WBR) + (size_t)br * 262144; K = 256; N = 1024; Npad = 1024; }
    else if ((tt -= 256) < 256) { src = p.in[I_WOUT] + (size_t)l * 1048576; dst = (bf16_t*)(p.ws + OFF_WO); K = 1024; N = 1024; Npad = 1024; }
    else if ((tt -= 256) < 704) { src = p.in[I_FWG] + (size_t)l * 1024 * 2816; dst = (bf16_t*)(p.ws + OFF_WF); K = 1024; N = 2816; Npad = 2816; }
    else if ((tt -= 704) < 704) { src = p.in[I_FWU] + (size_t)l * 1024 * 2816; dst = (bf16_t*)(p.ws + OFF_WF) + (size_t)2816 * 1024; K = 1024; N = 2816; Npad = 2816; }
    else { tt -= 704; src = p.in[I_FWD] + (size_t)l * 2816 * 1024; dst = (bf16_t*)(p.ws + OFF_WD); K = 2816; N = 1024; Npad = 1024; }
    const int nNt = Npad >> 6;
    const int kt = tt / nNt, nt = tt % nNt;
    conv_tile(src, dst, K, N, kt * 64, nt * 64, smem);
  }
}

DI void phase_norm(const Params& p, const float* xin, const float* g, int l, int scale_idx, int shift_idx, bf16_t* hout, float* fout) {
  const float* modp = (const float*)(p.ws + OFF_MODP);
  const int lane = otid() & 63, wv = otid() >> 6;
  const int nw = gridDim.x * 8;
  const int rows_per = 32;
  for (int chunk = obid() * 8 + wv; chunk < NTOK / 32; chunk += nw) {
  const int row0 = chunk * rows_per;
  const int b = row0 / SEQ;
  f32x4 gv[4], sc[4], sh[4];
#pragma unroll
  for (int j = 0; j < 4; ++j) {
    int c = lane * 4 + 256 * j;
    gv[j] = *(const f32x4*)(g + c);
    if (hout) {
#pragma unroll
      for (int e = 0; e < 4; ++e) {
        sc[j][e] = 1.f + modv(modp, p.in[I_BADA], l, b, scale_idx + c + e);
        sh[j][e] = modv(modp, p.in[I_BADA], l, b, shift_idx + c + e);
      }
    }
  }
  for (int rr = 0; rr < rows_per; ++rr) {
    const size_t row = (size_t)row0 + rr;
    f32x4 xv[4]; float ss = 0.f;
#pragma unroll
    for (int j = 0; j < 4; ++j) {
      xv[j] = *(const f32x4*)(xin + row * DM + lane * 4 + 256 * j);
      ss += xv[j][0] * xv[j][0] + xv[j][1] * xv[j][1] + xv[j][2] * xv[j][2] + xv[j][3] * xv[j][3];
    }
    ss = wave_sum(ss);
    const float rs = rsqrtf(ss * (1.f / 1024.f) + EPSF);
#pragma unroll
    for (int j = 0; j < 4; ++j) {
      f32x4 y = xv[j] * rs * gv[j];
      if (hout) {
        y = y * sc[j] + sh[j];
        uint2 o = {pack2(y[0], y[1]), pack2(y[2], y[3])};
        *(uint2*)(hout + row * DM + lane * 4 + 256 * j) = o;
      } else {
        *(f32x4*)(fout + row * DM + lane * 4 + 256 * j) = y;
      }
    }
  }
  }
}

#define PG_LAS __attribute__((address_space(3)))
namespace pg {
constexpr int BM = 256, BK = 64, HALF = 128, HTB = HALF * BK * 2, NXCD = 8, WGM = 8;
DI int lds_byte(int r, int c) { const int st = (r >> 4) * 2 + (c >> 5), rr = r & 15, cc = c & 31, ob = rr * 64 + cc * 2; return st * 1024 + (ob ^ (((ob >> 9) & 1) << 5)); }
DI void stage_rc(int b, int& R, int& C) { const int st = b / 1024, sb = b % 1024, swz = sb ^ (((sb >> 9) & 1) << 5); R = (st >> 1) * 16 + swz / 64; C = (st & 1) * 32 + (swz % 64) / 2; }
DI int perm32(int rho) { const int n = rho >> 4, i = rho & 15; return 8 * (i >> 2) + 4 * n + (i & 3); }
struct Unit { int pm, pn; int aux; long ao, bo; };
template <int REP> struct Order {
  int nM, nN, nwg, G, c, ashift; long astep, bstep, apnstep;
  DI void init(int M, int N, int G_, int c_, long astep_ = 0, long bstep_ = 0, int ashift_ = 0, long apnstep_ = 0) {
    nM = M / BM; nN = N / BM; nwg = nM * nN; G = G_; c = c_; astep = astep_; bstep = bstep_; ashift = ashift_; apnstep = apnstep_; }
  DI bool next(int i, Unit& u) const {
    const int ti = i / REP, aux = i % REP;
    const long L = (long)ti * G + c; if (L >= nwg) return false;
    int wgid = (int)L; { const int q = nwg / NXCD, r = nwg % NXCD, xcd = wgid % NXCD, off = wgid / NXCD; wgid = (xcd < r ? xcd * (q + 1) : r * (q + 1) + (xcd - r) * q) + off; }
    const int nig = WGM * nN, gid = wgid / nig, fm = gid * WGM, gsz = (nM - fm) < WGM ? (nM - fm) : WGM;
    u.pm = fm + ((wgid % nig) % gsz); u.pn = (wgid % nig) / gsz; u.aux = aux; u.ao = aux * astep + (long)(u.pn >> ashift) * apnstep; u.bo = aux * bstep; return true;
  }
};
DI unsigned cvt_pk_bf16(float lo, float hi) { return pack2(lo, hi); }

template <class Epi, class Sched>
DI void gemm_phase(PG_LAS unsigned char* lds, const bf16_t* Ag, int lda, const bf16_t* Bg, int K, const Sched& S, const Epi& E) {
  const int tid = otid(), wid = __builtin_amdgcn_readfirstlane(tid >> 6), lane = tid & 63, wr = wid >> 2, wc = wid & 3, fr = lane & 15, fq = lane >> 4;
  const int nt = K / BK;
  unsigned voffA[2], voffB[2];
#pragma unroll
  for (int i = 0; i < 2; ++i) { int R, C; stage_rc(tid * 16 + i * 8192, R, C); const int Rb = Epi::PERM ? ((R & ~31) + perm32(R & 31)) : R;
    voffA[i] = (unsigned)(R * lda + C) * 2u; voffB[i] = (unsigned)(Rb * K + C) * 2u; }
  const size_t kstep = (size_t)(BK * 2);
  const size_t hstepA = (size_t)HALF * lda * 2, hstepB = (size_t)HALF * K * 2;
  const size_t tstepA = 2 * hstepA, tstepB = 2 * hstepB;
  const unsigned ldsw = (unsigned)wid * 1024u;
  const int aoff = lds_byte(wr * 64 + fr, fq * 8), boff = lds_byte(wc * 32 + fr, fq * 8);
#define PG_SA(b, h) (((b) * 2 + (h)) * HTB)
#define PG_SB(b, h) ((4 + (b) * 2 + (h)) * HTB)
#define PG_STAGE(bufoff, gbase, voff) do { _Pragma("unroll") for (int _i = 0; _i < 2; ++_i) \
    __builtin_amdgcn_global_load_lds((const unsigned*)((const char*)(gbase) + (voff)[_i]), (PG_LAS unsigned*)(lds + (bufoff) + ldsw + _i * 8192), 16, 0, 0); } while (0)
#define PG_LDA(dst, b, h) do { _Pragma("unroll") for (int m = 0; m < 4; ++m) _Pragma("unroll") for (int k = 0; k < 2; ++k) dst[m][k] = *(const PG_LAS bf16x8*)(lds + PG_SA(b, h) + aoff + m * 2048 + k * 1024); } while (0)
#define PG_LDB(dst, b, h) do { _Pragma("unroll") for (int n = 0; n < 2; ++n) _Pragma("unroll") for (int k = 0; k < 2; ++k) dst[n][k] = *(const PG_LAS bf16x8*)(lds + PG_SB(b, h) + boff + n * 2048 + k * 1024); } while (0)
#define PG_MMA(ai, bj, At, Bt) do { __builtin_amdgcn_s_setprio(1); _Pragma("unroll") for (int m = 0; m < 4; ++m) _Pragma("unroll") for (int n = 0; n < 2; ++n) _Pragma("unroll") for (int k = 0; k < 2; ++k) \
    acc[ai][bj][m][n] = __builtin_amdgcn_mfma_f32_16x16x32_bf16(Bt[n][k], At[m][k], acc[ai][bj][m][n], 0, 0, 0); __builtin_amdgcn_s_setprio(0); } while (0)
#define PG_WAIT_V(n) asm volatile("s_waitcnt vmcnt(" #n ")" ::: "memory")
#define PG_WAIT_L(n) asm volatile("s_waitcnt lgkmcnt(" #n ")" ::: "memory")
#define PG_BAR __builtin_amdgcn_s_barrier()
#define PG_SCHED __builtin_amdgcn_sched_barrier(0)
  Unit cur, nxt; int ui = 0;
  if (!S.next(0, cur)) return;
  f32x4 acc[2][2][4][2];
#pragma unroll
  for (int a = 0; a < 2; ++a)
#pragma unroll
    for (int b = 0; b < 2; ++b)
#pragma unroll
      for (int m = 0; m < 4; ++m)
#pragma unroll
        for (int n = 0; n < 2; ++n) acc[a][b][m][n] = (f32x4){0.f, 0.f, 0.f, 0.f};
  bf16x8 At[4][2], B0[2][2], B1[2][2];
  const char* cA = (const char*)Ag + (size_t)cur.pm * tstepA + cur.ao; const char* cB = (const char*)Bg + (size_t)cur.pn * tstepB + cur.bo;
  PG_STAGE(PG_SB(0, 0), cB, voffB); PG_STAGE(PG_SA(0, 0), cA, voffA); PG_STAGE(PG_SB(0, 1), cB + hstepB, voffB); PG_STAGE(PG_SA(0, 1), cA + hstepA, voffA);
  if (wr == 1) PG_BAR;
  PG_WAIT_V(4); PG_BAR;
  PG_STAGE(PG_SB(1, 0), cB + kstep, voffB); PG_STAGE(PG_SA(1, 0), cA + kstep, voffA); PG_STAGE(PG_SB(1, 1), cB + hstepB + kstep, voffB);
  PG_WAIT_V(6); PG_BAR;
  for (;;) {
    const bool has_next = S.next(ui + 1, nxt);
    const char* nA = has_next ? (const char*)Ag + (size_t)nxt.pm * tstepA + nxt.ao : cA; const char* nB = has_next ? (const char*)Bg + (size_t)nxt.pn * tstepB + nxt.bo : cB;
#pragma unroll 1
    for (int t = 0; t < nt; t += 2) {
      const bool last = (t == nt - 2);
      const char* a1 = cA + (size_t)(t + 1) * kstep;
      const char* a2 = last ? nA : cA + (size_t)(t + 2) * kstep; const char* b2 = last ? nB : cB + (size_t)(t + 2) * kstep;
      const char* a3 = a2 + kstep; const char* b3 = b2 + kstep;
      PG_LDB(B0, 0, 0); PG_SCHED; PG_LDA(At, 0, 0); PG_STAGE(PG_SA(1, 1), a1 + hstepA, voffA);
      PG_WAIT_L(8); PG_BAR; PG_WAIT_L(0); PG_MMA(0, 0, At, B0); PG_BAR; PG_SCHED;
      PG_LDB(B1, 0, 1); PG_STAGE(PG_SB(0, 0), b2, voffB);
      PG_BAR; PG_WAIT_L(0); PG_MMA(0, 1, At, B1); PG_BAR;
      PG_LDA(At, 0, 1); PG_STAGE(PG_SA(0, 0), a2, voffA);
      PG_BAR; PG_WAIT_L(0); PG_MMA(1, 0, At, B0); PG_BAR; PG_SCHED;
      PG_STAGE(PG_SB(0, 1), b2 + hstepB, voffB);
      PG_WAIT_V(6); PG_BAR; PG_MMA(1, 1, At, B1); PG_BAR;
      PG_LDB(B0, 1, 0); PG_SCHED; PG_LDA(At, 1, 0); PG_STAGE(PG_SA(0, 1), a2 + hstepA, voffA);
      PG_WAIT_L(8); PG_BAR; PG_WAIT_L(0); PG_MMA(0, 0, At, B0); PG_BAR; PG_SCHED;
      PG_LDB(B1, 1, 1); PG_STAGE(PG_SB(1, 0), b3, voffB);
      PG_BAR; PG_WAIT_L(0); PG_MMA(0, 1, At, B1); PG_BAR;
      PG_LDA(At, 1, 1); PG_STAGE(PG_SA(1, 0), a3, voffA);
      PG_BAR; PG_WAIT_L(0); PG_MMA(1, 0, At, B0); PG_BAR; PG_SCHED;
      PG_STAGE(PG_SB(1, 1), b3 + hstepB, voffB);
      PG_WAIT_V(6); PG_BAR; PG_MMA(1, 1, At, B1); PG_BAR;
    }
    E(acc, cur, wr, wc, fr, fq);
    if (!has_next) break;
#pragma unroll
    for (int a = 0; a < 2; ++a)
#pragma unroll
      for (int b = 0; b < 2; ++b)
#pragma unroll
        for (int m = 0; m < 4; ++m)
#pragma unroll
          for (int n = 0; n < 2; ++n) acc[a][b][m][n] = (f32x4){0.f, 0.f, 0.f, 0.f};
    cur = nxt; cA = nA; cB = nB; ++ui;
  }
  PG_WAIT_V(0);
  if (wr == 0) PG_BAR;
  PG_BAR;
#undef PG_SA
#undef PG_SB
#undef PG_STAGE
#undef PG_LDA
#undef PG_LDB
#undef PG_MMA
#undef PG_WAIT_V
#undef PG_WAIT_L
#undef PG_BAR
#undef PG_SCHED
}

template <int ACT> struct EpiBf16 {
  static constexpr bool PERM = true;
  bf16_t* O; int ldc; const float* bias;
  DI void operator()(const f32x4 (&acc)[2][2][4][2], const Unit& u, int wr, int wc, int fr, int fq) const {
    const int row0 = u.pm * BM + wr * 64 + fr, col0 = u.pn * BM + wc * 32 + 8 * fq;
    f32x4 bv[2][2];
#pragma unroll
    for (int bj = 0; bj < 2; ++bj)
#pragma unroll
      for (int n = 0; n < 2; ++n) bv[bj][n] = ACT ? *(const f32x4*)(bias + col0 + bj * HALF + 4 * n) : (f32x4){0.f, 0.f, 0.f, 0.f};
#pragma unroll
    for (int ai = 0; ai < 2; ++ai)
#pragma unroll
      for (int m = 0; m < 4; ++m) { bf16_t* rowp = O + (size_t)(row0 + ai * HALF + m * 16) * ldc + col0;
#pragma unroll
        for (int bj = 0; bj < 2; ++bj) { f32x4 v0 = acc[ai][bj][m][0], v1 = acc[ai][bj][m][1];
          if (ACT) { v0 += bv[bj][0]; v1 += bv[bj][1];
#pragma unroll
            for (int j = 0; j < 4; ++j) { v0[j] = sigmoid_rcp(v0[j]); v1[j] = sigmoid_rcp(v1[j]); } }
          u32x4 w; w.x = cvt_pk_bf16(v0[0], v0[1]); w.y = cvt_pk_bf16(v0[2], v0[3]); w.z = cvt_pk_bf16(v1[0], v1[1]); w.w = cvt_pk_bf16(v1[2], v1[3]);
          *(u32x4*)(rowp + bj * HALF) = w; } }
  }
};
struct EpiBranch {
  static constexpr bool PERM = true;
  bf16_t* MIX; const bf16_t* G;
  DI void operator()(const f32x4 (&acc)[2][2][4][2], const Unit& u, int wr, int wc, int fr, int fq) const {
    const int row0 = u.pm * BM + wr * 64 + fr, col0 = u.pn * BM + wc * 32 + 8 * fq;
#pragma unroll
    for (int ai = 0; ai < 2; ++ai)
#pragma unroll
      for (int m = 0; m < 4; ++m) {
        asm volatile("" ::: "memory");
        const size_t row = (size_t)(row0 + ai * HALF + m * 16);
        bf16_t* mp = MIX + row * DM + col0; const bf16_t* gp = G + row * 4096 + u.aux * 1024 + col0;
#pragma unroll
        for (int bj = 0; bj < 2; ++bj) {
          const bf16x8 gv = *(const bf16x8*)(gp + bj * HALF);
          float o[8];
#pragma unroll
          for (int j = 0; j < 4; ++j) { o[j] = bf2f((bf16_t)gv[j]) * acc[ai][bj][m][0][j]; o[4 + j] = bf2f((bf16_t)gv[4 + j]) * acc[ai][bj][m][1][j]; }
          if (u.aux > 0) {
            const bf16x8 mv = *(const bf16x8*)(mp + bj * HALF);
#pragma unroll
            for (int j = 0; j < 8; ++j) o[j] += bf2f((bf16_t)mv[j]);
          }
          u32x4 w; w.x = cvt_pk_bf16(o[0], o[1]); w.y = cvt_pk_bf16(o[2], o[3]); w.z = cvt_pk_bf16(o[4], o[5]); w.w = cvt_pk_bf16(o[6], o[7]);
          *(u32x4*)(mp + bj * HALF) = w;
        }
      }
  }
};
struct EpiResid {
  static constexpr bool PERM = false;
  const float* xold; float* xnew; const float* modp; const float* bada; int l, gate_idx;
  DI void operator()(const f32x4 (&acc)[2][2][4][2], const Unit& u, int wr, int wc, int fr, int fq) const {
    const int row0 = u.pm * BM + wr * 64 + fr, col0 = u.pn * BM + wc * 32 + 4 * fq;
    const int b = (u.pm * BM) / SEQ;
    f32x4 gv[2][2];
#pragma unroll
    for (int bj = 0; bj < 2; ++bj)
#pragma unroll
      for (int n = 0; n < 2; ++n)
#pragma unroll
        for (int j = 0; j < 4; ++j) gv[bj][n][j] = modv(modp, bada, l, b, gate_idx + col0 + bj * HALF + n * 16 + j);
#pragma unroll
    for (int ai = 0; ai < 2; ++ai)
#pragma unroll
      for (int m = 0; m < 4; ++m) { const size_t ro = (size_t)(row0 + ai * HALF + m * 16) * DM + col0;
#pragma unroll
        for (int bj = 0; bj < 2; ++bj)
#pragma unroll
          for (int n = 0; n < 2; ++n) {
            const f32x4 xo = *(const f32x4*)(xold + ro + bj * HALF + n * 16);
            *(f32x4*)(xnew + ro + bj * HALF + n * 16) = xo + gv[bj][n] * acc[ai][bj][m][n];
          } }
  }
};
struct EpiFfnAct {
  static constexpr bool PERM = true;
  bf16_t* ACT; const bf16_t* APRE; const float* cw;
  DI void operator()(const f32x4 (&acc)[2][2][4][2], const Unit& u, int wr, int wc, int fr, int fq) const {
    const int row0 = u.pm * BM + wr * 64 + fr, col0 = u.pn * BM + wc * 32 + 8 * fq;
#pragma unroll
    for (int ai = 0; ai < 2; ++ai)
#pragma unroll
      for (int m = 0; m < 4; ++m) {
        asm volatile("" ::: "memory");
        const int row = row0 + ai * HALF + m * 16; const int sp = row & (SEQ - 1);
        const bf16_t* ap = APRE + (size_t)row * FFN + col0;
        bf16_t* op = ACT + (size_t)row * FFN + col0;
#pragma unroll
        for (int bj = 0; bj < 2; ++bj) {
          const int c = bj * HALF;
          const bf16x8 z8 = {0, 0, 0, 0, 0, 0, 0, 0};
          const bf16x8 a0 = *(const bf16x8*)(ap + c);
          const bf16x8 a1 = sp >= 1 ? *(const bf16x8*)(ap - FFN + c) : z8;
          const bf16x8 a2 = sp >= 2 ? *(const bf16x8*)(ap - 2 * FFN + c) : z8;
          float o[8];
#pragma unroll
          for (int hh = 0; hh < 2; ++hh) {
            const f32x4 w0 = *(const f32x4*)(cw + col0 + c + 4 * hh), w1 = *(const f32x4*)(cw + FFN + col0 + c + 4 * hh), w2 = *(const f32x4*)(cw + 2 * FFN + col0 + c + 4 * hh);
#pragma unroll
            for (int j = 0; j < 4; ++j) {
              const float cv = w0[j] * bf2f((bf16_t)a2[4 * hh + j]) + w1[j] * bf2f((bf16_t)a1[4 * hh + j]) + w2[j] * bf2f((bf16_t)a0[4 * hh + j]);
              o[4 * hh + j] = gelu_rcp(cv) * acc[ai][bj][m][hh][j];
            }
          }
          u32x4 w; w.x = cvt_pk_bf16(o[0], o[1]); w.y = cvt_pk_bf16(o[2], o[3]); w.z = cvt_pk_bf16(o[4], o[5]); w.w = cvt_pk_bf16(o[6], o[7]);
          *(u32x4*)(op + c) = w;
        }
      }
  }
};
struct EpiGateMix {
  static constexpr bool PERM = true;
  bf16_t* MIX; float* MIX32; const bf16_t* BH; const float* bias;
  DI void operator()(const f32x4 (&acc)[2][2][4][2], const Unit& u, int wr, int wc, int fr, int fq) const {
    const int row0 = u.pm * BM + wr * 64 + fr, col0 = u.pn * BM + wc * 32 + 8 * fq;
    const bool rmw = u.aux > 0, fin = u.aux == 3;
    f32x4 bv[2][2];
#pragma unroll
    for (int bj = 0; bj < 2; ++bj)
#pragma unroll
      for (int n = 0; n < 2; ++n) bv[bj][n] = *(const f32x4*)(bias + u.aux * 1024 + col0 + bj * HALF + 4 * n);
    const f32x4 z4 = {0.f, 0.f, 0.f, 0.f};
    bf16x8 nb[2]; f32x4 nm[2][2];
#define GM_LOAD(it_) { const size_t row_ = (size_t)(row0 + ((it_) >> 2) * HALF + ((it_) & 3) * 16); \
      _Pragma("unroll") for (int bj = 0; bj < 2; ++bj) { nb[bj] = *(const bf16x8*)(BH + row_ * 4096 + u.aux * 1024 + col0 + bj * HALF); \
        nm[bj][0] = rmw ? *(const f32x4*)(MIX32 + row_ * DM + col0 + bj * HALF) : z4; nm[bj][1] = rmw ? *(const f32x4*)(MIX32 + row_ * DM + col0 + bj * HALF + 4) : z4; } }
    GM_LOAD(0);
#pragma unroll
    for (int it = 0; it < 8; ++it) {
      const int ai = it >> 2, m = it & 3;
      bf16x8 cb[2]; f32x4 cm[2][2];
#pragma unroll
      for (int bj = 0; bj < 2; ++bj) { cb[bj] = nb[bj]; cm[bj][0] = nm[bj][0]; cm[bj][1] = nm[bj][1]; }
      if (it + 1 < 8) GM_LOAD(it + 1);
      const size_t ro = (size_t)(row0 + ai * HALF + m * 16) * DM + col0;
#pragma unroll
      for (int bj = 0; bj < 2; ++bj) {
        f32x4 o[2];
#pragma unroll
        for (int hh = 0; hh < 2; ++hh)
#pragma unroll
          for (int j = 0; j < 4; ++j)
            o[hh][j] = sigmoid_rcp(acc[ai][bj][m][hh][j] + bv[bj][hh][j]) * bf2f((bf16_t)cb[bj][4 * hh + j]) + cm[bj][hh][j];
        if (fin) {
          u32x4 w; w.x = cvt_pk_bf16(o[0][0], o[0][1]); w.y = cvt_pk_bf16(o[0][2], o[0][3]); w.z = cvt_pk_bf16(o[1][0], o[1][1]); w.w = cvt_pk_bf16(o[1][2], o[1][3]);
          *(u32x4*)(MIX + ro + bj * HALF) = w;
        } else {
          *(f32x4*)(MIX32 + ro + bj * HALF) = o[0]; *(f32x4*)(MIX32 + ro + bj * HALF + 4) = o[1];
        }
      }
    }
#undef GM_LOAD
  }
};
}

DI void phase_ffn_act(const Params& p, int l) {
  bf16_t* AU = (bf16_t*)(p.ws + OFF_P);
  const float* cw = p.in[I_FCW] + (size_t)l * 3 * FFN;
  const int nthr = gridDim.x * NTHR;
  for (int run = obid() * NTHR + otid(); run < 1024 * 352; run += nthr) {
    const int ch = run / 352, j8 = run % 352, j0 = j8 * 8;
    float w0[8], w1[8], w2[8];
#pragma unroll
    for (int e = 0; e < 8; ++e) { w0[e] = cw[j0 + e]; w1[e] = cw[FFN + j0 + e]; w2[e] = cw[2 * FFN + j0 + e]; }
    const int t0 = ch * 64, s0 = t0 % SEQ;
    float a1[8], a2[8];
#pragma unroll
    for (int e = 0; e < 8; ++e) { a1[e] = 0.f; a2[e] = 0.f; }
    if (s0 > 0) {
      bf16x8 v1 = *(const bf16x8*)(AU + (size_t)(t0 - 1) * AUS + j0);
      bf16x8 v2 = *(const bf16x8*)(AU + (size_t)(t0 - 2) * AUS + j0);
#pragma unroll
      for (int e = 0; e < 8; ++e) { a1[e] = bf2f((bf16_t)v1[e]); a2[e] = bf2f((bf16_t)v2[e]); }
    }
    for (int t = t0; t < t0 + 64; ++t) {
      bf16x8 va = *(const bf16x8*)(AU + (size_t)t * AUS + j0);
      bf16x8 vu = *(const bf16x8*)(AU + (size_t)t * AUS + FFN + j0);
      float o[8];
#pragma unroll
      for (int e = 0; e < 8; ++e) {
        float a0 = bf2f((bf16_t)va[e]);
        float cv = w0[e] * a2[e] + w1[e] * a1[e] + w2[e] * a0;
        o[e] = geluf_(cv) * bf2f((bf16_t)vu[e]);
        a2[e] = a1[e]; a1[e] = a0;
      }
      uint4 ov = {pack2(o[0], o[1]), pack2(o[2], o[3]), pack2(o[4], o[5]), pack2(o[6], o[7])};
      *(uint4*)(AU + (size_t)t * AUS + FFN + j0) = ov;
    }
  }
}

DI float mixf(bf16_t cur, bf16_t prev, float mu) { const float c = bf2f(cur); return c + (bf2f(prev) - c) * mu; }
DI void rw_prep_item(const Params& p, int l, int item, char* smem) {
  const bf16_t* P = (const bf16_t*)(p.ws + OFF_P);
  bf16_t* RD = (bf16_t*)(p.ws + OFF_L);
  bf16_t* RKK = (bf16_t*)(p.ws + OFF_L + GSZ);
  bf16_t* RA = (bf16_t*)(p.ws + OFF_L + 2 * GSZ);
  bf16_t* RG = (bf16_t*)(p.ws + OFF_L + 3 * GSZ);
  float* BON = (float*)(p.ws + OFF_BON);
  const int b = item >> 6, ct = item & 63;
  const int tid = otid(), lane = tid & 63, wv = tid >> 6, hd = wv & 3, mi = wv >> 2, r = lane & 31, h = lane >> 5;
  bf16_t* TX = (bf16_t*)smem;
  bf16_t* XA = TX + 64 * 40;
  bf16_t* SG = XA + 64 * 40;
  const float* mu = p.in[I_RMU] + (size_t)l * 896;
  const size_t tok0 = (size_t)b * SEQ + ct * 64;
  bf16x8 bw[2][2], ba[2][2], bg[2][4];
  {
    const float* wp = p.in[I_RWUP] + (size_t)l * 32 * 256 + hd * 64 + r;
    const float* ap = p.in[I_RAUP] + (size_t)l * 32 * 256 + hd * 64 + r;
    const float* gp = p.in[I_RGUP] + (size_t)l * 64 * 256 + hd * 64 + r;
    asm volatile("" : "+v"(wp), "+v"(ap), "+v"(gp));
#pragma unroll
    for (int ni = 0; ni < 2; ++ni) {
#pragma unroll
      for (int ks = 0; ks < 2; ++ks) {
        unsigned uw[4], ua[4];
#pragma unroll
        for (int j2 = 0; j2 < 4; ++j2) {
          const int k = 16 * ks + 8 * h + 2 * j2;
          uw[j2] = pack2(wp[k * 256 + 32 * ni], wp[(k + 1) * 256 + 32 * ni]);
          ua[j2] = pack2(ap[k * 256 + 32 * ni], ap[(k + 1) * 256 + 32 * ni]);
        }
        uint4 t1 = {uw[0], uw[1], uw[2], uw[3]}, t2 = {ua[0], ua[1], ua[2], ua[3]};
        bw[ni][ks] = __builtin_bit_cast(bf16x8, t1); ba[ni][ks] = __builtin_bit_cast(bf16x8, t2);
      }
#pragma unroll
      for (int ks = 0; ks < 4; ++ks) {
        unsigned ug[4];
#pragma unroll
        for (int j2 = 0; j2 < 4; ++j2) { const int k = 16 * ks + 8 * h + 2 * j2; ug[j2] = pack2(gp[k * 256 + 32 * ni], gp[(k + 1) * 256 + 32 * ni]); }
        uint4 t3 = {ug[0], ug[1], ug[2], ug[3]};
        bg[ni][ks] = __builtin_bit_cast(bf16x8, t3);
      }
    }
  }
#pragma unroll 4
  for (int i = 0; i < 16; ++i) {
    const int e = tid + NTHR * i; const int t = e >> 7, f = e & 127;
    const bf16_t* pr = P + (tok0 + t) * PSTR + C_RW + 768 + f;
    const bf16_t cur = pr[0];
    const bf16_t prev = (ct * 64 + t > 0) ? (pr - PSTR)[0] : (bf16_t)0;
    const float m = mixf(cur, prev, mu[768 + f]);
    if (f < 32) TX[t * 40 + f] = f2bf(tanhf_(m));
    else if (f < 64) XA[t * 40 + f - 32] = f2bf(m);
    else SG[t * 72 + f - 64] = f2bf(sigmoidf_(m));
  }
  __syncthreads();
  f32x16 cw[2], ca[2], cg[2];
#pragma unroll
  for (int ni = 0; ni < 2; ++ni)
#pragma unroll
    for (int i = 0; i < 16; ++i) { cw[ni][i] = 0.f; ca[ni][i] = 0.f; cg[ni][i] = 0.f; }
#pragma unroll
  for (int ks = 0; ks < 2; ++ks) {
    const bf16x8 atx = *(const bf16x8*)(TX + (32 * mi + r) * 40 + 16 * ks + 8 * h);
    const bf16x8 axa = *(const bf16x8*)(XA + (32 * mi + r) * 40 + 16 * ks + 8 * h);
#pragma unroll
    for (int ni = 0; ni < 2; ++ni) { cw[ni] = mfma32(atx, bw[ni][ks], cw[ni]); ca[ni] = mfma32(axa, ba[ni][ks], ca[ni]); }
  }
#pragma unroll
  for (int ks = 0; ks < 4; ++ks) {
    const bf16x8 asg = *(const bf16x8*)(SG + (32 * mi + r) * 72 + 16 * ks + 8 * h);
#pragma unroll
    for (int ni = 0; ni < 2; ++ni) cg[ni] = mfma32(asg, bg[ni][ks], cg[ni]);
  }
  float ss[16], bn[16];
#pragma unroll
  for (int i = 0; i < 16; ++i) { ss[i] = 0.f; bn[i] = 0.f; }
#pragma unroll
  for (int ni = 0; ni < 2; ++ni) {
    const int hc = hd * 64 + 32 * ni + r;
    const float w0c = p.in[I_RW0][l * 256 + hc], a0c = p.in[I_RA0][l * 256 + hc], kkc = p.in[I_RKK][l * 256 + hc],
                kac = p.in[I_RKA][l * 256 + hc], rkc = p.in[I_RRK][l * 256 + hc], mu_r = mu[hc], mu_k = mu[256 + hc];
#pragma unroll
    for (int i = 0; i < 16; ++i) {
      const int tl = 32 * mi + crow(i, h);
      const size_t tok = tok0 + tl;
      const bf16_t* pr = P + tok * PSTR + C_RW + hc;
      const bool hp = (ct * 64 + tl) > 0;
      const float rr = mixf(pr[0], hp ? (pr - PSTR)[0] : (bf16_t)0, mu_r);
      const float k = mixf(pr[256], hp ? (pr - PSTR)[256] : (bf16_t)0, mu_k);
      const float wl = w0c + cw[ni][i];
      const float wlog = -softplusf_(-wl) - 0.5f;
      const float dd = 1.f - __expf(-__expf(wlog));
      const float a = sigmoidf_(a0c + ca[ni][i]);
      const float kkr = k * kkc;
      const float kp = k * (1.f + (a - 1.f) * kac);
      ss[i] += kkr * kkr; bn[i] += rr * kp * rkc;
      cw[ni][i] = kkr;
      RD[tok * 256 + hc] = f2bf(dd); RA[tok * 256 + hc] = f2bf(a); RG[tok * 256 + hc] = f2bf(cg[ni][i]);
    }
  }
#pragma unroll
  for (int i = 0; i < 16; ++i) {
#pragma unroll
    for (int o = 1; o < 32; o <<= 1) { ss[i] += __shfl_xor(ss[i], o); bn[i] += __shfl_xor(bn[i], o); }
    ss[i] = rsqrtf(ss[i] + EPSF);
  }
#pragma unroll
  for (int ni = 0; ni < 2; ++ni) {
    const int hc = hd * 64 + 32 * ni + r;
#pragma unroll
    for (int i = 0; i < 16; ++i) {
      const size_t tok = tok0 + 32 * mi + crow(i, h);
      RKK[tok * 256 + hc] = f2bf(cw[ni][i] * ss[i]);
    }
  }
  if (r == 0) {
#pragma unroll
    for (int i = 0; i < 16; ++i) BON[(tok0 + 32 * mi + crow(i, h)) * 4 + hd] = bn[i];
  }
}

DI void rwkv_scan_item(const Params& p, int l, int b, int hd, int half, char* smem) {
  const bf16_t* P = (const bf16_t*)(p.ws + OFF_P);
  bf16_t* O = (bf16_t*)(p.ws + OFF_O);
  const bf16_t* RD = (const bf16_t*)(p.ws + OFF_L);
  const bf16_t* RKK = (const bf16_t*)(p.ws + OFF_L + GSZ);
  const bf16_t* RA = (const bf16_t*)(p.ws + OFF_L + 2 * GSZ);
  float* fb = (float*)smem;
  float* Yb = fb + 2 * 12352;
  const int tid = otid(), lane = tid & 63, wv = tid >> 6;
  const int hc = hd * 64 + lane;
  constexpr int NCH = SEQ / 32;
  float S[8];
#pragma unroll
  for (int j = 0; j < 8; ++j) S[j] = 0.f;
  const int rl = lane >> 3, kq = lane & 7, vloc = (wv & 3) * 8 + rl, vrow = half * 32 + vloc;
  const float* mu = p.in[I_RMU] + (size_t)l * 896;
  const float mu_r = mu[hc], mu_k = mu[256 + hc], mu_v = mu[512 + hc];
  const float kac = p.in[I_RKA][l * 256 + hc];
  const int pw = wv & 3;
  unsigned raw[8][9];
#pragma unroll
  for (int j = 0; j < 8; ++j)
#pragma unroll
    for (int e = 0; e < 9; ++e) raw[j][e] = 0u;
#define RAWLOAD(i_)                                                                                 \
  {                                                                                                 \
    _Pragma("unroll") for (int j = 0; j < 8; ++j) {                                                 \
      const int s_ = (i_) * 32 + pw * 8 + j;                                                        \
      const size_t tok_ = (size_t)b * SEQ + s_;                                                     \
      const bf16_t* pr_ = P + tok_ * PSTR + C_RW;                                                   \
      raw[j][0] = pr_[hc]; raw[j][1] = pr_[256 + hc]; raw[j][2] = pr_[512 + hc];                    \
      if (s_ > 0) { raw[j][3] = (pr_ - PSTR)[hc]; raw[j][4] = (pr_ - PSTR)[256 + hc]; raw[j][5] = (pr_ - PSTR)[512 + hc]; } \
      else { raw[j][3] = 0u; raw[j][4] = 0u; raw[j][5] = 0u; }                                      \
      raw[j][6] = RD[tok_ * 256 + hc]; raw[j][7] = RKK[tok_ * 256 + hc]; raw[j][8] = RA[tok_ * 256 + hc]; \
    }                                                                                               \
  }
#define RBAR() { asm volatile("s_waitcnt lgkmcnt(0)" ::: "memory"); __builtin_amdgcn_s_barrier(); asm volatile("" ::: "memory"); }
  if (wv >= 4) RAWLOAD(0);
#pragma unroll 1
  for (int i = 0; i < NCH + 2; ++i) {
    if (wv >= 4) {
      float* B = fb + (i & 1) * 12352;
      if (i >= 2) {
        const float* Yc = Yb + (i & 1) * 1024;
        if (lane < 32) {
#pragma unroll
          for (int j = 0; j < 8; ++j) {
            const int tl = pw * 8 + j;
            const size_t tok = (size_t)b * SEQ + (i - 2) * 32 + tl;
            O[tok * DM + 768 + hd * 64 + half * 32 + lane] = f2bf(Yc[tl * 32 + lane]);
          }
        }
      }
      if (i < NCH) {
#pragma unroll
        for (int j = 0; j < 8; ++j) {
          const int tl = pw * 8 + j;
          const float r = mixf((bf16_t)raw[j][0], (bf16_t)raw[j][3], mu_r), k = mixf((bf16_t)raw[j][1], (bf16_t)raw[j][4], mu_k), v = mixf((bf16_t)raw[j][2], (bf16_t)raw[j][5], mu_v);
          const float w = 1.f - bf2f((bf16_t)raw[j][6]), kk = bf2f((bf16_t)raw[j][7]), a = bf2f((bf16_t)raw[j][8]);
          const float ka = kk * a, kp = k * (1.f + (a - 1.f) * kac);
          const float c1 = wave_sum(ka * r), c2 = wave_sum(kp * r);
          B[tl * 64 + lane] = w; B[2048 + tl * 64 + lane] = kk; B[4096 + tl * 64 + lane] = ka; B[6144 + tl * 64 + lane] = kp;
          B[8192 + tl * 64 + lane] = w * r; B[10240 + tl * 64 + lane] = v;
          if (lane == 0) { B[12288 + tl * 2] = c1; B[12288 + tl * 2 + 1] = c2; }
        }
        if (i + 1 < NCH) RAWLOAD(i + 1);
      }
    } else if (i >= 1 && i <= NCH) {
      const float* B = fb + ((i - 1) & 1) * 12352;
      float* Yc = Yb + ((i - 1) & 1) * 1024;
      f32x4 vw[2][10]; float vvv[2]; float2 vsc[2];
#define RWLD(t_, s_)                                                                              \
      { const float* bt_ = B + (t_) * 64 + kq * 8;                                                 \
        _Pragma("unroll") for (int q_ = 0; q_ < 5; ++q_) { vw[s_][2 * q_] = *(const f32x4*)(bt_ + 2048 * q_); vw[s_][2 * q_ + 1] = *(const f32x4*)(bt_ + 2048 * q_ + 4); } \
        vvv[s_] = B[10240 + (t_) * 64 + vrow]; vsc[s_] = *(const float2*)(B + 12288 + (t_) * 2); }
#pragma unroll 1
      for (int tb = 0; tb < 32; tb += 16) {
      RWLD(tb, 0);
#pragma unroll
      for (int t = 0; t < 16; ++t) {
        const int cs = t & 1;
        if (t + 1 < 16) RWLD(tb + t + 1, cs ^ 1);
        const f32x4 w0 = vw[cs][0], w1 = vw[cs][1], kk0 = vw[cs][2], kk1 = vw[cs][3], ka0 = vw[cs][4], ka1 = vw[cs][5],
                    kp0 = vw[cs][6], kp1 = vw[cs][7], wr0 = vw[cs][8], wr1 = vw[cs][9];
        const float vv = vvv[cs]; const float2 sc = vsc[cs];
        float d0 = 0.f, e0 = 0.f;
#pragma unroll
        for (int j = 0; j < 4; ++j) { d0 += S[j] * kk0[j] + S[j + 4] * kk1[j]; e0 += S[j] * wr0[j] + S[j + 4] * wr1[j]; }
        d0 = reduce8(d0); e0 = reduce8(e0);
        const float sa0 = -d0;
        const float y0 = e0 + sa0 * sc.x + vv * sc.y;
#pragma unroll
        for (int j = 0; j < 4; ++j) {
          S[j] = S[j] * w0[j] + sa0 * ka0[j] + vv * kp0[j]; S[j + 4] = S[j + 4] * w1[j] + sa0 * ka1[j] + vv * kp1[j];
        }
        if (kq == 0) Yc[(tb + t) * 32 + vloc] = y0;
      }
      }
#undef RWLD
    }
    RBAR();
  }
#undef RAWLOAD
#undef RBAR
}

DI void rwkv_post(const Params& p, int l) {
  const bf16_t* P = (const bf16_t*)(p.ws + OFF_P);
  bf16_t* O = (bf16_t*)(p.ws + OFF_O);
  const bf16_t* RG = (const bf16_t*)(p.ws + OFF_L + 3 * GSZ);
  const float* BON = (const float*)(p.ws + OFF_BON);
  const int tid = otid(), lane = tid & 63, wv = tid >> 6;
  const float* mu = p.in[I_RMU] + (size_t)l * 896;
  const int nw = gridDim.x * 8;
  for (int task0 = (obid() * 8 + wv) * 4; task0 < NTOK * 4; task0 += nw * 4) {
    float yv[4], vv[4], gv[4], bv[4];
#pragma unroll
    for (int q = 0; q < 4; ++q) {
      const int task = task0 + q; const size_t tok = task >> 2; const int hd = task & 3, hc = hd * 64 + lane;
      yv[q] = bf2f(O[tok * DM + 768 + hc]);
      const bf16_t cur = P[tok * PSTR + C_RW + 512 + hc];
      const bf16_t prev = (tok % SEQ) ? P[(tok - 1) * PSTR + C_RW + 512 + hc] : (bf16_t)0;
      vv[q] = mixf(cur, prev, mu[512 + hc]);
      gv[q] = bf2f(RG[tok * 256 + hc]); bv[q] = BON[tok * 4 + hd];
    }
#pragma unroll
    for (int q = 0; q < 4; ++q) {
      const int task = task0 + q; const size_t tok = task >> 2; const int hd = task & 3, hc = hd * 64 + lane;
      const float mean = wave_sum(yv[q]) * (1.f / 64.f);
      const float d = yv[q] - mean;
      const float var = wave_sum(d * d) * (1.f / 64.f);
      const float yn = d * rsqrtf(var + 64e-5f) * p.in[I_RLG][l * 256 + hc] + p.in[I_RLB][l * 256 + hc];
      O[tok * DM + 768 + hc] = f2bf((yn + bv[q] * vv[q]) * gv[q]);
    }
  }
}

DI void sb_item(const Params& p, int item, char* smem) {
  const bf16_t* P = (const bf16_t*)(p.ws + OFF_P);
  bf16_t* O = (bf16_t*)(p.ws + OFF_O);
  const int qt = item & 15, hd = (item >> 4) & 3, b = item >> 6;
  const int tid = otid(), lane = tid & 63, wv = tid >> 6, r = lane & 31, h = lane >> 5;
  bf16_t* Vt = (bf16_t*)(smem + wv * 8704);
  const int q0 = qt * 256 + wv * 32;
  const int sq = q0 + r;
  const size_t tokb = (size_t)b * SEQ;
  bf16x8 qf[4];
#pragma unroll
  for (int ks = 0; ks < 4; ++ks) qf[ks] = *(const bf16x8*)(P + (tokb + sq) * PSTR + C_SB_Q + hd * 64 + ks * 16 + h * 8);
  f32x16 accO[2];
#pragma unroll
  for (int i = 0; i < 16; ++i) { accO[0][i] = 0.f; accO[1][i] = 0.f; }
  float Prun = 1.f;
  bf16x8 kf[2][4];
  const int kt0 = (q0 + 31) >> 6;
#define SBKLOAD(kt_) { _Pragma("unroll") for (int m = 0; m < 2; ++m) _Pragma("unroll") for (int ks = 0; ks < 4; ++ks) \
    kf[m][ks] = *(const bf16x8*)(P + (tokb + (kt_) * 64 + 32 * m + r) * PSTR + C_SB_K + hd * 64 + ks * 16 + h * 8); }
  SBKLOAD(kt0);
  for (int kt = kt0; kt >= 0; --kt) {
    const int k0 = kt * 64;
    bf16x8 vr[8];
#pragma unroll
    for (int it = 0; it < 8; ++it) vr[it] = *(const bf16x8*)(P + (tokb + k0 + it * 8 + (lane >> 3)) * PSTR + C_SB_V + hd * 64 + (lane & 7) * 8);
    f32x16 acc[2];
#pragma unroll
    for (int m = 0; m < 2; ++m) {
#pragma unroll
      for (int i = 0; i < 16; ++i) acc[m][i] = 0.f;
#pragma unroll
      for (int ks = 0; ks < 4; ++ks) acc[m] = mfma32(kf[m][ks], qf[ks], acc[m]);
    }
    if (kt > 0) SBKLOAD(kt - 1);
    float om[2][16];
#pragma unroll
    for (int m = 0; m < 2; ++m)
#pragma unroll
      for (int i = 0; i < 16; ++i) {
        const int key = k0 + 32 * m + crow(i, h);
        const float z = fmaxf(acc[m][i] * 0.125f, -80.f);
        const float e = __expf(-z);
        const float sg = __builtin_amdgcn_rcpf(1.f + e);
        const bool valid = key < sq;
        acc[m][i] = valid ? sg : 0.f;
        om[m][i] = valid ? e * sg : 1.f;
      }
    float gp[8];
#pragma unroll
    for (int q = 0; q < 8; ++q) {
      const int m = q >> 2, g = q & 3;
      gp[q] = (om[m][4 * g] * om[m][4 * g + 1]) * (om[m][4 * g + 2] * om[m][4 * g + 3]);
    }
    float run = 1.f;
#pragma unroll
    for (int q = 7; q >= 0; --q) {
      const int m = q >> 2, g = q & 3;
      const float pg = __shfl_xor(gp[q], 32);
      const float f3 = Prun * run * (h == 0 ? pg : 1.f);
      const float f2 = f3 * om[m][4 * g + 3], f1 = f2 * om[m][4 * g + 2], f0 = f1 * om[m][4 * g + 1];
      acc[m][4 * g + 3] *= f3; acc[m][4 * g + 2] *= f2; acc[m][4 * g + 1] *= f1; acc[m][4 * g + 0] *= f0;
      run *= gp[q] * pg;
    }
    Prun *= run;
    __builtin_amdgcn_wave_barrier();
#pragma unroll
    for (int it = 0; it < 8; ++it) {
      const int key = it * 8 + (lane >> 3), chv = lane & 7;
#pragma unroll
      for (int e = 0; e < 8; ++e) Vt[(chv * 8 + e) * 68 + key] = (bf16_t)vr[it][e];
    }
    __builtin_amdgcn_wave_barrier();
#pragma unroll
    for (int m = 0; m < 2; ++m)
#pragma unroll
      for (int s2 = 0; s2 < 2; ++s2) {
        uint4 uu = {pack2(acc[m][8 * s2 + 0], acc[m][8 * s2 + 1]), pack2(acc[m][8 * s2 + 2], acc[m][8 * s2 + 3]),
                    pack2(acc[m][8 * s2 + 4], acc[m][8 * s2 + 5]), pack2(acc[m][8 * s2 + 6], acc[m][8 * s2 + 7])};
        const bf16x8 pb = __builtin_bit_cast(bf16x8, uu);
#pragma unroll
        for (int dt = 0; dt < 2; ++dt) {
          const bf16_t* vp = Vt + (32 * dt + r) * 68 + 32 * m + 16 * s2 + 4 * h;
          s16x4 lo = *(const s16x4*)vp, hi = *(const s16x4*)(vp + 8);
          bf16x8 va = __builtin_shufflevector(lo, hi, 0, 1, 2, 3, 4, 5, 6, 7);
          accO[dt] = mfma32(va, pb, accO[dt]);
        }
      }
    __builtin_amdgcn_wave_barrier();
    if (__ballot(Prun > 1e-37f) == 0ull) break;
  }
#undef SBKLOAD
#pragma unroll
  for (int dt = 0; dt < 2; ++dt)
#pragma unroll
    for (int g = 0; g < 4; ++g) {
      const int d = 32 * dt + 8 * g + 4 * h;
      uint2 o = {pack2(accO[dt][4 * g], accO[dt][4 * g + 1]), pack2(accO[dt][4 * g + 2], accO[dt][4 * g + 3])};
      *(uint2*)(O + (tokb + sq) * DM + 256 + hd * 64 + d) = o;
    }
}

DI int frag_off(int row, int k) {
  const int rt = row >> 4, fr = row & 15, ks = k >> 5, kk = k & 31, hi = kk >> 4, fq = (kk & 15) >> 2, j = (kk & 3) + 4 * hi;
  return ((rt * 2 + ks) * 64 + fq * 16 + fr) * 8 + j;
}
DI int frag_off8(int row, int k0) {
  const int rt = row >> 4, fr = row & 15, ks = k0 >> 5, kk = k0 & 31, hi = kk >> 4, fq = (kk & 15) >> 2;
  return ((rt * 2 + ks) * 64 + fq * 16 + fr) * 8 + 4 * hi;
}
DI void gdn_intra_item(const Params& p, int l, int item, char* smem) {
  const bf16_t* P = (const bf16_t*)(p.ws + OFF_P);
  const int hp = item & 1, c = (item >> 1) & 63, b = item >> 7;
  const int tid = otid(), lane = tid & 63;
  bf16_t* Kb = (bf16_t*)smem;
  bf16_t* Qb = Kb + 2 * 64 * 72;
  bf16_t* Vb = Qb + 2 * 64 * 72;
  float* Lm = (float*)(smem + 3 * 2 * 64 * 72 * 2);
  float* Gs = Lm + 2 * 4096;
  float* Bs = Gs + 128;
  const size_t tok0 = (size_t)b * SEQ + c * 64;
  const float* cw = p.in[I_GCW] + (size_t)l * 4 * 768;
  float* CW = Bs + 128;
  for (int e = tid; e < 6 * 4 * 64; e += NTHR) {
    const int blk = e >> 8, j = (e >> 6) & 3, col = e & 63;
    const int hh_ = blk / 3, which_ = blk % 3;
    CW[e] = cw[j * 768 + which_ * 256 + (hp * 2 + hh_) * 64 + col];
  }
  __syncthreads();
  {
    const int t = tid >> 3, cg = tid & 7;
#pragma unroll 3
    for (int it = 0; it < 6; ++it) {
      const int hh = it / 3, which = it % 3, head = hp * 2 + hh;
      const int ccol = which * 256 + head * 64 + cg * 8;
      float acc[8];
#pragma unroll
      for (int e = 0; e < 8; ++e) acc[e] = 0.f;
#pragma unroll
      for (int j = 0; j < 4; ++j) {
        const int s = c * 64 + t - 3 + j;
        if (s >= 0) {
          bf16x8 xv = *(const bf16x8*)(P + ((size_t)b * SEQ + s) * PSTR + C_GDN_Q + ccol);
          f32x4 wa = *(const f32x4*)(CW + (it * 4 + j) * 64 + cg * 8), wb = *(const f32x4*)(CW + (it * 4 + j) * 64 + cg * 8 + 4);
#pragma unroll
          for (int e = 0; e < 4; ++e) { acc[e] += wa[e] * bf2f((bf16_t)xv[e]); acc[e + 4] += wb[e] * bf2f((bf16_t)xv[e + 4]); }
        }
      }
      float ss = 0.f;
#pragma unroll
      for (int e = 0; e < 8; ++e) { acc[e] = siluf_(acc[e]); ss += acc[e] * acc[e]; }
      ss += __shfl_xor(ss, 1); ss += __shfl_xor(ss, 2); ss += __shfl_xor(ss, 4);
      float sc = 1.f;
      if (which == 0) sc = rsqrtf(ss + EPSF) * 0.125f;
      else if (which == 1) sc = rsqrtf(ss + EPSF);
      uint4 ov = {pack2(acc[0] * sc, acc[1] * sc), pack2(acc[2] * sc, acc[3] * sc), pack2(acc[4] * sc, acc[5] * sc), pack2(acc[6] * sc, acc[7] * sc)};
      bf16_t* dst = (which == 0 ? Qb : (which == 1 ? Kb : Vb)) + (hh * 64 + t) * 72 + cg * 8;
      *(uint4*)dst = ov;
    }
  }
  if (tid < 128) {
    const int hh = tid >> 6, t = lane, head = hp * 2 + hh;
    const float a_in = bf2f(P[(tok0 + t) * PSTR + C_GDN_A + head]);
    const float b_in = bf2f(P[(tok0 + t) * PSTR + C_GDN_B + head]);
    const float beta = sigmoidf_(b_in);
    float g = -__expf(p.in[I_GAL][l * 4 + head]) * softplusf_(a_in + p.in[I_GDT][l * 4 + head]);
#pragma unroll
    for (int d = 1; d < 64; d <<= 1) { float v = __shfl_up(g, d); if (lane >= d) g += v; }
    Gs[hh * 64 + t] = g; Bs[hh * 64 + t] = beta;
  }
  __syncthreads();
  const int hh = tid >> 8, lt = tid & 255, head = hp * 2 + hh;
  const size_t ih = ((size_t)(b * 4 + head)) * 64 + c;
  bf16_t* GW = (bf16_t*)(p.ws + OFF_G) + ih * 4096;
  bf16_t* GQD = (bf16_t*)(p.ws + OFF_G + GSZ) + ih * 4096;
  bf16_t* GQK = (bf16_t*)(p.ws + OFF_G + 2 * GSZ) + ih * 4096;
  bf16_t* GKD = (bf16_t*)(p.ws + OFF_G + 3 * GSZ) + ih * 4096;
  bf16_t* GU = (bf16_t*)(p.ws + OFF_G + 4 * GSZ) + ih * 4096;
  float* GCD = (float*)(p.ws + OFF_GCD);
  const float* Gh = Gs + hh * 64; const float* Bh = Bs + hh * 64;
  {
    const int wq = (tid >> 6) & 3, ti = wq >> 1, tj = wq & 1, r = lane & 31, h = lane >> 5;
    f32x16 akk, aqk;
#pragma unroll
    for (int i = 0; i < 16; ++i) { akk[i] = 0.f; aqk[i] = 0.f; }
    if (ti >= tj) {
#pragma unroll
      for (int ks = 0; ks < 4; ++ks) {
        bf16x8 ka = *(const bf16x8*)(Kb + (hh * 64 + 32 * ti + r) * 72 + ks * 16 + h * 8);
        bf16x8 qa = *(const bf16x8*)(Qb + (hh * 64 + 32 * ti + r) * 72 + ks * 16 + h * 8);
        bf16x8 kb = *(const bf16x8*)(Kb + (hh * 64 + 32 * tj + r) * 72 + ks * 16 + h * 8);
        akk = mfma32(ka, kb, akk);
        aqk = mfma32(qa, kb, aqk);
      }
    }
    const int j = 32 * tj + r;
    const float Gj = Gh[j];
#pragma unroll
    for (int i_ = 0; i_ < 16; ++i_) {
      const int i = 32 * ti + crow(i_, h);
      const float dec = (i >= j) ? __expf(Gh[i] - Gj) : 0.f;
      Lm[hh * 4096 + i * 64 + j] = (i > j) ? Bh[i] * akk[i_] * dec : 0.f;
      GQK[frag_off(i, j)] = f2bf((i >= j) ? aqk[i_] * dec : 0.f);
    }
  }
  __syncthreads();
  if (lt < 128) {
    const int cc = lt;
    float x[64];
    if (cc < 64) {
#pragma unroll
      for (int i = 0; i < 64; ++i) x[i] = bf2f(Vb[(hh * 64 + i) * 72 + cc]) * Bh[i];
    } else {
#pragma unroll
      for (int i = 0; i < 64; ++i) x[i] = bf2f(Kb[(hh * 64 + i) * 72 + cc - 64]) * Bh[i] * __expf(Gh[i]);
    }
    const float* Lh = Lm + hh * 4096;
#pragma unroll
    for (int i = 1; i < 64; ++i) {
      float s = x[i];
#pragma unroll
      for (int j4 = 0; j4 < (i + 3) / 4; ++j4) {
        const f32x4 lv = *(const f32x4*)(Lh + i * 64 + j4 * 4);
#pragma unroll
        for (int e = 0; e < 4; ++e) if (j4 * 4 + e < i) s -= lv[e] * x[j4 * 4 + e];
      }
      x[i] = s;
    }
    if (cc < 64) {
      const int split = cc >> 4, fr = cc & 15;
#pragma unroll
      for (int i4 = 0; i4 < 16; ++i4) {
        uint2 ov = {pack2(x[4 * i4], x[4 * i4 + 1]), pack2(x[4 * i4 + 2], x[4 * i4 + 3])};
        *(uint2*)(GU + ((split * 4 + (i4 >> 2)) * 64 + (i4 & 3) * 16 + fr) * 4) = ov;
      }
    } else {
#pragma unroll
      for (int i = 0; i < 64; ++i) GW[frag_off(i, cc - 64)] = f2bf(x[i]);
    }
  } else {
    const int q_ = lt - 128;
    const float Glast = Gh[63];
#pragma unroll
    for (int i = 0; i < 4; ++i) {
      const int q = q_ + 128 * i; const int pos = q >> 3, kc = q & 7;
      bf16x8 qv = *(const bf16x8*)(Qb + (hh * 64 + pos) * 72 + kc * 8);
      const float eg = __expf(Gh[pos]);
      uint4 ov = {pack2(bf2f((bf16_t)qv[0]) * eg, bf2f((bf16_t)qv[1]) * eg), pack2(bf2f((bf16_t)qv[2]) * eg, bf2f((bf16_t)qv[3]) * eg),
                  pack2(bf2f((bf16_t)qv[4]) * eg, bf2f((bf16_t)qv[5]) * eg), pack2(bf2f((bf16_t)qv[6]) * eg, bf2f((bf16_t)qv[7]) * eg)};
      { const int fo = frag_off8(pos, kc * 8); uint2 o0 = {ov.x, ov.y}, o1 = {ov.z, ov.w}; *(uint2*)(GQD + fo) = o0; *(uint2*)(GQD + fo + 128) = o1; }
    }
#pragma unroll
    for (int i = 0; i < 4; ++i) {
      const int q = q_ + 128 * i; const int k = q >> 3, pc = q & 7;
      float o[8];
#pragma unroll
      for (int e = 0; e < 8; ++e) { const int pos = pc * 8 + e; o[e] = bf2f(Kb[(hh * 64 + pos) * 72 + k]) * __expf(Glast - Gh[pos]); }
      uint4 ov = {pack2(o[0], o[1]), pack2(o[2], o[3]), pack2(o[4], o[5]), pack2(o[6], o[7])};
      { const int fo = frag_off8(k, pc * 8); uint2 o0 = {ov.x, ov.y}, o1 = {ov.z, ov.w}; *(uint2*)(GKD + fo) = o0; *(uint2*)(GKD + fo + 128) = o1; }
    }
    if (q_ == 0) GCD[ih] = __expf(Glast);
  }
}

DI void gdn_rec_item(const Params& p, int l, int b, int head, char* smem) {
  const bf16_t* P = (const bf16_t*)(p.ws + OFF_P);
  bf16_t* O = (bf16_t*)(p.ws + OFF_O);
  float* SS = (float*)(smem + 81920);
  const int tid = otid(), lane = tid & 63, wv = tid >> 6, fr = lane & 15, fq = lane >> 4;
  const int split = wv & 3;
  const bool active = wv < 4;
  const float ng = p.in[I_GNG][l * 64 + split * 16 + fr];
  const float* GCD = (const float*)(p.ws + OFF_GCD);
  const size_t ih0 = ((size_t)(b * 4 + head)) * 64;
  f32x4 S[4];
#pragma unroll
  for (int kt = 0; kt < 4; ++kt) S[kt] = (f32x4){0.f, 0.f, 0.f, 0.f};
  u32x4 lr[10];
#pragma unroll
  for (int i = 0; i < 10; ++i) lr[i] = (u32x4){0u, 0u, 0u, 0u};
  const int lq = (wv & 3) * 64 + lane;
#define GLOADC(c_)                                                                              \
  {                                                                                             \
    _Pragma("unroll") for (int i = 0; i < 10; ++i) {                                            \
      const int q_ = lq + 256 * i; const int a_ = q_ >> 9, o_ = q_ & 511;                       \
      lr[i] = *(const u32x4*)((const bf16_t*)(p.ws + OFF_G + (size_t)a_ * GSZ) + (ih0 + (c_)) * 4096 + o_ * 8); \
    }                                                                                           \
  }
#define LSTORE(buf_)                                                                            \
  {                                                                                             \
    _Pragma("unroll") for (int i = 0; i < 10; ++i) {                                            \
      const int q_ = lq + 256 * i;                                                              \
      *(u32x4*)(smem + (buf_) * 40960 + q_ * 16) = lr[i];                                       \
    }                                                                                           \
  }
#define BAR_LDS() { asm volatile("s_waitcnt lgkmcnt(0)" ::: "memory"); __builtin_amdgcn_s_barrier(); asm volatile("" ::: "memory"); }
  float cdn = 0.f;
  if (!active) { GLOADC(0); LSTORE(0); GLOADC(1); }
  else cdn = GCD[ih0];
  BAR_LDS();
#pragma unroll 1
  for (int c = 0; c < 64; ++c) {
    f32x4 acco[4];
    if (active) {
      const char* bufp = smem + (c & 1) * 40960;
      const float cd = cdn;
      if (c + 1 < 64) cdn = GCD[ih0 + c + 1];
      float zr[16];
#pragma unroll
      for (int rt = 0; rt < 4; ++rt)
#pragma unroll
        for (int j = 0; j < 4; ++j) {
          const size_t tok = (size_t)b * SEQ + c * 64 + 16 * rt + 4 * fq + j;
          zr[rt * 4 + j] = bf2f(P[tok * PSTR + C_GDN_Z + head * 64 + split * 16 + fr]);
        }
      bf16x8 bS[2];
#pragma unroll
      for (int ks = 0; ks < 2; ++ks) {
        uint4 uu = {pack2(S[2 * ks][0], S[2 * ks][1]), pack2(S[2 * ks][2], S[2 * ks][3]), pack2(S[2 * ks + 1][0], S[2 * ks + 1][1]), pack2(S[2 * ks + 1][2], S[2 * ks + 1][3])};
        bS[ks] = __builtin_bit_cast(bf16x8, uu);
      }
      f32x4 u[4];
#pragma unroll
      for (int rt = 0; rt < 4; ++rt) {
        f32x4 aw = {0.f, 0.f, 0.f, 0.f};
        acco[rt] = (f32x4){0.f, 0.f, 0.f, 0.f};
#pragma unroll
        for (int ks = 0; ks < 2; ++ks) {
          const bf16x8 wa = *(const bf16x8*)(bufp + ((rt * 2 + ks) * 64 + lane) * 16);
          const bf16x8 qa = *(const bf16x8*)(bufp + 8192 + ((rt * 2 + ks) * 64 + lane) * 16);
          aw = mfma16(wa, bS[ks], aw); acco[rt] = mfma16(qa, bS[ks], acco[rt]);
        }
        const s16x4 uv = *(const s16x4*)(bufp + 32768 + ((split * 4 + rt) * 64 + lane) * 8);
#pragma unroll
        for (int j = 0; j < 4; ++j) u[rt][j] = bf2f((bf16_t)uv[j]) - aw[j];
      }
      bf16x8 bU[2];
#pragma unroll
      for (int ks = 0; ks < 2; ++ks) {
        uint4 uu = {pack2(u[2 * ks][0], u[2 * ks][1]), pack2(u[2 * ks][2], u[2 * ks][3]), pack2(u[2 * ks + 1][0], u[2 * ks + 1][1]), pack2(u[2 * ks + 1][2], u[2 * ks + 1][3])};
        bU[ks] = __builtin_bit_cast(bf16x8, uu);
      }
#pragma unroll
      for (int rt = 0; rt < 4; ++rt) {
        f32x4 sn = S[rt] * cd;
#pragma unroll
        for (int ks = 0; ks < 2; ++ks) {
          const bf16x8 qa = *(const bf16x8*)(bufp + 16384 + ((rt * 2 + ks) * 64 + lane) * 16);
          const bf16x8 ka = *(const bf16x8*)(bufp + 24576 + ((rt * 2 + ks) * 64 + lane) * 16);
          acco[rt] = mfma16(qa, bU[ks], acco[rt]); sn = mfma16(ka, bU[ks], sn);
        }
        S[rt] = sn;
      }
#pragma unroll
      for (int rt = 0; rt < 4; ++rt)
#pragma unroll
        for (int j = 0; j < 4; ++j) {
          float s = acco[rt][j] * acco[rt][j];
          s += __shfl_xor(s, 1); s += __shfl_xor(s, 2); s += __shfl_xor(s, 4); s += __shfl_xor(s, 8);
          if (fr == 0) SS[(c & 1) * 256 + split * 64 + 16 * rt + 4 * fq + j] = s;
        }
      BAR_LDS();
      const float* ssb = SS + (c & 1) * 256;
#pragma unroll
      for (int rt = 0; rt < 4; ++rt)
#pragma unroll
        for (int j = 0; j < 4; ++j) {
          const int pos = 16 * rt + 4 * fq + j;
          const float tot = ssb[pos] + ssb[64 + pos] + ssb[128 + pos] + ssb[192 + pos];
          const float rn = rsqrtf(tot * (1.f / 64.f) + EPSF);
          const size_t tok = (size_t)b * SEQ + c * 64 + pos;
          O[tok * DM + 512 + head * 64 + split * 16 + fr] = f2bf(acco[rt][j] * rn * ng * siluf_(zr[rt * 4 + j]));
        }
    } else {
      if (c + 1 < 64) LSTORE((c + 1) & 1);
      if (c + 2 < 64) GLOADC(c + 2);
      BAR_LDS();
    }
  }
#undef GLOADC
#undef LSTORE
#undef BAR_LDS
}

DI void lru_item(const Params& p, int l, int item, char* smem, const int mode) {
  const bf16_t* P = (const bf16_t*)(p.ws + OFF_P);
  bf16_t* O = (bf16_t*)(p.ws + OFF_O);
  float* CA = (float*)(p.ws + OFF_LCA);
  float* CH = (float*)(p.ws + OFF_LCH);
  bf16_t* XS = (bf16_t*)smem;
  bf16_t* UB = (bf16_t*)(smem + 34816);
  const int b = item >> 6, ct = item & 63;
  const int tid = otid(), lane = tid & 63, wv = tid >> 6, r = lane & 31, h = lane >> 5, n = wv & 3, mi = wv >> 2;
  for (int i = 0; i < 5; ++i) {
    const int q = tid + NTHR * i;
    if (q < 67 * 32) {
      const int row = q >> 5, cc = q & 31;
      const int s = ct * 64 - 3 + row;
      uint4 v = {0u, 0u, 0u, 0u};
      if (s >= 0) v = *(const uint4*)(P + ((size_t)b * SEQ + s) * PSTR + C_LRU_X + cc * 8);
      *(uint4*)(XS + row * 256 + cc * 8) = v;
    }
  }
  bf16x8 bwr[2][4], bwi[2][4];
  {
    const float* wrp = p.in[I_LWR] + (((size_t)l * 4 + n) * 64) * 64 + r;
    const float* wip = p.in[I_LWI] + (((size_t)l * 4 + n) * 64) * 64 + r;
    asm volatile("" : "+v"(wrp), "+v"(wip));
#pragma unroll
    for (int ni = 0; ni < 2; ++ni)
#pragma unroll
      for (int ks = 0; ks < 4; ++ks) {
        unsigned ur[4], ui[4];
#pragma unroll
        for (int j2 = 0; j2 < 4; ++j2) {
          const int e = 16 * ks + 8 * h + 2 * j2;
          ur[j2] = pack2(wrp[e * 64 + 32 * ni], wrp[(e + 1) * 64 + 32 * ni]);
          ui[j2] = pack2(wip[e * 64 + 32 * ni], wip[(e + 1) * 64 + 32 * ni]);
        }
        uint4 t1 = {ur[0], ur[1], ur[2], ur[3]}, t2 = {ui[0], ui[1], ui[2], ui[3]};
        bwr[ni][ks] = __builtin_bit_cast(bf16x8, t1); bwi[ni][ks] = __builtin_bit_cast(bf16x8, t2);
      }
  }
  __syncthreads();
  {
    const int sc = tid >> 8, c = tid & 255;
    const float cb = p.in[I_LCB][l * 256 + c];
    const float c0 = p.in[I_LCW][(l * 4 + 0) * 256 + c], c1 = p.in[I_LCW][(l * 4 + 1) * 256 + c],
                c2 = p.in[I_LCW][(l * 4 + 2) * 256 + c], c3 = p.in[I_LCW][(l * 4 + 3) * 256 + c];
    for (int t = sc * 32; t < sc * 32 + 32; ++t)
      UB[t * 264 + c] = f2bf(cb + c0 * bf2f(XS[t * 256 + c]) + c1 * bf2f(XS[(t + 1) * 256 + c]) + c2 * bf2f(XS[(t + 2) * 256 + c]) + c3 * bf2f(XS[(t + 3) * 256 + c]));
  }
  __syncthreads();
  f32x16 ar[2], ai[2];
#pragma unroll
  for (int ni = 0; ni < 2; ++ni)
#pragma unroll
    for (int i = 0; i < 16; ++i) { ar[ni][i] = 0.f; ai[ni][i] = 0.f; }
#pragma unroll
  for (int ks = 0; ks < 4; ++ks) {
    const bf16x8 au = *(const bf16x8*)(UB + (32 * mi + r) * 264 + n * 64 + 16 * ks + 8 * h);
#pragma unroll
    for (int ni = 0; ni < 2; ++ni) { ar[ni] = mfma32(au, bwr[ni][ks], ar[ni]); ai[ni] = mfma32(au, bwi[ni][ks], ai[ni]); }
  }
  const int ck = ct * 2 + mi;
#pragma unroll
  for (int ni = 0; ni < 2; ++ni) {
    const int c = n * 64 + 32 * ni + r;
    const float brc = p.in[I_LBR][l * 256 + c], bic = p.in[I_LBI][l * 256 + c];
    const float lamsp = softplusf_(-p.in[I_LLAM][l * 256 + c]);
    float av[16], bv[16];
#pragma unroll
    for (int i = 0; i < 16; ++i) {
      const int tl = 32 * mi + crow(i, h);
      const float u = bf2f(UB[tl * 264 + c]);
      const float rg = sigmoid_rcp(ar[ni][i] + brc), ig = sigmoid_rcp(ai[ni][i] + bic);
      const float la = -8.f * rg * lamsp;
      av[i] = __expf(la);
      bv[i] = __builtin_amdgcn_sqrtf(fmaxf(0.f, 1.f - __expf(2.f * la))) * (ig * u);
    }
    float GA[4], GB[4], PA[4], PB[4];
#pragma unroll
    for (int q = 0; q < 4; ++q) {
      float A = 1.f, hh = 0.f;
#pragma unroll
      for (int e = 0; e < 4; ++e) { hh = av[4 * q + e] * hh + bv[4 * q + e]; A *= av[4 * q + e]; }
      GA[q] = A; GB[q] = hh;
      PA[q] = __shfl_xor(A, 32); PB[q] = __shfl_xor(hh, 32);
    }
    float cin = 0.f;
    if (mode == 1) {
      const int lo = h ? (ck >> 1) : 0, hi = h ? ck : (ck >> 1);
      float A = 1.f, hh = 0.f;
      const float* ca = CA + ((size_t)b * 128) * 256 + c;
      const float* chp = CH + ((size_t)b * 128) * 256 + c;
      int k = lo;
      for (; k + 8 <= hi; k += 8) {
        float a8[8], h8[8];
#pragma unroll
        for (int e = 0; e < 8; ++e) { a8[e] = ca[(size_t)(k + e) * 256]; h8[e] = chp[(size_t)(k + e) * 256]; }
#pragma unroll
        for (int e = 0; e < 8; ++e) { hh = a8[e] * hh + h8[e]; A *= a8[e]; }
      }
      for (; k < hi; ++k) { const float a_ = ca[(size_t)k * 256], h_ = chp[(size_t)k * 256]; hh = a_ * hh + h_; A *= a_; }
      const float pAx = __shfl_xor(A, 32), pHx = __shfl_xor(hh, 32);
      cin = h ? (A * pHx + hh) : (pAx * hh + pHx);
    }
    float cg = cin, Ap = 1.f, myc[4];
#pragma unroll
    for (int q = 0; q < 4; ++q) {
      const float Ae = h ? PA[q] : GA[q], Be = h ? PB[q] : GB[q];
      const float Ao = h ? GA[q] : PA[q], Bo = h ? GB[q] : PB[q];
      const float c_even = cg;
      cg = Ae * cg + Be;
      const float c_odd = cg;
      cg = Ao * cg + Bo;
      myc[q] = h ? c_odd : c_even;
      Ap *= Ae * Ao;
    }
    if (mode == 0) {
      if (h == 0) { CA[((size_t)b * 128 + ck) * 256 + c] = Ap; CH[((size_t)b * 128 + ck) * 256 + c] = cg; }
    } else {
#pragma unroll
      for (int q = 0; q < 4; ++q) {
        float hh = myc[q];
#pragma unroll
        for (int e = 0; e < 4; ++e) {
          const int i = 4 * q + e;
          hh = av[i] * hh + bv[i];
          const size_t tok = (size_t)b * SEQ + ct * 64 + 32 * mi + crow(i, h);
          const float y = bf2f(P[tok * PSTR + C_LRU_Y + c]);
          O[tok * DM + c] = f2bf(hh * gelu_rcp(y));
        }
      }
    }
  }
}

#define XB_TMO      128
#define XB_XCNT(j)  (256  + 64 * (j))
#define XB_XSUB(j)  (1280 + 64 * (j))
#define XB_XGEN(j)  (2304 + 64 * (j))
#define XB_TOP      3328
#define XB_TOPGEN   3392
#define XCD_BAR_WORDS 3456
#define XB_SPIN_CAP (1u << 18)
#define XLAS __attribute__((address_space(3)))
DI unsigned xb_ld(unsigned* p)              { return __hip_atomic_load(p, __ATOMIC_RELAXED, __HIP_MEMORY_SCOPE_AGENT); }
DI unsigned xb_add(unsigned* p, unsigned v) { return __hip_atomic_fetch_add(p, v, __ATOMIC_RELAXED, __HIP_MEMORY_SCOPE_AGENT); }
DI unsigned xb_xcc_id() { return (unsigned)__builtin_amdgcn_s_getreg((3 << 11) | 20) & 0xFu; }
#define XB_SPIN(cond, bar) do { unsigned _sp = 0; while (cond) { __builtin_amdgcn_s_sleep(1); \
    if ((++_sp & 255u) == 0u) { if (xb_ld(&(bar)[XB_TMO])) break; if (_sp > XB_SPIN_CAP) { atomicAdd(&(bar)[XB_TMO], 1u); break; } } } } while (0)
struct XcdBarrier { unsigned* bar; unsigned x; volatile XLAS unsigned* st; };
DI XcdBarrier xcd_barrier_post(unsigned* bar, volatile XLAS unsigned* st) {
  XcdBarrier b; b.bar = bar; b.x = xb_xcc_id(); b.st = st;
  if (threadIdx.x == 0) (void)xb_add(&bar[XB_XCNT(b.x)], 1u);
  return b;
}
DI void xcd_barrier_complete(unsigned* bar, unsigned x, unsigned& nloc, unsigned& nx) {
  const unsigned G = gridDim.x * gridDim.y * gridDim.z;
  unsigned sum, cnt, mine, sp = 0u;
  for (;;) {
    sum = 0u; cnt = 0u; mine = 0u;
#pragma unroll
    for (unsigned j = 0; j < 16; ++j) { const unsigned c = xb_ld(&bar[XB_XCNT(j)]); sum += c; cnt += (c > 0u) ? 1u : 0u; mine = (j == x) ? c : mine; }
    if (sum == G) break;
    __builtin_amdgcn_s_sleep(1);
    if ((++sp & 255u) == 0u) { if (xb_ld(&bar[XB_TMO])) break; if (sp > XB_SPIN_CAP) { atomicAdd(&bar[XB_TMO], 1u); break; } }
  }
  nloc = mine > 0u ? mine : 1u; nx = cnt > 0u ? cnt : 1u;
}
DI void xcd_barrier(const XcdBarrier& b) {
  asm volatile("s_waitcnt vmcnt(0)" ::: "memory");
  __syncthreads();
  if (threadIdx.x == 0) {
    unsigned* bar = b.bar;
    __builtin_amdgcn_s_waitcnt(0);
    unsigned nloc = b.st[0], nx = b.st[1];
    if (nloc == 0u) { xcd_barrier_complete(bar, b.x, nloc, nx); b.st[0] = nloc; b.st[1] = nx; }
    const unsigned old = xb_add(&bar[XB_XSUB(b.x)], 1u);
    const unsigned gen = old / nloc;
    if (old + 1u == (gen + 1u) * nloc) {
      __builtin_amdgcn_fence(__ATOMIC_RELEASE, "agent");
      asm volatile("s_waitcnt vmcnt(0)" ::: "memory");
      const unsigned og = xb_add(&bar[XB_TOP], 1u);
      const unsigned tg = og / nx;
      if (og + 1u == (tg + 1u) * nx) xb_add(&bar[XB_TOPGEN], 1u);
      else XB_SPIN(xb_ld(&bar[XB_TOPGEN]) == tg, bar);
      __builtin_amdgcn_fence(__ATOMIC_ACQUIRE, "agent");
      xb_add(&bar[XB_XGEN(b.x)], 1u);
      asm volatile("s_waitcnt vmcnt(0)" ::: "memory");
    } else {
      XB_SPIN(xb_ld(&bar[XB_XGEN(b.x)]) == gen, bar);
      __builtin_amdgcn_fence(__ATOMIC_ACQUIRE, "agent");
      asm volatile("s_waitcnt vmcnt(0)" ::: "memory");
    }
  }
  __syncthreads();
}

__global__ void __launch_bounds__(NTHR) mega(Params p) {
  extern __shared__ __attribute__((aligned(16))) char smem[];
  cg::grid_group grid = cg::this_grid();
  const int tid = threadIdx.x;
  bf16_t* H = (bf16_t*)(p.ws + OFF_H);
  bf16_t* PB = (bf16_t*)(p.ws + OFF_P);
  PG_LAS unsigned char* lds = (PG_LAS unsigned char*)smem;
  volatile XLAS unsigned* xst = (volatile XLAS unsigned*)(smem + 131072);
  if (tid < 2) xst[tid] = 0u;
  __syncthreads();
  const XcdBarrier xb = xcd_barrier_post((unsigned*)(p.ws + OFF_BAR), xst);

  for (int rep = 0; rep < REP_MISC; ++rep) {
  if (MASK & 1) phase_mod(p, smem);
  grid.sync();
  }
  for (int l = 0; l < 4; ++l) {
    const float* xcur = (l == 0) ? p.in[I_X] : p.out;
    for (int rep = 0; rep < REP_MISC; ++rep) {
    if (MASK & 2) phase_convert(p, l, smem);
    if (MASK & 4) phase_norm(p, xcur, p.in[I_N1G] + l * 1024, l, 1024, 0, H, nullptr);
    xcd_barrier(xb);
    }
    for (int rep = 0; rep < REP_G; ++rep) {
    if (MASK & 8) { pg::Order<1> S; S.init(NTOK, PSTR, gridDim.x, blockIdx.x); pg::EpiBf16<0> E{PB, PSTR, nullptr};
      pg::gemm_phase(lds, H, DM, (const bf16_t*)(p.ws + OFF_WIN), 1024, S, E); }
    xcd_barrier(xb);
    }
    for (int rep = 0; rep < REP_M1; ++rep) {
    for (int it = blockIdx.x; it < 5120; it += gridDim.x) {
      if (it < 2048) { if (MASK & 32) gdn_intra_item(p, l, it, smem); }
      else if (it < 3072) { }
      else if (it < 4096) { if (MASK & 128) lru_item(p, l, it - 3072, smem, 0); }
      else { if (MASK & 16) rw_prep_item(p, l, it - 4096, smem); }
      __syncthreads();
    }
    xcd_barrier(xb);
    }
    for (int rep = 0; rep < REP_M2; ++rep) {
    if (blockIdx.x < 128) {
      if (MASK & 16) rwkv_scan_item(p, l, blockIdx.x >> 3, (blockIdx.x >> 1) & 3, blockIdx.x & 1, smem);
    } else {
      if (blockIdx.x < 192) { if (MASK & 256) gdn_rec_item(p, l, (blockIdx.x - 128) >> 2, (blockIdx.x - 128) & 3, smem); }
      unsigned* ctr = (unsigned*)(p.ws + OFF_CTR) + l * 4 + rep;
      volatile int* slot = (volatile int*)(smem + 110016);
      for (;;) {
        __syncthreads();
        if (tid == 0) *slot = (int)atomicAdd(ctr, 1u);
        __syncthreads();
        const int it = *slot;
        if (it >= 2048) break;
        if (it < 1024) { if (MASK & 64) sb_item(p, it, smem); }
        else { if (MASK & 512) lru_item(p, l, it - 1024, smem, 1); }
      }
    }
    xcd_barrier(xb);
    }
    for (int rep = 0; rep < REP_G; ++rep) {
    for (int half = 0; half < 4; ++half) {
      bf16_t* BH = (bf16_t*)(p.ws + OFF_P + 134217728);
      if (half == 0 && rep == 0) { if (MASK & 16) rwkv_post(p, l); xcd_barrier(xb); }
      if (MASK & 1024) { pg::Order<1> S; S.init(NTOK / 4, 4096, gridDim.x, blockIdx.x, 0, 0, 2, 512); pg::EpiBf16<0> E{BH, 4096, nullptr};
        pg::gemm_phase(lds, (const bf16_t*)(p.ws + OFF_O) + (size_t)half * 16384 * DM, DM, (const bf16_t*)(p.ws + OFF_WBR), 256, S, E); }
      xcd_barrier(xb);
      if (MASK & 1024) { pg::Order<4> S; S.init(NTOK / 4, 1024, gridDim.x, blockIdx.x, 0, 2097152); pg::EpiGateMix E{PB + (size_t)half * 16384 * DM, (float*)(p.ws + OFF_G), BH, p.in[I_BGATE] + (size_t)l * 4096};
        pg::gemm_phase(lds, H + (size_t)half * 16384 * DM, DM, (const bf16_t*)(p.ws + OFF_WG), 1024, S, E); }
      xcd_barrier(xb);
    }
    }
    if (MASK & 2048) { pg::Order<1> S; S.init(NTOK, 1024, gridDim.x, blockIdx.x); pg::EpiResid E{xcur, p.out, (const float*)(p.ws + OFF_MODP), p.in[I_BADA], l, 2048};
      pg::gemm_phase(lds, PB, DM, (const bf16_t*)(p.ws + OFF_WO), 1024, S, E); }
    xcd_barrier(xb);
    for (int rep = 0; rep < REP_MISC; ++rep) {
    if (MASK & 4096) phase_norm(p, p.out, p.in[I_N2G] + l * 1024, l, 4096, 3072, H, nullptr);
    xcd_barrier(xb);
    }
    for (int rep = 0; rep < REP_G; ++rep) {
    if (MASK & 8192) { pg::Order<1> S; S.init(NTOK, FFN, gridDim.x, blockIdx.x); pg::EpiBf16<0> E{PB, FFN, nullptr};
      pg::gemm_phase(lds, H, DM, (const bf16_t*)(p.ws + OFF_WF), 1024, S, E); }
    xcd_barrier(xb);
    if (MASK & 8192) { pg::Order<1> S; S.init(NTOK, FFN, gridDim.x, blockIdx.x); pg::EpiFfnAct E{PB + (size_t)NTOK * FFN, PB, p.in[I_FCW] + (size_t)l * 3 * FFN};
      pg::gemm_phase(lds, H, DM, (const bf16_t*)(p.ws + OFF_WF) + (size_t)FFN * 1024, 1024, S, E); }
    xcd_barrier(xb);
    }
    if (MASK & 32768) { pg::Order<1> S; S.init(NTOK, 1024, gridDim.x, blockIdx.x); pg::EpiResid E{p.out, p.out, (const float*)(p.ws + OFF_MODP), p.in[I_BADA], l, 5120};
      pg::gemm_phase(lds, PB + (size_t)NTOK * FFN, FFN, (const bf16_t*)(p.ws + OFF_WD), FFN, S, E); }
    xcd_barrier(xb);
  }
  if (MASK & 65536) phase_norm(p, p.out, p.in[I_FG], 0, 0, 0, nullptr, p.out);
}

extern "C" void kernel_launch(void* const* d_in, const int* in_sizes, int n_in,
                              void* d_out, int out_size, void* d_ws, size_t ws_size,
                              hipStream_t stream) {
  if (ws_size < WS_NEED || n_in < 38) { fprintf(stderr, "workspace too small: %zu < %zu\n", ws_size, (size_t)WS_NEED); return; }
  (void)hipFuncSetAttribute((const void*)mega, hipFuncAttributeMaxDynamicSharedMemorySize, SMEM_BYTES);
  int dev = 0, cus = 0, per_cu = 0;
  (void)hipGetDevice(&dev);
  (void)hipDeviceGetAttribute(&cus, hipDeviceAttributeMultiprocessorCount, dev);
  (void)hipOccupancyMaxActiveBlocksPerMultiprocessor(&per_cu, mega, NTHR, SMEM_BYTES);
  if (per_cu < 1 || cus < 1) { fprintf(stderr, "occupancy query failed (%d, %d)\n", per_cu, cus); return; }
  if (cus > 256) cus = 256;
  const int grid_blocks = cus;
  Params p{};
  for (int i = 0; i < 38; ++i) p.in[i] = (const float*)d_in[i];
  p.out = (float*)d_out; p.ws = (char*)d_ws;
  (void)hipMemsetAsync((char*)d_ws + OFF_BAR, 0, XCD_BAR_WORDS * 4, stream);
  void* args[] = {&p};
  hipError_t e = hipLaunchCooperativeKernel((void*)mega, dim3(grid_blocks), dim3(NTHR), args, SMEM_BYTES, stream);
  if (e != hipSuccess) fprintf(stderr, "cooperative launch failed: %s (grid %d)\n", hipGetErrorString(e), grid_blocks);
}
```

```cpp
#include <hip/hip_runtime.h>
#include <hip/hip_cooperative_groups.h>
#include <cstdio>
namespace cg = cooperative_groups;

typedef unsigned short bf16_t;
typedef short bf16x8 __attribute__((ext_vector_type(8)));
typedef short s16x4 __attribute__((ext_vector_type(4)));
typedef float f32x4 __attribute__((ext_vector_type(4)));
typedef float f32x16 __attribute__((ext_vector_type(16)));
typedef unsigned u32x4 __attribute__((ext_vector_type(4)));
#define DI __device__ __forceinline__

constexpr int NTOK = 65536, DM = 1024, SEQ = 4096, PSTR = 3328, FFN = 2816, AUS = 5632;
constexpr int C_LRU_X = 0, C_LRU_Y = 256, C_SB_Q = 512, C_SB_K = 768, C_SB_V = 1024;
constexpr int C_GDN_Q = 1280, C_GDN_Z = 2048, C_GDN_A = 2304, C_GDN_B = 2308, C_RW = 2312;
constexpr float EPSF = 1e-6f;
#ifndef MASK
#define MASK 0x1ffff
#endif
#ifndef REP_M1
#define REP_M1 1
#endif
#ifndef REP_M2
#define REP_M2 1
#endif
#ifndef REP_G
#define REP_G 1
#endif
#ifndef REP_MISC
#define REP_MISC 1
#endif
constexpr int NTHR = 512;
constexpr int SMEM_BYTES = 131072 + 64;

constexpr size_t OFF_MODP = 0;
constexpr size_t OFF_WIN = 6291456;
constexpr size_t OFF_WG = OFF_WIN + 6815744;
constexpr size_t OFF_WBR = OFF_WG + 8388608;
constexpr size_t OFF_WO = OFF_WBR + 2097152;
constexpr size_t OFF_WF = OFF_WO + 2097152;
constexpr size_t OFF_WD = OFF_WF + 11534336;
constexpr size_t OFF_H = OFF_WD + 5767168;
constexpr size_t OFF_P = OFF_H + 134217728;
constexpr size_t OFF_O = OFF_P + 436207616;
constexpr size_t OFF_G = OFF_O + 134217728;
constexpr size_t GSZ = 33554432;
constexpr size_t OFF_GCD = OFF_G + 5 * GSZ;
constexpr size_t OFF_L = OFF_GCD + 16384;
constexpr size_t LSZ = 67108864;
constexpr size_t OFF_LCA = OFF_L + 2 * LSZ;
constexpr size_t OFF_LCH = OFF_LCA + 2097152;
constexpr size_t OFF_BON = OFF_LCH + 2097152;
constexpr size_t OFF_CTR = OFF_BON + 1048576;
constexpr size_t OFF_BAR = OFF_CTR + 256;
constexpr size_t WS_NEED = OFF_BAR + 16384;

struct Params { const float* in[38]; float* out; char* ws; };
enum { I_X = 0, I_C, I_N1G, I_N2G, I_FG, I_WADA, I_BADA, I_WIN, I_LCW, I_LCB, I_LWR, I_LBR, I_LWI, I_LBI, I_LLAM,
       I_GCW, I_GAL, I_GDT, I_GNG, I_RMU, I_RW0, I_RWUP, I_RA0, I_RAUP, I_RGUP, I_RKK, I_RKA, I_RRK, I_RLG, I_RLB,
       I_WBR, I_WGATE, I_BGATE, I_WOUT, I_FWG, I_FWU, I_FCW, I_FWD };

DI float bf2f(bf16_t v) { return __uint_as_float(((unsigned)v) << 16); }
typedef __bf16 bf16n2 __attribute__((ext_vector_type(2)));
typedef float f32x2_ __attribute__((ext_vector_type(2)));
DI unsigned pack2(float lo, float hi) { f32x2_ v = {lo, hi}; bf16n2 b = __builtin_convertvector(v, bf16n2); return __builtin_bit_cast(unsigned, b); }
DI bf16_t f2bf(float x) { return (bf16_t)(pack2(x, x) & 0xffffu); }
DI float sigmoidf_(float x) { return __builtin_amdgcn_rcpf(1.f + __expf(-x)); }
DI float sigmoid_rcp(float x) { return __builtin_amdgcn_rcpf(1.f + __expf(-x)); }
DI float gelu_rcp(float x) { float u = 0.7978845608f * (x + 0.044715f * x * x * x); return x * __builtin_amdgcn_rcpf(1.f + __expf(-2.f * u)); }
DI float softplusf_(float x) { return fmaxf(x, 0.f) + __logf(1.f + __expf(-fabsf(x))); }
DI float siluf_(float x) { return x * __builtin_amdgcn_rcpf(1.f + __expf(-x)); }
DI float geluf_(float x) { float u = 0.7978845608f * (x + 0.044715f * x * x * x); return x * __builtin_amdgcn_rcpf(1.f + __expf(-2.f * u)); }
DI float tanhf_(float x) { return 1.f - 2.f * __builtin_amdgcn_rcpf(1.f + __expf(2.f * x)); }
DI float wave_sum(float x) {
#pragma unroll
  for (int o = 32; o >= 1; o >>= 1) x += __shfl_xor(x, o);
  return x;
}
template <int CTRL> DI float dppf(float x) { return __int_as_float(__builtin_amdgcn_update_dpp(0, __float_as_int(x), CTRL, 0xf, 0xf, true)); }
DI float reduce8(float x) { x += dppf<0xB1>(x); x += dppf<0x4E>(x); x += dppf<0x141>(x); return x; }
DI f32x16 mfma32(bf16x8 a, bf16x8 b, f32x16 c) { return __builtin_amdgcn_mfma_f32_32x32x16_bf16(a, b, c, 0, 0, 0); }
DI f32x4 mfma16(bf16x8 a, bf16x8 b, f32x4 c) { return __builtin_amdgcn_mfma_f32_16x16x32_bf16(a, b, c, 0, 0, 0); }
DI int crow(int i, int h) { return (i & 3) + 8 * (i >> 2) + 4 * h; }

DI float modv(const float* modp, const float* bada, int l, int b, int idx) {
  const float* q = modp + ((size_t)(l * 16 + b)) * 6144 + idx;
  const size_t ks = (size_t)4 * 16 * 6144;
  return bada[l * 6144 + idx] + q[0] + q[ks] + q[2 * ks] + q[3 * ks];
}

DI int otid() { int t = threadIdx.x; asm volatile("" : "+v"(t)); return t; }
DI int obid() { int b = blockIdx.x; asm volatile("" : "+s"(b)); return b; }
DI void phase_mod(const Params& p, char* smem) {
  float* sm = (float*)smem;
  float* modp = (float*)(p.ws + OFF_MODP);
  const int tid = otid();
  if (obid() == 0 && tid < 64) ((unsigned*)(p.ws + OFF_CTR))[tid] = 0u;
  for (int item = obid(); item < 192; item += gridDim.x) {
    const int l = item / 48, rem = item % 48, jb = rem >> 2, kq = rem & 3;
    for (int i = 0; i < 8; ++i) {
      int e = tid + 512 * i; int b = e >> 8, k = e & 255;
      float cv = p.in[I_C][b * 1024 + kq * 256 + k];
      sm[e] = siluf_(cv);
    }
    __syncthreads();
    float acc[16];
#pragma unroll
    for (int b = 0; b < 16; ++b) acc[b] = 0.f;
    const float* wp = p.in[I_WADA] + ((size_t)l * 1024 + kq * 256) * 6144 + jb * 512 + tid;
    for (int k = 0; k < 256; k += 4) {
      float w0 = wp[(size_t)k * 6144], w1 = wp[(size_t)(k + 1) * 6144], w2 = wp[(size_t)(k + 2) * 6144], w3 = wp[(size_t)(k + 3) * 6144];
#pragma unroll
      for (int b = 0; b < 16; ++b) {
        f32x4 cv = *(const f32x4*)(sm + b * 256 + k);
        acc[b] += cv[0] * w0 + cv[1] * w1 + cv[2] * w2 + cv[3] * w3;
      }
    }
#pragma unroll
    for (int b = 0; b < 16; ++b) modp[((size_t)((kq * 4 + l) * 16 + b)) * 6144 + jb * 512 + tid] = acc[b];
    __syncthreads();
  }
}

DI void conv_tile(const float* src, bf16_t* dst, int K, int N, int k0, int n0, char* smem) {
  float* tile = (float*)smem;
  const int tid = otid();
#pragma unroll
  for (int it = 0; it < 2; ++it) {
    int kr = (tid >> 4) + 32 * it, nc = (tid & 15) * 4;
    f32x4 v = {0.f, 0.f, 0.f, 0.f};
    if (n0 + nc < N) v = *(const f32x4*)(src + (size_t)(k0 + kr) * N + n0 + nc);
    tile[kr * 65 + nc] = v[0]; tile[kr * 65 + nc + 1] = v[1]; tile[kr * 65 + nc + 2] = v[2]; tile[kr * 65 + nc + 3] = v[3];
  }
  __syncthreads();
  {
    int n = tid >> 3, kc = (tid & 7) * 8;
    unsigned o[4];
#pragma unroll
    for (int e = 0; e < 4; ++e) o[e] = pack2(tile[(kc + 2 * e) * 65 + n], tile[(kc + 2 * e + 1) * 65 + n]);
    uint4 ov = {o[0], o[1], o[2], o[3]};
    *(uint4*)(dst + (size_t)(n0 + n) * K + k0 + kc) = ov;
  }
  __syncthreads();
}

DI void phase_convert(const Params& p, int l, char* smem) {
  for (int t = obid(); t < 4480; t += gridDim.x) {
    const float* src; bf16_t* dst; int K, N, Npad, tt = t;
    if (tt < 832) { src = p.in[I_WIN] + (size_t)l * 1024 * 3208; dst = (bf16_t*)(p.ws + OFF_WIN); K = 1024; N = 3208; Npad = 3328; }
    else if ((tt -= 832) < 1024) { int br = tt >> 8; tt &= 255; src = p.in[I_WGATE] + ((size_t)l * 4 + br) * 1048576; dst = (bf16_t*)(p.ws + OFF_WG) + (size_t)br * 1048576; K = 1024; N = 1024; Npad = 1024; }
    else if ((tt -= 1024) < 256) { int br = tt >> 6; tt &= 63; src = p.in[I_WBR] + ((size_t)l * 4 + br) * 262144; dst = (bf16_t*)(p.ws + OFF_WBR) + (size_t)br * 262144; K = 256; N = 1024; Npad = 1024; }
    else if ((tt -= 256) < 256) { src = p.in[I_WOUT] + (size_t)l * 1048576; dst = (bf16_t*)(p.ws + OFF_WO); K = 1024; N = 1024; Npad = 1024; }
    else if ((tt -= 256) < 704) { src = p.in[I_FWG] + (size_t)l * 1024 * 2816; dst = (bf16_t*)(p.ws + OFF_WF); K = 1024; N = 2816; Npad = 2816; }
    else if ((tt -= 704) < 704) { src = p.in[I_FWU] + (size_t)l * 1024 * 2816; dst = (bf16_t*)(p.ws + OFF_WF) + (size_t)2816 * 1024; K = 1024; N = 2816; Npad = 2816; }
    else { tt -= 704; src = p.in[I_FWD] + (size_t)l * 2816 * 1024; dst = (bf16_t*)(p.ws + OFF_WD); K = 2816; N = 1024; Npad = 1024; }
    const int nNt = Npad >> 6;
    const int kt = tt / nNt, nt = tt % nNt;
    conv_tile(src, dst, K, N, kt * 64, nt * 64, smem);
  }
}

DI void phase_norm(const Params& p, const float* xin, const float* g, int l, int scale_idx, int shift_idx, bf16_t* hout, float* fout) {
  const float* modp = (const float*)(p.ws + OFF_MODP);
  const int lane = otid() & 63, wv = otid() >> 6;
  const int nw = gridDim.x * 8;
  const int rows_per = 32;
  for (int chunk = obid() * 8 + wv; chunk < NTOK / 32; chunk += nw) {
  const int row0 = chunk * rows_per;
  const int b = row0 / SEQ;
  f32x4 gv[4], sc[4], sh[4];
#pragma unroll
  for (int j = 0; j < 4; ++j) {
    int c = lane * 4 + 256 * j;
    gv[j] = *(const f32x4*)(g + c);
    if (hout) {
#pragma unroll
      for (int e = 0; e < 4; ++e) {
        sc[j][e] = 1.f + modv(modp, p.in[I_BADA], l, b, scale_idx + c + e);
        sh[j][e] = modv(modp, p.in[I_BADA], l, b, shift_idx + c + e);
      }
    }
  }
  for (int rr = 0; rr < rows_per; ++rr) {
    const size_t row = (size_t)row0 + rr;
    f32x4 xv[4]; float ss = 0.f;
#pragma unroll
    for (int j = 0; j < 4; ++j) {
      xv[j] = *(const f32x4*)(xin + row * DM + lane * 4 + 256 * j);
      ss += xv[j][0] * xv[j][0] + xv[j][1] * xv[j][1] + xv[j][2] * xv[j][2] + xv[j][3] * xv[j][3];
    }
    ss = wave_sum(ss);
    const float rs = rsqrtf(ss * (1.f / 1024.f) + EPSF);
#pragma unroll
    for (int j = 0; j < 4; ++j) {
      f32x4 y = xv[j] * rs * gv[j];
      if (hout) {
        y = y * sc[j] + sh[j];
        uint2 o = {pack2(y[0], y[1]), pack2(y[2], y[3])};
        *(uint2*)(hout + row * DM + lane * 4 + 256 * j) = o;
      } else {
        *(f32x4*)(fout + row * DM + lane * 4 + 256 * j) = y;
      }
    }
  }
  }
}

#define PG_LAS __attribute__((address_space(3)))
namespace pg {
constexpr int BM = 256, BK = 64, HALF = 128, HTB = HALF * BK * 2, NXCD = 8, WGM = 8;
DI int lds_byte(int r, int c) { const int st = (r >> 4) * 2 + (c >> 5), rr = r & 15, cc = c & 31, ob = rr * 64 + cc * 2; return st * 1024 + (ob ^ (((ob >> 9) & 1) << 5)); }
DI void stage_rc(int b, int& R, int& C) { const int st = b / 1024, sb = b % 1024, swz = sb ^ (((sb >> 9) & 1) << 5); R = (st >> 1) * 16 + swz / 64; C = (st & 1) * 32 + (swz % 64) / 2; }
DI int perm32(int rho) { const int n = rho >> 4, i = rho & 15; return 8 * (i >> 2) + 4 * n + (i & 3); }
struct Unit { int pm, pn; int aux; long ao, bo; };
template <int REP> struct Order {
  int nM, nN, nwg, G, c, ashift; long astep, bstep, apnstep;
  DI void init(int M, int N, int G_, int c_, long astep_ = 0, long bstep_ = 0, int ashift_ = 0, long apnstep_ = 0) {
    nM = M / BM; nN = N / BM; nwg = nM * nN; G = G_; c = c_; astep = astep_; bstep = bstep_; ashift = ashift_; apnstep = apnstep_; }
  DI bool next(int i, Unit& u) const {
    const int ti = i / REP, aux = i % REP;
    const long L = (long)ti * G + c; if (L >= nwg) return false;
    int wgid = (int)L; { const int q = nwg / NXCD, r = nwg % NXCD, xcd = wgid % NXCD, off = wgid / NXCD; wgid = (xcd < r ? xcd * (q + 1) : r * (q + 1) + (xcd - r) * q) + off; }
    const int nig = WGM * nN, gid = wgid / nig, fm = gid * WGM, gsz = (nM - fm) < WGM ? (nM - fm) : WGM;
    u.pm = fm + ((wgid % nig) % gsz); u.pn = (wgid % nig) / gsz; u.aux = aux; u.ao = aux * astep + (long)(u.pn >> ashift) * apnstep; u.bo = aux * bstep; return true;
  }
};
DI unsigned cvt_pk_bf16(float lo, float hi) { return pack2(lo, hi); }

template <class Epi, class Sched>
DI void gemm_phase(PG_LAS unsigned char* lds, const bf16_t* Ag, int lda, const bf16_t* Bg, int K, const Sched& S, const Epi& E) {
  const int tid = otid(), wid = __builtin_amdgcn_readfirstlane(tid >> 6), lane = tid & 63, wr = wid >> 2, wc = wid & 3, fr = lane & 15, fq = lane >> 4;
  const int nt = K / BK;
  unsigned voffA[2], voffB[2];
#pragma unroll
  for (int i = 0; i < 2; ++i) { int R, C; stage_rc(tid * 16 + i * 8192, R, C); const int Rb = Epi::PERM ? ((R & ~31) + perm32(R & 31)) : R;
    voffA[i] = (unsigned)(R * lda + C) * 2u; voffB[i] = (unsigned)(Rb * K + C) * 2u; }
  const size_t kstep = (size_t)(BK * 2);
  const size_t hstepA = (size_t)HALF * lda * 2, hstepB = (size_t)HALF * K * 2;
  const size_t tstepA = 2 * hstepA, tstepB = 2 * hstepB;
  const unsigned ldsw = (unsigned)wid * 1024u;
  const int aoff = lds_byte(wr * 64 + fr, fq * 8), boff = lds_byte(wc * 32 + fr, fq * 8);
#define PG_SA(b, h) (((b) * 2 + (h)) * HTB)
#define PG_SB(b, h) ((4 + (b) * 2 + (h)) * HTB)
#define PG_STAGE(bufoff, gbase, voff) do { _Pragma("unroll") for (int _i = 0; _i < 2; ++_i) \
    __builtin_amdgcn_global_load_lds((const unsigned*)((const char*)(gbase) + (voff)[_i]), (PG_LAS unsigned*)(lds + (bufoff) + ldsw + _i * 8192), 16, 0, 0); } while (0)
#define PG_LDA(dst, b, h) do { _Pragma("unroll") for (int m = 0; m < 4; ++m) _Pragma("unroll") for (int k = 0; k < 2; ++k) dst[m][k] = *(const PG_LAS bf16x8*)(lds + PG_SA(b, h) + aoff + m * 2048 + k * 1024); } while (0)
#define PG_LDB(dst, b, h) do { _Pragma("unroll") for (int n = 0; n < 2; ++n) _Pragma("unroll") for (int k = 0; k < 2; ++k) dst[n][k] = *(const PG_LAS bf16x8*)(lds + PG_SB(b, h) + boff + n * 2048 + k * 1024); } while (0)
#define PG_MMA(ai, bj, At, Bt) do { __builtin_amdgcn_s_setprio(1); _Pragma("unroll") for (int m = 0; m < 4; ++m) _Pragma("unroll") for (int n = 0; n < 2; ++n) _Pragma("unroll") for (int k = 0; k < 2; ++k) \
    acc[ai][bj][m][n] = __builtin_amdgcn_mfma_f32_16x16x32_bf16(Bt[n][k], At[m][k], acc[ai][bj][m][n], 0, 0, 0); __builtin_amdgcn_s_setprio(0); } while (0)
#define PG_WAIT_V(n) asm volatile("s_waitcnt vmcnt(" #n ")" ::: "memory")
#define PG_WAIT_L(n) asm volatile("s_waitcnt lgkmcnt(" #n ")" ::: "memory")
#define PG_BAR __builtin_amdgcn_s_barrier()
#define PG_SCHED __builtin_amdgcn_sched_barrier(0)
  Unit cur, nxt; int ui = 0;
  if (!S.next(0, cur)) return;
  f32x4 acc[2][2][4][2];
#pragma unroll
  for (int a = 0; a < 2; ++a)
#pragma unroll
    for (int b = 0; b < 2; ++b)
#pragma unroll
      for (int m = 0; m < 4; ++m)
#pragma unroll
        for (int n = 0; n < 2; ++n) acc[a][b][m][n] = (f32x4){0.f, 0.f, 0.f, 0.f};
  bf16x8 At[4][2], B0[2][2], B1[2][2];
  const char* cA = (const char*)Ag + (size_t)cur.pm * tstepA + cur.ao; const char* cB = (const char*)Bg + (size_t)cur.pn * tstepB + cur.bo;
  PG_STAGE(PG_SB(0, 0), cB, voffB); PG_STAGE(PG_SA(0, 0), cA, voffA); PG_STAGE(PG_SB(0, 1), cB + hstepB, voffB); PG_STAGE(PG_SA(0, 1), cA + hstepA, voffA);
  if (wr == 1) PG_BAR;
  PG_WAIT_V(4); PG_BAR;
  PG_STAGE(PG_SB(1, 0), cB + kstep, voffB); PG_STAGE(PG_SA(1, 0), cA + kstep, voffA); PG_STAGE(PG_SB(1, 1), cB + hstepB + kstep, voffB);
  PG_WAIT_V(6); PG_BAR;
  for (;;) {
    const bool has_next = S.next(ui + 1, nxt);
    const char* nA = has_next ? (const char*)Ag + (size_t)nxt.pm * tstepA + nxt.ao : cA; const char* nB = has_next ? (const char*)Bg + (size_t)nxt.pn * tstepB + nxt.bo : cB;
#pragma unroll 1
    for (int t = 0; t < nt; t += 2) {
      const bool last = (t == nt - 2);
      const char* a1 = cA + (size_t)(t + 1) * kstep;
      const char* a2 = last ? nA : cA + (size_t)(t + 2) * kstep; const char* b2 = last ? nB : cB + (size_t)(t + 2) * kstep;
      const char* a3 = a2 + kstep; const char* b3 = b2 + kstep;
      PG_LDB(B0, 0, 0); PG_SCHED; PG_LDA(At, 0, 0); PG_STAGE(PG_SA(1, 1), a1 + hstepA, voffA);
      PG_WAIT_L(8); PG_BAR; PG_WAIT_L(0); PG_MMA(0, 0, At, B0); PG_BAR; PG_SCHED;
      PG_LDB(B1, 0, 1); PG_STAGE(PG_SB(0, 0), b2, voffB);
      PG_BAR; PG_WAIT_L(0); PG_MMA(0, 1, At, B1); PG_BAR;
      PG_LDA(At, 0, 1); PG_STAGE(PG_SA(0, 0), a2, voffA);
      PG_BAR; PG_WAIT_L(0); PG_MMA(1, 0, At, B0); PG_BAR; PG_SCHED;
      PG_STAGE(PG_SB(0, 1), b2 + hstepB, voffB);
      PG_WAIT_V(6); PG_BAR; PG_MMA(1, 1, At, B1); PG_BAR;
      PG_LDB(B0, 1, 0); PG_SCHED; PG_LDA(At, 1, 0); PG_STAGE(PG_SA(0, 1), a2 + hstepA, voffA);
      PG_WAIT_L(8); PG_BAR; PG_WAIT_L(0); PG_MMA(0, 0, At, B0); PG_BAR; PG_SCHED;
      PG_LDB(B1, 1, 1); PG_STAGE(PG_SB(1, 0), b3, voffB);
      PG_BAR; PG_WAIT_L(0); PG_MMA(0, 1, At, B1); PG_BAR;
      PG_LDA(At, 1, 1); PG_STAGE(PG_SA(1, 0), a3, voffA);
      PG_BAR; PG_WAIT_L(0); PG_MMA(1, 0, At, B0); PG_BAR; PG_SCHED;
      PG_STAGE(PG_SB(1, 1), b3 + hstepB, voffB);
      PG_WAIT_V(6); PG_BAR; PG_MMA(1, 1, At, B1); PG_BAR;
    }
    E(acc, cur, wr, wc, fr, fq);
    if (!has_next) break;
#pragma unroll
    for (int a = 0; a < 2; ++a)
#pragma unroll
      for (int b = 0; b < 2; ++b)
#pragma unroll
        for (int m = 0; m < 4; ++m)
#pragma unroll
          for (int n = 0; n < 2; ++n) acc[a][b][m][n] = (f32x4){0.f, 0.f, 0.f, 0.f};
    cur = nxt; cA = nA; cB = nB; ++ui;
  }
  PG_WAIT_V(0);
  if (wr == 0) PG_BAR;
  PG_BAR;
#undef PG_SA
#undef PG_SB
#undef PG_STAGE
#undef PG_LDA
#undef PG_LDB
#undef PG_MMA
#undef PG_WAIT_V
#undef PG_WAIT_L
#undef PG_BAR
#undef PG_SCHED
}

template <int ACT> struct EpiBf16 {
  static constexpr bool PERM = true;
  bf16_t* O; int ldc; const float* bias;
  DI void operator()(const f32x4 (&acc)[2][2][4][2], const Unit& u, int wr, int wc, int fr, int fq) const {
    const int row0 = u.pm * BM + wr * 64 + fr, col0 = u.pn * BM + wc * 32 + 8 * fq;
    f32x4 bv[2][2];
#pragma unroll
    for (int bj = 0; bj < 2; ++bj)
#pragma unroll
      for (int n = 0; n < 2; ++n) bv[bj][n] = ACT ? *(const f32x4*)(bias + col0 + bj * HALF + 4 * n) : (f32x4){0.f, 0.f, 0.f, 0.f};
#pragma unroll
    for (int ai = 0; ai < 2; ++ai)
#pragma unroll
      for (int m = 0; m < 4; ++m) { bf16_t* rowp = O + (size_t)(row0 + ai * HALF + m * 16) * ldc + col0;
#pragma unroll
        for (int bj = 0; bj < 2; ++bj) { f32x4 v0 = acc[ai][bj][m][0], v1 = acc[ai][bj][m][1];
          if (ACT) { v0 += bv[bj][0]; v1 += bv[bj][1];
#pragma unroll
            for (int j = 0; j < 4; ++j) { v0[j] = sigmoid_rcp(v0[j]); v1[j] = sigmoid_rcp(v1[j]); } }
          u32x4 w; w.x = cvt_pk_bf16(v0[0], v0[1]); w.y = cvt_pk_bf16(v0[2], v0[3]); w.z = cvt_pk_bf16(v1[0], v1[1]); w.w = cvt_pk_bf16(v1[2], v1[3]);
          *(u32x4*)(rowp + bj * HALF) = w; } }
  }
};
struct EpiBranch {
  static constexpr bool PERM = true;
  bf16_t* MIX; const bf16_t* G;
  DI void operator()(const f32x4 (&acc)[2][2][4][2], const Unit& u, int wr, int wc, int fr, int fq) const {
    const int row0 = u.pm * BM + wr * 64 + fr, col0 = u.pn * BM + wc * 32 + 8 * fq;
#pragma unroll
    for (int ai = 0; ai < 2; ++ai)
#pragma unroll
      for (int m = 0; m < 4; ++m) {
        asm volatile("" ::: "memory");
        const size_t row = (size_t)(row0 + ai * HALF + m * 16);
        bf16_t* mp = MIX + row * DM + col0; const bf16_t* gp = G + row * 4096 + u.aux * 1024 + col0;
#pragma unroll
        for (int bj = 0; bj < 2; ++bj) {
          const bf16x8 gv = *(const bf16x8*)(gp + bj * HALF);
          float o[8];
#pragma unroll
          for (int j = 0; j < 4; ++j) { o[j] = bf2f((bf16_t)gv[j]) * acc[ai][bj][m][0][j]; o[4 + j] = bf2f((bf16_t)gv[4 + j]) * acc[ai][bj][m][1][j]; }
          if (u.aux > 0) {
            const bf16x8 mv = *(const bf16x8*)(mp + bj * HALF);
#pragma unroll
            for (int j = 0; j < 8; ++j) o[j] += bf2f((bf16_t)mv[j]);
          }
          u32x4 w; w.x = cvt_pk_bf16(o[0], o[1]); w.y = cvt_pk_bf16(o[2], o[3]); w.z = cvt_pk_bf16(o[4], o[5]); w.w = cvt_pk_bf16(o[6], o[7]);
          *(u32x4*)(mp + bj * HALF) = w;
        }
      }
  }
};
struct EpiResid {
  static constexpr bool PERM = false;
  const float* xold; float* xnew; const float* modp; const float* bada; int l, gate_idx;
  DI void operator()(const f32x4 (&acc)[2][2][4][2], const Unit& u, int wr, int wc, int fr, int fq) const {
    const int row0 = u.pm * BM + wr * 64 + fr, col0 = u.pn * BM + wc * 32 + 4 * fq;
    const int b = (u.pm * BM) / SEQ;
    f32x4 gv[2][2];
#pragma unroll
    for (int bj = 0; bj < 2; ++bj)
#pragma unroll
      for (int n = 0; n < 2; ++n)
#pragma unroll
        for (int j = 0; j < 4; ++j) gv[bj][n][j] = modv(modp, bada, l, b, gate_idx + col0 + bj * HALF + n * 16 + j);
#pragma unroll
    for (int ai = 0; ai < 2; ++ai)
#pragma unroll
      for (int m = 0; m < 4; ++m) { const size_t ro = (size_t)(row0 + ai * HALF + m * 16) * DM + col0;
#pragma unroll
        for (int bj = 0; bj < 2; ++bj)
#pragma unroll
          for (int n = 0; n < 2; ++n) {
            const f32x4 xo = *(const f32x4*)(xold + ro + bj * HALF + n * 16);
            *(f32x4*)(xnew + ro + bj * HALF + n * 16) = xo + gv[bj][n] * acc[ai][bj][m][n];
          } }
  }
};
struct EpiFfnAct {
  static constexpr bool PERM = true;
  bf16_t* ACT; const bf16_t* APRE; const float* cw;
  DI void operator()(const f32x4 (&acc)[2][2][4][2], const Unit& u, int wr, int wc, int fr, int fq) const {
    const int row0 = u.pm * BM + wr * 64 + fr, col0 = u.pn * BM + wc * 32 + 8 * fq;
#pragma unroll
    for (int ai = 0; ai < 2; ++ai)
#pragma unroll
      for (int m = 0; m < 4; ++m) {
        asm volatile("" ::: "memory");
        const int row = row0 + ai * HALF + m * 16; const int sp = row & (SEQ - 1);
        const bf16_t* ap = APRE + (size_t)row * FFN + col0;
        bf16_t* op = ACT + (size_t)row * FFN + col0;
#pragma unroll
        for (int bj = 0; bj < 2; ++bj) {
          const int c = bj * HALF;
          const bf16x8 z8 = {0, 0, 0, 0, 0, 0, 0, 0};
          const bf16x8 a0 = *(const bf16x8*)(ap + c);
          const bf16x8 a1 = sp >= 1 ? *(const bf16x8*)(ap - FFN + c) : z8;
          const bf16x8 a2 = sp >= 2 ? *(const bf16x8*)(ap - 2 * FFN + c) : z8;
          float o[8];
#pragma unroll
          for (int hh = 0; hh < 2; ++hh) {
            const f32x4 w0 = *(const f32x4*)(cw + col0 + c + 4 * hh), w1 = *(const f32x4*)(cw + FFN + col0 + c + 4 * hh), w2 = *(const f32x4*)(cw + 2 * FFN + col0 + c + 4 * hh);
#pragma unroll
            for (int j = 0; j < 4; ++j) {
              const float cv = w0[j] * bf2f((bf16_t)a2[4 * hh + j]) + w1[j] * bf2f((bf16_t)a1[4 * hh + j]) + w2[j] * bf2f((bf16_t)a0[4 * hh + j]);
              o[4 * hh + j] = gelu_rcp(cv) * acc[ai][bj][m][hh][j];
            }
          }
          u32x4 w; w.x = cvt_pk_bf16(o[0], o[1]); w.y = cvt_pk_bf16(o[2], o[3]); w.z = cvt_pk_bf16(o[4], o[5]); w.w = cvt_pk_bf16(o[6], o[7]);
          *(u32x4*)(op + c) = w;
        }
      }
  }
};
struct EpiGateMix {
  static constexpr bool PERM = true;
  bf16_t* MIX; float* MIX32; const bf16_t* BH; const float* bias;
  DI void operator()(const f32x4 (&acc)[2][2][4][2], const Unit& u, int wr, int wc, int fr, int fq) const {
    const int row0 = u.pm * BM + wr * 64 + fr, col0 = u.pn * BM + wc * 32 + 8 * fq;
    const bool rmw = u.aux > 0, fin = u.aux == 3;
    f32x4 bv[2][2];
#pragma unroll
    for (int bj = 0; bj < 2; ++bj)
#pragma unroll
      for (int n = 0; n < 2; ++n) bv[bj][n] = *(const f32x4*)(bias + u.aux * 1024 + col0 + bj * HALF + 4 * n);
    const f32x4 z4 = {0.f, 0.f, 0.f, 0.f};
    bf16x8 nb[2]; f32x4 nm[2][2];
#define GM_LOAD(it_) { const size_t row_ = (size_t)(row0 + ((it_) >> 2) * HALF + ((it_) & 3) * 16); \
      _Pragma("unroll") for (int bj = 0; bj < 2; ++bj) { nb[bj] = *(const bf16x8*)(BH + row_ * 4096 + u.aux * 1024 + col0 + bj * HALF); \
        nm[bj][0] = rmw ? *(const f32x4*)(MIX32 + row_ * DM + col0 + bj * HALF) : z4; nm[bj][1] = rmw ? *(const f32x4*)(MIX32 + row_ * DM + col0 + bj * HALF + 4) : z4; } }
    GM_LOAD(0);
#pragma unroll
    for (int it = 0; it < 8; ++it) {
      const int ai = it >> 2, m = it & 3;
      bf16x8 cb[2]; f32x4 cm[2][2];
#pragma unroll
      for (int bj = 0; bj < 2; ++bj) { cb[bj] = nb[bj]; cm[bj][0] = nm[bj][0]; cm[bj][1] = nm[bj][1]; }
      if (it + 1 < 8) GM_LOAD(it + 1);
      const size_t ro = (size_t)(row0 + ai * HALF + m * 16) * DM + col0;
#pragma unroll
      for (int bj = 0; bj < 2; ++bj) {
        f32x4 o[2];
#pragma unroll
        for (int hh = 0; hh < 2; ++hh)
#pragma unroll
          for (int j = 0; j < 4; ++j)
            o[hh][j] = sigmoid_rcp(acc[ai][bj][m][hh][j] + bv[bj][hh][j]) * bf2f((bf16_t)cb[bj][4 * hh + j]) + cm[bj][hh][j];
        if (fin) {
          u32x4 w; w.x = cvt_pk_bf16(o[0][0], o[0][1]); w.y = cvt_pk_bf16(o[0][2], o[0][3]); w.z = cvt_pk_bf16(o[1][0], o[1][1]); w.w = cvt_pk_bf16(o[1][2], o[1][3]);
          *(u32x4*)(MIX + ro + bj * HALF) = w;
        } else {
          *(f32x4*)(MIX32 + ro + bj * HALF) = o[0]; *(f32x4*)(MIX32 + ro + bj * HALF + 4) = o[1];
        }
      }
    }
#undef GM_LOAD
  }
};
}

DI void phase_ffn_act(const Params& p, int l) {
  bf16_t* AU = (bf16_t*)(p.ws + OFF_P);
  const float* cw = p.in[I_FCW] + (size_t)l * 3 * FFN;
  const int nthr = gridDim.x * NTHR;
  for (int run = obid() * NTHR + otid(); run < 1024 * 352; run += nthr) {
    const int ch = run / 352, j8 = run % 352, j0 = j8 * 8;
    float w0[8], w1[8], w2[8];
#pragma unroll
    for (int e = 0; e < 8; ++e) { w0[e] = cw[j0 + e]; w1[e] = cw[FFN + j0 + e]; w2[e] = cw[2 * FFN + j0 + e]; }
    const int t0 = ch * 64, s0 = t0 % SEQ;
    float a1[8], a2[8];
#pragma unroll
    for (int e = 0; e < 8; ++e) { a1[e] = 0.f; a2[e] = 0.f; }
    if (s0 > 0) {
      bf16x8 v1 = *(const bf16x8*)(AU + (size_t)(t0 - 1) * AUS + j0);
      bf16x8 v2 = *(const bf16x8*)(AU + (size_t)(t0 - 2) * AUS + j0);
#pragma unroll
      for (int e = 0; e < 8; ++e) { a1[e] = bf2f((bf16_t)v1[e]); a2[e] = bf2f((bf16_t)v2[e]); }
    }
    for (int t = t0; t < t0 + 64; ++t) {
      bf16x8 va = *(const bf16x8*)(AU + (size_t)t * AUS + j0);
      bf16x8 vu = *(const bf16x8*)(AU + (size_t)t * AUS + FFN + j0);
      float o[8];
#pragma unroll
      for (int e = 0; e < 8; ++e) {
        float a0 = bf2f((bf16_t)va[e]);
        float cv = w0[e] * a2[e] + w1[e] * a1[e] + w2[e] * a0;
        o[e] = geluf_(cv) * bf2f((bf16_t)vu[e]);
        a2[e] = a1[e]; a1[e] = a0;
      }
      uint4 ov = {pack2(o[0], o[1]), pack2(o[2], o[3]), pack2(o[4], o[5]), pack2(o[6], o[7])};
      *(uint4*)(AU + (size_t)t * AUS + FFN + j0) = ov;
    }
  }
}

DI float mixf(bf16_t cur, bf16_t prev, float mu) { const float c = bf2f(cur); return c + (bf2f(prev) - c) * mu; }
DI void rw_prep_item(const Params& p, int l, int item, char* smem) {
  const bf16_t* P = (const bf16_t*)(p.ws + OFF_P);
  bf16_t* RD = (bf16_t*)(p.ws + OFF_L);
  bf16_t* RKK = (bf16_t*)(p.ws + OFF_L + GSZ);
  bf16_t* RA = (bf16_t*)(p.ws + OFF_L + 2 * GSZ);
  bf16_t* RG = (bf16_t*)(p.ws + OFF_L + 3 * GSZ);
  float* BON = (float*)(p.ws + OFF_BON);
  const int b = item >> 6, ct = item & 63;
  const int tid = otid(), lane = tid & 63, wv = tid >> 6, hd = wv & 3, mi = wv >> 2, r = lane & 31, h = lane >> 5;
  bf16_t* TX = (bf16_t*)smem;
  bf16_t* XA = TX + 64 * 40;
  bf16_t* SG = XA + 64 * 40;
  const float* mu = p.in[I_RMU] + (size_t)l * 896;
  const size_t tok0 = (size_t)b * SEQ + ct * 64;
  bf16x8 bw[2][2], ba[2][2], bg[2][4];
  {
    const float* wp = p.in[I_RWUP] + (size_t)l * 32 * 256 + hd * 64 + r;
    const float* ap = p.in[I_RAUP] + (size_t)l * 32 * 256 + hd * 64 + r;
    const float* gp = p.in[I_RGUP] + (size_t)l * 64 * 256 + hd * 64 + r;
    asm volatile("" : "+v"(wp), "+v"(ap), "+v"(gp));
#pragma unroll
    for (int ni = 0; ni < 2; ++ni) {
#pragma unroll
      for (int ks = 0; ks < 2; ++ks) {
        unsigned uw[4], ua[4];
#pragma unroll
        for (int j2 = 0; j2 < 4; ++j2) {
          const int k = 16 * ks + 8 * h + 2 * j2;
          uw[j2] = pack2(wp[k * 256 + 32 * ni], wp[(k + 1) * 256 + 32 * ni]);
          ua[j2] = pack2(ap[k * 256 + 32 * ni], ap[(k + 1) * 256 + 32 * ni]);
        }
        uint4 t1 = {uw[0], uw[1], uw[2], uw[3]}, t2 = {ua[0], ua[1], ua[2], ua[3]};
        bw[ni][ks] = __builtin_bit_cast(bf16x8, t1); ba[ni][ks] = __builtin_bit_cast(bf16x8, t2);
      }
#pragma unroll
      for (int ks = 0; ks < 4; ++ks) {
        unsigned ug[4];
#pragma unroll
        for (int j2 = 0; j2 < 4; ++j2) { const int k = 16 * ks + 8 * h + 2 * j2; ug[j2] = pack2(gp[k * 256 + 32 * ni], gp[(k + 1) * 256 + 32 * ni]); }
        uint4 t3 = {ug[0], ug[1], ug[2], ug[3]};
        bg[ni][ks] = __builtin_bit_cast(bf16x8, t3);
      }
    }
  }
#pragma unroll 4
  for (int i = 0; i < 16; ++i) {
    const int e = tid + NTHR * i; const int t = e >> 7, f = e & 127;
    const bf16_t* pr = P + (tok0 + t) * PSTR + C_RW + 768 + f;
    const bf16_t cur = pr[0];
    const bf16_t prev = (ct * 64 + t > 0) ? (pr - PSTR)[0] : (bf16_t)0;
    const float m = mixf(cur, prev, mu[768 + f]);
    if (f < 32) TX[t * 40 + f] = f2bf(tanhf_(m));
    else if (f < 64) XA[t * 40 + f - 32] = f2bf(m);
    else SG[t * 72 + f - 64] = f2bf(sigmoidf_(m));
  }
  __syncthreads();
  f32x16 cw[2], ca[2], cg[2];
#pragma unroll
  for (int ni = 0; ni < 2; ++ni)
#pragma unroll
    for (int i = 0; i < 16; ++i) { cw[ni][i] = 0.f; ca[ni][i] = 0.f; cg[ni][i] = 0.f; }
#pragma unroll
  for (int ks = 0; ks < 2; ++ks) {
    const bf16x8 atx = *(const bf16x8*)(TX + (32 * mi + r) * 40 + 16 * ks + 8 * h);
    const bf16x8 axa = *(const bf16x8*)(XA + (32 * mi + r) * 40 + 16 * ks + 8 * h);
#pragma unroll
    for (int ni = 0; ni < 2; ++ni) { cw[ni] = mfma32(atx, bw[ni][ks], cw[ni]); ca[ni] = mfma32(axa, ba[ni][ks], ca[ni]); }
  }
#pragma unroll
  for (int ks = 0; ks < 4; ++ks) {
    const bf16x8 asg = *(const bf16x8*)(SG + (32 * mi + r) * 72 + 16 * ks + 8 * h);
#pragma unroll
    for (int ni = 0; ni < 2; ++ni) cg[ni] = mfma32(asg, bg[ni][ks], cg[ni]);
  }
  float ss[16], bn[16];
#pragma unroll
  for (int i = 0; i < 16; ++i) { ss[i] = 0.f; bn[i] = 0.f; }
#pragma unroll
  for (int ni = 0; ni < 2; ++ni) {
    const int hc = hd * 64 + 32 * ni + r;
    const float w0c = p.in[I_RW0][l * 256 + hc], a0c = p.in[I_RA0][l * 256 + hc], kkc = p.in[I_RKK][l * 256 + hc],
                kac = p.in[I_RKA][l * 256 + hc], rkc = p.in[I_RRK][l * 256 + hc], mu_r = mu[hc], mu_k = mu[256 + hc];
#pragma unroll
    for (int i = 0; i < 16; ++i) {
      const int tl = 32 * mi + crow(i, h);
      const size_t tok = tok0 + tl;
      const bf16_t* pr = P + tok * PSTR + C_RW + hc;
      const bool hp = (ct * 64 + tl) > 0;
      const float rr = mixf(pr[0], hp ? (pr - PSTR)[0] : (bf16_t)0, mu_r);
      const float k = mixf(pr[256], hp ? (pr - PSTR)[256] : (bf16_t)0, mu_k);
      const float wl = w0c + cw[ni][i];
      const float wlog = -softplusf_(-wl) - 0.5f;
      const float dd = 1.f - __expf(-__expf(wlog));
      const float a = sigmoidf_(a0c + ca[ni][i]);
      const float kkr = k * kkc;
      const float kp = k * (1.f + (a - 1.f) * kac);
      ss[i] += kkr * kkr; bn[i] += rr * kp * rkc;
      cw[ni][i] = kkr;
      RD[tok * 256 + hc] = f2bf(dd); RA[tok * 256 + hc] = f2bf(a); RG[tok * 256 + hc] = f2bf(cg[ni][i]);
    }
  }
#pragma unroll
  for (int i = 0; i < 16; ++i) {
#pragma unroll
    for (int o = 1; o < 32; o <<= 1) { ss[i] += __shfl_xor(ss[i], o); bn[i] += __shfl_xor(bn[i], o); }
    ss[i] = rsqrtf(ss[i] + EPSF);
  }
#pragma unroll
  for (int ni = 0; ni < 2; ++ni) {
    const int hc = hd * 64 + 32 * ni + r;
#pragma unroll
    for (int i = 0; i < 16; ++i) {
      const size_t tok = tok0 + 32 * mi + crow(i, h);
      RKK[tok * 256 + hc] = f2bf(cw[ni][i] * ss[i]);
    }
  }
  if (r == 0) {
#pragma unroll
    for (int i = 0; i < 16; ++i) BON[(tok0 + 32 * mi + crow(i, h)) * 4 + hd] = bn[i];
  }
}

DI void rwkv_scan_item(const Params& p, int l, int b, int hd, int half, char* smem) {
  const bf16_t* P = (const bf16_t*)(p.ws + OFF_P);
  bf16_t* O = (bf16_t*)(p.ws + OFF_O);
  const bf16_t* RD = (const bf16_t*)(p.ws + OFF_L);
  const bf16_t* RKK = (const bf16_t*)(p.ws + OFF_L + GSZ);
  const bf16_t* RA = (const bf16_t*)(p.ws + OFF_L + 2 * GSZ);
  float* fb = (float*)smem;
  float* Yb = fb + 2 * 12352;
  const int tid = otid(), lane = tid & 63, wv = tid >> 6;
  const int hc = hd * 64 + lane;
  constexpr int NCH = SEQ / 32;
  f32x4 Sa = {0.f, 0.f, 0.f, 0.f}, Sb = {0.f, 0.f, 0.f, 0.f};
  const int rl = lane >> 3, kq = lane & 7, vloc = (wv & 3) * 8 + rl, vrow = half * 32 + vloc;
  const float* mu = p.in[I_RMU] + (size_t)l * 896;
  const float mu_r = mu[hc], mu_k = mu[256 + hc], mu_v = mu[512 + hc];
  const float kac = p.in[I_RKA][l * 256 + hc];
  const int pw = wv & 3;
  unsigned raw[8][9];
#pragma unroll
  for (int j = 0; j < 8; ++j)
#pragma unroll
    for (int e = 0; e < 9; ++e) raw[j][e] = 0u;
#define RAWLOAD(i_)                                                                                 \
  {                                                                                                 \
    _Pragma("unroll") for (int j = 0; j < 8; ++j) {                                                 \
      const int s_ = (i_) * 32 + pw * 8 + j;                                                        \
      const size_t tok_ = (size_t)b * SEQ + s_;                                                     \
      const bf16_t* pr_ = P + tok_ * PSTR + C_RW;                                                   \
      raw[j][0] = pr_[hc]; raw[j][1] = pr_[256 + hc]; raw[j][2] = pr_[512 + hc];                    \
      if (s_ > 0) { raw[j][3] = (pr_ - PSTR)[hc]; raw[j][4] = (pr_ - PSTR)[256 + hc]; raw[j][5] = (pr_ - PSTR)[512 + hc]; } \
      else { raw[j][3] = 0u; raw[j][4] = 0u; raw[j][5] = 0u; }                                      \
      raw[j][6] = RD[tok_ * 256 + hc]; raw[j][7] = RKK[tok_ * 256 + hc]; raw[j][8] = RA[tok_ * 256 + hc]; \
    }                                                                                               \
  }
#define RBAR() { asm volatile("s_waitcnt lgkmcnt(0)" ::: "memory"); __builtin_amdgcn_s_barrier(); asm volatile("" ::: "memory"); }
  if (wv >= 4) RAWLOAD(0);
#pragma unroll 1
  for (int i = 0; i < NCH + 2; ++i) {
    if (wv >= 4) {
      float* B = fb + (i & 1) * 12352;
      if (i >= 2) {
        const float* Yc = Yb + (i & 1) * 1024;
        if (lane < 32) {
#pragma unroll
          for (int j = 0; j < 8; ++j) {
            const int tl = pw * 8 + j;
            const size_t tok = (size_t)b * SEQ + (i - 2) * 32 + tl;
            O[tok * DM + 768 + hd * 64 + half * 32 + lane] = f2bf(Yc[tl * 32 + lane]);
          }
        }
      }
      if (i < NCH) {
#pragma unroll
        for (int j = 0; j < 8; ++j) {
          const int tl = pw * 8 + j;
          const float r = mixf((bf16_t)raw[j][0], (bf16_t)raw[j][3], mu_r), k = mixf((bf16_t)raw[j][1], (bf16_t)raw[j][4], mu_k), v = mixf((bf16_t)raw[j][2], (bf16_t)raw[j][5], mu_v);
          const float w = 1.f - bf2f((bf16_t)raw[j][6]), kk = bf2f((bf16_t)raw[j][7]), a = bf2f((bf16_t)raw[j][8]);
          const float ka = kk * a, kp = k * (1.f + (a - 1.f) * kac);
          const float c1 = wave_sum(ka * r), c2 = wave_sum(kp * r);
          B[tl * 64 + lane] = w; B[2048 + tl * 64 + lane] = kk; B[4096 + tl * 64 + lane] = ka; B[6144 + tl * 64 + lane] = kp;
          B[8192 + tl * 64 + lane] = w * r; B[10240 + tl * 64 + lane] = v;
          if (lane == 0) { B[12288 + tl * 2] = c1; B[12288 + tl * 2 + 1] = c2; }
        }
        if (i + 1 < NCH) RAWLOAD(i + 1);
      }
    } else if (i >= 1 && i <= NCH) {
      const float* B = fb + ((i - 1) & 1) * 12352;
      float* Yc = Yb + ((i - 1) & 1) * 1024;
      f32x4 vw[2][10]; float vvv[2]; float2 vsc[2];
#define RWLD(t_, s_)                                                                              \
      { const float* bt_ = B + (t_) * 64 + kq * 8;                                                 \
        _Pragma("unroll") for (int q_ = 0; q_ < 5; ++q_) { vw[s_][2 * q_] = *(const f32x4*)(bt_ + 2048 * q_); vw[s_][2 * q_ + 1] = *(const f32x4*)(bt_ + 2048 * q_ + 4); } \
        vvv[s_] = B[10240 + (t_) * 64 + vrow]; vsc[s_] = *(const float2*)(B + 12288 + (t_) * 2); }
#pragma unroll 1
      for (int tb = 0; tb < 32; tb += 16) {
      RWLD(tb, 0);
#pragma unroll
      for (int t = 0; t < 16; ++t) {
        const int cs = t & 1;
        if (t + 1 < 16) RWLD(tb + t + 1, cs ^ 1);
        const f32x4 w0 = vw[cs][0], w1 = vw[cs][1], kk0 = vw[cs][2], kk1 = vw[cs][3], ka0 = vw[cs][4], ka1 = vw[cs][5],
                    kp0 = vw[cs][6], kp1 = vw[cs][7], wr0 = vw[cs][8], wr1 = vw[cs][9];
        const float vv = vvv[cs]; const float2 sc = vsc[cs];
        const f32x4 pd = Sa * kk0 + Sb * kk1, pe = Sa * wr0 + Sb * wr1;
        float d0 = (pd[0] + pd[1]) + (pd[2] + pd[3]), e0 = (pe[0] + pe[1]) + (pe[2] + pe[3]);
        const f32x4 Ua = Sa * w0 + vv * kp0, Ub = Sb * w1 + vv * kp1;
        d0 = reduce8(d0); e0 = reduce8(e0);
        const float sa0 = -d0;
        const float y0 = e0 + sa0 * sc.x + vv * sc.y;
        Sa = Ua + sa0 * ka0; Sb = Ub + sa0 * ka1;
        if (kq == 0) Yc[(tb + t) * 32 + vloc] = y0;
      }
      }
#undef RWLD
    }
    RBAR();
  }
#undef RAWLOAD
#undef RBAR
}

DI void rwkv_post(const Params& p, int l) {
  const bf16_t* P = (const bf16_t*)(p.ws + OFF_P);
  bf16_t* O = (bf16_t*)(p.ws + OFF_O);
  const bf16_t* RG = (const bf16_t*)(p.ws + OFF_L + 3 * GSZ);
  const float* BON = (const float*)(p.ws + OFF_BON);
  const int tid = otid(), lane = tid & 63, wv = tid >> 6;
  const float* mu = p.in[I_RMU] + (size_t)l * 896;
  const int nw = gridDim.x * 8;
  for (int task0 = (obid() * 8 + wv) * 4; task0 < NTOK * 4; task0 += nw * 4) {
    float yv[4], vv[4], gv[4], bv[4];
#pragma unroll
    for (int q = 0; q < 4; ++q) {
      const int task = task0 + q; const size_t tok = task >> 2; const int hd = task & 3, hc = hd * 64 + lane;
      yv[q] = bf2f(O[tok * DM + 768 + hc]);
      const bf16_t cur = P[tok * PSTR + C_RW + 512 + hc];
      const bf16_t prev = (tok % SEQ) ? P[(tok - 1) * PSTR + C_RW + 512 + hc] : (bf16_t)0;
      vv[q] = mixf(cur, prev, mu[512 + hc]);
      gv[q] = bf2f(RG[tok * 256 + hc]); bv[q] = BON[tok * 4 + hd];
    }
#pragma unroll
    for (int q = 0; q < 4; ++q) {
      const int task = task0 + q; const size_t tok = task >> 2; const int hd = task & 3, hc = hd * 64 + lane;
      const float mean = wave_sum(yv[q]) * (1.f / 64.f);
      const float d = yv[q] - mean;
      const float var = wave_sum(d * d) * (1.f / 64.f);
      const float yn = d * rsqrtf(var + 64e-5f) * p.in[I_RLG][l * 256 + hc] + p.in[I_RLB][l * 256 + hc];
      O[tok * DM + 768 + hc] = f2bf((yn + bv[q] * vv[q]) * gv[q]);
    }
  }
}

DI void sb_item(const Params& p, int item, char* smem) {
  const bf16_t* P = (const bf16_t*)(p.ws + OFF_P);
  bf16_t* O = (bf16_t*)(p.ws + OFF_O);
  const int qt = item & 15, hd = (item >> 4) & 3, b = item >> 6;
  const int tid = otid(), lane = tid & 63, wv = tid >> 6, r = lane & 31, h = lane >> 5;
  bf16_t* Vt = (bf16_t*)(smem + wv * 8704);
  const int q0 = qt * 256 + wv * 32;
  const int sq = q0 + r;
  const size_t tokb = (size_t)b * SEQ;
  bf16x8 qf[4];
#pragma unroll
  for (int ks = 0; ks < 4; ++ks) qf[ks] = *(const bf16x8*)(P + (tokb + sq) * PSTR + C_SB_Q + hd * 64 + ks * 16 + h * 8);
  f32x16 accO[2];
#pragma unroll
  for (int i = 0; i < 16; ++i) { accO[0][i] = 0.f; accO[1][i] = 0.f; }
  float Prun = 1.f;
  bf16x8 kf[2][4];
  const int kt0 = (q0 + 31) >> 6;
#define SBKLOAD(kt_) { _Pragma("unroll") for (int m = 0; m < 2; ++m) _Pragma("unroll") for (int ks = 0; ks < 4; ++ks) \
    kf[m][ks] = *(const bf16x8*)(P + (tokb + (kt_) * 64 + 32 * m + r) * PSTR + C_SB_K + hd * 64 + ks * 16 + h * 8); }
  SBKLOAD(kt0);
  for (int kt = kt0; kt >= 0; --kt) {
    const int k0 = kt * 64;
    bf16x8 vr[8];
#pragma unroll
    for (int it = 0; it < 8; ++it) vr[it] = *(const bf16x8*)(P + (tokb + k0 + it * 8 + (lane >> 3)) * PSTR + C_SB_V + hd * 64 + (lane & 7) * 8);
    f32x16 acc[2];
#pragma unroll
    for (int m = 0; m < 2; ++m) {
#pragma unroll
      for (int i = 0; i < 16; ++i) acc[m][i] = 0.f;
#pragma unroll
      for (int ks = 0; ks < 4; ++ks) acc[m] = mfma32(kf[m][ks], qf[ks], acc[m]);
    }
    if (kt > 0) SBKLOAD(kt - 1);
    float om[2][16];
#pragma unroll
    for (int m = 0; m < 2; ++m)
#pragma unroll
      for (int i = 0; i < 16; ++i) {
        const int key = k0 + 32 * m + crow(i, h);
        const float z = fmaxf(acc[m][i] * 0.125f, -80.f);
        const float e = __expf(-z);
        const float sg = __builtin_amdgcn_rcpf(1.f + e);
        const bool valid = key < sq;
        acc[m][i] = valid ? sg : 0.f;
        om[m][i] = valid ? e * sg : 1.f;
      }
    float gp[8];
#pragma unroll
    for (int q = 0; q < 8; ++q) {
      const int m = q >> 2, g = q & 3;
      gp[q] = (om[m][4 * g] * om[m][4 * g + 1]) * (om[m][4 * g + 2] * om[m][4 * g + 3]);
    }
    float run = 1.f;
#pragma unroll
    for (int q = 7; q >= 0; --q) {
      const int m = q >> 2, g = q & 3;
      const float pg = __shfl_xor(gp[q], 32);
      const float f3 = Prun * run * (h == 0 ? pg : 1.f);
      const float f2 = f3 * om[m][4 * g + 3], f1 = f2 * om[m][4 * g + 2], f0 = f1 * om[m][4 * g + 1];
      acc[m][4 * g + 3] *= f3; acc[m][4 * g + 2] *= f2; acc[m][4 * g + 1] *= f1; acc[m][4 * g + 0] *= f0;
      run *= gp[q] * pg;
    }
    Prun *= run;
    __builtin_amdgcn_wave_barrier();
#pragma unroll
    for (int it = 0; it < 8; ++it) {
      const int key = it * 8 + (lane >> 3), chv = lane & 7;
#pragma unroll
      for (int e = 0; e < 8; ++e) Vt[(chv * 8 + e) * 68 + key] = (bf16_t)vr[it][e];
    }
    __builtin_amdgcn_wave_barrier();
#pragma unroll
    for (int m = 0; m < 2; ++m)
#pragma unroll
      for (int s2 = 0; s2 < 2; ++s2) {
        uint4 uu = {pack2(acc[m][8 * s2 + 0], acc[m][8 * s2 + 1]), pack2(acc[m][8 * s2 + 2], acc[m][8 * s2 + 3]),
                    pack2(acc[m][8 * s2 + 4], acc[m][8 * s2 + 5]), pack2(acc[m][8 * s2 + 6], acc[m][8 * s2 + 7])};
        const bf16x8 pb = __builtin_bit_cast(bf16x8, uu);
#pragma unroll
        for (int dt = 0; dt < 2; ++dt) {
          const bf16_t* vp = Vt + (32 * dt + r) * 68 + 32 * m + 16 * s2 + 4 * h;
          s16x4 lo = *(const s16x4*)vp, hi = *(const s16x4*)(vp + 8);
          bf16x8 va = __builtin_shufflevector(lo, hi, 0, 1, 2, 3, 4, 5, 6, 7);
          accO[dt] = mfma32(va, pb, accO[dt]);
        }
      }
    __builtin_amdgcn_wave_barrier();
    if (__ballot(Prun > 1e-37f) == 0ull) break;
  }
#undef SBKLOAD
#pragma unroll
  for (int dt = 0; dt < 2; ++dt)
#pragma unroll
    for (int g = 0; g < 4; ++g) {
      const int d = 32 * dt + 8 * g + 4 * h;
      uint2 o = {pack2(accO[dt][4 * g], accO[dt][4 * g + 1]), pack2(accO[dt][4 * g + 2], accO[dt][4 * g + 3])};
      *(uint2*)(O + (tokb + sq) * DM + 256 + hd * 64 + d) = o;
    }
}

DI int frag_off(int row, int k) {
  const int rt = row >> 4, fr = row & 15, ks = k >> 5, kk = k & 31, hi = kk >> 4, fq = (kk & 15) >> 2, j = (kk & 3) + 4 * hi;
  return ((rt * 2 + ks) * 64 + fq * 16 + fr) * 8 + j;
}
DI int frag_off8(int row, int k0) {
  const int rt = row >> 4, fr = row & 15, ks = k0 >> 5, kk = k0 & 31, hi = kk >> 4, fq = (kk & 15) >> 2;
  return ((rt * 2 + ks) * 64 + fq * 16 + fr) * 8 + 4 * hi;
}
DI void gdn_intra_item(const Params& p, int l, int item, char* smem) {
  const bf16_t* P = (const bf16_t*)(p.ws + OFF_P);
  const int hp = item & 1, c = (item >> 1) & 63, b = item >> 7;
  const int tid = otid(), lane = tid & 63;
  bf16_t* Kb = (bf16_t*)smem;
  bf16_t* Qb = Kb + 2 * 64 * 72;
  bf16_t* Vb = Qb + 2 * 64 * 72;
  float* Lm = (float*)(smem + 3 * 2 * 64 * 72 * 2);
  float* Gs = Lm + 2 * 4096;
  float* Bs = Gs + 128;
  const size_t tok0 = (size_t)b * SEQ + c * 64;
  const float* cw = p.in[I_GCW] + (size_t)l * 4 * 768;
  float* CW = Bs + 128;
  for (int e = tid; e < 6 * 4 * 64; e += NTHR) {
    const int blk = e >> 8, j = (e >> 6) & 3, col = e & 63;
    const int hh_ = blk / 3, which_ = blk % 3;
    CW[e] = cw[j * 768 + which_ * 256 + (hp * 2 + hh_) * 64 + col];
  }
  __syncthreads();
  {
    const int t = tid >> 3, cg = tid & 7;
#pragma unroll 3
    for (int it = 0; it < 6; ++it) {
      const int hh = it / 3, which = it % 3, head = hp * 2 + hh;
      const int ccol = which * 256 + head * 64 + cg * 8;
      float acc[8];
#pragma unroll
      for (int e = 0; e < 8; ++e) acc[e] = 0.f;
#pragma unroll
      for (int j = 0; j < 4; ++j) {
        const int s = c * 64 + t - 3 + j;
        if (s >= 0) {
          bf16x8 xv = *(const bf16x8*)(P + ((size_t)b * SEQ + s) * PSTR + C_GDN_Q + ccol);
          f32x4 wa = *(const f32x4*)(CW + (it * 4 + j) * 64 + cg * 8), wb = *(const f32x4*)(CW + (it * 4 + j) * 64 + cg * 8 + 4);
#pragma unroll
          for (int e = 0; e < 4; ++e) { acc[e] += wa[e] * bf2f((bf16_t)xv[e]); acc[e + 4] += wb[e] * bf2f((bf16_t)xv[e + 4]); }
        }
      }
      float ss = 0.f;
#pragma unroll
      for (int e = 0; e < 8; ++e) { acc[e] = siluf_(acc[e]); ss += acc[e] * acc[e]; }
      ss += __shfl_xor(ss, 1); ss += __shfl_xor(ss, 2); ss += __shfl_xor(ss, 4);
      float sc = 1.f;
      if (which == 0) sc = rsqrtf(ss + EPSF) * 0.125f;
      else if (which == 1) sc = rsqrtf(ss + EPSF);
      uint4 ov = {pack2(acc[0] * sc, acc[1] * sc), pack2(acc[2] * sc, acc[3] * sc), pack2(acc[4] * sc, acc[5] * sc), pack2(acc[6] * sc, acc[7] * sc)};
      bf16_t* dst = (which == 0 ? Qb : (which == 1 ? Kb : Vb)) + (hh * 64 + t) * 72 + cg * 8;
      *(uint4*)dst = ov;
    }
  }
  if (tid < 128) {
    const int hh = tid >> 6, t = lane, head = hp * 2 + hh;
    const float a_in = bf2f(P[(tok0 + t) * PSTR + C_GDN_A + head]);
    const float b_in = bf2f(P[(tok0 + t) * PSTR + C_GDN_B + head]);
    const float beta = sigmoidf_(b_in);
    float g = -__expf(p.in[I_GAL][l * 4 + head]) * softplusf_(a_in + p.in[I_GDT][l * 4 + head]);
#pragma unroll
    for (int d = 1; d < 64; d <<= 1) { float v = __shfl_up(g, d); if (lane >= d) g += v; }
    Gs[hh * 64 + t] = g; Bs[hh * 64 + t] = beta;
  }
  __syncthreads();
  const int hh = tid >> 8, lt = tid & 255, head = hp * 2 + hh;
  const size_t ih = ((size_t)(b * 4 + head)) * 64 + c;
  bf16_t* GW = (bf16_t*)(p.ws + OFF_G) + ih * 4096;
  bf16_t* GQD = (bf16_t*)(p.ws + OFF_G + GSZ) + ih * 4096;
  bf16_t* GQK = (bf16_t*)(p.ws + OFF_G + 2 * GSZ) + ih * 4096;
  bf16_t* GKD = (bf16_t*)(p.ws + OFF_G + 3 * GSZ) + ih * 4096;
  bf16_t* GU = (bf16_t*)(p.ws + OFF_G + 4 * GSZ) + ih * 4096;
  float* GCD = (float*)(p.ws + OFF_GCD);
  const float* Gh = Gs + hh * 64; const float* Bh = Bs + hh * 64;
  {
    const int wq = (tid >> 6) & 3, ti = wq >> 1, tj = wq & 1, r = lane & 31, h = lane >> 5;
    f32x16 akk, aqk;
#pragma unroll
    for (int i = 0; i < 16; ++i) { akk[i] = 0.f; aqk[i] = 0.f; }
    if (ti >= tj) {
#pragma unroll
      for (int ks = 0; ks < 4; ++ks) {
        bf16x8 ka = *(const bf16x8*)(Kb + (hh * 64 + 32 * ti + r) * 72 + ks * 16 + h * 8);
        bf16x8 qa = *(const bf16x8*)(Qb + (hh * 64 + 32 * ti + r) * 72 + ks * 16 + h * 8);
        bf16x8 kb = *(const bf16x8*)(Kb + (hh * 64 + 32 * tj + r) * 72 + ks * 16 + h * 8);
        akk = mfma32(ka, kb, akk);
        aqk = mfma32(qa, kb, aqk);
      }
    }
    const int j = 32 * tj + r;
    const float Gj = Gh[j];
#pragma unroll
    for (int i_ = 0; i_ < 16; ++i_) {
      const int i = 32 * ti + crow(i_, h);
      const float dec = (i >= j) ? __expf(Gh[i] - Gj) : 0.f;
      Lm[hh * 4096 + i * 64 + j] = (i > j) ? Bh[i] * akk[i_] * dec : 0.f;
      GQK[frag_off(i, j)] = f2bf((i >= j) ? aqk[i_] * dec : 0.f);
    }
  }
  __syncthreads();
  if (lt < 128) {
    const int cc = lt;
    float x[64];
    if (cc < 64) {
#pragma unroll
      for (int i = 0; i < 64; ++i) x[i] = bf2f(Vb[(hh * 64 + i) * 72 + cc]) * Bh[i];
    } else {
#pragma unroll
      for (int i = 0; i < 64; ++i) x[i] = bf2f(Kb[(hh * 64 + i) * 72 + cc - 64]) * Bh[i] * __expf(Gh[i]);
    }
    const float* Lh = Lm + hh * 4096;
#pragma unroll
    for (int i = 1; i < 64; ++i) {
      float s = x[i];
#pragma unroll
      for (int j4 = 0; j4 < (i + 3) / 4; ++j4) {
        const f32x4 lv = *(const f32x4*)(Lh + i * 64 + j4 * 4);
#pragma unroll
        for (int e = 0; e < 4; ++e) if (j4 * 4 + e < i) s -= lv[e] * x[j4 * 4 + e];
      }
      x[i] = s;
    }
    if (cc < 64) {
      const int split = cc >> 4, fr = cc & 15;
#pragma unroll
      for (int i4 = 0; i4 < 16; ++i4) {
        uint2 ov = {pack2(x[4 * i4], x[4 * i4 + 1]), pack2(x[4 * i4 + 2], x[4 * i4 + 3])};
        *(uint2*)(GU + ((split * 4 + (i4 >> 2)) * 64 + (i4 & 3) * 16 + fr) * 4) = ov;
      }
    } else {
#pragma unroll
      for (int i = 0; i < 64; ++i) GW[frag_off(i, cc - 64)] = f2bf(x[i]);
    }
  } else {
    const int q_ = lt - 128;
    const float Glast = Gh[63];
#pragma unroll
    for (int i = 0; i < 4; ++i) {
      const int q = q_ + 128 * i; const int pos = q >> 3, kc = q & 7;
      bf16x8 qv = *(const bf16x8*)(Qb + (hh * 64 + pos) * 72 + kc * 8);
      const float eg = __expf(Gh[pos]);
      uint4 ov = {pack2(bf2f((bf16_t)qv[0]) * eg, bf2f((bf16_t)qv[1]) * eg), pack2(bf2f((bf16_t)qv[2]) * eg, bf2f((bf16_t)qv[3]) * eg),
                  pack2(bf2f((bf16_t)qv[4]) * eg, bf2f((bf16_t)qv[5]) * eg), pack2(bf2f((bf16_t)qv[6]) * eg, bf2f((bf16_t)qv[7]) * eg)};
      { const int fo = frag_off8(pos, kc * 8); uint2 o0 = {ov.x, ov.y}, o1 = {ov.z, ov.w}; *(uint2*)(GQD + fo) = o0; *(uint2*)(GQD + fo + 128) = o1; }
    }
#pragma unroll
    for (int i = 0; i < 4; ++i) {
      const int q = q_ + 128 * i; const int k = q >> 3, pc = q & 7;
      float o[8];
#pragma unroll
      for (int e = 0; e < 8; ++e) { const int pos = pc * 8 + e; o[e] = bf2f(Kb[(hh * 64 + pos) * 72 + k]) * __expf(Glast - Gh[pos]); }
      uint4 ov = {pack2(o[0], o[1]), pack2(o[2], o[3]), pack2(o[4], o[5]), pack2(o[6], o[7])};
      { const int fo = frag_off8(k, pc * 8); uint2 o0 = {ov.x, ov.y}, o1 = {ov.z, ov.w}; *(uint2*)(GKD + fo) = o0; *(uint2*)(GKD + fo + 128) = o1; }
    }
    if (q_ == 0) GCD[ih] = __expf(Glast);
  }
}

DI void gdn_rec_item(const Params& p, int l, int b, int head, char* smem) {
  const bf16_t* P = (const bf16_t*)(p.ws + OFF_P);
  bf16_t* O = (bf16_t*)(p.ws + OFF_O);
  float* SS = (float*)(smem + 81920);
  const int tid = otid(), lane = tid & 63, wv = tid >> 6, fr = lane & 15, fq = lane >> 4;
  const int split = wv & 3;
  const bool active = wv < 4;
  const float ng = p.in[I_GNG][l * 64 + split * 16 + fr];
  const float* GCD = (const float*)(p.ws + OFF_GCD);
  const size_t ih0 = ((size_t)(b * 4 + head)) * 64;
  f32x4 S[4];
#pragma unroll
  for (int kt = 0; kt < 4; ++kt) S[kt] = (f32x4){0.f, 0.f, 0.f, 0.f};
  u32x4 lr[10];
#pragma unroll
  for (int i = 0; i < 10; ++i) lr[i] = (u32x4){0u, 0u, 0u, 0u};
  const int lq = (wv & 3) * 64 + lane;
#define GLOADC(c_)                                                                              \
  {                                                                                             \
    _Pragma("unroll") for (int i = 0; i < 10; ++i) {                                            \
      const int q_ = lq + 256 * i; const int a_ = q_ >> 9, o_ = q_ & 511;                       \
      lr[i] = *(const u32x4*)((const bf16_t*)(p.ws + OFF_G + (size_t)a_ * GSZ) + (ih0 + (c_)) * 4096 + o_ * 8); \
    }                                                                                           \
  }
#define LSTORE(buf_)                                                                            \
  {                                                                                             \
    _Pragma("unroll") for (int i = 0; i < 10; ++i) {                                            \
      const int q_ = lq + 256 * i;                                                              \
      *(u32x4*)(smem + (buf_) * 40960 + q_ * 16) = lr[i];                                       \
    }                                                                                           \
  }
#define BAR_LDS() { asm volatile("s_waitcnt lgkmcnt(0)" ::: "memory"); __builtin_amdgcn_s_barrier(); asm volatile("" ::: "memory"); }
  float cdn = 0.f;
  if (!active) { GLOADC(0); LSTORE(0); GLOADC(1); }
  else cdn = GCD[ih0];
  BAR_LDS();
#pragma unroll 1
  for (int c = 0; c < 64; ++c) {
    f32x4 acco[4];
    if (active) {
      const char* bufp = smem + (c & 1) * 40960;
      const float cd = cdn;
      if (c + 1 < 64) cdn = GCD[ih0 + c + 1];
      float zr[16];
#pragma unroll
      for (int rt = 0; rt < 4; ++rt)
#pragma unroll
        for (int j = 0; j < 4; ++j) {
          const size_t tok = (size_t)b * SEQ + c * 64 + 16 * rt + 4 * fq + j;
          zr[rt * 4 + j] = bf2f(P[tok * PSTR + C_GDN_Z + head * 64 + split * 16 + fr]);
        }
      bf16x8 bS[2];
#pragma unroll
      for (int ks = 0; ks < 2; ++ks) {
        uint4 uu = {pack2(S[2 * ks][0], S[2 * ks][1]), pack2(S[2 * ks][2], S[2 * ks][3]), pack2(S[2 * ks + 1][0], S[2 * ks + 1][1]), pack2(S[2 * ks + 1][2], S[2 * ks + 1][3])};
        bS[ks] = __builtin_bit_cast(bf16x8, uu);
      }
      f32x4 u[4];
#pragma unroll
      for (int rt = 0; rt < 4; ++rt) {
        f32x4 aw = {0.f, 0.f, 0.f, 0.f};
        acco[rt] = (f32x4){0.f, 0.f, 0.f, 0.f};
#pragma unroll
        for (int ks = 0; ks < 2; ++ks) {
          const bf16x8 wa = *(const bf16x8*)(bufp + ((rt * 2 + ks) * 64 + lane) * 16);
          const bf16x8 qa = *(const bf16x8*)(bufp + 8192 + ((rt * 2 + ks) * 64 + lane) * 16);
          aw = mfma16(wa, bS[ks], aw); acco[rt] = mfma16(qa, bS[ks], acco[rt]);
        }
        const s16x4 uv = *(const s16x4*)(bufp + 32768 + ((split * 4 + rt) * 64 + lane) * 8);
#pragma unroll
        for (int j = 0; j < 4; ++j) u[rt][j] = bf2f((bf16_t)uv[j]) - aw[j];
      }
      bf16x8 bU[2];
#pragma unroll
      for (int ks = 0; ks < 2; ++ks) {
        uint4 uu = {pack2(u[2 * ks][0], u[2 * ks][1]), pack2(u[2 * ks][2], u[2 * ks][3]), pack2(u[2 * ks + 1][0], u[2 * ks + 1][1]), pack2(u[2 * ks + 1][2], u[2 * ks + 1][3])};
        bU[ks] = __builtin_bit_cast(bf16x8, uu);
      }
#pragma unroll
      for (int rt = 0; rt < 4; ++rt) {
        f32x4 sn = S[rt] * cd;
#pragma unroll
        for (int ks = 0; ks < 2; ++ks) {
          const bf16x8 qa = *(const bf16x8*)(bufp + 16384 + ((rt * 2 + ks) * 64 + lane) * 16);
          const bf16x8 ka = *(const bf16x8*)(bufp + 24576 + ((rt * 2 + ks) * 64 + lane) * 16);
          acco[rt] = mfma16(qa, bU[ks], acco[rt]); sn = mfma16(ka, bU[ks], sn);
        }
        S[rt] = sn;
      }
#pragma unroll
      for (int rt = 0; rt < 4; ++rt)
#pragma unroll
        for (int j = 0; j < 4; ++j) {
          float s = acco[rt][j] * acco[rt][j];
          s += __shfl_xor(s, 1); s += __shfl_xor(s, 2); s += __shfl_xor(s, 4); s += __shfl_xor(s, 8);
          if (fr == 0) SS[(c & 1) * 256 + split * 64 + 16 * rt + 4 * fq + j] = s;
        }
      BAR_LDS();
      const float* ssb = SS + (c & 1) * 256;
#pragma unroll
      for (int rt = 0; rt < 4; ++rt)
#pragma unroll
        for (int j = 0; j < 4; ++j) {
          const int pos = 16 * rt + 4 * fq + j;
          const float tot = ssb[pos] + ssb[64 + pos] + ssb[128 + pos] + ssb[192 + pos];
          const float rn = rsqrtf(tot * (1.f / 64.f) + EPSF);
          const size_t tok = (size_t)b * SEQ + c * 64 + pos;
          O[tok * DM + 512 + head * 64 + split * 16 + fr] = f2bf(acco[rt][j] * rn * ng * siluf_(zr[rt * 4 + j]));
        }
    } else {
      if (c + 1 < 64) LSTORE((c + 1) & 1);
      if (c + 2 < 64) GLOADC(c + 2);
      BAR_LDS();
    }
  }
#undef GLOADC
#undef LSTORE
#undef BAR_LDS
}

DI void lru_item(const Params& p, int l, int item, char* smem, const int mode) {
  const bf16_t* P = (const bf16_t*)(p.ws + OFF_P);
  bf16_t* O = (bf16_t*)(p.ws + OFF_O);
  float* CA = (float*)(p.ws + OFF_LCA);
  float* CH = (float*)(p.ws + OFF_LCH);
  bf16_t* XS = (bf16_t*)smem;
  bf16_t* UB = (bf16_t*)(smem + 34816);
  const int b = item >> 6, ct = item & 63;
  const int tid = otid(), lane = tid & 63, wv = tid >> 6, r = lane & 31, h = lane >> 5, n = wv & 3, mi = wv >> 2;
  for (int i = 0; i < 5; ++i) {
    const int q = tid + NTHR * i;
    if (q < 67 * 32) {
      const int row = q >> 5, cc = q & 31;
      const int s = ct * 64 - 3 + row;
      uint4 v = {0u, 0u, 0u, 0u};
      if (s >= 0) v = *(const uint4*)(P + ((size_t)b * SEQ + s) * PSTR + C_LRU_X + cc * 8);
      *(uint4*)(XS + row * 256 + cc * 8) = v;
    }
  }
  bf16x8 bwr[2][4], bwi[2][4];
  {
    const float* wrp = p.in[I_LWR] + (((size_t)l * 4 + n) * 64) * 64 + r;
    const float* wip = p.in[I_LWI] + (((size_t)l * 4 + n) * 64) * 64 + r;
    asm volatile("" : "+v"(wrp), "+v"(wip));
#pragma unroll
    for (int ni = 0; ni < 2; ++ni)
#pragma unroll
      for (int ks = 0; ks < 4; ++ks) {
        unsigned ur[4], ui[4];
#pragma unroll
        for (int j2 = 0; j2 < 4; ++j2) {
          const int e = 16 * ks + 8 * h + 2 * j2;
          ur[j2] = pack2(wrp[e * 64 + 32 * ni], wrp[(e + 1) * 64 + 32 * ni]);
          ui[j2] = pack2(wip[e * 64 + 32 * ni], wip[(e + 1) * 64 + 32 * ni]);
        }
        uint4 t1 = {ur[0], ur[1], ur[2], ur[3]}, t2 = {ui[0], ui[1], ui[2], ui[3]};
        bwr[ni][ks] = __builtin_bit_cast(bf16x8, t1); bwi[ni][ks] = __builtin_bit_cast(bf16x8, t2);
      }
  }
  __syncthreads();
  {
    const int sc = tid >> 8, c = tid & 255;
    const float cb = p.in[I_LCB][l * 256 + c];
    const float c0 = p.in[I_LCW][(l * 4 + 0) * 256 + c], c1 = p.in[I_LCW][(l * 4 + 1) * 256 + c],
                c2 = p.in[I_LCW][(l * 4 + 2) * 256 + c], c3 = p.in[I_LCW][(l * 4 + 3) * 256 + c];
    for (int t = sc * 32; t < sc * 32 + 32; ++t)
      UB[t * 264 + c] = f2bf(cb + c0 * bf2f(XS[t * 256 + c]) + c1 * bf2f(XS[(t + 1) * 256 + c]) + c2 * bf2f(XS[(t + 2) * 256 + c]) + c3 * bf2f(XS[(t + 3) * 256 + c]));
  }
  __syncthreads();
  f32x16 ar[2], ai[2];
#pragma unroll
  for (int ni = 0; ni < 2; ++ni)
#pragma unroll
    for (int i = 0; i < 16; ++i) { ar[ni][i] = 0.f; ai[ni][i] = 0.f; }
#pragma unroll
  for (int ks = 0; ks < 4; ++ks) {
    const bf16x8 au = *(const bf16x8*)(UB + (32 * mi + r) * 264 + n * 64 + 16 * ks + 8 * h);
#pragma unroll
    for (int ni = 0; ni < 2; ++ni) { ar[ni] = mfma32(au, bwr[ni][ks], ar[ni]); ai[ni] = mfma32(au, bwi[ni][ks], ai[ni]); }
  }
  const int ck = ct * 2 + mi;
#pragma unroll
  for (int ni = 0; ni < 2; ++ni) {
    const int c = n * 64 + 32 * ni + r;
    const float brc = p.in[I_LBR][l * 256 + c], bic = p.in[I_LBI][l * 256 + c];
    const float lamsp = softplusf_(-p.in[I_LLAM][l * 256 + c]);
    float av[16], bv[16];
#pragma unroll
    for (int i = 0; i < 16; ++i) {
      const int tl = 32 * mi + crow(i, h);
      const float u = bf2f(UB[tl * 264 + c]);
      const float rg = sigmoid_rcp(ar[ni][i] + brc), ig = sigmoid_rcp(ai[ni][i] + bic);
      const float la = -8.f * rg * lamsp;
      av[i] = __expf(la);
      bv[i] = __builtin_amdgcn_sqrtf(fmaxf(0.f, 1.f - __expf(2.f * la))) * (ig * u);
    }
    float GA[4], GB[4], PA[4], PB[4];
#pragma unroll
    for (int q = 0; q < 4; ++q) {
      float A = 1.f, hh = 0.f;
#pragma unroll
      for (int e = 0; e < 4; ++e) { hh = av[4 * q + e] * hh + bv[4 * q + e]; A *= av[4 * q + e]; }
      GA[q] = A; GB[q] = hh;
      PA[q] = __shfl_xor(A, 32); PB[q] = __shfl_xor(hh, 32);
    }
    float cin = 0.f;
    if (mode == 1) {
      const int lo = h ? (ck >> 1) : 0, hi = h ? ck : (ck >> 1);
      float A = 1.f, hh = 0.f;
      const float* ca = CA + ((size_t)b * 128) * 256 + c;
      const float* chp = CH + ((size_t)b * 128) * 256 + c;
      int k = lo;
      for (; k + 8 <= hi; k += 8) {
        float a8[8], h8[8];
#pragma unroll
        for (int e = 0; e < 8; ++e) { a8[e] = ca[(size_t)(k + e) * 256]; h8[e] = chp[(size_t)(k + e) * 256]; }
#pragma unroll
        for (int e = 0; e < 8; ++e) { hh = a8[e] * hh + h8[e]; A *= a8[e]; }
      }
      for (; k < hi; ++k) { const float a_ = ca[(size_t)k * 256], h_ = chp[(size_t)k * 256]; hh = a_ * hh + h_; A *= a_; }
      const float pAx = __shfl_xor(A, 32), pHx = __shfl_xor(hh, 32);
      cin = h ? (A * pHx + hh) : (pAx * hh + pHx);
    }
    float cg = cin, Ap = 1.f, myc[4];
#pragma unroll
    for (int q = 0; q < 4; ++q) {
      const float Ae = h ? PA[q] : GA[q], Be = h ? PB[q] : GB[q];
      const float Ao = h ? GA[q] : PA[q], Bo = h ? GB[q] : PB[q];
      const float c_even = cg;
      cg = Ae * cg + Be;
      const float c_odd = cg;
      cg = Ao * cg + Bo;
      myc[q] = h ? c_odd : c_even;
      Ap *= Ae * Ao;
    }
    if (mode == 0) {
      if (h == 0) { CA[((size_t)b * 128 + ck) * 256 + c] = Ap; CH[((size_t)b * 128 + ck) * 256 + c] = cg; }
    } else {
#pragma unroll
      for (int q = 0; q < 4; ++q) {
        float hh = myc[q];
#pragma unroll
        for (int e = 0; e < 4; ++e) {
          const int i = 4 * q + e;
          hh = av[i] * hh + bv[i];
          const size_t tok = (size_t)b * SEQ + ct * 64 + 32 * mi + crow(i, h);
          const float y = bf2f(P[tok * PSTR + C_LRU_Y + c]);
          O[tok * DM + c] = f2bf(hh * gelu_rcp(y));
        }
      }
    }
  }
}

#define XB_TMO      128
#define XB_XCNT(j)  (256  + 64 * (j))
#define XB_XSUB(j)  (1280 + 64 * (j))
#define XB_XGEN(j)  (2304 + 64 * (j))
#define XB_TOP      3328
#define XB_TOPGEN   3392
#define XCD_BAR_WORDS 3456
#define XB_SPIN_CAP (1u << 18)
#define XLAS __attribute__((address_space(3)))
DI unsigned xb_ld(unsigned* p)              { return __hip_atomic_load(p, __ATOMIC_RELAXED, __HIP_MEMORY_SCOPE_AGENT); }
DI unsigned xb_add(unsigned* p, unsigned v) { return __hip_atomic_fetch_add(p, v, __ATOMIC_RELAXED, __HIP_MEMORY_SCOPE_AGENT); }
DI unsigned xb_xcc_id() { return (unsigned)__builtin_amdgcn_s_getreg((3 << 11) | 20) & 0xFu; }
#define XB_SPIN(cond, bar) do { unsigned _sp = 0; while (cond) { __builtin_amdgcn_s_sleep(1); \
    if ((++_sp & 255u) == 0u) { if (xb_ld(&(bar)[XB_TMO])) break; if (_sp > XB_SPIN_CAP) { atomicAdd(&(bar)[XB_TMO], 1u); break; } } } } while (0)
struct XcdBarrier { unsigned* bar; unsigned x; volatile XLAS unsigned* st; };
DI XcdBarrier xcd_barrier_post(unsigned* bar, volatile XLAS unsigned* st) {
  XcdBarrier b; b.bar = bar; b.x = xb_xcc_id(); b.st = st;
  if (threadIdx.x == 0) (void)xb_add(&bar[XB_XCNT(b.x)], 1u);
  return b;
}
DI void xcd_barrier_complete(unsigned* bar, unsigned x, unsigned& nloc, unsigned& nx) {
  const unsigned G = gridDim.x * gridDim.y * gridDim.z;
  unsigned sum, cnt, mine, sp = 0u;
  for (;;) {
    sum = 0u; cnt = 0u; mine = 0u;
#pragma unroll
    for (unsigned j = 0; j < 16; ++j) { const unsigned c = xb_ld(&bar[XB_XCNT(j)]); sum += c; cnt += (c > 0u) ? 1u : 0u; mine = (j == x) ? c : mine; }
    if (sum == G) break;
    __builtin_amdgcn_s_sleep(1);
    if ((++sp & 255u) == 0u) { if (xb_ld(&bar[XB_TMO])) break; if (sp > XB_SPIN_CAP) { atomicAdd(&bar[XB_TMO], 1u); break; } }
  }
  nloc = mine > 0u ? mine : 1u; nx = cnt > 0u ? cnt : 1u;
}
DI void xcd_barrier(const XcdBarrier& b) {
  asm volatile("s_waitcnt vmcnt(0)" ::: "memory");
  __syncthreads();
  if (threadIdx.x == 0) {
    unsigned* bar = b.bar;
    __builtin_amdgcn_s_waitcnt(0);
    unsigned nloc = b.st[0], nx = b.st[1];
    if (nloc == 0u) { xcd_barrier_complete(bar, b.x, nloc, nx); b.st[0] = nloc; b.st[1] = nx; }
    const unsigned old = xb_add(&bar[XB_XSUB(b.x)], 1u);
    const unsigned gen = old / nloc;
    if (old + 1u == (gen + 1u) * nloc) {
      __builtin_amdgcn_fence(__ATOMIC_RELEASE, "agent");
      asm volatile("s_waitcnt vmcnt(0)" ::: "memory");
      const unsigned og = xb_add(&bar[XB_TOP], 1u);
      const unsigned tg = og / nx;
      if (og + 1u == (tg + 1u) * nx) xb_add(&bar[XB_TOPGEN], 1u);
      else XB_SPIN(xb_ld(&bar[XB_TOPGEN]) == tg, bar);
      __builtin_amdgcn_fence(__ATOMIC_ACQUIRE, "agent");
      xb_add(&bar[XB_XGEN(b.x)], 1u);
      asm volatile("s_waitcnt vmcnt(0)" ::: "memory");
    } else {
      XB_SPIN(xb_ld(&bar[XB_XGEN(b.x)]) == gen, bar);
      __builtin_amdgcn_fence(__ATOMIC_ACQUIRE, "agent");
      asm volatile("s_waitcnt vmcnt(0)" ::: "memory");
    }
  }
  __syncthreads();
}

__global__ void __launch_bounds__(NTHR) mega(Params p) {
  extern __shared__ __attribute__((aligned(16))) char smem[];
  cg::grid_group grid = cg::this_grid();
  const int tid = threadIdx.x;
  bf16_t* H = (bf16_t*)(p.ws + OFF_H);
  bf16_t* PB = (bf16_t*)(p.ws + OFF_P);
  PG_LAS unsigned char* lds = (PG_LAS unsigned char*)smem;
  volatile XLAS unsigned* xst = (volatile XLAS unsigned*)(smem + 131072);
  if (tid < 2) xst[tid] = 0u;
  __syncthreads();
  const XcdBarrier xb = xcd_barrier_post((unsigned*)(p.ws + OFF_BAR), xst);

  for (int rep = 0; rep < REP_MISC; ++rep) {
  if (MASK & 1) phase_mod(p, smem);
  grid.sync();
  }
  for (int l = 0; l < 4; ++l) {
    const float* xcur = (l == 0) ? p.in[I_X] : p.out;
    for (int rep = 0; rep < REP_MISC; ++rep) {
    if (MASK & 2) phase_convert(p, l, smem);
    if (MASK & 4) phase_norm(p, xcur, p.in[I_N1G] + l * 1024, l, 1024, 0, H, nullptr);
    xcd_barrier(xb);
    }
    for (int rep = 0; rep < REP_G; ++rep) {
    if (MASK & 8) { pg::Order<1> S; S.init(NTOK, PSTR, gridDim.x, blockIdx.x); pg::EpiBf16<0> E{PB, PSTR, nullptr};
      pg::gemm_phase(lds, H, DM, (const bf16_t*)(p.ws + OFF_WIN), 1024, S, E); }
    xcd_barrier(xb);
    }
    for (int rep = 0; rep < REP_M1; ++rep) {
    for (int it = blockIdx.x; it < 5120; it += gridDim.x) {
      if (it < 2048) { if (MASK & 32) gdn_intra_item(p, l, it, smem); }
      else if (it < 3072) { }
      else if (it < 4096) { if (MASK & 128) lru_item(p, l, it - 3072, smem, 0); }
      else { if (MASK & 16) rw_prep_item(p, l, it - 4096, smem); }
      __syncthreads();
    }
    xcd_barrier(xb);
    }
    for (int rep = 0; rep < REP_M2; ++rep) {
    if (blockIdx.x < 128) {
      if (MASK & 16) rwkv_scan_item(p, l, blockIdx.x >> 3, (blockIdx.x >> 1) & 3, blockIdx.x & 1, smem);
    } else {
      if (blockIdx.x < 192) { if (MASK & 256) gdn_rec_item(p, l, (blockIdx.x - 128) >> 2, (blockIdx.x - 128) & 3, smem); }
      unsigned* ctr = (unsigned*)(p.ws + OFF_CTR) + l * 4 + rep;
      volatile int* slot = (volatile int*)(smem + 110016);
      for (;;) {
        __syncthreads();
        if (tid == 0) *slot = (int)atomicAdd(ctr, 1u);
        __syncthreads();
        const int it = *slot;
        if (it >= 2048) break;
        if (it < 1024) { if (MASK & 64) sb_item(p, it, smem); }
        else { if (MASK & 512) lru_item(p, l, it - 1024, smem, 1); }
      }
    }
    xcd_barrier(xb);
    }
    for (int rep = 0; rep < REP_G; ++rep) {
    for (int half = 0; half < 4; ++half) {
      bf16_t* BH = (bf16_t*)(p.ws + OFF_P + 134217728);
      if (half == 0 && rep == 0) { if (MASK & 16) rwkv_post(p, l); xcd_barrier(xb); }
      if (MASK & 1024) { pg::Order<1> S; S.init(NTOK / 4, 4096, gridDim.x, blockIdx.x, 0, 0, 2, 512); pg::EpiBf16<0> E{BH, 4096, nullptr};
        pg::gemm_phase(lds, (const bf16_t*)(p.ws + OFF_O) + (size_t)half * 16384 * DM, DM, (const bf16_t*)(p.ws + OFF_WBR), 256, S, E); }
      xcd_barrier(xb);
      if (MASK & 1024) { pg::Order<4> S; S.init(NTOK / 4, 1024, gridDim.x, blockIdx.x, 0, 2097152); pg::EpiGateMix E{PB + (size_t)half * 16384 * DM, (float*)(p.ws + OFF_G), BH, p.in[I_BGATE] + (size_t)l * 4096};
        pg::gemm_phase(lds, H + (size_t)half * 16384 * DM, DM, (const bf16_t*)(p.ws + OFF_WG), 1024, S, E); }
      xcd_barrier(xb);
    }
    }
    if (MASK & 2048) { pg::Order<1> S; S.init(NTOK, 1024, gridDim.x, blockIdx.x); pg::EpiResid E{xcur, p.out, (const float*)(p.ws + OFF_MODP), p.in[I_BADA], l, 2048};
      pg::gemm_phase(lds, PB, DM, (const bf16_t*)(p.ws + OFF_WO), 1024, S, E); }
    xcd_barrier(xb);
    for (int rep = 0; rep < REP_MISC; ++rep) {
    if (MASK & 4096) phase_norm(p, p.out, p.in[I_N2G] + l * 1024, l, 4096, 3072, H, nullptr);
    xcd_barrier(xb);
    }
    for (int rep = 0; rep < REP_G; ++rep) {
    if (MASK & 8192) { pg::Order<1> S; S.init(NTOK, FFN, gridDim.x, blockIdx.x); pg::EpiBf16<0> E{PB, FFN, nullptr};
      pg::gemm_phase(lds, H, DM, (const bf16_t*)(p.ws + OFF_WF), 1024, S, E); }
    xcd_barrier(xb);
    if (MASK & 8192) { pg::Order<1> S; S.init(NTOK, FFN, gridDim.x, blockIdx.x); pg::EpiFfnAct E{PB + (size_t)NTOK * FFN, PB, p.in[I_FCW] + (size_t)l * 3 * FFN};
      pg::gemm_phase(lds, H, DM, (const bf16_t*)(p.ws + OFF_WF) + (size_t)FFN * 1024, 1024, S, E); }
    xcd_barrier(xb);
    }
    if (MASK & 32768) { pg::Order<1> S; S.init(NTOK, 1024, gridDim.x, blockIdx.x); pg::EpiResid E{p.out, p.out, (const float*)(p.ws + OFF_MODP), p.in[I_BADA], l, 5120};
      pg::gemm_phase(lds, PB + (size_t)NTOK * FFN, FFN, (const bf16_t*)(p.ws + OFF_WD), FFN, S, E); }
    xcd_barrier(xb);
  }
  if (MASK & 65536) phase_norm(p, p.out, p.in[I_FG], 0, 0, 0, nullptr, p.out);
}

extern "C" void kernel_launch(void* const* d_in, const int* in_sizes, int n_in,
                              void* d_out, int out_size, void* d_ws, size_t ws_size,
                              hipStream_t stream) {
  if (ws_size < WS_NEED || n_in < 38) { fprintf(stderr, "workspace too small: %zu < %zu\n", ws_size, (size_t)WS_NEED); return; }
  (void)hipFuncSetAttribute((const void*)mega, hipFuncAttributeMaxDynamicSharedMemorySize, SMEM_BYTES);
  int dev = 0, cus = 0, per_cu = 0;
  (void)hipGetDevice(&dev);
  (void)hipDeviceGetAttribute(&cus, hipDeviceAttributeMultiprocessorCount, dev);
  (void)hipOccupancyMaxActiveBlocksPerMultiprocessor(&per_cu, mega, NTHR, SMEM_BYTES);
  if (per_cu < 1 || cus < 1) { fprintf(stderr, "occupancy query failed (%d, %d)\n", per_cu, cus); return; }
  if (cus > 256) cus = 256;
  const int grid_blocks = cus;
  Params p{};
  for (int i = 0; i < 38; ++i) p.in[i] = (const float*)d_in[i];
  p.out = (float*)d_out; p.ws = (char*)d_ws;
  (void)hipMemsetAsync((char*)d_ws + OFF_BAR, 0, XCD_BAR_WORDS * 4, stream);
  void* args[] = {&p};
  hipError_t e = hipLaunchCooperativeKernel((void*)mega, dim3(grid_blocks), dim3(NTHR), args, SMEM_BYTES, stream);
  if (e != hipSuccess) fprintf(stderr, "cooperative launch failed: %s (grid %d)\n", hipGetErrorString(e), grid_blocks);
}
```

```cpp
#include <hip/hip_runtime.h>
#include <hip/hip_cooperative_groups.h>
#include <cstdio>
namespace cg = cooperative_groups;

typedef unsigned short bf16_t;
typedef short bf16x8 __attribute__((ext_vector_type(8)));
typedef short s16x4 __attribute__((ext_vector_type(4)));
typedef float f32x4 __attribute__((ext_vector_type(4)));
typedef float f32x16 __attribute__((ext_vector_type(16)));
typedef unsigned u32x4 __attribute__((ext_vector_type(4)));
#define DI __device__ __forceinline__

constexpr int NTOK = 65536, DM = 1024, SEQ = 4096, PSTR = 3328, FFN = 2816, AUS = 5632;
constexpr int C_LRU_X = 0, C_LRU_Y = 256, C_SB_Q = 512, C_SB_K = 768, C_SB_V = 1024;
constexpr int C_GDN_Q = 1280, C_GDN_Z = 2048, C_GDN_A = 2304, C_GDN_B = 2308, C_RW = 2312;
constexpr float EPSF = 1e-6f;
#ifndef MASK
#define MASK 0x1ffff
#endif
#ifndef REP_M1
#define REP_M1 1
#endif
#ifndef REP_M2
#define REP_M2 1
#endif
#ifndef REP_G
#define REP_G 1
#endif
#ifndef REP_MISC
#define REP_MISC 1
#endif
constexpr int NTHR = 512;
constexpr int SMEM_BYTES = 131072 + 64;

constexpr size_t OFF_MODP = 0;
constexpr size_t OFF_WIN = 6291456;
constexpr size_t OFF_WG = OFF_WIN + 6815744;
constexpr size_t OFF_WBR = OFF_WG + 8388608;
constexpr size_t OFF_WO = OFF_WBR + 2097152;
constexpr size_t OFF_WF = OFF_WO + 2097152;
constexpr size_t OFF_WD = OFF_WF + 11534336;
constexpr size_t OFF_H = OFF_WD + 5767168;
constexpr size_t OFF_P = OFF_H + 134217728;
constexpr size_t OFF_O = OFF_P + 436207616;
constexpr size_t OFF_G = OFF_O + 134217728;
constexpr size_t GSZ = 33554432;
constexpr size_t OFF_GCD = OFF_G + 5 * GSZ;
constexpr size_t OFF_L = OFF_GCD + 16384;
constexpr size_t LSZ = 67108864;
constexpr size_t OFF_LCA = OFF_L + 2 * LSZ;
constexpr size_t OFF_LCH = OFF_LCA + 2097152;
constexpr size_t OFF_BON = OFF_LCH + 2097152;
constexpr size_t OFF_CTR = OFF_BON + 1048576;
constexpr size_t OFF_BAR = OFF_CTR + 256;
constexpr size_t WS_NEED = OFF_BAR + 16384;

struct Params { const float* in[38]; float* out; char* ws; };
enum { I_X = 0, I_C, I_N1G, I_N2G, I_FG, I_WADA, I_BADA, I_WIN, I_LCW, I_LCB, I_LWR, I_LBR, I_LWI, I_LBI, I_LLAM,
       I_GCW, I_GAL, I_GDT, I_GNG, I_RMU, I_RW0, I_RWUP, I_RA0, I_RAUP, I_RGUP, I_RKK, I_RKA, I_RRK, I_RLG, I_RLB,
       I_WBR, I_WGATE, I_BGATE, I_WOUT, I_FWG, I_FWU, I_FCW, I_FWD };

DI float bf2f(bf16_t v) { return __uint_as_float(((unsigned)v) << 16); }
typedef __bf16 bf16n2 __attribute__((ext_vector_type(2)));
typedef float f32x2_ __attribute__((ext_vector_type(2)));
DI unsigned pack2(float lo, float hi) { f32x2_ v = {lo, hi}; bf16n2 b = __builtin_convertvector(v, bf16n2); return __builtin_bit_cast(unsigned, b); }
DI bf16_t f2bf(float x) { return (bf16_t)(pack2(x, x) & 0xffffu); }
DI float sigmoidf_(float x) { return __builtin_amdgcn_rcpf(1.f + __expf(-x)); }
DI float sigmoid_rcp(float x) { return __builtin_amdgcn_rcpf(1.f + __expf(-x)); }
DI float gelu_rcp(float x) { float u = 0.7978845608f * (x + 0.044715f * x * x * x); return x * __builtin_amdgcn_rcpf(1.f + __expf(-2.f * u)); }
DI float softplusf_(float x) { return fmaxf(x, 0.f) + __logf(1.f + __expf(-fabsf(x))); }
DI float siluf_(float x) { return x * __builtin_amdgcn_rcpf(1.f + __expf(-x)); }
DI float geluf_(float x) { float u = 0.7978845608f * (x + 0.044715f * x * x * x); return x * __builtin_amdgcn_rcpf(1.f + __expf(-2.f * u)); }
DI float tanhf_(float x) { return 1.f - 2.f * __builtin_amdgcn_rcpf(1.f + __expf(2.f * x)); }
DI float wave_sum(float x) {
#pragma unroll
  for (int o = 32; o >= 1; o >>= 1) x += __shfl_xor(x, o);
  return x;
}
template <int CTRL> DI float dppf(float x) { return __int_as_float(__builtin_amdgcn_update_dpp(0, __float_as_int(x), CTRL, 0xf, 0xf, true)); }
DI float reduce8(float x) { x += dppf<0xB1>(x); x += dppf<0x4E>(x); x += dppf<0x141>(x); return x; }
DI f32x16 mfma32(bf16x8 a, bf16x8 b, f32x16 c) { return __builtin_amdgcn_mfma_f32_32x32x16_bf16(a, b, c, 0, 0, 0); }
DI f32x4 mfma16(bf16x8 a, bf16x8 b, f32x4 c) { return __builtin_amdgcn_mfma_f32_16x16x32_bf16(a, b, c, 0, 0, 0); }
DI int crow(int i, int h) { return (i & 3) + 8 * (i >> 2) + 4 * h; }

DI float modv(const float* modp, const float* bada, int l, int b, int idx) {
  const float* q = modp + ((size_t)(l * 16 + b)) * 6144 + idx;
  const size_t ks = (size_t)4 * 16 * 6144;
  return bada[l * 6144 + idx] + q[0] + q[ks] + q[2 * ks] + q[3 * ks];
}

DI int otid() { int t = threadIdx.x; asm volatile("" : "+v"(t)); return t; }
DI int obid() { int b = blockIdx.x; asm volatile("" : "+s"(b)); return b; }
DI void phase_mod(const Params& p, char* smem) {
  float* sm = (float*)smem;
  float* modp = (float*)(p.ws + OFF_MODP);
  const int tid = otid();
  if (obid() == 0 && tid < 64) ((unsigned*)(p.ws + OFF_CTR))[tid] = 0u;
  for (int item = obid(); item < 192; item += gridDim.x) {
    const int l = item / 48, rem = item % 48, jb = rem >> 2, kq = rem & 3;
    for (int i = 0; i < 8; ++i) {
      int e = tid + 512 * i; int b = e >> 8, k = e & 255;
      float cv = p.in[I_C][b * 1024 + kq * 256 + k];
      sm[e] = siluf_(cv);
    }
    __syncthreads();
    float acc[16];
#pragma unroll
    for (int b = 0; b < 16; ++b) acc[b] = 0.f;
    const float* wp = p.in[I_WADA] + ((size_t)l * 1024 + kq * 256) * 6144 + jb * 512 + tid;
    for (int k = 0; k < 256; k += 4) {
      float w0 = wp[(size_t)k * 6144], w1 = wp[(size_t)(k + 1) * 6144], w2 = wp[(size_t)(k + 2) * 6144], w3 = wp[(size_t)(k + 3) * 6144];
#pragma unroll
      for (int b = 0; b < 16; ++b) {
        f32x4 cv = *(const f32x4*)(sm + b * 256 + k);
        acc[b] += cv[0] * w0 + cv[1] * w1 + cv[2] * w2 + cv[3] * w3;
      }
    }
#pragma unroll
    for (int b = 0; b < 16; ++b) modp[((size_t)((kq * 4 + l) * 16 + b)) * 6144 + jb * 512 + tid] = acc[b];
    __syncthreads();
  }
}

DI void conv_tile(const float* src, bf16_t* dst, int K, int N, int k0, int n0, char* smem) {
  float* tile = (float*)smem;
  const int tid = otid();
#pragma unroll
  for (int it = 0; it < 2; ++it) {
    int kr = (tid >> 4) + 32 * it, nc = (tid & 15) * 4;
    f32x4 v = {0.f, 0.f, 0.f, 0.f};
    if (n0 + nc < N) v = *(const f32x4*)(src + (size_t)(k0 + kr) * N + n0 + nc);
    tile[kr * 65 + nc] = v[0]; tile[kr * 65 + nc + 1] = v[1]; tile[kr * 65 + nc + 2] = v[2]; tile[kr * 65 + nc + 3] = v[3];
  }
  __syncthreads();
  {
    int n = tid >> 3, kc = (tid & 7) * 8;
    unsigned o[4];
#pragma unroll
    for (int e = 0; e < 4; ++e) o[e] = pack2(tile[(kc + 2 * e) * 65 + n], tile[(kc + 2 * e + 1) * 65 + n]);
    uint4 ov = {o[0], o[1], o[2], o[3]};
    *(uint4*)(dst + (size_t)(n0 + n) * K + k0 + kc) = ov;
  }
  __syncthreads();
}

DI void phase_convert(const Params& p, int l, char* smem) {
  for (int t = obid(); t < 4480; t += gridDim.x) {
    const float* src; bf16_t* dst; int K, N, Npad, tt = t;
    if (tt < 832) { src = p.in[I_WIN] + (size_t)l * 1024 * 3208; dst = (bf16_t*)(p.ws + OFF_WIN); K = 1024; N = 3208; Npad = 3328; }
    else if ((tt -= 832) < 1024) { int br = tt >> 8; tt &= 255; src = p.in[I_WGATE] + ((size_t)l * 4 + br) * 1048576; dst = (bf16_t*)(p.ws + OFF_WG) + (size_t)br * 1048576; K = 1024; N = 1024; Npad = 1024; }
    else if ((tt -= 1024) < 256) { int br = tt >> 6; tt &= 63; src = p.in[I_WBR] + ((size_t)l * 4 + br) * 262144; dst = (bf16_t*)(p.ws + OFF_WBR) + (size_t)br * 262144; K = 256; N = 1024; Npad = 1024; }
    else if ((tt -= 256) < 256) { src = p.in[I_WOUT] + (size_t)l * 1048576; dst = (bf16_t*)(p.ws + OFF_WO); K = 1024; N = 1024; Npad = 1024; }
    else if ((tt -= 256) < 704) { src = p.in[I_FWG] + (size_t)l * 1024 * 2816; dst = (bf16_t*)(p.ws + OFF_WF); K = 1024; N = 2816; Npad = 2816; }
    else if ((tt -= 704) < 704) { src = p.in[I_FWU] + (size_t)l * 1024 * 2816; dst = (bf16_t*)(p.ws + OFF_WF) + (size_t)2816 * 1024; K = 1024; N = 2816; Npad = 2816; }
    else { tt -= 704; src = p.in[I_FWD] + (size_t)l * 2816 * 1024; dst = (bf16_t*)(p.ws + OFF_WD); K = 2816; N = 1024; Npad = 1024; }
    const int nNt = Npad >> 6;
    const int kt = tt / nNt, nt = tt % nNt;
    conv_tile(src, dst, K, N, kt * 64, nt * 64, smem);
  }
}

DI void phase_norm(const Params& p, const float* xin, const float* g, int l, int scale_idx, int shift_idx, bf16_t* hout, float* fout) {
  const float* modp = (const float*)(p.ws + OFF_MODP);
  const int lane = otid() & 63, wv = otid() >> 6;
  const int nw = gridDim.x * 8;
  const int rows_per = 32;
  for (int chunk = obid() * 8 + wv; chunk < NTOK / 32; chunk += nw) {
  const int row0 = chunk * rows_per;
  const int b = row0 / SEQ;
  f32x4 gv[4], sc[4], sh[4];
#pragma unroll
  for (int j = 0; j < 4; ++j) {
    int c = lane * 4 + 256 * j;
    gv[j] = *(const f32x4*)(g + c);
    if (hout) {
#pragma unroll
      for (int e = 0; e < 4; ++e) {
        sc[j][e] = 1.f + modv(modp, p.in[I_BADA], l, b, scale_idx + c + e);
        sh[j][e] = modv(modp, p.in[I_BADA], l, b, shift_idx + c + e);
      }
    }
  }
  for (int rr = 0; rr < rows_per; ++rr) {
    const size_t row = (size_t)row0 + rr;
    f32x4 xv[4]; float ss = 0.f;
#pragma unroll
    for (int j = 0; j < 4; ++j) {
      xv[j] = *(const f32x4*)(xin + row * DM + lane * 4 + 256 * j);
      ss += xv[j][0] * xv[j][0] + xv[j][1] * xv[j][1] + xv[j][2] * xv[j][2] + xv[j][3] * xv[j][3];
    }
    ss = wave_sum(ss);
    const float rs = rsqrtf(ss * (1.f / 1024.f) + EPSF);
#pragma unroll
    for (int j = 0; j < 4; ++j) {
      f32x4 y = xv[j] * rs * gv[j];
      if (hout) {
        y = y * sc[j] + sh[j];
        uint2 o = {pack2(y[0], y[1]), pack2(y[2], y[3])};
        *(uint2*)(hout + row * DM + lane * 4 + 256 * j) = o;
      } else {
        *(f32x4*)(fout + row * DM + lane * 4 + 256 * j) = y;
      }
    }
  }
  }
}

#define PG_LAS __attribute__((address_space(3)))
namespace pg {
constexpr int BM = 256, BK = 64, HALF = 128, HTB = HALF * BK * 2, NXCD = 8, WGM = 8;
DI int lds_byte(int r, int c) { const int st = (r >> 4) * 2 + (c >> 5), rr = r & 15, cc = c & 31, ob = rr * 64 + cc * 2; return st * 1024 + (ob ^ (((ob >> 9) & 1) << 5)); }
DI void stage_rc(int b, int& R, int& C) { const int st = b / 1024, sb = b % 1024, swz = sb ^ (((sb >> 9) & 1) << 5); R = (st >> 1) * 16 + swz / 64; C = (st & 1) * 32 + (swz % 64) / 2; }
DI int perm32(int rho) { const int n = rho >> 4, i = rho & 15; return 8 * (i >> 2) + 4 * n + (i & 3); }
struct Unit { int pm, pn; int aux; long ao, bo; };
template <int REP> struct Order {
  int nM, nN, nwg, G, c, ashift; long astep, bstep, apnstep;
  DI void init(int M, int N, int G_, int c_, long astep_ = 0, long bstep_ = 0, int ashift_ = 0, long apnstep_ = 0) {
    nM = M / BM; nN = N / BM; nwg = nM * nN; G = G_; c = c_; astep = astep_; bstep = bstep_; ashift = ashift_; apnstep = apnstep_; }
  DI bool next(int i, Unit& u) const {
    const int ti = i / REP, aux = i % REP;
    const long L = (long)ti * G + c; if (L >= nwg) return false;
    int wgid = (int)L; { const int q = nwg / NXCD, r = nwg % NXCD, xcd = wgid % NXCD, off = wgid / NXCD; wgid = (xcd < r ? xcd * (q + 1) : r * (q + 1) + (xcd - r) * q) + off; }
    const int nig = WGM * nN, gid = wgid / nig, fm = gid * WGM, gsz = (nM - fm) < WGM ? (nM - fm) : WGM;
    u.pm = fm + ((wgid % nig) % gsz); u.pn = (wgid % nig) / gsz; u.aux = aux; u.ao = aux * astep + (long)(u.pn >> ashift) * apnstep; u.bo = aux * bstep; return true;
  }
};
DI unsigned cvt_pk_bf16(float lo, float hi) { return pack2(lo, hi); }

template <class Epi, class Sched>
DI void gemm_phase(PG_LAS unsigned char* lds, const bf16_t* Ag, int lda, const bf16_t* Bg, int K, const Sched& S, const Epi& E) {
  const int tid = otid(), wid = __builtin_amdgcn_readfirstlane(tid >> 6), lane = tid & 63, wr = wid >> 2, wc = wid & 3, fr = lane & 15, fq = lane >> 4;
  const int nt = K / BK;
  unsigned voffA[2], voffB[2];
#pragma unroll
  for (int i = 0; i < 2; ++i) { int R, C; stage_rc(tid * 16 + i * 8192, R, C); const int Rb = Epi::PERM ? ((R & ~31) + perm32(R & 31)) : R;
    voffA[i] = (unsigned)(R * lda + C) * 2u; voffB[i] = (unsigned)(Rb * K + C) * 2u; }
  const size_t kstep = (size_t)(BK * 2);
  const size_t hstepA = (size_t)HALF * lda * 2, hstepB = (size_t)HALF * K * 2;
  const size_t tstepA = 2 * hstepA, tstepB = 2 * hstepB;
  const unsigned ldsw = (unsigned)wid * 1024u;
  const int aoff = lds_byte(wr * 64 + fr, fq * 8), boff = lds_byte(wc * 32 + fr, fq * 8);
#define PG_SA(b, h) (((b) * 2 + (h)) * HTB)
#define PG_SB(b, h) ((4 + (b) * 2 + (h)) * HTB)
#define PG_STAGE(bufoff, gbase, voff) do { _Pragma("unroll") for (int _i = 0; _i < 2; ++_i) \
    __builtin_amdgcn_global_load_lds((const unsigned*)((const char*)(gbase) + (voff)[_i]), (PG_LAS unsigned*)(lds + (bufoff) + ldsw + _i * 8192), 16, 0, 0); } while (0)
#define PG_LDA(dst, b, h) do { _Pragma("unroll") for (int m = 0; m < 4; ++m) _Pragma("unroll") for (int k = 0; k < 2; ++k) dst[m][k] = *(const PG_LAS bf16x8*)(lds + PG_SA(b, h) + aoff + m * 2048 + k * 1024); } while (0)
#define PG_LDB(dst, b, h) do { _Pragma("unroll") for (int n = 0; n < 2; ++n) _Pragma("unroll") for (int k = 0; k < 2; ++k) dst[n][k] = *(const PG_LAS bf16x8*)(lds + PG_SB(b, h) + boff + n * 2048 + k * 1024); } while (0)
#define PG_MMA(ai, bj, At, Bt) do { __builtin_amdgcn_s_setprio(1); _Pragma("unroll") for (int m = 0; m < 4; ++m) _Pragma("unroll") for (int n = 0; n < 2; ++n) _Pragma("unroll") for (int k = 0; k < 2; ++k) \
    acc[ai][bj][m][n] = __builtin_amdgcn_mfma_f32_16x16x32_bf16(Bt[n][k], At[m][k], acc[ai][bj][m][n], 0, 0, 0); __builtin_amdgcn_s_setprio(0); } while (0)
#define PG_WAIT_V(n) asm volatile("s_waitcnt vmcnt(" #n ")" ::: "memory")
#define PG_WAIT_L(n) asm volatile("s_waitcnt lgkmcnt(" #n ")" ::: "memory")
#define PG_BAR __builtin_amdgcn_s_barrier()
#define PG_SCHED __builtin_amdgcn_sched_barrier(0)
  Unit cur, nxt; int ui = 0;
  if (!S.next(0, cur)) return;
  f32x4 acc[2][2][4][2];
#pragma unroll
  for (int a = 0; a < 2; ++a)
#pragma unroll
    for (int b = 0; b < 2; ++b)
#pragma unroll
      for (int m = 0; m < 4; ++m)
#pragma unroll
        for (int n = 0; n < 2; ++n) acc[a][b][m][n] = (f32x4){0.f, 0.f, 0.f, 0.f};
  bf16x8 At[4][2], B0[2][2], B1[2][2];
  const char* cA = (const char*)Ag + (size_t)cur.pm * tstepA + cur.ao; const char* cB = (const char*)Bg + (size_t)cur.pn * tstepB + cur.bo;
  PG_STAGE(PG_SB(0, 0), cB, voffB); PG_STAGE(PG_SA(0, 0), cA, voffA); PG_STAGE(PG_SB(0, 1), cB + hstepB, voffB); PG_STAGE(PG_SA(0, 1), cA + hstepA, voffA);
  if (wr == 1) PG_BAR;
  PG_WAIT_V(4); PG_BAR;
  PG_STAGE(PG_SB(1, 0), cB + kstep, voffB); PG_STAGE(PG_SA(1, 0), cA + kstep, voffA); PG_STAGE(PG_SB(1, 1), cB + hstepB + kstep, voffB);
  PG_WAIT_V(6); PG_BAR;
  for (;;) {
    const bool has_next = S.next(ui + 1, nxt);
    const char* nA = has_next ? (const char*)Ag + (size_t)nxt.pm * tstepA + nxt.ao : cA; const char* nB = has_next ? (const char*)Bg + (size_t)nxt.pn * tstepB + nxt.bo : cB;
#pragma unroll 1
    for (int t = 0; t < nt; t += 2) {
      const bool last = (t == nt - 2);
      const char* a1 = cA + (size_t)(t + 1) * kstep;
      const char* a2 = last ? nA : cA + (size_t)(t + 2) * kstep; const char* b2 = last ? nB : cB + (size_t)(t + 2) * kstep;
      const char* a3 = a2 + kstep; const char* b3 = b2 + kstep;
      PG_LDB(B0, 0, 0); PG_SCHED; PG_LDA(At, 0, 0); PG_STAGE(PG_SA(1, 1), a1 + hstepA, voffA);
      PG_WAIT_L(8); PG_BAR; PG_WAIT_L(0); PG_MMA(0, 0, At, B0); PG_BAR; PG_SCHED;
      PG_LDB(B1, 0, 1); PG_STAGE(PG_SB(0, 0), b2, voffB);
      PG_BAR; PG_WAIT_L(0); PG_MMA(0, 1, At, B1); PG_BAR;
      PG_LDA(At, 0, 1); PG_STAGE(PG_SA(0, 0), a2, voffA);
      PG_BAR; PG_WAIT_L(0); PG_MMA(1, 0, At, B0); PG_BAR; PG_SCHED;
      PG_STAGE(PG_SB(0, 1), b2 + hstepB, voffB);
      PG_WAIT_V(6); PG_BAR; PG_MMA(1, 1, At, B1); PG_BAR;
      PG_LDB(B0, 1, 0); PG_SCHED; PG_LDA(At, 1, 0); PG_STAGE(PG_SA(0, 1), a2 + hstepA, voffA);
      PG_WAIT_L(8); PG_BAR; PG_WAIT_L(0); PG_MMA(0, 0, At, B0); PG_BAR; PG_SCHED;
      PG_LDB(B1, 1, 1); PG_STAGE(PG_SB(1, 0), b3, voffB);
      PG_BAR; PG_WAIT_L(0); PG_MMA(0, 1, At, B1); PG_BAR;
      PG_LDA(At, 1, 1); PG_STAGE(PG_SA(1, 0), a3, voffA);
      PG_BAR; PG_WAIT_L(0); PG_MMA(1, 0, At, B0); PG_BAR; PG_SCHED;
      PG_STAGE(PG_SB(1, 1), b3 + hstepB, voffB);
      PG_WAIT_V(6); PG_BAR; PG_MMA(1, 1, At, B1); PG_BAR;
    }
    E(acc, cur, wr, wc, fr, fq);
    if (!has_next) break;
#pragma unroll
    for (int a = 0; a < 2; ++a)
#pragma unroll
      for (int b = 0; b < 2; ++b)
#pragma unroll
        for (int m = 0; m < 4; ++m)
#pragma unroll
          for (int n = 0; n < 2; ++n) acc[a][b][m][n] = (f32x4){0.f, 0.f, 0.f, 0.f};
    cur = nxt; cA = nA; cB = nB; ++ui;
  }
  PG_WAIT_V(0);
  if (wr == 0) PG_BAR;
  PG_BAR;
#undef PG_SA
#undef PG_SB
#undef PG_STAGE
#undef PG_LDA
#undef PG_LDB
#undef PG_MMA
#undef PG_WAIT_V
#undef PG_WAIT_L
#undef PG_BAR
#undef PG_SCHED
}

template <int ACT> struct EpiBf16 {
  static constexpr bool PERM = true;
  bf16_t* O; int ldc; const float* bias;
  DI void operator()(const f32x4 (&acc)[2][2][4][2], const Unit& u, int wr, int wc, int fr, int fq) const {
    const int row0 = u.pm * BM + wr * 64 + fr, col0 = u.pn * BM + wc * 32 + 8 * fq;
    f32x4 bv[2][2];
#pragma unroll
    for (int bj = 0; bj < 2; ++bj)
#pragma unroll
      for (int n = 0; n < 2; ++n) bv[bj][n] = ACT ? *(const f32x4*)(bias + col0 + bj * HALF + 4 * n) : (f32x4){0.f, 0.f, 0.f, 0.f};
#pragma unroll
    for (int ai = 0; ai < 2; ++ai)
#pragma unroll
      for (int m = 0; m < 4; ++m) { bf16_t* rowp = O + (size_t)(row0 + ai * HALF + m * 16) * ldc + col0;
#pragma unroll
        for (int bj = 0; bj < 2; ++bj) { f32x4 v0 = acc[ai][bj][m][0], v1 = acc[ai][bj][m][1];
          if (ACT) { v0 += bv[bj][0]; v1 += bv[bj][1];
#pragma unroll
            for (int j = 0; j < 4; ++j) { v0[j] = sigmoid_rcp(v0[j]); v1[j] = sigmoid_rcp(v1[j]); } }
          u32x4 w; w.x = cvt_pk_bf16(v0[0], v0[1]); w.y = cvt_pk_bf16(v0[2], v0[3]); w.z = cvt_pk_bf16(v1[0], v1[1]); w.w = cvt_pk_bf16(v1[2], v1[3]);
          *(u32x4*)(rowp + bj * HALF) = w; } }
  }
};
struct EpiBranch {
  static constexpr bool PERM = true;
  bf16_t* MIX; const bf16_t* G;
  DI void operator()(const f32x4 (&acc)[2][2][4][2], const Unit& u, int wr, int wc, int fr, int fq) const {
    const int row0 = u.pm * BM + wr * 64 + fr, col0 = u.pn * BM + wc * 32 + 8 * fq;
#pragma unroll
    for (int ai = 0; ai < 2; ++ai)
#pragma unroll
      for (int m = 0; m < 4; ++m) {
        asm volatile("" ::: "memory");
        const size_t row = (size_t)(row0 + ai * HALF + m * 16);
        bf16_t* mp = MIX + row * DM + col0; const bf16_t* gp = G + row * 4096 + u.aux * 1024 + col0;
#pragma unroll
        for (int bj = 0; bj < 2; ++bj) {
          const bf16x8 gv = *(const bf16x8*)(gp + bj * HALF);
          float o[8];
#pragma unroll
          for (int j = 0; j < 4; ++j) { o[j] = bf2f((bf16_t)gv[j]) * acc[ai][bj][m][0][j]; o[4 + j] = bf2f((bf16_t)gv[4 + j]) * acc[ai][bj][m][1][j]; }
          if (u.aux > 0) {
            const bf16x8 mv = *(const bf16x8*)(mp + bj * HALF);
#pragma unroll
            for (int j = 0; j < 8; ++j) o[j] += bf2f((bf16_t)mv[j]);
          }
          u32x4 w; w.x = cvt_pk_bf16(o[0], o[1]); w.y = cvt_pk_bf16(o[2], o[3]); w.z = cvt_pk_bf16(o[4], o[5]); w.w = cvt_pk_bf16(o[6], o[7]);
          *(u32x4*)(mp + bj * HALF) = w;
        }
      }
  }
};
struct EpiResid {
  static constexpr bool PERM = false;
  const float* xold; float* xnew; const float* modp; const float* bada; int l, gate_idx;
  DI void operator()(const f32x4 (&acc)[2][2][4][2], const Unit& u, int wr, int wc, int fr, int fq) const {
    const int row0 = u.pm * BM + wr * 64 + fr, col0 = u.pn * BM + wc * 32 + 4 * fq;
    const int b = (u.pm * BM) / SEQ;
    f32x4 gv[2][2];
#pragma unroll
    for (int bj = 0; bj < 2; ++bj)
#pragma unroll
      for (int n = 0; n < 2; ++n)
#pragma unroll
        for (int j = 0; j < 4; ++j) gv[bj][n][j] = modv(modp, bada, l, b, gate_idx + col0 + bj * HALF + n * 16 + j);
#pragma unroll
    for (int ai = 0; ai < 2; ++ai)
#pragma unroll
      for (int m = 0; m < 4; ++m) { const size_t ro = (size_t)(row0 + ai * HALF + m * 16) * DM + col0;
#pragma unroll
        for (int bj = 0; bj < 2; ++bj)
#pragma unroll
          for (int n = 0; n < 2; ++n) {
            const f32x4 xo = *(const f32x4*)(xold + ro + bj * HALF + n * 16);
            *(f32x4*)(xnew + ro + bj * HALF + n * 16) = xo + gv[bj][n] * acc[ai][bj][m][n];
          } }
  }
};
struct EpiFfnAct {
  static constexpr bool PERM = true;
  bf16_t* ACT; const bf16_t* APRE; const float* cw;
  DI void operator()(const f32x4 (&acc)[2][2][4][2], const Unit& u, int wr, int wc, int fr, int fq) const {
    const int row0 = u.pm * BM + wr * 64 + fr, col0 = u.pn * BM + wc * 32 + 8 * fq;
#pragma unroll
    for (int ai = 0; ai < 2; ++ai)
#pragma unroll
      for (int m = 0; m < 4; ++m) {
        asm volatile("" ::: "memory");
        const int row = row0 + ai * HALF + m * 16; const int sp = row & (SEQ - 1);
        const bf16_t* ap = APRE + (size_t)row * FFN + col0;
        bf16_t* op = ACT + (size_t)row * FFN + col0;
#pragma unroll
        for (int bj = 0; bj < 2; ++bj) {
          const int c = bj * HALF;
          const bf16x8 z8 = {0, 0, 0, 0, 0, 0, 0, 0};
          const bf16x8 a0 = *(const bf16x8*)(ap + c);
          const bf16x8 a1 = sp >= 1 ? *(const bf16x8*)(ap - FFN + c) : z8;
          const bf16x8 a2 = sp >= 2 ? *(const bf16x8*)(ap - 2 * FFN + c) : z8;
          float o[8];
#pragma unroll
          for (int hh = 0; hh < 2; ++hh) {
            const f32x4 w0 = *(const f32x4*)(cw + col0 + c + 4 * hh), w1 = *(const f32x4*)(cw + FFN + col0 + c + 4 * hh), w2 = *(const f32x4*)(cw + 2 * FFN + col0 + c + 4 * hh);
#pragma unroll
            for (int j = 0; j < 4; ++j) {
              const float cv = w0[j] * bf2f((bf16_t)a2[4 * hh + j]) + w1[j] * bf2f((bf16_t)a1[4 * hh + j]) + w2[j] * bf2f((bf16_t)a0[4 * hh + j]);
              o[4 * hh + j] = gelu_rcp(cv) * acc[ai][bj][m][hh][j];
            }
          }
          u32x4 w; w.x = cvt_pk_bf16(o[0], o[1]); w.y = cvt_pk_bf16(o[2], o[3]); w.z = cvt_pk_bf16(o[4], o[5]); w.w = cvt_pk_bf16(o[6], o[7]);
          *(u32x4*)(op + c) = w;
        }
      }
  }
};
struct EpiGateMix {
  static constexpr bool PERM = true;
  bf16_t* MIX; float* MIX32; const bf16_t* BH; const float* bias;
  DI void operator()(const f32x4 (&acc)[2][2][4][2], const Unit& u, int wr, int wc, int fr, int fq) const {
    const int row0 = u.pm * BM + wr * 64 + fr, col0 = u.pn * BM + wc * 32 + 8 * fq;
    const bool rmw = u.aux > 0, fin = u.aux == 3;
    f32x4 bv[2][2];
#pragma unroll
    for (int bj = 0; bj < 2; ++bj)
#pragma unroll
      for (int n = 0; n < 2; ++n) bv[bj][n] = *(const f32x4*)(bias + u.aux * 1024 + col0 + bj * HALF + 4 * n);
    const f32x4 z4 = {0.f, 0.f, 0.f, 0.f};
    bf16x8 nb[2]; f32x4 nm[2][2];
#define GM_LOAD(it_) { const size_t row_ = (size_t)(row0 + ((it_) >> 2) * HALF + ((it_) & 3) * 16); \
      _Pragma("unroll") for (int bj = 0; bj < 2; ++bj) { nb[bj] = *(const bf16x8*)(BH + row_ * 4096 + u.aux * 1024 + col0 + bj * HALF); \
        nm[bj][0] = rmw ? *(const f32x4*)(MIX32 + row_ * DM + col0 + bj * HALF) : z4; nm[bj][1] = rmw ? *(const f32x4*)(MIX32 + row_ * DM + col0 + bj * HALF + 4) : z4; } }
    GM_LOAD(0);
#pragma unroll
    for (int it = 0; it < 8; ++it) {
      const int ai = it >> 2, m = it & 3;
      bf16x8 cb[2]; f32x4 cm[2][2];
#pragma unroll
      for (int bj = 0; bj < 2; ++bj) { cb[bj] = nb[bj]; cm[bj][0] = nm[bj][0]; cm[bj][1] = nm[bj][1]; }
      if (it + 1 < 8) GM_LOAD(it + 1);
      const size_t ro = (size_t)(row0 + ai * HALF + m * 16) * DM + col0;
#pragma unroll
      for (int bj = 0; bj < 2; ++bj) {
        f32x4 o[2];
#pragma unroll
        for (int hh = 0; hh < 2; ++hh)
#pragma unroll
          for (int j = 0; j < 4; ++j)
            o[hh][j] = sigmoid_rcp(acc[ai][bj][m][hh][j] + bv[bj][hh][j]) * bf2f((bf16_t)cb[bj][4 * hh + j]) + cm[bj][hh][j];
        if (fin) {
          u32x4 w; w.x = cvt_pk_bf16(o[0][0], o[0][1]); w.y = cvt_pk_bf16(o[0][2], o[0][3]); w.z = cvt_pk_bf16(o[1][0], o[1][1]); w.w = cvt_pk_bf16(o[1][2], o[1][3]);
          *(u32x4*)(MIX + ro + bj * HALF) = w;
        } else {
          *(f32x4*)(MIX32 + ro + bj * HALF) = o[0]; *(f32x4*)(MIX32 + ro + bj * HALF + 4) = o[1];
        }
      }
    }
#undef GM_LOAD
  }
};
}

DI void phase_ffn_act(const Params& p, int l) {
  bf16_t* AU = (bf16_t*)(p.ws + OFF_P);
  const float* cw = p.in[I_FCW] + (size_t)l * 3 * FFN;
  const int nthr = gridDim.x * NTHR;
  for (int run = obid() * NTHR + otid(); run < 1024 * 352; run += nthr) {
    const int ch = run / 352, j8 = run % 352, j0 = j8 * 8;
    float w0[8], w1[8], w2[8];
#pragma unroll
    for (int e = 0; e < 8; ++e) { w0[e] = cw[j0 + e]; w1[e] = cw[FFN + j0 + e]; w2[e] = cw[2 * FFN + j0 + e]; }
    const int t0 = ch * 64, s0 = t0 % SEQ;
    float a1[8], a2[8];
#pragma unroll
    for (int e = 0; e < 8; ++e) { a1[e] = 0.f; a2[e] = 0.f; }
    if (s0 > 0) {
      bf16x8 v1 = *(const bf16x8*)(AU + (size_t)(t0 - 1) * AUS + j0);
      bf16x8 v2 = *(const bf16x8*)(AU + (size_t)(t0 - 2) * AUS + j0);
#pragma unroll
      for (int e = 0; e < 8; ++e) { a1[e] = bf2f((bf16_t)v1[e]); a2[e] = bf2f((bf16_t)v2[e]); }
    }
    for (int t = t0; t < t0 + 64; ++t) {
      bf16x8 va = *(const bf16x8*)(AU + (size_t)t * AUS + j0);
      bf16x8 vu = *(const bf16x8*)(AU + (size_t)t * AUS + FFN + j0);
      float o[8];
#pragma unroll
      for (int e = 0; e < 8; ++e) {
        float a0 = bf2f((bf16_t)va[e]);
        float cv = w0[e] * a2[e] + w1[e] * a1[e] + w2[e] * a0;
        o[e] = geluf_(cv) * bf2f((bf16_t)vu[e]);
        a2[e] = a1[e]; a1[e] = a0;
      }
      uint4 ov = {pack2(o[0], o[1]), pack2(o[2], o[3]), pack2(o[4], o[5]), pack2(o[6], o[7])};
      *(uint4*)(AU + (size_t)t * AUS + FFN + j0) = ov;
    }
  }
}

DI float mixf(bf16_t cur, bf16_t prev, float mu) { const float c = bf2f(cur); return c + (bf2f(prev) - c) * mu; }
DI void rw_prep_item(const Params& p, int l, int item, char* smem) {
  const bf16_t* P = (const bf16_t*)(p.ws + OFF_P);
  bf16_t* RD = (bf16_t*)(p.ws + OFF_L);
  bf16_t* RKK = (bf16_t*)(p.ws + OFF_L + GSZ);
  bf16_t* RA = (bf16_t*)(p.ws + OFF_L + 2 * GSZ);
  bf16_t* RG = (bf16_t*)(p.ws + OFF_L + 3 * GSZ);
  float* BON = (float*)(p.ws + OFF_BON);
  const int b = item >> 6, ct = item & 63;
  const int tid = otid(), lane = tid & 63, wv = tid >> 6, hd = wv & 3, mi = wv >> 2, r = lane & 31, h = lane >> 5;
  bf16_t* TX = (bf16_t*)smem;
  bf16_t* XA = TX + 64 * 40;
  bf16_t* SG = XA + 64 * 40;
  bf16_t* RK = SG + 64 * 72;
  const float* mu = p.in[I_RMU] + (size_t)l * 896;
  const size_t tok0 = (size_t)b * SEQ + ct * 64;
  bf16x8 bw[2][2], ba[2][2], bg[2][4];
  {
    const float* wp = p.in[I_RWUP] + (size_t)l * 32 * 256 + hd * 64 + r;
    const float* ap = p.in[I_RAUP] + (size_t)l * 32 * 256 + hd * 64 + r;
    const float* gp = p.in[I_RGUP] + (size_t)l * 64 * 256 + hd * 64 + r;
    asm volatile("" : "+v"(wp), "+v"(ap), "+v"(gp));
#pragma unroll
    for (int ni = 0; ni < 2; ++ni) {
#pragma unroll
      for (int ks = 0; ks < 2; ++ks) {
        unsigned uw[4], ua[4];
#pragma unroll
        for (int j2 = 0; j2 < 4; ++j2) {
          const int k = 16 * ks + 8 * h + 2 * j2;
          uw[j2] = pack2(wp[k * 256 + 32 * ni], wp[(k + 1) * 256 + 32 * ni]);
          ua[j2] = pack2(ap[k * 256 + 32 * ni], ap[(k + 1) * 256 + 32 * ni]);
        }
        uint4 t1 = {uw[0], uw[1], uw[2], uw[3]}, t2 = {ua[0], ua[1], ua[2], ua[3]};
        bw[ni][ks] = __builtin_bit_cast(bf16x8, t1); ba[ni][ks] = __builtin_bit_cast(bf16x8, t2);
      }
#pragma unroll
      for (int ks = 0; ks < 4; ++ks) {
        unsigned ug[4];
#pragma unroll
        for (int j2 = 0; j2 < 4; ++j2) { const int k = 16 * ks + 8 * h + 2 * j2; ug[j2] = pack2(gp[k * 256 + 32 * ni], gp[(k + 1) * 256 + 32 * ni]); }
        uint4 t3 = {ug[0], ug[1], ug[2], ug[3]};
        bg[ni][ks] = __builtin_bit_cast(bf16x8, t3);
      }
    }
  }
#pragma unroll 4
  for (int i = 0; i < 16; ++i) {
    const int e = tid + NTHR * i; const int t = e >> 7, f = e & 127;
    const bf16_t* pr = P + (tok0 + t) * PSTR + C_RW + 768 + f;
    const bf16_t cur = pr[0];
    const bf16_t prev = (ct * 64 + t > 0) ? (pr - PSTR)[0] : (bf16_t)0;
    const float m = mixf(cur, prev, mu[768 + f]);
    if (f < 32) TX[t * 40 + f] = f2bf(tanhf_(m));
    else if (f < 64) XA[t * 40 + f - 32] = f2bf(m);
    else SG[t * 72 + f - 64] = f2bf(sigmoidf_(m));
  }
#pragma unroll 2
  for (int i = 0; i < 8; ++i) {
    const int q = tid + NTHR * i; const int t = q >> 6, col = (q & 63) * 8;
    const bf16_t* pr = P + (tok0 + t) * PSTR + C_RW + col;
    const bf16x8 cur = *(const bf16x8*)pr;
    bf16x8 prev = {0, 0, 0, 0, 0, 0, 0, 0};
    if (ct * 64 + t > 0) prev = *(const bf16x8*)(pr - PSTR);
    const f32x4 m0 = *(const f32x4*)(mu + col), m1 = *(const f32x4*)(mu + col + 4);
    float o[8];
#pragma unroll
    for (int e = 0; e < 4; ++e) { o[e] = mixf((bf16_t)cur[e], (bf16_t)prev[e], m0[e]); o[4 + e] = mixf((bf16_t)cur[4 + e], (bf16_t)prev[4 + e], m1[e]); }
    uint4 ov = {pack2(o[0], o[1]), pack2(o[2], o[3]), pack2(o[4], o[5]), pack2(o[6], o[7])};
    *(uint4*)(RK + t * 520 + col) = ov;
  }
  __syncthreads();
  f32x16 cw[2], ca[2], cg[2];
#pragma unroll
  for (int ni = 0; ni < 2; ++ni)
#pragma unroll
    for (int i = 0; i < 16; ++i) { cw[ni][i] = 0.f; ca[ni][i] = 0.f; cg[ni][i] = 0.f; }
#pragma unroll
  for (int ks = 0; ks < 2; ++ks) {
    const bf16x8 atx = *(const bf16x8*)(TX + (32 * mi + r) * 40 + 16 * ks + 8 * h);
    const bf16x8 axa = *(const bf16x8*)(XA + (32 * mi + r) * 40 + 16 * ks + 8 * h);
#pragma unroll
    for (int ni = 0; ni < 2; ++ni) { cw[ni] = mfma32(atx, bw[ni][ks], cw[ni]); ca[ni] = mfma32(axa, ba[ni][ks], ca[ni]); }
  }
#pragma unroll
  for (int ks = 0; ks < 4; ++ks) {
    const bf16x8 asg = *(const bf16x8*)(SG + (32 * mi + r) * 72 + 16 * ks + 8 * h);
#pragma unroll
    for (int ni = 0; ni < 2; ++ni) cg[ni] = mfma32(asg, bg[ni][ks], cg[ni]);
  }
  float ss[16], bn[16];
#pragma unroll
  for (int i = 0; i < 16; ++i) { ss[i] = 0.f; bn[i] = 0.f; }
#pragma unroll
  for (int ni = 0; ni < 2; ++ni) {
    const int hc = hd * 64 + 32 * ni + r;
    const float w0c = p.in[I_RW0][l * 256 + hc], a0c = p.in[I_RA0][l * 256 + hc], kkc = p.in[I_RKK][l * 256 + hc],
                kac = p.in[I_RKA][l * 256 + hc], rkc = p.in[I_RRK][l * 256 + hc];
#pragma unroll
    for (int i = 0; i < 16; ++i) {
      const int tl = 32 * mi + crow(i, h);
      const size_t tok = tok0 + tl;
      const float rr = bf2f(RK[tl * 520 + hc]);
      const float k = bf2f(RK[tl * 520 + 256 + hc]);
      const float wl = w0c + cw[ni][i];
      const float wlog = -softplusf_(-wl) - 0.5f;
      const float dd = 1.f - __expf(-__expf(wlog));
      const float a = sigmoidf_(a0c + ca[ni][i]);
      const float kkr = k * kkc;
      const float kp = k * (1.f + (a - 1.f) * kac);
      ss[i] += kkr * kkr; bn[i] += rr * kp * rkc;
      cw[ni][i] = kkr;
      RD[tok * 256 + hc] = f2bf(dd); RA[tok * 256 + hc] = f2bf(a); RG[tok * 256 + hc] = f2bf(cg[ni][i]);
    }
  }
#pragma unroll
  for (int i = 0; i < 16; ++i) {
#pragma unroll
    for (int o = 1; o < 32; o <<= 1) { ss[i] += __shfl_xor(ss[i], o); bn[i] += __shfl_xor(bn[i], o); }
    ss[i] = rsqrtf(ss[i] + EPSF);
  }
#pragma unroll
  for (int ni = 0; ni < 2; ++ni) {
    const int hc = hd * 64 + 32 * ni + r;
#pragma unroll
    for (int i = 0; i < 16; ++i) {
      const size_t tok = tok0 + 32 * mi + crow(i, h);
      RKK[tok * 256 + hc] = f2bf(cw[ni][i] * ss[i]);
    }
  }
  if (r == 0) {
#pragma unroll
    for (int i = 0; i < 16; ++i) BON[(tok0 + 32 * mi + crow(i, h)) * 4 + hd] = bn[i];
  }
}

DI void rwkv_scan_item(const Params& p, int l, int b, int hd, int half, char* smem) {
  const bf16_t* P = (const bf16_t*)(p.ws + OFF_P);
  bf16_t* O = (bf16_t*)(p.ws + OFF_O);
  const bf16_t* RD = (const bf16_t*)(p.ws + OFF_L);
  const bf16_t* RKK = (const bf16_t*)(p.ws + OFF_L + GSZ);
  const bf16_t* RA = (const bf16_t*)(p.ws + OFF_L + 2 * GSZ);
  float* fb = (float*)smem;
  float* Yb = fb + 2 * 12352;
  const int tid = otid(), lane = tid & 63, wv = tid >> 6;
  const int hc = hd * 64 + lane;
  constexpr int NCH = SEQ / 32;
  f32x4 Sa = {0.f, 0.f, 0.f, 0.f}, Sb = {0.f, 0.f, 0.f, 0.f};
  const int rl = lane >> 3, kq = lane & 7, vloc = (wv & 3) * 8 + rl, vrow = half * 32 + vloc;
  const float* mu = p.in[I_RMU] + (size_t)l * 896;
  const float mu_r = mu[hc], mu_k = mu[256 + hc], mu_v = mu[512 + hc];
  const float kac = p.in[I_RKA][l * 256 + hc];
  const int pw = wv & 3;
  unsigned raw[8][9];
#pragma unroll
  for (int j = 0; j < 8; ++j)
#pragma unroll
    for (int e = 0; e < 9; ++e) raw[j][e] = 0u;
#define RAWLOAD(i_)                                                                                 \
  {                                                                                                 \
    _Pragma("unroll") for (int j = 0; j < 8; ++j) {                                                 \
      const int s_ = (i_) * 32 + pw * 8 + j;                                                        \
      const size_t tok_ = (size_t)b * SEQ + s_;                                                     \
      const bf16_t* pr_ = P + tok_ * PSTR + C_RW;                                                   \
      raw[j][0] = pr_[hc]; raw[j][1] = pr_[256 + hc]; raw[j][2] = pr_[512 + hc];                    \
      if (s_ > 0) { raw[j][3] = (pr_ - PSTR)[hc]; raw[j][4] = (pr_ - PSTR)[256 + hc]; raw[j][5] = (pr_ - PSTR)[512 + hc]; } \
      else { raw[j][3] = 0u; raw[j][4] = 0u; raw[j][5] = 0u; }                                      \
      raw[j][6] = RD[tok_ * 256 + hc]; raw[j][7] = RKK[tok_ * 256 + hc]; raw[j][8] = RA[tok_ * 256 + hc]; \
    }                                                                                               \
  }
#define RBAR() { asm volatile("s_waitcnt lgkmcnt(0)" ::: "memory"); __builtin_amdgcn_s_barrier(); asm volatile("" ::: "memory"); }
  if (wv >= 4) RAWLOAD(0);
#pragma unroll 1
  for (int i = 0; i < NCH + 2; ++i) {
    if (wv >= 4) {
      float* B = fb + (i & 1) * 12352;
      if (i >= 2) {
        const float* Yc = Yb + (i & 1) * 1024;
        if (lane < 32) {
#pragma unroll
          for (int j = 0; j < 8; ++j) {
            const int tl = pw * 8 + j;
            const size_t tok = (size_t)b * SEQ + (i - 2) * 32 + tl;
            O[tok * DM + 768 + hd * 64 + half * 32 + lane] = f2bf(Yc[tl * 32 + lane]);
          }
        }
      }
      if (i < NCH) {
#pragma unroll
        for (int j = 0; j < 8; ++j) {
          const int tl = pw * 8 + j;
          const float r = mixf((bf16_t)raw[j][0], (bf16_t)raw[j][3], mu_r), k = mixf((bf16_t)raw[j][1], (bf16_t)raw[j][4], mu_k), v = mixf((bf16_t)raw[j][2], (bf16_t)raw[j][5], mu_v);
          const float w = 1.f - bf2f((bf16_t)raw[j][6]), kk = bf2f((bf16_t)raw[j][7]), a = bf2f((bf16_t)raw[j][8]);
          const float ka = kk * a, kp = k * (1.f + (a - 1.f) * kac);
          const float c1 = wave_sum(ka * r), c2 = wave_sum(kp * r);
          B[tl * 64 + lane] = w; B[2048 + tl * 64 + lane] = kk; B[4096 + tl * 64 + lane] = ka; B[6144 + tl * 64 + lane] = kp;
          B[8192 + tl * 64 + lane] = w * r; B[10240 + tl * 64 + lane] = v;
          if (lane == 0) { B[12288 + tl * 2] = c1; B[12288 + tl * 2 + 1] = c2; }
        }
        if (i + 1 < NCH) RAWLOAD(i + 1);
      }
    } else if (i >= 1 && i <= NCH) {
      const float* B = fb + ((i - 1) & 1) * 12352;
      float* Yc = Yb + ((i - 1) & 1) * 1024;
      f32x4 vw[2][10]; float vvv[2]; float2 vsc[2];
#define RWLD(t_, s_)                                                                              \
      { const float* bt_ = B + (t_) * 64 + kq * 8;                                                 \
        _Pragma("unroll") for (int q_ = 0; q_ < 5; ++q_) { vw[s_][2 * q_] = *(const f32x4*)(bt_ + 2048 * q_); vw[s_][2 * q_ + 1] = *(const f32x4*)(bt_ + 2048 * q_ + 4); } \
        vvv[s_] = B[10240 + (t_) * 64 + vrow]; vsc[s_] = *(const float2*)(B + 12288 + (t_) * 2); }
#pragma unroll 1
      for (int tb = 0; tb < 32; tb += 16) {
      RWLD(tb, 0);
#pragma unroll
      for (int t = 0; t < 16; ++t) {
        const int cs = t & 1;
        if (t + 1 < 16) RWLD(tb + t + 1, cs ^ 1);
        const f32x4 w0 = vw[cs][0], w1 = vw[cs][1], kk0 = vw[cs][2], kk1 = vw[cs][3], ka0 = vw[cs][4], ka1 = vw[cs][5],
                    kp0 = vw[cs][6], kp1 = vw[cs][7], wr0 = vw[cs][8], wr1 = vw[cs][9];
        const float vv = vvv[cs]; const float2 sc = vsc[cs];
        const f32x4 pd = Sa * kk0 + Sb * kk1, pe = Sa * wr0 + Sb * wr1;
        float d0 = (pd[0] + pd[1]) + (pd[2] + pd[3]), e0 = (pe[0] + pe[1]) + (pe[2] + pe[3]);
        const f32x4 Ua = Sa * w0 + vv * kp0, Ub = Sb * w1 + vv * kp1;
        d0 = reduce8(d0); e0 = reduce8(e0);
        const float sa0 = -d0;
        const float y0 = e0 + sa0 * sc.x + vv * sc.y;
        Sa = Ua + sa0 * ka0; Sb = Ub + sa0 * ka1;
        if (kq == 0) Yc[(tb + t) * 32 + vloc] = y0;
      }
      }
#undef RWLD
    }
    RBAR();
  }
#undef RAWLOAD
#undef RBAR
}

DI void rwkv_post(const Params& p, int l) {
  const bf16_t* P = (const bf16_t*)(p.ws + OFF_P);
  bf16_t* O = (bf16_t*)(p.ws + OFF_O);
  const bf16_t* RG = (const bf16_t*)(p.ws + OFF_L + 3 * GSZ);
  const float* BON = (const float*)(p.ws + OFF_BON);
  const int tid = otid(), lane = tid & 63, wv = tid >> 6;
  const float* mu = p.in[I_RMU] + (size_t)l * 896;
  const int nw = gridDim.x * 8;
  for (int task0 = (obid() * 8 + wv) * 4; task0 < NTOK * 4; task0 += nw * 4) {
    float yv[4], vv[4], gv[4], bv[4];
#pragma unroll
    for (int q = 0; q < 4; ++q) {
      const int task = task0 + q; const size_t tok = task >> 2; const int hd = task & 3, hc = hd * 64 + lane;
      yv[q] = bf2f(O[tok * DM + 768 + hc]);
      const bf16_t cur = P[tok * PSTR + C_RW + 512 + hc];
      const bf16_t prev = (tok % SEQ) ? P[(tok - 1) * PSTR + C_RW + 512 + hc] : (bf16_t)0;
      vv[q] = mixf(cur, prev, mu[512 + hc]);
      gv[q] = bf2f(RG[tok * 256 + hc]); bv[q] = BON[tok * 4 + hd];
    }
#pragma unroll
    for (int q = 0; q < 4; ++q) {
      const int task = task0 + q; const size_t tok = task >> 2; const int hd = task & 3, hc = hd * 64 + lane;
      const float mean = wave_sum(yv[q]) * (1.f / 64.f);
      const float d = yv[q] - mean;
      const float var = wave_sum(d * d) * (1.f / 64.f);
      const float yn = d * rsqrtf(var + 64e-5f) * p.in[I_RLG][l * 256 + hc] + p.in[I_RLB][l * 256 + hc];
      O[tok * DM + 768 + hc] = f2bf((yn + bv[q] * vv[q]) * gv[q]);
    }
  }
}

DI void sb_item(const Params& p, int item, char* smem) {
  const bf16_t* P = (const bf16_t*)(p.ws + OFF_P);
  bf16_t* O = (bf16_t*)(p.ws + OFF_O);
  const int qt = item & 15, hd = (item >> 4) & 3, b = item >> 6;
  const int tid = otid(), lane = tid & 63, wv = tid >> 6, r = lane & 31, h = lane >> 5;
  bf16_t* Vt = (bf16_t*)(smem + wv * 8704);
  const int q0 = qt * 256 + wv * 32;
  const int sq = q0 + r;
  const size_t tokb = (size_t)b * SEQ;
  bf16x8 qf[4];
#pragma unroll
  for (int ks = 0; ks < 4; ++ks) qf[ks] = *(const bf16x8*)(P + (tokb + sq) * PSTR + C_SB_Q + hd * 64 + ks * 16 + h * 8);
  f32x16 accO[2];
#pragma unroll
  for (int i = 0; i < 16; ++i) { accO[0][i] = 0.f; accO[1][i] = 0.f; }
  float Prun = 1.f;
  bf16x8 kf[2][4];
  const int kt0 = (q0 + 31) >> 6;
#define SBKLOAD(kt_) { _Pragma("unroll") for (int m = 0; m < 2; ++m) _Pragma("unroll") for (int ks = 0; ks < 4; ++ks) \
    kf[m][ks] = *(const bf16x8*)(P + (tokb + (kt_) * 64 + 32 * m + r) * PSTR + C_SB_K + hd * 64 + ks * 16 + h * 8); }
  SBKLOAD(kt0);
  for (int kt = kt0; kt >= 0; --kt) {
    const int k0 = kt * 64;
    bf16x8 vr[8];
#pragma unroll
    for (int it = 0; it < 8; ++it) vr[it] = *(const bf16x8*)(P + (tokb + k0 + it * 8 + (lane >> 3)) * PSTR + C_SB_V + hd * 64 + (lane & 7) * 8);
    f32x16 acc[2];
#pragma unroll
    for (int m = 0; m < 2; ++m) {
#pragma unroll
      for (int i = 0; i < 16; ++i) acc[m][i] = 0.f;
#pragma unroll
      for (int ks = 0; ks < 4; ++ks) acc[m] = mfma32(kf[m][ks], qf[ks], acc[m]);
    }
    if (kt > 0) SBKLOAD(kt - 1);
    float om[2][16];
#pragma unroll
    for (int m = 0; m < 2; ++m)
#pragma unroll
      for (int i = 0; i < 16; ++i) {
        const int key = k0 + 32 * m + crow(i, h);
        const float z = fmaxf(acc[m][i] * 0.125f, -80.f);
        const float e = __expf(-z);
        const float sg = __builtin_amdgcn_rcpf(1.f + e);
        const bool valid = key < sq;
        acc[m][i] = valid ? sg : 0.f;
        om[m][i] = valid ? e * sg : 1.f;
      }
    float gp[8];
#pragma unroll
    for (int q = 0; q < 8; ++q) {
      const int m = q >> 2, g = q & 3;
      gp[q] = (om[m][4 * g] * om[m][4 * g + 1]) * (om[m][4 * g + 2] * om[m][4 * g + 3]);
    }
    float run = 1.f;
#pragma unroll
    for (int q = 7; q >= 0; --q) {
      const int m = q >> 2, g = q & 3;
      const float pg = __shfl_xor(gp[q], 32);
      const float f3 = Prun * run * (h == 0 ? pg : 1.f);
      const float f2 = f3 * om[m][4 * g + 3], f1 = f2 * om[m][4 * g + 2], f0 = f1 * om[m][4 * g + 1];
      acc[m][4 * g + 3] *= f3; acc[m][4 * g + 2] *= f2; acc[m][4 * g + 1] *= f1; acc[m][4 * g + 0] *= f0;
      run *= gp[q] * pg;
    }
    Prun *= run;
    __builtin_amdgcn_wave_barrier();
#pragma unroll
    for (int it = 0; it < 8; ++it) {
      const int key = it * 8 + (lane >> 3), chv = lane & 7;
#pragma unroll
      for (int e = 0; e < 8; ++e) Vt[(chv * 8 + e) * 68 + key] = (bf16_t)vr[it][e];
    }
    __builtin_amdgcn_wave_barrier();
#pragma unroll
    for (int m = 0; m < 2; ++m)
#pragma unroll
      for (int s2 = 0; s2 < 2; ++s2) {
        uint4 uu = {pack2(acc[m][8 * s2 + 0], acc[m][8 * s2 + 1]), pack2(acc[m][8 * s2 + 2], acc[m][8 * s2 + 3]),
                    pack2(acc[m][8 * s2 + 4], acc[m][8 * s2 + 5]), pack2(acc[m][8 * s2 + 6], acc[m][8 * s2 + 7])};
        const bf16x8 pb = __builtin_bit_cast(bf16x8, uu);
#pragma unroll
        for (int dt = 0; dt < 2; ++dt) {
          const bf16_t* vp = Vt + (32 * dt + r) * 68 + 32 * m + 16 * s2 + 4 * h;
          s16x4 lo = *(const s16x4*)vp, hi = *(const s16x4*)(vp + 8);
          bf16x8 va = __builtin_shufflevector(lo, hi, 0, 1, 2, 3, 4, 5, 6, 7);
          accO[dt] = mfma32(va, pb, accO[dt]);
        }
      }
    __builtin_amdgcn_wave_barrier();
    if (__ballot(Prun > 1e-37f) == 0ull) break;
  }
#undef SBKLOAD
#pragma unroll
  for (int dt = 0; dt < 2; ++dt)
#pragma unroll
    for (int g = 0; g < 4; ++g) {
      const int d = 32 * dt + 8 * g + 4 * h;
      uint2 o = {pack2(accO[dt][4 * g], accO[dt][4 * g + 1]), pack2(accO[dt][4 * g + 2], accO[dt][4 * g + 3])};
      *(uint2*)(O + (tokb + sq) * DM + 256 + hd * 64 + d) = o;
    }
}

DI int frag_off(int row, int k) {
  const int rt = row >> 4, fr = row & 15, ks = k >> 5, kk = k & 31, hi = kk >> 4, fq = (kk & 15) >> 2, j = (kk & 3) + 4 * hi;
  return ((rt * 2 + ks) * 64 + fq * 16 + fr) * 8 + j;
}
DI int frag_off8(int row, int k0) {
  const int rt = row >> 4, fr = row & 15, ks = k0 >> 5, kk = k0 & 31, hi = kk >> 4, fq = (kk & 15) >> 2;
  return ((rt * 2 + ks) * 64 + fq * 16 + fr) * 8 + 4 * hi;
}
DI void gdn_intra_item(const Params& p, int l, int item, char* smem) {
  const bf16_t* P = (const bf16_t*)(p.ws + OFF_P);
  const int hp = item & 1, c = (item >> 1) & 63, b = item >> 7;
  const int tid = otid(), lane = tid & 63;
  bf16_t* Kb = (bf16_t*)smem;
  bf16_t* Qb = Kb + 2 * 64 * 72;
  bf16_t* Vb = Qb + 2 * 64 * 72;
  float* Lm = (float*)(smem + 3 * 2 * 64 * 72 * 2);
  float* Gs = Lm + 2 * 4096;
  float* Bs = Gs + 128;
  const size_t tok0 = (size_t)b * SEQ + c * 64;
  const float* cw = p.in[I_GCW] + (size_t)l * 4 * 768;
  float* CW = Bs + 128;
  for (int e = tid; e < 6 * 4 * 64; e += NTHR) {
    const int blk = e >> 8, j = (e >> 6) & 3, col = e & 63;
    const int hh_ = blk / 3, which_ = blk % 3;
    CW[e] = cw[j * 768 + which_ * 256 + (hp * 2 + hh_) * 64 + col];
  }
  __syncthreads();
  {
    const int t = tid >> 3, cg = tid & 7;
#pragma unroll 3
    for (int it = 0; it < 6; ++it) {
      const int hh = it / 3, which = it % 3, head = hp * 2 + hh;
      const int ccol = which * 256 + head * 64 + cg * 8;
      float acc[8];
#pragma unroll
      for (int e = 0; e < 8; ++e) acc[e] = 0.f;
#pragma unroll
      for (int j = 0; j < 4; ++j) {
        const int s = c * 64 + t - 3 + j;
        if (s >= 0) {
          bf16x8 xv = *(const bf16x8*)(P + ((size_t)b * SEQ + s) * PSTR + C_GDN_Q + ccol);
          f32x4 wa = *(const f32x4*)(CW + (it * 4 + j) * 64 + cg * 8), wb = *(const f32x4*)(CW + (it * 4 + j) * 64 + cg * 8 + 4);
#pragma unroll
          for (int e = 0; e < 4; ++e) { acc[e] += wa[e] * bf2f((bf16_t)xv[e]); acc[e + 4] += wb[e] * bf2f((bf16_t)xv[e + 4]); }
        }
      }
      float ss = 0.f;
#pragma unroll
      for (int e = 0; e < 8; ++e) { acc[e] = siluf_(acc[e]); ss += acc[e] * acc[e]; }
      ss += __shfl_xor(ss, 1); ss += __shfl_xor(ss, 2); ss += __shfl_xor(ss, 4);
      float sc = 1.f;
      if (which == 0) sc = rsqrtf(ss + EPSF) * 0.125f;
      else if (which == 1) sc = rsqrtf(ss + EPSF);
      uint4 ov = {pack2(acc[0] * sc, acc[1] * sc), pack2(acc[2] * sc, acc[3] * sc), pack2(acc[4] * sc, acc[5] * sc), pack2(acc[6] * sc, acc[7] * sc)};
      bf16_t* dst = (which == 0 ? Qb : (which == 1 ? Kb : Vb)) + (hh * 64 + t) * 72 + cg * 8;
      *(uint4*)dst = ov;
    }
  }
  if (tid < 128) {
    const int hh = tid >> 6, t = lane, head = hp * 2 + hh;
    const float a_in = bf2f(P[(tok0 + t) * PSTR + C_GDN_A + head]);
    const float b_in = bf2f(P[(tok0 + t) * PSTR + C_GDN_B + head]);
    const float beta = sigmoidf_(b_in);
    float g = -__expf(p.in[I_GAL][l * 4 + head]) * softplusf_(a_in + p.in[I_GDT][l * 4 + head]);
#pragma unroll
    for (int d = 1; d < 64; d <<= 1) { float v = __shfl_up(g, d); if (lane >= d) g += v; }
    Gs[hh * 64 + t] = g; Bs[hh * 64 + t] = beta;
  }
  __syncthreads();
  const int hh = tid >> 8, lt = tid & 255, head = hp * 2 + hh;
  const size_t ih = ((size_t)(b * 4 + head)) * 64 + c;
  bf16_t* GW = (bf16_t*)(p.ws + OFF_G) + ih * 4096;
  bf16_t* GQD = (bf16_t*)(p.ws + OFF_G + GSZ) + ih * 4096;
  bf16_t* GQK = (bf16_t*)(p.ws + OFF_G + 2 * GSZ) + ih * 4096;
  bf16_t* GKD = (bf16_t*)(p.ws + OFF_G + 3 * GSZ) + ih * 4096;
  bf16_t* GU = (bf16_t*)(p.ws + OFF_G + 4 * GSZ) + ih * 4096;
  float* GCD = (float*)(p.ws + OFF_GCD);
  const float* Gh = Gs + hh * 64; const float* Bh = Bs + hh * 64;
  {
    const int wq = (tid >> 6) & 3, ti = wq >> 1, tj = wq & 1, r = lane & 31, h = lane >> 5;
    f32x16 akk, aqk;
#pragma unroll
    for (int i = 0; i < 16; ++i) { akk[i] = 0.f; aqk[i] = 0.f; }
    if (ti >= tj) {
#pragma unroll
      for (int ks = 0; ks < 4; ++ks) {
        bf16x8 ka = *(const bf16x8*)(Kb + (hh * 64 + 32 * ti + r) * 72 + ks * 16 + h * 8);
        bf16x8 qa = *(const bf16x8*)(Qb + (hh * 64 + 32 * ti + r) * 72 + ks * 16 + h * 8);
        bf16x8 kb = *(const bf16x8*)(Kb + (hh * 64 + 32 * tj + r) * 72 + ks * 16 + h * 8);
        akk = mfma32(ka, kb, akk);
        aqk = mfma32(qa, kb, aqk);
      }
    }
    const int j = 32 * tj + r;
    const float Gj = Gh[j];
#pragma unroll
    for (int i_ = 0; i_ < 16; ++i_) {
      const int i = 32 * ti + crow(i_, h);
      const float dec = (i >= j) ? __expf(Gh[i] - Gj) : 0.f;
      Lm[hh * 4096 + i * 64 + j] = (i > j) ? Bh[i] * akk[i_] * dec : 0.f;
      GQK[frag_off(i, j)] = f2bf((i >= j) ? aqk[i_] * dec : 0.f);
    }
  }
  __syncthreads();
  if (lt < 128) {
    const int cc = lt;
    float x[64];
    if (cc < 64) {
#pragma unroll
      for (int i = 0; i < 64; ++i) x[i] = bf2f(Vb[(hh * 64 + i) * 72 + cc]) * Bh[i];
    } else {
#pragma unroll
      for (int i = 0; i < 64; ++i) x[i] = bf2f(Kb[(hh * 64 + i) * 72 + cc - 64]) * Bh[i] * __expf(Gh[i]);
    }
    const float* Lh = Lm + hh * 4096;
#pragma unroll
    for (int i = 1; i < 64; ++i) {
      float s = x[i];
#pragma unroll
      for (int j4 = 0; j4 < (i + 3) / 4; ++j4) {
        const f32x4 lv = *(const f32x4*)(Lh + i * 64 + j4 * 4);
#pragma unroll
        for (int e = 0; e < 4; ++e) if (j4 * 4 + e < i) s -= lv[e] * x[j4 * 4 + e];
      }
      x[i] = s;
    }
    if (cc < 64) {
      const int split = cc >> 4, fr = cc & 15;
#pragma unroll
      for (int i4 = 0; i4 < 16; ++i4) {
        uint2 ov = {pack2(x[4 * i4], x[4 * i4 + 1]), pack2(x[4 * i4 + 2], x[4 * i4 + 3])};
        *(uint2*)(GU + ((split * 4 + (i4 >> 2)) * 64 + (i4 & 3) * 16 + fr) * 4) = ov;
      }
    } else {
#pragma unroll
      for (int i = 0; i < 64; ++i) GW[frag_off(i, cc - 64)] = f2bf(x[i]);
    }
  } else {
    const int q_ = lt - 128;
    const float Glast = Gh[63];
#pragma unroll
    for (int i = 0; i < 4; ++i) {
      const int q = q_ + 128 * i; const int pos = q >> 3, kc = q & 7;
      bf16x8 qv = *(const bf16x8*)(Qb + (hh * 64 + pos) * 72 + kc * 8);
      const float eg = __expf(Gh[pos]);
      uint4 ov = {pack2(bf2f((bf16_t)qv[0]) * eg, bf2f((bf16_t)qv[1]) * eg), pack2(bf2f((bf16_t)qv[2]) * eg, bf2f((bf16_t)qv[3]) * eg),
                  pack2(bf2f((bf16_t)qv[4]) * eg, bf2f((bf16_t)qv[5]) * eg), pack2(bf2f((bf16_t)qv[6]) * eg, bf2f((bf16_t)qv[7]) * eg)};
      { const int fo = frag_off8(pos, kc * 8); uint2 o0 = {ov.x, ov.y}, o1 = {ov.z, ov.w}; *(uint2*)(GQD + fo) = o0; *(uint2*)(GQD + fo + 128) = o1; }
    }
#pragma unroll
    for (int i = 0; i < 4; ++i) {
      const int q = q_ + 128 * i; const int k = q >> 3, pc = q & 7;
      float o[8];
#pragma unroll
      for (int e = 0; e < 8; ++e) { const int pos = pc * 8 + e; o[e] = bf2f(Kb[(hh * 64 + pos) * 72 + k]) * __expf(Glast - Gh[pos]); }
      uint4 ov = {pack2(o[0], o[1]), pack2(o[2], o[3]), pack2(o[4], o[5]), pack2(o[6], o[7])};
      { const int fo = frag_off8(k, pc * 8); uint2 o0 = {ov.x, ov.y}, o1 = {ov.z, ov.w}; *(uint2*)(GKD + fo) = o0; *(uint2*)(GKD + fo + 128) = o1; }
    }
    if (q_ == 0) GCD[ih] = __expf(Glast);
  }
}

DI void gdn_rec_item(const Params& p, int l, int b, int head, char* smem) {
  const bf16_t* P = (const bf16_t*)(p.ws + OFF_P);
  bf16_t* O = (bf16_t*)(p.ws + OFF_O);
  float* SS = (float*)(smem + 81920);
  const int tid = otid(), lane = tid & 63, wv = tid >> 6, fr = lane & 15, fq = lane >> 4;
  const int split = wv & 3;
  const bool active = wv < 4;
  const float ng = p.in[I_GNG][l * 64 + split * 16 + fr];
  const float* GCD = (const float*)(p.ws + OFF_GCD);
  const size_t ih0 = ((size_t)(b * 4 + head)) * 64;
  f32x4 S[4];
#pragma unroll
  for (int kt = 0; kt < 4; ++kt) S[kt] = (f32x4){0.f, 0.f, 0.f, 0.f};
  u32x4 lr[10];
#pragma unroll
  for (int i = 0; i < 10; ++i) lr[i] = (u32x4){0u, 0u, 0u, 0u};
  const int lq = (wv & 3) * 64 + lane;
#define GLOADC(c_)                                                                              \
  {                                                                                             \
    _Pragma("unroll") for (int i = 0; i < 10; ++i) {                                            \
      const int q_ = lq + 256 * i; const int a_ = q_ >> 9, o_ = q_ & 511;                       \
      lr[i] = *(const u32x4*)((const bf16_t*)(p.ws + OFF_G + (size_t)a_ * GSZ) + (ih0 + (c_)) * 4096 + o_ * 8); \
    }                                                                                           \
  }
#define LSTORE(buf_)                                                                            \
  {                                                                                             \
    _Pragma("unroll") for (int i = 0; i < 10; ++i) {                                            \
      const int q_ = lq + 256 * i;                                                              \
      *(u32x4*)(smem + (buf_) * 40960 + q_ * 16) = lr[i];                                       \
    }                                                                                           \
  }
#define BAR_LDS() { asm volatile("s_waitcnt lgkmcnt(0)" ::: "memory"); __builtin_amdgcn_s_barrier(); asm volatile("" ::: "memory"); }
  float cdn = 0.f;
  if (!active) { GLOADC(0); LSTORE(0); GLOADC(1); }
  else cdn = GCD[ih0];
  BAR_LDS();
#pragma unroll 1
  for (int c = 0; c < 64; ++c) {
    f32x4 acco[4];
    if (active) {
      const char* bufp = smem + (c & 1) * 40960;
      const float cd = cdn;
      if (c + 1 < 64) cdn = GCD[ih0 + c + 1];
      float zr[16];
#pragma unroll
      for (int rt = 0; rt < 4; ++rt)
#pragma unroll
        for (int j = 0; j < 4; ++j) {
          const size_t tok = (size_t)b * SEQ + c * 64 + 16 * rt + 4 * fq + j;
          zr[rt * 4 + j] = bf2f(P[tok * PSTR + C_GDN_Z + head * 64 + split * 16 + fr]);
        }
      bf16x8 bS[2];
#pragma unroll
      for (int ks = 0; ks < 2; ++ks) {
        uint4 uu = {pack2(S[2 * ks][0], S[2 * ks][1]), pack2(S[2 * ks][2], S[2 * ks][3]), pack2(S[2 * ks + 1][0], S[2 * ks + 1][1]), pack2(S[2 * ks + 1][2], S[2 * ks + 1][3])};
        bS[ks] = __builtin_bit_cast(bf16x8, uu);
      }
      f32x4 u[4];
#pragma unroll
      for (int rt = 0; rt < 4; ++rt) {
        f32x4 aw = {0.f, 0.f, 0.f, 0.f};
        acco[rt] = (f32x4){0.f, 0.f, 0.f, 0.f};
#pragma unroll
        for (int ks = 0; ks < 2; ++ks) {
          const bf16x8 wa = *(const bf16x8*)(bufp + ((rt * 2 + ks) * 64 + lane) * 16);
          const bf16x8 qa = *(const bf16x8*)(bufp + 8192 + ((rt * 2 + ks) * 64 + lane) * 16);
          aw = mfma16(wa, bS[ks], aw); acco[rt] = mfma16(qa, bS[ks], acco[rt]);
        }
        const s16x4 uv = *(const s16x4*)(bufp + 32768 + ((split * 4 + rt) * 64 + lane) * 8);
#pragma unroll
        for (int j = 0; j < 4; ++j) u[rt][j] = bf2f((bf16_t)uv[j]) - aw[j];
      }
      bf16x8 bU[2];
#pragma unroll
      for (int ks = 0; ks < 2; ++ks) {
        uint4 uu = {pack2(u[2 * ks][0], u[2 * ks][1]), pack2(u[2 * ks][2], u[2 * ks][3]), pack2(u[2 * ks + 1][0], u[2 * ks + 1][1]), pack2(u[2 * ks + 1][2], u[2 * ks + 1][3])};
        bU[ks] = __builtin_bit_cast(bf16x8, uu);
      }
#pragma unroll
      for (int rt = 0; rt < 4; ++rt) {
        f32x4 sn = S[rt] * cd;
#pragma unroll
        for (int ks = 0; ks < 2; ++ks) {
          const bf16x8 qa = *(const bf16x8*)(bufp + 16384 + ((rt * 2 + ks) * 64 + lane) * 16);
          const bf16x8 ka = *(const bf16x8*)(bufp + 24576 + ((rt * 2 + ks) * 64 + lane) * 16);
          acco[rt] = mfma16(qa, bU[ks], acco[rt]); sn = mfma16(ka, bU[ks], sn);
        }
        S[rt] = sn;
      }
#pragma unroll
      for (int rt = 0; rt < 4; ++rt)
#pragma unroll
        for (int j = 0; j < 4; ++j) {
          float s = acco[rt][j] * acco[rt][j];
          s += __shfl_xor(s, 1); s += __shfl_xor(s, 2); s += __shfl_xor(s, 4); s += __shfl_xor(s, 8);
          if (fr == 0) SS[(c & 1) * 256 + split * 64 + 16 * rt + 4 * fq + j] = s;
        }
      BAR_LDS();
      const float* ssb = SS + (c & 1) * 256;
#pragma unroll
      for (int rt = 0; rt < 4; ++rt)
#pragma unroll
        for (int j = 0; j < 4; ++j) {
          const int pos = 16 * rt + 4 * fq + j;
          const float tot = ssb[pos] + ssb[64 + pos] + ssb[128 + pos] + ssb[192 + pos];
          const float rn = rsqrtf(tot * (1.f / 64.f) + EPSF);
          const size_t tok = (size_t)b * SEQ + c * 64 + pos;
          O[tok * DM + 512 + head * 64 + split * 16 + fr] = f2bf(acco[rt][j] * rn * ng * siluf_(zr[rt * 4 + j]));
        }
    } else {
      if (c + 1 < 64) LSTORE((c + 1) & 1);
      if (c + 2 < 64) GLOADC(c + 2);
      BAR_LDS();
    }
  }
#undef GLOADC
#undef LSTORE
#undef BAR_LDS
}

DI void lru_item(const Params& p, int l, int item, char* smem, const int mode) {
  const bf16_t* P = (const bf16_t*)(p.ws + OFF_P);
  bf16_t* O = (bf16_t*)(p.ws + OFF_O);
  float* CA = (float*)(p.ws + OFF_LCA);
  float* CH = (float*)(p.ws + OFF_LCH);
  bf16_t* XS = (bf16_t*)smem;
  bf16_t* UB = (bf16_t*)(smem + 34816);
  const int b = item >> 6, ct = item & 63;
  const int tid = otid(), lane = tid & 63, wv = tid >> 6, r = lane & 31, h = lane >> 5, n = wv & 3, mi = wv >> 2;
  for (int i = 0; i < 5; ++i) {
    const int q = tid + NTHR * i;
    if (q < 67 * 32) {
      const int row = q >> 5, cc = q & 31;
      const int s = ct * 64 - 3 + row;
      uint4 v = {0u, 0u, 0u, 0u};
      if (s >= 0) v = *(const uint4*)(P + ((size_t)b * SEQ + s) * PSTR + C_LRU_X + cc * 8);
      *(uint4*)(XS + row * 256 + cc * 8) = v;
    }
  }
  bf16x8 bwr[2][4], bwi[2][4];
  {
    const float* wrp = p.in[I_LWR] + (((size_t)l * 4 + n) * 64) * 64 + r;
    const float* wip = p.in[I_LWI] + (((size_t)l * 4 + n) * 64) * 64 + r;
    asm volatile("" : "+v"(wrp), "+v"(wip));
#pragma unroll
    for (int ni = 0; ni < 2; ++ni)
#pragma unroll
      for (int ks = 0; ks < 4; ++ks) {
        unsigned ur[4], ui[4];
#pragma unroll
        for (int j2 = 0; j2 < 4; ++j2) {
          const int e = 16 * ks + 8 * h + 2 * j2;
          ur[j2] = pack2(wrp[e * 64 + 32 * ni], wrp[(e + 1) * 64 + 32 * ni]);
          ui[j2] = pack2(wip[e * 64 + 32 * ni], wip[(e + 1) * 64 + 32 * ni]);
        }
        uint4 t1 = {ur[0], ur[1], ur[2], ur[3]}, t2 = {ui[0], ui[1], ui[2], ui[3]};
        bwr[ni][ks] = __builtin_bit_cast(bf16x8, t1); bwi[ni][ks] = __builtin_bit_cast(bf16x8, t2);
      }
  }
  __syncthreads();
  {
    const int sc = tid >> 8, c = tid & 255;
    const float cb = p.in[I_LCB][l * 256 + c];
    const float c0 = p.in[I_LCW][(l * 4 + 0) * 256 + c], c1 = p.in[I_LCW][(l * 4 + 1) * 256 + c],
                c2 = p.in[I_LCW][(l * 4 + 2) * 256 + c], c3 = p.in[I_LCW][(l * 4 + 3) * 256 + c];
    for (int t = sc * 32; t < sc * 32 + 32; ++t)
      UB[t * 264 + c] = f2bf(cb + c0 * bf2f(XS[t * 256 + c]) + c1 * bf2f(XS[(t + 1) * 256 + c]) + c2 * bf2f(XS[(t + 2) * 256 + c]) + c3 * bf2f(XS[(t + 3) * 256 + c]));
  }
  __syncthreads();
  f32x16 ar[2], ai[2];
#pragma unroll
  for (int ni = 0; ni < 2; ++ni)
#pragma unroll
    for (int i = 0; i < 16; ++i) { ar[ni][i] = 0.f; ai[ni][i] = 0.f; }
#pragma unroll
  for (int ks = 0; ks < 4; ++ks) {
    const bf16x8 au = *(const bf16x8*)(UB + (32 * mi + r) * 264 + n * 64 + 16 * ks + 8 * h);
#pragma unroll
    for (int ni = 0; ni < 2; ++ni) { ar[ni] = mfma32(au, bwr[ni][ks], ar[ni]); ai[ni] = mfma32(au, bwi[ni][ks], ai[ni]); }
  }
  const int ck = ct * 2 + mi;
#pragma unroll
  for (int ni = 0; ni < 2; ++ni) {
    const int c = n * 64 + 32 * ni + r;
    const float brc = p.in[I_LBR][l * 256 + c], bic = p.in[I_LBI][l * 256 + c];
    const float lamsp = softplusf_(-p.in[I_LLAM][l * 256 + c]);
    float av[16], bv[16];
#pragma unroll
    for (int i = 0; i < 16; ++i) {
      const int tl = 32 * mi + crow(i, h);
      const float u = bf2f(UB[tl * 264 + c]);
      const float rg = sigmoid_rcp(ar[ni][i] + brc), ig = sigmoid_rcp(ai[ni][i] + bic);
      const float la = -8.f * rg * lamsp;
      av[i] = __expf(la);
      bv[i] = __builtin_amdgcn_sqrtf(fmaxf(0.f, 1.f - __expf(2.f * la))) * (ig * u);
    }
    float GA[4], GB[4], PA[4], PB[4];
#pragma unroll
    for (int q = 0; q < 4; ++q) {
      float A = 1.f, hh = 0.f;
#pragma unroll
      for (int e = 0; e < 4; ++e) { hh = av[4 * q + e] * hh + bv[4 * q + e]; A *= av[4 * q + e]; }
      GA[q] = A; GB[q] = hh;
      PA[q] = __shfl_xor(A, 32); PB[q] = __shfl_xor(hh, 32);
    }
    float cin = 0.f;
    if (mode == 1) {
      const int lo = h ? (ck >> 1) : 0, hi = h ? ck : (ck >> 1);
      float A = 1.f, hh = 0.f;
      const float* ca = CA + ((size_t)b * 128) * 256 + c;
      const float* chp = CH + ((size_t)b * 128) * 256 + c;
      int k = lo;
      for (; k + 8 <= hi; k += 8) {
        float a8[8], h8[8];
#pragma unroll
        for (int e = 0; e < 8; ++e) { a8[e] = ca[(size_t)(k + e) * 256]; h8[e] = chp[(size_t)(k + e) * 256]; }
#pragma unroll
        for (int e = 0; e < 8; ++e) { hh = a8[e] * hh + h8[e]; A *= a8[e]; }
      }
      for (; k < hi; ++k) { const float a_ = ca[(size_t)k * 256], h_ = chp[(size_t)k * 256]; hh = a_ * hh + h_; A *= a_; }
      const float pAx = __shfl_xor(A, 32), pHx = __shfl_xor(hh, 32);
      cin = h ? (A * pHx + hh) : (pAx * hh + pHx);
    }
    float cg = cin, Ap = 1.f, myc[4];
#pragma unroll
    for (int q = 0; q < 4; ++q) {
      const float Ae = h ? PA[q] : GA[q], Be = h ? PB[q] : GB[q];
      const float Ao = h ? GA[q] : PA[q], Bo = h ? GB[q] : PB[q];
      const float c_even = cg;
      cg = Ae * cg + Be;
      const float c_odd = cg;
      cg = Ao * cg + Bo;
      myc[q] = h ? c_odd : c_even;
      Ap *= Ae * Ao;
    }
    if (mode == 0) {
      if (h == 0) { CA[((size_t)b * 128 + ck) * 256 + c] = Ap; CH[((size_t)b * 128 + ck) * 256 + c] = cg; }
    } else {
#pragma unroll
      for (int q = 0; q < 4; ++q) {
        float hh = myc[q];
#pragma unroll
        for (int e = 0; e < 4; ++e) {
          const int i = 4 * q + e;
          hh = av[i] * hh + bv[i];
          const size_t tok = (size_t)b * SEQ + ct * 64 + 32 * mi + crow(i, h);
          const float y = bf2f(P[tok * PSTR + C_LRU_Y + c]);
          O[tok * DM + c] = f2bf(hh * gelu_rcp(y));
        }
      }
    }
  }
}

#define XB_TMO      128
#define XB_XCNT(j)  (256  + 64 * (j))
#define XB_XSUB(j)  (1280 + 64 * (j))
#define XB_XGEN(j)  (2304 + 64 * (j))
#define XB_TOP      3328
#define XB_TOPGEN   3392
#define XCD_BAR_WORDS 3456
#define XB_SPIN_CAP (1u << 18)
#define XLAS __attribute__((address_space(3)))
DI unsigned xb_ld(unsigned* p)              { return __hip_atomic_load(p, __ATOMIC_RELAXED, __HIP_MEMORY_SCOPE_AGENT); }
DI unsigned xb_add(unsigned* p, unsigned v) { return __hip_atomic_fetch_add(p, v, __ATOMIC_RELAXED, __HIP_MEMORY_SCOPE_AGENT); }
DI unsigned xb_xcc_id() { return (unsigned)__builtin_amdgcn_s_getreg((3 << 11) | 20) & 0xFu; }
#define XB_SPIN(cond, bar) do { unsigned _sp = 0; while (cond) { __builtin_amdgcn_s_sleep(1); \
    if ((++_sp & 255u) == 0u) { if (xb_ld(&(bar)[XB_TMO])) break; if (_sp > XB_SPIN_CAP) { atomicAdd(&(bar)[XB_TMO], 1u); break; } } } } while (0)
struct XcdBarrier { unsigned* bar; unsigned x; volatile XLAS unsigned* st; };
DI XcdBarrier xcd_barrier_post(unsigned* bar, volatile XLAS unsigned* st) {
  XcdBarrier b; b.bar = bar; b.x = xb_xcc_id(); b.st = st;
  if (threadIdx.x == 0) (void)xb_add(&bar[XB_XCNT(b.x)], 1u);
  return b;
}
DI void xcd_barrier_complete(unsigned* bar, unsigned x, unsigned& nloc, unsigned& nx) {
  const unsigned G = gridDim.x * gridDim.y * gridDim.z;
  unsigned sum, cnt, mine, sp = 0u;
  for (;;) {
    sum = 0u; cnt = 0u; mine = 0u;
#pragma unroll
    for (unsigned j = 0; j < 16; ++j) { const unsigned c = xb_ld(&bar[XB_XCNT(j)]); sum += c; cnt += (c > 0u) ? 1u : 0u; mine = (j == x) ? c : mine; }
    if (sum == G) break;
    __builtin_amdgcn_s_sleep(1);
    if ((++sp & 255u) == 0u) { if (xb_ld(&bar[XB_TMO])) break; if (sp > XB_SPIN_CAP) { atomicAdd(&bar[XB_TMO], 1u); break; } }
  }
  nloc = mine > 0u ? mine : 1u; nx = cnt > 0u ? cnt : 1u;
}
DI void xcd_barrier(const XcdBarrier& b) {
  asm volatile("s_waitcnt vmcnt(0)" ::: "memory");
  __syncthreads();
  if (threadIdx.x == 0) {
    unsigned* bar = b.bar;
    __builtin_amdgcn_s_waitcnt(0);
    unsigned nloc = b.st[0], nx = b.st[1];
    if (nloc == 0u) { xcd_barrier_complete(bar, b.x, nloc, nx); b.st[0] = nloc; b.st[1] = nx; }
    const unsigned old = xb_add(&bar[XB_XSUB(b.x)], 1u);
    const unsigned gen = old / nloc;
    if (old + 1u == (gen + 1u) * nloc) {
      __builtin_amdgcn_fence(__ATOMIC_RELEASE, "agent");
      asm volatile("s_waitcnt vmcnt(0)" ::: "memory");
      const unsigned og = xb_add(&bar[XB_TOP], 1u);
      const unsigned tg = og / nx;
      if (og + 1u == (tg + 1u) * nx) xb_add(&bar[XB_TOPGEN], 1u);
      else XB_SPIN(xb_ld(&bar[XB_TOPGEN]) == tg, bar);
      __builtin_amdgcn_fence(__ATOMIC_ACQUIRE, "agent");
      xb_add(&bar[XB_XGEN(b.x)], 1u);
      asm volatile("s_waitcnt vmcnt(0)" ::: "memory");
    } else {
      XB_SPIN(xb_ld(&bar[XB_XGEN(b.x)]) == gen, bar);
      __builtin_amdgcn_fence(__ATOMIC_ACQUIRE, "agent");
      asm volatile("s_waitcnt vmcnt(0)" ::: "memory");
    }
  }
  __syncthreads();
}

__global__ void __launch_bounds__(NTHR) mega(Params p) {
  extern __shared__ __attribute__((aligned(16))) char smem[];
  cg::grid_group grid = cg::this_grid();
  const int tid = threadIdx.x;
  bf16_t* H = (bf16_t*)(p.ws + OFF_H);
  bf16_t* PB = (bf16_t*)(p.ws + OFF_P);
  PG_LAS unsigned char* lds = (PG_LAS unsigned char*)smem;
  volatile XLAS unsigned* xst = (volatile XLAS unsigned*)(smem + 131072);
  if (tid < 2) xst[tid] = 0u;
  __syncthreads();
  const XcdBarrier xb = xcd_barrier_post((unsigned*)(p.ws + OFF_BAR), xst);

  for (int rep = 0; rep < REP_MISC; ++rep) {
  if (MASK & 1) phase_mod(p, smem);
  grid.sync();
  }
  for (int l = 0; l < 4; ++l) {
    const float* xcur = (l == 0) ? p.in[I_X] : p.out;
    for (int rep = 0; rep < REP_MISC; ++rep) {
    if (MASK & 2) phase_convert(p, l, smem);
    if (MASK & 4) phase_norm(p, xcur, p.in[I_N1G] + l * 1024, l, 1024, 0, H, nullptr);
    xcd_barrier(xb);
    }
    for (int rep = 0; rep < REP_G; ++rep) {
    if (MASK & 8) { pg::Order<1> S; S.init(NTOK, PSTR, gridDim.x, blockIdx.x); pg::EpiBf16<0> E{PB, PSTR, nullptr};
      pg::gemm_phase(lds, H, DM, (const bf16_t*)(p.ws + OFF_WIN), 1024, S, E); }
    xcd_barrier(xb);
    }
    for (int rep = 0; rep < REP_M1; ++rep) {
    for (int it = blockIdx.x; it < 5120; it += gridDim.x) {
      if (it < 2048) { if (MASK & 32) gdn_intra_item(p, l, it, smem); }
      else if (it < 3072) { }
      else if (it < 4096) { if (MASK & 128) lru_item(p, l, it - 3072, smem, 0); }
      else { if (MASK & 16) rw_prep_item(p, l, it - 4096, smem); }
      __syncthreads();
    }
    xcd_barrier(xb);
    }
    for (int rep = 0; rep < REP_M2; ++rep) {
    if (blockIdx.x < 128) {
      if (MASK & 16) rwkv_scan_item(p, l, blockIdx.x >> 3, (blockIdx.x >> 1) & 3, blockIdx.x & 1, smem);
    } else {
      if (blockIdx.x < 192) { if (MASK & 256) gdn_rec_item(p, l, (blockIdx.x - 128) >> 2, (blockIdx.x - 128) & 3, smem); }
      unsigned* ctr = (unsigned*)(p.ws + OFF_CTR) + l * 4 + rep;
      volatile int* slot = (volatile int*)(smem + 110016);
      for (;;) {
        __syncthreads();
        if (tid == 0) *slot = (int)atomicAdd(ctr, 1u);
        __syncthreads();
        const int it = *slot;
        if (it >= 2048) break;
        if (it < 1024) { if (MASK & 64) sb_item(p, it, smem); }
        else { if (MASK & 512) lru_item(p, l, it - 1024, smem, 1); }
      }
    }
    xcd_barrier(xb);
    }
    for (int rep = 0; rep < REP_G; ++rep) {
    for (int half = 0; half < 4; ++half) {
      bf16_t* BH = (bf16_t*)(p.ws + OFF_P + 134217728);
      if (half == 0 && rep == 0) { if (MASK & 16) rwkv_post(p, l); xcd_barrier(xb); }
      if (MASK & 1024) { pg::Order<1> S; S.init(NTOK / 4, 4096, gridDim.x, blockIdx.x, 0, 0, 2, 512); pg::EpiBf16<0> E{BH, 4096, nullptr};
        pg::gemm_phase(lds, (const bf16_t*)(p.ws + OFF_O) + (size_t)half * 16384 * DM, DM, (const bf16_t*)(p.ws + OFF_WBR), 256, S, E); }
      xcd_barrier(xb);
      if (MASK & 1024) { pg::Order<4> S; S.init(NTOK / 4, 1024, gridDim.x, blockIdx.x, 0, 2097152); pg::EpiGateMix E{PB + (size_t)half * 16384 * DM, (float*)(p.ws + OFF_G), BH, p.in[I_BGATE] + (size_t)l * 4096};
        pg::gemm_phase(lds, H + (size_t)half * 16384 * DM, DM, (const bf16_t*)(p.ws + OFF_WG), 1024, S, E); }
      xcd_barrier(xb);
    }
    }
    if (MASK & 2048) { pg::Order<1> S; S.init(NTOK, 1024, gridDim.x, blockIdx.x); pg::EpiResid E{xcur, p.out, (const float*)(p.ws + OFF_MODP), p.in[I_BADA], l, 2048};
      pg::gemm_phase(lds, PB, DM, (const bf16_t*)(p.ws + OFF_WO), 1024, S, E); }
    xcd_barrier(xb);
    for (int rep = 0; rep < REP_MISC; ++rep) {
    if (MASK & 4096) phase_norm(p, p.out, p.in[I_N2G] + l * 1024, l, 4096, 3072, H, nullptr);
    xcd_barrier(xb);
    }
    for (int rep = 0; rep < REP_G; ++rep) {
    if (MASK & 8192) { pg::Order<1> S; S.init(NTOK, FFN, gridDim.x, blockIdx.x); pg::EpiBf16<0> E{PB, FFN, nullptr};
      pg::gemm_phase(lds, H, DM, (const bf16_t*)(p.ws + OFF_WF), 1024, S, E); }
    xcd_barrier(xb);
    if (MASK & 8192) { pg::Order<1> S; S.init(NTOK, FFN, gridDim.x, blockIdx.x); pg::EpiFfnAct E{PB + (size_t)NTOK * FFN, PB, p.in[I_FCW] + (size_t)l * 3 * FFN};
      pg::gemm_phase(lds, H, DM, (const bf16_t*)(p.ws + OFF_WF) + (size_t)FFN * 1024, 1024, S, E); }
    xcd_barrier(xb);
    }
    if (MASK & 32768) { pg::Order<1> S; S.init(NTOK, 1024, gridDim.x, blockIdx.x); pg::EpiResid E{p.out, p.out, (const float*)(p.ws + OFF_MODP), p.in[I_BADA], l, 5120};
      pg::gemm_phase(lds, PB + (size_t)NTOK * FFN, FFN, (const bf16_t*)(p.ws + OFF_WD), FFN, S, E); }
    xcd_barrier(xb);
  }
  if (MASK & 65536) phase_norm(p, p.out, p.in[I_FG], 0, 0, 0, nullptr, p.out);
}

extern "C" void kernel_launch(void* const* d_in, const int* in_sizes, int n_in,
                              void* d_out, int out_size, void* d_ws, size_t ws_size,
                              hipStream_t stream) {
  if (ws_size < WS_NEED || n_in < 38) { fprintf(stderr, "workspace too small: %zu < %zu\n", ws_size, (size_t)WS_NEED); return; }
  (void)hipFuncSetAttribute((const void*)mega, hipFuncAttributeMaxDynamicSharedMemorySize, SMEM_BYTES);
  int dev = 0, cus = 0, per_cu = 0;
  (void)hipGetDevice(&dev);
  (void)hipDeviceGetAttribute(&cus, hipDeviceAttributeMultiprocessorCount, dev);
  (void)hipOccupancyMaxActiveBlocksPerMultiprocessor(&per_cu, mega, NTHR, SMEM_BYTES);
  if (per_cu < 1 || cus < 1) { fprintf(stderr, "occupancy query failed (%d, %d)\n", per_cu, cus); return; }
  if (cus > 256) cus = 256;
  const int grid_blocks = cus;
  Params p{};
  for (int i = 0; i < 38; ++i) p.in[i] = (const float*)d_in[i];
  p.out = (float*)d_out; p.ws = (char*)d_ws;
  (void)hipMemsetAsync((char*)d_ws + OFF_BAR, 0, XCD_BAR_WORDS * 4, stream);
  void* args[] = {&p};
  hipError_t e = hipLaunchCooperativeKernel((void*)mega, dim3(grid_blocks), dim3(NTHR), args, SMEM_BYTES, stream);
  if (e != hipSuccess) fprintf(stderr, "cooperative launch failed: %s (grid %d)\n", hipGetErrorString(e), grid_blocks);
}
```

```cpp
#include <hip/hip_runtime.h>
#include <hip/hip_cooperative_groups.h>
#include <cstdio>
namespace cg = cooperative_groups;

typedef unsigned short bf16_t;
typedef short bf16x8 __attribute__((ext_vector_type(8)));
typedef short s16x4 __attribute__((ext_vector_type(4)));
typedef float f32x4 __attribute__((ext_vector_type(4)));
typedef float f32x16 __attribute__((ext_vector_type(16)));
typedef unsigned u32x4 __attribute__((ext_vector_type(4)));
#define DI __device__ __forceinline__

constexpr int NTOK = 65536, DM = 1024, SEQ = 4096, PSTR = 3328, FFN = 2816, AUS = 5632;
constexpr int C_LRU_X = 0, C_LRU_Y = 256, C_SB_Q = 512, C_SB_K = 768, C_SB_V = 1024;
constexpr int C_GDN_Q = 1280, C_GDN_Z = 2048, C_GDN_A = 2304, C_GDN_B = 2308, C_RW = 2312;
constexpr float EPSF = 1e-6f;
#ifndef MASK
#define MASK 0x1ffff
#endif
#ifndef REP_M1
#define REP_M1 1
#endif
#ifndef REP_M2
#define REP_M2 1
#endif
#ifndef REP_G
#define REP_G 1
#endif
#ifndef REP_MISC
#define REP_MISC 1
#endif
constexpr int NTHR = 512;
constexpr int SMEM_BYTES = 131072 + 64;

constexpr size_t OFF_MODP = 0;
constexpr size_t OFF_WIN = 6291456;
constexpr size_t OFF_WG = OFF_WIN + 6815744;
constexpr size_t OFF_WBR = OFF_WG + 8388608;
constexpr size_t OFF_WO = OFF_WBR + 2097152;
constexpr size_t OFF_WF = OFF_WO + 2097152;
constexpr size_t OFF_WD = OFF_WF + 11534336;
constexpr size_t OFF_H = OFF_WD + 5767168;
constexpr size_t OFF_P = OFF_H + 134217728;
constexpr size_t OFF_O = OFF_P + 436207616;
constexpr size_t OFF_G = OFF_O + 134217728;
constexpr size_t GSZ = 33554432;
constexpr size_t OFF_GCD = OFF_G + 5 * GSZ;
constexpr size_t OFF_L = OFF_GCD + 16384;
constexpr size_t LSZ = 67108864;
constexpr size_t OFF_LCA = OFF_L + 2 * LSZ;
constexpr size_t OFF_LCH = OFF_LCA + 2097152;
constexpr size_t OFF_BON = OFF_LCH + 2097152;
constexpr size_t OFF_CTR = OFF_BON + 1048576;
constexpr size_t OFF_BAR = OFF_CTR + 256;
constexpr size_t OFF_C12 = OFF_BAR + 16384;
constexpr size_t WS_NEED = OFF_C12 + 2097152;

struct Params { const float* in[38]; float* out; char* ws; };
enum { I_X = 0, I_C, I_N1G, I_N2G, I_FG, I_WADA, I_BADA, I_WIN, I_LCW, I_LCB, I_LWR, I_LBR, I_LWI, I_LBI, I_LLAM,
       I_GCW, I_GAL, I_GDT, I_GNG, I_RMU, I_RW0, I_RWUP, I_RA0, I_RAUP, I_RGUP, I_RKK, I_RKA, I_RRK, I_RLG, I_RLB,
       I_WBR, I_WGATE, I_BGATE, I_WOUT, I_FWG, I_FWU, I_FCW, I_FWD };

DI float bf2f(bf16_t v) { return __uint_as_float(((unsigned)v) << 16); }
typedef __bf16 bf16n2 __attribute__((ext_vector_type(2)));
typedef float f32x2_ __attribute__((ext_vector_type(2)));
DI unsigned pack2(float lo, float hi) { f32x2_ v = {lo, hi}; bf16n2 b = __builtin_convertvector(v, bf16n2); return __builtin_bit_cast(unsigned, b); }
DI bf16_t f2bf(float x) { return (bf16_t)(pack2(x, x) & 0xffffu); }
DI float sigmoidf_(float x) { return __builtin_amdgcn_rcpf(1.f + __expf(-x)); }
DI float sigmoid_rcp(float x) { return __builtin_amdgcn_rcpf(1.f + __expf(-x)); }
DI float gelu_rcp(float x) { float u = 0.7978845608f * (x + 0.044715f * x * x * x); return x * __builtin_amdgcn_rcpf(1.f + __expf(-2.f * u)); }
DI float softplusf_(float x) { return fmaxf(x, 0.f) + __logf(1.f + __expf(-fabsf(x))); }
DI float siluf_(float x) { return x * __builtin_amdgcn_rcpf(1.f + __expf(-x)); }
DI float geluf_(float x) { float u = 0.7978845608f * (x + 0.044715f * x * x * x); return x * __builtin_amdgcn_rcpf(1.f + __expf(-2.f * u)); }
DI float tanhf_(float x) { return 1.f - 2.f * __builtin_amdgcn_rcpf(1.f + __expf(2.f * x)); }
DI float wave_sum(float x) {
#pragma unroll
  for (int o = 32; o >= 1; o >>= 1) x += __shfl_xor(x, o);
  return x;
}
template <int CTRL> DI float dppf(float x) { return __int_as_float(__builtin_amdgcn_update_dpp(0, __float_as_int(x), CTRL, 0xf, 0xf, true)); }
DI float reduce8(float x) { x += dppf<0xB1>(x); x += dppf<0x4E>(x); x += dppf<0x141>(x); return x; }
DI f32x16 mfma32(bf16x8 a, bf16x8 b, f32x16 c) { return __builtin_amdgcn_mfma_f32_32x32x16_bf16(a, b, c, 0, 0, 0); }
DI f32x4 mfma16(bf16x8 a, bf16x8 b, f32x4 c) { return __builtin_amdgcn_mfma_f32_16x16x32_bf16(a, b, c, 0, 0, 0); }
DI int crow(int i, int h) { return (i & 3) + 8 * (i >> 2) + 4 * h; }

DI float modv(const float* modp, const float* bada, int l, int b, int idx) {
  const float* q = modp + ((size_t)(l * 16 + b)) * 6144 + idx;
  const size_t ks = (size_t)4 * 16 * 6144;
  return bada[l * 6144 + idx] + q[0] + q[ks] + q[2 * ks] + q[3 * ks];
}

DI int otid() { int t = threadIdx.x; asm volatile("" : "+v"(t)); return t; }
DI int obid() { int b = blockIdx.x; asm volatile("" : "+s"(b)); return b; }
DI void phase_mod(const Params& p, char* smem) {
  float* sm = (float*)smem;
  float* modp = (float*)(p.ws + OFF_MODP);
  const int tid = otid();
  if (obid() == 0 && tid < 64) ((unsigned*)(p.ws + OFF_CTR))[tid] = 0u;
  for (int item = obid(); item < 192; item += gridDim.x) {
    const int l = item / 48, rem = item % 48, jb = rem >> 2, kq = rem & 3;
    for (int i = 0; i < 8; ++i) {
      int e = tid + 512 * i; int b = e >> 8, k = e & 255;
      float cv = p.in[I_C][b * 1024 + kq * 256 + k];
      sm[e] = siluf_(cv);
    }
    __syncthreads();
    float acc[16];
#pragma unroll
    for (int b = 0; b < 16; ++b) acc[b] = 0.f;
    const float* wp = p.in[I_WADA] + ((size_t)l * 1024 + kq * 256) * 6144 + jb * 512 + tid;
    for (int k = 0; k < 256; k += 4) {
      float w0 = wp[(size_t)k * 6144], w1 = wp[(size_t)(k + 1) * 6144], w2 = wp[(size_t)(k + 2) * 6144], w3 = wp[(size_t)(k + 3) * 6144];
#pragma unroll
      for (int b = 0; b < 16; ++b) {
        f32x4 cv = *(const f32x4*)(sm + b * 256 + k);
        acc[b] += cv[0] * w0 + cv[1] * w1 + cv[2] * w2 + cv[3] * w3;
      }
    }
#pragma unroll
    for (int b = 0; b < 16; ++b) modp[((size_t)((kq * 4 + l) * 16 + b)) * 6144 + jb * 512 + tid] = acc[b];
    __syncthreads();
  }
}

DI void conv_tile(const float* src, bf16_t* dst, int K, int N, int k0, int n0, char* smem) {
  float* tile = (float*)smem;
  const int tid = otid();
#pragma unroll
  for (int it = 0; it < 2; ++it) {
    int kr = (tid >> 4) + 32 * it, nc = (tid & 15) * 4;
    f32x4 v = {0.f, 0.f, 0.f, 0.f};
    if (n0 + nc < N) v = *(const f32x4*)(src + (size_t)(k0 + kr) * N + n0 + nc);
    tile[kr * 65 + nc] = v[0]; tile[kr * 65 + nc + 1] = v[1]; tile[kr * 65 + nc + 2] = v[2]; tile[kr * 65 + nc + 3] = v[3];
  }
  __syncthreads();
  {
    int n = tid >> 3, kc = (tid & 7) * 8;
    unsigned o[4];
#pragma unroll
    for (int e = 0; e < 4; ++e) o[e] = pack2(tile[(kc + 2 * e) * 65 + n], tile[(kc + 2 * e + 1) * 65 + n]);
    uint4 ov = {o[0], o[1], o[2], o[3]};
    *(uint4*)(dst + (size_t)(n0 + n) * K + k0 + kc) = ov;
  }
  __syncthreads();
}

DI void phase_convert(const Params& p, int l, char* smem) {
  for (int t = obid(); t < 4480; t += gridDim.x) {
    const float* src; bf16_t* dst; int K, N, Npad, tt = t;
    if (tt < 832) { src = p.in[I_WIN] + (size_t)l * 1024 * 3208; dst = (bf16_t*)(p.ws + OFF_WIN); K = 1024; N = 3208; Npad = 3328; }
    else if ((tt -= 832) < 1024) { int br = tt >> 8; tt &= 255; src = p.in[I_WGATE] + ((size_t)l * 4 + br) * 1048576; dst = (bf16_t*)(p.ws + OFF_WG) + (size_t)br * 1048576; K = 1024; N = 1024; Npad = 1024; }
    else if ((tt -= 1024) < 256) { int br = tt >> 6; tt &= 63; src = p.in[I_WBR] + ((size_t)l * 4 + br) * 262144; dst = (bf16_t*)(p.ws + OFF_WBR) + (size_t)br * 262144; K = 256; N = 1024; Npad = 1024; }
    else if ((tt -= 256) < 256) { src = p.in[I_WOUT] + (size_t)l * 1048576; dst = (bf16_t*)(p.ws + OFF_WO); K = 1024; N = 1024; Npad = 1024; }
    else if ((tt -= 256) < 704) { src = p.in[I_FWG] + (size_t)l * 1024 * 2816; dst = (bf16_t*)(p.ws + OFF_WF); K = 1024; N = 2816; Npad = 2816; }
    else if ((tt -= 704) < 704) { src = p.in[I_FWU] + (size_t)l * 1024 * 2816; dst = (bf16_t*)(p.ws + OFF_WF) + (size_t)2816 * 1024; K = 1024; N = 2816; Npad = 2816; }
    else { tt -= 704; src = p.in[I_FWD] + (size_t)l * 2816 * 1024; dst = (bf16_t*)(p.ws + OFF_WD); K = 2816; N = 1024; Npad = 1024; }
    const int nNt = Npad >> 6;
    const int kt = tt / nNt, nt = tt % nNt;
    conv_tile(src, dst, K, N, kt * 64, nt * 64, smem);
  }
}

DI void phase_norm(const Params& p, const float* xin, const float* g, int l, int scale_idx, int shift_idx, bf16_t* hout, float* fout) {
  const float* modp = (const float*)(p.ws + OFF_MODP);
  const int lane = otid() & 63, wv = otid() >> 6;
  const int nw = gridDim.x * 8;
  const int rows_per = 32;
  for (int chunk = obid() * 8 + wv; chunk < NTOK / 32; chunk += nw) {
  const int row0 = chunk * rows_per;
  const int b = row0 / SEQ;
  f32x4 gv[4], sc[4], sh[4];
#pragma unroll
  for (int j = 0; j < 4; ++j) {
    int c = lane * 4 + 256 * j;
    gv[j] = *(const f32x4*)(g + c);
    if (hout) {
#pragma unroll
      for (int e = 0; e < 4; ++e) {
        sc[j][e] = 1.f + modv(modp, p.in[I_BADA], l, b, scale_idx + c + e);
        sh[j][e] = modv(modp, p.in[I_BADA], l, b, shift_idx + c + e);
      }
    }
  }
  for (int rr = 0; rr < rows_per; ++rr) {
    const size_t row = (size_t)row0 + rr;
    f32x4 xv[4]; float ss = 0.f;
#pragma unroll
    for (int j = 0; j < 4; ++j) {
      xv[j] = *(const f32x4*)(xin + row * DM + lane * 4 + 256 * j);
      ss += xv[j][0] * xv[j][0] + xv[j][1] * xv[j][1] + xv[j][2] * xv[j][2] + xv[j][3] * xv[j][3];
    }
    ss = wave_sum(ss);
    const float rs = rsqrtf(ss * (1.f / 1024.f) + EPSF);
#pragma unroll
    for (int j = 0; j < 4; ++j) {
      f32x4 y = xv[j] * rs * gv[j];
      if (hout) {
        y = y * sc[j] + sh[j];
        uint2 o = {pack2(y[0], y[1]), pack2(y[2], y[3])};
        *(uint2*)(hout + row * DM + lane * 4 + 256 * j) = o;
      } else {
        *(f32x4*)(fout + row * DM + lane * 4 + 256 * j) = y;
      }
    }
  }
  }
}

#define PG_LAS __attribute__((address_space(3)))
namespace pg {
constexpr int BM = 256, BK = 64, HALF = 128, HTB = HALF * BK * 2, NXCD = 8, WGM = 8;
DI int lds_byte(int r, int c) { const int st = (r >> 4) * 2 + (c >> 5), rr = r & 15, cc = c & 31, ob = rr * 64 + cc * 2; return st * 1024 + (ob ^ (((ob >> 9) & 1) << 5)); }
DI void stage_rc(int b, int& R, int& C) { const int st = b / 1024, sb = b % 1024, swz = sb ^ (((sb >> 9) & 1) << 5); R = (st >> 1) * 16 + swz / 64; C = (st & 1) * 32 + (swz % 64) / 2; }
DI int perm32(int rho) { const int n = rho >> 4, i = rho & 15; return 8 * (i >> 2) + 4 * n + (i & 3); }
struct Unit { int pm, pn; int aux; long ao, bo; };
template <int REP> struct Order {
  int nM, nN, nwg, G, c, ashift; long astep, bstep, apnstep;
  DI void init(int M, int N, int G_, int c_, long astep_ = 0, long bstep_ = 0, int ashift_ = 0, long apnstep_ = 0) {
    nM = M / BM; nN = N / BM; nwg = nM * nN; G = G_; c = c_; astep = astep_; bstep = bstep_; ashift = ashift_; apnstep = apnstep_; }
  DI bool next(int i, Unit& u) const {
    const int ti = i / REP, aux = i % REP;
    const long L = (long)ti * G + c; if (L >= nwg) return false;
    int wgid = (int)L; { const int q = nwg / NXCD, r = nwg % NXCD, xcd = wgid % NXCD, off = wgid / NXCD; wgid = (xcd < r ? xcd * (q + 1) : r * (q + 1) + (xcd - r) * q) + off; }
    const int nig = WGM * nN, gid = wgid / nig, fm = gid * WGM, gsz = (nM - fm) < WGM ? (nM - fm) : WGM;
    u.pm = fm + ((wgid % nig) % gsz); u.pn = (wgid % nig) / gsz; u.aux = aux; u.ao = aux * astep + (long)(u.pn >> ashift) * apnstep; u.bo = aux * bstep; return true;
  }
};
DI unsigned cvt_pk_bf16(float lo, float hi) { return pack2(lo, hi); }

template <class Epi, class Sched>
DI void gemm_phase(PG_LAS unsigned char* lds, const bf16_t* Ag, int lda, const bf16_t* Bg, int K, const Sched& S, const Epi& E) {
  const int tid = otid(), wid = __builtin_amdgcn_readfirstlane(tid >> 6), lane = tid & 63, wr = wid >> 2, wc = wid & 3, fr = lane & 15, fq = lane >> 4;
  const int nt = K / BK;
  unsigned voffA[2], voffB[2];
#pragma unroll
  for (int i = 0; i < 2; ++i) { int R, C; stage_rc(tid * 16 + i * 8192, R, C); const int Rb = Epi::PERM ? ((R & ~31) + perm32(R & 31)) : R;
    voffA[i] = (unsigned)(R * lda + C) * 2u; voffB[i] = (unsigned)(Rb * K + C) * 2u; }
  const size_t kstep = (size_t)(BK * 2);
  const size_t hstepA = (size_t)HALF * lda * 2, hstepB = (size_t)HALF * K * 2;
  const size_t tstepA = 2 * hstepA, tstepB = 2 * hstepB;
  const unsigned ldsw = (unsigned)wid * 1024u;
  const int aoff = lds_byte(wr * 64 + fr, fq * 8), boff = lds_byte(wc * 32 + fr, fq * 8);
#define PG_SA(b, h) (((b) * 2 + (h)) * HTB)
#define PG_SB(b, h) ((4 + (b) * 2 + (h)) * HTB)
#define PG_STAGE(bufoff, gbase, voff) do { _Pragma("unroll") for (int _i = 0; _i < 2; ++_i) \
    __builtin_amdgcn_global_load_lds((const unsigned*)((const char*)(gbase) + (voff)[_i]), (PG_LAS unsigned*)(lds + (bufoff) + ldsw + _i * 8192), 16, 0, 0); } while (0)
#define PG_LDA(dst, b, h) do { _Pragma("unroll") for (int m = 0; m < 4; ++m) _Pragma("unroll") for (int k = 0; k < 2; ++k) dst[m][k] = *(const PG_LAS bf16x8*)(lds + PG_SA(b, h) + aoff + m * 2048 + k * 1024); } while (0)
#define PG_LDB(dst, b, h) do { _Pragma("unroll") for (int n = 0; n < 2; ++n) _Pragma("unroll") for (int k = 0; k < 2; ++k) dst[n][k] = *(const PG_LAS bf16x8*)(lds + PG_SB(b, h) + boff + n * 2048 + k * 1024); } while (0)
#define PG_MMA(ai, bj, At, Bt) do { __builtin_amdgcn_s_setprio(1); _Pragma("unroll") for (int m = 0; m < 4; ++m) _Pragma("unroll") for (int n = 0; n < 2; ++n) _Pragma("unroll") for (int k = 0; k < 2; ++k) \
    acc[ai][bj][m][n] = __builtin_amdgcn_mfma_f32_16x16x32_bf16(Bt[n][k], At[m][k], acc[ai][bj][m][n], 0, 0, 0); __builtin_amdgcn_s_setprio(0); } while (0)
#define PG_WAIT_V(n) asm volatile("s_waitcnt vmcnt(" #n ")" ::: "memory")
#define PG_WAIT_L(n) asm volatile("s_waitcnt lgkmcnt(" #n ")" ::: "memory")
#define PG_BAR __builtin_amdgcn_s_barrier()
#define PG_SCHED __builtin_amdgcn_sched_barrier(0)
  Unit cur, nxt; int ui = 0;
  if (!S.next(0, cur)) return;
  f32x4 acc[2][2][4][2];
#pragma unroll
  for (int a = 0; a < 2; ++a)
#pragma unroll
    for (int b = 0; b < 2; ++b)
#pragma unroll
      for (int m = 0; m < 4; ++m)
#pragma unroll
        for (int n = 0; n < 2; ++n) acc[a][b][m][n] = (f32x4){0.f, 0.f, 0.f, 0.f};
  bf16x8 At[4][2], B0[2][2], B1[2][2];
  const char* cA = (const char*)Ag + (size_t)cur.pm * tstepA + cur.ao; const char* cB = (const char*)Bg + (size_t)cur.pn * tstepB + cur.bo;
  PG_STAGE(PG_SB(0, 0), cB, voffB); PG_STAGE(PG_SA(0, 0), cA, voffA); PG_STAGE(PG_SB(0, 1), cB + hstepB, voffB); PG_STAGE(PG_SA(0, 1), cA + hstepA, voffA);
  if (wr == 1) PG_BAR;
  PG_WAIT_V(4); PG_BAR;
  PG_STAGE(PG_SB(1, 0), cB + kstep, voffB); PG_STAGE(PG_SA(1, 0), cA + kstep, voffA); PG_STAGE(PG_SB(1, 1), cB + hstepB + kstep, voffB);
  PG_WAIT_V(6); PG_BAR;
  for (;;) {
    const bool has_next = S.next(ui + 1, nxt);
    const char* nA = has_next ? (const char*)Ag + (size_t)nxt.pm * tstepA + nxt.ao : cA; const char* nB = has_next ? (const char*)Bg + (size_t)nxt.pn * tstepB + nxt.bo : cB;
#pragma unroll 1
    for (int t = 0; t < nt; t += 2) {
      const bool last = (t == nt - 2);
      const char* a1 = cA + (size_t)(t + 1) * kstep;
      const char* a2 = last ? nA : cA + (size_t)(t + 2) * kstep; const char* b2 = last ? nB : cB + (size_t)(t + 2) * kstep;
      const char* a3 = a2 + kstep; const char* b3 = b2 + kstep;
      PG_LDB(B0, 0, 0); PG_SCHED; PG_LDA(At, 0, 0); PG_STAGE(PG_SA(1, 1), a1 + hstepA, voffA);
      PG_WAIT_L(8); PG_BAR; PG_WAIT_L(0); PG_MMA(0, 0, At, B0); PG_BAR; PG_SCHED;
      PG_LDB(B1, 0, 1); PG_STAGE(PG_SB(0, 0), b2, voffB);
      PG_BAR; PG_WAIT_L(0); PG_MMA(0, 1, At, B1); PG_BAR;
      PG_LDA(At, 0, 1); PG_STAGE(PG_SA(0, 0), a2, voffA);
      PG_BAR; PG_WAIT_L(0); PG_MMA(1, 0, At, B0); PG_BAR; PG_SCHED;
      PG_STAGE(PG_SB(0, 1), b2 + hstepB, voffB);
      PG_WAIT_V(6); PG_BAR; PG_MMA(1, 1, At, B1); PG_BAR;
      PG_LDB(B0, 1, 0); PG_SCHED; PG_LDA(At, 1, 0); PG_STAGE(PG_SA(0, 1), a2 + hstepA, voffA);
      PG_WAIT_L(8); PG_BAR; PG_WAIT_L(0); PG_MMA(0, 0, At, B0); PG_BAR; PG_SCHED;
      PG_LDB(B1, 1, 1); PG_STAGE(PG_SB(1, 0), b3, voffB);
      PG_BAR; PG_WAIT_L(0); PG_MMA(0, 1, At, B1); PG_BAR;
      PG_LDA(At, 1, 1); PG_STAGE(PG_SA(1, 0), a3, voffA);
      PG_BAR; PG_WAIT_L(0); PG_MMA(1, 0, At, B0); PG_BAR; PG_SCHED;
      PG_STAGE(PG_SB(1, 1), b3 + hstepB, voffB);
      PG_WAIT_V(6); PG_BAR; PG_MMA(1, 1, At, B1); PG_BAR;
    }
    E(acc, cur, wr, wc, fr, fq);
    if (!has_next) break;
#pragma unroll
    for (int a = 0; a < 2; ++a)
#pragma unroll
      for (int b = 0; b < 2; ++b)
#pragma unroll
        for (int m = 0; m < 4; ++m)
#pragma unroll
          for (int n = 0; n < 2; ++n) acc[a][b][m][n] = (f32x4){0.f, 0.f, 0.f, 0.f};
    cur = nxt; cA = nA; cB = nB; ++ui;
  }
  PG_WAIT_V(0);
  if (wr == 0) PG_BAR;
  PG_BAR;
#undef PG_SA
#undef PG_SB
#undef PG_STAGE
#undef PG_LDA
#undef PG_LDB
#undef PG_MMA
#undef PG_WAIT_V
#undef PG_WAIT_L
#undef PG_BAR
#undef PG_SCHED
}

template <int ACT> struct EpiBf16 {
  static constexpr bool PERM = true;
  bf16_t* O; int ldc; const float* bias;
  DI void operator()(const f32x4 (&acc)[2][2][4][2], const Unit& u, int wr, int wc, int fr, int fq) const {
    const int row0 = u.pm * BM + wr * 64 + fr, col0 = u.pn * BM + wc * 32 + 8 * fq;
    f32x4 bv[2][2];
#pragma unroll
    for (int bj = 0; bj < 2; ++bj)
#pragma unroll
      for (int n = 0; n < 2; ++n) bv[bj][n] = ACT ? *(const f32x4*)(bias + col0 + bj * HALF + 4 * n) : (f32x4){0.f, 0.f, 0.f, 0.f};
#pragma unroll
    for (int ai = 0; ai < 2; ++ai)
#pragma unroll
      for (int m = 0; m < 4; ++m) { bf16_t* rowp = O + (size_t)(row0 + ai * HALF + m * 16) * ldc + col0;
#pragma unroll
        for (int bj = 0; bj < 2; ++bj) { f32x4 v0 = acc[ai][bj][m][0], v1 = acc[ai][bj][m][1];
          if (ACT) { v0 += bv[bj][0]; v1 += bv[bj][1];
#pragma unroll
            for (int j = 0; j < 4; ++j) { v0[j] = sigmoid_rcp(v0[j]); v1[j] = sigmoid_rcp(v1[j]); } }
          u32x4 w; w.x = cvt_pk_bf16(v0[0], v0[1]); w.y = cvt_pk_bf16(v0[2], v0[3]); w.z = cvt_pk_bf16(v1[0], v1[1]); w.w = cvt_pk_bf16(v1[2], v1[3]);
          *(u32x4*)(rowp + bj * HALF) = w; } }
  }
};
struct EpiBranch {
  static constexpr bool PERM = true;
  bf16_t* MIX; const bf16_t* G;
  DI void operator()(const f32x4 (&acc)[2][2][4][2], const Unit& u, int wr, int wc, int fr, int fq) const {
    const int row0 = u.pm * BM + wr * 64 + fr, col0 = u.pn * BM + wc * 32 + 8 * fq;
#pragma unroll
    for (int ai = 0; ai < 2; ++ai)
#pragma unroll
      for (int m = 0; m < 4; ++m) {
        asm volatile("" ::: "memory");
        const size_t row = (size_t)(row0 + ai * HALF + m * 16);
        bf16_t* mp = MIX + row * DM + col0; const bf16_t* gp = G + row * 4096 + u.aux * 1024 + col0;
#pragma unroll
        for (int bj = 0; bj < 2; ++bj) {
          const bf16x8 gv = *(const bf16x8*)(gp + bj * HALF);
          float o[8];
#pragma unroll
          for (int j = 0; j < 4; ++j) { o[j] = bf2f((bf16_t)gv[j]) * acc[ai][bj][m][0][j]; o[4 + j] = bf2f((bf16_t)gv[4 + j]) * acc[ai][bj][m][1][j]; }
          if (u.aux > 0) {
            const bf16x8 mv = *(const bf16x8*)(mp + bj * HALF);
#pragma unroll
            for (int j = 0; j < 8; ++j) o[j] += bf2f((bf16_t)mv[j]);
          }
          u32x4 w; w.x = cvt_pk_bf16(o[0], o[1]); w.y = cvt_pk_bf16(o[2], o[3]); w.z = cvt_pk_bf16(o[4], o[5]); w.w = cvt_pk_bf16(o[6], o[7]);
          *(u32x4*)(mp + bj * HALF) = w;
        }
      }
  }
};
struct EpiResid {
  static constexpr bool PERM = false;
  const float* xold; float* xnew; const float* modp; const float* bada; int l, gate_idx;
  DI void operator()(const f32x4 (&acc)[2][2][4][2], const Unit& u, int wr, int wc, int fr, int fq) const {
    const int row0 = u.pm * BM + wr * 64 + fr, col0 = u.pn * BM + wc * 32 + 4 * fq;
    const int b = (u.pm * BM) / SEQ;
    f32x4 gv[2][2];
#pragma unroll
    for (int bj = 0; bj < 2; ++bj)
#pragma unroll
      for (int n = 0; n < 2; ++n)
#pragma unroll
        for (int j = 0; j < 4; ++j) gv[bj][n][j] = modv(modp, bada, l, b, gate_idx + col0 + bj * HALF + n * 16 + j);
#pragma unroll
    for (int ai = 0; ai < 2; ++ai)
#pragma unroll
      for (int m = 0; m < 4; ++m) { const size_t ro = (size_t)(row0 + ai * HALF + m * 16) * DM + col0;
#pragma unroll
        for (int bj = 0; bj < 2; ++bj)
#pragma unroll
          for (int n = 0; n < 2; ++n) {
            const f32x4 xo = *(const f32x4*)(xold + ro + bj * HALF + n * 16);
            *(f32x4*)(xnew + ro + bj * HALF + n * 16) = xo + gv[bj][n] * acc[ai][bj][m][n];
          } }
  }
};
struct EpiFfnAct {
  static constexpr bool PERM = true;
  bf16_t* ACT; const bf16_t* APRE; const float* cw;
  DI void operator()(const f32x4 (&acc)[2][2][4][2], const Unit& u, int wr, int wc, int fr, int fq) const {
    const int row0 = u.pm * BM + wr * 64 + fr, col0 = u.pn * BM + wc * 32 + 8 * fq;
#pragma unroll
    for (int ai = 0; ai < 2; ++ai)
#pragma unroll
      for (int m = 0; m < 4; ++m) {
        asm volatile("" ::: "memory");
        const int row = row0 + ai * HALF + m * 16; const int sp = row & (SEQ - 1);
        const bf16_t* ap = APRE + (size_t)row * FFN + col0;
        bf16_t* op = ACT + (size_t)row * FFN + col0;
#pragma unroll
        for (int bj = 0; bj < 2; ++bj) {
          const int c = bj * HALF;
          const bf16x8 z8 = {0, 0, 0, 0, 0, 0, 0, 0};
          const bf16x8 a0 = *(const bf16x8*)(ap + c);
          const bf16x8 a1 = sp >= 1 ? *(const bf16x8*)(ap - FFN + c) : z8;
          const bf16x8 a2 = sp >= 2 ? *(const bf16x8*)(ap - 2 * FFN + c) : z8;
          float o[8];
#pragma unroll
          for (int hh = 0; hh < 2; ++hh) {
            const f32x4 w0 = *(const f32x4*)(cw + col0 + c + 4 * hh), w1 = *(const f32x4*)(cw + FFN + col0 + c + 4 * hh), w2 = *(const f32x4*)(cw + 2 * FFN + col0 + c + 4 * hh);
#pragma unroll
            for (int j = 0; j < 4; ++j) {
              const float cv = w0[j] * bf2f((bf16_t)a2[4 * hh + j]) + w1[j] * bf2f((bf16_t)a1[4 * hh + j]) + w2[j] * bf2f((bf16_t)a0[4 * hh + j]);
              o[4 * hh + j] = gelu_rcp(cv) * acc[ai][bj][m][hh][j];
            }
          }
          u32x4 w; w.x = cvt_pk_bf16(o[0], o[1]); w.y = cvt_pk_bf16(o[2], o[3]); w.z = cvt_pk_bf16(o[4], o[5]); w.w = cvt_pk_bf16(o[6], o[7]);
          *(u32x4*)(op + c) = w;
        }
      }
  }
};
struct EpiGateMix {
  static constexpr bool PERM = true;
  bf16_t* MIX; float* MIX32; const bf16_t* BH; const float* bias;
  DI void operator()(const f32x4 (&acc)[2][2][4][2], const Unit& u, int wr, int wc, int fr, int fq) const {
    const int row0 = u.pm * BM + wr * 64 + fr, col0 = u.pn * BM + wc * 32 + 8 * fq;
    const bool rmw = u.aux > 0, fin = u.aux == 3;
    f32x4 bv[2][2];
#pragma unroll
    for (int bj = 0; bj < 2; ++bj)
#pragma unroll
      for (int n = 0; n < 2; ++n) bv[bj][n] = *(const f32x4*)(bias + u.aux * 1024 + col0 + bj * HALF + 4 * n);
    const f32x4 z4 = {0.f, 0.f, 0.f, 0.f};
    bf16x8 nb[2]; f32x4 nm[2][2];
#define GM_LOAD(it_) { const size_t row_ = (size_t)(row0 + ((it_) >> 2) * HALF + ((it_) & 3) * 16); \
      _Pragma("unroll") for (int bj = 0; bj < 2; ++bj) { nb[bj] = *(const bf16x8*)(BH + row_ * 4096 + u.aux * 1024 + col0 + bj * HALF); \
        nm[bj][0] = rmw ? *(const f32x4*)(MIX32 + row_ * DM + col0 + bj * HALF) : z4; nm[bj][1] = rmw ? *(const f32x4*)(MIX32 + row_ * DM + col0 + bj * HALF + 4) : z4; } }
    GM_LOAD(0);
#pragma unroll
    for (int it = 0; it < 8; ++it) {
      const int ai = it >> 2, m = it & 3;
      bf16x8 cb[2]; f32x4 cm[2][2];
#pragma unroll
      for (int bj = 0; bj < 2; ++bj) { cb[bj] = nb[bj]; cm[bj][0] = nm[bj][0]; cm[bj][1] = nm[bj][1]; }
      if (it + 1 < 8) GM_LOAD(it + 1);
      const size_t ro = (size_t)(row0 + ai * HALF + m * 16) * DM + col0;
#pragma unroll
      for (int bj = 0; bj < 2; ++bj) {
        f32x4 o[2];
#pragma unroll
        for (int hh = 0; hh < 2; ++hh)
#pragma unroll
          for (int j = 0; j < 4; ++j)
            o[hh][j] = sigmoid_rcp(acc[ai][bj][m][hh][j] + bv[bj][hh][j]) * bf2f((bf16_t)cb[bj][4 * hh + j]) + cm[bj][hh][j];
        if (fin) {
          u32x4 w; w.x = cvt_pk_bf16(o[0][0], o[0][1]); w.y = cvt_pk_bf16(o[0][2], o[0][3]); w.z = cvt_pk_bf16(o[1][0], o[1][1]); w.w = cvt_pk_bf16(o[1][2], o[1][3]);
          *(u32x4*)(MIX + ro + bj * HALF) = w;
        } else {
          *(f32x4*)(MIX32 + ro + bj * HALF) = o[0]; *(f32x4*)(MIX32 + ro + bj * HALF + 4) = o[1];
        }
      }
    }
#undef GM_LOAD
  }
};
}

DI void phase_ffn_act(const Params& p, int l) {
  bf16_t* AU = (bf16_t*)(p.ws + OFF_P);
  const float* cw = p.in[I_FCW] + (size_t)l * 3 * FFN;
  const int nthr = gridDim.x * NTHR;
  for (int run = obid() * NTHR + otid(); run < 1024 * 352; run += nthr) {
    const int ch = run / 352, j8 = run % 352, j0 = j8 * 8;
    float w0[8], w1[8], w2[8];
#pragma unroll
    for (int e = 0; e < 8; ++e) { w0[e] = cw[j0 + e]; w1[e] = cw[FFN + j0 + e]; w2[e] = cw[2 * FFN + j0 + e]; }
    const int t0 = ch * 64, s0 = t0 % SEQ;
    float a1[8], a2[8];
#pragma unroll
    for (int e = 0; e < 8; ++e) { a1[e] = 0.f; a2[e] = 0.f; }
    if (s0 > 0) {
      bf16x8 v1 = *(const bf16x8*)(AU + (size_t)(t0 - 1) * AUS + j0);
      bf16x8 v2 = *(const bf16x8*)(AU + (size_t)(t0 - 2) * AUS + j0);
#pragma unroll
      for (int e = 0; e < 8; ++e) { a1[e] = bf2f((bf16_t)v1[e]); a2[e] = bf2f((bf16_t)v2[e]); }
    }
    for (int t = t0; t < t0 + 64; ++t) {
      bf16x8 va = *(const bf16x8*)(AU + (size_t)t * AUS + j0);
      bf16x8 vu = *(const bf16x8*)(AU + (size_t)t * AUS + FFN + j0);
      float o[8];
#pragma unroll
      for (int e = 0; e < 8; ++e) {
        float a0 = bf2f((bf16_t)va[e]);
        float cv = w0[e] * a2[e] + w1[e] * a1[e] + w2[e] * a0;
        o[e] = geluf_(cv) * bf2f((bf16_t)vu[e]);
        a2[e] = a1[e]; a1[e] = a0;
      }
      uint4 ov = {pack2(o[0], o[1]), pack2(o[2], o[3]), pack2(o[4], o[5]), pack2(o[6], o[7])};
      *(uint4*)(AU + (size_t)t * AUS + FFN + j0) = ov;
    }
  }
}

DI float mixf(bf16_t cur, bf16_t prev, float mu) { const float c = bf2f(cur); return c + (bf2f(prev) - c) * mu; }
DI void rw_prep_item(const Params& p, int l, int item, char* smem) {
  const bf16_t* P = (const bf16_t*)(p.ws + OFF_P);
  bf16_t* RD = (bf16_t*)(p.ws + OFF_L);
  bf16_t* RKK = (bf16_t*)(p.ws + OFF_L + GSZ);
  bf16_t* RA = (bf16_t*)(p.ws + OFF_L + 2 * GSZ);
  bf16_t* RG = (bf16_t*)(p.ws + OFF_L + 3 * GSZ);
  float* BON = (float*)(p.ws + OFF_BON);
  float* C12 = (float*)(p.ws + OFF_C12);
  const int b = item >> 6, ct = item & 63;
  const int tid = otid(), lane = tid & 63, wv = tid >> 6, hd = wv & 3, mi = wv >> 2, r = lane & 31, h = lane >> 5;
  bf16_t* TX = (bf16_t*)smem;
  bf16_t* XA = TX + 64 * 40;
  bf16_t* SG = XA + 64 * 40;
  bf16_t* RK = SG + 64 * 72;
  const float* mu = p.in[I_RMU] + (size_t)l * 896;
  const size_t tok0 = (size_t)b * SEQ + ct * 64;
  bf16x8 bw[2][2], ba[2][2], bg[2][4];
  {
    const float* wp = p.in[I_RWUP] + (size_t)l * 32 * 256 + hd * 64 + r;
    const float* ap = p.in[I_RAUP] + (size_t)l * 32 * 256 + hd * 64 + r;
    const float* gp = p.in[I_RGUP] + (size_t)l * 64 * 256 + hd * 64 + r;
    asm volatile("" : "+v"(wp), "+v"(ap), "+v"(gp));
#pragma unroll
    for (int ni = 0; ni < 2; ++ni) {
#pragma unroll
      for (int ks = 0; ks < 2; ++ks) {
        unsigned uw[4], ua[4];
#pragma unroll
        for (int j2 = 0; j2 < 4; ++j2) {
          const int k = 16 * ks + 8 * h + 2 * j2;
          uw[j2] = pack2(wp[k * 256 + 32 * ni], wp[(k + 1) * 256 + 32 * ni]);
          ua[j2] = pack2(ap[k * 256 + 32 * ni], ap[(k + 1) * 256 + 32 * ni]);
        }
        uint4 t1 = {uw[0], uw[1], uw[2], uw[3]}, t2 = {ua[0], ua[1], ua[2], ua[3]};
        bw[ni][ks] = __builtin_bit_cast(bf16x8, t1); ba[ni][ks] = __builtin_bit_cast(bf16x8, t2);
      }
#pragma unroll
      for (int ks = 0; ks < 4; ++ks) {
        unsigned ug[4];
#pragma unroll
        for (int j2 = 0; j2 < 4; ++j2) { const int k = 16 * ks + 8 * h + 2 * j2; ug[j2] = pack2(gp[k * 256 + 32 * ni], gp[(k + 1) * 256 + 32 * ni]); }
        uint4 t3 = {ug[0], ug[1], ug[2], ug[3]};
        bg[ni][ks] = __builtin_bit_cast(bf16x8, t3);
      }
    }
  }
#pragma unroll 4
  for (int i = 0; i < 16; ++i) {
    const int e = tid + NTHR * i; const int t = e >> 7, f = e & 127;
    const bf16_t* pr = P + (tok0 + t) * PSTR + C_RW + 768 + f;
    const bf16_t cur = pr[0];
    const bf16_t prev = (ct * 64 + t > 0) ? (pr - PSTR)[0] : (bf16_t)0;
    const float m = mixf(cur, prev, mu[768 + f]);
    if (f < 32) TX[t * 40 + f] = f2bf(tanhf_(m));
    else if (f < 64) XA[t * 40 + f - 32] = f2bf(m);
    else SG[t * 72 + f - 64] = f2bf(sigmoidf_(m));
  }
#pragma unroll 2
  for (int i = 0; i < 8; ++i) {
    const int q = tid + NTHR * i; const int t = q >> 6, col = (q & 63) * 8;
    const bf16_t* pr = P + (tok0 + t) * PSTR + C_RW + col;
    const bf16x8 cur = *(const bf16x8*)pr;
    bf16x8 prev = {0, 0, 0, 0, 0, 0, 0, 0};
    if (ct * 64 + t > 0) prev = *(const bf16x8*)(pr - PSTR);
    const f32x4 m0 = *(const f32x4*)(mu + col), m1 = *(const f32x4*)(mu + col + 4);
    float o[8];
#pragma unroll
    for (int e = 0; e < 4; ++e) { o[e] = mixf((bf16_t)cur[e], (bf16_t)prev[e], m0[e]); o[4 + e] = mixf((bf16_t)cur[4 + e], (bf16_t)prev[4 + e], m1[e]); }
    uint4 ov = {pack2(o[0], o[1]), pack2(o[2], o[3]), pack2(o[4], o[5]), pack2(o[6], o[7])};
    *(uint4*)(RK + t * 520 + col) = ov;
  }
  __syncthreads();
  f32x16 cw[2], ca[2], cg[2];
#pragma unroll
  for (int ni = 0; ni < 2; ++ni)
#pragma unroll
    for (int i = 0; i < 16; ++i) { cw[ni][i] = 0.f; ca[ni][i] = 0.f; cg[ni][i] = 0.f; }
#pragma unroll
  for (int ks = 0; ks < 2; ++ks) {
    const bf16x8 atx = *(const bf16x8*)(TX + (32 * mi + r) * 40 + 16 * ks + 8 * h);
    const bf16x8 axa = *(const bf16x8*)(XA + (32 * mi + r) * 40 + 16 * ks + 8 * h);
#pragma unroll
    for (int ni = 0; ni < 2; ++ni) { cw[ni] = mfma32(atx, bw[ni][ks], cw[ni]); ca[ni] = mfma32(axa, ba[ni][ks], ca[ni]); }
  }
#pragma unroll
  for (int ks = 0; ks < 4; ++ks) {
    const bf16x8 asg = *(const bf16x8*)(SG + (32 * mi + r) * 72 + 16 * ks + 8 * h);
#pragma unroll
    for (int ni = 0; ni < 2; ++ni) cg[ni] = mfma32(asg, bg[ni][ks], cg[ni]);
  }
  float ss[16], bn[16], q1[16], q2[16];
#pragma unroll
  for (int i = 0; i < 16; ++i) { ss[i] = 0.f; bn[i] = 0.f; q1[i] = 0.f; q2[i] = 0.f; }
#pragma unroll
  for (int ni = 0; ni < 2; ++ni) {
    const int hc = hd * 64 + 32 * ni + r;
    const float w0c = p.in[I_RW0][l * 256 + hc], a0c = p.in[I_RA0][l * 256 + hc], kkc = p.in[I_RKK][l * 256 + hc],
                kac = p.in[I_RKA][l * 256 + hc], rkc = p.in[I_RRK][l * 256 + hc];
#pragma unroll
    for (int i = 0; i < 16; ++i) {
      const int tl = 32 * mi + crow(i, h);
      const size_t tok = tok0 + tl;
      const float rr = bf2f(RK[tl * 520 + hc]);
      const float k = bf2f(RK[tl * 520 + 256 + hc]);
      const float wl = w0c + cw[ni][i];
      const float wlog = -softplusf_(-wl) - 0.5f;
      const float dd = 1.f - __expf(-__expf(wlog));
      const float a = sigmoidf_(a0c + ca[ni][i]);
      const float kkr = k * kkc;
      const float kp = k * (1.f + (a - 1.f) * kac);
      ss[i] += kkr * kkr; bn[i] += rr * kp * rkc; q1[i] += kkr * a * rr; q2[i] += kp * rr;
      cw[ni][i] = kkr;
      RD[tok * 256 + hc] = f2bf(dd); RA[tok * 256 + hc] = f2bf(a); RG[tok * 256 + hc] = f2bf(cg[ni][i]);
    }
  }
#pragma unroll
  for (int i = 0; i < 16; ++i) {
#pragma unroll
    for (int o = 1; o < 32; o <<= 1) { ss[i] += __shfl_xor(ss[i], o); bn[i] += __shfl_xor(bn[i], o); q1[i] += __shfl_xor(q1[i], o); q2[i] += __shfl_xor(q2[i], o); }
    ss[i] = rsqrtf(ss[i] + EPSF);
  }
#pragma unroll
  for (int ni = 0; ni < 2; ++ni) {
    const int hc = hd * 64 + 32 * ni + r;
#pragma unroll
    for (int i = 0; i < 16; ++i) {
      const size_t tok = tok0 + 32 * mi + crow(i, h);
      RKK[tok * 256 + hc] = f2bf(cw[ni][i] * ss[i]);
    }
  }
  if (r == 0) {
#pragma unroll
    for (int i = 0; i < 16; ++i) { const size_t th = (tok0 + 32 * mi + crow(i, h)) * 4 + hd; BON[th] = bn[i]; C12[th * 2] = q1[i] * ss[i]; C12[th * 2 + 1] = q2[i]; }
  }
}

DI void rwkv_scan_item(const Params& p, int l, int b, int hd, int half, char* smem) {
  const bf16_t* P = (const bf16_t*)(p.ws + OFF_P);
  bf16_t* O = (bf16_t*)(p.ws + OFF_O);
  const bf16_t* RD = (const bf16_t*)(p.ws + OFF_L);
  const bf16_t* RKK = (const bf16_t*)(p.ws + OFF_L + GSZ);
  const bf16_t* RA = (const bf16_t*)(p.ws + OFF_L + 2 * GSZ);
  const float* C12 = (const float*)(p.ws + OFF_C12);
  float* fb = (float*)smem;
  float* Yb = fb + 2 * 12352;
  const int tid = otid(), lane = tid & 63, wv = tid >> 6;
  const int hc = hd * 64 + lane;
  constexpr int NCH = SEQ / 32;
  f32x4 Sa = {0.f, 0.f, 0.f, 0.f}, Sb = {0.f, 0.f, 0.f, 0.f};
  const int rl = lane >> 3, kq = lane & 7, vloc = (wv & 3) * 8 + rl, vrow = half * 32 + vloc;
  const float* mu = p.in[I_RMU] + (size_t)l * 896;
  const float mu_r = mu[hc], mu_k = mu[256 + hc], mu_v = mu[512 + hc];
  const float kac = p.in[I_RKA][l * 256 + hc];
  const int pw = wv & 3;
  unsigned raw[8][9];
#pragma unroll
  for (int j = 0; j < 8; ++j)
#pragma unroll
    for (int e = 0; e < 9; ++e) raw[j][e] = 0u;
#define RAWLOAD(i_)                                                                                 \
  {                                                                                                 \
    _Pragma("unroll") for (int j = 0; j < 8; ++j) {                                                 \
      const int s_ = (i_) * 32 + pw * 8 + j;                                                        \
      const size_t tok_ = (size_t)b * SEQ + s_;                                                     \
      const bf16_t* pr_ = P + tok_ * PSTR + C_RW;                                                   \
      raw[j][0] = pr_[hc]; raw[j][1] = pr_[256 + hc]; raw[j][2] = pr_[512 + hc];                    \
      if (s_ > 0) { raw[j][3] = (pr_ - PSTR)[hc]; raw[j][4] = (pr_ - PSTR)[256 + hc]; raw[j][5] = (pr_ - PSTR)[512 + hc]; } \
      else { raw[j][3] = 0u; raw[j][4] = 0u; raw[j][5] = 0u; }                                      \
      raw[j][6] = RD[tok_ * 256 + hc]; raw[j][7] = RKK[tok_ * 256 + hc]; raw[j][8] = RA[tok_ * 256 + hc]; \
    }                                                                                               \
  }
#define RBAR() { asm volatile("s_waitcnt lgkmcnt(0)" ::: "memory"); __builtin_amdgcn_s_barrier(); asm volatile("" ::: "memory"); }
  if (wv >= 4) RAWLOAD(0);
#pragma unroll 1
  for (int i = 0; i < NCH + 2; ++i) {
    if (wv >= 4) {
      float* B = fb + (i & 1) * 12352;
      if (i >= 2) {
        const float* Yc = Yb + (i & 1) * 1024;
        if (lane < 32) {
#pragma unroll
          for (int j = 0; j < 8; ++j) {
            const int tl = pw * 8 + j;
            const size_t tok = (size_t)b * SEQ + (i - 2) * 32 + tl;
            O[tok * DM + 768 + hd * 64 + half * 32 + lane] = f2bf(Yc[tl * 32 + lane]);
          }
        }
      }
      if (i < NCH) {
#pragma unroll
        for (int j = 0; j < 8; ++j) {
          const int tl = pw * 8 + j;
          const float r = mixf((bf16_t)raw[j][0], (bf16_t)raw[j][3], mu_r), k = mixf((bf16_t)raw[j][1], (bf16_t)raw[j][4], mu_k), v = mixf((bf16_t)raw[j][2], (bf16_t)raw[j][5], mu_v);
          const float w = 1.f - bf2f((bf16_t)raw[j][6]), kk = bf2f((bf16_t)raw[j][7]), a = bf2f((bf16_t)raw[j][8]);
          const float ka = kk * a, kp = k * (1.f + (a - 1.f) * kac);

          B[tl * 64 + lane] = w; B[2048 + tl * 64 + lane] = kk; B[4096 + tl * 64 + lane] = ka; B[6144 + tl * 64 + lane] = kp;
          B[8192 + tl * 64 + lane] = w * r; B[10240 + tl * 64 + lane] = v;
          if (lane < 2) B[12288 + tl * 2 + lane] = C12[(((size_t)b * SEQ + i * 32 + tl) * 4 + hd) * 2 + lane];
        }
        if (i + 1 < NCH) RAWLOAD(i + 1);
      }
    } else if (i >= 1 && i <= NCH) {
      const float* B = fb + ((i - 1) & 1) * 12352;
      float* Yc = Yb + ((i - 1) & 1) * 1024;
      f32x4 vw[2][10]; float vvv[2]; float2 vsc[2];
#define RWLD(t_, s_)                                                                              \
      { const float* bt_ = B + (t_) * 64 + kq * 8;                                                 \
        _Pragma("unroll") for (int q_ = 0; q_ < 5; ++q_) { vw[s_][2 * q_] = *(const f32x4*)(bt_ + 2048 * q_); vw[s_][2 * q_ + 1] = *(const f32x4*)(bt_ + 2048 * q_ + 4); } \
        vvv[s_] = B[10240 + (t_) * 64 + vrow]; vsc[s_] = *(const float2*)(B + 12288 + (t_) * 2); }
#pragma unroll 1
      for (int tb = 0; tb < 32; tb += 16) {
      RWLD(tb, 0);
#pragma unroll
      for (int t = 0; t < 16; ++t) {
        const int cs = t & 1;
        if (t + 1 < 16) RWLD(tb + t + 1, cs ^ 1);
        const f32x4 w0 = vw[cs][0], w1 = vw[cs][1], kk0 = vw[cs][2], kk1 = vw[cs][3], ka0 = vw[cs][4], ka1 = vw[cs][5],
                    kp0 = vw[cs][6], kp1 = vw[cs][7], wr0 = vw[cs][8], wr1 = vw[cs][9];
        const float vv = vvv[cs]; const float2 sc = vsc[cs];
        const f32x4 pd = Sa * kk0 + Sb * kk1, pe = Sa * wr0 + Sb * wr1;
        float d0 = (pd[0] + pd[1]) + (pd[2] + pd[3]), e0 = (pe[0] + pe[1]) + (pe[2] + pe[3]);
        const f32x4 Ua = Sa * w0 + vv * kp0, Ub = Sb * w1 + vv * kp1;
        d0 = reduce8(d0); e0 = reduce8(e0);
        const float sa0 = -d0;
        const float y0 = e0 + sa0 * sc.x + vv * sc.y;
        Sa = Ua + sa0 * ka0; Sb = Ub + sa0 * ka1;
        if (kq == 0) Yc[(tb + t) * 32 + vloc] = y0;
      }
      }
#undef RWLD
    }
    RBAR();
  }
#undef RAWLOAD
#undef RBAR
}

DI void rwkv_post(const Params& p, int l) {
  const bf16_t* P = (const bf16_t*)(p.ws + OFF_P);
  bf16_t* O = (bf16_t*)(p.ws + OFF_O);
  const bf16_t* RG = (const bf16_t*)(p.ws + OFF_L + 3 * GSZ);
  const float* BON = (const float*)(p.ws + OFF_BON);
  const int tid = otid(), lane = tid & 63, wv = tid >> 6;
  const float* mu = p.in[I_RMU] + (size_t)l * 896;
  const int nw = gridDim.x * 8;
  for (int task0 = (obid() * 8 + wv) * 4; task0 < NTOK * 4; task0 += nw * 4) {
    float yv[4], vv[4], gv[4], bv[4];
#pragma unroll
    for (int q = 0; q < 4; ++q) {
      const int task = task0 + q; const size_t tok = task >> 2; const int hd = task & 3, hc = hd * 64 + lane;
      yv[q] = bf2f(O[tok * DM + 768 + hc]);
      const bf16_t cur = P[tok * PSTR + C_RW + 512 + hc];
      const bf16_t prev = (tok % SEQ) ? P[(tok - 1) * PSTR + C_RW + 512 + hc] : (bf16_t)0;
      vv[q] = mixf(cur, prev, mu[512 + hc]);
      gv[q] = bf2f(RG[tok * 256 + hc]); bv[q] = BON[tok * 4 + hd];
    }
#pragma unroll
    for (int q = 0; q < 4; ++q) {
      const int task = task0 + q; const size_t tok = task >> 2; const int hd = task & 3, hc = hd * 64 + lane;
      const float mean = wave_sum(yv[q]) * (1.f / 64.f);
      const float d = yv[q] - mean;
      const float var = wave_sum(d * d) * (1.f / 64.f);
      const float yn = d * rsqrtf(var + 64e-5f) * p.in[I_RLG][l * 256 + hc] + p.in[I_RLB][l * 256 + hc];
      O[tok * DM + 768 + hc] = f2bf((yn + bv[q] * vv[q]) * gv[q]);
    }
  }
}

DI void sb_item(const Params& p, int item, char* smem) {
  const bf16_t* P = (const bf16_t*)(p.ws + OFF_P);
  bf16_t* O = (bf16_t*)(p.ws + OFF_O);
  const int qt = item & 15, hd = (item >> 4) & 3, b = item >> 6;
  const int tid = otid(), lane = tid & 63, wv = tid >> 6, r = lane & 31, h = lane >> 5;
  bf16_t* Vt = (bf16_t*)(smem + wv * 8704);
  const int q0 = qt * 256 + wv * 32;
  const int sq = q0 + r;
  const size_t tokb = (size_t)b * SEQ;
  bf16x8 qf[4];
#pragma unroll
  for (int ks = 0; ks < 4; ++ks) qf[ks] = *(const bf16x8*)(P + (tokb + sq) * PSTR + C_SB_Q + hd * 64 + ks * 16 + h * 8);
  f32x16 accO[2];
#pragma unroll
  for (int i = 0; i < 16; ++i) { accO[0][i] = 0.f; accO[1][i] = 0.f; }
  float Prun = 1.f;
  bf16x8 kf[2][4];
  const int kt0 = (q0 + 31) >> 6;
#define SBKLOAD(kt_) { _Pragma("unroll") for (int m = 0; m < 2; ++m) _Pragma("unroll") for (int ks = 0; ks < 4; ++ks) \
    kf[m][ks] = *(const bf16x8*)(P + (tokb + (kt_) * 64 + 32 * m + r) * PSTR + C_SB_K + hd * 64 + ks * 16 + h * 8); }
  SBKLOAD(kt0);
  for (int kt = kt0; kt >= 0; --kt) {
    const int k0 = kt * 64;
    bf16x8 vr[8];
#pragma unroll
    for (int it = 0; it < 8; ++it) vr[it] = *(const bf16x8*)(P + (tokb + k0 + it * 8 + (lane >> 3)) * PSTR + C_SB_V + hd * 64 + (lane & 7) * 8);
    f32x16 acc[2];
#pragma unroll
    for (int m = 0; m < 2; ++m) {
#pragma unroll
      for (int i = 0; i < 16; ++i) acc[m][i] = 0.f;
#pragma unroll
      for (int ks = 0; ks < 4; ++ks) acc[m] = mfma32(kf[m][ks], qf[ks], acc[m]);
    }
    if (kt > 0) SBKLOAD(kt - 1);
    float om[2][16];
#pragma unroll
    for (int m = 0; m < 2; ++m)
#pragma unroll
      for (int i = 0; i < 16; ++i) {
        const int key = k0 + 32 * m + crow(i, h);
        const float z = fmaxf(acc[m][i] * 0.125f, -80.f);
        const float e = __expf(-z);
        const float sg = __builtin_amdgcn_rcpf(1.f + e);
        const bool valid = key < sq;
        acc[m][i] = valid ? sg : 0.f;
        om[m][i] = valid ? e * sg : 1.f;
      }
    float gp[8];
#pragma unroll
    for (int q = 0; q < 8; ++q) {
      const int m = q >> 2, g = q & 3;
      gp[q] = (om[m][4 * g] * om[m][4 * g + 1]) * (om[m][4 * g + 2] * om[m][4 * g + 3]);
    }
    float run = 1.f;
#pragma unroll
    for (int q = 7; q >= 0; --q) {
      const int m = q >> 2, g = q & 3;
      const float pg = __shfl_xor(gp[q], 32);
      const float f3 = Prun * run * (h == 0 ? pg : 1.f);
      const float f2 = f3 * om[m][4 * g + 3], f1 = f2 * om[m][4 * g + 2], f0 = f1 * om[m][4 * g + 1];
      acc[m][4 * g + 3] *= f3; acc[m][4 * g + 2] *= f2; acc[m][4 * g + 1] *= f1; acc[m][4 * g + 0] *= f0;
      run *= gp[q] * pg;
    }
    Prun *= run;
    __builtin_amdgcn_wave_barrier();
#pragma unroll
    for (int it = 0; it < 8; ++it) {
      const int key = it * 8 + (lane >> 3), chv = lane & 7;
#pragma unroll
      for (int e = 0; e < 8; ++e) Vt[(chv * 8 + e) * 68 + key] = (bf16_t)vr[it][e];
    }
    __builtin_amdgcn_wave_barrier();
#pragma unroll
    for (int m = 0; m < 2; ++m)
#pragma unroll
      for (int s2 = 0; s2 < 2; ++s2) {
        uint4 uu = {pack2(acc[m][8 * s2 + 0], acc[m][8 * s2 + 1]), pack2(acc[m][8 * s2 + 2], acc[m][8 * s2 + 3]),
                    pack2(acc[m][8 * s2 + 4], acc[m][8 * s2 + 5]), pack2(acc[m][8 * s2 + 6], acc[m][8 * s2 + 7])};
        const bf16x8 pb = __builtin_bit_cast(bf16x8, uu);
#pragma unroll
        for (int dt = 0; dt < 2; ++dt) {
          const bf16_t* vp = Vt + (32 * dt + r) * 68 + 32 * m + 16 * s2 + 4 * h;
          s16x4 lo = *(const s16x4*)vp, hi = *(const s16x4*)(vp + 8);
          bf16x8 va = __builtin_shufflevector(lo, hi, 0, 1, 2, 3, 4, 5, 6, 7);
          accO[dt] = mfma32(va, pb, accO[dt]);
        }
      }
    __builtin_amdgcn_wave_barrier();
    if (__ballot(Prun > 1e-37f) == 0ull) break;
  }
#undef SBKLOAD
#pragma unroll
  for (int dt = 0; dt < 2; ++dt)
#pragma unroll
    for (int g = 0; g < 4; ++g) {
      const int d = 32 * dt + 8 * g + 4 * h;
      uint2 o = {pack2(accO[dt][4 * g], accO[dt][4 * g + 1]), pack2(accO[dt][4 * g + 2], accO[dt][4 * g + 3])};
      *(uint2*)(O + (tokb + sq) * DM + 256 + hd * 64 + d) = o;
    }
}

DI int frag_off(int row, int k) {
  const int rt = row >> 4, fr = row & 15, ks = k >> 5, kk = k & 31, hi = kk >> 4, fq = (kk & 15) >> 2, j = (kk & 3) + 4 * hi;
  return ((rt * 2 + ks) * 64 + fq * 16 + fr) * 8 + j;
}
DI int frag_off8(int row, int k0) {
  const int rt = row >> 4, fr = row & 15, ks = k0 >> 5, kk = k0 & 31, hi = kk >> 4, fq = (kk & 15) >> 2;
  return ((rt * 2 + ks) * 64 + fq * 16 + fr) * 8 + 4 * hi;
}
DI void gdn_intra_item(const Params& p, int l, int item, char* smem) {
  const bf16_t* P = (const bf16_t*)(p.ws + OFF_P);
  const int hp = item & 1, c = (item >> 1) & 63, b = item >> 7;
  const int tid = otid(), lane = tid & 63;
  bf16_t* Kb = (bf16_t*)smem;
  bf16_t* Qb = Kb + 2 * 64 * 72;
  bf16_t* Vb = Qb + 2 * 64 * 72;
  float* Lm = (float*)(smem + 3 * 2 * 64 * 72 * 2);
  float* Gs = Lm + 2 * 4096;
  float* Bs = Gs + 128;
  const size_t tok0 = (size_t)b * SEQ + c * 64;
  const float* cw = p.in[I_GCW] + (size_t)l * 4 * 768;
  float* CW = Bs + 128;
  for (int e = tid; e < 6 * 4 * 64; e += NTHR) {
    const int blk = e >> 8, j = (e >> 6) & 3, col = e & 63;
    const int hh_ = blk / 3, which_ = blk % 3;
    CW[e] = cw[j * 768 + which_ * 256 + (hp * 2 + hh_) * 64 + col];
  }
  __syncthreads();
  {
    const int t = tid >> 3, cg = tid & 7;
#pragma unroll 3
    for (int it = 0; it < 6; ++it) {
      const int hh = it / 3, which = it % 3, head = hp * 2 + hh;
      const int ccol = which * 256 + head * 64 + cg * 8;
      float acc[8];
#pragma unroll
      for (int e = 0; e < 8; ++e) acc[e] = 0.f;
#pragma unroll
      for (int j = 0; j < 4; ++j) {
        const int s = c * 64 + t - 3 + j;
        if (s >= 0) {
          bf16x8 xv = *(const bf16x8*)(P + ((size_t)b * SEQ + s) * PSTR + C_GDN_Q + ccol);
          f32x4 wa = *(const f32x4*)(CW + (it * 4 + j) * 64 + cg * 8), wb = *(const f32x4*)(CW + (it * 4 + j) * 64 + cg * 8 + 4);
#pragma unroll
          for (int e = 0; e < 4; ++e) { acc[e] += wa[e] * bf2f((bf16_t)xv[e]); acc[e + 4] += wb[e] * bf2f((bf16_t)xv[e + 4]); }
        }
      }
      float ss = 0.f;
#pragma unroll
      for (int e = 0; e < 8; ++e) { acc[e] = siluf_(acc[e]); ss += acc[e] * acc[e]; }
      ss += __shfl_xor(ss, 1); ss += __shfl_xor(ss, 2); ss += __shfl_xor(ss, 4);
      float sc = 1.f;
      if (which == 0) sc = rsqrtf(ss + EPSF) * 0.125f;
      else if (which == 1) sc = rsqrtf(ss + EPSF);
      uint4 ov = {pack2(acc[0] * sc, acc[1] * sc), pack2(acc[2] * sc, acc[3] * sc), pack2(acc[4] * sc, acc[5] * sc), pack2(acc[6] * sc, acc[7] * sc)};
      bf16_t* dst = (which == 0 ? Qb : (which == 1 ? Kb : Vb)) + (hh * 64 + t) * 72 + cg * 8;
      *(uint4*)dst = ov;
    }
  }
  if (tid < 128) {
    const int hh = tid >> 6, t = lane, head = hp * 2 + hh;
    const float a_in = bf2f(P[(tok0 + t) * PSTR + C_GDN_A + head]);
    const float b_in = bf2f(P[(tok0 + t) * PSTR + C_GDN_B + head]);
    const float beta = sigmoidf_(b_in);
    float g = -__expf(p.in[I_GAL][l * 4 + head]) * softplusf_(a_in + p.in[I_GDT][l * 4 + head]);
#pragma unroll
    for (int d = 1; d < 64; d <<= 1) { float v = __shfl_up(g, d); if (lane >= d) g += v; }
    Gs[hh * 64 + t] = g; Bs[hh * 64 + t] = beta;
  }
  __syncthreads();
  const int hh = tid >> 8, lt = tid & 255, head = hp * 2 + hh;
  const size_t ih = ((size_t)(b * 4 + head)) * 64 + c;
  bf16_t* GW = (bf16_t*)(p.ws + OFF_G) + ih * 4096;
  bf16_t* GQD = (bf16_t*)(p.ws + OFF_G + GSZ) + ih * 4096;
  bf16_t* GQK = (bf16_t*)(p.ws + OFF_G + 2 * GSZ) + ih * 4096;
  bf16_t* GKD = (bf16_t*)(p.ws + OFF_G + 3 * GSZ) + ih * 4096;
  bf16_t* GU = (bf16_t*)(p.ws + OFF_G + 4 * GSZ) + ih * 4096;
  float* GCD = (float*)(p.ws + OFF_GCD);
  const float* Gh = Gs + hh * 64; const float* Bh = Bs + hh * 64;
  {
    const int wq = (tid >> 6) & 3, ti = wq >> 1, tj = wq & 1, r = lane & 31, h = lane >> 5;
    f32x16 akk, aqk;
#pragma unroll
    for (int i = 0; i < 16; ++i) { akk[i] = 0.f; aqk[i] = 0.f; }
    if (ti >= tj) {
#pragma unroll
      for (int ks = 0; ks < 4; ++ks) {
        bf16x8 ka = *(const bf16x8*)(Kb + (hh * 64 + 32 * ti + r) * 72 + ks * 16 + h * 8);
        bf16x8 qa = *(const bf16x8*)(Qb + (hh * 64 + 32 * ti + r) * 72 + ks * 16 + h * 8);
        bf16x8 kb = *(const bf16x8*)(Kb + (hh * 64 + 32 * tj + r) * 72 + ks * 16 + h * 8);
        akk = mfma32(ka, kb, akk);
        aqk = mfma32(qa, kb, aqk);
      }
    }
    const int j = 32 * tj + r;
    const float Gj = Gh[j];
#pragma unroll
    for (int i_ = 0; i_ < 16; ++i_) {
      const int i = 32 * ti + crow(i_, h);
      const float dec = (i >= j) ? __expf(Gh[i] - Gj) : 0.f;
      Lm[hh * 4096 + i * 64 + j] = (i > j) ? Bh[i] * akk[i_] * dec : 0.f;
      GQK[frag_off(i, j)] = f2bf((i >= j) ? aqk[i_] * dec : 0.f);
    }
  }
  __syncthreads();
  if (lt < 128) {
    const int cc = lt;
    float x[64];
    if (cc < 64) {
#pragma unroll
      for (int i = 0; i < 64; ++i) x[i] = bf2f(Vb[(hh * 64 + i) * 72 + cc]) * Bh[i];
    } else {
#pragma unroll
      for (int i = 0; i < 64; ++i) x[i] = bf2f(Kb[(hh * 64 + i) * 72 + cc - 64]) * Bh[i] * __expf(Gh[i]);
    }
    const float* Lh = Lm + hh * 4096;
#pragma unroll
    for (int i = 1; i < 64; ++i) {
      float s = x[i];
#pragma unroll
      for (int j4 = 0; j4 < (i + 3) / 4; ++j4) {
        const f32x4 lv = *(const f32x4*)(Lh + i * 64 + j4 * 4);
#pragma unroll
        for (int e = 0; e < 4; ++e) if (j4 * 4 + e < i) s -= lv[e] * x[j4 * 4 + e];
      }
      x[i] = s;
    }
    if (cc < 64) {
      const int split = cc >> 4, fr = cc & 15;
#pragma unroll
      for (int i4 = 0; i4 < 16; ++i4) {
        uint2 ov = {pack2(x[4 * i4], x[4 * i4 + 1]), pack2(x[4 * i4 + 2], x[4 * i4 + 3])};
        *(uint2*)(GU + ((split * 4 + (i4 >> 2)) * 64 + (i4 & 3) * 16 + fr) * 4) = ov;
      }
    } else {
#pragma unroll
      for (int i = 0; i < 64; ++i) GW[frag_off(i, cc - 64)] = f2bf(x[i]);
    }
  } else {
    const int q_ = lt - 128;
    const float Glast = Gh[63];
#pragma unroll
    for (int i = 0; i < 4; ++i) {
      const int q = q_ + 128 * i; const int pos = q >> 3, kc = q & 7;
      bf16x8 qv = *(const bf16x8*)(Qb + (hh * 64 + pos) * 72 + kc * 8);
      const float eg = __expf(Gh[pos]);
      uint4 ov = {pack2(bf2f((bf16_t)qv[0]) * eg, bf2f((bf16_t)qv[1]) * eg), pack2(bf2f((bf16_t)qv[2]) * eg, bf2f((bf16_t)qv[3]) * eg),
                  pack2(bf2f((bf16_t)qv[4]) * eg, bf2f((bf16_t)qv[5]) * eg), pack2(bf2f((bf16_t)qv[6]) * eg, bf2f((bf16_t)qv[7]) * eg)};
      { const int fo = frag_off8(pos, kc * 8); uint2 o0 = {ov.x, ov.y}, o1 = {ov.z, ov.w}; *(uint2*)(GQD + fo) = o0; *(uint2*)(GQD + fo + 128) = o1; }
    }
#pragma unroll
    for (int i = 0; i < 4; ++i) {
      const int q = q_ + 128 * i; const int k = q >> 3, pc = q & 7;
      float o[8];
#pragma unroll
      for (int e = 0; e < 8; ++e) { const int pos = pc * 8 + e; o[e] = bf2f(Kb[(hh * 64 + pos) * 72 + k]) * __expf(Glast - Gh[pos]); }
      uint4 ov = {pack2(o[0], o[1]), pack2(o[2], o[3]), pack2(o[4], o[5]), pack2(o[6], o[7])};
      { const int fo = frag_off8(k, pc * 8); uint2 o0 = {ov.x, ov.y}, o1 = {ov.z, ov.w}; *(uint2*)(GKD + fo) = o0; *(uint2*)(GKD + fo + 128) = o1; }
    }
    if (q_ == 0) GCD[ih] = __expf(Glast);
  }
}

DI void gdn_rec_item(const Params& p, int l, int b, int head, char* smem) {
  const bf16_t* P = (const bf16_t*)(p.ws + OFF_P);
  bf16_t* O = (bf16_t*)(p.ws + OFF_O);
  float* SS = (float*)(smem + 81920);
  const int tid = otid(), lane = tid & 63, wv = tid >> 6, fr = lane & 15, fq = lane >> 4;
  const int split = wv & 3;
  const bool active = wv < 4;
  const float ng = p.in[I_GNG][l * 64 + split * 16 + fr];
  const float* GCD = (const float*)(p.ws + OFF_GCD);
  const size_t ih0 = ((size_t)(b * 4 + head)) * 64;
  f32x4 S[4];
#pragma unroll
  for (int kt = 0; kt < 4; ++kt) S[kt] = (f32x4){0.f, 0.f, 0.f, 0.f};
  u32x4 lr[10];
#pragma unroll
  for (int i = 0; i < 10; ++i) lr[i] = (u32x4){0u, 0u, 0u, 0u};
  const int lq = (wv & 3) * 64 + lane;
#define GLOADC(c_)                                                                              \
  {                                                                                             \
    _Pragma("unroll") for (int i = 0; i < 10; ++i) {                                            \
      const int q_ = lq + 256 * i; const int a_ = q_ >> 9, o_ = q_ & 511;                       \
      lr[i] = *(const u32x4*)((const bf16_t*)(p.ws + OFF_G + (size_t)a_ * GSZ) + (ih0 + (c_)) * 4096 + o_ * 8); \
    }                                                                                           \
  }
#define LSTORE(buf_)                                                                            \
  {                                                                                             \
    _Pragma("unroll") for (int i = 0; i < 10; ++i) {                                            \
      const int q_ = lq + 256 * i;                                                              \
      *(u32x4*)(smem + (buf_) * 40960 + q_ * 16) = lr[i];                                       \
    }                                                                                           \
  }
#define BAR_LDS() { asm volatile("s_waitcnt lgkmcnt(0)" ::: "memory"); __builtin_amdgcn_s_barrier(); asm volatile("" ::: "memory"); }
  float cdn = 0.f;
  if (!active) { GLOADC(0); LSTORE(0); GLOADC(1); }
  else cdn = GCD[ih0];
  BAR_LDS();
#pragma unroll 1
  for (int c = 0; c < 64; ++c) {
    f32x4 acco[4];
    if (active) {
      const char* bufp = smem + (c & 1) * 40960;
      const float cd = cdn;
      if (c + 1 < 64) cdn = GCD[ih0 + c + 1];
      float zr[16];
#pragma unroll
      for (int rt = 0; rt < 4; ++rt)
#pragma unroll
        for (int j = 0; j < 4; ++j) {
          const size_t tok = (size_t)b * SEQ + c * 64 + 16 * rt + 4 * fq + j;
          zr[rt * 4 + j] = bf2f(P[tok * PSTR + C_GDN_Z + head * 64 + split * 16 + fr]);
        }
      bf16x8 bS[2];
#pragma unroll
      for (int ks = 0; ks < 2; ++ks) {
        uint4 uu = {pack2(S[2 * ks][0], S[2 * ks][1]), pack2(S[2 * ks][2], S[2 * ks][3]), pack2(S[2 * ks + 1][0], S[2 * ks + 1][1]), pack2(S[2 * ks + 1][2], S[2 * ks + 1][3])};
        bS[ks] = __builtin_bit_cast(bf16x8, uu);
      }
      f32x4 u[4];
#pragma unroll
      for (int rt = 0; rt < 4; ++rt) {
        f32x4 aw = {0.f, 0.f, 0.f, 0.f};
        acco[rt] = (f32x4){0.f, 0.f, 0.f, 0.f};
#pragma unroll
        for (int ks = 0; ks < 2; ++ks) {
          const bf16x8 wa = *(const bf16x8*)(bufp + ((rt * 2 + ks) * 64 + lane) * 16);
          const bf16x8 qa = *(const bf16x8*)(bufp + 8192 + ((rt * 2 + ks) * 64 + lane) * 16);
          aw = mfma16(wa, bS[ks], aw); acco[rt] = mfma16(qa, bS[ks], acco[rt]);
        }
        const s16x4 uv = *(const s16x4*)(bufp + 32768 + ((split * 4 + rt) * 64 + lane) * 8);
#pragma unroll
        for (int j = 0; j < 4; ++j) u[rt][j] = bf2f((bf16_t)uv[j]) - aw[j];
      }
      bf16x8 bU[2];
#pragma unroll
      for (int ks = 0; ks < 2; ++ks) {
        uint4 uu = {pack2(u[2 * ks][0], u[2 * ks][1]), pack2(u[2 * ks][2], u[2 * ks][3]), pack2(u[2 * ks + 1][0], u[2 * ks + 1][1]), pack2(u[2 * ks + 1][2], u[2 * ks + 1][3])};
        bU[ks] = __builtin_bit_cast(bf16x8, uu);
      }
#pragma unroll
      for (int rt = 0; rt < 4; ++rt) {
        f32x4 sn = S[rt] * cd;
#pragma unroll
        for (int ks = 0; ks < 2; ++ks) {
          const bf16x8 qa = *(const bf16x8*)(bufp + 16384 + ((rt * 2 + ks) * 64 + lane) * 16);
          const bf16x8 ka = *(const bf16x8*)(bufp + 24576 + ((rt * 2 + ks) * 64 + lane) * 16);
          acco[rt] = mfma16(qa, bU[ks], acco[rt]); sn = mfma16(ka, bU[ks], sn);
        }
        S[rt] = sn;
      }
#pragma unroll
      for (int rt = 0; rt < 4; ++rt)
#pragma unroll
        for (int j = 0; j < 4; ++j) {
          float s = acco[rt][j] * acco[rt][j];
          s += __shfl_xor(s, 1); s += __shfl_xor(s, 2); s += __shfl_xor(s, 4); s += __shfl_xor(s, 8);
          if (fr == 0) SS[(c & 1) * 256 + split * 64 + 16 * rt + 4 * fq + j] = s;
        }
      BAR_LDS();
      const float* ssb = SS + (c & 1) * 256;
#pragma unroll
      for (int rt = 0; rt < 4; ++rt)
#pragma unroll
        for (int j = 0; j < 4; ++j) {
          const int pos = 16 * rt + 4 * fq + j;
          const float tot = ssb[pos] + ssb[64 + pos] + ssb[128 + pos] + ssb[192 + pos];
          const float rn = rsqrtf(tot * (1.f / 64.f) + EPSF);
          const size_t tok = (size_t)b * SEQ + c * 64 + pos;
          O[tok * DM + 512 + head * 64 + split * 16 + fr] = f2bf(acco[rt][j] * rn * ng * siluf_(zr[rt * 4 + j]));
        }
    } else {
      if (c + 1 < 64) LSTORE((c + 1) & 1);
      if (c + 2 < 64) GLOADC(c + 2);
      BAR_LDS();
    }
  }
#undef GLOADC
#undef LSTORE
#undef BAR_LDS
}

DI void lru_item(const Params& p, int l, int item, char* smem, const int mode) {
  const bf16_t* P = (const bf16_t*)(p.ws + OFF_P);
  bf16_t* O = (bf16_t*)(p.ws + OFF_O);
  float* CA = (float*)(p.ws + OFF_LCA);
  float* CH = (float*)(p.ws + OFF_LCH);
  bf16_t* XS = (bf16_t*)smem;
  bf16_t* UB = (bf16_t*)(smem + 34816);
  const int b = item >> 6, ct = item & 63;
  const int tid = otid(), lane = tid & 63, wv = tid >> 6, r = lane & 31, h = lane >> 5, n = wv & 3, mi = wv >> 2;
  for (int i = 0; i < 5; ++i) {
    const int q = tid + NTHR * i;
    if (q < 67 * 32) {
      const int row = q >> 5, cc = q & 31;
      const int s = ct * 64 - 3 + row;
      uint4 v = {0u, 0u, 0u, 0u};
      if (s >= 0) v = *(const uint4*)(P + ((size_t)b * SEQ + s) * PSTR + C_LRU_X + cc * 8);
      *(uint4*)(XS + row * 256 + cc * 8) = v;
    }
  }
  bf16x8 bwr[2][4], bwi[2][4];
  {
    const float* wrp = p.in[I_LWR] + (((size_t)l * 4 + n) * 64) * 64 + r;
    const float* wip = p.in[I_LWI] + (((size_t)l * 4 + n) * 64) * 64 + r;
    asm volatile("" : "+v"(wrp), "+v"(wip));
#pragma unroll
    for (int ni = 0; ni < 2; ++ni)
#pragma unroll
      for (int ks = 0; ks < 4; ++ks) {
        unsigned ur[4], ui[4];
#pragma unroll
        for (int j2 = 0; j2 < 4; ++j2) {
          const int e = 16 * ks + 8 * h + 2 * j2;
          ur[j2] = pack2(wrp[e * 64 + 32 * ni], wrp[(e + 1) * 64 + 32 * ni]);
          ui[j2] = pack2(wip[e * 64 + 32 * ni], wip[(e + 1) * 64 + 32 * ni]);
        }
        uint4 t1 = {ur[0], ur[1], ur[2], ur[3]}, t2 = {ui[0], ui[1], ui[2], ui[3]};
        bwr[ni][ks] = __builtin_bit_cast(bf16x8, t1); bwi[ni][ks] = __builtin_bit_cast(bf16x8, t2);
      }
  }
  __syncthreads();
  {
    const int sc = tid >> 8, c = tid & 255;
    const float cb = p.in[I_LCB][l * 256 + c];
    const float c0 = p.in[I_LCW][(l * 4 + 0) * 256 + c], c1 = p.in[I_LCW][(l * 4 + 1) * 256 + c],
                c2 = p.in[I_LCW][(l * 4 + 2) * 256 + c], c3 = p.in[I_LCW][(l * 4 + 3) * 256 + c];
    for (int t = sc * 32; t < sc * 32 + 32; ++t)
      UB[t * 264 + c] = f2bf(cb + c0 * bf2f(XS[t * 256 + c]) + c1 * bf2f(XS[(t + 1) * 256 + c]) + c2 * bf2f(XS[(t + 2) * 256 + c]) + c3 * bf2f(XS[(t + 3) * 256 + c]));
  }
  __syncthreads();
  f32x16 ar[2], ai[2];
#pragma unroll
  for (int ni = 0; ni < 2; ++ni)
#pragma unroll
    for (int i = 0; i < 16; ++i) { ar[ni][i] = 0.f; ai[ni][i] = 0.f; }
#pragma unroll
  for (int ks = 0; ks < 4; ++ks) {
    const bf16x8 au = *(const bf16x8*)(UB + (32 * mi + r) * 264 + n * 64 + 16 * ks + 8 * h);
#pragma unroll
    for (int ni = 0; ni < 2; ++ni) { ar[ni] = mfma32(au, bwr[ni][ks], ar[ni]); ai[ni] = mfma32(au, bwi[ni][ks], ai[ni]); }
  }
  const int ck = ct * 2 + mi;
#pragma unroll
  for (int ni = 0; ni < 2; ++ni) {
    const int c = n * 64 + 32 * ni + r;
    const float brc = p.in[I_LBR][l * 256 + c], bic = p.in[I_LBI][l * 256 + c];
    const float lamsp = softplusf_(-p.in[I_LLAM][l * 256 + c]);
    float av[16], bv[16];
#pragma unroll
    for (int i = 0; i < 16; ++i) {
      const int tl = 32 * mi + crow(i, h);
      const float u = bf2f(UB[tl * 264 + c]);
      const float rg = sigmoid_rcp(ar[ni][i] + brc), ig = sigmoid_rcp(ai[ni][i] + bic);
      const float la = -8.f * rg * lamsp;
      av[i] = __expf(la);
      bv[i] = __builtin_amdgcn_sqrtf(fmaxf(0.f, 1.f - __expf(2.f * la))) * (ig * u);
    }
    float GA[4], GB[4], PA[4], PB[4];
#pragma unroll
    for (int q = 0; q < 4; ++q) {
      float A = 1.f, hh = 0.f;
#pragma unroll
      for (int e = 0; e < 4; ++e) { hh = av[4 * q + e] * hh + bv[4 * q + e]; A *= av[4 * q + e]; }
      GA[q] = A; GB[q] = hh;
      PA[q] = __shfl_xor(A, 32); PB[q] = __shfl_xor(hh, 32);
    }
    float cin = 0.f;
    if (mode == 1) {
      const int lo = h ? (ck >> 1) : 0, hi = h ? ck : (ck >> 1);
      float A = 1.f, hh = 0.f;
      const float* ca = CA + ((size_t)b * 128) * 256 + c;
      const float* chp = CH + ((size_t)b * 128) * 256 + c;
      int k = lo;
      for (; k + 8 <= hi; k += 8) {
        float a8[8], h8[8];
#pragma unroll
        for (int e = 0; e < 8; ++e) { a8[e] = ca[(size_t)(k + e) * 256]; h8[e] = chp[(size_t)(k + e) * 256]; }
#pragma unroll
        for (int e = 0; e < 8; ++e) { hh = a8[e] * hh + h8[e]; A *= a8[e]; }
      }
      for (; k < hi; ++k) { const float a_ = ca[(size_t)k * 256], h_ = chp[(size_t)k * 256]; hh = a_ * hh + h_; A *= a_; }
      const float pAx = __shfl_xor(A, 32), pHx = __shfl_xor(hh, 32);
      cin = h ? (A * pHx + hh) : (pAx * hh + pHx);
    }
    float cg = cin, Ap = 1.f, myc[4];
#pragma unroll
    for (int q = 0; q < 4; ++q) {
      const float Ae = h ? PA[q] : GA[q], Be = h ? PB[q] : GB[q];
      const float Ao = h ? GA[q] : PA[q], Bo = h ? GB[q] : PB[q];
      const float c_even = cg;
      cg = Ae * cg + Be;
      const float c_odd = cg;
      cg = Ao * cg + Bo;
      myc[q] = h ? c_odd : c_even;
      Ap *= Ae * Ao;
    }
    if (mode == 0) {
      if (h == 0) { CA[((size_t)b * 128 + ck) * 256 + c] = Ap; CH[((size_t)b * 128 + ck) * 256 + c] = cg; }
    } else {
#pragma unroll
      for (int q = 0; q < 4; ++q) {
        float hh = myc[q];
#pragma unroll
        for (int e = 0; e < 4; ++e) {
          const int i = 4 * q + e;
          hh = av[i] * hh + bv[i];
          const size_t tok = (size_t)b * SEQ + ct * 64 + 32 * mi + crow(i, h);
          const float y = bf2f(P[tok * PSTR + C_LRU_Y + c]);
          O[tok * DM + c] = f2bf(hh * gelu_rcp(y));
        }
      }
    }
  }
}

#define XB_TMO      128
#define XB_XCNT(j)  (256  + 64 * (j))
#define XB_XSUB(j)  (1280 + 64 * (j))
#define XB_XGEN(j)  (2304 + 64 * (j))
#define XB_TOP      3328
#define XB_TOPGEN   3392
#define XCD_BAR_WORDS 3456
#define XB_SPIN_CAP (1u << 18)
#define XLAS __attribute__((address_space(3)))
DI unsigned xb_ld(unsigned* p)              { return __hip_atomic_load(p, __ATOMIC_RELAXED, __HIP_MEMORY_SCOPE_AGENT); }
DI unsigned xb_add(unsigned* p, unsigned v) { return __hip_atomic_fetch_add(p, v, __ATOMIC_RELAXED, __HIP_MEMORY_SCOPE_AGENT); }
DI unsigned xb_xcc_id() { return (unsigned)__builtin_amdgcn_s_getreg((3 << 11) | 20) & 0xFu; }
#define XB_SPIN(cond, bar) do { unsigned _sp = 0; while (cond) { __builtin_amdgcn_s_sleep(1); \
    if ((++_sp & 255u) == 0u) { if (xb_ld(&(bar)[XB_TMO])) break; if (_sp > XB_SPIN_CAP) { atomicAdd(&(bar)[XB_TMO], 1u); break; } } } } while (0)
struct XcdBarrier { unsigned* bar; unsigned x; volatile XLAS unsigned* st; };
DI XcdBarrier xcd_barrier_post(unsigned* bar, volatile XLAS unsigned* st) {
  XcdBarrier b; b.bar = bar; b.x = xb_xcc_id(); b.st = st;
  if (threadIdx.x == 0) (void)xb_add(&bar[XB_XCNT(b.x)], 1u);
  return b;
}
DI void xcd_barrier_complete(unsigned* bar, unsigned x, unsigned& nloc, unsigned& nx) {
  const unsigned G = gridDim.x * gridDim.y * gridDim.z;
  unsigned sum, cnt, mine, sp = 0u;
  for (;;) {
    sum = 0u; cnt = 0u; mine = 0u;
#pragma unroll
    for (unsigned j = 0; j < 16; ++j) { const unsigned c = xb_ld(&bar[XB_XCNT(j)]); sum += c; cnt += (c > 0u) ? 1u : 0u; mine = (j == x) ? c : mine; }
    if (sum == G) break;
    __builtin_amdgcn_s_sleep(1);
    if ((++sp & 255u) == 0u) { if (xb_ld(&bar[XB_TMO])) break; if (sp > XB_SPIN_CAP) { atomicAdd(&bar[XB_TMO], 1u); break; } }
  }
  nloc = mine > 0u ? mine : 1u; nx = cnt > 0u ? cnt : 1u;
}
DI void xcd_barrier(const XcdBarrier& b) {
  asm volatile("s_waitcnt vmcnt(0)" ::: "memory");
  __syncthreads();
  if (threadIdx.x == 0) {
    unsigned* bar = b.bar;
    __builtin_amdgcn_s_waitcnt(0);
    unsigned nloc = b.st[0], nx = b.st[1];
    if (nloc == 0u) { xcd_barrier_complete(bar, b.x, nloc, nx); b.st[0] = nloc; b.st[1] = nx; }
    const unsigned old = xb_add(&bar[XB_XSUB(b.x)], 1u);
    const unsigned gen = old / nloc;
    if (old + 1u == (gen + 1u) * nloc) {
      __builtin_amdgcn_fence(__ATOMIC_RELEASE, "agent");
      asm volatile("s_waitcnt vmcnt(0)" ::: "memory");
      const unsigned og = xb_add(&bar[XB_TOP], 1u);
      const unsigned tg = og / nx;
      if (og + 1u == (tg + 1u) * nx) xb_add(&bar[XB_TOPGEN], 1u);
      else XB_SPIN(xb_ld(&bar[XB_TOPGEN]) == tg, bar);
      __builtin_amdgcn_fence(__ATOMIC_ACQUIRE, "agent");
      xb_add(&bar[XB_XGEN(b.x)], 1u);
      asm volatile("s_waitcnt vmcnt(0)" ::: "memory");
    } else {
      XB_SPIN(xb_ld(&bar[XB_XGEN(b.x)]) == gen, bar);
      __builtin_amdgcn_fence(__ATOMIC_ACQUIRE, "agent");
      asm volatile("s_waitcnt vmcnt(0)" ::: "memory");
    }
  }
  __syncthreads();
}

__global__ void __launch_bounds__(NTHR) mega(Params p) {
  extern __shared__ __attribute__((aligned(16))) char smem[];
  cg::grid_group grid = cg::this_grid();
  const int tid = threadIdx.x;
  bf16_t* H = (bf16_t*)(p.ws + OFF_H);
  bf16_t* PB = (bf16_t*)(p.ws + OFF_P);
  PG_LAS unsigned char* lds = (PG_LAS unsigned char*)smem;
  volatile XLAS unsigned* xst = (volatile XLAS unsigned*)(smem + 131072);
  if (tid < 2) xst[tid] = 0u;
  __syncthreads();
  const XcdBarrier xb = xcd_barrier_post((unsigned*)(p.ws + OFF_BAR), xst);

  for (int rep = 0; rep < REP_MISC; ++rep) {
  if (MASK & 1) phase_mod(p, smem);
  grid.sync();
  }
  for (int l = 0; l < 4; ++l) {
    const float* xcur = (l == 0) ? p.in[I_X] : p.out;
    for (int rep = 0; rep < REP_MISC; ++rep) {
    if (MASK & 2) phase_convert(p, l, smem);
    if (MASK & 4) phase_norm(p, xcur, p.in[I_N1G] + l * 1024, l, 1024, 0, H, nullptr);
    xcd_barrier(xb);
    }
    for (int rep = 0; rep < REP_G; ++rep) {
    if (MASK & 8) { pg::Order<1> S; S.init(NTOK, PSTR, gridDim.x, blockIdx.x); pg::EpiBf16<0> E{PB, PSTR, nullptr};
      pg::gemm_phase(lds, H, DM, (const bf16_t*)(p.ws + OFF_WIN), 1024, S, E); }
    xcd_barrier(xb);
    }
    for (int rep = 0; rep < REP_M1; ++rep) {
    for (int it = blockIdx.x; it < 5120; it += gridDim.x) {
      if (it < 2048) { if (MASK & 32) gdn_intra_item(p, l, it, smem); }
      else if (it < 3072) { }
      else if (it < 4096) { if (MASK & 128) lru_item(p, l, it - 3072, smem, 0); }
      else { if (MASK & 16) rw_prep_item(p, l, it - 4096, smem); }
      __syncthreads();
    }
    xcd_barrier(xb);
    }
    for (int rep = 0; rep < REP_M2; ++rep) {
    if (blockIdx.x < 128) {
      if (MASK & 16) rwkv_scan_item(p, l, blockIdx.x >> 3, (blockIdx.x >> 1) & 3, blockIdx.x & 1, smem);
    } else {
      if (blockIdx.x < 192) { if (MASK & 256) gdn_rec_item(p, l, (blockIdx.x - 128) >> 2, (blockIdx.x - 128) & 3, smem); }
      unsigned* ctr = (unsigned*)(p.ws + OFF_CTR) + l * 4 + rep;
      volatile int* slot = (volatile int*)(smem + 110016);
      for (;;) {
        __syncthreads();
        if (tid == 0) *slot = (int)atomicAdd(ctr, 1u);
        __syncthreads();
        const int it = *slot;
        if (it >= 2048) break;
        if (it < 1024) { if (MASK & 64) sb_item(p, it, smem); }
        else { if (MASK & 512) lru_item(p, l, it - 1024, smem, 1); }
      }
    }
    xcd_barrier(xb);
    }
    for (int rep = 0; rep < REP_G; ++rep) {
    for (int half = 0; half < 4; ++half) {
      bf16_t* BH = (bf16_t*)(p.ws + OFF_P + 134217728);
      if (half == 0 && rep == 0) { if (MASK & 16) rwkv_post(p, l); xcd_barrier(xb); }
      if (MASK & 1024) { pg::Order<1> S; S.init(NTOK / 4, 4096, gridDim.x, blockIdx.x, 0, 0, 2, 512); pg::EpiBf16<0> E{BH, 4096, nullptr};
        pg::gemm_phase(lds, (const bf16_t*)(p.ws + OFF_O) + (size_t)half * 16384 * DM, DM, (const bf16_t*)(p.ws + OFF_WBR), 256, S, E); }
      xcd_barrier(xb);
      if (MASK & 1024) { pg::Order<4> S; S.init(NTOK / 4, 1024, gridDim.x, blockIdx.x, 0, 2097152); pg::EpiGateMix E{PB + (size_t)half * 16384 * DM, (float*)(p.ws + OFF_G), BH, p.in[I_BGATE] + (size_t)l * 4096};
        pg::gemm_phase(lds, H + (size_t)half * 16384 * DM, DM, (const bf16_t*)(p.ws + OFF_WG), 1024, S, E); }
      xcd_barrier(xb);
    }
    }
    if (MASK & 2048) { pg::Order<1> S; S.init(NTOK, 1024, gridDim.x, blockIdx.x); pg::EpiResid E{xcur, p.out, (const float*)(p.ws + OFF_MODP), p.in[I_BADA], l, 2048};
      pg::gemm_phase(lds, PB, DM, (const bf16_t*)(p.ws + OFF_WO), 1024, S, E); }
    xcd_barrier(xb);
    for (int rep = 0; rep < REP_MISC; ++rep) {
    if (MASK & 4096) phase_norm(p, p.out, p.in[I_N2G] + l * 1024, l, 4096, 3072, H, nullptr);
    xcd_barrier(xb);
    }
    for (int rep = 0; rep < REP_G; ++rep) {
    if (MASK & 8192) { pg::Order<1> S; S.init(NTOK, FFN, gridDim.x, blockIdx.x); pg::EpiBf16<0> E{PB, FFN, nullptr};
      pg::gemm_phase(lds, H, DM, (const bf16_t*)(p.ws + OFF_WF), 1024, S, E); }
    xcd_barrier(xb);
    if (MASK & 8192) { pg::Order<1> S; S.init(NTOK, FFN, gridDim.x, blockIdx.x); pg::EpiFfnAct E{PB + (size_t)NTOK * FFN, PB, p.in[I_FCW] + (size_t)l * 3 * FFN};
      pg::gemm_phase(lds, H, DM, (const bf16_t*)(p.ws + OFF_WF) + (size_t)FFN * 1024, 1024, S, E); }
    xcd_barrier(xb);
    }
    if (MASK & 32768) { pg::Order<1> S; S.init(NTOK, 1024, gridDim.x, blockIdx.x); pg::EpiResid E{p.out, p.out, (const float*)(p.ws + OFF_MODP), p.in[I_BADA], l, 5120};
      pg::gemm_phase(lds, PB + (size_t)NTOK * FFN, FFN, (const bf16_t*)(p.ws + OFF_WD), FFN, S, E); }
    xcd_barrier(xb);
  }
  if (MASK & 65536) phase_norm(p, p.out, p.in[I_FG], 0, 0, 0, nullptr, p.out);
}

extern "C" void kernel_launch(void* const* d_in, const int* in_sizes, int n_in,
                              void* d_out, int out_size, void* d_ws, size_t ws_size,
                              hipStream_t stream) {
  if (ws_size < WS_NEED || n_in < 38) { fprintf(stderr, "workspace too small: %zu < %zu\n", ws_size, (size_t)WS_NEED); return; }
  (void)hipFuncSetAttribute((const void*)mega, hipFuncAttributeMaxDynamicSharedMemorySize, SMEM_BYTES);
  int dev = 0, cus = 0, per_cu = 0;
  (void)hipGetDevice(&dev);
  (void)hipDeviceGetAttribute(&cus, hipDeviceAttributeMultiprocessorCount, dev);
  (void)hipOccupancyMaxActiveBlocksPerMultiprocessor(&per_cu, mega, NTHR, SMEM_BYTES);
  if (per_cu < 1 || cus < 1) { fprintf(stderr, "occupancy query failed (%d, %d)\n", per_cu, cus); return; }
  if (cus > 256) cus = 256;
  const int grid_blocks = cus;
  Params p{};
  for (int i = 0; i < 38; ++i) p.in[i] = (const float*)d_in[i];
  p.out = (float*)d_out; p.ws = (char*)d_ws;
  (void)hipMemsetAsync((char*)d_ws + OFF_BAR, 0, XCD_BAR_WORDS * 4, stream);
  void* args[] = {&p};
  hipError_t e = hipLaunchCooperativeKernel((void*)mega, dim3(grid_blocks), dim3(NTHR), args, SMEM_BYTES, stream);
  if (e != hipSuccess) fprintf(stderr, "cooperative launch failed: %s (grid %d)\n", hipGetErrorString(e), grid_blocks);
}
```

```cpp
#include <hip/hip_runtime.h>
#include <hip/hip_cooperative_groups.h>
#include <cstdio>
namespace cg = cooperative_groups;

typedef unsigned short bf16_t;
typedef short bf16x8 __attribute__((ext_vector_type(8)));
typedef short s16x4 __attribute__((ext_vector_type(4)));
typedef float f32x4 __attribute__((ext_vector_type(4)));
typedef float f32x16 __attribute__((ext_vector_type(16)));
typedef unsigned u32x4 __attribute__((ext_vector_type(4)));
#define DI __device__ __forceinline__

constexpr int NTOK = 65536, DM = 1024, SEQ = 4096, PSTR = 3328, FFN = 2816, AUS = 5632;
constexpr int C_LRU_X = 0, C_LRU_Y = 256, C_SB_Q = 512, C_SB_K = 768, C_SB_V = 1024;
constexpr int C_GDN_Q = 1280, C_GDN_Z = 2048, C_GDN_A = 2304, C_GDN_B = 2308, C_RW = 2312;
constexpr float EPSF = 1e-6f;
#ifndef MASK
#define MASK 0x1ffff
#endif
#ifndef REP_M1
#define REP_M1 1
#endif
#ifndef REP_M2
#define REP_M2 1
#endif
#ifndef REP_G
#define REP_G 1
#endif
#ifndef REP_MISC
#define REP_MISC 1
#endif
constexpr int NTHR = 512;
constexpr int SMEM_BYTES = 131072 + 64;

constexpr size_t OFF_MODP = 0;
constexpr size_t OFF_WIN = 6291456;
constexpr size_t OFF_WG = OFF_WIN + 6815744;
constexpr size_t OFF_WBR = OFF_WG + 8388608;
constexpr size_t OFF_WO = OFF_WBR + 2097152;
constexpr size_t OFF_WF = OFF_WO + 2097152;
constexpr size_t OFF_WD = OFF_WF + 11534336;
constexpr size_t OFF_H = OFF_WD + 5767168;
constexpr size_t OFF_P = OFF_H + 134217728;
constexpr size_t OFF_O = OFF_P + 436207616;
constexpr size_t OFF_G = OFF_O + 134217728;
constexpr size_t GSZ = 33554432;
constexpr size_t OFF_GCD = OFF_G + 5 * GSZ;
constexpr size_t OFF_L = OFF_GCD + 16384;
constexpr size_t LSZ = 67108864;
constexpr size_t OFF_LCA = OFF_L + 2 * LSZ;
constexpr size_t OFF_LCH = OFF_LCA + 2097152;
constexpr size_t OFF_BON = OFF_LCH + 2097152;
constexpr size_t OFF_CTR = OFF_BON + 1048576;
constexpr size_t OFF_BAR = OFF_CTR + 256;
constexpr size_t OFF_C12 = OFF_BAR + 16384;
constexpr size_t WS_NEED = OFF_C12 + 2097152;

struct Params { const float* in[38]; float* out; char* ws; };
enum { I_X = 0, I_C, I_N1G, I_N2G, I_FG, I_WADA, I_BADA, I_WIN, I_LCW, I_LCB, I_LWR, I_LBR, I_LWI, I_LBI, I_LLAM,
       I_GCW, I_GAL, I_GDT, I_GNG, I_RMU, I_RW0, I_RWUP, I_RA0, I_RAUP, I_RGUP, I_RKK, I_RKA, I_RRK, I_RLG, I_RLB,
       I_WBR, I_WGATE, I_BGATE, I_WOUT, I_FWG, I_FWU, I_FCW, I_FWD };

DI float bf2f(bf16_t v) { return __uint_as_float(((unsigned)v) << 16); }
typedef __bf16 bf16n2 __attribute__((ext_vector_type(2)));
typedef float f32x2_ __attribute__((ext_vector_type(2)));
DI unsigned pack2(float lo, float hi) { f32x2_ v = {lo, hi}; bf16n2 b = __builtin_convertvector(v, bf16n2); return __builtin_bit_cast(unsigned, b); }
DI bf16_t f2bf(float x) { return (bf16_t)(pack2(x, x) & 0xffffu); }
DI float sigmoidf_(float x) { return __builtin_amdgcn_rcpf(1.f + __expf(-x)); }
DI float sigmoid_rcp(float x) { return __builtin_amdgcn_rcpf(1.f + __expf(-x)); }
DI float gelu_rcp(float x) { float u = 0.7978845608f * (x + 0.044715f * x * x * x); return x * __builtin_amdgcn_rcpf(1.f + __expf(-2.f * u)); }
DI float softplusf_(float x) { return fmaxf(x, 0.f) + __logf(1.f + __expf(-fabsf(x))); }
DI float siluf_(float x) { return x * __builtin_amdgcn_rcpf(1.f + __expf(-x)); }
DI float geluf_(float x) { float u = 0.7978845608f * (x + 0.044715f * x * x * x); return x * __builtin_amdgcn_rcpf(1.f + __expf(-2.f * u)); }
DI float tanhf_(float x) { return 1.f - 2.f * __builtin_amdgcn_rcpf(1.f + __expf(2.f * x)); }
DI float wave_sum(float x) {
#pragma unroll
  for (int o = 32; o >= 1; o >>= 1) x += __shfl_xor(x, o);
  return x;
}
template <int CTRL> DI float dppf(float x) { return __int_as_float(__builtin_amdgcn_update_dpp(0, __float_as_int(x), CTRL, 0xf, 0xf, true)); }
DI float reduce8(float x) { x += dppf<0xB1>(x); x += dppf<0x4E>(x); x += dppf<0x141>(x); return x; }
DI f32x16 mfma32(bf16x8 a, bf16x8 b, f32x16 c) { return __builtin_amdgcn_mfma_f32_32x32x16_bf16(a, b, c, 0, 0, 0); }
DI f32x4 mfma16(bf16x8 a, bf16x8 b, f32x4 c) { return __builtin_amdgcn_mfma_f32_16x16x32_bf16(a, b, c, 0, 0, 0); }
DI int crow(int i, int h) { return (i & 3) + 8 * (i >> 2) + 4 * h; }

DI float modv(const float* modp, const float* bada, int l, int b, int idx) {
  const float* q = modp + ((size_t)(l * 16 + b)) * 6144 + idx;
  const size_t ks = (size_t)4 * 16 * 6144;
  return bada[l * 6144 + idx] + q[0] + q[ks] + q[2 * ks] + q[3 * ks];
}

DI int otid() { int t = threadIdx.x; asm volatile("" : "+v"(t)); return t; }
DI int obid() { int b = blockIdx.x; asm volatile("" : "+s"(b)); return b; }
DI void phase_mod(const Params& p, char* smem) {
  float* sm = (float*)smem;
  float* modp = (float*)(p.ws + OFF_MODP);
  const int tid = otid();
  if (obid() == 0 && tid < 64) ((unsigned*)(p.ws + OFF_CTR))[tid] = 0u;
  for (int item = obid(); item < 192; item += gridDim.x) {
    const int l = item / 48, rem = item % 48, jb = rem >> 2, kq = rem & 3;
    for (int i = 0; i < 8; ++i) {
      int e = tid + 512 * i; int b = e >> 8, k = e & 255;
      float cv = p.in[I_C][b * 1024 + kq * 256 + k];
      sm[e] = siluf_(cv);
    }
    __syncthreads();
    float acc[16];
#pragma unroll
    for (int b = 0; b < 16; ++b) acc[b] = 0.f;
    const float* wp = p.in[I_WADA] + ((size_t)l * 1024 + kq * 256) * 6144 + jb * 512 + tid;
    for (int k = 0; k < 256; k += 4) {
      float w0 = wp[(size_t)k * 6144], w1 = wp[(size_t)(k + 1) * 6144], w2 = wp[(size_t)(k + 2) * 6144], w3 = wp[(size_t)(k + 3) * 6144];
#pragma unroll
      for (int b = 0; b < 16; ++b) {
        f32x4 cv = *(const f32x4*)(sm + b * 256 + k);
        acc[b] += cv[0] * w0 + cv[1] * w1 + cv[2] * w2 + cv[3] * w3;
      }
    }
#pragma unroll
    for (int b = 0; b < 16; ++b) modp[((size_t)((kq * 4 + l) * 16 + b)) * 6144 + jb * 512 + tid] = acc[b];
    __syncthreads();
  }
}

DI void conv_tile(const float* src, bf16_t* dst, int K, int N, int k0, int n0, char* smem) {
  float* tile = (float*)smem;
  const int tid = otid();
#pragma unroll
  for (int it = 0; it < 2; ++it) {
    int kr = (tid >> 4) + 32 * it, nc = (tid & 15) * 4;
    f32x4 v = {0.f, 0.f, 0.f, 0.f};
    if (n0 + nc < N) v = *(const f32x4*)(src + (size_t)(k0 + kr) * N + n0 + nc);
    tile[kr * 65 + nc] = v[0]; tile[kr * 65 + nc + 1] = v[1]; tile[kr * 65 + nc + 2] = v[2]; tile[kr * 65 + nc + 3] = v[3];
  }
  __syncthreads();
  {
    int n = tid >> 3, kc = (tid & 7) * 8;
    unsigned o[4];
#pragma unroll
    for (int e = 0; e < 4; ++e) o[e] = pack2(tile[(kc + 2 * e) * 65 + n], tile[(kc + 2 * e + 1) * 65 + n]);
    uint4 ov = {o[0], o[1], o[2], o[3]};
    *(uint4*)(dst + (size_t)(n0 + n) * K + k0 + kc) = ov;
  }
  __syncthreads();
}

DI void phase_convert(const Params& p, int l, char* smem) {
  for (int t = obid(); t < 4480; t += gridDim.x) {
    const float* src; bf16_t* dst; int K, N, Npad, tt = t;
    if (tt < 832) { src = p.in[I_WIN] + (size_t)l * 1024 * 3208; dst = (bf16_t*)(p.ws + OFF_WIN); K = 1024; N = 3208; Npad = 3328; }
    else if ((tt -= 832) < 1024) { int br = tt >> 8; tt &= 255; src = p.in[I_WGATE] + ((size_t)l * 4 + br) * 1048576; dst = (bf16_t*)(p.ws + OFF_WG) + (size_t)br * 1048576; K = 1024; N = 1024; Npad = 1024; }
    else if ((tt -= 1024) < 256) { int br = tt >> 6; tt &= 63; src = p.in[I_WBR] + ((size_t)l * 4 + br) * 262144; dst = (bf16_t*)(p.ws + OFF_WBR) + (size_t)br * 262144; K = 256; N = 1024; Npad = 1024; }
    else if ((tt -= 256) < 256) { src = p.in[I_WOUT] + (size_t)l * 1048576; dst = (bf16_t*)(p.ws + OFF_WO); K = 1024; N = 1024; Npad = 1024; }
    else if ((tt -= 256) < 704) { src = p.in[I_FWG] + (size_t)l * 1024 * 2816; dst = (bf16_t*)(p.ws + OFF_WF); K = 1024; N = 2816; Npad = 2816; }
    else if ((tt -= 704) < 704) { src = p.in[I_FWU] + (size_t)l * 1024 * 2816; dst = (bf16_t*)(p.ws + OFF_WF) + (size_t)2816 * 1024; K = 1024; N = 2816; Npad = 2816; }
    else { tt -= 704; src = p.in[I_FWD] + (size_t)l * 2816 * 1024; dst = (bf16_t*)(p.ws + OFF_WD); K = 2816; N = 1024; Npad = 1024; }
    const int nNt = Npad >> 6;
    const int kt = tt / nNt, nt = tt % nNt;
    conv_tile(src, dst, K, N, kt * 64, nt * 64, smem);
  }
}

DI void phase_norm(const Params& p, const float* xin, const float* g, int l, int scale_idx, int shift_idx, bf16_t* hout, float* fout) {
  const float* modp = (const float*)(p.ws + OFF_MODP);
  const int lane = otid() & 63, wv = otid() >> 6;
  const int nw = gridDim.x * 8;
  const int rows_per = 32;
  for (int chunk = obid() * 8 + wv; chunk < NTOK / 32; chunk += nw) {
  const int row0 = chunk * rows_per;
  const int b = row0 / SEQ;
  f32x4 gv[4], sc[4], sh[4];
#pragma unroll
  for (int j = 0; j < 4; ++j) {
    int c = lane * 4 + 256 * j;
    gv[j] = *(const f32x4*)(g + c);
    if (hout) {
#pragma unroll
      for (int e = 0; e < 4; ++e) {
        sc[j][e] = 1.f + modv(modp, p.in[I_BADA], l, b, scale_idx + c + e);
        sh[j][e] = modv(modp, p.in[I_BADA], l, b, shift_idx + c + e);
      }
    }
  }
  for (int rr = 0; rr < rows_per; ++rr) {
    const size_t row = (size_t)row0 + rr;
    f32x4 xv[4]; float ss = 0.f;
#pragma unroll
    for (int j = 0; j < 4; ++j) {
      xv[j] = *(const f32x4*)(xin + row * DM + lane * 4 + 256 * j);
      ss += xv[j][0] * xv[j][0] + xv[j][1] * xv[j][1] + xv[j][2] * xv[j][2] + xv[j][3] * xv[j][3];
    }
    ss = wave_sum(ss);
    const float rs = rsqrtf(ss * (1.f / 1024.f) + EPSF);
#pragma unroll
    for (int j = 0; j < 4; ++j) {
      f32x4 y = xv[j] * rs * gv[j];
      if (hout) {
        y = y * sc[j] + sh[j];
        uint2 o = {pack2(y[0], y[1]), pack2(y[2], y[3])};
        *(uint2*)(hout + row * DM + lane * 4 + 256 * j) = o;
      } else {
        *(f32x4*)(fout + row * DM + lane * 4 + 256 * j) = y;
      }
    }
  }
  }
}

#define PG_LAS __attribute__((address_space(3)))
namespace pg {
constexpr int BM = 256, BK = 64, HALF = 128, HTB = HALF * BK * 2, NXCD = 8, WGM = 8;
DI int lds_byte(int r, int c) { const int st = (r >> 4) * 2 + (c >> 5), rr = r & 15, cc = c & 31, ob = rr * 64 + cc * 2; return st * 1024 + (ob ^ (((ob >> 9) & 1) << 5)); }
DI void stage_rc(int b, int& R, int& C) { const int st = b / 1024, sb = b % 1024, swz = sb ^ (((sb >> 9) & 1) << 5); R = (st >> 1) * 16 + swz / 64; C = (st & 1) * 32 + (swz % 64) / 2; }
DI int perm32(int rho) { const int n = rho >> 4, i = rho & 15; return 8 * (i >> 2) + 4 * n + (i & 3); }
struct Unit { int pm, pn; int aux; long ao, bo; };
template <int REP> struct Order {
  int nM, nN, nwg, G, c, ashift; long astep, bstep, apnstep;
  DI void init(int M, int N, int G_, int c_, long astep_ = 0, long bstep_ = 0, int ashift_ = 0, long apnstep_ = 0) {
    nM = M / BM; nN = N / BM; nwg = nM * nN; G = G_; c = c_; astep = astep_; bstep = bstep_; ashift = ashift_; apnstep = apnstep_; }
  DI bool next(int i, Unit& u) const {
    const int ti = i / REP, aux = i % REP;
    const long L = (long)ti * G + c; if (L >= nwg) return false;
    int wgid = (int)L; { const int q = nwg / NXCD, r = nwg % NXCD, xcd = wgid % NXCD, off = wgid / NXCD; wgid = (xcd < r ? xcd * (q + 1) : r * (q + 1) + (xcd - r) * q) + off; }
    const int nig = WGM * nN, gid = wgid / nig, fm = gid * WGM, gsz = (nM - fm) < WGM ? (nM - fm) : WGM;
    u.pm = fm + ((wgid % nig) % gsz); u.pn = (wgid % nig) / gsz; u.aux = aux; u.ao = aux * astep + (long)(u.pn >> ashift) * apnstep; u.bo = aux * bstep; return true;
  }
};
DI unsigned cvt_pk_bf16(float lo, float hi) { return pack2(lo, hi); }

template <class Epi, class Sched>
DI void gemm_phase(PG_LAS unsigned char* lds, const bf16_t* Ag, int lda, const bf16_t* Bg, int K, const Sched& S, const Epi& E) {
  const int tid = otid(), wid = __builtin_amdgcn_readfirstlane(tid >> 6), lane = tid & 63, wr = wid >> 2, wc = wid & 3, fr = lane & 15, fq = lane >> 4;
  const int nt = K / BK;
  unsigned voffA[2], voffB[2];
#pragma unroll
  for (int i = 0; i < 2; ++i) { int R, C; stage_rc(tid * 16 + i * 8192, R, C); const int Rb = Epi::PERM ? ((R & ~31) + perm32(R & 31)) : R;
    voffA[i] = (unsigned)(R * lda + C) * 2u; voffB[i] = (unsigned)(Rb * K + C) * 2u; }
  const size_t kstep = (size_t)(BK * 2);
  const size_t hstepA = (size_t)HALF * lda * 2, hstepB = (size_t)HALF * K * 2;
  const size_t tstepA = 2 * hstepA, tstepB = 2 * hstepB;
  const unsigned ldsw = (unsigned)wid * 1024u;
  const int aoff = lds_byte(wr * 64 + fr, fq * 8), boff = lds_byte(wc * 32 + fr, fq * 8);
#define PG_SA(b, h) (((b) * 2 + (h)) * HTB)
#define PG_SB(b, h) ((4 + (b) * 2 + (h)) * HTB)
#define PG_STAGE(bufoff, gbase, voff) do { _Pragma("unroll") for (int _i = 0; _i < 2; ++_i) \
    __builtin_amdgcn_global_load_lds((const unsigned*)((const char*)(gbase) + (voff)[_i]), (PG_LAS unsigned*)(lds + (bufoff) + ldsw + _i * 8192), 16, 0, 0); } while (0)
#define PG_LDA(dst, b, h) do { _Pragma("unroll") for (int m = 0; m < 4; ++m) _Pragma("unroll") for (int k = 0; k < 2; ++k) dst[m][k] = *(const PG_LAS bf16x8*)(lds + PG_SA(b, h) + aoff + m * 2048 + k * 1024); } while (0)
#define PG_LDB(dst, b, h) do { _Pragma("unroll") for (int n = 0; n < 2; ++n) _Pragma("unroll") for (int k = 0; k < 2; ++k) dst[n][k] = *(const PG_LAS bf16x8*)(lds + PG_SB(b, h) + boff + n * 2048 + k * 1024); } while (0)
#define PG_MMA(ai, bj, At, Bt) do { __builtin_amdgcn_s_setprio(1); _Pragma("unroll") for (int m = 0; m < 4; ++m) _Pragma("unroll") for (int n = 0; n < 2; ++n) _Pragma("unroll") for (int k = 0; k < 2; ++k) \
    acc[ai][bj][m][n] = __builtin_amdgcn_mfma_f32_16x16x32_bf16(Bt[n][k], At[m][k], acc[ai][bj][m][n], 0, 0, 0); __builtin_amdgcn_s_setprio(0); } while (0)
#define PG_WAIT_V(n) asm volatile("s_waitcnt vmcnt(" #n ")" ::: "memory")
#define PG_WAIT_L(n) asm volatile("s_waitcnt lgkmcnt(" #n ")" ::: "memory")
#define PG_BAR __builtin_amdgcn_s_barrier()
#define PG_SCHED __builtin_amdgcn_sched_barrier(0)
  Unit cur, nxt; int ui = 0;
  if (!S.next(0, cur)) return;
  f32x4 acc[2][2][4][2];
#pragma unroll
  for (int a = 0; a < 2; ++a)
#pragma unroll
    for (int b = 0; b < 2; ++b)
#pragma unroll
      for (int m = 0; m < 4; ++m)
#pragma unroll
        for (int n = 0; n < 2; ++n) acc[a][b][m][n] = (f32x4){0.f, 0.f, 0.f, 0.f};
  bf16x8 At[4][2], B0[2][2], B1[2][2];
  const char* cA = (const char*)Ag + (size_t)cur.pm * tstepA + cur.ao; const char* cB = (const char*)Bg + (size_t)cur.pn * tstepB + cur.bo;
  PG_STAGE(PG_SB(0, 0), cB, voffB); PG_STAGE(PG_SA(0, 0), cA, voffA); PG_STAGE(PG_SB(0, 1), cB + hstepB, voffB); PG_STAGE(PG_SA(0, 1), cA + hstepA, voffA);
  if (wr == 1) PG_BAR;
  PG_WAIT_V(4); PG_BAR;
  PG_STAGE(PG_SB(1, 0), cB + kstep, voffB); PG_STAGE(PG_SA(1, 0), cA + kstep, voffA); PG_STAGE(PG_SB(1, 1), cB + hstepB + kstep, voffB);
  PG_WAIT_V(6); PG_BAR;
  for (;;) {
    const bool has_next = S.next(ui + 1, nxt);
    const char* nA = has_next ? (const char*)Ag + (size_t)nxt.pm * tstepA + nxt.ao : cA; const char* nB = has_next ? (const char*)Bg + (size_t)nxt.pn * tstepB + nxt.bo : cB;
#pragma unroll 1
    for (int t = 0; t < nt; t += 2) {
      const bool last = (t == nt - 2);
      const char* a1 = cA + (size_t)(t + 1) * kstep;
      const char* a2 = last ? nA : cA + (size_t)(t + 2) * kstep; const char* b2 = last ? nB : cB + (size_t)(t + 2) * kstep;
      const char* a3 = a2 + kstep; const char* b3 = b2 + kstep;
      PG_LDB(B0, 0, 0); PG_SCHED; PG_LDA(At, 0, 0); PG_STAGE(PG_SA(1, 1), a1 + hstepA, voffA);
      PG_WAIT_L(8); PG_BAR; PG_WAIT_L(0); PG_MMA(0, 0, At, B0); PG_BAR; PG_SCHED;
      PG_LDB(B1, 0, 1); PG_STAGE(PG_SB(0, 0), b2, voffB);
      PG_BAR; PG_WAIT_L(0); PG_MMA(0, 1, At, B1); PG_BAR;
      PG_LDA(At, 0, 1); PG_STAGE(PG_SA(0, 0), a2, voffA);
      PG_BAR; PG_WAIT_L(0); PG_MMA(1, 0, At, B0); PG_BAR; PG_SCHED;
      PG_STAGE(PG_SB(0, 1), b2 + hstepB, voffB);
      PG_WAIT_V(6); PG_BAR; PG_MMA(1, 1, At, B1); PG_BAR;
      PG_LDB(B0, 1, 0); PG_SCHED; PG_LDA(At, 1, 0); PG_STAGE(PG_SA(0, 1), a2 + hstepA, voffA);
      PG_WAIT_L(8); PG_BAR; PG_WAIT_L(0); PG_MMA(0, 0, At, B0); PG_BAR; PG_SCHED;
      PG_LDB(B1, 1, 1); PG_STAGE(PG_SB(1, 0), b3, voffB);
      PG_BAR; PG_WAIT_L(0); PG_MMA(0, 1, At, B1); PG_BAR;
      PG_LDA(At, 1, 1); PG_STAGE(PG_SA(1, 0), a3, voffA);
      PG_BAR; PG_WAIT_L(0); PG_MMA(1, 0, At, B0); PG_BAR; PG_SCHED;
      PG_STAGE(PG_SB(1, 1), b3 + hstepB, voffB);
      PG_WAIT_V(6); PG_BAR; PG_MMA(1, 1, At, B1); PG_BAR;
    }
    E(acc, cur, wr, wc, fr, fq);
    if (!has_next) break;
#pragma unroll
    for (int a = 0; a < 2; ++a)
#pragma unroll
      for (int b = 0; b < 2; ++b)
#pragma unroll
        for (int m = 0; m < 4; ++m)
#pragma unroll
          for (int n = 0; n < 2; ++n) acc[a][b][m][n] = (f32x4){0.f, 0.f, 0.f, 0.f};
    cur = nxt; cA = nA; cB = nB; ++ui;
  }
  PG_WAIT_V(0);
  if (wr == 0) PG_BAR;
  PG_BAR;
#undef PG_SA
#undef PG_SB
#undef PG_STAGE
#undef PG_LDA
#undef PG_LDB
#undef PG_MMA
#undef PG_WAIT_V
#undef PG_WAIT_L
#undef PG_BAR
#undef PG_SCHED
}

template <int ACT> struct EpiBf16 {
  static constexpr bool PERM = true;
  bf16_t* O; int ldc; const float* bias;
  DI void operator()(const f32x4 (&acc)[2][2][4][2], const Unit& u, int wr, int wc, int fr, int fq) const {
    const int row0 = u.pm * BM + wr * 64 + fr, col0 = u.pn * BM + wc * 32 + 8 * fq;
    f32x4 bv[2][2];
#pragma unroll
    for (int bj = 0; bj < 2; ++bj)
#pragma unroll
      for (int n = 0; n < 2; ++n) bv[bj][n] = ACT ? *(const f32x4*)(bias + col0 + bj * HALF + 4 * n) : (f32x4){0.f, 0.f, 0.f, 0.f};
#pragma unroll
    for (int ai = 0; ai < 2; ++ai)
#pragma unroll
      for (int m = 0; m < 4; ++m) { bf16_t* rowp = O + (size_t)(row0 + ai * HALF + m * 16) * ldc + col0;
#pragma unroll
        for (int bj = 0; bj < 2; ++bj) { f32x4 v0 = acc[ai][bj][m][0], v1 = acc[ai][bj][m][1];
          if (ACT) { v0 += bv[bj][0]; v1 += bv[bj][1];
#pragma unroll
            for (int j = 0; j < 4; ++j) { v0[j] = sigmoid_rcp(v0[j]); v1[j] = sigmoid_rcp(v1[j]); } }
          u32x4 w; w.x = cvt_pk_bf16(v0[0], v0[1]); w.y = cvt_pk_bf16(v0[2], v0[3]); w.z = cvt_pk_bf16(v1[0], v1[1]); w.w = cvt_pk_bf16(v1[2], v1[3]);
          *(u32x4*)(rowp + bj * HALF) = w; } }
  }
};
struct EpiBranch {
  static constexpr bool PERM = true;
  bf16_t* MIX; const bf16_t* G;
  DI void operator()(const f32x4 (&acc)[2][2][4][2], const Unit& u, int wr, int wc, int fr, int fq) const {
    const int row0 = u.pm * BM + wr * 64 + fr, col0 = u.pn * BM + wc * 32 + 8 * fq;
#pragma unroll
    for (int ai = 0; ai < 2; ++ai)
#pragma unroll
      for (int m = 0; m < 4; ++m) {
        asm volatile("" ::: "memory");
        const size_t row = (size_t)(row0 + ai * HALF + m * 16);
        bf16_t* mp = MIX + row * DM + col0; const bf16_t* gp = G + row * 4096 + u.aux * 1024 + col0;
#pragma unroll
        for (int bj = 0; bj < 2; ++bj) {
          const bf16x8 gv = *(const bf16x8*)(gp + bj * HALF);
          float o[8];
#pragma unroll
          for (int j = 0; j < 4; ++j) { o[j] = bf2f((bf16_t)gv[j]) * acc[ai][bj][m][0][j]; o[4 + j] = bf2f((bf16_t)gv[4 + j]) * acc[ai][bj][m][1][j]; }
          if (u.aux > 0) {
            const bf16x8 mv = *(const bf16x8*)(mp + bj * HALF);
#pragma unroll
            for (int j = 0; j < 8; ++j) o[j] += bf2f((bf16_t)mv[j]);
          }
          u32x4 w; w.x = cvt_pk_bf16(o[0], o[1]); w.y = cvt_pk_bf16(o[2], o[3]); w.z = cvt_pk_bf16(o[4], o[5]); w.w = cvt_pk_bf16(o[6], o[7]);
          *(u32x4*)(mp + bj * HALF) = w;
        }
      }
  }
};
struct EpiResid {
  static constexpr bool PERM = false;
  const float* xold; float* xnew; const float* modp; const float* bada; int l, gate_idx;
  DI void operator()(const f32x4 (&acc)[2][2][4][2], const Unit& u, int wr, int wc, int fr, int fq) const {
    const int row0 = u.pm * BM + wr * 64 + fr, col0 = u.pn * BM + wc * 32 + 4 * fq;
    const int b = (u.pm * BM) / SEQ;
    f32x4 gv[2][2];
#pragma unroll
    for (int bj = 0; bj < 2; ++bj)
#pragma unroll
      for (int n = 0; n < 2; ++n)
#pragma unroll
        for (int j = 0; j < 4; ++j) gv[bj][n][j] = modv(modp, bada, l, b, gate_idx + col0 + bj * HALF + n * 16 + j);
#pragma unroll
    for (int ai = 0; ai < 2; ++ai)
#pragma unroll
      for (int m = 0; m < 4; ++m) { const size_t ro = (size_t)(row0 + ai * HALF + m * 16) * DM + col0;
#pragma unroll
        for (int bj = 0; bj < 2; ++bj)
#pragma unroll
          for (int n = 0; n < 2; ++n) {
            const f32x4 xo = *(const f32x4*)(xold + ro + bj * HALF + n * 16);
            *(f32x4*)(xnew + ro + bj * HALF + n * 16) = xo + gv[bj][n] * acc[ai][bj][m][n];
          } }
  }
};
struct EpiFfnAct {
  static constexpr bool PERM = true;
  bf16_t* ACT; const bf16_t* APRE; const float* cw;
  DI void operator()(const f32x4 (&acc)[2][2][4][2], const Unit& u, int wr, int wc, int fr, int fq) const {
    const int row0 = u.pm * BM + wr * 64 + fr, col0 = u.pn * BM + wc * 32 + 8 * fq;
#pragma unroll
    for (int ai = 0; ai < 2; ++ai)
#pragma unroll
      for (int m = 0; m < 4; ++m) {
        asm volatile("" ::: "memory");
        const int row = row0 + ai * HALF + m * 16; const int sp = row & (SEQ - 1);
        const bf16_t* ap = APRE + (size_t)row * FFN + col0;
        bf16_t* op = ACT + (size_t)row * FFN + col0;
#pragma unroll
        for (int bj = 0; bj < 2; ++bj) {
          const int c = bj * HALF;
          const bf16x8 z8 = {0, 0, 0, 0, 0, 0, 0, 0};
          const bf16x8 a0 = *(const bf16x8*)(ap + c);
          const bf16x8 a1 = sp >= 1 ? *(const bf16x8*)(ap - FFN + c) : z8;
          const bf16x8 a2 = sp >= 2 ? *(const bf16x8*)(ap - 2 * FFN + c) : z8;
          float o[8];
#pragma unroll
          for (int hh = 0; hh < 2; ++hh) {
            const f32x4 w0 = *(const f32x4*)(cw + col0 + c + 4 * hh), w1 = *(const f32x4*)(cw + FFN + col0 + c + 4 * hh), w2 = *(const f32x4*)(cw + 2 * FFN + col0 + c + 4 * hh);
#pragma unroll
            for (int j = 0; j < 4; ++j) {
              const float cv = w0[j] * bf2f((bf16_t)a2[4 * hh + j]) + w1[j] * bf2f((bf16_t)a1[4 * hh + j]) + w2[j] * bf2f((bf16_t)a0[4 * hh + j]);
              o[4 * hh + j] = gelu_rcp(cv) * acc[ai][bj][m][hh][j];
            }
          }
          u32x4 w; w.x = cvt_pk_bf16(o[0], o[1]); w.y = cvt_pk_bf16(o[2], o[3]); w.z = cvt_pk_bf16(o[4], o[5]); w.w = cvt_pk_bf16(o[6], o[7]);
          *(u32x4*)(op + c) = w;
        }
      }
  }
};
struct EpiGateMix {
  static constexpr bool PERM = true;
  bf16_t* MIX; float* MIX32; const bf16_t* BH; const float* bias;
  DI void operator()(const f32x4 (&acc)[2][2][4][2], const Unit& u, int wr, int wc, int fr, int fq) const {
    const int row0 = u.pm * BM + wr * 64 + fr, col0 = u.pn * BM + wc * 32 + 8 * fq;
    const bool rmw = u.aux > 0, fin = u.aux == 3;
    f32x4 bv[2][2];
#pragma unroll
    for (int bj = 0; bj < 2; ++bj)
#pragma unroll
      for (int n = 0; n < 2; ++n) bv[bj][n] = *(const f32x4*)(bias + u.aux * 1024 + col0 + bj * HALF + 4 * n);
    const f32x4 z4 = {0.f, 0.f, 0.f, 0.f};
    bf16x8 nb[2]; f32x4 nm[2][2];
#define GM_LOAD(it_) { const size_t row_ = (size_t)(row0 + ((it_) >> 2) * HALF + ((it_) & 3) * 16); \
      _Pragma("unroll") for (int bj = 0; bj < 2; ++bj) { nb[bj] = *(const bf16x8*)(BH + row_ * 4096 + u.aux * 1024 + col0 + bj * HALF); \
        nm[bj][0] = rmw ? *(const f32x4*)(MIX32 + row_ * DM + col0 + bj * HALF) : z4; nm[bj][1] = rmw ? *(const f32x4*)(MIX32 + row_ * DM + col0 + bj * HALF + 4) : z4; } }
    GM_LOAD(0);
#pragma unroll
    for (int it = 0; it < 8; ++it) {
      const int ai = it >> 2, m = it & 3;
      bf16x8 cb[2]; f32x4 cm[2][2];
#pragma unroll
      for (int bj = 0; bj < 2; ++bj) { cb[bj] = nb[bj]; cm[bj][0] = nm[bj][0]; cm[bj][1] = nm[bj][1]; }
      if (it + 1 < 8) GM_LOAD(it + 1);
      const size_t ro = (size_t)(row0 + ai * HALF + m * 16) * DM + col0;
#pragma unroll
      for (int bj = 0; bj < 2; ++bj) {
        f32x4 o[2];
#pragma unroll
        for (int hh = 0; hh < 2; ++hh)
#pragma unroll
          for (int j = 0; j < 4; ++j)
            o[hh][j] = sigmoid_rcp(acc[ai][bj][m][hh][j] + bv[bj][hh][j]) * bf2f((bf16_t)cb[bj][4 * hh + j]) + cm[bj][hh][j];
        if (fin) {
          u32x4 w; w.x = cvt_pk_bf16(o[0][0], o[0][1]); w.y = cvt_pk_bf16(o[0][2], o[0][3]); w.z = cvt_pk_bf16(o[1][0], o[1][1]); w.w = cvt_pk_bf16(o[1][2], o[1][3]);
          *(u32x4*)(MIX + ro + bj * HALF) = w;
        } else {
          *(f32x4*)(MIX32 + ro + bj * HALF) = o[0]; *(f32x4*)(MIX32 + ro + bj * HALF + 4) = o[1];
        }
      }
    }
#undef GM_LOAD
  }
};
}

DI void phase_ffn_act(const Params& p, int l) {
  bf16_t* AU = (bf16_t*)(p.ws + OFF_P);
  const float* cw = p.in[I_FCW] + (size_t)l * 3 * FFN;
  const int nthr = gridDim.x * NTHR;
  for (int run = obid() * NTHR + otid(); run < 1024 * 352; run += nthr) {
    const int ch = run / 352, j8 = run % 352, j0 = j8 * 8;
    float w0[8], w1[8], w2[8];
#pragma unroll
    for (int e = 0; e < 8; ++e) { w0[e] = cw[j0 + e]; w1[e] = cw[FFN + j0 + e]; w2[e] = cw[2 * FFN + j0 + e]; }
    const int t0 = ch * 64, s0 = t0 % SEQ;
    float a1[8], a2[8];
#pragma unroll
    for (int e = 0; e < 8; ++e) { a1[e] = 0.f; a2[e] = 0.f; }
    if (s0 > 0) {
      bf16x8 v1 = *(const bf16x8*)(AU + (size_t)(t0 - 1) * AUS + j0);
      bf16x8 v2 = *(const bf16x8*)(AU + (size_t)(t0 - 2) * AUS + j0);
#pragma unroll
      for (int e = 0; e < 8; ++e) { a1[e] = bf2f((bf16_t)v1[e]); a2[e] = bf2f((bf16_t)v2[e]); }
    }
    for (int t = t0; t < t0 + 64; ++t) {
      bf16x8 va = *(const bf16x8*)(AU + (size_t)t * AUS + j0);
      bf16x8 vu = *(const bf16x8*)(AU + (size_t)t * AUS + FFN + j0);
      float o[8];
#pragma unroll
      for (int e = 0; e < 8; ++e) {
        float a0 = bf2f((bf16_t)va[e]);
        float cv = w0[e] * a2[e] + w1[e] * a1[e] + w2[e] * a0;
        o[e] = geluf_(cv) * bf2f((bf16_t)vu[e]);
        a2[e] = a1[e]; a1[e] = a0;
      }
      uint4 ov = {pack2(o[0], o[1]), pack2(o[2], o[3]), pack2(o[4], o[5]), pack2(o[6], o[7])};
      *(uint4*)(AU + (size_t)t * AUS + FFN + j0) = ov;
    }
  }
}

DI float mixf(bf16_t cur, bf16_t prev, float mu) { const float c = bf2f(cur); return c + (bf2f(prev) - c) * mu; }
DI void rw_prep_item(const Params& p, int l, int item, char* smem) {
  const bf16_t* P = (const bf16_t*)(p.ws + OFF_P);
  bf16_t* RD = (bf16_t*)(p.ws + OFF_L);
  bf16_t* RKK = (bf16_t*)(p.ws + OFF_L + GSZ);
  bf16_t* RA = (bf16_t*)(p.ws + OFF_L + 2 * GSZ);
  bf16_t* RG = (bf16_t*)(p.ws + OFF_L + 3 * GSZ);
  float* BON = (float*)(p.ws + OFF_BON);
  float* C12 = (float*)(p.ws + OFF_C12);
  const int b = item >> 6, ct = item & 63;
  const int tid = otid(), lane = tid & 63, wv = tid >> 6, hd = wv & 3, mi = wv >> 2, r = lane & 31, h = lane >> 5;
  bf16_t* TX = (bf16_t*)smem;
  bf16_t* XA = TX + 64 * 40;
  bf16_t* SG = XA + 64 * 40;
  bf16_t* RK = SG + 64 * 72;
  const float* mu = p.in[I_RMU] + (size_t)l * 896;
  const size_t tok0 = (size_t)b * SEQ + ct * 64;
  bf16x8 bw[2][2], ba[2][2], bg[2][4];
  {
    const float* wp = p.in[I_RWUP] + (size_t)l * 32 * 256 + hd * 64 + r;
    const float* ap = p.in[I_RAUP] + (size_t)l * 32 * 256 + hd * 64 + r;
    const float* gp = p.in[I_RGUP] + (size_t)l * 64 * 256 + hd * 64 + r;
    asm volatile("" : "+v"(wp), "+v"(ap), "+v"(gp));
#pragma unroll
    for (int ni = 0; ni < 2; ++ni) {
#pragma unroll
      for (int ks = 0; ks < 2; ++ks) {
        unsigned uw[4], ua[4];
#pragma unroll
        for (int j2 = 0; j2 < 4; ++j2) {
          const int k = 16 * ks + 8 * h + 2 * j2;
          uw[j2] = pack2(wp[k * 256 + 32 * ni], wp[(k + 1) * 256 + 32 * ni]);
          ua[j2] = pack2(ap[k * 256 + 32 * ni], ap[(k + 1) * 256 + 32 * ni]);
        }
        uint4 t1 = {uw[0], uw[1], uw[2], uw[3]}, t2 = {ua[0], ua[1], ua[2], ua[3]};
        bw[ni][ks] = __builtin_bit_cast(bf16x8, t1); ba[ni][ks] = __builtin_bit_cast(bf16x8, t2);
      }
#pragma unroll
      for (int ks = 0; ks < 4; ++ks) {
        unsigned ug[4];
#pragma unroll
        for (int j2 = 0; j2 < 4; ++j2) { const int k = 16 * ks + 8 * h + 2 * j2; ug[j2] = pack2(gp[k * 256 + 32 * ni], gp[(k + 1) * 256 + 32 * ni]); }
        uint4 t3 = {ug[0], ug[1], ug[2], ug[3]};
        bg[ni][ks] = __builtin_bit_cast(bf16x8, t3);
      }
    }
  }
#pragma unroll 4
  for (int i = 0; i < 16; ++i) {
    const int e = tid + NTHR * i; const int t = e >> 7, f = e & 127;
    const bf16_t* pr = P + (tok0 + t) * PSTR + C_RW + 768 + f;
    const bf16_t cur = pr[0];
    const bf16_t prev = (ct * 64 + t > 0) ? (pr - PSTR)[0] : (bf16_t)0;
    const float m = mixf(cur, prev, mu[768 + f]);
    if (f < 32) TX[t * 40 + f] = f2bf(tanhf_(m));
    else if (f < 64) XA[t * 40 + f - 32] = f2bf(m);
    else SG[t * 72 + f - 64] = f2bf(sigmoidf_(m));
  }
#pragma unroll 2
  for (int i = 0; i < 8; ++i) {
    const int q = tid + NTHR * i; const int t = q >> 6, col = (q & 63) * 8;
    const bf16_t* pr = P + (tok0 + t) * PSTR + C_RW + col;
    const bf16x8 cur = *(const bf16x8*)pr;
    bf16x8 prev = {0, 0, 0, 0, 0, 0, 0, 0};
    if (ct * 64 + t > 0) prev = *(const bf16x8*)(pr - PSTR);
    const f32x4 m0 = *(const f32x4*)(mu + col), m1 = *(const f32x4*)(mu + col + 4);
    float o[8];
#pragma unroll
    for (int e = 0; e < 4; ++e) { o[e] = mixf((bf16_t)cur[e], (bf16_t)prev[e], m0[e]); o[4 + e] = mixf((bf16_t)cur[4 + e], (bf16_t)prev[4 + e], m1[e]); }
    uint4 ov = {pack2(o[0], o[1]), pack2(o[2], o[3]), pack2(o[4], o[5]), pack2(o[6], o[7])};
    *(uint4*)(RK + t * 520 + col) = ov;
  }
  __syncthreads();
  f32x16 cw[2], ca[2], cg[2];
#pragma unroll
  for (int ni = 0; ni < 2; ++ni)
#pragma unroll
    for (int i = 0; i < 16; ++i) { cw[ni][i] = 0.f; ca[ni][i] = 0.f; cg[ni][i] = 0.f; }
#pragma unroll
  for (int ks = 0; ks < 2; ++ks) {
    const bf16x8 atx = *(const bf16x8*)(TX + (32 * mi + r) * 40 + 16 * ks + 8 * h);
    const bf16x8 axa = *(const bf16x8*)(XA + (32 * mi + r) * 40 + 16 * ks + 8 * h);
#pragma unroll
    for (int ni = 0; ni < 2; ++ni) { cw[ni] = mfma32(atx, bw[ni][ks], cw[ni]); ca[ni] = mfma32(axa, ba[ni][ks], ca[ni]); }
  }
#pragma unroll
  for (int ks = 0; ks < 4; ++ks) {
    const bf16x8 asg = *(const bf16x8*)(SG + (32 * mi + r) * 72 + 16 * ks + 8 * h);
#pragma unroll
    for (int ni = 0; ni < 2; ++ni) cg[ni] = mfma32(asg, bg[ni][ks], cg[ni]);
  }
  float ss[16], bn[16], q1[16], q2[16];
#pragma unroll
  for (int i = 0; i < 16; ++i) { ss[i] = 0.f; bn[i] = 0.f; q1[i] = 0.f; q2[i] = 0.f; }
#pragma unroll
  for (int ni = 0; ni < 2; ++ni) {
    const int hc = hd * 64 + 32 * ni + r;
    const float w0c = p.in[I_RW0][l * 256 + hc], a0c = p.in[I_RA0][l * 256 + hc], kkc = p.in[I_RKK][l * 256 + hc],
                kac = p.in[I_RKA][l * 256 + hc], rkc = p.in[I_RRK][l * 256 + hc];
#pragma unroll
    for (int i = 0; i < 16; ++i) {
      const int tl = 32 * mi + crow(i, h);
      const size_t tok = tok0 + tl;
      const float rr = bf2f(RK[tl * 520 + hc]);
      const float k = bf2f(RK[tl * 520 + 256 + hc]);
      const float wl = w0c + cw[ni][i];
      const float wlog = -softplusf_(-wl) - 0.5f;
      const float dd = 1.f - __expf(-__expf(wlog));
      const float a = sigmoidf_(a0c + ca[ni][i]);
      const float kkr = k * kkc;
      const float kp = k * (1.f + (a - 1.f) * kac);
      ss[i] += kkr * kkr; bn[i] += rr * kp * rkc; q1[i] += kkr * a * rr; q2[i] += kp * rr;
      cw[ni][i] = kkr;
      RD[tok * 256 + hc] = f2bf(dd); RA[tok * 256 + hc] = f2bf(a); RG[tok * 256 + hc] = f2bf(cg[ni][i]);
    }
  }
#pragma unroll
  for (int i = 0; i < 16; ++i) {
#pragma unroll
    for (int o = 1; o < 32; o <<= 1) { ss[i] += __shfl_xor(ss[i], o); bn[i] += __shfl_xor(bn[i], o); q1[i] += __shfl_xor(q1[i], o); q2[i] += __shfl_xor(q2[i], o); }
    ss[i] = rsqrtf(ss[i] + EPSF);
  }
#pragma unroll
  for (int ni = 0; ni < 2; ++ni) {
    const int hc = hd * 64 + 32 * ni + r;
#pragma unroll
    for (int i = 0; i < 16; ++i) {
      const size_t tok = tok0 + 32 * mi + crow(i, h);
      RKK[tok * 256 + hc] = f2bf(cw[ni][i] * ss[i]);
    }
  }
  if (r == 0) {
#pragma unroll
    for (int i = 0; i < 16; ++i) { const size_t th = (tok0 + 32 * mi + crow(i, h)) * 4 + hd; BON[th] = bn[i]; C12[th * 2] = q1[i] * ss[i]; C12[th * 2 + 1] = q2[i]; }
  }
}

DI void rwkv_scan_item(const Params& p, int l, int b, int hd, int half, char* smem) {
  const bf16_t* P = (const bf16_t*)(p.ws + OFF_P);
  bf16_t* O = (bf16_t*)(p.ws + OFF_O);
  const bf16_t* RD = (const bf16_t*)(p.ws + OFF_L);
  const bf16_t* RKK = (const bf16_t*)(p.ws + OFF_L + GSZ);
  const bf16_t* RA = (const bf16_t*)(p.ws + OFF_L + 2 * GSZ);
  const float* C12 = (const float*)(p.ws + OFF_C12);
  float* fb = (float*)smem;
  float* Yb = fb + 2 * 12352;
  const int tid = otid(), lane = tid & 63, wv = tid >> 6;
  const int hc = hd * 64 + lane;
  constexpr int NCH = SEQ / 32;
  f32x4 Sa = {0.f, 0.f, 0.f, 0.f}, Sb = {0.f, 0.f, 0.f, 0.f};
  const int rl = lane >> 3, kq = lane & 7, vloc = (wv & 3) * 8 + rl, vrow = half * 32 + vloc;
  const float* mu = p.in[I_RMU] + (size_t)l * 896;
  const float mu_r = mu[hc], mu_k = mu[256 + hc], mu_v = mu[512 + hc];
  const float kac = p.in[I_RKA][l * 256 + hc];
  const int pw = wv & 3;
  unsigned raw[8][9];
#pragma unroll
  for (int j = 0; j < 8; ++j)
#pragma unroll
    for (int e = 0; e < 9; ++e) raw[j][e] = 0u;
#define RAWLOAD(i_)                                                                                 \
  {                                                                                                 \
    _Pragma("unroll") for (int j = 0; j < 8; ++j) {                                                 \
      const int s_ = (i_) * 32 + pw * 8 + j;                                                        \
      const size_t tok_ = (size_t)b * SEQ + s_;                                                     \
      const bf16_t* pr_ = P + tok_ * PSTR + C_RW;                                                   \
      raw[j][0] = pr_[hc]; raw[j][1] = pr_[256 + hc]; raw[j][2] = pr_[512 + hc];                    \
      if (s_ > 0) { raw[j][3] = (pr_ - PSTR)[hc]; raw[j][4] = (pr_ - PSTR)[256 + hc]; raw[j][5] = (pr_ - PSTR)[512 + hc]; } \
      else { raw[j][3] = 0u; raw[j][4] = 0u; raw[j][5] = 0u; }                                      \
      raw[j][6] = RD[tok_ * 256 + hc]; raw[j][7] = RKK[tok_ * 256 + hc]; raw[j][8] = RA[tok_ * 256 + hc]; \
    }                                                                                               \
  }
#define RBAR() { asm volatile("s_waitcnt lgkmcnt(0)" ::: "memory"); __builtin_amdgcn_s_barrier(); asm volatile("" ::: "memory"); }
  if (wv >= 4) RAWLOAD(0);
#pragma unroll 1
  for (int i = 0; i < NCH + 2; ++i) {
    if (wv >= 4) {
      float* B = fb + (i & 1) * 12352;
      if (i >= 2) {
        const float* Yc = Yb + (i & 1) * 1024;
        if (lane < 32) {
#pragma unroll
          for (int j = 0; j < 8; ++j) {
            const int tl = pw * 8 + j;
            const size_t tok = (size_t)b * SEQ + (i - 2) * 32 + tl;
            O[tok * DM + 768 + hd * 64 + half * 32 + lane] = f2bf(Yc[tl * 32 + lane]);
          }
        }
      }
      if (i < NCH) {
#pragma unroll
        for (int j = 0; j < 8; ++j) {
          const int tl = pw * 8 + j;
          const float r = mixf((bf16_t)raw[j][0], (bf16_t)raw[j][3], mu_r), k = mixf((bf16_t)raw[j][1], (bf16_t)raw[j][4], mu_k), v = mixf((bf16_t)raw[j][2], (bf16_t)raw[j][5], mu_v);
          const float w = 1.f - bf2f((bf16_t)raw[j][6]), kk = bf2f((bf16_t)raw[j][7]), a = bf2f((bf16_t)raw[j][8]);
          const float ka = kk * a, kp = k * (1.f + (a - 1.f) * kac);

          B[tl * 64 + lane] = w; B[2048 + tl * 64 + lane] = kk; B[4096 + tl * 64 + lane] = ka; B[6144 + tl * 64 + lane] = kp;
          B[8192 + tl * 64 + lane] = w * r; B[10240 + tl * 64 + lane] = v;
          if (lane < 2) B[12288 + tl * 2 + lane] = C12[(((size_t)b * SEQ + i * 32 + tl) * 4 + hd) * 2 + lane];
        }
        if (i + 1 < NCH) RAWLOAD(i + 1);
      }
    } else if (i >= 1 && i <= NCH) {
      const float* B = fb + ((i - 1) & 1) * 12352;
      float* Yc = Yb + ((i - 1) & 1) * 1024;
      f32x4 vw[2][10]; float vvv[2]; float2 vsc[2];
#define RWLD(t_, s_)                                                                              \
      { const float* bt_ = B + (t_) * 64 + kq * 8;                                                 \
        _Pragma("unroll") for (int q_ = 0; q_ < 5; ++q_) { vw[s_][2 * q_] = *(const f32x4*)(bt_ + 2048 * q_); vw[s_][2 * q_ + 1] = *(const f32x4*)(bt_ + 2048 * q_ + 4); } \
        vvv[s_] = B[10240 + (t_) * 64 + vrow]; vsc[s_] = *(const float2*)(B + 12288 + (t_) * 2); }
      {
      constexpr int tb = 0;
      RWLD(0, 0);
#pragma unroll
      for (int t = 0; t < 32; ++t) {
        const int cs = t & 1;
        if (t + 1 < 32) RWLD(t + 1, cs ^ 1);
        const f32x4 w0 = vw[cs][0], w1 = vw[cs][1], kk0 = vw[cs][2], kk1 = vw[cs][3], ka0 = vw[cs][4], ka1 = vw[cs][5],
                    kp0 = vw[cs][6], kp1 = vw[cs][7], wr0 = vw[cs][8], wr1 = vw[cs][9];
        const float vv = vvv[cs]; const float2 sc = vsc[cs];
        const f32x4 pd = Sa * kk0 + Sb * kk1, pe = Sa * wr0 + Sb * wr1;
        float d0 = (pd[0] + pd[1]) + (pd[2] + pd[3]), e0 = (pe[0] + pe[1]) + (pe[2] + pe[3]);
        const f32x4 Ua = Sa * w0 + vv * kp0, Ub = Sb * w1 + vv * kp1;
        d0 = reduce8(d0); e0 = reduce8(e0);
        const float sa0 = -d0;
        const float y0 = e0 + sa0 * sc.x + vv * sc.y;
        Sa = Ua + sa0 * ka0; Sb = Ub + sa0 * ka1;
        if (kq == 0) Yc[(tb + t) * 32 + vloc] = y0;
      }
      }
#undef RWLD
    }
    RBAR();
  }
#undef RAWLOAD
#undef RBAR
}

DI void rwkv_post(const Params& p, int l) {
  const bf16_t* P = (const bf16_t*)(p.ws + OFF_P);
  bf16_t* O = (bf16_t*)(p.ws + OFF_O);
  const bf16_t* RG = (const bf16_t*)(p.ws + OFF_L + 3 * GSZ);
  const float* BON = (const float*)(p.ws + OFF_BON);
  const int tid = otid(), lane = tid & 63, wv = tid >> 6;
  const float* mu = p.in[I_RMU] + (size_t)l * 896;
  const int nw = gridDim.x * 8;
  for (int task0 = (obid() * 8 + wv) * 4; task0 < NTOK * 4; task0 += nw * 4) {
    float yv[4], vv[4], gv[4], bv[4];
#pragma unroll
    for (int q = 0; q < 4; ++q) {
      const int task = task0 + q; const size_t tok = task >> 2; const int hd = task & 3, hc = hd * 64 + lane;
      yv[q] = bf2f(O[tok * DM + 768 + hc]);
      const bf16_t cur = P[tok * PSTR + C_RW + 512 + hc];
      const bf16_t prev = (tok % SEQ) ? P[(tok - 1) * PSTR + C_RW + 512 + hc] : (bf16_t)0;
      vv[q] = mixf(cur, prev, mu[512 + hc]);
      gv[q] = bf2f(RG[tok * 256 + hc]); bv[q] = BON[tok * 4 + hd];
    }
#pragma unroll
    for (int q = 0; q < 4; ++q) {
      const int task = task0 + q; const size_t tok = task >> 2; const int hd = task & 3, hc = hd * 64 + lane;
      const float mean = wave_sum(yv[q]) * (1.f / 64.f);
      const float d = yv[q] - mean;
      const float var = wave_sum(d * d) * (1.f / 64.f);
      const float yn = d * rsqrtf(var + 64e-5f) * p.in[I_RLG][l * 256 + hc] + p.in[I_RLB][l * 256 + hc];
      O[tok * DM + 768 + hc] = f2bf((yn + bv[q] * vv[q]) * gv[q]);
    }
  }
}

DI void sb_item(const Params& p, int item, char* smem) {
  const bf16_t* P = (const bf16_t*)(p.ws + OFF_P);
  bf16_t* O = (bf16_t*)(p.ws + OFF_O);
  const int qt = item & 15, hd = (item >> 4) & 3, b = item >> 6;
  const int tid = otid(), lane = tid & 63, wv = tid >> 6, r = lane & 31, h = lane >> 5;
  bf16_t* Vt = (bf16_t*)(smem + wv * 8704);
  const int q0 = qt * 256 + wv * 32;
  const int sq = q0 + r;
  const size_t tokb = (size_t)b * SEQ;
  bf16x8 qf[4];
#pragma unroll
  for (int ks = 0; ks < 4; ++ks) qf[ks] = *(const bf16x8*)(P + (tokb + sq) * PSTR + C_SB_Q + hd * 64 + ks * 16 + h * 8);
  f32x16 accO[2];
#pragma unroll
  for (int i = 0; i < 16; ++i) { accO[0][i] = 0.f; accO[1][i] = 0.f; }
  float Prun = 1.f;
  bf16x8 kf[2][4];
  const int kt0 = (q0 + 31) >> 6;
#define SBKLOAD(kt_) { _Pragma("unroll") for (int m = 0; m < 2; ++m) _Pragma("unroll") for (int ks = 0; ks < 4; ++ks) \
    kf[m][ks] = *(const bf16x8*)(P + (tokb + (kt_) * 64 + 32 * m + r) * PSTR + C_SB_K + hd * 64 + ks * 16 + h * 8); }
  SBKLOAD(kt0);
  for (int kt = kt0; kt >= 0; --kt) {
    const int k0 = kt * 64;
    bf16x8 vr[8];
#pragma unroll
    for (int it = 0; it < 8; ++it) vr[it] = *(const bf16x8*)(P + (tokb + k0 + it * 8 + (lane >> 3)) * PSTR + C_SB_V + hd * 64 + (lane & 7) * 8);
    f32x16 acc[2];
#pragma unroll
    for (int m = 0; m < 2; ++m) {
#pragma unroll
      for (int i = 0; i < 16; ++i) acc[m][i] = 0.f;
#pragma unroll
      for (int ks = 0; ks < 4; ++ks) acc[m] = mfma32(kf[m][ks], qf[ks], acc[m]);
    }
    if (kt > 0) SBKLOAD(kt - 1);
    float om[2][16];
#pragma unroll
    for (int m = 0; m < 2; ++m)
#pragma unroll
      for (int i = 0; i < 16; ++i) {
        const int key = k0 + 32 * m + crow(i, h);
        const float z = fmaxf(acc[m][i] * 0.125f, -80.f);
        const float e = __expf(-z);
        const float sg = __builtin_amdgcn_rcpf(1.f + e);
        const bool valid = key < sq;
        acc[m][i] = valid ? sg : 0.f;
        om[m][i] = valid ? e * sg : 1.f;
      }
    float gp[8];
#pragma unroll
    for (int q = 0; q < 8; ++q) {
      const int m = q >> 2, g = q & 3;
      gp[q] = (om[m][4 * g] * om[m][4 * g + 1]) * (om[m][4 * g + 2] * om[m][4 * g + 3]);
    }
    float run = 1.f;
#pragma unroll
    for (int q = 7; q >= 0; --q) {
      const int m = q >> 2, g = q & 3;
      const float pg = __shfl_xor(gp[q], 32);
      const float f3 = Prun * run * (h == 0 ? pg : 1.f);
      const float f2 = f3 * om[m][4 * g + 3], f1 = f2 * om[m][4 * g + 2], f0 = f1 * om[m][4 * g + 1];
      acc[m][4 * g + 3] *= f3; acc[m][4 * g + 2] *= f2; acc[m][4 * g + 1] *= f1; acc[m][4 * g + 0] *= f0;
      run *= gp[q] * pg;
    }
    Prun *= run;
    __builtin_amdgcn_wave_barrier();
#pragma unroll
    for (int it = 0; it < 8; ++it) {
      const int key = it * 8 + (lane >> 3), chv = lane & 7;
#pragma unroll
      for (int e = 0; e < 8; ++e) Vt[(chv * 8 + e) * 68 + key] = (bf16_t)vr[it][e];
    }
    __builtin_amdgcn_wave_barrier();
#pragma unroll
    for (int m = 0; m < 2; ++m)
#pragma unroll
      for (int s2 = 0; s2 < 2; ++s2) {
        uint4 uu = {pack2(acc[m][8 * s2 + 0], acc[m][8 * s2 + 1]), pack2(acc[m][8 * s2 + 2], acc[m][8 * s2 + 3]),
                    pack2(acc[m][8 * s2 + 4], acc[m][8 * s2 + 5]), pack2(acc[m][8 * s2 + 6], acc[m][8 * s2 + 7])};
        const bf16x8 pb = __builtin_bit_cast(bf16x8, uu);
#pragma unroll
        for (int dt = 0; dt < 2; ++dt) {
          const bf16_t* vp = Vt + (32 * dt + r) * 68 + 32 * m + 16 * s2 + 4 * h;
          s16x4 lo = *(const s16x4*)vp, hi = *(const s16x4*)(vp + 8);
          bf16x8 va = __builtin_shufflevector(lo, hi, 0, 1, 2, 3, 4, 5, 6, 7);
          accO[dt] = mfma32(va, pb, accO[dt]);
        }
      }
    __builtin_amdgcn_wave_barrier();
    if (__ballot(Prun > 1e-37f) == 0ull) break;
  }
#undef SBKLOAD
#pragma unroll
  for (int dt = 0; dt < 2; ++dt)
#pragma unroll
    for (int g = 0; g < 4; ++g) {
      const int d = 32 * dt + 8 * g + 4 * h;
      uint2 o = {pack2(accO[dt][4 * g], accO[dt][4 * g + 1]), pack2(accO[dt][4 * g + 2], accO[dt][4 * g + 3])};
      *(uint2*)(O + (tokb + sq) * DM + 256 + hd * 64 + d) = o;
    }
}

DI int frag_off(int row, int k) {
  const int rt = row >> 4, fr = row & 15, ks = k >> 5, kk = k & 31, hi = kk >> 4, fq = (kk & 15) >> 2, j = (kk & 3) + 4 * hi;
  return ((rt * 2 + ks) * 64 + fq * 16 + fr) * 8 + j;
}
DI int frag_off8(int row, int k0) {
  const int rt = row >> 4, fr = row & 15, ks = k0 >> 5, kk = k0 & 31, hi = kk >> 4, fq = (kk & 15) >> 2;
  return ((rt * 2 + ks) * 64 + fq * 16 + fr) * 8 + 4 * hi;
}
DI void gdn_intra_item(const Params& p, int l, int item, char* smem) {
  const bf16_t* P = (const bf16_t*)(p.ws + OFF_P);
  const int hp = item & 1, c = (item >> 1) & 63, b = item >> 7;
  const int tid = otid(), lane = tid & 63;
  bf16_t* Kb = (bf16_t*)smem;
  bf16_t* Qb = Kb + 2 * 64 * 72;
  bf16_t* Vb = Qb + 2 * 64 * 72;
  float* Lm = (float*)(smem + 3 * 2 * 64 * 72 * 2);
  float* Gs = Lm + 2 * 4096;
  float* Bs = Gs + 128;
  const size_t tok0 = (size_t)b * SEQ + c * 64;
  const float* cw = p.in[I_GCW] + (size_t)l * 4 * 768;
  float* CW = Bs + 128;
  for (int e = tid; e < 6 * 4 * 64; e += NTHR) {
    const int blk = e >> 8, j = (e >> 6) & 3, col = e & 63;
    const int hh_ = blk / 3, which_ = blk % 3;
    CW[e] = cw[j * 768 + which_ * 256 + (hp * 2 + hh_) * 64 + col];
  }
  __syncthreads();
  {
    const int t = tid >> 3, cg = tid & 7;
#pragma unroll 3
    for (int it = 0; it < 6; ++it) {
      const int hh = it / 3, which = it % 3, head = hp * 2 + hh;
      const int ccol = which * 256 + head * 64 + cg * 8;
      float acc[8];
#pragma unroll
      for (int e = 0; e < 8; ++e) acc[e] = 0.f;
#pragma unroll
      for (int j = 0; j < 4; ++j) {
        const int s = c * 64 + t - 3 + j;
        if (s >= 0) {
          bf16x8 xv = *(const bf16x8*)(P + ((size_t)b * SEQ + s) * PSTR + C_GDN_Q + ccol);
          f32x4 wa = *(const f32x4*)(CW + (it * 4 + j) * 64 + cg * 8), wb = *(const f32x4*)(CW + (it * 4 + j) * 64 + cg * 8 + 4);
#pragma unroll
          for (int e = 0; e < 4; ++e) { acc[e] += wa[e] * bf2f((bf16_t)xv[e]); acc[e + 4] += wb[e] * bf2f((bf16_t)xv[e + 4]); }
        }
      }
      float ss = 0.f;
#pragma unroll
      for (int e = 0; e < 8; ++e) { acc[e] = siluf_(acc[e]); ss += acc[e] * acc[e]; }
      ss += __shfl_xor(ss, 1); ss += __shfl_xor(ss, 2); ss += __shfl_xor(ss, 4);
      float sc = 1.f;
      if (which == 0) sc = rsqrtf(ss + EPSF) * 0.125f;
      else if (which == 1) sc = rsqrtf(ss + EPSF);
      uint4 ov = {pack2(acc[0] * sc, acc[1] * sc), pack2(acc[2] * sc, acc[3] * sc), pack2(acc[4] * sc, acc[5] * sc), pack2(acc[6] * sc, acc[7] * sc)};
      bf16_t* dst = (which == 0 ? Qb : (which == 1 ? Kb : Vb)) + (hh * 64 + t) * 72 + cg * 8;
      *(uint4*)dst = ov;
    }
  }
  if (tid < 128) {
    const int hh = tid >> 6, t = lane, head = hp * 2 + hh;
    const float a_in = bf2f(P[(tok0 + t) * PSTR + C_GDN_A + head]);
    const float b_in = bf2f(P[(tok0 + t) * PSTR + C_GDN_B + head]);
    const float beta = sigmoidf_(b_in);
    float g = -__expf(p.in[I_GAL][l * 4 + head]) * softplusf_(a_in + p.in[I_GDT][l * 4 + head]);
#pragma unroll
    for (int d = 1; d < 64; d <<= 1) { float v = __shfl_up(g, d); if (lane >= d) g += v; }
    Gs[hh * 64 + t] = g; Bs[hh * 64 + t] = beta;
  }
  __syncthreads();
  const int hh = tid >> 8, lt = tid & 255, head = hp * 2 + hh;
  const size_t ih = ((size_t)(b * 4 + head)) * 64 + c;
  bf16_t* GW = (bf16_t*)(p.ws + OFF_G) + ih * 4096;
  bf16_t* GQD = (bf16_t*)(p.ws + OFF_G + GSZ) + ih * 4096;
  bf16_t* GQK = (bf16_t*)(p.ws + OFF_G + 2 * GSZ) + ih * 4096;
  bf16_t* GKD = (bf16_t*)(p.ws + OFF_G + 3 * GSZ) + ih * 4096;
  bf16_t* GU = (bf16_t*)(p.ws + OFF_G + 4 * GSZ) + ih * 4096;
  float* GCD = (float*)(p.ws + OFF_GCD);
  const float* Gh = Gs + hh * 64; const float* Bh = Bs + hh * 64;
  {
    const int wq = (tid >> 6) & 3, ti = wq >> 1, tj = wq & 1, r = lane & 31, h = lane >> 5;
    f32x16 akk, aqk;
#pragma unroll
    for (int i = 0; i < 16; ++i) { akk[i] = 0.f; aqk[i] = 0.f; }
    if (ti >= tj) {
#pragma unroll
      for (int ks = 0; ks < 4; ++ks) {
        bf16x8 ka = *(const bf16x8*)(Kb + (hh * 64 + 32 * ti + r) * 72 + ks * 16 + h * 8);
        bf16x8 qa = *(const bf16x8*)(Qb + (hh * 64 + 32 * ti + r) * 72 + ks * 16 + h * 8);
        bf16x8 kb = *(const bf16x8*)(Kb + (hh * 64 + 32 * tj + r) * 72 + ks * 16 + h * 8);
        akk = mfma32(ka, kb, akk);
        aqk = mfma32(qa, kb, aqk);
      }
    }
    const int j = 32 * tj + r;
    const float Gj = Gh[j];
#pragma unroll
    for (int i_ = 0; i_ < 16; ++i_) {
      const int i = 32 * ti + crow(i_, h);
      const float dec = (i >= j) ? __expf(Gh[i] - Gj) : 0.f;
      Lm[hh * 4096 + i * 64 + j] = (i > j) ? Bh[i] * akk[i_] * dec : 0.f;
      GQK[frag_off(i, j)] = f2bf((i >= j) ? aqk[i_] * dec : 0.f);
    }
  }
  __syncthreads();
  if (lt < 128) {
    const int cc = lt;
    float x[64];
    if (cc < 64) {
#pragma unroll
      for (int i = 0; i < 64; ++i) x[i] = bf2f(Vb[(hh * 64 + i) * 72 + cc]) * Bh[i];
    } else {
#pragma unroll
      for (int i = 0; i < 64; ++i) x[i] = bf2f(Kb[(hh * 64 + i) * 72 + cc - 64]) * Bh[i] * __expf(Gh[i]);
    }
    const float* Lh = Lm + hh * 4096;
#pragma unroll
    for (int i = 1; i < 64; ++i) {
      float s = x[i];
#pragma unroll
      for (int j4 = 0; j4 < (i + 3) / 4; ++j4) {
        const f32x4 lv = *(const f32x4*)(Lh + i * 64 + j4 * 4);
#pragma unroll
        for (int e = 0; e < 4; ++e) if (j4 * 4 + e < i) s -= lv[e] * x[j4 * 4 + e];
      }
      x[i] = s;
    }
    if (cc < 64) {
      const int split = cc >> 4, fr = cc & 15;
#pragma unroll
      for (int i4 = 0; i4 < 16; ++i4) {
        uint2 ov = {pack2(x[4 * i4], x[4 * i4 + 1]), pack2(x[4 * i4 + 2], x[4 * i4 + 3])};
        *(uint2*)(GU + ((split * 4 + (i4 >> 2)) * 64 + (i4 & 3) * 16 + fr) * 4) = ov;
      }
    } else {
#pragma unroll
      for (int i = 0; i < 64; ++i) GW[frag_off(i, cc - 64)] = f2bf(x[i]);
    }
  } else {
    const int q_ = lt - 128;
    const float Glast = Gh[63];
#pragma unroll
    for (int i = 0; i < 4; ++i) {
      const int q = q_ + 128 * i; const int pos = q >> 3, kc = q & 7;
      bf16x8 qv = *(const bf16x8*)(Qb + (hh * 64 + pos) * 72 + kc * 8);
      const float eg = __expf(Gh[pos]);
      uint4 ov = {pack2(bf2f((bf16_t)qv[0]) * eg, bf2f((bf16_t)qv[1]) * eg), pack2(bf2f((bf16_t)qv[2]) * eg, bf2f((bf16_t)qv[3]) * eg),
                  pack2(bf2f((bf16_t)qv[4]) * eg, bf2f((bf16_t)qv[5]) * eg), pack2(bf2f((bf16_t)qv[6]) * eg, bf2f((bf16_t)qv[7]) * eg)};
      { const int fo = frag_off8(pos, kc * 8); uint2 o0 = {ov.x, ov.y}, o1 = {ov.z, ov.w}; *(uint2*)(GQD + fo) = o0; *(uint2*)(GQD + fo + 128) = o1; }
    }
#pragma unroll
    for (int i = 0; i < 4; ++i) {
      const int q = q_ + 128 * i; const int k = q >> 3, pc = q & 7;
      float o[8];
#pragma unroll
      for (int e = 0; e < 8; ++e) { const int pos = pc * 8 + e; o[e] = bf2f(Kb[(hh * 64 + pos) * 72 + k]) * __expf(Glast - Gh[pos]); }
      uint4 ov = {pack2(o[0], o[1]), pack2(o[2], o[3]), pack2(o[4], o[5]), pack2(o[6], o[7])};
      { const int fo = frag_off8(k, pc * 8); uint2 o0 = {ov.x, ov.y}, o1 = {ov.z, ov.w}; *(uint2*)(GKD + fo) = o0; *(uint2*)(GKD + fo + 128) = o1; }
    }
    if (q_ == 0) GCD[ih] = __expf(Glast);
  }
}

DI void gdn_rec_item(const Params& p, int l, int b, int head, char* smem) {
  const bf16_t* P = (const bf16_t*)(p.ws + OFF_P);
  bf16_t* O = (bf16_t*)(p.ws + OFF_O);
  float* SS = (float*)(smem + 81920);
  const int tid = otid(), lane = tid & 63, wv = tid >> 6, fr = lane & 15, fq = lane >> 4;
  const int split = wv & 3;
  const bool active = wv < 4;
  const float ng = p.in[I_GNG][l * 64 + split * 16 + fr];
  const float* GCD = (const float*)(p.ws + OFF_GCD);
  const size_t ih0 = ((size_t)(b * 4 + head)) * 64;
  f32x4 S[4];
#pragma unroll
  for (int kt = 0; kt < 4; ++kt) S[kt] = (f32x4){0.f, 0.f, 0.f, 0.f};
  u32x4 lr[10];
#pragma unroll
  for (int i = 0; i < 10; ++i) lr[i] = (u32x4){0u, 0u, 0u, 0u};
  const int lq = (wv & 3) * 64 + lane;
#define GLOADC(c_)                                                                              \
  {                                                                                             \
    _Pragma("unroll") for (int i = 0; i < 10; ++i) {                                            \
      const int q_ = lq + 256 * i; const int a_ = q_ >> 9, o_ = q_ & 511;                       \
      lr[i] = *(const u32x4*)((const bf16_t*)(p.ws + OFF_G + (size_t)a_ * GSZ) + (ih0 + (c_)) * 4096 + o_ * 8); \
    }                                                                                           \
  }
#define LSTORE(buf_)                                                                            \
  {                                                                                             \
    _Pragma("unroll") for (int i = 0; i < 10; ++i) {                                            \
      const int q_ = lq + 256 * i;                                                              \
      *(u32x4*)(smem + (buf_) * 40960 + q_ * 16) = lr[i];                                       \
    }                                                                                           \
  }
#define BAR_LDS() { asm volatile("s_waitcnt lgkmcnt(0)" ::: "memory"); __builtin_amdgcn_s_barrier(); asm volatile("" ::: "memory"); }
  float cdn = 0.f;
  if (!active) { GLOADC(0); LSTORE(0); GLOADC(1); }
  else cdn = GCD[ih0];
  BAR_LDS();
#pragma unroll 1
  for (int c = 0; c < 64; ++c) {
    f32x4 acco[4];
    if (active) {
      const char* bufp = smem + (c & 1) * 40960;
      const float cd = cdn;
      if (c + 1 < 64) cdn = GCD[ih0 + c + 1];
      float zr[16];
#pragma unroll
      for (int rt = 0; rt < 4; ++rt)
#pragma unroll
        for (int j = 0; j < 4; ++j) {
          const size_t tok = (size_t)b * SEQ + c * 64 + 16 * rt + 4 * fq + j;
          zr[rt * 4 + j] = bf2f(P[tok * PSTR + C_GDN_Z + head * 64 + split * 16 + fr]);
        }
      bf16x8 bS[2];
#pragma unroll
      for (int ks = 0; ks < 2; ++ks) {
        uint4 uu = {pack2(S[2 * ks][0], S[2 * ks][1]), pack2(S[2 * ks][2], S[2 * ks][3]), pack2(S[2 * ks + 1][0], S[2 * ks + 1][1]), pack2(S[2 * ks + 1][2], S[2 * ks + 1][3])};
        bS[ks] = __builtin_bit_cast(bf16x8, uu);
      }
      f32x4 u[4];
#pragma unroll
      for (int rt = 0; rt < 4; ++rt) {
        f32x4 aw = {0.f, 0.f, 0.f, 0.f};
        acco[rt] = (f32x4){0.f, 0.f, 0.f, 0.f};
#pragma unroll
        for (int ks = 0; ks < 2; ++ks) {
          const bf16x8 wa = *(const bf16x8*)(bufp + ((rt * 2 + ks) * 64 + lane) * 16);
          const bf16x8 qa = *(const bf16x8*)(bufp + 8192 + ((rt * 2 + ks) * 64 + lane) * 16);
          aw = mfma16(wa, bS[ks], aw); acco[rt] = mfma16(qa, bS[ks], acco[rt]);
        }
        const s16x4 uv = *(const s16x4*)(bufp + 32768 + ((split * 4 + rt) * 64 + lane) * 8);
#pragma unroll
        for (int j = 0; j < 4; ++j) u[rt][j] = bf2f((bf16_t)uv[j]) - aw[j];
      }
      bf16x8 bU[2];
#pragma unroll
      for (int ks = 0; ks < 2; ++ks) {
        uint4 uu = {pack2(u[2 * ks][0], u[2 * ks][1]), pack2(u[2 * ks][2], u[2 * ks][3]), pack2(u[2 * ks + 1][0], u[2 * ks + 1][1]), pack2(u[2 * ks + 1][2], u[2 * ks + 1][3])};
        bU[ks] = __builtin_bit_cast(bf16x8, uu);
      }
#pragma unroll
      for (int rt = 0; rt < 4; ++rt) {
        f32x4 sn = S[rt] * cd;
#pragma unroll
        for (int ks = 0; ks < 2; ++ks) {
          const bf16x8 qa = *(const bf16x8*)(bufp + 16384 + ((rt * 2 + ks) * 64 + lane) * 16);
          const bf16x8 ka = *(const bf16x8*)(bufp + 24576 + ((rt * 2 + ks) * 64 + lane) * 16);
          acco[rt] = mfma16(qa, bU[ks], acco[rt]); sn = mfma16(ka, bU[ks], sn);
        }
        S[rt] = sn;
      }
#pragma unroll
      for (int rt = 0; rt < 4; ++rt)
#pragma unroll
        for (int j = 0; j < 4; ++j) {
          float s = acco[rt][j] * acco[rt][j];
          s += __shfl_xor(s, 1); s += __shfl_xor(s, 2); s += __shfl_xor(s, 4); s += __shfl_xor(s, 8);
          if (fr == 0) SS[(c & 1) * 256 + split * 64 + 16 * rt + 4 * fq + j] = s;
        }
      BAR_LDS();
      const float* ssb = SS + (c & 1) * 256;
#pragma unroll
      for (int rt = 0; rt < 4; ++rt)
#pragma unroll
        for (int j = 0; j < 4; ++j) {
          const int pos = 16 * rt + 4 * fq + j;
          const float tot = ssb[pos] + ssb[64 + pos] + ssb[128 + pos] + ssb[192 + pos];
          const float rn = rsqrtf(tot * (1.f / 64.f) + EPSF);
          const size_t tok = (size_t)b * SEQ + c * 64 + pos;
          O[tok * DM + 512 + head * 64 + split * 16 + fr] = f2bf(acco[rt][j] * rn * ng * siluf_(zr[rt * 4 + j]));
        }
    } else {
      if (c + 1 < 64) LSTORE((c + 1) & 1);
      if (c + 2 < 64) GLOADC(c + 2);
      BAR_LDS();
    }
  }
#undef GLOADC
#undef LSTORE
#undef BAR_LDS
}

DI void lru_item(const Params& p, int l, int item, char* smem, const int mode) {
  const bf16_t* P = (const bf16_t*)(p.ws + OFF_P);
  bf16_t* O = (bf16_t*)(p.ws + OFF_O);
  float* CA = (float*)(p.ws + OFF_LCA);
  float* CH = (float*)(p.ws + OFF_LCH);
  bf16_t* XS = (bf16_t*)smem;
  bf16_t* UB = (bf16_t*)(smem + 34816);
  const int b = item >> 6, ct = item & 63;
  const int tid = otid(), lane = tid & 63, wv = tid >> 6, r = lane & 31, h = lane >> 5, n = wv & 3, mi = wv >> 2;
  for (int i = 0; i < 5; ++i) {
    const int q = tid + NTHR * i;
    if (q < 67 * 32) {
      const int row = q >> 5, cc = q & 31;
      const int s = ct * 64 - 3 + row;
      uint4 v = {0u, 0u, 0u, 0u};
      if (s >= 0) v = *(const uint4*)(P + ((size_t)b * SEQ + s) * PSTR + C_LRU_X + cc * 8);
      *(uint4*)(XS + row * 256 + cc * 8) = v;
    }
  }
  bf16x8 bwr[2][4], bwi[2][4];
  {
    const float* wrp = p.in[I_LWR] + (((size_t)l * 4 + n) * 64) * 64 + r;
    const float* wip = p.in[I_LWI] + (((size_t)l * 4 + n) * 64) * 64 + r;
    asm volatile("" : "+v"(wrp), "+v"(wip));
#pragma unroll
    for (int ni = 0; ni < 2; ++ni)
#pragma unroll
      for (int ks = 0; ks < 4; ++ks) {
        unsigned ur[4], ui[4];
#pragma unroll
        for (int j2 = 0; j2 < 4; ++j2) {
          const int e = 16 * ks + 8 * h + 2 * j2;
          ur[j2] = pack2(wrp[e * 64 + 32 * ni], wrp[(e + 1) * 64 + 32 * ni]);
          ui[j2] = pack2(wip[e * 64 + 32 * ni], wip[(e + 1) * 64 + 32 * ni]);
        }
        uint4 t1 = {ur[0], ur[1], ur[2], ur[3]}, t2 = {ui[0], ui[1], ui[2], ui[3]};
        bwr[ni][ks] = __builtin_bit_cast(bf16x8, t1); bwi[ni][ks] = __builtin_bit_cast(bf16x8, t2);
      }
  }
  __syncthreads();
  {
    const int sc = tid >> 8, c = tid & 255;
    const float cb = p.in[I_LCB][l * 256 + c];
    const float c0 = p.in[I_LCW][(l * 4 + 0) * 256 + c], c1 = p.in[I_LCW][(l * 4 + 1) * 256 + c],
                c2 = p.in[I_LCW][(l * 4 + 2) * 256 + c], c3 = p.in[I_LCW][(l * 4 + 3) * 256 + c];
    for (int t = sc * 32; t < sc * 32 + 32; ++t)
      UB[t * 264 + c] = f2bf(cb + c0 * bf2f(XS[t * 256 + c]) + c1 * bf2f(XS[(t + 1) * 256 + c]) + c2 * bf2f(XS[(t + 2) * 256 + c]) + c3 * bf2f(XS[(t + 3) * 256 + c]));
  }
  __syncthreads();
  f32x16 ar[2], ai[2];
#pragma unroll
  for (int ni = 0; ni < 2; ++ni)
#pragma unroll
    for (int i = 0; i < 16; ++i) { ar[ni][i] = 0.f; ai[ni][i] = 0.f; }
#pragma unroll
  for (int ks = 0; ks < 4; ++ks) {
    const bf16x8 au = *(const bf16x8*)(UB + (32 * mi + r) * 264 + n * 64 + 16 * ks + 8 * h);
#pragma unroll
    for (int ni = 0; ni < 2; ++ni) { ar[ni] = mfma32(au, bwr[ni][ks], ar[ni]); ai[ni] = mfma32(au, bwi[ni][ks], ai[ni]); }
  }
  const int ck = ct * 2 + mi;
#pragma unroll
  for (int ni = 0; ni < 2; ++ni) {
    const int c = n * 64 + 32 * ni + r;
    const float brc = p.in[I_LBR][l * 256 + c], bic = p.in[I_LBI][l * 256 + c];
    const float lamsp = softplusf_(-p.in[I_LLAM][l * 256 + c]);
    float av[16], bv[16];
#pragma unroll
    for (int i = 0; i < 16; ++i) {
      const int tl = 32 * mi + crow(i, h);
      const float u = bf2f(UB[tl * 264 + c]);
      const float rg = sigmoid_rcp(ar[ni][i] + brc), ig = sigmoid_rcp(ai[ni][i] + bic);
      const float la = -8.f * rg * lamsp;
      av[i] = __expf(la);
      bv[i] = __builtin_amdgcn_sqrtf(fmaxf(0.f, 1.f - __expf(2.f * la))) * (ig * u);
    }
    float GA[4], GB[4], PA[4], PB[4];
#pragma unroll
    for (int q = 0; q < 4; ++q) {
      float A = 1.f, hh = 0.f;
#pragma unroll
      for (int e = 0; e < 4; ++e) { hh = av[4 * q + e] * hh + bv[4 * q + e]; A *= av[4 * q + e]; }
      GA[q] = A; GB[q] = hh;
      PA[q] = __shfl_xor(A, 32); PB[q] = __shfl_xor(hh, 32);
    }
    float cin = 0.f;
    if (mode == 1) {
      const int lo = h ? (ck >> 1) : 0, hi = h ? ck : (ck >> 1);
      float A = 1.f, hh = 0.f;
      const float* ca = CA + ((size_t)b * 128) * 256 + c;
      const float* chp = CH + ((size_t)b * 128) * 256 + c;
      int k = lo;
      for (; k + 8 <= hi; k += 8) {
        float a8[8], h8[8];
#pragma unroll
        for (int e = 0; e < 8; ++e) { a8[e] = ca[(size_t)(k + e) * 256]; h8[e] = chp[(size_t)(k + e) * 256]; }
#pragma unroll
        for (int e = 0; e < 8; ++e) { hh = a8[e] * hh + h8[e]; A *= a8[e]; }
      }
      for (; k < hi; ++k) { const float a_ = ca[(size_t)k * 256], h_ = chp[(size_t)k * 256]; hh = a_ * hh + h_; A *= a_; }
      const float pAx = __shfl_xor(A, 32), pHx = __shfl_xor(hh, 32);
      cin = h ? (A * pHx + hh) : (pAx * hh + pHx);
    }
    float cg = cin, Ap = 1.f, myc[4];
#pragma unroll
    for (int q = 0; q < 4; ++q) {
      const float Ae = h ? PA[q] : GA[q], Be = h ? PB[q] : GB[q];
      const float Ao = h ? GA[q] : PA[q], Bo = h ? GB[q] : PB[q];
      const float c_even = cg;
      cg = Ae * cg + Be;
      const float c_odd = cg;
      cg = Ao * cg + Bo;
      myc[q] = h ? c_odd : c_even;
      Ap *= Ae * Ao;
    }
    if (mode == 0) {
      if (h == 0) { CA[((size_t)b * 128 + ck) * 256 + c] = Ap; CH[((size_t)b * 128 + ck) * 256 + c] = cg; }
    } else {
#pragma unroll
      for (int q = 0; q < 4; ++q) {
        float hh = myc[q];
#pragma unroll
        for (int e = 0; e < 4; ++e) {
          const int i = 4 * q + e;
          hh = av[i] * hh + bv[i];
          const size_t tok = (size_t)b * SEQ + ct * 64 + 32 * mi + crow(i, h);
          const float y = bf2f(P[tok * PSTR + C_LRU_Y + c]);
          O[tok * DM + c] = f2bf(hh * gelu_rcp(y));
        }
      }
    }
  }
}

#define XB_TMO      128
#define XB_XCNT(j)  (256  + 64 * (j))
#define XB_XSUB(j)  (1280 + 64 * (j))
#define XB_XGEN(j)  (2304 + 64 * (j))
#define XB_TOP      3328
#define XB_TOPGEN   3392
#define XCD_BAR_WORDS 3456
#define XB_SPIN_CAP (1u << 18)
#define XLAS __attribute__((address_space(3)))
DI unsigned xb_ld(unsigned* p)              { return __hip_atomic_load(p, __ATOMIC_RELAXED, __HIP_MEMORY_SCOPE_AGENT); }
DI unsigned xb_add(unsigned* p, unsigned v) { return __hip_atomic_fetch_add(p, v, __ATOMIC_RELAXED, __HIP_MEMORY_SCOPE_AGENT); }
DI unsigned xb_xcc_id() { return (unsigned)__builtin_amdgcn_s_getreg((3 << 11) | 20) & 0xFu; }
#define XB_SPIN(cond, bar) do { unsigned _sp = 0; while (cond) { __builtin_amdgcn_s_sleep(1); \
    if ((++_sp & 255u) == 0u) { if (xb_ld(&(bar)[XB_TMO])) break; if (_sp > XB_SPIN_CAP) { atomicAdd(&(bar)[XB_TMO], 1u); break; } } } } while (0)
struct XcdBarrier { unsigned* bar; unsigned x; volatile XLAS unsigned* st; };
DI XcdBarrier xcd_barrier_post(unsigned* bar, volatile XLAS unsigned* st) {
  XcdBarrier b; b.bar = bar; b.x = xb_xcc_id(); b.st = st;
  if (threadIdx.x == 0) (void)xb_add(&bar[XB_XCNT(b.x)], 1u);
  return b;
}
DI void xcd_barrier_complete(unsigned* bar, unsigned x, unsigned& nloc, unsigned& nx) {
  const unsigned G = gridDim.x * gridDim.y * gridDim.z;
  unsigned sum, cnt, mine, sp = 0u;
  for (;;) {
    sum = 0u; cnt = 0u; mine = 0u;
#pragma unroll
    for (unsigned j = 0; j < 16; ++j) { const unsigned c = xb_ld(&bar[XB_XCNT(j)]); sum += c; cnt += (c > 0u) ? 1u : 0u; mine = (j == x) ? c : mine; }
    if (sum == G) break;
    __builtin_amdgcn_s_sleep(1);
    if ((++sp & 255u) == 0u) { if (xb_ld(&bar[XB_TMO])) break; if (sp > XB_SPIN_CAP) { atomicAdd(&bar[XB_TMO], 1u); break; } }
  }
  nloc = mine > 0u ? mine : 1u; nx = cnt > 0u ? cnt : 1u;
}
DI void xcd_barrier(const XcdBarrier& b) {
  asm volatile("s_waitcnt vmcnt(0)" ::: "memory");
  __syncthreads();
  if (threadIdx.x == 0) {
    unsigned* bar = b.bar;
    __builtin_amdgcn_s_waitcnt(0);
    unsigned nloc = b.st[0], nx = b.st[1];
    if (nloc == 0u) { xcd_barrier_complete(bar, b.x, nloc, nx); b.st[0] = nloc; b.st[1] = nx; }
    const unsigned old = xb_add(&bar[XB_XSUB(b.x)], 1u);
    const unsigned gen = old / nloc;
    if (old + 1u == (gen + 1u) * nloc) {
      __builtin_amdgcn_fence(__ATOMIC_RELEASE, "agent");
      asm volatile("s_waitcnt vmcnt(0)" ::: "memory");
      const unsigned og = xb_add(&bar[XB_TOP], 1u);
      const unsigned tg = og / nx;
      if (og + 1u == (tg + 1u) * nx) xb_add(&bar[XB_TOPGEN], 1u);
      else XB_SPIN(xb_ld(&bar[XB_TOPGEN]) == tg, bar);
      __builtin_amdgcn_fence(__ATOMIC_ACQUIRE, "agent");
      xb_add(&bar[XB_XGEN(b.x)], 1u);
      asm volatile("s_waitcnt vmcnt(0)" ::: "memory");
    } else {
      XB_SPIN(xb_ld(&bar[XB_XGEN(b.x)]) == gen, bar);
      __builtin_amdgcn_fence(__ATOMIC_ACQUIRE, "agent");
      asm volatile("s_waitcnt vmcnt(0)" ::: "memory");
    }
  }
  __syncthreads();
}

__global__ void __launch_bounds__(NTHR) mega(Params p) {
  extern __shared__ __attribute__((aligned(16))) char smem[];
  cg::grid_group grid = cg::this_grid();
  const int tid = threadIdx.x;
  bf16_t* H = (bf16_t*)(p.ws + OFF_H);
  bf16_t* PB = (bf16_t*)(p.ws + OFF_P);
  PG_LAS unsigned char* lds = (PG_LAS unsigned char*)smem;
  volatile XLAS unsigned* xst = (volatile XLAS unsigned*)(smem + 131072);
  if (tid < 2) xst[tid] = 0u;
  __syncthreads();
  const XcdBarrier xb = xcd_barrier_post((unsigned*)(p.ws + OFF_BAR), xst);

  for (int rep = 0; rep < REP_MISC; ++rep) {
  if (MASK & 1) phase_mod(p, smem);
  grid.sync();
  }
  for (int l = 0; l < 4; ++l) {
    const float* xcur = (l == 0) ? p.in[I_X] : p.out;
    for (int rep = 0; rep < REP_MISC; ++rep) {
    if (MASK & 2) phase_convert(p, l, smem);
    if (MASK & 4) phase_norm(p, xcur, p.in[I_N1G] + l * 1024, l, 1024, 0, H, nullptr);
    xcd_barrier(xb);
    }
    for (int rep = 0; rep < REP_G; ++rep) {
    if (MASK & 8) { pg::Order<1> S; S.init(NTOK, PSTR, gridDim.x, blockIdx.x); pg::EpiBf16<0> E{PB, PSTR, nullptr};
      pg::gemm_phase(lds, H, DM, (const bf16_t*)(p.ws + OFF_WIN), 1024, S, E); }
    xcd_barrier(xb);
    }
    for (int rep = 0; rep < REP_M1; ++rep) {
    for (int it = blockIdx.x; it < 5120; it += gridDim.x) {
      if (it < 2048) { if (MASK & 32) gdn_intra_item(p, l, it, smem); }
      else if (it < 3072) { }
      else if (it < 4096) { if (MASK & 128) lru_item(p, l, it - 3072, smem, 0); }
      else { if (MASK & 16) rw_prep_item(p, l, it - 4096, smem); }
      __syncthreads();
    }
    xcd_barrier(xb);
    }
    for (int rep = 0; rep < REP_M2; ++rep) {
    if (blockIdx.x < 128) {
      if (MASK & 16) rwkv_scan_item(p, l, blockIdx.x >> 3, (blockIdx.x >> 1) & 3, blockIdx.x & 1, smem);
    } else {
      if (blockIdx.x < 192) { if (MASK & 256) gdn_rec_item(p, l, (blockIdx.x - 128) >> 2, (blockIdx.x - 128) & 3, smem); }
      unsigned* ctr = (unsigned*)(p.ws + OFF_CTR) + l * 4 + rep;
      volatile int* slot = (volatile int*)(smem + 110016);
      for (;;) {
        __syncthreads();
        if (tid == 0) *slot = (int)atomicAdd(ctr, 1u);
        __syncthreads();
        const int it = *slot;
        if (it >= 2048) break;
        if (it < 1024) { if (MASK & 64) sb_item(p, it, smem); }
        else { if (MASK & 512) lru_item(p, l, it - 1024, smem, 1); }
      }
    }
    xcd_barrier(xb);
    }
    for (int rep = 0; rep < REP_G; ++rep) {
    for (int half = 0; half < 4; ++half) {
      bf16_t* BH = (bf16_t*)(p.ws + OFF_P + 134217728);
      if (half == 0 && rep == 0) { if (MASK & 16) rwkv_post(p, l); xcd_barrier(xb); }
      if (MASK & 1024) { pg::Order<1> S; S.init(NTOK / 4, 4096, gridDim.x, blockIdx.x, 0, 0, 2, 512); pg::EpiBf16<0> E{BH, 4096, nullptr};
        pg::gemm_phase(lds, (const bf16_t*)(p.ws + OFF_O) + (size_t)half * 16384 * DM, DM, (const bf16_t*)(p.ws + OFF_WBR), 256, S, E); }
      xcd_barrier(xb);
      if (MASK & 1024) { pg::Order<4> S; S.init(NTOK / 4, 1024, gridDim.x, blockIdx.x, 0, 2097152); pg::EpiGateMix E{PB + (size_t)half * 16384 * DM, (float*)(p.ws + OFF_G), BH, p.in[I_BGATE] + (size_t)l * 4096};
        pg::gemm_phase(lds, H + (size_t)half * 16384 * DM, DM, (const bf16_t*)(p.ws + OFF_WG), 1024, S, E); }
      xcd_barrier(xb);
    }
    }
    if (MASK & 2048) { pg::Order<1> S; S.init(NTOK, 1024, gridDim.x, blockIdx.x); pg::EpiResid E{xcur, p.out, (const float*)(p.ws + OFF_MODP), p.in[I_BADA], l, 2048};
      pg::gemm_phase(lds, PB, DM, (const bf16_t*)(p.ws + OFF_WO), 1024, S, E); }
    xcd_barrier(xb);
    for (int rep = 0; rep < REP_MISC; ++rep) {
    if (MASK & 4096) phase_norm(p, p.out, p.in[I_N2G] + l * 1024, l, 4096, 3072, H, nullptr);
    xcd_barrier(xb);
    }
    for (int rep = 0; rep < REP_G; ++rep) {
    if (MASK & 8192) { pg::Order<1> S; S.init(NTOK, FFN, gridDim.x, blockIdx.x); pg::EpiBf16<0> E{PB, FFN, nullptr};
      pg::gemm_phase(lds, H, DM, (const bf16_t*)(p.ws + OFF_WF), 1024, S, E); }
    xcd_barrier(xb);
    if (MASK & 8192) { pg::Order<1> S; S.init(NTOK, FFN, gridDim.x, blockIdx.x); pg::EpiFfnAct E{PB + (size_t)NTOK * FFN, PB, p.in[I_FCW] + (size_t)l * 3 * FFN};
      pg::gemm_phase(lds, H, DM, (const bf16_t*)(p.ws + OFF_WF) + (size_t)FFN * 1024, 1024, S, E); }
    xcd_barrier(xb);
    }
    if (MASK & 32768) { pg::Order<1> S; S.init(NTOK, 1024, gridDim.x, blockIdx.x); pg::EpiResid E{p.out, p.out, (const float*)(p.ws + OFF_MODP), p.in[I_BADA], l, 5120};
      pg::gemm_phase(lds, PB + (size_t)NTOK * FFN, FFN, (const bf16_t*)(p.ws + OFF_WD), FFN, S, E); }
    xcd_barrier(xb);
  }
  if (MASK & 65536) phase_norm(p, p.out, p.in[I_FG], 0, 0, 0, nullptr, p.out);
}

extern "C" void kernel_launch(void* const* d_in, const int* in_sizes, int n_in,
                              void* d_out, int out_size, void* d_ws, size_t ws_size,
                              hipStream_t stream) {
  if (ws_size < WS_NEED || n_in < 38) { fprintf(stderr, "workspace too small: %zu < %zu\n", ws_size, (size_t)WS_NEED); return; }
  (void)hipFuncSetAttribute((const void*)mega, hipFuncAttributeMaxDynamicSharedMemorySize, SMEM_BYTES);
  int dev = 0, cus = 0, per_cu = 0;
  (void)hipGetDevice(&dev);
  (void)hipDeviceGetAttribute(&cus, hipDeviceAttributeMultiprocessorCount, dev);
  (void)hipOccupancyMaxActiveBlocksPerMultiprocessor(&per_cu, mega, NTHR, SMEM_BYTES);
  if (per_cu < 1 || cus < 1) { fprintf(stderr, "occupancy query failed (%d, %d)\n", per_cu, cus); return; }
  if (cus > 256) cus = 256;
  const int grid_blocks = cus;
  Params p{};
  for (int i = 0; i < 38; ++i) p.in[i] = (const float*)d_in[i];
  p.out = (float*)d_out; p.ws = (char*)d_ws;
  (void)hipMemsetAsync((char*)d_ws + OFF_BAR, 0, XCD_BAR_WORDS * 4, stream);
  void* args[] = {&p};
  hipError_t e = hipLaunchCooperativeKernel((void*)mega, dim3(grid_blocks), dim3(NTHR), args, SMEM_BYTES, stream);
  if (e != hipSuccess) fprintf(stderr, "cooperative launch failed: %s (grid %d)\n", hipGetErrorString(e), grid_blocks);
}
```

```cpp
#include <hip/hip_runtime.h>
#include <hip/hip_cooperative_groups.h>
#include <cstdio>
namespace cg = cooperative_groups;

typedef unsigned short bf16_t;
typedef short bf16x8 __attribute__((ext_vector_type(8)));
typedef short s16x4 __attribute__((ext_vector_type(4)));
typedef float f32x4 __attribute__((ext_vector_type(4)));
typedef float f32x16 __attribute__((ext_vector_type(16)));
typedef unsigned u32x4 __attribute__((ext_vector_type(4)));
#define DI __device__ __forceinline__

constexpr int NTOK = 65536, DM = 1024, SEQ = 4096, PSTR = 3328, FFN = 2816, AUS = 5632;
constexpr int C_LRU_X = 0, C_LRU_Y = 256, C_SB_Q = 512, C_SB_K = 768, C_SB_V = 1024;
constexpr int C_GDN_Q = 1280, C_GDN_Z = 2048, C_GDN_A = 2304, C_GDN_B = 2308, C_RW = 2312;
constexpr float EPSF = 1e-6f;
#ifndef MASK
#define MASK 0x1ffff
#endif
#ifndef REP_M1
#define REP_M1 1
#endif
#ifndef REP_M2
#define REP_M2 1
#endif
#ifndef REP_G
#define REP_G 1
#endif
#ifndef REP_MISC
#define REP_MISC 1
#endif
constexpr int NTHR = 512;
constexpr int SMEM_BYTES = 131072 + 64;

constexpr size_t OFF_MODP = 0;
constexpr size_t OFF_WIN = 6291456;
constexpr size_t OFF_WG = OFF_WIN + 6815744;
constexpr size_t OFF_WBR = OFF_WG + 8388608;
constexpr size_t OFF_WO = OFF_WBR + 2097152;
constexpr size_t OFF_WF = OFF_WO + 2097152;
constexpr size_t OFF_WD = OFF_WF + 11534336;
constexpr size_t OFF_H = OFF_WD + 5767168;
constexpr size_t OFF_P = OFF_H + 134217728;
constexpr size_t OFF_O = OFF_P + 436207616;
constexpr size_t OFF_G = OFF_O + 134217728;
constexpr size_t GSZ = 33554432;
constexpr size_t OFF_GCD = OFF_G + 5 * GSZ;
constexpr size_t OFF_L = OFF_GCD + 16384;
constexpr size_t LSZ = 67108864;
constexpr size_t OFF_LCA = OFF_L + 2 * LSZ;
constexpr size_t OFF_LCH = OFF_LCA + 2097152;
constexpr size_t OFF_BON = OFF_LCH + 2097152;
constexpr size_t OFF_CTR = OFF_BON + 1048576;
constexpr size_t OFF_BAR = OFF_CTR + 256;
constexpr size_t OFF_C12 = OFF_BAR + 16384;
constexpr size_t WS_NEED = OFF_C12 + 2097152;

struct Params { const float* in[38]; float* out; char* ws; };
enum { I_X = 0, I_C, I_N1G, I_N2G, I_FG, I_WADA, I_BADA, I_WIN, I_LCW, I_LCB, I_LWR, I_LBR, I_LWI, I_LBI, I_LLAM,
       I_GCW, I_GAL, I_GDT, I_GNG, I_RMU, I_RW0, I_RWUP, I_RA0, I_RAUP, I_RGUP, I_RKK, I_RKA, I_RRK, I_RLG, I_RLB,
       I_WBR, I_WGATE, I_BGATE, I_WOUT, I_FWG, I_FWU, I_FCW, I_FWD };

DI float bf2f(bf16_t v) { return __uint_as_float(((unsigned)v) << 16); }
typedef __bf16 bf16n2 __attribute__((ext_vector_type(2)));
typedef float f32x2_ __attribute__((ext_vector_type(2)));
DI unsigned pack2(float lo, float hi) { f32x2_ v = {lo, hi}; bf16n2 b = __builtin_convertvector(v, bf16n2); return __builtin_bit_cast(unsigned, b); }
DI bf16_t f2bf(float x) { return (bf16_t)(pack2(x, x) & 0xffffu); }
DI float sigmoidf_(float x) { return __builtin_amdgcn_rcpf(1.f + __expf(-x)); }
DI float sigmoid_rcp(float x) { return __builtin_amdgcn_rcpf(1.f + __expf(-x)); }
DI float gelu_rcp(float x) { float u = 0.7978845608f * (x + 0.044715f * x * x * x); return x * __builtin_amdgcn_rcpf(1.f + __expf(-2.f * u)); }
DI float softplusf_(float x) { return fmaxf(x, 0.f) + __logf(1.f + __expf(-fabsf(x))); }
DI float siluf_(float x) { return x * __builtin_amdgcn_rcpf(1.f + __expf(-x)); }
DI float geluf_(float x) { float u = 0.7978845608f * (x + 0.044715f * x * x * x); return x * __builtin_amdgcn_rcpf(1.f + __expf(-2.f * u)); }
DI float tanhf_(float x) { return 1.f - 2.f * __builtin_amdgcn_rcpf(1.f + __expf(2.f * x)); }
DI float wave_sum(float x) {
#pragma unroll
  for (int o = 32; o >= 1; o >>= 1) x += __shfl_xor(x, o);
  return x;
}
template <int CTRL> DI float dppf(float x) { return __int_as_float(__builtin_amdgcn_update_dpp(0, __float_as_int(x), CTRL, 0xf, 0xf, true)); }
DI float reduce8(float x) { x += dppf<0xB1>(x); x += dppf<0x4E>(x); x += dppf<0x141>(x); return x; }
DI f32x16 mfma32(bf16x8 a, bf16x8 b, f32x16 c) { return __builtin_amdgcn_mfma_f32_32x32x16_bf16(a, b, c, 0, 0, 0); }
DI f32x4 mfma16(bf16x8 a, bf16x8 b, f32x4 c) { return __builtin_amdgcn_mfma_f32_16x16x32_bf16(a, b, c, 0, 0, 0); }
DI int crow(int i, int h) { return (i & 3) + 8 * (i >> 2) + 4 * h; }

DI float modv(const float* modp, const float* bada, int l, int b, int idx) {
  const float* q = modp + ((size_t)(l * 16 + b)) * 6144 + idx;
  const size_t ks = (size_t)4 * 16 * 6144;
  return bada[l * 6144 + idx] + q[0] + q[ks] + q[2 * ks] + q[3 * ks];
}

DI int otid() { int t = threadIdx.x; asm volatile("" : "+v"(t)); return t; }
DI int obid() { int b = blockIdx.x; asm volatile("" : "+s"(b)); return b; }
DI void phase_mod(const Params& p, char* smem) {
  float* sm = (float*)smem;
  float* modp = (float*)(p.ws + OFF_MODP);
  const int tid = otid();
  if (obid() == 0 && tid < 64) ((unsigned*)(p.ws + OFF_CTR))[tid] = 0u;
  for (int item = obid(); item < 192; item += gridDim.x) {
    const int l = item / 48, rem = item % 48, jb = rem >> 2, kq = rem & 3;
    for (int i = 0; i < 8; ++i) {
      int e = tid + 512 * i; int b = e >> 8, k = e & 255;
      float cv = p.in[I_C][b * 1024 + kq * 256 + k];
      sm[e] = siluf_(cv);
    }
    __syncthreads();
    float acc[16];
#pragma unroll
    for (int b = 0; b < 16; ++b) acc[b] = 0.f;
    const float* wp = p.in[I_WADA] + ((size_t)l * 1024 + kq * 256) * 6144 + jb * 512 + tid;
    for (int k = 0; k < 256; k += 4) {
      float w0 = wp[(size_t)k * 6144], w1 = wp[(size_t)(k + 1) * 6144], w2 = wp[(size_t)(k + 2) * 6144], w3 = wp[(size_t)(k + 3) * 6144];
#pragma unroll
      for (int b = 0; b < 16; ++b) {
        f32x4 cv = *(const f32x4*)(sm + b * 256 + k);
        acc[b] += cv[0] * w0 + cv[1] * w1 + cv[2] * w2 + cv[3] * w3;
      }
    }
#pragma unroll
    for (int b = 0; b < 16; ++b) modp[((size_t)((kq * 4 + l) * 16 + b)) * 6144 + jb * 512 + tid] = acc[b];
    __syncthreads();
  }
}

DI void conv_tile(const float* src, bf16_t* dst, int K, int N, int k0, int n0, char* smem) {
  float* tile = (float*)smem;
  const int tid = otid();
#pragma unroll
  for (int it = 0; it < 2; ++it) {
    int kr = (tid >> 4) + 32 * it, nc = (tid & 15) * 4;
    f32x4 v = {0.f, 0.f, 0.f, 0.f};
    if (n0 + nc < N) v = *(const f32x4*)(src + (size_t)(k0 + kr) * N + n0 + nc);
    tile[kr * 65 + nc] = v[0]; tile[kr * 65 + nc + 1] = v[1]; tile[kr * 65 + nc + 2] = v[2]; tile[kr * 65 + nc + 3] = v[3];
  }
  __syncthreads();
  {
    int n = tid >> 3, kc = (tid & 7) * 8;
    unsigned o[4];
#pragma unroll
    for (int e = 0; e < 4; ++e) o[e] = pack2(tile[(kc + 2 * e) * 65 + n], tile[(kc + 2 * e + 1) * 65 + n]);
    uint4 ov = {o[0], o[1], o[2], o[3]};
    *(uint4*)(dst + (size_t)(n0 + n) * K + k0 + kc) = ov;
  }
  __syncthreads();
}

DI void phase_convert(const Params& p, int l, char* smem) {
  for (int t = obid(); t < 4480; t += gridDim.x) {
    const float* src; bf16_t* dst; int K, N, Npad, tt = t;
    if (tt < 832) { src = p.in[I_WIN] + (size_t)l * 1024 * 3208; dst = (bf16_t*)(p.ws + OFF_WIN); K = 1024; N = 3208; Npad = 3328; }
    else if ((tt -= 832) < 1024) { int br = tt >> 8; tt &= 255; src = p.in[I_WGATE] + ((size_t)l * 4 + br) * 1048576; dst = (bf16_t*)(p.ws + OFF_WG) + (size_t)br * 1048576; K = 1024; N = 1024; Npad = 1024; }
    else if ((tt -= 1024) < 256) { int br = tt >> 6; tt &= 63; src = p.in[I_WBR] + ((size_t)l * 4 + br) * 262144; dst = (bf16_t*)(p.ws + OFF_WBR) + (size_t)br * 262144; K = 256; N = 1024; Npad = 1024; }
    else if ((tt -= 256) < 256) { src = p.in[I_WOUT] + (size_t)l * 1048576; dst = (bf16_t*)(p.ws + OFF_WO); K = 1024; N = 1024; Npad = 1024; }
    else if ((tt -= 256) < 704) { src = p.in[I_FWG] + (size_t)l * 1024 * 2816; dst = (bf16_t*)(p.ws + OFF_WF); K = 1024; N = 2816; Npad = 2816; }
    else if ((tt -= 704) < 704) { src = p.in[I_FWU] + (size_t)l * 1024 * 2816; dst = (bf16_t*)(p.ws + OFF_WF) + (size_t)2816 * 1024; K = 1024; N = 2816; Npad = 2816; }
    else { tt -= 704; src = p.in[I_FWD] + (size_t)l * 2816 * 1024; dst = (bf16_t*)(p.ws + OFF_WD); K = 2816; N = 1024; Npad = 1024; }
    const int nNt = Npad >> 6;
    const int kt = tt / nNt, nt = tt % nNt;
    conv_tile(src, dst, K, N, kt * 64, nt * 64, smem);
  }
}

DI void phase_norm(const Params& p, const float* xin, const float* g, int l, int scale_idx, int shift_idx, bf16_t* hout, float* fout) {
  const float* modp = (const float*)(p.ws + OFF_MODP);
  const int lane = otid() & 63, wv = otid() >> 6;
  const int nw = gridDim.x * 8;
  const int rows_per = 32;
  for (int chunk = obid() * 8 + wv; chunk < NTOK / 32; chunk += nw) {
  const int row0 = chunk * rows_per;
  const int b = row0 / SEQ;
  f32x4 gv[4], sc[4], sh[4];
#pragma unroll
  for (int j = 0; j < 4; ++j) {
    int c = lane * 4 + 256 * j;
    gv[j] = *(const f32x4*)(g + c);
    if (hout) {
#pragma unroll
      for (int e = 0; e < 4; ++e) {
        sc[j][e] = 1.f + modv(modp, p.in[I_BADA], l, b, scale_idx + c + e);
        sh[j][e] = modv(modp, p.in[I_BADA], l, b, shift_idx + c + e);
      }
    }
  }
  for (int rr = 0; rr < rows_per; ++rr) {
    const size_t row = (size_t)row0 + rr;
    f32x4 xv[4]; float ss = 0.f;
#pragma unroll
    for (int j = 0; j < 4; ++j) {
      xv[j] = *(const f32x4*)(xin + row * DM + lane * 4 + 256 * j);
      ss += xv[j][0] * xv[j][0] + xv[j][1] * xv[j][1] + xv[j][2] * xv[j][2] + xv[j][3] * xv[j][3];
    }
    ss = wave_sum(ss);
    const float rs = rsqrtf(ss * (1.f / 1024.f) + EPSF);
#pragma unroll
    for (int j = 0; j < 4; ++j) {
      f32x4 y = xv[j] * rs * gv[j];
      if (hout) {
        y = y * sc[j] + sh[j];
        uint2 o = {pack2(y[0], y[1]), pack2(y[2], y[3])};
        *(uint2*)(hout + row * DM + lane * 4 + 256 * j) = o;
      } else {
        *(f32x4*)(fout + row * DM + lane * 4 + 256 * j) = y;
      }
    }
  }
  }
}

#define PG_LAS __attribute__((address_space(3)))
namespace pg {
constexpr int BM = 256, BK = 64, HALF = 128, HTB = HALF * BK * 2, NXCD = 8, WGM = 8;
DI int lds_byte(int r, int c) { const int st = (r >> 4) * 2 + (c >> 5), rr = r & 15, cc = c & 31, ob = rr * 64 + cc * 2; return st * 1024 + (ob ^ (((ob >> 9) & 1) << 5)); }
DI void stage_rc(int b, int& R, int& C) { const int st = b / 1024, sb = b % 1024, swz = sb ^ (((sb >> 9) & 1) << 5); R = (st >> 1) * 16 + swz / 64; C = (st & 1) * 32 + (swz % 64) / 2; }
DI int perm32(int rho) { const int n = rho >> 4, i = rho & 15; return 8 * (i >> 2) + 4 * n + (i & 3); }
struct Unit { int pm, pn; int aux; long ao, bo; };
template <int REP> struct Order {
  int nM, nN, nwg, G, c, ashift; long astep, bstep, apnstep;
  DI void init(int M, int N, int G_, int c_, long astep_ = 0, long bstep_ = 0, int ashift_ = 0, long apnstep_ = 0) {
    nM = M / BM; nN = N / BM; nwg = nM * nN; G = G_; c = c_; astep = astep_; bstep = bstep_; ashift = ashift_; apnstep = apnstep_; }
  DI bool next(int i, Unit& u) const {
    const int ti = i / REP, aux = i % REP;
    const long L = (long)ti * G + c; if (L >= nwg) return false;
    int wgid = (int)L; { const int q = nwg / NXCD, r = nwg % NXCD, xcd = wgid % NXCD, off = wgid / NXCD; wgid = (xcd < r ? xcd * (q + 1) : r * (q + 1) + (xcd - r) * q) + off; }
    const int nig = WGM * nN, gid = wgid / nig, fm = gid * WGM, gsz = (nM - fm) < WGM ? (nM - fm) : WGM;
    u.pm = fm + ((wgid % nig) % gsz); u.pn = (wgid % nig) / gsz; u.aux = aux; u.ao = aux * astep + (long)(u.pn >> ashift) * apnstep; u.bo = aux * bstep; return true;
  }
};
DI unsigned cvt_pk_bf16(float lo, float hi) { return pack2(lo, hi); }

template <class Epi, class Sched>
DI void gemm_phase(PG_LAS unsigned char* lds, const bf16_t* Ag, int lda, const bf16_t* Bg, int K, const Sched& S, const Epi& E) {
  const int tid = otid(), wid = __builtin_amdgcn_readfirstlane(tid >> 6), lane = tid & 63, wr = wid >> 2, wc = wid & 3, fr = lane & 15, fq = lane >> 4;
  const int nt = K / BK;
  unsigned voffA[2], voffB[2];
#pragma unroll
  for (int i = 0; i < 2; ++i) { int R, C; stage_rc(tid * 16 + i * 8192, R, C); const int Rb = Epi::PERM ? ((R & ~31) + perm32(R & 31)) : R;
    voffA[i] = (unsigned)(R * lda + C) * 2u; voffB[i] = (unsigned)(Rb * K + C) * 2u; }
  const size_t kstep = (size_t)(BK * 2);
  const size_t hstepA = (size_t)HALF * lda * 2, hstepB = (size_t)HALF * K * 2;
  const size_t tstepA = 2 * hstepA, tstepB = 2 * hstepB;
  const unsigned ldsw = (unsigned)wid * 1024u;
  const int aoff = lds_byte(wr * 64 + fr, fq * 8), boff = lds_byte(wc * 32 + fr, fq * 8);
#define PG_SA(b, h) (((b) * 2 + (h)) * HTB)
#define PG_SB(b, h) ((4 + (b) * 2 + (h)) * HTB)
#define PG_STAGE(bufoff, gbase, voff) do { _Pragma("unroll") for (int _i = 0; _i < 2; ++_i) \
    __builtin_amdgcn_global_load_lds((const unsigned*)((const char*)(gbase) + (voff)[_i]), (PG_LAS unsigned*)(lds + (bufoff) + ldsw + _i * 8192), 16, 0, 0); } while (0)
#define PG_LDA(dst, b, h) do { _Pragma("unroll") for (int m = 0; m < 4; ++m) _Pragma("unroll") for (int k = 0; k < 2; ++k) dst[m][k] = *(const PG_LAS bf16x8*)(lds + PG_SA(b, h) + aoff + m * 2048 + k * 1024); } while (0)
#define PG_LDB(dst, b, h) do { _Pragma("unroll") for (int n = 0; n < 2; ++n) _Pragma("unroll") for (int k = 0; k < 2; ++k) dst[n][k] = *(const PG_LAS bf16x8*)(lds + PG_SB(b, h) + boff + n * 2048 + k * 1024); } while (0)
#define PG_MMA(ai, bj, At, Bt) do { __builtin_amdgcn_s_setprio(1); _Pragma("unroll") for (int m = 0; m < 4; ++m) _Pragma("unroll") for (int n = 0; n < 2; ++n) _Pragma("unroll") for (int k = 0; k < 2; ++k) \
    acc[ai][bj][m][n] = __builtin_amdgcn_mfma_f32_16x16x32_bf16(Bt[n][k], At[m][k], acc[ai][bj][m][n], 0, 0, 0); __builtin_amdgcn_s_setprio(0); } while (0)
#define PG_WAIT_V(n) asm volatile("s_waitcnt vmcnt(" #n ")" ::: "memory")
#define PG_WAIT_L(n) asm volatile("s_waitcnt lgkmcnt(" #n ")" ::: "memory")
#define PG_BAR __builtin_amdgcn_s_barrier()
#define PG_SCHED __builtin_amdgcn_sched_barrier(0)
  Unit cur, nxt; int ui = 0;
  if (!S.next(0, cur)) return;
  f32x4 acc[2][2][4][2];
#pragma unroll
  for (int a = 0; a < 2; ++a)
#pragma unroll
    for (int b = 0; b < 2; ++b)
#pragma unroll
      for (int m = 0; m < 4; ++m)
#pragma unroll
        for (int n = 0; n < 2; ++n) acc[a][b][m][n] = (f32x4){0.f, 0.f, 0.f, 0.f};
  bf16x8 At[4][2], B0[2][2], B1[2][2];
  const char* cA = (const char*)Ag + (size_t)cur.pm * tstepA + cur.ao; const char* cB = (const char*)Bg + (size_t)cur.pn * tstepB + cur.bo;
  PG_STAGE(PG_SB(0, 0), cB, voffB); PG_STAGE(PG_SA(0, 0), cA, voffA); PG_STAGE(PG_SB(0, 1), cB + hstepB, voffB); PG_STAGE(PG_SA(0, 1), cA + hstepA, voffA);
  if (wr == 1) PG_BAR;
  PG_WAIT_V(4); PG_BAR;
  PG_STAGE(PG_SB(1, 0), cB + kstep, voffB); PG_STAGE(PG_SA(1, 0), cA + kstep, voffA); PG_STAGE(PG_SB(1, 1), cB + hstepB + kstep, voffB);
  PG_WAIT_V(6); PG_BAR;
  for (;;) {
    const bool has_next = S.next(ui + 1, nxt);
    const char* nA = has_next ? (const char*)Ag + (size_t)nxt.pm * tstepA + nxt.ao : cA; const char* nB = has_next ? (const char*)Bg + (size_t)nxt.pn * tstepB + nxt.bo : cB;
#pragma unroll 1
    for (int t = 0; t < nt; t += 2) {
      const bool last = (t == nt - 2);
      const char* a1 = cA + (size_t)(t + 1) * kstep;
      const char* a2 = last ? nA : cA + (size_t)(t + 2) * kstep; const char* b2 = last ? nB : cB + (size_t)(t + 2) * kstep;
      const char* a3 = a2 + kstep; const char* b3 = b2 + kstep;
      PG_LDB(B0, 0, 0); PG_SCHED; PG_LDA(At, 0, 0); PG_STAGE(PG_SA(1, 1), a1 + hstepA, voffA);
      PG_WAIT_L(8); PG_BAR; PG_WAIT_L(0); PG_MMA(0, 0, At, B0); PG_BAR; PG_SCHED;
      PG_LDB(B1, 0, 1); PG_STAGE(PG_SB(0, 0), b2, voffB);
      PG_BAR; PG_WAIT_L(0); PG_MMA(0, 1, At, B1); PG_BAR;
      PG_LDA(At, 0, 1); PG_STAGE(PG_SA(0, 0), a2, voffA);
      PG_BAR; PG_WAIT_L(0); PG_MMA(1, 0, At, B0); PG_BAR; PG_SCHED;
      PG_STAGE(PG_SB(0, 1), b2 + hstepB, voffB);
      PG_WAIT_V(6); PG_BAR; PG_MMA(1, 1, At, B1); PG_BAR;
      PG_LDB(B0, 1, 0); PG_SCHED; PG_LDA(At, 1, 0); PG_STAGE(PG_SA(0, 1), a2 + hstepA, voffA);
      PG_WAIT_L(8); PG_BAR; PG_WAIT_L(0); PG_MMA(0, 0, At, B0); PG_BAR; PG_SCHED;
      PG_LDB(B1, 1, 1); PG_STAGE(PG_SB(1, 0), b3, voffB);
      PG_BAR; PG_WAIT_L(0); PG_MMA(0, 1, At, B1); PG_BAR;
      PG_LDA(At, 1, 1); PG_STAGE(PG_SA(1, 0), a3, voffA);
      PG_BAR; PG_WAIT_L(0); PG_MMA(1, 0, At, B0); PG_BAR; PG_SCHED;
      PG_STAGE(PG_SB(1, 1), b3 + hstepB, voffB);
      PG_WAIT_V(6); PG_BAR; PG_MMA(1, 1, At, B1); PG_BAR;
    }
    E(acc, cur, wr, wc, fr, fq);
    if (!has_next) break;
#pragma unroll
    for (int a = 0; a < 2; ++a)
#pragma unroll
      for (int b = 0; b < 2; ++b)
#pragma unroll
        for (int m = 0; m < 4; ++m)
#pragma unroll
          for (int n = 0; n < 2; ++n) acc[a][b][m][n] = (f32x4){0.f, 0.f, 0.f, 0.f};
    cur = nxt; cA = nA; cB = nB; ++ui;
  }
  PG_WAIT_V(0);
  if (wr == 0) PG_BAR;
  PG_BAR;
#undef PG_SA
#undef PG_SB
#undef PG_STAGE
#undef PG_LDA
#undef PG_LDB
#undef PG_MMA
#undef PG_WAIT_V
#undef PG_WAIT_L
#undef PG_BAR
#undef PG_SCHED
}

template <int ACT> struct EpiBf16 {
  static constexpr bool PERM = true;
  bf16_t* O; int ldc; const float* bias;
  DI void operator()(const f32x4 (&acc)[2][2][4][2], const Unit& u, int wr, int wc, int fr, int fq) const {
    const int row0 = u.pm * BM + wr * 64 + fr, col0 = u.pn * BM + wc * 32 + 8 * fq;
    f32x4 bv[2][2];
#pragma unroll
    for (int bj = 0; bj < 2; ++bj)
#pragma unroll
      for (int n = 0; n < 2; ++n) bv[bj][n] = ACT ? *(const f32x4*)(bias + col0 + bj * HALF + 4 * n) : (f32x4){0.f, 0.f, 0.f, 0.f};
#pragma unroll
    for (int ai = 0; ai < 2; ++ai)
#pragma unroll
      for (int m = 0; m < 4; ++m) { bf16_t* rowp = O + (size_t)(row0 + ai * HALF + m * 16) * ldc + col0;
#pragma unroll
        for (int bj = 0; bj < 2; ++bj) { f32x4 v0 = acc[ai][bj][m][0], v1 = acc[ai][bj][m][1];
          if (ACT) { v0 += bv[bj][0]; v1 += bv[bj][1];
#pragma unroll
            for (int j = 0; j < 4; ++j) { v0[j] = sigmoid_rcp(v0[j]); v1[j] = sigmoid_rcp(v1[j]); } }
          u32x4 w; w.x = cvt_pk_bf16(v0[0], v0[1]); w.y = cvt_pk_bf16(v0[2], v0[3]); w.z = cvt_pk_bf16(v1[0], v1[1]); w.w = cvt_pk_bf16(v1[2], v1[3]);
          *(u32x4*)(rowp + bj * HALF) = w; } }
  }
};
struct EpiBranch {
  static constexpr bool PERM = true;
  bf16_t* MIX; const bf16_t* G;
  DI void operator()(const f32x4 (&acc)[2][2][4][2], const Unit& u, int wr, int wc, int fr, int fq) const {
    const int row0 = u.pm * BM + wr * 64 + fr, col0 = u.pn * BM + wc * 32 + 8 * fq;
#pragma unroll
    for (int ai = 0; ai < 2; ++ai)
#pragma unroll
      for (int m = 0; m < 4; ++m) {
        asm volatile("" ::: "memory");
        const size_t row = (size_t)(row0 + ai * HALF + m * 16);
        bf16_t* mp = MIX + row * DM + col0; const bf16_t* gp = G + row * 4096 + u.aux * 1024 + col0;
#pragma unroll
        for (int bj = 0; bj < 2; ++bj) {
          const bf16x8 gv = *(const bf16x8*)(gp + bj * HALF);
          float o[8];
#pragma unroll
          for (int j = 0; j < 4; ++j) { o[j] = bf2f((bf16_t)gv[j]) * acc[ai][bj][m][0][j]; o[4 + j] = bf2f((bf16_t)gv[4 + j]) * acc[ai][bj][m][1][j]; }
          if (u.aux > 0) {
            const bf16x8 mv = *(const bf16x8*)(mp + bj * HALF);
#pragma unroll
            for (int j = 0; j < 8; ++j) o[j] += bf2f((bf16_t)mv[j]);
          }
          u32x4 w; w.x = cvt_pk_bf16(o[0], o[1]); w.y = cvt_pk_bf16(o[2], o[3]); w.z = cvt_pk_bf16(o[4], o[5]); w.w = cvt_pk_bf16(o[6], o[7]);
          *(u32x4*)(mp + bj * HALF) = w;
        }
      }
  }
};
struct EpiResid {
  static constexpr bool PERM = false;
  const float* xold; float* xnew; const float* modp; const float* bada; int l, gate_idx;
  DI void operator()(const f32x4 (&acc)[2][2][4][2], const Unit& u, int wr, int wc, int fr, int fq) const {
    const int row0 = u.pm * BM + wr * 64 + fr, col0 = u.pn * BM + wc * 32 + 4 * fq;
    const int b = (u.pm * BM) / SEQ;
    f32x4 gv[2][2];
#pragma unroll
    for (int bj = 0; bj < 2; ++bj)
#pragma unroll
      for (int n = 0; n < 2; ++n)
#pragma unroll
        for (int j = 0; j < 4; ++j) gv[bj][n][j] = modv(modp, bada, l, b, gate_idx + col0 + bj * HALF + n * 16 + j);
#pragma unroll
    for (int ai = 0; ai < 2; ++ai)
#pragma unroll
      for (int m = 0; m < 4; ++m) { const size_t ro = (size_t)(row0 + ai * HALF + m * 16) * DM + col0;
#pragma unroll
        for (int bj = 0; bj < 2; ++bj)
#pragma unroll
          for (int n = 0; n < 2; ++n) {
            const f32x4 xo = *(const f32x4*)(xold + ro + bj * HALF + n * 16);
            *(f32x4*)(xnew + ro + bj * HALF + n * 16) = xo + gv[bj][n] * acc[ai][bj][m][n];
          } }
  }
};
struct EpiFfnAct {
  static constexpr bool PERM = true;
  bf16_t* ACT; const bf16_t* APRE; const float* cw;
  DI void operator()(const f32x4 (&acc)[2][2][4][2], const Unit& u, int wr, int wc, int fr, int fq) const {
    const int row0 = u.pm * BM + wr * 64 + fr, col0 = u.pn * BM + wc * 32 + 8 * fq;
#pragma unroll
    for (int ai = 0; ai < 2; ++ai)
#pragma unroll
      for (int m = 0; m < 4; ++m) {
        asm volatile("" ::: "memory");
        const int row = row0 + ai * HALF + m * 16; const int sp = row & (SEQ - 1);
        const bf16_t* ap = APRE + (size_t)row * FFN + col0;
        bf16_t* op = ACT + (size_t)row * FFN + col0;
#pragma unroll
        for (int bj = 0; bj < 2; ++bj) {
          const int c = bj * HALF;
          const bf16x8 z8 = {0, 0, 0, 0, 0, 0, 0, 0};
          const bf16x8 a0 = *(const bf16x8*)(ap + c);
          const bf16x8 a1 = sp >= 1 ? *(const bf16x8*)(ap - FFN + c) : z8;
          const bf16x8 a2 = sp >= 2 ? *(const bf16x8*)(ap - 2 * FFN + c) : z8;
          float o[8];
#pragma unroll
          for (int hh = 0; hh < 2; ++hh) {
            const f32x4 w0 = *(const f32x4*)(cw + col0 + c + 4 * hh), w1 = *(const f32x4*)(cw + FFN + col0 + c + 4 * hh), w2 = *(const f32x4*)(cw + 2 * FFN + col0 + c + 4 * hh);
#pragma unroll
            for (int j = 0; j < 4; ++j) {
              const float cv = w0[j] * bf2f((bf16_t)a2[4 * hh + j]) + w1[j] * bf2f((bf16_t)a1[4 * hh + j]) + w2[j] * bf2f((bf16_t)a0[4 * hh + j]);
              o[4 * hh + j] = gelu_rcp(cv) * acc[ai][bj][m][hh][j];
            }
          }
          u32x4 w; w.x = cvt_pk_bf16(o[0], o[1]); w.y = cvt_pk_bf16(o[2], o[3]); w.z = cvt_pk_bf16(o[4], o[5]); w.w = cvt_pk_bf16(o[6], o[7]);
          *(u32x4*)(op + c) = w;
        }
      }
  }
};
struct EpiGateMix {
  static constexpr bool PERM = true;
  bf16_t* MIX; float* MIX32; const bf16_t* BH; const float* bias;
  DI void operator()(const f32x4 (&acc)[2][2][4][2], const Unit& u, int wr, int wc, int fr, int fq) const {
    const int row0 = u.pm * BM + wr * 64 + fr, col0 = u.pn * BM + wc * 32 + 8 * fq;
    const bool rmw = u.aux > 0, fin = u.aux == 3;
    f32x4 bv[2][2];
#pragma unroll
    for (int bj = 0; bj < 2; ++bj)
#pragma unroll
      for (int n = 0; n < 2; ++n) bv[bj][n] = *(const f32x4*)(bias + u.aux * 1024 + col0 + bj * HALF + 4 * n);
    const f32x4 z4 = {0.f, 0.f, 0.f, 0.f};
    bf16x8 nb[2]; f32x4 nm[2][2];
#define GM_LOAD(it_) { const size_t row_ = (size_t)(row0 + ((it_) >> 2) * HALF + ((it_) & 3) * 16); \
      _Pragma("unroll") for (int bj = 0; bj < 2; ++bj) { nb[bj] = *(const bf16x8*)(BH + row_ * 4096 + u.aux * 1024 + col0 + bj * HALF); \
        nm[bj][0] = rmw ? *(const f32x4*)(MIX32 + row_ * DM + col0 + bj * HALF) : z4; nm[bj][1] = rmw ? *(const f32x4*)(MIX32 + row_ * DM + col0 + bj * HALF + 4) : z4; } }
    GM_LOAD(0);
#pragma unroll
    for (int it = 0; it < 8; ++it) {
      const int ai = it >> 2, m = it & 3;
      bf16x8 cb[2]; f32x4 cm[2][2];
#pragma unroll
      for (int bj = 0; bj < 2; ++bj) { cb[bj] = nb[bj]; cm[bj][0] = nm[bj][0]; cm[bj][1] = nm[bj][1]; }
      if (it + 1 < 8) GM_LOAD(it + 1);
      const size_t ro = (size_t)(row0 + ai * HALF + m * 16) * DM + col0;
#pragma unroll
      for (int bj = 0; bj < 2; ++bj) {
        f32x4 o[2];
#pragma unroll
        for (int hh = 0; hh < 2; ++hh)
#pragma unroll
          for (int j = 0; j < 4; ++j)
            o[hh][j] = sigmoid_rcp(acc[ai][bj][m][hh][j] + bv[bj][hh][j]) * bf2f((bf16_t)cb[bj][4 * hh + j]) + cm[bj][hh][j];
        if (fin) {
          u32x4 w; w.x = cvt_pk_bf16(o[0][0], o[0][1]); w.y = cvt_pk_bf16(o[0][2], o[0][3]); w.z = cvt_pk_bf16(o[1][0], o[1][1]); w.w = cvt_pk_bf16(o[1][2], o[1][3]);
          *(u32x4*)(MIX + ro + bj * HALF) = w;
        } else {
          *(f32x4*)(MIX32 + ro + bj * HALF) = o[0]; *(f32x4*)(MIX32 + ro + bj * HALF + 4) = o[1];
        }
      }
    }
#undef GM_LOAD
  }
};
}

DI void phase_ffn_act(const Params& p, int l) {
  bf16_t* AU = (bf16_t*)(p.ws + OFF_P);
  const float* cw = p.in[I_FCW] + (size_t)l * 3 * FFN;
  const int nthr = gridDim.x * NTHR;
  for (int run = obid() * NTHR + otid(); run < 1024 * 352; run += nthr) {
    const int ch = run / 352, j8 = run % 352, j0 = j8 * 8;
    float w0[8], w1[8], w2[8];
#pragma unroll
    for (int e = 0; e < 8; ++e) { w0[e] = cw[j0 + e]; w1[e] = cw[FFN + j0 + e]; w2[e] = cw[2 * FFN + j0 + e]; }
    const int t0 = ch * 64, s0 = t0 % SEQ;
    float a1[8], a2[8];
#pragma unroll
    for (int e = 0; e < 8; ++e) { a1[e] = 0.f; a2[e] = 0.f; }
    if (s0 > 0) {
      bf16x8 v1 = *(const bf16x8*)(AU + (size_t)(t0 - 1) * AUS + j0);
      bf16x8 v2 = *(const bf16x8*)(AU + (size_t)(t0 - 2) * AUS + j0);
#pragma unroll
      for (int e = 0; e < 8; ++e) { a1[e] = bf2f((bf16_t)v1[e]); a2[e] = bf2f((bf16_t)v2[e]); }
    }
    for (int t = t0; t < t0 + 64; ++t) {
      bf16x8 va = *(const bf16x8*)(AU + (size_t)t * AUS + j0);
      bf16x8 vu = *(const bf16x8*)(AU + (size_t)t * AUS + FFN + j0);
      float o[8];
#pragma unroll
      for (int e = 0; e < 8; ++e) {
        float a0 = bf2f((bf16_t)va[e]);
        float cv = w0[e] * a2[e] + w1[e] * a1[e] + w2[e] * a0;
        o[e] = geluf_(cv) * bf2f((bf16_t)vu[e]);
        a2[e] = a1[e]; a1[e] = a0;
      }
      uint4 ov = {pack2(o[0], o[1]), pack2(o[2], o[3]), pack2(o[4], o[5]), pack2(o[6], o[7])};
      *(uint4*)(AU + (size_t)t * AUS + FFN + j0) = ov;
    }
  }
}

DI float mixf(bf16_t cur, bf16_t prev, float mu) { const float c = bf2f(cur); return c + (bf2f(prev) - c) * mu; }
DI void rw_prep_item(const Params& p, int l, int item, char* smem) {
  const bf16_t* P = (const bf16_t*)(p.ws + OFF_P);
  bf16_t* RD = (bf16_t*)(p.ws + OFF_L);
  bf16_t* RKK = (bf16_t*)(p.ws + OFF_L + GSZ);
  bf16_t* RA = (bf16_t*)(p.ws + OFF_L + 2 * GSZ);
  bf16_t* RG = (bf16_t*)(p.ws + OFF_L + 3 * GSZ);
  float* BON = (float*)(p.ws + OFF_BON);
  float* C12 = (float*)(p.ws + OFF_C12);
  const int b = item >> 6, ct = item & 63;
  const int tid = otid(), lane = tid & 63, wv = tid >> 6, hd = wv & 3, mi = wv >> 2, r = lane & 31, h = lane >> 5;
  bf16_t* TX = (bf16_t*)smem;
  bf16_t* XA = TX + 64 * 40;
  bf16_t* SG = XA + 64 * 40;
  bf16_t* RK = SG + 64 * 72;
  const float* mu = p.in[I_RMU] + (size_t)l * 896;
  const size_t tok0 = (size_t)b * SEQ + ct * 64;
  bf16x8 bw[2][2], ba[2][2], bg[2][4];
  {
    const float* wp = p.in[I_RWUP] + (size_t)l * 32 * 256 + hd * 64 + r;
    const float* ap = p.in[I_RAUP] + (size_t)l * 32 * 256 + hd * 64 + r;
    const float* gp = p.in[I_RGUP] + (size_t)l * 64 * 256 + hd * 64 + r;
    asm volatile("" : "+v"(wp), "+v"(ap), "+v"(gp));
#pragma unroll
    for (int ni = 0; ni < 2; ++ni) {
#pragma unroll
      for (int ks = 0; ks < 2; ++ks) {
        unsigned uw[4], ua[4];
#pragma unroll
        for (int j2 = 0; j2 < 4; ++j2) {
          const int k = 16 * ks + 8 * h + 2 * j2;
          uw[j2] = pack2(wp[k * 256 + 32 * ni], wp[(k + 1) * 256 + 32 * ni]);
          ua[j2] = pack2(ap[k * 256 + 32 * ni], ap[(k + 1) * 256 + 32 * ni]);
        }
        uint4 t1 = {uw[0], uw[1], uw[2], uw[3]}, t2 = {ua[0], ua[1], ua[2], ua[3]};
        bw[ni][ks] = __builtin_bit_cast(bf16x8, t1); ba[ni][ks] = __builtin_bit_cast(bf16x8, t2);
      }
#pragma unroll
      for (int ks = 0; ks < 4; ++ks) {
        unsigned ug[4];
#pragma unroll
        for (int j2 = 0; j2 < 4; ++j2) { const int k = 16 * ks + 8 * h + 2 * j2; ug[j2] = pack2(gp[k * 256 + 32 * ni], gp[(k + 1) * 256 + 32 * ni]); }
        uint4 t3 = {ug[0], ug[1], ug[2], ug[3]};
        bg[ni][ks] = __builtin_bit_cast(bf16x8, t3);
      }
    }
  }
#pragma unroll 4
  for (int i = 0; i < 16; ++i) {
    const int e = tid + NTHR * i; const int t = e >> 7, f = e & 127;
    const bf16_t* pr = P + (tok0 + t) * PSTR + C_RW + 768 + f;
    const bf16_t cur = pr[0];
    const bf16_t prev = (ct * 64 + t > 0) ? (pr - PSTR)[0] : (bf16_t)0;
    const float m = mixf(cur, prev, mu[768 + f]);
    if (f < 32) TX[t * 40 + f] = f2bf(tanhf_(m));
    else if (f < 64) XA[t * 40 + f - 32] = f2bf(m);
    else SG[t * 72 + f - 64] = f2bf(sigmoidf_(m));
  }
#pragma unroll 2
  for (int i = 0; i < 8; ++i) {
    const int q = tid + NTHR * i; const int t = q >> 6, col = (q & 63) * 8;
    const bf16_t* pr = P + (tok0 + t) * PSTR + C_RW + col;
    const bf16x8 cur = *(const bf16x8*)pr;
    bf16x8 prev = {0, 0, 0, 0, 0, 0, 0, 0};
    if (ct * 64 + t > 0) prev = *(const bf16x8*)(pr - PSTR);
    const f32x4 m0 = *(const f32x4*)(mu + col), m1 = *(const f32x4*)(mu + col + 4);
    float o[8];
#pragma unroll
    for (int e = 0; e < 4; ++e) { o[e] = mixf((bf16_t)cur[e], (bf16_t)prev[e], m0[e]); o[4 + e] = mixf((bf16_t)cur[4 + e], (bf16_t)prev[4 + e], m1[e]); }
    uint4 ov = {pack2(o[0], o[1]), pack2(o[2], o[3]), pack2(o[4], o[5]), pack2(o[6], o[7])};
    *(uint4*)(RK + t * 520 + col) = ov;
  }
  __syncthreads();
  f32x16 cw[2], ca[2], cg[2];
#pragma unroll
  for (int ni = 0; ni < 2; ++ni)
#pragma unroll
    for (int i = 0; i < 16; ++i) { cw[ni][i] = 0.f; ca[ni][i] = 0.f; cg[ni][i] = 0.f; }
#pragma unroll
  for (int ks = 0; ks < 2; ++ks) {
    const bf16x8 atx = *(const bf16x8*)(TX + (32 * mi + r) * 40 + 16 * ks + 8 * h);
    const bf16x8 axa = *(const bf16x8*)(XA + (32 * mi + r) * 40 + 16 * ks + 8 * h);
#pragma unroll
    for (int ni = 0; ni < 2; ++ni) { cw[ni] = mfma32(atx, bw[ni][ks], cw[ni]); ca[ni] = mfma32(axa, ba[ni][ks], ca[ni]); }
  }
#pragma unroll
  for (int ks = 0; ks < 4; ++ks) {
    const bf16x8 asg = *(const bf16x8*)(SG + (32 * mi + r) * 72 + 16 * ks + 8 * h);
#pragma unroll
    for (int ni = 0; ni < 2; ++ni) cg[ni] = mfma32(asg, bg[ni][ks], cg[ni]);
  }
  float ss[16], bn[16], q1[16], q2[16];
#pragma unroll
  for (int i = 0; i < 16; ++i) { ss[i] = 0.f; bn[i] = 0.f; q1[i] = 0.f; q2[i] = 0.f; }
#pragma unroll
  for (int ni = 0; ni < 2; ++ni) {
    const int hc = hd * 64 + 32 * ni + r;
    const float w0c = p.in[I_RW0][l * 256 + hc], a0c = p.in[I_RA0][l * 256 + hc], kkc = p.in[I_RKK][l * 256 + hc],
                kac = p.in[I_RKA][l * 256 + hc], rkc = p.in[I_RRK][l * 256 + hc];
#pragma unroll
    for (int i = 0; i < 16; ++i) {
      const int tl = 32 * mi + crow(i, h);
      const size_t tok = tok0 + tl;
      const float rr = bf2f(RK[tl * 520 + hc]);
      const float k = bf2f(RK[tl * 520 + 256 + hc]);
      const float wl = w0c + cw[ni][i];
      const float wlog = -softplusf_(-wl) - 0.5f;
      const float dd = 1.f - __expf(-__expf(wlog));
      const float a = sigmoidf_(a0c + ca[ni][i]);
      const float kkr = k * kkc;
      const float kp = k * (1.f + (a - 1.f) * kac);
      ss[i] += kkr * kkr; bn[i] += rr * kp * rkc; q1[i] += kkr * a * rr; q2[i] += kp * rr;
      cw[ni][i] = kkr;
      RD[tok * 256 + hc] = f2bf(dd); RA[tok * 256 + hc] = f2bf(a); RG[tok * 256 + hc] = f2bf(cg[ni][i]);
    }
  }
#pragma unroll
  for (int i = 0; i < 16; ++i) {
#pragma unroll
    for (int o = 1; o < 32; o <<= 1) { ss[i] += __shfl_xor(ss[i], o); bn[i] += __shfl_xor(bn[i], o); q1[i] += __shfl_xor(q1[i], o); q2[i] += __shfl_xor(q2[i], o); }
    ss[i] = rsqrtf(ss[i] + EPSF);
  }
#pragma unroll
  for (int ni = 0; ni < 2; ++ni) {
    const int hc = hd * 64 + 32 * ni + r;
#pragma unroll
    for (int i = 0; i < 16; ++i) {
      const size_t tok = tok0 + 32 * mi + crow(i, h);
      RKK[tok * 256 + hc] = f2bf(cw[ni][i] * ss[i]);
    }
  }
  if (r == 0) {
#pragma unroll
    for (int i = 0; i < 16; ++i) { const size_t th = (tok0 + 32 * mi + crow(i, h)) * 4 + hd; BON[th] = bn[i]; C12[th * 2] = q1[i] * ss[i]; C12[th * 2 + 1] = q2[i]; }
  }
}

DI void rwkv_scan_item(const Params& p, int l, int b, int hd, int half, char* smem) {
  const bf16_t* P = (const bf16_t*)(p.ws + OFF_P);
  bf16_t* O = (bf16_t*)(p.ws + OFF_O);
  const bf16_t* RD = (const bf16_t*)(p.ws + OFF_L);
  const bf16_t* RKK = (const bf16_t*)(p.ws + OFF_L + GSZ);
  const bf16_t* RA = (const bf16_t*)(p.ws + OFF_L + 2 * GSZ);
  const float* C12 = (const float*)(p.ws + OFF_C12);
  float* fb = (float*)smem;
  float* Yb = fb + 2 * 12352;
  const int tid = otid(), lane = tid & 63, wv = tid >> 6;
  const int hc = hd * 64 + lane;
  constexpr int NCH = SEQ / 32;
  f32x4 Sa = {0.f, 0.f, 0.f, 0.f}, Sb = {0.f, 0.f, 0.f, 0.f};
  const int rl = lane >> 3, kq = lane & 7, vloc = (wv & 3) * 8 + rl, vrow = half * 32 + vloc;
  const float* mu = p.in[I_RMU] + (size_t)l * 896;
  const float mu_r = mu[hc], mu_k = mu[256 + hc], mu_v = mu[512 + hc];
  const float kac = p.in[I_RKA][l * 256 + hc];
  const int pw = wv & 3;
  unsigned raw[8][9];
#pragma unroll
  for (int j = 0; j < 8; ++j)
#pragma unroll
    for (int e = 0; e < 9; ++e) raw[j][e] = 0u;
#define RAWLOAD(i_)                                                                                 \
  {                                                                                                 \
    _Pragma("unroll") for (int j = 0; j < 8; ++j) {                                                 \
      const int s_ = (i_) * 32 + pw * 8 + j;                                                        \
      const size_t tok_ = (size_t)b * SEQ + s_;                                                     \
      const bf16_t* pr_ = P + tok_ * PSTR + C_RW;                                                   \
      raw[j][0] = pr_[hc]; raw[j][1] = pr_[256 + hc]; raw[j][2] = pr_[512 + hc];                    \
      if (s_ > 0) { raw[j][3] = (pr_ - PSTR)[hc]; raw[j][4] = (pr_ - PSTR)[256 + hc]; raw[j][5] = (pr_ - PSTR)[512 + hc]; } \
      else { raw[j][3] = 0u; raw[j][4] = 0u; raw[j][5] = 0u; }                                      \
      raw[j][6] = RD[tok_ * 256 + hc]; raw[j][7] = RKK[tok_ * 256 + hc]; raw[j][8] = RA[tok_ * 256 + hc]; \
    }                                                                                               \
  }
#define RBAR() { asm volatile("s_waitcnt lgkmcnt(0)" ::: "memory"); __builtin_amdgcn_s_barrier(); asm volatile("" ::: "memory"); }
  if (wv >= 4) RAWLOAD(0);
#pragma unroll 1
  for (int i = 0; i < NCH + 2; ++i) {
    if (wv >= 4) {
      float* B = fb + (i & 1) * 12352;
      if (i >= 2) {
        const float* Yc = Yb + (i & 1) * 1024;
        if (lane < 32) {
#pragma unroll
          for (int j = 0; j < 8; ++j) {
            const int tl = pw * 8 + j;
            const size_t tok = (size_t)b * SEQ + (i - 2) * 32 + tl;
            O[tok * DM + 768 + hd * 64 + half * 32 + lane] = f2bf(Yc[tl * 32 + lane]);
          }
        }
      }
      if (i < NCH) {
#pragma unroll
        for (int j = 0; j < 8; ++j) {
          const int tl = pw * 8 + j;
          const float r = mixf((bf16_t)raw[j][0], (bf16_t)raw[j][3], mu_r), k = mixf((bf16_t)raw[j][1], (bf16_t)raw[j][4], mu_k), v = mixf((bf16_t)raw[j][2], (bf16_t)raw[j][5], mu_v);
          const float w = 1.f - bf2f((bf16_t)raw[j][6]), kk = bf2f((bf16_t)raw[j][7]), a = bf2f((bf16_t)raw[j][8]);
          const float ka = kk * a, kp = k * (1.f + (a - 1.f) * kac);

          B[tl * 64 + lane] = w; B[2048 + tl * 64 + lane] = kk; B[4096 + tl * 64 + lane] = ka; B[6144 + tl * 64 + lane] = kp;
          B[8192 + tl * 64 + lane] = w * r; B[10240 + tl * 64 + lane] = v;
          if (lane < 2) B[12288 + tl * 2 + lane] = C12[(((size_t)b * SEQ + i * 32 + tl) * 4 + hd) * 2 + lane];
        }
        if (i + 1 < NCH) RAWLOAD(i + 1);
      }
    } else if (i >= 1 && i <= NCH) {
      const float* B = fb + ((i - 1) & 1) * 12352;
      float* Yc = Yb + ((i - 1) & 1) * 1024;
      f32x4 vw[2][10]; float vvv[2]; float2 vsc[2];
#define RWLD(t_, s_)                                                                              \
      { const float* bt_ = B + (t_) * 64 + kq * 8;                                                 \
        _Pragma("unroll") for (int q_ = 0; q_ < 5; ++q_) { vw[s_][2 * q_] = *(const f32x4*)(bt_ + 2048 * q_); vw[s_][2 * q_ + 1] = *(const f32x4*)(bt_ + 2048 * q_ + 4); } \
        vvv[s_] = B[10240 + (t_) * 64 + vrow]; vsc[s_] = *(const float2*)(B + 12288 + (t_) * 2); }
      {
      constexpr int tb = 0;
      RWLD(0, 0);
#pragma unroll
      for (int t = 0; t < 32; ++t) {
        const int cs = t & 1;
        if (t + 1 < 32) RWLD(t + 1, cs ^ 1);
        const f32x4 w0 = vw[cs][0], w1 = vw[cs][1], kk0 = vw[cs][2], kk1 = vw[cs][3], ka0 = vw[cs][4], ka1 = vw[cs][5],
                    kp0 = vw[cs][6], kp1 = vw[cs][7], wr0 = vw[cs][8], wr1 = vw[cs][9];
        const float vv = vvv[cs]; const float2 sc = vsc[cs];
        const f32x4 pd = Sa * kk0 + Sb * kk1, pe = Sa * wr0 + Sb * wr1;
        float d0 = (pd[0] + pd[1]) + (pd[2] + pd[3]), e0 = (pe[0] + pe[1]) + (pe[2] + pe[3]);
        const f32x4 Ua = Sa * w0 + vv * kp0, Ub = Sb * w1 + vv * kp1;
        d0 = reduce8(d0); e0 = reduce8(e0);
        const float sa0 = -d0;
        const float y0 = e0 + sa0 * sc.x + vv * sc.y;
        Sa = Ua + sa0 * ka0; Sb = Ub + sa0 * ka1;
        if (kq == 0) Yc[(tb + t) * 32 + vloc] = y0;
      }
      }
#undef RWLD
    }
    RBAR();
  }
#undef RAWLOAD
#undef RBAR
}

DI void rwkv_post(const Params& p, int l) {
  const bf16_t* P = (const bf16_t*)(p.ws + OFF_P);
  bf16_t* O = (bf16_t*)(p.ws + OFF_O);
  const bf16_t* RG = (const bf16_t*)(p.ws + OFF_L + 3 * GSZ);
  const float* BON = (const float*)(p.ws + OFF_BON);
  const int tid = otid(), lane = tid & 63, wv = tid >> 6;
  const float* mu = p.in[I_RMU] + (size_t)l * 896;
  const int nw = gridDim.x * 8;
  for (int task0 = (obid() * 8 + wv) * 4; task0 < NTOK * 4; task0 += nw * 4) {
    float yv[4], vv[4], gv[4], bv[4];
#pragma unroll
    for (int q = 0; q < 4; ++q) {
      const int task = task0 + q; const size_t tok = task >> 2; const int hd = task & 3, hc = hd * 64 + lane;
      yv[q] = bf2f(O[tok * DM + 768 + hc]);
      const bf16_t cur = P[tok * PSTR + C_RW + 512 + hc];
      const bf16_t prev = (tok % SEQ) ? P[(tok - 1) * PSTR + C_RW + 512 + hc] : (bf16_t)0;
      vv[q] = mixf(cur, prev, mu[512 + hc]);
      gv[q] = bf2f(RG[tok * 256 + hc]); bv[q] = BON[tok * 4 + hd];
    }
#pragma unroll
    for (int q = 0; q < 4; ++q) {
      const int task = task0 + q; const size_t tok = task >> 2; const int hd = task & 3, hc = hd * 64 + lane;
      const float mean = wave_sum(yv[q]) * (1.f / 64.f);
      const float d = yv[q] - mean;
      const float var = wave_sum(d * d) * (1.f / 64.f);
      const float yn = d * rsqrtf(var + 64e-5f) * p.in[I_RLG][l * 256 + hc] + p.in[I_RLB][l * 256 + hc];
      O[tok * DM + 768 + hc] = f2bf((yn + bv[q] * vv[q]) * gv[q]);
    }
  }
}

DI void sb_item(const Params& p, int item, char* smem) {
  const bf16_t* P = (const bf16_t*)(p.ws + OFF_P);
  bf16_t* O = (bf16_t*)(p.ws + OFF_O);
  const int qt = item & 15, hd = (item >> 4) & 3, b = item >> 6;
  const int tid = otid(), lane = tid & 63, wv = tid >> 6, r = lane & 31, h = lane >> 5;
  bf16_t* Vt = (bf16_t*)(smem + wv * 8704);
  const int q0 = qt * 256 + wv * 32;
  const int sq = q0 + r;
  const size_t tokb = (size_t)b * SEQ;
  bf16x8 qf[4];
#pragma unroll
  for (int ks = 0; ks < 4; ++ks) qf[ks] = *(const bf16x8*)(P + (tokb + sq) * PSTR + C_SB_Q + hd * 64 + ks * 16 + h * 8);
  f32x16 accO[2];
#pragma unroll
  for (int i = 0; i < 16; ++i) { accO[0][i] = 0.f; accO[1][i] = 0.f; }
  float Prun = 1.f;
  bf16x8 kf[2][4];
  const int kt0 = (q0 + 31) >> 6;
#define SBKLOAD(kt_) { _Pragma("unroll") for (int m = 0; m < 2; ++m) _Pragma("unroll") for (int ks = 0; ks < 4; ++ks) \
    kf[m][ks] = *(const bf16x8*)(P + (tokb + (kt_) * 64 + 32 * m + r) * PSTR + C_SB_K + hd * 64 + ks * 16 + h * 8); }
  SBKLOAD(kt0);
  for (int kt = kt0; kt >= 0; --kt) {
    const int k0 = kt * 64;
    bf16x8 vr[8];
#pragma unroll
    for (int it = 0; it < 8; ++it) vr[it] = *(const bf16x8*)(P + (tokb + k0 + it * 8 + (lane >> 3)) * PSTR + C_SB_V + hd * 64 + (lane & 7) * 8);
    f32x16 acc[2];
#pragma unroll
    for (int m = 0; m < 2; ++m) {
#pragma unroll
      for (int i = 0; i < 16; ++i) acc[m][i] = 0.f;
#pragma unroll
      for (int ks = 0; ks < 4; ++ks) acc[m] = mfma32(kf[m][ks], qf[ks], acc[m]);
    }
    if (kt > 0) SBKLOAD(kt - 1);
    float om[2][16];
#pragma unroll
    for (int m = 0; m < 2; ++m)
#pragma unroll
      for (int i = 0; i < 16; ++i) {
        const int key = k0 + 32 * m + crow(i, h);
        const float z = fmaxf(acc[m][i] * 0.125f, -80.f);
        const float e = __expf(-z);
        const float sg = __builtin_amdgcn_rcpf(1.f + e);
        const bool valid = key < sq;
        acc[m][i] = valid ? sg : 0.f;
        om[m][i] = valid ? e * sg : 1.f;
      }
    float gp[8];
#pragma unroll
    for (int q = 0; q < 8; ++q) {
      const int m = q >> 2, g = q & 3;
      gp[q] = (om[m][4 * g] * om[m][4 * g + 1]) * (om[m][4 * g + 2] * om[m][4 * g + 3]);
    }
    float run = 1.f;
#pragma unroll
    for (int q = 7; q >= 0; --q) {
      const int m = q >> 2, g = q & 3;
      const float pg = __shfl_xor(gp[q], 32);
      const float f3 = Prun * run * (h == 0 ? pg : 1.f);
      const float f2 = f3 * om[m][4 * g + 3], f1 = f2 * om[m][4 * g + 2], f0 = f1 * om[m][4 * g + 1];
      acc[m][4 * g + 3] *= f3; acc[m][4 * g + 2] *= f2; acc[m][4 * g + 1] *= f1; acc[m][4 * g + 0] *= f0;
      run *= gp[q] * pg;
    }
    Prun *= run;
    __builtin_amdgcn_wave_barrier();
#pragma unroll
    for (int it = 0; it < 8; ++it) {
      const int key = it * 8 + (lane >> 3), chv = lane & 7;
#pragma unroll
      for (int e = 0; e < 8; ++e) Vt[(chv * 8 + e) * 68 + key] = (bf16_t)vr[it][e];
    }
    __builtin_amdgcn_wave_barrier();
#pragma unroll
    for (int m = 0; m < 2; ++m)
#pragma unroll
      for (int s2 = 0; s2 < 2; ++s2) {
        uint4 uu = {pack2(acc[m][8 * s2 + 0], acc[m][8 * s2 + 1]), pack2(acc[m][8 * s2 + 2], acc[m][8 * s2 + 3]),
                    pack2(acc[m][8 * s2 + 4], acc[m][8 * s2 + 5]), pack2(acc[m][8 * s2 + 6], acc[m][8 * s2 + 7])};
        const bf16x8 pb = __builtin_bit_cast(bf16x8, uu);
#pragma unroll
        for (int dt = 0; dt < 2; ++dt) {
          const bf16_t* vp = Vt + (32 * dt + r) * 68 + 32 * m + 16 * s2 + 4 * h;
          s16x4 lo = *(const s16x4*)vp, hi = *(const s16x4*)(vp + 8);
          bf16x8 va = __builtin_shufflevector(lo, hi, 0, 1, 2, 3, 4, 5, 6, 7);
          accO[dt] = mfma32(va, pb, accO[dt]);
        }
      }
    __builtin_amdgcn_wave_barrier();
    if (__ballot(Prun > 1e-37f) == 0ull) break;
  }
#undef SBKLOAD
#pragma unroll
  for (int dt = 0; dt < 2; ++dt)
#pragma unroll
    for (int g = 0; g < 4; ++g) {
      const int d = 32 * dt + 8 * g + 4 * h;
      uint2 o = {pack2(accO[dt][4 * g], accO[dt][4 * g + 1]), pack2(accO[dt][4 * g + 2], accO[dt][4 * g + 3])};
      *(uint2*)(O + (tokb + sq) * DM + 256 + hd * 64 + d) = o;
    }
}

DI int frag_off(int row, int k) {
  const int rt = row >> 4, fr = row & 15, ks = k >> 5, kk = k & 31, hi = kk >> 4, fq = (kk & 15) >> 2, j = (kk & 3) + 4 * hi;
  return ((rt * 2 + ks) * 64 + fq * 16 + fr) * 8 + j;
}
DI int frag_off8(int row, int k0) {
  const int rt = row >> 4, fr = row & 15, ks = k0 >> 5, kk = k0 & 31, hi = kk >> 4, fq = (kk & 15) >> 2;
  return ((rt * 2 + ks) * 64 + fq * 16 + fr) * 8 + 4 * hi;
}
DI void gdn_intra_item(const Params& p, int l, int item, char* smem) {
  const bf16_t* P = (const bf16_t*)(p.ws + OFF_P);
  const int hp = item & 1, c = (item >> 1) & 63, b = item >> 7;
  const int tid = otid(), lane = tid & 63;
  bf16_t* Kb = (bf16_t*)smem;
  bf16_t* Qb = Kb + 2 * 64 * 72;
  bf16_t* Vb = Qb + 2 * 64 * 72;
  float* Lm = (float*)(smem + 3 * 2 * 64 * 72 * 2);
  float* Gs = Lm + 2 * 4096;
  float* Bs = Gs + 128;
  const size_t tok0 = (size_t)b * SEQ + c * 64;
  const float* cw = p.in[I_GCW] + (size_t)l * 4 * 768;
  float* CW = Bs + 128;
  for (int e = tid; e < 6 * 4 * 64; e += NTHR) {
    const int blk = e >> 8, j = (e >> 6) & 3, col = e & 63;
    const int hh_ = blk / 3, which_ = blk % 3;
    CW[e] = cw[j * 768 + which_ * 256 + (hp * 2 + hh_) * 64 + col];
  }
  __syncthreads();
  {
    const int t = tid >> 3, cg = tid & 7;
#pragma unroll 3
    for (int it = 0; it < 6; ++it) {
      const int hh = it / 3, which = it % 3, head = hp * 2 + hh;
      const int ccol = which * 256 + head * 64 + cg * 8;
      float acc[8];
#pragma unroll
      for (int e = 0; e < 8; ++e) acc[e] = 0.f;
#pragma unroll
      for (int j = 0; j < 4; ++j) {
        const int s = c * 64 + t - 3 + j;
        if (s >= 0) {
          bf16x8 xv = *(const bf16x8*)(P + ((size_t)b * SEQ + s) * PSTR + C_GDN_Q + ccol);
          f32x4 wa = *(const f32x4*)(CW + (it * 4 + j) * 64 + cg * 8), wb = *(const f32x4*)(CW + (it * 4 + j) * 64 + cg * 8 + 4);
#pragma unroll
          for (int e = 0; e < 4; ++e) { acc[e] += wa[e] * bf2f((bf16_t)xv[e]); acc[e + 4] += wb[e] * bf2f((bf16_t)xv[e + 4]); }
        }
      }
      float ss = 0.f;
#pragma unroll
      for (int e = 0; e < 8; ++e) { acc[e] = siluf_(acc[e]); ss += acc[e] * acc[e]; }
      ss += __shfl_xor(ss, 1); ss += __shfl_xor(ss, 2); ss += __shfl_xor(ss, 4);
      float sc = 1.f;
      if (which == 0) sc = rsqrtf(ss + EPSF) * 0.125f;
      else if (which == 1) sc = rsqrtf(ss + EPSF);
      uint4 ov = {pack2(acc[0] * sc, acc[1] * sc), pack2(acc[2] * sc, acc[3] * sc), pack2(acc[4] * sc, acc[5] * sc), pack2(acc[6] * sc, acc[7] * sc)};
      bf16_t* dst = (which == 0 ? Qb : (which == 1 ? Kb : Vb)) + (hh * 64 + t) * 72 + cg * 8;
      *(uint4*)dst = ov;
    }
  }
  if (tid < 128) {
    const int hh = tid >> 6, t = lane, head = hp * 2 + hh;
    const float a_in = bf2f(P[(tok0 + t) * PSTR + C_GDN_A + head]);
    const float b_in = bf2f(P[(tok0 + t) * PSTR + C_GDN_B + head]);
    const float beta = sigmoidf_(b_in);
    float g = -__expf(p.in[I_GAL][l * 4 + head]) * softplusf_(a_in + p.in[I_GDT][l * 4 + head]);
#pragma unroll
    for (int d = 1; d < 64; d <<= 1) { float v = __shfl_up(g, d); if (lane >= d) g += v; }
    Gs[hh * 64 + t] = g; Bs[hh * 64 + t] = beta;
  }
  __syncthreads();
  const int hh = tid >> 8, lt = tid & 255, head = hp * 2 + hh;
  const size_t ih = ((size_t)(b * 4 + head)) * 64 + c;
  bf16_t* GW = (bf16_t*)(p.ws + OFF_G) + ih * 4096;
  bf16_t* GQD = (bf16_t*)(p.ws + OFF_G + GSZ) + ih * 4096;
  bf16_t* GQK = (bf16_t*)(p.ws + OFF_G + 2 * GSZ) + ih * 4096;
  bf16_t* GKD = (bf16_t*)(p.ws + OFF_G + 3 * GSZ) + ih * 4096;
  bf16_t* GU = (bf16_t*)(p.ws + OFF_G + 4 * GSZ) + ih * 4096;
  float* GCD = (float*)(p.ws + OFF_GCD);
  const float* Gh = Gs + hh * 64; const float* Bh = Bs + hh * 64;
  {
    const int wq = (tid >> 6) & 3, ti = wq >> 1, tj = wq & 1, r = lane & 31, h = lane >> 5;
    f32x16 akk, aqk;
#pragma unroll
    for (int i = 0; i < 16; ++i) { akk[i] = 0.f; aqk[i] = 0.f; }
    if (ti >= tj) {
#pragma unroll
      for (int ks = 0; ks < 4; ++ks) {
        bf16x8 ka = *(const bf16x8*)(Kb + (hh * 64 + 32 * ti + r) * 72 + ks * 16 + h * 8);
        bf16x8 qa = *(const bf16x8*)(Qb + (hh * 64 + 32 * ti + r) * 72 + ks * 16 + h * 8);
        bf16x8 kb = *(const bf16x8*)(Kb + (hh * 64 + 32 * tj + r) * 72 + ks * 16 + h * 8);
        akk = mfma32(ka, kb, akk);
        aqk = mfma32(qa, kb, aqk);
      }
    }
    const int j = 32 * tj + r;
    const float Gj = Gh[j];
#pragma unroll
    for (int i_ = 0; i_ < 16; ++i_) {
      const int i = 32 * ti + crow(i_, h);
      const float dec = (i >= j) ? __expf(Gh[i] - Gj) : 0.f;
      Lm[hh * 4096 + i * 64 + j] = (i > j) ? Bh[i] * akk[i_] * dec : 0.f;
      GQK[frag_off(i, j)] = f2bf((i >= j) ? aqk[i_] * dec : 0.f);
    }
  }
  __syncthreads();
  if (lt < 128) {
    const int cc = lt;
    float x[64];
    if (cc < 64) {
#pragma unroll
      for (int i = 0; i < 64; ++i) x[i] = bf2f(Vb[(hh * 64 + i) * 72 + cc]) * Bh[i];
    } else {
#pragma unroll
      for (int i = 0; i < 64; ++i) x[i] = bf2f(Kb[(hh * 64 + i) * 72 + cc - 64]) * Bh[i] * __expf(Gh[i]);
    }
    const float* Lh = Lm + hh * 4096;
#pragma unroll
    for (int i = 1; i < 64; ++i) {
      float s = x[i];
#pragma unroll
      for (int j4 = 0; j4 < (i + 3) / 4; ++j4) {
        const f32x4 lv = *(const f32x4*)(Lh + i * 64 + j4 * 4);
#pragma unroll
        for (int e = 0; e < 4; ++e) if (j4 * 4 + e < i) s -= lv[e] * x[j4 * 4 + e];
      }
      x[i] = s;
    }
    if (cc < 64) {
      const int split = cc >> 4, fr = cc & 15;
#pragma unroll
      for (int i4 = 0; i4 < 16; ++i4) {
        uint2 ov = {pack2(x[4 * i4], x[4 * i4 + 1]), pack2(x[4 * i4 + 2], x[4 * i4 + 3])};
        *(uint2*)(GU + ((split * 4 + (i4 >> 2)) * 64 + (i4 & 3) * 16 + fr) * 4) = ov;
      }
    } else {
#pragma unroll
      for (int i = 0; i < 64; ++i) GW[frag_off(i, cc - 64)] = f2bf(x[i]);
    }
  } else {
    const int q_ = lt - 128;
    const float Glast = Gh[63];
#pragma unroll
    for (int i = 0; i < 4; ++i) {
      const int q = q_ + 128 * i; const int pos = q >> 3, kc = q & 7;
      bf16x8 qv = *(const bf16x8*)(Qb + (hh * 64 + pos) * 72 + kc * 8);
      const float eg = __expf(Gh[pos]);
      uint4 ov = {pack2(bf2f((bf16_t)qv[0]) * eg, bf2f((bf16_t)qv[1]) * eg), pack2(bf2f((bf16_t)qv[2]) * eg, bf2f((bf16_t)qv[3]) * eg),
                  pack2(bf2f((bf16_t)qv[4]) * eg, bf2f((bf16_t)qv[5]) * eg), pack2(bf2f((bf16_t)qv[6]) * eg, bf2f((bf16_t)qv[7]) * eg)};
      { const int fo = frag_off8(pos, kc * 8); uint2 o0 = {ov.x, ov.y}, o1 = {ov.z, ov.w}; *(uint2*)(GQD + fo) = o0; *(uint2*)(GQD + fo + 128) = o1; }
    }
#pragma unroll
    for (int i = 0; i < 4; ++i) {
      const int q = q_ + 128 * i; const int k = q >> 3, pc = q & 7;
      float o[8];
#pragma unroll
      for (int e = 0; e < 8; ++e) { const int pos = pc * 8 + e; o[e] = bf2f(Kb[(hh * 64 + pos) * 72 + k]) * __expf(Glast - Gh[pos]); }
      uint4 ov = {pack2(o[0], o[1]), pack2(o[2], o[3]), pack2(o[4], o[5]), pack2(o[6], o[7])};
      { const int fo = frag_off8(k, pc * 8); uint2 o0 = {ov.x, ov.y}, o1 = {ov.z, ov.w}; *(uint2*)(GKD + fo) = o0; *(uint2*)(GKD + fo + 128) = o1; }
    }
    if (q_ == 0) GCD[ih] = __expf(Glast);
  }
}

DI void gdn_rec_item(const Params& p, int l, int b, int head, char* smem) {
  const bf16_t* P = (const bf16_t*)(p.ws + OFF_P);
  bf16_t* O = (bf16_t*)(p.ws + OFF_O);
  float* SS = (float*)(smem + 81920);
  const int tid = otid(), lane = tid & 63, wv = tid >> 6, fr = lane & 15, fq = lane >> 4;
  const int split = wv & 3;
  const bool active = wv < 4;
  const float ng = p.in[I_GNG][l * 64 + split * 16 + fr];
  const float* GCD = (const float*)(p.ws + OFF_GCD);
  const size_t ih0 = ((size_t)(b * 4 + head)) * 64;
  f32x4 S[4];
#pragma unroll
  for (int kt = 0; kt < 4; ++kt) S[kt] = (f32x4){0.f, 0.f, 0.f, 0.f};
  u32x4 lr[10];
#pragma unroll
  for (int i = 0; i < 10; ++i) lr[i] = (u32x4){0u, 0u, 0u, 0u};
  const int lq = (wv & 3) * 64 + lane;
#define GLOADC(c_)                                                                              \
  {                                                                                             \
    _Pragma("unroll") for (int i = 0; i < 10; ++i) {                                            \
      const int q_ = lq + 256 * i; const int a_ = q_ >> 9, o_ = q_ & 511;                       \
      lr[i] = *(const u32x4*)((const bf16_t*)(p.ws + OFF_G + (size_t)a_ * GSZ) + (ih0 + (c_)) * 4096 + o_ * 8); \
    }                                                                                           \
  }
#define LSTORE(buf_)                                                                            \
  {                                                                                             \
    _Pragma("unroll") for (int i = 0; i < 10; ++i) {                                            \
      const int q_ = lq + 256 * i;                                                              \
      *(u32x4*)(smem + (buf_) * 40960 + q_ * 16) = lr[i];                                       \
    }                                                                                           \
  }
#define BAR_LDS() { asm volatile("s_waitcnt lgkmcnt(0)" ::: "memory"); __builtin_amdgcn_s_barrier(); asm volatile("" ::: "memory"); }
  float cdn = 0.f;
  if (!active) { GLOADC(0); LSTORE(0); GLOADC(1); }
  else cdn = GCD[ih0];
  BAR_LDS();
#pragma unroll 1
  for (int c = 0; c < 64; ++c) {
    f32x4 acco[4];
    if (active) {
      const char* bufp = smem + (c & 1) * 40960;
      const float cd = cdn;
      if (c + 1 < 64) cdn = GCD[ih0 + c + 1];
      float zr[16];
#pragma unroll
      for (int rt = 0; rt < 4; ++rt)
#pragma unroll
        for (int j = 0; j < 4; ++j) {
          const size_t tok = (size_t)b * SEQ + c * 64 + 16 * rt + 4 * fq + j;
          zr[rt * 4 + j] = bf2f(P[tok * PSTR + C_GDN_Z + head * 64 + split * 16 + fr]);
        }
      bf16x8 bS[2];
#pragma unroll
      for (int ks = 0; ks < 2; ++ks) {
        uint4 uu = {pack2(S[2 * ks][0], S[2 * ks][1]), pack2(S[2 * ks][2], S[2 * ks][3]), pack2(S[2 * ks + 1][0], S[2 * ks + 1][1]), pack2(S[2 * ks + 1][2], S[2 * ks + 1][3])};
        bS[ks] = __builtin_bit_cast(bf16x8, uu);
      }
      f32x4 u[4];
#pragma unroll
      for (int rt = 0; rt < 4; ++rt) {
        f32x4 aw = {0.f, 0.f, 0.f, 0.f};
        acco[rt] = (f32x4){0.f, 0.f, 0.f, 0.f};
#pragma unroll
        for (int ks = 0; ks < 2; ++ks) {
          const bf16x8 wa = *(const bf16x8*)(bufp + ((rt * 2 + ks) * 64 + lane) * 16);
          const bf16x8 qa = *(const bf16x8*)(bufp + 8192 + ((rt * 2 + ks) * 64 + lane) * 16);
          aw = mfma16(wa, bS[ks], aw); acco[rt] = mfma16(qa, bS[ks], acco[rt]);
        }
        const s16x4 uv = *(const s16x4*)(bufp + 32768 + ((split * 4 + rt) * 64 + lane) * 8);
#pragma unroll
        for (int j = 0; j < 4; ++j) u[rt][j] = bf2f((bf16_t)uv[j]) - aw[j];
      }
      bf16x8 bU[2];
#pragma unroll
      for (int ks = 0; ks < 2; ++ks) {
        uint4 uu = {pack2(u[2 * ks][0], u[2 * ks][1]), pack2(u[2 * ks][2], u[2 * ks][3]), pack2(u[2 * ks + 1][0], u[2 * ks + 1][1]), pack2(u[2 * ks + 1][2], u[2 * ks + 1][3])};
        bU[ks] = __builtin_bit_cast(bf16x8, uu);
      }
#pragma unroll
      for (int rt = 0; rt < 4; ++rt) {
        f32x4 sn = S[rt] * cd;
#pragma unroll
        for (int ks = 0; ks < 2; ++ks) {
          const bf16x8 qa = *(const bf16x8*)(bufp + 16384 + ((rt * 2 + ks) * 64 + lane) * 16);
          const bf16x8 ka = *(const bf16x8*)(bufp + 24576 + ((rt * 2 + ks) * 64 + lane) * 16);
          acco[rt] = mfma16(qa, bU[ks], acco[rt]); sn = mfma16(ka, bU[ks], sn);
        }
        S[rt] = sn;
      }
#pragma unroll
      for (int rt = 0; rt < 4; ++rt)
#pragma unroll
        for (int j = 0; j < 4; ++j) {
          float s = acco[rt][j] * acco[rt][j];
          s += __shfl_xor(s, 1); s += __shfl_xor(s, 2); s += __shfl_xor(s, 4); s += __shfl_xor(s, 8);
          if (fr == 0) SS[(c & 1) * 256 + split * 64 + 16 * rt + 4 * fq + j] = s;
        }
      BAR_LDS();
      const float* ssb = SS + (c & 1) * 256;
#pragma unroll
      for (int rt = 0; rt < 4; ++rt)
#pragma unroll
        for (int j = 0; j < 4; ++j) {
          const int pos = 16 * rt + 4 * fq + j;
          const float tot = ssb[pos] + ssb[64 + pos] + ssb[128 + pos] + ssb[192 + pos];
          const float rn = rsqrtf(tot * (1.f / 64.f) + EPSF);
          const size_t tok = (size_t)b * SEQ + c * 64 + pos;
          O[tok * DM + 512 + head * 64 + split * 16 + fr] = f2bf(acco[rt][j] * rn * ng * siluf_(zr[rt * 4 + j]));
        }
    } else {
      if (c + 1 < 64) LSTORE((c + 1) & 1);
      if (c + 2 < 64) GLOADC(c + 2);
      BAR_LDS();
    }
  }
#undef GLOADC
#undef LSTORE
#undef BAR_LDS
}

DI void lru_item(const Params& p, int l, int item, char* smem, const int mode) {
  const bf16_t* P = (const bf16_t*)(p.ws + OFF_P);
  bf16_t* O = (bf16_t*)(p.ws + OFF_O);
  float* CA = (float*)(p.ws + OFF_LCA);
  float* CH = (float*)(p.ws + OFF_LCH);
  bf16_t* XS = (bf16_t*)smem;
  bf16_t* UB = (bf16_t*)(smem + 34816);
  const int b = item >> 6, ct = item & 63;
  const int tid = otid(), lane = tid & 63, wv = tid >> 6, r = lane & 31, h = lane >> 5, n = wv & 3, mi = wv >> 2;
  for (int i = 0; i < 5; ++i) {
    const int q = tid + NTHR * i;
    if (q < 67 * 32) {
      const int row = q >> 5, cc = q & 31;
      const int s = ct * 64 - 3 + row;
      uint4 v = {0u, 0u, 0u, 0u};
      if (s >= 0) v = *(const uint4*)(P + ((size_t)b * SEQ + s) * PSTR + C_LRU_X + cc * 8);
      *(uint4*)(XS + row * 256 + cc * 8) = v;
    }
  }
  bf16x8 bwr[2][4], bwi[2][4];
  {
    const float* wrp = p.in[I_LWR] + (((size_t)l * 4 + n) * 64) * 64 + r;
    const float* wip = p.in[I_LWI] + (((size_t)l * 4 + n) * 64) * 64 + r;
    asm volatile("" : "+v"(wrp), "+v"(wip));
#pragma unroll
    for (int ni = 0; ni < 2; ++ni)
#pragma unroll
      for (int ks = 0; ks < 4; ++ks) {
        unsigned ur[4], ui[4];
#pragma unroll
        for (int j2 = 0; j2 < 4; ++j2) {
          const int e = 16 * ks + 8 * h + 2 * j2;
          ur[j2] = pack2(wrp[e * 64 + 32 * ni], wrp[(e + 1) * 64 + 32 * ni]);
          ui[j2] = pack2(wip[e * 64 + 32 * ni], wip[(e + 1) * 64 + 32 * ni]);
        }
        uint4 t1 = {ur[0], ur[1], ur[2], ur[3]}, t2 = {ui[0], ui[1], ui[2], ui[3]};
        bwr[ni][ks] = __builtin_bit_cast(bf16x8, t1); bwi[ni][ks] = __builtin_bit_cast(bf16x8, t2);
      }
  }
  __syncthreads();
  {
    const int sc = tid >> 8, c = tid & 255;
    const float cb = p.in[I_LCB][l * 256 + c];
    const float c0 = p.in[I_LCW][(l * 4 + 0) * 256 + c], c1 = p.in[I_LCW][(l * 4 + 1) * 256 + c],
                c2 = p.in[I_LCW][(l * 4 + 2) * 256 + c], c3 = p.in[I_LCW][(l * 4 + 3) * 256 + c];
    for (int t = sc * 32; t < sc * 32 + 32; ++t)
      UB[t * 264 + c] = f2bf(cb + c0 * bf2f(XS[t * 256 + c]) + c1 * bf2f(XS[(t + 1) * 256 + c]) + c2 * bf2f(XS[(t + 2) * 256 + c]) + c3 * bf2f(XS[(t + 3) * 256 + c]));
  }
  __syncthreads();
  f32x16 ar[2], ai[2];
#pragma unroll
  for (int ni = 0; ni < 2; ++ni)
#pragma unroll
    for (int i = 0; i < 16; ++i) { ar[ni][i] = 0.f; ai[ni][i] = 0.f; }
#pragma unroll
  for (int ks = 0; ks < 4; ++ks) {
    const bf16x8 au = *(const bf16x8*)(UB + (32 * mi + r) * 264 + n * 64 + 16 * ks + 8 * h);
#pragma unroll
    for (int ni = 0; ni < 2; ++ni) { ar[ni] = mfma32(au, bwr[ni][ks], ar[ni]); ai[ni] = mfma32(au, bwi[ni][ks], ai[ni]); }
  }
  const int ck = ct * 2 + mi;
#pragma unroll
  for (int ni = 0; ni < 2; ++ni) {
    const int c = n * 64 + 32 * ni + r;
    const float brc = p.in[I_LBR][l * 256 + c], bic = p.in[I_LBI][l * 256 + c];
    const float lamsp = softplusf_(-p.in[I_LLAM][l * 256 + c]);
    float av[16], bv[16];
#pragma unroll
    for (int i = 0; i < 16; ++i) {
      const int tl = 32 * mi + crow(i, h);
      const float u = bf2f(UB[tl * 264 + c]);
      const float rg = sigmoid_rcp(ar[ni][i] + brc), ig = sigmoid_rcp(ai[ni][i] + bic);
      const float la = -8.f * rg * lamsp;
      av[i] = __expf(la);
      bv[i] = __builtin_amdgcn_sqrtf(fmaxf(0.f, 1.f - __expf(2.f * la))) * (ig * u);
    }
    float GA[4], GB[4], PA[4], PB[4];
#pragma unroll
    for (int q = 0; q < 4; ++q) {
      float A = 1.f, hh = 0.f;
#pragma unroll
      for (int e = 0; e < 4; ++e) { hh = av[4 * q + e] * hh + bv[4 * q + e]; A *= av[4 * q + e]; }
      GA[q] = A; GB[q] = hh;
      PA[q] = __shfl_xor(A, 32); PB[q] = __shfl_xor(hh, 32);
    }
    float cin = 0.f;
    if (mode == 1) {
      const int lo = h ? (ck >> 1) : 0, hi = h ? ck : (ck >> 1);
      float A = 1.f, hh = 0.f;
      const float* ca = CA + ((size_t)b * 128) * 256 + c;
      const float* chp = CH + ((size_t)b * 128) * 256 + c;
      int k = lo;
      for (; k + 8 <= hi; k += 8) {
        float a8[8], h8[8];
#pragma unroll
        for (int e = 0; e < 8; ++e) { a8[e] = ca[(size_t)(k + e) * 256]; h8[e] = chp[(size_t)(k + e) * 256]; }
#pragma unroll
        for (int e = 0; e < 8; ++e) { hh = a8[e] * hh + h8[e]; A *= a8[e]; }
      }
      for (; k < hi; ++k) { const float a_ = ca[(size_t)k * 256], h_ = chp[(size_t)k * 256]; hh = a_ * hh + h_; A *= a_; }
      const float pAx = __shfl_xor(A, 32), pHx = __shfl_xor(hh, 32);
      cin = h ? (A * pHx + hh) : (pAx * hh + pHx);
    }
    float cg = cin, Ap = 1.f, myc[4];
#pragma unroll
    for (int q = 0; q < 4; ++q) {
      const float Ae = h ? PA[q] : GA[q], Be = h ? PB[q] : GB[q];
      const float Ao = h ? GA[q] : PA[q], Bo = h ? GB[q] : PB[q];
      const float c_even = cg;
      cg = Ae * cg + Be;
      const float c_odd = cg;
      cg = Ao * cg + Bo;
      myc[q] = h ? c_odd : c_even;
      Ap *= Ae * Ao;
    }
    if (mode == 0) {
      if (h == 0) { CA[((size_t)b * 128 + ck) * 256 + c] = Ap; CH[((size_t)b * 128 + ck) * 256 + c] = cg; }
    } else {
#pragma unroll
      for (int q = 0; q < 4; ++q) {
        float hh = myc[q];
#pragma unroll
        for (int e = 0; e < 4; ++e) {
          const int i = 4 * q + e;
          hh = av[i] * hh + bv[i];
          const size_t tok = (size_t)b * SEQ + ct * 64 + 32 * mi + crow(i, h);
          const float y = bf2f(P[tok * PSTR + C_LRU_Y + c]);
          O[tok * DM + c] = f2bf(hh * gelu_rcp(y));
        }
      }
    }
  }
}

#define XB_TMO      128
#define XB_XCNT(j)  (256  + 64 * (j))
#define XB_XSUB(j)  (1280 + 64 * (j))
#define XB_XGEN(j)  (2304 + 64 * (j))
#define XB_TOP      3328
#define XB_TOPGEN   3392
#define XCD_BAR_WORDS 3456
#define XB_SPIN_CAP (1u << 18)
#define XLAS __attribute__((address_space(3)))
DI unsigned xb_ld(unsigned* p)              { return __hip_atomic_load(p, __ATOMIC_RELAXED, __HIP_MEMORY_SCOPE_AGENT); }
DI unsigned xb_add(unsigned* p, unsigned v) { return __hip_atomic_fetch_add(p, v, __ATOMIC_RELAXED, __HIP_MEMORY_SCOPE_AGENT); }
DI unsigned xb_xcc_id() { return (unsigned)__builtin_amdgcn_s_getreg((3 << 11) | 20) & 0xFu; }
#define XB_SPIN(cond, bar) do { unsigned _sp = 0; while (cond) { __builtin_amdgcn_s_sleep(1); \
    if ((++_sp & 255u) == 0u) { if (xb_ld(&(bar)[XB_TMO])) break; if (_sp > XB_SPIN_CAP) { atomicAdd(&(bar)[XB_TMO], 1u); break; } } } } while (0)
struct XcdBarrier { unsigned* bar; unsigned x; volatile XLAS unsigned* st; };
DI XcdBarrier xcd_barrier_post(unsigned* bar, volatile XLAS unsigned* st) {
  XcdBarrier b; b.bar = bar; b.x = xb_xcc_id(); b.st = st;
  if (threadIdx.x == 0) (void)xb_add(&bar[XB_XCNT(b.x)], 1u);
  return b;
}
DI void xcd_barrier_complete(unsigned* bar, unsigned x, unsigned& nloc, unsigned& nx) {
  const unsigned G = gridDim.x * gridDim.y * gridDim.z;
  unsigned sum, cnt, mine, sp = 0u;
  for (;;) {
    sum = 0u; cnt = 0u; mine = 0u;
#pragma unroll
    for (unsigned j = 0; j < 16; ++j) { const unsigned c = xb_ld(&bar[XB_XCNT(j)]); sum += c; cnt += (c > 0u) ? 1u : 0u; mine = (j == x) ? c : mine; }
    if (sum == G) break;
    __builtin_amdgcn_s_sleep(1);
    if ((++sp & 255u) == 0u) { if (xb_ld(&bar[XB_TMO])) break; if (sp > XB_SPIN_CAP) { atomicAdd(&bar[XB_TMO], 1u); break; } }
  }
  nloc = mine > 0u ? mine : 1u; nx = cnt > 0u ? cnt : 1u;
}
DI void xcd_barrier(const XcdBarrier& b) {
  asm volatile("s_waitcnt vmcnt(0)" ::: "memory");
  __syncthreads();
  if (threadIdx.x == 0) {
    unsigned* bar = b.bar;
    __builtin_amdgcn_s_waitcnt(0);
    unsigned nloc = b.st[0], nx = b.st[1];
    if (nloc == 0u) { xcd_barrier_complete(bar, b.x, nloc, nx); b.st[0] = nloc; b.st[1] = nx; }
    const unsigned old = xb_add(&bar[XB_XSUB(b.x)], 1u);
    const unsigned gen = old / nloc;
    if (old + 1u == (gen + 1u) * nloc) {
      __builtin_amdgcn_fence(__ATOMIC_RELEASE, "agent");
      asm volatile("s_waitcnt vmcnt(0)" ::: "memory");
      const unsigned og = xb_add(&bar[XB_TOP], 1u);
      const unsigned tg = og / nx;
      if (og + 1u == (tg + 1u) * nx) xb_add(&bar[XB_TOPGEN], 1u);
      else XB_SPIN(xb_ld(&bar[XB_TOPGEN]) == tg, bar);
      __builtin_amdgcn_fence(__ATOMIC_ACQUIRE, "agent");
      xb_add(&bar[XB_XGEN(b.x)], 1u);
      asm volatile("s_waitcnt vmcnt(0)" ::: "memory");
    } else {
      XB_SPIN(xb_ld(&bar[XB_XGEN(b.x)]) == gen, bar);
      __builtin_amdgcn_fence(__ATOMIC_ACQUIRE, "agent");
      asm volatile("s_waitcnt vmcnt(0)" ::: "memory");
    }
  }
  __syncthreads();
}

__global__ void __launch_bounds__(NTHR) mega(Params p) {
  extern __shared__ __attribute__((aligned(16))) char smem[];
  cg::grid_group grid = cg::this_grid();
  const int tid = threadIdx.x;
  bf16_t* H = (bf16_t*)(p.ws + OFF_H);
  bf16_t* PB = (bf16_t*)(p.ws + OFF_P);
  PG_LAS unsigned char* lds = (PG_LAS unsigned char*)smem;
  volatile XLAS unsigned* xst = (volatile XLAS unsigned*)(smem + 131072);
  if (tid < 2) xst[tid] = 0u;
  __syncthreads();
  const XcdBarrier xb = xcd_barrier_post((unsigned*)(p.ws + OFF_BAR), xst);

  for (int rep = 0; rep < REP_MISC; ++rep) {
  if (MASK & 1) phase_mod(p, smem);
  grid.sync();
  }
  for (int l = 0; l < 4; ++l) {
    const float* xcur = (l == 0) ? p.in[I_X] : p.out;
    for (int rep = 0; rep < REP_MISC; ++rep) {
    if (MASK & 2) phase_convert(p, l, smem);
    if (MASK & 4) phase_norm(p, xcur, p.in[I_N1G] + l * 1024, l, 1024, 0, H, nullptr);
    xcd_barrier(xb);
    }
    for (int rep = 0; rep < REP_G; ++rep) {
    if (MASK & 8) { pg::Order<1> S; S.init(NTOK, PSTR, gridDim.x, blockIdx.x); pg::EpiBf16<0> E{PB, PSTR, nullptr};
      pg::gemm_phase(lds, H, DM, (const bf16_t*)(p.ws + OFF_WIN), 1024, S, E); }
    xcd_barrier(xb);
    }
    for (int rep = 0; rep < REP_M1; ++rep) {
    for (int it = blockIdx.x; it < 5120; it += gridDim.x) {
      if (it < 2048) { if (MASK & 32) gdn_intra_item(p, l, it, smem); }
      else if (it < 3072) { }
      else if (it < 4096) { if (MASK & 128) lru_item(p, l, it - 3072, smem, 0); }
      else { if (MASK & 16) rw_prep_item(p, l, it - 4096, smem); }
      __syncthreads();
    }
    xcd_barrier(xb);
    }
    for (int rep = 0; rep < REP_M2; ++rep) {
    if (blockIdx.x < 128) {
      { const int pid_ = (blockIdx.x & 7) + 8 * (blockIdx.x >> 4), half_ = (blockIdx.x >> 3) & 1;
        if (MASK & 16) rwkv_scan_item(p, l, pid_ >> 2, pid_ & 3, half_, smem); }
    } else {
      if (blockIdx.x < 192) { if (MASK & 256) gdn_rec_item(p, l, (blockIdx.x - 128) >> 2, (blockIdx.x - 128) & 3, smem); }
      unsigned* ctr = (unsigned*)(p.ws + OFF_CTR) + l * 4 + rep;
      volatile int* slot = (volatile int*)(smem + 110016);
      for (;;) {
        __syncthreads();
        if (tid == 0) *slot = (int)atomicAdd(ctr, 1u);
        __syncthreads();
        const int it = *slot;
        if (it >= 2048) break;
        if (it < 1024) { if (MASK & 64) sb_item(p, it, smem); }
        else { if (MASK & 512) lru_item(p, l, it - 1024, smem, 1); }
      }
    }
    xcd_barrier(xb);
    }
    for (int rep = 0; rep < REP_G; ++rep) {
    for (int half = 0; half < 4; ++half) {
      bf16_t* BH = (bf16_t*)(p.ws + OFF_P + 134217728);
      if (half == 0 && rep == 0) { if (MASK & 16) rwkv_post(p, l); xcd_barrier(xb); }
      if (MASK & 1024) { pg::Order<1> S; S.init(NTOK / 4, 4096, gridDim.x, blockIdx.x, 0, 0, 2, 512); pg::EpiBf16<0> E{BH, 4096, nullptr};
        pg::gemm_phase(lds, (const bf16_t*)(p.ws + OFF_O) + (size_t)half * 16384 * DM, DM, (const bf16_t*)(p.ws + OFF_WBR), 256, S, E); }
      xcd_barrier(xb);
      if (MASK & 1024) { pg::Order<4> S; S.init(NTOK / 4, 1024, gridDim.x, blockIdx.x, 0, 2097152); pg::EpiGateMix E{PB + (size_t)half * 16384 * DM, (float*)(p.ws + OFF_G), BH, p.in[I_BGATE] + (size_t)l * 4096};
        pg::gemm_phase(lds, H + (size_t)half * 16384 * DM, DM, (const bf16_t*)(p.ws + OFF_WG), 1024, S, E); }
      xcd_barrier(xb);
    }
    }
    if (MASK & 2048) { pg::Order<1> S; S.init(NTOK, 1024, gridDim.x, blockIdx.x); pg::EpiResid E{xcur, p.out, (const float*)(p.ws + OFF_MODP), p.in[I_BADA], l, 2048};
      pg::gemm_phase(lds, PB, DM, (const bf16_t*)(p.ws + OFF_WO), 1024, S, E); }
    xcd_barrier(xb);
    for (int rep = 0; rep < REP_MISC; ++rep) {
    if (MASK & 4096) phase_norm(p, p.out, p.in[I_N2G] + l * 1024, l, 4096, 3072, H, nullptr);
    xcd_barrier(xb);
    }
    for (int rep = 0; rep < REP_G; ++rep) {
    if (MASK & 8192) { pg::Order<1> S; S.init(NTOK, FFN, gridDim.x, blockIdx.x); pg::EpiBf16<0> E{PB, FFN, nullptr};
      pg::gemm_phase(lds, H, DM, (const bf16_t*)(p.ws + OFF_WF), 1024, S, E); }
    xcd_barrier(xb);
    if (MASK & 8192) { pg::Order<1> S; S.init(NTOK, FFN, gridDim.x, blockIdx.x); pg::EpiFfnAct E{PB + (size_t)NTOK * FFN, PB, p.in[I_FCW] + (size_t)l * 3 * FFN};
      pg::gemm_phase(lds, H, DM, (const bf16_t*)(p.ws + OFF_WF) + (size_t)FFN * 1024, 1024, S, E); }
    xcd_barrier(xb);
    }
    if (MASK & 32768) { pg::Order<1> S; S.init(NTOK, 1024, gridDim.x, blockIdx.x); pg::EpiResid E{p.out, p.out, (const float*)(p.ws + OFF_MODP), p.in[I_BADA], l, 5120};
      pg::gemm_phase(lds, PB + (size_t)NTOK * FFN, FFN, (const bf16_t*)(p.ws + OFF_WD), FFN, S, E); }
    xcd_barrier(xb);
  }
  if (MASK & 65536) phase_norm(p, p.out, p.in[I_FG], 0, 0, 0, nullptr, p.out);
}

extern "C" void kernel_launch(void* const* d_in, const int* in_sizes, int n_in,
                              void* d_out, int out_size, void* d_ws, size_t ws_size,
                              hipStream_t stream) {
  if (ws_size < WS_NEED || n_in < 38) { fprintf(stderr, "workspace too small: %zu < %zu\n", ws_size, (size_t)WS_NEED); return; }
  (void)hipFuncSetAttribute((const void*)mega, hipFuncAttributeMaxDynamicSharedMemorySize, SMEM_BYTES);
  int dev = 0, cus = 0, per_cu = 0;
  (void)hipGetDevice(&dev);
  (void)hipDeviceGetAttribute(&cus, hipDeviceAttributeMultiprocessorCount, dev);
  (void)hipOccupancyMaxActiveBlocksPerMultiprocessor(&per_cu, mega, NTHR, SMEM_BYTES);
  if (per_cu < 1 || cus < 1) { fprintf(stderr, "occupancy query failed (%d, %d)\n", per_cu, cus); return; }
  if (cus > 256) cus = 256;
  const int grid_blocks = cus;
  Params p{};
  for (int i = 0; i < 38; ++i) p.in[i] = (const float*)d_in[i];
  p.out = (float*)d_out; p.ws = (char*)d_ws;
  (void)hipMemsetAsync((char*)d_ws + OFF_BAR, 0, XCD_BAR_WORDS * 4, stream);
  void* args[] = {&p};
  hipError_t e = hipLaunchCooperativeKernel((void*)mega, dim3(grid_blocks), dim3(NTHR), args, SMEM_BYTES, stream);
  if (e != hipSuccess) fprintf(stderr, "cooperative launch failed: %s (grid %d)\n", hipGetErrorString(e), grid_blocks);
}
```

```cpp
#include <hip/hip_runtime.h>
#include <hip/hip_cooperative_groups.h>
#include <cstdio>
namespace cg = cooperative_groups;

typedef unsigned short bf16_t;
typedef short bf16x8 __attribute__((ext_vector_type(8)));
typedef short s16x4 __attribute__((ext_vector_type(4)));
typedef float f32x4 __attribute__((ext_vector_type(4)));
typedef float f32x16 __attribute__((ext_vector_type(16)));
typedef unsigned u32x4 __attribute__((ext_vector_type(4)));
#define DI __device__ __forceinline__

constexpr int NTOK = 65536, DM = 1024, SEQ = 4096, PSTR = 3328, FFN = 2816, AUS = 5632;
constexpr int C_LRU_X = 0, C_LRU_Y = 256, C_SB_Q = 512, C_SB_K = 768, C_SB_V = 1024;
constexpr int C_GDN_Q = 1280, C_GDN_Z = 2048, C_GDN_A = 2304, C_GDN_B = 2308, C_RW = 2312;
constexpr float EPSF = 1e-6f;
#ifndef MASK
#define MASK 0x1ffff
#endif
#ifndef REP_M1
#define REP_M1 1
#endif
#ifndef REP_M2
#define REP_M2 1
#endif
#ifndef REP_G
#define REP_G 1
#endif
#ifndef REP_MISC
#define REP_MISC 1
#endif
constexpr int NTHR = 512;
constexpr int SMEM_BYTES = 131072 + 64;

constexpr size_t OFF_MODP = 0;
constexpr size_t OFF_WIN = 6291456;
constexpr size_t OFF_WG = OFF_WIN + 6815744;
constexpr size_t OFF_WBR = OFF_WG + 8388608;
constexpr size_t OFF_WO = OFF_WBR + 2097152;
constexpr size_t OFF_WF = OFF_WO + 2097152;
constexpr size_t OFF_WD = OFF_WF + 11534336;
constexpr size_t OFF_H = OFF_WD + 5767168;
constexpr size_t OFF_P = OFF_H + 134217728;
constexpr size_t OFF_O = OFF_P + 436207616;
constexpr size_t OFF_G = OFF_O + 134217728;
constexpr size_t GSZ = 33554432;
constexpr size_t OFF_GCD = OFF_G + 5 * GSZ;
constexpr size_t OFF_L = OFF_GCD + 16384;
constexpr size_t LSZ = 67108864;
constexpr size_t OFF_LCA = OFF_L + 2 * LSZ;
constexpr size_t OFF_LCH = OFF_LCA + 2097152;
constexpr size_t OFF_BON = OFF_LCH + 2097152;
constexpr size_t OFF_CTR = OFF_BON + 1048576;
constexpr size_t OFF_BAR = OFF_CTR + 256;
constexpr size_t OFF_C12 = OFF_BAR + 16384;
constexpr size_t WS_NEED = OFF_C12 + 2097152;

struct Params { const float* in[38]; float* out; char* ws; };
enum { I_X = 0, I_C, I_N1G, I_N2G, I_FG, I_WADA, I_BADA, I_WIN, I_LCW, I_LCB, I_LWR, I_LBR, I_LWI, I_LBI, I_LLAM,
       I_GCW, I_GAL, I_GDT, I_GNG, I_RMU, I_RW0, I_RWUP, I_RA0, I_RAUP, I_RGUP, I_RKK, I_RKA, I_RRK, I_RLG, I_RLB,
       I_WBR, I_WGATE, I_BGATE, I_WOUT, I_FWG, I_FWU, I_FCW, I_FWD };

DI float bf2f(bf16_t v) { return __uint_as_float(((unsigned)v) << 16); }
typedef __bf16 bf16n2 __attribute__((ext_vector_type(2)));
typedef float f32x2_ __attribute__((ext_vector_type(2)));
DI unsigned pack2(float lo, float hi) { f32x2_ v = {lo, hi}; bf16n2 b = __builtin_convertvector(v, bf16n2); return __builtin_bit_cast(unsigned, b); }
DI bf16_t f2bf(float x) { return (bf16_t)(pack2(x, x) & 0xffffu); }
DI float sigmoidf_(float x) { return __builtin_amdgcn_rcpf(1.f + __expf(-x)); }
DI float sigmoid_rcp(float x) { return __builtin_amdgcn_rcpf(1.f + __expf(-x)); }
DI float gelu_rcp(float x) { float u = 0.7978845608f * (x + 0.044715f * x * x * x); return x * __builtin_amdgcn_rcpf(1.f + __expf(-2.f * u)); }
DI float softplusf_(float x) { return fmaxf(x, 0.f) + __logf(1.f + __expf(-fabsf(x))); }
DI float siluf_(float x) { return x * __builtin_amdgcn_rcpf(1.f + __expf(-x)); }
DI float geluf_(float x) { float u = 0.7978845608f * (x + 0.044715f * x * x * x); return x * __builtin_amdgcn_rcpf(1.f + __expf(-2.f * u)); }
DI float tanhf_(float x) { return 1.f - 2.f * __builtin_amdgcn_rcpf(1.f + __expf(2.f * x)); }
DI float wave_sum(float x) {
#pragma unroll
  for (int o = 32; o >= 1; o >>= 1) x += __shfl_xor(x, o);
  return x;
}
template <int CTRL> DI float dppf(float x) { return __int_as_float(__builtin_amdgcn_update_dpp(0, __float_as_int(x), CTRL, 0xf, 0xf, true)); }
DI float reduce8(float x) { x += dppf<0xB1>(x); x += dppf<0x4E>(x); x += dppf<0x141>(x); return x; }
DI f32x16 mfma32(bf16x8 a, bf16x8 b, f32x16 c) { return __builtin_amdgcn_mfma_f32_32x32x16_bf16(a, b, c, 0, 0, 0); }
DI f32x4 mfma16(bf16x8 a, bf16x8 b, f32x4 c) { return __builtin_amdgcn_mfma_f32_16x16x32_bf16(a, b, c, 0, 0, 0); }
DI int crow(int i, int h) { return (i & 3) + 8 * (i >> 2) + 4 * h; }

DI float modv(const float* modp, const float* bada, int l, int b, int idx) {
  const float* q = modp + ((size_t)(l * 16 + b)) * 6144 + idx;
  const size_t ks = (size_t)4 * 16 * 6144;
  return bada[l * 6144 + idx] + q[0] + q[ks] + q[2 * ks] + q[3 * ks];
}

DI int otid() { int t = threadIdx.x; asm volatile("" : "+v"(t)); return t; }
DI int obid() { int b = blockIdx.x; asm volatile("" : "+s"(b)); return b; }
DI void phase_mod(const Params& p, char* smem) {
  float* sm = (float*)smem;
  float* modp = (float*)(p.ws + OFF_MODP);
  const int tid = otid();
  if (obid() == 0 && tid < 64) ((unsigned*)(p.ws + OFF_CTR))[tid] = 0u;
  for (int item = obid(); item < 192; item += gridDim.x) {
    const int l = item / 48, rem = item % 48, jb = rem >> 2, kq = rem & 3;
    for (int i = 0; i < 8; ++i) {
      int e = tid + 512 * i; int b = e >> 8, k = e & 255;
      float cv = p.in[I_C][b * 1024 + kq * 256 + k];
      sm[e] = siluf_(cv);
    }
    __syncthreads();
    float acc[16];
#pragma unroll
    for (int b = 0; b < 16; ++b) acc[b] = 0.f;
    const float* wp = p.in[I_WADA] + ((size_t)l * 1024 + kq * 256) * 6144 + jb * 512 + tid;
    for (int k = 0; k < 256; k += 4) {
      float w0 = wp[(size_t)k * 6144], w1 = wp[(size_t)(k + 1) * 6144], w2 = wp[(size_t)(k + 2) * 6144], w3 = wp[(size_t)(k + 3) * 6144];
#pragma unroll
      for (int b = 0; b < 16; ++b) {
        f32x4 cv = *(const f32x4*)(sm + b * 256 + k);
        acc[b] += cv[0] * w0 + cv[1] * w1 + cv[2] * w2 + cv[3] * w3;
      }
    }
#pragma unroll
    for (int b = 0; b < 16; ++b) modp[((size_t)((kq * 4 + l) * 16 + b)) * 6144 + jb * 512 + tid] = acc[b];
    __syncthreads();
  }
}

DI void conv_tile(const float* src, bf16_t* dst, int K, int N, int k0, int n0, char* smem) {
  float* tile = (float*)smem;
  const int tid = otid();
#pragma unroll
  for (int it = 0; it < 2; ++it) {
    int kr = (tid >> 4) + 32 * it, nc = (tid & 15) * 4;
    f32x4 v = {0.f, 0.f, 0.f, 0.f};
    if (n0 + nc < N) v = *(const f32x4*)(src + (size_t)(k0 + kr) * N + n0 + nc);
    tile[kr * 65 + nc] = v[0]; tile[kr * 65 + nc + 1] = v[1]; tile[kr * 65 + nc + 2] = v[2]; tile[kr * 65 + nc + 3] = v[3];
  }
  __syncthreads();
  {
    int n = tid >> 3, kc = (tid & 7) * 8;
    unsigned o[4];
#pragma unroll
    for (int e = 0; e < 4; ++e) o[e] = pack2(tile[(kc + 2 * e) * 65 + n], tile[(kc + 2 * e + 1) * 65 + n]);
    uint4 ov = {o[0], o[1], o[2], o[3]};
    *(uint4*)(dst + (size_t)(n0 + n) * K + k0 + kc) = ov;
  }
  __syncthreads();
}

DI void phase_convert(const Params& p, int l, char* smem) {
  for (int t = obid(); t < 4480; t += gridDim.x) {
    const float* src; bf16_t* dst; int K, N, Npad, tt = t;
    if (tt < 832) { src = p.in[I_WIN] + (size_t)l * 1024 * 3208; dst = (bf16_t*)(p.ws + OFF_WIN); K = 1024; N = 3208; Npad = 3328; }
    else if ((tt -= 832) < 1024) { int br = tt >> 8; tt &= 255; src = p.in[I_WGATE] + ((size_t)l * 4 + br) * 1048576; dst = (bf16_t*)(p.ws + OFF_WG) + (size_t)br * 1048576; K = 1024; N = 1024; Npad = 1024; }
    else if ((tt -= 1024) < 256) { int br = tt >> 6; tt &= 63; src = p.in[I_WBR] + ((size_t)l * 4 + br) * 262144; dst = (bf16_t*)(p.ws + OFF_WBR) + (size_t)br * 262144; K = 256; N = 1024; Npad = 1024; }
    else if ((tt -= 256) < 256) { src = p.in[I_WOUT] + (size_t)l * 1048576; dst = (bf16_t*)(p.ws + OFF_WO); K = 1024; N = 1024; Npad = 1024; }
    else if ((tt -= 256) < 704) { src = p.in[I_FWG] + (size_t)l * 1024 * 2816; dst = (bf16_t*)(p.ws + OFF_WF); K = 1024; N = 2816; Npad = 2816; }
    else if ((tt -= 704) < 704) { src = p.in[I_FWU] + (size_t)l * 1024 * 2816; dst = (bf16_t*)(p.ws + OFF_WF) + (size_t)2816 * 1024; K = 1024; N = 2816; Npad = 2816; }
    else { tt -= 704; src = p.in[I_FWD] + (size_t)l * 2816 * 1024; dst = (bf16_t*)(p.ws + OFF_WD); K = 2816; N = 1024; Npad = 1024; }
    const int nNt = Npad >> 6;
    const int kt = tt / nNt, nt = tt % nNt;
    conv_tile(src, dst, K, N, kt * 64, nt * 64, smem);
  }
}

DI void phase_norm(const Params& p, const float* xin, const float* g, int l, int scale_idx, int shift_idx, bf16_t* hout, float* fout) {
  const float* modp = (const float*)(p.ws + OFF_MODP);
  const int lane = otid() & 63, wv = otid() >> 6;
  const int nw = gridDim.x * 8;
  const int rows_per = 32;
  for (int chunk = obid() * 8 + wv; chunk < NTOK / 32; chunk += nw) {
  const int row0 = chunk * rows_per;
  const int b = row0 / SEQ;
  f32x4 gv[4], sc[4], sh[4];
#pragma unroll
  for (int j = 0; j < 4; ++j) {
    int c = lane * 4 + 256 * j;
    gv[j] = *(const f32x4*)(g + c);
    if (hout) {
#pragma unroll
      for (int e = 0; e < 4; ++e) {
        sc[j][e] = 1.f + modv(modp, p.in[I_BADA], l, b, scale_idx + c + e);
        sh[j][e] = modv(modp, p.in[I_BADA], l, b, shift_idx + c + e);
      }
    }
  }
  for (int rr = 0; rr < rows_per; ++rr) {
    const size_t row = (size_t)row0 + rr;
    f32x4 xv[4]; float ss = 0.f;
#pragma unroll
    for (int j = 0; j < 4; ++j) {
      xv[j] = *(const f32x4*)(xin + row * DM + lane * 4 + 256 * j);
      ss += xv[j][0] * xv[j][0] + xv[j][1] * xv[j][1] + xv[j][2] * xv[j][2] + xv[j][3] * xv[j][3];
    }
    ss = wave_sum(ss);
    const float rs = rsqrtf(ss * (1.f / 1024.f) + EPSF);
#pragma unroll
    for (int j = 0; j < 4; ++j) {
      f32x4 y = xv[j] * rs * gv[j];
      if (hout) {
        y = y * sc[j] + sh[j];
        uint2 o = {pack2(y[0], y[1]), pack2(y[2], y[3])};
        *(uint2*)(hout + row * DM + lane * 4 + 256 * j) = o;
      } else {
        *(f32x4*)(fout + row * DM + lane * 4 + 256 * j) = y;
      }
    }
  }
  }
}

#define PG_LAS __attribute__((address_space(3)))
namespace pg {
constexpr int BM = 256, BK = 64, HALF = 128, HTB = HALF * BK * 2, NXCD = 8, WGM = 8;
DI int lds_byte(int r, int c) { const int st = (r >> 4) * 2 + (c >> 5), rr = r & 15, cc = c & 31, ob = rr * 64 + cc * 2; return st * 1024 + (ob ^ (((ob >> 9) & 1) << 5)); }
DI void stage_rc(int b, int& R, int& C) { const int st = b / 1024, sb = b % 1024, swz = sb ^ (((sb >> 9) & 1) << 5); R = (st >> 1) * 16 + swz / 64; C = (st & 1) * 32 + (swz % 64) / 2; }
DI int perm32(int rho) { const int n = rho >> 4, i = rho & 15; return 8 * (i >> 2) + 4 * n + (i & 3); }
struct Unit { int pm, pn; int aux; long ao, bo; };
template <int REP> struct Order {
  int nM, nN, nwg, G, c, ashift; long astep, bstep, apnstep;
  DI void init(int M, int N, int G_, int c_, long astep_ = 0, long bstep_ = 0, int ashift_ = 0, long apnstep_ = 0) {
    nM = M / BM; nN = N / BM; nwg = nM * nN; G = G_; c = c_; astep = astep_; bstep = bstep_; ashift = ashift_; apnstep = apnstep_; }
  DI bool next(int i, Unit& u) const {
    const int ti = i / REP, aux = i % REP;
    const long L = (long)ti * G + c; if (L >= nwg) return false;
    int wgid = (int)L; { const int q = nwg / NXCD, r = nwg % NXCD, xcd = wgid % NXCD, off = wgid / NXCD; wgid = (xcd < r ? xcd * (q + 1) : r * (q + 1) + (xcd - r) * q) + off; }
    const int nig = WGM * nN, gid = wgid / nig, fm = gid * WGM, gsz = (nM - fm) < WGM ? (nM - fm) : WGM;
    u.pm = fm + ((wgid % nig) % gsz); u.pn = (wgid % nig) / gsz; u.aux = aux; u.ao = aux * astep + (long)(u.pn >> ashift) * apnstep; u.bo = aux * bstep; return true;
  }
};
DI unsigned cvt_pk_bf16(float lo, float hi) { return pack2(lo, hi); }

template <class Epi, class Sched>
DI void gemm_phase(PG_LAS unsigned char* lds, const bf16_t* Ag, int lda, const bf16_t* Bg, int K, const Sched& S, const Epi& E) {
  const int tid = otid(), wid = __builtin_amdgcn_readfirstlane(tid >> 6), lane = tid & 63, wr = wid >> 2, wc = wid & 3, fr = lane & 15, fq = lane >> 4;
  const int nt = K / BK;
  unsigned voffA[2], voffB[2];
#pragma unroll
  for (int i = 0; i < 2; ++i) { int R, C; stage_rc(tid * 16 + i * 8192, R, C); const int Rb = Epi::PERM ? ((R & ~31) + perm32(R & 31)) : R;
    voffA[i] = (unsigned)(R * lda + C) * 2u; voffB[i] = (unsigned)(Rb * K + C) * 2u; }
  const size_t kstep = (size_t)(BK * 2);
  const size_t hstepA = (size_t)HALF * lda * 2, hstepB = (size_t)HALF * K * 2;
  const size_t tstepA = 2 * hstepA, tstepB = 2 * hstepB;
  const unsigned ldsw = (unsigned)wid * 1024u;
  const int aoff = lds_byte(wr * 64 + fr, fq * 8), boff = lds_byte(wc * 32 + fr, fq * 8);
#define PG_SA(b, h) (((b) * 2 + (h)) * HTB)
#define PG_SB(b, h) ((4 + (b) * 2 + (h)) * HTB)
#define PG_STAGE(bufoff, gbase, voff) do { _Pragma("unroll") for (int _i = 0; _i < 2; ++_i) \
    __builtin_amdgcn_global_load_lds((const unsigned*)((const char*)(gbase) + (voff)[_i]), (PG_LAS unsigned*)(lds + (bufoff) + ldsw + _i * 8192), 16, 0, 0); } while (0)
#define PG_LDA(dst, b, h) do { _Pragma("unroll") for (int m = 0; m < 4; ++m) _Pragma("unroll") for (int k = 0; k < 2; ++k) dst[m][k] = *(const PG_LAS bf16x8*)(lds + PG_SA(b, h) + aoff + m * 2048 + k * 1024); } while (0)
#define PG_LDB(dst, b, h) do { _Pragma("unroll") for (int n = 0; n < 2; ++n) _Pragma("unroll") for (int k = 0; k < 2; ++k) dst[n][k] = *(const PG_LAS bf16x8*)(lds + PG_SB(b, h) + boff + n * 2048 + k * 1024); } while (0)
#define PG_MMA(ai, bj, At, Bt) do { __builtin_amdgcn_s_setprio(1); _Pragma("unroll") for (int m = 0; m < 4; ++m) _Pragma("unroll") for (int n = 0; n < 2; ++n) _Pragma("unroll") for (int k = 0; k < 2; ++k) \
    acc[ai][bj][m][n] = __builtin_amdgcn_mfma_f32_16x16x32_bf16(Bt[n][k], At[m][k], acc[ai][bj][m][n], 0, 0, 0); __builtin_amdgcn_s_setprio(0); } while (0)
#define PG_WAIT_V(n) asm volatile("s_waitcnt vmcnt(" #n ")" ::: "memory")
#define PG_WAIT_L(n) asm volatile("s_waitcnt lgkmcnt(" #n ")" ::: "memory")
#define PG_BAR __builtin_amdgcn_s_barrier()
#define PG_SCHED __builtin_amdgcn_sched_barrier(0)
  Unit cur, nxt; int ui = 0;
  if (!S.next(0, cur)) return;
  f32x4 acc[2][2][4][2];
#pragma unroll
  for (int a = 0; a < 2; ++a)
#pragma unroll
    for (int b = 0; b < 2; ++b)
#pragma unroll
      for (int m = 0; m < 4; ++m)
#pragma unroll
        for (int n = 0; n < 2; ++n) acc[a][b][m][n] = (f32x4){0.f, 0.f, 0.f, 0.f};
  bf16x8 At[4][2], B0[2][2], B1[2][2];
  const char* cA = (const char*)Ag + (size_t)cur.pm * tstepA + cur.ao; const char* cB = (const char*)Bg + (size_t)cur.pn * tstepB + cur.bo;
  PG_STAGE(PG_SB(0, 0), cB, voffB); PG_STAGE(PG_SA(0, 0), cA, voffA); PG_STAGE(PG_SB(0, 1), cB + hstepB, voffB); PG_STAGE(PG_SA(0, 1), cA + hstepA, voffA);
  if (wr == 1) PG_BAR;
  PG_WAIT_V(4); PG_BAR;
  PG_STAGE(PG_SB(1, 0), cB + kstep, voffB); PG_STAGE(PG_SA(1, 0), cA + kstep, voffA); PG_STAGE(PG_SB(1, 1), cB + hstepB + kstep, voffB);
  PG_WAIT_V(6); PG_BAR;
  for (;;) {
    const bool has_next = S.next(ui + 1, nxt);
    const char* nA = has_next ? (const char*)Ag + (size_t)nxt.pm * tstepA + nxt.ao : cA; const char* nB = has_next ? (const char*)Bg + (size_t)nxt.pn * tstepB + nxt.bo : cB;
#pragma unroll 1
    for (int t = 0; t < nt; t += 2) {
      const bool last = (t == nt - 2);
      const char* a1 = cA + (size_t)(t + 1) * kstep;
      const char* a2 = last ? nA : cA + (size_t)(t + 2) * kstep; const char* b2 = last ? nB : cB + (size_t)(t + 2) * kstep;
      const char* a3 = a2 + kstep; const char* b3 = b2 + kstep;
      PG_LDB(B0, 0, 0); PG_SCHED; PG_LDA(At, 0, 0); PG_STAGE(PG_SA(1, 1), a1 + hstepA, voffA);
      PG_WAIT_L(8); PG_BAR; PG_WAIT_L(0); PG_MMA(0, 0, At, B0); PG_BAR; PG_SCHED;
      PG_LDB(B1, 0, 1); PG_STAGE(PG_SB(0, 0), b2, voffB);
      PG_BAR; PG_WAIT_L(0); PG_MMA(0, 1, At, B1); PG_BAR;
      PG_LDA(At, 0, 1); PG_STAGE(PG_SA(0, 0), a2, voffA);
      PG_BAR; PG_WAIT_L(0); PG_MMA(1, 0, At, B0); PG_BAR; PG_SCHED;
      PG_STAGE(PG_SB(0, 1), b2 + hstepB, voffB);
      PG_WAIT_V(6); PG_BAR; PG_MMA(1, 1, At, B1); PG_BAR;
      PG_LDB(B0, 1, 0); PG_SCHED; PG_LDA(At, 1, 0); PG_STAGE(PG_SA(0, 1), a2 + hstepA, voffA);
      PG_WAIT_L(8); PG_BAR; PG_WAIT_L(0); PG_MMA(0, 0, At, B0); PG_BAR; PG_SCHED;
      PG_LDB(B1, 1, 1); PG_STAGE(PG_SB(1, 0), b3, voffB);
      PG_BAR; PG_WAIT_L(0); PG_MMA(0, 1, At, B1); PG_BAR;
      PG_LDA(At, 1, 1); PG_STAGE(PG_SA(1, 0), a3, voffA);
      PG_BAR; PG_WAIT_L(0); PG_MMA(1, 0, At, B0); PG_BAR; PG_SCHED;
      PG_STAGE(PG_SB(1, 1), b3 + hstepB, voffB);
      PG_WAIT_V(6); PG_BAR; PG_MMA(1, 1, At, B1); PG_BAR;
    }
    E(acc, cur, wr, wc, fr, fq);
    if (!has_next) break;
#pragma unroll
    for (int a = 0; a < 2; ++a)
#pragma unroll
      for (int b = 0; b < 2; ++b)
#pragma unroll
        for (int m = 0; m < 4; ++m)
#pragma unroll
          for (int n = 0; n < 2; ++n) acc[a][b][m][n] = (f32x4){0.f, 0.f, 0.f, 0.f};
    cur = nxt; cA = nA; cB = nB; ++ui;
  }
  PG_WAIT_V(0);
  if (wr == 0) PG_BAR;
  PG_BAR;
#undef PG_SA
#undef PG_SB
#undef PG_STAGE
#undef PG_LDA
#undef PG_LDB
#undef PG_MMA
#undef PG_WAIT_V
#undef PG_WAIT_L
#undef PG_BAR
#undef PG_SCHED
}

template <int ACT> struct EpiBf16 {
  static constexpr bool PERM = true;
  bf16_t* O; int ldc; const float* bias;
  DI void operator()(const f32x4 (&acc)[2][2][4][2], const Unit& u, int wr, int wc, int fr, int fq) const {
    const int row0 = u.pm * BM + wr * 64 + fr, col0 = u.pn * BM + wc * 32 + 8 * fq;
    f32x4 bv[2][2];
#pragma unroll
    for (int bj = 0; bj < 2; ++bj)
#pragma unroll
      for (int n = 0; n < 2; ++n) bv[bj][n] = ACT ? *(const f32x4*)(bias + col0 + bj * HALF + 4 * n) : (f32x4){0.f, 0.f, 0.f, 0.f};
#pragma unroll
    for (int ai = 0; ai < 2; ++ai)
#pragma unroll
      for (int m = 0; m < 4; ++m) { bf16_t* rowp = O + (size_t)(row0 + ai * HALF + m * 16) * ldc + col0;
#pragma unroll
        for (int bj = 0; bj < 2; ++bj) { f32x4 v0 = acc[ai][bj][m][0], v1 = acc[ai][bj][m][1];
          if (ACT) { v0 += bv[bj][0]; v1 += bv[bj][1];
#pragma unroll
            for (int j = 0; j < 4; ++j) { v0[j] = sigmoid_rcp(v0[j]); v1[j] = sigmoid_rcp(v1[j]); } }
          u32x4 w; w.x = cvt_pk_bf16(v0[0], v0[1]); w.y = cvt_pk_bf16(v0[2], v0[3]); w.z = cvt_pk_bf16(v1[0], v1[1]); w.w = cvt_pk_bf16(v1[2], v1[3]);
          *(u32x4*)(rowp + bj * HALF) = w; } }
  }
};
struct EpiBranch {
  static constexpr bool PERM = true;
  bf16_t* MIX; const bf16_t* G;
  DI void operator()(const f32x4 (&acc)[2][2][4][2], const Unit& u, int wr, int wc, int fr, int fq) const {
    const int row0 = u.pm * BM + wr * 64 + fr, col0 = u.pn * BM + wc * 32 + 8 * fq;
#pragma unroll
    for (int ai = 0; ai < 2; ++ai)
#pragma unroll
      for (int m = 0; m < 4; ++m) {
        asm volatile("" ::: "memory");
        const size_t row = (size_t)(row0 + ai * HALF + m * 16);
        bf16_t* mp = MIX + row * DM + col0; const bf16_t* gp = G + row * 4096 + u.aux * 1024 + col0;
#pragma unroll
        for (int bj = 0; bj < 2; ++bj) {
          const bf16x8 gv = *(const bf16x8*)(gp + bj * HALF);
          float o[8];
#pragma unroll
          for (int j = 0; j < 4; ++j) { o[j] = bf2f((bf16_t)gv[j]) * acc[ai][bj][m][0][j]; o[4 + j] = bf2f((bf16_t)gv[4 + j]) * acc[ai][bj][m][1][j]; }
          if (u.aux > 0) {
            const bf16x8 mv = *(const bf16x8*)(mp + bj * HALF);
#pragma unroll
            for (int j = 0; j < 8; ++j) o[j] += bf2f((bf16_t)mv[j]);
          }
          u32x4 w; w.x = cvt_pk_bf16(o[0], o[1]); w.y = cvt_pk_bf16(o[2], o[3]); w.z = cvt_pk_bf16(o[4], o[5]); w.w = cvt_pk_bf16(o[6], o[7]);
          *(u32x4*)(mp + bj * HALF) = w;
        }
      }
  }
};
struct EpiResid {
  static constexpr bool PERM = false;
  const float* xold; float* xnew; const float* modp; const float* bada; int l, gate_idx;
  DI void operator()(const f32x4 (&acc)[2][2][4][2], const Unit& u, int wr, int wc, int fr, int fq) const {
    const int row0 = u.pm * BM + wr * 64 + fr, col0 = u.pn * BM + wc * 32 + 4 * fq;
    const int b = (u.pm * BM) / SEQ;
    f32x4 gv[2][2];
#pragma unroll
    for (int bj = 0; bj < 2; ++bj)
#pragma unroll
      for (int n = 0; n < 2; ++n)
#pragma unroll
        for (int j = 0; j < 4; ++j) gv[bj][n][j] = modv(modp, bada, l, b, gate_idx + col0 + bj * HALF + n * 16 + j);
#pragma unroll
    for (int ai = 0; ai < 2; ++ai)
#pragma unroll
      for (int m = 0; m < 4; ++m) { const size_t ro = (size_t)(row0 + ai * HALF + m * 16) * DM + col0;
#pragma unroll
        for (int bj = 0; bj < 2; ++bj)
#pragma unroll
          for (int n = 0; n < 2; ++n) {
            const f32x4 xo = *(const f32x4*)(xold + ro + bj * HALF + n * 16);
            *(f32x4*)(xnew + ro + bj * HALF + n * 16) = xo + gv[bj][n] * acc[ai][bj][m][n];
          } }
  }
};
struct EpiFfnAct {
  static constexpr bool PERM = true;
  bf16_t* ACT; const bf16_t* APRE; const float* cw;
  DI void operator()(const f32x4 (&acc)[2][2][4][2], const Unit& u, int wr, int wc, int fr, int fq) const {
    const int row0 = u.pm * BM + wr * 64 + fr, col0 = u.pn * BM + wc * 32 + 8 * fq;
#pragma unroll
    for (int ai = 0; ai < 2; ++ai)
#pragma unroll
      for (int m = 0; m < 4; ++m) {
        asm volatile("" ::: "memory");
        const int row = row0 + ai * HALF + m * 16; const int sp = row & (SEQ - 1);
        const bf16_t* ap = APRE + (size_t)row * FFN + col0;
        bf16_t* op = ACT + (size_t)row * FFN + col0;
#pragma unroll
        for (int bj = 0; bj < 2; ++bj) {
          const int c = bj * HALF;
          const bf16x8 z8 = {0, 0, 0, 0, 0, 0, 0, 0};
          const bf16x8 a0 = *(const bf16x8*)(ap + c);
          const bf16x8 a1 = sp >= 1 ? *(const bf16x8*)(ap - FFN + c) : z8;
          const bf16x8 a2 = sp >= 2 ? *(const bf16x8*)(ap - 2 * FFN + c) : z8;
          float o[8];
#pragma unroll
          for (int hh = 0; hh < 2; ++hh) {
            const f32x4 w0 = *(const f32x4*)(cw + col0 + c + 4 * hh), w1 = *(const f32x4*)(cw + FFN + col0 + c + 4 * hh), w2 = *(const f32x4*)(cw + 2 * FFN + col0 + c + 4 * hh);
#pragma unroll
            for (int j = 0; j < 4; ++j) {
              const float cv = w0[j] * bf2f((bf16_t)a2[4 * hh + j]) + w1[j] * bf2f((bf16_t)a1[4 * hh + j]) + w2[j] * bf2f((bf16_t)a0[4 * hh + j]);
              o[4 * hh + j] = gelu_rcp(cv) * acc[ai][bj][m][hh][j];
            }
          }
          u32x4 w; w.x = cvt_pk_bf16(o[0], o[1]); w.y = cvt_pk_bf16(o[2], o[3]); w.z = cvt_pk_bf16(o[4], o[5]); w.w = cvt_pk_bf16(o[6], o[7]);
          *(u32x4*)(op + c) = w;
        }
      }
  }
};
struct EpiGateMix {
  static constexpr bool PERM = true;
  bf16_t* MIX; float* MIX32; const bf16_t* BH; const float* bias;
  DI void operator()(const f32x4 (&acc)[2][2][4][2], const Unit& u, int wr, int wc, int fr, int fq) const {
    const int row0 = u.pm * BM + wr * 64 + fr, col0 = u.pn * BM + wc * 32 + 8 * fq;
    const bool rmw = u.aux > 0, fin = u.aux == 3;
    f32x4 bv[2][2];
#pragma unroll
    for (int bj = 0; bj < 2; ++bj)
#pragma unroll
      for (int n = 0; n < 2; ++n) bv[bj][n] = *(const f32x4*)(bias + u.aux * 1024 + col0 + bj * HALF + 4 * n);
    const f32x4 z4 = {0.f, 0.f, 0.f, 0.f};
    bf16x8 nb[2]; f32x4 nm[2][2];
#define GM_LOAD(it_) { const size_t row_ = (size_t)(row0 + ((it_) >> 2) * HALF + ((it_) & 3) * 16); \
      _Pragma("unroll") for (int bj = 0; bj < 2; ++bj) { nb[bj] = *(const bf16x8*)(BH + row_ * 4096 + u.aux * 1024 + col0 + bj * HALF); \
        nm[bj][0] = rmw ? *(const f32x4*)(MIX32 + row_ * DM + col0 + bj * HALF) : z4; nm[bj][1] = rmw ? *(const f32x4*)(MIX32 + row_ * DM + col0 + bj * HALF + 4) : z4; } }
    GM_LOAD(0);
#pragma unroll
    for (int it = 0; it < 8; ++it) {
      const int ai = it >> 2, m = it & 3;
      bf16x8 cb[2]; f32x4 cm[2][2];
#pragma unroll
      for (int bj = 0; bj < 2; ++bj) { cb[bj] = nb[bj]; cm[bj][0] = nm[bj][0]; cm[bj][1] = nm[bj][1]; }
      if (it + 1 < 8) GM_LOAD(it + 1);
      const size_t ro = (size_t)(row0 + ai * HALF + m * 16) * DM + col0;
#pragma unroll
      for (int bj = 0; bj < 2; ++bj) {
        f32x4 o[2];
#pragma unroll
        for (int hh = 0; hh < 2; ++hh)
#pragma unroll
          for (int j = 0; j < 4; ++j)
            o[hh][j] = sigmoid_rcp(acc[ai][bj][m][hh][j] + bv[bj][hh][j]) * bf2f((bf16_t)cb[bj][4 * hh + j]) + cm[bj][hh][j];
        if (fin) {
          u32x4 w; w.x = cvt_pk_bf16(o[0][0], o[0][1]); w.y = cvt_pk_bf16(o[0][2], o[0][3]); w.z = cvt_pk_bf16(o[1][0], o[1][1]); w.w = cvt_pk_bf16(o[1][2], o[1][3]);
          *(u32x4*)(MIX + ro + bj * HALF) = w;
        } else {
          *(f32x4*)(MIX32 + ro + bj * HALF) = o[0]; *(f32x4*)(MIX32 + ro + bj * HALF + 4) = o[1];
        }
      }
    }
#undef GM_LOAD
  }
};
}

DI void phase_ffn_act(const Params& p, int l) {
  bf16_t* AU = (bf16_t*)(p.ws + OFF_P);
  const float* cw = p.in[I_FCW] + (size_t)l * 3 * FFN;
  const int nthr = gridDim.x * NTHR;
  for (int run = obid() * NTHR + otid(); run < 1024 * 352; run += nthr) {
    const int ch = run / 352, j8 = run % 352, j0 = j8 * 8;
    float w0[8], w1[8], w2[8];
#pragma unroll
    for (int e = 0; e < 8; ++e) { w0[e] = cw[j0 + e]; w1[e] = cw[FFN + j0 + e]; w2[e] = cw[2 * FFN + j0 + e]; }
    const int t0 = ch * 64, s0 = t0 % SEQ;
    float a1[8], a2[8];
#pragma unroll
    for (int e = 0; e < 8; ++e) { a1[e] = 0.f; a2[e] = 0.f; }
    if (s0 > 0) {
      bf16x8 v1 = *(const bf16x8*)(AU + (size_t)(t0 - 1) * AUS + j0);
      bf16x8 v2 = *(const bf16x8*)(AU + (size_t)(t0 - 2) * AUS + j0);
#pragma unroll
      for (int e = 0; e < 8; ++e) { a1[e] = bf2f((bf16_t)v1[e]); a2[e] = bf2f((bf16_t)v2[e]); }
    }
    for (int t = t0; t < t0 + 64; ++t) {
      bf16x8 va = *(const bf16x8*)(AU + (size_t)t * AUS + j0);
      bf16x8 vu = *(const bf16x8*)(AU + (size_t)t * AUS + FFN + j0);
      float o[8];
#pragma unroll
      for (int e = 0; e < 8; ++e) {
        float a0 = bf2f((bf16_t)va[e]);
        float cv = w0[e] * a2[e] + w1[e] * a1[e] + w2[e] * a0;
        o[e] = geluf_(cv) * bf2f((bf16_t)vu[e]);
        a2[e] = a1[e]; a1[e] = a0;
      }
      uint4 ov = {pack2(o[0], o[1]), pack2(o[2], o[3]), pack2(o[4], o[5]), pack2(o[6], o[7])};
      *(uint4*)(AU + (size_t)t * AUS + FFN + j0) = ov;
    }
  }
}

DI float mixf(bf16_t cur, bf16_t prev, float mu) { const float c = bf2f(cur); return c + (bf2f(prev) - c) * mu; }
DI void rw_prep_item(const Params& p, int l, int item, char* smem) {
  const bf16_t* P = (const bf16_t*)(p.ws + OFF_P);
  bf16_t* RD = (bf16_t*)(p.ws + OFF_L);
  bf16_t* RKK = (bf16_t*)(p.ws + OFF_L + GSZ);
  bf16_t* RA = (bf16_t*)(p.ws + OFF_L + 2 * GSZ);
  bf16_t* RG = (bf16_t*)(p.ws + OFF_L + 3 * GSZ);
  float* BON = (float*)(p.ws + OFF_BON);
  float* C12 = (float*)(p.ws + OFF_C12);
  const int b = item >> 6, ct = item & 63;
  const int tid = otid(), lane = tid & 63, wv = tid >> 6, hd = wv & 3, mi = wv >> 2, r = lane & 31, h = lane >> 5;
  bf16_t* TX = (bf16_t*)smem;
  bf16_t* XA = TX + 64 * 40;
  bf16_t* SG = XA + 64 * 40;
  bf16_t* RK = SG + 64 * 72;
  const float* mu = p.in[I_RMU] + (size_t)l * 896;
  const size_t tok0 = (size_t)b * SEQ + ct * 64;
  bf16x8 bw[2][2], ba[2][2], bg[2][4];
  {
    const float* wp = p.in[I_RWUP] + (size_t)l * 32 * 256 + hd * 64 + r;
    const float* ap = p.in[I_RAUP] + (size_t)l * 32 * 256 + hd * 64 + r;
    const float* gp = p.in[I_RGUP] + (size_t)l * 64 * 256 + hd * 64 + r;
    asm volatile("" : "+v"(wp), "+v"(ap), "+v"(gp));
#pragma unroll
    for (int ni = 0; ni < 2; ++ni) {
#pragma unroll
      for (int ks = 0; ks < 2; ++ks) {
        unsigned uw[4], ua[4];
#pragma unroll
        for (int j2 = 0; j2 < 4; ++j2) {
          const int k = 16 * ks + 8 * h + 2 * j2;
          uw[j2] = pack2(wp[k * 256 + 32 * ni], wp[(k + 1) * 256 + 32 * ni]);
          ua[j2] = pack2(ap[k * 256 + 32 * ni], ap[(k + 1) * 256 + 32 * ni]);
        }
        uint4 t1 = {uw[0], uw[1], uw[2], uw[3]}, t2 = {ua[0], ua[1], ua[2], ua[3]};
        bw[ni][ks] = __builtin_bit_cast(bf16x8, t1); ba[ni][ks] = __builtin_bit_cast(bf16x8, t2);
      }
#pragma unroll
      for (int ks = 0; ks < 4; ++ks) {
        unsigned ug[4];
#pragma unroll
        for (int j2 = 0; j2 < 4; ++j2) { const int k = 16 * ks + 8 * h + 2 * j2; ug[j2] = pack2(gp[k * 256 + 32 * ni], gp[(k + 1) * 256 + 32 * ni]); }
        uint4 t3 = {ug[0], ug[1], ug[2], ug[3]};
        bg[ni][ks] = __builtin_bit_cast(bf16x8, t3);
      }
    }
  }
#pragma unroll 4
  for (int i = 0; i < 16; ++i) {
    const int e = tid + NTHR * i; const int t = e >> 7, f = e & 127;
    const bf16_t* pr = P + (tok0 + t) * PSTR + C_RW + 768 + f;
    const bf16_t cur = pr[0];
    const bf16_t prev = (ct * 64 + t > 0) ? (pr - PSTR)[0] : (bf16_t)0;
    const float m = mixf(cur, prev, mu[768 + f]);
    if (f < 32) TX[t * 40 + f] = f2bf(tanhf_(m));
    else if (f < 64) XA[t * 40 + f - 32] = f2bf(m);
    else SG[t * 72 + f - 64] = f2bf(sigmoidf_(m));
  }
#pragma unroll 2
  for (int i = 0; i < 8; ++i) {
    const int q = tid + NTHR * i; const int t = q >> 6, col = (q & 63) * 8;
    const bf16_t* pr = P + (tok0 + t) * PSTR + C_RW + col;
    const bf16x8 cur = *(const bf16x8*)pr;
    bf16x8 prev = {0, 0, 0, 0, 0, 0, 0, 0};
    if (ct * 64 + t > 0) prev = *(const bf16x8*)(pr - PSTR);
    const f32x4 m0 = *(const f32x4*)(mu + col), m1 = *(const f32x4*)(mu + col + 4);
    float o[8];
#pragma unroll
    for (int e = 0; e < 4; ++e) { o[e] = mixf((bf16_t)cur[e], (bf16_t)prev[e], m0[e]); o[4 + e] = mixf((bf16_t)cur[4 + e], (bf16_t)prev[4 + e], m1[e]); }
    uint4 ov = {pack2(o[0], o[1]), pack2(o[2], o[3]), pack2(o[4], o[5]), pack2(o[6], o[7])};
    *(uint4*)(RK + t * 520 + col) = ov;
  }
  __syncthreads();
  f32x16 cw[2], ca[2], cg[2];
#pragma unroll
  for (int ni = 0; ni < 2; ++ni)
#pragma unroll
    for (int i = 0; i < 16; ++i) { cw[ni][i] = 0.f; ca[ni][i] = 0.f; cg[ni][i] = 0.f; }
#pragma unroll
  for (int ks = 0; ks < 2; ++ks) {
    const bf16x8 atx = *(const bf16x8*)(TX + (32 * mi + r) * 40 + 16 * ks + 8 * h);
    const bf16x8 axa = *(const bf16x8*)(XA + (32 * mi + r) * 40 + 16 * ks + 8 * h);
#pragma unroll
    for (int ni = 0; ni < 2; ++ni) { cw[ni] = mfma32(atx, bw[ni][ks], cw[ni]); ca[ni] = mfma32(axa, ba[ni][ks], ca[ni]); }
  }
#pragma unroll
  for (int ks = 0; ks < 4; ++ks) {
    const bf16x8 asg = *(const bf16x8*)(SG + (32 * mi + r) * 72 + 16 * ks + 8 * h);
#pragma unroll
    for (int ni = 0; ni < 2; ++ni) cg[ni] = mfma32(asg, bg[ni][ks], cg[ni]);
  }
  float ss[16], bn[16], q1[16], q2[16];
#pragma unroll
  for (int i = 0; i < 16; ++i) { ss[i] = 0.f; bn[i] = 0.f; q1[i] = 0.f; q2[i] = 0.f; }
#pragma unroll
  for (int ni = 0; ni < 2; ++ni) {
    const int hc = hd * 64 + 32 * ni + r;
    const float w0c = p.in[I_RW0][l * 256 + hc], a0c = p.in[I_RA0][l * 256 + hc], kkc = p.in[I_RKK][l * 256 + hc],
                kac = p.in[I_RKA][l * 256 + hc], rkc = p.in[I_RRK][l * 256 + hc];
#pragma unroll
    for (int i = 0; i < 16; ++i) {
      const int tl = 32 * mi + crow(i, h);
      const size_t tok = tok0 + tl;
      const float rr = bf2f(RK[tl * 520 + hc]);
      const float k = bf2f(RK[tl * 520 + 256 + hc]);
      const float wl = w0c + cw[ni][i];
      const float wlog = -softplusf_(-wl) - 0.5f;
      const float dd = 1.f - __expf(-__expf(wlog));
      const float a = sigmoidf_(a0c + ca[ni][i]);
      const float kkr = k * kkc;
      const float kp = k * (1.f + (a - 1.f) * kac);
      ss[i] += kkr * kkr; bn[i] += rr * kp * rkc; q1[i] += kkr * a * rr; q2[i] += kp * rr;
      cw[ni][i] = kkr;
      RD[tok * 256 + hc] = f2bf(dd); RA[tok * 256 + hc] = f2bf(a); RG[tok * 256 + hc] = f2bf(cg[ni][i]);
    }
  }
#pragma unroll
  for (int i = 0; i < 16; ++i) {
#pragma unroll
    for (int o = 1; o < 32; o <<= 1) { ss[i] += __shfl_xor(ss[i], o); bn[i] += __shfl_xor(bn[i], o); q1[i] += __shfl_xor(q1[i], o); q2[i] += __shfl_xor(q2[i], o); }
    ss[i] = rsqrtf(ss[i] + EPSF);
  }
#pragma unroll
  for (int ni = 0; ni < 2; ++ni) {
    const int hc = hd * 64 + 32 * ni + r;
#pragma unroll
    for (int i = 0; i < 16; ++i) {
      const size_t tok = tok0 + 32 * mi + crow(i, h);
      RKK[tok * 256 + hc] = f2bf(cw[ni][i] * ss[i]);
    }
  }
  if (r == 0) {
#pragma unroll
    for (int i = 0; i < 16; ++i) { const size_t th = (tok0 + 32 * mi + crow(i, h)) * 4 + hd; BON[th] = bn[i]; C12[th * 2] = q1[i] * ss[i]; C12[th * 2 + 1] = q2[i]; }
  }
}

DI void rwkv_scan_item(const Params& p, int l, int b, int hd, int half, char* smem) {
  const bf16_t* P = (const bf16_t*)(p.ws + OFF_P);
  bf16_t* O = (bf16_t*)(p.ws + OFF_O);
  const bf16_t* RD = (const bf16_t*)(p.ws + OFF_L);
  const bf16_t* RKK = (const bf16_t*)(p.ws + OFF_L + GSZ);
  const bf16_t* RA = (const bf16_t*)(p.ws + OFF_L + 2 * GSZ);
  const float* C12 = (const float*)(p.ws + OFF_C12);
  float* fb = (float*)smem;
  float* Yb = fb + 2 * 12352;
  const int tid = otid(), lane = tid & 63, wv = tid >> 6;
  const int hc = hd * 64 + lane;
  constexpr int NCH = SEQ / 32;
  f32x4 Sa = {0.f, 0.f, 0.f, 0.f}, Sb = {0.f, 0.f, 0.f, 0.f};
  const int rl = lane >> 3, kq = lane & 7, vloc = (wv & 3) * 8 + rl, vrow = half * 32 + vloc;
  const float* mu = p.in[I_RMU] + (size_t)l * 896;
  const float mu_r = mu[hc], mu_k = mu[256 + hc], mu_v = mu[512 + hc];
  const float kac = p.in[I_RKA][l * 256 + hc];
  const int pw = wv & 3;
  unsigned raw[8][9];
#pragma unroll
  for (int j = 0; j < 8; ++j)
#pragma unroll
    for (int e = 0; e < 9; ++e) raw[j][e] = 0u;
#define RAWLOAD(i_)                                                                                 \
  {                                                                                                 \
    _Pragma("unroll") for (int j = 0; j < 8; ++j) {                                                 \
      const int s_ = (i_) * 32 + pw * 8 + j;                                                        \
      const size_t tok_ = (size_t)b * SEQ + s_;                                                     \
      const bf16_t* pr_ = P + tok_ * PSTR + C_RW;                                                   \
      raw[j][0] = pr_[hc]; raw[j][1] = pr_[256 + hc]; raw[j][2] = pr_[512 + hc];                    \
      if (s_ > 0) { raw[j][3] = (pr_ - PSTR)[hc]; raw[j][4] = (pr_ - PSTR)[256 + hc]; raw[j][5] = (pr_ - PSTR)[512 + hc]; } \
      else { raw[j][3] = 0u; raw[j][4] = 0u; raw[j][5] = 0u; }                                      \
      raw[j][6] = RD[tok_ * 256 + hc]; raw[j][7] = RKK[tok_ * 256 + hc]; raw[j][8] = RA[tok_ * 256 + hc]; \
    }                                                                                               \
  }
#define RBAR() { asm volatile("s_waitcnt lgkmcnt(0)" ::: "memory"); __builtin_amdgcn_s_barrier(); asm volatile("" ::: "memory"); }
  if (wv >= 4) RAWLOAD(0);
#pragma unroll 1
  for (int i = 0; i < NCH + 2; ++i) {
    if (wv >= 4) {
      float* B = fb + (i & 1) * 12352;
      if (i >= 2) {
        const float* Yc = Yb + (i & 1) * 1024;
        if (lane < 32) {
#pragma unroll
          for (int j = 0; j < 8; ++j) {
            const int tl = pw * 8 + j;
            const size_t tok = (size_t)b * SEQ + (i - 2) * 32 + tl;
            O[tok * DM + 768 + hd * 64 + half * 32 + lane] = f2bf(Yc[tl * 32 + lane]);
          }
        }
      }
      if (i < NCH) {
#pragma unroll
        for (int j = 0; j < 8; ++j) {
          const int tl = pw * 8 + j;
          const float r = mixf((bf16_t)raw[j][0], (bf16_t)raw[j][3], mu_r), k = mixf((bf16_t)raw[j][1], (bf16_t)raw[j][4], mu_k), v = mixf((bf16_t)raw[j][2], (bf16_t)raw[j][5], mu_v);
          const float w = 1.f - bf2f((bf16_t)raw[j][6]), kk = bf2f((bf16_t)raw[j][7]), a = bf2f((bf16_t)raw[j][8]);
          const float ka = kk * a, kp = k * (1.f + (a - 1.f) * kac);

          B[tl * 64 + lane] = w; B[2048 + tl * 64 + lane] = kk; B[4096 + tl * 64 + lane] = ka; B[6144 + tl * 64 + lane] = kp;
          B[8192 + tl * 64 + lane] = w * r; B[10240 + tl * 64 + lane] = v;
          if (lane < 2) B[12288 + tl * 2 + lane] = C12[(((size_t)b * SEQ + i * 32 + tl) * 4 + hd) * 2 + lane];
        }
        if (i + 1 < NCH) RAWLOAD(i + 1);
      }
    } else if (i >= 1 && i <= NCH) {
      const float* B = fb + ((i - 1) & 1) * 12352;
      float* Yc = Yb + ((i - 1) & 1) * 1024;
      f32x4 vw[2][10]; float vvv[2]; float2 vsc[2];
#define RWLD(t_, s_)                                                                              \
      { const float* bt_ = B + (t_) * 64 + kq * 8;                                                 \
        _Pragma("unroll") for (int q_ = 0; q_ < 5; ++q_) { vw[s_][2 * q_] = *(const f32x4*)(bt_ + 2048 * q_); vw[s_][2 * q_ + 1] = *(const f32x4*)(bt_ + 2048 * q_ + 4); } \
        vvv[s_] = B[10240 + (t_) * 64 + vrow]; vsc[s_] = *(const float2*)(B + 12288 + (t_) * 2); }
      {
      constexpr int tb = 0;
      RWLD(0, 0);
#pragma unroll
      for (int t = 0; t < 32; ++t) {
        const int cs = t & 1;
        if (t + 1 < 32) RWLD(t + 1, cs ^ 1);
        const f32x4 w0 = vw[cs][0], w1 = vw[cs][1], kk0 = vw[cs][2], kk1 = vw[cs][3], ka0 = vw[cs][4], ka1 = vw[cs][5],
                    kp0 = vw[cs][6], kp1 = vw[cs][7], wr0 = vw[cs][8], wr1 = vw[cs][9];
        const float vv = vvv[cs]; const float2 sc = vsc[cs];
        const f32x4 pd = Sa * kk0 + Sb * kk1, pe = Sa * wr0 + Sb * wr1;
        float d0 = (pd[0] + pd[1]) + (pd[2] + pd[3]), e0 = (pe[0] + pe[1]) + (pe[2] + pe[3]);
        const f32x4 Ua = Sa * w0 + vv * kp0, Ub = Sb * w1 + vv * kp1;
        d0 = reduce8(d0); e0 = reduce8(e0);
        const float sa0 = -d0;
        const float y0 = e0 + sa0 * sc.x + vv * sc.y;
        Sa = Ua + sa0 * ka0; Sb = Ub + sa0 * ka1;
        Yc[(tb + t) * 32 + vloc] = y0;
      }
      }
#undef RWLD
    }
    RBAR();
  }
#undef RAWLOAD
#undef RBAR
}

DI void rwkv_post(const Params& p, int l) {
  const bf16_t* P = (const bf16_t*)(p.ws + OFF_P);
  bf16_t* O = (bf16_t*)(p.ws + OFF_O);
  const bf16_t* RG = (const bf16_t*)(p.ws + OFF_L + 3 * GSZ);
  const float* BON = (const float*)(p.ws + OFF_BON);
  const int tid = otid(), lane = tid & 63, wv = tid >> 6;
  const float* mu = p.in[I_RMU] + (size_t)l * 896;
  const int nw = gridDim.x * 8;
  for (int task0 = (obid() * 8 + wv) * 4; task0 < NTOK * 4; task0 += nw * 4) {
    float yv[4], vv[4], gv[4], bv[4];
#pragma unroll
    for (int q = 0; q < 4; ++q) {
      const int task = task0 + q; const size_t tok = task >> 2; const int hd = task & 3, hc = hd * 64 + lane;
      yv[q] = bf2f(O[tok * DM + 768 + hc]);
      const bf16_t cur = P[tok * PSTR + C_RW + 512 + hc];
      const bf16_t prev = (tok % SEQ) ? P[(tok - 1) * PSTR + C_RW + 512 + hc] : (bf16_t)0;
      vv[q] = mixf(cur, prev, mu[512 + hc]);
      gv[q] = bf2f(RG[tok * 256 + hc]); bv[q] = BON[tok * 4 + hd];
    }
#pragma unroll
    for (int q = 0; q < 4; ++q) {
      const int task = task0 + q; const size_t tok = task >> 2; const int hd = task & 3, hc = hd * 64 + lane;
      const float mean = wave_sum(yv[q]) * (1.f / 64.f);
      const float d = yv[q] - mean;
      const float var = wave_sum(d * d) * (1.f / 64.f);
      const float yn = d * rsqrtf(var + 64e-5f) * p.in[I_RLG][l * 256 + hc] + p.in[I_RLB][l * 256 + hc];
      O[tok * DM + 768 + hc] = f2bf((yn + bv[q] * vv[q]) * gv[q]);
    }
  }
}

DI void sb_item(const Params& p, int item, char* smem) {
  const bf16_t* P = (const bf16_t*)(p.ws + OFF_P);
  bf16_t* O = (bf16_t*)(p.ws + OFF_O);
  const int qt = item & 15, hd = (item >> 4) & 3, b = item >> 6;
  const int tid = otid(), lane = tid & 63, wv = tid >> 6, r = lane & 31, h = lane >> 5;
  bf16_t* Vt = (bf16_t*)(smem + wv * 8704);
  const int q0 = qt * 256 + wv * 32;
  const int sq = q0 + r;
  const size_t tokb = (size_t)b * SEQ;
  bf16x8 qf[4];
#pragma unroll
  for (int ks = 0; ks < 4; ++ks) qf[ks] = *(const bf16x8*)(P + (tokb + sq) * PSTR + C_SB_Q + hd * 64 + ks * 16 + h * 8);
  f32x16 accO[2];
#pragma unroll
  for (int i = 0; i < 16; ++i) { accO[0][i] = 0.f; accO[1][i] = 0.f; }
  float Prun = 1.f;
  bf16x8 kf[2][4];
  const int kt0 = (q0 + 31) >> 6;
#define SBKLOAD(kt_) { _Pragma("unroll") for (int m = 0; m < 2; ++m) _Pragma("unroll") for (int ks = 0; ks < 4; ++ks) \
    kf[m][ks] = *(const bf16x8*)(P + (tokb + (kt_) * 64 + 32 * m + r) * PSTR + C_SB_K + hd * 64 + ks * 16 + h * 8); }
  SBKLOAD(kt0);
  for (int kt = kt0; kt >= 0; --kt) {
    const int k0 = kt * 64;
    bf16x8 vr[8];
#pragma unroll
    for (int it = 0; it < 8; ++it) vr[it] = *(const bf16x8*)(P + (tokb + k0 + it * 8 + (lane >> 3)) * PSTR + C_SB_V + hd * 64 + (lane & 7) * 8);
    f32x16 acc[2];
#pragma unroll
    for (int m = 0; m < 2; ++m) {
#pragma unroll
      for (int i = 0; i < 16; ++i) acc[m][i] = 0.f;
#pragma unroll
      for (int ks = 0; ks < 4; ++ks) acc[m] = mfma32(kf[m][ks], qf[ks], acc[m]);
    }
    if (kt > 0) SBKLOAD(kt - 1);
    float om[2][16];
#pragma unroll
    for (int m = 0; m < 2; ++m)
#pragma unroll
      for (int i = 0; i < 16; ++i) {
        const int key = k0 + 32 * m + crow(i, h);
        const float z = fmaxf(acc[m][i] * 0.125f, -80.f);
        const float e = __expf(-z);
        const float sg = __builtin_amdgcn_rcpf(1.f + e);
        const bool valid = key < sq;
        acc[m][i] = valid ? sg : 0.f;
        om[m][i] = valid ? e * sg : 1.f;
      }
    float gp[8];
#pragma unroll
    for (int q = 0; q < 8; ++q) {
      const int m = q >> 2, g = q & 3;
      gp[q] = (om[m][4 * g] * om[m][4 * g + 1]) * (om[m][4 * g + 2] * om[m][4 * g + 3]);
    }
    float run = 1.f;
#pragma unroll
    for (int q = 7; q >= 0; --q) {
      const int m = q >> 2, g = q & 3;
      const float pg = __shfl_xor(gp[q], 32);
      const float f3 = Prun * run * (h == 0 ? pg : 1.f);
      const float f2 = f3 * om[m][4 * g + 3], f1 = f2 * om[m][4 * g + 2], f0 = f1 * om[m][4 * g + 1];
      acc[m][4 * g + 3] *= f3; acc[m][4 * g + 2] *= f2; acc[m][4 * g + 1] *= f1; acc[m][4 * g + 0] *= f0;
      run *= gp[q] * pg;
    }
    Prun *= run;
    __builtin_amdgcn_wave_barrier();
#pragma unroll
    for (int it = 0; it < 8; ++it) {
      const int key = it * 8 + (lane >> 3), chv = lane & 7;
#pragma unroll
      for (int e = 0; e < 8; ++e) Vt[(chv * 8 + e) * 68 + key] = (bf16_t)vr[it][e];
    }
    __builtin_amdgcn_wave_barrier();
#pragma unroll
    for (int m = 0; m < 2; ++m)
#pragma unroll
      for (int s2 = 0; s2 < 2; ++s2) {
        uint4 uu = {pack2(acc[m][8 * s2 + 0], acc[m][8 * s2 + 1]), pack2(acc[m][8 * s2 + 2], acc[m][8 * s2 + 3]),
                    pack2(acc[m][8 * s2 + 4], acc[m][8 * s2 + 5]), pack2(acc[m][8 * s2 + 6], acc[m][8 * s2 + 7])};
        const bf16x8 pb = __builtin_bit_cast(bf16x8, uu);
#pragma unroll
        for (int dt = 0; dt < 2; ++dt) {
          const bf16_t* vp = Vt + (32 * dt + r) * 68 + 32 * m + 16 * s2 + 4 * h;
          s16x4 lo = *(const s16x4*)vp, hi = *(const s16x4*)(vp + 8);
          bf16x8 va = __builtin_shufflevector(lo, hi, 0, 1, 2, 3, 4, 5, 6, 7);
          accO[dt] = mfma32(va, pb, accO[dt]);
        }
      }
    __builtin_amdgcn_wave_barrier();
    if (__ballot(Prun > 1e-37f) == 0ull) break;
  }
#undef SBKLOAD
#pragma unroll
  for (int dt = 0; dt < 2; ++dt)
#pragma unroll
    for (int g = 0; g < 4; ++g) {
      const int d = 32 * dt + 8 * g + 4 * h;
      uint2 o = {pack2(accO[dt][4 * g], accO[dt][4 * g + 1]), pack2(accO[dt][4 * g + 2], accO[dt][4 * g + 3])};
      *(uint2*)(O + (tokb + sq) * DM + 256 + hd * 64 + d) = o;
    }
}

DI int frag_off(int row, int k) {
  const int rt = row >> 4, fr = row & 15, ks = k >> 5, kk = k & 31, hi = kk >> 4, fq = (kk & 15) >> 2, j = (kk & 3) + 4 * hi;
  return ((rt * 2 + ks) * 64 + fq * 16 + fr) * 8 + j;
}
DI int frag_off8(int row, int k0) {
  const int rt = row >> 4, fr = row & 15, ks = k0 >> 5, kk = k0 & 31, hi = kk >> 4, fq = (kk & 15) >> 2;
  return ((rt * 2 + ks) * 64 + fq * 16 + fr) * 8 + 4 * hi;
}
DI void gdn_intra_item(const Params& p, int l, int item, char* smem) {
  const bf16_t* P = (const bf16_t*)(p.ws + OFF_P);
  const int hp = item & 1, c = (item >> 1) & 63, b = item >> 7;
  const int tid = otid(), lane = tid & 63;
  bf16_t* Kb = (bf16_t*)smem;
  bf16_t* Qb = Kb + 2 * 64 * 72;
  bf16_t* Vb = Qb + 2 * 64 * 72;
  float* Lm = (float*)(smem + 3 * 2 * 64 * 72 * 2);
  float* Gs = Lm + 2 * 4096;
  float* Bs = Gs + 128;
  const size_t tok0 = (size_t)b * SEQ + c * 64;
  const float* cw = p.in[I_GCW] + (size_t)l * 4 * 768;
  float* CW = Bs + 128;
  for (int e = tid; e < 6 * 4 * 64; e += NTHR) {
    const int blk = e >> 8, j = (e >> 6) & 3, col = e & 63;
    const int hh_ = blk / 3, which_ = blk % 3;
    CW[e] = cw[j * 768 + which_ * 256 + (hp * 2 + hh_) * 64 + col];
  }
  __syncthreads();
  {
    const int t = tid >> 3, cg = tid & 7;
#pragma unroll 3
    for (int it = 0; it < 6; ++it) {
      const int hh = it / 3, which = it % 3, head = hp * 2 + hh;
      const int ccol = which * 256 + head * 64 + cg * 8;
      float acc[8];
#pragma unroll
      for (int e = 0; e < 8; ++e) acc[e] = 0.f;
#pragma unroll
      for (int j = 0; j < 4; ++j) {
        const int s = c * 64 + t - 3 + j;
        if (s >= 0) {
          bf16x8 xv = *(const bf16x8*)(P + ((size_t)b * SEQ + s) * PSTR + C_GDN_Q + ccol);
          f32x4 wa = *(const f32x4*)(CW + (it * 4 + j) * 64 + cg * 8), wb = *(const f32x4*)(CW + (it * 4 + j) * 64 + cg * 8 + 4);
#pragma unroll
          for (int e = 0; e < 4; ++e) { acc[e] += wa[e] * bf2f((bf16_t)xv[e]); acc[e + 4] += wb[e] * bf2f((bf16_t)xv[e + 4]); }
        }
      }
      float ss = 0.f;
#pragma unroll
      for (int e = 0; e < 8; ++e) { acc[e] = siluf_(acc[e]); ss += acc[e] * acc[e]; }
      ss += __shfl_xor(ss, 1); ss += __shfl_xor(ss, 2); ss += __shfl_xor(ss, 4);
      float sc = 1.f;
      if (which == 0) sc = rsqrtf(ss + EPSF) * 0.125f;
      else if (which == 1) sc = rsqrtf(ss + EPSF);
      uint4 ov = {pack2(acc[0] * sc, acc[1] * sc), pack2(acc[2] * sc, acc[3] * sc), pack2(acc[4] * sc, acc[5] * sc), pack2(acc[6] * sc, acc[7] * sc)};
      bf16_t* dst = (which == 0 ? Qb : (which == 1 ? Kb : Vb)) + (hh * 64 + t) * 72 + cg * 8;
      *(uint4*)dst = ov;
    }
  }
  if (tid < 128) {
    const int hh = tid >> 6, t = lane, head = hp * 2 + hh;
    const float a_in = bf2f(P[(tok0 + t) * PSTR + C_GDN_A + head]);
    const float b_in = bf2f(P[(tok0 + t) * PSTR + C_GDN_B + head]);
    const float beta = sigmoidf_(b_in);
    float g = -__expf(p.in[I_GAL][l * 4 + head]) * softplusf_(a_in + p.in[I_GDT][l * 4 + head]);
#pragma unroll
    for (int d = 1; d < 64; d <<= 1) { float v = __shfl_up(g, d); if (lane >= d) g += v; }
    Gs[hh * 64 + t] = g; Bs[hh * 64 + t] = beta;
  }
  __syncthreads();
  const int hh = tid >> 8, lt = tid & 255, head = hp * 2 + hh;
  const size_t ih = ((size_t)(b * 4 + head)) * 64 + c;
  bf16_t* GW = (bf16_t*)(p.ws + OFF_G) + ih * 4096;
  bf16_t* GQD = (bf16_t*)(p.ws + OFF_G + GSZ) + ih * 4096;
  bf16_t* GQK = (bf16_t*)(p.ws + OFF_G + 2 * GSZ) + ih * 4096;
  bf16_t* GKD = (bf16_t*)(p.ws + OFF_G + 3 * GSZ) + ih * 4096;
  bf16_t* GU = (bf16_t*)(p.ws + OFF_G + 4 * GSZ) + ih * 4096;
  float* GCD = (float*)(p.ws + OFF_GCD);
  const float* Gh = Gs + hh * 64; const float* Bh = Bs + hh * 64;
  {
    const int wq = (tid >> 6) & 3, ti = wq >> 1, tj = wq & 1, r = lane & 31, h = lane >> 5;
    f32x16 akk, aqk;
#pragma unroll
    for (int i = 0; i < 16; ++i) { akk[i] = 0.f; aqk[i] = 0.f; }
    if (ti >= tj) {
#pragma unroll
      for (int ks = 0; ks < 4; ++ks) {
        bf16x8 ka = *(const bf16x8*)(Kb + (hh * 64 + 32 * ti + r) * 72 + ks * 16 + h * 8);
        bf16x8 qa = *(const bf16x8*)(Qb + (hh * 64 + 32 * ti + r) * 72 + ks * 16 + h * 8);
        bf16x8 kb = *(const bf16x8*)(Kb + (hh * 64 + 32 * tj + r) * 72 + ks * 16 + h * 8);
        akk = mfma32(ka, kb, akk);
        aqk = mfma32(qa, kb, aqk);
      }
    }
    const int j = 32 * tj + r;
    const float Gj = Gh[j];
#pragma unroll
    for (int i_ = 0; i_ < 16; ++i_) {
      const int i = 32 * ti + crow(i_, h);
      const float dec = (i >= j) ? __expf(Gh[i] - Gj) : 0.f;
      Lm[hh * 4096 + i * 64 + j] = (i > j) ? Bh[i] * akk[i_] * dec : 0.f;
      GQK[frag_off(i, j)] = f2bf((i >= j) ? aqk[i_] * dec : 0.f);
    }
  }
  __syncthreads();
  if (lt < 128) {
    const int cc = lt;
    float x[64];
    if (cc < 64) {
#pragma unroll
      for (int i = 0; i < 64; ++i) x[i] = bf2f(Vb[(hh * 64 + i) * 72 + cc]) * Bh[i];
    } else {
#pragma unroll
      for (int i = 0; i < 64; ++i) x[i] = bf2f(Kb[(hh * 64 + i) * 72 + cc - 64]) * Bh[i] * __expf(Gh[i]);
    }
    const float* Lh = Lm + hh * 4096;
#pragma unroll
    for (int i = 1; i < 64; ++i) {
      float s = x[i];
#pragma unroll
      for (int j4 = 0; j4 < (i + 3) / 4; ++j4) {
        const f32x4 lv = *(const f32x4*)(Lh + i * 64 + j4 * 4);
#pragma unroll
        for (int e = 0; e < 4; ++e) if (j4 * 4 + e < i) s -= lv[e] * x[j4 * 4 + e];
      }
      x[i] = s;
    }
    if (cc < 64) {
      const int split = cc >> 4, fr = cc & 15;
#pragma unroll
      for (int i4 = 0; i4 < 16; ++i4) {
        uint2 ov = {pack2(x[4 * i4], x[4 * i4 + 1]), pack2(x[4 * i4 + 2], x[4 * i4 + 3])};
        *(uint2*)(GU + ((split * 4 + (i4 >> 2)) * 64 + (i4 & 3) * 16 + fr) * 4) = ov;
      }
    } else {
#pragma unroll
      for (int i = 0; i < 64; ++i) GW[frag_off(i, cc - 64)] = f2bf(x[i]);
    }
  } else {
    const int q_ = lt - 128;
    const float Glast = Gh[63];
#pragma unroll
    for (int i = 0; i < 4; ++i) {
      const int q = q_ + 128 * i; const int pos = q >> 3, kc = q & 7;
      bf16x8 qv = *(const bf16x8*)(Qb + (hh * 64 + pos) * 72 + kc * 8);
      const float eg = __expf(Gh[pos]);
      uint4 ov = {pack2(bf2f((bf16_t)qv[0]) * eg, bf2f((bf16_t)qv[1]) * eg), pack2(bf2f((bf16_t)qv[2]) * eg, bf2f((bf16_t)qv[3]) * eg),
                  pack2(bf2f((bf16_t)qv[4]) * eg, bf2f((bf16_t)qv[5]) * eg), pack2(bf2f((bf16_t)qv[6]) * eg, bf2f((bf16_t)qv[7]) * eg)};
      { const int fo = frag_off8(pos, kc * 8); uint2 o0 = {ov.x, ov.y}, o1 = {ov.z, ov.w}; *(uint2*)(GQD + fo) = o0; *(uint2*)(GQD + fo + 128) = o1; }
    }
#pragma unroll
    for (int i = 0; i < 4; ++i) {
      const int q = q_ + 128 * i; const int k = q >> 3, pc = q & 7;
      float o[8];
#pragma unroll
      for (int e = 0; e < 8; ++e) { const int pos = pc * 8 + e; o[e] = bf2f(Kb[(hh * 64 + pos) * 72 + k]) * __expf(Glast - Gh[pos]); }
      uint4 ov = {pack2(o[0], o[1]), pack2(o[2], o[3]), pack2(o[4], o[5]), pack2(o[6], o[7])};
      { const int fo = frag_off8(k, pc * 8); uint2 o0 = {ov.x, ov.y}, o1 = {ov.z, ov.w}; *(uint2*)(GKD + fo) = o0; *(uint2*)(GKD + fo + 128) = o1; }
    }
    if (q_ == 0) GCD[ih] = __expf(Glast);
  }
}

DI void gdn_rec_item(const Params& p, int l, int b, int head, char* smem) {
  const bf16_t* P = (const bf16_t*)(p.ws + OFF_P);
  bf16_t* O = (bf16_t*)(p.ws + OFF_O);
  float* SS = (float*)(smem + 81920);
  const int tid = otid(), lane = tid & 63, wv = tid >> 6, fr = lane & 15, fq = lane >> 4;
  const int split = wv & 3;
  const bool active = wv < 4;
  const float ng = p.in[I_GNG][l * 64 + split * 16 + fr];
  const float* GCD = (const float*)(p.ws + OFF_GCD);
  const size_t ih0 = ((size_t)(b * 4 + head)) * 64;
  f32x4 S[4];
#pragma unroll
  for (int kt = 0; kt < 4; ++kt) S[kt] = (f32x4){0.f, 0.f, 0.f, 0.f};
  u32x4 lr[10];
#pragma unroll
  for (int i = 0; i < 10; ++i) lr[i] = (u32x4){0u, 0u, 0u, 0u};
  const int lq = (wv & 3) * 64 + lane;
#define GLOADC(c_)                                                                              \
  {                                                                                             \
    _Pragma("unroll") for (int i = 0; i < 10; ++i) {                                            \
      const int q_ = lq + 256 * i; const int a_ = q_ >> 9, o_ = q_ & 511;                       \
      lr[i] = *(const u32x4*)((const bf16_t*)(p.ws + OFF_G + (size_t)a_ * GSZ) + (ih0 + (c_)) * 4096 + o_ * 8); \
    }                                                                                           \
  }
#define LSTORE(buf_)                                                                            \
  {                                                                                             \
    _Pragma("unroll") for (int i = 0; i < 10; ++i) {                                            \
      const int q_ = lq + 256 * i;                                                              \
      *(u32x4*)(smem + (buf_) * 40960 + q_ * 16) = lr[i];                                       \
    }                                                                                           \
  }
#define BAR_LDS() { asm volatile("s_waitcnt lgkmcnt(0)" ::: "memory"); __builtin_amdgcn_s_barrier(); asm volatile("" ::: "memory"); }
  float cdn = 0.f;
  if (!active) { GLOADC(0); LSTORE(0); GLOADC(1); }
  else cdn = GCD[ih0];
  BAR_LDS();
#pragma unroll 1
  for (int c = 0; c < 64; ++c) {
    f32x4 acco[4];
    if (active) {
      const char* bufp = smem + (c & 1) * 40960;
      const float cd = cdn;
      if (c + 1 < 64) cdn = GCD[ih0 + c + 1];
      float zr[16];
#pragma unroll
      for (int rt = 0; rt < 4; ++rt)
#pragma unroll
        for (int j = 0; j < 4; ++j) {
          const size_t tok = (size_t)b * SEQ + c * 64 + 16 * rt + 4 * fq + j;
          zr[rt * 4 + j] = bf2f(P[tok * PSTR + C_GDN_Z + head * 64 + split * 16 + fr]);
        }
      bf16x8 bS[2];
#pragma unroll
      for (int ks = 0; ks < 2; ++ks) {
        uint4 uu = {pack2(S[2 * ks][0], S[2 * ks][1]), pack2(S[2 * ks][2], S[2 * ks][3]), pack2(S[2 * ks + 1][0], S[2 * ks + 1][1]), pack2(S[2 * ks + 1][2], S[2 * ks + 1][3])};
        bS[ks] = __builtin_bit_cast(bf16x8, uu);
      }
      f32x4 u[4];
#pragma unroll
      for (int rt = 0; rt < 4; ++rt) {
        f32x4 aw = {0.f, 0.f, 0.f, 0.f};
        acco[rt] = (f32x4){0.f, 0.f, 0.f, 0.f};
#pragma unroll
        for (int ks = 0; ks < 2; ++ks) {
          const bf16x8 wa = *(const bf16x8*)(bufp + ((rt * 2 + ks) * 64 + lane) * 16);
          const bf16x8 qa = *(const bf16x8*)(bufp + 8192 + ((rt * 2 + ks) * 64 + lane) * 16);
          aw = mfma16(wa, bS[ks], aw); acco[rt] = mfma16(qa, bS[ks], acco[rt]);
        }
        const s16x4 uv = *(const s16x4*)(bufp + 32768 + ((split * 4 + rt) * 64 + lane) * 8);
#pragma unroll
        for (int j = 0; j < 4; ++j) u[rt][j] = bf2f((bf16_t)uv[j]) - aw[j];
      }
      bf16x8 bU[2];
#pragma unroll
      for (int ks = 0; ks < 2; ++ks) {
        uint4 uu = {pack2(u[2 * ks][0], u[2 * ks][1]), pack2(u[2 * ks][2], u[2 * ks][3]), pack2(u[2 * ks + 1][0], u[2 * ks + 1][1]), pack2(u[2 * ks + 1][2], u[2 * ks + 1][3])};
        bU[ks] = __builtin_bit_cast(bf16x8, uu);
      }
#pragma unroll
      for (int rt = 0; rt < 4; ++rt) {
        f32x4 sn = S[rt] * cd;
#pragma unroll
        for (int ks = 0; ks < 2; ++ks) {
          const bf16x8 qa = *(const bf16x8*)(bufp + 16384 + ((rt * 2 + ks) * 64 + lane) * 16);
          const bf16x8 ka = *(const bf16x8*)(bufp + 24576 + ((rt * 2 + ks) * 64 + lane) * 16);
          acco[rt] = mfma16(qa, bU[ks], acco[rt]); sn = mfma16(ka, bU[ks], sn);
        }
        S[rt] = sn;
      }
#pragma unroll
      for (int rt = 0; rt < 4; ++rt)
#pragma unroll
        for (int j = 0; j < 4; ++j) {
          float s = acco[rt][j] * acco[rt][j];
          s += __shfl_xor(s, 1); s += __shfl_xor(s, 2); s += __shfl_xor(s, 4); s += __shfl_xor(s, 8);
          if (fr == 0) SS[(c & 1) * 256 + split * 64 + 16 * rt + 4 * fq + j] = s;
        }
      BAR_LDS();
      const float* ssb = SS + (c & 1) * 256;
#pragma unroll
      for (int rt = 0; rt < 4; ++rt)
#pragma unroll
        for (int j = 0; j < 4; ++j) {
          const int pos = 16 * rt + 4 * fq + j;
          const float tot = ssb[pos] + ssb[64 + pos] + ssb[128 + pos] + ssb[192 + pos];
          const float rn = rsqrtf(tot * (1.f / 64.f) + EPSF);
          const size_t tok = (size_t)b * SEQ + c * 64 + pos;
          O[tok * DM + 512 + head * 64 + split * 16 + fr] = f2bf(acco[rt][j] * rn * ng * siluf_(zr[rt * 4 + j]));
        }
    } else {
      if (c + 1 < 64) LSTORE((c + 1) & 1);
      if (c + 2 < 64) GLOADC(c + 2);
      BAR_LDS();
    }
  }
#undef GLOADC
#undef LSTORE
#undef BAR_LDS
}

DI void lru_item(const Params& p, int l, int item, char* smem, const int mode) {
  const bf16_t* P = (const bf16_t*)(p.ws + OFF_P);
  bf16_t* O = (bf16_t*)(p.ws + OFF_O);
  float* CA = (float*)(p.ws + OFF_LCA);
  float* CH = (float*)(p.ws + OFF_LCH);
  bf16_t* XS = (bf16_t*)smem;
  bf16_t* UB = (bf16_t*)(smem + 34816);
  const int b = item >> 6, ct = item & 63;
  const int tid = otid(), lane = tid & 63, wv = tid >> 6, r = lane & 31, h = lane >> 5, n = wv & 3, mi = wv >> 2;
  for (int i = 0; i < 5; ++i) {
    const int q = tid + NTHR * i;
    if (q < 67 * 32) {
      const int row = q >> 5, cc = q & 31;
      const int s = ct * 64 - 3 + row;
      uint4 v = {0u, 0u, 0u, 0u};
      if (s >= 0) v = *(const uint4*)(P + ((size_t)b * SEQ + s) * PSTR + C_LRU_X + cc * 8);
      *(uint4*)(XS + row * 256 + cc * 8) = v;
    }
  }
  bf16x8 bwr[2][4], bwi[2][4];
  {
    const float* wrp = p.in[I_LWR] + (((size_t)l * 4 + n) * 64) * 64 + r;
    const float* wip = p.in[I_LWI] + (((size_t)l * 4 + n) * 64) * 64 + r;
    asm volatile("" : "+v"(wrp), "+v"(wip));
#pragma unroll
    for (int ni = 0; ni < 2; ++ni)
#pragma unroll
      for (int ks = 0; ks < 4; ++ks) {
        unsigned ur[4], ui[4];
#pragma unroll
        for (int j2 = 0; j2 < 4; ++j2) {
          const int e = 16 * ks + 8 * h + 2 * j2;
          ur[j2] = pack2(wrp[e * 64 + 32 * ni], wrp[(e + 1) * 64 + 32 * ni]);
          ui[j2] = pack2(wip[e * 64 + 32 * ni], wip[(e + 1) * 64 + 32 * ni]);
        }
        uint4 t1 = {ur[0], ur[1], ur[2], ur[3]}, t2 = {ui[0], ui[1], ui[2], ui[3]};
        bwr[ni][ks] = __builtin_bit_cast(bf16x8, t1); bwi[ni][ks] = __builtin_bit_cast(bf16x8, t2);
      }
  }
  __syncthreads();
  {
    const int sc = tid >> 8, c = tid & 255;
    const float cb = p.in[I_LCB][l * 256 + c];
    const float c0 = p.in[I_LCW][(l * 4 + 0) * 256 + c], c1 = p.in[I_LCW][(l * 4 + 1) * 256 + c],
                c2 = p.in[I_LCW][(l * 4 + 2) * 256 + c], c3 = p.in[I_LCW][(l * 4 + 3) * 256 + c];
    for (int t = sc * 32; t < sc * 32 + 32; ++t)
      UB[t * 264 + c] = f2bf(cb + c0 * bf2f(XS[t * 256 + c]) + c1 * bf2f(XS[(t + 1) * 256 + c]) + c2 * bf2f(XS[(t + 2) * 256 + c]) + c3 * bf2f(XS[(t + 3) * 256 + c]));
  }
  __syncthreads();
  f32x16 ar[2], ai[2];
#pragma unroll
  for (int ni = 0; ni < 2; ++ni)
#pragma unroll
    for (int i = 0; i < 16; ++i) { ar[ni][i] = 0.f; ai[ni][i] = 0.f; }
#pragma unroll
  for (int ks = 0; ks < 4; ++ks) {
    const bf16x8 au = *(const bf16x8*)(UB + (32 * mi + r) * 264 + n * 64 + 16 * ks + 8 * h);
#pragma unroll
    for (int ni = 0; ni < 2; ++ni) { ar[ni] = mfma32(au, bwr[ni][ks], ar[ni]); ai[ni] = mfma32(au, bwi[ni][ks], ai[ni]); }
  }
  const int ck = ct * 2 + mi;
#pragma unroll
  for (int ni = 0; ni < 2; ++ni) {
    const int c = n * 64 + 32 * ni + r;
    const float brc = p.in[I_LBR][l * 256 + c], bic = p.in[I_LBI][l * 256 + c];
    const float lamsp = softplusf_(-p.in[I_LLAM][l * 256 + c]);
    float av[16], bv[16];
#pragma unroll
    for (int i = 0; i < 16; ++i) {
      const int tl = 32 * mi + crow(i, h);
      const float u = bf2f(UB[tl * 264 + c]);
      const float rg = sigmoid_rcp(ar[ni][i] + brc), ig = sigmoid_rcp(ai[ni][i] + bic);
      const float la = -8.f * rg * lamsp;
      av[i] = __expf(la);
      bv[i] = __builtin_amdgcn_sqrtf(fmaxf(0.f, 1.f - __expf(2.f * la))) * (ig * u);
    }
    float GA[4], GB[4], PA[4], PB[4];
#pragma unroll
    for (int q = 0; q < 4; ++q) {
      float A = 1.f, hh = 0.f;
#pragma unroll
      for (int e = 0; e < 4; ++e) { hh = av[4 * q + e] * hh + bv[4 * q + e]; A *= av[4 * q + e]; }
      GA[q] = A; GB[q] = hh;
      PA[q] = __shfl_xor(A, 32); PB[q] = __shfl_xor(hh, 32);
    }
    float cin = 0.f;
    if (mode == 1) {
      const int lo = h ? (ck >> 1) : 0, hi = h ? ck : (ck >> 1);
      float A = 1.f, hh = 0.f;
      const float* ca = CA + ((size_t)b * 128) * 256 + c;
      const float* chp = CH + ((size_t)b * 128) * 256 + c;
      int k = lo;
      for (; k + 8 <= hi; k += 8) {
        float a8[8], h8[8];
#pragma unroll
        for (int e = 0; e < 8; ++e) { a8[e] = ca[(size_t)(k + e) * 256]; h8[e] = chp[(size_t)(k + e) * 256]; }
#pragma unroll
        for (int e = 0; e < 8; ++e) { hh = a8[e] * hh + h8[e]; A *= a8[e]; }
      }
      for (; k < hi; ++k) { const float a_ = ca[(size_t)k * 256], h_ = chp[(size_t)k * 256]; hh = a_ * hh + h_; A *= a_; }
      const float pAx = __shfl_xor(A, 32), pHx = __shfl_xor(hh, 32);
      cin = h ? (A * pHx + hh) : (pAx * hh + pHx);
    }
    float cg = cin, Ap = 1.f, myc[4];
#pragma unroll
    for (int q = 0; q < 4; ++q) {
      const float Ae = h ? PA[q] : GA[q], Be = h ? PB[q] : GB[q];
      const float Ao = h ? GA[q] : PA[q], Bo = h ? GB[q] : PB[q];
      const float c_even = cg;
      cg = Ae * cg + Be;
      const float c_odd = cg;
      cg = Ao * cg + Bo;
      myc[q] = h ? c_odd : c_even;
      Ap *= Ae * Ao;
    }
    if (mode == 0) {
      if (h == 0) { CA[((size_t)b * 128 + ck) * 256 + c] = Ap; CH[((size_t)b * 128 + ck) * 256 + c] = cg; }
    } else {
#pragma unroll
      for (int q = 0; q < 4; ++q) {
        float hh = myc[q];
#pragma unroll
        for (int e = 0; e < 4; ++e) {
          const int i = 4 * q + e;
          hh = av[i] * hh + bv[i];
          const size_t tok = (size_t)b * SEQ + ct * 64 + 32 * mi + crow(i, h);
          const float y = bf2f(P[tok * PSTR + C_LRU_Y + c]);
          O[tok * DM + c] = f2bf(hh * gelu_rcp(y));
        }
      }
    }
  }
}

#define XB_TMO      128
#define XB_XCNT(j)  (256  + 64 * (j))
#define XB_XSUB(j)  (1280 + 64 * (j))
#define XB_XGEN(j)  (2304 + 64 * (j))
#define XB_TOP      3328
#define XB_TOPGEN   3392
#define XCD_BAR_WORDS 3456
#define XB_SPIN_CAP (1u << 18)
#define XLAS __attribute__((address_space(3)))
DI unsigned xb_ld(unsigned* p)              { return __hip_atomic_load(p, __ATOMIC_RELAXED, __HIP_MEMORY_SCOPE_AGENT); }
DI unsigned xb_add(unsigned* p, unsigned v) { return __hip_atomic_fetch_add(p, v, __ATOMIC_RELAXED, __HIP_MEMORY_SCOPE_AGENT); }
DI unsigned xb_xcc_id() { return (unsigned)__builtin_amdgcn_s_getreg((3 << 11) | 20) & 0xFu; }
#define XB_SPIN(cond, bar) do { unsigned _sp = 0; while (cond) { __builtin_amdgcn_s_sleep(1); \
    if ((++_sp & 255u) == 0u) { if (xb_ld(&(bar)[XB_TMO])) break; if (_sp > XB_SPIN_CAP) { atomicAdd(&(bar)[XB_TMO], 1u); break; } } } } while (0)
struct XcdBarrier { unsigned* bar; unsigned x; volatile XLAS unsigned* st; };
DI XcdBarrier xcd_barrier_post(unsigned* bar, volatile XLAS unsigned* st) {
  XcdBarrier b; b.bar = bar; b.x = xb_xcc_id(); b.st = st;
  if (threadIdx.x == 0) (void)xb_add(&bar[XB_XCNT(b.x)], 1u);
  return b;
}
DI void xcd_barrier_complete(unsigned* bar, unsigned x, unsigned& nloc, unsigned& nx) {
  const unsigned G = gridDim.x * gridDim.y * gridDim.z;
  unsigned sum, cnt, mine, sp = 0u;
  for (;;) {
    sum = 0u; cnt = 0u; mine = 0u;
#pragma unroll
    for (unsigned j = 0; j < 16; ++j) { const unsigned c = xb_ld(&bar[XB_XCNT(j)]); sum += c; cnt += (c > 0u) ? 1u : 0u; mine = (j == x) ? c : mine; }
    if (sum == G) break;
    __builtin_amdgcn_s_sleep(1);
    if ((++sp & 255u) == 0u) { if (xb_ld(&bar[XB_TMO])) break; if (sp > XB_SPIN_CAP) { atomicAdd(&bar[XB_TMO], 1u); break; } }
  }
  nloc = mine > 0u ? mine : 1u; nx = cnt > 0u ? cnt : 1u;
}
DI void xcd_barrier(const XcdBarrier& b) {
  asm volatile("s_waitcnt vmcnt(0)" ::: "memory");
  __syncthreads();
  if (threadIdx.x == 0) {
    unsigned* bar = b.bar;
    __builtin_amdgcn_s_waitcnt(0);
    unsigned nloc = b.st[0], nx = b.st[1];
    if (nloc == 0u) { xcd_barrier_complete(bar, b.x, nloc, nx); b.st[0] = nloc; b.st[1] = nx; }
    const unsigned old = xb_add(&bar[XB_XSUB(b.x)], 1u);
    const unsigned gen = old / nloc;
    if (old + 1u == (gen + 1u) * nloc) {
      __builtin_amdgcn_fence(__ATOMIC_RELEASE, "agent");
      asm volatile("s_waitcnt vmcnt(0)" ::: "memory");
      const unsigned og = xb_add(&bar[XB_TOP], 1u);
      const unsigned tg = og / nx;
      if (og + 1u == (tg + 1u) * nx) xb_add(&bar[XB_TOPGEN], 1u);
      else XB_SPIN(xb_ld(&bar[XB_TOPGEN]) == tg, bar);
      __builtin_amdgcn_fence(__ATOMIC_ACQUIRE, "agent");
      xb_add(&bar[XB_XGEN(b.x)], 1u);
      asm volatile("s_waitcnt vmcnt(0)" ::: "memory");
    } else {
      XB_SPIN(xb_ld(&bar[XB_XGEN(b.x)]) == gen, bar);
      __builtin_amdgcn_fence(__ATOMIC_ACQUIRE, "agent");
      asm volatile("s_waitcnt vmcnt(0)" ::: "memory");
    }
  }
  __syncthreads();
}

__global__ void __launch_bounds__(NTHR) mega(Params p) {
  extern __shared__ __attribute__((aligned(16))) char smem[];
  cg::grid_group grid = cg::this_grid();
  const int tid = threadIdx.x;
  bf16_t* H = (bf16_t*)(p.ws + OFF_H);
  bf16_t* PB = (bf16_t*)(p.ws + OFF_P);
  PG_LAS unsigned char* lds = (PG_LAS unsigned char*)smem;
  volatile XLAS unsigned* xst = (volatile XLAS unsigned*)(smem + 131072);
  if (tid < 2) xst[tid] = 0u;
  __syncthreads();
  const XcdBarrier xb = xcd_barrier_post((unsigned*)(p.ws + OFF_BAR), xst);

  for (int rep = 0; rep < REP_MISC; ++rep) {
  if (MASK & 1) phase_mod(p, smem);
  grid.sync();
  }
  for (int l = 0; l < 4; ++l) {
    const float* xcur = (l == 0) ? p.in[I_X] : p.out;
    for (int rep = 0; rep < REP_MISC; ++rep) {
    if (MASK & 2) phase_convert(p, l, smem);
    if (MASK & 4) phase_norm(p, xcur, p.in[I_N1G] + l * 1024, l, 1024, 0, H, nullptr);
    xcd_barrier(xb);
    }
    for (int rep = 0; rep < REP_G; ++rep) {
    if (MASK & 8) { pg::Order<1> S; S.init(NTOK, PSTR, gridDim.x, blockIdx.x); pg::EpiBf16<0> E{PB, PSTR, nullptr};
      pg::gemm_phase(lds, H, DM, (const bf16_t*)(p.ws + OFF_WIN), 1024, S, E); }
    xcd_barrier(xb);
    }
    for (int rep = 0; rep < REP_M1; ++rep) {
    for (int it = blockIdx.x; it < 5120; it += gridDim.x) {
      if (it < 2048) { if (MASK & 32) gdn_intra_item(p, l, it, smem); }
      else if (it < 3072) { }
      else if (it < 4096) { if (MASK & 128) lru_item(p, l, it - 3072, smem, 0); }
      else { if (MASK & 16) rw_prep_item(p, l, it - 4096, smem); }
      __syncthreads();
    }
    xcd_barrier(xb);
    }
    for (int rep = 0; rep < REP_M2; ++rep) {
    if (blockIdx.x < 128) {
      { const int pid_ = (blockIdx.x & 7) + 8 * (blockIdx.x >> 4), half_ = (blockIdx.x >> 3) & 1;
        if (MASK & 16) rwkv_scan_item(p, l, pid_ >> 2, pid_ & 3, half_, smem); }
    } else {
      if (blockIdx.x < 192) { if (MASK & 256) gdn_rec_item(p, l, (blockIdx.x - 128) >> 2, (blockIdx.x - 128) & 3, smem); }
      unsigned* ctr = (unsigned*)(p.ws + OFF_CTR) + l * 4 + rep;
      volatile int* slot = (volatile int*)(smem + 110016);
      for (;;) {
        __syncthreads();
        if (tid == 0) *slot = (int)atomicAdd(ctr, 1u);
        __syncthreads();
        const int it = *slot;
        if (it >= 2048) break;
        if (it < 1024) { if (MASK & 64) sb_item(p, it, smem); }
        else { if (MASK & 512) lru_item(p, l, it - 1024, smem, 1); }
      }
    }
    xcd_barrier(xb);
    }
    for (int rep = 0; rep < REP_G; ++rep) {
    for (int half = 0; half < 4; ++half) {
      bf16_t* BH = (bf16_t*)(p.ws + OFF_P + 134217728);
      if (half == 0 && rep == 0) { if (MASK & 16) rwkv_post(p, l); xcd_barrier(xb); }
      if (MASK & 1024) { pg::Order<1> S; S.init(NTOK / 4, 4096, gridDim.x, blockIdx.x, 0, 0, 2, 512); pg::EpiBf16<0> E{BH, 4096, nullptr};
        pg::gemm_phase(lds, (const bf16_t*)(p.ws + OFF_O) + (size_t)half * 16384 * DM, DM, (const bf16_t*)(p.ws + OFF_WBR), 256, S, E); }
      xcd_barrier(xb);
      if (MASK & 1024) { pg::Order<4> S; S.init(NTOK / 4, 1024, gridDim.x, blockIdx.x, 0, 2097152); pg::EpiGateMix E{PB + (size_t)half * 16384 * DM, (float*)(p.ws + OFF_G), BH, p.in[I_BGATE] + (size_t)l * 4096};
        pg::gemm_phase(lds, H + (size_t)half * 16384 * DM, DM, (const bf16_t*)(p.ws + OFF_WG), 1024, S, E); }
      xcd_barrier(xb);
    }
    }
    if (MASK & 2048) { pg::Order<1> S; S.init(NTOK, 1024, gridDim.x, blockIdx.x); pg::EpiResid E{xcur, p.out, (const float*)(p.ws + OFF_MODP), p.in[I_BADA], l, 2048};
      pg::gemm_phase(lds, PB, DM, (const bf16_t*)(p.ws + OFF_WO), 1024, S, E); }
    xcd_barrier(xb);
    for (int rep = 0; rep < REP_MISC; ++rep) {
    if (MASK & 4096) phase_norm(p, p.out, p.in[I_N2G] + l * 1024, l, 4096, 3072, H, nullptr);
    xcd_barrier(xb);
    }
    for (int rep = 0; rep < REP_G; ++rep) {
    if (MASK & 8192) { pg::Order<1> S; S.init(NTOK, FFN, gridDim.x, blockIdx.x); pg::EpiBf16<0> E{PB, FFN, nullptr};
      pg::gemm_phase(lds, H, DM, (const bf16_t*)(p.ws + OFF_WF), 1024, S, E); }
    xcd_barrier(xb);
    if (MASK & 8192) { pg::Order<1> S; S.init(NTOK, FFN, gridDim.x, blockIdx.x); pg::EpiFfnAct E{PB + (size_t)NTOK * FFN, PB, p.in[I_FCW] + (size_t)l * 3 * FFN};
      pg::gemm_phase(lds, H, DM, (const bf16_t*)(p.ws + OFF_WF) + (size_t)FFN * 1024, 1024, S, E); }
    xcd_barrier(xb);
    }
    if (MASK & 32768) { pg::Order<1> S; S.init(NTOK, 1024, gridDim.x, blockIdx.x); pg::EpiResid E{p.out, p.out, (const float*)(p.ws + OFF_MODP), p.in[I_BADA], l, 5120};
      pg::gemm_phase(lds, PB + (size_t)NTOK * FFN, FFN, (const bf16_t*)(p.ws + OFF_WD), FFN, S, E); }
    xcd_barrier(xb);
  }
  if (MASK & 65536) phase_norm(p, p.out, p.in[I_FG], 0, 0, 0, nullptr, p.out);
}

extern "C" void kernel_launch(void* const* d_in, const int* in_sizes, int n_in,
                              void* d_out, int out_size, void* d_ws, size_t ws_size,
                              hipStream_t stream) {
  if (ws_size < WS_NEED || n_in < 38) { fprintf(stderr, "workspace too small: %zu < %zu\n", ws_size, (size_t)WS_NEED); return; }
  (void)hipFuncSetAttribute((const void*)mega, hipFuncAttributeMaxDynamicSharedMemorySize, SMEM_BYTES);
  int dev = 0, cus = 0, per_cu = 0;
  (void)hipGetDevice(&dev);
  (void)hipDeviceGetAttribute(&cus, hipDeviceAttributeMultiprocessorCount, dev);
  (void)hipOccupancyMaxActiveBlocksPerMultiprocessor(&per_cu, mega, NTHR, SMEM_BYTES);
  if (per_cu < 1 || cus < 1) { fprintf(stderr, "occupancy query failed (%d, %d)\n", per_cu, cus); return; }
  if (cus > 256) cus = 256;
  const int grid_blocks = cus;
  Params p{};
  for (int i = 0; i < 38; ++i) p.in[i] = (const float*)d_in[i];
  p.out = (float*)d_out; p.ws = (char*)d_ws;
  (void)hipMemsetAsync((char*)d_ws + OFF_BAR, 0, XCD_BAR_WORDS * 4, stream);
  void* args[] = {&p};
  hipError_t e = hipLaunchCooperativeKernel((void*)mega, dim3(grid_blocks), dim3(NTHR), args, SMEM_BYTES, stream);
  if (e != hipSuccess) fprintf(stderr, "cooperative launch failed: %s (grid %d)\n", hipGetErrorString(e), grid_blocks);
}
```
